# Optimizing an MI355X kernel written in HIP

```python
import math
import jax, jax.numpy as jnp
from jax import lax
import numpy as np

D_MODEL = 1024
BATCH = 8
SEQ = 4096
DEPTH = 4

HEAD_DIM = 64
ROT_DIM = HEAD_DIM // 4
ROPE_THETA = 500000.0
EPS = 1e-6
NEG = -1e30
FORCE_SCORE = 1e9
Q_BLOCK = 128

DSA_HEADS = 8
DSA_WIDTH = DSA_HEADS * HEAD_DIM
DSA_KV_RANK = 128
IDX_HEADS = 4
IDX_DIM = 64
DSA_TOPK_MAX = 256

POOL_GROUPS = 4
POOL_WINDOWS = (2, 4, 8, 16)
POOL_WIDTH = 512
POOL_GDIM = POOL_WIDTH // POOL_GROUPS

NSA_HEADS = 8
NSA_KV_HEADS = 2
NSA_REP = NSA_HEADS // NSA_KV_HEADS
NSA_WIDTH = NSA_HEADS * HEAD_DIM
NSA_KV_COLS = 2 * NSA_KV_HEADS * HEAD_DIM
CMP_LEN = 32
CMP_STRIDE = 16
CMP_HIDDEN = 128
SEL_BLOCK = 64
SEL_N = 8
WINDOW = 256

D_FF = 2816

IN_SPLITS = (
    DSA_WIDTH,
    DSA_KV_RANK,
    IDX_HEADS * IDX_DIM,
    IDX_DIM,
    IDX_HEADS,
    POOL_WIDTH,
    NSA_WIDTH,
    NSA_KV_COLS,
    NSA_KV_COLS,
    NSA_KV_COLS,
    NSA_HEADS * 3,
    3 * D_MODEL,
)
N_IN = sum(IN_SPLITS)

kernel_name = "hybrid_dsa_pool_nsa_macaron"


def rms_norm(x, g):
    x32 = x.astype(jnp.float32)
    y = x32 * lax.rsqrt(jnp.mean(x32 * x32, axis=-1, keepdims=True) + EPS)
    return (y * g.astype(jnp.float32)).astype(x.dtype)


def swiglu(x, w_gate, w_up, w_down):
    return (jax.nn.silu(x @ w_gate) * (x @ w_up)) @ w_down


def rope_tables(positions):
    inv_freq = ROPE_THETA ** (-jnp.arange(0, ROT_DIM, 2, dtype=jnp.float32) / ROT_DIM)
    ang = positions.astype(jnp.float32)[..., None] * inv_freq
    return jnp.cos(ang), jnp.sin(ang)


def partial_rope(x, cos, sin):
    half = ROT_DIM // 2
    shape = cos.shape[:2] + (1,) * (x.ndim - 3) + (half,)
    c = cos.reshape(shape)
    s = sin.reshape(shape)
    x1 = x[..., :half].astype(jnp.float32)
    x2 = x[..., half:ROT_DIM].astype(jnp.float32)
    r1 = (x1 * c - x2 * s).astype(x.dtype)
    r2 = (x2 * c + x1 * s).astype(x.dtype)
    return jnp.concatenate([r1, r2, x[..., ROT_DIM:]], axis=-1)


def masked_softmax(s, mask):
    return jax.nn.softmax(jnp.where(mask, s.astype(jnp.float32), NEG), axis=-1)


def dsa_mixer(q, c_kv, iq, ik, iw, kv_norm, w_ukv, cos, sin):
    B, S = q.shape[:2]
    q = partial_rope(q.reshape(B, S, DSA_HEADS, HEAD_DIM), cos, sin) * (HEAD_DIM ** -0.5)
    kv = rms_norm(c_kv, kv_norm) @ w_ukv
    k = partial_rope(kv[..., :HEAD_DIM], cos, sin)
    v = kv[..., HEAD_DIM:]
    iq = partial_rope(iq.reshape(B, S, IDX_HEADS, IDX_DIM), cos, sin) * (IDX_DIM ** -0.5)
    ik = partial_rope(ik, cos, sin)
    iw = (iw * (IDX_HEADS ** -0.5)).astype(jnp.float32)
    top_k = min(DSA_TOPK_MAX, S // 4)
    key_pos = jnp.arange(S)
    gather = jax.vmap(lambda table, idx: table[idx])

    def block(q0):
        t = q0 + jnp.arange(Q_BLOCK)
        qb = lax.dynamic_slice_in_dim(q, q0, Q_BLOCK, axis=1)
        iqb = lax.dynamic_slice_in_dim(iq, q0, Q_BLOCK, axis=1)
        iwb = lax.dynamic_slice_in_dim(iw, q0, Q_BLOCK, axis=1)
        logits = jnp.einsum('bqhd,bsd->bqhs', iqb, ik).astype(jnp.float32)
        score = jnp.einsum('bqhs,bqh->bqs', jax.nn.relu(logits), iwb)
        score = jnp.where(key_pos[None, None, :] <= t[None, :, None], score, NEG)
        _, sel = lax.top_k(score, top_k)
        kg = gather(k, sel)
        vg = gather(v, sel)
        s = jnp.einsum('bqhd,bqkd->bhqk', qb, kg)
        p = masked_softmax(s, (sel <= t[None, :, None])[:, None])
        return jnp.einsum('bhqk,bqkd->bqhd', p.astype(vg.dtype), vg)

    out = lax.map(block, jnp.arange(S // Q_BLOCK) * Q_BLOCK)
    return out.transpose(1, 0, 2, 3, 4).reshape(B, S, DSA_WIDTH)


def pool_mixer(u, pool_w, pool_scale):
    B, S, _ = u.shape
    u32 = u.reshape(B, S, POOL_GROUPS, POOL_GDIM).astype(jnp.float32)
    csum = jnp.pad(jnp.cumsum(u32, axis=1), ((0, 0), (1, 0), (0, 0), (0, 0)))
    t = jnp.arange(S)
    pooled = []
    for g, w in enumerate(POOL_WINDOWS):
        lo = jnp.maximum(t + 1 - w, 0)
        cnt = (t + 1 - lo).astype(jnp.float32)
        win_sum = csum[:, 1:, g] - csum[:, lo, g]
        pooled.append(win_sum / cnt[None, :, None] - u32[:, :, g])
    pooled = jnp.stack(pooled, axis=2).astype(u.dtype)
    y = jnp.einsum('bsgc,gcd->bsgd', pooled, pool_w)
    return y.reshape(B, S, POOL_WIDTH) * pool_scale


def nsa_mixer(q, kv_cmp, kv_sel, kv_win, gates, cmp_pos, cmp_w1, cmp_w2, cos, sin):
    B, S = q.shape[:2]
    G, R = NSA_KV_HEADS, NSA_REP
    q = partial_rope(q.reshape(B, S, G, R, HEAD_DIM), cos, sin) * (HEAD_DIM ** -0.5)

    def split_kv(kv):
        kv = kv.reshape(B, S, 2, G, HEAD_DIM)
        return partial_rope(kv[:, :, 0], cos, sin), kv[:, :, 1]

    kc_tok, vc_tok = split_kv(kv_cmp)
    ks, vs = split_kv(kv_sel)
    kw, vw = split_kv(kv_win)

    n_cmp = (S - CMP_LEN) // CMP_STRIDE + 1
    cmp_start = jnp.arange(n_cmp) * CMP_STRIDE
    cmp_end = cmp_start + CMP_LEN - 1
    tok_idx = cmp_start[:, None] + jnp.arange(CMP_LEN)[None, :]

    def compress(x, pos, w1, w2):
        blocks = x[:, tok_idx] + pos[None, None, :, None, :]
        flat = blocks.transpose(0, 1, 3, 2, 4).reshape(B, n_cmp, G, CMP_LEN * HEAD_DIM)
        return jax.nn.gelu(flat @ w1) @ w2

    kc = compress(kc_tok, cmp_pos[0], cmp_w1[0], cmp_w2[0])
    vc = compress(vc_tok, cmp_pos[1], cmp_w1[1], cmp_w2[1])

    n_blk = S // SEL_BLOCK
    blk = jnp.arange(n_blk)
    sel_start = blk * SEL_BLOCK
    overlap = jnp.clip(jnp.minimum(cmp_end[:, None], sel_start[None, :] + SEL_BLOCK - 1)
                       - jnp.maximum(cmp_start[:, None], sel_start[None, :]) + 1, 0)
    cmp_to_sel = overlap.astype(jnp.float32) / CMP_LEN
    n_sel = min(SEL_N, n_blk)

    ks_g = ks.transpose(0, 2, 1, 3)
    vs_g = vs.transpose(0, 2, 1, 3)
    kw_pad = jnp.pad(kw, ((0, 0), (WINDOW, 0), (0, 0), (0, 0)))
    vw_pad = jnp.pad(vw, ((0, 0), (WINDOW, 0), (0, 0), (0, 0)))
    gate = jax.nn.sigmoid(gates.reshape(B, S, G, R, 3).astype(jnp.float32)).astype(q.dtype)
    gather = jax.vmap(jax.vmap(lambda table, idx: table[idx]))
    blk_off = jnp.arange(SEL_BLOCK)
    win_off = jnp.arange(WINDOW + Q_BLOCK) - WINDOW

    def block(q0):
        t = q0 + jnp.arange(Q_BLOCK)
        qb = lax.dynamic_slice_in_dim(q, q0, Q_BLOCK, axis=1)
        gb = lax.dynamic_slice_in_dim(gate, q0, Q_BLOCK, axis=1)
        s_c = jnp.einsum('bqgrd,bngd->bgrqn', qb, kc)
        m_c = cmp_end[None, :] <= t[:, None]
        p_c = masked_softmax(s_c, m_c) * jnp.any(m_c, axis=-1)[:, None]
        o_c = jnp.einsum('bgrqn,bngd->bqgrd', p_c.astype(vc.dtype), vc)
        imp = jnp.einsum('bgrqn,nj->bgqj', p_c, cmp_to_sel)
        forced = (blk[None, :] == 0) | (blk[None, :] == (t // SEL_BLOCK)[:, None])
        admissible = sel_start[None, :] <= t[:, None]
        imp = jnp.where(forced, FORCE_SCORE, jnp.where(admissible, imp, NEG))
        _, sel = lax.top_k(imp, n_sel)
        tok = (sel[..., None] * SEL_BLOCK + blk_off).reshape(B, G, Q_BLOCK, n_sel * SEL_BLOCK)
        k_s = gather(ks_g, tok)
        v_s = gather(vs_g, tok)
        s_s = jnp.einsum('bqgrd,bgqtd->bgrqt', qb, k_s)
        p_s = masked_softmax(s_s, (tok <= t[None, None, :, None])[:, :, None])
        o_s = jnp.einsum('bgrqt,bgqtd->bqgrd', p_s.astype(v_s.dtype), v_s)
        k_w = lax.dynamic_slice_in_dim(kw_pad, q0, WINDOW + Q_BLOCK, axis=1)
        v_w = lax.dynamic_slice_in_dim(vw_pad, q0, WINDOW + Q_BLOCK, axis=1)
        kpos = q0 + win_off
        diff = t[:, None] - kpos[None, :]
        m_w = (kpos[None, :] >= 0) & (diff >= 0) & (diff < WINDOW)
        s_w = jnp.einsum('bqgrd,bkgd->bgrqk', qb, k_w)
        p_w = masked_softmax(s_w, m_w)
        o_w = jnp.einsum('bgrqk,bkgd->bqgrd', p_w.astype(v_w.dtype), v_w)
        o = gb[..., 0:1] * o_c + gb[..., 1:2] * o_s + gb[..., 2:3] * o_w
        return o.reshape(B, Q_BLOCK, NSA_WIDTH)

    out = lax.map(block, jnp.arange(S // Q_BLOCK) * Q_BLOCK)
    return out.transpose(1, 0, 2, 3).reshape(B, S, NSA_WIDTH)


def setup_inputs(seed: int = 0) -> dict:
    key = jax.random.key(seed)
    ks = jax.random.split(key, 32)

    def nrm(k, shape, scale):
        return jax.random.normal(k, shape, jnp.float32) * scale

    def gain(k, shape):
        return 1.0 + 0.05 * jax.random.normal(k, shape, jnp.float32)

    L, D, F = DEPTH, D_MODEL, D_FF
    start = jax.random.randint(ks[1], (BATCH, 1), 0, 1024)
    positions = (start + jnp.arange(SEQ, dtype=jnp.int32)[None, :]).astype(jnp.int32)
    return {
        "x": nrm(ks[0], (BATCH, SEQ, D), 1.0),
        "positions": positions,
        "ffn1_norm": gain(ks[2], (L, D)),
        "ffn1_gate": nrm(ks[3], (L, D, F), D ** -0.5),
        "ffn1_up": nrm(ks[4], (L, D, F), D ** -0.5),
        "ffn1_down": nrm(ks[5], (L, F, D), F ** -0.5),
        "mix_norm": gain(ks[6], (L, D)),
        "w_in": nrm(ks[7], (L, D, N_IN), D ** -0.5),
        "dsa_kv_norm": gain(ks[8], (L, DSA_KV_RANK)),
        "dsa_w_ukv": nrm(ks[9], (L, DSA_KV_RANK, 2 * HEAD_DIM), DSA_KV_RANK ** -0.5),
        "pool_w": nrm(ks[10], (L, POOL_GROUPS, POOL_GDIM, POOL_GDIM), POOL_GDIM ** -0.5),
        "pool_scale": gain(ks[11], (L, POOL_WIDTH)),
        "nsa_cmp_pos": nrm(ks[12], (L, 2, CMP_LEN, HEAD_DIM), 0.02),
        "nsa_cmp_w1": nrm(ks[13], (L, 2, CMP_LEN * HEAD_DIM, CMP_HIDDEN), (CMP_LEN * HEAD_DIM) ** -0.5),
        "nsa_cmp_w2": nrm(ks[14], (L, 2, CMP_HIDDEN, HEAD_DIM), CMP_HIDDEN ** -0.5),
        "proj_a": nrm(ks[15], (L, DSA_WIDTH, D), DSA_WIDTH ** -0.5),
        "proj_b": nrm(ks[16], (L, POOL_WIDTH, D), POOL_WIDTH ** -0.5),
        "proj_c": nrm(ks[17], (L, NSA_WIDTH, D), NSA_WIDTH ** -0.5),
        "w_out": nrm(ks[18], (L, D, D), D ** -0.5),
        "ffn2_norm": gain(ks[19], (L, D)),
        "ffn2_gate": nrm(ks[20], (L, D, F), D ** -0.5),
        "ffn2_up": nrm(ks[21], (L, D, F), D ** -0.5),
        "ffn2_down": nrm(ks[22], (L, F, D), F ** -0.5),
        "final_norm": gain(ks[23], (D,)),
    }


def reference(x, positions, ffn1_norm, ffn1_gate, ffn1_up, ffn1_down, mix_norm, w_in,
              dsa_kv_norm, dsa_w_ukv, pool_w, pool_scale, nsa_cmp_pos, nsa_cmp_w1, nsa_cmp_w2,
              proj_a, proj_b, proj_c, w_out, ffn2_norm, ffn2_gate, ffn2_up, ffn2_down, final_norm):
    cos, sin = rope_tables(positions)
    offsets = [int(o) for o in np.cumsum(IN_SPLITS)[:-1]]
    for l in range(DEPTH):
        x = x + 0.5 * swiglu(rms_norm(x, ffn1_norm[l]), ffn1_gate[l], ffn1_up[l], ffn1_down[l])
        h = rms_norm(x, mix_norm[l])
        (a_q, a_ckv, a_iq, a_ik, a_iw, b_u, c_q, c_kv_cmp, c_kv_sel, c_kv_win, c_gate,
         merge_gate) = jnp.split(h @ w_in[l], offsets, axis=-1)
        y_a = dsa_mixer(a_q, a_ckv, a_iq, a_ik, a_iw, dsa_kv_norm[l], dsa_w_ukv[l], cos, sin)
        y_b = pool_mixer(b_u, pool_w[l], pool_scale[l])
        y_c = nsa_mixer(c_q, c_kv_cmp, c_kv_sel, c_kv_win, c_gate,
                        nsa_cmp_pos[l], nsa_cmp_w1[l], nsa_cmp_w2[l], cos, sin)
        g_a, g_b, g_c = jnp.split(jax.nn.sigmoid(merge_gate), 3, axis=-1)
        merged = g_a * (y_a @ proj_a[l]) + g_b * (y_b @ proj_b[l]) + g_c * (y_c @ proj_c[l])
        x = x + merged @ w_out[l]
        x = x + 0.5 * swiglu(rms_norm(x, ffn2_norm[l]), ffn2_gate[l], ffn2_up[l], ffn2_down[l])
    return rms_norm(x, final_norm)
```

```cpp
#include <hip/hip_runtime.h>
#include <cstdio>
#include <cstdint>
#ifndef MK_ONE_LAUNCH
#define MK_ONE_LAUNCH 0
#endif
namespace pg8 {
#define PG8_LAS __attribute__((address_space(3)))
typedef unsigned short bf16_t;
typedef short bf16x8 __attribute__((ext_vector_type(8)));
typedef float f32x4 __attribute__((ext_vector_type(4)));
typedef unsigned u32x4 __attribute__((ext_vector_type(4)));
constexpr int BM = 256, BK = 64, HALF = 128, HTB = HALF * BK * 2  , STAGE_BYTES = 8 * HTB, NXCD = 8, WGM = 8;

__host__ __device__ __forceinline__ int lds_byte(int r, int c) { const int st = (r >> 4) * 2 + (c >> 5), rr = r & 15, cc = c & 31, ob = rr * 64 + cc * 2; return st * 1024 + (ob ^ (((ob >> 9) & 1) << 5)); }
__host__ __device__ __forceinline__ void stage_rc(int b, int& R, int& C) { const int st = b / 1024, sb = b % 1024, swz = sb ^ (((sb >> 9) & 1) << 5); R = (st >> 1) * 16 + swz / 64; C = (st & 1) * 32 + (swz % 64) / 2; }
__host__ __device__ __forceinline__ int perm32(int rho) { const int n = rho >> 4, i = rho & 15; return 8 * (i >> 2) + 4 * n + (i & 3); }

struct Unit { int pm, pn; };
struct Gemm { const bf16_t* A; const bf16_t* Bt; int M, N, K; };

struct StaticOrder {
    int nM, nN, nwg, G, c;
    __host__ __device__ void init(int M, int N, int G_, int c_) { nM = M / BM; nN = N / BM; nwg = nM * nN; G = G_; c = c_; }
    __host__ __device__ bool next(int i, Unit& u) const {
        const long L = (long)i * G + c; if (L >= nwg) return false;
        int wgid = (int)L; { const int q = nwg / NXCD, r = nwg % NXCD, xcd = wgid % NXCD, off = wgid / NXCD; wgid = (xcd < r ? xcd * (q + 1) : r * (q + 1) + (xcd - r) * q) + off; }
        const int nig = WGM * nN, gid = wgid / nig, fm = gid * WGM, gsz = (nM - fm) < WGM ? (nM - fm) : WGM;
        u.pm = fm + ((wgid % nig) % gsz); u.pn = (wgid % nig) / gsz; return true;
    }
    __device__ __forceinline__ void a_ready(const Unit&) const {}
    __device__ __forceinline__ void done(const Unit&) const {}
};

__device__ __forceinline__ unsigned cvt_pk_bf16(float lo, float hi) { unsigned r; asm volatile("v_cvt_pk_bf16_f32 %0, %1, %2" : "=v"(r) : "v"(lo), "v"(hi)); return r; }
__device__ __forceinline__ float bflo(unsigned w) { return __uint_as_float(w << 16); }
__device__ __forceinline__ float bfhi(unsigned w) { return __uint_as_float(w & 0xffff0000u); }
__device__ __forceinline__ float fast_sigmoid(float x) { return __builtin_amdgcn_rcpf(1.0f + __expf(-x)); }

struct EpiSwiglu {
    static constexpr bool PERM = true, AFTER_DRAIN = false;
    bf16_t* H; int ldh;
    __device__ __forceinline__ void operator()(const f32x4 (&acc)[2][2][4][2], const Unit& u, int wr, int wc, int fr, int fq) const {
        const int row0 = u.pm * BM + wr * 64 + fr, col0 = u.pn * HALF + wc * 32 + 8 * fq;
#pragma unroll
        for (int ai = 0; ai < 2; ++ai)
#pragma unroll
            for (int m = 0; m < 4; ++m) {
                bf16_t* rowp = H + (size_t)(row0 + ai * HALF + m * 16) * ldh + col0;
                float o[8];
#pragma unroll
                for (int n = 0; n < 2; ++n)
#pragma unroll
                    for (int e = 0; e < 4; ++e) { const float g = acc[ai][0][m][n][e], up = acc[ai][1][m][n][e]; o[n * 4 + e] = g * fast_sigmoid(g) * up; }
                u32x4 w; w.x = cvt_pk_bf16(o[0], o[1]); w.y = cvt_pk_bf16(o[2], o[3]); w.z = cvt_pk_bf16(o[4], o[5]); w.w = cvt_pk_bf16(o[6], o[7]);
                *(u32x4*)rowp = w;
            }
    }
};
struct EpiResid {
    static constexpr bool PERM = true, AFTER_DRAIN = false;
    const float* base; float* out; float s;
    __device__ __forceinline__ void operator()(const f32x4 (&acc)[2][2][4][2], const Unit& u, int wr, int wc, int fr, int fq) const {
        const int row0 = u.pm * BM + wr * 64 + fr, col0 = u.pn * BM + wc * 32 + 8 * fq;
#pragma unroll
        for (int ai = 0; ai < 2; ++ai)
#pragma unroll
            for (int m = 0; m < 4; ++m) {
                const size_t off = (size_t)(row0 + ai * HALF + m * 16) * 1024 + col0;
#pragma unroll
                for (int bj = 0; bj < 2; ++bj) {
                    const f32x4 b0 = *(const f32x4*)(base + off + bj * HALF), b1 = *(const f32x4*)(base + off + bj * HALF + 4);
                    *(f32x4*)(out + off + bj * HALF) = b0 + acc[ai][bj][m][0] * s; *(f32x4*)(out + off + bj * HALF + 4) = b1 + acc[ai][bj][m][1] * s;
                }
            }
    }
};
template <int MODE> struct EpiProj {
    static constexpr bool PERM = true, AFTER_DRAIN = false;
    bf16_t* MG; const bf16_t* G; int gofs;
    __device__ __forceinline__ void operator()(const f32x4 (&acc)[2][2][4][2], const Unit& u, int wr, int wc, int fr, int fq) const {
        const int row0 = u.pm * BM + wr * 64 + fr, col0 = u.pn * BM + wc * 32 + 8 * fq;
#pragma unroll
        for (int ai = 0; ai < 2; ++ai)
#pragma unroll
            for (int m = 0; m < 4; ++m) {
                const size_t row = (size_t)(row0 + ai * HALF + m * 16);
#pragma unroll
                for (int bj = 0; bj < 2; ++bj) {
                    const u32x4 gv = *(const u32x4*)(G + row * 3072 + gofs + col0 + bj * HALF);
                    bf16_t* mp = MG + row * 1024 + col0 + bj * HALF;
                    const f32x4 a0 = acc[ai][bj][m][0], a1 = acc[ai][bj][m][1];
                    float o[8] = {bflo(gv.x) * a0[0], bfhi(gv.x) * a0[1], bflo(gv.y) * a0[2], bfhi(gv.y) * a0[3], bflo(gv.z) * a1[0], bfhi(gv.z) * a1[1], bflo(gv.w) * a1[2], bfhi(gv.w) * a1[3]};
                    if (MODE) { const u32x4 ov = *(const u32x4*)mp; o[0] += bflo(ov.x); o[1] += bfhi(ov.x); o[2] += bflo(ov.y); o[3] += bfhi(ov.y); o[4] += bflo(ov.z); o[5] += bfhi(ov.z); o[6] += bflo(ov.w); o[7] += bfhi(ov.w); }
                    u32x4 w; w.x = cvt_pk_bf16(o[0], o[1]); w.y = cvt_pk_bf16(o[2], o[3]); w.z = cvt_pk_bf16(o[4], o[5]); w.w = cvt_pk_bf16(o[6], o[7]);
                    *(u32x4*)mp = w;
                }
            }
    }
};
struct EpiWin {
    static constexpr bool PERM = true, AFTER_DRAIN = false;
    bf16_t *QA, *QC, *IQ, *MISC, *KVC, *KVS, *KVW, *BU, *G; const float* rope;
    __device__ __forceinline__ void operator()(const f32x4 (&acc)[2][2][4][2], const Unit& u, int wr, int wc, int fr, int fq) const {
        const int pn = u.pn;
        bf16_t* dst; int ld, cbase, mode;
        if (pn < 2) { dst = QA; ld = 512; cbase = pn * 256; mode = 1; }
        else if (pn < 4) { dst = QC; ld = 512; cbase = (pn - 2) * 256; mode = 1; }
        else if (pn == 4) { dst = IQ; ld = 256; cbase = 0; mode = 1; }
        else if (pn == 5) { dst = MISC; ld = 256; cbase = 0; mode = 3; }
        else if (pn <= 8) { dst = pn == 6 ? KVC : (pn == 7 ? KVS : KVW); ld = 256; cbase = 0; mode = 2; }
        else if (pn <= 10) { dst = BU; ld = 512; cbase = (pn - 9) * 256; mode = 0; }
        else { dst = G; ld = 3072; cbase = (pn - 11) * 256; mode = 4; }
        const int row0 = u.pm * BM + wr * 64 + fr, col0 = cbase + wc * 32 + 8 * fq;
        const bool ropelane = ((wc & 1) == 0) && fq < 2;
        const float sc = (mode == 1) ? 0.125f : 1.0f;
#pragma unroll
        for (int ai = 0; ai < 2; ++ai)
#pragma unroll
            for (int m = 0; m < 4; ++m) {
                const size_t row = (size_t)(row0 + ai * HALF + m * 16);
                f32x4 cs = {1.f, 1.f, 1.f, 1.f}, sn = {0.f, 0.f, 0.f, 0.f};
                if (ropelane && mode >= 1 && mode <= 3) { cs = *(const f32x4*)(rope + row * 16 + 4 * fq); sn = *(const f32x4*)(rope + row * 16 + 8 + 4 * fq); }
#pragma unroll
                for (int bj = 0; bj < 2; ++bj) {
                    const f32x4 a0 = acc[ai][bj][m][0], a1 = acc[ai][bj][m][1];
                    float o[8] = {a0[0], a0[1], a0[2], a0[3], a1[0], a1[1], a1[2], a1[3]};
                    const bool dorope = ropelane && (mode == 1 || (mode == 2 && bj == 0) || (mode == 3 && bj == 0 && wc == 0));
                    if (dorope) {
#pragma unroll
                        for (int p = 0; p < 4; ++p) { const float x1 = o[2 * p], x2 = o[2 * p + 1]; o[2 * p] = x1 * cs[p] - x2 * sn[p]; o[2 * p + 1] = x2 * cs[p] + x1 * sn[p]; }
                    }
                    if (mode == 4) {
#pragma unroll
                        for (int e = 0; e < 8; ++e) o[e] = fast_sigmoid(o[e]);
                    } else {
#pragma unroll
                        for (int e = 0; e < 8; ++e) o[e] *= sc;
                    }
                    u32x4 w; w.x = cvt_pk_bf16(o[0], o[1]); w.y = cvt_pk_bf16(o[2], o[3]); w.z = cvt_pk_bf16(o[4], o[5]); w.w = cvt_pk_bf16(o[6], o[7]);
                    *(u32x4*)(dst + row * ld + col0 + bj * HALF) = w;
                }
            }
    }
};

template <class Epi, class Sched, bool ALIGN_EPI = false, bool SP2 = false>
__device__ __forceinline__ void gemm_phase(PG8_LAS unsigned char* lds, const Gemm g, const Sched& S, const Epi& E) {
    int tid_ = threadIdx.x; asm volatile("" : "+v"(tid_));
    const int tid = tid_, wid = __builtin_amdgcn_readfirstlane(tid >> 6), lane = tid & 63, wr = wid >> 2, wc = wid & 3, fr = lane & 15, fq = lane >> 4;
    const int K = g.K, nt = K / BK;
    unsigned voffA[2], voffB[2];
#pragma unroll
    for (int i = 0; i < 2; ++i) { int R, C; stage_rc(tid * 16 + i * 8192, R, C); const int Rb = Epi::PERM ? ((R & ~31) + perm32(R & 31)) : R;
        voffA[i] = (unsigned)(R * K + C) * 2u; voffB[i] = (unsigned)(Rb * K + C) * 2u; }
    const size_t kstep = (size_t)(BK * 2);
    const size_t hstep = (size_t)HALF * K * 2;
    const size_t tstep = 2 * hstep;
    const unsigned ldsw = (unsigned)wid * 1024u;
    const int aoff = lds_byte(wr * 64 + fr, fq * 8), boff = lds_byte(wc * 32 + fr, fq * 8);
#define PG8_SA(b, h) (((b) * 2 + (h)) * HTB)
#define PG8_SB(b, h) ((4 + (b) * 2 + (h)) * HTB)
#define PG8_STAGE(bufoff, gbase, voff) do { _Pragma("unroll") for (int _i = 0; _i < 2; ++_i) \
        __builtin_amdgcn_global_load_lds((const unsigned*)((const char*)(gbase) + (voff)[_i]), (PG8_LAS unsigned*)(lds + (bufoff) + ldsw + _i * 8192), 16, 0, 0); } while (0)
#define PG8_LDA(dst, b, h) do { _Pragma("unroll") for (int m = 0; m < 4; ++m) _Pragma("unroll") for (int k = 0; k < 2; ++k) dst[m][k] = *(const PG8_LAS bf16x8*)(lds + PG8_SA(b, h) + aoff + m * 2048 + k * 1024); } while (0)
#define PG8_LDB(dst, b, h) do { _Pragma("unroll") for (int n = 0; n < 2; ++n) _Pragma("unroll") for (int k = 0; k < 2; ++k) dst[n][k] = *(const PG8_LAS bf16x8*)(lds + PG8_SB(b, h) + boff + n * 2048 + k * 1024); } while (0)
#define PG8_MMA(ai, bj, At, Bt) do { __builtin_amdgcn_s_setprio(1); _Pragma("unroll") for (int m = 0; m < 4; ++m) _Pragma("unroll") for (int n = 0; n < 2; ++n) _Pragma("unroll") for (int k = 0; k < 2; ++k) \
        acc[ai][bj][m][n] = __builtin_amdgcn_mfma_f32_16x16x32_bf16(Bt[n][k], At[m][k], acc[ai][bj][m][n], 0, 0, 0); __builtin_amdgcn_s_setprio(0); } while (0)
#define PG8_WAIT_V(n) asm volatile("s_waitcnt vmcnt(" #n ")" ::: "memory")
#define PG8_WAIT_L(n) asm volatile("s_waitcnt lgkmcnt(" #n ")" ::: "memory")
#define PG8_BAR __builtin_amdgcn_s_barrier()
#define PG8_SCHED __builtin_amdgcn_sched_barrier(0)
    Unit cur, nxt; int ui = 0;
    if (!S.next(0, cur)) return;
    f32x4 acc[2][2][4][2];
#pragma unroll
    for (int a = 0; a < 2; ++a)
#pragma unroll
        for (int b = 0; b < 2; ++b)
#pragma unroll
            for (int m = 0; m < 4; ++m)
#pragma unroll
                for (int n = 0; n < 2; ++n) acc[a][b][m][n] = (f32x4){0.f, 0.f, 0.f, 0.f};
    bf16x8 At[4][2], B0[2][2], B1[2][2];
    const char* cA = (const char*)g.A + (size_t)cur.pm * tstep; const char* cB = (const char*)g.Bt + (size_t)cur.pn * tstep;
    S.a_ready(cur);
    if constexpr (SP2) {
        PG8_STAGE(PG8_SB(0, 0), cB, voffB); PG8_STAGE(PG8_SB(0, 1), cB + hstep, voffB); PG8_STAGE(PG8_SA(0, 0), cA, voffA); PG8_STAGE(PG8_SA(0, 1), cA + hstep, voffA);
        if (wr == 1) PG8_BAR;
        PG8_WAIT_V(2); PG8_BAR;
        PG8_STAGE(PG8_SB(1, 0), cB + kstep, voffB); PG8_STAGE(PG8_SA(1, 0), cA + kstep, voffA); PG8_STAGE(PG8_SB(1, 1), cB + hstep + kstep, voffB);
        PG8_WAIT_V(6); PG8_BAR;
    } else {
        PG8_STAGE(PG8_SB(0, 0), cB, voffB); PG8_STAGE(PG8_SA(0, 0), cA, voffA); PG8_STAGE(PG8_SB(0, 1), cB + hstep, voffB); PG8_STAGE(PG8_SA(0, 1), cA + hstep, voffA);
        if (wr == 1) PG8_BAR;
        PG8_WAIT_V(4); PG8_BAR;
        PG8_STAGE(PG8_SB(1, 0), cB + kstep, voffB); PG8_STAGE(PG8_SA(1, 0), cA + kstep, voffA); PG8_STAGE(PG8_SB(1, 1), cB + hstep + kstep, voffB);
        PG8_WAIT_V(6); PG8_BAR;
    }
    for (;;) {
        const bool has_next = S.next(ui + 1, nxt);
        const char* nA = has_next ? (const char*)g.A + (size_t)nxt.pm * tstep : cA; const char* nB = has_next ? (const char*)g.Bt + (size_t)nxt.pn * tstep : cB;
        for (int t = 0; t < nt; t += 2) {
            const bool last = (t == nt - 2);
            const char* a1 = cA + (size_t)(t + 1) * kstep;
            const char* a2 = last ? nA : cA + (size_t)(t + 2) * kstep; const char* b2 = last ? nB : cB + (size_t)(t + 2) * kstep;
            const char* a3 = a2 + kstep; const char* b3 = b2 + kstep;
            if (last && has_next) S.a_ready(nxt);
            if constexpr (SP2) {
            PG8_LDB(B0, 0, 0); PG8_LDB(B1, 0, 1); PG8_SCHED; PG8_LDA(At, 0, 0); PG8_STAGE(PG8_SA(1, 1), a1 + hstep, voffA);
            PG8_WAIT_V(8); PG8_WAIT_L(0); PG8_BAR; PG8_MMA(0, 0, At, B0); PG8_MMA(0, 1, At, B1); PG8_BAR; PG8_SCHED;
            PG8_LDA(At, 0, 1); PG8_STAGE(PG8_SB(0, 0), b2, voffB); PG8_STAGE(PG8_SB(0, 1), b2 + hstep, voffB); PG8_STAGE(PG8_SA(0, 0), a2, voffA);
            PG8_WAIT_V(8); PG8_WAIT_L(0); PG8_BAR; PG8_MMA(1, 0, At, B0); PG8_MMA(1, 1, At, B1); PG8_BAR; PG8_SCHED;
            PG8_LDB(B0, 1, 0); PG8_LDB(B1, 1, 1); PG8_SCHED; PG8_LDA(At, 1, 0); PG8_STAGE(PG8_SA(0, 1), a2 + hstep, voffA);
            PG8_WAIT_V(8); PG8_WAIT_L(0); PG8_BAR; PG8_MMA(0, 0, At, B0); PG8_MMA(0, 1, At, B1); PG8_BAR; PG8_SCHED;
            PG8_LDA(At, 1, 1); PG8_STAGE(PG8_SB(1, 0), b3, voffB); PG8_STAGE(PG8_SB(1, 1), b3 + hstep, voffB); PG8_STAGE(PG8_SA(1, 0), a3, voffA);
            PG8_WAIT_V(8); PG8_WAIT_L(0); PG8_BAR; PG8_MMA(1, 0, At, B0); PG8_MMA(1, 1, At, B1); PG8_BAR; PG8_SCHED;
            } else {
            PG8_LDB(B0, 0, 0); PG8_SCHED; PG8_LDA(At, 0, 0); PG8_STAGE(PG8_SA(1, 1), a1 + hstep, voffA);
            PG8_WAIT_L(8); PG8_BAR; PG8_WAIT_L(0); PG8_MMA(0, 0, At, B0); PG8_BAR; PG8_SCHED;
            PG8_LDB(B1, 0, 1); PG8_STAGE(PG8_SB(0, 0), b2, voffB);
            PG8_BAR; PG8_WAIT_L(0); PG8_MMA(0, 1, At, B1); PG8_BAR;
            PG8_LDA(At, 0, 1); PG8_STAGE(PG8_SA(0, 0), a2, voffA);
            PG8_BAR; PG8_WAIT_L(0); PG8_MMA(1, 0, At, B0); PG8_BAR; PG8_SCHED;
            PG8_STAGE(PG8_SB(0, 1), b2 + hstep, voffB);
            PG8_WAIT_V(6); PG8_BAR; PG8_MMA(1, 1, At, B1); PG8_BAR;
            PG8_LDB(B0, 1, 0); PG8_SCHED; PG8_LDA(At, 1, 0); PG8_STAGE(PG8_SA(0, 1), a2 + hstep, voffA);
            PG8_WAIT_L(8); PG8_BAR; PG8_WAIT_L(0); PG8_MMA(0, 0, At, B0); PG8_BAR; PG8_SCHED;
            PG8_LDB(B1, 1, 1); PG8_STAGE(PG8_SB(1, 0), b3, voffB);
            PG8_BAR; PG8_WAIT_L(0); PG8_MMA(0, 1, At, B1); PG8_BAR;
            PG8_LDA(At, 1, 1); PG8_STAGE(PG8_SA(1, 0), a3, voffA);
            PG8_BAR; PG8_WAIT_L(0); PG8_MMA(1, 0, At, B0); PG8_BAR; PG8_SCHED;
            PG8_STAGE(PG8_SB(1, 1), b3 + hstep, voffB);
            PG8_WAIT_V(6); PG8_BAR; PG8_MMA(1, 1, At, B1); PG8_BAR;
            }
        }
        if constexpr (ALIGN_EPI) { if (wr == 0) PG8_BAR; }
        if constexpr (!Epi::AFTER_DRAIN) { E(acc, cur, wr, wc, fr, fq); S.done(cur); }
        if (!has_next) break;
#pragma unroll
        for (int a = 0; a < 2; ++a)
#pragma unroll
            for (int b = 0; b < 2; ++b)
#pragma unroll
                for (int m = 0; m < 4; ++m)
#pragma unroll
                    for (int n = 0; n < 2; ++n) acc[a][b][m][n] = (f32x4){0.f, 0.f, 0.f, 0.f};
        cur = nxt; cA = nA; cB = nB; ++ui;
        if constexpr (ALIGN_EPI) { if (wr == 1) PG8_BAR; }
    }
    PG8_WAIT_V(0);
    if constexpr (!ALIGN_EPI) { if (wr == 0) PG8_BAR; }
    PG8_BAR;
    if constexpr (Epi::AFTER_DRAIN) { E.fused(acc, cur, wr, wc, fr, fq, lds, wid, lane); S.done(cur); }
#undef PG8_SA
#undef PG8_SB
#undef PG8_STAGE
#undef PG8_LDA
#undef PG8_LDB
#undef PG8_MMA
#undef PG8_WAIT_V
#undef PG8_WAIT_L
#undef PG8_BAR
#undef PG8_SCHED
}
}
#define GAS __attribute__((address_space(1)))
#define LAS __attribute__((address_space(3)))
typedef unsigned short bf16;
typedef unsigned v4u __attribute__((ext_vector_type(4)));
typedef float f32x4 __attribute__((ext_vector_type(4)));
typedef short bf16x8 __attribute__((ext_vector_type(8)));
typedef GAS unsigned gu32;
typedef GAS unsigned long long gu64;
#define RLX_AGENT __ATOMIC_RELAXED, __HIP_MEMORY_SCOPE_AGENT
#define LDS_WAIT() asm volatile("s_waitcnt lgkmcnt(0)" ::: "memory")
#define VM_WAIT() asm volatile("s_waitcnt vmcnt(0)" ::: "memory")
__device__ __forceinline__ unsigned long long rt() { return __builtin_amdgcn_s_memrealtime(); }
__device__ __forceinline__ unsigned f2bf(float f) { unsigned u = __builtin_bit_cast(unsigned, f); return (u + 0x7fffu + ((u >> 16) & 1u)) >> 16; }
__device__ __forceinline__ unsigned pk2(float lo, float hi) { return f2bf(lo) | (f2bf(hi) << 16); }
#define XB_TMO      128
#define XB_XCNT(j)  (256  + 64 * (j))
#define XB_XSUB(j)  (1280 + 64 * (j))
#define XB_XGEN(j)  (2304 + 64 * (j))
#define XB_TOP      3328
#define XB_TOPGEN   3392
#define XCD_BAR_WORDS 3456
#define XB_SPIN_CAP (1u << 18)

__device__ __forceinline__ unsigned xb_ld(unsigned* p)              { return __hip_atomic_load(p, __ATOMIC_RELAXED, __HIP_MEMORY_SCOPE_AGENT); }
__device__ __forceinline__ unsigned xb_add(unsigned* p, unsigned v) { return __hip_atomic_fetch_add(p, v, __ATOMIC_RELAXED, __HIP_MEMORY_SCOPE_AGENT); }
__device__ __forceinline__ unsigned xb_xcc_id() { return (unsigned)__builtin_amdgcn_s_getreg((3 << 11) | 20) & 0xFu; }
#define XB_SPIN(cond, bar) do { unsigned _sp = 0; while (cond) { __builtin_amdgcn_s_sleep(1); \
    if ((++_sp & 255u) == 0u) { if (xb_ld(&(bar)[XB_TMO])) break; if (_sp > XB_SPIN_CAP) { atomicAdd(&(bar)[XB_TMO], 1u); break; } } } } while (0)

struct XcdBarrier {
    unsigned* bar; unsigned x;
    volatile LAS unsigned* st;
};

__device__ __forceinline__ XcdBarrier xcd_barrier_post(unsigned* bar, volatile LAS unsigned* st) {
    XcdBarrier b; b.bar = bar; b.x = xb_xcc_id(); b.st = st;
    if (threadIdx.x == 0) (void)xb_add(&bar[XB_XCNT(b.x)], 1u);
    return b;
}
__device__ __forceinline__ void xcd_barrier_complete(unsigned* bar, unsigned x, unsigned& nloc, unsigned& nx) {
    const unsigned G = gridDim.x * gridDim.y * gridDim.z;
    unsigned sum, cnt, mine, sp = 0u;
    for (;;) {
        sum = 0u; cnt = 0u; mine = 0u;
#pragma unroll
        for (unsigned j = 0; j < 16; ++j) { const unsigned c = xb_ld(&bar[XB_XCNT(j)]); sum += c; cnt += (c > 0u) ? 1u : 0u; mine = (j == x) ? c : mine; }
        if (sum == G) break;
        __builtin_amdgcn_s_sleep(1);
        if ((++sp & 255u) == 0u) { if (xb_ld(&bar[XB_TMO])) break; if (sp > XB_SPIN_CAP) { atomicAdd(&bar[XB_TMO], 1u); break; } }
    }
    nloc = mine > 0u ? mine : 1u; nx = cnt > 0u ? cnt : 1u;
}

__device__ __forceinline__ void xcd_barrier(const XcdBarrier& b) {
    asm volatile("s_waitcnt vmcnt(0)" ::: "memory");
    __syncthreads();
    if (threadIdx.x == 0) {
        unsigned* bar = b.bar;
        __builtin_amdgcn_s_waitcnt(0);
        unsigned nloc = b.st[0], nx = b.st[1];
        if (nloc == 0u) { xcd_barrier_complete(bar, b.x, nloc, nx); b.st[0] = nloc; b.st[1] = nx; }
        const unsigned old = xb_add(&bar[XB_XSUB(b.x)], 1u);
        const unsigned gen = old / nloc;
        if (old + 1u == (gen + 1u) * nloc) {
            __builtin_amdgcn_fence(__ATOMIC_RELEASE, "agent");
            asm volatile("s_waitcnt vmcnt(0)" ::: "memory");
            const unsigned og = xb_add(&bar[XB_TOP], 1u);
            const unsigned tg = og / nx;
            if (og + 1u == (tg + 1u) * nx) xb_add(&bar[XB_TOPGEN], 1u);
            else XB_SPIN(xb_ld(&bar[XB_TOPGEN]) == tg, bar);
            __builtin_amdgcn_fence(__ATOMIC_ACQUIRE, "agent");
            xb_add(&bar[XB_XGEN(b.x)], 1u);
            asm volatile("s_waitcnt vmcnt(0)" ::: "memory");
        } else {
            XB_SPIN(xb_ld(&bar[XB_XGEN(b.x)]) == gen, bar);
            __builtin_amdgcn_fence(__ATOMIC_ACQUIRE, "agent");
            asm volatile("s_waitcnt vmcnt(0)" ::: "memory");
        }
    }
    __syncthreads();
}
constexpr int NB = 8, SEQ = 4096, DM = 1024, DEPTH = 4, M = NB * SEQ;
constexpr int FF = 2816, NIN = 5852, NINP = 5888;
constexpr float EPS = 1e-6f, NEGF = -1e30f;
constexpr int NWAVES = 8;
constexpr size_t MiB = 1u << 20;
constexpr size_t WS_CTL = 0, CTL_ZERO_BYTES = 1 * MiB;
constexpr size_t WS_ROPE = 1 * MiB;
constexpr size_t WS_KVA = 3 * MiB;
constexpr size_t WS_KC = 11 * MiB, WS_VC = WS_KC + 512 * 1024;
constexpr size_t WS_W = 12 * MiB;
constexpr size_t WO_GU1 = 0, WO_D1 = 11 * MiB, WO_GU2 = WO_D1 + 5 * MiB + 512 * 1024, WO_D2 = WO_GU2 + 11 * MiB, WO_IN = WO_D2 + 5 * MiB + 512 * 1024,
                 WO_PA = WO_IN + 11 * MiB + 512 * 1024, WO_PB = WO_PA + MiB, WO_PC = WO_PB + MiB, WO_OUT = WO_PC + MiB, WO_END = WO_OUT + 2 * MiB;
static_assert(WO_END <= 52 * MiB, "weights region");
constexpr size_t WS_XN = 64 * MiB;
constexpr size_t WS_R = 128 * MiB;
constexpr size_t WS_G = WS_R, WS_QA = WS_R + 192 * MiB, WS_QC = WS_QA + 32 * MiB, WS_IQ = WS_QC + 32 * MiB, WS_MISC = WS_IQ + 16 * MiB,
                 WS_KVC = WS_MISC + 16 * MiB, WS_KVS = WS_KVC + 16 * MiB, WS_KVW = WS_KVS + 16 * MiB, WS_BU = WS_KVW + 16 * MiB, WS_END = WS_BU + 32 * MiB;
constexpr size_t WS_MG = WS_IQ;
constexpr size_t WS_H = WS_R;
static_assert(WS_END == 496 * MiB, "ws map");
constexpr int RING_BYTES = 131072, LDS_BYTES = 163840, LDSCTL_OFF = 163840 - 256;
constexpr int NPL = 12, NPH = 1 + DEPTH * NPL + 1;

__device__ __forceinline__ float bflo(unsigned w) { return __uint_as_float(w << 16); }
__device__ __forceinline__ float bfhi(unsigned w) { return __uint_as_float(w & 0xffff0000u); }
__device__ __forceinline__ float bf2f(bf16 v) { return __uint_as_float((unsigned)v << 16); }
__device__ __forceinline__ float wave_sum(float v) {
#pragma unroll
    for (int o = 1; o < 64; o <<= 1) v += __shfl_xor(v, o);
    return v;
}
__device__ __forceinline__ float wave_max(float v) {
#pragma unroll
    for (int o = 1; o < 64; o <<= 1) v = fmaxf(v, __shfl_xor(v, o));
    return v;
}
__device__ __forceinline__ int wave_sum_i(int v) {
#pragma unroll
    for (int o = 1; o < 64; o <<= 1) v += __shfl_xor(v, o);
    return v;
}
__device__ __forceinline__ unsigned wave_max_u(unsigned v) {
#pragma unroll
    for (int o = 1; o < 64; o <<= 1) { const unsigned w = (unsigned)__shfl_xor((int)v, o); v = w > v ? w : v; }
    return v;
}
#define WAVE_LDS_SYNC() do { asm volatile("s_waitcnt lgkmcnt(0)" ::: "memory"); __builtin_amdgcn_wave_barrier(); } while (0)
__host__ __device__ __forceinline__ int permd(int d) { return d < 8 ? 2 * d : (d < 16 ? 2 * (d - 8) + 1 : d); }
__device__ __forceinline__ int win_newcol(int n) {
    if (n < 512) return (n & ~63) + permd(n & 63);
    if (n < 640) return 1280 + 64 + (n - 512);
    if (n < 896) { const int m = n - 640; return 1024 + (m & ~63) + permd(m & 63); }
    if (n < 960) return 1280 + permd(n - 896);
    if (n < 964) return 1280 + 192 + (n - 960);
    if (n < 1476) return 2304 + (n - 964);
    if (n < 1988) { const int m = n - 1476; return 512 + (m & ~63) + permd(m & 63); }
    if (n < 2756) { const int m = n - 1988, kv = m >> 8, r = m & 255, base = 1536 + kv * 256; return r < 128 ? base + (r & ~63) + permd(r & 63) : base + r; }
    if (n < 2780) return 1280 + 196 + (n - 2756);
    return 2816 + (n - 2780);
}
__device__ __forceinline__ int map_row(int mode, int n) { return mode == 0 ? n : (mode == 1 ? ((n >> 7) << 8) + (n & 127) : (mode == 2 ? ((n >> 7) << 8) + 128 + (n & 127) : win_newcol(n))); }

struct Args { const float* in[24]; float* out; unsigned char* ws; int ph_lo, ph_hi; };

__device__ __forceinline__ void tr_item(const float* W, int K, int N, bf16* WT, int mode, LAS float* scr, int item, int lane) {
    const int nblk = (N + 31) >> 5, kb = item / nblk, nb = item - kb * nblk, k0 = 64 * kb, n0 = 32 * nb;
    const int nn = n0 + (lane & 31);
#pragma unroll 8
    for (int i = 0; i < 32; ++i) { const int kk = 2 * i + (lane >> 5); scr[kk * 33 + (lane & 31)] = nn < N ? W[(size_t)(k0 + kk) * N + nn] : 0.f; }
    LDS_WAIT(); asm volatile("" ::: "memory");
    const int c = lane & 7;
#pragma unroll
    for (int j = 0; j < 4; ++j) { const int n = (lane >> 3) + 8 * j; const LAS float* s = scr + (8 * c) * 33 + n;
        v4u o; o.x = pk2(s[0 * 33], s[1 * 33]); o.y = pk2(s[2 * 33], s[3 * 33]); o.z = pk2(s[4 * 33], s[5 * 33]); o.w = pk2(s[6 * 33], s[7 * 33]);
        if (n0 + n < N) *(v4u*)(WT + (size_t)map_row(mode, n0 + n) * K + k0 + 8 * c) = o; }
    LDS_WAIT(); asm volatile("" ::: "memory");
}
__device__ __forceinline__ void phase_convert(const Args& P, unsigned char* ws, int z, int l, LAS unsigned char* lds, int gw, int NGW, int lane, int wave) {
    asm volatile("" : "+v"(lane)); asm volatile("" : "+s"(gw));
    LAS float* scr = (LAS float*)(lds + wave * 16384);
    unsigned char* wb = ws + WS_W;
    constexpr int I_F = 16 * 88, I_D = 44 * 32, I_IN = 16 * 183, I_P = 8 * 32, I_O = 16 * 32;
    constexpr int NIT = 4 * I_F + 2 * I_D + I_IN + 3 * I_P + I_O;
    const size_t fo = (size_t)l * DM * FF;
    for (int it = gw; it < NIT; it += NGW) {
        int r = it, K = DM, N = FF, mode = 1; const float* W = P.in[3 + z] + fo; size_t wo = WO_GU1;
        if (r >= I_F) { r -= I_F; mode = 2; W = P.in[4 + z] + fo;
        if (r >= I_F) { r -= I_F; mode = 0; W = P.in[5 + z] + fo; K = FF; N = DM; wo = WO_D1;
        if (r >= I_D) { r -= I_D; mode = 1; W = P.in[20 + z] + fo; K = DM; N = FF; wo = WO_GU2;
        if (r >= I_F) { r -= I_F; mode = 2; W = P.in[21 + z] + fo;
        if (r >= I_F) { r -= I_F; mode = 0; W = P.in[22 + z] + fo; K = FF; N = DM; wo = WO_D2;
        if (r >= I_D) { r -= I_D; mode = 3; W = P.in[7 + z] + (size_t)l * DM * NIN; K = DM; N = NIN; wo = WO_IN;
        if (r >= I_IN) { r -= I_IN; mode = 0; W = P.in[15 + z] + (size_t)l * 512 * DM; K = 512; N = DM; wo = WO_PA;
        if (r >= I_P) { r -= I_P; W = P.in[16 + z] + (size_t)l * 512 * DM; wo = WO_PB;
        if (r >= I_P) { r -= I_P; W = P.in[17 + z] + (size_t)l * 512 * DM; wo = WO_PC;
        if (r >= I_P) { r -= I_P; W = P.in[18 + z] + (size_t)l * DM * DM; K = DM; wo = WO_OUT; } } } } } } } } } }
        tr_item(W, K, N, (bf16*)(wb + wo), mode, scr, r, lane);
    }
    if (gw < 36) { v4u z = {0u, 0u, 0u, 0u}; v4u* rp = (v4u*)((bf16*)(wb + WO_IN) + (size_t)(1500 + gw) * DM); for (int i = lane; i < DM / 8; i += 64) rp[i] = z; }
}
__device__ __forceinline__ void phase_rope(const Args& P, unsigned char* ws, int z, int gtid, int gthreads) {
    float* rope = (float*)(ws + WS_ROPE);
    for (int idx = gtid; idx < M * 8; idx += gthreads) {
        const int row = idx >> 3, i = idx & 7;
        const double inv = pow(500000.0, -(double)i / 8.0), ang = (double)((const int*)P.in[1 + z])[row] * inv;
        double s, c; sincos(ang, &s, &c);
        rope[row * 16 + i] = (float)c; rope[row * 16 + 8 + i] = (float)s;
    }
}
__device__ __forceinline__ void norm_row_bf16(const float* xrow, const float* gain, bf16* orow, int lane) {
    const f32x4* xr = (const f32x4*)xrow + lane; const f32x4* gr = (const f32x4*)gain + lane;
    f32x4 v[4]; float s = 0.f;
#pragma unroll
    for (int j = 0; j < 4; ++j) { v[j] = xr[64 * j]; s += (v[j].x * v[j].x + v[j].y * v[j].y) + (v[j].z * v[j].z + v[j].w * v[j].w); }
    const float r = 1.0f / sqrtf(wave_sum(s) * (1.f / DM) + EPS);
    unsigned long long* o8 = (unsigned long long*)orow + lane;
#pragma unroll
    for (int j = 0; j < 4; ++j) { const f32x4 g = gr[64 * j]; o8[64 * j] = (unsigned long long)pk2(v[j].x * r * g.x, v[j].y * r * g.y) | ((unsigned long long)pk2(v[j].z * r * g.z, v[j].w * r * g.w) << 32); }
}
__device__ __forceinline__ void norm_row_f32(float* xrow, const float* gain, int lane) {
    f32x4* xr = (f32x4*)xrow + lane; const f32x4* gr = (const f32x4*)gain + lane;
    f32x4 v[4]; float s = 0.f;
#pragma unroll
    for (int j = 0; j < 4; ++j) { v[j] = xr[64 * j]; s += (v[j].x * v[j].x + v[j].y * v[j].y) + (v[j].z * v[j].z + v[j].w * v[j].w); }
    const float r = 1.0f / sqrtf(wave_sum(s) * (1.f / DM) + EPS);
#pragma unroll
    for (int j = 0; j < 4; ++j) { const f32x4 g = gr[64 * j]; xr[64 * j] = v[j] * r * g; }
}
__device__ __forceinline__ void prep_kva_row(const Args& P, unsigned char* ws, int z, int l, int row, LAS float* wl, int lane) {
    const bf16* misc = (const bf16*)(ws + WS_MISC) + (size_t)row * 256;
    const unsigned cw = *(const unsigned*)(misc + 64 + 2 * lane);
    const float c0 = bflo(cw), c1 = bfhi(cw);
    const float r = 1.0f / sqrtf(wave_sum(c0 * c0 + c1 * c1) * (1.f / 128.f) + EPS);
    const float* gn = P.in[8 + z] + l * 128;
    wl[2 * lane] = c0 * r * gn[2 * lane]; wl[2 * lane + 1] = c1 * r * gn[2 * lane + 1];
    WAVE_LDS_SYNC();
    const float* w = P.in[9 + z] + (size_t)l * 128 * 128;
    float a0 = 0.f, a1 = 0.f;
#pragma unroll 8
    for (int k = 0; k < 128; ++k) { const float c = wl[k]; a0 += c * w[k * 128 + lane]; a1 += c * w[k * 128 + 64 + lane]; }
    WAVE_LDS_SYNC();
    wl[lane] = a0;
    WAVE_LDS_SYNC();
    const float* rp = (const float*)(ws + WS_ROPE) + (size_t)row * 16;
    float kr = a0;
    if (lane < 8) kr = a0 * rp[lane] - wl[lane + 8] * rp[8 + lane];
    else if (lane < 16) kr = a0 * rp[lane - 8] + wl[lane - 8] * rp[8 + lane - 8];
    bf16* o = (bf16*)(ws + WS_KVA) + (size_t)row * 128;
    o[permd(lane)] = (bf16)f2bf(kr); o[64 + lane] = (bf16)f2bf(a1);
    WAVE_LDS_SYNC();
}
__device__ __forceinline__ void prep_pool_row(const Args& P, unsigned char* ws, int z, int l, int row, LAS float* wl, int lane) {
    const int t = row & (SEQ - 1), g = lane >> 4, w = 2 << g, lo = (t + 1 - w) > 0 ? (t + 1 - w) : 0, cnt = t + 1 - lo;
    const bf16* bu = (const bf16*)(ws + WS_BU);
    float sum[8] = {0.f, 0.f, 0.f, 0.f, 0.f, 0.f, 0.f, 0.f}, cur[8];
    for (int tt = lo; tt <= t; ++tt) {
        const v4u v = *(const v4u*)(bu + (size_t)(row - t + tt) * 512 + lane * 8);
        cur[0] = bflo(v.x); cur[1] = bfhi(v.x); cur[2] = bflo(v.y); cur[3] = bfhi(v.y); cur[4] = bflo(v.z); cur[5] = bfhi(v.z); cur[6] = bflo(v.w); cur[7] = bfhi(v.w);
#pragma unroll
        for (int e = 0; e < 8; ++e) sum[e] += cur[e];
    }
    const float inv = 1.0f / (float)cnt;
#pragma unroll
    for (int e = 0; e < 8; ++e) wl[lane * 8 + e] = sum[e] * inv - cur[e];
    WAVE_LDS_SYNC();
    const float* pw = P.in[10 + z] + (size_t)l * 4 * 128 * 128; const float* ps = P.in[11 + z] + l * 512;
    bf16* yb = (bf16*)(ws + WS_XN) + (size_t)row * 512;
    for (int gg = 0; gg < 4; ++gg) {
        const float* wg = pw + gg * 128 * 128; float a0 = 0.f, a1 = 0.f;
#pragma unroll 8
        for (int c = 0; c < 128; ++c) { const float x = wl[gg * 128 + c]; a0 += x * wg[c * 128 + lane]; a1 += x * wg[c * 128 + 64 + lane]; }
        yb[gg * 128 + lane] = (bf16)f2bf(a0 * ps[gg * 128 + lane]); yb[gg * 128 + 64 + lane] = (bf16)f2bf(a1 * ps[gg * 128 + 64 + lane]);
    }
    WAVE_LDS_SYNC();
}
__device__ __forceinline__ float gelu_tanh(float x) { const float u = 0.7978845608028654f * (x + 0.044715f * x * x * x); return 0.5f * x * (1.0f + tanhf(u)); }
__device__ __forceinline__ void prep_cmp_item(const Args& P, unsigned char* ws, int z, int l, int item, LAS float* wl, int lane) {
    const int i = item & 255, bg = (item >> 8) & 15, br = item >> 12, b = bg >> 1, g = bg & 1;
    bf16* dst = (bf16*)(ws + (br ? WS_VC : WS_KC)) + ((size_t)bg * 256 + i) * 64;
    if (i == 255) { dst[lane] = 0; return; }
    const bf16* kvc = (const bf16*)(ws + WS_KVC);
    const float* pos = P.in[12 + z] + (size_t)(l * 2 + br) * 32 * 64;
    const int sd = br ? lane : permd(lane);
    for (int ll = 0; ll < 32; ++ll) wl[ll * 64 + lane] = bf2f(kvc[(size_t)(b * SEQ + 16 * i + ll) * 256 + br * 128 + g * 64 + sd]) + pos[ll * 64 + lane];
    WAVE_LDS_SYNC();
    const float* w1 = P.in[13 + z] + (size_t)(l * 2 + br) * 2048 * 128;
    float a0 = 0.f, a1 = 0.f;
#pragma unroll 8
    for (int k = 0; k < 2048; ++k) { const float x = wl[k]; a0 += x * w1[(size_t)k * 128 + lane]; a1 += x * w1[(size_t)k * 128 + 64 + lane]; }
    wl[2048 + lane] = gelu_tanh(a0); wl[2048 + 64 + lane] = gelu_tanh(a1);
    WAVE_LDS_SYNC();
    const float* w2 = P.in[14 + z] + (size_t)(l * 2 + br) * 128 * 64;
    float o = 0.f;
#pragma unroll 8
    for (int n = 0; n < 128; ++n) o += wl[2048 + n] * w2[n * 64 + lane];
    dst[sd] = (bf16)f2bf(o);
    WAVE_LDS_SYNC();
}
__device__ __forceinline__ void phase_prep(const Args& P, unsigned char* ws, int z, int l, LAS unsigned char* lds, int gw, int NGW, int lane, int wave) {
    asm volatile("" : "+v"(lane)); asm volatile("" : "+s"(gw));
    LAS float* wl = (LAS float*)(lds + wave * 16384);
    for (int it = gw; it < 2 * 16 * 256; it += NGW) prep_cmp_item(P, ws, z, l, it, wl, lane);
    for (int row = gw; row < M; row += NGW) { prep_kva_row(P, ws, z, l, row, wl, lane); prep_pool_row(P, ws, z, l, row, wl, lane); }
}
__device__ __forceinline__ unsigned f2o(float s) { const unsigned b = __float_as_uint(s); return (b & 0x80000000u) ? ~b : (b | 0x80000000u); }
__device__ __forceinline__ void unpack8(const v4u v, float* f) { f[0] = bflo(v.x); f[1] = bfhi(v.x); f[2] = bflo(v.y); f[3] = bfhi(v.y); f[4] = bflo(v.z); f[5] = bfhi(v.z); f[6] = bflo(v.w); f[7] = bfhi(v.w); }
__device__ __forceinline__ void load_row64(const bf16* p, float* f) {
    const v4u* q = (const v4u*)p;
#pragma unroll
    for (int i = 0; i < 8; ++i) unpack8(q[i], f + 8 * i);
}
__device__ __forceinline__ float dot64(const LAS float* q, const float* k) {
    float d = 0.f;
#pragma unroll
    for (int i = 0; i < 16; ++i) { const f32x4 qq = *(const LAS f32x4*)(q + 4 * i); d += qq.x * k[4 * i] + qq.y * k[4 * i + 1] + qq.z * k[4 * i + 2] + qq.w * k[4 * i + 3]; }
    return d;
}
__device__ __forceinline__ void dsa_query(const Args& P, unsigned char* ws, int z, int row, LAS unsigned char* wl, int lane) {
    const int b = row >> 12, t = row & (SEQ - 1), n = t + 1;
    LAS unsigned* su = (LAS unsigned*)wl; LAS float* pb = (LAS float*)wl; LAS unsigned short* list = (LAS unsigned short*)(wl + 16384); LAS float* qb = (LAS float*)(wl + 16896);
    const bf16* misc = (const bf16*)(ws + WS_MISC);
    const unsigned long long lt = (1ull << lane) - 1ull;
    int nsel;
    if (n <= 256) { for (int i = lane; i < n; i += 64) list[i] = (unsigned short)i; nsel = n; }
    else {
        { const uint2 v = *(const uint2*)((const bf16*)(ws + WS_IQ) + (size_t)row * 256 + lane * 4); qb[lane * 4] = bflo(v.x); qb[lane * 4 + 1] = bfhi(v.x); qb[lane * 4 + 2] = bflo(v.y); qb[lane * 4 + 3] = bfhi(v.y); }
        float iw[4]; { const uint2 v = *(const uint2*)(misc + (size_t)row * 256 + 192); iw[0] = 0.5f * bflo(v.x); iw[1] = 0.5f * bfhi(v.x); iw[2] = 0.5f * bflo(v.y); iw[3] = 0.5f * bfhi(v.y); }
        WAVE_LDS_SYNC();
        const int nch = (n + 63) >> 6;
        for (int i = 0; i < nch; ++i) {
            const int key = i * 64 + lane; const bool valid = key <= t;
            float kf[64]; load_row64(misc + (size_t)(b * SEQ + (valid ? key : t)) * 256, kf);
            float s = 0.f;
#pragma unroll
            for (int h = 0; h < 4; ++h) s += iw[h] * fmaxf(dot64(qb + h * 64, kf), 0.f);
            su[key] = valid ? f2o(s) : 0u;
        }
        WAVE_LDS_SYNC();
        unsigned prefix = 0u;
        for (int bit = 31; bit >= 0; --bit) {
            const unsigned cand = prefix | (1u << bit); int c = 0;
            for (int i = 0; i < nch; ++i) c += (su[i * 64 + lane] >= cand) ? 1 : 0;
            c = wave_sum_i(c);
            if (c >= 256) prefix = cand;
            if (c == 256) break;
        }
        int cgt = 0;
        for (int i = 0; i < nch; ++i) cgt += (su[i * 64 + lane] > prefix) ? 1 : 0;
        const int need_eq = 256 - wave_sum_i(cgt);
        int base = 0, eq_taken = 0;
        for (int i = 0; i < nch; ++i) {
            const unsigned v = su[i * 64 + lane]; const bool gt = v > prefix, eq = v == prefix;
            const unsigned long long meq = __ballot(eq);
            const bool sel = gt || (eq && (eq_taken + __popcll(meq & lt)) < need_eq);
            const unsigned long long ms = __ballot(sel);
            if (sel) list[base + __popcll(ms & lt)] = (unsigned short)(i * 64 + lane);
            base += __popcll(ms); eq_taken += __popcll(meq);
        }
        nsel = 256;
    }
    { const v4u v = *(const v4u*)((const bf16*)(ws + WS_QA) + (size_t)row * 512 + lane * 8); float f[8]; unpack8(v, f);
#pragma unroll
      for (int e = 0; e < 8; ++e) qb[lane * 8 + e] = f[e]; }
    WAVE_LDS_SYNC();
    const bf16* kva = (const bf16*)(ws + WS_KVA);
    float s[8][4];
#pragma unroll
    for (int j = 0; j < 4; ++j) {
        const int slot = lane + 64 * j; const bool valid = slot < nsel; const int key = list[valid ? slot : 0];
        float kf[64]; load_row64(kva + (size_t)(b * SEQ + key) * 128, kf);
#pragma unroll
        for (int h = 0; h < 8; ++h) s[h][j] = valid ? dot64(qb + h * 64, kf) : NEGF;
    }
    float linv[8];
#pragma unroll
    for (int h = 0; h < 8; ++h) {
        const float m = wave_max(fmaxf(fmaxf(s[h][0], s[h][1]), fmaxf(s[h][2], s[h][3]))); float ls = 0.f;
#pragma unroll
        for (int j = 0; j < 4; ++j) { const float p = __expf(s[h][j] - m); ls += p; pb[h * 256 + lane + 64 * j] = p; }
        linv[h] = 1.0f / wave_sum(ls);
    }
    WAVE_LDS_SYNC();
    float acc[8] = {0.f, 0.f, 0.f, 0.f, 0.f, 0.f, 0.f, 0.f};
    for (int slot = 0; slot < nsel; ++slot) {
        const float v = bf2f(kva[(size_t)(b * SEQ + list[slot]) * 128 + 64 + lane]);
#pragma unroll
        for (int h = 0; h < 8; ++h) acc[h] += pb[h * 256 + slot] * v;
    }
    bf16* ya = (bf16*)(ws + WS_QA) + (size_t)row * 512;
#pragma unroll
    for (int h = 0; h < 8; ++h) ya[h * 64 + lane] = (bf16)f2bf(acc[h] * linv[h]);
    WAVE_LDS_SYNC();
}
__device__ __forceinline__ void nsa_query(const Args& P, unsigned char* ws, int z, int row, int g, LAS unsigned char* wl, int lane) {
    const int b = row >> 12, t = row & (SEQ - 1), bg = b * 2 + g;
    LAS float* pb = (LAS float*)wl; LAS float* qb = (LAS float*)(wl + 8192);
    const bf16* misc = (const bf16*)(ws + WS_MISC);
    bf16* qc = (bf16*)(ws + WS_QC) + (size_t)row * 512 + g * 256;
    { const uint2 v = *(const uint2*)(qc + lane * 4); qb[lane * 4] = bflo(v.x); qb[lane * 4 + 1] = bfhi(v.x); qb[lane * 4 + 2] = bflo(v.y); qb[lane * 4 + 3] = bfhi(v.y); }
    float gate[4][3];
#pragma unroll
    for (int r = 0; r < 4; ++r)
#pragma unroll
        for (int e = 0; e < 3; ++e) gate[r][e] = 1.0f / (1.0f + __expf(-bf2f(misc[(size_t)row * 256 + 196 + (g * 4 + r) * 3 + e])));
    WAVE_LDS_SYNC();
    float o[4] = {0.f, 0.f, 0.f, 0.f};
    const int nv = t >= 31 ? ((t - 15) >> 4) : 0;
    const bf16* kc = (const bf16*)(ws + WS_KC) + (size_t)bg * 256 * 64; const bf16* vc = (const bf16*)(ws + WS_VC) + (size_t)bg * 256 * 64;
    {
        float s[4][4];
#pragma unroll
        for (int j = 0; j < 4; ++j) {
            const int i = lane + 64 * j; const bool valid = i < nv;
            float kf[64]; load_row64(kc + (size_t)(valid ? i : 0) * 64, kf);
#pragma unroll
            for (int r = 0; r < 4; ++r) s[r][j] = valid ? dot64(qb + r * 64, kf) : NEGF;
        }
#pragma unroll
        for (int r = 0; r < 4; ++r) {
            const float m = wave_max(fmaxf(fmaxf(s[r][0], s[r][1]), fmaxf(s[r][2], s[r][3]))); float p[4], ls = 0.f;
#pragma unroll
            for (int j = 0; j < 4; ++j) { p[j] = (lane + 64 * j < nv) ? __expf(s[r][j] - m) : 0.f; ls += p[j]; }
            ls = wave_sum(ls); const float inv = nv > 0 ? 1.0f / ls : 0.f;
#pragma unroll
            for (int j = 0; j < 4; ++j) pb[r * 512 + lane + 64 * j] = p[j] * inv;
        }
        WAVE_LDS_SYNC();
        float a[4] = {0.f, 0.f, 0.f, 0.f};
        for (int i = 0; i < nv; ++i) { const float v = bf2f(vc[(size_t)i * 64 + lane]);
#pragma unroll
            for (int r = 0; r < 4; ++r) a[r] += pb[r * 512 + i] * v; }
#pragma unroll
        for (int r = 0; r < 4; ++r) o[r] += gate[r][0] * a[r];
    }
    unsigned long long selmask = 0ull;
    {
        const int j = lane, cur = t >> 6; float imp = 0.f;
#pragma unroll
        for (int r = 0; r < 4; ++r) { const LAS float* pr = pb + r * 512 + 4 * j; imp += (j > 0 ? 0.5f * pr[-1] : 0.f) + pr[0] + pr[1] + pr[2] + 0.5f * pr[3]; }
        const bool forced = (j == 0) || (j == cur), adm = j <= cur;
        unsigned key = forced ? (0xFFFFFF00u | (unsigned)(63 - j)) : (adm ? ((__float_as_uint(imp) & 0xFFFFFFC0u) | (unsigned)(63 - j)) : 0u);
        for (int k = 0; k < 8; ++k) { const unsigned mx = wave_max_u(key); if (mx == 0u) break; const int win = 63 - (int)(mx & 63u); selmask |= 1ull << win; if (j == win) key = 0u; }
    }
    WAVE_LDS_SYNC();
    {
        const bf16* kvs = (const bf16*)(ws + WS_KVS);
        float s[4][8]; int jb[8]; unsigned long long mm = selmask;
#pragma unroll
        for (int k = 0; k < 8; ++k) {
            const bool have = mm != 0ull; jb[k] = have ? (int)__builtin_ctzll(mm) : 0; mm &= mm - 1ull;
            const int key = jb[k] * 64 + lane; const bool valid = have && key <= t;
            float kf[64]; load_row64(kvs + (size_t)(b * SEQ + (valid ? key : t)) * 256 + g * 64, kf);
#pragma unroll
            for (int r = 0; r < 4; ++r) s[r][k] = valid ? dot64(qb + r * 64, kf) : NEGF;
        }
        float linv[4];
#pragma unroll
        for (int r = 0; r < 4; ++r) {
            float m = s[r][0];
#pragma unroll
            for (int k = 1; k < 8; ++k) m = fmaxf(m, s[r][k]);
            m = wave_max(m); float ls = 0.f;
#pragma unroll
            for (int k = 0; k < 8; ++k) { const float p = __expf(s[r][k] - m); ls += p; pb[r * 512 + k * 64 + lane] = p; }
            linv[r] = 1.0f / wave_sum(ls);
        }
        WAVE_LDS_SYNC();
        float a[4] = {0.f, 0.f, 0.f, 0.f};
        const int nblk = __popcll(selmask);
        for (int k = 0; k < nblk; ++k) {
            int jk = 0;
#pragma unroll
            for (int q = 0; q < 8; ++q) jk = (q == k) ? jb[q] : jk;
            const int kend = (jk * 64 + 63 <= t) ? 64 : (t - jk * 64 + 1);
            for (int kk = 0; kk < kend; ++kk) { const float v = bf2f(kvs[(size_t)(b * SEQ + jk * 64 + kk) * 256 + 128 + g * 64 + lane]);
#pragma unroll
                for (int r = 0; r < 4; ++r) a[r] += pb[r * 512 + k * 64 + kk] * v; }
        }
#pragma unroll
        for (int r = 0; r < 4; ++r) o[r] += gate[r][1] * a[r] * linv[r];
    }
    WAVE_LDS_SYNC();
    {
        const bf16* kvw = (const bf16*)(ws + WS_KVW);
        float s[4][4];
#pragma unroll
        for (int j = 0; j < 4; ++j) {
            const int kp = t - 255 + lane + 64 * j; const bool valid = kp >= 0;
            float kf[64]; load_row64(kvw + (size_t)(b * SEQ + (valid ? kp : 0)) * 256 + g * 64, kf);
#pragma unroll
            for (int r = 0; r < 4; ++r) s[r][j] = valid ? dot64(qb + r * 64, kf) : NEGF;
        }
        float linv[4];
#pragma unroll
        for (int r = 0; r < 4; ++r) {
            const float m = wave_max(fmaxf(fmaxf(s[r][0], s[r][1]), fmaxf(s[r][2], s[r][3]))); float ls = 0.f;
#pragma unroll
            for (int j = 0; j < 4; ++j) { const float p = __expf(s[r][j] - m); ls += p; pb[r * 512 + lane + 64 * j] = p; }
            linv[r] = 1.0f / wave_sum(ls);
        }
        WAVE_LDS_SYNC();
        float a[4] = {0.f, 0.f, 0.f, 0.f};
        const int k0 = t - 255 < 0 ? 255 - t : 0;
        for (int kk = k0; kk < 256; ++kk) { const float v = bf2f(kvw[(size_t)(b * SEQ + t - 255 + kk) * 256 + 128 + g * 64 + lane]);
#pragma unroll
            for (int r = 0; r < 4; ++r) a[r] += pb[r * 512 + kk] * v; }
#pragma unroll
        for (int r = 0; r < 4; ++r) o[r] += gate[r][2] * a[r] * linv[r];
    }
#pragma unroll
    for (int r = 0; r < 4; ++r) qc[r * 64 + lane] = (bf16)f2bf(o[r]);
    WAVE_LDS_SYNC();
}
__device__ __forceinline__ void phase_mixers(const Args& P, unsigned char* ws, int z, LAS unsigned char* lds, int gw, int NGW, int lane, int wave) {
    asm volatile("" : "+v"(lane)); asm volatile("" : "+s"(gw));
    LAS unsigned char* wl = lds + wave * 18944;
    for (int row = gw; row < M; row += NGW) dsa_query(P, ws, z, row, wl, lane);
    for (int it = gw; it < 2 * M; it += NGW) nsa_query(P, ws, z, it >> 1, it & 1, wl, lane);
}
__global__ void __launch_bounds__(NWAVES * 64, 2) fwd_kernel(Args args) {
    extern __shared__ __attribute__((aligned(16))) unsigned char lds_raw[];
    LAS unsigned char* lds = (LAS unsigned char*)lds_raw;
    const int wave = __builtin_amdgcn_readfirstlane((int)threadIdx.x >> 6);
#define tid ((int)threadIdx.x)
#define lane ((int)threadIdx.x & 63)
    const int G = gridDim.x, bid = blockIdx.x;
    const int gw = bid * NWAVES + wave, NGW = G * NWAVES;
    const int lo = args.ph_lo, hi = args.ph_hi;
    const Args& P = args;
    int z = 0; asm volatile("" : "+s"(z));
    unsigned char* ws = args.ws + z;
    volatile LAS unsigned* MISCW = (volatile LAS unsigned*)(lds + LDSCTL_OFF);
    if (tid < 64) MISCW[tid] = 0u;
    __syncthreads();
    XcdBarrier bar; bar.bar = (unsigned*)(ws + WS_CTL) + 4096; bar.x = 0; bar.st = nullptr;
    if (hi - lo > 1) bar = xcd_barrier_post((unsigned*)(ws + WS_CTL) + 4096, MISCW + 8);
#define RUN(k) (lo <= (k) && (k) < hi)
#define SEAM(k) do { if ((k) + 1 < hi) { XcdBarrier b2_ = bar; asm volatile("" : "+s"(b2_.bar)); xcd_barrier(b2_); } else { VM_WAIT(); __syncthreads(); } } while (0)


    if (RUN(0)) { phase_rope(P, ws, z, bid * (NWAVES * 64) + tid, G * NWAVES * 64); SEAM(0); }

    for (int it = 0; it < 2 * DEPTH; ++it) {
        const int l = it >> 1, second = it & 1, pb = 1 + l * NPL + (second ? 9 : 0);
        asm volatile("" : "+s"(z));
        ws = args.ws + z;
        bf16* const XN = (bf16*)(ws + WS_XN);
        bf16* const HB = (bf16*)(ws + WS_H);
        bf16* const MG = (bf16*)(ws + WS_MG);
        bf16* const GB = (bf16*)(ws + WS_G);
        unsigned char* const wb = ws + WS_W;
        float* const OUT = P.out + z;
        const float* xin = (it == 0) ? P.in[0 + z] : (const float*)OUT;
        if (RUN(pb)) {
            if (!second) phase_convert(P, ws, z, l, lds, gw, NGW, lane, wave);
            const float* gain = (second ? P.in[19 + z] : P.in[2 + z]) + l * DM;
            { int ln_ = lane; asm volatile("" : "+v"(ln_)); for (int m = gw; m < M; m += NGW) norm_row_bf16(xin + (size_t)m * DM, gain, XN + (size_t)m * DM, ln_); }
            SEAM(pb);
        }
        if (RUN(pb + 1)) {
            pg8::Gemm g{XN, (const bf16*)(wb + (second ? WO_GU2 : WO_GU1)), M, 2 * FF, DM}; pg8::StaticOrder S; S.init(M, 2 * FF, G, bid + z);
            pg8::EpiSwiglu E{HB, FF};
#if !defined(SITE_MASK) || ((SITE_MASK >> 0) & 1)
            pg8::gemm_phase<pg8::EpiSwiglu, pg8::StaticOrder, true, true>(lds, g, S, E);
#endif
            SEAM(pb + 1);
        }
        if (RUN(pb + 2)) {
            pg8::Gemm g{HB, (const bf16*)(wb + (second ? WO_D2 : WO_D1)), M, DM, FF}; pg8::StaticOrder S; S.init(M, DM, G, bid + z);
            pg8::EpiResid E{xin, OUT, 0.5f};
#if !defined(SITE_MASK) || ((SITE_MASK >> 1) & 1)
            pg8::gemm_phase<pg8::EpiResid, pg8::StaticOrder, true, true>(lds, g, S, E);
#endif
            SEAM(pb + 2);
        }
        if (second) continue;
        const int pm = 1 + l * NPL + 3;
        if (RUN(pm)) {
            const float* gain = P.in[6 + z] + l * DM;
            { int ln_ = lane; asm volatile("" : "+v"(ln_)); for (int m = gw; m < M; m += NGW) norm_row_bf16(OUT + (size_t)m * DM, gain, XN + (size_t)m * DM, ln_); }
            SEAM(pm);
        }
        if (RUN(pm + 1)) {
            pg8::Gemm g{XN, (const bf16*)(wb + WO_IN), M, NINP, DM}; pg8::StaticOrder S; S.init(M, NINP, G, bid + z);
            pg8::EpiWin E{(bf16*)(ws + WS_QA), (bf16*)(ws + WS_QC), (bf16*)(ws + WS_IQ), (bf16*)(ws + WS_MISC), (bf16*)(ws + WS_KVC), (bf16*)(ws + WS_KVS), (bf16*)(ws + WS_KVW), (bf16*)(ws + WS_BU), GB,
                          (const float*)(ws + WS_ROPE)};
#if !defined(SITE_MASK) || ((SITE_MASK >> 2) & 1)
            pg8::gemm_phase<pg8::EpiWin, pg8::StaticOrder, true, true>(lds, g, S, E);
#endif
            SEAM(pm + 1);
        }
        #ifndef NO_PREP
        if (RUN(pm + 2)) { phase_prep(P, ws, z, l, lds, gw, NGW, lane, wave); SEAM(pm + 2); }
#endif
        #ifndef NO_MIX
        if (RUN(pm + 3)) { phase_mixers(P, ws, z, lds, gw, NGW, lane, wave); SEAM(pm + 3); }
#endif
        if (RUN(pm + 4)) {
            pg8::StaticOrder S; S.init(M, DM, G, bid + z);
            { pg8::Gemm g{(const bf16*)(ws + WS_QA), (const bf16*)(wb + WO_PA), M, DM, 512}; pg8::EpiProj<0> E{MG, GB, 0};
#if !defined(SITE_MASK) || ((SITE_MASK >> 3) & 1)
              pg8::gemm_phase<pg8::EpiProj<0>, pg8::StaticOrder, true, true>(lds, g, S, E);
#endif
            }
            { pg8::Gemm g{(const bf16*)(ws + WS_XN), (const bf16*)(wb + WO_PB), M, DM, 512}; pg8::EpiProj<1> E{MG, GB, 1024};
#if !defined(SITE_MASK) || ((SITE_MASK >> 4) & 1)
              pg8::gemm_phase<pg8::EpiProj<1>, pg8::StaticOrder, true, true>(lds, g, S, E);
#endif
            }
            { pg8::Gemm g{(const bf16*)(ws + WS_QC), (const bf16*)(wb + WO_PC), M, DM, 512}; pg8::EpiProj<1> E{MG, GB, 2048};
#if !defined(SITE_MASK) || ((SITE_MASK >> 5) & 1)
              pg8::gemm_phase<pg8::EpiProj<1>, pg8::StaticOrder, true, true>(lds, g, S, E);
#endif
            }
            SEAM(pm + 4);
        }
        if (RUN(pm + 5)) {
            pg8::Gemm g{MG, (const bf16*)(wb + WO_OUT), M, DM, DM}; pg8::StaticOrder S; S.init(M, DM, G, bid + z);
            pg8::EpiResid E{OUT, OUT, 1.0f};
#if !defined(SITE_MASK) || ((SITE_MASK >> 6) & 1)
            pg8::gemm_phase<pg8::EpiResid, pg8::StaticOrder, true, true>(lds, g, S, E);
#endif
            SEAM(pm + 5);
        }
    }
    if (RUN(NPH - 1)) { asm volatile("" : "+s"(z)); int ln_ = lane; asm volatile("" : "+v"(ln_)); float* o_ = P.out + z; for (int m = gw; m < M; m += NGW) norm_row_f32(o_ + (size_t)m * DM, P.in[23 + z], ln_); }
#undef RUN
#undef tid
#undef lane
#undef SEAM
}

extern "C" void kernel_launch(void* const* d_in, const int* in_sizes, int n_in, void* d_out, int out_size, void* d_ws, size_t ws_size, hipStream_t stream) {
    static int grid = 0;
    if (grid == 0) {
        if (n_in != 24 || out_size != M * DM || ws_size < WS_END) { fprintf(stderr, "kernel_launch: unexpected shapes (n_in %d out %d ws %zu)\n", n_in, out_size, ws_size); grid = -1; return; }
        int dev = 0, cus = 0, per_cu = 0;
        if (hipGetDevice(&dev) != hipSuccess || hipDeviceGetAttribute(&cus, hipDeviceAttributeMultiprocessorCount, dev) != hipSuccess) { grid = -1; return; }
        if (hipFuncSetAttribute((const void*)fwd_kernel, hipFuncAttributeMaxDynamicSharedMemorySize, LDS_BYTES) != hipSuccess) { fprintf(stderr, "kernel_launch: hipFuncSetAttribute failed\n"); grid = -1; return; }
        if (hipOccupancyMaxActiveBlocksPerMultiprocessor(&per_cu, (const void*)fwd_kernel, NWAVES * 64, LDS_BYTES) != hipSuccess || per_cu < 1) { fprintf(stderr, "kernel_launch: occupancy query says %d\n", per_cu); }
        (void)hipGetLastError();
        grid = cus;
    }
    if (grid < 0) return;
    (void)hipMemsetAsync((char*)d_ws + WS_CTL, 0, CTL_ZERO_BYTES, stream);
    Args a{};
    for (int i = 0; i < 24; ++i) a.in[i] = (const float*)d_in[i];
    a.out = (float*)d_out; a.ws = (unsigned char*)d_ws;
#if MK_ONE_LAUNCH
    a.ph_lo = 0; a.ph_hi = NPH;
    hipLaunchKernelGGL(fwd_kernel, dim3(grid), dim3(NWAVES * 64), LDS_BYTES, stream, a);
#else
    for (int ph = 0; ph < NPH; ++ph) { a.ph_lo = ph; a.ph_hi = ph + 1; hipLaunchKernelGGL(fwd_kernel, dim3(grid), dim3(NWAVES * 64), LDS_BYTES, stream, a); }
#endif
}
```

```cpp
#include <hip/hip_runtime.h>
#include <cstdio>
#include <cstdint>
#ifndef MK_ONE_LAUNCH
#define MK_ONE_LAUNCH 1
#endif
namespace pg8 {
#define PG8_LAS __attribute__((address_space(3)))
typedef unsigned short bf16_t;
typedef short bf16x8 __attribute__((ext_vector_type(8)));
typedef float f32x4 __attribute__((ext_vector_type(4)));
typedef unsigned u32x4 __attribute__((ext_vector_type(4)));
constexpr int BM = 256, BK = 64, HALF = 128, HTB = HALF * BK * 2  , STAGE_BYTES = 8 * HTB, NXCD = 8, WGM = 8;

__host__ __device__ __forceinline__ int lds_byte(int r, int c) { const int st = (r >> 4) * 2 + (c >> 5), rr = r & 15, cc = c & 31, ob = rr * 64 + cc * 2; return st * 1024 + (ob ^ (((ob >> 9) & 1) << 5)); }
__host__ __device__ __forceinline__ void stage_rc(int b, int& R, int& C) { const int st = b / 1024, sb = b % 1024, swz = sb ^ (((sb >> 9) & 1) << 5); R = (st >> 1) * 16 + swz / 64; C = (st & 1) * 32 + (swz % 64) / 2; }
__host__ __device__ __forceinline__ int perm32(int rho) { const int n = rho >> 4, i = rho & 15; return 8 * (i >> 2) + 4 * n + (i & 3); }

struct Unit { int pm, pn; };
struct Gemm { const bf16_t* A; const bf16_t* Bt; int M, N, K; };

struct StaticOrder {
    int nM, nN, nwg, G, c;
    __host__ __device__ void init(int M, int N, int G_, int c_) { nM = M / BM; nN = N / BM; nwg = nM * nN; G = G_; c = c_; }
    __host__ __device__ bool next(int i, Unit& u) const {
        const long L = (long)i * G + c; if (L >= nwg) return false;
        int wgid = (int)L; { const int q = nwg / NXCD, r = nwg % NXCD, xcd = wgid % NXCD, off = wgid / NXCD; wgid = (xcd < r ? xcd * (q + 1) : r * (q + 1) + (xcd - r) * q) + off; }
        const int nig = WGM * nN, gid = wgid / nig, fm = gid * WGM, gsz = (nM - fm) < WGM ? (nM - fm) : WGM;
        u.pm = fm + ((wgid % nig) % gsz); u.pn = (wgid % nig) / gsz; return true;
    }
    __device__ __forceinline__ void a_ready(const Unit&) const {}
    __device__ __forceinline__ void done(const Unit&) const {}
};

__device__ __forceinline__ unsigned cvt_pk_bf16(float lo, float hi) { unsigned r; asm volatile("v_cvt_pk_bf16_f32 %0, %1, %2" : "=v"(r) : "v"(lo), "v"(hi)); return r; }
__device__ __forceinline__ float bflo(unsigned w) { return __uint_as_float(w << 16); }
__device__ __forceinline__ float bfhi(unsigned w) { return __uint_as_float(w & 0xffff0000u); }
__device__ __forceinline__ float fast_sigmoid(float x) { return __builtin_amdgcn_rcpf(1.0f + __expf(-x)); }

struct EpiSwiglu {
    static constexpr bool PERM = true, AFTER_DRAIN = false;
    bf16_t* H; int ldh;
    __device__ __forceinline__ void operator()(const f32x4 (&acc)[2][2][4][2], const Unit& u, int wr, int wc, int fr, int fq) const {
        const int row0 = u.pm * BM + wr * 64 + fr, col0 = u.pn * HALF + wc * 32 + 8 * fq;
#pragma unroll
        for (int ai = 0; ai < 2; ++ai)
#pragma unroll
            for (int m = 0; m < 4; ++m) {
                bf16_t* rowp = H + (size_t)(row0 + ai * HALF + m * 16) * ldh + col0;
                float o[8];
#pragma unroll
                for (int n = 0; n < 2; ++n)
#pragma unroll
                    for (int e = 0; e < 4; ++e) { const float g = acc[ai][0][m][n][e], up = acc[ai][1][m][n][e]; o[n * 4 + e] = g * fast_sigmoid(g) * up; }
                u32x4 w; w.x = cvt_pk_bf16(o[0], o[1]); w.y = cvt_pk_bf16(o[2], o[3]); w.z = cvt_pk_bf16(o[4], o[5]); w.w = cvt_pk_bf16(o[6], o[7]);
                *(u32x4*)rowp = w;
            }
    }
};
struct EpiResid {
    static constexpr bool PERM = true, AFTER_DRAIN = false;
    const float* base; float* out; float s;
    __device__ __forceinline__ void operator()(const f32x4 (&acc)[2][2][4][2], const Unit& u, int wr, int wc, int fr, int fq) const {
        const int row0 = u.pm * BM + wr * 64 + fr, col0 = u.pn * BM + wc * 32 + 8 * fq;
#pragma unroll
        for (int ai = 0; ai < 2; ++ai)
#pragma unroll
            for (int m = 0; m < 4; ++m) {
                const size_t off = (size_t)(row0 + ai * HALF + m * 16) * 1024 + col0;
#pragma unroll
                for (int bj = 0; bj < 2; ++bj) {
                    const f32x4 b0 = *(const f32x4*)(base + off + bj * HALF), b1 = *(const f32x4*)(base + off + bj * HALF + 4);
                    *(f32x4*)(out + off + bj * HALF) = b0 + acc[ai][bj][m][0] * s; *(f32x4*)(out + off + bj * HALF + 4) = b1 + acc[ai][bj][m][1] * s;
                }
            }
    }
};
template <int MODE> struct EpiProj {
    static constexpr bool PERM = true, AFTER_DRAIN = false;
    bf16_t* MG; const bf16_t* G; int gofs;
    __device__ __forceinline__ void operator()(const f32x4 (&acc)[2][2][4][2], const Unit& u, int wr, int wc, int fr, int fq) const {
        const int row0 = u.pm * BM + wr * 64 + fr, col0 = u.pn * BM + wc * 32 + 8 * fq;
#pragma unroll
        for (int ai = 0; ai < 2; ++ai)
#pragma unroll
            for (int m = 0; m < 4; ++m) {
                const size_t row = (size_t)(row0 + ai * HALF + m * 16);
#pragma unroll
                for (int bj = 0; bj < 2; ++bj) {
                    const u32x4 gv = *(const u32x4*)(G + row * 3072 + gofs + col0 + bj * HALF);
                    bf16_t* mp = MG + row * 1024 + col0 + bj * HALF;
                    const f32x4 a0 = acc[ai][bj][m][0], a1 = acc[ai][bj][m][1];
                    float o[8] = {bflo(gv.x) * a0[0], bfhi(gv.x) * a0[1], bflo(gv.y) * a0[2], bfhi(gv.y) * a0[3], bflo(gv.z) * a1[0], bfhi(gv.z) * a1[1], bflo(gv.w) * a1[2], bfhi(gv.w) * a1[3]};
                    if (MODE) { const u32x4 ov = *(const u32x4*)mp; o[0] += bflo(ov.x); o[1] += bfhi(ov.x); o[2] += bflo(ov.y); o[3] += bfhi(ov.y); o[4] += bflo(ov.z); o[5] += bfhi(ov.z); o[6] += bflo(ov.w); o[7] += bfhi(ov.w); }
                    u32x4 w; w.x = cvt_pk_bf16(o[0], o[1]); w.y = cvt_pk_bf16(o[2], o[3]); w.z = cvt_pk_bf16(o[4], o[5]); w.w = cvt_pk_bf16(o[6], o[7]);
                    *(u32x4*)mp = w;
                }
            }
    }
};
struct EpiWin {
    static constexpr bool PERM = true, AFTER_DRAIN = false;
    bf16_t *QA, *QC, *IQ, *MISC, *KVC, *KVS, *KVW, *BU, *G; const float* rope;
    __device__ __forceinline__ void operator()(const f32x4 (&acc)[2][2][4][2], const Unit& u, int wr, int wc, int fr, int fq) const {
        const int pn = u.pn;
        bf16_t* dst; int ld, cbase, mode;
        if (pn < 2) { dst = QA; ld = 512; cbase = pn * 256; mode = 1; }
        else if (pn < 4) { dst = QC; ld = 512; cbase = (pn - 2) * 256; mode = 1; }
        else if (pn == 4) { dst = IQ; ld = 256; cbase = 0; mode = 1; }
        else if (pn == 5) { dst = MISC; ld = 256; cbase = 0; mode = 3; }
        else if (pn <= 8) { dst = pn == 6 ? KVC : (pn == 7 ? KVS : KVW); ld = 256; cbase = 0; mode = 2; }
        else if (pn <= 10) { dst = BU; ld = 512; cbase = (pn - 9) * 256; mode = 0; }
        else { dst = G; ld = 3072; cbase = (pn - 11) * 256; mode = 4; }
        const int row0 = u.pm * BM + wr * 64 + fr, col0 = cbase + wc * 32 + 8 * fq;
        const bool ropelane = ((wc & 1) == 0) && fq < 2;
        const float sc = (mode == 1) ? 0.125f : 1.0f;
#pragma unroll
        for (int ai = 0; ai < 2; ++ai)
#pragma unroll
            for (int m = 0; m < 4; ++m) {
                const size_t row = (size_t)(row0 + ai * HALF + m * 16);
                f32x4 cs = {1.f, 1.f, 1.f, 1.f}, sn = {0.f, 0.f, 0.f, 0.f};
                if (ropelane && mode >= 1 && mode <= 3) { cs = *(const f32x4*)(rope + row * 16 + 4 * fq); sn = *(const f32x4*)(rope + row * 16 + 8 + 4 * fq); }
#pragma unroll
                for (int bj = 0; bj < 2; ++bj) {
                    const f32x4 a0 = acc[ai][bj][m][0], a1 = acc[ai][bj][m][1];
                    float o[8] = {a0[0], a0[1], a0[2], a0[3], a1[0], a1[1], a1[2], a1[3]};
                    const bool dorope = ropelane && (mode == 1 || (mode == 2 && bj == 0) || (mode == 3 && bj == 0 && wc == 0));
                    if (dorope) {
#pragma unroll
                        for (int p = 0; p < 4; ++p) { const float x1 = o[2 * p], x2 = o[2 * p + 1]; o[2 * p] = x1 * cs[p] - x2 * sn[p]; o[2 * p + 1] = x2 * cs[p] + x1 * sn[p]; }
                    }
                    if (mode == 4) {
#pragma unroll
                        for (int e = 0; e < 8; ++e) o[e] = fast_sigmoid(o[e]);
                    } else {
#pragma unroll
                        for (int e = 0; e < 8; ++e) o[e] *= sc;
                    }
                    u32x4 w; w.x = cvt_pk_bf16(o[0], o[1]); w.y = cvt_pk_bf16(o[2], o[3]); w.z = cvt_pk_bf16(o[4], o[5]); w.w = cvt_pk_bf16(o[6], o[7]);
                    *(u32x4*)(dst + row * ld + col0 + bj * HALF) = w;
                }
            }
    }
};

template <class Epi, class Sched, bool ALIGN_EPI = false, bool SP2 = false>
__device__ __forceinline__ void gemm_phase(PG8_LAS unsigned char* lds, const Gemm g, const Sched& S, const Epi& E) {
    int tid_ = threadIdx.x; asm volatile("" : "+v"(tid_));
    const int tid = tid_, wid = __builtin_amdgcn_readfirstlane(tid >> 6), lane = tid & 63, wr = wid >> 2, wc = wid & 3, fr = lane & 15, fq = lane >> 4;
    const int K = g.K, nt = K / BK;
    unsigned voffA[2], voffB[2];
#pragma unroll
    for (int i = 0; i < 2; ++i) { int R, C; stage_rc(tid * 16 + i * 8192, R, C); const int Rb = Epi::PERM ? ((R & ~31) + perm32(R & 31)) : R;
        voffA[i] = (unsigned)(R * K + C) * 2u; voffB[i] = (unsigned)(Rb * K + C) * 2u; }
    const size_t kstep = (size_t)(BK * 2);
    const size_t hstep = (size_t)HALF * K * 2;
    const size_t tstep = 2 * hstep;
    const unsigned ldsw = (unsigned)wid * 1024u;
    const int aoff = lds_byte(wr * 64 + fr, fq * 8), boff = lds_byte(wc * 32 + fr, fq * 8);
#define PG8_SA(b, h) (((b) * 2 + (h)) * HTB)
#define PG8_SB(b, h) ((4 + (b) * 2 + (h)) * HTB)
#define PG8_STAGE(bufoff, gbase, voff) do { _Pragma("unroll") for (int _i = 0; _i < 2; ++_i) \
        __builtin_amdgcn_global_load_lds((const unsigned*)((const char*)(gbase) + (voff)[_i]), (PG8_LAS unsigned*)(lds + (bufoff) + ldsw + _i * 8192), 16, 0, 0); } while (0)
#define PG8_LDA(dst, b, h) do { _Pragma("unroll") for (int m = 0; m < 4; ++m) _Pragma("unroll") for (int k = 0; k < 2; ++k) dst[m][k] = *(const PG8_LAS bf16x8*)(lds + PG8_SA(b, h) + aoff + m * 2048 + k * 1024); } while (0)
#define PG8_LDB(dst, b, h) do { _Pragma("unroll") for (int n = 0; n < 2; ++n) _Pragma("unroll") for (int k = 0; k < 2; ++k) dst[n][k] = *(const PG8_LAS bf16x8*)(lds + PG8_SB(b, h) + boff + n * 2048 + k * 1024); } while (0)
#define PG8_MMA(ai, bj, At, Bt) do { __builtin_amdgcn_s_setprio(1); _Pragma("unroll") for (int m = 0; m < 4; ++m) _Pragma("unroll") for (int n = 0; n < 2; ++n) _Pragma("unroll") for (int k = 0; k < 2; ++k) \
        acc[ai][bj][m][n] = __builtin_amdgcn_mfma_f32_16x16x32_bf16(Bt[n][k], At[m][k], acc[ai][bj][m][n], 0, 0, 0); __builtin_amdgcn_s_setprio(0); } while (0)
#define PG8_WAIT_V(n) asm volatile("s_waitcnt vmcnt(" #n ")" ::: "memory")
#define PG8_WAIT_L(n) asm volatile("s_waitcnt lgkmcnt(" #n ")" ::: "memory")
#define PG8_BAR __builtin_amdgcn_s_barrier()
#define PG8_SCHED __builtin_amdgcn_sched_barrier(0)
    Unit cur, nxt; int ui = 0;
    if (!S.next(0, cur)) return;
    f32x4 acc[2][2][4][2];
#pragma unroll
    for (int a = 0; a < 2; ++a)
#pragma unroll
        for (int b = 0; b < 2; ++b)
#pragma unroll
            for (int m = 0; m < 4; ++m)
#pragma unroll
                for (int n = 0; n < 2; ++n) acc[a][b][m][n] = (f32x4){0.f, 0.f, 0.f, 0.f};
    bf16x8 At[4][2], B0[2][2], B1[2][2];
    const char* cA = (const char*)g.A + (size_t)cur.pm * tstep; const char* cB = (const char*)g.Bt + (size_t)cur.pn * tstep;
    S.a_ready(cur);
    if constexpr (SP2) {
        PG8_STAGE(PG8_SB(0, 0), cB, voffB); PG8_STAGE(PG8_SB(0, 1), cB + hstep, voffB); PG8_STAGE(PG8_SA(0, 0), cA, voffA); PG8_STAGE(PG8_SA(0, 1), cA + hstep, voffA);
        if (wr == 1) PG8_BAR;
        PG8_WAIT_V(2); PG8_BAR;
        PG8_STAGE(PG8_SB(1, 0), cB + kstep, voffB); PG8_STAGE(PG8_SA(1, 0), cA + kstep, voffA); PG8_STAGE(PG8_SB(1, 1), cB + hstep + kstep, voffB);
        PG8_WAIT_V(6); PG8_BAR;
    } else {
        PG8_STAGE(PG8_SB(0, 0), cB, voffB); PG8_STAGE(PG8_SA(0, 0), cA, voffA); PG8_STAGE(PG8_SB(0, 1), cB + hstep, voffB); PG8_STAGE(PG8_SA(0, 1), cA + hstep, voffA);
        if (wr == 1) PG8_BAR;
        PG8_WAIT_V(4); PG8_BAR;
        PG8_STAGE(PG8_SB(1, 0), cB + kstep, voffB); PG8_STAGE(PG8_SA(1, 0), cA + kstep, voffA); PG8_STAGE(PG8_SB(1, 1), cB + hstep + kstep, voffB);
        PG8_WAIT_V(6); PG8_BAR;
    }
    for (;;) {
        const bool has_next = S.next(ui + 1, nxt);
        const char* nA = has_next ? (const char*)g.A + (size_t)nxt.pm * tstep : cA; const char* nB = has_next ? (const char*)g.Bt + (size_t)nxt.pn * tstep : cB;
        for (int t = 0; t < nt; t += 2) {
            const bool last = (t == nt - 2);
            const char* a1 = cA + (size_t)(t + 1) * kstep;
            const char* a2 = last ? nA : cA + (size_t)(t + 2) * kstep; const char* b2 = last ? nB : cB + (size_t)(t + 2) * kstep;
            const char* a3 = a2 + kstep; const char* b3 = b2 + kstep;
            if (last && has_next) S.a_ready(nxt);
            if constexpr (SP2) {
            PG8_LDB(B0, 0, 0); PG8_LDB(B1, 0, 1); PG8_SCHED; PG8_LDA(At, 0, 0); PG8_STAGE(PG8_SA(1, 1), a1 + hstep, voffA);
            PG8_WAIT_V(8); PG8_WAIT_L(0); PG8_BAR; PG8_MMA(0, 0, At, B0); PG8_MMA(0, 1, At, B1); PG8_BAR; PG8_SCHED;
            PG8_LDA(At, 0, 1); PG8_STAGE(PG8_SB(0, 0), b2, voffB); PG8_STAGE(PG8_SB(0, 1), b2 + hstep, voffB); PG8_STAGE(PG8_SA(0, 0), a2, voffA);
            PG8_WAIT_V(8); PG8_WAIT_L(0); PG8_BAR; PG8_MMA(1, 0, At, B0); PG8_MMA(1, 1, At, B1); PG8_BAR; PG8_SCHED;
            PG8_LDB(B0, 1, 0); PG8_LDB(B1, 1, 1); PG8_SCHED; PG8_LDA(At, 1, 0); PG8_STAGE(PG8_SA(0, 1), a2 + hstep, voffA);
            PG8_WAIT_V(8); PG8_WAIT_L(0); PG8_BAR; PG8_MMA(0, 0, At, B0); PG8_MMA(0, 1, At, B1); PG8_BAR; PG8_SCHED;
            PG8_LDA(At, 1, 1); PG8_STAGE(PG8_SB(1, 0), b3, voffB); PG8_STAGE(PG8_SB(1, 1), b3 + hstep, voffB); PG8_STAGE(PG8_SA(1, 0), a3, voffA);
            PG8_WAIT_V(8); PG8_WAIT_L(0); PG8_BAR; PG8_MMA(1, 0, At, B0); PG8_MMA(1, 1, At, B1); PG8_BAR; PG8_SCHED;
            } else {
            PG8_LDB(B0, 0, 0); PG8_SCHED; PG8_LDA(At, 0, 0); PG8_STAGE(PG8_SA(1, 1), a1 + hstep, voffA);
            PG8_WAIT_L(8); PG8_BAR; PG8_WAIT_L(0); PG8_MMA(0, 0, At, B0); PG8_BAR; PG8_SCHED;
            PG8_LDB(B1, 0, 1); PG8_STAGE(PG8_SB(0, 0), b2, voffB);
            PG8_BAR; PG8_WAIT_L(0); PG8_MMA(0, 1, At, B1); PG8_BAR;
            PG8_LDA(At, 0, 1); PG8_STAGE(PG8_SA(0, 0), a2, voffA);
            PG8_BAR; PG8_WAIT_L(0); PG8_MMA(1, 0, At, B0); PG8_BAR; PG8_SCHED;
            PG8_STAGE(PG8_SB(0, 1), b2 + hstep, voffB);
            PG8_WAIT_V(6); PG8_BAR; PG8_MMA(1, 1, At, B1); PG8_BAR;
            PG8_LDB(B0, 1, 0); PG8_SCHED; PG8_LDA(At, 1, 0); PG8_STAGE(PG8_SA(0, 1), a2 + hstep, voffA);
            PG8_WAIT_L(8); PG8_BAR; PG8_WAIT_L(0); PG8_MMA(0, 0, At, B0); PG8_BAR; PG8_SCHED;
            PG8_LDB(B1, 1, 1); PG8_STAGE(PG8_SB(1, 0), b3, voffB);
            PG8_BAR; PG8_WAIT_L(0); PG8_MMA(0, 1, At, B1); PG8_BAR;
            PG8_LDA(At, 1, 1); PG8_STAGE(PG8_SA(1, 0), a3, voffA);
            PG8_BAR; PG8_WAIT_L(0); PG8_MMA(1, 0, At, B0); PG8_BAR; PG8_SCHED;
            PG8_STAGE(PG8_SB(1, 1), b3 + hstep, voffB);
            PG8_WAIT_V(6); PG8_BAR; PG8_MMA(1, 1, At, B1); PG8_BAR;
            }
        }
        if constexpr (ALIGN_EPI) { if (wr == 0) PG8_BAR; }
        if constexpr (!Epi::AFTER_DRAIN) { E(acc, cur, wr, wc, fr, fq); S.done(cur); }
        if (!has_next) break;
#pragma unroll
        for (int a = 0; a < 2; ++a)
#pragma unroll
            for (int b = 0; b < 2; ++b)
#pragma unroll
                for (int m = 0; m < 4; ++m)
#pragma unroll
                    for (int n = 0; n < 2; ++n) acc[a][b][m][n] = (f32x4){0.f, 0.f, 0.f, 0.f};
        cur = nxt; cA = nA; cB = nB; ++ui;
        if constexpr (ALIGN_EPI) { if (wr == 1) PG8_BAR; }
    }
    PG8_WAIT_V(0);
    if constexpr (!ALIGN_EPI) { if (wr == 0) PG8_BAR; }
    PG8_BAR;
    if constexpr (Epi::AFTER_DRAIN) { E.fused(acc, cur, wr, wc, fr, fq, lds, wid, lane); S.done(cur); }
#undef PG8_SA
#undef PG8_SB
#undef PG8_STAGE
#undef PG8_LDA
#undef PG8_LDB
#undef PG8_MMA
#undef PG8_WAIT_V
#undef PG8_WAIT_L
#undef PG8_BAR
#undef PG8_SCHED
}
}
#define GAS __attribute__((address_space(1)))
#define LAS __attribute__((address_space(3)))
typedef unsigned short bf16;
typedef unsigned v4u __attribute__((ext_vector_type(4)));
typedef float f32x4 __attribute__((ext_vector_type(4)));
typedef short bf16x8 __attribute__((ext_vector_type(8)));
typedef GAS unsigned gu32;
typedef GAS unsigned long long gu64;
#define RLX_AGENT __ATOMIC_RELAXED, __HIP_MEMORY_SCOPE_AGENT
#define LDS_WAIT() asm volatile("s_waitcnt lgkmcnt(0)" ::: "memory")
#define VM_WAIT() asm volatile("s_waitcnt vmcnt(0)" ::: "memory")
__device__ __forceinline__ unsigned long long rt() { return __builtin_amdgcn_s_memrealtime(); }
__device__ __forceinline__ unsigned f2bf(float f) { unsigned u = __builtin_bit_cast(unsigned, f); return (u + 0x7fffu + ((u >> 16) & 1u)) >> 16; }
__device__ __forceinline__ unsigned pk2(float lo, float hi) { return f2bf(lo) | (f2bf(hi) << 16); }
#define XB_TMO      128
#define XB_XCNT(j)  (256  + 64 * (j))
#define XB_XSUB(j)  (1280 + 64 * (j))
#define XB_XGEN(j)  (2304 + 64 * (j))
#define XB_TOP      3328
#define XB_TOPGEN   3392
#define XCD_BAR_WORDS 3456
#define XB_SPIN_CAP (1u << 18)

__device__ __forceinline__ unsigned xb_ld(unsigned* p)              { return __hip_atomic_load(p, __ATOMIC_RELAXED, __HIP_MEMORY_SCOPE_AGENT); }
__device__ __forceinline__ unsigned xb_add(unsigned* p, unsigned v) { return __hip_atomic_fetch_add(p, v, __ATOMIC_RELAXED, __HIP_MEMORY_SCOPE_AGENT); }
__device__ __forceinline__ unsigned xb_xcc_id() { return (unsigned)__builtin_amdgcn_s_getreg((3 << 11) | 20) & 0xFu; }
#define XB_SPIN(cond, bar) do { unsigned _sp = 0; while (cond) { __builtin_amdgcn_s_sleep(1); \
    if ((++_sp & 255u) == 0u) { if (xb_ld(&(bar)[XB_TMO])) break; if (_sp > XB_SPIN_CAP) { atomicAdd(&(bar)[XB_TMO], 1u); break; } } } } while (0)

struct XcdBarrier {
    unsigned* bar; unsigned x;
    volatile LAS unsigned* st;
};

__device__ __forceinline__ XcdBarrier xcd_barrier_post(unsigned* bar, volatile LAS unsigned* st) {
    XcdBarrier b; b.bar = bar; b.x = xb_xcc_id(); b.st = st;
    if (threadIdx.x == 0) (void)xb_add(&bar[XB_XCNT(b.x)], 1u);
    return b;
}
__device__ __forceinline__ void xcd_barrier_complete(unsigned* bar, unsigned x, unsigned& nloc, unsigned& nx) {
    const unsigned G = gridDim.x * gridDim.y * gridDim.z;
    unsigned sum, cnt, mine, sp = 0u;
    for (;;) {
        sum = 0u; cnt = 0u; mine = 0u;
#pragma unroll
        for (unsigned j = 0; j < 16; ++j) { const unsigned c = xb_ld(&bar[XB_XCNT(j)]); sum += c; cnt += (c > 0u) ? 1u : 0u; mine = (j == x) ? c : mine; }
        if (sum == G) break;
        __builtin_amdgcn_s_sleep(1);
        if ((++sp & 255u) == 0u) { if (xb_ld(&bar[XB_TMO])) break; if (sp > XB_SPIN_CAP) { atomicAdd(&bar[XB_TMO], 1u); break; } }
    }
    nloc = mine > 0u ? mine : 1u; nx = cnt > 0u ? cnt : 1u;
}

__device__ __forceinline__ void xcd_barrier(const XcdBarrier& b) {
    asm volatile("s_waitcnt vmcnt(0)" ::: "memory");
    __syncthreads();
    if (threadIdx.x == 0) {
        unsigned* bar = b.bar;
        __builtin_amdgcn_s_waitcnt(0);
        unsigned nloc = b.st[0], nx = b.st[1];
        if (nloc == 0u) { xcd_barrier_complete(bar, b.x, nloc, nx); b.st[0] = nloc; b.st[1] = nx; }
        const unsigned old = xb_add(&bar[XB_XSUB(b.x)], 1u);
        const unsigned gen = old / nloc;
        if (old + 1u == (gen + 1u) * nloc) {
            __builtin_amdgcn_fence(__ATOMIC_RELEASE, "agent");
            asm volatile("s_waitcnt vmcnt(0)" ::: "memory");
            const unsigned og = xb_add(&bar[XB_TOP], 1u);
            const unsigned tg = og / nx;
            if (og + 1u == (tg + 1u) * nx) xb_add(&bar[XB_TOPGEN], 1u);
            else XB_SPIN(xb_ld(&bar[XB_TOPGEN]) == tg, bar);
            __builtin_amdgcn_fence(__ATOMIC_ACQUIRE, "agent");
            xb_add(&bar[XB_XGEN(b.x)], 1u);
            asm volatile("s_waitcnt vmcnt(0)" ::: "memory");
        } else {
            XB_SPIN(xb_ld(&bar[XB_XGEN(b.x)]) == gen, bar);
            __builtin_amdgcn_fence(__ATOMIC_ACQUIRE, "agent");
            asm volatile("s_waitcnt vmcnt(0)" ::: "memory");
        }
    }
    __syncthreads();
}
constexpr int NB = 8, SEQ = 4096, DM = 1024, DEPTH = 4, M = NB * SEQ;
constexpr int FF = 2816, NIN = 5852, NINP = 5888;
constexpr float EPS = 1e-6f, NEGF = -1e30f;
constexpr int NWAVES = 8;
constexpr size_t MiB = 1u << 20;
constexpr size_t WS_CTL = 0, CTL_ZERO_BYTES = 1 * MiB;
constexpr size_t WS_ROPE = 1 * MiB;
constexpr size_t WS_KVA = 3 * MiB;
constexpr size_t WS_KC = 11 * MiB, WS_VC = WS_KC + 512 * 1024;
constexpr size_t WS_W = 12 * MiB;
constexpr size_t WO_GU1 = 0, WO_D1 = 11 * MiB, WO_GU2 = WO_D1 + 5 * MiB + 512 * 1024, WO_D2 = WO_GU2 + 11 * MiB, WO_IN = WO_D2 + 5 * MiB + 512 * 1024,
                 WO_PA = WO_IN + 11 * MiB + 512 * 1024, WO_PB = WO_PA + MiB, WO_PC = WO_PB + MiB, WO_OUT = WO_PC + MiB, WO_END = WO_OUT + 2 * MiB;
static_assert(WO_END <= 52 * MiB, "weights region");
constexpr size_t WS_XN = 64 * MiB;
constexpr size_t WS_R = 128 * MiB;
constexpr size_t WS_G = WS_R, WS_QA = WS_R + 192 * MiB, WS_QC = WS_QA + 32 * MiB, WS_IQ = WS_QC + 32 * MiB, WS_MISC = WS_IQ + 16 * MiB,
                 WS_KVC = WS_MISC + 16 * MiB, WS_KVS = WS_KVC + 16 * MiB, WS_KVW = WS_KVS + 16 * MiB, WS_BU = WS_KVW + 16 * MiB, WS_END = WS_BU + 32 * MiB;
constexpr size_t WS_MG = WS_IQ;
constexpr size_t WS_H = WS_R;
static_assert(WS_END == 496 * MiB, "ws map");
constexpr int RING_BYTES = 131072, LDS_BYTES = 163840, LDSCTL_OFF = 163840 - 256;
constexpr int NPL = 12, NPH = 1 + DEPTH * NPL + 1;

__device__ __forceinline__ float bflo(unsigned w) { return __uint_as_float(w << 16); }
__device__ __forceinline__ float bfhi(unsigned w) { return __uint_as_float(w & 0xffff0000u); }
__device__ __forceinline__ float bf2f(bf16 v) { return __uint_as_float((unsigned)v << 16); }
__device__ __forceinline__ float wave_sum(float v) {
#pragma unroll
    for (int o = 1; o < 64; o <<= 1) v += __shfl_xor(v, o);
    return v;
}
__device__ __forceinline__ float wave_max(float v) {
#pragma unroll
    for (int o = 1; o < 64; o <<= 1) v = fmaxf(v, __shfl_xor(v, o));
    return v;
}
__device__ __forceinline__ int wave_sum_i(int v) {
#pragma unroll
    for (int o = 1; o < 64; o <<= 1) v += __shfl_xor(v, o);
    return v;
}
__device__ __forceinline__ unsigned wave_max_u(unsigned v) {
#pragma unroll
    for (int o = 1; o < 64; o <<= 1) { const unsigned w = (unsigned)__shfl_xor((int)v, o); v = w > v ? w : v; }
    return v;
}
#define WAVE_LDS_SYNC() do { asm volatile("s_waitcnt lgkmcnt(0)" ::: "memory"); __builtin_amdgcn_wave_barrier(); } while (0)
__host__ __device__ __forceinline__ int permd(int d) { return d < 8 ? 2 * d : (d < 16 ? 2 * (d - 8) + 1 : d); }
__device__ __forceinline__ int win_newcol(int n) {
    if (n < 512) return (n & ~63) + permd(n & 63);
    if (n < 640) return 1280 + 64 + (n - 512);
    if (n < 896) { const int m = n - 640; return 1024 + (m & ~63) + permd(m & 63); }
    if (n < 960) return 1280 + permd(n - 896);
    if (n < 964) return 1280 + 192 + (n - 960);
    if (n < 1476) return 2304 + (n - 964);
    if (n < 1988) { const int m = n - 1476; return 512 + (m & ~63) + permd(m & 63); }
    if (n < 2756) { const int m = n - 1988, kv = m >> 8, r = m & 255, base = 1536 + kv * 256; return r < 128 ? base + (r & ~63) + permd(r & 63) : base + r; }
    if (n < 2780) return 1280 + 196 + (n - 2756);
    return 2816 + (n - 2780);
}
__device__ __forceinline__ int map_row(int mode, int n) { return mode == 0 ? n : (mode == 1 ? ((n >> 7) << 8) + (n & 127) : (mode == 2 ? ((n >> 7) << 8) + 128 + (n & 127) : win_newcol(n))); }

struct Args { const float* in[24]; float* out; unsigned char* ws; int ph_lo, ph_hi; };

__device__ __forceinline__ void tr_item(const float* W, int K, int N, bf16* WT, int mode, LAS float* scr, int item, int lane) {
    const int nblk = (N + 31) >> 5, kb = item / nblk, nb = item - kb * nblk, k0 = 64 * kb, n0 = 32 * nb;
    const int nn = n0 + (lane & 31);
#pragma unroll 8
    for (int i = 0; i < 32; ++i) { const int kk = 2 * i + (lane >> 5); scr[kk * 33 + (lane & 31)] = nn < N ? W[(size_t)(k0 + kk) * N + nn] : 0.f; }
    LDS_WAIT(); asm volatile("" ::: "memory");
    const int c = lane & 7;
#pragma unroll
    for (int j = 0; j < 4; ++j) { const int n = (lane >> 3) + 8 * j; const LAS float* s = scr + (8 * c) * 33 + n;
        v4u o; o.x = pk2(s[0 * 33], s[1 * 33]); o.y = pk2(s[2 * 33], s[3 * 33]); o.z = pk2(s[4 * 33], s[5 * 33]); o.w = pk2(s[6 * 33], s[7 * 33]);
        if (n0 + n < N) *(v4u*)(WT + (size_t)map_row(mode, n0 + n) * K + k0 + 8 * c) = o; }
    LDS_WAIT(); asm volatile("" ::: "memory");
}
__device__ __forceinline__ void phase_convert(const Args& P, unsigned char* ws, int z, int l, LAS unsigned char* lds, int gw, int NGW, int lane, int wave) {
    asm volatile("" : "+v"(lane)); asm volatile("" : "+s"(gw));
    LAS float* scr = (LAS float*)(lds + wave * 16384);
    unsigned char* wb = ws + WS_W;
    constexpr int I_F = 16 * 88, I_D = 44 * 32, I_IN = 16 * 183, I_P = 8 * 32, I_O = 16 * 32;
    constexpr int NIT = 4 * I_F + 2 * I_D + I_IN + 3 * I_P + I_O;
    const size_t fo = (size_t)l * DM * FF;
    for (int it = gw; it < NIT; it += NGW) {
        int r = it, K = DM, N = FF, mode = 1; const float* W = P.in[3 + z] + fo; size_t wo = WO_GU1;
        if (r >= I_F) { r -= I_F; mode = 2; W = P.in[4 + z] + fo;
        if (r >= I_F) { r -= I_F; mode = 0; W = P.in[5 + z] + fo; K = FF; N = DM; wo = WO_D1;
        if (r >= I_D) { r -= I_D; mode = 1; W = P.in[20 + z] + fo; K = DM; N = FF; wo = WO_GU2;
        if (r >= I_F) { r -= I_F; mode = 2; W = P.in[21 + z] + fo;
        if (r >= I_F) { r -= I_F; mode = 0; W = P.in[22 + z] + fo; K = FF; N = DM; wo = WO_D2;
        if (r >= I_D) { r -= I_D; mode = 3; W = P.in[7 + z] + (size_t)l * DM * NIN; K = DM; N = NIN; wo = WO_IN;
        if (r >= I_IN) { r -= I_IN; mode = 0; W = P.in[15 + z] + (size_t)l * 512 * DM; K = 512; N = DM; wo = WO_PA;
        if (r >= I_P) { r -= I_P; W = P.in[16 + z] + (size_t)l * 512 * DM; wo = WO_PB;
        if (r >= I_P) { r -= I_P; W = P.in[17 + z] + (size_t)l * 512 * DM; wo = WO_PC;
        if (r >= I_P) { r -= I_P; W = P.in[18 + z] + (size_t)l * DM * DM; K = DM; wo = WO_OUT; } } } } } } } } } }
        tr_item(W, K, N, (bf16*)(wb + wo), mode, scr, r, lane);
    }
    if (gw < 36) { v4u z = {0u, 0u, 0u, 0u}; v4u* rp = (v4u*)((bf16*)(wb + WO_IN) + (size_t)(1500 + gw) * DM); for (int i = lane; i < DM / 8; i += 64) rp[i] = z; }
}
__device__ __forceinline__ void phase_rope(const Args& P, unsigned char* ws, int z, int gtid, int gthreads) {
    float* rope = (float*)(ws + WS_ROPE);
    for (int idx = gtid; idx < M * 8; idx += gthreads) {
        const int row = idx >> 3, i = idx & 7;
        const double inv = pow(500000.0, -(double)i / 8.0), ang = (double)((const int*)P.in[1 + z])[row] * inv;
        double s, c; sincos(ang, &s, &c);
        rope[row * 16 + i] = (float)c; rope[row * 16 + 8 + i] = (float)s;
    }
}
__device__ __forceinline__ void norm_row_bf16(const float* xrow, const float* gain, bf16* orow, int lane) {
    const f32x4* xr = (const f32x4*)xrow + lane; const f32x4* gr = (const f32x4*)gain + lane;
    f32x4 v[4]; float s = 0.f;
#pragma unroll
    for (int j = 0; j < 4; ++j) { v[j] = xr[64 * j]; s += (v[j].x * v[j].x + v[j].y * v[j].y) + (v[j].z * v[j].z + v[j].w * v[j].w); }
    const float r = 1.0f / sqrtf(wave_sum(s) * (1.f / DM) + EPS);
    unsigned long long* o8 = (unsigned long long*)orow + lane;
#pragma unroll
    for (int j = 0; j < 4; ++j) { const f32x4 g = gr[64 * j]; o8[64 * j] = (unsigned long long)pk2(v[j].x * r * g.x, v[j].y * r * g.y) | ((unsigned long long)pk2(v[j].z * r * g.z, v[j].w * r * g.w) << 32); }
}
__device__ __forceinline__ void norm_row_f32(float* xrow, const float* gain, int lane) {
    f32x4* xr = (f32x4*)xrow + lane; const f32x4* gr = (const f32x4*)gain + lane;
    f32x4 v[4]; float s = 0.f;
#pragma unroll
    for (int j = 0; j < 4; ++j) { v[j] = xr[64 * j]; s += (v[j].x * v[j].x + v[j].y * v[j].y) + (v[j].z * v[j].z + v[j].w * v[j].w); }
    const float r = 1.0f / sqrtf(wave_sum(s) * (1.f / DM) + EPS);
#pragma unroll
    for (int j = 0; j < 4; ++j) { const f32x4 g = gr[64 * j]; xr[64 * j] = v[j] * r * g; }
}
__device__ __forceinline__ void prep_kva_row(const Args& P, unsigned char* ws, int z, int l, int row, LAS float* wl, int lane) {
    const bf16* misc = (const bf16*)(ws + WS_MISC) + (size_t)row * 256;
    const unsigned cw = *(const unsigned*)(misc + 64 + 2 * lane);
    const float c0 = bflo(cw), c1 = bfhi(cw);
    const float r = 1.0f / sqrtf(wave_sum(c0 * c0 + c1 * c1) * (1.f / 128.f) + EPS);
    const float* gn = P.in[8 + z] + l * 128;
    wl[2 * lane] = c0 * r * gn[2 * lane]; wl[2 * lane + 1] = c1 * r * gn[2 * lane + 1];
    WAVE_LDS_SYNC();
    const float* w = P.in[9 + z] + (size_t)l * 128 * 128;
    float a0 = 0.f, a1 = 0.f;
#pragma unroll 8
    for (int k = 0; k < 128; ++k) { const float c = wl[k]; a0 += c * w[k * 128 + lane]; a1 += c * w[k * 128 + 64 + lane]; }
    WAVE_LDS_SYNC();
    wl[lane] = a0;
    WAVE_LDS_SYNC();
    const float* rp = (const float*)(ws + WS_ROPE) + (size_t)row * 16;
    float kr = a0;
    if (lane < 8) kr = a0 * rp[lane] - wl[lane + 8] * rp[8 + lane];
    else if (lane < 16) kr = a0 * rp[lane - 8] + wl[lane - 8] * rp[8 + lane - 8];
    bf16* o = (bf16*)(ws + WS_KVA) + (size_t)row * 128;
    o[permd(lane)] = (bf16)f2bf(kr); o[64 + lane] = (bf16)f2bf(a1);
    WAVE_LDS_SYNC();
}
__device__ __forceinline__ void prep_pool_row(const Args& P, unsigned char* ws, int z, int l, int row, LAS float* wl, int lane) {
    const int t = row & (SEQ - 1), g = lane >> 4, w = 2 << g, lo = (t + 1 - w) > 0 ? (t + 1 - w) : 0, cnt = t + 1 - lo;
    const bf16* bu = (const bf16*)(ws + WS_BU);
    float sum[8] = {0.f, 0.f, 0.f, 0.f, 0.f, 0.f, 0.f, 0.f}, cur[8];
    for (int tt = lo; tt <= t; ++tt) {
        const v4u v = *(const v4u*)(bu + (size_t)(row - t + tt) * 512 + lane * 8);
        cur[0] = bflo(v.x); cur[1] = bfhi(v.x); cur[2] = bflo(v.y); cur[3] = bfhi(v.y); cur[4] = bflo(v.z); cur[5] = bfhi(v.z); cur[6] = bflo(v.w); cur[7] = bfhi(v.w);
#pragma unroll
        for (int e = 0; e < 8; ++e) sum[e] += cur[e];
    }
    const float inv = 1.0f / (float)cnt;
#pragma unroll
    for (int e = 0; e < 8; ++e) wl[lane * 8 + e] = sum[e] * inv - cur[e];
    WAVE_LDS_SYNC();
    const float* pw = P.in[10 + z] + (size_t)l * 4 * 128 * 128; const float* ps = P.in[11 + z] + l * 512;
    bf16* yb = (bf16*)(ws + WS_XN) + (size_t)row * 512;
    for (int gg = 0; gg < 4; ++gg) {
        const float* wg = pw + gg * 128 * 128; float a0 = 0.f, a1 = 0.f;
#pragma unroll 8
        for (int c = 0; c < 128; ++c) { const float x = wl[gg * 128 + c]; a0 += x * wg[c * 128 + lane]; a1 += x * wg[c * 128 + 64 + lane]; }
        yb[gg * 128 + lane] = (bf16)f2bf(a0 * ps[gg * 128 + lane]); yb[gg * 128 + 64 + lane] = (bf16)f2bf(a1 * ps[gg * 128 + 64 + lane]);
    }
    WAVE_LDS_SYNC();
}
__device__ __forceinline__ float gelu_tanh(float x) { const float u = 0.7978845608028654f * (x + 0.044715f * x * x * x); return 0.5f * x * (1.0f + tanhf(u)); }
__device__ __forceinline__ void prep_cmp_item(const Args& P, unsigned char* ws, int z, int l, int item, LAS float* wl, int lane) {
    const int i = item & 255, bg = (item >> 8) & 15, br = item >> 12, b = bg >> 1, g = bg & 1;
    bf16* dst = (bf16*)(ws + (br ? WS_VC : WS_KC)) + ((size_t)bg * 256 + i) * 64;
    if (i == 255) { dst[lane] = 0; return; }
    const bf16* kvc = (const bf16*)(ws + WS_KVC);
    const float* pos = P.in[12 + z] + (size_t)(l * 2 + br) * 32 * 64;
    const int sd = br ? lane : permd(lane);
    for (int ll = 0; ll < 32; ++ll) wl[ll * 64 + lane] = bf2f(kvc[(size_t)(b * SEQ + 16 * i + ll) * 256 + br * 128 + g * 64 + sd]) + pos[ll * 64 + lane];
    WAVE_LDS_SYNC();
    const float* w1 = P.in[13 + z] + (size_t)(l * 2 + br) * 2048 * 128;
    float a0 = 0.f, a1 = 0.f;
#pragma unroll 8
    for (int k = 0; k < 2048; ++k) { const float x = wl[k]; a0 += x * w1[(size_t)k * 128 + lane]; a1 += x * w1[(size_t)k * 128 + 64 + lane]; }
    wl[2048 + lane] = gelu_tanh(a0); wl[2048 + 64 + lane] = gelu_tanh(a1);
    WAVE_LDS_SYNC();
    const float* w2 = P.in[14 + z] + (size_t)(l * 2 + br) * 128 * 64;
    float o = 0.f;
#pragma unroll 8
    for (int n = 0; n < 128; ++n) o += wl[2048 + n] * w2[n * 64 + lane];
    dst[sd] = (bf16)f2bf(o);
    WAVE_LDS_SYNC();
}
__device__ __forceinline__ void phase_prep(const Args& P, unsigned char* ws, int z, int l, LAS unsigned char* lds, int gw, int NGW, int lane, int wave) {
    asm volatile("" : "+v"(lane)); asm volatile("" : "+s"(gw));
    LAS float* wl = (LAS float*)(lds + wave * 16384);
    for (int it = gw; it < 2 * 16 * 256; it += NGW) prep_cmp_item(P, ws, z, l, it, wl, lane);
    for (int row = gw; row < M; row += NGW) { prep_kva_row(P, ws, z, l, row, wl, lane); prep_pool_row(P, ws, z, l, row, wl, lane); }
}
__device__ __forceinline__ unsigned f2o(float s) { const unsigned b = __float_as_uint(s); return (b & 0x80000000u) ? ~b : (b | 0x80000000u); }
__device__ __forceinline__ void unpack8(const v4u v, float* f) { f[0] = bflo(v.x); f[1] = bfhi(v.x); f[2] = bflo(v.y); f[3] = bfhi(v.y); f[4] = bflo(v.z); f[5] = bfhi(v.z); f[6] = bflo(v.w); f[7] = bfhi(v.w); }
__device__ __forceinline__ void load_row64(const bf16* p, float* f) {
    const v4u* q = (const v4u*)p;
#pragma unroll
    for (int i = 0; i < 8; ++i) unpack8(q[i], f + 8 * i);
}
__device__ __forceinline__ float dot64(const LAS float* q, const float* k) {
    float d = 0.f;
#pragma unroll
    for (int i = 0; i < 16; ++i) { const f32x4 qq = *(const LAS f32x4*)(q + 4 * i); d += qq.x * k[4 * i] + qq.y * k[4 * i + 1] + qq.z * k[4 * i + 2] + qq.w * k[4 * i + 3]; }
    return d;
}
__device__ __forceinline__ void dsa_query(const Args& P, unsigned char* ws, int z, int row, LAS unsigned char* wl, int lane) {
    const int b = row >> 12, t = row & (SEQ - 1), n = t + 1;
    LAS unsigned* su = (LAS unsigned*)wl; LAS float* pb = (LAS float*)wl; LAS unsigned short* list = (LAS unsigned short*)(wl + 16384); LAS float* qb = (LAS float*)(wl + 16896);
    const bf16* misc = (const bf16*)(ws + WS_MISC);
    const unsigned long long lt = (1ull << lane) - 1ull;
    int nsel;
    if (n <= 256) { for (int i = lane; i < n; i += 64) list[i] = (unsigned short)i; nsel = n; }
    else {
        { const uint2 v = *(const uint2*)((const bf16*)(ws + WS_IQ) + (size_t)row * 256 + lane * 4); qb[lane * 4] = bflo(v.x); qb[lane * 4 + 1] = bfhi(v.x); qb[lane * 4 + 2] = bflo(v.y); qb[lane * 4 + 3] = bfhi(v.y); }
        float iw[4]; { const uint2 v = *(const uint2*)(misc + (size_t)row * 256 + 192); iw[0] = 0.5f * bflo(v.x); iw[1] = 0.5f * bfhi(v.x); iw[2] = 0.5f * bflo(v.y); iw[3] = 0.5f * bfhi(v.y); }
        WAVE_LDS_SYNC();
        const int nch = (n + 63) >> 6;
        for (int i = 0; i < nch; ++i) {
            const int key = i * 64 + lane; const bool valid = key <= t;
            float kf[64]; load_row64(misc + (size_t)(b * SEQ + (valid ? key : t)) * 256, kf);
            float s = 0.f;
#pragma unroll
            for (int h = 0; h < 4; ++h) s += iw[h] * fmaxf(dot64(qb + h * 64, kf), 0.f);
            su[key] = valid ? f2o(s) : 0u;
        }
        WAVE_LDS_SYNC();
        unsigned prefix = 0u;
        for (int bit = 31; bit >= 0; --bit) {
            const unsigned cand = prefix | (1u << bit); int c = 0;
            for (int i = 0; i < nch; ++i) c += (su[i * 64 + lane] >= cand) ? 1 : 0;
            c = wave_sum_i(c);
            if (c >= 256) prefix = cand;
            if (c == 256) break;
        }
        int cgt = 0;
        for (int i = 0; i < nch; ++i) cgt += (su[i * 64 + lane] > prefix) ? 1 : 0;
        const int need_eq = 256 - wave_sum_i(cgt);
        int base = 0, eq_taken = 0;
        for (int i = 0; i < nch; ++i) {
            const unsigned v = su[i * 64 + lane]; const bool gt = v > prefix, eq = v == prefix;
            const unsigned long long meq = __ballot(eq);
            const bool sel = gt || (eq && (eq_taken + __popcll(meq & lt)) < need_eq);
            const unsigned long long ms = __ballot(sel);
            if (sel) list[base + __popcll(ms & lt)] = (unsigned short)(i * 64 + lane);
            base += __popcll(ms); eq_taken += __popcll(meq);
        }
        nsel = 256;
    }
    { const v4u v = *(const v4u*)((const bf16*)(ws + WS_QA) + (size_t)row * 512 + lane * 8); float f[8]; unpack8(v, f);
#pragma unroll
      for (int e = 0; e < 8; ++e) qb[lane * 8 + e] = f[e]; }
    WAVE_LDS_SYNC();
    const bf16* kva = (const bf16*)(ws + WS_KVA);
    float s[8][4];
#pragma unroll
    for (int j = 0; j < 4; ++j) {
        const int slot = lane + 64 * j; const bool valid = slot < nsel; const int key = list[valid ? slot : 0];
        float kf[64]; load_row64(kva + (size_t)(b * SEQ + key) * 128, kf);
#pragma unroll
        for (int h = 0; h < 8; ++h) s[h][j] = valid ? dot64(qb + h * 64, kf) : NEGF;
    }
    float linv[8];
#pragma unroll
    for (int h = 0; h < 8; ++h) {
        const float m = wave_max(fmaxf(fmaxf(s[h][0], s[h][1]), fmaxf(s[h][2], s[h][3]))); float ls = 0.f;
#pragma unroll
        for (int j = 0; j < 4; ++j) { const float p = __expf(s[h][j] - m); ls += p; pb[h * 256 + lane + 64 * j] = p; }
        linv[h] = 1.0f / wave_sum(ls);
    }
    WAVE_LDS_SYNC();
    float acc[8] = {0.f, 0.f, 0.f, 0.f, 0.f, 0.f, 0.f, 0.f};
    for (int slot = 0; slot < nsel; ++slot) {
        const float v = bf2f(kva[(size_t)(b * SEQ + list[slot]) * 128 + 64 + lane]);
#pragma unroll
        for (int h = 0; h < 8; ++h) acc[h] += pb[h * 256 + slot] * v;
    }
    bf16* ya = (bf16*)(ws + WS_QA) + (size_t)row * 512;
#pragma unroll
    for (int h = 0; h < 8; ++h) ya[h * 64 + lane] = (bf16)f2bf(acc[h] * linv[h]);
    WAVE_LDS_SYNC();
}
__device__ __forceinline__ void nsa_query(const Args& P, unsigned char* ws, int z, int row, int g, LAS unsigned char* wl, int lane) {
    const int b = row >> 12, t = row & (SEQ - 1), bg = b * 2 + g;
    LAS float* pb = (LAS float*)wl; LAS float* qb = (LAS float*)(wl + 8192);
    const bf16* misc = (const bf16*)(ws + WS_MISC);
    bf16* qc = (bf16*)(ws + WS_QC) + (size_t)row * 512 + g * 256;
    { const uint2 v = *(const uint2*)(qc + lane * 4); qb[lane * 4] = bflo(v.x); qb[lane * 4 + 1] = bfhi(v.x); qb[lane * 4 + 2] = bflo(v.y); qb[lane * 4 + 3] = bfhi(v.y); }
    float gate[4][3];
#pragma unroll
    for (int r = 0; r < 4; ++r)
#pragma unroll
        for (int e = 0; e < 3; ++e) gate[r][e] = 1.0f / (1.0f + __expf(-bf2f(misc[(size_t)row * 256 + 196 + (g * 4 + r) * 3 + e])));
    WAVE_LDS_SYNC();
    float o[4] = {0.f, 0.f, 0.f, 0.f};
    const int nv = t >= 31 ? ((t - 15) >> 4) : 0;
    const bf16* kc = (const bf16*)(ws + WS_KC) + (size_t)bg * 256 * 64; const bf16* vc = (const bf16*)(ws + WS_VC) + (size_t)bg * 256 * 64;
    {
        float s[4][4];
#pragma unroll
        for (int j = 0; j < 4; ++j) {
            const int i = lane + 64 * j; const bool valid = i < nv;
            float kf[64]; load_row64(kc + (size_t)(valid ? i : 0) * 64, kf);
#pragma unroll
            for (int r = 0; r < 4; ++r) s[r][j] = valid ? dot64(qb + r * 64, kf) : NEGF;
        }
#pragma unroll
        for (int r = 0; r < 4; ++r) {
            const float m = wave_max(fmaxf(fmaxf(s[r][0], s[r][1]), fmaxf(s[r][2], s[r][3]))); float p[4], ls = 0.f;
#pragma unroll
            for (int j = 0; j < 4; ++j) { p[j] = (lane + 64 * j < nv) ? __expf(s[r][j] - m) : 0.f; ls += p[j]; }
            ls = wave_sum(ls); const float inv = nv > 0 ? 1.0f / ls : 0.f;
#pragma unroll
            for (int j = 0; j < 4; ++j) pb[r * 512 + lane + 64 * j] = p[j] * inv;
        }
        WAVE_LDS_SYNC();
        float a[4] = {0.f, 0.f, 0.f, 0.f};
        for (int i = 0; i < nv; ++i) { const float v = bf2f(vc[(size_t)i * 64 + lane]);
#pragma unroll
            for (int r = 0; r < 4; ++r) a[r] += pb[r * 512 + i] * v; }
#pragma unroll
        for (int r = 0; r < 4; ++r) o[r] += gate[r][0] * a[r];
    }
    unsigned long long selmask = 0ull;
    {
        const int j = lane, cur = t >> 6; float imp = 0.f;
#pragma unroll
        for (int r = 0; r < 4; ++r) { const LAS float* pr = pb + r * 512 + 4 * j; imp += (j > 0 ? 0.5f * pr[-1] : 0.f) + pr[0] + pr[1] + pr[2] + 0.5f * pr[3]; }
        const bool forced = (j == 0) || (j == cur), adm = j <= cur;
        unsigned key = forced ? (0xFFFFFF00u | (unsigned)(63 - j)) : (adm ? ((__float_as_uint(imp) & 0xFFFFFFC0u) | (unsigned)(63 - j)) : 0u);
        for (int k = 0; k < 8; ++k) { const unsigned mx = wave_max_u(key); if (mx == 0u) break; const int win = 63 - (int)(mx & 63u); selmask |= 1ull << win; if (j == win) key = 0u; }
    }
    WAVE_LDS_SYNC();
    {
        const bf16* kvs = (const bf16*)(ws + WS_KVS);
        float s[4][8]; int jb[8]; unsigned long long mm = selmask;
#pragma unroll
        for (int k = 0; k < 8; ++k) {
            const bool have = mm != 0ull; jb[k] = have ? (int)__builtin_ctzll(mm) : 0; mm &= mm - 1ull;
            const int key = jb[k] * 64 + lane; const bool valid = have && key <= t;
            float kf[64]; load_row64(kvs + (size_t)(b * SEQ + (valid ? key : t)) * 256 + g * 64, kf);
#pragma unroll
            for (int r = 0; r < 4; ++r) s[r][k] = valid ? dot64(qb + r * 64, kf) : NEGF;
        }
        float linv[4];
#pragma unroll
        for (int r = 0; r < 4; ++r) {
            float m = s[r][0];
#pragma unroll
            for (int k = 1; k < 8; ++k) m = fmaxf(m, s[r][k]);
            m = wave_max(m); float ls = 0.f;
#pragma unroll
            for (int k = 0; k < 8; ++k) { const float p = __expf(s[r][k] - m); ls += p; pb[r * 512 + k * 64 + lane] = p; }
            linv[r] = 1.0f / wave_sum(ls);
        }
        WAVE_LDS_SYNC();
        float a[4] = {0.f, 0.f, 0.f, 0.f};
        const int nblk = __popcll(selmask);
        for (int k = 0; k < nblk; ++k) {
            int jk = 0;
#pragma unroll
            for (int q = 0; q < 8; ++q) jk = (q == k) ? jb[q] : jk;
            const int kend = (jk * 64 + 63 <= t) ? 64 : (t - jk * 64 + 1);
            for (int kk = 0; kk < kend; ++kk) { const float v = bf2f(kvs[(size_t)(b * SEQ + jk * 64 + kk) * 256 + 128 + g * 64 + lane]);
#pragma unroll
                for (int r = 0; r < 4; ++r) a[r] += pb[r * 512 + k * 64 + kk] * v; }
        }
#pragma unroll
        for (int r = 0; r < 4; ++r) o[r] += gate[r][1] * a[r] * linv[r];
    }
    WAVE_LDS_SYNC();
    {
        const bf16* kvw = (const bf16*)(ws + WS_KVW);
        float s[4][4];
#pragma unroll
        for (int j = 0; j < 4; ++j) {
            const int kp = t - 255 + lane + 64 * j; const bool valid = kp >= 0;
            float kf[64]; load_row64(kvw + (size_t)(b * SEQ + (valid ? kp : 0)) * 256 + g * 64, kf);
#pragma unroll
            for (int r = 0; r < 4; ++r) s[r][j] = valid ? dot64(qb + r * 64, kf) : NEGF;
        }
        float linv[4];
#pragma unroll
        for (int r = 0; r < 4; ++r) {
            const float m = wave_max(fmaxf(fmaxf(s[r][0], s[r][1]), fmaxf(s[r][2], s[r][3]))); float ls = 0.f;
#pragma unroll
            for (int j = 0; j < 4; ++j) { const float p = __expf(s[r][j] - m); ls += p; pb[r * 512 + lane + 64 * j] = p; }
            linv[r] = 1.0f / wave_sum(ls);
        }
        WAVE_LDS_SYNC();
        float a[4] = {0.f, 0.f, 0.f, 0.f};
        const int k0 = t - 255 < 0 ? 255 - t : 0;
        for (int kk = k0; kk < 256; ++kk) { const float v = bf2f(kvw[(size_t)(b * SEQ + t - 255 + kk) * 256 + 128 + g * 64 + lane]);
#pragma unroll
            for (int r = 0; r < 4; ++r) a[r] += pb[r * 512 + kk] * v; }
#pragma unroll
        for (int r = 0; r < 4; ++r) o[r] += gate[r][2] * a[r] * linv[r];
    }
#pragma unroll
    for (int r = 0; r < 4; ++r) qc[r * 64 + lane] = (bf16)f2bf(o[r]);
    WAVE_LDS_SYNC();
}
__device__ __forceinline__ void phase_mixers(const Args& P, unsigned char* ws, int z, LAS unsigned char* lds, int gw, int NGW, int lane, int wave) {
    asm volatile("" : "+v"(lane)); asm volatile("" : "+s"(gw));
    LAS unsigned char* wl = lds + wave * 18944;
    for (int row = gw; row < M; row += NGW) dsa_query(P, ws, z, row, wl, lane);
    for (int it = gw; it < 2 * M; it += NGW) nsa_query(P, ws, z, it >> 1, it & 1, wl, lane);
}
__global__ void __launch_bounds__(NWAVES * 64, 2) fwd_kernel(Args args) {
    extern __shared__ __attribute__((aligned(16))) unsigned char lds_raw[];
    LAS unsigned char* lds = (LAS unsigned char*)lds_raw;
    const int wave = __builtin_amdgcn_readfirstlane((int)threadIdx.x >> 6);
#define tid ((int)threadIdx.x)
#define lane ((int)threadIdx.x & 63)
    const int G = gridDim.x, bid = blockIdx.x;
    const int gw = bid * NWAVES + wave, NGW = G * NWAVES;
    const int lo = args.ph_lo, hi = args.ph_hi;
    const Args& P = args;
    int z = 0; asm volatile("" : "+s"(z));
    unsigned char* ws = args.ws + z;
    volatile LAS unsigned* MISCW = (volatile LAS unsigned*)(lds + LDSCTL_OFF);
    if (tid < 64) MISCW[tid] = 0u;
    __syncthreads();
    XcdBarrier bar; bar.bar = (unsigned*)(ws + WS_CTL) + 4096; bar.x = 0; bar.st = nullptr;
    if (hi - lo > 1) bar = xcd_barrier_post((unsigned*)(ws + WS_CTL) + 4096, MISCW + 8);
#define RUN(k) (lo <= (k) && (k) < hi)
#define SEAM(k) do { if ((k) + 1 < hi) { XcdBarrier b2_ = bar; asm volatile("" : "+s"(b2_.bar)); xcd_barrier(b2_); } else { VM_WAIT(); __syncthreads(); } } while (0)


    if (RUN(0)) { phase_rope(P, ws, z, bid * (NWAVES * 64) + tid, G * NWAVES * 64); SEAM(0); }

    for (int it = 0; it < 2 * DEPTH; ++it) {
        const int l = it >> 1, second = it & 1, pb = 1 + l * NPL + (second ? 9 : 0);
        asm volatile("" : "+s"(z));
        ws = args.ws + z;
        bf16* const XN = (bf16*)(ws + WS_XN);
        bf16* const HB = (bf16*)(ws + WS_H);
        bf16* const MG = (bf16*)(ws + WS_MG);
        bf16* const GB = (bf16*)(ws + WS_G);
        unsigned char* const wb = ws + WS_W;
        float* const OUT = P.out + z;
        const float* xin = (it == 0) ? P.in[0 + z] : (const float*)OUT;
        if (RUN(pb)) {
            if (!second) phase_convert(P, ws, z, l, lds, gw, NGW, lane, wave);
            const float* gain = (second ? P.in[19 + z] : P.in[2 + z]) + l * DM;
            { int ln_ = lane; asm volatile("" : "+v"(ln_)); for (int m = gw; m < M; m += NGW) norm_row_bf16(xin + (size_t)m * DM, gain, XN + (size_t)m * DM, ln_); }
            SEAM(pb);
        }
        if (RUN(pb + 1)) {
            pg8::Gemm g{XN, (const bf16*)(wb + (second ? WO_GU2 : WO_GU1)), M, 2 * FF, DM}; pg8::StaticOrder S; S.init(M, 2 * FF, G, bid + z);
            pg8::EpiSwiglu E{HB, FF};
#if !defined(SITE_MASK) || ((SITE_MASK >> 0) & 1)
            pg8::gemm_phase<pg8::EpiSwiglu, pg8::StaticOrder, true, true>(lds, g, S, E);
#endif
            SEAM(pb + 1);
        }
        if (RUN(pb + 2)) {
            pg8::Gemm g{HB, (const bf16*)(wb + (second ? WO_D2 : WO_D1)), M, DM, FF}; pg8::StaticOrder S; S.init(M, DM, G, bid + z);
            pg8::EpiResid E{xin, OUT, 0.5f};
#if !defined(SITE_MASK) || ((SITE_MASK >> 1) & 1)
            pg8::gemm_phase<pg8::EpiResid, pg8::StaticOrder, true, true>(lds, g, S, E);
#endif
            SEAM(pb + 2);
        }
        if (second) continue;
        const int pm = 1 + l * NPL + 3;
        if (RUN(pm)) {
            const float* gain = P.in[6 + z] + l * DM;
            { int ln_ = lane; asm volatile("" : "+v"(ln_)); for (int m = gw; m < M; m += NGW) norm_row_bf16(OUT + (size_t)m * DM, gain, XN + (size_t)m * DM, ln_); }
            SEAM(pm);
        }
        if (RUN(pm + 1)) {
            pg8::Gemm g{XN, (const bf16*)(wb + WO_IN), M, NINP, DM}; pg8::StaticOrder S; S.init(M, NINP, G, bid + z);
            pg8::EpiWin E{(bf16*)(ws + WS_QA), (bf16*)(ws + WS_QC), (bf16*)(ws + WS_IQ), (bf16*)(ws + WS_MISC), (bf16*)(ws + WS_KVC), (bf16*)(ws + WS_KVS), (bf16*)(ws + WS_KVW), (bf16*)(ws + WS_BU), GB,
                          (const float*)(ws + WS_ROPE)};
#if !defined(SITE_MASK) || ((SITE_MASK >> 2) & 1)
            pg8::gemm_phase<pg8::EpiWin, pg8::StaticOrder, true, true>(lds, g, S, E);
#endif
            SEAM(pm + 1);
        }
        #ifndef NO_PREP
        if (RUN(pm + 2)) { phase_prep(P, ws, z, l, lds, gw, NGW, lane, wave); SEAM(pm + 2); }
#endif
        #ifndef NO_MIX
        if (RUN(pm + 3)) { phase_mixers(P, ws, z, lds, gw, NGW, lane, wave); SEAM(pm + 3); }
#endif
        if (RUN(pm + 4)) {
            pg8::StaticOrder S; S.init(M, DM, G, bid + z);
            { pg8::Gemm g{(const bf16*)(ws + WS_QA), (const bf16*)(wb + WO_PA), M, DM, 512}; pg8::EpiProj<0> E{MG, GB, 0};
#if !defined(SITE_MASK) || ((SITE_MASK >> 3) & 1)
              pg8::gemm_phase<pg8::EpiProj<0>, pg8::StaticOrder, true, true>(lds, g, S, E);
#endif
            }
            { pg8::Gemm g{(const bf16*)(ws + WS_XN), (const bf16*)(wb + WO_PB), M, DM, 512}; pg8::EpiProj<1> E{MG, GB, 1024};
#if !defined(SITE_MASK) || ((SITE_MASK >> 4) & 1)
              pg8::gemm_phase<pg8::EpiProj<1>, pg8::StaticOrder, true, true>(lds, g, S, E);
#endif
            }
            { pg8::Gemm g{(const bf16*)(ws + WS_QC), (const bf16*)(wb + WO_PC), M, DM, 512}; pg8::EpiProj<1> E{MG, GB, 2048};
#if !defined(SITE_MASK) || ((SITE_MASK >> 5) & 1)
              pg8::gemm_phase<pg8::EpiProj<1>, pg8::StaticOrder, true, true>(lds, g, S, E);
#endif
            }
            SEAM(pm + 4);
        }
        if (RUN(pm + 5)) {
            pg8::Gemm g{MG, (const bf16*)(wb + WO_OUT), M, DM, DM}; pg8::StaticOrder S; S.init(M, DM, G, bid + z);
            pg8::EpiResid E{OUT, OUT, 1.0f};
#if !defined(SITE_MASK) || ((SITE_MASK >> 6) & 1)
            pg8::gemm_phase<pg8::EpiResid, pg8::StaticOrder, true, true>(lds, g, S, E);
#endif
            SEAM(pm + 5);
        }
    }
    if (RUN(NPH - 1)) { asm volatile("" : "+s"(z)); int ln_ = lane; asm volatile("" : "+v"(ln_)); float* o_ = P.out + z; for (int m = gw; m < M; m += NGW) norm_row_f32(o_ + (size_t)m * DM, P.in[23 + z], ln_); }
#undef RUN
#undef tid
#undef lane
#undef SEAM
}

extern "C" void kernel_launch(void* const* d_in, const int* in_sizes, int n_in, void* d_out, int out_size, void* d_ws, size_t ws_size, hipStream_t stream) {
    static int grid = 0;
    if (grid == 0) {
        if (n_in != 24 || out_size != M * DM || ws_size < WS_END) { fprintf(stderr, "kernel_launch: unexpected shapes (n_in %d out %d ws %zu)\n", n_in, out_size, ws_size); grid = -1; return; }
        int dev = 0, cus = 0, per_cu = 0;
        if (hipGetDevice(&dev) != hipSuccess || hipDeviceGetAttribute(&cus, hipDeviceAttributeMultiprocessorCount, dev) != hipSuccess) { grid = -1; return; }
        if (hipFuncSetAttribute((const void*)fwd_kernel, hipFuncAttributeMaxDynamicSharedMemorySize, LDS_BYTES) != hipSuccess) { fprintf(stderr, "kernel_launch: hipFuncSetAttribute failed\n"); grid = -1; return; }
        if (hipOccupancyMaxActiveBlocksPerMultiprocessor(&per_cu, (const void*)fwd_kernel, NWAVES * 64, LDS_BYTES) != hipSuccess || per_cu < 1) { fprintf(stderr, "kernel_launch: occupancy query says %d\n", per_cu); }
        (void)hipGetLastError();
        grid = cus;
    }
    if (grid < 0) return;
    (void)hipMemsetAsync((char*)d_ws + WS_CTL, 0, CTL_ZERO_BYTES, stream);
    Args a{};
    for (int i = 0; i < 24; ++i) a.in[i] = (const float*)d_in[i];
    a.out = (float*)d_out; a.ws = (unsigned char*)d_ws;
#if MK_ONE_LAUNCH
    a.ph_lo = 0; a.ph_hi = NPH;
    hipLaunchKernelGGL(fwd_kernel, dim3(grid), dim3(NWAVES * 64), LDS_BYTES, stream, a);
#else
    for (int ph = 0; ph < NPH; ++ph) { a.ph_lo = ph; a.ph_hi = ph + 1; hipLaunchKernelGGL(fwd_kernel, dim3(grid), dim3(NWAVES * 64), LDS_BYTES, stream, a); }
#endif
}
```

```cpp
#include <hip/hip_runtime.h>
#include <cstdio>
#include <cstdint>
#ifndef MK_ONE_LAUNCH
#define MK_ONE_LAUNCH 1
#endif
namespace pg8 {
#define PG8_LAS __attribute__((address_space(3)))
typedef unsigned short bf16_t;
typedef short bf16x8 __attribute__((ext_vector_type(8)));
typedef float f32x4 __attribute__((ext_vector_type(4)));
typedef unsigned u32x4 __attribute__((ext_vector_type(4)));
constexpr int BM = 256, BK = 64, HALF = 128, HTB = HALF * BK * 2  , STAGE_BYTES = 8 * HTB, NXCD = 8, WGM = 8;

__host__ __device__ __forceinline__ int lds_byte(int r, int c) { const int st = (r >> 4) * 2 + (c >> 5), rr = r & 15, cc = c & 31, ob = rr * 64 + cc * 2; return st * 1024 + (ob ^ (((ob >> 9) & 1) << 5)); }
__host__ __device__ __forceinline__ void stage_rc(int b, int& R, int& C) { const int st = b / 1024, sb = b % 1024, swz = sb ^ (((sb >> 9) & 1) << 5); R = (st >> 1) * 16 + swz / 64; C = (st & 1) * 32 + (swz % 64) / 2; }
__host__ __device__ __forceinline__ int perm32(int rho) { const int n = rho >> 4, i = rho & 15; return 8 * (i >> 2) + 4 * n + (i & 3); }

struct Unit { int pm, pn; };
struct Gemm { const bf16_t* A; const bf16_t* Bt; int M, N, K; };

struct StaticOrder {
    int nM, nN, nwg, G, c;
    __host__ __device__ void init(int M, int N, int G_, int c_) { nM = M / BM; nN = N / BM; nwg = nM * nN; G = G_; c = c_; }
    __host__ __device__ bool next(int i, Unit& u) const {
        const long L = (long)i * G + c; if (L >= nwg) return false;
        int wgid = (int)L; { const int q = nwg / NXCD, r = nwg % NXCD, xcd = wgid % NXCD, off = wgid / NXCD; wgid = (xcd < r ? xcd * (q + 1) : r * (q + 1) + (xcd - r) * q) + off; }
        const int nig = WGM * nN, gid = wgid / nig, fm = gid * WGM, gsz = (nM - fm) < WGM ? (nM - fm) : WGM;
        u.pm = fm + ((wgid % nig) % gsz); u.pn = (wgid % nig) / gsz; return true;
    }
    __device__ __forceinline__ void a_ready(const Unit&) const {}
    __device__ __forceinline__ void done(const Unit&) const {}
};

__device__ __forceinline__ unsigned cvt_pk_bf16(float lo, float hi) { unsigned r; asm volatile("v_cvt_pk_bf16_f32 %0, %1, %2" : "=v"(r) : "v"(lo), "v"(hi)); return r; }
__device__ __forceinline__ float bflo(unsigned w) { return __uint_as_float(w << 16); }
__device__ __forceinline__ float bfhi(unsigned w) { return __uint_as_float(w & 0xffff0000u); }
__device__ __forceinline__ float fast_sigmoid(float x) { return __builtin_amdgcn_rcpf(1.0f + __expf(-x)); }

struct EpiSwiglu {
    static constexpr bool PERM = true, AFTER_DRAIN = false;
    bf16_t* H; int ldh;
    __device__ __forceinline__ void operator()(const f32x4 (&acc)[2][2][4][2], const Unit& u, int wr, int wc, int fr, int fq) const {
        const int row0 = u.pm * BM + wr * 64 + fr, col0 = u.pn * HALF + wc * 32 + 8 * fq;
#pragma unroll
        for (int ai = 0; ai < 2; ++ai)
#pragma unroll
            for (int m = 0; m < 4; ++m) {
                bf16_t* rowp = H + (size_t)(row0 + ai * HALF + m * 16) * ldh + col0;
                float o[8];
#pragma unroll
                for (int n = 0; n < 2; ++n)
#pragma unroll
                    for (int e = 0; e < 4; ++e) { const float g = acc[ai][0][m][n][e], up = acc[ai][1][m][n][e]; o[n * 4 + e] = g * fast_sigmoid(g) * up; }
                u32x4 w; w.x = cvt_pk_bf16(o[0], o[1]); w.y = cvt_pk_bf16(o[2], o[3]); w.z = cvt_pk_bf16(o[4], o[5]); w.w = cvt_pk_bf16(o[6], o[7]);
                *(u32x4*)rowp = w;
            }
    }
};
struct EpiResid {
    static constexpr bool PERM = true, AFTER_DRAIN = false;
    const float* base; float* out; float s;
    __device__ __forceinline__ void operator()(const f32x4 (&acc)[2][2][4][2], const Unit& u, int wr, int wc, int fr, int fq) const {
        const int row0 = u.pm * BM + wr * 64 + fr, col0 = u.pn * BM + wc * 32 + 8 * fq;
#pragma unroll
        for (int ai = 0; ai < 2; ++ai)
#pragma unroll
            for (int m = 0; m < 4; ++m) {
                const size_t off = (size_t)(row0 + ai * HALF + m * 16) * 1024 + col0;
#pragma unroll
                for (int bj = 0; bj < 2; ++bj) {
                    const f32x4 b0 = *(const f32x4*)(base + off + bj * HALF), b1 = *(const f32x4*)(base + off + bj * HALF + 4);
                    *(f32x4*)(out + off + bj * HALF) = b0 + acc[ai][bj][m][0] * s; *(f32x4*)(out + off + bj * HALF + 4) = b1 + acc[ai][bj][m][1] * s;
                }
            }
    }
};
template <int MODE> struct EpiProj {
    static constexpr bool PERM = true, AFTER_DRAIN = false;
    bf16_t* MG; const bf16_t* G; int gofs;
    __device__ __forceinline__ void operator()(const f32x4 (&acc)[2][2][4][2], const Unit& u, int wr, int wc, int fr, int fq) const {
        const int row0 = u.pm * BM + wr * 64 + fr, col0 = u.pn * BM + wc * 32 + 8 * fq;
#pragma unroll
        for (int ai = 0; ai < 2; ++ai)
#pragma unroll
            for (int m = 0; m < 4; ++m) {
                const size_t row = (size_t)(row0 + ai * HALF + m * 16);
#pragma unroll
                for (int bj = 0; bj < 2; ++bj) {
                    const u32x4 gv = *(const u32x4*)(G + row * 3072 + gofs + col0 + bj * HALF);
                    bf16_t* mp = MG + row * 1024 + col0 + bj * HALF;
                    const f32x4 a0 = acc[ai][bj][m][0], a1 = acc[ai][bj][m][1];
                    float o[8] = {bflo(gv.x) * a0[0], bfhi(gv.x) * a0[1], bflo(gv.y) * a0[2], bfhi(gv.y) * a0[3], bflo(gv.z) * a1[0], bfhi(gv.z) * a1[1], bflo(gv.w) * a1[2], bfhi(gv.w) * a1[3]};
                    if (MODE) { const u32x4 ov = *(const u32x4*)mp; o[0] += bflo(ov.x); o[1] += bfhi(ov.x); o[2] += bflo(ov.y); o[3] += bfhi(ov.y); o[4] += bflo(ov.z); o[5] += bfhi(ov.z); o[6] += bflo(ov.w); o[7] += bfhi(ov.w); }
                    u32x4 w; w.x = cvt_pk_bf16(o[0], o[1]); w.y = cvt_pk_bf16(o[2], o[3]); w.z = cvt_pk_bf16(o[4], o[5]); w.w = cvt_pk_bf16(o[6], o[7]);
                    *(u32x4*)mp = w;
                }
            }
    }
};
struct EpiWin {
    static constexpr bool PERM = true, AFTER_DRAIN = false;
    bf16_t *QA, *QC, *IQ, *MISC, *KVC, *KVS, *KVW, *BU, *G; const float* rope;
    __device__ __forceinline__ void operator()(const f32x4 (&acc)[2][2][4][2], const Unit& u, int wr, int wc, int fr, int fq) const {
        const int pn = u.pn;
        bf16_t* dst; int ld, cbase, mode;
        if (pn < 2) { dst = QA; ld = 512; cbase = pn * 256; mode = 1; }
        else if (pn < 4) { dst = QC; ld = 512; cbase = (pn - 2) * 256; mode = 1; }
        else if (pn == 4) { dst = IQ; ld = 256; cbase = 0; mode = 1; }
        else if (pn == 5) { dst = MISC; ld = 256; cbase = 0; mode = 3; }
        else if (pn <= 8) { dst = pn == 6 ? KVC : (pn == 7 ? KVS : KVW); ld = 256; cbase = 0; mode = 2; }
        else if (pn <= 10) { dst = BU; ld = 512; cbase = (pn - 9) * 256; mode = 0; }
        else { dst = G; ld = 3072; cbase = (pn - 11) * 256; mode = 4; }
        const int row0 = u.pm * BM + wr * 64 + fr, col0 = cbase + wc * 32 + 8 * fq;
        const bool ropelane = ((wc & 1) == 0) && fq < 2;
        const float sc = (mode == 1) ? 0.125f : 1.0f;
#pragma unroll
        for (int ai = 0; ai < 2; ++ai)
#pragma unroll
            for (int m = 0; m < 4; ++m) {
                const size_t row = (size_t)(row0 + ai * HALF + m * 16);
                f32x4 cs = {1.f, 1.f, 1.f, 1.f}, sn = {0.f, 0.f, 0.f, 0.f};
                if (ropelane && mode >= 1 && mode <= 3) { cs = *(const f32x4*)(rope + row * 16 + 4 * fq); sn = *(const f32x4*)(rope + row * 16 + 8 + 4 * fq); }
#pragma unroll
                for (int bj = 0; bj < 2; ++bj) {
                    const f32x4 a0 = acc[ai][bj][m][0], a1 = acc[ai][bj][m][1];
                    float o[8] = {a0[0], a0[1], a0[2], a0[3], a1[0], a1[1], a1[2], a1[3]};
                    const bool dorope = ropelane && (mode == 1 || (mode == 2 && bj == 0) || (mode == 3 && bj == 0 && wc == 0));
                    if (dorope) {
#pragma unroll
                        for (int p = 0; p < 4; ++p) { const float x1 = o[2 * p], x2 = o[2 * p + 1]; o[2 * p] = x1 * cs[p] - x2 * sn[p]; o[2 * p + 1] = x2 * cs[p] + x1 * sn[p]; }
                    }
                    if (mode == 4) {
#pragma unroll
                        for (int e = 0; e < 8; ++e) o[e] = fast_sigmoid(o[e]);
                    } else {
#pragma unroll
                        for (int e = 0; e < 8; ++e) o[e] *= sc;
                    }
                    u32x4 w; w.x = cvt_pk_bf16(o[0], o[1]); w.y = cvt_pk_bf16(o[2], o[3]); w.z = cvt_pk_bf16(o[4], o[5]); w.w = cvt_pk_bf16(o[6], o[7]);
                    *(u32x4*)(dst + row * ld + col0 + bj * HALF) = w;
                }
            }
    }
};

template <class Epi, class Sched, bool ALIGN_EPI = false, bool SP2 = false>
__device__ __forceinline__ void gemm_phase(PG8_LAS unsigned char* lds, const Gemm g, const Sched& S, const Epi& E) {
    int tid_ = threadIdx.x; asm volatile("" : "+v"(tid_));
    const int tid = tid_, wid = __builtin_amdgcn_readfirstlane(tid >> 6), lane = tid & 63, wr = wid >> 2, wc = wid & 3, fr = lane & 15, fq = lane >> 4;
    const int K = g.K, nt = K / BK;
    unsigned voffA[2], voffB[2];
#pragma unroll
    for (int i = 0; i < 2; ++i) { int R, C; stage_rc(tid * 16 + i * 8192, R, C); const int Rb = Epi::PERM ? ((R & ~31) + perm32(R & 31)) : R;
        voffA[i] = (unsigned)(R * K + C) * 2u; voffB[i] = (unsigned)(Rb * K + C) * 2u; }
    const size_t kstep = (size_t)(BK * 2);
    const size_t hstep = (size_t)HALF * K * 2;
    const size_t tstep = 2 * hstep;
    const unsigned ldsw = (unsigned)wid * 1024u;
    const int aoff = lds_byte(wr * 64 + fr, fq * 8), boff = lds_byte(wc * 32 + fr, fq * 8);
#define PG8_SA(b, h) (((b) * 2 + (h)) * HTB)
#define PG8_SB(b, h) ((4 + (b) * 2 + (h)) * HTB)
#define PG8_STAGE(bufoff, gbase, voff) do { _Pragma("unroll") for (int _i = 0; _i < 2; ++_i) \
        __builtin_amdgcn_global_load_lds((const unsigned*)((const char*)(gbase) + (voff)[_i]), (PG8_LAS unsigned*)(lds + (bufoff) + ldsw + _i * 8192), 16, 0, 0); } while (0)
#define PG8_LDA(dst, b, h) do { _Pragma("unroll") for (int m = 0; m < 4; ++m) _Pragma("unroll") for (int k = 0; k < 2; ++k) dst[m][k] = *(const PG8_LAS bf16x8*)(lds + PG8_SA(b, h) + aoff + m * 2048 + k * 1024); } while (0)
#define PG8_LDB(dst, b, h) do { _Pragma("unroll") for (int n = 0; n < 2; ++n) _Pragma("unroll") for (int k = 0; k < 2; ++k) dst[n][k] = *(const PG8_LAS bf16x8*)(lds + PG8_SB(b, h) + boff + n * 2048 + k * 1024); } while (0)
#define PG8_MMA(ai, bj, At, Bt) do { __builtin_amdgcn_s_setprio(1); _Pragma("unroll") for (int m = 0; m < 4; ++m) _Pragma("unroll") for (int n = 0; n < 2; ++n) _Pragma("unroll") for (int k = 0; k < 2; ++k) \
        acc[ai][bj][m][n] = __builtin_amdgcn_mfma_f32_16x16x32_bf16(Bt[n][k], At[m][k], acc[ai][bj][m][n], 0, 0, 0); __builtin_amdgcn_s_setprio(0); } while (0)
#define PG8_WAIT_V(n) asm volatile("s_waitcnt vmcnt(" #n ")" ::: "memory")
#define PG8_WAIT_L(n) asm volatile("s_waitcnt lgkmcnt(" #n ")" ::: "memory")
#define PG8_BAR __builtin_amdgcn_s_barrier()
#define PG8_SCHED __builtin_amdgcn_sched_barrier(0)
    Unit cur, nxt; int ui = 0;
    if (!S.next(0, cur)) return;
    f32x4 acc[2][2][4][2];
#pragma unroll
    for (int a = 0; a < 2; ++a)
#pragma unroll
        for (int b = 0; b < 2; ++b)
#pragma unroll
            for (int m = 0; m < 4; ++m)
#pragma unroll
                for (int n = 0; n < 2; ++n) acc[a][b][m][n] = (f32x4){0.f, 0.f, 0.f, 0.f};
    bf16x8 At[4][2], B0[2][2], B1[2][2];
    const char* cA = (const char*)g.A + (size_t)cur.pm * tstep; const char* cB = (const char*)g.Bt + (size_t)cur.pn * tstep;
    S.a_ready(cur);
    if constexpr (SP2) {
        PG8_STAGE(PG8_SB(0, 0), cB, voffB); PG8_STAGE(PG8_SB(0, 1), cB + hstep, voffB); PG8_STAGE(PG8_SA(0, 0), cA, voffA); PG8_STAGE(PG8_SA(0, 1), cA + hstep, voffA);
        if (wr == 1) PG8_BAR;
        PG8_WAIT_V(2); PG8_BAR;
        PG8_STAGE(PG8_SB(1, 0), cB + kstep, voffB); PG8_STAGE(PG8_SA(1, 0), cA + kstep, voffA); PG8_STAGE(PG8_SB(1, 1), cB + hstep + kstep, voffB);
        PG8_WAIT_V(6); PG8_BAR;
    } else {
        PG8_STAGE(PG8_SB(0, 0), cB, voffB); PG8_STAGE(PG8_SA(0, 0), cA, voffA); PG8_STAGE(PG8_SB(0, 1), cB + hstep, voffB); PG8_STAGE(PG8_SA(0, 1), cA + hstep, voffA);
        if (wr == 1) PG8_BAR;
        PG8_WAIT_V(4); PG8_BAR;
        PG8_STAGE(PG8_SB(1, 0), cB + kstep, voffB); PG8_STAGE(PG8_SA(1, 0), cA + kstep, voffA); PG8_STAGE(PG8_SB(1, 1), cB + hstep + kstep, voffB);
        PG8_WAIT_V(6); PG8_BAR;
    }
    for (;;) {
        const bool has_next = S.next(ui + 1, nxt);
        const char* nA = has_next ? (const char*)g.A + (size_t)nxt.pm * tstep : cA; const char* nB = has_next ? (const char*)g.Bt + (size_t)nxt.pn * tstep : cB;
        for (int t = 0; t < nt; t += 2) {
            const bool last = (t == nt - 2);
            const char* a1 = cA + (size_t)(t + 1) * kstep;
            const char* a2 = last ? nA : cA + (size_t)(t + 2) * kstep; const char* b2 = last ? nB : cB + (size_t)(t + 2) * kstep;
            const char* a3 = a2 + kstep; const char* b3 = b2 + kstep;
            if (last && has_next) S.a_ready(nxt);
            if constexpr (SP2) {
            PG8_LDB(B0, 0, 0); PG8_LDB(B1, 0, 1); PG8_SCHED; PG8_LDA(At, 0, 0); PG8_STAGE(PG8_SA(1, 1), a1 + hstep, voffA);
            PG8_WAIT_V(8); PG8_WAIT_L(0); PG8_BAR; PG8_MMA(0, 0, At, B0); PG8_MMA(0, 1, At, B1); PG8_BAR; PG8_SCHED;
            PG8_LDA(At, 0, 1); PG8_STAGE(PG8_SB(0, 0), b2, voffB); PG8_STAGE(PG8_SB(0, 1), b2 + hstep, voffB); PG8_STAGE(PG8_SA(0, 0), a2, voffA);
            PG8_WAIT_V(8); PG8_WAIT_L(0); PG8_BAR; PG8_MMA(1, 0, At, B0); PG8_MMA(1, 1, At, B1); PG8_BAR; PG8_SCHED;
            PG8_LDB(B0, 1, 0); PG8_LDB(B1, 1, 1); PG8_SCHED; PG8_LDA(At, 1, 0); PG8_STAGE(PG8_SA(0, 1), a2 + hstep, voffA);
            PG8_WAIT_V(8); PG8_WAIT_L(0); PG8_BAR; PG8_MMA(0, 0, At, B0); PG8_MMA(0, 1, At, B1); PG8_BAR; PG8_SCHED;
            PG8_LDA(At, 1, 1); PG8_STAGE(PG8_SB(1, 0), b3, voffB); PG8_STAGE(PG8_SB(1, 1), b3 + hstep, voffB); PG8_STAGE(PG8_SA(1, 0), a3, voffA);
            PG8_WAIT_V(8); PG8_WAIT_L(0); PG8_BAR; PG8_MMA(1, 0, At, B0); PG8_MMA(1, 1, At, B1); PG8_BAR; PG8_SCHED;
            } else {
            PG8_LDB(B0, 0, 0); PG8_SCHED; PG8_LDA(At, 0, 0); PG8_STAGE(PG8_SA(1, 1), a1 + hstep, voffA);
            PG8_WAIT_L(8); PG8_BAR; PG8_WAIT_L(0); PG8_MMA(0, 0, At, B0); PG8_BAR; PG8_SCHED;
            PG8_LDB(B1, 0, 1); PG8_STAGE(PG8_SB(0, 0), b2, voffB);
            PG8_BAR; PG8_WAIT_L(0); PG8_MMA(0, 1, At, B1); PG8_BAR;
            PG8_LDA(At, 0, 1); PG8_STAGE(PG8_SA(0, 0), a2, voffA);
            PG8_BAR; PG8_WAIT_L(0); PG8_MMA(1, 0, At, B0); PG8_BAR; PG8_SCHED;
            PG8_STAGE(PG8_SB(0, 1), b2 + hstep, voffB);
            PG8_WAIT_V(6); PG8_BAR; PG8_MMA(1, 1, At, B1); PG8_BAR;
            PG8_LDB(B0, 1, 0); PG8_SCHED; PG8_LDA(At, 1, 0); PG8_STAGE(PG8_SA(0, 1), a2 + hstep, voffA);
            PG8_WAIT_L(8); PG8_BAR; PG8_WAIT_L(0); PG8_MMA(0, 0, At, B0); PG8_BAR; PG8_SCHED;
            PG8_LDB(B1, 1, 1); PG8_STAGE(PG8_SB(1, 0), b3, voffB);
            PG8_BAR; PG8_WAIT_L(0); PG8_MMA(0, 1, At, B1); PG8_BAR;
            PG8_LDA(At, 1, 1); PG8_STAGE(PG8_SA(1, 0), a3, voffA);
            PG8_BAR; PG8_WAIT_L(0); PG8_MMA(1, 0, At, B0); PG8_BAR; PG8_SCHED;
            PG8_STAGE(PG8_SB(1, 1), b3 + hstep, voffB);
            PG8_WAIT_V(6); PG8_BAR; PG8_MMA(1, 1, At, B1); PG8_BAR;
            }
        }
        if constexpr (ALIGN_EPI) { if (wr == 0) PG8_BAR; }
        if constexpr (!Epi::AFTER_DRAIN) { E(acc, cur, wr, wc, fr, fq); S.done(cur); }
        if (!has_next) break;
#pragma unroll
        for (int a = 0; a < 2; ++a)
#pragma unroll
            for (int b = 0; b < 2; ++b)
#pragma unroll
                for (int m = 0; m < 4; ++m)
#pragma unroll
                    for (int n = 0; n < 2; ++n) acc[a][b][m][n] = (f32x4){0.f, 0.f, 0.f, 0.f};
        cur = nxt; cA = nA; cB = nB; ++ui;
        if constexpr (ALIGN_EPI) { if (wr == 1) PG8_BAR; }
    }
    PG8_WAIT_V(0);
    if constexpr (!ALIGN_EPI) { if (wr == 0) PG8_BAR; }
    PG8_BAR;
    if constexpr (Epi::AFTER_DRAIN) { E.fused(acc, cur, wr, wc, fr, fq, lds, wid, lane); S.done(cur); }
#undef PG8_SA
#undef PG8_SB
#undef PG8_STAGE
#undef PG8_LDA
#undef PG8_LDB
#undef PG8_MMA
#undef PG8_WAIT_V
#undef PG8_WAIT_L
#undef PG8_BAR
#undef PG8_SCHED
}
}
#define GAS __attribute__((address_space(1)))
#define LAS __attribute__((address_space(3)))
typedef unsigned short bf16;
typedef unsigned v4u __attribute__((ext_vector_type(4)));
typedef float f32x4 __attribute__((ext_vector_type(4)));
typedef short bf16x8 __attribute__((ext_vector_type(8)));
typedef GAS unsigned gu32;
typedef GAS unsigned long long gu64;
#define RLX_AGENT __ATOMIC_RELAXED, __HIP_MEMORY_SCOPE_AGENT
#define LDS_WAIT() asm volatile("s_waitcnt lgkmcnt(0)" ::: "memory")
#define VM_WAIT() asm volatile("s_waitcnt vmcnt(0)" ::: "memory")
__device__ __forceinline__ unsigned long long rt() { return __builtin_amdgcn_s_memrealtime(); }
__device__ __forceinline__ unsigned f2bf(float f) { unsigned u = __builtin_bit_cast(unsigned, f); return (u + 0x7fffu + ((u >> 16) & 1u)) >> 16; }
__device__ __forceinline__ unsigned pk2(float lo, float hi) { return f2bf(lo) | (f2bf(hi) << 16); }
#define XB_TMO      128
#define XB_XCNT(j)  (256  + 64 * (j))
#define XB_XSUB(j)  (1280 + 64 * (j))
#define XB_XGEN(j)  (2304 + 64 * (j))
#define XB_TOP      3328
#define XB_TOPGEN   3392
#define XCD_BAR_WORDS 3456
#define XB_SPIN_CAP (1u << 18)

__device__ __forceinline__ unsigned xb_ld(unsigned* p)              { return __hip_atomic_load(p, __ATOMIC_RELAXED, __HIP_MEMORY_SCOPE_AGENT); }
__device__ __forceinline__ unsigned xb_add(unsigned* p, unsigned v) { return __hip_atomic_fetch_add(p, v, __ATOMIC_RELAXED, __HIP_MEMORY_SCOPE_AGENT); }
__device__ __forceinline__ unsigned xb_xcc_id() { return (unsigned)__builtin_amdgcn_s_getreg((3 << 11) | 20) & 0xFu; }
#define XB_SPIN(cond, bar) do { unsigned _sp = 0; while (cond) { __builtin_amdgcn_s_sleep(1); \
    if ((++_sp & 255u) == 0u) { if (xb_ld(&(bar)[XB_TMO])) break; if (_sp > XB_SPIN_CAP) { atomicAdd(&(bar)[XB_TMO], 1u); break; } } } } while (0)

struct XcdBarrier {
    unsigned* bar; unsigned x;
    volatile LAS unsigned* st;
};

__device__ __forceinline__ XcdBarrier xcd_barrier_post(unsigned* bar, volatile LAS unsigned* st) {
    XcdBarrier b; b.bar = bar; b.x = xb_xcc_id(); b.st = st;
    if (threadIdx.x == 0) (void)xb_add(&bar[XB_XCNT(b.x)], 1u);
    return b;
}
__device__ __forceinline__ void xcd_barrier_complete(unsigned* bar, unsigned x, unsigned& nloc, unsigned& nx) {
    const unsigned G = gridDim.x * gridDim.y * gridDim.z;
    unsigned sum, cnt, mine, sp = 0u;
    for (;;) {
        sum = 0u; cnt = 0u; mine = 0u;
#pragma unroll
        for (unsigned j = 0; j < 16; ++j) { const unsigned c = xb_ld(&bar[XB_XCNT(j)]); sum += c; cnt += (c > 0u) ? 1u : 0u; mine = (j == x) ? c : mine; }
        if (sum == G) break;
        __builtin_amdgcn_s_sleep(1);
        if ((++sp & 255u) == 0u) { if (xb_ld(&bar[XB_TMO])) break; if (sp > XB_SPIN_CAP) { atomicAdd(&bar[XB_TMO], 1u); break; } }
    }
    nloc = mine > 0u ? mine : 1u; nx = cnt > 0u ? cnt : 1u;
}

__device__ __forceinline__ void xcd_barrier(const XcdBarrier& b) {
    asm volatile("s_waitcnt vmcnt(0)" ::: "memory");
    __syncthreads();
    if (threadIdx.x == 0) {
        unsigned* bar = b.bar;
        __builtin_amdgcn_s_waitcnt(0);
        unsigned nloc = b.st[0], nx = b.st[1];
        if (nloc == 0u) { xcd_barrier_complete(bar, b.x, nloc, nx); b.st[0] = nloc; b.st[1] = nx; }
        const unsigned old = xb_add(&bar[XB_XSUB(b.x)], 1u);
        const unsigned gen = old / nloc;
        if (old + 1u == (gen + 1u) * nloc) {
            __builtin_amdgcn_fence(__ATOMIC_RELEASE, "agent");
            asm volatile("s_waitcnt vmcnt(0)" ::: "memory");
            const unsigned og = xb_add(&bar[XB_TOP], 1u);
            const unsigned tg = og / nx;
            if (og + 1u == (tg + 1u) * nx) xb_add(&bar[XB_TOPGEN], 1u);
            else XB_SPIN(xb_ld(&bar[XB_TOPGEN]) == tg, bar);
            __builtin_amdgcn_fence(__ATOMIC_ACQUIRE, "agent");
            xb_add(&bar[XB_XGEN(b.x)], 1u);
            asm volatile("s_waitcnt vmcnt(0)" ::: "memory");
        } else {
            XB_SPIN(xb_ld(&bar[XB_XGEN(b.x)]) == gen, bar);
            __builtin_amdgcn_fence(__ATOMIC_ACQUIRE, "agent");
            asm volatile("s_waitcnt vmcnt(0)" ::: "memory");
        }
    }
    __syncthreads();
}
constexpr int NB = 8, SEQ = 4096, DM = 1024, DEPTH = 4, M = NB * SEQ;
constexpr int FF = 2816, NIN = 5852, NINP = 5888;
constexpr float EPS = 1e-6f, NEGF = -1e30f;
constexpr int NWAVES = 8;
constexpr size_t MiB = 1u << 20;
constexpr size_t WS_CTL = 0, CTL_ZERO_BYTES = 1 * MiB;
constexpr size_t WS_ROPE = 1 * MiB;
constexpr size_t WS_KVA = 3 * MiB;
constexpr size_t WS_KC = 11 * MiB, WS_VC = WS_KC + 512 * 1024;
constexpr size_t WS_W = 12 * MiB;
constexpr size_t WO_GU1 = 0, WO_D1 = 11 * MiB, WO_GU2 = WO_D1 + 5 * MiB + 512 * 1024, WO_D2 = WO_GU2 + 11 * MiB, WO_IN = WO_D2 + 5 * MiB + 512 * 1024,
                 WO_PA = WO_IN + 11 * MiB + 512 * 1024, WO_PB = WO_PA + MiB, WO_PC = WO_PB + MiB, WO_OUT = WO_PC + MiB, WO_END = WO_OUT + 2 * MiB;
static_assert(WO_END <= 52 * MiB, "weights region");
constexpr size_t WS_XN = 64 * MiB;
constexpr size_t WS_R = 128 * MiB;
constexpr size_t WS_G = WS_R, WS_QA = WS_R + 192 * MiB, WS_QC = WS_QA + 32 * MiB, WS_IQ = WS_QC + 32 * MiB, WS_MISC = WS_IQ + 16 * MiB,
                 WS_KVC = WS_MISC + 16 * MiB, WS_KVS = WS_KVC + 16 * MiB, WS_KVW = WS_KVS + 16 * MiB, WS_BU = WS_KVW + 16 * MiB, WS_END = WS_BU + 32 * MiB;
constexpr size_t WS_MG = WS_IQ;
constexpr size_t WS_H = WS_R;
static_assert(WS_END == 496 * MiB, "ws map");
constexpr int RING_BYTES = 131072, LDS_BYTES = 163840, LDSCTL_OFF = 163840 - 256;
constexpr int NPL = 12, NPH = 1 + DEPTH * NPL + 1;

__device__ __forceinline__ float bflo(unsigned w) { return __uint_as_float(w << 16); }
__device__ __forceinline__ float bfhi(unsigned w) { return __uint_as_float(w & 0xffff0000u); }
__device__ __forceinline__ float bf2f(bf16 v) { return __uint_as_float((unsigned)v << 16); }
__device__ __forceinline__ float wave_sum(float v) {
#pragma unroll
    for (int o = 1; o < 64; o <<= 1) v += __shfl_xor(v, o);
    return v;
}
__device__ __forceinline__ float wave_max(float v) {
#pragma unroll
    for (int o = 1; o < 64; o <<= 1) v = fmaxf(v, __shfl_xor(v, o));
    return v;
}
__device__ __forceinline__ int wave_sum_i(int v) {
#pragma unroll
    for (int o = 1; o < 64; o <<= 1) v += __shfl_xor(v, o);
    return v;
}
__device__ __forceinline__ unsigned wave_max_u(unsigned v) {
#pragma unroll
    for (int o = 1; o < 64; o <<= 1) { const unsigned w = (unsigned)__shfl_xor((int)v, o); v = w > v ? w : v; }
    return v;
}
#define WAVE_LDS_SYNC() do { asm volatile("s_waitcnt lgkmcnt(0)" ::: "memory"); __builtin_amdgcn_wave_barrier(); } while (0)
__host__ __device__ __forceinline__ int permd(int d) { return d < 8 ? 2 * d : (d < 16 ? 2 * (d - 8) + 1 : d); }
__device__ __forceinline__ int win_newcol(int n) {
    if (n < 512) return (n & ~63) + permd(n & 63);
    if (n < 640) return 1280 + 64 + (n - 512);
    if (n < 896) { const int m = n - 640; return 1024 + (m & ~63) + permd(m & 63); }
    if (n < 960) return 1280 + permd(n - 896);
    if (n < 964) return 1280 + 192 + (n - 960);
    if (n < 1476) return 2304 + (n - 964);
    if (n < 1988) { const int m = n - 1476; return 512 + (m & ~63) + permd(m & 63); }
    if (n < 2756) { const int m = n - 1988, kv = m >> 8, r = m & 255, base = 1536 + kv * 256; return r < 128 ? base + (r & ~63) + permd(r & 63) : base + r; }
    if (n < 2780) return 1280 + 196 + (n - 2756);
    return 2816 + (n - 2780);
}
__device__ __forceinline__ int map_row(int mode, int n) { return mode == 0 ? n : (mode == 1 ? ((n >> 7) << 8) + (n & 127) : (mode == 2 ? ((n >> 7) << 8) + 128 + (n & 127) : win_newcol(n))); }

struct Args { const float* in[24]; float* out; unsigned char* ws; int ph_lo, ph_hi; };

__device__ __forceinline__ void tr_item(const float* W, int K, int N, bf16* WT, int mode, LAS float* scr, int item, int lane) {
    const int nblk = (N + 31) >> 5, kb = item / nblk, nb = item - kb * nblk, k0 = 64 * kb, n0 = 32 * nb;
    const int nn = n0 + (lane & 31);
#pragma unroll 8
    for (int i = 0; i < 32; ++i) { const int kk = 2 * i + (lane >> 5); scr[kk * 33 + (lane & 31)] = nn < N ? W[(size_t)(k0 + kk) * N + nn] : 0.f; }
    LDS_WAIT(); asm volatile("" ::: "memory");
    const int c = lane & 7;
#pragma unroll
    for (int j = 0; j < 4; ++j) { const int n = (lane >> 3) + 8 * j; const LAS float* s = scr + (8 * c) * 33 + n;
        v4u o; o.x = pk2(s[0 * 33], s[1 * 33]); o.y = pk2(s[2 * 33], s[3 * 33]); o.z = pk2(s[4 * 33], s[5 * 33]); o.w = pk2(s[6 * 33], s[7 * 33]);
        if (n0 + n < N) *(v4u*)(WT + (size_t)map_row(mode, n0 + n) * K + k0 + 8 * c) = o; }
    LDS_WAIT(); asm volatile("" ::: "memory");
}
__device__ __forceinline__ void phase_convert(const Args& P, unsigned char* ws, int z, int l, LAS unsigned char* lds, int gw, int NGW, int lane, int wave) {
    asm volatile("" : "+v"(lane)); asm volatile("" : "+s"(gw));
    LAS float* scr = (LAS float*)(lds + wave * 16384);
    unsigned char* wb = ws + WS_W;
    constexpr int I_F = 16 * 88, I_D = 44 * 32, I_IN = 16 * 183, I_P = 8 * 32, I_O = 16 * 32;
    constexpr int NIT = 4 * I_F + 2 * I_D + I_IN + 3 * I_P + I_O;
    const size_t fo = (size_t)l * DM * FF;
    for (int it = gw; it < NIT; it += NGW) {
        int r = it, K = DM, N = FF, mode = 1; const float* W = P.in[3 + z] + fo; size_t wo = WO_GU1;
        if (r >= I_F) { r -= I_F; mode = 2; W = P.in[4 + z] + fo;
        if (r >= I_F) { r -= I_F; mode = 0; W = P.in[5 + z] + fo; K = FF; N = DM; wo = WO_D1;
        if (r >= I_D) { r -= I_D; mode = 1; W = P.in[20 + z] + fo; K = DM; N = FF; wo = WO_GU2;
        if (r >= I_F) { r -= I_F; mode = 2; W = P.in[21 + z] + fo;
        if (r >= I_F) { r -= I_F; mode = 0; W = P.in[22 + z] + fo; K = FF; N = DM; wo = WO_D2;
        if (r >= I_D) { r -= I_D; mode = 3; W = P.in[7 + z] + (size_t)l * DM * NIN; K = DM; N = NIN; wo = WO_IN;
        if (r >= I_IN) { r -= I_IN; mode = 0; W = P.in[15 + z] + (size_t)l * 512 * DM; K = 512; N = DM; wo = WO_PA;
        if (r >= I_P) { r -= I_P; W = P.in[16 + z] + (size_t)l * 512 * DM; wo = WO_PB;
        if (r >= I_P) { r -= I_P; W = P.in[17 + z] + (size_t)l * 512 * DM; wo = WO_PC;
        if (r >= I_P) { r -= I_P; W = P.in[18 + z] + (size_t)l * DM * DM; K = DM; wo = WO_OUT; } } } } } } } } } }
        tr_item(W, K, N, (bf16*)(wb + wo), mode, scr, r, lane);
    }
    if (gw < 36) { unsigned zz = 0u; asm volatile("" : "+v"(zz)); v4u z = {zz, zz, zz, zz}; v4u* rp = (v4u*)((bf16*)(wb + WO_IN) + (size_t)(1500 + gw) * DM); for (int i = lane; i < DM / 8; i += 64) rp[i] = z; }
}
__device__ __forceinline__ void phase_rope(const Args& P, unsigned char* ws, int z, int gtid, int gthreads) {
    float* rope = (float*)(ws + WS_ROPE);
    for (int idx = gtid; idx < M * 8; idx += gthreads) {
        const int row = idx >> 3, i = idx & 7;
        const double inv = pow(500000.0, -(double)i / 8.0), ang = (double)((const int*)P.in[1 + z])[row] * inv;
        double s, c; sincos(ang, &s, &c);
        rope[row * 16 + i] = (float)c; rope[row * 16 + 8 + i] = (float)s;
    }
}
__device__ __forceinline__ void norm_row_bf16(const float* xrow, const float* gain, bf16* orow, int lane) {
    const f32x4* xr = (const f32x4*)xrow + lane; const f32x4* gr = (const f32x4*)gain + lane;
    f32x4 v[4]; float s = 0.f;
#pragma unroll
    for (int j = 0; j < 4; ++j) { v[j] = xr[64 * j]; s += (v[j].x * v[j].x + v[j].y * v[j].y) + (v[j].z * v[j].z + v[j].w * v[j].w); }
    const float r = 1.0f / sqrtf(wave_sum(s) * (1.f / DM) + EPS);
    unsigned long long* o8 = (unsigned long long*)orow + lane;
#pragma unroll
    for (int j = 0; j < 4; ++j) { const f32x4 g = gr[64 * j]; o8[64 * j] = (unsigned long long)pk2(v[j].x * r * g.x, v[j].y * r * g.y) | ((unsigned long long)pk2(v[j].z * r * g.z, v[j].w * r * g.w) << 32); }
}
__device__ __forceinline__ void norm_row_f32(float* xrow, const float* gain, int lane) {
    f32x4* xr = (f32x4*)xrow + lane; const f32x4* gr = (const f32x4*)gain + lane;
    f32x4 v[4]; float s = 0.f;
#pragma unroll
    for (int j = 0; j < 4; ++j) { v[j] = xr[64 * j]; s += (v[j].x * v[j].x + v[j].y * v[j].y) + (v[j].z * v[j].z + v[j].w * v[j].w); }
    const float r = 1.0f / sqrtf(wave_sum(s) * (1.f / DM) + EPS);
#pragma unroll
    for (int j = 0; j < 4; ++j) { const f32x4 g = gr[64 * j]; xr[64 * j] = v[j] * r * g; }
}
__device__ __forceinline__ void prep_kva_row(const Args& P, unsigned char* ws, int z, int l, int row, LAS float* wl, int lane) {
    const bf16* misc = (const bf16*)(ws + WS_MISC) + (size_t)row * 256;
    const unsigned cw = *(const unsigned*)(misc + 64 + 2 * lane);
    const float c0 = bflo(cw), c1 = bfhi(cw);
    const float r = 1.0f / sqrtf(wave_sum(c0 * c0 + c1 * c1) * (1.f / 128.f) + EPS);
    const float* gn = P.in[8 + z] + l * 128;
    wl[2 * lane] = c0 * r * gn[2 * lane]; wl[2 * lane + 1] = c1 * r * gn[2 * lane + 1];
    WAVE_LDS_SYNC();
    const float* w = P.in[9 + z] + (size_t)l * 128 * 128;
    float a0 = 0.f, a1 = 0.f;
#pragma unroll 8
    for (int k = 0; k < 128; ++k) { const float c = wl[k]; a0 += c * w[k * 128 + lane]; a1 += c * w[k * 128 + 64 + lane]; }
    WAVE_LDS_SYNC();
    wl[lane] = a0;
    WAVE_LDS_SYNC();
    const float* rp = (const float*)(ws + WS_ROPE) + (size_t)row * 16;
    float kr = a0;
    if (lane < 8) kr = a0 * rp[lane] - wl[lane + 8] * rp[8 + lane];
    else if (lane < 16) kr = a0 * rp[lane - 8] + wl[lane - 8] * rp[8 + lane - 8];
    bf16* o = (bf16*)(ws + WS_KVA) + (size_t)row * 128;
    o[permd(lane)] = (bf16)f2bf(kr); o[64 + lane] = (bf16)f2bf(a1);
    WAVE_LDS_SYNC();
}
__device__ __forceinline__ void prep_pool_row(const Args& P, unsigned char* ws, int z, int l, int row, LAS float* wl, int lane) {
    const int t = row & (SEQ - 1), g = lane >> 4, w = 2 << g, lo = (t + 1 - w) > 0 ? (t + 1 - w) : 0, cnt = t + 1 - lo;
    const bf16* bu = (const bf16*)(ws + WS_BU);
    float sum[8] = {0.f, 0.f, 0.f, 0.f, 0.f, 0.f, 0.f, 0.f}, cur[8];
    for (int tt = lo; tt <= t; ++tt) {
        const v4u v = *(const v4u*)(bu + (size_t)(row - t + tt) * 512 + lane * 8);
        cur[0] = bflo(v.x); cur[1] = bfhi(v.x); cur[2] = bflo(v.y); cur[3] = bfhi(v.y); cur[4] = bflo(v.z); cur[5] = bfhi(v.z); cur[6] = bflo(v.w); cur[7] = bfhi(v.w);
#pragma unroll
        for (int e = 0; e < 8; ++e) sum[e] += cur[e];
    }
    const float inv = 1.0f / (float)cnt;
#pragma unroll
    for (int e = 0; e < 8; ++e) wl[lane * 8 + e] = sum[e] * inv - cur[e];
    WAVE_LDS_SYNC();
    const float* pw = P.in[10 + z] + (size_t)l * 4 * 128 * 128; const float* ps = P.in[11 + z] + l * 512;
    bf16* yb = (bf16*)(ws + WS_XN) + (size_t)row * 512;
    for (int gg = 0; gg < 4; ++gg) {
        const float* wg = pw + gg * 128 * 128; float a0 = 0.f, a1 = 0.f;
#pragma unroll 8
        for (int c = 0; c < 128; ++c) { const float x = wl[gg * 128 + c]; a0 += x * wg[c * 128 + lane]; a1 += x * wg[c * 128 + 64 + lane]; }
        yb[gg * 128 + lane] = (bf16)f2bf(a0 * ps[gg * 128 + lane]); yb[gg * 128 + 64 + lane] = (bf16)f2bf(a1 * ps[gg * 128 + 64 + lane]);
    }
    WAVE_LDS_SYNC();
}
__device__ __forceinline__ float gelu_tanh(float x) { const float u = 0.7978845608028654f * (x + 0.044715f * x * x * x); return 0.5f * x * (1.0f + tanhf(u)); }
__device__ __forceinline__ void prep_cmp_item(const Args& P, unsigned char* ws, int z, int l, int item, LAS float* wl, int lane) {
    const int i = item & 255, bg = (item >> 8) & 15, br = item >> 12, b = bg >> 1, g = bg & 1;
    bf16* dst = br ? (bf16*)(ws + WS_VC) + (size_t)bg * 64 * 256 + i : (bf16*)(ws + WS_KC) + ((size_t)bg * 256 + i) * 64;
    const int dstr = br ? 256 : 1;
    if (i == 255) { dst[lane * dstr] = 0; return; }
    const bf16* kvc = (const bf16*)(ws + WS_KVC);
    const float* pos = P.in[12 + z] + (size_t)(l * 2 + br) * 32 * 64;
    const int sd = br ? lane : permd(lane);
    for (int ll = 0; ll < 32; ++ll) wl[ll * 64 + lane] = bf2f(kvc[(size_t)(b * SEQ + 16 * i + ll) * 256 + br * 128 + g * 64 + sd]) + pos[ll * 64 + lane];
    WAVE_LDS_SYNC();
    const float* w1 = P.in[13 + z] + (size_t)(l * 2 + br) * 2048 * 128;
    float a0 = 0.f, a1 = 0.f;
#pragma unroll 8
    for (int k = 0; k < 2048; ++k) { const float x = wl[k]; a0 += x * w1[(size_t)k * 128 + lane]; a1 += x * w1[(size_t)k * 128 + 64 + lane]; }
    wl[2048 + lane] = gelu_tanh(a0); wl[2048 + 64 + lane] = gelu_tanh(a1);
    WAVE_LDS_SYNC();
    const float* w2 = P.in[14 + z] + (size_t)(l * 2 + br) * 128 * 64;
    float o = 0.f;
#pragma unroll 8
    for (int n = 0; n < 128; ++n) o += wl[2048 + n] * w2[n * 64 + lane];
    dst[sd * dstr] = (bf16)f2bf(o);
    WAVE_LDS_SYNC();
}
__device__ __forceinline__ void phase_prep(const Args& P, unsigned char* ws, int z, int l, LAS unsigned char* lds, int gw, int NGW, int lane, int wave) {
    asm volatile("" : "+v"(lane)); asm volatile("" : "+s"(gw));
    LAS float* wl = (LAS float*)(lds + wave * 16384);
    for (int it = gw; it < 2 * 16 * 256; it += NGW) prep_cmp_item(P, ws, z, l, it, wl, lane);
    for (int row = gw; row < M; row += NGW) { prep_kva_row(P, ws, z, l, row, wl, lane); prep_pool_row(P, ws, z, l, row, wl, lane); }
}
__device__ __forceinline__ unsigned f2o(float s) { const unsigned b = __float_as_uint(s); return (b & 0x80000000u) ? ~b : (b | 0x80000000u); }
__device__ __forceinline__ void unpack8(const v4u v, float* f) { f[0] = bflo(v.x); f[1] = bfhi(v.x); f[2] = bflo(v.y); f[3] = bfhi(v.y); f[4] = bflo(v.z); f[5] = bfhi(v.z); f[6] = bflo(v.w); f[7] = bfhi(v.w); }
__device__ __forceinline__ void load_row64(const bf16* p, float* f) {
    const v4u* q = (const v4u*)p;
#pragma unroll
    for (int i = 0; i < 8; ++i) unpack8(q[i], f + 8 * i);
}
__device__ __forceinline__ float dot64(const LAS float* q, const float* k) {
    float d = 0.f;
#pragma unroll
    for (int i = 0; i < 16; ++i) { const f32x4 qq = *(const LAS f32x4*)(q + 4 * i); d += qq.x * k[4 * i] + qq.y * k[4 * i + 1] + qq.z * k[4 * i + 2] + qq.w * k[4 * i + 3]; }
    return d;
}
__device__ __forceinline__ void dsa_query(const Args& P, unsigned char* ws, int z, int row, LAS unsigned char* wl, int lane) {
    const int b = row >> 12, t = row & (SEQ - 1), n = t + 1;
    LAS unsigned* su = (LAS unsigned*)wl; LAS float* pb = (LAS float*)wl; LAS unsigned short* list = (LAS unsigned short*)(wl + 16384); LAS float* qb = (LAS float*)(wl + 16896);
    const bf16* misc = (const bf16*)(ws + WS_MISC);
    const unsigned long long lt = (1ull << lane) - 1ull;
    int nsel;
    if (n <= 256) { for (int i = lane; i < n; i += 64) list[i] = (unsigned short)i; nsel = n; }
    else {
        { const uint2 v = *(const uint2*)((const bf16*)(ws + WS_IQ) + (size_t)row * 256 + lane * 4); qb[lane * 4] = bflo(v.x); qb[lane * 4 + 1] = bfhi(v.x); qb[lane * 4 + 2] = bflo(v.y); qb[lane * 4 + 3] = bfhi(v.y); }
        float iw[4]; { const uint2 v = *(const uint2*)(misc + (size_t)row * 256 + 192); iw[0] = 0.5f * bflo(v.x); iw[1] = 0.5f * bfhi(v.x); iw[2] = 0.5f * bflo(v.y); iw[3] = 0.5f * bfhi(v.y); }
        WAVE_LDS_SYNC();
        const int nch = (n + 63) >> 6;
        for (int i = 0; i < nch; ++i) {
            const int key = i * 64 + lane; const bool valid = key <= t;
            float kf[64]; load_row64(misc + (size_t)(b * SEQ + (valid ? key : t)) * 256, kf);
            float s = 0.f;
#pragma unroll
            for (int h = 0; h < 4; ++h) s += iw[h] * fmaxf(dot64(qb + h * 64, kf), 0.f);
            su[key] = valid ? f2o(s) : 0u;
        }
        WAVE_LDS_SYNC();
        unsigned prefix = 0u;
        for (int bit = 31; bit >= 0; --bit) {
            const unsigned cand = prefix | (1u << bit); int c = 0;
            for (int i = 0; i < nch; ++i) c += (su[i * 64 + lane] >= cand) ? 1 : 0;
            c = wave_sum_i(c);
            if (c >= 256) prefix = cand;
            if (c == 256) break;
        }
        int cgt = 0;
        for (int i = 0; i < nch; ++i) cgt += (su[i * 64 + lane] > prefix) ? 1 : 0;
        const int need_eq = 256 - wave_sum_i(cgt);
        int base = 0, eq_taken = 0;
        for (int i = 0; i < nch; ++i) {
            const unsigned v = su[i * 64 + lane]; const bool gt = v > prefix, eq = v == prefix;
            const unsigned long long meq = __ballot(eq);
            const bool sel = gt || (eq && (eq_taken + __popcll(meq & lt)) < need_eq);
            const unsigned long long ms = __ballot(sel);
            if (sel) list[base + __popcll(ms & lt)] = (unsigned short)(i * 64 + lane);
            base += __popcll(ms); eq_taken += __popcll(meq);
        }
        nsel = 256;
    }
    { const v4u v = *(const v4u*)((const bf16*)(ws + WS_QA) + (size_t)row * 512 + lane * 8); float f[8]; unpack8(v, f);
#pragma unroll
      for (int e = 0; e < 8; ++e) qb[lane * 8 + e] = f[e]; }
    WAVE_LDS_SYNC();
    const bf16* kva = (const bf16*)(ws + WS_KVA);
    float s[8][4];
#pragma unroll
    for (int j = 0; j < 4; ++j) {
        const int slot = lane + 64 * j; const bool valid = slot < nsel; const int key = list[valid ? slot : 0];
        float kf[64]; load_row64(kva + (size_t)(b * SEQ + key) * 128, kf);
#pragma unroll
        for (int h = 0; h < 8; ++h) s[h][j] = valid ? dot64(qb + h * 64, kf) : NEGF;
    }
    float linv[8];
#pragma unroll
    for (int h = 0; h < 8; ++h) {
        const float m = wave_max(fmaxf(fmaxf(s[h][0], s[h][1]), fmaxf(s[h][2], s[h][3]))); float ls = 0.f;
#pragma unroll
        for (int j = 0; j < 4; ++j) { const float p = __expf(s[h][j] - m); ls += p; pb[h * 256 + lane + 64 * j] = p; }
        linv[h] = 1.0f / wave_sum(ls);
    }
    WAVE_LDS_SYNC();
    float acc[8] = {0.f, 0.f, 0.f, 0.f, 0.f, 0.f, 0.f, 0.f};
    for (int slot = 0; slot < nsel; ++slot) {
        const float v = bf2f(kva[(size_t)(b * SEQ + list[slot]) * 128 + 64 + lane]);
#pragma unroll
        for (int h = 0; h < 8; ++h) acc[h] += pb[h * 256 + slot] * v;
    }
    bf16* ya = (bf16*)(ws + WS_QA) + (size_t)row * 512;
#pragma unroll
    for (int h = 0; h < 8; ++h) ya[h * 64 + lane] = (bf16)f2bf(acc[h] * linv[h]);
    WAVE_LDS_SYNC();
}
typedef short s16x4 __attribute__((ext_vector_type(4)));
typedef short v4i16_t __attribute__((ext_vector_type(4)));
typedef float f32x4v __attribute__((ext_vector_type(4)));
constexpr float L2E = 1.4426950408889634f;
constexpr int NSA_KSTR = 72, NSA_VSTR = 80;
constexpr int NSA_KB = 64 * NSA_KSTR * 2, NSA_VB = 64 * NSA_VSTR * 2;
constexpr int NSA_OFF_K = 0, NSA_OFF_V = 2 * NSA_KB, NSA_OFF_IMPA = NSA_OFF_V + 2 * NSA_VB, NSA_OFF_IMPB = NSA_OFF_IMPA + 64 * 65 * 4, NSA_OFF_UM = NSA_OFF_IMPB + 64 * 65 * 4, NSA_LDS = NSA_OFF_UM + 64;
__device__ __forceinline__ s16x4 tr16(const LAS unsigned char* p) { return __builtin_bit_cast(s16x4, __builtin_amdgcn_ds_read_tr16_b64_v4i16((LAS v4i16_t*)p)); }
__device__ __forceinline__ bf16x8 cat4(s16x4 a, s16x4 b) { return __builtin_shufflevector(a, b, 0, 1, 2, 3, 4, 5, 6, 7); }
__device__ __forceinline__ bf16x8 pack8(float a0, float a1, float a2, float a3, float b0, float b1, float b2, float b3) {
    v4u w; w.x = pg8::cvt_pk_bf16(a0, a1); w.y = pg8::cvt_pk_bf16(a2, a3); w.z = pg8::cvt_pk_bf16(b0, b1); w.w = pg8::cvt_pk_bf16(b2, b3); return __builtin_bit_cast(bf16x8, w);
}
__device__ __forceinline__ float xmax16(float v) { v = fmaxf(v, __shfl_xor(v, 16)); return fmaxf(v, __shfl_xor(v, 32)); }
__device__ __forceinline__ float xsum16(float v) { v += __shfl_xor(v, 16); return v + __shfl_xor(v, 32); }

__device__ __forceinline__ void nsa_block(const LAS unsigned char* Kb, const LAS unsigned char* Vb, const bf16x8 (&qf)[2], bool sel, int klo, int khi, float& mrow, float& lrow, f32x4v (&o)[4], int lane) {
    const int j = lane & 15, gq = lane >> 4;
    f32x4v s[4];
#pragma unroll
    for (int kt = 0; kt < 4; ++kt) {
        s[kt] = (f32x4v){0.f, 0.f, 0.f, 0.f};
#pragma unroll
        for (int ks = 0; ks < 2; ++ks) {
            const bf16x8 kf = *(const LAS bf16x8*)(Kb + ((16 * kt + j) * NSA_KSTR + 8 * gq + 32 * ks) * 2);
            s[kt] = __builtin_amdgcn_mfma_f32_16x16x32_bf16(kf, qf[ks], s[kt], 0, 0, 0);
        }
    }
    float bm = NEGF;
#pragma unroll
    for (int kt = 0; kt < 4; ++kt)
#pragma unroll
        for (int e = 0; e < 4; ++e) { const int ko = 16 * kt + 4 * gq + e; const bool ok = sel && ko >= klo && ko <= khi; const float v = ok ? s[kt][e] * L2E : NEGF; s[kt][e] = v; bm = fmaxf(bm, v); }
    bm = xmax16(bm);
    const float mnew = fmaxf(mrow, bm), alpha = __builtin_amdgcn_exp2f(mrow - mnew);
    mrow = mnew;
    float ps = 0.f;
#pragma unroll
    for (int kt = 0; kt < 4; ++kt)
#pragma unroll
        for (int e = 0; e < 4; ++e) { const float p = __builtin_amdgcn_exp2f(s[kt][e] - mnew); s[kt][e] = p; ps += p; }
    lrow = lrow * alpha + ps;
#pragma unroll
    for (int dt = 0; dt < 4; ++dt) o[dt] *= alpha;
#pragma unroll
    for (int kk = 0; kk < 2; ++kk) {
        const bf16x8 pf = pack8(s[2 * kk][0], s[2 * kk][1], s[2 * kk][2], s[2 * kk][3], s[2 * kk + 1][0], s[2 * kk + 1][1], s[2 * kk + 1][2], s[2 * kk + 1][3]);
#pragma unroll
        for (int dt = 0; dt < 4; ++dt) {
            const LAS unsigned char* va = Vb + ((32 * kk + 4 * gq + (j >> 2)) * NSA_VSTR + 16 * dt + 4 * (j & 3)) * 2;
            const bf16x8 vf = cat4(tr16(va), tr16(va + 16 * NSA_VSTR * 2));
            o[dt] = __builtin_amdgcn_mfma_f32_16x16x32_bf16(vf, pf, o[dt], 0, 0, 0);
        }
    }
}
__device__ __forceinline__ void nsa_fetch(const bf16* kv, int b, int jb, int g, int tid, v4u& kr, v4u& vr) {
    const bf16* p = kv + (size_t)(b * SEQ + 64 * jb + (tid >> 3)) * 256 + g * 64 + (tid & 7) * 8;
    kr = *(const v4u*)p; vr = *(const v4u*)(p + 128);
}
__device__ __forceinline__ void nsa_stash(LAS unsigned char* Kb, LAS unsigned char* Vb, int tid, const v4u& kr, const v4u& vr) {
    *(LAS v4u*)(Kb + ((tid >> 3) * NSA_KSTR + (tid & 7) * 8) * 2) = kr; *(LAS v4u*)(Vb + ((tid >> 3) * NSA_VSTR + (tid & 7) * 8) * 2) = vr;
}
__device__ __forceinline__ void nsa_unit(unsigned char* ws, int unit, LAS unsigned char* lds, int tid_in) {
    int tid = tid_in; asm volatile("" : "+v"(tid));
    const int lane = tid & 63, wave = __builtin_amdgcn_readfirstlane(tid >> 6), j = lane & 15, gq = lane >> 4;
    const int c = unit & 63, g = (unit >> 6) & 1, b = unit >> 7, bg = b * 2 + g;
    LAS float* impa = (LAS float*)(lds + NSA_OFF_IMPA); LAS float* impb = (LAS float*)(lds + NSA_OFF_IMPB);
    LAS unsigned long long* um = (LAS unsigned long long*)(lds + NSA_OFF_UM);
    for (int i = tid; i < 2 * 64 * 65; i += 512) impa[i] = 0.f;
    bf16* qc = (bf16*)(ws + WS_QC);
    const bf16* misc = (const bf16*)(ws + WS_MISC);
    bf16x8 qf[2][2]; float gate[2][3]; int trow[2];
#pragma unroll
    for (int rg = 0; rg < 2; ++rg) {
        const int q = 8 * wave + 4 * rg + (j >> 2), t = 64 * c + q, row = b * SEQ + t, head = g * 4 + (j & 3);
        trow[rg] = t;
#pragma unroll
        for (int ks = 0; ks < 2; ++ks) qf[rg][ks] = *(const bf16x8*)(qc + (size_t)row * 512 + head * 64 + 8 * gq + 32 * ks);
#pragma unroll
        for (int e = 0; e < 3; ++e) gate[rg][e] = 1.0f / (1.0f + __expf(-bf2f(misc[(size_t)row * 256 + 196 + head * 3 + e])));
    }
    f32x4v otot[2][4];
    __syncthreads();
    const int nT = (c >> 2) + 1;
    const bf16* kc = (const bf16*)(ws + WS_KC) + (size_t)bg * 256 * 64; const bf16* vct = (const bf16*)(ws + WS_VC) + (size_t)bg * 64 * 256;
#pragma unroll
    for (int rg = 0; rg < 2; ++rg) {
        const int t = trow[rg], nv = t >= 31 ? ((t - 15) >> 4) : 0;
        f32x4v s[16]; float mx = NEGF;
#pragma unroll
        for (int T = 0; T < 16; ++T) {
            s[T] = (f32x4v){0.f, 0.f, 0.f, 0.f};
            if (T < nT) {
#pragma unroll
                for (int ks = 0; ks < 2; ++ks) { const bf16x8 kf = *(const bf16x8*)(kc + (size_t)(16 * T + j) * 64 + 8 * gq + 32 * ks); s[T] = __builtin_amdgcn_mfma_f32_16x16x32_bf16(kf, qf[rg][ks], s[T], 0, 0, 0); }
#pragma unroll
                for (int e = 0; e < 4; ++e) { const float v = (16 * T + 4 * gq + e < nv) ? s[T][e] * L2E : NEGF; s[T][e] = v; mx = fmaxf(mx, v); }
            }
        }
        mx = xmax16(mx);
        float ls = 0.f;
#pragma unroll
        for (int T = 0; T < 16; ++T) if (T < nT) {
#pragma unroll
            for (int e = 0; e < 4; ++e) { const float p = (16 * T + 4 * gq + e < nv) ? __builtin_amdgcn_exp2f(s[T][e] - mx) : 0.f; s[T][e] = p; ls += p; }
        }
        ls = xsum16(ls);
        const float inv = nv > 0 ? 1.0f / ls : 0.f;
        const int q = 8 * wave + 4 * rg + (j >> 2);
#pragma unroll
        for (int T = 0; T < 16; ++T) if (T < nT) {
#pragma unroll
            for (int e = 0; e < 4; ++e) s[T][e] *= inv;
            float a = s[T][0] + s[T][1] + s[T][2] + 0.5f * s[T][3], bb = 0.5f * s[T][3];
            a += __shfl_xor(a, 1); a += __shfl_xor(a, 2); bb += __shfl_xor(bb, 1); bb += __shfl_xor(bb, 2);
            if ((j & 3) == 0) { impa[q * 65 + 4 * T + gq] = a; impb[q * 65 + 4 * T + gq + 1] = bb; }
        }
        f32x4v oc[4];
#pragma unroll
        for (int dt = 0; dt < 4; ++dt) oc[dt] = (f32x4v){0.f, 0.f, 0.f, 0.f};
#pragma unroll
        for (int kk = 0; kk < 8; ++kk) if (2 * kk < nT) {
            const bf16x8 pf = pack8(s[2 * kk][0], s[2 * kk][1], s[2 * kk][2], s[2 * kk][3], s[2 * kk + 1][0], s[2 * kk + 1][1], s[2 * kk + 1][2], s[2 * kk + 1][3]);
#pragma unroll
            for (int dt = 0; dt < 4; ++dt) {
                const bf16* vp = vct + (size_t)(16 * dt + j) * 256 + 32 * kk + 4 * gq;
                const s16x4 v0 = *(const s16x4*)vp, v1 = *(const s16x4*)(vp + 16);
                oc[dt] = __builtin_amdgcn_mfma_f32_16x16x32_bf16(cat4(v0, v1), pf, oc[dt], 0, 0, 0);
            }
        }
#pragma unroll
        for (int dt = 0; dt < 4; ++dt) otot[rg][dt] = oc[dt] * gate[rg][0];
    }
    __syncthreads();
    unsigned long long smask[8], mymask = 0ull;
#pragma unroll
    for (int qi = 0; qi < 8; ++qi) {
        const int q = 8 * wave + qi; const float imp = impa[q * 65 + lane] + impb[q * 65 + lane];
        const bool forced = (lane == 0) || (lane == c), adm = lane <= c;
        unsigned key = forced ? (0xFFFFFF00u | (unsigned)(63 - lane)) : (adm ? ((__float_as_uint(imp) & 0xFFFFFFC0u) | (unsigned)(63 - lane)) : 0u);
        unsigned long long mk = 0ull;
        for (int k = 0; k < 8; ++k) { const unsigned mx = wave_max_u(key); if (mx == 0u) break; const int win = 63 - (int)(mx & 63u); mk |= 1ull << win; if (lane == win) key = 0u; }
        mk = ((unsigned long long)__builtin_amdgcn_readfirstlane((unsigned)(mk >> 32)) << 32) | (unsigned long long)__builtin_amdgcn_readfirstlane((unsigned)mk);
        smask[qi] = mk; mymask |= mk;
    }
    if (lane == 0) um[wave] = mymask;
    __syncthreads();
    unsigned long long umask = 0ull;
#pragma unroll
    for (int w = 0; w < 8; ++w) umask |= um[w];
    umask = ((unsigned long long)__builtin_amdgcn_readfirstlane((unsigned)(umask >> 32)) << 32) | (unsigned long long)__builtin_amdgcn_readfirstlane((unsigned)umask);
    unsigned long long rmask[2];
#pragma unroll
    for (int rg = 0; rg < 2; ++rg) { const int qi = j >> 2; rmask[rg] = qi == 0 ? smask[4 * rg] : (qi == 1 ? smask[4 * rg + 1] : (qi == 2 ? smask[4 * rg + 2] : smask[4 * rg + 3])); }
    const unsigned long long gmask[2] = {smask[0] | smask[1] | smask[2] | smask[3], smask[4] | smask[5] | smask[6] | smask[7]};
    const bf16* kvs = (const bf16*)(ws + WS_KVS); const bf16* kvw = (const bf16*)(ws + WS_KVW);
    LAS unsigned char* Kb = lds + NSA_OFF_K; LAS unsigned char* Vb = lds + NSA_OFF_V;
    {
        float mrow[2] = {NEGF, NEGF}, lrow[2] = {0.f, 0.f}; f32x4v o[2][4];
#pragma unroll
        for (int rg = 0; rg < 2; ++rg)
#pragma unroll
            for (int dt = 0; dt < 4; ++dt) o[rg][dt] = (f32x4v){0.f, 0.f, 0.f, 0.f};
        unsigned long long rem = umask; int buf = 0;
        v4u kr, vr; int jb = (int)__builtin_ctzll(rem); rem &= rem - 1ull;
        nsa_fetch(kvs, b, jb, g, tid, kr, vr); nsa_stash(Kb, Vb, tid, kr, vr);
        __syncthreads();
        for (;;) {
            const bool more = rem != 0ull; const int jn = more ? (int)__builtin_ctzll(rem) : jb; rem &= rem - 1ull;
            if (more) nsa_fetch(kvs, b, jn, g, tid, kr, vr);
#pragma unroll
            for (int rg = 0; rg < 2; ++rg) if ((gmask[rg] >> jb) & 1ull) {
                const bool sel = (rmask[rg] >> jb) & 1ull; const int khi = (jb == c) ? (trow[rg] & 63) : 63;
                nsa_block(Kb + buf * NSA_KB, Vb + buf * NSA_VB, qf[rg], sel, 0, khi, mrow[rg], lrow[rg], o[rg], lane);
            }
            if (!more) break;
            nsa_stash(Kb + (buf ^ 1) * NSA_KB, Vb + (buf ^ 1) * NSA_VB, tid, kr, vr);
            __syncthreads();
            buf ^= 1; jb = jn;
        }
#pragma unroll
        for (int rg = 0; rg < 2; ++rg) { const float sc = gate[rg][1] / xsum16(lrow[rg]);
#pragma unroll
            for (int dt = 0; dt < 4; ++dt) otot[rg][dt] += o[rg][dt] * sc; }
        __syncthreads();
    }
    {
        float mrow[2] = {NEGF, NEGF}, lrow[2] = {0.f, 0.f}; f32x4v o[2][4];
#pragma unroll
        for (int rg = 0; rg < 2; ++rg)
#pragma unroll
            for (int dt = 0; dt < 4; ++dt) o[rg][dt] = (f32x4v){0.f, 0.f, 0.f, 0.f};
        int jb = c - 4 > 0 ? c - 4 : 0, buf = 0; v4u kr, vr;
        nsa_fetch(kvw, b, jb, g, tid, kr, vr); nsa_stash(Kb, Vb, tid, kr, vr);
        __syncthreads();
        for (;;) {
            const bool more = jb < c;
            if (more) nsa_fetch(kvw, b, jb + 1, g, tid, kr, vr);
#pragma unroll
            for (int rg = 0; rg < 2; ++rg) {
                const int o6 = trow[rg] & 63;
                const int klo = (jb == c - 4) ? o6 + 1 : 0, khi = (jb == c) ? o6 : 63;
                nsa_block(Kb + buf * NSA_KB, Vb + buf * NSA_VB, qf[rg], true, klo, khi, mrow[rg], lrow[rg], o[rg], lane);
            }
            if (!more) break;
            nsa_stash(Kb + (buf ^ 1) * NSA_KB, Vb + (buf ^ 1) * NSA_VB, tid, kr, vr);
            __syncthreads();
            buf ^= 1; ++jb;
        }
#pragma unroll
        for (int rg = 0; rg < 2; ++rg) { const float sc = gate[rg][2] / xsum16(lrow[rg]);
#pragma unroll
            for (int dt = 0; dt < 4; ++dt) otot[rg][dt] += o[rg][dt] * sc; }
    }
#pragma unroll
    for (int rg = 0; rg < 2; ++rg) {
        const int row = b * SEQ + trow[rg], head = g * 4 + (j & 3);
#pragma unroll
        for (int dt = 0; dt < 4; ++dt) {
            uint2 w; w.x = pg8::cvt_pk_bf16(otot[rg][dt][0], otot[rg][dt][1]); w.y = pg8::cvt_pk_bf16(otot[rg][dt][2], otot[rg][dt][3]);
            *(uint2*)(qc + (size_t)row * 512 + head * 64 + 16 * dt + 4 * gq) = w;
        }
    }
    __syncthreads();
}
constexpr int DSA_OFF_CNT = 0, DSA_OFF_PC = 1024, DSA_OFF_LIST = DSA_OFF_PC + 32 * 16 * 4, DSA_OFF_V = DSA_OFF_LIST + 16 * 256 * 2, DSA_VB = 64 * NSA_VSTR * 2, DSA_LDS = DSA_OFF_V + 8 * DSA_VB;
#define DSA_FOR_TILES(...) _Pragma("unroll") for (int G8 = 0; G8 < 4; ++G8) { if (G8 < ngrp) { _Pragma("unroll") for (int T8 = 0; T8 < 8; ++T8) { const int T = G8 * 8 + T8; __VA_ARGS__ } } }
__device__ __forceinline__ void cnt_ge(int& c, unsigned u, unsigned cand) { asm volatile("v_cmp_ge_u32_e32 vcc, %1, %2\n\tv_addc_co_u32_e32 %0, vcc, 0, %0, vcc" : "+v"(c) : "v"(u), "v"(cand) : "vcc"); }
__device__ __forceinline__ void cnt_gt(int& c, unsigned u, unsigned cand) { asm volatile("v_cmp_gt_u32_e32 vcc, %1, %2\n\tv_addc_co_u32_e32 %0, vcc, 0, %0, vcc" : "+v"(c) : "v"(u), "v"(cand) : "vcc"); }
__device__ __forceinline__ void cnt_le(int& c, unsigned u, unsigned cand) { asm volatile("v_cmp_le_u32_e32 vcc, %1, %2\n\tv_addc_co_u32_e32 %0, vcc, 0, %0, vcc" : "+v"(c) : "v"(u), "v"(cand) : "vcc"); }
__device__ __forceinline__ int dsa_total(LAS unsigned* cnt, int par, int wave, int j, int gq, int c) {
    c += __shfl_xor(c, 16); c += __shfl_xor(c, 32);
    if (gq == 0) cnt[(par * 8 + wave) * 16 + j] = (unsigned)c;
    __syncthreads();
    int tot = 0;
#pragma unroll
    for (int w = 0; w < 8; ++w) tot += (int)cnt[(par * 8 + w) * 16 + j];
    return tot;
}
__device__ __forceinline__ void dsa_unit(unsigned char* ws, int unit, LAS unsigned char* lds, int tid_in) {
    int tid = tid_in; asm volatile("" : "+v"(tid));
    const int lane = tid & 63, wave = __builtin_amdgcn_readfirstlane(tid >> 6), j = lane & 15, gq = lane >> 4;
    const int b = unit >> 8, q0 = (unit & 255) * 16, t = q0 + j, row = b * SEQ + t;
    LAS unsigned* cnt = (LAS unsigned*)(lds + DSA_OFF_CNT); LAS unsigned* pc = (LAS unsigned*)(lds + DSA_OFF_PC);
    LAS unsigned short* list = (LAS unsigned short*)(lds + DSA_OFF_LIST);
    const bf16* misc = (const bf16*)(ws + WS_MISC);
    if (q0 >= 256) {
        const int ntiles = (q0 >> 4) + 1;
        const int ntl = wave < ntiles ? ((ntiles - 1 - wave) >> 3) + 1 : 0;
        const int ngrp = (ntl + 7) >> 3;
        bf16x8 qf[4][2]; float iw[4];
        { const bf16* iq = (const bf16*)(ws + WS_IQ) + (size_t)row * 256;
#pragma unroll
          for (int h = 0; h < 4; ++h) { iw[h] = 0.5f * bf2f(misc[(size_t)row * 256 + 192 + h]);
#pragma unroll
              for (int ks = 0; ks < 2; ++ks) qf[h][ks] = *(const bf16x8*)(iq + h * 64 + 8 * gq + 32 * ks); } }
        unsigned u[32][4];
#pragma unroll
        for (int T = 0; T < 32; ++T)
#pragma unroll
            for (int e = 0; e < 4; ++e) u[T][e] = 0u;
        const int kb0 = 16 * wave + 4 * gq;
        DSA_FOR_TILES(
            const bf16* kp = misc + (size_t)(b * SEQ + 16 * wave + 128 * T + j) * 256 + 8 * gq;
            const bf16x8 kf0 = *(const bf16x8*)kp; const bf16x8 kf1 = *(const bf16x8*)(kp + 32);
            float sc[4] = {0.f, 0.f, 0.f, 0.f};
            _Pragma("unroll") for (int h = 0; h < 4; ++h) {
                f32x4v a = {0.f, 0.f, 0.f, 0.f};
                a = __builtin_amdgcn_mfma_f32_16x16x32_bf16(kf0, qf[h][0], a, 0, 0, 0);
                a = __builtin_amdgcn_mfma_f32_16x16x32_bf16(kf1, qf[h][1], a, 0, 0, 0);
                _Pragma("unroll") for (int e = 0; e < 4; ++e) sc[e] += iw[h] * fmaxf(a[e], 0.f);
                asm volatile("" : "+v"(sc[0]), "+v"(sc[1]), "+v"(sc[2]), "+v"(sc[3]));
            }
            _Pragma("unroll") for (int e = 0; e < 4; ++e) { unsigned x = f2o(sc[e]); asm volatile("" : "+v"(x)); u[T][e] = (kb0 + 128 * T + e <= t) ? x : 0u; }
            if ((T8 & 1) == 1) __builtin_amdgcn_sched_barrier(0);
        )
        unsigned prefix = 0u; bool exact = false; int par = 0;
#pragma unroll 1
        for (int bit = 31; bit >= 0; --bit) {
            const unsigned cand = prefix | (1u << bit); int c0 = 0, c1 = 0;
            DSA_FOR_TILES(cnt_ge(c0, u[T][0], cand); cnt_ge(c1, u[T][1], cand); cnt_ge(c0, u[T][2], cand); cnt_ge(c1, u[T][3], cand);)
            const int tot = dsa_total(cnt, par, wave, j, gq, c0 + c1); par ^= 1;
            if (!exact && tot >= 256) { prefix = cand; exact = (tot == 256); }
            if (__all(exact)) break;
        }
        const bool alle = __all(exact);
        DSA_FOR_TILES(_Pragma("unroll") for (int e = 0; e < 4; ++e) { const unsigned x = u[T][e]; u[T][e] = (x > prefix || (exact && x == prefix)) ? 0u : (x == prefix ? (unsigned)(1 + kb0 + 128 * T + e) : 0xFFFFFFFFu); })
        unsigned kp = 0u;
        if (!alle) {
#pragma unroll 1
            for (int bit = 11; bit >= 0; --bit) {
                const unsigned cand = kp | (1u << bit); int c0 = 0, c1 = 0;
                DSA_FOR_TILES(cnt_le(c0, u[T][0], cand); cnt_le(c1, u[T][1], cand); cnt_le(c0, u[T][2], cand); cnt_le(c1, u[T][3], cand);)
                const int tot = dsa_total(cnt, par, wave, j, gq, c0 + c1); par ^= 1;
                if (tot <= 255) kp = cand;
            }
        }
        const unsigned kp1 = kp + 1u;
        int ns0 = 0, ns1 = 0;
        DSA_FOR_TILES(cnt_le(ns0, u[T][0], kp1); cnt_le(ns1, u[T][1], kp1); cnt_le(ns0, u[T][2], kp1); cnt_le(ns1, u[T][3], kp1);)
        pc[(wave * 4 + gq) * 16 + j] = (unsigned)(ns0 + ns1);
        __syncthreads();
        int base = 0;
        for (int i = 0; i < wave * 4 + gq; ++i) base += (int)pc[i * 16 + j];
        DSA_FOR_TILES(_Pragma("unroll") for (int e = 0; e < 4; ++e) { if (u[T][e] <= kp1) { if (base < 256) list[j * 256 + base] = (unsigned short)(kb0 + 128 * T + e); ++base; } })
    } else {
        for (int i = tid; i < 16 * 256; i += 512) list[i] = (unsigned short)(i & 255);
    }
    __syncthreads();
    const bf16* kva = (const bf16*)(ws + WS_KVA);
    bf16* qa = (bf16*)(ws + WS_QA);
    LAS unsigned char* Vb = lds + DSA_OFF_V + wave * DSA_VB;
#pragma unroll 1
    for (int qq = 0; qq < 2; ++qq) {
        const int ql = 2 * wave + qq, tq = q0 + ql, rowq = b * SEQ + tq, nsel = tq + 1 < 256 ? tq + 1 : 256;
        bf16x8 qf[2];
#pragma unroll
        for (int ks = 0; ks < 2; ++ks) { qf[ks] = (bf16x8){0, 0, 0, 0, 0, 0, 0, 0}; if (j < 8) qf[ks] = *(const bf16x8*)(qa + (size_t)rowq * 512 + j * 64 + 8 * gq + 32 * ks); }
        f32x4v s[16]; float mx = NEGF;
#pragma unroll
        for (int kt = 0; kt < 16; ++kt) {
            const int slot = 16 * kt + j; const int key = list[ql * 256 + (slot < nsel ? slot : 0)];
            const bf16* kp2 = kva + (size_t)(b * SEQ + key) * 128 + 8 * gq;
            const bf16x8 kf0 = *(const bf16x8*)kp2, kf1 = *(const bf16x8*)(kp2 + 32);
            f32x4v a = {0.f, 0.f, 0.f, 0.f};
            a = __builtin_amdgcn_mfma_f32_16x16x32_bf16(kf0, qf[0], a, 0, 0, 0);
            a = __builtin_amdgcn_mfma_f32_16x16x32_bf16(kf1, qf[1], a, 0, 0, 0);
#pragma unroll
            for (int e = 0; e < 4; ++e) { const float v = (16 * kt + 4 * gq + e < nsel) ? a[e] * L2E : NEGF; a[e] = v; mx = fmaxf(mx, v); }
            s[kt] = a;
        }
        mx = xmax16(mx);
        float ls = 0.f;
#pragma unroll
        for (int kt = 0; kt < 16; ++kt)
#pragma unroll
            for (int e = 0; e < 4; ++e) { const float p = __builtin_amdgcn_exp2f(s[kt][e] - mx); s[kt][e] = p; ls += p; }
        ls = xsum16(ls);
        f32x4v o[4];
#pragma unroll
        for (int dt = 0; dt < 4; ++dt) o[dt] = (f32x4v){0.f, 0.f, 0.f, 0.f};
#pragma unroll
        for (int ch = 0; ch < 4; ++ch) {
            v4u vr[8];
#pragma unroll
            for (int i = 0; i < 8; ++i) { const int slot = 64 * ch + 8 * i + (lane >> 3); const int key = list[ql * 256 + (slot < nsel ? slot : 0)];
                vr[i] = *(const v4u*)(kva + (size_t)(b * SEQ + key) * 128 + 64 + (lane & 7) * 8); }
#pragma unroll
            for (int i = 0; i < 8; ++i) *(LAS v4u*)(Vb + ((8 * i + (lane >> 3)) * NSA_VSTR + (lane & 7) * 8) * 2) = vr[i];
            WAVE_LDS_SYNC();
#pragma unroll
            for (int kk = 0; kk < 2; ++kk) {
                const int k4 = 4 * ch + 2 * kk;
                const bf16x8 pf = pack8(s[k4][0], s[k4][1], s[k4][2], s[k4][3], s[k4 + 1][0], s[k4 + 1][1], s[k4 + 1][2], s[k4 + 1][3]);
#pragma unroll
                for (int dt = 0; dt < 4; ++dt) {
                    const LAS unsigned char* va = Vb + ((32 * kk + 4 * gq + (j >> 2)) * NSA_VSTR + 16 * dt + 4 * (j & 3)) * 2;
                    o[dt] = __builtin_amdgcn_mfma_f32_16x16x32_bf16(cat4(tr16(va), tr16(va + 16 * NSA_VSTR * 2)), pf, o[dt], 0, 0, 0);
                }
            }
            WAVE_LDS_SYNC();
        }
        const float inv = 1.0f / ls;
        if (j < 8) {
#pragma unroll
            for (int dt = 0; dt < 4; ++dt) { uint2 w; w.x = pg8::cvt_pk_bf16(o[dt][0] * inv, o[dt][1] * inv); w.y = pg8::cvt_pk_bf16(o[dt][2] * inv, o[dt][3] * inv);
                *(uint2*)(qa + (size_t)rowq * 512 + j * 64 + 16 * dt + 4 * gq) = w; }
        }
    }
    __syncthreads();
}
__device__ __forceinline__ void phase_mixers(const Args& P, unsigned char* ws, int z, LAS unsigned char* lds, int gw, int NGW, int lane, int wave, int bid, int G) {
    asm volatile("" : "+v"(lane)); asm volatile("" : "+s"(gw));
    for (int k = 0; bid + G * k < 1024; ++k) {
        const int u = bid + G * k, c0 = u & 63, unit = (u & ~63) | ((k & 1) ? 63 - c0 : c0);
        nsa_unit(ws, unit, lds, (int)threadIdx.x);
    }
    for (int k = 0; bid + G * k < 2048; ++k) {
        const int u = bid + G * k, c0 = u & 255, unit = (u & ~255) | ((k & 1) ? 255 - c0 : c0);
        dsa_unit(ws, unit, lds, (int)threadIdx.x);
    }
}
__global__ void __launch_bounds__(NWAVES * 64, 2) fwd_kernel(Args args) {
    extern __shared__ __attribute__((aligned(16))) unsigned char lds_raw[];
    LAS unsigned char* lds = (LAS unsigned char*)lds_raw;
    const int wave = __builtin_amdgcn_readfirstlane((int)threadIdx.x >> 6);
#define tid ((int)threadIdx.x)
#define lane ((int)threadIdx.x & 63)
    const int G = gridDim.x, bid = blockIdx.x;
    const int gw = bid * NWAVES + wave, NGW = G * NWAVES;
    const int lo = args.ph_lo, hi = args.ph_hi;
    const Args& P = args;
    int z = 0; asm volatile("" : "+s"(z));
    unsigned char* ws = args.ws + z;
    volatile LAS unsigned* MISCW = (volatile LAS unsigned*)(lds + LDSCTL_OFF);
    if (tid < 64) MISCW[tid] = 0u;
    __syncthreads();
    XcdBarrier bar; bar.bar = (unsigned*)(ws + WS_CTL) + 4096; bar.x = 0; bar.st = nullptr;
    if (hi - lo > 1) bar = xcd_barrier_post((unsigned*)(ws + WS_CTL) + 4096, MISCW + 8);
#define RUN(k) (lo <= (k) && (k) < hi)
#define SEAM(k) do { if ((k) + 1 < hi) { XcdBarrier b2_ = bar; asm volatile("" : "+s"(b2_.bar), "+s"(b2_.x)); xcd_barrier(b2_); } else { VM_WAIT(); __syncthreads(); } } while (0)


    if (RUN(0)) { phase_rope(P, ws, z, bid * (NWAVES * 64) + tid, G * NWAVES * 64); SEAM(0); }

    for (int it = 0; it < 2 * DEPTH; ++it) {
        const int l = it >> 1, second = it & 1, pb = 1 + l * NPL + (second ? 9 : 0);
        asm volatile("" : "+s"(z));
        ws = args.ws + z;
        bf16* const XN = (bf16*)(ws + WS_XN);
        bf16* const HB = (bf16*)(ws + WS_H);
        bf16* const MG = (bf16*)(ws + WS_MG);
        bf16* const GB = (bf16*)(ws + WS_G);
        unsigned char* const wb = ws + WS_W;
        float* const OUT = P.out + z;
        const float* xin = (it == 0) ? P.in[0 + z] : (const float*)OUT;
        if (RUN(pb)) {
            if (!second) phase_convert(P, ws, z, l, lds, gw, NGW, lane, wave);
            const float* gain = (second ? P.in[19 + z] : P.in[2 + z]) + l * DM;
            { int ln_ = (int)threadIdx.x; asm volatile("" : "+v"(ln_)); ln_ &= 63; for (int m = gw; m < M; m += NGW) norm_row_bf16(xin + (size_t)m * DM, gain, XN + (size_t)m * DM, ln_); }
            SEAM(pb);
        }
        if (RUN(pb + 1)) {
            pg8::Gemm g{XN, (const bf16*)(wb + (second ? WO_GU2 : WO_GU1)), M, 2 * FF, DM}; pg8::StaticOrder S; S.init(M, 2 * FF, G, bid + z);
            pg8::EpiSwiglu E{HB, FF};
#if !defined(SITE_MASK) || ((SITE_MASK >> 0) & 1)
            pg8::gemm_phase<pg8::EpiSwiglu, pg8::StaticOrder, true, true>(lds, g, S, E);
#endif
            SEAM(pb + 1);
        }
        if (RUN(pb + 2)) {
            pg8::Gemm g{HB, (const bf16*)(wb + (second ? WO_D2 : WO_D1)), M, DM, FF}; pg8::StaticOrder S; S.init(M, DM, G, bid + z);
            pg8::EpiResid E{xin, OUT, 0.5f};
#if !defined(SITE_MASK) || ((SITE_MASK >> 1) & 1)
            pg8::gemm_phase<pg8::EpiResid, pg8::StaticOrder, true, true>(lds, g, S, E);
#endif
            SEAM(pb + 2);
        }
        if (second) continue;
        const int pm = 1 + l * NPL + 3;
        if (RUN(pm)) {
            const float* gain = P.in[6 + z] + l * DM;
            { int ln_ = (int)threadIdx.x; asm volatile("" : "+v"(ln_)); ln_ &= 63; for (int m = gw; m < M; m += NGW) norm_row_bf16(OUT + (size_t)m * DM, gain, XN + (size_t)m * DM, ln_); }
            SEAM(pm);
        }
        if (RUN(pm + 1)) {
            pg8::Gemm g{XN, (const bf16*)(wb + WO_IN), M, NINP, DM}; pg8::StaticOrder S; S.init(M, NINP, G, bid + z);
            pg8::EpiWin E{(bf16*)(ws + WS_QA), (bf16*)(ws + WS_QC), (bf16*)(ws + WS_IQ), (bf16*)(ws + WS_MISC), (bf16*)(ws + WS_KVC), (bf16*)(ws + WS_KVS), (bf16*)(ws + WS_KVW), (bf16*)(ws + WS_BU), GB,
                          (const float*)(ws + WS_ROPE)};
#if !defined(SITE_MASK) || ((SITE_MASK >> 2) & 1)
            pg8::gemm_phase<pg8::EpiWin, pg8::StaticOrder, true, true>(lds, g, S, E);
#endif
            SEAM(pm + 1);
        }
        #ifndef NO_PREP
        if (RUN(pm + 2)) { phase_prep(P, ws, z, l, lds, gw, NGW, lane, wave); SEAM(pm + 2); }
#endif
        #ifndef NO_MIX
        if (RUN(pm + 3)) { phase_mixers(P, ws, z, lds, gw, NGW, lane, wave, bid, G); SEAM(pm + 3); }
#endif
        if (RUN(pm + 4)) {
            pg8::StaticOrder S; S.init(M, DM, G, bid + z);
            { pg8::Gemm g{(const bf16*)(ws + WS_QA), (const bf16*)(wb + WO_PA), M, DM, 512}; pg8::EpiProj<0> E{MG, GB, 0};
#if !defined(SITE_MASK) || ((SITE_MASK >> 3) & 1)
              pg8::gemm_phase<pg8::EpiProj<0>, pg8::StaticOrder, true, true>(lds, g, S, E);
#endif
            }
            { pg8::Gemm g{(const bf16*)(ws + WS_XN), (const bf16*)(wb + WO_PB), M, DM, 512}; pg8::EpiProj<1> E{MG, GB, 1024};
#if !defined(SITE_MASK) || ((SITE_MASK >> 4) & 1)
              pg8::gemm_phase<pg8::EpiProj<1>, pg8::StaticOrder, true, true>(lds, g, S, E);
#endif
            }
            { pg8::Gemm g{(const bf16*)(ws + WS_QC), (const bf16*)(wb + WO_PC), M, DM, 512}; pg8::EpiProj<1> E{MG, GB, 2048};
#if !defined(SITE_MASK) || ((SITE_MASK >> 5) & 1)
              pg8::gemm_phase<pg8::EpiProj<1>, pg8::StaticOrder, true, true>(lds, g, S, E);
#endif
            }
            SEAM(pm + 4);
        }
        if (RUN(pm + 5)) {
            pg8::Gemm g{MG, (const bf16*)(wb + WO_OUT), M, DM, DM}; pg8::StaticOrder S; S.init(M, DM, G, bid + z);
            pg8::EpiResid E{OUT, OUT, 1.0f};
#if !defined(SITE_MASK) || ((SITE_MASK >> 6) & 1)
            pg8::gemm_phase<pg8::EpiResid, pg8::StaticOrder, true, true>(lds, g, S, E);
#endif
            SEAM(pm + 5);
        }
    }
    if (RUN(NPH - 1)) { asm volatile("" : "+s"(z)); int ln_ = (int)threadIdx.x; asm volatile("" : "+v"(ln_)); ln_ &= 63; float* o_ = P.out + z; for (int m = gw; m < M; m += NGW) norm_row_f32(o_ + (size_t)m * DM, P.in[23 + z], ln_); }
#undef RUN
#undef tid
#undef lane
#undef SEAM
}

extern "C" void kernel_launch(void* const* d_in, const int* in_sizes, int n_in, void* d_out, int out_size, void* d_ws, size_t ws_size, hipStream_t stream) {
    static int grid = 0;
    if (grid == 0) {
        if (n_in != 24 || out_size != M * DM || ws_size < WS_END) { fprintf(stderr, "kernel_launch: unexpected shapes (n_in %d out %d ws %zu)\n", n_in, out_size, ws_size); grid = -1; return; }
        int dev = 0, cus = 0, per_cu = 0;
        if (hipGetDevice(&dev) != hipSuccess || hipDeviceGetAttribute(&cus, hipDeviceAttributeMultiprocessorCount, dev) != hipSuccess) { grid = -1; return; }
        if (hipFuncSetAttribute((const void*)fwd_kernel, hipFuncAttributeMaxDynamicSharedMemorySize, LDS_BYTES) != hipSuccess) { fprintf(stderr, "kernel_launch: hipFuncSetAttribute failed\n"); grid = -1; return; }
        if (hipOccupancyMaxActiveBlocksPerMultiprocessor(&per_cu, (const void*)fwd_kernel, NWAVES * 64, LDS_BYTES) != hipSuccess || per_cu < 1) { fprintf(stderr, "kernel_launch: occupancy query says %d\n", per_cu); }
        (void)hipGetLastError();
        grid = cus;
    }
    if (grid < 0) return;
    (void)hipMemsetAsync((char*)d_ws + WS_CTL, 0, CTL_ZERO_BYTES, stream);
    Args a{};
    for (int i = 0; i < 24; ++i) a.in[i] = (const float*)d_in[i];
    a.out = (float*)d_out; a.ws = (unsigned char*)d_ws;
#if MK_ONE_LAUNCH
    a.ph_lo = 0; a.ph_hi = NPH;
    hipLaunchKernelGGL(fwd_kernel, dim3(grid), dim3(NWAVES * 64), LDS_BYTES, stream, a);
#else
    for (int ph = 0; ph < NPH; ++ph) { a.ph_lo = ph; a.ph_hi = ph + 1; hipLaunchKernelGGL(fwd_kernel, dim3(grid), dim3(NWAVES * 64), LDS_BYTES, stream, a); }
#endif
}
```

```cpp
#include <hip/hip_runtime.h>
#include <cstdio>
#include <cstdint>
#define PROBE 0
#define PROBE_GAIN 10.0f
#define TOP8_RANK 0
#define PROBE_ROWTHR 0.01f
#define PROBE_ROWCOND 1
#define PROBE_BR -1
#define FIXHOM 0
#define DUP 0
#define POOLDBG 0
#define YB_SPARE 0
#ifndef MK_ONE_LAUNCH
#define MK_ONE_LAUNCH 1
#endif
namespace pg8 {
#define PG8_LAS __attribute__((address_space(3)))
typedef unsigned short bf16_t;
typedef short bf16x8 __attribute__((ext_vector_type(8)));
typedef float f32x4 __attribute__((ext_vector_type(4)));
typedef unsigned u32x4 __attribute__((ext_vector_type(4)));
constexpr int BM = 256, BK = 64, HALF = 128, HTB = HALF * BK * 2  , STAGE_BYTES = 8 * HTB, NXCD = 8, WGM = 8;

__host__ __device__ __forceinline__ int lds_byte(int r, int c) { const int st = (r >> 4) * 2 + (c >> 5), rr = r & 15, cc = c & 31, ob = rr * 64 + cc * 2; return st * 1024 + (ob ^ (((ob >> 9) & 1) << 5)); }
__host__ __device__ __forceinline__ void stage_rc(int b, int& R, int& C) { const int st = b / 1024, sb = b % 1024, swz = sb ^ (((sb >> 9) & 1) << 5); R = (st >> 1) * 16 + swz / 64; C = (st & 1) * 32 + (swz % 64) / 2; }
__host__ __device__ __forceinline__ int perm32(int rho) { const int n = rho >> 4, i = rho & 15; return 8 * (i >> 2) + 4 * n + (i & 3); }

struct Unit { int pm, pn; };
struct Gemm { const bf16_t* A; const bf16_t* Bt; int M, N, K; };

struct StaticOrder {
    int nM, nN, nwg, G, c;
    __host__ __device__ void init(int M, int N, int G_, int c_) { nM = M / BM; nN = N / BM; nwg = nM * nN; G = G_; c = c_; }
    __host__ __device__ bool next(int i, Unit& u) const {
        const long L = (long)i * G + c; if (L >= nwg) return false;
        int wgid = (int)L; { const int q = nwg / NXCD, r = nwg % NXCD, xcd = wgid % NXCD, off = wgid / NXCD; wgid = (xcd < r ? xcd * (q + 1) : r * (q + 1) + (xcd - r) * q) + off; }
        const int nig = WGM * nN, gid = wgid / nig, fm = gid * WGM, gsz = (nM - fm) < WGM ? (nM - fm) : WGM;
        u.pm = fm + ((wgid % nig) % gsz); u.pn = (wgid % nig) / gsz; return true;
    }
    __device__ __forceinline__ void a_ready(const Unit&) const {}
    __device__ __forceinline__ void done(const Unit&) const {}
};

__device__ __forceinline__ unsigned cvt_pk_bf16(float lo, float hi) { unsigned r; asm volatile("v_cvt_pk_bf16_f32 %0, %1, %2" : "=v"(r) : "v"(lo), "v"(hi)); return r; }
__device__ __forceinline__ float bflo(unsigned w) { return __uint_as_float(w << 16); }
__device__ __forceinline__ float bfhi(unsigned w) { return __uint_as_float(w & 0xffff0000u); }
__device__ __forceinline__ float fast_sigmoid(float x) { return __builtin_amdgcn_rcpf(1.0f + __expf(-x)); }

struct EpiSwiglu {
    static constexpr bool PERM = true, AFTER_DRAIN = false;
    bf16_t* H; int ldh;
    __device__ __forceinline__ void operator()(const f32x4 (&acc)[2][2][4][2], const Unit& u, int wr, int wc, int fr, int fq) const {
        const int row0 = u.pm * BM + wr * 64 + fr, col0 = u.pn * HALF + wc * 32 + 8 * fq;
#pragma unroll
        for (int ai = 0; ai < 2; ++ai)
#pragma unroll
            for (int m = 0; m < 4; ++m) {
                bf16_t* rowp = H + (size_t)(row0 + ai * HALF + m * 16) * ldh + col0;
                float o[8];
#pragma unroll
                for (int n = 0; n < 2; ++n)
#pragma unroll
                    for (int e = 0; e < 4; ++e) { const float g = acc[ai][0][m][n][e], up = acc[ai][1][m][n][e]; o[n * 4 + e] = g * fast_sigmoid(g) * up; }
                u32x4 w; w.x = cvt_pk_bf16(o[0], o[1]); w.y = cvt_pk_bf16(o[2], o[3]); w.z = cvt_pk_bf16(o[4], o[5]); w.w = cvt_pk_bf16(o[6], o[7]);
                *(u32x4*)rowp = w;
            }
    }
};
struct EpiResid {
    static constexpr bool PERM = true, AFTER_DRAIN = false;
    const float* base; float* out; float s;
    __device__ __forceinline__ void operator()(const f32x4 (&acc)[2][2][4][2], const Unit& u, int wr, int wc, int fr, int fq) const {
        const int row0 = u.pm * BM + wr * 64 + fr, col0 = u.pn * BM + wc * 32 + 8 * fq;
#pragma unroll
        for (int ai = 0; ai < 2; ++ai)
#pragma unroll
            for (int m = 0; m < 4; ++m) {
                const size_t off = (size_t)(row0 + ai * HALF + m * 16) * 1024 + col0;
#pragma unroll
                for (int bj = 0; bj < 2; ++bj) {
                    const f32x4 b0 = *(const f32x4*)(base + off + bj * HALF), b1 = *(const f32x4*)(base + off + bj * HALF + 4);
                    *(f32x4*)(out + off + bj * HALF) = b0 + acc[ai][bj][m][0] * s; *(f32x4*)(out + off + bj * HALF + 4) = b1 + acc[ai][bj][m][1] * s;
                }
            }
    }
};
template <int MODE> struct EpiProj {
    static constexpr bool PERM = true, AFTER_DRAIN = false;
    bf16_t* MG; const bf16_t* G; int gofs;
    __device__ __forceinline__ void operator()(const f32x4 (&acc)[2][2][4][2], const Unit& u, int wr, int wc, int fr, int fq) const {
        const int row0 = u.pm * BM + wr * 64 + fr, col0 = u.pn * BM + wc * 32 + 8 * fq;
#pragma unroll
        for (int ai = 0; ai < 2; ++ai)
#pragma unroll
            for (int m = 0; m < 4; ++m) {
                const size_t row = (size_t)(row0 + ai * HALF + m * 16);
#pragma unroll
                for (int bj = 0; bj < 2; ++bj) {
                    const u32x4 gv = *(const u32x4*)(G + row * 3072 + gofs + col0 + bj * HALF);
                    bf16_t* mp = MG + row * 1024 + col0 + bj * HALF;
                    const f32x4 a0 = acc[ai][bj][m][0], a1 = acc[ai][bj][m][1];
                    float o[8] = {bflo(gv.x) * a0[0], bfhi(gv.x) * a0[1], bflo(gv.y) * a0[2], bfhi(gv.y) * a0[3], bflo(gv.z) * a1[0], bfhi(gv.z) * a1[1], bflo(gv.w) * a1[2], bfhi(gv.w) * a1[3]};
                    if (MODE) { const u32x4 ov = *(const u32x4*)mp; o[0] += bflo(ov.x); o[1] += bfhi(ov.x); o[2] += bflo(ov.y); o[3] += bfhi(ov.y); o[4] += bflo(ov.z); o[5] += bfhi(ov.z); o[6] += bflo(ov.w); o[7] += bfhi(ov.w); }
                    u32x4 w; w.x = cvt_pk_bf16(o[0], o[1]); w.y = cvt_pk_bf16(o[2], o[3]); w.z = cvt_pk_bf16(o[4], o[5]); w.w = cvt_pk_bf16(o[6], o[7]);
                    *(u32x4*)mp = w;
                }
            }
    }
};
struct EpiWin {
    static constexpr bool PERM = true, AFTER_DRAIN = false;
    bf16_t *QA, *QC, *IQ, *MISC, *KVC, *KVS, *KVW, *BU, *G; const float* rope;
    __device__ __forceinline__ void operator()(const f32x4 (&acc)[2][2][4][2], const Unit& u, int wr, int wc, int fr, int fq) const {
        const int pn = u.pn;
        bf16_t* dst; int ld, cbase, mode;
        if (pn < 2) { dst = QA; ld = 512; cbase = pn * 256; mode = 1; }
        else if (pn < 4) { dst = QC; ld = 512; cbase = (pn - 2) * 256; mode = 1; }
        else if (pn == 4) { dst = IQ; ld = 256; cbase = 0; mode = 1; }
        else if (pn == 5) { dst = MISC; ld = 256; cbase = 0; mode = 3; }
        else if (pn <= 8) { dst = pn == 6 ? KVC : (pn == 7 ? KVS : KVW); ld = 256; cbase = 0; mode = 2; }
        else if (pn <= 10) { dst = BU; ld = 512; cbase = (pn - 9) * 256; mode = 0; }
        else { dst = G; ld = 3072; cbase = (pn - 11) * 256; mode = 4; }
        const int row0 = u.pm * BM + wr * 64 + fr, col0 = cbase + wc * 32 + 8 * fq;
        const bool ropelane = ((wc & 1) == 0) && fq < 2;
        const float sc = (mode == 1) ? 0.125f : 1.0f;
#pragma unroll
        for (int ai = 0; ai < 2; ++ai)
#pragma unroll
            for (int m = 0; m < 4; ++m) {
                const size_t row = (size_t)(row0 + ai * HALF + m * 16);
                f32x4 cs = {1.f, 1.f, 1.f, 1.f}, sn = {0.f, 0.f, 0.f, 0.f};
                if (ropelane && mode >= 1 && mode <= 3) { cs = *(const f32x4*)(rope + row * 16 + 4 * fq); sn = *(const f32x4*)(rope + row * 16 + 8 + 4 * fq); }
#pragma unroll
                for (int bj = 0; bj < 2; ++bj) {
                    const f32x4 a0 = acc[ai][bj][m][0], a1 = acc[ai][bj][m][1];
                    float o[8] = {a0[0], a0[1], a0[2], a0[3], a1[0], a1[1], a1[2], a1[3]};
                    const bool dorope = ropelane && (mode == 1 || (mode == 2 && bj == 0) || (mode == 3 && bj == 0 && wc == 0));
                    if (dorope) {
#pragma unroll
                        for (int p = 0; p < 4; ++p) { const float x1 = o[2 * p], x2 = o[2 * p + 1]; o[2 * p] = x1 * cs[p] - x2 * sn[p]; o[2 * p + 1] = x2 * cs[p] + x1 * sn[p]; }
                    }
                    if (mode == 4) {
#pragma unroll
                        for (int e = 0; e < 8; ++e) o[e] = fast_sigmoid(o[e]);
                    } else {
#pragma unroll
                        for (int e = 0; e < 8; ++e) o[e] *= sc;
                    }
                    u32x4 w; w.x = cvt_pk_bf16(o[0], o[1]); w.y = cvt_pk_bf16(o[2], o[3]); w.z = cvt_pk_bf16(o[4], o[5]); w.w = cvt_pk_bf16(o[6], o[7]);
                    *(u32x4*)(dst + row * ld + col0 + bj * HALF) = w;
                }
            }
    }
};

template <class Epi, class Sched, bool ALIGN_EPI = false, bool SP2 = false>
__device__ __forceinline__ void gemm_phase(PG8_LAS unsigned char* lds, const Gemm g, const Sched& S, const Epi& E, int tid_in) {
    int tid_ = tid_in; asm volatile("" : "+v"(tid_));
    const int tid = tid_, wid = __builtin_amdgcn_readfirstlane(tid >> 6), lane = tid & 63, wr = wid >> 2, wc = wid & 3, fr = lane & 15, fq = lane >> 4;
    const int K = g.K, nt = K / BK;
    unsigned voffA[2], voffB[2];
#pragma unroll
    for (int i = 0; i < 2; ++i) { int R, C; stage_rc(tid * 16 + i * 8192, R, C); const int Rb = Epi::PERM ? ((R & ~31) + perm32(R & 31)) : R;
        voffA[i] = (unsigned)(R * K + C) * 2u; voffB[i] = (unsigned)(Rb * K + C) * 2u; }
    const size_t kstep = (size_t)(BK * 2);
    const size_t hstep = (size_t)HALF * K * 2;
    const size_t tstep = 2 * hstep;
    const unsigned ldsw = (unsigned)wid * 1024u;
    const int aoff = lds_byte(wr * 64 + fr, fq * 8), boff = lds_byte(wc * 32 + fr, fq * 8);
#define PG8_SA(b, h) (((b) * 2 + (h)) * HTB)
#define PG8_SB(b, h) ((4 + (b) * 2 + (h)) * HTB)
#define PG8_STAGE(bufoff, gbase, voff) do { _Pragma("unroll") for (int _i = 0; _i < 2; ++_i) \
        __builtin_amdgcn_global_load_lds((const unsigned*)((const char*)(gbase) + (voff)[_i]), (PG8_LAS unsigned*)(lds + (bufoff) + ldsw + _i * 8192), 16, 0, 0); } while (0)
#define PG8_LDA(dst, b, h) do { _Pragma("unroll") for (int m = 0; m < 4; ++m) _Pragma("unroll") for (int k = 0; k < 2; ++k) dst[m][k] = *(const PG8_LAS bf16x8*)(lds + PG8_SA(b, h) + aoff + m * 2048 + k * 1024); } while (0)
#define PG8_LDB(dst, b, h) do { _Pragma("unroll") for (int n = 0; n < 2; ++n) _Pragma("unroll") for (int k = 0; k < 2; ++k) dst[n][k] = *(const PG8_LAS bf16x8*)(lds + PG8_SB(b, h) + boff + n * 2048 + k * 1024); } while (0)
#define PG8_MMA(ai, bj, At, Bt) do { __builtin_amdgcn_s_setprio(1); _Pragma("unroll") for (int m = 0; m < 4; ++m) _Pragma("unroll") for (int n = 0; n < 2; ++n) _Pragma("unroll") for (int k = 0; k < 2; ++k) \
        acc[ai][bj][m][n] = __builtin_amdgcn_mfma_f32_16x16x32_bf16(Bt[n][k], At[m][k], acc[ai][bj][m][n], 0, 0, 0); __builtin_amdgcn_s_setprio(0); } while (0)
#define PG8_WAIT_V(n) asm volatile("s_waitcnt vmcnt(" #n ")" ::: "memory")
#define PG8_WAIT_L(n) asm volatile("s_waitcnt lgkmcnt(" #n ")" ::: "memory")
#define PG8_BAR __builtin_amdgcn_s_barrier()
#define PG8_SCHED __builtin_amdgcn_sched_barrier(0)
    Unit cur, nxt; int ui = 0;
    if (!S.next(0, cur)) return;
    f32x4 acc[2][2][4][2];
#pragma unroll
    for (int a = 0; a < 2; ++a)
#pragma unroll
        for (int b = 0; b < 2; ++b)
#pragma unroll
            for (int m = 0; m < 4; ++m)
#pragma unroll
                for (int n = 0; n < 2; ++n) acc[a][b][m][n] = (f32x4){0.f, 0.f, 0.f, 0.f};
    bf16x8 At[4][2], B0[2][2], B1[2][2];
    const char* cA = (const char*)g.A + (size_t)cur.pm * tstep; const char* cB = (const char*)g.Bt + (size_t)cur.pn * tstep;
    S.a_ready(cur);
    if constexpr (SP2) {
        PG8_STAGE(PG8_SB(0, 0), cB, voffB); PG8_STAGE(PG8_SB(0, 1), cB + hstep, voffB); PG8_STAGE(PG8_SA(0, 0), cA, voffA); PG8_STAGE(PG8_SA(0, 1), cA + hstep, voffA);
        if (wr == 1) PG8_BAR;
        PG8_WAIT_V(2); PG8_BAR;
        PG8_STAGE(PG8_SB(1, 0), cB + kstep, voffB); PG8_STAGE(PG8_SA(1, 0), cA + kstep, voffA); PG8_STAGE(PG8_SB(1, 1), cB + hstep + kstep, voffB);
        PG8_WAIT_V(6); PG8_BAR;
    } else {
        PG8_STAGE(PG8_SB(0, 0), cB, voffB); PG8_STAGE(PG8_SA(0, 0), cA, voffA); PG8_STAGE(PG8_SB(0, 1), cB + hstep, voffB); PG8_STAGE(PG8_SA(0, 1), cA + hstep, voffA);
        if (wr == 1) PG8_BAR;
        PG8_WAIT_V(4); PG8_BAR;
        PG8_STAGE(PG8_SB(1, 0), cB + kstep, voffB); PG8_STAGE(PG8_SA(1, 0), cA + kstep, voffA); PG8_STAGE(PG8_SB(1, 1), cB + hstep + kstep, voffB);
        PG8_WAIT_V(6); PG8_BAR;
    }
    for (;;) {
        const bool has_next = S.next(ui + 1, nxt);
        const char* nA = has_next ? (const char*)g.A + (size_t)nxt.pm * tstep : cA; const char* nB = has_next ? (const char*)g.Bt + (size_t)nxt.pn * tstep : cB;
        for (int t = 0; t < nt; t += 2) {
            const bool last = (t == nt - 2);
            const char* a1 = cA + (size_t)(t + 1) * kstep;
            const char* a2 = last ? nA : cA + (size_t)(t + 2) * kstep; const char* b2 = last ? nB : cB + (size_t)(t + 2) * kstep;
            const char* a3 = a2 + kstep; const char* b3 = b2 + kstep;
            if (last && has_next) S.a_ready(nxt);
            if constexpr (SP2) {
            PG8_LDB(B0, 0, 0); PG8_LDB(B1, 0, 1); PG8_SCHED; PG8_LDA(At, 0, 0); PG8_STAGE(PG8_SA(1, 1), a1 + hstep, voffA);
            PG8_WAIT_V(8); PG8_WAIT_L(0); PG8_BAR; PG8_MMA(0, 0, At, B0); PG8_MMA(0, 1, At, B1); PG8_BAR; PG8_SCHED;
            PG8_LDA(At, 0, 1); PG8_STAGE(PG8_SB(0, 0), b2, voffB); PG8_STAGE(PG8_SB(0, 1), b2 + hstep, voffB); PG8_STAGE(PG8_SA(0, 0), a2, voffA);
            PG8_WAIT_V(8); PG8_WAIT_L(0); PG8_BAR; PG8_MMA(1, 0, At, B0); PG8_MMA(1, 1, At, B1); PG8_BAR; PG8_SCHED;
            PG8_LDB(B0, 1, 0); PG8_LDB(B1, 1, 1); PG8_SCHED; PG8_LDA(At, 1, 0); PG8_STAGE(PG8_SA(0, 1), a2 + hstep, voffA);
            PG8_WAIT_V(8); PG8_WAIT_L(0); PG8_BAR; PG8_MMA(0, 0, At, B0); PG8_MMA(0, 1, At, B1); PG8_BAR; PG8_SCHED;
            PG8_LDA(At, 1, 1); PG8_STAGE(PG8_SB(1, 0), b3, voffB); PG8_STAGE(PG8_SB(1, 1), b3 + hstep, voffB); PG8_STAGE(PG8_SA(1, 0), a3, voffA);
            PG8_WAIT_V(8); PG8_WAIT_L(0); PG8_BAR; PG8_MMA(1, 0, At, B0); PG8_MMA(1, 1, At, B1); PG8_BAR; PG8_SCHED;
            } else {
            PG8_LDB(B0, 0, 0); PG8_SCHED; PG8_LDA(At, 0, 0); PG8_STAGE(PG8_SA(1, 1), a1 + hstep, voffA);
            PG8_WAIT_L(8); PG8_BAR; PG8_WAIT_L(0); PG8_MMA(0, 0, At, B0); PG8_BAR; PG8_SCHED;
            PG8_LDB(B1, 0, 1); PG8_STAGE(PG8_SB(0, 0), b2, voffB);
            PG8_BAR; PG8_WAIT_L(0); PG8_MMA(0, 1, At, B1); PG8_BAR;
            PG8_LDA(At, 0, 1); PG8_STAGE(PG8_SA(0, 0), a2, voffA);
            PG8_BAR; PG8_WAIT_L(0); PG8_MMA(1, 0, At, B0); PG8_BAR; PG8_SCHED;
            PG8_STAGE(PG8_SB(0, 1), b2 + hstep, voffB);
            PG8_WAIT_V(6); PG8_BAR; PG8_MMA(1, 1, At, B1); PG8_BAR;
            PG8_LDB(B0, 1, 0); PG8_SCHED; PG8_LDA(At, 1, 0); PG8_STAGE(PG8_SA(0, 1), a2 + hstep, voffA);
            PG8_WAIT_L(8); PG8_BAR; PG8_WAIT_L(0); PG8_MMA(0, 0, At, B0); PG8_BAR; PG8_SCHED;
            PG8_LDB(B1, 1, 1); PG8_STAGE(PG8_SB(1, 0), b3, voffB);
            PG8_BAR; PG8_WAIT_L(0); PG8_MMA(0, 1, At, B1); PG8_BAR;
            PG8_LDA(At, 1, 1); PG8_STAGE(PG8_SA(1, 0), a3, voffA);
            PG8_BAR; PG8_WAIT_L(0); PG8_MMA(1, 0, At, B0); PG8_BAR; PG8_SCHED;
            PG8_STAGE(PG8_SB(1, 1), b3 + hstep, voffB);
            PG8_WAIT_V(6); PG8_BAR; PG8_MMA(1, 1, At, B1); PG8_BAR;
            }
        }
        if constexpr (ALIGN_EPI) { if (wr == 0) PG8_BAR; }
        if constexpr (!Epi::AFTER_DRAIN) { E(acc, cur, wr, wc, fr, fq); S.done(cur); }
        if (!has_next) break;
#pragma unroll
        for (int a = 0; a < 2; ++a)
#pragma unroll
            for (int b = 0; b < 2; ++b)
#pragma unroll
                for (int m = 0; m < 4; ++m)
#pragma unroll
                    for (int n = 0; n < 2; ++n) acc[a][b][m][n] = (f32x4){0.f, 0.f, 0.f, 0.f};
        cur = nxt; cA = nA; cB = nB; ++ui;
        if constexpr (ALIGN_EPI) { if (wr == 1) PG8_BAR; }
    }
    PG8_WAIT_V(0);
    if constexpr (!ALIGN_EPI) { if (wr == 0) PG8_BAR; }
    PG8_BAR;
    if constexpr (Epi::AFTER_DRAIN) { E.fused(acc, cur, wr, wc, fr, fq, lds, wid, lane); S.done(cur); }
#undef PG8_SA
#undef PG8_SB
#undef PG8_STAGE
#undef PG8_LDA
#undef PG8_LDB
#undef PG8_MMA
#undef PG8_WAIT_V
#undef PG8_WAIT_L
#undef PG8_BAR
#undef PG8_SCHED
}
}
#define GAS __attribute__((address_space(1)))
#define LAS __attribute__((address_space(3)))
typedef unsigned short bf16;
typedef unsigned v4u __attribute__((ext_vector_type(4)));
typedef float f32x4 __attribute__((ext_vector_type(4)));
typedef short bf16x8 __attribute__((ext_vector_type(8)));
typedef GAS unsigned gu32;
typedef GAS unsigned long long gu64;
#define RLX_AGENT __ATOMIC_RELAXED, __HIP_MEMORY_SCOPE_AGENT
#define LDS_WAIT() asm volatile("s_waitcnt lgkmcnt(0)" ::: "memory")
#define VM_WAIT() asm volatile("s_waitcnt vmcnt(0)" ::: "memory")
__device__ __forceinline__ unsigned long long rt() { return __builtin_amdgcn_s_memrealtime(); }
__device__ __forceinline__ unsigned f2bf(float f) { unsigned u = __builtin_bit_cast(unsigned, f); return (u + 0x7fffu + ((u >> 16) & 1u)) >> 16; }
__device__ __forceinline__ unsigned pk2(float lo, float hi) { return f2bf(lo) | (f2bf(hi) << 16); }
#define XB_TMO      128
#define XB_XCNT(j)  (256  + 64 * (j))
#define XB_XSUB(j)  (1280 + 64 * (j))
#define XB_XGEN(j)  (2304 + 64 * (j))
#define XB_TOP      3328
#define XB_TOPGEN   3392
#define XCD_BAR_WORDS 3456
#define XB_SPIN_CAP (1u << 18)

__device__ __forceinline__ unsigned xb_ld(unsigned* p)              { return __hip_atomic_load(p, __ATOMIC_RELAXED, __HIP_MEMORY_SCOPE_AGENT); }
__device__ __forceinline__ unsigned xb_add(unsigned* p, unsigned v) { return __hip_atomic_fetch_add(p, v, __ATOMIC_RELAXED, __HIP_MEMORY_SCOPE_AGENT); }
__device__ __forceinline__ unsigned xb_xcc_id() { return (unsigned)__builtin_amdgcn_s_getreg((3 << 11) | 20) & 0xFu; }
#define XB_SPIN(cond, bar) do { unsigned _sp = 0; while (cond) { __builtin_amdgcn_s_sleep(1); \
    if ((++_sp & 255u) == 0u) { if (xb_ld(&(bar)[XB_TMO])) break; if (_sp > XB_SPIN_CAP) { atomicAdd(&(bar)[XB_TMO], 1u); break; } } } } while (0)

struct XcdBarrier {
    unsigned* bar; unsigned x;
    volatile LAS unsigned* st;
};

__device__ __forceinline__ XcdBarrier xcd_barrier_post(unsigned* bar, volatile LAS unsigned* st) {
    XcdBarrier b; b.bar = bar; b.x = xb_xcc_id(); b.st = st;
    if (threadIdx.x == 0) (void)xb_add(&bar[XB_XCNT(b.x)], 1u);
    return b;
}
__device__ __forceinline__ void xcd_barrier_complete(unsigned* bar, unsigned x, unsigned& nloc, unsigned& nx) {
    const unsigned G = gridDim.x * gridDim.y * gridDim.z;
    unsigned sum, cnt, mine, sp = 0u;
    for (;;) {
        sum = 0u; cnt = 0u; mine = 0u;
#pragma unroll
        for (unsigned j = 0; j < 16; ++j) { const unsigned c = xb_ld(&bar[XB_XCNT(j)]); sum += c; cnt += (c > 0u) ? 1u : 0u; mine = (j == x) ? c : mine; }
        if (sum == G) break;
        __builtin_amdgcn_s_sleep(1);
        if ((++sp & 255u) == 0u) { if (xb_ld(&bar[XB_TMO])) break; if (sp > XB_SPIN_CAP) { atomicAdd(&bar[XB_TMO], 1u); break; } }
    }
    nloc = mine > 0u ? mine : 1u; nx = cnt > 0u ? cnt : 1u;
}

__device__ __forceinline__ void xcd_barrier(const XcdBarrier& b) {
    asm volatile("s_waitcnt vmcnt(0)" ::: "memory");
    __syncthreads();
    if (threadIdx.x == 0) {
        unsigned* bar = b.bar;
        __builtin_amdgcn_s_waitcnt(0);
        unsigned nloc = b.st[0], nx = b.st[1];
        if (nloc == 0u) { xcd_barrier_complete(bar, b.x, nloc, nx); b.st[0] = nloc; b.st[1] = nx; }
        const unsigned old = xb_add(&bar[XB_XSUB(b.x)], 1u);
        const unsigned gen = old / nloc;
        if (old + 1u == (gen + 1u) * nloc) {
            __builtin_amdgcn_fence(__ATOMIC_RELEASE, "agent");
            asm volatile("s_waitcnt vmcnt(0)" ::: "memory");
            const unsigned og = xb_add(&bar[XB_TOP], 1u);
            const unsigned tg = og / nx;
            if (og + 1u == (tg + 1u) * nx) xb_add(&bar[XB_TOPGEN], 1u);
            else XB_SPIN(xb_ld(&bar[XB_TOPGEN]) == tg, bar);
            __builtin_amdgcn_fence(__ATOMIC_ACQUIRE, "agent");
            xb_add(&bar[XB_XGEN(b.x)], 1u);
            asm volatile("s_waitcnt vmcnt(0)" ::: "memory");
        } else {
            XB_SPIN(xb_ld(&bar[XB_XGEN(b.x)]) == gen, bar);
            __builtin_amdgcn_fence(__ATOMIC_ACQUIRE, "agent");
            asm volatile("s_waitcnt vmcnt(0)" ::: "memory");
        }
    }
    __syncthreads();
}
constexpr int NB = 8, SEQ = 4096, DM = 1024, DEPTH = 4, M = NB * SEQ;
constexpr int FF = 2816, NIN = 5852, NINP = 5888;
constexpr float EPS = 1e-6f, NEGF = -1e30f;
constexpr int NWAVES = 8;
constexpr size_t MiB = 1u << 20;
constexpr size_t WS_CTL = 0, CTL_ZERO_BYTES = 1 * MiB;
constexpr size_t WS_ROPE = 1 * MiB;
constexpr size_t WS_KVA = 3 * MiB;
constexpr size_t WS_KC = 11 * MiB, WS_VC = WS_KC + 512 * 1024;
constexpr size_t WS_W = 12 * MiB;
constexpr size_t WO_GU1 = 0, WO_D1 = 11 * MiB, WO_GU2 = WO_D1 + 5 * MiB + 512 * 1024, WO_D2 = WO_GU2 + 11 * MiB, WO_IN = WO_D2 + 5 * MiB + 512 * 1024,
                 WO_PA = WO_IN + 11 * MiB + 512 * 1024, WO_PB = WO_PA + MiB, WO_PC = WO_PB + MiB, WO_OUT = WO_PC + MiB,
                 WO_CW1 = WO_OUT + 2 * MiB  , WO_CW2 = WO_CW1 + MiB  , WO_UKV = WO_CW2 + 32768  , WO_POOL = WO_UKV + 32768  ,
                 WO_POSB = WO_POOL + 131072  , WO_END = WO_POSB + 1024;
static_assert(WO_END <= 52 * MiB, "weights region");
constexpr size_t WS_XN = 64 * MiB;
constexpr size_t WS_R = 128 * MiB;
constexpr size_t WS_G = WS_R, WS_QA = WS_R + 192 * MiB, WS_QC = WS_QA + 32 * MiB, WS_IQ = WS_QC + 32 * MiB, WS_MISC = WS_IQ + 16 * MiB,
                 WS_KVC = WS_MISC + 16 * MiB, WS_KVS = WS_KVC + 16 * MiB, WS_KVW = WS_KVS + 16 * MiB, WS_BU = WS_KVW + 16 * MiB, WS_END = WS_BU + 32 * MiB;
#ifndef YB_SPARE
#define YB_SPARE 0
#endif
constexpr size_t WS_YB = YB_SPARE ? 496 * MiB : WS_XN;
constexpr size_t WS_MG = WS_IQ;
constexpr size_t WS_H = WS_R;
static_assert(WS_END == 496 * MiB, "ws map");
constexpr int RING_BYTES = 131072, LDS_BYTES = 163840, LDSCTL_OFF = 163840 - 256;
constexpr int NPL = 12, NPH = 1 + DEPTH * NPL + 1;

__device__ __forceinline__ int lane_id_v() { int l; asm volatile("v_mbcnt_lo_u32_b32 %0, -1, 0\n\tv_mbcnt_hi_u32_b32 %0, -1, %0" : "=v"(l)); return l; }
__device__ __forceinline__ float bflo(unsigned w) { return __uint_as_float(w << 16); }
__device__ __forceinline__ float bfhi(unsigned w) { return __uint_as_float(w & 0xffff0000u); }
__device__ __forceinline__ float bf2f(bf16 v) { return __uint_as_float((unsigned)v << 16); }
__device__ __forceinline__ float wave_sum(float v) {
#pragma unroll
    for (int o = 1; o < 64; o <<= 1) v += __shfl_xor(v, o);
    return v;
}
__device__ __forceinline__ float wave_max(float v) {
#pragma unroll
    for (int o = 1; o < 64; o <<= 1) v = fmaxf(v, __shfl_xor(v, o));
    return v;
}
__device__ __forceinline__ int wave_sum_i(int v) {
#pragma unroll
    for (int o = 1; o < 64; o <<= 1) v += __shfl_xor(v, o);
    return v;
}
__device__ __forceinline__ unsigned wave_max_u(unsigned v) {
#pragma unroll
    for (int o = 1; o < 64; o <<= 1) { const unsigned w = (unsigned)__shfl_xor((int)v, o); v = w > v ? w : v; }
    return v;
}
#define WAVE_LDS_SYNC() do { asm volatile("s_waitcnt lgkmcnt(0)" ::: "memory"); __builtin_amdgcn_wave_barrier(); } while (0)
__host__ __device__ __forceinline__ int permd(int d) { return d < 8 ? 2 * d : (d < 16 ? 2 * (d - 8) + 1 : d); }
__device__ __forceinline__ int win_newcol(int n) {
    if (n < 512) return (n & ~63) + permd(n & 63);
    if (n < 640) return 1280 + 64 + (n - 512);
    if (n < 896) { const int m = n - 640; return 1024 + (m & ~63) + permd(m & 63); }
    if (n < 960) return 1280 + permd(n - 896);
    if (n < 964) return 1280 + 192 + (n - 960);
    if (n < 1476) return 2304 + (n - 964);
    if (n < 1988) { const int m = n - 1476; return 512 + (m & ~63) + permd(m & 63); }
    if (n < 2756) { const int m = n - 1988, kv = m >> 8, r = m & 255, base = 1536 + kv * 256; return r < 128 ? base + (r & ~63) + permd(r & 63) : base + r; }
    if (n < 2780) return 1280 + 196 + (n - 2756);
    return 2816 + (n - 2780);
}
__device__ __forceinline__ int map_row(int mode, int n) { return mode == 0 ? n : (mode == 1 ? ((n >> 7) << 8) + (n & 127) : (mode == 2 ? ((n >> 7) << 8) + 128 + (n & 127) : win_newcol(n))); }

struct Args { const float* in[24]; float* out; unsigned char* ws; int ph_lo, ph_hi; };

__device__ __forceinline__ int unperm(int p) { return p < 16 ? ((p & 1) ? (p >> 1) + 8 : (p >> 1)) : p; }
__device__ __forceinline__ void tr_item(const float* W, int K, int N, bf16* WT, int mode, LAS float* scr, int item, int lane, bool kperm = false) {
    const int nblk = (N + 31) >> 5, kb = item / nblk, nb = item - kb * nblk, k0 = 64 * kb, n0 = 32 * nb;
    const int nn = n0 + (lane & 31);
#pragma unroll 8
    for (int i = 0; i < 32; ++i) { const int kk = 2 * i + (lane >> 5); scr[kk * 33 + (lane & 31)] = nn < N ? W[(size_t)(k0 + kk) * N + nn] : 0.f; }
    LDS_WAIT(); asm volatile("" ::: "memory");
    const int c = lane & 7;
#pragma unroll
    for (int j = 0; j < 4; ++j) { const int n = (lane >> 3) + 8 * j; const LAS float* s = scr + n;
        int ks[8];
#pragma unroll
        for (int i = 0; i < 8; ++i) ks[i] = (kperm ? unperm(8 * c + i) : 8 * c + i) * 33;
        v4u o; o.x = pk2(s[ks[0]], s[ks[1]]); o.y = pk2(s[ks[2]], s[ks[3]]); o.z = pk2(s[ks[4]], s[ks[5]]); o.w = pk2(s[ks[6]], s[ks[7]]);
        if (n0 + n < N) *(v4u*)(WT + (size_t)map_row(mode, n0 + n) * K + k0 + 8 * c) = o; }
    LDS_WAIT(); asm volatile("" ::: "memory");
}
__device__ __forceinline__ void phase_convert(const Args& P, unsigned char* ws, int z, int l, LAS unsigned char* lds, int gw, int NGW, int lane, int wave) {
    asm volatile("" : "+v"(lane)); lane &= 63; asm volatile("" : "+s"(gw), "+s"(NGW));
    LAS float* scr = (LAS float*)(lds + wave * 16384);
    unsigned char* wb = ws + WS_W;
    constexpr int I_F = 16 * 88, I_D = 44 * 32, I_IN = 16 * 183, I_P = 8 * 32, I_O = 16 * 32;
    constexpr int I_C = 32 * 4;
    constexpr int NIT = 4 * I_F + 2 * I_D + I_IN + 3 * I_P + I_O + 2 * I_C;
    const size_t fo = (size_t)l * DM * FF;
    for (int it = gw; it < NIT; it += NGW) {
        int r = it, K = DM, N = FF, mode = 1; const float* W = P.in[3 + z] + fo; size_t wo = WO_GU1; bool kperm = false;
        if (r >= I_F) { r -= I_F; mode = 2; W = P.in[4 + z] + fo;
        if (r >= I_F) { r -= I_F; mode = 0; W = P.in[5 + z] + fo; K = FF; N = DM; wo = WO_D1;
        if (r >= I_D) { r -= I_D; mode = 1; W = P.in[20 + z] + fo; K = DM; N = FF; wo = WO_GU2;
        if (r >= I_F) { r -= I_F; mode = 2; W = P.in[21 + z] + fo;
        if (r >= I_F) { r -= I_F; mode = 0; W = P.in[22 + z] + fo; K = FF; N = DM; wo = WO_D2;
        if (r >= I_D) { r -= I_D; mode = 3; W = P.in[7 + z] + (size_t)l * DM * NIN; K = DM; N = NIN; wo = WO_IN;
        if (r >= I_IN) { r -= I_IN; mode = 0; W = P.in[15 + z] + (size_t)l * 512 * DM; K = 512; N = DM; wo = WO_PA;
        if (r >= I_P) { r -= I_P; W = P.in[16 + z] + (size_t)l * 512 * DM; wo = WO_PB;
        if (r >= I_P) { r -= I_P; W = P.in[17 + z] + (size_t)l * 512 * DM; wo = WO_PC;
        if (r >= I_P) { r -= I_P; W = P.in[18 + z] + (size_t)l * DM * DM; K = DM; wo = WO_OUT;
        if (r >= I_O) { r -= I_O; W = P.in[13 + z] + (size_t)(l * 2) * 2048 * 128; K = 2048; N = 128; wo = WO_CW1; kperm = true;
        if (r >= I_C) { r -= I_C; W += (size_t)2048 * 128; wo = WO_CW1 + 128 * 2048 * 2; kperm = false; } } } } } } } } } } } }
        tr_item(W, K, N, (bf16*)(wb + wo), mode, scr, r, lane, kperm);
    }
    {
        const int gt = gw * 64 + lane, GT = NGW * 64;
        bf16* ukv = (bf16*)(wb + WO_UKV); bf16* pool = (bf16*)(wb + WO_POOL); bf16* cw2 = (bf16*)(wb + WO_CW2); float* posb = (float*)(wb + WO_POSB);
        const float* w_ukv = P.in[9 + z] + (size_t)l * 128 * 128; const float* gn = P.in[8 + z] + l * 128;
        for (int i = gt; i < 128 * 128; i += GT) { const int np = i >> 7, k = i & 127, n = np < 64 ? unperm(np) : np; ukv[i] = (bf16)f2bf(gn[k] * w_ukv[k * 128 + n]); }
        const float* pw = P.in[10 + z] + (size_t)l * 4 * 128 * 128; const float* psc = P.in[11 + z] + l * 512;
        for (int i = gt; i < 4 * 128 * 128; i += GT) { const int g = i >> 14, d = (i >> 7) & 127, c = i & 127; pool[i] = (bf16)f2bf(pw[(g * 128 + c) * 128 + d] * psc[g * 128 + d]); }
        const float* w2 = P.in[14 + z] + (size_t)l * 2 * 128 * 64;
        for (int i = gt; i < 2 * 64 * 128; i += GT) { const int br = i >> 13, dp = (i >> 7) & 63, n = i & 127, d = br ? dp : unperm(dp); cw2[i] = (bf16)f2bf(w2[(br * 128 + n) * 64 + d]); }
        const float* w1 = P.in[13 + z] + (size_t)l * 2 * 2048 * 128; const float* pos = P.in[12 + z] + (size_t)l * 2 * 2048;
        for (int i = gt; i < 256; i += GT) { const int br = i >> 7, n = i & 127; float a = 0.f; for (int k = 0; k < 2048; ++k) a += pos[br * 2048 + k] * w1[((size_t)br * 2048 + k) * 128 + n]; posb[i] = a; }
    }
    if (gw < 36) { unsigned zz = 0u; asm volatile("" : "+v"(zz)); v4u z = {zz, zz, zz, zz}; v4u* rp = (v4u*)((bf16*)(wb + WO_IN) + (size_t)(1500 + gw) * DM); for (int i = lane; i < DM / 8; i += 64) rp[i] = z; }
}
__device__ __forceinline__ void phase_rope(const Args& P, unsigned char* ws, int z, int gtid, int gthreads) {
    float* rope = (float*)(ws + WS_ROPE);
    for (int idx = gtid; idx < M * 8; idx += gthreads) {
        const int row = idx >> 3, i = idx & 7;
        const double inv = pow(500000.0, -(double)i / 8.0), ang = (double)((const int*)P.in[1 + z])[row] * inv;
        double s, c; sincos(ang, &s, &c);
        rope[row * 16 + i] = (float)c; rope[row * 16 + 8 + i] = (float)s;
    }
}
__device__ __forceinline__ void norm_row_bf16(const float* xrow, const float* gain, bf16* orow, int lane) {
    const f32x4* xr = (const f32x4*)xrow + lane; const f32x4* gr = (const f32x4*)gain + lane;
    f32x4 v[4]; float s = 0.f;
#pragma unroll
    for (int j = 0; j < 4; ++j) { v[j] = xr[64 * j]; s += (v[j].x * v[j].x + v[j].y * v[j].y) + (v[j].z * v[j].z + v[j].w * v[j].w); }
    const float r = 1.0f / sqrtf(wave_sum(s) * (1.f / DM) + EPS);
    unsigned long long* o8 = (unsigned long long*)orow + lane;
#pragma unroll
    for (int j = 0; j < 4; ++j) { const f32x4 g = gr[64 * j]; o8[64 * j] = (unsigned long long)pk2(v[j].x * r * g.x, v[j].y * r * g.y) | ((unsigned long long)pk2(v[j].z * r * g.z, v[j].w * r * g.w) << 32); }
}
__device__ __forceinline__ void norm_row_f32(float* xrow, const float* gain, int lane) {
    f32x4* xr = (f32x4*)xrow + lane; const f32x4* gr = (const f32x4*)gain + lane;
    f32x4 v[4]; float s = 0.f;
#pragma unroll
    for (int j = 0; j < 4; ++j) { v[j] = xr[64 * j]; s += (v[j].x * v[j].x + v[j].y * v[j].y) + (v[j].z * v[j].z + v[j].w * v[j].w); }
    const float r = 1.0f / sqrtf(wave_sum(s) * (1.f / DM) + EPS);
#pragma unroll
    for (int j = 0; j < 4; ++j) { const f32x4 g = gr[64 * j]; xr[64 * j] = v[j] * r * g; }
}
__device__ __forceinline__ unsigned f2o(float s) { const unsigned b = __float_as_uint(s); return (b & 0x80000000u) ? ~b : (b | 0x80000000u); }
__device__ __forceinline__ void unpack8(const v4u v, float* f) { f[0] = bflo(v.x); f[1] = bfhi(v.x); f[2] = bflo(v.y); f[3] = bfhi(v.y); f[4] = bflo(v.z); f[5] = bfhi(v.z); f[6] = bflo(v.w); f[7] = bfhi(v.w); }
__device__ __forceinline__ void load_row64(const bf16* p, float* f) {
    const v4u* q = (const v4u*)p;
#pragma unroll
    for (int i = 0; i < 8; ++i) unpack8(q[i], f + 8 * i);
}
__device__ __forceinline__ float dot64(const LAS float* q, const float* k) {
    float d = 0.f;
#pragma unroll
    for (int i = 0; i < 16; ++i) { const f32x4 qq = *(const LAS f32x4*)(q + 4 * i); d += qq.x * k[4 * i] + qq.y * k[4 * i + 1] + qq.z * k[4 * i + 2] + qq.w * k[4 * i + 3]; }
    return d;
}
__device__ __forceinline__ void dsa_query(const Args& P, unsigned char* ws, int z, int row, LAS unsigned char* wl, int lane) {
    const int b = row >> 12, t = row & (SEQ - 1), n = t + 1;
    LAS unsigned* su = (LAS unsigned*)wl; LAS float* pb = (LAS float*)wl; LAS unsigned short* list = (LAS unsigned short*)(wl + 16384); LAS float* qb = (LAS float*)(wl + 16896);
    const bf16* misc = (const bf16*)(ws + WS_MISC);
    const unsigned long long lt = (1ull << lane) - 1ull;
    int nsel;
    if (n <= 256) { for (int i = lane; i < n; i += 64) list[i] = (unsigned short)i; nsel = n; }
    else {
        { const uint2 v = *(const uint2*)((const bf16*)(ws + WS_IQ) + (size_t)row * 256 + lane * 4); qb[lane * 4] = bflo(v.x); qb[lane * 4 + 1] = bfhi(v.x); qb[lane * 4 + 2] = bflo(v.y); qb[lane * 4 + 3] = bfhi(v.y); }
        float iw[4]; { const uint2 v = *(const uint2*)(misc + (size_t)row * 256 + 192); iw[0] = 0.5f * bflo(v.x); iw[1] = 0.5f * bfhi(v.x); iw[2] = 0.5f * bflo(v.y); iw[3] = 0.5f * bfhi(v.y); }
        WAVE_LDS_SYNC();
        const int nch = (n + 63) >> 6;
        for (int i = 0; i < nch; ++i) {
            const int key = i * 64 + lane; const bool valid = key <= t;
            float kf[64]; load_row64(misc + (size_t)(b * SEQ + (valid ? key : t)) * 256, kf);
            float s = 0.f;
#pragma unroll
            for (int h = 0; h < 4; ++h) s += iw[h] * fmaxf(dot64(qb + h * 64, kf), 0.f);
            su[key] = valid ? f2o(s) : 0u;
        }
        WAVE_LDS_SYNC();
        unsigned prefix = 0u;
        for (int bit = 31; bit >= 0; --bit) {
            const unsigned cand = prefix | (1u << bit); int c = 0;
            for (int i = 0; i < nch; ++i) c += (su[i * 64 + lane] >= cand) ? 1 : 0;
            c = wave_sum_i(c);
            if (c >= 256) prefix = cand;
            if (c == 256) break;
        }
        int cgt = 0;
        for (int i = 0; i < nch; ++i) cgt += (su[i * 64 + lane] > prefix) ? 1 : 0;
        const int need_eq = 256 - wave_sum_i(cgt);
        int base = 0, eq_taken = 0;
        for (int i = 0; i < nch; ++i) {
            const unsigned v = su[i * 64 + lane]; const bool gt = v > prefix, eq = v == prefix;
            const unsigned long long meq = __ballot(eq);
            const bool sel = gt || (eq && (eq_taken + __popcll(meq & lt)) < need_eq);
            const unsigned long long ms = __ballot(sel);
            if (sel) list[base + __popcll(ms & lt)] = (unsigned short)(i * 64 + lane);
            base += __popcll(ms); eq_taken += __popcll(meq);
        }
        nsel = 256;
    }
    { const v4u v = *(const v4u*)((const bf16*)(ws + WS_QA) + (size_t)row * 512 + lane * 8); float f[8]; unpack8(v, f);
#pragma unroll
      for (int e = 0; e < 8; ++e) qb[lane * 8 + e] = f[e]; }
    WAVE_LDS_SYNC();
    const bf16* kva = (const bf16*)(ws + WS_KVA);
    float s[8][4];
#pragma unroll
    for (int j = 0; j < 4; ++j) {
        const int slot = lane + 64 * j; const bool valid = slot < nsel; const int key = list[valid ? slot : 0];
        float kf[64]; load_row64(kva + (size_t)(b * SEQ + key) * 128, kf);
#pragma unroll
        for (int h = 0; h < 8; ++h) s[h][j] = valid ? dot64(qb + h * 64, kf) : NEGF;
    }
    float linv[8];
#pragma unroll
    for (int h = 0; h < 8; ++h) {
        const float m = wave_max(fmaxf(fmaxf(s[h][0], s[h][1]), fmaxf(s[h][2], s[h][3]))); float ls = 0.f;
#pragma unroll
        for (int j = 0; j < 4; ++j) { const float p = __expf(s[h][j] - m); ls += p; pb[h * 256 + lane + 64 * j] = p; }
        linv[h] = 1.0f / wave_sum(ls);
    }
    WAVE_LDS_SYNC();
    float acc[8] = {0.f, 0.f, 0.f, 0.f, 0.f, 0.f, 0.f, 0.f};
    for (int slot = 0; slot < nsel; ++slot) {
        const float v = bf2f(kva[(size_t)(b * SEQ + list[slot]) * 128 + 64 + lane]);
#pragma unroll
        for (int h = 0; h < 8; ++h) acc[h] += pb[h * 256 + slot] * v;
    }
    bf16* ya = (bf16*)(ws + WS_QA) + (size_t)row * 512;
#pragma unroll
    for (int h = 0; h < 8; ++h) ya[h * 64 + lane] = (bf16)f2bf(acc[h] * linv[h]);
    WAVE_LDS_SYNC();
}
typedef short s16x4 __attribute__((ext_vector_type(4)));
typedef short v4i16_t __attribute__((ext_vector_type(4)));
typedef float f32x4v __attribute__((ext_vector_type(4)));
typedef __bf16 bf16x2_t __attribute__((ext_vector_type(2)));
typedef float f32x2_t __attribute__((ext_vector_type(2)));
__device__ __forceinline__ unsigned cvtpk(float lo, float hi) { f32x2_t v = {lo, hi}; bf16x2_t b = __builtin_convertvector(v, bf16x2_t); return __builtin_bit_cast(unsigned, b); }
constexpr float L2E = 1.4426950408889634f;
#ifndef NSA_NOSKIP
#define NSA_NOSKIP 0
#endif
constexpr int NSA_KSTR = 72, NSA_VSTR = 80;
constexpr int NSA_KB = 64 * NSA_KSTR * 2, NSA_VB = 64 * NSA_VSTR * 2;
constexpr int NSA_OFF_K = 0, NSA_OFF_V = 2 * NSA_KB, NSA_OFF_IMPA = NSA_OFF_V + 2 * NSA_VB, NSA_OFF_IMPB = NSA_OFF_IMPA + 64 * 65 * 4, NSA_OFF_UM = NSA_OFF_IMPB + 64 * 65 * 4, NSA_LDS = NSA_OFF_UM + 64;
__device__ __forceinline__ s16x4 tr16(const LAS unsigned char* p) { return __builtin_bit_cast(s16x4, __builtin_amdgcn_ds_read_tr16_b64_v4i16((LAS v4i16_t*)p)); }
__device__ __forceinline__ bf16x8 cat4(s16x4 a, s16x4 b) { return __builtin_shufflevector(a, b, 0, 1, 2, 3, 4, 5, 6, 7); }
__device__ __forceinline__ bf16x8 pack8(float a0, float a1, float a2, float a3, float b0, float b1, float b2, float b3) {
    v4u w; w.x = pg8::cvt_pk_bf16(a0, a1); w.y = pg8::cvt_pk_bf16(a2, a3); w.z = pg8::cvt_pk_bf16(b0, b1); w.w = pg8::cvt_pk_bf16(b2, b3); return __builtin_bit_cast(bf16x8, w);
}
__device__ __forceinline__ float xmax16(float v) { v = fmaxf(v, __shfl_xor(v, 16)); return fmaxf(v, __shfl_xor(v, 32)); }
__device__ __forceinline__ float xsum16(float v) { v += __shfl_xor(v, 16); return v + __shfl_xor(v, 32); }

__device__ __forceinline__ void nsa_block(const LAS unsigned char* Kb, const LAS unsigned char* Vb, const bf16x8 (&qf)[2], bool sel, int klo, int khi, float& mrow, float& lrow, f32x4v (&o)[4], int lane) {
    const int j = lane & 15, gq = lane >> 4;
    f32x4v s[4];
#pragma unroll
    for (int kt = 0; kt < 4; ++kt) {
        s[kt] = (f32x4v){0.f, 0.f, 0.f, 0.f};
#pragma unroll
        for (int ks = 0; ks < 2; ++ks) {
            const bf16x8 kf = *(const LAS bf16x8*)(Kb + ((16 * kt + j) * NSA_KSTR + 8 * gq + 32 * ks) * 2);
            s[kt] = __builtin_amdgcn_mfma_f32_16x16x32_bf16(kf, qf[ks], s[kt], 0, 0, 0);
        }
    }
    float bm = NEGF;
#pragma unroll
    for (int kt = 0; kt < 4; ++kt)
#pragma unroll
        for (int e = 0; e < 4; ++e) { const int ko = 16 * kt + 4 * gq + e; const bool ok = sel && ko >= klo && ko <= khi; const float v = ok ? s[kt][e] * L2E : NEGF; s[kt][e] = v; bm = fmaxf(bm, v); }
    bm = xmax16(bm);
    const float mnew = fmaxf(mrow, bm), alpha = __builtin_amdgcn_exp2f(mrow - mnew);
    mrow = mnew;
    float ps = 0.f;
#pragma unroll
    for (int kt = 0; kt < 4; ++kt)
#pragma unroll
        for (int e = 0; e < 4; ++e) { const float p = __builtin_amdgcn_exp2f(s[kt][e] - mnew); s[kt][e] = p; ps += p; }
    lrow = lrow * alpha + ps;
#pragma unroll
    for (int dt = 0; dt < 4; ++dt) o[dt] *= alpha;
#pragma unroll
    for (int kk = 0; kk < 2; ++kk) {
        const bf16x8 pf = pack8(s[2 * kk][0], s[2 * kk][1], s[2 * kk][2], s[2 * kk][3], s[2 * kk + 1][0], s[2 * kk + 1][1], s[2 * kk + 1][2], s[2 * kk + 1][3]);
#pragma unroll
        for (int dt = 0; dt < 4; ++dt) {
            const LAS unsigned char* va = Vb + ((32 * kk + 4 * gq + (j >> 2)) * NSA_VSTR + 16 * dt + 4 * (j & 3)) * 2;
            const bf16x8 vf = cat4(tr16(va), tr16(va + 16 * NSA_VSTR * 2));
            o[dt] = __builtin_amdgcn_mfma_f32_16x16x32_bf16(vf, pf, o[dt], 0, 0, 0);
        }
    }
}
__device__ __forceinline__ void nsa_fetch(const bf16* kv, int b, int jb, int g, int tid, v4u& kr, v4u& vr) {
    const bf16* p = kv + (size_t)(b * SEQ + 64 * jb + (tid >> 3)) * 256 + g * 64 + (tid & 7) * 8;
    kr = *(const v4u*)p; vr = *(const v4u*)(p + 128);
}
__device__ __forceinline__ void nsa_stash(LAS unsigned char* Kb, LAS unsigned char* Vb, int tid, const v4u& kr, const v4u& vr) {
    *(LAS v4u*)(Kb + ((tid >> 3) * NSA_KSTR + (tid & 7) * 8) * 2) = kr; *(LAS v4u*)(Vb + ((tid >> 3) * NSA_VSTR + (tid & 7) * 8) * 2) = vr;
}
#if defined(PROBE_CMP)
__device__ __forceinline__ void nsa_probe_store(unsigned char* ws, int row, int head, int gq, const f32x4v (&v)[4]) {
    bf16* pb_ = (bf16*)(ws + 497 * MiB);
    for (int dt = 0; dt < 4; ++dt) { uint2 w; w.x = cvtpk(v[dt][0], v[dt][1]); w.y = cvtpk(v[dt][2], v[dt][3]); *(uint2*)(pb_ + (size_t)row * 512 + head * 64 + 16 * dt + 4 * gq) = w; }
}
#endif
__device__ __forceinline__ void nsa_unit(unsigned char* ws, int unit, LAS unsigned char* lds, int tid_in) {
    int tid = tid_in; asm volatile("" : "+v"(tid));
    const int lane = tid & 63, wave = __builtin_amdgcn_readfirstlane(tid >> 6), j = lane & 15, gq = lane >> 4;
    const int c = unit & 63, g = (unit >> 6) & 1, b = unit >> 7, bg = b * 2 + g;
    LAS float* impa = (LAS float*)(lds + NSA_OFF_IMPA); LAS float* impb = (LAS float*)(lds + NSA_OFF_IMPB);
    LAS unsigned long long* um = (LAS unsigned long long*)(lds + NSA_OFF_UM);
    for (int i = tid; i < 2 * 64 * 65; i += 512) impa[i] = 0.f;
    bf16* qc = (bf16*)(ws + WS_QC);
    const bf16* misc = (const bf16*)(ws + WS_MISC);
    bf16x8 qf[2][2]; float gate[2][3]; int trow[2];
#pragma unroll
    for (int rg = 0; rg < 2; ++rg) {
        const int q = 8 * wave + 4 * rg + (j >> 2), t = 64 * c + q, row = b * SEQ + t, head = g * 4 + (j & 3);
        trow[rg] = t;
#pragma unroll
        for (int ks = 0; ks < 2; ++ks) qf[rg][ks] = *(const bf16x8*)(qc + (size_t)row * 512 + head * 64 + 8 * gq + 32 * ks);
#pragma unroll
        for (int e = 0; e < 3; ++e) gate[rg][e] = __builtin_amdgcn_rcpf(1.0f + __expf(-bf2f(misc[(size_t)row * 256 + 196 + head * 3 + e])));
#ifdef BRMASK
        for (int e = 0; e < 3; ++e) if (!((BRMASK >> e) & 1)) gate[rg][e] = 0.f;
#endif
    }
    f32x4v otot[2][4];
    __syncthreads();
    const int nT = (c >> 2) + 1;
    const bf16* kc = (const bf16*)(ws + WS_KC) + (size_t)bg * 256 * 64; const bf16* vct = (const bf16*)(ws + WS_VC) + (size_t)bg * 64 * 256;
#pragma unroll
    for (int rg = 0; rg < 2; ++rg) {
        const int t = trow[rg], nv = t >= 31 ? ((t - 15) >> 4) : 0;
        f32x4v s[16]; float mx = NEGF;
#pragma unroll
        for (int T = 0; T < 16; ++T) {
            s[T] = (f32x4v){0.f, 0.f, 0.f, 0.f};
            if (T < nT) {
#pragma unroll
                for (int ks = 0; ks < 2; ++ks) { const bf16x8 kf = *(const bf16x8*)(kc + (size_t)(16 * T + j) * 64 + 8 * gq + 32 * ks); s[T] = __builtin_amdgcn_mfma_f32_16x16x32_bf16(kf, qf[rg][ks], s[T], 0, 0, 0); }
#pragma unroll
                for (int e = 0; e < 4; ++e) { const float v = (16 * T + 4 * gq + e < nv) ? s[T][e] * L2E : NEGF; s[T][e] = v; mx = fmaxf(mx, v); }
            }
        }
        mx = xmax16(mx);
        float ls = 0.f;
#pragma unroll
        for (int T = 0; T < 16; ++T) if (T < nT) {
#pragma unroll
            for (int e = 0; e < 4; ++e) { const float p = (16 * T + 4 * gq + e < nv) ? __builtin_amdgcn_exp2f(s[T][e] - mx) : 0.f; s[T][e] = p; ls += p; }
        }
        ls = xsum16(ls);
        const float inv = nv > 0 ? __builtin_amdgcn_rcpf(ls) : 0.f;
        const int q = 8 * wave + 4 * rg + (j >> 2);
#pragma unroll
        for (int T = 0; T < 16; ++T) if (T < nT) {
#pragma unroll
            for (int e = 0; e < 4; ++e) s[T][e] *= inv;
            float a = s[T][0] + s[T][1] + s[T][2] + 0.5f * s[T][3], bb = 0.5f * s[T][3];
            a += __shfl_xor(a, 1); a += __shfl_xor(a, 2); bb += __shfl_xor(bb, 1); bb += __shfl_xor(bb, 2);
            if ((j & 3) == 0) { impa[q * 65 + 4 * T + gq] = a; impb[q * 65 + 4 * T + gq + 1] = bb; }
        }
        f32x4v oc[4];
#pragma unroll
        for (int dt = 0; dt < 4; ++dt) oc[dt] = (f32x4v){0.f, 0.f, 0.f, 0.f};
#pragma unroll
        for (int kk = 0; kk < 8; ++kk) if (2 * kk < nT) {
            const bf16x8 pf = pack8(s[2 * kk][0], s[2 * kk][1], s[2 * kk][2], s[2 * kk][3], s[2 * kk + 1][0], s[2 * kk + 1][1], s[2 * kk + 1][2], s[2 * kk + 1][3]);
#pragma unroll
            for (int dt = 0; dt < 4; ++dt) {
                const bf16* vp = vct + (size_t)(16 * dt + j) * 256 + 32 * kk + 4 * gq;
                const s16x4 v0 = *(const s16x4*)vp, v1 = *(const s16x4*)(vp + 16);
                oc[dt] = __builtin_amdgcn_mfma_f32_16x16x32_bf16(cat4(v0, v1), pf, oc[dt], 0, 0, 0);
            }
        }
#pragma unroll
        for (int dt = 0; dt < 4; ++dt) otot[rg][dt] = oc[dt] * gate[rg][0];
        __builtin_amdgcn_sched_barrier(0);
#if defined(PROBE_CMP)
        if (PROBE_BR == 0) nsa_probe_store(ws, b * SEQ + trow[rg], g * 4 + (j & 3), gq, otot[rg]);
#endif
    }
    __syncthreads();
    unsigned long long smask[8], mymask = 0ull;
#pragma unroll
    for (int qi = 0; qi < 8; ++qi) {
        const int q = 8 * wave + qi;
#if PROBE == 4
        const float imp = ((const float*)(ws + 500 * MiB))[((size_t)(b * SEQ + 64 * c + q) * 2 + g) * 64 + lane];
#else
        const float imp = impa[q * 65 + lane] + impb[q * 65 + lane];
#endif
#if PROBE && (PROBE != 5 || defined(PROBE5_IMP))
        ((float*)(ws + 516 * MiB))[((size_t)(b * SEQ + 64 * c + q) * 2 + g) * 64 + lane] = (lane <= c) ? imp : 0.f;
#endif
        const bool forced = (lane == 0) || (lane == c), adm = lane <= c;
        unsigned key = forced ? (0xFFFFFF00u | (unsigned)(63 - lane)) : (adm ? ((__float_as_uint(imp) & 0xFFFFFFC0u) | (unsigned)(63 - lane)) : 0u);
        unsigned long long mk = 0ull;
#if TOP8_RANK
        { int rank = 0;
#pragma unroll
          for (int jj = 0; jj < 64; ++jj) { const unsigned kk = (unsigned)__builtin_amdgcn_readlane((int)key, jj); rank += (kk > key) ? 1 : 0; }
          mk = __ballot(key != 0u && rank < 8); }
#else
        for (int k = 0; k < 8; ++k) { const unsigned mx = wave_max_u(key); if (mx == 0u) break; const int win = 63 - (int)(mx & 63u); mk |= 1ull << win; if (lane == win) key = 0u; }
#endif
        mk = ((unsigned long long)__builtin_amdgcn_readfirstlane((unsigned)(mk >> 32)) << 32) | (unsigned long long)__builtin_amdgcn_readfirstlane((unsigned)mk);
#ifdef FIXSEL
        { mk = 1ull | (1ull << c); for (int d = 1; d <= 6; ++d) mk |= 1ull << (((FIXHOM ? 0 : q * 7) + d * 5) % (c + 1)); }
#endif
#if PROBE == 2
        mk = ((const unsigned long long*)(ws + 496 * MiB))[(size_t)(b * SEQ + 64 * c + q) * 2 + g];
        mk = ((unsigned long long)__builtin_amdgcn_readfirstlane((unsigned)(mk >> 32)) << 32) | (unsigned long long)__builtin_amdgcn_readfirstlane((unsigned)mk);
#endif
#if PROBE == 5
        if (lane == 0) ((unsigned long long*)(ws + 498 * MiB))[(size_t)(b * SEQ + 64 * c + q) * 2 + g] = mk;
#endif
#if PROBE == 5 && !defined(PROBE5_IMP)
        ((float*)(ws + 516 * MiB))[((size_t)(b * SEQ + 64 * c + q) * 2 + g) * 64 + lane] = ((mk >> lane) & 1ull) ? 1.f : 0.f;
#endif
        smask[qi] = mk; mymask |= mk;
    }
    if (lane == 0) um[wave] = mymask;
    __syncthreads();
    unsigned long long umask = 0ull;
#pragma unroll
    for (int w = 0; w < 8; ++w) umask |= um[w];
    umask = ((unsigned long long)__builtin_amdgcn_readfirstlane((unsigned)(umask >> 32)) << 32) | (unsigned long long)__builtin_amdgcn_readfirstlane((unsigned)umask);
    unsigned long long rmask[2];
    { LAS unsigned long long* qm = (LAS unsigned long long*)(lds + NSA_OFF_IMPA);
      __syncthreads();
#pragma unroll
      for (int qi = 0; qi < 8; ++qi) if (lane == 0) qm[8 * wave + qi] = smask[qi];
      __syncthreads();
#pragma unroll
      for (int rg = 0; rg < 2; ++rg) rmask[rg] = qm[8 * wave + 4 * rg + (j >> 2)]; }
    const unsigned long long gmask[2] = {smask[0] | smask[1] | smask[2] | smask[3], smask[4] | smask[5] | smask[6] | smask[7]};
    const bf16* kvs = (const bf16*)(ws + WS_KVS); const bf16* kvw = (const bf16*)(ws + WS_KVW);
    LAS unsigned char* Kb = lds + NSA_OFF_K; LAS unsigned char* Vb = lds + NSA_OFF_V;
    {
        float mrow[2] = {NEGF, NEGF}, lrow[2] = {0.f, 0.f}; f32x4v o[2][4];
#pragma unroll
        for (int rg = 0; rg < 2; ++rg)
#pragma unroll
            for (int dt = 0; dt < 4; ++dt) o[rg][dt] = (f32x4v){0.f, 0.f, 0.f, 0.f};
        unsigned long long rem = umask; int buf = 0;
        v4u kr, vr; int jb = (int)__builtin_ctzll(rem); rem &= rem - 1ull;
        nsa_fetch(kvs, b, jb, g, tid, kr, vr); nsa_stash(Kb, Vb, tid, kr, vr);
        __syncthreads();
        for (;;) {
            const bool more = rem != 0ull; const int jn = more ? (int)__builtin_ctzll(rem) : jb; rem &= rem - 1ull;
            if (more) nsa_fetch(kvs, b, jn, g, tid, kr, vr);
#pragma unroll
            for (int rg = 0; rg < 2; ++rg) if (NSA_NOSKIP || ((gmask[rg] >> jb) & 1ull)) {
                const bool sel = (rmask[rg] >> jb) & 1ull; const int khi = (jb == c) ? (trow[rg] & 63) : 63;
                nsa_block(Kb + buf * NSA_KB, Vb + buf * NSA_VB, qf[rg], sel, 0, khi, mrow[rg], lrow[rg], o[rg], lane);
            }
            if (!more) break;
#ifdef NSA_XSYNC
            __syncthreads();
#endif
            nsa_stash(Kb + (buf ^ 1) * NSA_KB, Vb + (buf ^ 1) * NSA_VB, tid, kr, vr);
            __syncthreads();
            buf ^= 1; jb = jn;
        }
#pragma unroll
        for (int rg = 0; rg < 2; ++rg) { const float sc = gate[rg][1] * __builtin_amdgcn_rcpf(xsum16(lrow[rg]));
#pragma unroll
            for (int dt = 0; dt < 4; ++dt) otot[rg][dt] += o[rg][dt] * sc;
#if defined(PROBE_CMP)
            if (PROBE_BR == 1) { f32x4v t_[4]; for (int dt = 0; dt < 4; ++dt) t_[dt] = o[rg][dt] * sc; nsa_probe_store(ws, b * SEQ + trow[rg], g * 4 + (j & 3), gq, t_); }
#endif
            }
        __syncthreads();
    }
    {
        float mrow[2] = {NEGF, NEGF}, lrow[2] = {0.f, 0.f}; f32x4v o[2][4];
#pragma unroll
        for (int rg = 0; rg < 2; ++rg)
#pragma unroll
            for (int dt = 0; dt < 4; ++dt) o[rg][dt] = (f32x4v){0.f, 0.f, 0.f, 0.f};
        int jb = c - 4 > 0 ? c - 4 : 0, buf = 0; v4u kr, vr;
        nsa_fetch(kvw, b, jb, g, tid, kr, vr); nsa_stash(Kb, Vb, tid, kr, vr);
        __syncthreads();
        for (;;) {
            const bool more = jb < c;
            if (more) nsa_fetch(kvw, b, jb + 1, g, tid, kr, vr);
#pragma unroll
            for (int rg = 0; rg < 2; ++rg) {
                const int o6 = trow[rg] & 63;
                const int klo = (jb == c - 4) ? o6 + 1 : 0, khi = (jb == c) ? o6 : 63;
                nsa_block(Kb + buf * NSA_KB, Vb + buf * NSA_VB, qf[rg], true, klo, khi, mrow[rg], lrow[rg], o[rg], lane);
            }
            if (!more) break;
            nsa_stash(Kb + (buf ^ 1) * NSA_KB, Vb + (buf ^ 1) * NSA_VB, tid, kr, vr);
            __syncthreads();
            buf ^= 1; ++jb;
        }
#pragma unroll
        for (int rg = 0; rg < 2; ++rg) { const float sc = gate[rg][2] * __builtin_amdgcn_rcpf(xsum16(lrow[rg]));
#pragma unroll
            for (int dt = 0; dt < 4; ++dt) otot[rg][dt] += o[rg][dt] * sc;
#if defined(PROBE_CMP)
            if (PROBE_BR == 2) { f32x4v t_[4]; for (int dt = 0; dt < 4; ++dt) t_[dt] = o[rg][dt] * sc; nsa_probe_store(ws, b * SEQ + trow[rg], g * 4 + (j & 3), gq, t_); }
#endif
            }
    }
#pragma unroll
    for (int rg = 0; rg < 2; ++rg) {
        const int row = b * SEQ + trow[rg], head = g * 4 + (j & 3);
#pragma unroll
        for (int dt = 0; dt < 4; ++dt) {
            uint2 w; w.x = pg8::cvt_pk_bf16(otot[rg][dt][0], otot[rg][dt][1]); w.y = pg8::cvt_pk_bf16(otot[rg][dt][2], otot[rg][dt][3]);
            *(uint2*)(qc + (size_t)row * 512 + head * 64 + 16 * dt + 4 * gq) = w;
        }
    }
    __syncthreads();
}
__device__ __forceinline__ void prep_kva16(unsigned char* ws, int task, int lane) {
    const int j = lane & 15, gq = lane >> 4, row = task * 16 + j;
    const bf16* misc = (const bf16*)(ws + WS_MISC) + (size_t)row * 256 + 64;
    const bf16* wu = (const bf16*)(ws + WS_W + WO_UKV);
    bf16x8 cf[4]; float ss = 0.f;
#pragma unroll
    for (int ks = 0; ks < 4; ++ks) { const v4u v = *(const v4u*)(misc + 8 * gq + 32 * ks); cf[ks] = __builtin_bit_cast(bf16x8, v); float f[8]; unpack8(v, f);
#pragma unroll
        for (int e = 0; e < 8; ++e) ss += f[e] * f[e]; }
    ss = xsum16(ss);
    const float r = 1.0f / sqrtf(ss * (1.f / 128.f) + EPS);
    const float* rp = (const float*)(ws + WS_ROPE) + (size_t)row * 16;
    bf16* o = (bf16*)(ws + WS_KVA) + (size_t)row * 128;
#pragma unroll
    for (int ct = 0; ct < 8; ++ct) {
        f32x4v a = {0.f, 0.f, 0.f, 0.f};
#pragma unroll
        for (int ks = 0; ks < 4; ++ks) { const bf16x8 wf = *(const bf16x8*)(wu + (size_t)(16 * ct + j) * 128 + 8 * gq + 32 * ks); a = __builtin_amdgcn_mfma_f32_16x16x32_bf16(wf, cf[ks], a, 0, 0, 0); }
        a *= r;
        if (ct == 0) {
            const float c0 = rp[2 * gq], s0 = rp[8 + 2 * gq], c1 = rp[2 * gq + 1], s1 = rp[8 + 2 * gq + 1];
            const float x0 = a[0], x1 = a[1], x2 = a[2], x3 = a[3];
            a[0] = x0 * c0 - x1 * s0; a[1] = x1 * c0 + x0 * s0; a[2] = x2 * c1 - x3 * s1; a[3] = x3 * c1 + x2 * s1;
        }
        uint2 w; w.x = cvtpk(a[0], a[1]); w.y = cvtpk(a[2], a[3]);
        *(uint2*)(o + 16 * ct + 4 * gq) = w;
    }
}
__device__ __forceinline__ void prep_pool16(unsigned char* ws, int task, int lane) {
    const int j = lane & 15, gq = lane >> 4, row = task * 16 + j, t = row & (SEQ - 1);
    const bf16* bu = (const bf16*)(ws + WS_BU);
    const bf16* pw = (const bf16*)(ws + WS_W + WO_POOL);
    bf16* yb = (bf16*)(ws + WS_YB) + (size_t)row * 512;
#pragma unroll 1
    for (int g = 0; g < 4; ++g) {
        const int w = 2 << g, lo = (t + 1 - w) > 0 ? (t + 1 - w) : 0, cnt = t + 1 - lo; const float inv = 1.0f / (float)cnt;
        bf16x8 pf[4];
#pragma unroll
        for (int ks = 0; ks < 4; ++ks) {
            const bf16* p = bu + (size_t)row * 512 + g * 128 + 8 * gq + 32 * ks;
            float sum[8] = {0.f, 0.f, 0.f, 0.f, 0.f, 0.f, 0.f, 0.f}, cur[8];
            { const v4u v = *(const v4u*)p; unpack8(v, cur);
#pragma unroll
              for (int e = 0; e < 8; ++e) sum[e] = cur[e]; }
#pragma unroll 2
            for (int i = 1; i < w; ++i) { const bool ok = i < cnt; const v4u v = *(const v4u*)(p - (size_t)(ok ? i : 0) * 512); float f[8]; unpack8(v, f);
#pragma unroll
                for (int e = 0; e < 8; ++e) sum[e] += ok ? f[e] : 0.f; }
            __builtin_amdgcn_sched_barrier(0);
            pf[ks] = pack8(sum[0] * inv - cur[0], sum[1] * inv - cur[1], sum[2] * inv - cur[2], sum[3] * inv - cur[3], sum[4] * inv - cur[4], sum[5] * inv - cur[5], sum[6] * inv - cur[6], sum[7] * inv - cur[7]);
        }
#pragma unroll
        for (int dt = 0; dt < 8; ++dt) {
            f32x4v a = {0.f, 0.f, 0.f, 0.f};
#pragma unroll
            for (int ks = 0; ks < 4; ++ks) {
#if POOLDBG == 1
                bf16x8 wf; for (int e = 0; e < 8; ++e) wf[e] = (short)0x3c00;
#else
                const bf16x8 wf = *(const bf16x8*)(pw + (size_t)(g * 128 + 16 * dt + j) * 128 + 8 * gq + 32 * ks);
#endif
#if POOLDBG == 2
                bf16x8 pz; for (int e = 0; e < 8; ++e) pz[e] = (short)0x3c00; a = __builtin_amdgcn_mfma_f32_16x16x32_bf16(wf, pz, a, 0, 0, 0);
#else
                a = __builtin_amdgcn_mfma_f32_16x16x32_bf16(wf, pf[ks], a, 0, 0, 0);
#endif
            }
            uint2 wv; wv.x = cvtpk(a[0], a[1]); wv.y = cvtpk(a[2], a[3]);
            *(uint2*)(yb + g * 128 + 16 * dt + 4 * gq) = wv;
        }
    }
}
__device__ __forceinline__ float gelu_tanh_f(float x) { const float u = 0.7978845608028654f * (x + 0.044715f * x * x * x); const float e = __expf(2.0f * u); return 0.5f * x * (1.0f + (1.0f - 2.0f / (e + 1.0f))); }
__device__ __forceinline__ void prep_cmp16(unsigned char* ws, int task, int lane) {
    const int j = lane & 15, gq = lane >> 4;
    const int i0 = (task & 15) * 16, bg = (task >> 4) & 15, br = task >> 8, b = bg >> 1, g = bg & 1, i = i0 + j;
    const bf16* kvc = (const bf16*)(ws + WS_KVC);
    const bf16* w1 = (const bf16*)(ws + WS_W + WO_CW1) + (size_t)br * 128 * 2048;
    const bf16* w2 = (const bf16*)(ws + WS_W + WO_CW2) + (size_t)br * 64 * 128;
    const float* posb = (const float*)(ws + WS_W + WO_POSB) + br * 128;
    f32x4v h[8];
#pragma unroll
    for (int nt = 0; nt < 8; ++nt) h[nt] = (f32x4v){0.f, 0.f, 0.f, 0.f};
#pragma unroll 2
    for (int ks = 0; ks < 64; ++ks) {
        const int l = ks >> 1; int tok = 16 * i + l; tok = tok > SEQ - 1 ? SEQ - 1 : tok;
        const bf16x8 ff = *(const bf16x8*)(kvc + (size_t)(b * SEQ + tok) * 256 + br * 128 + g * 64 + 32 * (ks & 1) + 8 * gq);
#pragma unroll
        for (int nt = 0; nt < 8; ++nt) { const bf16x8 wf = *(const bf16x8*)(w1 + (size_t)(16 * nt + j) * 2048 + 32 * ks + 8 * gq); h[nt] = __builtin_amdgcn_mfma_f32_16x16x32_bf16(wf, ff, h[nt], 0, 0, 0); }
    }
#pragma unroll
    for (int nt = 0; nt < 8; ++nt) { const f32x4v pbv = *(const f32x4v*)(posb + 16 * nt + 4 * gq);
#pragma unroll
        for (int e = 0; e < 4; ++e) h[nt][e] = gelu_tanh_f(h[nt][e] + pbv[e]); }
    f32x4v o[4];
#pragma unroll
    for (int dt = 0; dt < 4; ++dt) o[dt] = (f32x4v){0.f, 0.f, 0.f, 0.f};
#pragma unroll
    for (int kk = 0; kk < 4; ++kk) {
        const bf16x8 hf = pack8(h[2 * kk][0], h[2 * kk][1], h[2 * kk][2], h[2 * kk][3], h[2 * kk + 1][0], h[2 * kk + 1][1], h[2 * kk + 1][2], h[2 * kk + 1][3]);
#pragma unroll
        for (int dt = 0; dt < 4; ++dt) { const bf16* wp = w2 + (size_t)(16 * dt + j) * 128 + 32 * kk + 4 * gq; const s16x4 v0 = *(const s16x4*)wp, v1 = *(const s16x4*)(wp + 16);
            o[dt] = __builtin_amdgcn_mfma_f32_16x16x32_bf16(cat4(v0, v1), hf, o[dt], 0, 0, 0); }
    }
    const bool dead = i == 255;
    if (br == 0) { bf16* kc = (bf16*)(ws + WS_KC) + ((size_t)bg * 256 + i) * 64;
#pragma unroll
        for (int dt = 0; dt < 4; ++dt) { uint2 w; w.x = dead ? 0u : cvtpk(o[dt][0], o[dt][1]); w.y = dead ? 0u : cvtpk(o[dt][2], o[dt][3]); *(uint2*)(kc + 16 * dt + 4 * gq) = w; }
    } else { bf16* vct = (bf16*)(ws + WS_VC) + (size_t)bg * 64 * 256 + i;
#pragma unroll
        for (int dt = 0; dt < 4; ++dt)
#pragma unroll
            for (int e = 0; e < 4; ++e) vct[(size_t)(16 * dt + 4 * gq + e) * 256] = dead ? (bf16)0 : (bf16)f2bf(o[dt][e]);
    }
}
__device__ __forceinline__ void phase_prep(const Args& P, unsigned char* ws, int z, int l, LAS unsigned char* lds, int gw, int NGW, int lane, int wave) {
    asm volatile("" : "+v"(lane)); lane &= 63; asm volatile("" : "+s"(gw), "+s"(NGW));
    for (int it = gw; it < 512; it += NGW) prep_cmp16(ws, it, lane);
    for (int it = gw; it < M / 16; it += NGW) { prep_kva16(ws, it, lane); prep_pool16(ws, it, lane); }
}
constexpr int DSA_OFF_CNT = 0, DSA_OFF_PC = 1024, DSA_OFF_LIST = DSA_OFF_PC + 32 * 16 * 4, DSA_OFF_V = DSA_OFF_LIST + 16 * 256 * 2, DSA_VB = 64 * NSA_VSTR * 2, DSA_LDS = DSA_OFF_V + 8 * DSA_VB;
#define DSA_FOR_TILES(...) _Pragma("unroll") for (int G8 = 0; G8 < 4; ++G8) { if (G8 < ngrp) { _Pragma("unroll") for (int T8 = 0; T8 < 8; ++T8) { const int T = G8 * 8 + T8; __VA_ARGS__ } } }
__device__ __forceinline__ void cnt_ge(int& c, unsigned u, unsigned cand) { asm volatile("v_cmp_ge_u32_e32 vcc, %1, %2\n\tv_addc_co_u32_e32 %0, vcc, 0, %0, vcc" : "+v"(c) : "v"(u), "v"(cand) : "vcc"); }
__device__ __forceinline__ void cnt_gt(int& c, unsigned u, unsigned cand) { asm volatile("v_cmp_gt_u32_e32 vcc, %1, %2\n\tv_addc_co_u32_e32 %0, vcc, 0, %0, vcc" : "+v"(c) : "v"(u), "v"(cand) : "vcc"); }
__device__ __forceinline__ void cnt_le(int& c, unsigned u, unsigned cand) { asm volatile("v_cmp_le_u32_e32 vcc, %1, %2\n\tv_addc_co_u32_e32 %0, vcc, 0, %0, vcc" : "+v"(c) : "v"(u), "v"(cand) : "vcc"); }
__device__ __forceinline__ int dsa_total(LAS unsigned* cnt, int par, int wave, int j, int gq, int c) {
    c += __shfl_xor(c, 16); c += __shfl_xor(c, 32);
    if (gq == 0) cnt[(par * 8 + wave) * 16 + j] = (unsigned)c;
    __syncthreads();
    int tot = 0;
#pragma unroll
    for (int w = 0; w < 8; ++w) tot += (int)cnt[(par * 8 + w) * 16 + j];
    return tot;
}
__device__ __forceinline__ void dsa_unit(unsigned char* ws, int unit, LAS unsigned char* lds, int tid_in) {
    int tid = tid_in; asm volatile("" : "+v"(tid));
    const int lane = tid & 63, wave = __builtin_amdgcn_readfirstlane(tid >> 6), j = lane & 15, gq = lane >> 4;
    const int b = unit >> 8, q0 = (unit & 255) * 16, t = q0 + j, row = b * SEQ + t;
    LAS unsigned* cnt = (LAS unsigned*)(lds + DSA_OFF_CNT); LAS unsigned* pc = (LAS unsigned*)(lds + DSA_OFF_PC);
    LAS unsigned short* list = (LAS unsigned short*)(lds + DSA_OFF_LIST);
    const bf16* misc = (const bf16*)(ws + WS_MISC);
    if (q0 >= 256) {
        const int ntiles = (q0 >> 4) + 1;
        const int ntl = wave < ntiles ? ((ntiles - 1 - wave) >> 3) + 1 : 0;
        const int ngrp = (ntl + 7) >> 3;
        bf16x8 qf[4][2]; float iw[4];
        { const bf16* iq = (const bf16*)(ws + WS_IQ) + (size_t)row * 256;
#pragma unroll
          for (int h = 0; h < 4; ++h) { iw[h] = 0.5f * bf2f(misc[(size_t)row * 256 + 192 + h]);
#pragma unroll
              for (int ks = 0; ks < 2; ++ks) qf[h][ks] = *(const bf16x8*)(iq + h * 64 + 8 * gq + 32 * ks); } }
        unsigned u[32][4];
#pragma unroll
        for (int T = 0; T < 32; ++T)
#pragma unroll
            for (int e = 0; e < 4; ++e) u[T][e] = 0u;
        const int kb0 = 16 * wave + 4 * gq;
        DSA_FOR_TILES(
            const bf16* kp = misc + (size_t)(b * SEQ + 16 * wave + 128 * T + j) * 256 + 8 * gq;
            const bf16x8 kf0 = *(const bf16x8*)kp; const bf16x8 kf1 = *(const bf16x8*)(kp + 32);
            float sc[4] = {0.f, 0.f, 0.f, 0.f};
            _Pragma("unroll") for (int h = 0; h < 4; ++h) {
                f32x4v a = {0.f, 0.f, 0.f, 0.f};
                a = __builtin_amdgcn_mfma_f32_16x16x32_bf16(kf0, qf[h][0], a, 0, 0, 0);
                a = __builtin_amdgcn_mfma_f32_16x16x32_bf16(kf1, qf[h][1], a, 0, 0, 0);
                _Pragma("unroll") for (int e = 0; e < 4; ++e) sc[e] += iw[h] * fmaxf(a[e], 0.f);
                asm volatile("" : "+v"(sc[0]), "+v"(sc[1]), "+v"(sc[2]), "+v"(sc[3]));
            }
            _Pragma("unroll") for (int e = 0; e < 4; ++e) { unsigned x = f2o(sc[e]); asm volatile("" : "+v"(x)); u[T][e] = (kb0 + 128 * T + e <= t) ? x : 0u; }
            if ((T8 & 1) == 1) __builtin_amdgcn_sched_barrier(0);
        )
        unsigned prefix = 0u; bool exact = false; int par = 0;
#pragma unroll 1
        for (int bit = 31; bit >= 0; --bit) {
            const unsigned cand = prefix | (1u << bit); int c0 = 0, c1 = 0;
            DSA_FOR_TILES(cnt_ge(c0, u[T][0], cand); cnt_ge(c1, u[T][1], cand); cnt_ge(c0, u[T][2], cand); cnt_ge(c1, u[T][3], cand);)
            const int tot = dsa_total(cnt, par, wave, j, gq, c0 + c1); par ^= 1;
            if (!exact && tot >= 256) { prefix = cand; exact = (tot == 256); }
            if (__all(exact)) break;
        }
        const bool alle = __all(exact);
        DSA_FOR_TILES(_Pragma("unroll") for (int e = 0; e < 4; ++e) { const unsigned x = u[T][e]; u[T][e] = (x > prefix || (exact && x == prefix)) ? 0u : (x == prefix ? (unsigned)(1 + kb0 + 128 * T + e) : 0xFFFFFFFFu); })
        unsigned kp = 0u;
        if (!alle) {
#pragma unroll 1
            for (int bit = 11; bit >= 0; --bit) {
                const unsigned cand = kp | (1u << bit); int c0 = 0, c1 = 0;
                DSA_FOR_TILES(cnt_le(c0, u[T][0], cand); cnt_le(c1, u[T][1], cand); cnt_le(c0, u[T][2], cand); cnt_le(c1, u[T][3], cand);)
                const int tot = dsa_total(cnt, par, wave, j, gq, c0 + c1); par ^= 1;
                if (tot <= 255) kp = cand;
            }
        }
        const unsigned kp1 = kp + 1u;
        int ns0 = 0, ns1 = 0;
        DSA_FOR_TILES(cnt_le(ns0, u[T][0], kp1); cnt_le(ns1, u[T][1], kp1); cnt_le(ns0, u[T][2], kp1); cnt_le(ns1, u[T][3], kp1);)
        pc[(wave * 4 + gq) * 16 + j] = (unsigned)(ns0 + ns1);
        __syncthreads();
        int base = 0;
        for (int i = 0; i < wave * 4 + gq; ++i) base += (int)pc[i * 16 + j];
        DSA_FOR_TILES(_Pragma("unroll") for (int e = 0; e < 4; ++e) { if (u[T][e] <= kp1) { if (base < 256) list[j * 256 + base] = (unsigned short)(kb0 + 128 * T + e); ++base; } })
    } else {
        for (int i = tid; i < 16 * 256; i += 512) list[i] = (unsigned short)(i & 255);
    }
    __syncthreads();
    const bf16* kva = (const bf16*)(ws + WS_KVA);
    bf16* qa = (bf16*)(ws + WS_QA);
    LAS unsigned char* Vb = lds + DSA_OFF_V + wave * DSA_VB;
#pragma unroll 1
    for (int qq = 0; qq < 2; ++qq) {
        const int ql = 2 * wave + qq, tq = q0 + ql, rowq = b * SEQ + tq, nsel = tq + 1 < 256 ? tq + 1 : 256;
        bf16x8 qf[2];
#pragma unroll
        for (int ks = 0; ks < 2; ++ks) { qf[ks] = (bf16x8){0, 0, 0, 0, 0, 0, 0, 0}; if (j < 8) qf[ks] = *(const bf16x8*)(qa + (size_t)rowq * 512 + j * 64 + 8 * gq + 32 * ks); }
        f32x4v s[16]; float mx = NEGF;
#pragma unroll
        for (int kt = 0; kt < 16; ++kt) {
            const int slot = 16 * kt + j; const int key = list[ql * 256 + (slot < nsel ? slot : 0)];
            const bf16* kp2 = kva + (size_t)(b * SEQ + key) * 128 + 8 * gq;
            const bf16x8 kf0 = *(const bf16x8*)kp2, kf1 = *(const bf16x8*)(kp2 + 32);
            f32x4v a = {0.f, 0.f, 0.f, 0.f};
            a = __builtin_amdgcn_mfma_f32_16x16x32_bf16(kf0, qf[0], a, 0, 0, 0);
            a = __builtin_amdgcn_mfma_f32_16x16x32_bf16(kf1, qf[1], a, 0, 0, 0);
#pragma unroll
            for (int e = 0; e < 4; ++e) { const float v = (16 * kt + 4 * gq + e < nsel) ? a[e] * L2E : NEGF; a[e] = v; mx = fmaxf(mx, v); }
            s[kt] = a;
        }
        mx = xmax16(mx);
        float ls = 0.f;
#pragma unroll
        for (int kt = 0; kt < 16; ++kt)
#pragma unroll
            for (int e = 0; e < 4; ++e) { const float p = __builtin_amdgcn_exp2f(s[kt][e] - mx); s[kt][e] = p; ls += p; }
        ls = xsum16(ls);
        f32x4v o[4];
#pragma unroll
        for (int dt = 0; dt < 4; ++dt) o[dt] = (f32x4v){0.f, 0.f, 0.f, 0.f};
#pragma unroll
        for (int ch = 0; ch < 4; ++ch) {
            v4u vr[8];
#pragma unroll
            for (int i = 0; i < 8; ++i) { const int slot = 64 * ch + 8 * i + (lane >> 3); const int key = list[ql * 256 + (slot < nsel ? slot : 0)];
                vr[i] = *(const v4u*)(kva + (size_t)(b * SEQ + key) * 128 + 64 + (lane & 7) * 8); }
#pragma unroll
            for (int i = 0; i < 8; ++i) *(LAS v4u*)(Vb + ((8 * i + (lane >> 3)) * NSA_VSTR + (lane & 7) * 8) * 2) = vr[i];
            WAVE_LDS_SYNC();
#pragma unroll
            for (int kk = 0; kk < 2; ++kk) {
                const int k4 = 4 * ch + 2 * kk;
                const bf16x8 pf = pack8(s[k4][0], s[k4][1], s[k4][2], s[k4][3], s[k4 + 1][0], s[k4 + 1][1], s[k4 + 1][2], s[k4 + 1][3]);
#pragma unroll
                for (int dt = 0; dt < 4; ++dt) {
                    const LAS unsigned char* va = Vb + ((32 * kk + 4 * gq + (j >> 2)) * NSA_VSTR + 16 * dt + 4 * (j & 3)) * 2;
                    o[dt] = __builtin_amdgcn_mfma_f32_16x16x32_bf16(cat4(tr16(va), tr16(va + 16 * NSA_VSTR * 2)), pf, o[dt], 0, 0, 0);
                }
            }
            WAVE_LDS_SYNC();
        }
        const float inv = 1.0f / ls;
        if (j < 8) {
#pragma unroll
            for (int dt = 0; dt < 4; ++dt) { uint2 w; w.x = pg8::cvt_pk_bf16(o[dt][0] * inv, o[dt][1] * inv); w.y = pg8::cvt_pk_bf16(o[dt][2] * inv, o[dt][3] * inv);
                *(uint2*)(qa + (size_t)rowq * 512 + j * 64 + 16 * dt + 4 * gq) = w; }
        }
    }
    __syncthreads();
}
__device__ __forceinline__ void phase_mixers(const Args& P, unsigned char* ws, int z, LAS unsigned char* lds, int gw, int NGW, int lane, int wave, int bid, int G) {
    asm volatile("" : "+v"(lane)); lane &= 63; asm volatile("" : "+s"(gw), "+s"(NGW));
#if PROBE == 3
    { LAS unsigned char* wl = lds + wave * 18944; for (int it2 = gw; it2 < 2 * M; it2 += NGW) nsa_query(P, ws, z, it2 >> 1, it2 & 1, wl, lane); }
#else
    for (int k = 0; bid + G * k < 1024; ++k) {
        const int u = bid + G * k, c0 = u & 63, unit = (u & ~63) | ((k & 1) ? 63 - c0 : c0);
        nsa_unit(ws, unit, lds, (wave << 6) | lane_id_v());
    }
#endif
    for (int k = 0; bid + G * k < 2048; ++k) {
        const int u = bid + G * k, c0 = u & 255, unit = (u & ~255) | ((k & 1) ? 255 - c0 : c0);
        dsa_unit(ws, unit, lds, (wave << 6) | lane_id_v());
    }
}
__global__ void __launch_bounds__(NWAVES * 64, 2) fwd_kernel(Args args) {
    extern __shared__ __attribute__((aligned(16))) unsigned char lds_raw[];
    LAS unsigned char* lds = (LAS unsigned char*)lds_raw;
    const int wave = __builtin_amdgcn_readfirstlane((int)threadIdx.x >> 6);
#define TIDX ((wave << 6) | lane_id_v())
#define tid TIDX
#define lane TIDX
    const int G = gridDim.x, bid = blockIdx.x;
    const int gw = bid * NWAVES + wave, NGW = G * NWAVES;
    const int lo = args.ph_lo, hi = args.ph_hi;
    const Args& P = args;
    int z = 0; asm volatile("" : "+s"(z));
    unsigned char* ws = args.ws + z;
    volatile LAS unsigned* MISCW = (volatile LAS unsigned*)(lds + LDSCTL_OFF);
    if (tid < 64) MISCW[tid] = 0u;
    __syncthreads();
    XcdBarrier bar; bar.bar = (unsigned*)(ws + WS_CTL) + 4096; bar.x = 0; bar.st = nullptr;
    if (hi - lo > 1) bar = xcd_barrier_post((unsigned*)(ws + WS_CTL) + 4096, MISCW + 8);
#define RUN(k) (lo <= (k) && (k) < hi)
#define SEAM(k) do { if ((k) + 1 < hi) { XcdBarrier b2_ = bar; asm volatile("" : "+s"(b2_.bar), "+s"(b2_.x)); xcd_barrier(b2_); } else { VM_WAIT(); __syncthreads(); } } while (0)


    if (RUN(0)) { phase_rope(P, ws, z, bid * (NWAVES * 64) + tid, G * NWAVES * 64); SEAM(0); }

    for (int it = 0; it < 2 * DEPTH; ++it) {
        const int l = it >> 1, second = it & 1, pb = 1 + l * NPL + (second ? 9 : 0);
        asm volatile("" : "+s"(z));
        ws = args.ws + z;
        bf16* const XN = (bf16*)(ws + WS_XN);
        bf16* const HB = (bf16*)(ws + WS_H);
        bf16* const MG = (bf16*)(ws + WS_MG);
        bf16* const GB = (bf16*)(ws + WS_G);
        unsigned char* const wb = ws + WS_W;
        float* const OUT = P.out + z;
        const float* xin = (it == 0) ? P.in[0 + z] : (const float*)OUT;
        if (RUN(pb)) {
            if (!second) phase_convert(P, ws, z, l, lds, gw, NGW, lane, wave);
            const float* gain = (second ? P.in[19 + z] : P.in[2 + z]) + l * DM;
            { int ln_ = TIDX; asm volatile("" : "+v"(ln_)); ln_ &= 63; for (int m = gw; m < M; m += NGW) norm_row_bf16(xin + (size_t)m * DM, gain, XN + (size_t)m * DM, ln_); }
            SEAM(pb);
        }
        if (RUN(pb + 1)) {
            pg8::Gemm g{XN, (const bf16*)(wb + (second ? WO_GU2 : WO_GU1)), M, 2 * FF, DM}; pg8::StaticOrder S; S.init(M, 2 * FF, G, bid + z);
            pg8::EpiSwiglu E{HB, FF};
#if !defined(SITE_MASK) || ((SITE_MASK >> 0) & 1)
            pg8::gemm_phase<pg8::EpiSwiglu, pg8::StaticOrder, true, true>(lds, g, S, E, TIDX);
#endif
            SEAM(pb + 1);
        }
        if (RUN(pb + 2)) {
            pg8::Gemm g{HB, (const bf16*)(wb + (second ? WO_D2 : WO_D1)), M, DM, FF}; pg8::StaticOrder S; S.init(M, DM, G, bid + z);
            pg8::EpiResid E{xin, OUT, 0.5f};
#if !defined(SITE_MASK) || ((SITE_MASK >> 1) & 1)
            pg8::gemm_phase<pg8::EpiResid, pg8::StaticOrder, true, true>(lds, g, S, E, TIDX);
#endif
            SEAM(pb + 2);
        }
        if (second) continue;
        const int pm = 1 + l * NPL + 3;
        if (RUN(pm)) {
            const float* gain = P.in[6 + z] + l * DM;
            { int ln_ = TIDX; asm volatile("" : "+v"(ln_)); ln_ &= 63; for (int m = gw; m < M; m += NGW) norm_row_bf16(OUT + (size_t)m * DM, gain, XN + (size_t)m * DM, ln_); }
            SEAM(pm);
        }
        if (RUN(pm + 1)) {
            pg8::Gemm g{XN, (const bf16*)(wb + WO_IN), M, NINP, DM}; pg8::StaticOrder S; S.init(M, NINP, G, bid + z);
            pg8::EpiWin E{(bf16*)(ws + WS_QA), (bf16*)(ws + WS_QC), (bf16*)(ws + WS_IQ), (bf16*)(ws + WS_MISC), (bf16*)(ws + WS_KVC), (bf16*)(ws + WS_KVS), (bf16*)(ws + WS_KVW), (bf16*)(ws + WS_BU), GB,
                          (const float*)(ws + WS_ROPE)};
#if !defined(SITE_MASK) || ((SITE_MASK >> 2) & 1)
            pg8::gemm_phase<pg8::EpiWin, pg8::StaticOrder, true, true>(lds, g, S, E, TIDX);
#endif
            SEAM(pm + 1);
        }
        #ifndef NO_PREP
        if (RUN(pm + 2)) { phase_prep(P, ws, z, l, lds, gw, NGW, lane, wave); SEAM(pm + 2); }
#endif
        #ifndef NO_MIX
        if (RUN(pm + 3)) { phase_mixers(P, ws, z, lds, gw, NGW, lane, wave, bid, G); SEAM(pm + 3); }
#endif
        if (RUN(pm + 4)) {
            pg8::StaticOrder S; S.init(M, DM, G, bid + z);
            { pg8::Gemm g{(const bf16*)(ws + WS_QA), (const bf16*)(wb + WO_PA), M, DM, 512}; pg8::EpiProj<0> E{MG, GB, 0};
#if !defined(SITE_MASK) || ((SITE_MASK >> 3) & 1)
              pg8::gemm_phase<pg8::EpiProj<0>, pg8::StaticOrder, true, true>(lds, g, S, E, TIDX);
#endif
            }
            { pg8::Gemm g{(const bf16*)(ws + WS_YB), (const bf16*)(wb + WO_PB), M, DM, 512}; pg8::EpiProj<1> E{MG, GB, 1024};
#if !defined(SITE_MASK) || ((SITE_MASK >> 4) & 1)
              pg8::gemm_phase<pg8::EpiProj<1>, pg8::StaticOrder, true, true>(lds, g, S, E, TIDX);
#endif
            }
            { pg8::Gemm g{(const bf16*)(ws + WS_QC), (const bf16*)(wb + WO_PC), M, DM, 512}; pg8::EpiProj<1> E{MG, GB, 2048};
#if !defined(SITE_MASK) || ((SITE_MASK >> 5) & 1)
              pg8::gemm_phase<pg8::EpiProj<1>, pg8::StaticOrder, true, true>(lds, g, S, E, TIDX);
#endif
            }
            SEAM(pm + 4);
        }
        if (RUN(pm + 5)) {
            pg8::Gemm g{MG, (const bf16*)(wb + WO_OUT), M, DM, DM}; pg8::StaticOrder S; S.init(M, DM, G, bid + z);
            pg8::EpiResid E{OUT, OUT, 1.0f};
#if !defined(SITE_MASK) || ((SITE_MASK >> 6) & 1)
            pg8::gemm_phase<pg8::EpiResid, pg8::StaticOrder, true, true>(lds, g, S, E, TIDX);
#endif
            SEAM(pm + 5);
        }
    }
    if (RUN(NPH - 1)) { asm volatile("" : "+s"(z)); int ln_ = TIDX; asm volatile("" : "+v"(ln_)); ln_ &= 63; float* o_ = P.out + z; for (int m = gw; m < M; m += NGW) norm_row_f32(o_ + (size_t)m * DM, P.in[23 + z], ln_); }
#undef RUN
#undef tid
#undef TIDX
#undef lane
#undef SEAM
}

extern "C" void kernel_launch(void* const* d_in, const int* in_sizes, int n_in, void* d_out, int out_size, void* d_ws, size_t ws_size, hipStream_t stream) {
    static int grid = 0;
    if (grid == 0) {
        if (n_in != 24 || out_size != M * DM || ws_size < WS_END) { fprintf(stderr, "kernel_launch: unexpected shapes (n_in %d out %d ws %zu)\n", n_in, out_size, ws_size); grid = -1; return; }
        int dev = 0, cus = 0, per_cu = 0;
        if (hipGetDevice(&dev) != hipSuccess || hipDeviceGetAttribute(&cus, hipDeviceAttributeMultiprocessorCount, dev) != hipSuccess) { grid = -1; return; }
        if (hipFuncSetAttribute((const void*)fwd_kernel, hipFuncAttributeMaxDynamicSharedMemorySize, LDS_BYTES) != hipSuccess) { fprintf(stderr, "kernel_launch: hipFuncSetAttribute failed\n"); grid = -1; return; }
        if (hipOccupancyMaxActiveBlocksPerMultiprocessor(&per_cu, (const void*)fwd_kernel, NWAVES * 64, LDS_BYTES) != hipSuccess || per_cu < 1) { fprintf(stderr, "kernel_launch: occupancy query says %d\n", per_cu); }
        (void)hipGetLastError();
        grid = cus;
    }
    if (grid < 0) return;
    (void)hipMemsetAsync((char*)d_ws + WS_CTL, 0, CTL_ZERO_BYTES, stream);
    Args a{};
    for (int i = 0; i < 24; ++i) a.in[i] = (const float*)d_in[i];
    a.out = (float*)d_out; a.ws = (unsigned char*)d_ws;
#if MK_ONE_LAUNCH
    a.ph_lo = 0; a.ph_hi = NPH;
    hipLaunchKernelGGL(fwd_kernel, dim3(grid), dim3(NWAVES * 64), LDS_BYTES, stream, a);
#else
    for (int ph = 0; ph < NPH; ++ph) { a.ph_lo = ph; a.ph_hi = ph + 1; hipLaunchKernelGGL(fwd_kernel, dim3(grid), dim3(NWAVES * 64), LDS_BYTES, stream, a); }
#endif
}
```

```cpp
#include <hip/hip_runtime.h>
#include <cstdio>
#include <cstdint>
#define PROBE 0
#define PROBE_GAIN 10.0f
#define TOP8_RANK 1
#define PROBE_ROWTHR 0.01f
#define PROBE_ROWCOND 1
#define PROBE_BR -1
#define FIXHOM 0
#define DUP 0
#define POOLDBG 0
#define YB_SPARE 0
#ifndef MK_ONE_LAUNCH
#define MK_ONE_LAUNCH 1
#endif
namespace pg8 {
#define PG8_LAS __attribute__((address_space(3)))
typedef unsigned short bf16_t;
typedef short bf16x8 __attribute__((ext_vector_type(8)));
typedef float f32x4 __attribute__((ext_vector_type(4)));
typedef unsigned u32x4 __attribute__((ext_vector_type(4)));
constexpr int BM = 256, BK = 64, HALF = 128, HTB = HALF * BK * 2  , STAGE_BYTES = 8 * HTB, NXCD = 8, WGM = 8;

__host__ __device__ __forceinline__ int lds_byte(int r, int c) { const int st = (r >> 4) * 2 + (c >> 5), rr = r & 15, cc = c & 31, ob = rr * 64 + cc * 2; return st * 1024 + (ob ^ (((ob >> 9) & 1) << 5)); }
__host__ __device__ __forceinline__ void stage_rc(int b, int& R, int& C) { const int st = b / 1024, sb = b % 1024, swz = sb ^ (((sb >> 9) & 1) << 5); R = (st >> 1) * 16 + swz / 64; C = (st & 1) * 32 + (swz % 64) / 2; }
__host__ __device__ __forceinline__ int perm32(int rho) { const int n = rho >> 4, i = rho & 15; return 8 * (i >> 2) + 4 * n + (i & 3); }

struct Unit { int pm, pn; };
struct Gemm { const bf16_t* A; const bf16_t* Bt; int M, N, K; };

struct StaticOrder {
    int nM, nN, nwg, G, c;
    __host__ __device__ void init(int M, int N, int G_, int c_) { nM = M / BM; nN = N / BM; nwg = nM * nN; G = G_; c = c_; }
    __host__ __device__ bool next(int i, Unit& u) const {
        const long L = (long)i * G + c; if (L >= nwg) return false;
        int wgid = (int)L; { const int q = nwg / NXCD, r = nwg % NXCD, xcd = wgid % NXCD, off = wgid / NXCD; wgid = (xcd < r ? xcd * (q + 1) : r * (q + 1) + (xcd - r) * q) + off; }
        const int nig = WGM * nN, gid = wgid / nig, fm = gid * WGM, gsz = (nM - fm) < WGM ? (nM - fm) : WGM;
        u.pm = fm + ((wgid % nig) % gsz); u.pn = (wgid % nig) / gsz; return true;
    }
    __device__ __forceinline__ void a_ready(const Unit&) const {}
    __device__ __forceinline__ void done(const Unit&) const {}
};

__device__ __forceinline__ unsigned cvt_pk_bf16(float lo, float hi) { unsigned r; asm volatile("v_cvt_pk_bf16_f32 %0, %1, %2" : "=v"(r) : "v"(lo), "v"(hi)); return r; }
__device__ __forceinline__ float bflo(unsigned w) { return __uint_as_float(w << 16); }
__device__ __forceinline__ float bfhi(unsigned w) { return __uint_as_float(w & 0xffff0000u); }
__device__ __forceinline__ float fast_sigmoid(float x) { return __builtin_amdgcn_rcpf(1.0f + __expf(-x)); }

struct EpiSwiglu {
    static constexpr bool PERM = true, AFTER_DRAIN = false;
    bf16_t* H; int ldh;
    __device__ __forceinline__ void operator()(const f32x4 (&acc)[2][2][4][2], const Unit& u, int wr, int wc, int fr, int fq) const {
        const int row0 = u.pm * BM + wr * 64 + fr, col0 = u.pn * HALF + wc * 32 + 8 * fq;
#pragma unroll
        for (int ai = 0; ai < 2; ++ai)
#pragma unroll
            for (int m = 0; m < 4; ++m) {
                bf16_t* rowp = H + (size_t)(row0 + ai * HALF + m * 16) * ldh + col0;
                float o[8];
#pragma unroll
                for (int n = 0; n < 2; ++n)
#pragma unroll
                    for (int e = 0; e < 4; ++e) { const float g = acc[ai][0][m][n][e], up = acc[ai][1][m][n][e]; o[n * 4 + e] = g * fast_sigmoid(g) * up; }
                u32x4 w; w.x = cvt_pk_bf16(o[0], o[1]); w.y = cvt_pk_bf16(o[2], o[3]); w.z = cvt_pk_bf16(o[4], o[5]); w.w = cvt_pk_bf16(o[6], o[7]);
                *(u32x4*)rowp = w;
            }
    }
};
struct EpiResid {
    static constexpr bool PERM = true, AFTER_DRAIN = false;
    const float* base; float* out; float s;
    __device__ __forceinline__ void operator()(const f32x4 (&acc)[2][2][4][2], const Unit& u, int wr, int wc, int fr, int fq) const {
        const int row0 = u.pm * BM + wr * 64 + fr, col0 = u.pn * BM + wc * 32 + 8 * fq;
#pragma unroll
        for (int ai = 0; ai < 2; ++ai)
#pragma unroll
            for (int m = 0; m < 4; ++m) {
                const size_t off = (size_t)(row0 + ai * HALF + m * 16) * 1024 + col0;
#pragma unroll
                for (int bj = 0; bj < 2; ++bj) {
                    const f32x4 b0 = *(const f32x4*)(base + off + bj * HALF), b1 = *(const f32x4*)(base + off + bj * HALF + 4);
                    *(f32x4*)(out + off + bj * HALF) = b0 + acc[ai][bj][m][0] * s; *(f32x4*)(out + off + bj * HALF + 4) = b1 + acc[ai][bj][m][1] * s;
                }
            }
    }
};
template <int MODE> struct EpiProj {
    static constexpr bool PERM = true, AFTER_DRAIN = false;
    bf16_t* MG; const bf16_t* G; int gofs;
    __device__ __forceinline__ void operator()(const f32x4 (&acc)[2][2][4][2], const Unit& u, int wr, int wc, int fr, int fq) const {
        const int row0 = u.pm * BM + wr * 64 + fr, col0 = u.pn * BM + wc * 32 + 8 * fq;
#pragma unroll
        for (int ai = 0; ai < 2; ++ai)
#pragma unroll
            for (int m = 0; m < 4; ++m) {
                const size_t row = (size_t)(row0 + ai * HALF + m * 16);
#pragma unroll
                for (int bj = 0; bj < 2; ++bj) {
                    const u32x4 gv = *(const u32x4*)(G + row * 3072 + gofs + col0 + bj * HALF);
                    bf16_t* mp = MG + row * 1024 + col0 + bj * HALF;
                    const f32x4 a0 = acc[ai][bj][m][0], a1 = acc[ai][bj][m][1];
                    float o[8] = {bflo(gv.x) * a0[0], bfhi(gv.x) * a0[1], bflo(gv.y) * a0[2], bfhi(gv.y) * a0[3], bflo(gv.z) * a1[0], bfhi(gv.z) * a1[1], bflo(gv.w) * a1[2], bfhi(gv.w) * a1[3]};
                    if (MODE) { const u32x4 ov = *(const u32x4*)mp; o[0] += bflo(ov.x); o[1] += bfhi(ov.x); o[2] += bflo(ov.y); o[3] += bfhi(ov.y); o[4] += bflo(ov.z); o[5] += bfhi(ov.z); o[6] += bflo(ov.w); o[7] += bfhi(ov.w); }
                    u32x4 w; w.x = cvt_pk_bf16(o[0], o[1]); w.y = cvt_pk_bf16(o[2], o[3]); w.z = cvt_pk_bf16(o[4], o[5]); w.w = cvt_pk_bf16(o[6], o[7]);
                    *(u32x4*)mp = w;
                }
            }
    }
};
struct EpiWin {
    static constexpr bool PERM = true, AFTER_DRAIN = false;
    bf16_t *QA, *QC, *IQ, *MISC, *KVC, *KVS, *KVW, *BU, *G; const float* rope;
    __device__ __forceinline__ void operator()(const f32x4 (&acc)[2][2][4][2], const Unit& u, int wr, int wc, int fr, int fq) const {
        const int pn = u.pn;
        bf16_t* dst; int ld, cbase, mode;
        if (pn < 2) { dst = QA; ld = 512; cbase = pn * 256; mode = 1; }
        else if (pn < 4) { dst = QC; ld = 512; cbase = (pn - 2) * 256; mode = 1; }
        else if (pn == 4) { dst = IQ; ld = 256; cbase = 0; mode = 1; }
        else if (pn == 5) { dst = MISC; ld = 256; cbase = 0; mode = 3; }
        else if (pn <= 8) { dst = pn == 6 ? KVC : (pn == 7 ? KVS : KVW); ld = 256; cbase = 0; mode = 2; }
        else if (pn <= 10) { dst = BU; ld = 512; cbase = (pn - 9) * 256; mode = 0; }
        else { dst = G; ld = 3072; cbase = (pn - 11) * 256; mode = 4; }
        const int row0 = u.pm * BM + wr * 64 + fr, col0 = cbase + wc * 32 + 8 * fq;
        const bool ropelane = ((wc & 1) == 0) && fq < 2;
        const float sc = (mode == 1) ? (pn < 4 ? 0.125f * 1.4426950408889634f : 0.125f) : 1.0f;
#pragma unroll
        for (int ai = 0; ai < 2; ++ai)
#pragma unroll
            for (int m = 0; m < 4; ++m) {
                const size_t row = (size_t)(row0 + ai * HALF + m * 16);
                f32x4 cs = {1.f, 1.f, 1.f, 1.f}, sn = {0.f, 0.f, 0.f, 0.f};
                if (ropelane && mode >= 1 && mode <= 3) { cs = *(const f32x4*)(rope + row * 16 + 4 * fq); sn = *(const f32x4*)(rope + row * 16 + 8 + 4 * fq); }
#pragma unroll
                for (int bj = 0; bj < 2; ++bj) {
                    const f32x4 a0 = acc[ai][bj][m][0], a1 = acc[ai][bj][m][1];
                    float o[8] = {a0[0], a0[1], a0[2], a0[3], a1[0], a1[1], a1[2], a1[3]};
                    const bool dorope = ropelane && (mode == 1 || (mode == 2 && bj == 0) || (mode == 3 && bj == 0 && wc == 0));
                    if (dorope) {
#pragma unroll
                        for (int p = 0; p < 4; ++p) { const float x1 = o[2 * p], x2 = o[2 * p + 1]; o[2 * p] = x1 * cs[p] - x2 * sn[p]; o[2 * p + 1] = x2 * cs[p] + x1 * sn[p]; }
                    }
                    if (mode == 4) {
#pragma unroll
                        for (int e = 0; e < 8; ++e) o[e] = fast_sigmoid(o[e]);
                    } else {
#pragma unroll
                        for (int e = 0; e < 8; ++e) o[e] *= sc;
                    }
                    u32x4 w; w.x = cvt_pk_bf16(o[0], o[1]); w.y = cvt_pk_bf16(o[2], o[3]); w.z = cvt_pk_bf16(o[4], o[5]); w.w = cvt_pk_bf16(o[6], o[7]);
                    *(u32x4*)(dst + row * ld + col0 + bj * HALF) = w;
                }
            }
    }
};

template <class Epi, class Sched, bool ALIGN_EPI = false, bool SP2 = false>
__device__ __forceinline__ void gemm_phase(PG8_LAS unsigned char* lds, const Gemm g, const Sched& S, const Epi& E, int tid_in) {
    int tid_ = tid_in; asm volatile("" : "+v"(tid_));
    const int tid = tid_, wid = __builtin_amdgcn_readfirstlane(tid >> 6), lane = tid & 63, wr = wid >> 2, wc = wid & 3, fr = lane & 15, fq = lane >> 4;
    const int K = g.K, nt = K / BK;
    unsigned voffA[2], voffB[2];
#pragma unroll
    for (int i = 0; i < 2; ++i) { int R, C; stage_rc(tid * 16 + i * 8192, R, C); const int Rb = Epi::PERM ? ((R & ~31) + perm32(R & 31)) : R;
        voffA[i] = (unsigned)(R * K + C) * 2u; voffB[i] = (unsigned)(Rb * K + C) * 2u; }
    const size_t kstep = (size_t)(BK * 2);
    const size_t hstep = (size_t)HALF * K * 2;
    const size_t tstep = 2 * hstep;
    const unsigned ldsw = (unsigned)wid * 1024u;
    const int aoff = lds_byte(wr * 64 + fr, fq * 8), boff = lds_byte(wc * 32 + fr, fq * 8);
#define PG8_SA(b, h) (((b) * 2 + (h)) * HTB)
#define PG8_SB(b, h) ((4 + (b) * 2 + (h)) * HTB)
#define PG8_STAGE(bufoff, gbase, voff) do { _Pragma("unroll") for (int _i = 0; _i < 2; ++_i) \
        __builtin_amdgcn_global_load_lds((const unsigned*)((const char*)(gbase) + (voff)[_i]), (PG8_LAS unsigned*)(lds + (bufoff) + ldsw + _i * 8192), 16, 0, 0); } while (0)
#define PG8_LDA(dst, b, h) do { _Pragma("unroll") for (int m = 0; m < 4; ++m) _Pragma("unroll") for (int k = 0; k < 2; ++k) dst[m][k] = *(const PG8_LAS bf16x8*)(lds + PG8_SA(b, h) + aoff + m * 2048 + k * 1024); } while (0)
#define PG8_LDB(dst, b, h) do { _Pragma("unroll") for (int n = 0; n < 2; ++n) _Pragma("unroll") for (int k = 0; k < 2; ++k) dst[n][k] = *(const PG8_LAS bf16x8*)(lds + PG8_SB(b, h) + boff + n * 2048 + k * 1024); } while (0)
#define PG8_MMA(ai, bj, At, Bt) do { __builtin_amdgcn_s_setprio(1); _Pragma("unroll") for (int m = 0; m < 4; ++m) _Pragma("unroll") for (int n = 0; n < 2; ++n) _Pragma("unroll") for (int k = 0; k < 2; ++k) \
        acc[ai][bj][m][n] = __builtin_amdgcn_mfma_f32_16x16x32_bf16(Bt[n][k], At[m][k], acc[ai][bj][m][n], 0, 0, 0); __builtin_amdgcn_s_setprio(0); } while (0)
#define PG8_WAIT_V(n) asm volatile("s_waitcnt vmcnt(" #n ")" ::: "memory")
#define PG8_WAIT_L(n) asm volatile("s_waitcnt lgkmcnt(" #n ")" ::: "memory")
#define PG8_BAR __builtin_amdgcn_s_barrier()
#define PG8_SCHED __builtin_amdgcn_sched_barrier(0)
    Unit cur, nxt; int ui = 0;
    if (!S.next(0, cur)) return;
    f32x4 acc[2][2][4][2];
#pragma unroll
    for (int a = 0; a < 2; ++a)
#pragma unroll
        for (int b = 0; b < 2; ++b)
#pragma unroll
            for (int m = 0; m < 4; ++m)
#pragma unroll
                for (int n = 0; n < 2; ++n) acc[a][b][m][n] = (f32x4){0.f, 0.f, 0.f, 0.f};
    bf16x8 At[4][2], B0[2][2], B1[2][2];
    const char* cA = (const char*)g.A + (size_t)cur.pm * tstep; const char* cB = (const char*)g.Bt + (size_t)cur.pn * tstep;
    S.a_ready(cur);
    if constexpr (SP2) {
        PG8_STAGE(PG8_SB(0, 0), cB, voffB); PG8_STAGE(PG8_SB(0, 1), cB + hstep, voffB); PG8_STAGE(PG8_SA(0, 0), cA, voffA); PG8_STAGE(PG8_SA(0, 1), cA + hstep, voffA);
        if (wr == 1) PG8_BAR;
        PG8_WAIT_V(2); PG8_BAR;
        PG8_STAGE(PG8_SB(1, 0), cB + kstep, voffB); PG8_STAGE(PG8_SA(1, 0), cA + kstep, voffA); PG8_STAGE(PG8_SB(1, 1), cB + hstep + kstep, voffB);
        PG8_WAIT_V(6); PG8_BAR;
    } else {
        PG8_STAGE(PG8_SB(0, 0), cB, voffB); PG8_STAGE(PG8_SA(0, 0), cA, voffA); PG8_STAGE(PG8_SB(0, 1), cB + hstep, voffB); PG8_STAGE(PG8_SA(0, 1), cA + hstep, voffA);
        if (wr == 1) PG8_BAR;
        PG8_WAIT_V(4); PG8_BAR;
        PG8_STAGE(PG8_SB(1, 0), cB + kstep, voffB); PG8_STAGE(PG8_SA(1, 0), cA + kstep, voffA); PG8_STAGE(PG8_SB(1, 1), cB + hstep + kstep, voffB);
        PG8_WAIT_V(6); PG8_BAR;
    }
    for (;;) {
        const bool has_next = S.next(ui + 1, nxt);
        const char* nA = has_next ? (const char*)g.A + (size_t)nxt.pm * tstep : cA; const char* nB = has_next ? (const char*)g.Bt + (size_t)nxt.pn * tstep : cB;
        for (int t = 0; t < nt; t += 2) {
            const bool last = (t == nt - 2);
            const char* a1 = cA + (size_t)(t + 1) * kstep;
            const char* a2 = last ? nA : cA + (size_t)(t + 2) * kstep; const char* b2 = last ? nB : cB + (size_t)(t + 2) * kstep;
            const char* a3 = a2 + kstep; const char* b3 = b2 + kstep;
            if (last && has_next) S.a_ready(nxt);
            if constexpr (SP2) {
            PG8_LDB(B0, 0, 0); PG8_LDB(B1, 0, 1); PG8_SCHED; PG8_LDA(At, 0, 0); PG8_STAGE(PG8_SA(1, 1), a1 + hstep, voffA);
            PG8_WAIT_V(8); PG8_WAIT_L(0); PG8_BAR; PG8_MMA(0, 0, At, B0); PG8_MMA(0, 1, At, B1); PG8_BAR; PG8_SCHED;
            PG8_LDA(At, 0, 1); PG8_STAGE(PG8_SB(0, 0), b2, voffB); PG8_STAGE(PG8_SB(0, 1), b2 + hstep, voffB); PG8_STAGE(PG8_SA(0, 0), a2, voffA);
            PG8_WAIT_V(8); PG8_WAIT_L(0); PG8_BAR; PG8_MMA(1, 0, At, B0); PG8_MMA(1, 1, At, B1); PG8_BAR; PG8_SCHED;
            PG8_LDB(B0, 1, 0); PG8_LDB(B1, 1, 1); PG8_SCHED; PG8_LDA(At, 1, 0); PG8_STAGE(PG8_SA(0, 1), a2 + hstep, voffA);
            PG8_WAIT_V(8); PG8_WAIT_L(0); PG8_BAR; PG8_MMA(0, 0, At, B0); PG8_MMA(0, 1, At, B1); PG8_BAR; PG8_SCHED;
            PG8_LDA(At, 1, 1); PG8_STAGE(PG8_SB(1, 0), b3, voffB); PG8_STAGE(PG8_SB(1, 1), b3 + hstep, voffB); PG8_STAGE(PG8_SA(1, 0), a3, voffA);
            PG8_WAIT_V(8); PG8_WAIT_L(0); PG8_BAR; PG8_MMA(1, 0, At, B0); PG8_MMA(1, 1, At, B1); PG8_BAR; PG8_SCHED;
            } else {
            PG8_LDB(B0, 0, 0); PG8_SCHED; PG8_LDA(At, 0, 0); PG8_STAGE(PG8_SA(1, 1), a1 + hstep, voffA);
            PG8_WAIT_L(8); PG8_BAR; PG8_WAIT_L(0); PG8_MMA(0, 0, At, B0); PG8_BAR; PG8_SCHED;
            PG8_LDB(B1, 0, 1); PG8_STAGE(PG8_SB(0, 0), b2, voffB);
            PG8_BAR; PG8_WAIT_L(0); PG8_MMA(0, 1, At, B1); PG8_BAR;
            PG8_LDA(At, 0, 1); PG8_STAGE(PG8_SA(0, 0), a2, voffA);
            PG8_BAR; PG8_WAIT_L(0); PG8_MMA(1, 0, At, B0); PG8_BAR; PG8_SCHED;
            PG8_STAGE(PG8_SB(0, 1), b2 + hstep, voffB);
            PG8_WAIT_V(6); PG8_BAR; PG8_MMA(1, 1, At, B1); PG8_BAR;
            PG8_LDB(B0, 1, 0); PG8_SCHED; PG8_LDA(At, 1, 0); PG8_STAGE(PG8_SA(0, 1), a2 + hstep, voffA);
            PG8_WAIT_L(8); PG8_BAR; PG8_WAIT_L(0); PG8_MMA(0, 0, At, B0); PG8_BAR; PG8_SCHED;
            PG8_LDB(B1, 1, 1); PG8_STAGE(PG8_SB(1, 0), b3, voffB);
            PG8_BAR; PG8_WAIT_L(0); PG8_MMA(0, 1, At, B1); PG8_BAR;
            PG8_LDA(At, 1, 1); PG8_STAGE(PG8_SA(1, 0), a3, voffA);
            PG8_BAR; PG8_WAIT_L(0); PG8_MMA(1, 0, At, B0); PG8_BAR; PG8_SCHED;
            PG8_STAGE(PG8_SB(1, 1), b3 + hstep, voffB);
            PG8_WAIT_V(6); PG8_BAR; PG8_MMA(1, 1, At, B1); PG8_BAR;
            }
        }
        if constexpr (ALIGN_EPI) { if (wr == 0) PG8_BAR; }
        if constexpr (!Epi::AFTER_DRAIN) { E(acc, cur, wr, wc, fr, fq); S.done(cur); }
        if (!has_next) break;
#pragma unroll
        for (int a = 0; a < 2; ++a)
#pragma unroll
            for (int b = 0; b < 2; ++b)
#pragma unroll
                for (int m = 0; m < 4; ++m)
#pragma unroll
                    for (int n = 0; n < 2; ++n) acc[a][b][m][n] = (f32x4){0.f, 0.f, 0.f, 0.f};
        cur = nxt; cA = nA; cB = nB; ++ui;
        if constexpr (ALIGN_EPI) { if (wr == 1) PG8_BAR; }
    }
    PG8_WAIT_V(0);
    if constexpr (!ALIGN_EPI) { if (wr == 0) PG8_BAR; }
    PG8_BAR;
    if constexpr (Epi::AFTER_DRAIN) { E.fused(acc, cur, wr, wc, fr, fq, lds, wid, lane); S.done(cur); }
#undef PG8_SA
#undef PG8_SB
#undef PG8_STAGE
#undef PG8_LDA
#undef PG8_LDB
#undef PG8_MMA
#undef PG8_WAIT_V
#undef PG8_WAIT_L
#undef PG8_BAR
#undef PG8_SCHED
}
}
#define GAS __attribute__((address_space(1)))
#define LAS __attribute__((address_space(3)))
typedef unsigned short bf16;
typedef unsigned v4u __attribute__((ext_vector_type(4)));
typedef float f32x4 __attribute__((ext_vector_type(4)));
typedef short bf16x8 __attribute__((ext_vector_type(8)));
typedef GAS unsigned gu32;
typedef GAS unsigned long long gu64;
#define RLX_AGENT __ATOMIC_RELAXED, __HIP_MEMORY_SCOPE_AGENT
#define LDS_WAIT() asm volatile("s_waitcnt lgkmcnt(0)" ::: "memory")
#define VM_WAIT() asm volatile("s_waitcnt vmcnt(0)" ::: "memory")
__device__ __forceinline__ unsigned long long rt() { return __builtin_amdgcn_s_memrealtime(); }
__device__ __forceinline__ unsigned f2bf(float f) { unsigned u = __builtin_bit_cast(unsigned, f); return (u + 0x7fffu + ((u >> 16) & 1u)) >> 16; }
__device__ __forceinline__ unsigned pk2(float lo, float hi) { return f2bf(lo) | (f2bf(hi) << 16); }
#define XB_TMO      128
#define XB_XCNT(j)  (256  + 64 * (j))
#define XB_XSUB(j)  (1280 + 64 * (j))
#define XB_XGEN(j)  (2304 + 64 * (j))
#define XB_TOP      3328
#define XB_TOPGEN   3392
#define XCD_BAR_WORDS 3456
#define XB_SPIN_CAP (1u << 18)

__device__ __forceinline__ unsigned xb_ld(unsigned* p)              { return __hip_atomic_load(p, __ATOMIC_RELAXED, __HIP_MEMORY_SCOPE_AGENT); }
__device__ __forceinline__ unsigned xb_add(unsigned* p, unsigned v) { return __hip_atomic_fetch_add(p, v, __ATOMIC_RELAXED, __HIP_MEMORY_SCOPE_AGENT); }
__device__ __forceinline__ unsigned xb_xcc_id() { return (unsigned)__builtin_amdgcn_s_getreg((3 << 11) | 20) & 0xFu; }
#define XB_SPIN(cond, bar) do { unsigned _sp = 0; while (cond) { __builtin_amdgcn_s_sleep(1); \
    if ((++_sp & 255u) == 0u) { if (xb_ld(&(bar)[XB_TMO])) break; if (_sp > XB_SPIN_CAP) { atomicAdd(&(bar)[XB_TMO], 1u); break; } } } } while (0)

struct XcdBarrier {
    unsigned* bar; unsigned x;
    volatile LAS unsigned* st;
};

__device__ __forceinline__ XcdBarrier xcd_barrier_post(unsigned* bar, volatile LAS unsigned* st) {
    XcdBarrier b; b.bar = bar; b.x = xb_xcc_id(); b.st = st;
    if (threadIdx.x == 0) (void)xb_add(&bar[XB_XCNT(b.x)], 1u);
    return b;
}
__device__ __forceinline__ void xcd_barrier_complete(unsigned* bar, unsigned x, unsigned& nloc, unsigned& nx) {
    const unsigned G = gridDim.x * gridDim.y * gridDim.z;
    unsigned sum, cnt, mine, sp = 0u;
    for (;;) {
        sum = 0u; cnt = 0u; mine = 0u;
#pragma unroll
        for (unsigned j = 0; j < 16; ++j) { const unsigned c = xb_ld(&bar[XB_XCNT(j)]); sum += c; cnt += (c > 0u) ? 1u : 0u; mine = (j == x) ? c : mine; }
        if (sum == G) break;
        __builtin_amdgcn_s_sleep(1);
        if ((++sp & 255u) == 0u) { if (xb_ld(&bar[XB_TMO])) break; if (sp > XB_SPIN_CAP) { atomicAdd(&bar[XB_TMO], 1u); break; } }
    }
    nloc = mine > 0u ? mine : 1u; nx = cnt > 0u ? cnt : 1u;
}

__device__ __forceinline__ void xcd_barrier(const XcdBarrier& b) {
    asm volatile("s_waitcnt vmcnt(0)" ::: "memory");
    __syncthreads();
    if (threadIdx.x == 0) {
        unsigned* bar = b.bar;
        __builtin_amdgcn_s_waitcnt(0);
        unsigned nloc = b.st[0], nx = b.st[1];
        if (nloc == 0u) { xcd_barrier_complete(bar, b.x, nloc, nx); b.st[0] = nloc; b.st[1] = nx; }
        const unsigned old = xb_add(&bar[XB_XSUB(b.x)], 1u);
        const unsigned gen = old / nloc;
        if (old + 1u == (gen + 1u) * nloc) {
            __builtin_amdgcn_fence(__ATOMIC_RELEASE, "agent");
            asm volatile("s_waitcnt vmcnt(0)" ::: "memory");
            const unsigned og = xb_add(&bar[XB_TOP], 1u);
            const unsigned tg = og / nx;
            if (og + 1u == (tg + 1u) * nx) xb_add(&bar[XB_TOPGEN], 1u);
            else XB_SPIN(xb_ld(&bar[XB_TOPGEN]) == tg, bar);
            __builtin_amdgcn_fence(__ATOMIC_ACQUIRE, "agent");
            xb_add(&bar[XB_XGEN(b.x)], 1u);
            asm volatile("s_waitcnt vmcnt(0)" ::: "memory");
        } else {
            XB_SPIN(xb_ld(&bar[XB_XGEN(b.x)]) == gen, bar);
            __builtin_amdgcn_fence(__ATOMIC_ACQUIRE, "agent");
            asm volatile("s_waitcnt vmcnt(0)" ::: "memory");
        }
    }
    __syncthreads();
}
constexpr int NB = 8, SEQ = 4096, DM = 1024, DEPTH = 4, M = NB * SEQ;
constexpr int FF = 2816, NIN = 5852, NINP = 5888;
constexpr float EPS = 1e-6f, NEGF = -1e30f;
constexpr int NWAVES = 8;
constexpr size_t MiB = 1u << 20;
constexpr size_t WS_CTL = 0, CTL_ZERO_BYTES = 1 * MiB;
constexpr size_t WS_ROPE = 1 * MiB;
constexpr size_t WS_KVA = 3 * MiB;
constexpr size_t WS_KC = 11 * MiB, WS_VC = WS_KC + 512 * 1024;
constexpr size_t WS_W = 12 * MiB;
constexpr size_t WO_GU1 = 0, WO_D1 = 11 * MiB, WO_GU2 = WO_D1 + 5 * MiB + 512 * 1024, WO_D2 = WO_GU2 + 11 * MiB, WO_IN = WO_D2 + 5 * MiB + 512 * 1024,
                 WO_PA = WO_IN + 11 * MiB + 512 * 1024, WO_PB = WO_PA + MiB, WO_PC = WO_PB + MiB, WO_OUT = WO_PC + MiB,
                 WO_CW1 = WO_OUT + 2 * MiB  , WO_CW2 = WO_CW1 + MiB  , WO_UKV = WO_CW2 + 32768  , WO_POOL = WO_UKV + 32768  ,
                 WO_POSB = WO_POOL + 131072  , WO_END = WO_POSB + 1024;
static_assert(WO_END <= 52 * MiB, "weights region");
constexpr size_t WS_XN = 64 * MiB;
constexpr size_t WS_R = 128 * MiB;
constexpr size_t WS_G = WS_R, WS_QA = WS_R + 192 * MiB, WS_QC = WS_QA + 32 * MiB, WS_IQ = WS_QC + 32 * MiB, WS_MISC = WS_IQ + 16 * MiB,
                 WS_KVC = WS_MISC + 16 * MiB, WS_KVS = WS_KVC + 16 * MiB, WS_KVW = WS_KVS + 16 * MiB, WS_BU = WS_KVW + 16 * MiB, WS_END = WS_BU + 32 * MiB;
#ifndef YB_SPARE
#define YB_SPARE 0
#endif
constexpr size_t WS_YB = YB_SPARE ? 496 * MiB : WS_XN;
constexpr size_t WS_MG = WS_IQ;
constexpr size_t WS_H = WS_R;
static_assert(WS_END == 496 * MiB, "ws map");
constexpr int RING_BYTES = 131072, LDS_BYTES = 163840, LDSCTL_OFF = 163840 - 256;
constexpr int NPL = 12, NPH = 1 + DEPTH * NPL + 1;

__device__ __forceinline__ int lane_id_v() { int l; asm volatile("v_mbcnt_lo_u32_b32 %0, -1, 0\n\tv_mbcnt_hi_u32_b32 %0, -1, %0" : "=v"(l)); return l; }
__device__ __forceinline__ float bflo(unsigned w) { return __uint_as_float(w << 16); }
__device__ __forceinline__ float bfhi(unsigned w) { return __uint_as_float(w & 0xffff0000u); }
__device__ __forceinline__ float bf2f(bf16 v) { return __uint_as_float((unsigned)v << 16); }
__device__ __forceinline__ float wave_sum(float v) {
#pragma unroll
    for (int o = 1; o < 64; o <<= 1) v += __shfl_xor(v, o);
    return v;
}
__device__ __forceinline__ float wave_max(float v) {
#pragma unroll
    for (int o = 1; o < 64; o <<= 1) v = fmaxf(v, __shfl_xor(v, o));
    return v;
}
__device__ __forceinline__ int wave_sum_i(int v) {
#pragma unroll
    for (int o = 1; o < 64; o <<= 1) v += __shfl_xor(v, o);
    return v;
}
__device__ __forceinline__ unsigned wave_max_u(unsigned v) {
#pragma unroll
    for (int o = 1; o < 64; o <<= 1) { const unsigned w = (unsigned)__shfl_xor((int)v, o); v = w > v ? w : v; }
    return v;
}
#define WAVE_LDS_SYNC() do { asm volatile("s_waitcnt lgkmcnt(0)" ::: "memory"); __builtin_amdgcn_wave_barrier(); } while (0)
__host__ __device__ __forceinline__ int permd(int d) { return d < 8 ? 2 * d : (d < 16 ? 2 * (d - 8) + 1 : d); }
__device__ __forceinline__ int win_newcol(int n) {
    if (n < 512) return (n & ~63) + permd(n & 63);
    if (n < 640) return 1280 + 64 + (n - 512);
    if (n < 896) { const int m = n - 640; return 1024 + (m & ~63) + permd(m & 63); }
    if (n < 960) return 1280 + permd(n - 896);
    if (n < 964) return 1280 + 192 + (n - 960);
    if (n < 1476) return 2304 + (n - 964);
    if (n < 1988) { const int m = n - 1476; return 512 + (m & ~63) + permd(m & 63); }
    if (n < 2756) { const int m = n - 1988, kv = m >> 8, r = m & 255, base = 1536 + kv * 256; return r < 128 ? base + (r & ~63) + permd(r & 63) : base + r; }
    if (n < 2780) return 1280 + 196 + (n - 2756);
    return 2816 + (n - 2780);
}
__device__ __forceinline__ int map_row(int mode, int n) { return mode == 0 ? n : (mode == 1 ? ((n >> 7) << 8) + (n & 127) : (mode == 2 ? ((n >> 7) << 8) + 128 + (n & 127) : win_newcol(n))); }

struct Args { const float* in[24]; float* out; unsigned char* ws; int ph_lo, ph_hi; };

__device__ __forceinline__ int unperm(int p) { return p < 16 ? ((p & 1) ? (p >> 1) + 8 : (p >> 1)) : p; }
__device__ __forceinline__ void tr_item(const float* W, int K, int N, bf16* WT, int mode, LAS float* scr, int item, int lane, bool kperm = false) {
    const int nblk = (N + 31) >> 5, kb = item / nblk, nb = item - kb * nblk, k0 = 64 * kb, n0 = 32 * nb;
    const int nn = n0 + (lane & 31);
#pragma unroll 8
    for (int i = 0; i < 32; ++i) { const int kk = 2 * i + (lane >> 5); scr[kk * 33 + (lane & 31)] = nn < N ? W[(size_t)(k0 + kk) * N + nn] : 0.f; }
    LDS_WAIT(); asm volatile("" ::: "memory");
    const int c = lane & 7;
#pragma unroll
    for (int j = 0; j < 4; ++j) { const int n = (lane >> 3) + 8 * j; const LAS float* s = scr + n;
        int ks[8];
#pragma unroll
        for (int i = 0; i < 8; ++i) ks[i] = (kperm ? unperm(8 * c + i) : 8 * c + i) * 33;
        v4u o; o.x = pk2(s[ks[0]], s[ks[1]]); o.y = pk2(s[ks[2]], s[ks[3]]); o.z = pk2(s[ks[4]], s[ks[5]]); o.w = pk2(s[ks[6]], s[ks[7]]);
        if (n0 + n < N) *(v4u*)(WT + (size_t)map_row(mode, n0 + n) * K + k0 + 8 * c) = o; }
    LDS_WAIT(); asm volatile("" ::: "memory");
}
__device__ __forceinline__ void phase_convert(const Args& P, unsigned char* ws, int z, int l, LAS unsigned char* lds, int gw, int NGW, int lane, int wave) {
    asm volatile("" : "+v"(lane)); lane &= 63; asm volatile("" : "+s"(gw), "+s"(NGW));
    LAS float* scr = (LAS float*)(lds + wave * 16384);
    unsigned char* wb = ws + WS_W;
    constexpr int I_F = 16 * 88, I_D = 44 * 32, I_IN = 16 * 183, I_P = 8 * 32, I_O = 16 * 32;
    constexpr int I_C = 32 * 4;
    constexpr int NIT = 4 * I_F + 2 * I_D + I_IN + 3 * I_P + I_O + 2 * I_C;
    const size_t fo = (size_t)l * DM * FF;
    for (int it = gw; it < NIT; it += NGW) {
        int r = it, K = DM, N = FF, mode = 1; const float* W = P.in[3 + z] + fo; size_t wo = WO_GU1; bool kperm = false;
        if (r >= I_F) { r -= I_F; mode = 2; W = P.in[4 + z] + fo;
        if (r >= I_F) { r -= I_F; mode = 0; W = P.in[5 + z] + fo; K = FF; N = DM; wo = WO_D1;
        if (r >= I_D) { r -= I_D; mode = 1; W = P.in[20 + z] + fo; K = DM; N = FF; wo = WO_GU2;
        if (r >= I_F) { r -= I_F; mode = 2; W = P.in[21 + z] + fo;
        if (r >= I_F) { r -= I_F; mode = 0; W = P.in[22 + z] + fo; K = FF; N = DM; wo = WO_D2;
        if (r >= I_D) { r -= I_D; mode = 3; W = P.in[7 + z] + (size_t)l * DM * NIN; K = DM; N = NIN; wo = WO_IN;
        if (r >= I_IN) { r -= I_IN; mode = 0; W = P.in[15 + z] + (size_t)l * 512 * DM; K = 512; N = DM; wo = WO_PA;
        if (r >= I_P) { r -= I_P; W = P.in[16 + z] + (size_t)l * 512 * DM; wo = WO_PB;
        if (r >= I_P) { r -= I_P; W = P.in[17 + z] + (size_t)l * 512 * DM; wo = WO_PC;
        if (r >= I_P) { r -= I_P; W = P.in[18 + z] + (size_t)l * DM * DM; K = DM; wo = WO_OUT;
        if (r >= I_O) { r -= I_O; W = P.in[13 + z] + (size_t)(l * 2) * 2048 * 128; K = 2048; N = 128; wo = WO_CW1; kperm = true;
        if (r >= I_C) { r -= I_C; W += (size_t)2048 * 128; wo = WO_CW1 + 128 * 2048 * 2; kperm = false; } } } } } } } } } } } }
        tr_item(W, K, N, (bf16*)(wb + wo), mode, scr, r, lane, kperm);
    }
    {
        const int gt = gw * 64 + lane, GT = NGW * 64;
        bf16* ukv = (bf16*)(wb + WO_UKV); bf16* pool = (bf16*)(wb + WO_POOL); bf16* cw2 = (bf16*)(wb + WO_CW2); float* posb = (float*)(wb + WO_POSB);
        const float* w_ukv = P.in[9 + z] + (size_t)l * 128 * 128; const float* gn = P.in[8 + z] + l * 128;
        for (int i = gt; i < 128 * 128; i += GT) { const int np = i >> 7, k = i & 127, n = np < 64 ? unperm(np) : np; ukv[i] = (bf16)f2bf(gn[k] * w_ukv[k * 128 + n]); }
        const float* pw = P.in[10 + z] + (size_t)l * 4 * 128 * 128; const float* psc = P.in[11 + z] + l * 512;
        for (int i = gt; i < 4 * 128 * 128; i += GT) { const int g = i >> 14, d = (i >> 7) & 127, c = i & 127; pool[i] = (bf16)f2bf(pw[(g * 128 + c) * 128 + d] * psc[g * 128 + d]); }
        const float* w2 = P.in[14 + z] + (size_t)l * 2 * 128 * 64;
        for (int i = gt; i < 2 * 64 * 128; i += GT) { const int br = i >> 13, dp = (i >> 7) & 63, n = i & 127, d = br ? dp : unperm(dp); cw2[i] = (bf16)f2bf(w2[(br * 128 + n) * 64 + d]); }
        const float* w1 = P.in[13 + z] + (size_t)l * 2 * 2048 * 128; const float* pos = P.in[12 + z] + (size_t)l * 2 * 2048;
        for (int i = gw; i < 256; i += NGW) { const int br = i >> 7, n = i & 127; float a = 0.f;
#pragma unroll 8
            for (int k = lane; k < 2048; k += 64) a += pos[br * 2048 + k] * w1[((size_t)br * 2048 + k) * 128 + n];
            a = wave_sum(a); if (lane == 0) posb[i] = a; }
    }
    if (gw < 36) { unsigned zz = 0u; asm volatile("" : "+v"(zz)); v4u z = {zz, zz, zz, zz}; v4u* rp = (v4u*)((bf16*)(wb + WO_IN) + (size_t)(1500 + gw) * DM); for (int i = lane; i < DM / 8; i += 64) rp[i] = z; }
}
__device__ __forceinline__ void phase_rope(const Args& P, unsigned char* ws, int z, int gtid, int gthreads) {
    float* rope = (float*)(ws + WS_ROPE);
    for (int idx = gtid; idx < M * 8; idx += gthreads) {
        const int row = idx >> 3, i = idx & 7;
        const double inv = pow(500000.0, -(double)i / 8.0), ang = (double)((const int*)P.in[1 + z])[row] * inv;
        double s, c; sincos(ang, &s, &c);
        rope[row * 16 + i] = (float)c; rope[row * 16 + 8 + i] = (float)s;
    }
}
__device__ __forceinline__ void norm_row_bf16(const float* xrow, const float* gain, bf16* orow, int lane) {
    const f32x4* xr = (const f32x4*)xrow + lane; const f32x4* gr = (const f32x4*)gain + lane;
    f32x4 v[4]; float s = 0.f;
#pragma unroll
    for (int j = 0; j < 4; ++j) { v[j] = xr[64 * j]; s += (v[j].x * v[j].x + v[j].y * v[j].y) + (v[j].z * v[j].z + v[j].w * v[j].w); }
    const float r = 1.0f / sqrtf(wave_sum(s) * (1.f / DM) + EPS);
    unsigned long long* o8 = (unsigned long long*)orow + lane;
#pragma unroll
    for (int j = 0; j < 4; ++j) { const f32x4 g = gr[64 * j]; o8[64 * j] = (unsigned long long)pk2(v[j].x * r * g.x, v[j].y * r * g.y) | ((unsigned long long)pk2(v[j].z * r * g.z, v[j].w * r * g.w) << 32); }
}
__device__ __forceinline__ void norm_row_f32(float* xrow, const float* gain, int lane) {
    f32x4* xr = (f32x4*)xrow + lane; const f32x4* gr = (const f32x4*)gain + lane;
    f32x4 v[4]; float s = 0.f;
#pragma unroll
    for (int j = 0; j < 4; ++j) { v[j] = xr[64 * j]; s += (v[j].x * v[j].x + v[j].y * v[j].y) + (v[j].z * v[j].z + v[j].w * v[j].w); }
    const float r = 1.0f / sqrtf(wave_sum(s) * (1.f / DM) + EPS);
#pragma unroll
    for (int j = 0; j < 4; ++j) { const f32x4 g = gr[64 * j]; xr[64 * j] = v[j] * r * g; }
}
__device__ __forceinline__ unsigned f2o(float s) { const unsigned b = __float_as_uint(s); return (b & 0x80000000u) ? ~b : (b | 0x80000000u); }
__device__ __forceinline__ void unpack8(const v4u v, float* f) { f[0] = bflo(v.x); f[1] = bfhi(v.x); f[2] = bflo(v.y); f[3] = bfhi(v.y); f[4] = bflo(v.z); f[5] = bfhi(v.z); f[6] = bflo(v.w); f[7] = bfhi(v.w); }
__device__ __forceinline__ void load_row64(const bf16* p, float* f) {
    const v4u* q = (const v4u*)p;
#pragma unroll
    for (int i = 0; i < 8; ++i) unpack8(q[i], f + 8 * i);
}
__device__ __forceinline__ float dot64(const LAS float* q, const float* k) {
    float d = 0.f;
#pragma unroll
    for (int i = 0; i < 16; ++i) { const f32x4 qq = *(const LAS f32x4*)(q + 4 * i); d += qq.x * k[4 * i] + qq.y * k[4 * i + 1] + qq.z * k[4 * i + 2] + qq.w * k[4 * i + 3]; }
    return d;
}
__device__ __forceinline__ void dsa_query(const Args& P, unsigned char* ws, int z, int row, LAS unsigned char* wl, int lane) {
    const int b = row >> 12, t = row & (SEQ - 1), n = t + 1;
    LAS unsigned* su = (LAS unsigned*)wl; LAS float* pb = (LAS float*)wl; LAS unsigned short* list = (LAS unsigned short*)(wl + 16384); LAS float* qb = (LAS float*)(wl + 16896);
    const bf16* misc = (const bf16*)(ws + WS_MISC);
    const unsigned long long lt = (1ull << lane) - 1ull;
    int nsel;
    if (n <= 256) { for (int i = lane; i < n; i += 64) list[i] = (unsigned short)i; nsel = n; }
    else {
        { const uint2 v = *(const uint2*)((const bf16*)(ws + WS_IQ) + (size_t)row * 256 + lane * 4); qb[lane * 4] = bflo(v.x); qb[lane * 4 + 1] = bfhi(v.x); qb[lane * 4 + 2] = bflo(v.y); qb[lane * 4 + 3] = bfhi(v.y); }
        float iw[4]; { const uint2 v = *(const uint2*)(misc + (size_t)row * 256 + 192); iw[0] = 0.5f * bflo(v.x); iw[1] = 0.5f * bfhi(v.x); iw[2] = 0.5f * bflo(v.y); iw[3] = 0.5f * bfhi(v.y); }
        WAVE_LDS_SYNC();
        const int nch = (n + 63) >> 6;
        for (int i = 0; i < nch; ++i) {
            const int key = i * 64 + lane; const bool valid = key <= t;
            float kf[64]; load_row64(misc + (size_t)(b * SEQ + (valid ? key : t)) * 256, kf);
            float s = 0.f;
#pragma unroll
            for (int h = 0; h < 4; ++h) s += iw[h] * fmaxf(dot64(qb + h * 64, kf), 0.f);
            su[key] = valid ? f2o(s) : 0u;
        }
        WAVE_LDS_SYNC();
        unsigned prefix = 0u;
        for (int bit = 31; bit >= 0; --bit) {
            const unsigned cand = prefix | (1u << bit); int c = 0;
            for (int i = 0; i < nch; ++i) c += (su[i * 64 + lane] >= cand) ? 1 : 0;
            c = wave_sum_i(c);
            if (c >= 256) prefix = cand;
            if (c == 256) break;
        }
        int cgt = 0;
        for (int i = 0; i < nch; ++i) cgt += (su[i * 64 + lane] > prefix) ? 1 : 0;
        const int need_eq = 256 - wave_sum_i(cgt);
        int base = 0, eq_taken = 0;
        for (int i = 0; i < nch; ++i) {
            const unsigned v = su[i * 64 + lane]; const bool gt = v > prefix, eq = v == prefix;
            const unsigned long long meq = __ballot(eq);
            const bool sel = gt || (eq && (eq_taken + __popcll(meq & lt)) < need_eq);
            const unsigned long long ms = __ballot(sel);
            if (sel) list[base + __popcll(ms & lt)] = (unsigned short)(i * 64 + lane);
            base += __popcll(ms); eq_taken += __popcll(meq);
        }
        nsel = 256;
    }
    { const v4u v = *(const v4u*)((const bf16*)(ws + WS_QA) + (size_t)row * 512 + lane * 8); float f[8]; unpack8(v, f);
#pragma unroll
      for (int e = 0; e < 8; ++e) qb[lane * 8 + e] = f[e]; }
    WAVE_LDS_SYNC();
    const bf16* kva = (const bf16*)(ws + WS_KVA);
    float s[8][4];
#pragma unroll
    for (int j = 0; j < 4; ++j) {
        const int slot = lane + 64 * j; const bool valid = slot < nsel; const int key = list[valid ? slot : 0];
        float kf[64]; load_row64(kva + (size_t)(b * SEQ + key) * 128, kf);
#pragma unroll
        for (int h = 0; h < 8; ++h) s[h][j] = valid ? dot64(qb + h * 64, kf) : NEGF;
    }
    float linv[8];
#pragma unroll
    for (int h = 0; h < 8; ++h) {
        const float m = wave_max(fmaxf(fmaxf(s[h][0], s[h][1]), fmaxf(s[h][2], s[h][3]))); float ls = 0.f;
#pragma unroll
        for (int j = 0; j < 4; ++j) { const float p = __expf(s[h][j] - m); ls += p; pb[h * 256 + lane + 64 * j] = p; }
        linv[h] = 1.0f / wave_sum(ls);
    }
    WAVE_LDS_SYNC();
    float acc[8] = {0.f, 0.f, 0.f, 0.f, 0.f, 0.f, 0.f, 0.f};
    for (int slot = 0; slot < nsel; ++slot) {
        const float v = bf2f(kva[(size_t)(b * SEQ + list[slot]) * 128 + 64 + lane]);
#pragma unroll
        for (int h = 0; h < 8; ++h) acc[h] += pb[h * 256 + slot] * v;
    }
    bf16* ya = (bf16*)(ws + WS_QA) + (size_t)row * 512;
#pragma unroll
    for (int h = 0; h < 8; ++h) ya[h * 64 + lane] = (bf16)f2bf(acc[h] * linv[h]);
    WAVE_LDS_SYNC();
}
typedef short s16x4 __attribute__((ext_vector_type(4)));
typedef short v4i16_t __attribute__((ext_vector_type(4)));
typedef float f32x4v __attribute__((ext_vector_type(4)));
typedef __bf16 bf16x2_t __attribute__((ext_vector_type(2)));
typedef float f32x2_t __attribute__((ext_vector_type(2)));
__device__ __forceinline__ unsigned cvtpk(float lo, float hi) { f32x2_t v = {lo, hi}; bf16x2_t b = __builtin_convertvector(v, bf16x2_t); return __builtin_bit_cast(unsigned, b); }
constexpr float L2E = 1.4426950408889634f;
#ifndef NSA_NOSKIP
#define NSA_NOSKIP 0
#endif
constexpr int NSA_KSTR = 72, NSA_VSTR = 80;
constexpr int NSA_KB = 64 * NSA_KSTR * 2, NSA_VB = 64 * NSA_VSTR * 2;
constexpr int NSA_OFF_K = 0, NSA_OFF_V = 4 * NSA_KB, NSA_OFF_IMPA = NSA_OFF_V + 4 * NSA_VB, NSA_OFF_IMPB = NSA_OFF_IMPA + 64 * 65 * 4, NSA_OFF_UM = NSA_OFF_IMPB + 64 * 65 * 4, NSA_LDS = NSA_OFF_UM + 64;
__device__ __forceinline__ s16x4 tr16(const LAS unsigned char* p) { return __builtin_bit_cast(s16x4, __builtin_amdgcn_ds_read_tr16_b64_v4i16((LAS v4i16_t*)p)); }
__device__ __forceinline__ bf16x8 cat4(s16x4 a, s16x4 b) { return __builtin_shufflevector(a, b, 0, 1, 2, 3, 4, 5, 6, 7); }
__device__ __forceinline__ bf16x8 pack8(float a0, float a1, float a2, float a3, float b0, float b1, float b2, float b3) {
    v4u w; w.x = pg8::cvt_pk_bf16(a0, a1); w.y = pg8::cvt_pk_bf16(a2, a3); w.z = pg8::cvt_pk_bf16(b0, b1); w.w = pg8::cvt_pk_bf16(b2, b3); return __builtin_bit_cast(bf16x8, w);
}
__device__ __forceinline__ float xmax16(float v) { v = fmaxf(v, __shfl_xor(v, 16)); return fmaxf(v, __shfl_xor(v, 32)); }
__device__ __forceinline__ float xsum16(float v) { v += __shfl_xor(v, 16); return v + __shfl_xor(v, 32); }

__device__ __forceinline__ void nsa_block(const LAS unsigned char* Kb, const LAS unsigned char* Vb, const bf16x8 (&qf)[2], bool sel, int klo, int khi, float& mrow, float& lrow, f32x4v (&o)[4], int lane) {
    const int j = lane & 15, gq = lane >> 4;
    f32x4v s[4];
#pragma unroll
    for (int kt = 0; kt < 4; ++kt) {
        s[kt] = (f32x4v){0.f, 0.f, 0.f, 0.f};
#pragma unroll
        for (int ks = 0; ks < 2; ++ks) {
            const bf16x8 kf = *(const LAS bf16x8*)(Kb + ((16 * kt + j) * NSA_KSTR + 8 * gq + 32 * ks) * 2);
            s[kt] = __builtin_amdgcn_mfma_f32_16x16x32_bf16(kf, qf[ks], s[kt], 0, 0, 0);
        }
    }
    float bm = NEGF;
#pragma unroll
    for (int kt = 0; kt < 4; ++kt)
#pragma unroll
        for (int e = 0; e < 4; ++e) { const int ko = 16 * kt + 4 * gq + e; const bool ok = sel && ko >= klo && ko <= khi; const float v = ok ? s[kt][e] : NEGF; s[kt][e] = v; bm = fmaxf(bm, v); }
    bm = xmax16(bm);
    const float mnew = fmaxf(mrow, bm), alpha = __builtin_amdgcn_exp2f(mrow - mnew);
    mrow = mnew;
    float ps = 0.f;
#pragma unroll
    for (int kt = 0; kt < 4; ++kt)
#pragma unroll
        for (int e = 0; e < 4; ++e) { const float p = __builtin_amdgcn_exp2f(s[kt][e] - mnew); s[kt][e] = p; ps += p; }
    lrow = lrow * alpha + ps;
#pragma unroll
    for (int dt = 0; dt < 4; ++dt) o[dt] *= alpha;
#pragma unroll
    for (int kk = 0; kk < 2; ++kk) {
        const bf16x8 pf = pack8(s[2 * kk][0], s[2 * kk][1], s[2 * kk][2], s[2 * kk][3], s[2 * kk + 1][0], s[2 * kk + 1][1], s[2 * kk + 1][2], s[2 * kk + 1][3]);
#pragma unroll
        for (int dt = 0; dt < 4; ++dt) {
            const LAS unsigned char* va = Vb + ((32 * kk + 4 * gq + (j >> 2)) * NSA_VSTR + 16 * dt + 4 * (j & 3)) * 2;
            const bf16x8 vf = cat4(tr16(va), tr16(va + 16 * NSA_VSTR * 2));
            o[dt] = __builtin_amdgcn_mfma_f32_16x16x32_bf16(vf, pf, o[dt], 0, 0, 0);
        }
    }
}
__device__ __forceinline__ void nsa_fetch(const bf16* kv, int b, int jb, int g, int tid, v4u& kr, v4u& vr) {
    const bf16* p = kv + (size_t)(b * SEQ + 64 * jb + (tid >> 3)) * 256 + g * 64 + (tid & 7) * 8;
    kr = *(const v4u*)p; vr = *(const v4u*)(p + 128);
}
__device__ __forceinline__ void nsa_stash(LAS unsigned char* Kb, LAS unsigned char* Vb, int tid, const v4u& kr, const v4u& vr) {
    *(LAS v4u*)(Kb + ((tid >> 3) * NSA_KSTR + (tid & 7) * 8) * 2) = kr; *(LAS v4u*)(Vb + ((tid >> 3) * NSA_VSTR + (tid & 7) * 8) * 2) = vr;
}
__device__ __forceinline__ void nsa_block2(const LAS unsigned char* Kb, const LAS unsigned char* Vb, const bf16x8 (&qf)[2][2], const bool (&sel)[2], const int (&klo)[2], const int (&khi)[2],
                                           float (&mrow)[2], float (&lrow)[2], f32x4v (&o)[2][4], int lane) {
    const int j = lane & 15, gq = lane >> 4;
    f32x4v s[2][4];
#pragma unroll
    for (int kt = 0; kt < 4; ++kt) {
        s[0][kt] = (f32x4v){0.f, 0.f, 0.f, 0.f}; s[1][kt] = (f32x4v){0.f, 0.f, 0.f, 0.f};
#pragma unroll
        for (int ks = 0; ks < 2; ++ks) {
            const bf16x8 kf = *(const LAS bf16x8*)(Kb + ((16 * kt + j) * NSA_KSTR + 8 * gq + 32 * ks) * 2);
            s[0][kt] = __builtin_amdgcn_mfma_f32_16x16x32_bf16(kf, qf[0][ks], s[0][kt], 0, 0, 0);
            s[1][kt] = __builtin_amdgcn_mfma_f32_16x16x32_bf16(kf, qf[1][ks], s[1][kt], 0, 0, 0);
        }
    }
#pragma unroll
    for (int rg = 0; rg < 2; ++rg) {
        float bm = NEGF;
#pragma unroll
        for (int kt = 0; kt < 4; ++kt)
#pragma unroll
            for (int e = 0; e < 4; ++e) { const int ko = 16 * kt + 4 * gq + e; const bool ok = sel[rg] && ko >= klo[rg] && ko <= khi[rg]; const float v = ok ? s[rg][kt][e] : NEGF; s[rg][kt][e] = v; bm = fmaxf(bm, v); }
        bm = xmax16(bm);
        const float mnew = fmaxf(mrow[rg], bm), alpha = __builtin_amdgcn_exp2f(mrow[rg] - mnew);
        mrow[rg] = mnew;
        float ps = 0.f;
#pragma unroll
        for (int kt = 0; kt < 4; ++kt)
#pragma unroll
            for (int e = 0; e < 4; ++e) { const float p = __builtin_amdgcn_exp2f(s[rg][kt][e] - mnew); s[rg][kt][e] = p; ps += p; }
        lrow[rg] = lrow[rg] * alpha + ps;
#pragma unroll
        for (int dt = 0; dt < 4; ++dt) o[rg][dt] *= alpha;
    }
#pragma unroll
    for (int kk = 0; kk < 2; ++kk) {
        const bf16x8 pf0 = pack8(s[0][2 * kk][0], s[0][2 * kk][1], s[0][2 * kk][2], s[0][2 * kk][3], s[0][2 * kk + 1][0], s[0][2 * kk + 1][1], s[0][2 * kk + 1][2], s[0][2 * kk + 1][3]);
        const bf16x8 pf1 = pack8(s[1][2 * kk][0], s[1][2 * kk][1], s[1][2 * kk][2], s[1][2 * kk][3], s[1][2 * kk + 1][0], s[1][2 * kk + 1][1], s[1][2 * kk + 1][2], s[1][2 * kk + 1][3]);
#pragma unroll
        for (int dt = 0; dt < 4; ++dt) {
            const LAS unsigned char* va = Vb + ((32 * kk + 4 * gq + (j >> 2)) * NSA_VSTR + 16 * dt + 4 * (j & 3)) * 2;
            const bf16x8 vf = cat4(tr16(va), tr16(va + 16 * NSA_VSTR * 2));
            o[0][dt] = __builtin_amdgcn_mfma_f32_16x16x32_bf16(vf, pf0, o[0][dt], 0, 0, 0);
            o[1][dt] = __builtin_amdgcn_mfma_f32_16x16x32_bf16(vf, pf1, o[1][dt], 0, 0, 0);
        }
        }
}
template <int MODE>
__device__ __forceinline__ void nsa_attend(const bf16* kv, unsigned long long mask, int b, int g, int c, int tid, int lane, LAS unsigned char* Kb, LAS unsigned char* Vb, const bf16x8 (&qf)[2][2],
                                           const unsigned long long (&rmask)[2], const unsigned long long (&gmask)[2], const int (&trow)[2], float (&mrow)[2], float (&lrow)[2], f32x4v (&o)[2][4]) {
    unsigned long long rem = mask; int st = 0;
    int jb[2]; bool have1;
    jb[0] = (int)__builtin_ctzll(rem); rem &= rem - 1ull; have1 = rem != 0ull; jb[1] = have1 ? (int)__builtin_ctzll(rem) : jb[0]; rem &= rem - 1ull;
    v4u kr[2], vr[2];
    nsa_fetch(kv, b, jb[0], g, tid, kr[0], vr[0]); nsa_fetch(kv, b, jb[1], g, tid, kr[1], vr[1]);
    nsa_stash(Kb, Vb, tid, kr[0], vr[0]); nsa_stash(Kb + NSA_KB, Vb + NSA_VB, tid, kr[1], vr[1]);
    __syncthreads();
    for (;;) {
        const bool more = rem != 0ull; int jn[2]; bool nhave1 = false;
        if (more) { jn[0] = (int)__builtin_ctzll(rem); rem &= rem - 1ull; nhave1 = rem != 0ull; jn[1] = nhave1 ? (int)__builtin_ctzll(rem) : jn[0]; rem &= rem - 1ull;
                    nsa_fetch(kv, b, jn[0], g, tid, kr[0], vr[0]); nsa_fetch(kv, b, jn[1], g, tid, kr[1], vr[1]); }
        else { jn[0] = jb[0]; jn[1] = jb[0]; }
#pragma unroll
        for (int bi = 0; bi < 2; ++bi) if (bi == 0 || have1) {
            const int jj = jb[bi]; const LAS unsigned char* kb_ = Kb + (st * 2 + bi) * NSA_KB; const LAS unsigned char* vb_ = Vb + (st * 2 + bi) * NSA_VB;
            bool sel[2]; int klo[2], khi[2]; bool act[2];
#pragma unroll
            for (int rg = 0; rg < 2; ++rg) { const int o6 = trow[rg] & 63;
                if (MODE == 0) { sel[rg] = (rmask[rg] >> jj) & 1ull; act[rg] = (gmask[rg] >> jj) & 1ull; klo[rg] = 0; khi[rg] = (jj == c) ? o6 : 63; }
                else { sel[rg] = true; act[rg] = true; klo[rg] = (jj == c - 4) ? o6 + 1 : 0; khi[rg] = (jj == c) ? o6 : 63; } }
            if (act[0] || act[1]) {
                nsa_block2(kb_, vb_, qf, sel, klo, khi, mrow, lrow, o, lane);
            }
        }
        if (!more) break;
        nsa_stash(Kb + ((st ^ 1) * 2) * NSA_KB, Vb + ((st ^ 1) * 2) * NSA_VB, tid, kr[0], vr[0]); nsa_stash(Kb + ((st ^ 1) * 2 + 1) * NSA_KB, Vb + ((st ^ 1) * 2 + 1) * NSA_VB, tid, kr[1], vr[1]);
        __syncthreads();
        st ^= 1; jb[0] = jn[0]; jb[1] = jn[1]; have1 = nhave1;
    }
}
#if defined(PROBE_CMP)
__device__ __forceinline__ void nsa_probe_store(unsigned char* ws, int row, int head, int gq, const f32x4v (&v)[4]) {
    bf16* pb_ = (bf16*)(ws + 497 * MiB);
    for (int dt = 0; dt < 4; ++dt) { uint2 w; w.x = cvtpk(v[dt][0], v[dt][1]); w.y = cvtpk(v[dt][2], v[dt][3]); *(uint2*)(pb_ + (size_t)row * 512 + head * 64 + 16 * dt + 4 * gq) = w; }
}
#endif
__device__ __forceinline__ void nsa_unit(unsigned char* ws, int unit, LAS unsigned char* lds, int tid_in, bf16* yout) {
    int tid = tid_in; asm volatile("" : "+v"(tid));
    const int lane = tid & 63, wave = __builtin_amdgcn_readfirstlane(tid >> 6), j = lane & 15, gq = lane >> 4;
    const int c = unit & 63, g = (unit >> 6) & 1, b = unit >> 7, bg = b * 2 + g;
    LAS float* impa = (LAS float*)(lds + NSA_OFF_IMPA); LAS float* impb = (LAS float*)(lds + NSA_OFF_IMPB);
    LAS unsigned long long* um = (LAS unsigned long long*)(lds + NSA_OFF_UM);
    for (int i = tid; i < 2 * 64 * 65; i += 512) impa[i] = 0.f;
    bf16* qc = (bf16*)(ws + WS_QC);
    const bf16* misc = (const bf16*)(ws + WS_MISC);
    bf16x8 qf[2][2]; float gate[2][3]; int trow[2];
#pragma unroll
    for (int rg = 0; rg < 2; ++rg) {
        const int q = 8 * wave + 4 * rg + (j >> 2), t = 64 * c + q, row = b * SEQ + t, head = g * 4 + (j & 3);
        trow[rg] = t;
#pragma unroll
        for (int ks = 0; ks < 2; ++ks) qf[rg][ks] = *(const bf16x8*)(qc + (size_t)row * 512 + head * 64 + 8 * gq + 32 * ks);
#pragma unroll
        for (int e = 0; e < 3; ++e) gate[rg][e] = __builtin_amdgcn_rcpf(1.0f + __expf(-bf2f(misc[(size_t)row * 256 + 196 + head * 3 + e])));
    }
    f32x4v otot[2][4];
    __syncthreads();
    const int nT = (c >> 2) + 1;
    const bf16* kc = (const bf16*)(ws + WS_KC) + (size_t)bg * 256 * 64; const bf16* vct = (const bf16*)(ws + WS_VC) + (size_t)bg * 64 * 256;
#pragma unroll
    for (int rg = 0; rg < 2; ++rg) {
        const int t = trow[rg], nv = t >= 31 ? ((t - 15) >> 4) : 0;
        f32x4v s[16]; float mx = NEGF;
#pragma unroll
        for (int T = 0; T < 16; ++T) {
            s[T] = (f32x4v){0.f, 0.f, 0.f, 0.f};
            if (T < nT) {
#pragma unroll
                for (int ks = 0; ks < 2; ++ks) { const bf16x8 kf = *(const bf16x8*)(kc + (size_t)(16 * T + j) * 64 + 8 * gq + 32 * ks); s[T] = __builtin_amdgcn_mfma_f32_16x16x32_bf16(kf, qf[rg][ks], s[T], 0, 0, 0); }
#pragma unroll
                for (int e = 0; e < 4; ++e) { const float v = (16 * T + 4 * gq + e < nv) ? s[T][e] : NEGF; s[T][e] = v; mx = fmaxf(mx, v); }
            }
        }
        mx = xmax16(mx);
        float ls = 0.f;
#pragma unroll
        for (int T = 0; T < 16; ++T) if (T < nT) {
#pragma unroll
            for (int e = 0; e < 4; ++e) { const float p = (16 * T + 4 * gq + e < nv) ? __builtin_amdgcn_exp2f(s[T][e] - mx) : 0.f; s[T][e] = p; ls += p; }
        }
        ls = xsum16(ls);
        const float inv = nv > 0 ? __builtin_amdgcn_rcpf(ls) : 0.f;
        const int q = 8 * wave + 4 * rg + (j >> 2);
#pragma unroll
        for (int T = 0; T < 16; ++T) if (T < nT) {
#pragma unroll
            for (int e = 0; e < 4; ++e) s[T][e] *= inv;
            float a = s[T][0] + s[T][1] + s[T][2] + 0.5f * s[T][3], bb = 0.5f * s[T][3];
            a += __shfl_xor(a, 1); a += __shfl_xor(a, 2); bb += __shfl_xor(bb, 1); bb += __shfl_xor(bb, 2);
            if ((j & 3) == 0) { impa[q * 65 + 4 * T + gq] = a; impb[q * 65 + 4 * T + gq + 1] = bb; }
        }
        f32x4v oc[4];
#pragma unroll
        for (int dt = 0; dt < 4; ++dt) oc[dt] = (f32x4v){0.f, 0.f, 0.f, 0.f};
#pragma unroll
        for (int kk = 0; kk < 8; ++kk) if (2 * kk < nT) {
            const bf16x8 pf = pack8(s[2 * kk][0], s[2 * kk][1], s[2 * kk][2], s[2 * kk][3], s[2 * kk + 1][0], s[2 * kk + 1][1], s[2 * kk + 1][2], s[2 * kk + 1][3]);
#pragma unroll
            for (int dt = 0; dt < 4; ++dt) {
                const bf16* vp = vct + (size_t)(16 * dt + j) * 256 + 32 * kk + 4 * gq;
                const s16x4 v0 = *(const s16x4*)vp, v1 = *(const s16x4*)(vp + 16);
                oc[dt] = __builtin_amdgcn_mfma_f32_16x16x32_bf16(cat4(v0, v1), pf, oc[dt], 0, 0, 0);
            }
        }
#pragma unroll
        for (int dt = 0; dt < 4; ++dt) otot[rg][dt] = oc[dt] * gate[rg][0];
        __builtin_amdgcn_sched_barrier(0);
#if defined(PROBE_CMP)
        if (PROBE_BR == 0) nsa_probe_store(ws, b * SEQ + trow[rg], g * 4 + (j & 3), gq, otot[rg]);
#endif
    }
    __syncthreads();
    unsigned long long smask[8], mymask = 0ull;
#pragma unroll
    for (int qi = 0; qi < 8; ++qi) {
        const int q = 8 * wave + qi;
#if PROBE == 4
        const float imp = ((const float*)(ws + 500 * MiB))[((size_t)(b * SEQ + 64 * c + q) * 2 + g) * 64 + lane];
#else
        const float imp = impa[q * 65 + lane] + impb[q * 65 + lane];
#endif
#if PROBE && (PROBE != 5 || defined(PROBE5_IMP))
        ((float*)(ws + 516 * MiB))[((size_t)(b * SEQ + 64 * c + q) * 2 + g) * 64 + lane] = (lane <= c) ? imp : 0.f;
#endif
        const bool forced = (lane == 0) || (lane == c), adm = lane <= c;
        unsigned key = forced ? (0xFFFFFF00u | (unsigned)(63 - lane)) : (adm ? ((__float_as_uint(imp) & 0xFFFFFFC0u) | (unsigned)(63 - lane)) : 0u);
        unsigned long long mk = 0ull;
#if TOP8_RANK
        { int rank = 0;
#pragma unroll
          for (int jj = 0; jj < 64; ++jj) { const unsigned kk = (unsigned)__builtin_amdgcn_readlane((int)key, jj); rank += (kk > key) ? 1 : 0; }
          mk = __ballot(key != 0u && rank < 8); }
#else
        for (int k = 0; k < 8; ++k) { const unsigned mx = wave_max_u(key); if (mx == 0u) break; const int win = 63 - (int)(mx & 63u); mk |= 1ull << win; if (lane == win) key = 0u; }
#endif
        mk = ((unsigned long long)__builtin_amdgcn_readfirstlane((unsigned)(mk >> 32)) << 32) | (unsigned long long)__builtin_amdgcn_readfirstlane((unsigned)mk);
#ifdef FIXSEL
        { mk = 1ull | (1ull << c); for (int d = 1; d <= 6; ++d) mk |= 1ull << (((FIXHOM ? 0 : q * 7) + d * 5) % (c + 1)); }
#endif
#if PROBE == 2
        mk = ((const unsigned long long*)(ws + 496 * MiB))[(size_t)(b * SEQ + 64 * c + q) * 2 + g];
        mk = ((unsigned long long)__builtin_amdgcn_readfirstlane((unsigned)(mk >> 32)) << 32) | (unsigned long long)__builtin_amdgcn_readfirstlane((unsigned)mk);
#endif
#if PROBE == 5
        if (lane == 0) ((unsigned long long*)(ws + 498 * MiB))[(size_t)(b * SEQ + 64 * c + q) * 2 + g] = mk;
#endif
#if PROBE == 5 && !defined(PROBE5_IMP)
        ((float*)(ws + 516 * MiB))[((size_t)(b * SEQ + 64 * c + q) * 2 + g) * 64 + lane] = ((mk >> lane) & 1ull) ? 1.f : 0.f;
#endif
        smask[qi] = mk; mymask |= mk;
    }
    if (lane == 0) um[wave] = mymask;
    __syncthreads();
    unsigned long long umask = 0ull;
#pragma unroll
    for (int w = 0; w < 8; ++w) umask |= um[w];
    umask = ((unsigned long long)__builtin_amdgcn_readfirstlane((unsigned)(umask >> 32)) << 32) | (unsigned long long)__builtin_amdgcn_readfirstlane((unsigned)umask);
    unsigned long long rmask[2];
    { LAS unsigned long long* qm = (LAS unsigned long long*)(lds + NSA_OFF_IMPA);
      __syncthreads();
#pragma unroll
      for (int qi = 0; qi < 8; ++qi) if (lane == 0) qm[8 * wave + qi] = smask[qi];
      __syncthreads();
#pragma unroll
      for (int rg = 0; rg < 2; ++rg) rmask[rg] = qm[8 * wave + 4 * rg + (j >> 2)]; }
    const unsigned long long gmask[2] = {smask[0] | smask[1] | smask[2] | smask[3], smask[4] | smask[5] | smask[6] | smask[7]};
    const bf16* kvs = (const bf16*)(ws + WS_KVS); const bf16* kvw = (const bf16*)(ws + WS_KVW);
    LAS unsigned char* Kb = lds + NSA_OFF_K; LAS unsigned char* Vb = lds + NSA_OFF_V;
    {
        float mrow[2] = {NEGF, NEGF}, lrow[2] = {0.f, 0.f}; f32x4v o[2][4];
#pragma unroll
        for (int rg = 0; rg < 2; ++rg)
#pragma unroll
            for (int dt = 0; dt < 4; ++dt) o[rg][dt] = (f32x4v){0.f, 0.f, 0.f, 0.f};
        nsa_attend<0>(kvs, umask, b, g, c, tid, lane, Kb, Vb, qf, rmask, gmask, trow, mrow, lrow, o);
#if DUP == 8
        { __syncthreads(); float m2[2] = {NEGF, NEGF}, l2[2] = {0.f, 0.f}; f32x4v o2[2][4];
          for (int rg = 0; rg < 2; ++rg) for (int dt = 0; dt < 4; ++dt) o2[rg][dt] = (f32x4v){0.f, 0.f, 0.f, 0.f};
          nsa_attend<0>(kvs, umask, b, g, c, tid, lane, Kb, Vb, qf, rmask, gmask, trow, m2, l2, o2);
          bf16* dmy = (bf16*)(ws + WS_BU) + (size_t)(b * SEQ + trow[0]) * 512 + (g * 4 + (j & 3)) * 64 + 4 * gq;
          for (int rg = 0; rg < 2; ++rg) for (int dt = 0; dt < 4; ++dt) { uint2 w; w.x = pg8::cvt_pk_bf16(o2[rg][dt][0] + l2[rg], o2[rg][dt][1]); w.y = pg8::cvt_pk_bf16(o2[rg][dt][2], o2[rg][dt][3]); *(uint2*)(dmy + 16 * dt) = w; } }
#endif
#pragma unroll
        for (int rg = 0; rg < 2; ++rg) { const float sc = gate[rg][1] * __builtin_amdgcn_rcpf(xsum16(lrow[rg]));
#pragma unroll
            for (int dt = 0; dt < 4; ++dt) otot[rg][dt] += o[rg][dt] * sc;
#if defined(PROBE_CMP)
            if (PROBE_BR == 1) { f32x4v t_[4]; for (int dt = 0; dt < 4; ++dt) t_[dt] = o[rg][dt] * sc; nsa_probe_store(ws, b * SEQ + trow[rg], g * 4 + (j & 3), gq, t_); }
#endif
            }
        __syncthreads();
    }
    {
        float mrow[2] = {NEGF, NEGF}, lrow[2] = {0.f, 0.f}; f32x4v o[2][4];
#pragma unroll
        for (int rg = 0; rg < 2; ++rg)
#pragma unroll
            for (int dt = 0; dt < 4; ++dt) o[rg][dt] = (f32x4v){0.f, 0.f, 0.f, 0.f};
        { const int j0 = c - 4 > 0 ? c - 4 : 0; const unsigned long long wmask = ((c == 63 ? ~0ull : ((1ull << (c + 1)) - 1ull)) >> j0) << j0;
          nsa_attend<1>(kvw, wmask, b, g, c, tid, lane, Kb, Vb, qf, rmask, gmask, trow, mrow, lrow, o); }
#pragma unroll
        for (int rg = 0; rg < 2; ++rg) { const float sc = gate[rg][2] * __builtin_amdgcn_rcpf(xsum16(lrow[rg]));
#pragma unroll
            for (int dt = 0; dt < 4; ++dt) otot[rg][dt] += o[rg][dt] * sc;
#if defined(PROBE_CMP)
            if (PROBE_BR == 2) { f32x4v t_[4]; for (int dt = 0; dt < 4; ++dt) t_[dt] = o[rg][dt] * sc; nsa_probe_store(ws, b * SEQ + trow[rg], g * 4 + (j & 3), gq, t_); }
#endif
            }
    }
#pragma unroll
    for (int rg = 0; rg < 2; ++rg) {
        const int row = b * SEQ + trow[rg], head = g * 4 + (j & 3);
#pragma unroll
        for (int dt = 0; dt < 4; ++dt) {
            uint2 w; w.x = pg8::cvt_pk_bf16(otot[rg][dt][0], otot[rg][dt][1]); w.y = pg8::cvt_pk_bf16(otot[rg][dt][2], otot[rg][dt][3]);
            *(uint2*)(yout + (size_t)row * 512 + head * 64 + 16 * dt + 4 * gq) = w;
        }
    }
    __syncthreads();
}
__device__ __forceinline__ void prep_kva16(unsigned char* ws, int task, int lane) {
    const int j = lane & 15, gq = lane >> 4, row = task * 16 + j;
    const bf16* misc = (const bf16*)(ws + WS_MISC) + (size_t)row * 256 + 64;
    const bf16* wu = (const bf16*)(ws + WS_W + WO_UKV);
    bf16x8 cf[4]; float ss = 0.f;
#pragma unroll
    for (int ks = 0; ks < 4; ++ks) { const v4u v = *(const v4u*)(misc + 8 * gq + 32 * ks); cf[ks] = __builtin_bit_cast(bf16x8, v); float f[8]; unpack8(v, f);
#pragma unroll
        for (int e = 0; e < 8; ++e) ss += f[e] * f[e]; }
    ss = xsum16(ss);
    const float r = 1.0f / sqrtf(ss * (1.f / 128.f) + EPS);
    const float* rp = (const float*)(ws + WS_ROPE) + (size_t)row * 16;
    bf16* o = (bf16*)(ws + WS_KVA) + (size_t)row * 128;
#pragma unroll
    for (int ct = 0; ct < 8; ++ct) {
        f32x4v a = {0.f, 0.f, 0.f, 0.f};
#pragma unroll
        for (int ks = 0; ks < 4; ++ks) { const bf16x8 wf = *(const bf16x8*)(wu + (size_t)(16 * ct + j) * 128 + 8 * gq + 32 * ks); a = __builtin_amdgcn_mfma_f32_16x16x32_bf16(wf, cf[ks], a, 0, 0, 0); }
        a *= r;
        if (ct == 0) {
            const float c0 = rp[2 * gq], s0 = rp[8 + 2 * gq], c1 = rp[2 * gq + 1], s1 = rp[8 + 2 * gq + 1];
            const float x0 = a[0], x1 = a[1], x2 = a[2], x3 = a[3];
            a[0] = x0 * c0 - x1 * s0; a[1] = x1 * c0 + x0 * s0; a[2] = x2 * c1 - x3 * s1; a[3] = x3 * c1 + x2 * s1;
        }
        uint2 w; w.x = cvtpk(a[0], a[1]); w.y = cvtpk(a[2], a[3]);
        *(uint2*)(o + 16 * ct + 4 * gq) = w;
    }
}
__device__ __forceinline__ void prep_pool16(unsigned char* ws, int task, int lane) {
    const int j = lane & 15, gq = lane >> 4, row = task * 16 + j, t = row & (SEQ - 1);
    const bf16* bu = (const bf16*)(ws + WS_BU);
    const bf16* pw = (const bf16*)(ws + WS_W + WO_POOL);
    bf16* yb = (bf16*)(ws + WS_YB) + (size_t)row * 512;
#pragma unroll 1
    for (int g = 0; g < 4; ++g) {
        const int w = 2 << g, lo = (t + 1 - w) > 0 ? (t + 1 - w) : 0, cnt = t + 1 - lo; const float inv = 1.0f / (float)cnt;
        bf16x8 pf[4];
#pragma unroll
        for (int ks = 0; ks < 4; ++ks) {
            const bf16* p = bu + (size_t)row * 512 + g * 128 + 8 * gq + 32 * ks;
            float sum[8] = {0.f, 0.f, 0.f, 0.f, 0.f, 0.f, 0.f, 0.f}, cur[8];
            { const v4u v = *(const v4u*)p; unpack8(v, cur);
#pragma unroll
              for (int e = 0; e < 8; ++e) sum[e] = cur[e]; }
#pragma unroll 2
            for (int i = 1; i < w; ++i) { const bool ok = i < cnt; const v4u v = *(const v4u*)(p - (size_t)(ok ? i : 0) * 512); float f[8]; unpack8(v, f);
#pragma unroll
                for (int e = 0; e < 8; ++e) sum[e] += ok ? f[e] : 0.f; }
            __builtin_amdgcn_sched_barrier(0);
            pf[ks] = pack8(sum[0] * inv - cur[0], sum[1] * inv - cur[1], sum[2] * inv - cur[2], sum[3] * inv - cur[3], sum[4] * inv - cur[4], sum[5] * inv - cur[5], sum[6] * inv - cur[6], sum[7] * inv - cur[7]);
        }
#pragma unroll
        for (int dt = 0; dt < 8; ++dt) {
            f32x4v a = {0.f, 0.f, 0.f, 0.f};
#pragma unroll
            for (int ks = 0; ks < 4; ++ks) {
#if POOLDBG == 1
                bf16x8 wf; for (int e = 0; e < 8; ++e) wf[e] = (short)0x3c00;
#else
                const bf16x8 wf = *(const bf16x8*)(pw + (size_t)(g * 128 + 16 * dt + j) * 128 + 8 * gq + 32 * ks);
#endif
#if POOLDBG == 2
                bf16x8 pz; for (int e = 0; e < 8; ++e) pz[e] = (short)0x3c00; a = __builtin_amdgcn_mfma_f32_16x16x32_bf16(wf, pz, a, 0, 0, 0);
#else
                a = __builtin_amdgcn_mfma_f32_16x16x32_bf16(wf, pf[ks], a, 0, 0, 0);
#endif
            }
            uint2 wv; wv.x = cvtpk(a[0], a[1]); wv.y = cvtpk(a[2], a[3]);
            *(uint2*)(yb + g * 128 + 16 * dt + 4 * gq) = wv;
        }
    }
}
__device__ __forceinline__ float gelu_tanh_f(float x) { const float u = 0.7978845608028654f * (x + 0.044715f * x * x * x); const float e = __expf(2.0f * u); return 0.5f * x * (1.0f + (1.0f - 2.0f / (e + 1.0f))); }
__device__ __forceinline__ void prep_cmp16(unsigned char* ws, int task, int lane) {
    const int j = lane & 15, gq = lane >> 4;
    const int i0 = (task & 15) * 16, bg = (task >> 4) & 15, br = task >> 8, b = bg >> 1, g = bg & 1, i = i0 + j;
    const bf16* kvc = (const bf16*)(ws + WS_KVC);
    const bf16* w1 = (const bf16*)(ws + WS_W + WO_CW1) + (size_t)br * 128 * 2048;
    const bf16* w2 = (const bf16*)(ws + WS_W + WO_CW2) + (size_t)br * 64 * 128;
    const float* posb = (const float*)(ws + WS_W + WO_POSB) + br * 128;
    f32x4v h[8];
#pragma unroll
    for (int nt = 0; nt < 8; ++nt) h[nt] = (f32x4v){0.f, 0.f, 0.f, 0.f};
#pragma unroll 2
    for (int ks = 0; ks < 64; ++ks) {
        const int l = ks >> 1; int tok = 16 * i + l; tok = tok > SEQ - 1 ? SEQ - 1 : tok;
        const bf16x8 ff = *(const bf16x8*)(kvc + (size_t)(b * SEQ + tok) * 256 + br * 128 + g * 64 + 32 * (ks & 1) + 8 * gq);
#pragma unroll
        for (int nt = 0; nt < 8; ++nt) { const bf16x8 wf = *(const bf16x8*)(w1 + (size_t)(16 * nt + j) * 2048 + 32 * ks + 8 * gq); h[nt] = __builtin_amdgcn_mfma_f32_16x16x32_bf16(wf, ff, h[nt], 0, 0, 0); }
    }
#pragma unroll
    for (int nt = 0; nt < 8; ++nt) { const f32x4v pbv = *(const f32x4v*)(posb + 16 * nt + 4 * gq);
#pragma unroll
        for (int e = 0; e < 4; ++e) h[nt][e] = gelu_tanh_f(h[nt][e] + pbv[e]); }
    f32x4v o[4];
#pragma unroll
    for (int dt = 0; dt < 4; ++dt) o[dt] = (f32x4v){0.f, 0.f, 0.f, 0.f};
#pragma unroll
    for (int kk = 0; kk < 4; ++kk) {
        const bf16x8 hf = pack8(h[2 * kk][0], h[2 * kk][1], h[2 * kk][2], h[2 * kk][3], h[2 * kk + 1][0], h[2 * kk + 1][1], h[2 * kk + 1][2], h[2 * kk + 1][3]);
#pragma unroll
        for (int dt = 0; dt < 4; ++dt) { const bf16* wp = w2 + (size_t)(16 * dt + j) * 128 + 32 * kk + 4 * gq; const s16x4 v0 = *(const s16x4*)wp, v1 = *(const s16x4*)(wp + 16);
            o[dt] = __builtin_amdgcn_mfma_f32_16x16x32_bf16(cat4(v0, v1), hf, o[dt], 0, 0, 0); }
    }
    const bool dead = i == 255;
    if (br == 0) { bf16* kc = (bf16*)(ws + WS_KC) + ((size_t)bg * 256 + i) * 64;
#pragma unroll
        for (int dt = 0; dt < 4; ++dt) { uint2 w; w.x = dead ? 0u : cvtpk(o[dt][0], o[dt][1]); w.y = dead ? 0u : cvtpk(o[dt][2], o[dt][3]); *(uint2*)(kc + 16 * dt + 4 * gq) = w; }
    } else { bf16* vct = (bf16*)(ws + WS_VC) + (size_t)bg * 64 * 256 + i;
#pragma unroll
        for (int dt = 0; dt < 4; ++dt)
#pragma unroll
            for (int e = 0; e < 4; ++e) vct[(size_t)(16 * dt + 4 * gq + e) * 256] = dead ? (bf16)0 : (bf16)f2bf(o[dt][e]);
    }
}
__device__ __forceinline__ void phase_prep(const Args& P, unsigned char* ws, int z, int l, LAS unsigned char* lds, int gw, int NGW, int lane, int wave) {
    asm volatile("" : "+v"(lane)); lane &= 63; asm volatile("" : "+s"(gw), "+s"(NGW));
    for (int it = gw; it < 512; it += NGW) prep_cmp16(ws, it, lane);
    for (int it = gw; it < M / 16; it += NGW) { prep_kva16(ws, it, lane); prep_pool16(ws, it, lane); }
}
constexpr int DSA_OFF_CNT = 0, DSA_OFF_PC = 1024, DSA_OFF_LIST = DSA_OFF_PC + 32 * 16 * 4, DSA_OFF_V = DSA_OFF_LIST + 16 * 256 * 2, DSA_VB = 64 * NSA_VSTR * 2, DSA_LDS = DSA_OFF_V + 8 * DSA_VB;
#define DSA_FOR_TILES(...) _Pragma("unroll") for (int G8 = 0; G8 < 4; ++G8) { if (G8 < ngrp) { _Pragma("unroll") for (int T8 = 0; T8 < 8; ++T8) { const int T = G8 * 8 + T8; __VA_ARGS__ } } }
__device__ __forceinline__ void cnt_ge(int& c, unsigned u, unsigned cand) { asm volatile("v_cmp_ge_u32_e32 vcc, %1, %2\n\tv_addc_co_u32_e32 %0, vcc, 0, %0, vcc" : "+v"(c) : "v"(u), "v"(cand) : "vcc"); }
__device__ __forceinline__ void cnt_gt(int& c, unsigned u, unsigned cand) { asm volatile("v_cmp_gt_u32_e32 vcc, %1, %2\n\tv_addc_co_u32_e32 %0, vcc, 0, %0, vcc" : "+v"(c) : "v"(u), "v"(cand) : "vcc"); }
__device__ __forceinline__ void cnt_le(int& c, unsigned u, unsigned cand) { asm volatile("v_cmp_le_u32_e32 vcc, %1, %2\n\tv_addc_co_u32_e32 %0, vcc, 0, %0, vcc" : "+v"(c) : "v"(u), "v"(cand) : "vcc"); }
__device__ __forceinline__ int dsa_total(LAS unsigned* cnt, int par, int wave, int j, int gq, int c) {
    c += __shfl_xor(c, 16); c += __shfl_xor(c, 32);
    if (gq == 0) cnt[(par * 8 + wave) * 16 + j] = (unsigned)c;
    __syncthreads();
    int tot = 0;
#pragma unroll
    for (int w = 0; w < 8; ++w) tot += (int)cnt[(par * 8 + w) * 16 + j];
    return tot;
}
__device__ __forceinline__ void dsa_unit(unsigned char* ws, int unit, LAS unsigned char* lds, int tid_in, bf16* yout) {
    int tid = tid_in; asm volatile("" : "+v"(tid));
    const int lane = tid & 63, wave = __builtin_amdgcn_readfirstlane(tid >> 6), j = lane & 15, gq = lane >> 4;
    const int b = unit >> 8, q0 = (unit & 255) * 16, t = q0 + j, row = b * SEQ + t;
    LAS unsigned* cnt = (LAS unsigned*)(lds + DSA_OFF_CNT); LAS unsigned* pc = (LAS unsigned*)(lds + DSA_OFF_PC);
    LAS unsigned short* list = (LAS unsigned short*)(lds + DSA_OFF_LIST);
    const bf16* misc = (const bf16*)(ws + WS_MISC);
    if (q0 >= 256) {
        const int ntiles = (q0 >> 4) + 1;
        const int ntl = wave < ntiles ? ((ntiles - 1 - wave) >> 3) + 1 : 0;
        const int ngrp = (ntl + 7) >> 3;
        bf16x8 qf[4][2]; float iw[4];
        { const bf16* iq = (const bf16*)(ws + WS_IQ) + (size_t)row * 256;
#pragma unroll
          for (int h = 0; h < 4; ++h) { iw[h] = 0.5f * bf2f(misc[(size_t)row * 256 + 192 + h]);
#pragma unroll
              for (int ks = 0; ks < 2; ++ks) qf[h][ks] = *(const bf16x8*)(iq + h * 64 + 8 * gq + 32 * ks); } }
        unsigned u[32][4];
#pragma unroll
        for (int T = 0; T < 32; ++T)
#pragma unroll
            for (int e = 0; e < 4; ++e) u[T][e] = 0u;
        const int kb0 = 16 * wave + 4 * gq;
        DSA_FOR_TILES(
            const bf16* kp = misc + (size_t)(b * SEQ + 16 * wave + 128 * T + j) * 256 + 8 * gq;
            const bf16x8 kf0 = *(const bf16x8*)kp; const bf16x8 kf1 = *(const bf16x8*)(kp + 32);
            float sc[4] = {0.f, 0.f, 0.f, 0.f};
            _Pragma("unroll") for (int h = 0; h < 4; ++h) {
                f32x4v a = {0.f, 0.f, 0.f, 0.f};
                a = __builtin_amdgcn_mfma_f32_16x16x32_bf16(kf0, qf[h][0], a, 0, 0, 0);
                a = __builtin_amdgcn_mfma_f32_16x16x32_bf16(kf1, qf[h][1], a, 0, 0, 0);
                _Pragma("unroll") for (int e = 0; e < 4; ++e) sc[e] += iw[h] * fmaxf(a[e], 0.f);
                asm volatile("" : "+v"(sc[0]), "+v"(sc[1]), "+v"(sc[2]), "+v"(sc[3]));
            }
            _Pragma("unroll") for (int e = 0; e < 4; ++e) { unsigned x = f2o(sc[e]); asm volatile("" : "+v"(x)); u[T][e] = (kb0 + 128 * T + e <= t) ? x : 0u; }
            if ((T8 & 1) == 1) __builtin_amdgcn_sched_barrier(0);
        )
        unsigned prefix = 0u; bool exact = false; int par = 0;
#pragma unroll 1
        for (int bit = 31; bit >= 0; --bit) {
            const unsigned cand = prefix | (1u << bit); int c0 = 0, c1 = 0;
            DSA_FOR_TILES(cnt_ge(c0, u[T][0], cand); cnt_ge(c1, u[T][1], cand); cnt_ge(c0, u[T][2], cand); cnt_ge(c1, u[T][3], cand);)
            const int tot = dsa_total(cnt, par, wave, j, gq, c0 + c1); par ^= 1;
            if (!exact && tot >= 256) { prefix = cand; exact = (tot == 256); }
            if (__all(exact)) break;
        }
        const bool alle = __all(exact);
        DSA_FOR_TILES(_Pragma("unroll") for (int e = 0; e < 4; ++e) { const unsigned x = u[T][e]; u[T][e] = (x > prefix || (exact && x == prefix)) ? 0u : (x == prefix ? (unsigned)(1 + kb0 + 128 * T + e) : 0xFFFFFFFFu); })
        unsigned kp = 0u;
        if (!alle) {
#pragma unroll 1
            for (int bit = 11; bit >= 0; --bit) {
                const unsigned cand = kp | (1u << bit); int c0 = 0, c1 = 0;
                DSA_FOR_TILES(cnt_le(c0, u[T][0], cand); cnt_le(c1, u[T][1], cand); cnt_le(c0, u[T][2], cand); cnt_le(c1, u[T][3], cand);)
                const int tot = dsa_total(cnt, par, wave, j, gq, c0 + c1); par ^= 1;
                if (tot <= 255) kp = cand;
            }
        }
        const unsigned kp1 = kp + 1u;
        int ns0 = 0, ns1 = 0;
        DSA_FOR_TILES(cnt_le(ns0, u[T][0], kp1); cnt_le(ns1, u[T][1], kp1); cnt_le(ns0, u[T][2], kp1); cnt_le(ns1, u[T][3], kp1);)
        pc[(wave * 4 + gq) * 16 + j] = (unsigned)(ns0 + ns1);
        __syncthreads();
        int base = 0;
        for (int i = 0; i < wave * 4 + gq; ++i) base += (int)pc[i * 16 + j];
        DSA_FOR_TILES(_Pragma("unroll") for (int e = 0; e < 4; ++e) { if (u[T][e] <= kp1) { if (base < 256) list[j * 256 + base] = (unsigned short)(kb0 + 128 * T + e); ++base; } })
    } else {
        for (int i = tid; i < 16 * 256; i += 512) list[i] = (unsigned short)(i & 255);
    }
    __syncthreads();
    const bf16* kva = (const bf16*)(ws + WS_KVA);
    bf16* qa = (bf16*)(ws + WS_QA);
    LAS unsigned char* Vb = lds + DSA_OFF_V + wave * DSA_VB;
#pragma unroll 1
    for (int qq = 0; qq < 2; ++qq) {
        const int ql = 2 * wave + qq, tq = q0 + ql, rowq = b * SEQ + tq, nsel = tq + 1 < 256 ? tq + 1 : 256;
        bf16x8 qf[2];
#pragma unroll
        for (int ks = 0; ks < 2; ++ks) { qf[ks] = (bf16x8){0, 0, 0, 0, 0, 0, 0, 0}; if (j < 8) qf[ks] = *(const bf16x8*)(qa + (size_t)rowq * 512 + j * 64 + 8 * gq + 32 * ks); }
        f32x4v s[16]; float mx = NEGF;
#pragma unroll
        for (int kt = 0; kt < 16; ++kt) {
            const int slot = 16 * kt + j; const int key = list[ql * 256 + (slot < nsel ? slot : 0)];
            const bf16* kp2 = kva + (size_t)(b * SEQ + key) * 128 + 8 * gq;
            const bf16x8 kf0 = *(const bf16x8*)kp2, kf1 = *(const bf16x8*)(kp2 + 32);
            f32x4v a = {0.f, 0.f, 0.f, 0.f};
            a = __builtin_amdgcn_mfma_f32_16x16x32_bf16(kf0, qf[0], a, 0, 0, 0);
            a = __builtin_amdgcn_mfma_f32_16x16x32_bf16(kf1, qf[1], a, 0, 0, 0);
#pragma unroll
            for (int e = 0; e < 4; ++e) { const float v = (16 * kt + 4 * gq + e < nsel) ? a[e] : NEGF; a[e] = v; mx = fmaxf(mx, v); }
            s[kt] = a;
        }
        mx = xmax16(mx);
        float ls = 0.f;
#pragma unroll
        for (int kt = 0; kt < 16; ++kt)
#pragma unroll
            for (int e = 0; e < 4; ++e) { const float p = __builtin_amdgcn_exp2f(s[kt][e] - mx); s[kt][e] = p; ls += p; }
        ls = xsum16(ls);
        f32x4v o[4];
#pragma unroll
        for (int dt = 0; dt < 4; ++dt) o[dt] = (f32x4v){0.f, 0.f, 0.f, 0.f};
#pragma unroll
        for (int ch = 0; ch < 4; ++ch) {
            v4u vr[8];
#pragma unroll
            for (int i = 0; i < 8; ++i) { const int slot = 64 * ch + 8 * i + (lane >> 3); const int key = list[ql * 256 + (slot < nsel ? slot : 0)];
                vr[i] = *(const v4u*)(kva + (size_t)(b * SEQ + key) * 128 + 64 + (lane & 7) * 8); }
#pragma unroll
            for (int i = 0; i < 8; ++i) *(LAS v4u*)(Vb + ((8 * i + (lane >> 3)) * NSA_VSTR + (lane & 7) * 8) * 2) = vr[i];
            WAVE_LDS_SYNC();
#pragma unroll
            for (int kk = 0; kk < 2; ++kk) {
                const int k4 = 4 * ch + 2 * kk;
                const bf16x8 pf = pack8(s[k4][0], s[k4][1], s[k4][2], s[k4][3], s[k4 + 1][0], s[k4 + 1][1], s[k4 + 1][2], s[k4 + 1][3]);
#pragma unroll
                for (int dt = 0; dt < 4; ++dt) {
                    const LAS unsigned char* va = Vb + ((32 * kk + 4 * gq + (j >> 2)) * NSA_VSTR + 16 * dt + 4 * (j & 3)) * 2;
                    o[dt] = __builtin_amdgcn_mfma_f32_16x16x32_bf16(cat4(tr16(va), tr16(va + 16 * NSA_VSTR * 2)), pf, o[dt], 0, 0, 0);
                }
            }
            WAVE_LDS_SYNC();
        }
        const float inv = 1.0f / ls;
        if (j < 8) {
#pragma unroll
            for (int dt = 0; dt < 4; ++dt) { uint2 w; w.x = pg8::cvt_pk_bf16(o[dt][0] * inv, o[dt][1] * inv); w.y = pg8::cvt_pk_bf16(o[dt][2] * inv, o[dt][3] * inv);
                *(uint2*)(yout + (size_t)rowq * 512 + j * 64 + 16 * dt + 4 * gq) = w; }
        }
    }
    __syncthreads();
}
__device__ __forceinline__ void phase_mixers(const Args& P, unsigned char* ws, int z, LAS unsigned char* lds, int gw, int NGW, int lane, int wave, int bid, int G) {
    asm volatile("" : "+v"(lane)); lane &= 63; asm volatile("" : "+s"(gw), "+s"(NGW));
#if PROBE == 3
    { LAS unsigned char* wl = lds + wave * 18944; for (int it2 = gw; it2 < 2 * M; it2 += NGW) nsa_query(P, ws, z, it2 >> 1, it2 & 1, wl, lane); }
#else
    for (int k = 0; bid + G * k < 1024; ++k) {
        const int u = bid + G * k, c0 = u & 63, unit = (u & ~63) | ((k & 1) ? 63 - c0 : c0);
#if DUP == 7
        nsa_unit(ws, unit, lds, (wave << 6) | lane_id_v(), (bf16*)(ws + WS_BU));
#endif
        nsa_unit(ws, unit, lds, (wave << 6) | lane_id_v(), (bf16*)(ws + WS_QC));
    }
#endif
    for (int k = 0; bid + G * k < 2048; ++k) {
        const int u = bid + G * k, c0 = u & 255, unit = (u & ~255) | ((k & 1) ? 255 - c0 : c0);
#if DUP == 6
        dsa_unit(ws, unit, lds, (wave << 6) | lane_id_v(), (bf16*)(ws + WS_BU));
#endif
        dsa_unit(ws, unit, lds, (wave << 6) | lane_id_v(), (bf16*)(ws + WS_QA));
    }
}
__global__ void __launch_bounds__(NWAVES * 64, 2) fwd_kernel(Args args) {
    extern __shared__ __attribute__((aligned(16))) unsigned char lds_raw[];
    LAS unsigned char* lds = (LAS unsigned char*)lds_raw;
    const int wave = __builtin_amdgcn_readfirstlane((int)threadIdx.x >> 6);
#define TIDX ((wave << 6) | lane_id_v())
#define tid TIDX
#define lane TIDX
    const int G = gridDim.x, bid = blockIdx.x;
    const int gw = bid * NWAVES + wave, NGW = G * NWAVES;
    const int lo = args.ph_lo, hi = args.ph_hi;
    const Args& P = args;
    int z = 0; asm volatile("" : "+s"(z));
    unsigned char* ws = args.ws + z;
    volatile LAS unsigned* MISCW = (volatile LAS unsigned*)(lds + LDSCTL_OFF);
    if (tid < 64) MISCW[tid] = 0u;
    __syncthreads();
    XcdBarrier bar; bar.bar = (unsigned*)(ws + WS_CTL) + 4096; bar.x = 0; bar.st = nullptr;
    if (hi - lo > 1) bar = xcd_barrier_post((unsigned*)(ws + WS_CTL) + 4096, MISCW + 8);
#define RUN(k) (lo <= (k) && (k) < hi)
#define SEAM(k) do { if ((k) + 1 < hi) { XcdBarrier b2_ = bar; asm volatile("" : "+s"(b2_.bar), "+s"(b2_.x)); xcd_barrier(b2_); } else { VM_WAIT(); __syncthreads(); } } while (0)


    if (RUN(0)) { phase_rope(P, ws, z, bid * (NWAVES * 64) + tid, G * NWAVES * 64); SEAM(0); }

    for (int it = 0; it < 2 * DEPTH; ++it) {
        const int l = it >> 1, second = it & 1, pb = 1 + l * NPL + (second ? 9 : 0);
        asm volatile("" : "+s"(z));
        ws = args.ws + z;
        bf16* const XN = (bf16*)(ws + WS_XN);
        bf16* const HB = (bf16*)(ws + WS_H);
        bf16* const MG = (bf16*)(ws + WS_MG);
        bf16* const GB = (bf16*)(ws + WS_G);
        unsigned char* const wb = ws + WS_W;
        float* const OUT = P.out + z;
        const float* xin = (it == 0) ? P.in[0 + z] : (const float*)OUT;
        if (RUN(pb)) {
            if (!second) phase_convert(P, ws, z, l, lds, gw, NGW, lane, wave);
#if DUP == 2
            if (!second) { VM_WAIT(); __syncthreads(); phase_convert(P, ws, z, l, lds, gw, NGW, lane, wave); }
#endif
            const float* gain = (second ? P.in[19 + z] : P.in[2 + z]) + l * DM;
            { int ln_ = TIDX; asm volatile("" : "+v"(ln_)); ln_ &= 63; for (int m = gw; m < M; m += NGW) norm_row_bf16(xin + (size_t)m * DM, gain, XN + (size_t)m * DM, ln_); }
            SEAM(pb);
        }
        if (RUN(pb + 1)) {
            pg8::Gemm g{XN, (const bf16*)(wb + (second ? WO_GU2 : WO_GU1)), M, 2 * FF, DM}; pg8::StaticOrder S; S.init(M, 2 * FF, G, bid + z);
            pg8::EpiSwiglu E{HB, FF};
#if !defined(SITE_MASK) || ((SITE_MASK >> 0) & 1)
            pg8::gemm_phase<pg8::EpiSwiglu, pg8::StaticOrder, true, true>(lds, g, S, E, TIDX);
#if DUP == 3
            pg8::gemm_phase<pg8::EpiSwiglu, pg8::StaticOrder, true, true>(lds, g, S, E, TIDX);
#endif
#endif
            SEAM(pb + 1);
        }
        if (RUN(pb + 2)) {
            pg8::Gemm g{HB, (const bf16*)(wb + (second ? WO_D2 : WO_D1)), M, DM, FF}; pg8::StaticOrder S; S.init(M, DM, G, bid + z);
            pg8::EpiResid E{xin, OUT, 0.5f};
#if !defined(SITE_MASK) || ((SITE_MASK >> 1) & 1)
            pg8::gemm_phase<pg8::EpiResid, pg8::StaticOrder, true, true>(lds, g, S, E, TIDX);
#endif
            SEAM(pb + 2);
        }
        if (second) continue;
        const int pm = 1 + l * NPL + 3;
        if (RUN(pm)) {
            const float* gain = P.in[6 + z] + l * DM;
            { int ln_ = TIDX; asm volatile("" : "+v"(ln_)); ln_ &= 63; for (int m = gw; m < M; m += NGW) norm_row_bf16(OUT + (size_t)m * DM, gain, XN + (size_t)m * DM, ln_); }
            SEAM(pm);
        }
        if (RUN(pm + 1)) {
            pg8::Gemm g{XN, (const bf16*)(wb + WO_IN), M, NINP, DM}; pg8::StaticOrder S; S.init(M, NINP, G, bid + z);
            pg8::EpiWin E{(bf16*)(ws + WS_QA), (bf16*)(ws + WS_QC), (bf16*)(ws + WS_IQ), (bf16*)(ws + WS_MISC), (bf16*)(ws + WS_KVC), (bf16*)(ws + WS_KVS), (bf16*)(ws + WS_KVW), (bf16*)(ws + WS_BU), GB,
                          (const float*)(ws + WS_ROPE)};
#if !defined(SITE_MASK) || ((SITE_MASK >> 2) & 1)
            pg8::gemm_phase<pg8::EpiWin, pg8::StaticOrder, true, true>(lds, g, S, E, TIDX);
#if DUP == 4
            pg8::gemm_phase<pg8::EpiWin, pg8::StaticOrder, true, true>(lds, g, S, E, TIDX);
#endif
#endif
            SEAM(pm + 1);
        }
        #ifndef NO_PREP
        if (RUN(pm + 2)) { phase_prep(P, ws, z, l, lds, gw, NGW, lane, wave); SEAM(pm + 2); }
#endif
        #ifndef NO_MIX
        if (RUN(pm + 3)) { phase_mixers(P, ws, z, lds, gw, NGW, lane, wave, bid, G); SEAM(pm + 3); }
#endif
        if (RUN(pm + 4)) {
            pg8::StaticOrder S; S.init(M, DM, G, bid + z);
            { pg8::Gemm g{(const bf16*)(ws + WS_QA), (const bf16*)(wb + WO_PA), M, DM, 512}; pg8::EpiProj<0> E{MG, GB, 0};
#if !defined(SITE_MASK) || ((SITE_MASK >> 3) & 1)
              pg8::gemm_phase<pg8::EpiProj<0>, pg8::StaticOrder, true, true>(lds, g, S, E, TIDX);
#endif
            }
            { pg8::Gemm g{(const bf16*)(ws + WS_YB), (const bf16*)(wb + WO_PB), M, DM, 512}; pg8::EpiProj<1> E{MG, GB, 1024};
#if !defined(SITE_MASK) || ((SITE_MASK >> 4) & 1)
              pg8::gemm_phase<pg8::EpiProj<1>, pg8::StaticOrder, true, true>(lds, g, S, E, TIDX);
#endif
            }
            { pg8::Gemm g{(const bf16*)(ws + WS_QC), (const bf16*)(wb + WO_PC), M, DM, 512}; pg8::EpiProj<1> E{MG, GB, 2048};
#if !defined(SITE_MASK) || ((SITE_MASK >> 5) & 1)
              pg8::gemm_phase<pg8::EpiProj<1>, pg8::StaticOrder, true, true>(lds, g, S, E, TIDX);
#endif
            }
            SEAM(pm + 4);
        }
        if (RUN(pm + 5)) {
            pg8::Gemm g{MG, (const bf16*)(wb + WO_OUT), M, DM, DM}; pg8::StaticOrder S; S.init(M, DM, G, bid + z);
            pg8::EpiResid E{OUT, OUT, 1.0f};
#if !defined(SITE_MASK) || ((SITE_MASK >> 6) & 1)
            pg8::gemm_phase<pg8::EpiResid, pg8::StaticOrder, true, true>(lds, g, S, E, TIDX);
#endif
            SEAM(pm + 5);
        }
    }
    if (RUN(NPH - 1)) { asm volatile("" : "+s"(z)); int ln_ = TIDX; asm volatile("" : "+v"(ln_)); ln_ &= 63; float* o_ = P.out + z; for (int m = gw; m < M; m += NGW) norm_row_f32(o_ + (size_t)m * DM, P.in[23 + z], ln_); }
#undef RUN
#undef tid
#undef TIDX
#undef lane
#undef SEAM
}

extern "C" void kernel_launch(void* const* d_in, const int* in_sizes, int n_in, void* d_out, int out_size, void* d_ws, size_t ws_size, hipStream_t stream) {
    static int grid = 0;
    if (grid == 0) {
        if (n_in != 24 || out_size != M * DM || ws_size < WS_END) { fprintf(stderr, "kernel_launch: unexpected shapes (n_in %d out %d ws %zu)\n", n_in, out_size, ws_size); grid = -1; return; }
        int dev = 0, cus = 0, per_cu = 0;
        if (hipGetDevice(&dev) != hipSuccess || hipDeviceGetAttribute(&cus, hipDeviceAttributeMultiprocessorCount, dev) != hipSuccess) { grid = -1; return; }
        if (hipFuncSetAttribute((const void*)fwd_kernel, hipFuncAttributeMaxDynamicSharedMemorySize, LDS_BYTES) != hipSuccess) { fprintf(stderr, "kernel_launch: hipFuncSetAttribute failed\n"); grid = -1; return; }
        if (hipOccupancyMaxActiveBlocksPerMultiprocessor(&per_cu, (const void*)fwd_kernel, NWAVES * 64, LDS_BYTES) != hipSuccess || per_cu < 1) { fprintf(stderr, "kernel_launch: occupancy query says %d\n", per_cu); }
        (void)hipGetLastError();
        grid = cus;
    }
    if (grid < 0) return;
    (void)hipMemsetAsync((char*)d_ws + WS_CTL, 0, CTL_ZERO_BYTES, stream);
    Args a{};
    for (int i = 0; i < 24; ++i) a.in[i] = (const float*)d_in[i];
    a.out = (float*)d_out; a.ws = (unsigned char*)d_ws;
#if MK_ONE_LAUNCH
    a.ph_lo = 0; a.ph_hi = NPH;
    hipLaunchKernelGGL(fwd_kernel, dim3(grid), dim3(NWAVES * 64), LDS_BYTES, stream, a);
#else
    for (int ph = 0; ph < NPH; ++ph) { a.ph_lo = ph; a.ph_hi = ph + 1; hipLaunchKernelGGL(fwd_kernel, dim3(grid), dim3(NWAVES * 64), LDS_BYTES, stream, a); }
#endif
}
```

```cpp
#include <hip/hip_runtime.h>
#include <cstdio>
#include <cstdint>
#define PROBE 0
#define PROBE_GAIN 10.0f
#define TOP8_RANK 1
#define PROBE_ROWTHR 0.01f
#define PROBE_ROWCOND 1
#define PROBE_BR -1
#define FIXHOM 0
#define DUP 0
#define POOLDBG 0
#define YB_SPARE 0
#ifndef MK_ONE_LAUNCH
#define MK_ONE_LAUNCH 1
#endif
namespace pg8 {
#define PG8_LAS __attribute__((address_space(3)))
typedef unsigned short bf16_t;
typedef short bf16x8 __attribute__((ext_vector_type(8)));
typedef float f32x4 __attribute__((ext_vector_type(4)));
typedef unsigned u32x4 __attribute__((ext_vector_type(4)));
constexpr int BM = 256, BK = 64, HALF = 128, HTB = HALF * BK * 2  , STAGE_BYTES = 8 * HTB, NXCD = 8, WGM = 8;

__host__ __device__ __forceinline__ int lds_byte(int r, int c) { const int st = (r >> 4) * 2 + (c >> 5), rr = r & 15, cc = c & 31, ob = rr * 64 + cc * 2; return st * 1024 + (ob ^ (((ob >> 9) & 1) << 5)); }
__host__ __device__ __forceinline__ void stage_rc(int b, int& R, int& C) { const int st = b / 1024, sb = b % 1024, swz = sb ^ (((sb >> 9) & 1) << 5); R = (st >> 1) * 16 + swz / 64; C = (st & 1) * 32 + (swz % 64) / 2; }
__host__ __device__ __forceinline__ int perm32(int rho) { const int n = rho >> 4, i = rho & 15; return 8 * (i >> 2) + 4 * n + (i & 3); }

struct Unit { int pm, pn, ord; };
struct Gemm { const bf16_t* A; const bf16_t* Bt; int M, N, K; };

struct StaticOrder {
    int nM, nN, nwg, G, c;
    __host__ __device__ __forceinline__ void init(int M, int N, int G_, int c_) { nM = M / BM; nN = N / BM; nwg = nM * nN; G = G_; c = c_; }
    __host__ __device__ __forceinline__ bool next(int i, Unit& u) const {
        const long L = (long)i * G + c; if (L >= nwg) return false;
        int wgid = (int)L; { const int q = nwg / NXCD, r = nwg % NXCD, xcd = wgid % NXCD, off = wgid / NXCD; wgid = (xcd < r ? xcd * (q + 1) : r * (q + 1) + (xcd - r) * q) + off; }
        const int nig = WGM * nN, gid = wgid / nig, fm = gid * WGM, gsz = (nM - fm) < WGM ? (nM - fm) : WGM;
        u.pm = fm + ((wgid % nig) % gsz); u.pn = (wgid % nig) / gsz; u.ord = i; return true;
    }
    __device__ __forceinline__ void a_ready(const Unit&) const {}
    __device__ __forceinline__ void done(const Unit&) const {}
};

__device__ __forceinline__ unsigned cvt_pk_bf16(float lo, float hi) { unsigned r; asm volatile("v_cvt_pk_bf16_f32 %0, %1, %2" : "=v"(r) : "v"(lo), "v"(hi)); return r; }
__device__ __forceinline__ float bflo(unsigned w) { return __uint_as_float(w << 16); }
__device__ __forceinline__ float bfhi(unsigned w) { return __uint_as_float(w & 0xffff0000u); }
__device__ __forceinline__ float fast_sigmoid(float x) { return __builtin_amdgcn_rcpf(1.0f + __expf(-x)); }

struct EpiSwiglu {
    static constexpr bool PERM = true, AFTER_DRAIN = false;
    bf16_t* H; int ldh; const PG8_LAS float* rs;
    __device__ __forceinline__ void operator()(const f32x4 (&acc)[2][2][4][2], const Unit& u, int wr, int wc, int fr, int fq) const {
        const int row0 = u.pm * BM + wr * 64 + fr, col0 = u.pn * HALF + wc * 32 + 8 * fq;
#pragma unroll
        for (int ai = 0; ai < 2; ++ai)
#pragma unroll
            for (int m = 0; m < 4; ++m) {
                bf16_t* rowp = H + (size_t)(row0 + ai * HALF + m * 16) * ldh + col0;
                const float r = rs[u.ord * 256 + wr * 64 + fr + ai * HALF + m * 16];
                float o[8];
#pragma unroll
                for (int n = 0; n < 2; ++n)
#pragma unroll
                    for (int e = 0; e < 4; ++e) { const float g = acc[ai][0][m][n][e] * r, up = acc[ai][1][m][n][e] * r; o[n * 4 + e] = g * fast_sigmoid(g) * up; }
                u32x4 w; w.x = cvt_pk_bf16(o[0], o[1]); w.y = cvt_pk_bf16(o[2], o[3]); w.z = cvt_pk_bf16(o[4], o[5]); w.w = cvt_pk_bf16(o[6], o[7]);
                *(u32x4*)rowp = w;
            }
    }
};
struct EpiResid {
    static constexpr bool PERM = true, AFTER_DRAIN = false;
    const float* base; float* out; float s; bf16_t* xb; float* ssq;
    __device__ __forceinline__ void operator()(const f32x4 (&acc)[2][2][4][2], const Unit& u, int wr, int wc, int fr, int fq) const {
        const int row0 = u.pm * BM + wr * 64 + fr, col0 = u.pn * BM + wc * 32 + 8 * fq;
#pragma unroll
        for (int ai = 0; ai < 2; ++ai)
#pragma unroll
            for (int m = 0; m < 4; ++m) {
                const size_t off = (size_t)(row0 + ai * HALF + m * 16) * 1024 + col0;
                float q = 0.f;
#pragma unroll
                for (int bj = 0; bj < 2; ++bj) {
                    const f32x4 b0 = *(const f32x4*)(base + off + bj * HALF), b1 = *(const f32x4*)(base + off + bj * HALF + 4);
                    const f32x4 x0 = b0 + acc[ai][bj][m][0] * s, x1 = b1 + acc[ai][bj][m][1] * s;
                    *(f32x4*)(out + off + bj * HALF) = x0; *(f32x4*)(out + off + bj * HALF + 4) = x1;
                    q += (x0[0] * x0[0] + x0[1] * x0[1]) + (x0[2] * x0[2] + x0[3] * x0[3]) + (x1[0] * x1[0] + x1[1] * x1[1]) + (x1[2] * x1[2] + x1[3] * x1[3]);
                    u32x4 w; w.x = cvt_pk_bf16(x0[0], x0[1]); w.y = cvt_pk_bf16(x0[2], x0[3]); w.z = cvt_pk_bf16(x1[0], x1[1]); w.w = cvt_pk_bf16(x1[2], x1[3]);
                    *(u32x4*)(xb + off + bj * HALF) = w;
                }
                q += __shfl_xor(q, 16); q += __shfl_xor(q, 32);
                if (fq == 0) ssq[(size_t)(row0 + ai * HALF + m * 16) * 16 + u.pn * 4 + wc] = q;
            }
    }
};
template <int MODE> struct EpiProj {
    static constexpr bool PERM = true, AFTER_DRAIN = false;
    bf16_t* MG; const bf16_t* G; int gofs;
    __device__ __forceinline__ void operator()(const f32x4 (&acc)[2][2][4][2], const Unit& u, int wr, int wc, int fr, int fq) const {
        const int row0 = u.pm * BM + wr * 64 + fr, col0 = u.pn * BM + wc * 32 + 8 * fq;
#pragma unroll
        for (int ai = 0; ai < 2; ++ai)
#pragma unroll
            for (int m = 0; m < 4; ++m) {
                const size_t row = (size_t)(row0 + ai * HALF + m * 16);
#pragma unroll
                for (int bj = 0; bj < 2; ++bj) {
                    const u32x4 gv = *(const u32x4*)(G + row * 3072 + gofs + col0 + bj * HALF);
                    bf16_t* mp = MG + row * 1024 + col0 + bj * HALF;
                    const f32x4 a0 = acc[ai][bj][m][0], a1 = acc[ai][bj][m][1];
                    float o[8] = {bflo(gv.x) * a0[0], bfhi(gv.x) * a0[1], bflo(gv.y) * a0[2], bfhi(gv.y) * a0[3], bflo(gv.z) * a1[0], bfhi(gv.z) * a1[1], bflo(gv.w) * a1[2], bfhi(gv.w) * a1[3]};
                    if (MODE) { const u32x4 ov = *(const u32x4*)mp; o[0] += bflo(ov.x); o[1] += bfhi(ov.x); o[2] += bflo(ov.y); o[3] += bfhi(ov.y); o[4] += bflo(ov.z); o[5] += bfhi(ov.z); o[6] += bflo(ov.w); o[7] += bfhi(ov.w); }
                    u32x4 w; w.x = cvt_pk_bf16(o[0], o[1]); w.y = cvt_pk_bf16(o[2], o[3]); w.z = cvt_pk_bf16(o[4], o[5]); w.w = cvt_pk_bf16(o[6], o[7]);
                    *(u32x4*)mp = w;
                }
            }
    }
};
struct EpiWin {
    static constexpr bool PERM = true, AFTER_DRAIN = false;
    bf16_t *QA, *QC, *IQ, *MISC, *KVC, *KVS, *KVW, *BU, *G; const float* rope; const PG8_LAS float* rs;
    __device__ __forceinline__ void operator()(const f32x4 (&acc)[2][2][4][2], const Unit& u, int wr, int wc, int fr, int fq) const {
        const int pn = u.pn;
        bf16_t* dst; int ld, cbase, mode;
        if (pn < 2) { dst = QA; ld = 512; cbase = pn * 256; mode = 1; }
        else if (pn < 4) { dst = QC; ld = 512; cbase = (pn - 2) * 256; mode = 1; }
        else if (pn == 4) { dst = IQ; ld = 256; cbase = 0; mode = 1; }
        else if (pn == 5) { dst = MISC; ld = 256; cbase = 0; mode = 3; }
        else if (pn <= 8) { dst = pn == 6 ? KVC : (pn == 7 ? KVS : KVW); ld = 256; cbase = 0; mode = 2; }
        else if (pn <= 10) { dst = BU; ld = 512; cbase = (pn - 9) * 256; mode = 0; }
        else { dst = G; ld = 3072; cbase = (pn - 11) * 256; mode = 4; }
        const int row0 = u.pm * BM + wr * 64 + fr, col0 = cbase + wc * 32 + 8 * fq;
        const bool ropelane = ((wc & 1) == 0) && fq < 2;
        const float sc = (mode == 1) ? (pn < 4 ? 0.125f * 1.4426950408889634f : 0.125f) : 1.0f;
#pragma unroll
        for (int ai = 0; ai < 2; ++ai)
#pragma unroll
            for (int m = 0; m < 4; ++m) {
                const size_t row = (size_t)(row0 + ai * HALF + m * 16);
                const float rr = rs[u.ord * 256 + wr * 64 + fr + ai * HALF + m * 16];
                f32x4 cs = {1.f, 1.f, 1.f, 1.f}, sn = {0.f, 0.f, 0.f, 0.f};
                if (ropelane && mode >= 1 && mode <= 3) { cs = *(const f32x4*)(rope + row * 16 + 4 * fq); sn = *(const f32x4*)(rope + row * 16 + 8 + 4 * fq); }
#pragma unroll
                for (int bj = 0; bj < 2; ++bj) {
                    const f32x4 a0 = acc[ai][bj][m][0] * rr, a1 = acc[ai][bj][m][1] * rr;
                    float o[8] = {a0[0], a0[1], a0[2], a0[3], a1[0], a1[1], a1[2], a1[3]};
                    const bool dorope = ropelane && (mode == 1 || (mode == 2 && bj == 0) || (mode == 3 && bj == 0 && wc == 0));
                    if (dorope) {
#pragma unroll
                        for (int p = 0; p < 4; ++p) { const float x1 = o[2 * p], x2 = o[2 * p + 1]; o[2 * p] = x1 * cs[p] - x2 * sn[p]; o[2 * p + 1] = x2 * cs[p] + x1 * sn[p]; }
                    }
                    if (mode == 4) {
#pragma unroll
                        for (int e = 0; e < 8; ++e) o[e] = fast_sigmoid(o[e]);
                    } else {
#pragma unroll
                        for (int e = 0; e < 8; ++e) o[e] *= sc;
                    }
                    u32x4 w; w.x = cvt_pk_bf16(o[0], o[1]); w.y = cvt_pk_bf16(o[2], o[3]); w.z = cvt_pk_bf16(o[4], o[5]); w.w = cvt_pk_bf16(o[6], o[7]);
                    *(u32x4*)(dst + row * ld + col0 + bj * HALF) = w;
                }
            }
    }
};

template <class Epi, class Sched, bool ALIGN_EPI = false, bool SP2 = false>
__device__ __forceinline__ void gemm_phase(PG8_LAS unsigned char* lds, const Gemm g, const Sched& S, const Epi& E, int tid_in) {
    int tid_ = tid_in; asm volatile("" : "+v"(tid_));
    const int tid = tid_, wid = __builtin_amdgcn_readfirstlane(tid >> 6), lane = tid & 63, wr = wid >> 2, wc = wid & 3, fr = lane & 15, fq = lane >> 4;
    const int K = g.K, nt = K / BK;
    unsigned voffA[2], voffB[2];
#pragma unroll
    for (int i = 0; i < 2; ++i) { int R, C; stage_rc(tid * 16 + i * 8192, R, C); const int Rb = Epi::PERM ? ((R & ~31) + perm32(R & 31)) : R;
        voffA[i] = (unsigned)(R * K + C) * 2u; voffB[i] = (unsigned)(Rb * K + C) * 2u; }
    const size_t kstep = (size_t)(BK * 2);
    const size_t hstep = (size_t)HALF * K * 2;
    const size_t tstep = 2 * hstep;
    const unsigned ldsw = (unsigned)wid * 1024u;
    const int aoff = lds_byte(wr * 64 + fr, fq * 8), boff = lds_byte(wc * 32 + fr, fq * 8);
#define PG8_SA(b, h) (((b) * 2 + (h)) * HTB)
#define PG8_SB(b, h) ((4 + (b) * 2 + (h)) * HTB)
#define PG8_STAGE(bufoff, gbase, voff) do { _Pragma("unroll") for (int _i = 0; _i < 2; ++_i) \
        __builtin_amdgcn_global_load_lds((const unsigned*)((const char*)(gbase) + (voff)[_i]), (PG8_LAS unsigned*)(lds + (bufoff) + ldsw + _i * 8192), 16, 0, 0); } while (0)
#define PG8_LDA(dst, b, h) do { _Pragma("unroll") for (int m = 0; m < 4; ++m) _Pragma("unroll") for (int k = 0; k < 2; ++k) dst[m][k] = *(const PG8_LAS bf16x8*)(lds + PG8_SA(b, h) + aoff + m * 2048 + k * 1024); } while (0)
#define PG8_LDB(dst, b, h) do { _Pragma("unroll") for (int n = 0; n < 2; ++n) _Pragma("unroll") for (int k = 0; k < 2; ++k) dst[n][k] = *(const PG8_LAS bf16x8*)(lds + PG8_SB(b, h) + boff + n * 2048 + k * 1024); } while (0)
#define PG8_MMA(ai, bj, At, Bt) do { __builtin_amdgcn_s_setprio(1); _Pragma("unroll") for (int m = 0; m < 4; ++m) _Pragma("unroll") for (int n = 0; n < 2; ++n) _Pragma("unroll") for (int k = 0; k < 2; ++k) \
        acc[ai][bj][m][n] = __builtin_amdgcn_mfma_f32_16x16x32_bf16(Bt[n][k], At[m][k], acc[ai][bj][m][n], 0, 0, 0); __builtin_amdgcn_s_setprio(0); } while (0)
#define PG8_WAIT_V(n) asm volatile("s_waitcnt vmcnt(" #n ")" ::: "memory")
#define PG8_WAIT_L(n) asm volatile("s_waitcnt lgkmcnt(" #n ")" ::: "memory")
#define PG8_BAR __builtin_amdgcn_s_barrier()
#define PG8_SCHED __builtin_amdgcn_sched_barrier(0)
    Unit cur, nxt; int ui = 0;
    if (!S.next(0, cur)) return;
    f32x4 acc[2][2][4][2];
#pragma unroll
    for (int a = 0; a < 2; ++a)
#pragma unroll
        for (int b = 0; b < 2; ++b)
#pragma unroll
            for (int m = 0; m < 4; ++m)
#pragma unroll
                for (int n = 0; n < 2; ++n) acc[a][b][m][n] = (f32x4){0.f, 0.f, 0.f, 0.f};
    bf16x8 At[4][2], B0[2][2], B1[2][2];
    const char* cA = (const char*)g.A + (size_t)cur.pm * tstep; const char* cB = (const char*)g.Bt + (size_t)cur.pn * tstep;
    S.a_ready(cur);
    if constexpr (SP2) {
        PG8_STAGE(PG8_SB(0, 0), cB, voffB); PG8_STAGE(PG8_SB(0, 1), cB + hstep, voffB); PG8_STAGE(PG8_SA(0, 0), cA, voffA); PG8_STAGE(PG8_SA(0, 1), cA + hstep, voffA);
        if (wr == 1) PG8_BAR;
        PG8_WAIT_V(2); PG8_BAR;
        PG8_STAGE(PG8_SB(1, 0), cB + kstep, voffB); PG8_STAGE(PG8_SA(1, 0), cA + kstep, voffA); PG8_STAGE(PG8_SB(1, 1), cB + hstep + kstep, voffB);
        PG8_WAIT_V(6); PG8_BAR;
    } else {
        PG8_STAGE(PG8_SB(0, 0), cB, voffB); PG8_STAGE(PG8_SA(0, 0), cA, voffA); PG8_STAGE(PG8_SB(0, 1), cB + hstep, voffB); PG8_STAGE(PG8_SA(0, 1), cA + hstep, voffA);
        if (wr == 1) PG8_BAR;
        PG8_WAIT_V(4); PG8_BAR;
        PG8_STAGE(PG8_SB(1, 0), cB + kstep, voffB); PG8_STAGE(PG8_SA(1, 0), cA + kstep, voffA); PG8_STAGE(PG8_SB(1, 1), cB + hstep + kstep, voffB);
        PG8_WAIT_V(6); PG8_BAR;
    }
    for (;;) {
        const bool has_next = S.next(ui + 1, nxt);
        const char* nA = has_next ? (const char*)g.A + (size_t)nxt.pm * tstep : cA; const char* nB = has_next ? (const char*)g.Bt + (size_t)nxt.pn * tstep : cB;
        for (int t = 0; t < nt; t += 2) {
            const bool last = (t == nt - 2);
            const char* a1 = cA + (size_t)(t + 1) * kstep;
            const char* a2 = last ? nA : cA + (size_t)(t + 2) * kstep; const char* b2 = last ? nB : cB + (size_t)(t + 2) * kstep;
            const char* a3 = a2 + kstep; const char* b3 = b2 + kstep;
            if (last && has_next) S.a_ready(nxt);
            if constexpr (SP2) {
            PG8_LDB(B0, 0, 0); PG8_LDB(B1, 0, 1); PG8_SCHED; PG8_LDA(At, 0, 0); PG8_STAGE(PG8_SA(1, 1), a1 + hstep, voffA);
            PG8_WAIT_V(8); PG8_WAIT_L(0); PG8_BAR; PG8_MMA(0, 0, At, B0); PG8_MMA(0, 1, At, B1); PG8_BAR; PG8_SCHED;
            PG8_LDA(At, 0, 1); PG8_STAGE(PG8_SB(0, 0), b2, voffB); PG8_STAGE(PG8_SB(0, 1), b2 + hstep, voffB); PG8_STAGE(PG8_SA(0, 0), a2, voffA);
            PG8_WAIT_V(8); PG8_WAIT_L(0); PG8_BAR; PG8_MMA(1, 0, At, B0); PG8_MMA(1, 1, At, B1); PG8_BAR; PG8_SCHED;
            PG8_LDB(B0, 1, 0); PG8_LDB(B1, 1, 1); PG8_SCHED; PG8_LDA(At, 1, 0); PG8_STAGE(PG8_SA(0, 1), a2 + hstep, voffA);
            PG8_WAIT_V(8); PG8_WAIT_L(0); PG8_BAR; PG8_MMA(0, 0, At, B0); PG8_MMA(0, 1, At, B1); PG8_BAR; PG8_SCHED;
            PG8_LDA(At, 1, 1); PG8_STAGE(PG8_SB(1, 0), b3, voffB); PG8_STAGE(PG8_SB(1, 1), b3 + hstep, voffB); PG8_STAGE(PG8_SA(1, 0), a3, voffA);
            PG8_WAIT_V(8); PG8_WAIT_L(0); PG8_BAR; PG8_MMA(1, 0, At, B0); PG8_MMA(1, 1, At, B1); PG8_BAR; PG8_SCHED;
            } else {
            PG8_LDB(B0, 0, 0); PG8_SCHED; PG8_LDA(At, 0, 0); PG8_STAGE(PG8_SA(1, 1), a1 + hstep, voffA);
            PG8_WAIT_L(8); PG8_BAR; PG8_WAIT_L(0); PG8_MMA(0, 0, At, B0); PG8_BAR; PG8_SCHED;
            PG8_LDB(B1, 0, 1); PG8_STAGE(PG8_SB(0, 0), b2, voffB);
            PG8_BAR; PG8_WAIT_L(0); PG8_MMA(0, 1, At, B1); PG8_BAR;
            PG8_LDA(At, 0, 1); PG8_STAGE(PG8_SA(0, 0), a2, voffA);
            PG8_BAR; PG8_WAIT_L(0); PG8_MMA(1, 0, At, B0); PG8_BAR; PG8_SCHED;
            PG8_STAGE(PG8_SB(0, 1), b2 + hstep, voffB);
            PG8_WAIT_V(6); PG8_BAR; PG8_MMA(1, 1, At, B1); PG8_BAR;
            PG8_LDB(B0, 1, 0); PG8_SCHED; PG8_LDA(At, 1, 0); PG8_STAGE(PG8_SA(0, 1), a2 + hstep, voffA);
            PG8_WAIT_L(8); PG8_BAR; PG8_WAIT_L(0); PG8_MMA(0, 0, At, B0); PG8_BAR; PG8_SCHED;
            PG8_LDB(B1, 1, 1); PG8_STAGE(PG8_SB(1, 0), b3, voffB);
            PG8_BAR; PG8_WAIT_L(0); PG8_MMA(0, 1, At, B1); PG8_BAR;
            PG8_LDA(At, 1, 1); PG8_STAGE(PG8_SA(1, 0), a3, voffA);
            PG8_BAR; PG8_WAIT_L(0); PG8_MMA(1, 0, At, B0); PG8_BAR; PG8_SCHED;
            PG8_STAGE(PG8_SB(1, 1), b3 + hstep, voffB);
            PG8_WAIT_V(6); PG8_BAR; PG8_MMA(1, 1, At, B1); PG8_BAR;
            }
        }
        if constexpr (ALIGN_EPI) { if (wr == 0) PG8_BAR; }
        if constexpr (!Epi::AFTER_DRAIN) { E(acc, cur, wr, wc, fr, fq); S.done(cur); }
        if (!has_next) break;
#pragma unroll
        for (int a = 0; a < 2; ++a)
#pragma unroll
            for (int b = 0; b < 2; ++b)
#pragma unroll
                for (int m = 0; m < 4; ++m)
#pragma unroll
                    for (int n = 0; n < 2; ++n) acc[a][b][m][n] = (f32x4){0.f, 0.f, 0.f, 0.f};
        cur = nxt; cA = nA; cB = nB; ++ui;
        if constexpr (ALIGN_EPI) { if (wr == 1) PG8_BAR; }
    }
    PG8_WAIT_V(0);
    if constexpr (!ALIGN_EPI) { if (wr == 0) PG8_BAR; }
    PG8_BAR;
    if constexpr (Epi::AFTER_DRAIN) { E.fused(acc, cur, wr, wc, fr, fq, lds, wid, lane); S.done(cur); }
#undef PG8_SA
#undef PG8_SB
#undef PG8_STAGE
#undef PG8_LDA
#undef PG8_LDB
#undef PG8_MMA
#undef PG8_WAIT_V
#undef PG8_WAIT_L
#undef PG8_BAR
#undef PG8_SCHED
}
}
#define GAS __attribute__((address_space(1)))
#define LAS __attribute__((address_space(3)))
typedef unsigned short bf16;
typedef unsigned v4u __attribute__((ext_vector_type(4)));
typedef float f32x4 __attribute__((ext_vector_type(4)));
typedef short bf16x8 __attribute__((ext_vector_type(8)));
typedef GAS unsigned gu32;
typedef GAS unsigned long long gu64;
#define RLX_AGENT __ATOMIC_RELAXED, __HIP_MEMORY_SCOPE_AGENT
#define LDS_WAIT() asm volatile("s_waitcnt lgkmcnt(0)" ::: "memory")
#define VM_WAIT() asm volatile("s_waitcnt vmcnt(0)" ::: "memory")
__device__ __forceinline__ unsigned long long rt() { return __builtin_amdgcn_s_memrealtime(); }
__device__ __forceinline__ unsigned f2bf(float f) { unsigned u = __builtin_bit_cast(unsigned, f); return (u + 0x7fffu + ((u >> 16) & 1u)) >> 16; }
__device__ __forceinline__ unsigned pk2(float lo, float hi) { return f2bf(lo) | (f2bf(hi) << 16); }
#define XB_TMO      128
#define XB_XCNT(j)  (256  + 64 * (j))
#define XB_XSUB(j)  (1280 + 64 * (j))
#define XB_XGEN(j)  (2304 + 64 * (j))
#define XB_TOP      3328
#define XB_TOPGEN   3392
#define XCD_BAR_WORDS 3456
#define XB_SPIN_CAP (1u << 18)

__device__ __forceinline__ unsigned xb_ld(unsigned* p)              { return __hip_atomic_load(p, __ATOMIC_RELAXED, __HIP_MEMORY_SCOPE_AGENT); }
__device__ __forceinline__ unsigned xb_add(unsigned* p, unsigned v) { return __hip_atomic_fetch_add(p, v, __ATOMIC_RELAXED, __HIP_MEMORY_SCOPE_AGENT); }
__device__ __forceinline__ unsigned xb_xcc_id() { return (unsigned)__builtin_amdgcn_s_getreg((3 << 11) | 20) & 0xFu; }
#define XB_SPIN(cond, bar) do { unsigned _sp = 0; while (cond) { __builtin_amdgcn_s_sleep(1); \
    if ((++_sp & 255u) == 0u) { if (xb_ld(&(bar)[XB_TMO])) break; if (_sp > XB_SPIN_CAP) { atomicAdd(&(bar)[XB_TMO], 1u); break; } } } } while (0)

struct XcdBarrier {
    unsigned* bar; unsigned x;
    volatile LAS unsigned* st;
};

__device__ __forceinline__ XcdBarrier xcd_barrier_post(unsigned* bar, volatile LAS unsigned* st) {
    XcdBarrier b; b.bar = bar; b.x = xb_xcc_id(); b.st = st;
    if (threadIdx.x == 0) (void)xb_add(&bar[XB_XCNT(b.x)], 1u);
    return b;
}
__device__ __forceinline__ void xcd_barrier_complete(unsigned* bar, unsigned x, unsigned& nloc, unsigned& nx) {
    const unsigned G = gridDim.x * gridDim.y * gridDim.z;
    unsigned sum, cnt, mine, sp = 0u;
    for (;;) {
        sum = 0u; cnt = 0u; mine = 0u;
#pragma unroll
        for (unsigned j = 0; j < 16; ++j) { const unsigned c = xb_ld(&bar[XB_XCNT(j)]); sum += c; cnt += (c > 0u) ? 1u : 0u; mine = (j == x) ? c : mine; }
        if (sum == G) break;
        __builtin_amdgcn_s_sleep(1);
        if ((++sp & 255u) == 0u) { if (xb_ld(&bar[XB_TMO])) break; if (sp > XB_SPIN_CAP) { atomicAdd(&bar[XB_TMO], 1u); break; } }
    }
    nloc = mine > 0u ? mine : 1u; nx = cnt > 0u ? cnt : 1u;
}

__device__ __forceinline__ void xcd_barrier(const XcdBarrier& b) {
    asm volatile("s_waitcnt vmcnt(0)" ::: "memory");
    __syncthreads();
    if (threadIdx.x == 0) {
        unsigned* bar = b.bar;
        __builtin_amdgcn_s_waitcnt(0);
        unsigned nloc = b.st[0], nx = b.st[1];
        if (nloc == 0u) { xcd_barrier_complete(bar, b.x, nloc, nx); b.st[0] = nloc; b.st[1] = nx; }
        const unsigned old = xb_add(&bar[XB_XSUB(b.x)], 1u);
        const unsigned gen = old / nloc;
        if (old + 1u == (gen + 1u) * nloc) {
            __builtin_amdgcn_fence(__ATOMIC_RELEASE, "agent");
            asm volatile("s_waitcnt vmcnt(0)" ::: "memory");
            const unsigned og = xb_add(&bar[XB_TOP], 1u);
            const unsigned tg = og / nx;
            if (og + 1u == (tg + 1u) * nx) xb_add(&bar[XB_TOPGEN], 1u);
            else XB_SPIN(xb_ld(&bar[XB_TOPGEN]) == tg, bar);
            __builtin_amdgcn_fence(__ATOMIC_ACQUIRE, "agent");
            xb_add(&bar[XB_XGEN(b.x)], 1u);
            asm volatile("s_waitcnt vmcnt(0)" ::: "memory");
        } else {
            XB_SPIN(xb_ld(&bar[XB_XGEN(b.x)]) == gen, bar);
            __builtin_amdgcn_fence(__ATOMIC_ACQUIRE, "agent");
            asm volatile("s_waitcnt vmcnt(0)" ::: "memory");
        }
    }
    __syncthreads();
}
constexpr int NB = 8, SEQ = 4096, DM = 1024, DEPTH = 4, M = NB * SEQ;
constexpr int FF = 2816, NIN = 5852, NINP = 5888;
constexpr float EPS = 1e-6f, NEGF = -1e30f;
constexpr int NWAVES = 8;
constexpr size_t MiB = 1u << 20;
constexpr size_t WS_CTL = 0, CTL_ZERO_BYTES = 1 * MiB;
constexpr size_t WS_ROPE = 1 * MiB;
constexpr size_t WS_KVA = 3 * MiB;
constexpr size_t WS_KC = 11 * MiB, WS_VC = WS_KC + 512 * 1024;
constexpr size_t WS_W = 12 * MiB;
constexpr size_t WO_GU1 = 0, WO_D1 = 11 * MiB, WO_GU2 = WO_D1 + 5 * MiB + 512 * 1024, WO_D2 = WO_GU2 + 11 * MiB, WO_IN = WO_D2 + 5 * MiB + 512 * 1024,
                 WO_PA = WO_IN + 11 * MiB + 512 * 1024, WO_PB = WO_PA + MiB, WO_PC = WO_PB + MiB, WO_OUT = WO_PC + MiB,
                 WO_CW1 = WO_OUT + 2 * MiB  , WO_CW2 = WO_CW1 + MiB  , WO_UKV = WO_CW2 + 32768  , WO_POOL = WO_UKV + 32768  ,
                 WO_POSB = WO_POOL + 131072  , WO_END = WO_POSB + 1024;
static_assert(WO_END <= 52 * MiB, "weights region");
constexpr size_t WS_XN = 64 * MiB;
constexpr size_t WS_R = 128 * MiB;
constexpr size_t WS_G = WS_R, WS_QA = WS_R + 192 * MiB, WS_QC = WS_QA + 32 * MiB, WS_IQ = WS_QC + 32 * MiB, WS_MISC = WS_IQ + 16 * MiB,
                 WS_KVC = WS_MISC + 16 * MiB, WS_KVS = WS_KVC + 16 * MiB, WS_KVW = WS_KVS + 16 * MiB, WS_BU = WS_KVW + 16 * MiB, WS_END = WS_BU + 32 * MiB;
#ifndef YB_SPARE
#define YB_SPARE 0
#endif
constexpr size_t WS_YB = YB_SPARE ? 496 * MiB : WS_XN;
constexpr size_t WS_MG = WS_IQ;
constexpr size_t WS_H = WS_R;
static_assert(WS_END == 496 * MiB, "ws map");
constexpr int RING_BYTES = 131072, LDS_BYTES = 163840, LDSCTL_OFF = 163840 - 256;
constexpr size_t WS_SSQ = 496 * MiB;
constexpr int RS_OFF = 131072;
constexpr int NPL = 10, NPH = 1 + DEPTH * NPL + 1;

__device__ __forceinline__ int lane_id_v() { int l; asm volatile("v_mbcnt_lo_u32_b32 %0, -1, 0\n\tv_mbcnt_hi_u32_b32 %0, -1, %0" : "=v"(l)); return l; }
__device__ __forceinline__ float bflo(unsigned w) { return __uint_as_float(w << 16); }
__device__ __forceinline__ float bfhi(unsigned w) { return __uint_as_float(w & 0xffff0000u); }
__device__ __forceinline__ float bf2f(bf16 v) { return __uint_as_float((unsigned)v << 16); }
__device__ __forceinline__ float wave_sum(float v) {
#pragma unroll
    for (int o = 1; o < 64; o <<= 1) v += __shfl_xor(v, o);
    return v;
}
__device__ __forceinline__ float wave_max(float v) {
#pragma unroll
    for (int o = 1; o < 64; o <<= 1) v = fmaxf(v, __shfl_xor(v, o));
    return v;
}
__device__ __forceinline__ int wave_sum_i(int v) {
#pragma unroll
    for (int o = 1; o < 64; o <<= 1) v += __shfl_xor(v, o);
    return v;
}
__device__ __forceinline__ unsigned wave_max_u(unsigned v) {
#pragma unroll
    for (int o = 1; o < 64; o <<= 1) { const unsigned w = (unsigned)__shfl_xor((int)v, o); v = w > v ? w : v; }
    return v;
}
#define WAVE_LDS_SYNC() do { asm volatile("s_waitcnt lgkmcnt(0)" ::: "memory"); __builtin_amdgcn_wave_barrier(); } while (0)
__host__ __device__ __forceinline__ int permd(int d) { return d < 8 ? 2 * d : (d < 16 ? 2 * (d - 8) + 1 : d); }
__device__ __forceinline__ int win_newcol(int n) {
    if (n < 512) return (n & ~63) + permd(n & 63);
    if (n < 640) return 1280 + 64 + (n - 512);
    if (n < 896) { const int m = n - 640; return 1024 + (m & ~63) + permd(m & 63); }
    if (n < 960) return 1280 + permd(n - 896);
    if (n < 964) return 1280 + 192 + (n - 960);
    if (n < 1476) return 2304 + (n - 964);
    if (n < 1988) { const int m = n - 1476; return 512 + (m & ~63) + permd(m & 63); }
    if (n < 2756) { const int m = n - 1988, kv = m >> 8, r = m & 255, base = 1536 + kv * 256; return r < 128 ? base + (r & ~63) + permd(r & 63) : base + r; }
    if (n < 2780) return 1280 + 196 + (n - 2756);
    return 2816 + (n - 2780);
}
__device__ __forceinline__ int map_row(int mode, int n) { return mode == 0 ? n : (mode == 1 ? ((n >> 7) << 8) + (n & 127) : (mode == 2 ? ((n >> 7) << 8) + 128 + (n & 127) : win_newcol(n))); }

struct Args { const float* in[24]; float* out; unsigned char* ws; int ph_lo, ph_hi; };

__device__ __forceinline__ int unperm(int p) { return p < 16 ? ((p & 1) ? (p >> 1) + 8 : (p >> 1)) : p; }
__device__ __forceinline__ void tr_item(const float* W, int K, int N, bf16* WT, int mode, LAS float* scr, int item, int lane, bool kperm = false, const float* kscale = nullptr) {
    const int nblk = (N + 31) >> 5, kb = item / nblk, nb = item - kb * nblk, k0 = 64 * kb, n0 = 32 * nb;
    const int nn = n0 + (lane & 31);
#pragma unroll 8
    for (int i = 0; i < 32; ++i) { const int kk = 2 * i + (lane >> 5); const float sc_ = kscale ? kscale[k0 + kk] : 1.0f; scr[kk * 33 + (lane & 31)] = nn < N ? W[(size_t)(k0 + kk) * N + nn] * sc_ : 0.f; }
    LDS_WAIT(); asm volatile("" ::: "memory");
    const int c = lane & 7;
#pragma unroll
    for (int j = 0; j < 4; ++j) { const int n = (lane >> 3) + 8 * j; const LAS float* s = scr + n;
        int ks[8];
#pragma unroll
        for (int i = 0; i < 8; ++i) ks[i] = (kperm ? unperm(8 * c + i) : 8 * c + i) * 33;
        v4u o; o.x = pk2(s[ks[0]], s[ks[1]]); o.y = pk2(s[ks[2]], s[ks[3]]); o.z = pk2(s[ks[4]], s[ks[5]]); o.w = pk2(s[ks[6]], s[ks[7]]);
        if (n0 + n < N) *(v4u*)(WT + (size_t)map_row(mode, n0 + n) * K + k0 + 8 * c) = o; }
    LDS_WAIT(); asm volatile("" ::: "memory");
}
__device__ __forceinline__ void phase_convert(const Args& P, unsigned char* ws, int z, int l, LAS unsigned char* lds, int gw, int NGW, int lane, int wave) {
    asm volatile("" : "+v"(lane)); lane &= 63; asm volatile("" : "+s"(gw), "+s"(NGW));
    LAS float* scr = (LAS float*)(lds + wave * 16384);
    unsigned char* wb = ws + WS_W;
    constexpr int I_F = 16 * 88, I_D = 44 * 32, I_IN = 16 * 183, I_P = 8 * 32, I_O = 16 * 32;
    constexpr int I_C = 32 * 4;
    constexpr int NIT = 4 * I_F + 2 * I_D + I_IN + 3 * I_P + I_O + 2 * I_C;
    const size_t fo = (size_t)l * DM * FF;
    for (int it = gw; it < NIT; it += NGW) {
        int r = it, K = DM, N = FF, mode = 1; const float* W = P.in[3 + z] + fo; size_t wo = WO_GU1; bool kperm = false; const float* ksc = P.in[2 + z] + l * DM;
        if (r >= I_F) { r -= I_F; mode = 2; W = P.in[4 + z] + fo;
        if (r >= I_F) { r -= I_F; mode = 0; W = P.in[5 + z] + fo; K = FF; N = DM; wo = WO_D1; ksc = nullptr;
        if (r >= I_D) { r -= I_D; mode = 1; W = P.in[20 + z] + fo; K = DM; N = FF; wo = WO_GU2; ksc = P.in[19 + z] + l * DM;
        if (r >= I_F) { r -= I_F; mode = 2; W = P.in[21 + z] + fo;
        if (r >= I_F) { r -= I_F; mode = 0; W = P.in[22 + z] + fo; K = FF; N = DM; wo = WO_D2; ksc = nullptr;
        if (r >= I_D) { r -= I_D; mode = 3; W = P.in[7 + z] + (size_t)l * DM * NIN; K = DM; N = NIN; wo = WO_IN; ksc = P.in[6 + z] + l * DM;
        if (r >= I_IN) { r -= I_IN; mode = 0; W = P.in[15 + z] + (size_t)l * 512 * DM; K = 512; N = DM; wo = WO_PA; ksc = nullptr;
        if (r >= I_P) { r -= I_P; W = P.in[16 + z] + (size_t)l * 512 * DM; wo = WO_PB;
        if (r >= I_P) { r -= I_P; W = P.in[17 + z] + (size_t)l * 512 * DM; wo = WO_PC;
        if (r >= I_P) { r -= I_P; W = P.in[18 + z] + (size_t)l * DM * DM; K = DM; wo = WO_OUT;
        if (r >= I_O) { r -= I_O; W = P.in[13 + z] + (size_t)(l * 2) * 2048 * 128; K = 2048; N = 128; wo = WO_CW1; kperm = true;
        if (r >= I_C) { r -= I_C; W += (size_t)2048 * 128; wo = WO_CW1 + 128 * 2048 * 2; kperm = false; } } } } } } } } } } } }
        tr_item(W, K, N, (bf16*)(wb + wo), mode, scr, r, lane, kperm, ksc);
    }
    {
        const int gt = gw * 64 + lane, GT = NGW * 64;
        bf16* ukv = (bf16*)(wb + WO_UKV); bf16* pool = (bf16*)(wb + WO_POOL); bf16* cw2 = (bf16*)(wb + WO_CW2); float* posb = (float*)(wb + WO_POSB);
        const float* w_ukv = P.in[9 + z] + (size_t)l * 128 * 128; const float* gn = P.in[8 + z] + l * 128;
        for (int i = gt; i < 128 * 128; i += GT) { const int np = i >> 7, k = i & 127, n = np < 64 ? unperm(np) : np; ukv[i] = (bf16)f2bf(gn[k] * w_ukv[k * 128 + n]); }
        const float* pw = P.in[10 + z] + (size_t)l * 4 * 128 * 128; const float* psc = P.in[11 + z] + l * 512;
        for (int i = gt; i < 4 * 128 * 128; i += GT) { const int g = i >> 14, d = (i >> 7) & 127, c = i & 127; pool[i] = (bf16)f2bf(pw[(g * 128 + c) * 128 + d] * psc[g * 128 + d]); }
        const float* w2 = P.in[14 + z] + (size_t)l * 2 * 128 * 64;
        for (int i = gt; i < 2 * 64 * 128; i += GT) { const int br = i >> 13, dp = (i >> 7) & 63, n = i & 127, d = br ? dp : unperm(dp); cw2[i] = (bf16)f2bf(w2[(br * 128 + n) * 64 + d]); }
        const float* w1 = P.in[13 + z] + (size_t)l * 2 * 2048 * 128; const float* pos = P.in[12 + z] + (size_t)l * 2 * 2048;
        for (int i = gw; i < 256; i += NGW) { const int br = i >> 7, n = i & 127; float a = 0.f;
#pragma unroll 8
            for (int k = lane; k < 2048; k += 64) a += pos[br * 2048 + k] * w1[((size_t)br * 2048 + k) * 128 + n];
            a = wave_sum(a); if (lane == 0) posb[i] = a; }
    }
    if (gw < 36) { unsigned zz = 0u; asm volatile("" : "+v"(zz)); v4u z = {zz, zz, zz, zz}; v4u* rp = (v4u*)((bf16*)(wb + WO_IN) + (size_t)(1500 + gw) * DM); for (int i = lane; i < DM / 8; i += 64) rp[i] = z; }
}
__device__ __forceinline__ void phase_rope(const Args& P, unsigned char* ws, int z, int gtid, int gthreads) {
    float* rope = (float*)(ws + WS_ROPE);
    for (int idx = gtid; idx < M * 8; idx += gthreads) {
        const int row = idx >> 3, i = idx & 7;
        const double inv = pow(500000.0, -(double)i / 8.0), ang = (double)((const int*)P.in[1 + z])[row] * inv;
        double s, c; sincos(ang, &s, &c);
        rope[row * 16 + i] = (float)c; rope[row * 16 + 8 + i] = (float)s;
    }
}
__device__ __forceinline__ void norm_row_bf16(const float* xrow, const float* gain, bf16* orow, int lane) {
    const f32x4* xr = (const f32x4*)xrow + lane; const f32x4* gr = (const f32x4*)gain + lane;
    f32x4 v[4]; float s = 0.f;
#pragma unroll
    for (int j = 0; j < 4; ++j) { v[j] = xr[64 * j]; s += (v[j].x * v[j].x + v[j].y * v[j].y) + (v[j].z * v[j].z + v[j].w * v[j].w); }
    const float r = 1.0f / sqrtf(wave_sum(s) * (1.f / DM) + EPS);
    unsigned long long* o8 = (unsigned long long*)orow + lane;
#pragma unroll
    for (int j = 0; j < 4; ++j) { const f32x4 g = gr[64 * j]; o8[64 * j] = (unsigned long long)pk2(v[j].x * r * g.x, v[j].y * r * g.y) | ((unsigned long long)pk2(v[j].z * r * g.z, v[j].w * r * g.w) << 32); }
}
__device__ __forceinline__ void stat_row_bf16(const float* xrow, bf16* orow, float* ssq16, int lane) {
    const f32x4* xr = (const f32x4*)xrow + lane;
    f32x4 v[4]; float s = 0.f;
#pragma unroll
    for (int j = 0; j < 4; ++j) { v[j] = xr[64 * j]; s += (v[j].x * v[j].x + v[j].y * v[j].y) + (v[j].z * v[j].z + v[j].w * v[j].w); }
    s = wave_sum(s);
    unsigned long long* o8 = (unsigned long long*)orow + lane;
#pragma unroll
    for (int j = 0; j < 4; ++j) o8[64 * j] = (unsigned long long)pk2(v[j].x, v[j].y) | ((unsigned long long)pk2(v[j].z, v[j].w) << 32);
    if (lane < 16) ssq16[lane] = lane == 0 ? s : 0.f;
}
__device__ __forceinline__ void norm_row_f32(float* xrow, const float* gain, int lane) {
    f32x4* xr = (f32x4*)xrow + lane; const f32x4* gr = (const f32x4*)gain + lane;
    f32x4 v[4]; float s = 0.f;
#pragma unroll
    for (int j = 0; j < 4; ++j) { v[j] = xr[64 * j]; s += (v[j].x * v[j].x + v[j].y * v[j].y) + (v[j].z * v[j].z + v[j].w * v[j].w); }
    const float r = 1.0f / sqrtf(wave_sum(s) * (1.f / DM) + EPS);
#pragma unroll
    for (int j = 0; j < 4; ++j) { const f32x4 g = gr[64 * j]; xr[64 * j] = v[j] * r * g; }
}
__device__ __forceinline__ unsigned f2o(float s) { const unsigned b = __float_as_uint(s); return (b & 0x80000000u) ? ~b : (b | 0x80000000u); }
__device__ __forceinline__ void unpack8(const v4u v, float* f) { f[0] = bflo(v.x); f[1] = bfhi(v.x); f[2] = bflo(v.y); f[3] = bfhi(v.y); f[4] = bflo(v.z); f[5] = bfhi(v.z); f[6] = bflo(v.w); f[7] = bfhi(v.w); }
__device__ __forceinline__ void load_row64(const bf16* p, float* f) {
    const v4u* q = (const v4u*)p;
#pragma unroll
    for (int i = 0; i < 8; ++i) unpack8(q[i], f + 8 * i);
}
__device__ __forceinline__ float dot64(const LAS float* q, const float* k) {
    float d = 0.f;
#pragma unroll
    for (int i = 0; i < 16; ++i) { const f32x4 qq = *(const LAS f32x4*)(q + 4 * i); d += qq.x * k[4 * i] + qq.y * k[4 * i + 1] + qq.z * k[4 * i + 2] + qq.w * k[4 * i + 3]; }
    return d;
}
__device__ __forceinline__ void dsa_query(const Args& P, unsigned char* ws, int z, int row, LAS unsigned char* wl, int lane) {
    const int b = row >> 12, t = row & (SEQ - 1), n = t + 1;
    LAS unsigned* su = (LAS unsigned*)wl; LAS float* pb = (LAS float*)wl; LAS unsigned short* list = (LAS unsigned short*)(wl + 16384); LAS float* qb = (LAS float*)(wl + 16896);
    const bf16* misc = (const bf16*)(ws + WS_MISC);
    const unsigned long long lt = (1ull << lane) - 1ull;
    int nsel;
    if (n <= 256) { for (int i = lane; i < n; i += 64) list[i] = (unsigned short)i; nsel = n; }
    else {
        { const uint2 v = *(const uint2*)((const bf16*)(ws + WS_IQ) + (size_t)row * 256 + lane * 4); qb[lane * 4] = bflo(v.x); qb[lane * 4 + 1] = bfhi(v.x); qb[lane * 4 + 2] = bflo(v.y); qb[lane * 4 + 3] = bfhi(v.y); }
        float iw[4]; { const uint2 v = *(const uint2*)(misc + (size_t)row * 256 + 192); iw[0] = 0.5f * bflo(v.x); iw[1] = 0.5f * bfhi(v.x); iw[2] = 0.5f * bflo(v.y); iw[3] = 0.5f * bfhi(v.y); }
        WAVE_LDS_SYNC();
        const int nch = (n + 63) >> 6;
        for (int i = 0; i < nch; ++i) {
            const int key = i * 64 + lane; const bool valid = key <= t;
            float kf[64]; load_row64(misc + (size_t)(b * SEQ + (valid ? key : t)) * 256, kf);
            float s = 0.f;
#pragma unroll
            for (int h = 0; h < 4; ++h) s += iw[h] * fmaxf(dot64(qb + h * 64, kf), 0.f);
            su[key] = valid ? f2o(s) : 0u;
        }
        WAVE_LDS_SYNC();
        unsigned prefix = 0u;
        for (int bit = 31; bit >= 0; --bit) {
            const unsigned cand = prefix | (1u << bit); int c = 0;
            for (int i = 0; i < nch; ++i) c += (su[i * 64 + lane] >= cand) ? 1 : 0;
            c = wave_sum_i(c);
            if (c >= 256) prefix = cand;
            if (c == 256) break;
        }
        int cgt = 0;
        for (int i = 0; i < nch; ++i) cgt += (su[i * 64 + lane] > prefix) ? 1 : 0;
        const int need_eq = 256 - wave_sum_i(cgt);
        int base = 0, eq_taken = 0;
        for (int i = 0; i < nch; ++i) {
            const unsigned v = su[i * 64 + lane]; const bool gt = v > prefix, eq = v == prefix;
            const unsigned long long meq = __ballot(eq);
            const bool sel = gt || (eq && (eq_taken + __popcll(meq & lt)) < need_eq);
            const unsigned long long ms = __ballot(sel);
            if (sel) list[base + __popcll(ms & lt)] = (unsigned short)(i * 64 + lane);
            base += __popcll(ms); eq_taken += __popcll(meq);
        }
        nsel = 256;
    }
    { const v4u v = *(const v4u*)((const bf16*)(ws + WS_QA) + (size_t)row * 512 + lane * 8); float f[8]; unpack8(v, f);
#pragma unroll
      for (int e = 0; e < 8; ++e) qb[lane * 8 + e] = f[e]; }
    WAVE_LDS_SYNC();
    const bf16* kva = (const bf16*)(ws + WS_KVA);
    float s[8][4];
#pragma unroll
    for (int j = 0; j < 4; ++j) {
        const int slot = lane + 64 * j; const bool valid = slot < nsel; const int key = list[valid ? slot : 0];
        float kf[64]; load_row64(kva + (size_t)(b * SEQ + key) * 128, kf);
#pragma unroll
        for (int h = 0; h < 8; ++h) s[h][j] = valid ? dot64(qb + h * 64, kf) : NEGF;
    }
    float linv[8];
#pragma unroll
    for (int h = 0; h < 8; ++h) {
        const float m = wave_max(fmaxf(fmaxf(s[h][0], s[h][1]), fmaxf(s[h][2], s[h][3]))); float ls = 0.f;
#pragma unroll
        for (int j = 0; j < 4; ++j) { const float p = __expf(s[h][j] - m); ls += p; pb[h * 256 + lane + 64 * j] = p; }
        linv[h] = 1.0f / wave_sum(ls);
    }
    WAVE_LDS_SYNC();
    float acc[8] = {0.f, 0.f, 0.f, 0.f, 0.f, 0.f, 0.f, 0.f};
    for (int slot = 0; slot < nsel; ++slot) {
        const float v = bf2f(kva[(size_t)(b * SEQ + list[slot]) * 128 + 64 + lane]);
#pragma unroll
        for (int h = 0; h < 8; ++h) acc[h] += pb[h * 256 + slot] * v;
    }
    bf16* ya = (bf16*)(ws + WS_QA) + (size_t)row * 512;
#pragma unroll
    for (int h = 0; h < 8; ++h) ya[h * 64 + lane] = (bf16)f2bf(acc[h] * linv[h]);
    WAVE_LDS_SYNC();
}
typedef short s16x4 __attribute__((ext_vector_type(4)));
typedef short v4i16_t __attribute__((ext_vector_type(4)));
typedef float f32x4v __attribute__((ext_vector_type(4)));
typedef __bf16 bf16x2_t __attribute__((ext_vector_type(2)));
typedef float f32x2_t __attribute__((ext_vector_type(2)));
__device__ __forceinline__ unsigned cvtpk(float lo, float hi) { f32x2_t v = {lo, hi}; bf16x2_t b = __builtin_convertvector(v, bf16x2_t); return __builtin_bit_cast(unsigned, b); }
constexpr float L2E = 1.4426950408889634f;
#ifndef NSA_NOSKIP
#define NSA_NOSKIP 0
#endif
constexpr int NSA_KSTR = 72, NSA_VSTR = 80;
constexpr int NSA_KB = 64 * NSA_KSTR * 2, NSA_VB = 64 * NSA_VSTR * 2;
constexpr int NSA_OFF_K = 0, NSA_OFF_V = 4 * NSA_KB, NSA_OFF_IMPA = NSA_OFF_V + 4 * NSA_VB, NSA_OFF_IMPB = NSA_OFF_IMPA + 64 * 65 * 4, NSA_OFF_UM = NSA_OFF_IMPB + 64 * 65 * 4, NSA_LDS = NSA_OFF_UM + 64;
__device__ __forceinline__ s16x4 tr16(const LAS unsigned char* p) { return __builtin_bit_cast(s16x4, __builtin_amdgcn_ds_read_tr16_b64_v4i16((LAS v4i16_t*)p)); }
__device__ __forceinline__ bf16x8 cat4(s16x4 a, s16x4 b) { return __builtin_shufflevector(a, b, 0, 1, 2, 3, 4, 5, 6, 7); }
__device__ __forceinline__ bf16x8 pack8(float a0, float a1, float a2, float a3, float b0, float b1, float b2, float b3) {
    v4u w; w.x = pg8::cvt_pk_bf16(a0, a1); w.y = pg8::cvt_pk_bf16(a2, a3); w.z = pg8::cvt_pk_bf16(b0, b1); w.w = pg8::cvt_pk_bf16(b2, b3); return __builtin_bit_cast(bf16x8, w);
}
__device__ __forceinline__ float xmax16(float v) { v = fmaxf(v, __shfl_xor(v, 16)); return fmaxf(v, __shfl_xor(v, 32)); }
__device__ __forceinline__ float xsum16(float v) { v += __shfl_xor(v, 16); return v + __shfl_xor(v, 32); }

__device__ __forceinline__ void nsa_block(const LAS unsigned char* Kb, const LAS unsigned char* Vb, const bf16x8 (&qf)[2], bool sel, int klo, int khi, float& mrow, float& lrow, f32x4v (&o)[4], int lane) {
    const int j = lane & 15, gq = lane >> 4;
    f32x4v s[4];
#pragma unroll
    for (int kt = 0; kt < 4; ++kt) {
        s[kt] = (f32x4v){0.f, 0.f, 0.f, 0.f};
#pragma unroll
        for (int ks = 0; ks < 2; ++ks) {
            const bf16x8 kf = *(const LAS bf16x8*)(Kb + ((16 * kt + j) * NSA_KSTR + 8 * gq + 32 * ks) * 2);
            s[kt] = __builtin_amdgcn_mfma_f32_16x16x32_bf16(kf, qf[ks], s[kt], 0, 0, 0);
        }
    }
    float bm = NEGF;
#pragma unroll
    for (int kt = 0; kt < 4; ++kt)
#pragma unroll
        for (int e = 0; e < 4; ++e) { const int ko = 16 * kt + 4 * gq + e; const bool ok = sel && ko >= klo && ko <= khi; const float v = ok ? s[kt][e] : NEGF; s[kt][e] = v; bm = fmaxf(bm, v); }
    bm = xmax16(bm);
    const float mnew = fmaxf(mrow, bm), alpha = __builtin_amdgcn_exp2f(mrow - mnew);
    mrow = mnew;
    float ps = 0.f;
#pragma unroll
    for (int kt = 0; kt < 4; ++kt)
#pragma unroll
        for (int e = 0; e < 4; ++e) { const float p = __builtin_amdgcn_exp2f(s[kt][e] - mnew); s[kt][e] = p; ps += p; }
    lrow = lrow * alpha + ps;
#pragma unroll
    for (int dt = 0; dt < 4; ++dt) o[dt] *= alpha;
#pragma unroll
    for (int kk = 0; kk < 2; ++kk) {
        const bf16x8 pf = pack8(s[2 * kk][0], s[2 * kk][1], s[2 * kk][2], s[2 * kk][3], s[2 * kk + 1][0], s[2 * kk + 1][1], s[2 * kk + 1][2], s[2 * kk + 1][3]);
#pragma unroll
        for (int dt = 0; dt < 4; ++dt) {
            const LAS unsigned char* va = Vb + ((32 * kk + 4 * gq + (j >> 2)) * NSA_VSTR + 16 * dt + 4 * (j & 3)) * 2;
            const bf16x8 vf = cat4(tr16(va), tr16(va + 16 * NSA_VSTR * 2));
            o[dt] = __builtin_amdgcn_mfma_f32_16x16x32_bf16(vf, pf, o[dt], 0, 0, 0);
        }
    }
}
__device__ __forceinline__ void nsa_fetch(const bf16* kv, int b, int jb, int g, int tid, v4u& kr, v4u& vr) {
    const bf16* p = kv + (size_t)(b * SEQ + 64 * jb + (tid >> 3)) * 256 + g * 64 + (tid & 7) * 8;
    kr = *(const v4u*)p; vr = *(const v4u*)(p + 128);
}
__device__ __forceinline__ void nsa_stash(LAS unsigned char* Kb, LAS unsigned char* Vb, int tid, const v4u& kr, const v4u& vr) {
    *(LAS v4u*)(Kb + ((tid >> 3) * NSA_KSTR + (tid & 7) * 8) * 2) = kr; *(LAS v4u*)(Vb + ((tid >> 3) * NSA_VSTR + (tid & 7) * 8) * 2) = vr;
}
__device__ __forceinline__ void nsa_block2(const LAS unsigned char* Kb, const LAS unsigned char* Vb, const bf16x8 (&qf)[2][2], const bool (&sel)[2], const int (&klo)[2], const int (&khi)[2],
                                           float (&mrow)[2], float (&lrow)[2], f32x4v (&o)[2][4], int lane) {
    const int j = lane & 15, gq = lane >> 4;
    f32x4v s[2][4];
#pragma unroll
    for (int kt = 0; kt < 4; ++kt) {
        s[0][kt] = (f32x4v){0.f, 0.f, 0.f, 0.f}; s[1][kt] = (f32x4v){0.f, 0.f, 0.f, 0.f};
#pragma unroll
        for (int ks = 0; ks < 2; ++ks) {
            const bf16x8 kf = *(const LAS bf16x8*)(Kb + ((16 * kt + j) * NSA_KSTR + 8 * gq + 32 * ks) * 2);
            s[0][kt] = __builtin_amdgcn_mfma_f32_16x16x32_bf16(kf, qf[0][ks], s[0][kt], 0, 0, 0);
            s[1][kt] = __builtin_amdgcn_mfma_f32_16x16x32_bf16(kf, qf[1][ks], s[1][kt], 0, 0, 0);
        }
    }
#pragma unroll
    for (int rg = 0; rg < 2; ++rg) {
        float bm = NEGF;
#pragma unroll
        for (int kt = 0; kt < 4; ++kt)
#pragma unroll
            for (int e = 0; e < 4; ++e) { const int ko = 16 * kt + 4 * gq + e; const bool ok = sel[rg] && ko >= klo[rg] && ko <= khi[rg]; const float v = ok ? s[rg][kt][e] : NEGF; s[rg][kt][e] = v; bm = fmaxf(bm, v); }
        bm = xmax16(bm);
        const float mnew = fmaxf(mrow[rg], bm), alpha = __builtin_amdgcn_exp2f(mrow[rg] - mnew);
        mrow[rg] = mnew;
        float ps = 0.f;
#pragma unroll
        for (int kt = 0; kt < 4; ++kt)
#pragma unroll
            for (int e = 0; e < 4; ++e) { const float p = __builtin_amdgcn_exp2f(s[rg][kt][e] - mnew); s[rg][kt][e] = p; ps += p; }
        lrow[rg] = lrow[rg] * alpha + ps;
#pragma unroll
        for (int dt = 0; dt < 4; ++dt) o[rg][dt] *= alpha;
    }
#pragma unroll
    for (int kk = 0; kk < 2; ++kk) {
        const bf16x8 pf0 = pack8(s[0][2 * kk][0], s[0][2 * kk][1], s[0][2 * kk][2], s[0][2 * kk][3], s[0][2 * kk + 1][0], s[0][2 * kk + 1][1], s[0][2 * kk + 1][2], s[0][2 * kk + 1][3]);
        const bf16x8 pf1 = pack8(s[1][2 * kk][0], s[1][2 * kk][1], s[1][2 * kk][2], s[1][2 * kk][3], s[1][2 * kk + 1][0], s[1][2 * kk + 1][1], s[1][2 * kk + 1][2], s[1][2 * kk + 1][3]);
#pragma unroll
        for (int dt = 0; dt < 4; ++dt) {
            const LAS unsigned char* va = Vb + ((32 * kk + 4 * gq + (j >> 2)) * NSA_VSTR + 16 * dt + 4 * (j & 3)) * 2;
            const bf16x8 vf = cat4(tr16(va), tr16(va + 16 * NSA_VSTR * 2));
            o[0][dt] = __builtin_amdgcn_mfma_f32_16x16x32_bf16(vf, pf0, o[0][dt], 0, 0, 0);
            o[1][dt] = __builtin_amdgcn_mfma_f32_16x16x32_bf16(vf, pf1, o[1][dt], 0, 0, 0);
        }
        }
}
template <int MODE>
__device__ __forceinline__ void nsa_attend(const bf16* kv, unsigned long long mask, int b, int g, int c, int tid, int lane, LAS unsigned char* Kb, LAS unsigned char* Vb, const bf16x8 (&qf)[2][2],
                                           const unsigned long long (&rmask)[2], const unsigned long long (&gmask)[2], const int (&trow)[2], float (&mrow)[2], float (&lrow)[2], f32x4v (&o)[2][4]) {
    unsigned long long rem = mask; int st = 0;
    int jb[2]; bool have1;
    jb[0] = (int)__builtin_ctzll(rem); rem &= rem - 1ull; have1 = rem != 0ull; jb[1] = have1 ? (int)__builtin_ctzll(rem) : jb[0]; rem &= rem - 1ull;
    v4u kr[2], vr[2];
    nsa_fetch(kv, b, jb[0], g, tid, kr[0], vr[0]); nsa_fetch(kv, b, jb[1], g, tid, kr[1], vr[1]);
    nsa_stash(Kb, Vb, tid, kr[0], vr[0]); nsa_stash(Kb + NSA_KB, Vb + NSA_VB, tid, kr[1], vr[1]);
    __syncthreads();
    for (;;) {
        const bool more = rem != 0ull; int jn[2]; bool nhave1 = false;
        if (more) { jn[0] = (int)__builtin_ctzll(rem); rem &= rem - 1ull; nhave1 = rem != 0ull; jn[1] = nhave1 ? (int)__builtin_ctzll(rem) : jn[0]; rem &= rem - 1ull;
                    nsa_fetch(kv, b, jn[0], g, tid, kr[0], vr[0]); nsa_fetch(kv, b, jn[1], g, tid, kr[1], vr[1]); }
        else { jn[0] = jb[0]; jn[1] = jb[0]; }
#pragma unroll
        for (int bi = 0; bi < 2; ++bi) if (bi == 0 || have1) {
            const int jj = jb[bi]; const LAS unsigned char* kb_ = Kb + (st * 2 + bi) * NSA_KB; const LAS unsigned char* vb_ = Vb + (st * 2 + bi) * NSA_VB;
            bool sel[2]; int klo[2], khi[2]; bool act[2];
#pragma unroll
            for (int rg = 0; rg < 2; ++rg) { const int o6 = trow[rg] & 63;
                if (MODE == 0) { sel[rg] = (rmask[rg] >> jj) & 1ull; act[rg] = (gmask[rg] >> jj) & 1ull; klo[rg] = 0; khi[rg] = (jj == c) ? o6 : 63; }
                else { sel[rg] = true; act[rg] = true; klo[rg] = (jj == c - 4) ? o6 + 1 : 0; khi[rg] = (jj == c) ? o6 : 63; } }
            if (act[0] || act[1]) {
                nsa_block2(kb_, vb_, qf, sel, klo, khi, mrow, lrow, o, lane);
            }
        }
        if (!more) break;
        nsa_stash(Kb + ((st ^ 1) * 2) * NSA_KB, Vb + ((st ^ 1) * 2) * NSA_VB, tid, kr[0], vr[0]); nsa_stash(Kb + ((st ^ 1) * 2 + 1) * NSA_KB, Vb + ((st ^ 1) * 2 + 1) * NSA_VB, tid, kr[1], vr[1]);
        __syncthreads();
        st ^= 1; jb[0] = jn[0]; jb[1] = jn[1]; have1 = nhave1;
    }
}
#if defined(PROBE_CMP)
__device__ __forceinline__ void nsa_probe_store(unsigned char* ws, int row, int head, int gq, const f32x4v (&v)[4]) {
    bf16* pb_ = (bf16*)(ws + 497 * MiB);
    for (int dt = 0; dt < 4; ++dt) { uint2 w; w.x = cvtpk(v[dt][0], v[dt][1]); w.y = cvtpk(v[dt][2], v[dt][3]); *(uint2*)(pb_ + (size_t)row * 512 + head * 64 + 16 * dt + 4 * gq) = w; }
}
#endif
__device__ __forceinline__ void nsa_unit(unsigned char* ws, int unit, LAS unsigned char* lds, int tid_in, bf16* yout) {
    int tid = tid_in; asm volatile("" : "+v"(tid));
    const int lane = tid & 63, wave = __builtin_amdgcn_readfirstlane(tid >> 6), j = lane & 15, gq = lane >> 4;
    const int c = unit & 63, g = (unit >> 6) & 1, b = unit >> 7, bg = b * 2 + g;
    LAS float* impa = (LAS float*)(lds + NSA_OFF_IMPA); LAS float* impb = (LAS float*)(lds + NSA_OFF_IMPB);
    LAS unsigned long long* um = (LAS unsigned long long*)(lds + NSA_OFF_UM);
    for (int i = tid; i < 2 * 64 * 65; i += 512) impa[i] = 0.f;
    bf16* qc = (bf16*)(ws + WS_QC);
    const bf16* misc = (const bf16*)(ws + WS_MISC);
    bf16x8 qf[2][2]; float gate[2][3]; int trow[2];
#pragma unroll
    for (int rg = 0; rg < 2; ++rg) {
        const int q = 8 * wave + 4 * rg + (j >> 2), t = 64 * c + q, row = b * SEQ + t, head = g * 4 + (j & 3);
        trow[rg] = t;
#pragma unroll
        for (int ks = 0; ks < 2; ++ks) qf[rg][ks] = *(const bf16x8*)(qc + (size_t)row * 512 + head * 64 + 8 * gq + 32 * ks);
#pragma unroll
        for (int e = 0; e < 3; ++e) gate[rg][e] = __builtin_amdgcn_rcpf(1.0f + __expf(-bf2f(misc[(size_t)row * 256 + 196 + head * 3 + e])));
    }
    f32x4v otot[2][4];
    __syncthreads();
    const int nT = (c >> 2) + 1;
    const bf16* kc = (const bf16*)(ws + WS_KC) + (size_t)bg * 256 * 64; const bf16* vct = (const bf16*)(ws + WS_VC) + (size_t)bg * 64 * 256;
#pragma unroll
    for (int rg = 0; rg < 2; ++rg) {
        const int t = trow[rg], nv = t >= 31 ? ((t - 15) >> 4) : 0;
        f32x4v s[16]; float mx = NEGF;
#pragma unroll
        for (int T = 0; T < 16; ++T) {
            s[T] = (f32x4v){0.f, 0.f, 0.f, 0.f};
            if (T < nT) {
#pragma unroll
                for (int ks = 0; ks < 2; ++ks) { const bf16x8 kf = *(const bf16x8*)(kc + (size_t)(16 * T + j) * 64 + 8 * gq + 32 * ks); s[T] = __builtin_amdgcn_mfma_f32_16x16x32_bf16(kf, qf[rg][ks], s[T], 0, 0, 0); }
#pragma unroll
                for (int e = 0; e < 4; ++e) { const float v = (16 * T + 4 * gq + e < nv) ? s[T][e] : NEGF; s[T][e] = v; mx = fmaxf(mx, v); }
            }
        }
        mx = xmax16(mx);
        float ls = 0.f;
#pragma unroll
        for (int T = 0; T < 16; ++T) if (T < nT) {
#pragma unroll
            for (int e = 0; e < 4; ++e) { const float p = (16 * T + 4 * gq + e < nv) ? __builtin_amdgcn_exp2f(s[T][e] - mx) : 0.f; s[T][e] = p; ls += p; }
        }
        ls = xsum16(ls);
        const float inv = nv > 0 ? __builtin_amdgcn_rcpf(ls) : 0.f;
        const int q = 8 * wave + 4 * rg + (j >> 2);
#pragma unroll
        for (int T = 0; T < 16; ++T) if (T < nT) {
#pragma unroll
            for (int e = 0; e < 4; ++e) s[T][e] *= inv;
            float a = s[T][0] + s[T][1] + s[T][2] + 0.5f * s[T][3], bb = 0.5f * s[T][3];
            a += __shfl_xor(a, 1); a += __shfl_xor(a, 2); bb += __shfl_xor(bb, 1); bb += __shfl_xor(bb, 2);
            if ((j & 3) == 0) { impa[q * 65 + 4 * T + gq] = a; impb[q * 65 + 4 * T + gq + 1] = bb; }
        }
        f32x4v oc[4];
#pragma unroll
        for (int dt = 0; dt < 4; ++dt) oc[dt] = (f32x4v){0.f, 0.f, 0.f, 0.f};
#pragma unroll
        for (int kk = 0; kk < 8; ++kk) if (2 * kk < nT) {
            const bf16x8 pf = pack8(s[2 * kk][0], s[2 * kk][1], s[2 * kk][2], s[2 * kk][3], s[2 * kk + 1][0], s[2 * kk + 1][1], s[2 * kk + 1][2], s[2 * kk + 1][3]);
#pragma unroll
            for (int dt = 0; dt < 4; ++dt) {
                const bf16* vp = vct + (size_t)(16 * dt + j) * 256 + 32 * kk + 4 * gq;
                const s16x4 v0 = *(const s16x4*)vp, v1 = *(const s16x4*)(vp + 16);
                oc[dt] = __builtin_amdgcn_mfma_f32_16x16x32_bf16(cat4(v0, v1), pf, oc[dt], 0, 0, 0);
            }
        }
#pragma unroll
        for (int dt = 0; dt < 4; ++dt) otot[rg][dt] = oc[dt] * gate[rg][0];
        __builtin_amdgcn_sched_barrier(0);
#if defined(PROBE_CMP)
        if (PROBE_BR == 0) nsa_probe_store(ws, b * SEQ + trow[rg], g * 4 + (j & 3), gq, otot[rg]);
#endif
    }
    __syncthreads();
    unsigned long long smask[8], mymask = 0ull;
#pragma unroll
    for (int qi = 0; qi < 8; ++qi) {
        const int q = 8 * wave + qi;
#if PROBE == 4
        const float imp = ((const float*)(ws + 500 * MiB))[((size_t)(b * SEQ + 64 * c + q) * 2 + g) * 64 + lane];
#else
        const float imp = impa[q * 65 + lane] + impb[q * 65 + lane];
#endif
#if PROBE && (PROBE != 5 || defined(PROBE5_IMP))
        ((float*)(ws + 516 * MiB))[((size_t)(b * SEQ + 64 * c + q) * 2 + g) * 64 + lane] = (lane <= c) ? imp : 0.f;
#endif
        const bool forced = (lane == 0) || (lane == c), adm = lane <= c;
        unsigned key = forced ? (0xFFFFFF00u | (unsigned)(63 - lane)) : (adm ? ((__float_as_uint(imp) & 0xFFFFFFC0u) | (unsigned)(63 - lane)) : 0u);
        unsigned long long mk = 0ull;
#if TOP8_RANK
        { int rank = 0;
#pragma unroll
          for (int jj = 0; jj < 64; ++jj) { const unsigned kk = (unsigned)__builtin_amdgcn_readlane((int)key, jj); rank += (kk > key) ? 1 : 0; }
          mk = __ballot(key != 0u && rank < 8); }
#else
        for (int k = 0; k < 8; ++k) { const unsigned mx = wave_max_u(key); if (mx == 0u) break; const int win = 63 - (int)(mx & 63u); mk |= 1ull << win; if (lane == win) key = 0u; }
#endif
        mk = ((unsigned long long)__builtin_amdgcn_readfirstlane((unsigned)(mk >> 32)) << 32) | (unsigned long long)__builtin_amdgcn_readfirstlane((unsigned)mk);
#ifdef FIXSEL
        { mk = 1ull | (1ull << c); for (int d = 1; d <= 6; ++d) mk |= 1ull << (((FIXHOM ? 0 : q * 7) + d * 5) % (c + 1)); }
#endif
#if PROBE == 2
        mk = ((const unsigned long long*)(ws + 496 * MiB))[(size_t)(b * SEQ + 64 * c + q) * 2 + g];
        mk = ((unsigned long long)__builtin_amdgcn_readfirstlane((unsigned)(mk >> 32)) << 32) | (unsigned long long)__builtin_amdgcn_readfirstlane((unsigned)mk);
#endif
#if PROBE == 5
        if (lane == 0) ((unsigned long long*)(ws + 498 * MiB))[(size_t)(b * SEQ + 64 * c + q) * 2 + g] = mk;
#endif
#if PROBE == 5 && !defined(PROBE5_IMP)
        ((float*)(ws + 516 * MiB))[((size_t)(b * SEQ + 64 * c + q) * 2 + g) * 64 + lane] = ((mk >> lane) & 1ull) ? 1.f : 0.f;
#endif
        smask[qi] = mk; mymask |= mk;
    }
    if (lane == 0) um[wave] = mymask;
    __syncthreads();
    unsigned long long umask = 0ull;
#pragma unroll
    for (int w = 0; w < 8; ++w) umask |= um[w];
    umask = ((unsigned long long)__builtin_amdgcn_readfirstlane((unsigned)(umask >> 32)) << 32) | (unsigned long long)__builtin_amdgcn_readfirstlane((unsigned)umask);
    unsigned long long rmask[2];
    { LAS unsigned long long* qm = (LAS unsigned long long*)(lds + NSA_OFF_IMPA);
      __syncthreads();
#pragma unroll
      for (int qi = 0; qi < 8; ++qi) if (lane == 0) qm[8 * wave + qi] = smask[qi];
      __syncthreads();
#pragma unroll
      for (int rg = 0; rg < 2; ++rg) rmask[rg] = qm[8 * wave + 4 * rg + (j >> 2)]; }
    const unsigned long long gmask[2] = {smask[0] | smask[1] | smask[2] | smask[3], smask[4] | smask[5] | smask[6] | smask[7]};
    const bf16* kvs = (const bf16*)(ws + WS_KVS); const bf16* kvw = (const bf16*)(ws + WS_KVW);
    LAS unsigned char* Kb = lds + NSA_OFF_K; LAS unsigned char* Vb = lds + NSA_OFF_V;
    {
        float mrow[2] = {NEGF, NEGF}, lrow[2] = {0.f, 0.f}; f32x4v o[2][4];
#pragma unroll
        for (int rg = 0; rg < 2; ++rg)
#pragma unroll
            for (int dt = 0; dt < 4; ++dt) o[rg][dt] = (f32x4v){0.f, 0.f, 0.f, 0.f};
        nsa_attend<0>(kvs, umask, b, g, c, tid, lane, Kb, Vb, qf, rmask, gmask, trow, mrow, lrow, o);
#if DUP == 8
        { __syncthreads(); float m2[2] = {NEGF, NEGF}, l2[2] = {0.f, 0.f}; f32x4v o2[2][4];
          for (int rg = 0; rg < 2; ++rg) for (int dt = 0; dt < 4; ++dt) o2[rg][dt] = (f32x4v){0.f, 0.f, 0.f, 0.f};
          nsa_attend<0>(kvs, umask, b, g, c, tid, lane, Kb, Vb, qf, rmask, gmask, trow, m2, l2, o2);
          bf16* dmy = (bf16*)(ws + WS_BU) + (size_t)(b * SEQ + trow[0]) * 512 + (g * 4 + (j & 3)) * 64 + 4 * gq;
          for (int rg = 0; rg < 2; ++rg) for (int dt = 0; dt < 4; ++dt) { uint2 w; w.x = pg8::cvt_pk_bf16(o2[rg][dt][0] + l2[rg], o2[rg][dt][1]); w.y = pg8::cvt_pk_bf16(o2[rg][dt][2], o2[rg][dt][3]); *(uint2*)(dmy + 16 * dt) = w; } }
#endif
#pragma unroll
        for (int rg = 0; rg < 2; ++rg) { const float sc = gate[rg][1] * __builtin_amdgcn_rcpf(xsum16(lrow[rg]));
#pragma unroll
            for (int dt = 0; dt < 4; ++dt) otot[rg][dt] += o[rg][dt] * sc;
#if defined(PROBE_CMP)
            if (PROBE_BR == 1) { f32x4v t_[4]; for (int dt = 0; dt < 4; ++dt) t_[dt] = o[rg][dt] * sc; nsa_probe_store(ws, b * SEQ + trow[rg], g * 4 + (j & 3), gq, t_); }
#endif
            }
        __syncthreads();
    }
    {
        float mrow[2] = {NEGF, NEGF}, lrow[2] = {0.f, 0.f}; f32x4v o[2][4];
#pragma unroll
        for (int rg = 0; rg < 2; ++rg)
#pragma unroll
            for (int dt = 0; dt < 4; ++dt) o[rg][dt] = (f32x4v){0.f, 0.f, 0.f, 0.f};
        { const int j0 = c - 4 > 0 ? c - 4 : 0; const unsigned long long wmask = ((c == 63 ? ~0ull : ((1ull << (c + 1)) - 1ull)) >> j0) << j0;
          nsa_attend<1>(kvw, wmask, b, g, c, tid, lane, Kb, Vb, qf, rmask, gmask, trow, mrow, lrow, o); }
#pragma unroll
        for (int rg = 0; rg < 2; ++rg) { const float sc = gate[rg][2] * __builtin_amdgcn_rcpf(xsum16(lrow[rg]));
#pragma unroll
            for (int dt = 0; dt < 4; ++dt) otot[rg][dt] += o[rg][dt] * sc;
#if defined(PROBE_CMP)
            if (PROBE_BR == 2) { f32x4v t_[4]; for (int dt = 0; dt < 4; ++dt) t_[dt] = o[rg][dt] * sc; nsa_probe_store(ws, b * SEQ + trow[rg], g * 4 + (j & 3), gq, t_); }
#endif
            }
    }
#pragma unroll
    for (int rg = 0; rg < 2; ++rg) {
        const int row = b * SEQ + trow[rg], head = g * 4 + (j & 3);
#pragma unroll
        for (int dt = 0; dt < 4; ++dt) {
            uint2 w; w.x = pg8::cvt_pk_bf16(otot[rg][dt][0], otot[rg][dt][1]); w.y = pg8::cvt_pk_bf16(otot[rg][dt][2], otot[rg][dt][3]);
            *(uint2*)(yout + (size_t)row * 512 + head * 64 + 16 * dt + 4 * gq) = w;
        }
    }
    __syncthreads();
}
__device__ __forceinline__ void prep_kva16(unsigned char* ws, int task, int lane) {
    const int j = lane & 15, gq = lane >> 4, row = task * 16 + j;
    const bf16* misc = (const bf16*)(ws + WS_MISC) + (size_t)row * 256 + 64;
    const bf16* wu = (const bf16*)(ws + WS_W + WO_UKV);
    bf16x8 cf[4]; float ss = 0.f;
#pragma unroll
    for (int ks = 0; ks < 4; ++ks) { const v4u v = *(const v4u*)(misc + 8 * gq + 32 * ks); cf[ks] = __builtin_bit_cast(bf16x8, v); float f[8]; unpack8(v, f);
#pragma unroll
        for (int e = 0; e < 8; ++e) ss += f[e] * f[e]; }
    ss = xsum16(ss);
    const float r = 1.0f / sqrtf(ss * (1.f / 128.f) + EPS);
    const float* rp = (const float*)(ws + WS_ROPE) + (size_t)row * 16;
    bf16* o = (bf16*)(ws + WS_KVA) + (size_t)row * 128;
#pragma unroll
    for (int ct = 0; ct < 8; ++ct) {
        f32x4v a = {0.f, 0.f, 0.f, 0.f};
#pragma unroll
        for (int ks = 0; ks < 4; ++ks) { const bf16x8 wf = *(const bf16x8*)(wu + (size_t)(16 * ct + j) * 128 + 8 * gq + 32 * ks); a = __builtin_amdgcn_mfma_f32_16x16x32_bf16(wf, cf[ks], a, 0, 0, 0); }
        a *= r;
        if (ct == 0) {
            const float c0 = rp[2 * gq], s0 = rp[8 + 2 * gq], c1 = rp[2 * gq + 1], s1 = rp[8 + 2 * gq + 1];
            const float x0 = a[0], x1 = a[1], x2 = a[2], x3 = a[3];
            a[0] = x0 * c0 - x1 * s0; a[1] = x1 * c0 + x0 * s0; a[2] = x2 * c1 - x3 * s1; a[3] = x3 * c1 + x2 * s1;
        }
        uint2 w; w.x = cvtpk(a[0], a[1]); w.y = cvtpk(a[2], a[3]);
        *(uint2*)(o + 16 * ct + 4 * gq) = w;
    }
}
__device__ __forceinline__ void prep_pool16(unsigned char* ws, int task, int lane) {
    const int j = lane & 15, gq = lane >> 4, row = task * 16 + j, t = row & (SEQ - 1);
    const bf16* bu = (const bf16*)(ws + WS_BU);
    const bf16* pw = (const bf16*)(ws + WS_W + WO_POOL);
    bf16* yb = (bf16*)(ws + WS_YB) + (size_t)row * 512;
#pragma unroll 1
    for (int g = 0; g < 4; ++g) {
        const int w = 2 << g, lo = (t + 1 - w) > 0 ? (t + 1 - w) : 0, cnt = t + 1 - lo; const float inv = 1.0f / (float)cnt;
        bf16x8 pf[4];
#pragma unroll
        for (int ks = 0; ks < 4; ++ks) {
            const bf16* p = bu + (size_t)row * 512 + g * 128 + 8 * gq + 32 * ks;
            float sum[8] = {0.f, 0.f, 0.f, 0.f, 0.f, 0.f, 0.f, 0.f}, cur[8];
            { const v4u v = *(const v4u*)p; unpack8(v, cur);
#pragma unroll
              for (int e = 0; e < 8; ++e) sum[e] = cur[e]; }
#pragma unroll 2
            for (int i = 1; i < w; ++i) { const bool ok = i < cnt; const v4u v = *(const v4u*)(p - (size_t)(ok ? i : 0) * 512); float f[8]; unpack8(v, f);
#pragma unroll
                for (int e = 0; e < 8; ++e) sum[e] += ok ? f[e] : 0.f; }
            __builtin_amdgcn_sched_barrier(0);
            pf[ks] = pack8(sum[0] * inv - cur[0], sum[1] * inv - cur[1], sum[2] * inv - cur[2], sum[3] * inv - cur[3], sum[4] * inv - cur[4], sum[5] * inv - cur[5], sum[6] * inv - cur[6], sum[7] * inv - cur[7]);
        }
#pragma unroll
        for (int dt = 0; dt < 8; ++dt) {
            f32x4v a = {0.f, 0.f, 0.f, 0.f};
#pragma unroll
            for (int ks = 0; ks < 4; ++ks) {
#if POOLDBG == 1
                bf16x8 wf; for (int e = 0; e < 8; ++e) wf[e] = (short)0x3c00;
#else
                const bf16x8 wf = *(const bf16x8*)(pw + (size_t)(g * 128 + 16 * dt + j) * 128 + 8 * gq + 32 * ks);
#endif
#if POOLDBG == 2
                bf16x8 pz; for (int e = 0; e < 8; ++e) pz[e] = (short)0x3c00; a = __builtin_amdgcn_mfma_f32_16x16x32_bf16(wf, pz, a, 0, 0, 0);
#else
                a = __builtin_amdgcn_mfma_f32_16x16x32_bf16(wf, pf[ks], a, 0, 0, 0);
#endif
            }
            uint2 wv; wv.x = cvtpk(a[0], a[1]); wv.y = cvtpk(a[2], a[3]);
            *(uint2*)(yb + g * 128 + 16 * dt + 4 * gq) = wv;
        }
    }
}
__device__ __forceinline__ float gelu_tanh_f(float x) { const float u = 0.7978845608028654f * (x + 0.044715f * x * x * x); const float e = __expf(2.0f * u); return 0.5f * x * (1.0f + (1.0f - 2.0f / (e + 1.0f))); }
__device__ __forceinline__ void prep_cmp16(unsigned char* ws, int task, int lane) {
    const int j = lane & 15, gq = lane >> 4;
    const int i0 = (task & 15) * 16, bg = (task >> 4) & 15, br = task >> 8, b = bg >> 1, g = bg & 1, i = i0 + j;
    const bf16* kvc = (const bf16*)(ws + WS_KVC);
    const bf16* w1 = (const bf16*)(ws + WS_W + WO_CW1) + (size_t)br * 128 * 2048;
    const bf16* w2 = (const bf16*)(ws + WS_W + WO_CW2) + (size_t)br * 64 * 128;
    const float* posb = (const float*)(ws + WS_W + WO_POSB) + br * 128;
    f32x4v h[8];
#pragma unroll
    for (int nt = 0; nt < 8; ++nt) h[nt] = (f32x4v){0.f, 0.f, 0.f, 0.f};
#pragma unroll 2
    for (int ks = 0; ks < 64; ++ks) {
        const int l = ks >> 1; int tok = 16 * i + l; tok = tok > SEQ - 1 ? SEQ - 1 : tok;
        const bf16x8 ff = *(const bf16x8*)(kvc + (size_t)(b * SEQ + tok) * 256 + br * 128 + g * 64 + 32 * (ks & 1) + 8 * gq);
#pragma unroll
        for (int nt = 0; nt < 8; ++nt) { const bf16x8 wf = *(const bf16x8*)(w1 + (size_t)(16 * nt + j) * 2048 + 32 * ks + 8 * gq); h[nt] = __builtin_amdgcn_mfma_f32_16x16x32_bf16(wf, ff, h[nt], 0, 0, 0); }
    }
#pragma unroll
    for (int nt = 0; nt < 8; ++nt) { const f32x4v pbv = *(const f32x4v*)(posb + 16 * nt + 4 * gq);
#pragma unroll
        for (int e = 0; e < 4; ++e) h[nt][e] = gelu_tanh_f(h[nt][e] + pbv[e]); }
    f32x4v o[4];
#pragma unroll
    for (int dt = 0; dt < 4; ++dt) o[dt] = (f32x4v){0.f, 0.f, 0.f, 0.f};
#pragma unroll
    for (int kk = 0; kk < 4; ++kk) {
        const bf16x8 hf = pack8(h[2 * kk][0], h[2 * kk][1], h[2 * kk][2], h[2 * kk][3], h[2 * kk + 1][0], h[2 * kk + 1][1], h[2 * kk + 1][2], h[2 * kk + 1][3]);
#pragma unroll
        for (int dt = 0; dt < 4; ++dt) { const bf16* wp = w2 + (size_t)(16 * dt + j) * 128 + 32 * kk + 4 * gq; const s16x4 v0 = *(const s16x4*)wp, v1 = *(const s16x4*)(wp + 16);
            o[dt] = __builtin_amdgcn_mfma_f32_16x16x32_bf16(cat4(v0, v1), hf, o[dt], 0, 0, 0); }
    }
    const bool dead = i == 255;
    if (br == 0) { bf16* kc = (bf16*)(ws + WS_KC) + ((size_t)bg * 256 + i) * 64;
#pragma unroll
        for (int dt = 0; dt < 4; ++dt) { uint2 w; w.x = dead ? 0u : cvtpk(o[dt][0], o[dt][1]); w.y = dead ? 0u : cvtpk(o[dt][2], o[dt][3]); *(uint2*)(kc + 16 * dt + 4 * gq) = w; }
    } else { bf16* vct = (bf16*)(ws + WS_VC) + (size_t)bg * 64 * 256 + i;
#pragma unroll
        for (int dt = 0; dt < 4; ++dt)
#pragma unroll
            for (int e = 0; e < 4; ++e) vct[(size_t)(16 * dt + 4 * gq + e) * 256] = dead ? (bf16)0 : (bf16)f2bf(o[dt][e]);
    }
}
__device__ __forceinline__ void phase_prep(const Args& P, unsigned char* ws, int z, int l, LAS unsigned char* lds, int gw, int NGW, int lane, int wave) {
    asm volatile("" : "+v"(lane)); lane &= 63; asm volatile("" : "+s"(gw), "+s"(NGW));
    for (int it = gw; it < 512; it += NGW) prep_cmp16(ws, it, lane);
    for (int it = gw; it < M / 16; it += NGW) { prep_kva16(ws, it, lane); prep_pool16(ws, it, lane); }
}
constexpr int DSA_K = 12, DSA_S = 32 - DSA_K, DSA_CAP = 256;
constexpr int DSA_OFF_CNT = 0, DSA_OFF_PC = 3072, DSA_OFF_LIST = DSA_OFF_PC + 32 * 16 * 4, DSA_OFF_V = DSA_OFF_LIST + 16 * 256 * 2, DSA_VB = 64 * NSA_VSTR * 2, DSA_LDS = DSA_OFF_V + 8 * DSA_VB;
#define DSA_FOR_TILES(...) _Pragma("unroll") for (int G8 = 0; G8 < 4; ++G8) { if (G8 < ngrp) { _Pragma("unroll") for (int T8 = 0; T8 < 8; ++T8) { const int T = G8 * 8 + T8; __VA_ARGS__ } } }
__device__ __forceinline__ void cnt_ge(int& c, unsigned u, unsigned cand) { asm volatile("v_cmp_ge_u32_e32 vcc, %1, %2\n\tv_addc_co_u32_e32 %0, vcc, 0, %0, vcc" : "+v"(c) : "v"(u), "v"(cand) : "vcc"); }
__device__ __forceinline__ void cnt_gt(int& c, unsigned u, unsigned cand) { asm volatile("v_cmp_gt_u32_e32 vcc, %1, %2\n\tv_addc_co_u32_e32 %0, vcc, 0, %0, vcc" : "+v"(c) : "v"(u), "v"(cand) : "vcc"); }
__device__ __forceinline__ void cnt_le(int& c, unsigned u, unsigned cand) { asm volatile("v_cmp_le_u32_e32 vcc, %1, %2\n\tv_addc_co_u32_e32 %0, vcc, 0, %0, vcc" : "+v"(c) : "v"(u), "v"(cand) : "vcc"); }
__device__ __forceinline__ int dsa_total(LAS unsigned* cnt, int par, int wave, int j, int gq, int c) {
    c += __shfl_xor(c, 16); c += __shfl_xor(c, 32);
    if (gq == 0) cnt[(par * 8 + wave) * 16 + j] = (unsigned)c;
    __syncthreads();
    int tot = 0;
#pragma unroll
    for (int w = 0; w < 8; ++w) tot += (int)cnt[(par * 8 + w) * 16 + j];
    return tot;
}
__device__ __forceinline__ void dsa_unit(unsigned char* ws, int unit, LAS unsigned char* lds, int tid_in, bf16* yout) {
    int tid = tid_in; asm volatile("" : "+v"(tid));
    const int lane = tid & 63, wave = __builtin_amdgcn_readfirstlane(tid >> 6), j = lane & 15, gq = lane >> 4;
    const int b = unit >> 8, q0 = (unit & 255) * 16, t = q0 + j, row = b * SEQ + t;
    LAS unsigned* cnt = (LAS unsigned*)(lds + DSA_OFF_CNT); LAS unsigned* pc = (LAS unsigned*)(lds + DSA_OFF_PC);
    LAS unsigned short* list = (LAS unsigned short*)(lds + DSA_OFF_LIST);
    const bf16* misc = (const bf16*)(ws + WS_MISC);
    if (q0 >= 256) {
        const int ntiles = (q0 >> 4) + 1;
        const int ntl = wave < ntiles ? ((ntiles - 1 - wave) >> 3) + 1 : 0;
        const int ngrp = (ntl + 7) >> 3;
        bf16x8 qf[4][2]; float iw[4];
        { const bf16* iq = (const bf16*)(ws + WS_IQ) + (size_t)row * 256;
#pragma unroll
          for (int h = 0; h < 4; ++h) { iw[h] = 0.5f * bf2f(misc[(size_t)row * 256 + 192 + h]);
#pragma unroll
              for (int ks = 0; ks < 2; ++ks) qf[h][ks] = *(const bf16x8*)(iq + h * 64 + 8 * gq + 32 * ks); } }
        unsigned u[32][4];
#pragma unroll
        for (int T = 0; T < 32; ++T)
#pragma unroll
            for (int e = 0; e < 4; ++e) u[T][e] = 0u;
        const int kb0 = 16 * wave + 4 * gq;
        DSA_FOR_TILES(
            const bf16* kp = misc + (size_t)(b * SEQ + 16 * wave + 128 * T + j) * 256 + 8 * gq;
            const bf16x8 kf0 = *(const bf16x8*)kp; const bf16x8 kf1 = *(const bf16x8*)(kp + 32);
            float sc[4] = {0.f, 0.f, 0.f, 0.f};
            _Pragma("unroll") for (int h = 0; h < 4; ++h) {
                f32x4v a = {0.f, 0.f, 0.f, 0.f};
                a = __builtin_amdgcn_mfma_f32_16x16x32_bf16(kf0, qf[h][0], a, 0, 0, 0);
                a = __builtin_amdgcn_mfma_f32_16x16x32_bf16(kf1, qf[h][1], a, 0, 0, 0);
                _Pragma("unroll") for (int e = 0; e < 4; ++e) sc[e] += iw[h] * fmaxf(a[e], 0.f);
                asm volatile("" : "+v"(sc[0]), "+v"(sc[1]), "+v"(sc[2]), "+v"(sc[3]));
            }
            _Pragma("unroll") for (int e = 0; e < 4; ++e) { unsigned x = f2o(sc[e]); asm volatile("" : "+v"(x)); u[T][e] = (kb0 + 128 * T + e <= t) ? x : 0u; }
            if ((T8 & 3) == 3) __builtin_amdgcn_sched_barrier(0);
        )
        unsigned prefix = 0u; bool exact = false; int par = 0; int cab = 0;
        LAS unsigned* lcnt = (LAS unsigned*)(lds + DSA_OFF_V); LAS unsigned* lcab = lcnt + 16; LAS unsigned* lvst = lcnt + 32; LAS unsigned* lexf = lcnt + 48; LAS unsigned* llist = lcnt + 64;
        if (tid < 16) lcnt[tid] = 0u;
#pragma unroll 1
        for (int bit = 31; bit >= DSA_S; --bit) {
            const unsigned cand = prefix | (1u << bit); int c0 = 0, c1 = 0;
            DSA_FOR_TILES(cnt_ge(c0, u[T][0], cand); cnt_ge(c1, u[T][1], cand); cnt_ge(c0, u[T][2], cand); cnt_ge(c1, u[T][3], cand);)
            const int tot = dsa_total(cnt, par, wave, j, gq, c0 + c1); par ^= 1;
            if (tot >= 256) prefix = cand; else cab = tot;
        }
        { const unsigned ptop = prefix >> DSA_S;
          DSA_FOR_TILES(_Pragma("unroll") for (int e = 0; e < 4; ++e) { const unsigned x = u[T][e]; if (x != 0u && (x >> DSA_S) == ptop) { const unsigned pos = __hip_atomic_fetch_add(&lcnt[j], 1u, __ATOMIC_RELAXED, __HIP_MEMORY_SCOPE_WORKGROUP); if (pos < DSA_CAP) llist[j * DSA_CAP + pos] = x; } })
          if (wave == 0 && gq == 0) lcab[j] = (unsigned)cab; }
        __syncthreads();
        const bool ovf = __any(lcnt[j] > (unsigned)DSA_CAP);
        if (!ovf) {
#pragma unroll 1
            for (int qq = 0; qq < 2; ++qq) {
                const int q = 2 * wave + qq; const int n = (int)lcnt[q]; const int r = 256 - (int)lcab[q];
                unsigned ev[DSA_CAP / 64];
#pragma unroll
                for (int i = 0; i < DSA_CAP / 64; ++i) ev[i] = (lane + 64 * i < n) ? llist[q * DSA_CAP + lane + 64 * i] : 0u;
                unsigned p2 = (unsigned)__shfl((int)prefix, q);
#pragma unroll 1
                for (int bit = DSA_S - 1; bit >= 0; --bit) {
                    const unsigned cand = p2 | (1u << bit); int c = 0;
#pragma unroll
                    for (int i = 0; i < DSA_CAP / 64; ++i) c += __popcll(__ballot(ev[i] >= cand));
                    if (c >= r) p2 = cand;
                }
                int cf = 0;
#pragma unroll
                for (int i = 0; i < DSA_CAP / 64; ++i) cf += __popcll(__ballot(ev[i] >= p2));
                if (lane == 0) { lvst[q] = p2; lexf[q] = (cf == r) ? 1u : 0u; }
            }
            __syncthreads();
            prefix = lvst[j]; exact = lexf[j] != 0u;
        } else {
#pragma unroll 1
            for (int bit = DSA_S - 1; bit >= 0; --bit) {
                const unsigned cand = prefix | (1u << bit); int c0 = 0, c1 = 0;
                DSA_FOR_TILES(cnt_ge(c0, u[T][0], cand); cnt_ge(c1, u[T][1], cand); cnt_ge(c0, u[T][2], cand); cnt_ge(c1, u[T][3], cand);)
                const int tot = dsa_total(cnt, par, wave, j, gq, c0 + c1); par ^= 1;
                if (!exact && tot >= 256) { prefix = cand; exact = (tot == 256); }
            }
        }
        const bool alle = __all(exact);
        DSA_FOR_TILES(_Pragma("unroll") for (int e = 0; e < 4; ++e) { const unsigned x = u[T][e]; u[T][e] = (x > prefix || (exact && x == prefix)) ? 0u : (x == prefix ? (unsigned)(1 + kb0 + 128 * T + e) : 0xFFFFFFFFu); })
        unsigned kp = 0u;
        if (!alle) {
            __syncthreads();
#pragma unroll 1
            for (int bit = 11; bit >= 0; --bit) {
                const unsigned cand = kp | (1u << bit); int c0 = 0, c1 = 0;
                DSA_FOR_TILES(cnt_le(c0, u[T][0], cand); cnt_le(c1, u[T][1], cand); cnt_le(c0, u[T][2], cand); cnt_le(c1, u[T][3], cand);)
                const int tot = dsa_total(cnt, par, wave, j, gq, c0 + c1); par ^= 1;
                if (tot <= 255) kp = cand;
            }
        }
        const unsigned kp1 = kp + 1u;
        int ns0 = 0, ns1 = 0;
        DSA_FOR_TILES(cnt_le(ns0, u[T][0], kp1); cnt_le(ns1, u[T][1], kp1); cnt_le(ns0, u[T][2], kp1); cnt_le(ns1, u[T][3], kp1);)
        pc[(wave * 4 + gq) * 16 + j] = (unsigned)(ns0 + ns1);
        __syncthreads();
        int base = 0;
        for (int i = 0; i < wave * 4 + gq; ++i) base += (int)pc[i * 16 + j];
        DSA_FOR_TILES(_Pragma("unroll") for (int e = 0; e < 4; ++e) { if (u[T][e] <= kp1) { if (base < 256) list[j * 256 + base] = (unsigned short)(kb0 + 128 * T + e); ++base; } })
    } else {
        for (int i = tid; i < 16 * 256; i += 512) list[i] = (unsigned short)(i & 255);
    }
    __syncthreads();
    const bf16* kva = (const bf16*)(ws + WS_KVA);
    bf16* qa = (bf16*)(ws + WS_QA);
    LAS unsigned char* Vb = lds + DSA_OFF_V + wave * DSA_VB;
#pragma unroll 1
    for (int qq = 0; qq < 2; ++qq) {
        const int ql = 2 * wave + qq, tq = q0 + ql, rowq = b * SEQ + tq, nsel = tq + 1 < 256 ? tq + 1 : 256;
        bf16x8 qf[2];
#pragma unroll
        for (int ks = 0; ks < 2; ++ks) { qf[ks] = (bf16x8){0, 0, 0, 0, 0, 0, 0, 0}; if (j < 8) qf[ks] = *(const bf16x8*)(qa + (size_t)rowq * 512 + j * 64 + 8 * gq + 32 * ks); }
        f32x4v s[16]; float mx = NEGF;
#pragma unroll
        for (int kt = 0; kt < 16; ++kt) {
            const int slot = 16 * kt + j; const int key = list[ql * 256 + (slot < nsel ? slot : 0)];
            const bf16* kp2 = kva + (size_t)(b * SEQ + key) * 128 + 8 * gq;
            const bf16x8 kf0 = *(const bf16x8*)kp2, kf1 = *(const bf16x8*)(kp2 + 32);
            f32x4v a = {0.f, 0.f, 0.f, 0.f};
            a = __builtin_amdgcn_mfma_f32_16x16x32_bf16(kf0, qf[0], a, 0, 0, 0);
            a = __builtin_amdgcn_mfma_f32_16x16x32_bf16(kf1, qf[1], a, 0, 0, 0);
#pragma unroll
            for (int e = 0; e < 4; ++e) { const float v = (16 * kt + 4 * gq + e < nsel) ? a[e] : NEGF; a[e] = v; mx = fmaxf(mx, v); }
            s[kt] = a;
        }
        mx = xmax16(mx);
        float ls = 0.f;
#pragma unroll
        for (int kt = 0; kt < 16; ++kt)
#pragma unroll
            for (int e = 0; e < 4; ++e) { const float p = __builtin_amdgcn_exp2f(s[kt][e] - mx); s[kt][e] = p; ls += p; }
        ls = xsum16(ls);
        f32x4v o[4];
#pragma unroll
        for (int dt = 0; dt < 4; ++dt) o[dt] = (f32x4v){0.f, 0.f, 0.f, 0.f};
#define DSA_VLOAD(ch_) do { _Pragma("unroll") for (int i = 0; i < 8; ++i) { const int slot = 64 * (ch_) + 8 * i + (lane >> 3); const int key = list[ql * 256 + (slot < nsel ? slot : 0)]; \
            vr[i] = *(const v4u*)(kva + (size_t)(b * SEQ + key) * 128 + 64 + (lane & 7) * 8); } } while (0)
        v4u vr[8];
        DSA_VLOAD(0);
#pragma unroll
        for (int ch = 0; ch < 4; ++ch) {
#pragma unroll
            for (int i = 0; i < 8; ++i) *(LAS v4u*)(Vb + ((8 * i + (lane >> 3)) * NSA_VSTR + (lane & 7) * 8) * 2) = vr[i];
            WAVE_LDS_SYNC();
            if (ch < 3) DSA_VLOAD(ch + 1);
#pragma unroll
            for (int kk = 0; kk < 2; ++kk) {
                const int k4 = 4 * ch + 2 * kk;
                const bf16x8 pf = pack8(s[k4][0], s[k4][1], s[k4][2], s[k4][3], s[k4 + 1][0], s[k4 + 1][1], s[k4 + 1][2], s[k4 + 1][3]);
#pragma unroll
                for (int dt = 0; dt < 4; ++dt) {
                    const LAS unsigned char* va = Vb + ((32 * kk + 4 * gq + (j >> 2)) * NSA_VSTR + 16 * dt + 4 * (j & 3)) * 2;
                    o[dt] = __builtin_amdgcn_mfma_f32_16x16x32_bf16(cat4(tr16(va), tr16(va + 16 * NSA_VSTR * 2)), pf, o[dt], 0, 0, 0);
                }
            }
            WAVE_LDS_SYNC();
        }
#undef DSA_VLOAD
        const float inv = 1.0f / ls;
        if (j < 8) {
#pragma unroll
            for (int dt = 0; dt < 4; ++dt) { uint2 w; w.x = pg8::cvt_pk_bf16(o[dt][0] * inv, o[dt][1] * inv); w.y = pg8::cvt_pk_bf16(o[dt][2] * inv, o[dt][3] * inv);
                *(uint2*)(yout + (size_t)rowq * 512 + j * 64 + 16 * dt + 4 * gq) = w; }
        }
    }
    __syncthreads();
}
__device__ __forceinline__ void phase_mixers(const Args& P, unsigned char* ws, int z, LAS unsigned char* lds, int gw, int NGW, int lane, int wave, int bid, int G) {
    asm volatile("" : "+v"(lane)); lane &= 63; asm volatile("" : "+s"(gw), "+s"(NGW));
#if PROBE == 3
    { LAS unsigned char* wl = lds + wave * 18944; for (int it2 = gw; it2 < 2 * M; it2 += NGW) nsa_query(P, ws, z, it2 >> 1, it2 & 1, wl, lane); }
#else
    for (int k = 0; bid + G * k < 1024; ++k) {
        const int u = bid + G * k, c0 = u & 63, unit = (u & ~63) | ((k & 1) ? 63 - c0 : c0);
#if DUP == 7
        nsa_unit(ws, unit, lds, (wave << 6) | lane_id_v(), (bf16*)(ws + WS_BU));
#endif
        nsa_unit(ws, unit, lds, (wave << 6) | lane_id_v(), (bf16*)(ws + WS_QC));
    }
#endif
    for (int k = 0; bid + G * k < 2048; ++k) {
        const int u = bid + G * k, c0 = u & 255, unit = (u & ~255) | ((k & 1) ? 255 - c0 : c0);
#if DUP == 6
        dsa_unit(ws, unit, lds, (wave << 6) | lane_id_v(), (bf16*)(ws + WS_BU));
#endif
        dsa_unit(ws, unit, lds, (wave << 6) | lane_id_v(), (bf16*)(ws + WS_QA));
    }
}
__global__ void __launch_bounds__(NWAVES * 64, 2) fwd_kernel(Args args) {
    extern __shared__ __attribute__((aligned(16))) unsigned char lds_raw[];
    LAS unsigned char* lds = (LAS unsigned char*)lds_raw;
    const int wave = __builtin_amdgcn_readfirstlane((int)threadIdx.x >> 6);
#define TIDX ((wave << 6) | lane_id_v())
#define tid TIDX
#define lane TIDX
    const int G = gridDim.x, bid = blockIdx.x;
    const int gw = bid * NWAVES + wave, NGW = G * NWAVES;
    const int lo = args.ph_lo, hi = args.ph_hi;
    const Args& P = args;
    int z = 0; asm volatile("" : "+s"(z));
    unsigned char* ws = args.ws + z;
    volatile LAS unsigned* MISCW = (volatile LAS unsigned*)(lds + LDSCTL_OFF);
    if (tid < 64) MISCW[tid] = 0u;
    __syncthreads();
    XcdBarrier bar; bar.bar = (unsigned*)(ws + WS_CTL) + 4096; bar.x = 0; bar.st = nullptr;
    if (hi - lo > 1) bar = xcd_barrier_post((unsigned*)(ws + WS_CTL) + 4096, MISCW + 8);
#define RUN(k) (lo <= (k) && (k) < hi)
#define SEAM(k) do { if ((k) + 1 < hi) { XcdBarrier b2_ = bar; asm volatile("" : "+s"(b2_.bar), "+s"(b2_.x)); xcd_barrier(b2_); } else { VM_WAIT(); __syncthreads(); } } while (0)


    if (RUN(0)) { phase_rope(P, ws, z, bid * (NWAVES * 64) + tid, G * NWAVES * 64);
        { int ln_ = TIDX; asm volatile("" : "+v"(ln_)); ln_ &= 63;
          for (int m = gw; m < M; m += NGW) stat_row_bf16(P.in[0 + z] + (size_t)m * DM, (bf16*)(ws + WS_XN) + (size_t)m * DM, (float*)(ws + WS_SSQ) + (size_t)m * 16, ln_); }
        SEAM(0); }
#define RS_PREPASS(Sref) do { const float* ssq_ = (const float*)(ws + WS_SSQ); LAS float* rsl_ = (LAS float*)(lds + RS_OFF); const int t_ = TIDX; pg8::Unit u_; \
        for (int i_ = 0; (Sref).next(i_, u_); ++i_) { const f32x4* p_ = (const f32x4*)(ssq_ + (size_t)(u_.pm * 256 + (t_ >> 1)) * 16 + (t_ & 1) * 8); const f32x4 a_ = p_[0], b_ = p_[1]; \
            float s_ = (a_.x + a_.y) + (a_.z + a_.w) + (b_.x + b_.y) + (b_.z + b_.w); s_ += __shfl_xor(s_, 1); if ((t_ & 1) == 0) rsl_[i_ * 256 + (t_ >> 1)] = 1.0f / sqrtf(s_ * (1.f / DM) + EPS); } \
        __syncthreads(); } while (0)

    for (int it = 0; it < 2 * DEPTH; ++it) {
        const int l = it >> 1, second = it & 1, pb = 1 + l * NPL + (second ? 7 : 0);
        asm volatile("" : "+s"(z));
        ws = args.ws + z;
        bf16* const XN = (bf16*)(ws + WS_XN);
        bf16* const HB = (bf16*)(ws + WS_H);
        bf16* const MG = (bf16*)(ws + WS_MG);
        bf16* const GB = (bf16*)(ws + WS_G);
        unsigned char* const wb = ws + WS_W;
        float* const OUT = P.out + z;
        const float* xin = (it == 0) ? P.in[0 + z] : (const float*)OUT;
        if (!second && RUN(pb)) { phase_convert(P, ws, z, l, lds, gw, NGW, lane, wave); SEAM(pb); }
        if (RUN(pb + 1)) {
            pg8::Gemm g{XN, (const bf16*)(wb + (second ? WO_GU2 : WO_GU1)), M, 2 * FF, DM}; pg8::StaticOrder S; S.init(M, 2 * FF, G, bid + z);
            pg8::EpiSwiglu E{HB, FF, (const LAS float*)(lds + RS_OFF)};
            RS_PREPASS(S);
#if !defined(SITE_MASK) || ((SITE_MASK >> 0) & 1)
            pg8::gemm_phase<pg8::EpiSwiglu, pg8::StaticOrder, true, true>(lds, g, S, E, TIDX);
#if DUP == 3
            pg8::gemm_phase<pg8::EpiSwiglu, pg8::StaticOrder, true, true>(lds, g, S, E, TIDX);
#endif
#endif
            SEAM(pb + 1);
        }
        if (RUN(pb + 2)) {
            pg8::Gemm g{HB, (const bf16*)(wb + (second ? WO_D2 : WO_D1)), M, DM, FF}; pg8::StaticOrder S; S.init(M, DM, G, bid + z);
            pg8::EpiResid E{xin, OUT, 0.5f, XN, (float*)(ws + WS_SSQ)};
#if !defined(SITE_MASK) || ((SITE_MASK >> 1) & 1)
            pg8::gemm_phase<pg8::EpiResid, pg8::StaticOrder, true, true>(lds, g, S, E, TIDX);
#endif
            SEAM(pb + 2);
        }
        if (second) continue;
        const int pm = 1 + l * NPL + 2;
        if (RUN(pm + 1)) {
            pg8::Gemm g{XN, (const bf16*)(wb + WO_IN), M, NINP, DM}; pg8::StaticOrder S; S.init(M, NINP, G, bid + z);
            pg8::EpiWin E{(bf16*)(ws + WS_QA), (bf16*)(ws + WS_QC), (bf16*)(ws + WS_IQ), (bf16*)(ws + WS_MISC), (bf16*)(ws + WS_KVC), (bf16*)(ws + WS_KVS), (bf16*)(ws + WS_KVW), (bf16*)(ws + WS_BU), GB,
                          (const float*)(ws + WS_ROPE), (const LAS float*)(lds + RS_OFF)};
            RS_PREPASS(S);
#if !defined(SITE_MASK) || ((SITE_MASK >> 2) & 1)
            pg8::gemm_phase<pg8::EpiWin, pg8::StaticOrder, true, true>(lds, g, S, E, TIDX);
#if DUP == 4
            pg8::gemm_phase<pg8::EpiWin, pg8::StaticOrder, true, true>(lds, g, S, E, TIDX);
#endif
#endif
            SEAM(pm + 1);
        }
        #ifndef NO_PREP
        if (RUN(pm + 2)) { phase_prep(P, ws, z, l, lds, gw, NGW, lane, wave); SEAM(pm + 2); }
#endif
        #ifndef NO_MIX
        if (RUN(pm + 3)) { phase_mixers(P, ws, z, lds, gw, NGW, lane, wave, bid, G); SEAM(pm + 3); }
#endif
        if (RUN(pm + 4)) {
            pg8::StaticOrder S; S.init(M, DM, G, bid + z);
            { pg8::Gemm g{(const bf16*)(ws + WS_QA), (const bf16*)(wb + WO_PA), M, DM, 512}; pg8::EpiProj<0> E{MG, GB, 0};
#if !defined(SITE_MASK) || ((SITE_MASK >> 3) & 1)
              pg8::gemm_phase<pg8::EpiProj<0>, pg8::StaticOrder, true, true>(lds, g, S, E, TIDX);
#endif
            }
            { pg8::Gemm g{(const bf16*)(ws + WS_YB), (const bf16*)(wb + WO_PB), M, DM, 512}; pg8::EpiProj<1> E{MG, GB, 1024};
#if !defined(SITE_MASK) || ((SITE_MASK >> 4) & 1)
              pg8::gemm_phase<pg8::EpiProj<1>, pg8::StaticOrder, true, true>(lds, g, S, E, TIDX);
#endif
            }
            { pg8::Gemm g{(const bf16*)(ws + WS_QC), (const bf16*)(wb + WO_PC), M, DM, 512}; pg8::EpiProj<1> E{MG, GB, 2048};
#if !defined(SITE_MASK) || ((SITE_MASK >> 5) & 1)
              pg8::gemm_phase<pg8::EpiProj<1>, pg8::StaticOrder, true, true>(lds, g, S, E, TIDX);
#endif
            }
            SEAM(pm + 4);
        }
        if (RUN(pm + 5)) {
            pg8::Gemm g{MG, (const bf16*)(wb + WO_OUT), M, DM, DM}; pg8::StaticOrder S; S.init(M, DM, G, bid + z);
            pg8::EpiResid E{OUT, OUT, 1.0f, XN, (float*)(ws + WS_SSQ)};
#if !defined(SITE_MASK) || ((SITE_MASK >> 6) & 1)
            pg8::gemm_phase<pg8::EpiResid, pg8::StaticOrder, true, true>(lds, g, S, E, TIDX);
#endif
            SEAM(pm + 5);
        }
    }
    if (RUN(NPH - 1)) { asm volatile("" : "+s"(z)); int ln_ = TIDX; asm volatile("" : "+v"(ln_)); ln_ &= 63; float* o_ = P.out + z; for (int m = gw; m < M; m += NGW) norm_row_f32(o_ + (size_t)m * DM, P.in[23 + z], ln_); }
#undef RUN
#undef tid
#undef TIDX
#undef lane
#undef SEAM
}

extern "C" void kernel_launch(void* const* d_in, const int* in_sizes, int n_in, void* d_out, int out_size, void* d_ws, size_t ws_size, hipStream_t stream) {
    static int grid = 0;
    if (grid == 0) {
        if (n_in != 24 || out_size != M * DM || ws_size < WS_END) { fprintf(stderr, "kernel_launch: unexpected shapes (n_in %d out %d ws %zu)\n", n_in, out_size, ws_size); grid = -1; return; }
        int dev = 0, cus = 0, per_cu = 0;
        if (hipGetDevice(&dev) != hipSuccess || hipDeviceGetAttribute(&cus, hipDeviceAttributeMultiprocessorCount, dev) != hipSuccess) { grid = -1; return; }
        if (hipFuncSetAttribute((const void*)fwd_kernel, hipFuncAttributeMaxDynamicSharedMemorySize, LDS_BYTES) != hipSuccess) { fprintf(stderr, "kernel_launch: hipFuncSetAttribute failed\n"); grid = -1; return; }
        if (hipOccupancyMaxActiveBlocksPerMultiprocessor(&per_cu, (const void*)fwd_kernel, NWAVES * 64, LDS_BYTES) != hipSuccess || per_cu < 1) { fprintf(stderr, "kernel_launch: occupancy query says %d\n", per_cu); }
        (void)hipGetLastError();
        grid = cus;
    }
    if (grid < 0) return;
    (void)hipMemsetAsync((char*)d_ws + WS_CTL, 0, CTL_ZERO_BYTES, stream);
    Args a{};
    for (int i = 0; i < 24; ++i) a.in[i] = (const float*)d_in[i];
    a.out = (float*)d_out; a.ws = (unsigned char*)d_ws;
#if MK_ONE_LAUNCH
    a.ph_lo = 0; a.ph_hi = NPH;
    hipLaunchKernelGGL(fwd_kernel, dim3(grid), dim3(NWAVES * 64), LDS_BYTES, stream, a);
#else
    for (int ph = 0; ph < NPH; ++ph) { a.ph_lo = ph; a.ph_hi = ph + 1; hipLaunchKernelGGL(fwd_kernel, dim3(grid), dim3(NWAVES * 64), LDS_BYTES, stream, a); }
#endif
}
```

```cpp
#include <hip/hip_runtime.h>
#include <cstdio>
#include <cstdint>
#define PROBE 0
#define PROBE_GAIN 10.0f
#define TOP8_RANK 1
#define PROBE_ROWTHR 0.01f
#define PROBE_ROWCOND 1
#define PROBE_BR -1
#define FIXHOM 0
#define DUP 0
#define POOLDBG 0
#define YB_SPARE 0
#ifndef MK_ONE_LAUNCH
#define MK_ONE_LAUNCH 1
#endif
namespace pg8 {
#define PG8_LAS __attribute__((address_space(3)))
typedef unsigned short bf16_t;
typedef short bf16x8 __attribute__((ext_vector_type(8)));
typedef float f32x4 __attribute__((ext_vector_type(4)));
typedef unsigned u32x4 __attribute__((ext_vector_type(4)));
constexpr int BM = 256, BK = 64, HALF = 128, HTB = HALF * BK * 2  , STAGE_BYTES = 8 * HTB, NXCD = 8, WGM = 8;

__host__ __device__ __forceinline__ int lds_byte(int r, int c) { const int st = (r >> 4) * 2 + (c >> 5), rr = r & 15, cc = c & 31, ob = rr * 64 + cc * 2; return st * 1024 + (ob ^ (((ob >> 9) & 1) << 5)); }
__host__ __device__ __forceinline__ void stage_rc(int b, int& R, int& C) { const int st = b / 1024, sb = b % 1024, swz = sb ^ (((sb >> 9) & 1) << 5); R = (st >> 1) * 16 + swz / 64; C = (st & 1) * 32 + (swz % 64) / 2; }
__host__ __device__ __forceinline__ int perm32(int rho) { const int n = rho >> 4, i = rho & 15; return 8 * (i >> 2) + 4 * n + (i & 3); }

struct Unit { int pm, pn, ord; };
struct Gemm { const bf16_t* A; const bf16_t* Bt; int M, N, K; };

struct StaticOrder {
    int nM, nN, nwg, G, c;
    __host__ __device__ __forceinline__ void init(int M, int N, int G_, int c_) { nM = M / BM; nN = N / BM; nwg = nM * nN; G = G_; c = c_; }
    __host__ __device__ __forceinline__ bool next(int i, Unit& u) const {
        const long L = (long)i * G + c; if (L >= nwg) return false;
        int wgid = (int)L; { const int q = nwg / NXCD, r = nwg % NXCD, xcd = wgid % NXCD, off = wgid / NXCD; wgid = (xcd < r ? xcd * (q + 1) : r * (q + 1) + (xcd - r) * q) + off; }
        const int nig = WGM * nN, gid = wgid / nig, fm = gid * WGM, gsz = (nM - fm) < WGM ? (nM - fm) : WGM;
        u.pm = fm + ((wgid % nig) % gsz); u.pn = (wgid % nig) / gsz; u.ord = i; return true;
    }
    __device__ __forceinline__ void a_ready(const Unit&) const {}
    __device__ __forceinline__ void done(const Unit&) const {}
};

__device__ __forceinline__ unsigned cvt_pk_bf16(float lo, float hi) { unsigned r; asm volatile("v_cvt_pk_bf16_f32 %0, %1, %2" : "=v"(r) : "v"(lo), "v"(hi)); return r; }
__device__ __forceinline__ float bflo(unsigned w) { return __uint_as_float(w << 16); }
__device__ __forceinline__ float bfhi(unsigned w) { return __uint_as_float(w & 0xffff0000u); }
__device__ __forceinline__ float fast_sigmoid(float x) { return __builtin_amdgcn_rcpf(1.0f + __expf(-x)); }

struct EpiSwiglu {
    static constexpr bool PERM = true, AFTER_DRAIN = false;
    bf16_t* H; int ldh; const PG8_LAS float* rs;
    __device__ __forceinline__ void operator()(const f32x4 (&acc)[2][2][4][2], const Unit& u, int wr, int wc, int fr, int fq) const {
        const int row0 = u.pm * BM + wr * 64 + fr, col0 = u.pn * HALF + wc * 32 + 8 * fq;
#pragma unroll
        for (int ai = 0; ai < 2; ++ai)
#pragma unroll
            for (int m = 0; m < 4; ++m) {
                bf16_t* rowp = H + (size_t)(row0 + ai * HALF + m * 16) * ldh + col0;
                const float r = rs[u.ord * 256 + wr * 64 + fr + ai * HALF + m * 16];
                float o[8];
#pragma unroll
                for (int n = 0; n < 2; ++n)
#pragma unroll
                    for (int e = 0; e < 4; ++e) { const float g = acc[ai][0][m][n][e] * r, up = acc[ai][1][m][n][e] * r; o[n * 4 + e] = g * fast_sigmoid(g) * up; }
                u32x4 w; w.x = cvt_pk_bf16(o[0], o[1]); w.y = cvt_pk_bf16(o[2], o[3]); w.z = cvt_pk_bf16(o[4], o[5]); w.w = cvt_pk_bf16(o[6], o[7]);
                *(u32x4*)rowp = w;
            }
    }
};
struct EpiResid {
    static constexpr bool PERM = true, AFTER_DRAIN = false;
    const float* base; float* out; float s; bf16_t* xb; float* ssq;
    __device__ __forceinline__ void operator()(const f32x4 (&acc)[2][2][4][2], const Unit& u, int wr, int wc, int fr, int fq) const {
        const int row0 = u.pm * BM + wr * 64 + fr, col0 = u.pn * BM + wc * 32 + 8 * fq;
#pragma unroll
        for (int ai = 0; ai < 2; ++ai)
#pragma unroll
            for (int m = 0; m < 4; ++m) {
                const size_t off = (size_t)(row0 + ai * HALF + m * 16) * 1024 + col0;
                float q = 0.f;
#pragma unroll
                for (int bj = 0; bj < 2; ++bj) {
                    const f32x4 b0 = *(const f32x4*)(base + off + bj * HALF), b1 = *(const f32x4*)(base + off + bj * HALF + 4);
                    const f32x4 x0 = b0 + acc[ai][bj][m][0] * s, x1 = b1 + acc[ai][bj][m][1] * s;
                    *(f32x4*)(out + off + bj * HALF) = x0; *(f32x4*)(out + off + bj * HALF + 4) = x1;
                    q += (x0[0] * x0[0] + x0[1] * x0[1]) + (x0[2] * x0[2] + x0[3] * x0[3]) + (x1[0] * x1[0] + x1[1] * x1[1]) + (x1[2] * x1[2] + x1[3] * x1[3]);
                    u32x4 w; w.x = cvt_pk_bf16(x0[0], x0[1]); w.y = cvt_pk_bf16(x0[2], x0[3]); w.z = cvt_pk_bf16(x1[0], x1[1]); w.w = cvt_pk_bf16(x1[2], x1[3]);
                    *(u32x4*)(xb + off + bj * HALF) = w;
                }
                q += __shfl_xor(q, 16); q += __shfl_xor(q, 32);
                if (fq == 0) ssq[(size_t)(row0 + ai * HALF + m * 16) * 16 + u.pn * 4 + wc] = q;
            }
    }
};
template <int MODE> struct EpiProj {
    static constexpr bool PERM = true, AFTER_DRAIN = false;
    bf16_t* MG; const bf16_t* G; int gofs;
    __device__ __forceinline__ void operator()(const f32x4 (&acc)[2][2][4][2], const Unit& u, int wr, int wc, int fr, int fq) const {
        const int row0 = u.pm * BM + wr * 64 + fr, col0 = u.pn * BM + wc * 32 + 8 * fq;
#pragma unroll
        for (int ai = 0; ai < 2; ++ai)
#pragma unroll
            for (int m = 0; m < 4; ++m) {
                const size_t row = (size_t)(row0 + ai * HALF + m * 16);
#pragma unroll
                for (int bj = 0; bj < 2; ++bj) {
                    const u32x4 gv = *(const u32x4*)(G + row * 3072 + gofs + col0 + bj * HALF);
                    bf16_t* mp = MG + row * 1024 + col0 + bj * HALF;
                    const f32x4 a0 = acc[ai][bj][m][0], a1 = acc[ai][bj][m][1];
                    float o[8] = {bflo(gv.x) * a0[0], bfhi(gv.x) * a0[1], bflo(gv.y) * a0[2], bfhi(gv.y) * a0[3], bflo(gv.z) * a1[0], bfhi(gv.z) * a1[1], bflo(gv.w) * a1[2], bfhi(gv.w) * a1[3]};
                    if (MODE) { const u32x4 ov = *(const u32x4*)mp; o[0] += bflo(ov.x); o[1] += bfhi(ov.x); o[2] += bflo(ov.y); o[3] += bfhi(ov.y); o[4] += bflo(ov.z); o[5] += bfhi(ov.z); o[6] += bflo(ov.w); o[7] += bfhi(ov.w); }
                    u32x4 w; w.x = cvt_pk_bf16(o[0], o[1]); w.y = cvt_pk_bf16(o[2], o[3]); w.z = cvt_pk_bf16(o[4], o[5]); w.w = cvt_pk_bf16(o[6], o[7]);
                    *(u32x4*)mp = w;
                }
            }
    }
};
struct EpiWin {
    static constexpr bool PERM = true, AFTER_DRAIN = false;
    bf16_t *QA, *QC, *IQ, *MISC, *KVC, *KVS, *KVW, *BU, *G; const float* rope; const PG8_LAS float* rs;
    __device__ __forceinline__ void operator()(const f32x4 (&acc)[2][2][4][2], const Unit& u, int wr, int wc, int fr, int fq) const {
        const int pn = u.pn;
        bf16_t* dst; int ld, cbase, mode;
        if (pn < 2) { dst = QA; ld = 512; cbase = pn * 256; mode = 1; }
        else if (pn < 4) { dst = QC; ld = 512; cbase = (pn - 2) * 256; mode = 1; }
        else if (pn == 4) { dst = IQ; ld = 256; cbase = 0; mode = 1; }
        else if (pn == 5) { dst = MISC; ld = 256; cbase = 0; mode = 3; }
        else if (pn <= 8) { dst = pn == 6 ? KVC : (pn == 7 ? KVS : KVW); ld = 256; cbase = 0; mode = 2; }
        else if (pn <= 10) { dst = BU; ld = 512; cbase = (pn - 9) * 256; mode = 0; }
        else { dst = G; ld = 3072; cbase = (pn - 11) * 256; mode = 4; }
        const int row0 = u.pm * BM + wr * 64 + fr, col0 = cbase + wc * 32 + 8 * fq;
        const bool ropelane = ((wc & 1) == 0) && fq < 2;
        const float sc = (mode == 1) ? (pn < 4 ? 0.125f * 1.4426950408889634f : 0.125f) : 1.0f;
#pragma unroll
        for (int ai = 0; ai < 2; ++ai)
#pragma unroll
            for (int m = 0; m < 4; ++m) {
                const size_t row = (size_t)(row0 + ai * HALF + m * 16);
                const float rr = rs[u.ord * 256 + wr * 64 + fr + ai * HALF + m * 16];
                f32x4 cs = {1.f, 1.f, 1.f, 1.f}, sn = {0.f, 0.f, 0.f, 0.f};
                if (ropelane && mode >= 1 && mode <= 3) { cs = *(const f32x4*)(rope + row * 16 + 4 * fq); sn = *(const f32x4*)(rope + row * 16 + 8 + 4 * fq); }
#pragma unroll
                for (int bj = 0; bj < 2; ++bj) {
                    const f32x4 a0 = acc[ai][bj][m][0] * rr, a1 = acc[ai][bj][m][1] * rr;
                    float o[8] = {a0[0], a0[1], a0[2], a0[3], a1[0], a1[1], a1[2], a1[3]};
                    const bool dorope = ropelane && (mode == 1 || (mode == 2 && bj == 0) || (mode == 3 && bj == 0 && wc == 0));
                    if (dorope) {
#pragma unroll
                        for (int p = 0; p < 4; ++p) { const float x1 = o[2 * p], x2 = o[2 * p + 1]; o[2 * p] = x1 * cs[p] - x2 * sn[p]; o[2 * p + 1] = x2 * cs[p] + x1 * sn[p]; }
                    }
                    if (mode == 4) {
#pragma unroll
                        for (int e = 0; e < 8; ++e) o[e] = fast_sigmoid(o[e]);
                    } else {
#pragma unroll
                        for (int e = 0; e < 8; ++e) o[e] *= sc;
                    }
                    u32x4 w; w.x = cvt_pk_bf16(o[0], o[1]); w.y = cvt_pk_bf16(o[2], o[3]); w.z = cvt_pk_bf16(o[4], o[5]); w.w = cvt_pk_bf16(o[6], o[7]);
                    *(u32x4*)(dst + row * ld + col0 + bj * HALF) = w;
                }
            }
    }
};

template <class Epi, class Sched, bool ALIGN_EPI = false, bool SP2 = false>
__device__ __forceinline__ void gemm_phase(PG8_LAS unsigned char* lds, const Gemm g, const Sched& S, const Epi& E, int tid_in) {
    int tid_ = tid_in; asm volatile("" : "+v"(tid_));
    const int tid = tid_, wid = __builtin_amdgcn_readfirstlane(tid >> 6), lane = tid & 63, wr = wid >> 2, wc = wid & 3, fr = lane & 15, fq = lane >> 4;
    const int K = g.K, nt = K / BK;
    unsigned voffA[2], voffB[2];
#pragma unroll
    for (int i = 0; i < 2; ++i) { int R, C; stage_rc(tid * 16 + i * 8192, R, C); const int Rb = Epi::PERM ? ((R & ~31) + perm32(R & 31)) : R;
        voffA[i] = (unsigned)(R * K + C) * 2u; voffB[i] = (unsigned)(Rb * K + C) * 2u; }
    const size_t kstep = (size_t)(BK * 2);
    const size_t hstep = (size_t)HALF * K * 2;
    const size_t tstep = 2 * hstep;
    const unsigned ldsw = (unsigned)wid * 1024u;
    const int aoff = lds_byte(wr * 64 + fr, fq * 8), boff = lds_byte(wc * 32 + fr, fq * 8);
#define PG8_SA(b, h) (((b) * 2 + (h)) * HTB)
#define PG8_SB(b, h) ((4 + (b) * 2 + (h)) * HTB)
#define PG8_STAGE(bufoff, gbase, voff) do { _Pragma("unroll") for (int _i = 0; _i < 2; ++_i) \
        __builtin_amdgcn_global_load_lds((const unsigned*)((const char*)(gbase) + (voff)[_i]), (PG8_LAS unsigned*)(lds + (bufoff) + ldsw + _i * 8192), 16, 0, 0); } while (0)
#define PG8_LDA(dst, b, h) do { _Pragma("unroll") for (int m = 0; m < 4; ++m) _Pragma("unroll") for (int k = 0; k < 2; ++k) dst[m][k] = *(const PG8_LAS bf16x8*)(lds + PG8_SA(b, h) + aoff + m * 2048 + k * 1024); } while (0)
#define PG8_LDB(dst, b, h) do { _Pragma("unroll") for (int n = 0; n < 2; ++n) _Pragma("unroll") for (int k = 0; k < 2; ++k) dst[n][k] = *(const PG8_LAS bf16x8*)(lds + PG8_SB(b, h) + boff + n * 2048 + k * 1024); } while (0)
#define PG8_MMA(ai, bj, At, Bt) do { __builtin_amdgcn_s_setprio(1); _Pragma("unroll") for (int m = 0; m < 4; ++m) _Pragma("unroll") for (int n = 0; n < 2; ++n) _Pragma("unroll") for (int k = 0; k < 2; ++k) \
        acc[ai][bj][m][n] = __builtin_amdgcn_mfma_f32_16x16x32_bf16(Bt[n][k], At[m][k], acc[ai][bj][m][n], 0, 0, 0); __builtin_amdgcn_s_setprio(0); } while (0)
#define PG8_WAIT_V(n) asm volatile("s_waitcnt vmcnt(" #n ")" ::: "memory")
#define PG8_WAIT_L(n) asm volatile("s_waitcnt lgkmcnt(" #n ")" ::: "memory")
#define PG8_BAR __builtin_amdgcn_s_barrier()
#define PG8_SCHED __builtin_amdgcn_sched_barrier(0)
    Unit cur, nxt; int ui = 0;
    if (!S.next(0, cur)) return;
    f32x4 acc[2][2][4][2];
#pragma unroll
    for (int a = 0; a < 2; ++a)
#pragma unroll
        for (int b = 0; b < 2; ++b)
#pragma unroll
            for (int m = 0; m < 4; ++m)
#pragma unroll
                for (int n = 0; n < 2; ++n) acc[a][b][m][n] = (f32x4){0.f, 0.f, 0.f, 0.f};
    bf16x8 At[4][2], B0[2][2], B1[2][2];
    const char* cA = (const char*)g.A + (size_t)cur.pm * tstep; const char* cB = (const char*)g.Bt + (size_t)cur.pn * tstep;
    S.a_ready(cur);
    if constexpr (SP2) {
        PG8_STAGE(PG8_SB(0, 0), cB, voffB); PG8_STAGE(PG8_SB(0, 1), cB + hstep, voffB); PG8_STAGE(PG8_SA(0, 0), cA, voffA); PG8_STAGE(PG8_SA(0, 1), cA + hstep, voffA);
        if (wr == 1) PG8_BAR;
        PG8_WAIT_V(2); PG8_BAR;
        PG8_STAGE(PG8_SB(1, 0), cB + kstep, voffB); PG8_STAGE(PG8_SA(1, 0), cA + kstep, voffA); PG8_STAGE(PG8_SB(1, 1), cB + hstep + kstep, voffB);
        PG8_WAIT_V(6); PG8_BAR;
    } else {
        PG8_STAGE(PG8_SB(0, 0), cB, voffB); PG8_STAGE(PG8_SA(0, 0), cA, voffA); PG8_STAGE(PG8_SB(0, 1), cB + hstep, voffB); PG8_STAGE(PG8_SA(0, 1), cA + hstep, voffA);
        if (wr == 1) PG8_BAR;
        PG8_WAIT_V(4); PG8_BAR;
        PG8_STAGE(PG8_SB(1, 0), cB + kstep, voffB); PG8_STAGE(PG8_SA(1, 0), cA + kstep, voffA); PG8_STAGE(PG8_SB(1, 1), cB + hstep + kstep, voffB);
        PG8_WAIT_V(6); PG8_BAR;
    }
    for (;;) {
        const bool has_next = S.next(ui + 1, nxt);
        const char* nA = has_next ? (const char*)g.A + (size_t)nxt.pm * tstep : cA; const char* nB = has_next ? (const char*)g.Bt + (size_t)nxt.pn * tstep : cB;
        for (int t = 0; t < nt; t += 2) {
            const bool last = (t == nt - 2);
            const char* a1 = cA + (size_t)(t + 1) * kstep;
            const char* a2 = last ? nA : cA + (size_t)(t + 2) * kstep; const char* b2 = last ? nB : cB + (size_t)(t + 2) * kstep;
            const char* a3 = a2 + kstep; const char* b3 = b2 + kstep;
            if (last && has_next) S.a_ready(nxt);
            if constexpr (SP2) {
            PG8_LDB(B0, 0, 0); PG8_LDB(B1, 0, 1); PG8_SCHED; PG8_LDA(At, 0, 0); PG8_STAGE(PG8_SA(1, 1), a1 + hstep, voffA);
            PG8_WAIT_V(8); PG8_WAIT_L(0); PG8_BAR; PG8_MMA(0, 0, At, B0); PG8_MMA(0, 1, At, B1); PG8_BAR; PG8_SCHED;
            PG8_LDA(At, 0, 1); PG8_STAGE(PG8_SB(0, 0), b2, voffB); PG8_STAGE(PG8_SB(0, 1), b2 + hstep, voffB); PG8_STAGE(PG8_SA(0, 0), a2, voffA);
            PG8_WAIT_V(8); PG8_WAIT_L(0); PG8_BAR; PG8_MMA(1, 0, At, B0); PG8_MMA(1, 1, At, B1); PG8_BAR; PG8_SCHED;
            PG8_LDB(B0, 1, 0); PG8_LDB(B1, 1, 1); PG8_SCHED; PG8_LDA(At, 1, 0); PG8_STAGE(PG8_SA(0, 1), a2 + hstep, voffA);
            PG8_WAIT_V(8); PG8_WAIT_L(0); PG8_BAR; PG8_MMA(0, 0, At, B0); PG8_MMA(0, 1, At, B1); PG8_BAR; PG8_SCHED;
            PG8_LDA(At, 1, 1); PG8_STAGE(PG8_SB(1, 0), b3, voffB); PG8_STAGE(PG8_SB(1, 1), b3 + hstep, voffB); PG8_STAGE(PG8_SA(1, 0), a3, voffA);
            PG8_WAIT_V(8); PG8_WAIT_L(0); PG8_BAR; PG8_MMA(1, 0, At, B0); PG8_MMA(1, 1, At, B1); PG8_BAR; PG8_SCHED;
            } else {
            PG8_LDB(B0, 0, 0); PG8_SCHED; PG8_LDA(At, 0, 0); PG8_STAGE(PG8_SA(1, 1), a1 + hstep, voffA);
            PG8_WAIT_L(8); PG8_BAR; PG8_WAIT_L(0); PG8_MMA(0, 0, At, B0); PG8_BAR; PG8_SCHED;
            PG8_LDB(B1, 0, 1); PG8_STAGE(PG8_SB(0, 0), b2, voffB);
            PG8_BAR; PG8_WAIT_L(0); PG8_MMA(0, 1, At, B1); PG8_BAR;
            PG8_LDA(At, 0, 1); PG8_STAGE(PG8_SA(0, 0), a2, voffA);
            PG8_BAR; PG8_WAIT_L(0); PG8_MMA(1, 0, At, B0); PG8_BAR; PG8_SCHED;
            PG8_STAGE(PG8_SB(0, 1), b2 + hstep, voffB);
            PG8_WAIT_V(6); PG8_BAR; PG8_MMA(1, 1, At, B1); PG8_BAR;
            PG8_LDB(B0, 1, 0); PG8_SCHED; PG8_LDA(At, 1, 0); PG8_STAGE(PG8_SA(0, 1), a2 + hstep, voffA);
            PG8_WAIT_L(8); PG8_BAR; PG8_WAIT_L(0); PG8_MMA(0, 0, At, B0); PG8_BAR; PG8_SCHED;
            PG8_LDB(B1, 1, 1); PG8_STAGE(PG8_SB(1, 0), b3, voffB);
            PG8_BAR; PG8_WAIT_L(0); PG8_MMA(0, 1, At, B1); PG8_BAR;
            PG8_LDA(At, 1, 1); PG8_STAGE(PG8_SA(1, 0), a3, voffA);
            PG8_BAR; PG8_WAIT_L(0); PG8_MMA(1, 0, At, B0); PG8_BAR; PG8_SCHED;
            PG8_STAGE(PG8_SB(1, 1), b3 + hstep, voffB);
            PG8_WAIT_V(6); PG8_BAR; PG8_MMA(1, 1, At, B1); PG8_BAR;
            }
        }
        if constexpr (ALIGN_EPI) { if (wr == 0) PG8_BAR; }
        if constexpr (!Epi::AFTER_DRAIN) { E(acc, cur, wr, wc, fr, fq); S.done(cur); }
        if (!has_next) break;
#pragma unroll
        for (int a = 0; a < 2; ++a)
#pragma unroll
            for (int b = 0; b < 2; ++b)
#pragma unroll
                for (int m = 0; m < 4; ++m)
#pragma unroll
                    for (int n = 0; n < 2; ++n) acc[a][b][m][n] = (f32x4){0.f, 0.f, 0.f, 0.f};
        cur = nxt; cA = nA; cB = nB; ++ui;
        if constexpr (ALIGN_EPI) { if (wr == 1) PG8_BAR; }
    }
    PG8_WAIT_V(0);
    if constexpr (!ALIGN_EPI) { if (wr == 0) PG8_BAR; }
    PG8_BAR;
    if constexpr (Epi::AFTER_DRAIN) { E.fused(acc, cur, wr, wc, fr, fq, lds, wid, lane); S.done(cur); }
#undef PG8_SA
#undef PG8_SB
#undef PG8_STAGE
#undef PG8_LDA
#undef PG8_LDB
#undef PG8_MMA
#undef PG8_WAIT_V
#undef PG8_WAIT_L
#undef PG8_BAR
#undef PG8_SCHED
}
}
#define GAS __attribute__((address_space(1)))
#define LAS __attribute__((address_space(3)))
typedef unsigned short bf16;
typedef unsigned v4u __attribute__((ext_vector_type(4)));
typedef float f32x4 __attribute__((ext_vector_type(4)));
typedef short bf16x8 __attribute__((ext_vector_type(8)));
typedef GAS unsigned gu32;
typedef GAS unsigned long long gu64;
#define RLX_AGENT __ATOMIC_RELAXED, __HIP_MEMORY_SCOPE_AGENT
#define LDS_WAIT() asm volatile("s_waitcnt lgkmcnt(0)" ::: "memory")
#define VM_WAIT() asm volatile("s_waitcnt vmcnt(0)" ::: "memory")
__device__ __forceinline__ unsigned long long rt() { return __builtin_amdgcn_s_memrealtime(); }
__device__ __forceinline__ unsigned f2bf(float f) { unsigned u = __builtin_bit_cast(unsigned, f); return (u + 0x7fffu + ((u >> 16) & 1u)) >> 16; }
__device__ __forceinline__ unsigned pk2(float lo, float hi) { return f2bf(lo) | (f2bf(hi) << 16); }
#define XB_TMO      128
#define XB_XCNT(j)  (256  + 64 * (j))
#define XB_XSUB(j)  (1280 + 64 * (j))
#define XB_XGEN(j)  (2304 + 64 * (j))
#define XB_TOP      3328
#define XB_TOPGEN   3392
#define XCD_BAR_WORDS 3456
#define XB_SPIN_CAP (1u << 18)

__device__ __forceinline__ unsigned xb_ld(unsigned* p)              { return __hip_atomic_load(p, __ATOMIC_RELAXED, __HIP_MEMORY_SCOPE_AGENT); }
__device__ __forceinline__ unsigned xb_add(unsigned* p, unsigned v) { return __hip_atomic_fetch_add(p, v, __ATOMIC_RELAXED, __HIP_MEMORY_SCOPE_AGENT); }
__device__ __forceinline__ unsigned xb_xcc_id() { return (unsigned)__builtin_amdgcn_s_getreg((3 << 11) | 20) & 0xFu; }
#define XB_SPIN(cond, bar) do { unsigned _sp = 0; while (cond) { __builtin_amdgcn_s_sleep(1); \
    if ((++_sp & 255u) == 0u) { if (xb_ld(&(bar)[XB_TMO])) break; if (_sp > XB_SPIN_CAP) { atomicAdd(&(bar)[XB_TMO], 1u); break; } } } } while (0)

struct XcdBarrier {
    unsigned* bar; unsigned x;
    volatile LAS unsigned* st;
};

__device__ __forceinline__ XcdBarrier xcd_barrier_post(unsigned* bar, volatile LAS unsigned* st) {
    XcdBarrier b; b.bar = bar; b.x = xb_xcc_id(); b.st = st;
    if (threadIdx.x == 0) (void)xb_add(&bar[XB_XCNT(b.x)], 1u);
    return b;
}
__device__ __forceinline__ void xcd_barrier_complete(unsigned* bar, unsigned x, unsigned& nloc, unsigned& nx) {
    const unsigned G = gridDim.x * gridDim.y * gridDim.z;
    unsigned sum, cnt, mine, sp = 0u;
    for (;;) {
        sum = 0u; cnt = 0u; mine = 0u;
#pragma unroll
        for (unsigned j = 0; j < 16; ++j) { const unsigned c = xb_ld(&bar[XB_XCNT(j)]); sum += c; cnt += (c > 0u) ? 1u : 0u; mine = (j == x) ? c : mine; }
        if (sum == G) break;
        __builtin_amdgcn_s_sleep(1);
        if ((++sp & 255u) == 0u) { if (xb_ld(&bar[XB_TMO])) break; if (sp > XB_SPIN_CAP) { atomicAdd(&bar[XB_TMO], 1u); break; } }
    }
    nloc = mine > 0u ? mine : 1u; nx = cnt > 0u ? cnt : 1u;
}

__device__ __forceinline__ void xcd_barrier(const XcdBarrier& b) {
    asm volatile("s_waitcnt vmcnt(0)" ::: "memory");
    __syncthreads();
    if (threadIdx.x == 0) {
        unsigned* bar = b.bar;
        __builtin_amdgcn_s_waitcnt(0);
        unsigned nloc = b.st[0], nx = b.st[1];
        if (nloc == 0u) { xcd_barrier_complete(bar, b.x, nloc, nx); b.st[0] = nloc; b.st[1] = nx; }
        const unsigned old = xb_add(&bar[XB_XSUB(b.x)], 1u);
        const unsigned gen = old / nloc;
        if (old + 1u == (gen + 1u) * nloc) {
            __builtin_amdgcn_fence(__ATOMIC_RELEASE, "agent");
            asm volatile("s_waitcnt vmcnt(0)" ::: "memory");
            const unsigned og = xb_add(&bar[XB_TOP], 1u);
            const unsigned tg = og / nx;
            if (og + 1u == (tg + 1u) * nx) xb_add(&bar[XB_TOPGEN], 1u);
            else XB_SPIN(xb_ld(&bar[XB_TOPGEN]) == tg, bar);
            __builtin_amdgcn_fence(__ATOMIC_ACQUIRE, "agent");
            xb_add(&bar[XB_XGEN(b.x)], 1u);
            asm volatile("s_waitcnt vmcnt(0)" ::: "memory");
        } else {
            XB_SPIN(xb_ld(&bar[XB_XGEN(b.x)]) == gen, bar);
            __builtin_amdgcn_fence(__ATOMIC_ACQUIRE, "agent");
            asm volatile("s_waitcnt vmcnt(0)" ::: "memory");
        }
    }
    __syncthreads();
}
constexpr int NB = 8, SEQ = 4096, DM = 1024, DEPTH = 4, M = NB * SEQ;
constexpr int FF = 2816, NIN = 5852, NINP = 5888;
constexpr float EPS = 1e-6f, NEGF = -1e30f;
constexpr int NWAVES = 8;
constexpr size_t MiB = 1u << 20;
constexpr size_t WS_CTL = 0, CTL_ZERO_BYTES = 1 * MiB;
constexpr size_t WS_ROPE = 1 * MiB;
constexpr size_t WS_KVA = 3 * MiB;
constexpr size_t WS_KC = 11 * MiB, WS_VC = WS_KC + 512 * 1024;
constexpr size_t WS_W = 12 * MiB;
constexpr size_t WO_GU1 = 0, WO_D1 = 11 * MiB, WO_GU2 = WO_D1 + 5 * MiB + 512 * 1024, WO_D2 = WO_GU2 + 11 * MiB, WO_IN = WO_D2 + 5 * MiB + 512 * 1024,
                 WO_PA = WO_IN + 11 * MiB + 512 * 1024, WO_PB = WO_PA + MiB, WO_PC = WO_PB + MiB, WO_OUT = WO_PC + MiB,
                 WO_CW1 = WO_OUT + 2 * MiB  , WO_CW2 = WO_CW1 + MiB  , WO_UKV = WO_CW2 + 32768  , WO_POOL = WO_UKV + 32768  ,
                 WO_POSB = WO_POOL + 131072  , WO_END = WO_POSB + 1024;
static_assert(WO_END <= 52 * MiB, "weights region");
constexpr size_t WS_XN = 64 * MiB;
constexpr size_t WS_R = 128 * MiB;
constexpr size_t WS_G = WS_R, WS_QA = WS_R + 192 * MiB, WS_QC = WS_QA + 32 * MiB, WS_IQ = WS_QC + 32 * MiB, WS_MISC = WS_IQ + 16 * MiB,
                 WS_KVC = WS_MISC + 16 * MiB, WS_KVS = WS_KVC + 16 * MiB, WS_KVW = WS_KVS + 16 * MiB, WS_BU = WS_KVW + 16 * MiB, WS_END = WS_BU + 32 * MiB;
#ifndef YB_SPARE
#define YB_SPARE 0
#endif
constexpr size_t WS_YB = YB_SPARE ? 496 * MiB : WS_XN;
constexpr size_t WS_MG = WS_IQ;
constexpr size_t WS_H = WS_R;
static_assert(WS_END == 496 * MiB, "ws map");
constexpr int RING_BYTES = 131072, LDS_BYTES = 163840, LDSCTL_OFF = 163840 - 256;
constexpr size_t WS_SSQ = 496 * MiB;
constexpr int RS_OFF = 131072;
constexpr int NPL = 10, NPH = 1 + DEPTH * NPL + 1;

__device__ __forceinline__ int lane_id_v() { int l; asm volatile("v_mbcnt_lo_u32_b32 %0, -1, 0\n\tv_mbcnt_hi_u32_b32 %0, -1, %0" : "=v"(l)); return l; }
__device__ __forceinline__ float bflo(unsigned w) { return __uint_as_float(w << 16); }
__device__ __forceinline__ float bfhi(unsigned w) { return __uint_as_float(w & 0xffff0000u); }
__device__ __forceinline__ float bf2f(bf16 v) { return __uint_as_float((unsigned)v << 16); }
__device__ __forceinline__ float wave_sum(float v) {
#pragma unroll
    for (int o = 1; o < 64; o <<= 1) v += __shfl_xor(v, o);
    return v;
}
__device__ __forceinline__ float wave_max(float v) {
#pragma unroll
    for (int o = 1; o < 64; o <<= 1) v = fmaxf(v, __shfl_xor(v, o));
    return v;
}
__device__ __forceinline__ int wave_sum_i(int v) {
#pragma unroll
    for (int o = 1; o < 64; o <<= 1) v += __shfl_xor(v, o);
    return v;
}
__device__ __forceinline__ unsigned wave_max_u(unsigned v) {
#pragma unroll
    for (int o = 1; o < 64; o <<= 1) { const unsigned w = (unsigned)__shfl_xor((int)v, o); v = w > v ? w : v; }
    return v;
}
#define WAVE_LDS_SYNC() do { asm volatile("s_waitcnt lgkmcnt(0)" ::: "memory"); __builtin_amdgcn_wave_barrier(); } while (0)
__host__ __device__ __forceinline__ int permd(int d) { return d < 8 ? 2 * d : (d < 16 ? 2 * (d - 8) + 1 : d); }
__device__ __forceinline__ int win_newcol(int n) {
    if (n < 512) return (n & ~63) + permd(n & 63);
    if (n < 640) return 1280 + 64 + (n - 512);
    if (n < 896) { const int m = n - 640; return 1024 + (m & ~63) + permd(m & 63); }
    if (n < 960) return 1280 + permd(n - 896);
    if (n < 964) return 1280 + 192 + (n - 960);
    if (n < 1476) return 2304 + (n - 964);
    if (n < 1988) { const int m = n - 1476; return 512 + (m & ~63) + permd(m & 63); }
    if (n < 2756) { const int m = n - 1988, kv = m >> 8, r = m & 255, base = 1536 + kv * 256; return r < 128 ? base + (r & ~63) + permd(r & 63) : base + r; }
    if (n < 2780) return 1280 + 196 + (n - 2756);
    return 2816 + (n - 2780);
}
__device__ __forceinline__ int map_row(int mode, int n) { return mode == 0 ? n : (mode == 1 ? ((n >> 7) << 8) + (n & 127) : (mode == 2 ? ((n >> 7) << 8) + 128 + (n & 127) : win_newcol(n))); }

struct Args { const float* in[24]; float* out; unsigned char* ws; int ph_lo, ph_hi; };

__device__ __forceinline__ int unperm(int p) { return p < 16 ? ((p & 1) ? (p >> 1) + 8 : (p >> 1)) : p; }
__device__ __forceinline__ void tr_item(const float* W, int K, int N, bf16* WT, int mode, LAS float* scr, int item, int lane, bool kperm = false, const float* kscale = nullptr) {
    const int nblk = (N + 31) >> 5, kb = item / nblk, nb = item - kb * nblk, k0 = 64 * kb, n0 = 32 * nb;
    const int nn = n0 + (lane & 31);
#pragma unroll
    for (int i = 0; i < 32; ++i) { const int kk = 2 * i + (lane >> 5); const float sc_ = kscale ? kscale[k0 + kk] : 1.0f; scr[kk * 33 + (lane & 31)] = nn < N ? W[(size_t)(k0 + kk) * N + nn] * sc_ : 0.f; }
    LDS_WAIT(); asm volatile("" ::: "memory");
    const int c = lane & 7;
#pragma unroll
    for (int j = 0; j < 4; ++j) { const int n = (lane >> 3) + 8 * j; const LAS float* s = scr + n;
        int ks[8];
#pragma unroll
        for (int i = 0; i < 8; ++i) ks[i] = (kperm ? unperm(8 * c + i) : 8 * c + i) * 33;
        v4u o; o.x = pk2(s[ks[0]], s[ks[1]]); o.y = pk2(s[ks[2]], s[ks[3]]); o.z = pk2(s[ks[4]], s[ks[5]]); o.w = pk2(s[ks[6]], s[ks[7]]);
        if (n0 + n < N) *(v4u*)(WT + (size_t)map_row(mode, n0 + n) * K + k0 + 8 * c) = o; }
    LDS_WAIT(); asm volatile("" ::: "memory");
}
__device__ __forceinline__ void phase_convert(const Args& P, unsigned char* ws, int z, int l, LAS unsigned char* lds, int gw, int NGW, int lane, int wave) {
    asm volatile("" : "+v"(lane)); lane &= 63; asm volatile("" : "+s"(gw), "+s"(NGW));
    LAS float* scr = (LAS float*)(lds + wave * 16384);
    unsigned char* wb = ws + WS_W;
    constexpr int I_F = 16 * 88, I_D = 44 * 32, I_IN = 16 * 183, I_P = 8 * 32, I_O = 16 * 32;
    constexpr int I_C = 32 * 4;
    constexpr int NIT = 4 * I_F + 2 * I_D + I_IN + 3 * I_P + I_O + 2 * I_C;
    const size_t fo = (size_t)l * DM * FF;
    for (int it = gw; it < NIT; it += NGW) {
        int r = it, K = DM, N = FF, mode = 1; const float* W = P.in[3 + z] + fo; size_t wo = WO_GU1; bool kperm = false; const float* ksc = P.in[2 + z] + l * DM;
        if (r >= I_F) { r -= I_F; mode = 2; W = P.in[4 + z] + fo;
        if (r >= I_F) { r -= I_F; mode = 0; W = P.in[5 + z] + fo; K = FF; N = DM; wo = WO_D1; ksc = nullptr;
        if (r >= I_D) { r -= I_D; mode = 1; W = P.in[20 + z] + fo; K = DM; N = FF; wo = WO_GU2; ksc = P.in[19 + z] + l * DM;
        if (r >= I_F) { r -= I_F; mode = 2; W = P.in[21 + z] + fo;
        if (r >= I_F) { r -= I_F; mode = 0; W = P.in[22 + z] + fo; K = FF; N = DM; wo = WO_D2; ksc = nullptr;
        if (r >= I_D) { r -= I_D; mode = 3; W = P.in[7 + z] + (size_t)l * DM * NIN; K = DM; N = NIN; wo = WO_IN; ksc = P.in[6 + z] + l * DM;
        if (r >= I_IN) { r -= I_IN; mode = 0; W = P.in[15 + z] + (size_t)l * 512 * DM; K = 512; N = DM; wo = WO_PA; ksc = nullptr;
        if (r >= I_P) { r -= I_P; W = P.in[16 + z] + (size_t)l * 512 * DM; wo = WO_PB;
        if (r >= I_P) { r -= I_P; W = P.in[17 + z] + (size_t)l * 512 * DM; wo = WO_PC;
        if (r >= I_P) { r -= I_P; W = P.in[18 + z] + (size_t)l * DM * DM; K = DM; wo = WO_OUT;
        if (r >= I_O) { r -= I_O; W = P.in[13 + z] + (size_t)(l * 2) * 2048 * 128; K = 2048; N = 128; wo = WO_CW1; kperm = true;
        if (r >= I_C) { r -= I_C; W += (size_t)2048 * 128; wo = WO_CW1 + 128 * 2048 * 2; kperm = false; } } } } } } } } } } } }
        tr_item(W, K, N, (bf16*)(wb + wo), mode, scr, r, lane, kperm, ksc);
    }
    {
        const int gt = gw * 64 + lane, GT = NGW * 64;
        bf16* ukv = (bf16*)(wb + WO_UKV); bf16* pool = (bf16*)(wb + WO_POOL); bf16* cw2 = (bf16*)(wb + WO_CW2); float* posb = (float*)(wb + WO_POSB);
        const float* w_ukv = P.in[9 + z] + (size_t)l * 128 * 128; const float* gn = P.in[8 + z] + l * 128;
        for (int i = gt; i < 128 * 128; i += GT) { const int np = i >> 7, k = i & 127, n = np < 64 ? unperm(np) : np; ukv[i] = (bf16)f2bf(gn[k] * w_ukv[k * 128 + n]); }
        const float* pw = P.in[10 + z] + (size_t)l * 4 * 128 * 128; const float* psc = P.in[11 + z] + l * 512;
        for (int i = gt; i < 4 * 128 * 128; i += GT) { const int g = i >> 14, d = (i >> 7) & 127, c = i & 127; pool[i] = (bf16)f2bf(pw[(g * 128 + c) * 128 + d] * psc[g * 128 + d]); }
        const float* w2 = P.in[14 + z] + (size_t)l * 2 * 128 * 64;
        for (int i = gt; i < 2 * 64 * 128; i += GT) { const int br = i >> 13, dp = (i >> 7) & 63, n = i & 127, d = br ? dp : unperm(dp); cw2[i] = (bf16)f2bf(w2[(br * 128 + n) * 64 + d]); }
        const float* w1 = P.in[13 + z] + (size_t)l * 2 * 2048 * 128; const float* pos = P.in[12 + z] + (size_t)l * 2 * 2048;
        for (int i = gw; i < 256; i += NGW) { const int br = i >> 7, n = i & 127; float a = 0.f;
#pragma unroll 8
            for (int k = lane; k < 2048; k += 64) a += pos[br * 2048 + k] * w1[((size_t)br * 2048 + k) * 128 + n];
            a = wave_sum(a); if (lane == 0) posb[i] = a; }
    }
    if (gw < 36) { unsigned zz = 0u; asm volatile("" : "+v"(zz)); v4u z = {zz, zz, zz, zz}; v4u* rp = (v4u*)((bf16*)(wb + WO_IN) + (size_t)(1500 + gw) * DM); for (int i = lane; i < DM / 8; i += 64) rp[i] = z; }
}
__device__ __forceinline__ void phase_rope(const Args& P, unsigned char* ws, int z, int gtid, int gthreads) {
    float* rope = (float*)(ws + WS_ROPE);
    for (int idx = gtid; idx < M * 8; idx += gthreads) {
        const int row = idx >> 3, i = idx & 7;
        const double inv = pow(500000.0, -(double)i / 8.0), ang = (double)((const int*)P.in[1 + z])[row] * inv;
        double s, c; sincos(ang, &s, &c);
        rope[row * 16 + i] = (float)c; rope[row * 16 + 8 + i] = (float)s;
    }
}
__device__ __forceinline__ void norm_row_bf16(const float* xrow, const float* gain, bf16* orow, int lane) {
    const f32x4* xr = (const f32x4*)xrow + lane; const f32x4* gr = (const f32x4*)gain + lane;
    f32x4 v[4]; float s = 0.f;
#pragma unroll
    for (int j = 0; j < 4; ++j) { v[j] = xr[64 * j]; s += (v[j].x * v[j].x + v[j].y * v[j].y) + (v[j].z * v[j].z + v[j].w * v[j].w); }
    const float r = 1.0f / sqrtf(wave_sum(s) * (1.f / DM) + EPS);
    unsigned long long* o8 = (unsigned long long*)orow + lane;
#pragma unroll
    for (int j = 0; j < 4; ++j) { const f32x4 g = gr[64 * j]; o8[64 * j] = (unsigned long long)pk2(v[j].x * r * g.x, v[j].y * r * g.y) | ((unsigned long long)pk2(v[j].z * r * g.z, v[j].w * r * g.w) << 32); }
}
__device__ __forceinline__ void stat_row_bf16(const float* xrow, bf16* orow, float* ssq16, int lane) {
    const f32x4* xr = (const f32x4*)xrow + lane;
    f32x4 v[4]; float s = 0.f;
#pragma unroll
    for (int j = 0; j < 4; ++j) { v[j] = xr[64 * j]; s += (v[j].x * v[j].x + v[j].y * v[j].y) + (v[j].z * v[j].z + v[j].w * v[j].w); }
    s = wave_sum(s);
    unsigned long long* o8 = (unsigned long long*)orow + lane;
#pragma unroll
    for (int j = 0; j < 4; ++j) o8[64 * j] = (unsigned long long)pk2(v[j].x, v[j].y) | ((unsigned long long)pk2(v[j].z, v[j].w) << 32);
    if (lane < 16) ssq16[lane] = lane == 0 ? s : 0.f;
}
__device__ __forceinline__ void norm_row_f32(float* xrow, const float* gain, int lane) {
    f32x4* xr = (f32x4*)xrow + lane; const f32x4* gr = (const f32x4*)gain + lane;
    f32x4 v[4]; float s = 0.f;
#pragma unroll
    for (int j = 0; j < 4; ++j) { v[j] = xr[64 * j]; s += (v[j].x * v[j].x + v[j].y * v[j].y) + (v[j].z * v[j].z + v[j].w * v[j].w); }
    const float r = 1.0f / sqrtf(wave_sum(s) * (1.f / DM) + EPS);
#pragma unroll
    for (int j = 0; j < 4; ++j) { const f32x4 g = gr[64 * j]; xr[64 * j] = v[j] * r * g; }
}
__device__ __forceinline__ unsigned f2o(float s) { const unsigned b = __float_as_uint(s); return (b & 0x80000000u) ? ~b : (b | 0x80000000u); }
__device__ __forceinline__ void unpack8(const v4u v, float* f) { f[0] = bflo(v.x); f[1] = bfhi(v.x); f[2] = bflo(v.y); f[3] = bfhi(v.y); f[4] = bflo(v.z); f[5] = bfhi(v.z); f[6] = bflo(v.w); f[7] = bfhi(v.w); }
__device__ __forceinline__ void load_row64(const bf16* p, float* f) {
    const v4u* q = (const v4u*)p;
#pragma unroll
    for (int i = 0; i < 8; ++i) unpack8(q[i], f + 8 * i);
}
__device__ __forceinline__ float dot64(const LAS float* q, const float* k) {
    float d = 0.f;
#pragma unroll
    for (int i = 0; i < 16; ++i) { const f32x4 qq = *(const LAS f32x4*)(q + 4 * i); d += qq.x * k[4 * i] + qq.y * k[4 * i + 1] + qq.z * k[4 * i + 2] + qq.w * k[4 * i + 3]; }
    return d;
}
__device__ __forceinline__ void dsa_query(const Args& P, unsigned char* ws, int z, int row, LAS unsigned char* wl, int lane) {
    const int b = row >> 12, t = row & (SEQ - 1), n = t + 1;
    LAS unsigned* su = (LAS unsigned*)wl; LAS float* pb = (LAS float*)wl; LAS unsigned short* list = (LAS unsigned short*)(wl + 16384); LAS float* qb = (LAS float*)(wl + 16896);
    const bf16* misc = (const bf16*)(ws + WS_MISC);
    const unsigned long long lt = (1ull << lane) - 1ull;
    int nsel;
    if (n <= 256) { for (int i = lane; i < n; i += 64) list[i] = (unsigned short)i; nsel = n; }
    else {
        { const uint2 v = *(const uint2*)((const bf16*)(ws + WS_IQ) + (size_t)row * 256 + lane * 4); qb[lane * 4] = bflo(v.x); qb[lane * 4 + 1] = bfhi(v.x); qb[lane * 4 + 2] = bflo(v.y); qb[lane * 4 + 3] = bfhi(v.y); }
        float iw[4]; { const uint2 v = *(const uint2*)(misc + (size_t)row * 256 + 192); iw[0] = 0.5f * bflo(v.x); iw[1] = 0.5f * bfhi(v.x); iw[2] = 0.5f * bflo(v.y); iw[3] = 0.5f * bfhi(v.y); }
        WAVE_LDS_SYNC();
        const int nch = (n + 63) >> 6;
        for (int i = 0; i < nch; ++i) {
            const int key = i * 64 + lane; const bool valid = key <= t;
            float kf[64]; load_row64(misc + (size_t)(b * SEQ + (valid ? key : t)) * 256, kf);
            float s = 0.f;
#pragma unroll
            for (int h = 0; h < 4; ++h) s += iw[h] * fmaxf(dot64(qb + h * 64, kf), 0.f);
            su[key] = valid ? f2o(s) : 0u;
        }
        WAVE_LDS_SYNC();
        unsigned prefix = 0u;
        for (int bit = 31; bit >= 0; --bit) {
            const unsigned cand = prefix | (1u << bit); int c = 0;
            for (int i = 0; i < nch; ++i) c += (su[i * 64 + lane] >= cand) ? 1 : 0;
            c = wave_sum_i(c);
            if (c >= 256) prefix = cand;
            if (c == 256) break;
        }
        int cgt = 0;
        for (int i = 0; i < nch; ++i) cgt += (su[i * 64 + lane] > prefix) ? 1 : 0;
        const int need_eq = 256 - wave_sum_i(cgt);
        int base = 0, eq_taken = 0;
        for (int i = 0; i < nch; ++i) {
            const unsigned v = su[i * 64 + lane]; const bool gt = v > prefix, eq = v == prefix;
            const unsigned long long meq = __ballot(eq);
            const bool sel = gt || (eq && (eq_taken + __popcll(meq & lt)) < need_eq);
            const unsigned long long ms = __ballot(sel);
            if (sel) list[base + __popcll(ms & lt)] = (unsigned short)(i * 64 + lane);
            base += __popcll(ms); eq_taken += __popcll(meq);
        }
        nsel = 256;
    }
    { const v4u v = *(const v4u*)((const bf16*)(ws + WS_QA) + (size_t)row * 512 + lane * 8); float f[8]; unpack8(v, f);
#pragma unroll
      for (int e = 0; e < 8; ++e) qb[lane * 8 + e] = f[e]; }
    WAVE_LDS_SYNC();
    const bf16* kva = (const bf16*)(ws + WS_KVA);
    float s[8][4];
#pragma unroll
    for (int j = 0; j < 4; ++j) {
        const int slot = lane + 64 * j; const bool valid = slot < nsel; const int key = list[valid ? slot : 0];
        float kf[64]; load_row64(kva + (size_t)(b * SEQ + key) * 128, kf);
#pragma unroll
        for (int h = 0; h < 8; ++h) s[h][j] = valid ? dot64(qb + h * 64, kf) : NEGF;
    }
    float linv[8];
#pragma unroll
    for (int h = 0; h < 8; ++h) {
        const float m = wave_max(fmaxf(fmaxf(s[h][0], s[h][1]), fmaxf(s[h][2], s[h][3]))); float ls = 0.f;
#pragma unroll
        for (int j = 0; j < 4; ++j) { const float p = __expf(s[h][j] - m); ls += p; pb[h * 256 + lane + 64 * j] = p; }
        linv[h] = 1.0f / wave_sum(ls);
    }
    WAVE_LDS_SYNC();
    float acc[8] = {0.f, 0.f, 0.f, 0.f, 0.f, 0.f, 0.f, 0.f};
    for (int slot = 0; slot < nsel; ++slot) {
        const float v = bf2f(kva[(size_t)(b * SEQ + list[slot]) * 128 + 64 + lane]);
#pragma unroll
        for (int h = 0; h < 8; ++h) acc[h] += pb[h * 256 + slot] * v;
    }
    bf16* ya = (bf16*)(ws + WS_QA) + (size_t)row * 512;
#pragma unroll
    for (int h = 0; h < 8; ++h) ya[h * 64 + lane] = (bf16)f2bf(acc[h] * linv[h]);
    WAVE_LDS_SYNC();
}
typedef short s16x4 __attribute__((ext_vector_type(4)));
typedef short v4i16_t __attribute__((ext_vector_type(4)));
typedef float f32x4v __attribute__((ext_vector_type(4)));
typedef __bf16 bf16x2_t __attribute__((ext_vector_type(2)));
typedef float f32x2_t __attribute__((ext_vector_type(2)));
__device__ __forceinline__ unsigned cvtpk(float lo, float hi) { f32x2_t v = {lo, hi}; bf16x2_t b = __builtin_convertvector(v, bf16x2_t); return __builtin_bit_cast(unsigned, b); }
constexpr float L2E = 1.4426950408889634f;
#ifndef NSA_NOSKIP
#define NSA_NOSKIP 0
#endif
constexpr int NSA_KSTR = 72, NSA_VSTR = 80;
constexpr int NSA_KB = 64 * NSA_KSTR * 2, NSA_VB = 64 * NSA_VSTR * 2;
constexpr int NSA_OFF_K = 0, NSA_OFF_V = 4 * NSA_KB, NSA_OFF_IMPA = NSA_OFF_V + 4 * NSA_VB, NSA_OFF_IMPB = NSA_OFF_IMPA + 64 * 65 * 4, NSA_OFF_UM = NSA_OFF_IMPB + 64 * 65 * 4, NSA_OFF_ST = NSA_OFF_UM + 64, NSA_LDS = NSA_OFF_ST + 512 * 64;
__device__ __forceinline__ s16x4 tr16(const LAS unsigned char* p) { return __builtin_bit_cast(s16x4, __builtin_amdgcn_ds_read_tr16_b64_v4i16((LAS v4i16_t*)p)); }
__device__ __forceinline__ bf16x8 cat4(s16x4 a, s16x4 b) { return __builtin_shufflevector(a, b, 0, 1, 2, 3, 4, 5, 6, 7); }
__device__ __forceinline__ bf16x8 pack8(float a0, float a1, float a2, float a3, float b0, float b1, float b2, float b3) {
    v4u w; w.x = pg8::cvt_pk_bf16(a0, a1); w.y = pg8::cvt_pk_bf16(a2, a3); w.z = pg8::cvt_pk_bf16(b0, b1); w.w = pg8::cvt_pk_bf16(b2, b3); return __builtin_bit_cast(bf16x8, w);
}
__device__ __forceinline__ float xmax16(float v) { v = fmaxf(v, __shfl_xor(v, 16)); return fmaxf(v, __shfl_xor(v, 32)); }
__device__ __forceinline__ float xsum16(float v) { v += __shfl_xor(v, 16); return v + __shfl_xor(v, 32); }

__device__ __forceinline__ void nsa_fetch(const bf16* kv, int b, int jb, int g, int tid, v4u& kr, v4u& vr) {
    const bf16* p = kv + (size_t)(b * SEQ + 64 * jb + (tid >> 3)) * 256 + g * 64 + (tid & 7) * 8;
    kr = *(const v4u*)p; vr = *(const v4u*)(p + 128);
}
__device__ __forceinline__ void nsa_stash(LAS unsigned char* Kb, LAS unsigned char* Vb, int tid, const v4u& kr, const v4u& vr) {
    *(LAS v4u*)(Kb + ((tid >> 3) * NSA_KSTR + (tid & 7) * 8) * 2) = kr; *(LAS v4u*)(Vb + ((tid >> 3) * NSA_VSTR + (tid & 7) * 8) * 2) = vr;
}
template <bool FULL>
__device__ __forceinline__ void nsa_block2(const LAS unsigned char* Kb, const LAS unsigned char* Vb, const bf16x8 (&qf)[2][2], const bool (&sel)[2], const int (&klo)[2], const int (&khi)[2],
                                           float (&mrow)[2], float (&lrow)[2], f32x4v (&o)[2][4], int lane) {
    const int j = lane & 15, gq = lane >> 4;
    f32x4v s[2][4];
#pragma unroll
    for (int kt = 0; kt < 4; ++kt) {
        s[0][kt] = (f32x4v){0.f, 0.f, 0.f, 0.f}; s[1][kt] = (f32x4v){0.f, 0.f, 0.f, 0.f};
#pragma unroll
        for (int ks = 0; ks < 2; ++ks) {
            const bf16x8 kf = *(const LAS bf16x8*)(Kb + ((16 * kt + j) * NSA_KSTR + 8 * gq + 32 * ks) * 2);
            s[0][kt] = __builtin_amdgcn_mfma_f32_16x16x32_bf16(kf, qf[0][ks], s[0][kt], 0, 0, 0);
            s[1][kt] = __builtin_amdgcn_mfma_f32_16x16x32_bf16(kf, qf[1][ks], s[1][kt], 0, 0, 0);
        }
    }
#pragma unroll
    for (int rg = 0; rg < 2; ++rg) {
        float bm = NEGF;
        if (FULL) { const float bias = sel[rg] ? 0.f : NEGF;
#pragma unroll
            for (int kt = 0; kt < 4; ++kt)
#pragma unroll
                for (int e = 0; e < 4; ++e) { const float v = s[rg][kt][e] + bias; s[rg][kt][e] = v; bm = fmaxf(bm, v); }
        } else {
#pragma unroll
            for (int kt = 0; kt < 4; ++kt)
#pragma unroll
                for (int e = 0; e < 4; ++e) { const int ko = 16 * kt + 4 * gq + e; const bool ok = sel[rg] && ko >= klo[rg] && ko <= khi[rg]; const float v = ok ? s[rg][kt][e] : NEGF; s[rg][kt][e] = v; bm = fmaxf(bm, v); }
        }
        bm = xmax16(bm);
        const float mnew = fmaxf(mrow[rg], bm), alpha = __builtin_amdgcn_exp2f(mrow[rg] - mnew);
        const bool moved = __builtin_amdgcn_ballot_w64(mnew != mrow[rg]) != 0ull;
        mrow[rg] = mnew;
        float ps = 0.f;
#pragma unroll
        for (int kt = 0; kt < 4; ++kt)
#pragma unroll
            for (int e = 0; e < 4; ++e) { const float p = __builtin_amdgcn_exp2f(s[rg][kt][e] - mnew); s[rg][kt][e] = p; ps += p; }
        lrow[rg] = lrow[rg] * alpha + ps;
        if (moved) {
#pragma unroll
            for (int dt = 0; dt < 4; ++dt) o[rg][dt] *= alpha;
        }
    }
#pragma unroll
    for (int kk = 0; kk < 2; ++kk) {
        const bf16x8 pf0 = pack8(s[0][2 * kk][0], s[0][2 * kk][1], s[0][2 * kk][2], s[0][2 * kk][3], s[0][2 * kk + 1][0], s[0][2 * kk + 1][1], s[0][2 * kk + 1][2], s[0][2 * kk + 1][3]);
        const bf16x8 pf1 = pack8(s[1][2 * kk][0], s[1][2 * kk][1], s[1][2 * kk][2], s[1][2 * kk][3], s[1][2 * kk + 1][0], s[1][2 * kk + 1][1], s[1][2 * kk + 1][2], s[1][2 * kk + 1][3]);
#pragma unroll
        for (int dt = 0; dt < 4; ++dt) {
            const LAS unsigned char* va = Vb + ((32 * kk + 4 * gq + (j >> 2)) * NSA_VSTR + 16 * dt + 4 * (j & 3)) * 2;
            const bf16x8 vf = cat4(tr16(va), tr16(va + 16 * NSA_VSTR * 2));
            o[0][dt] = __builtin_amdgcn_mfma_f32_16x16x32_bf16(vf, pf0, o[0][dt], 0, 0, 0);
            o[1][dt] = __builtin_amdgcn_mfma_f32_16x16x32_bf16(vf, pf1, o[1][dt], 0, 0, 0);
        }
        }
}
template <int MODE>
__device__ __forceinline__ void nsa_attend(const bf16* kv, unsigned long long mask, int b, int g, int c, int tid, int lane, LAS unsigned char* Kb, LAS unsigned char* Vb, const bf16x8 (&qf)[2][2],
                                           const unsigned long long (&rmask)[2], const unsigned long long (&gmask)[2], const int (&trow)[2], float (&mrow)[2], float (&lrow)[2], f32x4v (&o)[2][4]) {
    unsigned long long rem = mask; int st = 0;
    int jb[2]; bool have1;
    jb[0] = (int)__builtin_ctzll(rem); rem &= rem - 1ull; have1 = rem != 0ull; jb[1] = have1 ? (int)__builtin_ctzll(rem) : jb[0]; rem &= rem - 1ull;
    v4u kr[2], vr[2];
    nsa_fetch(kv, b, jb[0], g, tid, kr[0], vr[0]); nsa_fetch(kv, b, jb[1], g, tid, kr[1], vr[1]);
    nsa_stash(Kb, Vb, tid, kr[0], vr[0]); nsa_stash(Kb + NSA_KB, Vb + NSA_VB, tid, kr[1], vr[1]);
    __syncthreads();
    for (;;) {
        const bool more = rem != 0ull; int jn[2]; bool nhave1 = false;
        if (more) { jn[0] = (int)__builtin_ctzll(rem); rem &= rem - 1ull; nhave1 = rem != 0ull; jn[1] = nhave1 ? (int)__builtin_ctzll(rem) : jn[0]; rem &= rem - 1ull;
                    nsa_fetch(kv, b, jn[0], g, tid, kr[0], vr[0]); nsa_fetch(kv, b, jn[1], g, tid, kr[1], vr[1]); }
        else { jn[0] = jb[0]; jn[1] = jb[0]; }
#pragma unroll
        for (int bi = 0; bi < 2; ++bi) if (bi == 0 || have1) {
            const int jj = jb[bi]; const LAS unsigned char* kb_ = Kb + (st * 2 + bi) * NSA_KB; const LAS unsigned char* vb_ = Vb + (st * 2 + bi) * NSA_VB;
            bool sel[2]; int klo[2], khi[2]; bool act[2];
#pragma unroll
            for (int rg = 0; rg < 2; ++rg) { const int o6 = trow[rg] & 63;
                if (MODE == 0) { sel[rg] = (rmask[rg] >> jj) & 1ull; act[rg] = (gmask[rg] >> jj) & 1ull; klo[rg] = 0; khi[rg] = (jj == c) ? o6 : 63; }
                else { sel[rg] = true; act[rg] = true; klo[rg] = (jj == c - 4) ? o6 + 1 : 0; khi[rg] = (jj == c) ? o6 : 63; } }
            if (act[0] || act[1]) {
                const bool full = (MODE == 0) ? (jj != c) : (jj != c && jj != c - 4);
                if (full) nsa_block2<true>(kb_, vb_, qf, sel, klo, khi, mrow, lrow, o, lane); else nsa_block2<false>(kb_, vb_, qf, sel, klo, khi, mrow, lrow, o, lane);
            }
        }
        if (!more) break;
        nsa_stash(Kb + ((st ^ 1) * 2) * NSA_KB, Vb + ((st ^ 1) * 2) * NSA_VB, tid, kr[0], vr[0]); nsa_stash(Kb + ((st ^ 1) * 2 + 1) * NSA_KB, Vb + ((st ^ 1) * 2 + 1) * NSA_VB, tid, kr[1], vr[1]);
        __syncthreads();
        st ^= 1; jb[0] = jn[0]; jb[1] = jn[1]; have1 = nhave1;
    }
}
#if defined(PROBE_CMP)
__device__ __forceinline__ void nsa_probe_store(unsigned char* ws, int row, int head, int gq, const f32x4v (&v)[4]) {
    bf16* pb_ = (bf16*)(ws + 497 * MiB);
    for (int dt = 0; dt < 4; ++dt) { uint2 w; w.x = cvtpk(v[dt][0], v[dt][1]); w.y = cvtpk(v[dt][2], v[dt][3]); *(uint2*)(pb_ + (size_t)row * 512 + head * 64 + 16 * dt + 4 * gq) = w; }
}
#endif
__device__ __forceinline__ void nsa_unit(unsigned char* ws, int unit, LAS unsigned char* lds, int tid_in, bf16* yout) {
    int tid = tid_in; asm volatile("" : "+v"(tid));
    const int lane = tid & 63, wave = __builtin_amdgcn_readfirstlane(tid >> 6), j = lane & 15, gq = lane >> 4;
    const int c = unit & 63, g = (unit >> 6) & 1, b = unit >> 7, bg = b * 2 + g;
    LAS float* impa = (LAS float*)(lds + NSA_OFF_IMPA); LAS float* impb = (LAS float*)(lds + NSA_OFF_IMPB);
    LAS unsigned long long* um = (LAS unsigned long long*)(lds + NSA_OFF_UM);
    for (int i = tid; i < 2 * 64 * 65; i += 512) impa[i] = 0.f;
    bf16* qc = (bf16*)(ws + WS_QC);
    const bf16* misc = (const bf16*)(ws + WS_MISC);
    bf16x8 qf[2][2]; float gate[2][3]; int trow[2];
#pragma unroll
    for (int rg = 0; rg < 2; ++rg) {
        const int q = 8 * wave + 4 * rg + (j >> 2), t = 64 * c + q, row = b * SEQ + t, head = g * 4 + (j & 3);
        trow[rg] = t;
#pragma unroll
        for (int ks = 0; ks < 2; ++ks) qf[rg][ks] = *(const bf16x8*)(qc + (size_t)row * 512 + head * 64 + 8 * gq + 32 * ks);
#pragma unroll
        for (int e = 0; e < 3; ++e) gate[rg][e] = __builtin_amdgcn_rcpf(1.0f + __expf(-bf2f(misc[(size_t)row * 256 + 196 + head * 3 + e])));
    }
    typedef unsigned u32x2v __attribute__((ext_vector_type(2)));
    LAS u32x2v* stash = (LAS u32x2v*)(lds + NSA_OFF_ST) + tid * 8;
    __syncthreads();
    const int nT = (c >> 2) + 1;
    const bf16* kc = (const bf16*)(ws + WS_KC) + (size_t)bg * 256 * 64; const bf16* vct = (const bf16*)(ws + WS_VC) + (size_t)bg * 64 * 256;
#pragma unroll
    for (int rg = 0; rg < 2; ++rg) {
        const int t = trow[rg], nv = t >= 31 ? ((t - 15) >> 4) : 0;
        f32x4v s[16]; float mx = NEGF;
#pragma unroll
        for (int T = 0; T < 16; ++T) {
            s[T] = (f32x4v){0.f, 0.f, 0.f, 0.f};
            if (T < nT) {
#pragma unroll
                for (int ks = 0; ks < 2; ++ks) { const bf16x8 kf = *(const bf16x8*)(kc + (size_t)(16 * T + j) * 64 + 8 * gq + 32 * ks); s[T] = __builtin_amdgcn_mfma_f32_16x16x32_bf16(kf, qf[rg][ks], s[T], 0, 0, 0); }
#pragma unroll
                for (int e = 0; e < 4; ++e) { const float v = (16 * T + 4 * gq + e < nv) ? s[T][e] : NEGF; s[T][e] = v; mx = fmaxf(mx, v); }
            }
        }
        mx = xmax16(mx);
        float ls = 0.f;
#pragma unroll
        for (int T = 0; T < 16; ++T) if (T < nT) {
#pragma unroll
            for (int e = 0; e < 4; ++e) { const float p = (16 * T + 4 * gq + e < nv) ? __builtin_amdgcn_exp2f(s[T][e] - mx) : 0.f; s[T][e] = p; ls += p; }
        }
        ls = xsum16(ls);
        const float inv = nv > 0 ? __builtin_amdgcn_rcpf(ls) : 0.f;
        const int q = 8 * wave + 4 * rg + (j >> 2);
#pragma unroll
        for (int T = 0; T < 16; ++T) if (T < nT) {
#pragma unroll
            for (int e = 0; e < 4; ++e) s[T][e] *= inv;
            float a = s[T][0] + s[T][1] + s[T][2] + 0.5f * s[T][3], bb = 0.5f * s[T][3];
            a += __shfl_xor(a, 1); a += __shfl_xor(a, 2); bb += __shfl_xor(bb, 1); bb += __shfl_xor(bb, 2);
            if ((j & 3) == 0) { impa[q * 65 + 4 * T + gq] = a; impb[q * 65 + 4 * T + gq + 1] = bb; }
        }
        f32x4v oc[4];
#pragma unroll
        for (int dt = 0; dt < 4; ++dt) oc[dt] = (f32x4v){0.f, 0.f, 0.f, 0.f};
#pragma unroll
        for (int kk = 0; kk < 8; ++kk) if (2 * kk < nT) {
            const bf16x8 pf = pack8(s[2 * kk][0], s[2 * kk][1], s[2 * kk][2], s[2 * kk][3], s[2 * kk + 1][0], s[2 * kk + 1][1], s[2 * kk + 1][2], s[2 * kk + 1][3]);
#pragma unroll
            for (int dt = 0; dt < 4; ++dt) {
                const bf16* vp = vct + (size_t)(16 * dt + j) * 256 + 32 * kk + 4 * gq;
                const s16x4 v0 = *(const s16x4*)vp, v1 = *(const s16x4*)(vp + 16);
                oc[dt] = __builtin_amdgcn_mfma_f32_16x16x32_bf16(cat4(v0, v1), pf, oc[dt], 0, 0, 0);
            }
        }
#pragma unroll
        for (int dt = 0; dt < 4; ++dt) { const f32x4v v = oc[dt] * gate[rg][0]; u32x2v w; w.x = pg8::cvt_pk_bf16(v[0], v[1]); w.y = pg8::cvt_pk_bf16(v[2], v[3]); stash[rg * 4 + dt] = w; }
        __builtin_amdgcn_sched_barrier(0);
    }
    __syncthreads();
    unsigned long long smask[8], mymask = 0ull;
#pragma unroll
    for (int qi = 0; qi < 8; ++qi) {
        const int q = 8 * wave + qi;
#if PROBE == 4
        const float imp = ((const float*)(ws + 500 * MiB))[((size_t)(b * SEQ + 64 * c + q) * 2 + g) * 64 + lane];
#else
        const float imp = impa[q * 65 + lane] + impb[q * 65 + lane];
#endif
#if PROBE && (PROBE != 5 || defined(PROBE5_IMP))
        ((float*)(ws + 516 * MiB))[((size_t)(b * SEQ + 64 * c + q) * 2 + g) * 64 + lane] = (lane <= c) ? imp : 0.f;
#endif
        const bool forced = (lane == 0) || (lane == c), adm = lane <= c;
        unsigned key = forced ? (0xFFFFFF00u | (unsigned)(63 - lane)) : (adm ? ((__float_as_uint(imp) & 0xFFFFFFC0u) | (unsigned)(63 - lane)) : 0u);
        unsigned long long mk = 0ull;
#if TOP8_RANK
        { int rank = 0;
#pragma unroll
          for (int jj = 0; jj < 64; ++jj) { const unsigned kk = (unsigned)__builtin_amdgcn_readlane((int)key, jj); rank += (kk > key) ? 1 : 0; }
          mk = __ballot(key != 0u && rank < 8); }
#else
        for (int k = 0; k < 8; ++k) { const unsigned mx = wave_max_u(key); if (mx == 0u) break; const int win = 63 - (int)(mx & 63u); mk |= 1ull << win; if (lane == win) key = 0u; }
#endif
        mk = ((unsigned long long)__builtin_amdgcn_readfirstlane((unsigned)(mk >> 32)) << 32) | (unsigned long long)__builtin_amdgcn_readfirstlane((unsigned)mk);
#ifdef FIXSEL
        { mk = 1ull | (1ull << c); for (int d = 1; d <= 6; ++d) mk |= 1ull << (((FIXHOM ? 0 : q * 7) + d * 5) % (c + 1)); }
#endif
#if PROBE == 2
        mk = ((const unsigned long long*)(ws + 496 * MiB))[(size_t)(b * SEQ + 64 * c + q) * 2 + g];
        mk = ((unsigned long long)__builtin_amdgcn_readfirstlane((unsigned)(mk >> 32)) << 32) | (unsigned long long)__builtin_amdgcn_readfirstlane((unsigned)mk);
#endif
#if PROBE == 5
        if (lane == 0) ((unsigned long long*)(ws + 498 * MiB))[(size_t)(b * SEQ + 64 * c + q) * 2 + g] = mk;
#endif
#if PROBE == 5 && !defined(PROBE5_IMP)
        ((float*)(ws + 516 * MiB))[((size_t)(b * SEQ + 64 * c + q) * 2 + g) * 64 + lane] = ((mk >> lane) & 1ull) ? 1.f : 0.f;
#endif
        smask[qi] = mk; mymask |= mk;
    }
    if (lane == 0) um[wave] = mymask;
    __syncthreads();
    unsigned long long umask = 0ull;
#pragma unroll
    for (int w = 0; w < 8; ++w) umask |= um[w];
    umask = ((unsigned long long)__builtin_amdgcn_readfirstlane((unsigned)(umask >> 32)) << 32) | (unsigned long long)__builtin_amdgcn_readfirstlane((unsigned)umask);
    unsigned long long rmask[2];
    { LAS unsigned long long* qm = (LAS unsigned long long*)(lds + NSA_OFF_IMPA);
      __syncthreads();
#pragma unroll
      for (int qi = 0; qi < 8; ++qi) if (lane == 0) qm[8 * wave + qi] = smask[qi];
      __syncthreads();
#pragma unroll
      for (int rg = 0; rg < 2; ++rg) rmask[rg] = qm[8 * wave + 4 * rg + (j >> 2)]; }
    const unsigned long long gmask[2] = {smask[0] | smask[1] | smask[2] | smask[3], smask[4] | smask[5] | smask[6] | smask[7]};
    const bf16* kvs = (const bf16*)(ws + WS_KVS); const bf16* kvw = (const bf16*)(ws + WS_KVW);
    LAS unsigned char* Kb = lds + NSA_OFF_K; LAS unsigned char* Vb = lds + NSA_OFF_V;
    {
        float mrow[2] = {NEGF, NEGF}, lrow[2] = {0.f, 0.f}; f32x4v o[2][4];
#pragma unroll
        for (int rg = 0; rg < 2; ++rg)
#pragma unroll
            for (int dt = 0; dt < 4; ++dt) o[rg][dt] = (f32x4v){0.f, 0.f, 0.f, 0.f};
        nsa_attend<0>(kvs, umask, b, g, c, tid, lane, Kb, Vb, qf, rmask, gmask, trow, mrow, lrow, o);
#if DUP == 8
        { __syncthreads(); float m2[2] = {NEGF, NEGF}, l2[2] = {0.f, 0.f}; f32x4v o2[2][4];
          for (int rg = 0; rg < 2; ++rg) for (int dt = 0; dt < 4; ++dt) o2[rg][dt] = (f32x4v){0.f, 0.f, 0.f, 0.f};
          nsa_attend<0>(kvs, umask, b, g, c, tid, lane, Kb, Vb, qf, rmask, gmask, trow, m2, l2, o2);
          bf16* dmy = (bf16*)(ws + WS_BU) + (size_t)(b * SEQ + trow[0]) * 512 + (g * 4 + (j & 3)) * 64 + 4 * gq;
          for (int rg = 0; rg < 2; ++rg) for (int dt = 0; dt < 4; ++dt) { uint2 w; w.x = pg8::cvt_pk_bf16(o2[rg][dt][0] + l2[rg], o2[rg][dt][1]); w.y = pg8::cvt_pk_bf16(o2[rg][dt][2], o2[rg][dt][3]); *(uint2*)(dmy + 16 * dt) = w; } }
#endif
#pragma unroll
        for (int rg = 0; rg < 2; ++rg) { const float sc = gate[rg][1] * __builtin_amdgcn_rcpf(xsum16(lrow[rg]));
#pragma unroll
            for (int dt = 0; dt < 4; ++dt) { const u32x2v p = stash[rg * 4 + dt]; const f32x4v v = o[rg][dt] * sc; u32x2v w; w.x = pg8::cvt_pk_bf16(v[0] + bflo(p.x), v[1] + bfhi(p.x)); w.y = pg8::cvt_pk_bf16(v[2] + bflo(p.y), v[3] + bfhi(p.y)); stash[rg * 4 + dt] = w; }
            }
        __syncthreads();
    }
    {
        float mrow[2] = {NEGF, NEGF}, lrow[2] = {0.f, 0.f}; f32x4v o[2][4];
#pragma unroll
        for (int rg = 0; rg < 2; ++rg)
#pragma unroll
            for (int dt = 0; dt < 4; ++dt) o[rg][dt] = (f32x4v){0.f, 0.f, 0.f, 0.f};
        { const int j0 = c - 4 > 0 ? c - 4 : 0; const unsigned long long wmask = ((c == 63 ? ~0ull : ((1ull << (c + 1)) - 1ull)) >> j0) << j0;
          nsa_attend<1>(kvw, wmask, b, g, c, tid, lane, Kb, Vb, qf, rmask, gmask, trow, mrow, lrow, o); }
#pragma unroll
        for (int rg = 0; rg < 2; ++rg) { const float sc = gate[rg][2] * __builtin_amdgcn_rcpf(xsum16(lrow[rg]));
#pragma unroll
            for (int dt = 0; dt < 4; ++dt) { const u32x2v p = stash[rg * 4 + dt]; const f32x4v v = o[rg][dt] * sc; uint2 w; w.x = pg8::cvt_pk_bf16(v[0] + bflo(p.x), v[1] + bfhi(p.x)); w.y = pg8::cvt_pk_bf16(v[2] + bflo(p.y), v[3] + bfhi(p.y));
                *(uint2*)(yout + (size_t)(b * SEQ + trow[rg]) * 512 + (g * 4 + (j & 3)) * 64 + 16 * dt + 4 * gq) = w; }
            }
    }
    __syncthreads();
}
__device__ __forceinline__ void prep_kva16(unsigned char* ws, int task, int lane) {
    const int j = lane & 15, gq = lane >> 4, row = task * 16 + j;
    const bf16* misc = (const bf16*)(ws + WS_MISC) + (size_t)row * 256 + 64;
    const bf16* wu = (const bf16*)(ws + WS_W + WO_UKV);
    bf16x8 cf[4]; float ss = 0.f;
#pragma unroll
    for (int ks = 0; ks < 4; ++ks) { const v4u v = *(const v4u*)(misc + 8 * gq + 32 * ks); cf[ks] = __builtin_bit_cast(bf16x8, v); float f[8]; unpack8(v, f);
#pragma unroll
        for (int e = 0; e < 8; ++e) ss += f[e] * f[e]; }
    ss = xsum16(ss);
    const float r = 1.0f / sqrtf(ss * (1.f / 128.f) + EPS);
    const float* rp = (const float*)(ws + WS_ROPE) + (size_t)row * 16;
    bf16* o = (bf16*)(ws + WS_KVA) + (size_t)row * 128;
#pragma unroll
    for (int ct = 0; ct < 8; ++ct) {
        f32x4v a = {0.f, 0.f, 0.f, 0.f};
#pragma unroll
        for (int ks = 0; ks < 4; ++ks) { const bf16x8 wf = *(const bf16x8*)(wu + (size_t)(16 * ct + j) * 128 + 8 * gq + 32 * ks); a = __builtin_amdgcn_mfma_f32_16x16x32_bf16(wf, cf[ks], a, 0, 0, 0); }
        a *= r;
        if (ct == 0) {
            const float c0 = rp[2 * gq], s0 = rp[8 + 2 * gq], c1 = rp[2 * gq + 1], s1 = rp[8 + 2 * gq + 1];
            const float x0 = a[0], x1 = a[1], x2 = a[2], x3 = a[3];
            a[0] = x0 * c0 - x1 * s0; a[1] = x1 * c0 + x0 * s0; a[2] = x2 * c1 - x3 * s1; a[3] = x3 * c1 + x2 * s1;
        }
        uint2 w; w.x = cvtpk(a[0], a[1]); w.y = cvtpk(a[2], a[3]);
        *(uint2*)(o + 16 * ct + 4 * gq) = w;
    }
}
__device__ __forceinline__ void prep_pool16(unsigned char* ws, int task, int lane) {
    const int j = lane & 15, gq = lane >> 4, row = task * 16 + j, t = row & (SEQ - 1);
    const bf16* bu = (const bf16*)(ws + WS_BU);
    const bf16* pw = (const bf16*)(ws + WS_W + WO_POOL);
    bf16* yb = (bf16*)(ws + WS_YB) + (size_t)row * 512;
#pragma unroll 1
    for (int g = 0; g < 4; ++g) {
        const int w = 2 << g, lo = (t + 1 - w) > 0 ? (t + 1 - w) : 0, cnt = t + 1 - lo; const float inv = 1.0f / (float)cnt;
        bf16x8 pf[4];
#pragma unroll
        for (int ks = 0; ks < 4; ++ks) {
            const bf16* p = bu + (size_t)row * 512 + g * 128 + 8 * gq + 32 * ks;
            float sum[8] = {0.f, 0.f, 0.f, 0.f, 0.f, 0.f, 0.f, 0.f}, cur[8];
            { const v4u v = *(const v4u*)p; unpack8(v, cur);
#pragma unroll
              for (int e = 0; e < 8; ++e) sum[e] = cur[e]; }
#pragma unroll 2
            for (int i = 1; i < w; ++i) { const bool ok = i < cnt; const v4u v = *(const v4u*)(p - (size_t)(ok ? i : 0) * 512); float f[8]; unpack8(v, f);
#pragma unroll
                for (int e = 0; e < 8; ++e) sum[e] += ok ? f[e] : 0.f; }
            __builtin_amdgcn_sched_barrier(0);
            pf[ks] = pack8(sum[0] * inv - cur[0], sum[1] * inv - cur[1], sum[2] * inv - cur[2], sum[3] * inv - cur[3], sum[4] * inv - cur[4], sum[5] * inv - cur[5], sum[6] * inv - cur[6], sum[7] * inv - cur[7]);
        }
#pragma unroll
        for (int dt = 0; dt < 8; ++dt) {
            f32x4v a = {0.f, 0.f, 0.f, 0.f};
#pragma unroll
            for (int ks = 0; ks < 4; ++ks) {
#if POOLDBG == 1
                bf16x8 wf; for (int e = 0; e < 8; ++e) wf[e] = (short)0x3c00;
#else
                const bf16x8 wf = *(const bf16x8*)(pw + (size_t)(g * 128 + 16 * dt + j) * 128 + 8 * gq + 32 * ks);
#endif
#if POOLDBG == 2
                bf16x8 pz; for (int e = 0; e < 8; ++e) pz[e] = (short)0x3c00; a = __builtin_amdgcn_mfma_f32_16x16x32_bf16(wf, pz, a, 0, 0, 0);
#else
                a = __builtin_amdgcn_mfma_f32_16x16x32_bf16(wf, pf[ks], a, 0, 0, 0);
#endif
            }
            uint2 wv; wv.x = cvtpk(a[0], a[1]); wv.y = cvtpk(a[2], a[3]);
            *(uint2*)(yb + g * 128 + 16 * dt + 4 * gq) = wv;
        }
    }
}
__device__ __forceinline__ float gelu_tanh_f(float x) { const float u = 0.7978845608028654f * (x + 0.044715f * x * x * x); const float e = __expf(2.0f * u); return 0.5f * x * (1.0f + (1.0f - 2.0f / (e + 1.0f))); }
__device__ __forceinline__ void prep_cmp16(unsigned char* ws, int task, int lane) {
    const int j = lane & 15, gq = lane >> 4;
    const int i0 = (task & 15) * 16, bg = (task >> 4) & 15, br = task >> 8, b = bg >> 1, g = bg & 1, i = i0 + j;
    const bf16* kvc = (const bf16*)(ws + WS_KVC);
    const bf16* w1 = (const bf16*)(ws + WS_W + WO_CW1) + (size_t)br * 128 * 2048;
    const bf16* w2 = (const bf16*)(ws + WS_W + WO_CW2) + (size_t)br * 64 * 128;
    const float* posb = (const float*)(ws + WS_W + WO_POSB) + br * 128;
    f32x4v h[8];
#pragma unroll
    for (int nt = 0; nt < 8; ++nt) h[nt] = (f32x4v){0.f, 0.f, 0.f, 0.f};
#pragma unroll 4
    for (int ks = 0; ks < 64; ++ks) {
        const int l = ks >> 1; int tok = 16 * i + l; tok = tok > SEQ - 1 ? SEQ - 1 : tok;
        const bf16x8 ff = *(const bf16x8*)(kvc + (size_t)(b * SEQ + tok) * 256 + br * 128 + g * 64 + 32 * (ks & 1) + 8 * gq);
#pragma unroll
        for (int nt = 0; nt < 8; ++nt) { const bf16x8 wf = *(const bf16x8*)(w1 + (size_t)(16 * nt + j) * 2048 + 32 * ks + 8 * gq); h[nt] = __builtin_amdgcn_mfma_f32_16x16x32_bf16(wf, ff, h[nt], 0, 0, 0); }
    }
#pragma unroll
    for (int nt = 0; nt < 8; ++nt) { const f32x4v pbv = *(const f32x4v*)(posb + 16 * nt + 4 * gq);
#pragma unroll
        for (int e = 0; e < 4; ++e) h[nt][e] = gelu_tanh_f(h[nt][e] + pbv[e]); }
    f32x4v o[4];
#pragma unroll
    for (int dt = 0; dt < 4; ++dt) o[dt] = (f32x4v){0.f, 0.f, 0.f, 0.f};
#pragma unroll
    for (int kk = 0; kk < 4; ++kk) {
        const bf16x8 hf = pack8(h[2 * kk][0], h[2 * kk][1], h[2 * kk][2], h[2 * kk][3], h[2 * kk + 1][0], h[2 * kk + 1][1], h[2 * kk + 1][2], h[2 * kk + 1][3]);
#pragma unroll
        for (int dt = 0; dt < 4; ++dt) { const bf16* wp = w2 + (size_t)(16 * dt + j) * 128 + 32 * kk + 4 * gq; const s16x4 v0 = *(const s16x4*)wp, v1 = *(const s16x4*)(wp + 16);
            o[dt] = __builtin_amdgcn_mfma_f32_16x16x32_bf16(cat4(v0, v1), hf, o[dt], 0, 0, 0); }
    }
    const bool dead = i == 255;
    if (br == 0) { bf16* kc = (bf16*)(ws + WS_KC) + ((size_t)bg * 256 + i) * 64;
#pragma unroll
        for (int dt = 0; dt < 4; ++dt) { uint2 w; w.x = dead ? 0u : cvtpk(o[dt][0], o[dt][1]); w.y = dead ? 0u : cvtpk(o[dt][2], o[dt][3]); *(uint2*)(kc + 16 * dt + 4 * gq) = w; }
    } else { bf16* vct = (bf16*)(ws + WS_VC) + (size_t)bg * 64 * 256 + i;
#pragma unroll
        for (int dt = 0; dt < 4; ++dt)
#pragma unroll
            for (int e = 0; e < 4; ++e) vct[(size_t)(16 * dt + 4 * gq + e) * 256] = dead ? (bf16)0 : (bf16)f2bf(o[dt][e]);
    }
}
__device__ __forceinline__ void phase_prep(const Args& P, unsigned char* ws, int z, int l, LAS unsigned char* lds, int gw, int NGW, int lane, int wave) {
    asm volatile("" : "+v"(lane)); lane &= 63; asm volatile("" : "+s"(gw), "+s"(NGW));
    for (int it = gw; it < 512; it += NGW) prep_cmp16(ws, it, lane);
    for (int it = gw; it < M / 16; it += NGW) { prep_kva16(ws, it, lane); prep_pool16(ws, it, lane); }
}
constexpr int DSA_K = 12, DSA_S = 32 - DSA_K, DSA_CAP = 256;
constexpr int DSA_OFF_CNT = 0, DSA_OFF_PC = 3072, DSA_OFF_LIST = DSA_OFF_PC + 32 * 16 * 4, DSA_OFF_V = DSA_OFF_LIST + 16 * 256 * 2, DSA_VB = 64 * NSA_VSTR * 2, DSA_LDS = DSA_OFF_V + 8 * DSA_VB;
#define DSA_FOR_TILES(...) _Pragma("unroll") for (int G8 = 0; G8 < 4; ++G8) { if (G8 < ngrp) { _Pragma("unroll") for (int T8 = 0; T8 < 8; ++T8) { const int T = G8 * 8 + T8; __VA_ARGS__ } } }
__device__ __forceinline__ void cnt_ge(int& c, unsigned u, unsigned cand) { asm volatile("v_cmp_ge_u32_e32 vcc, %1, %2\n\tv_addc_co_u32_e32 %0, vcc, 0, %0, vcc" : "+v"(c) : "v"(u), "v"(cand) : "vcc"); }
__device__ __forceinline__ void cnt_gt(int& c, unsigned u, unsigned cand) { asm volatile("v_cmp_gt_u32_e32 vcc, %1, %2\n\tv_addc_co_u32_e32 %0, vcc, 0, %0, vcc" : "+v"(c) : "v"(u), "v"(cand) : "vcc"); }
__device__ __forceinline__ void cnt_le(int& c, unsigned u, unsigned cand) { asm volatile("v_cmp_le_u32_e32 vcc, %1, %2\n\tv_addc_co_u32_e32 %0, vcc, 0, %0, vcc" : "+v"(c) : "v"(u), "v"(cand) : "vcc"); }
__device__ __forceinline__ int dsa_total(LAS unsigned* cnt, int par, int wave, int j, int gq, int c) {
    c += __shfl_xor(c, 16); c += __shfl_xor(c, 32);
    if (gq == 0) cnt[(par * 8 + wave) * 16 + j] = (unsigned)c;
    __syncthreads();
    int tot = 0;
#pragma unroll
    for (int w = 0; w < 8; ++w) tot += (int)cnt[(par * 8 + w) * 16 + j];
    return tot;
}
__device__ __forceinline__ void dsa_unit(unsigned char* ws, int unit, LAS unsigned char* lds, int tid_in, bf16* yout) {
    int tid = tid_in; asm volatile("" : "+v"(tid));
    const int lane = tid & 63, wave = __builtin_amdgcn_readfirstlane(tid >> 6), j = lane & 15, gq = lane >> 4;
    const int b = unit >> 8, q0 = (unit & 255) * 16, t = q0 + j, row = b * SEQ + t;
    LAS unsigned* cnt = (LAS unsigned*)(lds + DSA_OFF_CNT); LAS unsigned* pc = (LAS unsigned*)(lds + DSA_OFF_PC);
    LAS unsigned short* list = (LAS unsigned short*)(lds + DSA_OFF_LIST);
    const bf16* misc = (const bf16*)(ws + WS_MISC);
    if (q0 >= 256) {
        const int ntiles = (q0 >> 4) + 1;
        const int ntl = wave < ntiles ? ((ntiles - 1 - wave) >> 3) + 1 : 0;
        const int ngrp = (ntl + 7) >> 3;
        bf16x8 qf[4][2]; float iw[4];
        { const bf16* iq = (const bf16*)(ws + WS_IQ) + (size_t)row * 256;
#pragma unroll
          for (int h = 0; h < 4; ++h) { iw[h] = 0.5f * bf2f(misc[(size_t)row * 256 + 192 + h]);
#pragma unroll
              for (int ks = 0; ks < 2; ++ks) qf[h][ks] = *(const bf16x8*)(iq + h * 64 + 8 * gq + 32 * ks); } }
        unsigned u[32][4];
#pragma unroll
        for (int T = 0; T < 32; ++T)
#pragma unroll
            for (int e = 0; e < 4; ++e) u[T][e] = 0u;
        const int kb0 = 16 * wave + 4 * gq;
        LAS unsigned char* ring = lds + DSA_OFF_V + wave * 16384;
#define DSA_ISSUE(Ti) do { _Pragma("unroll") for (int i_ = 0; i_ < 2; ++i_) { const int r_ = 8 * i_ + (lane >> 3); int kr_ = 16 * wave + 128 * (Ti) + r_; kr_ = kr_ > SEQ - 1 ? SEQ - 1 : kr_; \
            __builtin_amdgcn_global_load_lds((const unsigned*)(misc + (size_t)(b * SEQ + kr_) * 256 + (((lane & 7) ^ (r_ & 7)) << 3)), (LAS unsigned*)(ring + ((Ti) & 7) * 2048 + i_ * 1024), 16, 0, 0); } } while (0)
        if (ngrp > 0) {
#pragma unroll
            for (int T = 0; T < 8; ++T) DSA_ISSUE(T);
        }
        DSA_FOR_TILES(
            asm volatile("s_waitcnt vmcnt(14)" ::: "memory");
            const LAS unsigned char* tp = ring + (T & 7) * 2048 + j * 128;
            const bf16x8 kf0 = *(const LAS bf16x8*)(tp + ((gq ^ (j & 7)) << 4)); const bf16x8 kf1 = *(const LAS bf16x8*)(tp + (((gq + 4) ^ (j & 7)) << 4));
            asm volatile("s_waitcnt lgkmcnt(0)" ::: "memory");
            DSA_ISSUE(T + 8);
            float sc[4] = {0.f, 0.f, 0.f, 0.f};
            _Pragma("unroll") for (int h = 0; h < 4; ++h) {
                f32x4v a = {0.f, 0.f, 0.f, 0.f};
                a = __builtin_amdgcn_mfma_f32_16x16x32_bf16(kf0, qf[h][0], a, 0, 0, 0);
                a = __builtin_amdgcn_mfma_f32_16x16x32_bf16(kf1, qf[h][1], a, 0, 0, 0);
                _Pragma("unroll") for (int e = 0; e < 4; ++e) sc[e] += iw[h] * fmaxf(a[e], 0.f);
                asm volatile("" : "+v"(sc[0]), "+v"(sc[1]), "+v"(sc[2]), "+v"(sc[3]));
            }
            _Pragma("unroll") for (int e = 0; e < 4; ++e) { unsigned x = f2o(sc[e]); asm volatile("" : "+v"(x)); u[T][e] = (kb0 + 128 * T + e <= t) ? x : 0u; }
        )
        asm volatile("s_waitcnt vmcnt(0)" ::: "memory");
#undef DSA_ISSUE
        unsigned prefix = 0u; bool exact = false; int par = 0; int cab = 0;
        LAS unsigned* lcnt = (LAS unsigned*)(lds + DSA_OFF_V); LAS unsigned* lcab = lcnt + 16; LAS unsigned* lvst = lcnt + 32; LAS unsigned* lexf = lcnt + 48; LAS unsigned* llist = lcnt + 64;
        if (tid < 16) lcnt[tid] = 0u;
#pragma unroll 1
        for (int bit = 31; bit >= DSA_S; --bit) {
            const unsigned cand = prefix | (1u << bit); int c0 = 0, c1 = 0;
            DSA_FOR_TILES(cnt_ge(c0, u[T][0], cand); cnt_ge(c1, u[T][1], cand); cnt_ge(c0, u[T][2], cand); cnt_ge(c1, u[T][3], cand);)
            const int tot = dsa_total(cnt, par, wave, j, gq, c0 + c1); par ^= 1;
            if (tot >= 256) prefix = cand; else cab = tot;
        }
        { const unsigned ptop = prefix >> DSA_S;
          DSA_FOR_TILES(_Pragma("unroll") for (int e = 0; e < 4; ++e) { const unsigned x = u[T][e]; if (x != 0u && (x >> DSA_S) == ptop) { const unsigned pos = __hip_atomic_fetch_add(&lcnt[j], 1u, __ATOMIC_RELAXED, __HIP_MEMORY_SCOPE_WORKGROUP); if (pos < DSA_CAP) llist[j * DSA_CAP + pos] = x; } })
          if (wave == 0 && gq == 0) lcab[j] = (unsigned)cab; }
        __syncthreads();
        const bool ovf = __any(lcnt[j] > (unsigned)DSA_CAP);
        if (!ovf) {
#pragma unroll 1
            for (int qq = 0; qq < 2; ++qq) {
                const int q = 2 * wave + qq; const int n = (int)lcnt[q]; const int r = 256 - (int)lcab[q];
                unsigned ev[DSA_CAP / 64];
#pragma unroll
                for (int i = 0; i < DSA_CAP / 64; ++i) ev[i] = (lane + 64 * i < n) ? llist[q * DSA_CAP + lane + 64 * i] : 0u;
                unsigned p2 = (unsigned)__shfl((int)prefix, q);
#pragma unroll 1
                for (int bit = DSA_S - 1; bit >= 0; --bit) {
                    const unsigned cand = p2 | (1u << bit); int c = 0;
#pragma unroll
                    for (int i = 0; i < DSA_CAP / 64; ++i) c += __popcll(__ballot(ev[i] >= cand));
                    if (c >= r) p2 = cand;
                }
                int cf = 0;
#pragma unroll
                for (int i = 0; i < DSA_CAP / 64; ++i) cf += __popcll(__ballot(ev[i] >= p2));
                if (lane == 0) { lvst[q] = p2; lexf[q] = (cf == r) ? 1u : 0u; }
            }
            __syncthreads();
            prefix = lvst[j]; exact = lexf[j] != 0u;
        } else {
#pragma unroll 1
            for (int bit = DSA_S - 1; bit >= 0; --bit) {
                const unsigned cand = prefix | (1u << bit); int c0 = 0, c1 = 0;
                DSA_FOR_TILES(cnt_ge(c0, u[T][0], cand); cnt_ge(c1, u[T][1], cand); cnt_ge(c0, u[T][2], cand); cnt_ge(c1, u[T][3], cand);)
                const int tot = dsa_total(cnt, par, wave, j, gq, c0 + c1); par ^= 1;
                if (!exact && tot >= 256) { prefix = cand; exact = (tot == 256); }
            }
        }
        const bool alle = __all(exact);
        DSA_FOR_TILES(_Pragma("unroll") for (int e = 0; e < 4; ++e) { const unsigned x = u[T][e]; u[T][e] = (x > prefix || (exact && x == prefix)) ? 0u : (x == prefix ? (unsigned)(1 + kb0 + 128 * T + e) : 0xFFFFFFFFu); })
        unsigned kp = 0u;
        if (!alle) {
            __syncthreads();
#pragma unroll 1
            for (int bit = 11; bit >= 0; --bit) {
                const unsigned cand = kp | (1u << bit); int c0 = 0, c1 = 0;
                DSA_FOR_TILES(cnt_le(c0, u[T][0], cand); cnt_le(c1, u[T][1], cand); cnt_le(c0, u[T][2], cand); cnt_le(c1, u[T][3], cand);)
                const int tot = dsa_total(cnt, par, wave, j, gq, c0 + c1); par ^= 1;
                if (tot <= 255) kp = cand;
            }
        }
        const unsigned kp1 = kp + 1u;
        int ns0 = 0, ns1 = 0;
        DSA_FOR_TILES(cnt_le(ns0, u[T][0], kp1); cnt_le(ns1, u[T][1], kp1); cnt_le(ns0, u[T][2], kp1); cnt_le(ns1, u[T][3], kp1);)
        pc[(wave * 4 + gq) * 16 + j] = (unsigned)(ns0 + ns1);
        __syncthreads();
        int base = 0;
        for (int i = 0; i < wave * 4 + gq; ++i) base += (int)pc[i * 16 + j];
        DSA_FOR_TILES(_Pragma("unroll") for (int e = 0; e < 4; ++e) { if (u[T][e] <= kp1) { if (base < 256) list[j * 256 + base] = (unsigned short)(kb0 + 128 * T + e); ++base; } })
    } else {
        for (int i = tid; i < 16 * 256; i += 512) list[i] = (unsigned short)(i & 255);
    }
    __syncthreads();
    const bf16* kva = (const bf16*)(ws + WS_KVA);
    bf16* qa = (bf16*)(ws + WS_QA);
    LAS unsigned char* Vb = lds + DSA_OFF_V + wave * DSA_VB;
#if DUP == 10
#define DSA_QREP 4
#else
#define DSA_QREP 2
#endif
#pragma unroll 1
    for (int qq_ = 0; qq_ < DSA_QREP; ++qq_) { const int qq = qq_ & 1;
        bf16* const yo_ = (qq_ < DSA_QREP - 2) ? (bf16*)(ws + WS_BU) : yout;
        const int ql = 2 * wave + qq, tq = q0 + ql, rowq = b * SEQ + tq, nsel = tq + 1 < 256 ? tq + 1 : 256;
        bf16x8 qf[2];
#pragma unroll
        for (int ks = 0; ks < 2; ++ks) { qf[ks] = (bf16x8){0, 0, 0, 0, 0, 0, 0, 0}; if (j < 8) qf[ks] = *(const bf16x8*)(qa + (size_t)rowq * 512 + j * 64 + 8 * gq + 32 * ks); }
        f32x4v s[16]; float mx = NEGF;
#pragma unroll
        for (int kt = 0; kt < 16; ++kt) {
            const int slot = 16 * kt + j; const int key = list[ql * 256 + (slot < nsel ? slot : 0)];
            const bf16* kp2 = kva + (size_t)(b * SEQ + key) * 128 + 8 * gq;
            const bf16x8 kf0 = *(const bf16x8*)kp2, kf1 = *(const bf16x8*)(kp2 + 32);
            f32x4v a = {0.f, 0.f, 0.f, 0.f};
            a = __builtin_amdgcn_mfma_f32_16x16x32_bf16(kf0, qf[0], a, 0, 0, 0);
            a = __builtin_amdgcn_mfma_f32_16x16x32_bf16(kf1, qf[1], a, 0, 0, 0);
#pragma unroll
            for (int e = 0; e < 4; ++e) { const float v = (16 * kt + 4 * gq + e < nsel) ? a[e] : NEGF; a[e] = v; mx = fmaxf(mx, v); }
            s[kt] = a;
        }
        mx = xmax16(mx);
        float ls = 0.f;
#pragma unroll
        for (int kt = 0; kt < 16; ++kt)
#pragma unroll
            for (int e = 0; e < 4; ++e) { const float p = __builtin_amdgcn_exp2f(s[kt][e] - mx); s[kt][e] = p; ls += p; }
        ls = xsum16(ls);
        f32x4v o[4];
#pragma unroll
        for (int dt = 0; dt < 4; ++dt) o[dt] = (f32x4v){0.f, 0.f, 0.f, 0.f};
#define DSA_VLOAD(ch_) do { _Pragma("unroll") for (int i = 0; i < 8; ++i) { const int slot = 64 * (ch_) + 8 * i + (lane >> 3); const int key = list[ql * 256 + (slot < nsel ? slot : 0)]; \
            vr[i] = *(const v4u*)(kva + (size_t)(b * SEQ + key) * 128 + 64 + (lane & 7) * 8); } } while (0)
        v4u vr[8];
        DSA_VLOAD(0);
#pragma unroll
        for (int ch = 0; ch < 4; ++ch) {
#pragma unroll
            for (int i = 0; i < 8; ++i) *(LAS v4u*)(Vb + ((8 * i + (lane >> 3)) * NSA_VSTR + (lane & 7) * 8) * 2) = vr[i];
            WAVE_LDS_SYNC();
            if (ch < 3) DSA_VLOAD(ch + 1);
#pragma unroll
            for (int kk = 0; kk < 2; ++kk) {
                const int k4 = 4 * ch + 2 * kk;
                const bf16x8 pf = pack8(s[k4][0], s[k4][1], s[k4][2], s[k4][3], s[k4 + 1][0], s[k4 + 1][1], s[k4 + 1][2], s[k4 + 1][3]);
#pragma unroll
                for (int dt = 0; dt < 4; ++dt) {
                    const LAS unsigned char* va = Vb + ((32 * kk + 4 * gq + (j >> 2)) * NSA_VSTR + 16 * dt + 4 * (j & 3)) * 2;
                    o[dt] = __builtin_amdgcn_mfma_f32_16x16x32_bf16(cat4(tr16(va), tr16(va + 16 * NSA_VSTR * 2)), pf, o[dt], 0, 0, 0);
                }
            }
            WAVE_LDS_SYNC();
        }
#undef DSA_VLOAD
        const float inv = 1.0f / ls;
        if (j < 8) {
#pragma unroll
            for (int dt = 0; dt < 4; ++dt) { uint2 w; w.x = pg8::cvt_pk_bf16(o[dt][0] * inv, o[dt][1] * inv); w.y = pg8::cvt_pk_bf16(o[dt][2] * inv, o[dt][3] * inv);
                *(uint2*)(yo_ + (size_t)rowq * 512 + j * 64 + 16 * dt + 4 * gq) = w; }
        }
    }
    __syncthreads();
}
__device__ __forceinline__ void phase_mixers(const Args& P, unsigned char* ws, int z, LAS unsigned char* lds, int gw, int NGW, int lane, int wave, int bid, int G) {
    asm volatile("" : "+v"(lane)); lane &= 63; asm volatile("" : "+s"(gw), "+s"(NGW));
#if PROBE == 3
    { LAS unsigned char* wl = lds + wave * 18944; for (int it2 = gw; it2 < 2 * M; it2 += NGW) nsa_query(P, ws, z, it2 >> 1, it2 & 1, wl, lane); }
#else
    for (int k = 0; bid + G * k < 1024; ++k) {
        const int u = bid + G * k, c0 = u & 63, unit = (u & ~63) | ((k & 1) ? 63 - c0 : c0);
#if DUP == 7
        nsa_unit(ws, unit, lds, (wave << 6) | lane_id_v(), (bf16*)(ws + WS_BU));
#endif
        nsa_unit(ws, unit, lds, (wave << 6) | lane_id_v(), (bf16*)(ws + WS_QC));
    }
#endif
    for (int k = 0; bid + G * k < 2048; ++k) {
        const int u = bid + G * k, c0 = u & 255, unit = (u & ~255) | ((k & 1) ? 255 - c0 : c0);
#if DUP == 6
        dsa_unit(ws, unit, lds, (wave << 6) | lane_id_v(), (bf16*)(ws + WS_BU));
#endif
        dsa_unit(ws, unit, lds, (wave << 6) | lane_id_v(), (bf16*)(ws + WS_QA));
    }
}
__global__ void __launch_bounds__(NWAVES * 64, 2) fwd_kernel(Args args) {
    extern __shared__ __attribute__((aligned(16))) unsigned char lds_raw[];
    LAS unsigned char* lds = (LAS unsigned char*)lds_raw;
    const int wave = __builtin_amdgcn_readfirstlane((int)threadIdx.x >> 6);
#define TIDX ((wave << 6) | lane_id_v())
#define tid TIDX
#define lane TIDX
    const int G = gridDim.x, bid = blockIdx.x;
    const int gw = bid * NWAVES + wave, NGW = G * NWAVES;
    const int lo = args.ph_lo, hi = args.ph_hi;
    const Args& P = args;
    int z = 0; asm volatile("" : "+s"(z));
    unsigned char* ws = args.ws + z;
    volatile LAS unsigned* MISCW = (volatile LAS unsigned*)(lds + LDSCTL_OFF);
    if (tid < 64) MISCW[tid] = 0u;
    __syncthreads();
    XcdBarrier bar; bar.bar = (unsigned*)(ws + WS_CTL) + 4096; bar.x = 0; bar.st = nullptr;
    if (hi - lo > 1) bar = xcd_barrier_post((unsigned*)(ws + WS_CTL) + 4096, MISCW + 8);
#define RUN(k) (lo <= (k) && (k) < hi)
#define SEAM(k) do { if ((k) + 1 < hi) { XcdBarrier b2_ = bar; asm volatile("" : "+s"(b2_.bar), "+s"(b2_.x)); xcd_barrier(b2_); } else { VM_WAIT(); __syncthreads(); } } while (0)


    if (RUN(0)) { phase_rope(P, ws, z, bid * (NWAVES * 64) + tid, G * NWAVES * 64);
        { int ln_ = TIDX; asm volatile("" : "+v"(ln_)); ln_ &= 63;
          for (int m = gw; m < M; m += NGW) stat_row_bf16(P.in[0 + z] + (size_t)m * DM, (bf16*)(ws + WS_XN) + (size_t)m * DM, (float*)(ws + WS_SSQ) + (size_t)m * 16, ln_); }
        SEAM(0); }
#define RS_PREPASS(Sref) do { const float* ssq_ = (const float*)(ws + WS_SSQ); LAS float* rsl_ = (LAS float*)(lds + RS_OFF); const int t_ = TIDX; pg8::Unit u_; \
        for (int i_ = 0; (Sref).next(i_, u_); ++i_) { const f32x4* p_ = (const f32x4*)(ssq_ + (size_t)(u_.pm * 256 + (t_ >> 1)) * 16 + (t_ & 1) * 8); const f32x4 a_ = p_[0], b_ = p_[1]; \
            float s_ = (a_.x + a_.y) + (a_.z + a_.w) + (b_.x + b_.y) + (b_.z + b_.w); s_ += __shfl_xor(s_, 1); if ((t_ & 1) == 0) rsl_[i_ * 256 + (t_ >> 1)] = 1.0f / sqrtf(s_ * (1.f / DM) + EPS); } \
        __syncthreads(); } while (0)

    for (int it = 0; it < 2 * DEPTH; ++it) {
        const int l = it >> 1, second = it & 1, pb = 1 + l * NPL + (second ? 7 : 0);
        asm volatile("" : "+s"(z));
        ws = args.ws + z;
        bf16* const XN = (bf16*)(ws + WS_XN);
        bf16* const HB = (bf16*)(ws + WS_H);
        bf16* const MG = (bf16*)(ws + WS_MG);
        bf16* const GB = (bf16*)(ws + WS_G);
        unsigned char* const wb = ws + WS_W;
        float* const OUT = P.out + z;
        const float* xin = (it == 0) ? P.in[0 + z] : (const float*)OUT;
        if (!second && RUN(pb)) { phase_convert(P, ws, z, l, lds, gw, NGW, lane, wave); SEAM(pb); }
        if (RUN(pb + 1)) {
            pg8::Gemm g{XN, (const bf16*)(wb + (second ? WO_GU2 : WO_GU1)), M, 2 * FF, DM}; pg8::StaticOrder S; S.init(M, 2 * FF, G, bid + z);
            pg8::EpiSwiglu E{HB, FF, (const LAS float*)(lds + RS_OFF)};
            RS_PREPASS(S);
#if !defined(SITE_MASK) || ((SITE_MASK >> 0) & 1)
            pg8::gemm_phase<pg8::EpiSwiglu, pg8::StaticOrder, true, true>(lds, g, S, E, TIDX);
#if DUP == 3
            pg8::gemm_phase<pg8::EpiSwiglu, pg8::StaticOrder, true, true>(lds, g, S, E, TIDX);
#endif
#endif
            SEAM(pb + 1);
        }
        if (RUN(pb + 2)) {
            pg8::Gemm g{HB, (const bf16*)(wb + (second ? WO_D2 : WO_D1)), M, DM, FF}; pg8::StaticOrder S; S.init(M, DM, G, bid + z);
            pg8::EpiResid E{xin, OUT, 0.5f, XN, (float*)(ws + WS_SSQ)};
#if !defined(SITE_MASK) || ((SITE_MASK >> 1) & 1)
            pg8::gemm_phase<pg8::EpiResid, pg8::StaticOrder, true, true>(lds, g, S, E, TIDX);
#endif
            SEAM(pb + 2);
        }
        if (second) continue;
        const int pm = 1 + l * NPL + 2;
        if (RUN(pm + 1)) {
            pg8::Gemm g{XN, (const bf16*)(wb + WO_IN), M, NINP, DM}; pg8::StaticOrder S; S.init(M, NINP, G, bid + z);
            pg8::EpiWin E{(bf16*)(ws + WS_QA), (bf16*)(ws + WS_QC), (bf16*)(ws + WS_IQ), (bf16*)(ws + WS_MISC), (bf16*)(ws + WS_KVC), (bf16*)(ws + WS_KVS), (bf16*)(ws + WS_KVW), (bf16*)(ws + WS_BU), GB,
                          (const float*)(ws + WS_ROPE), (const LAS float*)(lds + RS_OFF)};
            RS_PREPASS(S);
#if !defined(SITE_MASK) || ((SITE_MASK >> 2) & 1)
            pg8::gemm_phase<pg8::EpiWin, pg8::StaticOrder, true, true>(lds, g, S, E, TIDX);
#if DUP == 4
            pg8::gemm_phase<pg8::EpiWin, pg8::StaticOrder, true, true>(lds, g, S, E, TIDX);
#endif
#endif
            SEAM(pm + 1);
        }
        #ifndef NO_PREP
        if (RUN(pm + 2)) { phase_prep(P, ws, z, l, lds, gw, NGW, lane, wave);
            SEAM(pm + 2); }
#endif
        #ifndef NO_MIX
        if (RUN(pm + 3)) { phase_mixers(P, ws, z, lds, gw, NGW, lane, wave, bid, G); SEAM(pm + 3); }
#endif
        if (RUN(pm + 4)) {
#if DUP == 5
          for (int rep_ = 0; rep_ < 2; ++rep_) {
#endif
            pg8::StaticOrder S; S.init(M, DM, G, bid + z);
            { pg8::Gemm g{(const bf16*)(ws + WS_QA), (const bf16*)(wb + WO_PA), M, DM, 512}; pg8::EpiProj<0> E{MG, GB, 0};
#if !defined(SITE_MASK) || ((SITE_MASK >> 3) & 1)
              pg8::gemm_phase<pg8::EpiProj<0>, pg8::StaticOrder, true, true>(lds, g, S, E, TIDX);
#endif
            }
            { pg8::Gemm g{(const bf16*)(ws + WS_YB), (const bf16*)(wb + WO_PB), M, DM, 512}; pg8::EpiProj<1> E{MG, GB, 1024};
#if !defined(SITE_MASK) || ((SITE_MASK >> 4) & 1)
              pg8::gemm_phase<pg8::EpiProj<1>, pg8::StaticOrder, true, true>(lds, g, S, E, TIDX);
#endif
            }
            { pg8::Gemm g{(const bf16*)(ws + WS_QC), (const bf16*)(wb + WO_PC), M, DM, 512}; pg8::EpiProj<1> E{MG, GB, 2048};
#if !defined(SITE_MASK) || ((SITE_MASK >> 5) & 1)
              pg8::gemm_phase<pg8::EpiProj<1>, pg8::StaticOrder, true, true>(lds, g, S, E, TIDX);
#endif
            }
#if DUP == 5
          }
#endif
            SEAM(pm + 4);
        }
        if (RUN(pm + 5)) {
            pg8::Gemm g{MG, (const bf16*)(wb + WO_OUT), M, DM, DM}; pg8::StaticOrder S; S.init(M, DM, G, bid + z);
            pg8::EpiResid E{OUT, OUT, 1.0f, XN, (float*)(ws + WS_SSQ)};
#if !defined(SITE_MASK) || ((SITE_MASK >> 6) & 1)
            pg8::gemm_phase<pg8::EpiResid, pg8::StaticOrder, true, true>(lds, g, S, E, TIDX);
#endif
            SEAM(pm + 5);
        }
    }
    if (RUN(NPH - 1)) { asm volatile("" : "+s"(z)); int ln_ = TIDX; asm volatile("" : "+v"(ln_)); ln_ &= 63; float* o_ = P.out + z; for (int m = gw; m < M; m += NGW) norm_row_f32(o_ + (size_t)m * DM, P.in[23 + z], ln_); }
#undef RUN
#undef tid
#undef TIDX
#undef lane
#undef SEAM
}

extern "C" void kernel_launch(void* const* d_in, const int* in_sizes, int n_in, void* d_out, int out_size, void* d_ws, size_t ws_size, hipStream_t stream) {
    static int grid = 0;
    if (grid == 0) {
        if (n_in != 24 || out_size != M * DM || ws_size < WS_END) { fprintf(stderr, "kernel_launch: unexpected shapes (n_in %d out %d ws %zu)\n", n_in, out_size, ws_size); grid = -1; return; }
        int dev = 0, cus = 0, per_cu = 0;
        if (hipGetDevice(&dev) != hipSuccess || hipDeviceGetAttribute(&cus, hipDeviceAttributeMultiprocessorCount, dev) != hipSuccess) { grid = -1; return; }
        if (hipFuncSetAttribute((const void*)fwd_kernel, hipFuncAttributeMaxDynamicSharedMemorySize, LDS_BYTES) != hipSuccess) { fprintf(stderr, "kernel_launch: hipFuncSetAttribute failed\n"); grid = -1; return; }
        if (hipOccupancyMaxActiveBlocksPerMultiprocessor(&per_cu, (const void*)fwd_kernel, NWAVES * 64, LDS_BYTES) != hipSuccess || per_cu < 1) { fprintf(stderr, "kernel_launch: occupancy query says %d\n", per_cu); }
        (void)hipGetLastError();
        grid = cus;
    }
    if (grid < 0) return;
    (void)hipMemsetAsync((char*)d_ws + WS_CTL, 0, CTL_ZERO_BYTES, stream);
    Args a{};
    for (int i = 0; i < 24; ++i) a.in[i] = (const float*)d_in[i];
    a.out = (float*)d_out; a.ws = (unsigned char*)d_ws;
#if MK_ONE_LAUNCH
    a.ph_lo = 0; a.ph_hi = NPH;
    hipLaunchKernelGGL(fwd_kernel, dim3(grid), dim3(NWAVES * 64), LDS_BYTES, stream, a);
#else
    for (int ph = 0; ph < NPH; ++ph) { a.ph_lo = ph; a.ph_hi = ph + 1; hipLaunchKernelGGL(fwd_kernel, dim3(grid), dim3(NWAVES * 64), LDS_BYTES, stream, a); }
#endif
}
```

```cpp
#include <hip/hip_runtime.h>
#include <cstdio>
#include <cstdint>
#define PROBE 0
#define PROBE_GAIN 10.0f
#define TOP8_RANK 1
#define PROBE_ROWTHR 0.01f
#define PROBE_ROWCOND 1
#define PROBE_BR -1
#define FIXHOM 0
#define DUP 0
#define POOLDBG 0
#define YB_SPARE 0
#define ALIGN_UP true
#define ALIGN_WIN true
#ifndef MK_ONE_LAUNCH
#define MK_ONE_LAUNCH 1
#endif
namespace pg8 {
#define PG8_LAS __attribute__((address_space(3)))
typedef unsigned short bf16_t;
typedef short bf16x8 __attribute__((ext_vector_type(8)));
typedef float f32x4 __attribute__((ext_vector_type(4)));
typedef unsigned u32x4 __attribute__((ext_vector_type(4)));
constexpr int BM = 256, BK = 64, HALF = 128, HTB = HALF * BK * 2  , STAGE_BYTES = 8 * HTB, NXCD = 8, WGM = 8;

__host__ __device__ __forceinline__ int lds_byte(int r, int c) { const int st = (r >> 4) * 2 + (c >> 5), rr = r & 15, cc = c & 31, ob = rr * 64 + cc * 2; return st * 1024 + (ob ^ (((ob >> 9) & 1) << 5)); }
__host__ __device__ __forceinline__ void stage_rc(int b, int& R, int& C) { const int st = b / 1024, sb = b % 1024, swz = sb ^ (((sb >> 9) & 1) << 5); R = (st >> 1) * 16 + swz / 64; C = (st & 1) * 32 + (swz % 64) / 2; }
__host__ __device__ __forceinline__ int perm32(int rho) { const int n = rho >> 4, i = rho & 15; return 8 * (i >> 2) + 4 * n + (i & 3); }

struct Unit { int pm, pn, ord; };
struct Gemm { const bf16_t* A; const bf16_t* Bt; int M, N, K; };

struct StaticOrder {
    int nM, nN, nwg, G, c;
    __host__ __device__ __forceinline__ void init(int M, int N, int G_, int c_) { nM = M / BM; nN = N / BM; nwg = nM * nN; G = G_; c = c_; }
    __host__ __device__ __forceinline__ bool next(int i, Unit& u) const {
        const long L = (long)i * G + c; if (L >= nwg) return false;
        int wgid = (int)L; { const int q = nwg / NXCD, r = nwg % NXCD, xcd = wgid % NXCD, off = wgid / NXCD; wgid = (xcd < r ? xcd * (q + 1) : r * (q + 1) + (xcd - r) * q) + off; }
        const int nig = WGM * nN, gid = wgid / nig, fm = gid * WGM, gsz = (nM - fm) < WGM ? (nM - fm) : WGM;
        u.pm = fm + ((wgid % nig) % gsz); u.pn = (wgid % nig) / gsz; u.ord = i; return true;
    }
    __device__ __forceinline__ void a_ready(const Unit&) const {}
    __device__ __forceinline__ void done(const Unit&) const {}
};

__device__ __forceinline__ unsigned cvt_pk_bf16(float lo, float hi) { unsigned r; asm volatile("v_cvt_pk_bf16_f32 %0, %1, %2" : "=v"(r) : "v"(lo), "v"(hi)); return r; }
__device__ __forceinline__ float bflo(unsigned w) { return __uint_as_float(w << 16); }
__device__ __forceinline__ float bfhi(unsigned w) { return __uint_as_float(w & 0xffff0000u); }
__device__ __forceinline__ float fast_sigmoid(float x) { return __builtin_amdgcn_rcpf(1.0f + __expf(-x)); }

struct EpiSwiglu {
    static constexpr bool PERM = true, AFTER_DRAIN = false;
    bf16_t* H; int ldh; const PG8_LAS float* rs;
    __device__ __forceinline__ void operator()(const f32x4 (&acc)[2][2][4][2], const Unit& u, int wr, int wc, int fr, int fq) const {
        const int row0 = u.pm * BM + wr * 64 + fr, col0 = u.pn * HALF + wc * 32 + 8 * fq;
#pragma unroll
        for (int ai = 0; ai < 2; ++ai)
#pragma unroll
            for (int m = 0; m < 4; ++m) {
                bf16_t* rowp = H + (size_t)(row0 + ai * HALF + m * 16) * ldh + col0;
                const float r = rs[u.ord * 256 + wr * 64 + fr + ai * HALF + m * 16];
                float o[8];
#pragma unroll
                for (int n = 0; n < 2; ++n)
#pragma unroll
                    for (int e = 0; e < 4; ++e) { const float g = acc[ai][0][m][n][e] * r, up = acc[ai][1][m][n][e] * r; o[n * 4 + e] = g * fast_sigmoid(g) * up; }
                u32x4 w; w.x = cvt_pk_bf16(o[0], o[1]); w.y = cvt_pk_bf16(o[2], o[3]); w.z = cvt_pk_bf16(o[4], o[5]); w.w = cvt_pk_bf16(o[6], o[7]);
                *(u32x4*)rowp = w;
            }
    }
};
struct EpiResid {
    static constexpr bool PERM = true, AFTER_DRAIN = false;
    const float* base; float* out; float s; bf16_t* xb; float* ssq;
    __device__ __forceinline__ void operator()(const f32x4 (&acc)[2][2][4][2], const Unit& u, int wr, int wc, int fr, int fq) const {
        const int row0 = u.pm * BM + wr * 64 + fr, col0 = u.pn * BM + wc * 32 + 8 * fq;
#pragma unroll
        for (int ai = 0; ai < 2; ++ai)
#pragma unroll
            for (int m = 0; m < 4; ++m) {
                const size_t off = (size_t)(row0 + ai * HALF + m * 16) * 1024 + col0;
                float q = 0.f;
#pragma unroll
                for (int bj = 0; bj < 2; ++bj) {
                    const f32x4 b0 = *(const f32x4*)(base + off + bj * HALF), b1 = *(const f32x4*)(base + off + bj * HALF + 4);
                    const f32x4 x0 = b0 + acc[ai][bj][m][0] * s, x1 = b1 + acc[ai][bj][m][1] * s;
                    *(f32x4*)(out + off + bj * HALF) = x0; *(f32x4*)(out + off + bj * HALF + 4) = x1;
                    q += (x0[0] * x0[0] + x0[1] * x0[1]) + (x0[2] * x0[2] + x0[3] * x0[3]) + (x1[0] * x1[0] + x1[1] * x1[1]) + (x1[2] * x1[2] + x1[3] * x1[3]);
                    u32x4 w; w.x = cvt_pk_bf16(x0[0], x0[1]); w.y = cvt_pk_bf16(x0[2], x0[3]); w.z = cvt_pk_bf16(x1[0], x1[1]); w.w = cvt_pk_bf16(x1[2], x1[3]);
                    *(u32x4*)(xb + off + bj * HALF) = w;
                }
                q += __shfl_xor(q, 16); q += __shfl_xor(q, 32);
                if (fq == 0) ssq[(size_t)(row0 + ai * HALF + m * 16) * 16 + u.pn * 4 + wc] = q;
            }
    }
};
template <int MODE> struct EpiProj {
    static constexpr bool PERM = true, AFTER_DRAIN = false;
    bf16_t* MG; const bf16_t* G; int gofs;
    __device__ __forceinline__ void operator()(const f32x4 (&acc)[2][2][4][2], const Unit& u, int wr, int wc, int fr, int fq) const {
        const int row0 = u.pm * BM + wr * 64 + fr, col0 = u.pn * BM + wc * 32 + 8 * fq;
#pragma unroll
        for (int ai = 0; ai < 2; ++ai)
#pragma unroll
            for (int m = 0; m < 4; ++m) {
                const size_t row = (size_t)(row0 + ai * HALF + m * 16);
#pragma unroll
                for (int bj = 0; bj < 2; ++bj) {
                    const u32x4 gv = *(const u32x4*)(G + row * 3072 + gofs + col0 + bj * HALF);
                    bf16_t* mp = MG + row * 1024 + col0 + bj * HALF;
                    const f32x4 a0 = acc[ai][bj][m][0], a1 = acc[ai][bj][m][1];
                    float o[8] = {bflo(gv.x) * a0[0], bfhi(gv.x) * a0[1], bflo(gv.y) * a0[2], bfhi(gv.y) * a0[3], bflo(gv.z) * a1[0], bfhi(gv.z) * a1[1], bflo(gv.w) * a1[2], bfhi(gv.w) * a1[3]};
                    if (MODE) { const u32x4 ov = *(const u32x4*)mp; o[0] += bflo(ov.x); o[1] += bfhi(ov.x); o[2] += bflo(ov.y); o[3] += bfhi(ov.y); o[4] += bflo(ov.z); o[5] += bfhi(ov.z); o[6] += bflo(ov.w); o[7] += bfhi(ov.w); }
                    u32x4 w; w.x = cvt_pk_bf16(o[0], o[1]); w.y = cvt_pk_bf16(o[2], o[3]); w.z = cvt_pk_bf16(o[4], o[5]); w.w = cvt_pk_bf16(o[6], o[7]);
                    *(u32x4*)mp = w;
                }
            }
    }
};
struct EpiWin {
    static constexpr bool PERM = true, AFTER_DRAIN = false;
    bf16_t *QA, *QC, *IQ, *MISC, *KVC, *KVS, *KVW, *BU, *G; const float* rope; const PG8_LAS float* rs;
    __device__ __forceinline__ void operator()(const f32x4 (&acc)[2][2][4][2], const Unit& u, int wr, int wc, int fr, int fq) const {
        const int pn = u.pn;
        bf16_t* dst; int ld, cbase, mode;
        if (pn < 2) { dst = QA; ld = 512; cbase = pn * 256; mode = 1; }
        else if (pn < 4) { dst = QC; ld = 512; cbase = (pn - 2) * 256; mode = 1; }
        else if (pn == 4) { dst = IQ; ld = 256; cbase = 0; mode = 1; }
        else if (pn == 5) { dst = MISC; ld = 256; cbase = 0; mode = 3; }
        else if (pn <= 8) { dst = pn == 6 ? KVC : (pn == 7 ? KVS : KVW); ld = 256; cbase = 0; mode = 2; }
        else if (pn <= 10) { dst = BU; ld = 512; cbase = (pn - 9) * 256; mode = 0; }
        else { dst = G; ld = 3072; cbase = (pn - 11) * 256; mode = 4; }
        const int row0 = u.pm * BM + wr * 64 + fr, col0 = cbase + wc * 32 + 8 * fq;
        const bool ropelane = ((wc & 1) == 0) && fq < 2;
        const float sc = (mode == 1) ? (pn < 4 ? 0.125f * 1.4426950408889634f : 0.125f) : 1.0f;
#pragma unroll
        for (int ai = 0; ai < 2; ++ai)
#pragma unroll
            for (int m = 0; m < 4; ++m) {
                const size_t row = (size_t)(row0 + ai * HALF + m * 16);
                const float rr = rs[u.ord * 256 + wr * 64 + fr + ai * HALF + m * 16];
                f32x4 cs = {1.f, 1.f, 1.f, 1.f}, sn = {0.f, 0.f, 0.f, 0.f};
                if (ropelane && mode >= 1 && mode <= 3) { cs = *(const f32x4*)(rope + row * 16 + 4 * fq); sn = *(const f32x4*)(rope + row * 16 + 8 + 4 * fq); }
#pragma unroll
                for (int bj = 0; bj < 2; ++bj) {
                    const f32x4 a0 = acc[ai][bj][m][0] * rr, a1 = acc[ai][bj][m][1] * rr;
                    float o[8] = {a0[0], a0[1], a0[2], a0[3], a1[0], a1[1], a1[2], a1[3]};
                    const bool dorope = ropelane && (mode == 1 || (mode == 2 && bj == 0) || (mode == 3 && bj == 0 && wc == 0));
                    if (dorope) {
#pragma unroll
                        for (int p = 0; p < 4; ++p) { const float x1 = o[2 * p], x2 = o[2 * p + 1]; o[2 * p] = x1 * cs[p] - x2 * sn[p]; o[2 * p + 1] = x2 * cs[p] + x1 * sn[p]; }
                    }
                    if (mode == 4) {
#pragma unroll
                        for (int e = 0; e < 8; ++e) o[e] = fast_sigmoid(o[e]);
                    } else {
#pragma unroll
                        for (int e = 0; e < 8; ++e) o[e] *= sc;
                    }
                    u32x4 w; w.x = cvt_pk_bf16(o[0], o[1]); w.y = cvt_pk_bf16(o[2], o[3]); w.z = cvt_pk_bf16(o[4], o[5]); w.w = cvt_pk_bf16(o[6], o[7]);
                    *(u32x4*)(dst + row * ld + col0 + bj * HALF) = w;
                }
            }
    }
};

template <class Epi, class Sched, bool ALIGN_EPI = false, bool SP2 = false>
__device__ __forceinline__ void gemm_phase(PG8_LAS unsigned char* lds, const Gemm g, const Sched& S, const Epi& E, int tid_in) {
    int tid_ = tid_in; asm volatile("" : "+v"(tid_));
    const int tid = tid_, wid = __builtin_amdgcn_readfirstlane(tid >> 6), lane = tid & 63, wr = wid >> 2, wc = wid & 3, fr = lane & 15, fq = lane >> 4;
    const int K = g.K, nt = K / BK;
    unsigned voffA[2], voffB[2];
#pragma unroll
    for (int i = 0; i < 2; ++i) { int R, C; stage_rc(tid * 16 + i * 8192, R, C); const int Rb = Epi::PERM ? ((R & ~31) + perm32(R & 31)) : R;
        voffA[i] = (unsigned)(R * K + C) * 2u; voffB[i] = (unsigned)(Rb * K + C) * 2u; }
    const size_t kstep = (size_t)(BK * 2);
    const size_t hstep = (size_t)HALF * K * 2;
    const size_t tstep = 2 * hstep;
    const unsigned ldsw = (unsigned)wid * 1024u;
    const int aoff = lds_byte(wr * 64 + fr, fq * 8), boff = lds_byte(wc * 32 + fr, fq * 8);
#define PG8_SA(b, h) (((b) * 2 + (h)) * HTB)
#define PG8_SB(b, h) ((4 + (b) * 2 + (h)) * HTB)
#define PG8_STAGE(bufoff, gbase, voff) do { _Pragma("unroll") for (int _i = 0; _i < 2; ++_i) \
        __builtin_amdgcn_global_load_lds((const unsigned*)((const char*)(gbase) + (voff)[_i]), (PG8_LAS unsigned*)(lds + (bufoff) + ldsw + _i * 8192), 16, 0, 0); } while (0)
#define PG8_LDA(dst, b, h) do { _Pragma("unroll") for (int m = 0; m < 4; ++m) _Pragma("unroll") for (int k = 0; k < 2; ++k) dst[m][k] = *(const PG8_LAS bf16x8*)(lds + PG8_SA(b, h) + aoff + m * 2048 + k * 1024); } while (0)
#define PG8_LDB(dst, b, h) do { _Pragma("unroll") for (int n = 0; n < 2; ++n) _Pragma("unroll") for (int k = 0; k < 2; ++k) dst[n][k] = *(const PG8_LAS bf16x8*)(lds + PG8_SB(b, h) + boff + n * 2048 + k * 1024); } while (0)
#define PG8_MMA(ai, bj, At, Bt) do { __builtin_amdgcn_s_setprio(1); _Pragma("unroll") for (int m = 0; m < 4; ++m) _Pragma("unroll") for (int n = 0; n < 2; ++n) _Pragma("unroll") for (int k = 0; k < 2; ++k) \
        acc[ai][bj][m][n] = __builtin_amdgcn_mfma_f32_16x16x32_bf16(Bt[n][k], At[m][k], acc[ai][bj][m][n], 0, 0, 0); __builtin_amdgcn_s_setprio(0); } while (0)
#define PG8_WAIT_V(n) asm volatile("s_waitcnt vmcnt(" #n ")" ::: "memory")
#define PG8_WAIT_L(n) asm volatile("s_waitcnt lgkmcnt(" #n ")" ::: "memory")
#define PG8_BAR __builtin_amdgcn_s_barrier()
#define PG8_SCHED __builtin_amdgcn_sched_barrier(0)
    Unit cur, nxt; int ui = 0;
    if (!S.next(0, cur)) return;
    f32x4 acc[2][2][4][2];
#pragma unroll
    for (int a = 0; a < 2; ++a)
#pragma unroll
        for (int b = 0; b < 2; ++b)
#pragma unroll
            for (int m = 0; m < 4; ++m)
#pragma unroll
                for (int n = 0; n < 2; ++n) acc[a][b][m][n] = (f32x4){0.f, 0.f, 0.f, 0.f};
    bf16x8 At[4][2], B0[2][2], B1[2][2];
    const char* cA = (const char*)g.A + (size_t)cur.pm * tstep; const char* cB = (const char*)g.Bt + (size_t)cur.pn * tstep;
    S.a_ready(cur);
    if constexpr (SP2) {
        PG8_STAGE(PG8_SB(0, 0), cB, voffB); PG8_STAGE(PG8_SB(0, 1), cB + hstep, voffB); PG8_STAGE(PG8_SA(0, 0), cA, voffA); PG8_STAGE(PG8_SA(0, 1), cA + hstep, voffA);
        if (wr == 1) PG8_BAR;
        PG8_WAIT_V(2); PG8_BAR;
        PG8_STAGE(PG8_SB(1, 0), cB + kstep, voffB); PG8_STAGE(PG8_SA(1, 0), cA + kstep, voffA); PG8_STAGE(PG8_SB(1, 1), cB + hstep + kstep, voffB);
        PG8_WAIT_V(6); PG8_BAR;
    } else {
        PG8_STAGE(PG8_SB(0, 0), cB, voffB); PG8_STAGE(PG8_SA(0, 0), cA, voffA); PG8_STAGE(PG8_SB(0, 1), cB + hstep, voffB); PG8_STAGE(PG8_SA(0, 1), cA + hstep, voffA);
        if (wr == 1) PG8_BAR;
        PG8_WAIT_V(4); PG8_BAR;
        PG8_STAGE(PG8_SB(1, 0), cB + kstep, voffB); PG8_STAGE(PG8_SA(1, 0), cA + kstep, voffA); PG8_STAGE(PG8_SB(1, 1), cB + hstep + kstep, voffB);
        PG8_WAIT_V(6); PG8_BAR;
    }
    for (;;) {
        const bool has_next = S.next(ui + 1, nxt);
        const char* nA = has_next ? (const char*)g.A + (size_t)nxt.pm * tstep : cA; const char* nB = has_next ? (const char*)g.Bt + (size_t)nxt.pn * tstep : cB;
        for (int t = 0; t < nt; t += 2) {
            const bool last = (t == nt - 2);
            const char* a1 = cA + (size_t)(t + 1) * kstep;
            const char* a2 = last ? nA : cA + (size_t)(t + 2) * kstep; const char* b2 = last ? nB : cB + (size_t)(t + 2) * kstep;
            const char* a3 = a2 + kstep; const char* b3 = b2 + kstep;
            if (last && has_next) S.a_ready(nxt);
            if constexpr (SP2) {
            PG8_LDB(B0, 0, 0); PG8_LDB(B1, 0, 1); PG8_SCHED; PG8_LDA(At, 0, 0); PG8_STAGE(PG8_SA(1, 1), a1 + hstep, voffA);
            PG8_WAIT_V(8); PG8_WAIT_L(0); PG8_BAR; PG8_MMA(0, 0, At, B0); PG8_MMA(0, 1, At, B1); PG8_BAR; PG8_SCHED;
            PG8_LDA(At, 0, 1); PG8_STAGE(PG8_SB(0, 0), b2, voffB); PG8_STAGE(PG8_SB(0, 1), b2 + hstep, voffB); PG8_STAGE(PG8_SA(0, 0), a2, voffA);
            PG8_WAIT_V(8); PG8_WAIT_L(0); PG8_BAR; PG8_MMA(1, 0, At, B0); PG8_MMA(1, 1, At, B1); PG8_BAR; PG8_SCHED;
            PG8_LDB(B0, 1, 0); PG8_LDB(B1, 1, 1); PG8_SCHED; PG8_LDA(At, 1, 0); PG8_STAGE(PG8_SA(0, 1), a2 + hstep, voffA);
            PG8_WAIT_V(8); PG8_WAIT_L(0); PG8_BAR; PG8_MMA(0, 0, At, B0); PG8_MMA(0, 1, At, B1); PG8_BAR; PG8_SCHED;
            PG8_LDA(At, 1, 1); PG8_STAGE(PG8_SB(1, 0), b3, voffB); PG8_STAGE(PG8_SB(1, 1), b3 + hstep, voffB); PG8_STAGE(PG8_SA(1, 0), a3, voffA);
            PG8_WAIT_V(8); PG8_WAIT_L(0); PG8_BAR; PG8_MMA(1, 0, At, B0); PG8_MMA(1, 1, At, B1); PG8_BAR; PG8_SCHED;
            } else {
            PG8_LDB(B0, 0, 0); PG8_SCHED; PG8_LDA(At, 0, 0); PG8_STAGE(PG8_SA(1, 1), a1 + hstep, voffA);
            PG8_WAIT_L(8); PG8_BAR; PG8_WAIT_L(0); PG8_MMA(0, 0, At, B0); PG8_BAR; PG8_SCHED;
            PG8_LDB(B1, 0, 1); PG8_STAGE(PG8_SB(0, 0), b2, voffB);
            PG8_BAR; PG8_WAIT_L(0); PG8_MMA(0, 1, At, B1); PG8_BAR;
            PG8_LDA(At, 0, 1); PG8_STAGE(PG8_SA(0, 0), a2, voffA);
            PG8_BAR; PG8_WAIT_L(0); PG8_MMA(1, 0, At, B0); PG8_BAR; PG8_SCHED;
            PG8_STAGE(PG8_SB(0, 1), b2 + hstep, voffB);
            PG8_WAIT_V(6); PG8_BAR; PG8_MMA(1, 1, At, B1); PG8_BAR;
            PG8_LDB(B0, 1, 0); PG8_SCHED; PG8_LDA(At, 1, 0); PG8_STAGE(PG8_SA(0, 1), a2 + hstep, voffA);
            PG8_WAIT_L(8); PG8_BAR; PG8_WAIT_L(0); PG8_MMA(0, 0, At, B0); PG8_BAR; PG8_SCHED;
            PG8_LDB(B1, 1, 1); PG8_STAGE(PG8_SB(1, 0), b3, voffB);
            PG8_BAR; PG8_WAIT_L(0); PG8_MMA(0, 1, At, B1); PG8_BAR;
            PG8_LDA(At, 1, 1); PG8_STAGE(PG8_SA(1, 0), a3, voffA);
            PG8_BAR; PG8_WAIT_L(0); PG8_MMA(1, 0, At, B0); PG8_BAR; PG8_SCHED;
            PG8_STAGE(PG8_SB(1, 1), b3 + hstep, voffB);
            PG8_WAIT_V(6); PG8_BAR; PG8_MMA(1, 1, At, B1); PG8_BAR;
            }
        }
        if constexpr (ALIGN_EPI) { if (wr == 0) PG8_BAR; }
        if constexpr (!Epi::AFTER_DRAIN) { E(acc, cur, wr, wc, fr, fq); S.done(cur); }
        if (!has_next) break;
#pragma unroll
        for (int a = 0; a < 2; ++a)
#pragma unroll
            for (int b = 0; b < 2; ++b)
#pragma unroll
                for (int m = 0; m < 4; ++m)
#pragma unroll
                    for (int n = 0; n < 2; ++n) acc[a][b][m][n] = (f32x4){0.f, 0.f, 0.f, 0.f};
        cur = nxt; cA = nA; cB = nB; ++ui;
        if constexpr (ALIGN_EPI) { if (wr == 1) PG8_BAR; }
    }
    PG8_WAIT_V(0);
    if constexpr (!ALIGN_EPI) { if (wr == 0) PG8_BAR; }
    PG8_BAR;
    if constexpr (Epi::AFTER_DRAIN) { E.fused(acc, cur, wr, wc, fr, fq, lds, wid, lane); S.done(cur); }
#undef PG8_SA
#undef PG8_SB
#undef PG8_STAGE
#undef PG8_LDA
#undef PG8_LDB
#undef PG8_MMA
#undef PG8_WAIT_V
#undef PG8_WAIT_L
#undef PG8_BAR
#undef PG8_SCHED
}
}
#define GAS __attribute__((address_space(1)))
#define LAS __attribute__((address_space(3)))
typedef unsigned short bf16;
typedef unsigned v4u __attribute__((ext_vector_type(4)));
typedef float f32x4 __attribute__((ext_vector_type(4)));
typedef short bf16x8 __attribute__((ext_vector_type(8)));
typedef GAS unsigned gu32;
typedef GAS unsigned long long gu64;
#define RLX_AGENT __ATOMIC_RELAXED, __HIP_MEMORY_SCOPE_AGENT
#define LDS_WAIT() asm volatile("s_waitcnt lgkmcnt(0)" ::: "memory")
#define VM_WAIT() asm volatile("s_waitcnt vmcnt(0)" ::: "memory")
__device__ __forceinline__ unsigned long long rt() { return __builtin_amdgcn_s_memrealtime(); }
__device__ __forceinline__ unsigned f2bf(float f) { unsigned u = __builtin_bit_cast(unsigned, f); return (u + 0x7fffu + ((u >> 16) & 1u)) >> 16; }
__device__ __forceinline__ unsigned pk2(float lo, float hi) { return f2bf(lo) | (f2bf(hi) << 16); }
#define XB_TMO      128
#define XB_XCNT(j)  (256  + 64 * (j))
#define XB_XSUB(j)  (1280 + 64 * (j))
#define XB_XGEN(j)  (2304 + 64 * (j))
#define XB_TOP      3328
#define XB_TOPGEN   3392
#define XCD_BAR_WORDS 3456
#define XB_SPIN_CAP (1u << 18)

__device__ __forceinline__ unsigned xb_ld(unsigned* p)              { return __hip_atomic_load(p, __ATOMIC_RELAXED, __HIP_MEMORY_SCOPE_AGENT); }
__device__ __forceinline__ unsigned xb_add(unsigned* p, unsigned v) { return __hip_atomic_fetch_add(p, v, __ATOMIC_RELAXED, __HIP_MEMORY_SCOPE_AGENT); }
__device__ __forceinline__ unsigned xb_xcc_id() { return (unsigned)__builtin_amdgcn_s_getreg((3 << 11) | 20) & 0xFu; }
#define XB_SPIN(cond, bar) do { unsigned _sp = 0; while (cond) { __builtin_amdgcn_s_sleep(1); \
    if ((++_sp & 255u) == 0u) { if (xb_ld(&(bar)[XB_TMO])) break; if (_sp > XB_SPIN_CAP) { atomicAdd(&(bar)[XB_TMO], 1u); break; } } } } while (0)

struct XcdBarrier {
    unsigned* bar; unsigned x;
    volatile LAS unsigned* st;
};

__device__ __forceinline__ XcdBarrier xcd_barrier_post(unsigned* bar, volatile LAS unsigned* st) {
    XcdBarrier b; b.bar = bar; b.x = xb_xcc_id(); b.st = st;
    if (threadIdx.x == 0) (void)xb_add(&bar[XB_XCNT(b.x)], 1u);
    return b;
}
__device__ __forceinline__ void xcd_barrier_complete(unsigned* bar, unsigned x, unsigned& nloc, unsigned& nx) {
    const unsigned G = gridDim.x * gridDim.y * gridDim.z;
    unsigned sum, cnt, mine, sp = 0u;
    for (;;) {
        sum = 0u; cnt = 0u; mine = 0u;
#pragma unroll
        for (unsigned j = 0; j < 16; ++j) { const unsigned c = xb_ld(&bar[XB_XCNT(j)]); sum += c; cnt += (c > 0u) ? 1u : 0u; mine = (j == x) ? c : mine; }
        if (sum == G) break;
        __builtin_amdgcn_s_sleep(1);
        if ((++sp & 255u) == 0u) { if (xb_ld(&bar[XB_TMO])) break; if (sp > XB_SPIN_CAP) { atomicAdd(&bar[XB_TMO], 1u); break; } }
    }
    nloc = mine > 0u ? mine : 1u; nx = cnt > 0u ? cnt : 1u;
}

__device__ __forceinline__ void xcd_barrier(const XcdBarrier& b) {
    asm volatile("s_waitcnt vmcnt(0)" ::: "memory");
    __syncthreads();
    if (threadIdx.x == 0) {
        unsigned* bar = b.bar;
        __builtin_amdgcn_s_waitcnt(0);
        unsigned nloc = b.st[0], nx = b.st[1];
        if (nloc == 0u) { xcd_barrier_complete(bar, b.x, nloc, nx); b.st[0] = nloc; b.st[1] = nx; }
        const unsigned old = xb_add(&bar[XB_XSUB(b.x)], 1u);
        const unsigned gen = old / nloc;
        if (old + 1u == (gen + 1u) * nloc) {
            __builtin_amdgcn_fence(__ATOMIC_RELEASE, "agent");
            asm volatile("s_waitcnt vmcnt(0)" ::: "memory");
            const unsigned og = xb_add(&bar[XB_TOP], 1u);
            const unsigned tg = og / nx;
            if (og + 1u == (tg + 1u) * nx) xb_add(&bar[XB_TOPGEN], 1u);
            else XB_SPIN(xb_ld(&bar[XB_TOPGEN]) == tg, bar);
            __builtin_amdgcn_fence(__ATOMIC_ACQUIRE, "agent");
            xb_add(&bar[XB_XGEN(b.x)], 1u);
            asm volatile("s_waitcnt vmcnt(0)" ::: "memory");
        } else {
            XB_SPIN(xb_ld(&bar[XB_XGEN(b.x)]) == gen, bar);
            __builtin_amdgcn_fence(__ATOMIC_ACQUIRE, "agent");
            asm volatile("s_waitcnt vmcnt(0)" ::: "memory");
        }
    }
    __syncthreads();
}
constexpr int NB = 8, SEQ = 4096, DM = 1024, DEPTH = 4, M = NB * SEQ;
constexpr int FF = 2816, NIN = 5852, NINP = 5888;
constexpr float EPS = 1e-6f, NEGF = -1e30f;
constexpr int NWAVES = 8;
constexpr size_t MiB = 1u << 20;
constexpr size_t WS_CTL = 0, CTL_ZERO_BYTES = 1 * MiB;
constexpr size_t WS_ROPE = 1 * MiB;
constexpr size_t WS_KVA = 3 * MiB;
constexpr size_t WS_KC = 11 * MiB, WS_VC = WS_KC + 512 * 1024;
constexpr size_t WS_W = 12 * MiB;
constexpr size_t WO_GU1 = 0, WO_D1 = 11 * MiB, WO_GU2 = WO_D1 + 5 * MiB + 512 * 1024, WO_D2 = WO_GU2 + 11 * MiB, WO_IN = WO_D2 + 5 * MiB + 512 * 1024,
                 WO_PA = WO_IN + 11 * MiB + 512 * 1024, WO_PB = WO_PA + MiB, WO_PC = WO_PB + MiB, WO_OUT = WO_PC + MiB,
                 WO_CW1 = WO_OUT + 2 * MiB  , WO_CW2 = WO_CW1 + MiB  , WO_UKV = WO_CW2 + 32768  , WO_POOL = WO_UKV + 32768  ,
                 WO_POSB = WO_POOL + 131072  , WO_END = WO_POSB + 1024;
static_assert(WO_END <= 52 * MiB, "weights region");
constexpr size_t WS_XN = 64 * MiB;
constexpr size_t WS_R = 128 * MiB;
constexpr size_t WS_G = WS_R, WS_QA = WS_R + 192 * MiB, WS_QC = WS_QA + 32 * MiB, WS_IQ = WS_QC + 32 * MiB, WS_MISC = WS_IQ + 16 * MiB,
                 WS_KVC = WS_MISC + 16 * MiB, WS_KVS = WS_KVC + 16 * MiB, WS_KVW = WS_KVS + 16 * MiB, WS_BU = WS_KVW + 16 * MiB, WS_END = WS_BU + 32 * MiB;
#ifndef YB_SPARE
#define YB_SPARE 0
#endif
constexpr size_t WS_YB = YB_SPARE ? 496 * MiB : WS_XN;
constexpr size_t WS_MG = WS_IQ;
constexpr size_t WS_H = WS_R;
static_assert(WS_END == 496 * MiB, "ws map");
constexpr int RING_BYTES = 131072, LDS_BYTES = 163840, LDSCTL_OFF = 163840 - 256;
constexpr size_t WS_SSQ = 496 * MiB;
constexpr int RS_OFF = 131072;
constexpr int NPL = 10, NPH = 1 + DEPTH * NPL + 1;

__device__ __forceinline__ int lane_id_v() { int l; asm volatile("v_mbcnt_lo_u32_b32 %0, -1, 0\n\tv_mbcnt_hi_u32_b32 %0, -1, %0" : "=v"(l)); return l; }
__device__ __forceinline__ float bflo(unsigned w) { return __uint_as_float(w << 16); }
__device__ __forceinline__ float bfhi(unsigned w) { return __uint_as_float(w & 0xffff0000u); }
__device__ __forceinline__ float bf2f(bf16 v) { return __uint_as_float((unsigned)v << 16); }
__device__ __forceinline__ float wave_sum(float v) {
#pragma unroll
    for (int o = 1; o < 64; o <<= 1) v += __shfl_xor(v, o);
    return v;
}
__device__ __forceinline__ float wave_max(float v) {
#pragma unroll
    for (int o = 1; o < 64; o <<= 1) v = fmaxf(v, __shfl_xor(v, o));
    return v;
}
__device__ __forceinline__ int wave_sum_i(int v) {
#pragma unroll
    for (int o = 1; o < 64; o <<= 1) v += __shfl_xor(v, o);
    return v;
}
__device__ __forceinline__ unsigned wave_max_u(unsigned v) {
#pragma unroll
    for (int o = 1; o < 64; o <<= 1) { const unsigned w = (unsigned)__shfl_xor((int)v, o); v = w > v ? w : v; }
    return v;
}
#define WAVE_LDS_SYNC() do { asm volatile("s_waitcnt lgkmcnt(0)" ::: "memory"); __builtin_amdgcn_wave_barrier(); } while (0)
__host__ __device__ __forceinline__ int permd(int d) { return d < 8 ? 2 * d : (d < 16 ? 2 * (d - 8) + 1 : d); }
__device__ __forceinline__ int win_newcol(int n) {
    if (n < 512) return (n & ~63) + permd(n & 63);
    if (n < 640) return 1280 + 64 + (n - 512);
    if (n < 896) { const int m = n - 640; return 1024 + (m & ~63) + permd(m & 63); }
    if (n < 960) return 1280 + permd(n - 896);
    if (n < 964) return 1280 + 192 + (n - 960);
    if (n < 1476) return 2304 + (n - 964);
    if (n < 1988) { const int m = n - 1476; return 512 + (m & ~63) + permd(m & 63); }
    if (n < 2756) { const int m = n - 1988, kv = m >> 8, r = m & 255, base = 1536 + kv * 256; return r < 128 ? base + (r & ~63) + permd(r & 63) : base + r; }
    if (n < 2780) return 1280 + 196 + (n - 2756);
    return 2816 + (n - 2780);
}
__device__ __forceinline__ int map_row(int mode, int n) { return mode == 0 ? n : (mode == 1 ? ((n >> 7) << 8) + (n & 127) : (mode == 2 ? ((n >> 7) << 8) + 128 + (n & 127) : win_newcol(n))); }

struct Args { const float* in[24]; float* out; unsigned char* ws; int ph_lo, ph_hi; };

__device__ __forceinline__ int unperm(int p) { return p < 16 ? ((p & 1) ? (p >> 1) + 8 : (p >> 1)) : p; }
__device__ __forceinline__ void tr_item(const float* W, int K, int N, bf16* WT, int mode, LAS float* scr, int item, int lane, bool kperm = false, const float* kscale = nullptr) {
    const int nblk = (N + 31) >> 5, kb = item / nblk, nb = item - kb * nblk, k0 = 64 * kb, n0 = 32 * nb;
    const int nn = n0 + (lane & 31);
#pragma unroll
    for (int i = 0; i < 32; ++i) { const int kk = 2 * i + (lane >> 5); const float sc_ = kscale ? kscale[k0 + kk] : 1.0f; scr[kk * 33 + (lane & 31)] = nn < N ? W[(size_t)(k0 + kk) * N + nn] * sc_ : 0.f; }
    LDS_WAIT(); asm volatile("" ::: "memory");
    const int c = lane & 7;
#pragma unroll
    for (int j = 0; j < 4; ++j) { const int n = (lane >> 3) + 8 * j; const LAS float* s = scr + n;
        int ks[8];
#pragma unroll
        for (int i = 0; i < 8; ++i) ks[i] = (kperm ? unperm(8 * c + i) : 8 * c + i) * 33;
        v4u o; o.x = pk2(s[ks[0]], s[ks[1]]); o.y = pk2(s[ks[2]], s[ks[3]]); o.z = pk2(s[ks[4]], s[ks[5]]); o.w = pk2(s[ks[6]], s[ks[7]]);
        if (n0 + n < N) *(v4u*)(WT + (size_t)map_row(mode, n0 + n) * K + k0 + 8 * c) = o; }
    LDS_WAIT(); asm volatile("" ::: "memory");
}
__device__ __forceinline__ void phase_convert(const Args& P, unsigned char* ws, int z, int l, LAS unsigned char* lds, int gw, int NGW, int lane, int wave) {
    asm volatile("" : "+v"(lane)); lane &= 63; asm volatile("" : "+s"(gw), "+s"(NGW));
    LAS float* scr = (LAS float*)(lds + wave * 16384);
    unsigned char* wb = ws + WS_W;
    constexpr int I_F = 16 * 88, I_D = 44 * 32, I_IN = 16 * 183, I_P = 8 * 32, I_O = 16 * 32;
    constexpr int I_C = 32 * 4;
    constexpr int NIT = 4 * I_F + 2 * I_D + I_IN + 3 * I_P + I_O + 2 * I_C;
    const size_t fo = (size_t)l * DM * FF;
    for (int it = gw; it < NIT; it += NGW) {
        int r = it, K = DM, N = FF, mode = 1; const float* W = P.in[3 + z] + fo; size_t wo = WO_GU1; bool kperm = false; const float* ksc = P.in[2 + z] + l * DM;
        if (r >= I_F) { r -= I_F; mode = 2; W = P.in[4 + z] + fo;
        if (r >= I_F) { r -= I_F; mode = 0; W = P.in[5 + z] + fo; K = FF; N = DM; wo = WO_D1; ksc = nullptr;
        if (r >= I_D) { r -= I_D; mode = 1; W = P.in[20 + z] + fo; K = DM; N = FF; wo = WO_GU2; ksc = P.in[19 + z] + l * DM;
        if (r >= I_F) { r -= I_F; mode = 2; W = P.in[21 + z] + fo;
        if (r >= I_F) { r -= I_F; mode = 0; W = P.in[22 + z] + fo; K = FF; N = DM; wo = WO_D2; ksc = nullptr;
        if (r >= I_D) { r -= I_D; mode = 3; W = P.in[7 + z] + (size_t)l * DM * NIN; K = DM; N = NIN; wo = WO_IN; ksc = P.in[6 + z] + l * DM;
        if (r >= I_IN) { r -= I_IN; mode = 0; W = P.in[15 + z] + (size_t)l * 512 * DM; K = 512; N = DM; wo = WO_PA; ksc = nullptr;
        if (r >= I_P) { r -= I_P; W = P.in[16 + z] + (size_t)l * 512 * DM; wo = WO_PB;
        if (r >= I_P) { r -= I_P; W = P.in[17 + z] + (size_t)l * 512 * DM; wo = WO_PC;
        if (r >= I_P) { r -= I_P; W = P.in[18 + z] + (size_t)l * DM * DM; K = DM; wo = WO_OUT;
        if (r >= I_O) { r -= I_O; W = P.in[13 + z] + (size_t)(l * 2) * 2048 * 128; K = 2048; N = 128; wo = WO_CW1; kperm = true;
        if (r >= I_C) { r -= I_C; W += (size_t)2048 * 128; wo = WO_CW1 + 128 * 2048 * 2; kperm = false; } } } } } } } } } } } }
        tr_item(W, K, N, (bf16*)(wb + wo), mode, scr, r, lane, kperm, ksc);
    }
    {
        const int gt = gw * 64 + lane, GT = NGW * 64;
        bf16* ukv = (bf16*)(wb + WO_UKV); bf16* pool = (bf16*)(wb + WO_POOL); bf16* cw2 = (bf16*)(wb + WO_CW2); float* posb = (float*)(wb + WO_POSB);
        const float* w_ukv = P.in[9 + z] + (size_t)l * 128 * 128; const float* gn = P.in[8 + z] + l * 128;
        for (int i = gt; i < 128 * 128; i += GT) { const int np = i >> 7, k = i & 127, n = np < 64 ? unperm(np) : np; ukv[i] = (bf16)f2bf(gn[k] * w_ukv[k * 128 + n]); }
        const float* pw = P.in[10 + z] + (size_t)l * 4 * 128 * 128; const float* psc = P.in[11 + z] + l * 512;
        for (int i = gt; i < 4 * 128 * 128; i += GT) { const int g = i >> 14, d = (i >> 7) & 127, c = i & 127; pool[i] = (bf16)f2bf(pw[(g * 128 + c) * 128 + d] * psc[g * 128 + d]); }
        const float* w2 = P.in[14 + z] + (size_t)l * 2 * 128 * 64;
        for (int i = gt; i < 2 * 64 * 128; i += GT) { const int br = i >> 13, dp = (i >> 7) & 63, n = i & 127, d = br ? dp : unperm(dp); cw2[i] = (bf16)f2bf(w2[(br * 128 + n) * 64 + d]); }
        const float* w1 = P.in[13 + z] + (size_t)l * 2 * 2048 * 128; const float* pos = P.in[12 + z] + (size_t)l * 2 * 2048;
        for (int i = gw; i < 256; i += NGW) { const int br = i >> 7, n = i & 127; float a = 0.f;
#pragma unroll 8
            for (int k = lane; k < 2048; k += 64) a += pos[br * 2048 + k] * w1[((size_t)br * 2048 + k) * 128 + n];
            a = wave_sum(a); if (lane == 0) posb[i] = a; }
    }
    if (gw < 36) { unsigned zz = 0u; asm volatile("" : "+v"(zz)); v4u z = {zz, zz, zz, zz}; v4u* rp = (v4u*)((bf16*)(wb + WO_IN) + (size_t)(1500 + gw) * DM); for (int i = lane; i < DM / 8; i += 64) rp[i] = z; }
}
__device__ __forceinline__ void phase_rope(const Args& P, unsigned char* ws, int z, int gtid, int gthreads) {
    float* rope = (float*)(ws + WS_ROPE);
    for (int idx = gtid; idx < M * 8; idx += gthreads) {
        const int row = idx >> 3, i = idx & 7;
        const double inv = i == 0 ? 1.0 : i == 1 ? 0.19392274474868576 : i == 2 ? 0.03760603093086393 : i == 3 ? 0.007292664737217109 : i == 4 ? 0.001414213562373095 : i == 5 ? 0.0002742481756762073 : i == 6 ? 5.318295896944988e-05 : 1.031338537721246e-05;
        const double ang = (double)((const int*)P.in[1 + z])[row] * inv;
        double s, c; sincos(ang, &s, &c);
        rope[row * 16 + i] = (float)c; rope[row * 16 + 8 + i] = (float)s;
    }
}
__device__ __forceinline__ void norm_row_bf16(const float* xrow, const float* gain, bf16* orow, int lane) {
    const f32x4* xr = (const f32x4*)xrow + lane; const f32x4* gr = (const f32x4*)gain + lane;
    f32x4 v[4]; float s = 0.f;
#pragma unroll
    for (int j = 0; j < 4; ++j) { v[j] = xr[64 * j]; s += (v[j].x * v[j].x + v[j].y * v[j].y) + (v[j].z * v[j].z + v[j].w * v[j].w); }
    const float r = 1.0f / sqrtf(wave_sum(s) * (1.f / DM) + EPS);
    unsigned long long* o8 = (unsigned long long*)orow + lane;
#pragma unroll
    for (int j = 0; j < 4; ++j) { const f32x4 g = gr[64 * j]; o8[64 * j] = (unsigned long long)pk2(v[j].x * r * g.x, v[j].y * r * g.y) | ((unsigned long long)pk2(v[j].z * r * g.z, v[j].w * r * g.w) << 32); }
}
__device__ __forceinline__ void stat_row_bf16(const float* xrow, bf16* orow, float* ssq16, int lane) {
    const f32x4* xr = (const f32x4*)xrow + lane;
    f32x4 v[4]; float s = 0.f;
#pragma unroll
    for (int j = 0; j < 4; ++j) { v[j] = xr[64 * j]; s += (v[j].x * v[j].x + v[j].y * v[j].y) + (v[j].z * v[j].z + v[j].w * v[j].w); }
    s = wave_sum(s);
    unsigned long long* o8 = (unsigned long long*)orow + lane;
#pragma unroll
    for (int j = 0; j < 4; ++j) o8[64 * j] = (unsigned long long)pk2(v[j].x, v[j].y) | ((unsigned long long)pk2(v[j].z, v[j].w) << 32);
    if (lane < 16) ssq16[lane] = lane == 0 ? s : 0.f;
}
__device__ __forceinline__ void norm_row_f32(float* xrow, const float* gain, int lane) {
    f32x4* xr = (f32x4*)xrow + lane; const f32x4* gr = (const f32x4*)gain + lane;
    f32x4 v[4]; float s = 0.f;
#pragma unroll
    for (int j = 0; j < 4; ++j) { v[j] = xr[64 * j]; s += (v[j].x * v[j].x + v[j].y * v[j].y) + (v[j].z * v[j].z + v[j].w * v[j].w); }
    const float r = 1.0f / sqrtf(wave_sum(s) * (1.f / DM) + EPS);
#pragma unroll
    for (int j = 0; j < 4; ++j) { const f32x4 g = gr[64 * j]; xr[64 * j] = v[j] * r * g; }
}
__device__ __forceinline__ unsigned f2o(float s) { const unsigned b = __float_as_uint(s); return (b & 0x80000000u) ? ~b : (b | 0x80000000u); }
__device__ __forceinline__ void unpack8(const v4u v, float* f) { f[0] = bflo(v.x); f[1] = bfhi(v.x); f[2] = bflo(v.y); f[3] = bfhi(v.y); f[4] = bflo(v.z); f[5] = bfhi(v.z); f[6] = bflo(v.w); f[7] = bfhi(v.w); }
__device__ __forceinline__ void load_row64(const bf16* p, float* f) {
    const v4u* q = (const v4u*)p;
#pragma unroll
    for (int i = 0; i < 8; ++i) unpack8(q[i], f + 8 * i);
}
__device__ __forceinline__ float dot64(const LAS float* q, const float* k) {
    float d = 0.f;
#pragma unroll
    for (int i = 0; i < 16; ++i) { const f32x4 qq = *(const LAS f32x4*)(q + 4 * i); d += qq.x * k[4 * i] + qq.y * k[4 * i + 1] + qq.z * k[4 * i + 2] + qq.w * k[4 * i + 3]; }
    return d;
}
__device__ __forceinline__ void dsa_query(const Args& P, unsigned char* ws, int z, int row, LAS unsigned char* wl, int lane) {
    const int b = row >> 12, t = row & (SEQ - 1), n = t + 1;
    LAS unsigned* su = (LAS unsigned*)wl; LAS float* pb = (LAS float*)wl; LAS unsigned short* list = (LAS unsigned short*)(wl + 16384); LAS float* qb = (LAS float*)(wl + 16896);
    const bf16* misc = (const bf16*)(ws + WS_MISC);
    const unsigned long long lt = (1ull << lane) - 1ull;
    int nsel;
    if (n <= 256) { for (int i = lane; i < n; i += 64) list[i] = (unsigned short)i; nsel = n; }
    else {
        { const uint2 v = *(const uint2*)((const bf16*)(ws + WS_IQ) + (size_t)row * 256 + lane * 4); qb[lane * 4] = bflo(v.x); qb[lane * 4 + 1] = bfhi(v.x); qb[lane * 4 + 2] = bflo(v.y); qb[lane * 4 + 3] = bfhi(v.y); }
        float iw[4]; { const uint2 v = *(const uint2*)(misc + (size_t)row * 256 + 192); iw[0] = 0.5f * bflo(v.x); iw[1] = 0.5f * bfhi(v.x); iw[2] = 0.5f * bflo(v.y); iw[3] = 0.5f * bfhi(v.y); }
        WAVE_LDS_SYNC();
        const int nch = (n + 63) >> 6;
        for (int i = 0; i < nch; ++i) {
            const int key = i * 64 + lane; const bool valid = key <= t;
            float kf[64]; load_row64(misc + (size_t)(b * SEQ + (valid ? key : t)) * 256, kf);
            float s = 0.f;
#pragma unroll
            for (int h = 0; h < 4; ++h) s += iw[h] * fmaxf(dot64(qb + h * 64, kf), 0.f);
            su[key] = valid ? f2o(s) : 0u;
        }
        WAVE_LDS_SYNC();
        unsigned prefix = 0u;
        for (int bit = 31; bit >= 0; --bit) {
            const unsigned cand = prefix | (1u << bit); int c = 0;
            for (int i = 0; i < nch; ++i) c += (su[i * 64 + lane] >= cand) ? 1 : 0;
            c = wave_sum_i(c);
            if (c >= 256) prefix = cand;
            if (c == 256) break;
        }
        int cgt = 0;
        for (int i = 0; i < nch; ++i) cgt += (su[i * 64 + lane] > prefix) ? 1 : 0;
        const int need_eq = 256 - wave_sum_i(cgt);
        int base = 0, eq_taken = 0;
        for (int i = 0; i < nch; ++i) {
            const unsigned v = su[i * 64 + lane]; const bool gt = v > prefix, eq = v == prefix;
            const unsigned long long meq = __ballot(eq);
            const bool sel = gt || (eq && (eq_taken + __popcll(meq & lt)) < need_eq);
            const unsigned long long ms = __ballot(sel);
            if (sel) list[base + __popcll(ms & lt)] = (unsigned short)(i * 64 + lane);
            base += __popcll(ms); eq_taken += __popcll(meq);
        }
        nsel = 256;
    }
    { const v4u v = *(const v4u*)((const bf16*)(ws + WS_QA) + (size_t)row * 512 + lane * 8); float f[8]; unpack8(v, f);
#pragma unroll
      for (int e = 0; e < 8; ++e) qb[lane * 8 + e] = f[e]; }
    WAVE_LDS_SYNC();
    const bf16* kva = (const bf16*)(ws + WS_KVA);
    float s[8][4];
#pragma unroll
    for (int j = 0; j < 4; ++j) {
        const int slot = lane + 64 * j; const bool valid = slot < nsel; const int key = list[valid ? slot : 0];
        float kf[64]; load_row64(kva + (size_t)(b * SEQ + key) * 128, kf);
#pragma unroll
        for (int h = 0; h < 8; ++h) s[h][j] = valid ? dot64(qb + h * 64, kf) : NEGF;
    }
    float linv[8];
#pragma unroll
    for (int h = 0; h < 8; ++h) {
        const float m = wave_max(fmaxf(fmaxf(s[h][0], s[h][1]), fmaxf(s[h][2], s[h][3]))); float ls = 0.f;
#pragma unroll
        for (int j = 0; j < 4; ++j) { const float p = __expf(s[h][j] - m); ls += p; pb[h * 256 + lane + 64 * j] = p; }
        linv[h] = 1.0f / wave_sum(ls);
    }
    WAVE_LDS_SYNC();
    float acc[8] = {0.f, 0.f, 0.f, 0.f, 0.f, 0.f, 0.f, 0.f};
    for (int slot = 0; slot < nsel; ++slot) {
        const float v = bf2f(kva[(size_t)(b * SEQ + list[slot]) * 128 + 64 + lane]);
#pragma unroll
        for (int h = 0; h < 8; ++h) acc[h] += pb[h * 256 + slot] * v;
    }
    bf16* ya = (bf16*)(ws + WS_QA) + (size_t)row * 512;
#pragma unroll
    for (int h = 0; h < 8; ++h) ya[h * 64 + lane] = (bf16)f2bf(acc[h] * linv[h]);
    WAVE_LDS_SYNC();
}
typedef short s16x4 __attribute__((ext_vector_type(4)));
typedef short v4i16_t __attribute__((ext_vector_type(4)));
typedef float f32x4v __attribute__((ext_vector_type(4)));
typedef __bf16 bf16x2_t __attribute__((ext_vector_type(2)));
typedef float f32x2_t __attribute__((ext_vector_type(2)));
__device__ __forceinline__ unsigned cvtpk(float lo, float hi) { f32x2_t v = {lo, hi}; bf16x2_t b = __builtin_convertvector(v, bf16x2_t); return __builtin_bit_cast(unsigned, b); }
constexpr float L2E = 1.4426950408889634f;
#ifndef NSA_NOSKIP
#define NSA_NOSKIP 0
#endif
constexpr int NSA_KSTR = 72, NSA_VSTR = 80;
constexpr int NSA_KB = 64 * NSA_KSTR * 2, NSA_VB = 64 * NSA_VSTR * 2;
constexpr int NSA_D = 6, NSA_SLOT = 16384;
constexpr int NSA_OFF_RING = 0, NSA_OFF_IMPA = 0  , NSA_OFF_IMPB = NSA_OFF_IMPA + 64 * 65 * 4, NSA_OFF_UM = NSA_D * NSA_SLOT, NSA_OFF_QM = NSA_OFF_UM + 64, NSA_OFF_ST = NSA_OFF_UM + 1024, NSA_LDS = NSA_OFF_ST + 512 * 64;
__device__ __forceinline__ s16x4 tr16(const LAS unsigned char* p) { return __builtin_bit_cast(s16x4, __builtin_amdgcn_ds_read_tr16_b64_v4i16((LAS v4i16_t*)p)); }
__device__ __forceinline__ bf16x8 cat4(s16x4 a, s16x4 b) { return __builtin_shufflevector(a, b, 0, 1, 2, 3, 4, 5, 6, 7); }
__device__ __forceinline__ bf16x8 pack8(float a0, float a1, float a2, float a3, float b0, float b1, float b2, float b3) {
    v4u w; w.x = pg8::cvt_pk_bf16(a0, a1); w.y = pg8::cvt_pk_bf16(a2, a3); w.z = pg8::cvt_pk_bf16(b0, b1); w.w = pg8::cvt_pk_bf16(b2, b3); return __builtin_bit_cast(bf16x8, w);
}
__device__ __forceinline__ float xmax16(float v) { v = fmaxf(v, __shfl_xor(v, 16)); return fmaxf(v, __shfl_xor(v, 32)); }
__device__ __forceinline__ float xsum16(float v) { v += __shfl_xor(v, 16); return v + __shfl_xor(v, 32); }

__device__ __forceinline__ void nsa_fetch(const bf16* kv, int b, int jb, int g, int tid, v4u& kr, v4u& vr) {
    const bf16* p = kv + (size_t)(b * SEQ + 64 * jb + (tid >> 3)) * 256 + g * 64 + (tid & 7) * 8;
    kr = *(const v4u*)p; vr = *(const v4u*)(p + 128);
}
__device__ __forceinline__ void nsa_stash(LAS unsigned char* Kb, LAS unsigned char* Vb, int tid, const v4u& kr, const v4u& vr) {
    *(LAS v4u*)(Kb + ((tid >> 3) * NSA_KSTR + (tid & 7) * 8) * 2) = kr; *(LAS v4u*)(Vb + ((tid >> 3) * NSA_VSTR + (tid & 7) * 8) * 2) = vr;
}
template <bool FULL>
__device__ __forceinline__ void nsa_block2(const LAS unsigned char* Kb, const LAS unsigned char* Vb, const bf16x8 (&qf)[2][2], const bool (&sel)[2], const int (&klo)[2], const int (&khi)[2],
                                           float (&mrow)[2], float (&lrow)[2], f32x4v (&o)[2][4], int lane) {
    const int j = lane & 15, gq = lane >> 4;
    f32x4v s[2][4];
#pragma unroll
    for (int kt = 0; kt < 4; ++kt) {
        s[0][kt] = (f32x4v){0.f, 0.f, 0.f, 0.f}; s[1][kt] = (f32x4v){0.f, 0.f, 0.f, 0.f};
#pragma unroll
        for (int ks = 0; ks < 2; ++ks) {
            const bf16x8 kf = *(const LAS bf16x8*)(Kb + (16 * kt + j) * 128 + (((gq + 4 * ks) ^ (j & 7)) << 4));
            s[0][kt] = __builtin_amdgcn_mfma_f32_16x16x32_bf16(kf, qf[0][ks], s[0][kt], 0, 0, 0);
            s[1][kt] = __builtin_amdgcn_mfma_f32_16x16x32_bf16(kf, qf[1][ks], s[1][kt], 0, 0, 0);
        }
    }
#pragma unroll
    for (int rg = 0; rg < 2; ++rg) {
        float bm = NEGF;
        if (FULL) { const float bias = sel[rg] ? 0.f : NEGF;
#pragma unroll
            for (int kt = 0; kt < 4; ++kt)
#pragma unroll
                for (int e = 0; e < 4; ++e) { const float v = s[rg][kt][e] + bias; s[rg][kt][e] = v; bm = fmaxf(bm, v); }
        } else {
#pragma unroll
            for (int kt = 0; kt < 4; ++kt)
#pragma unroll
                for (int e = 0; e < 4; ++e) { const int ko = 16 * kt + 4 * gq + e; const bool ok = sel[rg] && ko >= klo[rg] && ko <= khi[rg]; const float v = ok ? s[rg][kt][e] : NEGF; s[rg][kt][e] = v; bm = fmaxf(bm, v); }
        }
        bm = xmax16(bm);
        const float mnew = fmaxf(mrow[rg], bm), alpha = __builtin_amdgcn_exp2f(mrow[rg] - mnew);
        const bool moved = __builtin_amdgcn_ballot_w64(mnew != mrow[rg]) != 0ull;
        mrow[rg] = mnew;
        float ps = 0.f;
#pragma unroll
        for (int kt = 0; kt < 4; ++kt)
#pragma unroll
            for (int e = 0; e < 4; ++e) { const float p = __builtin_amdgcn_exp2f(s[rg][kt][e] - mnew); s[rg][kt][e] = p; ps += p; }
        lrow[rg] = lrow[rg] * alpha + ps;
        if (moved) {
#pragma unroll
            for (int dt = 0; dt < 4; ++dt) o[rg][dt] *= alpha;
        }
    }
#pragma unroll
    for (int kk = 0; kk < 2; ++kk) {
        const bf16x8 pf0 = pack8(s[0][2 * kk][0], s[0][2 * kk][1], s[0][2 * kk][2], s[0][2 * kk][3], s[0][2 * kk + 1][0], s[0][2 * kk + 1][1], s[0][2 * kk + 1][2], s[0][2 * kk + 1][3]);
        const bf16x8 pf1 = pack8(s[1][2 * kk][0], s[1][2 * kk][1], s[1][2 * kk][2], s[1][2 * kk][3], s[1][2 * kk + 1][0], s[1][2 * kk + 1][1], s[1][2 * kk + 1][2], s[1][2 * kk + 1][3]);
#pragma unroll
        for (int dt = 0; dt < 4; ++dt) {
            const LAS unsigned char* va = Vb + (32 * kk + 4 * gq + (j >> 2)) * 128 + (16 * dt + 4 * (j & 3)) * 2;
            const bf16x8 vf = cat4(tr16(va), tr16(va + 16 * 128));
            o[0][dt] = __builtin_amdgcn_mfma_f32_16x16x32_bf16(vf, pf0, o[0][dt], 0, 0, 0);
            o[1][dt] = __builtin_amdgcn_mfma_f32_16x16x32_bf16(vf, pf1, o[1][dt], 0, 0, 0);
        }
        }
}
__device__ __forceinline__ void glds16(const void* gsrc, unsigned lds_dst) { unsigned keep;
    asm volatile("s_mov_b32 %0, m0\n\ts_mov_b32 m0, %2\n\ts_nop 0\n\tglobal_load_lds_dwordx4 %1, off\n\ts_mov_b32 m0, %0" : "=&s"(keep) : "v"(gsrc), "s"(lds_dst) : "memory"); }
template <int MODE>
__device__ __forceinline__ void nsa_attend(const bf16* kv, unsigned long long mask, int b, int g, int c, int tid, int lane, LAS unsigned char* ring, const bf16x8 (&qf)[2][2],
                                           const unsigned long long (&rmask)[2], const unsigned long long (&gmask)[2], const int (&trow)[2], float (&mrow)[2], float (&lrow)[2], f32x4v (&o)[2][4]) {
    const int wave = __builtin_amdgcn_readfirstlane(tid >> 6);
    const int rr = 8 * wave + (lane >> 3);
    const bf16* gk = kv + (size_t)(b * SEQ + rr) * 256 + g * 64 + (((lane & 7) ^ (rr & 7)) << 3);
    const bf16* gv = kv + (size_t)(b * SEQ + rr) * 256 + 128 + g * 64 + ((lane & 7) << 3);
    const unsigned ring0 = (unsigned)(uintptr_t)(unsigned char*)ring + wave * 1024;
#define NSA_ISSUE(jb_, slot_) do { glds16(gk + (size_t)(jb_) * 64 * 256, (unsigned)__builtin_amdgcn_readfirstlane(ring0 + (slot_) * NSA_SLOT)); \
                                   glds16(gv + (size_t)(jb_) * 64 * 256, (unsigned)__builtin_amdgcn_readfirstlane(ring0 + (slot_) * NSA_SLOT + 8192)); } while (0)
    unsigned long long remi = mask, remc = mask; int lastb = 0, si = 0, sc_ = 0;
#pragma unroll
    for (int d = 0; d < NSA_D - 1; ++d) { if (remi) { lastb = (int)__builtin_ctzll(remi); remi &= remi - 1ull; } NSA_ISSUE(lastb, si); si = si + 1 == NSA_D ? 0 : si + 1; }
    while (remc) {
        const int jj = (int)__builtin_ctzll(remc); remc &= remc - 1ull;
        asm volatile("s_waitcnt vmcnt(8) lgkmcnt(0)\n\ts_barrier" ::: "memory");
        if (remi) { lastb = (int)__builtin_ctzll(remi); remi &= remi - 1ull; }
        NSA_ISSUE(lastb, si); si = si + 1 == NSA_D ? 0 : si + 1;
        const LAS unsigned char* kb_ = ring + sc_ * NSA_SLOT; const LAS unsigned char* vb_ = kb_ + 8192; sc_ = sc_ + 1 == NSA_D ? 0 : sc_ + 1;
        bool sel[2]; int klo[2], khi[2]; bool act[2];
#pragma unroll
        for (int rg = 0; rg < 2; ++rg) { const int o6 = trow[rg] & 63;
            if (MODE == 0) { sel[rg] = (rmask[rg] >> jj) & 1ull; act[rg] = (gmask[rg] >> jj) & 1ull; klo[rg] = 0; khi[rg] = (jj == c) ? o6 : 63; }
            else { sel[rg] = true; act[rg] = true; klo[rg] = (jj == c - 4) ? o6 + 1 : 0; khi[rg] = (jj == c) ? o6 : 63; } }
        if (act[0] || act[1]) {
            const bool full = (MODE == 0) ? (jj != c) : (jj != c && jj != c - 4);
            if (full) nsa_block2<true>(kb_, vb_, qf, sel, klo, khi, mrow, lrow, o, lane); else nsa_block2<false>(kb_, vb_, qf, sel, klo, khi, mrow, lrow, o, lane);
        }
    }
    asm volatile("s_waitcnt vmcnt(0) lgkmcnt(0)\n\ts_barrier" ::: "memory");
#undef NSA_ISSUE
}
#if defined(PROBE_CMP)
__device__ __forceinline__ void nsa_probe_store(unsigned char* ws, int row, int head, int gq, const f32x4v (&v)[4]) {
    bf16* pb_ = (bf16*)(ws + 497 * MiB);
    for (int dt = 0; dt < 4; ++dt) { uint2 w; w.x = cvtpk(v[dt][0], v[dt][1]); w.y = cvtpk(v[dt][2], v[dt][3]); *(uint2*)(pb_ + (size_t)row * 512 + head * 64 + 16 * dt + 4 * gq) = w; }
}
#endif
__device__ __forceinline__ void nsa_unit(unsigned char* ws, int unit, LAS unsigned char* lds, int tid_in, bf16* yout) {
    int tid = tid_in; asm volatile("" : "+v"(tid));
    const int lane = tid & 63, wave = __builtin_amdgcn_readfirstlane(tid >> 6), j = lane & 15, gq = lane >> 4;
    const int c = unit & 63, g = (unit >> 6) & 1, b = unit >> 7, bg = b * 2 + g;
    LAS float* impa = (LAS float*)(lds + NSA_OFF_IMPA); LAS float* impb = (LAS float*)(lds + NSA_OFF_IMPB);
    LAS unsigned long long* um = (LAS unsigned long long*)(lds + NSA_OFF_UM);
    for (int i = tid; i < 2 * 64 * 65; i += 512) impa[i] = 0.f;
    bf16* qc = (bf16*)(ws + WS_QC);
    const bf16* misc = (const bf16*)(ws + WS_MISC);
    bf16x8 qf[2][2]; float gate[2][3]; int trow[2];
#pragma unroll
    for (int rg = 0; rg < 2; ++rg) {
        const int q = 8 * wave + 4 * rg + (j >> 2), t = 64 * c + q, row = b * SEQ + t, head = g * 4 + (j & 3);
        trow[rg] = t;
#pragma unroll
        for (int ks = 0; ks < 2; ++ks) qf[rg][ks] = *(const bf16x8*)(qc + (size_t)row * 512 + head * 64 + 8 * gq + 32 * ks);
#pragma unroll
        for (int e = 0; e < 3; ++e) gate[rg][e] = __builtin_amdgcn_rcpf(1.0f + __expf(-bf2f(misc[(size_t)row * 256 + 196 + head * 3 + e])));
    }
    typedef unsigned u32x2v __attribute__((ext_vector_type(2)));
    LAS u32x2v* stash = (LAS u32x2v*)(lds + NSA_OFF_ST) + tid * 8;
    __syncthreads();
    const int nT = (c >> 2) + 1;
    const bf16* kc = (const bf16*)(ws + WS_KC) + (size_t)bg * 256 * 64; const bf16* vct = (const bf16*)(ws + WS_VC) + (size_t)bg * 64 * 256;
#pragma unroll
    for (int rg = 0; rg < 2; ++rg) {
        const int t = trow[rg], nv = t >= 31 ? ((t - 15) >> 4) : 0;
        f32x4v s[16]; float mx = NEGF;
#pragma unroll
        for (int T = 0; T < 16; ++T) {
            s[T] = (f32x4v){0.f, 0.f, 0.f, 0.f};
            if (T < nT) {
#pragma unroll
                for (int ks = 0; ks < 2; ++ks) { const bf16x8 kf = *(const bf16x8*)(kc + (size_t)(16 * T + j) * 64 + 8 * gq + 32 * ks); s[T] = __builtin_amdgcn_mfma_f32_16x16x32_bf16(kf, qf[rg][ks], s[T], 0, 0, 0); }
#pragma unroll
                for (int e = 0; e < 4; ++e) { const float v = (16 * T + 4 * gq + e < nv) ? s[T][e] : NEGF; s[T][e] = v; mx = fmaxf(mx, v); }
            }
        }
        mx = xmax16(mx);
        float ls = 0.f;
#pragma unroll
        for (int T = 0; T < 16; ++T) if (T < nT) {
#pragma unroll
            for (int e = 0; e < 4; ++e) { const float p = (16 * T + 4 * gq + e < nv) ? __builtin_amdgcn_exp2f(s[T][e] - mx) : 0.f; s[T][e] = p; ls += p; }
        }
        ls = xsum16(ls);
        const float inv = nv > 0 ? __builtin_amdgcn_rcpf(ls) : 0.f;
        const int q = 8 * wave + 4 * rg + (j >> 2);
#pragma unroll
        for (int T = 0; T < 16; ++T) if (T < nT) {
#pragma unroll
            for (int e = 0; e < 4; ++e) s[T][e] *= inv;
            float a = s[T][0] + s[T][1] + s[T][2] + 0.5f * s[T][3], bb = 0.5f * s[T][3];
            a += __shfl_xor(a, 1); a += __shfl_xor(a, 2); bb += __shfl_xor(bb, 1); bb += __shfl_xor(bb, 2);
            if ((j & 3) == 0) { impa[q * 65 + 4 * T + gq] = a; impb[q * 65 + 4 * T + gq + 1] = bb; }
        }
        f32x4v oc[4];
#pragma unroll
        for (int dt = 0; dt < 4; ++dt) oc[dt] = (f32x4v){0.f, 0.f, 0.f, 0.f};
#pragma unroll
        for (int kk = 0; kk < 8; ++kk) if (2 * kk < nT) {
            const bf16x8 pf = pack8(s[2 * kk][0], s[2 * kk][1], s[2 * kk][2], s[2 * kk][3], s[2 * kk + 1][0], s[2 * kk + 1][1], s[2 * kk + 1][2], s[2 * kk + 1][3]);
#pragma unroll
            for (int dt = 0; dt < 4; ++dt) {
                const bf16* vp = vct + (size_t)(16 * dt + j) * 256 + 32 * kk + 4 * gq;
                const s16x4 v0 = *(const s16x4*)vp, v1 = *(const s16x4*)(vp + 16);
                oc[dt] = __builtin_amdgcn_mfma_f32_16x16x32_bf16(cat4(v0, v1), pf, oc[dt], 0, 0, 0);
            }
        }
#pragma unroll
        for (int dt = 0; dt < 4; ++dt) { const f32x4v v = oc[dt] * gate[rg][0]; u32x2v w; w.x = pg8::cvt_pk_bf16(v[0], v[1]); w.y = pg8::cvt_pk_bf16(v[2], v[3]); stash[rg * 4 + dt] = w; }
        __builtin_amdgcn_sched_barrier(0);
    }
    __syncthreads();
    unsigned long long smask[8], mymask = 0ull;
#pragma unroll
    for (int qi = 0; qi < 8; ++qi) {
        const int q = 8 * wave + qi;
#if PROBE == 4
        const float imp = ((const float*)(ws + 500 * MiB))[((size_t)(b * SEQ + 64 * c + q) * 2 + g) * 64 + lane];
#else
        const float imp = impa[q * 65 + lane] + impb[q * 65 + lane];
#endif
#if PROBE && (PROBE != 5 || defined(PROBE5_IMP))
        ((float*)(ws + 516 * MiB))[((size_t)(b * SEQ + 64 * c + q) * 2 + g) * 64 + lane] = (lane <= c) ? imp : 0.f;
#endif
        const bool forced = (lane == 0) || (lane == c), adm = lane <= c;
        unsigned key = forced ? (0xFFFFFF00u | (unsigned)(63 - lane)) : (adm ? ((__float_as_uint(imp) & 0xFFFFFFC0u) | (unsigned)(63 - lane)) : 0u);
        unsigned long long mk = 0ull;
#if TOP8_RANK
        { int rank = 0;
#pragma unroll
          for (int jj = 0; jj < 64; ++jj) { const unsigned kk = (unsigned)__builtin_amdgcn_readlane((int)key, jj); rank += (kk > key) ? 1 : 0; }
          mk = __ballot(key != 0u && rank < 8); }
#else
        for (int k = 0; k < 8; ++k) { const unsigned mx = wave_max_u(key); if (mx == 0u) break; const int win = 63 - (int)(mx & 63u); mk |= 1ull << win; if (lane == win) key = 0u; }
#endif
        mk = ((unsigned long long)__builtin_amdgcn_readfirstlane((unsigned)(mk >> 32)) << 32) | (unsigned long long)__builtin_amdgcn_readfirstlane((unsigned)mk);
#ifdef FIXSEL
        { mk = 1ull | (1ull << c); for (int d = 1; d <= 6; ++d) mk |= 1ull << (((FIXHOM ? 0 : q * 7) + d * 5) % (c + 1)); }
#endif
#if PROBE == 2
        mk = ((const unsigned long long*)(ws + 496 * MiB))[(size_t)(b * SEQ + 64 * c + q) * 2 + g];
        mk = ((unsigned long long)__builtin_amdgcn_readfirstlane((unsigned)(mk >> 32)) << 32) | (unsigned long long)__builtin_amdgcn_readfirstlane((unsigned)mk);
#endif
#if PROBE == 5
        if (lane == 0) ((unsigned long long*)(ws + 498 * MiB))[(size_t)(b * SEQ + 64 * c + q) * 2 + g] = mk;
#endif
#if PROBE == 5 && !defined(PROBE5_IMP)
        ((float*)(ws + 516 * MiB))[((size_t)(b * SEQ + 64 * c + q) * 2 + g) * 64 + lane] = ((mk >> lane) & 1ull) ? 1.f : 0.f;
#endif
        smask[qi] = mk; mymask |= mk;
    }
    if (lane == 0) um[wave] = mymask;
    __syncthreads();
    unsigned long long umask = 0ull;
#pragma unroll
    for (int w = 0; w < 8; ++w) umask |= um[w];
    umask = ((unsigned long long)__builtin_amdgcn_readfirstlane((unsigned)(umask >> 32)) << 32) | (unsigned long long)__builtin_amdgcn_readfirstlane((unsigned)umask);
    unsigned long long rmask[2];
    { LAS unsigned long long* qm = (LAS unsigned long long*)(lds + NSA_OFF_QM);
      __syncthreads();
#pragma unroll
      for (int qi = 0; qi < 8; ++qi) if (lane == 0) qm[8 * wave + qi] = smask[qi];
      __syncthreads();
#pragma unroll
      for (int rg = 0; rg < 2; ++rg) rmask[rg] = qm[8 * wave + 4 * rg + (j >> 2)]; }
    const unsigned long long gmask[2] = {smask[0] | smask[1] | smask[2] | smask[3], smask[4] | smask[5] | smask[6] | smask[7]};
    const bf16* kvs = (const bf16*)(ws + WS_KVS); const bf16* kvw = (const bf16*)(ws + WS_KVW);
    LAS unsigned char* ring = lds + NSA_OFF_RING;
    {
        float mrow[2] = {NEGF, NEGF}, lrow[2] = {0.f, 0.f}; f32x4v o[2][4];
#pragma unroll
        for (int rg = 0; rg < 2; ++rg)
#pragma unroll
            for (int dt = 0; dt < 4; ++dt) o[rg][dt] = (f32x4v){0.f, 0.f, 0.f, 0.f};
        nsa_attend<0>(kvs, umask, b, g, c, tid, lane, ring, qf, rmask, gmask, trow, mrow, lrow, o);
#if DUP == 8
        { __syncthreads(); float m2[2] = {NEGF, NEGF}, l2[2] = {0.f, 0.f}; f32x4v o2[2][4];
          for (int rg = 0; rg < 2; ++rg) for (int dt = 0; dt < 4; ++dt) o2[rg][dt] = (f32x4v){0.f, 0.f, 0.f, 0.f};
          nsa_attend<0>(kvs, umask, b, g, c, tid, lane, Kb, Vb, qf, rmask, gmask, trow, m2, l2, o2);
          bf16* dmy = (bf16*)(ws + WS_BU) + (size_t)(b * SEQ + trow[0]) * 512 + (g * 4 + (j & 3)) * 64 + 4 * gq;
          for (int rg = 0; rg < 2; ++rg) for (int dt = 0; dt < 4; ++dt) { uint2 w; w.x = pg8::cvt_pk_bf16(o2[rg][dt][0] + l2[rg], o2[rg][dt][1]); w.y = pg8::cvt_pk_bf16(o2[rg][dt][2], o2[rg][dt][3]); *(uint2*)(dmy + 16 * dt) = w; } }
#endif
#pragma unroll
        for (int rg = 0; rg < 2; ++rg) { const float sc = gate[rg][1] * __builtin_amdgcn_rcpf(xsum16(lrow[rg]));
#pragma unroll
            for (int dt = 0; dt < 4; ++dt) { const u32x2v p = stash[rg * 4 + dt]; const f32x4v v = o[rg][dt] * sc; u32x2v w; w.x = pg8::cvt_pk_bf16(v[0] + bflo(p.x), v[1] + bfhi(p.x)); w.y = pg8::cvt_pk_bf16(v[2] + bflo(p.y), v[3] + bfhi(p.y)); stash[rg * 4 + dt] = w; }
            }
        __syncthreads();
    }
    {
        float mrow[2] = {NEGF, NEGF}, lrow[2] = {0.f, 0.f}; f32x4v o[2][4];
#pragma unroll
        for (int rg = 0; rg < 2; ++rg)
#pragma unroll
            for (int dt = 0; dt < 4; ++dt) o[rg][dt] = (f32x4v){0.f, 0.f, 0.f, 0.f};
        { const int j0 = c - 4 > 0 ? c - 4 : 0; const unsigned long long wmask = ((c == 63 ? ~0ull : ((1ull << (c + 1)) - 1ull)) >> j0) << j0;
          nsa_attend<1>(kvw, wmask, b, g, c, tid, lane, ring, qf, rmask, gmask, trow, mrow, lrow, o); }
#pragma unroll
        for (int rg = 0; rg < 2; ++rg) { const float sc = gate[rg][2] * __builtin_amdgcn_rcpf(xsum16(lrow[rg]));
#pragma unroll
            for (int dt = 0; dt < 4; ++dt) { const u32x2v p = stash[rg * 4 + dt]; const f32x4v v = o[rg][dt] * sc; uint2 w; w.x = pg8::cvt_pk_bf16(v[0] + bflo(p.x), v[1] + bfhi(p.x)); w.y = pg8::cvt_pk_bf16(v[2] + bflo(p.y), v[3] + bfhi(p.y));
                *(uint2*)(yout + (size_t)(b * SEQ + trow[rg]) * 512 + (g * 4 + (j & 3)) * 64 + 16 * dt + 4 * gq) = w; }
            }
    }
    __syncthreads();
}
__device__ __forceinline__ void prep_kva16(unsigned char* ws, int task, int lane) {
    const int j = lane & 15, gq = lane >> 4, row = task * 16 + j;
    const bf16* misc = (const bf16*)(ws + WS_MISC) + (size_t)row * 256 + 64;
    const bf16* wu = (const bf16*)(ws + WS_W + WO_UKV);
    bf16x8 cf[4]; float ss = 0.f;
#pragma unroll
    for (int ks = 0; ks < 4; ++ks) { const v4u v = *(const v4u*)(misc + 8 * gq + 32 * ks); cf[ks] = __builtin_bit_cast(bf16x8, v); float f[8]; unpack8(v, f);
#pragma unroll
        for (int e = 0; e < 8; ++e) ss += f[e] * f[e]; }
    ss = xsum16(ss);
    const float r = 1.0f / sqrtf(ss * (1.f / 128.f) + EPS);
    const float* rp = (const float*)(ws + WS_ROPE) + (size_t)row * 16;
    bf16* o = (bf16*)(ws + WS_KVA) + (size_t)row * 128;
#pragma unroll
    for (int ct = 0; ct < 8; ++ct) {
        f32x4v a = {0.f, 0.f, 0.f, 0.f};
#pragma unroll
        for (int ks = 0; ks < 4; ++ks) { const bf16x8 wf = *(const bf16x8*)(wu + (size_t)(16 * ct + j) * 128 + 8 * gq + 32 * ks); a = __builtin_amdgcn_mfma_f32_16x16x32_bf16(wf, cf[ks], a, 0, 0, 0); }
        a *= r;
        if (ct == 0) {
            const float c0 = rp[2 * gq], s0 = rp[8 + 2 * gq], c1 = rp[2 * gq + 1], s1 = rp[8 + 2 * gq + 1];
            const float x0 = a[0], x1 = a[1], x2 = a[2], x3 = a[3];
            a[0] = x0 * c0 - x1 * s0; a[1] = x1 * c0 + x0 * s0; a[2] = x2 * c1 - x3 * s1; a[3] = x3 * c1 + x2 * s1;
        }
        uint2 w; w.x = cvtpk(a[0], a[1]); w.y = cvtpk(a[2], a[3]);
        *(uint2*)(o + 16 * ct + 4 * gq) = w;
    }
}
__device__ __forceinline__ void prep_pool16(unsigned char* ws, int task, int lane) {
    const int j = lane & 15, gq = lane >> 4, row = task * 16 + j, t = row & (SEQ - 1);
    const bf16* bu = (const bf16*)(ws + WS_BU);
    const bf16* pw = (const bf16*)(ws + WS_W + WO_POOL);
    bf16* yb = (bf16*)(ws + WS_YB) + (size_t)row * 512;
#pragma unroll 1
    for (int g = 0; g < 4; ++g) {
        const int w = 2 << g, lo = (t + 1 - w) > 0 ? (t + 1 - w) : 0, cnt = t + 1 - lo; const float inv = 1.0f / (float)cnt;
        bf16x8 pf[4];
#pragma unroll
        for (int ks = 0; ks < 4; ++ks) {
            const bf16* p = bu + (size_t)row * 512 + g * 128 + 8 * gq + 32 * ks;
            float sum[8] = {0.f, 0.f, 0.f, 0.f, 0.f, 0.f, 0.f, 0.f}, cur[8];
            { const v4u v = *(const v4u*)p; unpack8(v, cur);
#pragma unroll
              for (int e = 0; e < 8; ++e) sum[e] = cur[e]; }
#pragma unroll 2
            for (int i = 1; i < w; ++i) { const bool ok = i < cnt; const v4u v = *(const v4u*)(p - (size_t)(ok ? i : 0) * 512); float f[8]; unpack8(v, f);
#pragma unroll
                for (int e = 0; e < 8; ++e) sum[e] += ok ? f[e] : 0.f; }
            __builtin_amdgcn_sched_barrier(0);
            pf[ks] = pack8(sum[0] * inv - cur[0], sum[1] * inv - cur[1], sum[2] * inv - cur[2], sum[3] * inv - cur[3], sum[4] * inv - cur[4], sum[5] * inv - cur[5], sum[6] * inv - cur[6], sum[7] * inv - cur[7]);
        }
#pragma unroll
        for (int dt = 0; dt < 8; ++dt) {
            f32x4v a = {0.f, 0.f, 0.f, 0.f};
#pragma unroll
            for (int ks = 0; ks < 4; ++ks) {
#if POOLDBG == 1
                bf16x8 wf; for (int e = 0; e < 8; ++e) wf[e] = (short)0x3c00;
#else
                const bf16x8 wf = *(const bf16x8*)(pw + (size_t)(g * 128 + 16 * dt + j) * 128 + 8 * gq + 32 * ks);
#endif
#if POOLDBG == 2
                bf16x8 pz; for (int e = 0; e < 8; ++e) pz[e] = (short)0x3c00; a = __builtin_amdgcn_mfma_f32_16x16x32_bf16(wf, pz, a, 0, 0, 0);
#else
                a = __builtin_amdgcn_mfma_f32_16x16x32_bf16(wf, pf[ks], a, 0, 0, 0);
#endif
            }
            uint2 wv; wv.x = cvtpk(a[0], a[1]); wv.y = cvtpk(a[2], a[3]);
            *(uint2*)(yb + g * 128 + 16 * dt + 4 * gq) = wv;
        }
    }
}
__device__ __forceinline__ float gelu_tanh_f(float x) { const float u = 0.7978845608028654f * (x + 0.044715f * x * x * x); const float e = __expf(2.0f * u); return 0.5f * x * (1.0f + (1.0f - 2.0f / (e + 1.0f))); }
__device__ __forceinline__ void prep_cmp16(unsigned char* ws, int task, int lane) {
    const int j = lane & 15, gq = lane >> 4;
    const int i0 = (task & 15) * 16, bg = (task >> 4) & 15, br = task >> 8, b = bg >> 1, g = bg & 1, i = i0 + j;
    const bf16* kvc = (const bf16*)(ws + WS_KVC);
    const bf16* w1 = (const bf16*)(ws + WS_W + WO_CW1) + (size_t)br * 128 * 2048;
    const bf16* w2 = (const bf16*)(ws + WS_W + WO_CW2) + (size_t)br * 64 * 128;
    const float* posb = (const float*)(ws + WS_W + WO_POSB) + br * 128;
    f32x4v h[8];
#pragma unroll
    for (int nt = 0; nt < 8; ++nt) h[nt] = (f32x4v){0.f, 0.f, 0.f, 0.f};
#pragma unroll 4
    for (int ks = 0; ks < 64; ++ks) {
        const int l = ks >> 1; int tok = 16 * i + l; tok = tok > SEQ - 1 ? SEQ - 1 : tok;
        const bf16x8 ff = *(const bf16x8*)(kvc + (size_t)(b * SEQ + tok) * 256 + br * 128 + g * 64 + 32 * (ks & 1) + 8 * gq);
#pragma unroll
        for (int nt = 0; nt < 8; ++nt) { const bf16x8 wf = *(const bf16x8*)(w1 + (size_t)(16 * nt + j) * 2048 + 32 * ks + 8 * gq); h[nt] = __builtin_amdgcn_mfma_f32_16x16x32_bf16(wf, ff, h[nt], 0, 0, 0); }
    }
#pragma unroll
    for (int nt = 0; nt < 8; ++nt) { const f32x4v pbv = *(const f32x4v*)(posb + 16 * nt + 4 * gq);
#pragma unroll
        for (int e = 0; e < 4; ++e) h[nt][e] = gelu_tanh_f(h[nt][e] + pbv[e]); }
    f32x4v o[4];
#pragma unroll
    for (int dt = 0; dt < 4; ++dt) o[dt] = (f32x4v){0.f, 0.f, 0.f, 0.f};
#pragma unroll
    for (int kk = 0; kk < 4; ++kk) {
        const bf16x8 hf = pack8(h[2 * kk][0], h[2 * kk][1], h[2 * kk][2], h[2 * kk][3], h[2 * kk + 1][0], h[2 * kk + 1][1], h[2 * kk + 1][2], h[2 * kk + 1][3]);
#pragma unroll
        for (int dt = 0; dt < 4; ++dt) { const bf16* wp = w2 + (size_t)(16 * dt + j) * 128 + 32 * kk + 4 * gq; const s16x4 v0 = *(const s16x4*)wp, v1 = *(const s16x4*)(wp + 16);
            o[dt] = __builtin_amdgcn_mfma_f32_16x16x32_bf16(cat4(v0, v1), hf, o[dt], 0, 0, 0); }
    }
    const bool dead = i == 255;
    if (br == 0) { bf16* kc = (bf16*)(ws + WS_KC) + ((size_t)bg * 256 + i) * 64;
#pragma unroll
        for (int dt = 0; dt < 4; ++dt) { uint2 w; w.x = dead ? 0u : cvtpk(o[dt][0], o[dt][1]); w.y = dead ? 0u : cvtpk(o[dt][2], o[dt][3]); *(uint2*)(kc + 16 * dt + 4 * gq) = w; }
    } else { bf16* vct = (bf16*)(ws + WS_VC) + (size_t)bg * 64 * 256 + i;
#pragma unroll
        for (int dt = 0; dt < 4; ++dt)
#pragma unroll
            for (int e = 0; e < 4; ++e) vct[(size_t)(16 * dt + 4 * gq + e) * 256] = dead ? (bf16)0 : (bf16)f2bf(o[dt][e]);
    }
}
__device__ __forceinline__ void phase_prep(const Args& P, unsigned char* ws, int z, int l, LAS unsigned char* lds, int gw, int NGW, int lane, int wave) {
    asm volatile("" : "+v"(lane)); lane &= 63; asm volatile("" : "+s"(gw), "+s"(NGW));
    for (int it = gw; it < 512; it += NGW) prep_cmp16(ws, it, lane);
    for (int it = gw; it < M / 16; it += NGW) { prep_kva16(ws, it, lane); prep_pool16(ws, it, lane); }
}
constexpr int DSA_K = 12, DSA_S = 32 - DSA_K, DSA_CAP = 256;
constexpr int DSA_OFF_CNT = 0, DSA_OFF_PC = 3072, DSA_OFF_LIST = DSA_OFF_PC + 32 * 16 * 4, DSA_OFF_V = DSA_OFF_LIST + 16 * 256 * 2, DSA_VB = 64 * NSA_VSTR * 2, DSA_LDS = DSA_OFF_V + 8 * DSA_VB;
#define DSA_FOR_TILES(...) _Pragma("unroll") for (int G8 = 0; G8 < 4; ++G8) { if (G8 < ngrp) { _Pragma("unroll") for (int T8 = 0; T8 < 8; ++T8) { const int T = G8 * 8 + T8; __VA_ARGS__ } } }
__device__ __forceinline__ void cnt_ge(int& c, unsigned u, unsigned cand) { asm volatile("v_cmp_ge_u32_e32 vcc, %1, %2\n\tv_addc_co_u32_e32 %0, vcc, 0, %0, vcc" : "+v"(c) : "v"(u), "v"(cand) : "vcc"); }
__device__ __forceinline__ void cnt_gt(int& c, unsigned u, unsigned cand) { asm volatile("v_cmp_gt_u32_e32 vcc, %1, %2\n\tv_addc_co_u32_e32 %0, vcc, 0, %0, vcc" : "+v"(c) : "v"(u), "v"(cand) : "vcc"); }
__device__ __forceinline__ void cnt_le(int& c, unsigned u, unsigned cand) { asm volatile("v_cmp_le_u32_e32 vcc, %1, %2\n\tv_addc_co_u32_e32 %0, vcc, 0, %0, vcc" : "+v"(c) : "v"(u), "v"(cand) : "vcc"); }
__device__ __forceinline__ int dsa_total(LAS unsigned* cnt, int par, int wave, int j, int gq, int c) {
    c += __shfl_xor(c, 16); c += __shfl_xor(c, 32);
    if (gq == 0) cnt[(par * 8 + wave) * 16 + j] = (unsigned)c;
    __syncthreads();
    int tot = 0;
#pragma unroll
    for (int w = 0; w < 8; ++w) tot += (int)cnt[(par * 8 + w) * 16 + j];
    return tot;
}
__device__ __forceinline__ void dsa_unit(unsigned char* ws, int unit, LAS unsigned char* lds, int tid_in, bf16* yout) {
    int tid = tid_in; asm volatile("" : "+v"(tid));
    const int lane = tid & 63, wave = __builtin_amdgcn_readfirstlane(tid >> 6), j = lane & 15, gq = lane >> 4;
    const int b = unit >> 8, q0 = (unit & 255) * 16, t = q0 + j, row = b * SEQ + t;
    LAS unsigned* cnt = (LAS unsigned*)(lds + DSA_OFF_CNT); LAS unsigned* pc = (LAS unsigned*)(lds + DSA_OFF_PC);
    LAS unsigned short* list = (LAS unsigned short*)(lds + DSA_OFF_LIST);
    const bf16* misc = (const bf16*)(ws + WS_MISC);
    if (q0 >= 256) {
        const int ntiles = (q0 >> 4) + 1;
        const int ntl = wave < ntiles ? ((ntiles - 1 - wave) >> 3) + 1 : 0;
        const int ngrp = (ntl + 7) >> 3;
        bf16x8 qf[4][2]; float iw[4];
        { const bf16* iq = (const bf16*)(ws + WS_IQ) + (size_t)row * 256;
#pragma unroll
          for (int h = 0; h < 4; ++h) { iw[h] = 0.5f * bf2f(misc[(size_t)row * 256 + 192 + h]);
#pragma unroll
              for (int ks = 0; ks < 2; ++ks) qf[h][ks] = *(const bf16x8*)(iq + h * 64 + 8 * gq + 32 * ks); } }
        unsigned u[32][4];
#pragma unroll
        for (int T = 0; T < 32; ++T)
#pragma unroll
            for (int e = 0; e < 4; ++e) u[T][e] = 0u;
        const int kb0 = 16 * wave + 4 * gq;
        LAS unsigned char* ring = lds + DSA_OFF_V + wave * 16384;
#define DSA_ISSUE(Ti) do { _Pragma("unroll") for (int i_ = 0; i_ < 2; ++i_) { const int r_ = 8 * i_ + (lane >> 3); int kr_ = 16 * wave + 128 * (Ti) + r_; kr_ = kr_ > SEQ - 1 ? SEQ - 1 : kr_; \
            __builtin_amdgcn_global_load_lds((const unsigned*)(misc + (size_t)(b * SEQ + kr_) * 256 + (((lane & 7) ^ (r_ & 7)) << 3)), (LAS unsigned*)(ring + ((Ti) & 7) * 2048 + i_ * 1024), 16, 0, 0); } } while (0)
        if (ngrp > 0) {
#pragma unroll
            for (int T = 0; T < 8; ++T) DSA_ISSUE(T);
        }
        DSA_FOR_TILES(
            asm volatile("s_waitcnt vmcnt(14)" ::: "memory");
            const LAS unsigned char* tp = ring + (T & 7) * 2048 + j * 128;
            const bf16x8 kf0 = *(const LAS bf16x8*)(tp + ((gq ^ (j & 7)) << 4)); const bf16x8 kf1 = *(const LAS bf16x8*)(tp + (((gq + 4) ^ (j & 7)) << 4));
            asm volatile("s_waitcnt lgkmcnt(0)" ::: "memory");
            DSA_ISSUE(T + 8);
            float sc[4] = {0.f, 0.f, 0.f, 0.f};
            _Pragma("unroll") for (int h = 0; h < 4; ++h) {
                f32x4v a = {0.f, 0.f, 0.f, 0.f};
                a = __builtin_amdgcn_mfma_f32_16x16x32_bf16(kf0, qf[h][0], a, 0, 0, 0);
                a = __builtin_amdgcn_mfma_f32_16x16x32_bf16(kf1, qf[h][1], a, 0, 0, 0);
                _Pragma("unroll") for (int e = 0; e < 4; ++e) sc[e] += iw[h] * fmaxf(a[e], 0.f);
                asm volatile("" : "+v"(sc[0]), "+v"(sc[1]), "+v"(sc[2]), "+v"(sc[3]));
            }
            _Pragma("unroll") for (int e = 0; e < 4; ++e) { unsigned x = f2o(sc[e]); asm volatile("" : "+v"(x)); u[T][e] = (kb0 + 128 * T + e <= t) ? x : 0u; }
        )
        asm volatile("s_waitcnt vmcnt(0)" ::: "memory");
#undef DSA_ISSUE
        unsigned prefix = 0u; bool exact = false; int par = 0; int cab = 0;
        LAS unsigned* lcnt = (LAS unsigned*)(lds + DSA_OFF_V); LAS unsigned* lcab = lcnt + 16; LAS unsigned* lvst = lcnt + 32; LAS unsigned* lexf = lcnt + 48; LAS unsigned* llist = lcnt + 64;
        if (tid < 16) lcnt[tid] = 0u;
#pragma unroll 1
        for (int bit = 31; bit >= DSA_S; --bit) {
            const unsigned cand = prefix | (1u << bit); int c0 = 0, c1 = 0;
            DSA_FOR_TILES(cnt_ge(c0, u[T][0], cand); cnt_ge(c1, u[T][1], cand); cnt_ge(c0, u[T][2], cand); cnt_ge(c1, u[T][3], cand);)
            const int tot = dsa_total(cnt, par, wave, j, gq, c0 + c1); par ^= 1;
            if (tot >= 256) prefix = cand; else cab = tot;
        }
        { const unsigned ptop = prefix >> DSA_S;
          DSA_FOR_TILES(_Pragma("unroll") for (int e = 0; e < 4; ++e) { const unsigned x = u[T][e]; if (x != 0u && (x >> DSA_S) == ptop) { const unsigned pos = __hip_atomic_fetch_add(&lcnt[j], 1u, __ATOMIC_RELAXED, __HIP_MEMORY_SCOPE_WORKGROUP); if (pos < DSA_CAP) llist[j * DSA_CAP + pos] = x; } })
          if (wave == 0 && gq == 0) lcab[j] = (unsigned)cab; }
        __syncthreads();
        const bool ovf = __any(lcnt[j] > (unsigned)DSA_CAP);
        if (!ovf) {
#pragma unroll 1
            for (int qq = 0; qq < 2; ++qq) {
                const int q = 2 * wave + qq; const int n = (int)lcnt[q]; const int r = 256 - (int)lcab[q];
                unsigned ev[DSA_CAP / 64];
#pragma unroll
                for (int i = 0; i < DSA_CAP / 64; ++i) ev[i] = (lane + 64 * i < n) ? llist[q * DSA_CAP + lane + 64 * i] : 0u;
                unsigned p2 = (unsigned)__shfl((int)prefix, q);
#pragma unroll 1
                for (int bit = DSA_S - 1; bit >= 0; --bit) {
                    const unsigned cand = p2 | (1u << bit); int c = 0;
#pragma unroll
                    for (int i = 0; i < DSA_CAP / 64; ++i) c += __popcll(__ballot(ev[i] >= cand));
                    if (c >= r) p2 = cand;
                }
                int cf = 0;
#pragma unroll
                for (int i = 0; i < DSA_CAP / 64; ++i) cf += __popcll(__ballot(ev[i] >= p2));
                if (lane == 0) { lvst[q] = p2; lexf[q] = (cf == r) ? 1u : 0u; }
            }
            __syncthreads();
            prefix = lvst[j]; exact = lexf[j] != 0u;
        } else {
#pragma unroll 1
            for (int bit = DSA_S - 1; bit >= 0; --bit) {
                const unsigned cand = prefix | (1u << bit); int c0 = 0, c1 = 0;
                DSA_FOR_TILES(cnt_ge(c0, u[T][0], cand); cnt_ge(c1, u[T][1], cand); cnt_ge(c0, u[T][2], cand); cnt_ge(c1, u[T][3], cand);)
                const int tot = dsa_total(cnt, par, wave, j, gq, c0 + c1); par ^= 1;
                if (!exact && tot >= 256) { prefix = cand; exact = (tot == 256); }
            }
        }
        const bool alle = __all(exact);
        DSA_FOR_TILES(_Pragma("unroll") for (int e = 0; e < 4; ++e) { const unsigned x = u[T][e]; u[T][e] = (x > prefix || (exact && x == prefix)) ? 0u : (x == prefix ? (unsigned)(1 + kb0 + 128 * T + e) : 0xFFFFFFFFu); })
        unsigned kp = 0u;
        if (!alle) {
            __syncthreads();
#pragma unroll 1
            for (int bit = 11; bit >= 0; --bit) {
                const unsigned cand = kp | (1u << bit); int c0 = 0, c1 = 0;
                DSA_FOR_TILES(cnt_le(c0, u[T][0], cand); cnt_le(c1, u[T][1], cand); cnt_le(c0, u[T][2], cand); cnt_le(c1, u[T][3], cand);)
                const int tot = dsa_total(cnt, par, wave, j, gq, c0 + c1); par ^= 1;
                if (tot <= 255) kp = cand;
            }
        }
        const unsigned kp1 = kp + 1u;
        int ns0 = 0, ns1 = 0;
        DSA_FOR_TILES(cnt_le(ns0, u[T][0], kp1); cnt_le(ns1, u[T][1], kp1); cnt_le(ns0, u[T][2], kp1); cnt_le(ns1, u[T][3], kp1);)
        pc[(wave * 4 + gq) * 16 + j] = (unsigned)(ns0 + ns1);
        __syncthreads();
        int base = 0;
        for (int i = 0; i < wave * 4 + gq; ++i) base += (int)pc[i * 16 + j];
        DSA_FOR_TILES(_Pragma("unroll") for (int e = 0; e < 4; ++e) { if (u[T][e] <= kp1) { if (base < 256) list[j * 256 + base] = (unsigned short)(kb0 + 128 * T + e); ++base; } })
    } else {
        for (int i = tid; i < 16 * 256; i += 512) list[i] = (unsigned short)(i & 255);
    }
    __syncthreads();
    const bf16* kva = (const bf16*)(ws + WS_KVA);
    bf16* qa = (bf16*)(ws + WS_QA);
    LAS unsigned char* Vb = lds + DSA_OFF_V + wave * DSA_VB;
    const int tq2[2] = {q0 + 2 * wave, q0 + 2 * wave + 1};
#define DSA_KEY(st_, slot_) ((int)list[(2 * wave + ((st_) >> 2)) * 256 + (((slot_) < nselq[(st_) >> 2]) ? (slot_) : 0)])
#define DSA_LOADK(buf_, st_) do { _Pragma("unroll") for (int kt_ = 0; kt_ < 4; ++kt_) { const bf16* kp_ = kva + (size_t)(b * SEQ + DSA_KEY(st_, 64 * ((st_) & 3) + 16 * kt_ + j)) * 128 + 8 * gq; \
        buf_[kt_][0] = *(const bf16x8*)kp_; buf_[kt_][1] = *(const bf16x8*)(kp_ + 32); } } while (0)
#define DSA_LOADV(st_) do { _Pragma("unroll") for (int i_ = 0; i_ < 8; ++i_) vr[i_] = *(const v4u*)(kva + (size_t)(b * SEQ + DSA_KEY(st_, 64 * ((st_) & 3) + 8 * i_ + (lane >> 3))) * 128 + 64 + (lane & 7) * 8); } while (0)
    const int nselq[2] = {tq2[0] + 1 < 256 ? tq2[0] + 1 : 256, tq2[1] + 1 < 256 ? tq2[1] + 1 : 256};
    bf16x8 kfA[4][2], kfB[4][2]; v4u vr[8];
    bf16x8 qf[2]; float mrow = NEGF, lrow = 0.f; f32x4v o[4];
    DSA_LOADK(kfA, 0); DSA_LOADV(0);
#define DSA_STEP(st_, cur_, nxt_) do { \
        if (((st_) & 3) == 0) { const int rowq_ = b * SEQ + tq2[(st_) >> 2]; \
            _Pragma("unroll") for (int ks_ = 0; ks_ < 2; ++ks_) { qf[ks_] = (bf16x8){0, 0, 0, 0, 0, 0, 0, 0}; if (j < 8) qf[ks_] = *(const bf16x8*)(qa + (size_t)rowq_ * 512 + j * 64 + 8 * gq + 32 * ks_); } \
            mrow = NEGF; lrow = 0.f; _Pragma("unroll") for (int dt_ = 0; dt_ < 4; ++dt_) o[dt_] = (f32x4v){0.f, 0.f, 0.f, 0.f}; } \
        _Pragma("unroll") for (int i_ = 0; i_ < 8; ++i_) *(LAS v4u*)(Vb + ((8 * i_ + (lane >> 3)) * NSA_VSTR + (lane & 7) * 8) * 2) = vr[i_]; \
        if ((st_) < 7) { DSA_LOADK(nxt_, (st_) + 1); DSA_LOADV((st_) + 1); } \
        f32x4v s_[4]; float bm_ = NEGF; \
        _Pragma("unroll") for (int kt_ = 0; kt_ < 4; ++kt_) { f32x4v a_ = {0.f, 0.f, 0.f, 0.f}; \
            a_ = __builtin_amdgcn_mfma_f32_16x16x32_bf16(cur_[kt_][0], qf[0], a_, 0, 0, 0); a_ = __builtin_amdgcn_mfma_f32_16x16x32_bf16(cur_[kt_][1], qf[1], a_, 0, 0, 0); \
            _Pragma("unroll") for (int e_ = 0; e_ < 4; ++e_) { const float v_ = (64 * ((st_) & 3) + 16 * kt_ + 4 * gq + e_ < nselq[(st_) >> 2]) ? a_[e_] : NEGF; a_[e_] = v_; bm_ = fmaxf(bm_, v_); } s_[kt_] = a_; } \
        bm_ = xmax16(bm_); \
        { const float mnew_ = fmaxf(mrow, bm_), alpha_ = __builtin_amdgcn_exp2f(mrow - mnew_); mrow = mnew_; float ps_ = 0.f; \
          _Pragma("unroll") for (int kt_ = 0; kt_ < 4; ++kt_) _Pragma("unroll") for (int e_ = 0; e_ < 4; ++e_) { const float p_ = __builtin_amdgcn_exp2f(s_[kt_][e_] - mnew_); s_[kt_][e_] = p_; ps_ += p_; } \
          lrow = lrow * alpha_ + ps_; _Pragma("unroll") for (int dt_ = 0; dt_ < 4; ++dt_) o[dt_] *= alpha_; } \
        WAVE_LDS_SYNC(); \
        _Pragma("unroll") for (int kk_ = 0; kk_ < 2; ++kk_) { \
            const bf16x8 pf_ = pack8(s_[2 * kk_][0], s_[2 * kk_][1], s_[2 * kk_][2], s_[2 * kk_][3], s_[2 * kk_ + 1][0], s_[2 * kk_ + 1][1], s_[2 * kk_ + 1][2], s_[2 * kk_ + 1][3]); \
            _Pragma("unroll") for (int dt_ = 0; dt_ < 4; ++dt_) { const LAS unsigned char* va_ = Vb + ((32 * kk_ + 4 * gq + (j >> 2)) * NSA_VSTR + 16 * dt_ + 4 * (j & 3)) * 2; \
                o[dt_] = __builtin_amdgcn_mfma_f32_16x16x32_bf16(cat4(tr16(va_), tr16(va_ + 16 * NSA_VSTR * 2)), pf_, o[dt_], 0, 0, 0); } } \
        WAVE_LDS_SYNC(); \
        if (((st_) & 3) == 3) { const float inv_ = __builtin_amdgcn_rcpf(xsum16(lrow)); const int rowq_ = b * SEQ + tq2[(st_) >> 2]; \
            if (j < 8) { _Pragma("unroll") for (int dt_ = 0; dt_ < 4; ++dt_) { uint2 w_; w_.x = pg8::cvt_pk_bf16(o[dt_][0] * inv_, o[dt_][1] * inv_); w_.y = pg8::cvt_pk_bf16(o[dt_][2] * inv_, o[dt_][3] * inv_); \
                *(uint2*)(yout + (size_t)rowq_ * 512 + j * 64 + 16 * dt_ + 4 * gq) = w_; } } } \
    } while (0)
    DSA_STEP(0, kfA, kfB); DSA_STEP(1, kfB, kfA); DSA_STEP(2, kfA, kfB); DSA_STEP(3, kfB, kfA);
    DSA_STEP(4, kfA, kfB); DSA_STEP(5, kfB, kfA); DSA_STEP(6, kfA, kfB); DSA_STEP(7, kfB, kfA);
#undef DSA_STEP
#undef DSA_LOADK
#undef DSA_LOADV
#undef DSA_KEY
    __syncthreads();
}
__device__ __forceinline__ void phase_mixers(const Args& P, unsigned char* ws, int z, LAS unsigned char* lds, int gw, int NGW, int lane, int wave, int bid, int G) {
    asm volatile("" : "+v"(lane)); lane &= 63; asm volatile("" : "+s"(gw), "+s"(NGW));
#if PROBE == 3
    { LAS unsigned char* wl = lds + wave * 18944; for (int it2 = gw; it2 < 2 * M; it2 += NGW) nsa_query(P, ws, z, it2 >> 1, it2 & 1, wl, lane); }
#else
    for (int k = 0; bid + G * k < 1024; ++k) {
        const int u = bid + G * k, c0 = u & 63, unit = (u & ~63) | ((k & 1) ? 63 - c0 : c0);
#if DUP == 7
        nsa_unit(ws, unit, lds, (wave << 6) | lane_id_v(), (bf16*)(ws + WS_BU));
#endif
        nsa_unit(ws, unit, lds, (wave << 6) | lane_id_v(), (bf16*)(ws + WS_QC));
    }
#endif
    for (int k = 0; bid + G * k < 2048; ++k) {
        const int u = bid + G * k, c0 = u & 255, unit = (u & ~255) | ((k & 1) ? 255 - c0 : c0);
#if DUP == 6
        dsa_unit(ws, unit, lds, (wave << 6) | lane_id_v(), (bf16*)(ws + WS_BU));
#endif
        dsa_unit(ws, unit, lds, (wave << 6) | lane_id_v(), (bf16*)(ws + WS_QA));
    }
}
__global__ void __launch_bounds__(NWAVES * 64, 2) fwd_kernel(Args args) {
    extern __shared__ __attribute__((aligned(16))) unsigned char lds_raw[];
    LAS unsigned char* lds = (LAS unsigned char*)lds_raw;
    const int wave = __builtin_amdgcn_readfirstlane((int)threadIdx.x >> 6);
#define TIDX ((wave << 6) | lane_id_v())
#define tid TIDX
#define lane TIDX
    const int G = gridDim.x, bid = blockIdx.x;
    const int gw = bid * NWAVES + wave, NGW = G * NWAVES;
    const int lo = args.ph_lo, hi = args.ph_hi;
    const Args& P = args;
    int z = 0; asm volatile("" : "+s"(z));
    unsigned char* ws = args.ws + z;
    volatile LAS unsigned* MISCW = (volatile LAS unsigned*)(lds + LDSCTL_OFF);
    if (tid < 64) MISCW[tid] = 0u;
    __syncthreads();
    XcdBarrier bar; bar.bar = (unsigned*)(ws + WS_CTL) + 4096; bar.x = 0; bar.st = nullptr;
    if (hi - lo > 1) bar = xcd_barrier_post((unsigned*)(ws + WS_CTL) + 4096, MISCW + 8);
#define RUN(k) (lo <= (k) && (k) < hi)
#define SEAM(k) do { if ((k) + 1 < hi) { XcdBarrier b2_ = bar; asm volatile("" : "+s"(b2_.bar), "+s"(b2_.x)); xcd_barrier(b2_); } else { VM_WAIT(); __syncthreads(); } } while (0)


    if (RUN(0)) { phase_rope(P, ws, z, bid * (NWAVES * 64) + tid, G * NWAVES * 64);
        { int ln_ = TIDX; asm volatile("" : "+v"(ln_)); ln_ &= 63;
          for (int m = gw; m < M; m += NGW) stat_row_bf16(P.in[0 + z] + (size_t)m * DM, (bf16*)(ws + WS_XN) + (size_t)m * DM, (float*)(ws + WS_SSQ) + (size_t)m * 16, ln_); }
        SEAM(0); }
#define RS_PREPASS(Sref) do { const float* ssq_ = (const float*)(ws + WS_SSQ); LAS float* rsl_ = (LAS float*)(lds + RS_OFF); const int t_ = TIDX; pg8::Unit u_; \
        for (int i_ = 0; (Sref).next(i_, u_); ++i_) { const f32x4* p_ = (const f32x4*)(ssq_ + (size_t)(u_.pm * 256 + (t_ >> 1)) * 16 + (t_ & 1) * 8); const f32x4 a_ = p_[0], b_ = p_[1]; \
            float s_ = (a_.x + a_.y) + (a_.z + a_.w) + (b_.x + b_.y) + (b_.z + b_.w); s_ += __shfl_xor(s_, 1); if ((t_ & 1) == 0) rsl_[i_ * 256 + (t_ >> 1)] = 1.0f / sqrtf(s_ * (1.f / DM) + EPS); } \
        __syncthreads(); } while (0)

    for (int it = 0; it < 2 * DEPTH; ++it) {
        const int l = it >> 1, second = it & 1, pb = 1 + l * NPL + (second ? 7 : 0);
        asm volatile("" : "+s"(z));
        ws = args.ws + z;
        bf16* const XN = (bf16*)(ws + WS_XN);
        bf16* const HB = (bf16*)(ws + WS_H);
        bf16* const MG = (bf16*)(ws + WS_MG);
        bf16* const GB = (bf16*)(ws + WS_G);
        unsigned char* const wb = ws + WS_W;
        float* const OUT = P.out + z;
        const float* xin = (it == 0) ? P.in[0 + z] : (const float*)OUT;
        if (!second && RUN(pb)) { phase_convert(P, ws, z, l, lds, gw, NGW, lane, wave); SEAM(pb); }
        if (RUN(pb + 1)) {
            pg8::Gemm g{XN, (const bf16*)(wb + (second ? WO_GU2 : WO_GU1)), M, 2 * FF, DM}; pg8::StaticOrder S; S.init(M, 2 * FF, G, bid + z);
            pg8::EpiSwiglu E{HB, FF, (const LAS float*)(lds + RS_OFF)};
            RS_PREPASS(S);
#if !defined(SITE_MASK) || ((SITE_MASK >> 0) & 1)
            pg8::gemm_phase<pg8::EpiSwiglu, pg8::StaticOrder, ALIGN_UP, true>(lds, g, S, E, TIDX);
#if DUP == 3
            pg8::gemm_phase<pg8::EpiSwiglu, pg8::StaticOrder, ALIGN_UP, true>(lds, g, S, E, TIDX);
#endif
#endif
            SEAM(pb + 1);
        }
        if (RUN(pb + 2)) {
            pg8::Gemm g{HB, (const bf16*)(wb + (second ? WO_D2 : WO_D1)), M, DM, FF}; pg8::StaticOrder S; S.init(M, DM, G, bid + z);
            pg8::EpiResid E{xin, OUT, 0.5f, XN, (float*)(ws + WS_SSQ)};
#if !defined(SITE_MASK) || ((SITE_MASK >> 1) & 1)
            pg8::gemm_phase<pg8::EpiResid, pg8::StaticOrder, true, true>(lds, g, S, E, TIDX);
#endif
            SEAM(pb + 2);
        }
        if (second) continue;
        const int pm = 1 + l * NPL + 2;
        if (RUN(pm + 1)) {
            pg8::Gemm g{XN, (const bf16*)(wb + WO_IN), M, NINP, DM}; pg8::StaticOrder S; S.init(M, NINP, G, bid + z);
            pg8::EpiWin E{(bf16*)(ws + WS_QA), (bf16*)(ws + WS_QC), (bf16*)(ws + WS_IQ), (bf16*)(ws + WS_MISC), (bf16*)(ws + WS_KVC), (bf16*)(ws + WS_KVS), (bf16*)(ws + WS_KVW), (bf16*)(ws + WS_BU), GB,
                          (const float*)(ws + WS_ROPE), (const LAS float*)(lds + RS_OFF)};
            RS_PREPASS(S);
#if !defined(SITE_MASK) || ((SITE_MASK >> 2) & 1)
            pg8::gemm_phase<pg8::EpiWin, pg8::StaticOrder, ALIGN_WIN, true>(lds, g, S, E, TIDX);
#if DUP == 4
            pg8::gemm_phase<pg8::EpiWin, pg8::StaticOrder, ALIGN_WIN, true>(lds, g, S, E, TIDX);
#endif
#endif
            SEAM(pm + 1);
        }
        #ifndef NO_PREP
        if (RUN(pm + 2)) { phase_prep(P, ws, z, l, lds, gw, NGW, lane, wave);
            SEAM(pm + 2); }
#endif
        #ifndef NO_MIX
        if (RUN(pm + 3)) { phase_mixers(P, ws, z, lds, gw, NGW, lane, wave, bid, G); SEAM(pm + 3); }
#endif
        if (RUN(pm + 4)) {
#if DUP == 5
          for (int rep_ = 0; rep_ < 2; ++rep_) {
#endif
            pg8::StaticOrder S; S.init(M, DM, G, bid + z);
            { pg8::Gemm g{(const bf16*)(ws + WS_QA), (const bf16*)(wb + WO_PA), M, DM, 512}; pg8::EpiProj<0> E{MG, GB, 0};
#if !defined(SITE_MASK) || ((SITE_MASK >> 3) & 1)
              pg8::gemm_phase<pg8::EpiProj<0>, pg8::StaticOrder, true, true>(lds, g, S, E, TIDX);
#endif
            }
            { pg8::Gemm g{(const bf16*)(ws + WS_YB), (const bf16*)(wb + WO_PB), M, DM, 512}; pg8::EpiProj<1> E{MG, GB, 1024};
#if !defined(SITE_MASK) || ((SITE_MASK >> 4) & 1)
              pg8::gemm_phase<pg8::EpiProj<1>, pg8::StaticOrder, true, true>(lds, g, S, E, TIDX);
#endif
            }
            { pg8::Gemm g{(const bf16*)(ws + WS_QC), (const bf16*)(wb + WO_PC), M, DM, 512}; pg8::EpiProj<1> E{MG, GB, 2048};
#if !defined(SITE_MASK) || ((SITE_MASK >> 5) & 1)
              pg8::gemm_phase<pg8::EpiProj<1>, pg8::StaticOrder, true, true>(lds, g, S, E, TIDX);
#endif
            }
#if DUP == 5
          }
#endif
            SEAM(pm + 4);
        }
        if (RUN(pm + 5)) {
            pg8::Gemm g{MG, (const bf16*)(wb + WO_OUT), M, DM, DM}; pg8::StaticOrder S; S.init(M, DM, G, bid + z);
            pg8::EpiResid E{OUT, OUT, 1.0f, XN, (float*)(ws + WS_SSQ)};
#if !defined(SITE_MASK) || ((SITE_MASK >> 6) & 1)
            pg8::gemm_phase<pg8::EpiResid, pg8::StaticOrder, true, true>(lds, g, S, E, TIDX);
#endif
            SEAM(pm + 5);
        }
    }
    if (RUN(NPH - 1)) { asm volatile("" : "+s"(z)); int ln_ = TIDX; asm volatile("" : "+v"(ln_)); ln_ &= 63; float* o_ = P.out + z; for (int m = gw; m < M; m += NGW) norm_row_f32(o_ + (size_t)m * DM, P.in[23 + z], ln_); }
#undef RUN
#undef tid
#undef TIDX
#undef lane
#undef SEAM
}

extern "C" void kernel_launch(void* const* d_in, const int* in_sizes, int n_in, void* d_out, int out_size, void* d_ws, size_t ws_size, hipStream_t stream) {
    static int grid = 0;
    if (grid == 0) {
        if (n_in != 24 || out_size != M * DM || ws_size < WS_END) { fprintf(stderr, "kernel_launch: unexpected shapes (n_in %d out %d ws %zu)\n", n_in, out_size, ws_size); grid = -1; return; }
        int dev = 0, cus = 0, per_cu = 0;
        if (hipGetDevice(&dev) != hipSuccess || hipDeviceGetAttribute(&cus, hipDeviceAttributeMultiprocessorCount, dev) != hipSuccess) { grid = -1; return; }
        if (hipFuncSetAttribute((const void*)fwd_kernel, hipFuncAttributeMaxDynamicSharedMemorySize, LDS_BYTES) != hipSuccess) { fprintf(stderr, "kernel_launch: hipFuncSetAttribute failed\n"); grid = -1; return; }
        if (hipOccupancyMaxActiveBlocksPerMultiprocessor(&per_cu, (const void*)fwd_kernel, NWAVES * 64, LDS_BYTES) != hipSuccess || per_cu < 1) { fprintf(stderr, "kernel_launch: occupancy query says %d\n", per_cu); }
        (void)hipGetLastError();
        grid = cus;
    }
    if (grid < 0) return;
    (void)hipMemsetAsync((char*)d_ws + WS_CTL, 0, CTL_ZERO_BYTES, stream);
    Args a{};
    for (int i = 0; i < 24; ++i) a.in[i] = (const float*)d_in[i];
    a.out = (float*)d_out; a.ws = (unsigned char*)d_ws;
#if MK_ONE_LAUNCH
    a.ph_lo = 0; a.ph_hi = NPH;
    hipLaunchKernelGGL(fwd_kernel, dim3(grid), dim3(NWAVES * 64), LDS_BYTES, stream, a);
#else
    for (int ph = 0; ph < NPH; ++ph) { a.ph_lo = ph; a.ph_hi = ph + 1; hipLaunchKernelGGL(fwd_kernel, dim3(grid), dim3(NWAVES * 64), LDS_BYTES, stream, a); }
#endif
}
```

```cpp
#include <hip/hip_runtime.h>
#include <cstdio>
#include <cstdint>
#define PROBE 0
#define PROBE_GAIN 10.0f
#define TOP8_RANK 1
#define PROBE_ROWTHR 0.01f
#define PROBE_ROWCOND 1
#define PROBE_BR -1
#define FIXHOM 0
#define DUP 0
#define POOLDBG 0
#define YB_SPARE 0
#define ALIGN_UP true
#define ALIGN_WIN true
#define DSA_CAP_V 256
#define DSA_K_V 12
#ifndef MK_ONE_LAUNCH
#define MK_ONE_LAUNCH 1
#endif
namespace pg8 {
#define PG8_LAS __attribute__((address_space(3)))
typedef unsigned short bf16_t;
typedef short bf16x8 __attribute__((ext_vector_type(8)));
typedef float f32x4 __attribute__((ext_vector_type(4)));
typedef unsigned u32x4 __attribute__((ext_vector_type(4)));
constexpr int BM = 256, BK = 64, HALF = 128, HTB = HALF * BK * 2  , STAGE_BYTES = 8 * HTB, NXCD = 8, WGM = 8;

__host__ __device__ __forceinline__ int lds_byte(int r, int c) { const int st = (r >> 4) * 2 + (c >> 5), rr = r & 15, cc = c & 31, ob = rr * 64 + cc * 2; return st * 1024 + (ob ^ (((ob >> 9) & 1) << 5)); }
__host__ __device__ __forceinline__ void stage_rc(int b, int& R, int& C) { const int st = b / 1024, sb = b % 1024, swz = sb ^ (((sb >> 9) & 1) << 5); R = (st >> 1) * 16 + swz / 64; C = (st & 1) * 32 + (swz % 64) / 2; }
__host__ __device__ __forceinline__ int perm32(int rho) { const int n = rho >> 4, i = rho & 15; return 8 * (i >> 2) + 4 * n + (i & 3); }

struct Unit { int pm, pn, ord; };
struct Gemm { const bf16_t* A; const bf16_t* Bt; int M, N, K; };

struct StaticOrder {
    int nM, nN, nwg, G, c;
    __host__ __device__ __forceinline__ void init(int M, int N, int G_, int c_) { nM = M / BM; nN = N / BM; nwg = nM * nN; G = G_; c = c_; }
    __host__ __device__ __forceinline__ bool next(int i, Unit& u) const {
        const long L = (long)i * G + c; if (L >= nwg) return false;
        int wgid = (int)L; { const int q = nwg / NXCD, r = nwg % NXCD, xcd = wgid % NXCD, off = wgid / NXCD; wgid = (xcd < r ? xcd * (q + 1) : r * (q + 1) + (xcd - r) * q) + off; }
        const int nig = WGM * nN, gid = wgid / nig, fm = gid * WGM, gsz = (nM - fm) < WGM ? (nM - fm) : WGM;
        u.pm = fm + ((wgid % nig) % gsz); u.pn = (wgid % nig) / gsz; u.ord = i; return true;
    }
    __device__ __forceinline__ void a_ready(const Unit&) const {}
    __device__ __forceinline__ void done(const Unit&) const {}
};

__device__ __forceinline__ unsigned cvt_pk_bf16(float lo, float hi) { unsigned r; asm volatile("v_cvt_pk_bf16_f32 %0, %1, %2" : "=v"(r) : "v"(lo), "v"(hi)); return r; }
__device__ __forceinline__ float bflo(unsigned w) { return __uint_as_float(w << 16); }
__device__ __forceinline__ float bfhi(unsigned w) { return __uint_as_float(w & 0xffff0000u); }
__device__ __forceinline__ float fast_sigmoid(float x) { return __builtin_amdgcn_rcpf(1.0f + __expf(-x)); }

struct EpiSwiglu {
    static constexpr bool PERM = true, AFTER_DRAIN = false;
    bf16_t* H; int ldh; const PG8_LAS float* rs;
    __device__ __forceinline__ void operator()(const f32x4 (&acc)[2][2][4][2], const Unit& u, int wr, int wc, int fr, int fq) const {
        const int row0 = u.pm * BM + wr * 64 + fr, col0 = u.pn * HALF + wc * 32 + 8 * fq;
#pragma unroll
        for (int ai = 0; ai < 2; ++ai)
#pragma unroll
            for (int m = 0; m < 4; ++m) {
                bf16_t* rowp = H + (size_t)(row0 + ai * HALF + m * 16) * ldh + col0;
                const float r = rs[u.ord * 256 + wr * 64 + fr + ai * HALF + m * 16];
                float o[8];
#pragma unroll
                for (int n = 0; n < 2; ++n)
#pragma unroll
                    for (int e = 0; e < 4; ++e) { const float g = acc[ai][0][m][n][e] * r, up = acc[ai][1][m][n][e] * r; o[n * 4 + e] = g * fast_sigmoid(g) * up; }
                u32x4 w; w.x = cvt_pk_bf16(o[0], o[1]); w.y = cvt_pk_bf16(o[2], o[3]); w.z = cvt_pk_bf16(o[4], o[5]); w.w = cvt_pk_bf16(o[6], o[7]);
                *(u32x4*)rowp = w;
            }
    }
};
struct EpiResid {
    static constexpr bool PERM = true, AFTER_DRAIN = false;
    const float* base; float* out; float s; bf16_t* xb; float* ssq;
    __device__ __forceinline__ void operator()(const f32x4 (&acc)[2][2][4][2], const Unit& u, int wr, int wc, int fr, int fq) const {
        const int row0 = u.pm * BM + wr * 64 + fr, col0 = u.pn * BM + wc * 32 + 8 * fq;
#pragma unroll
        for (int ai = 0; ai < 2; ++ai)
#pragma unroll
            for (int m = 0; m < 4; ++m) {
                const size_t off = (size_t)(row0 + ai * HALF + m * 16) * 1024 + col0;
                float q = 0.f;
#pragma unroll
                for (int bj = 0; bj < 2; ++bj) {
                    const f32x4 b0 = *(const f32x4*)(base + off + bj * HALF), b1 = *(const f32x4*)(base + off + bj * HALF + 4);
                    const f32x4 x0 = b0 + acc[ai][bj][m][0] * s, x1 = b1 + acc[ai][bj][m][1] * s;
                    *(f32x4*)(out + off + bj * HALF) = x0; *(f32x4*)(out + off + bj * HALF + 4) = x1;
                    q += (x0[0] * x0[0] + x0[1] * x0[1]) + (x0[2] * x0[2] + x0[3] * x0[3]) + (x1[0] * x1[0] + x1[1] * x1[1]) + (x1[2] * x1[2] + x1[3] * x1[3]);
                    u32x4 w; w.x = cvt_pk_bf16(x0[0], x0[1]); w.y = cvt_pk_bf16(x0[2], x0[3]); w.z = cvt_pk_bf16(x1[0], x1[1]); w.w = cvt_pk_bf16(x1[2], x1[3]);
                    *(u32x4*)(xb + off + bj * HALF) = w;
                }
                q += __shfl_xor(q, 16); q += __shfl_xor(q, 32);
                if (fq == 0) ssq[(size_t)(row0 + ai * HALF + m * 16) * 16 + u.pn * 4 + wc] = q;
            }
    }
};
template <int MODE> struct EpiProj {
    static constexpr bool PERM = true, AFTER_DRAIN = false;
    bf16_t* MG; const bf16_t* G; int gofs;
    __device__ __forceinline__ void operator()(const f32x4 (&acc)[2][2][4][2], const Unit& u, int wr, int wc, int fr, int fq) const {
        const int row0 = u.pm * BM + wr * 64 + fr, col0 = u.pn * BM + wc * 32 + 8 * fq;
#pragma unroll
        for (int ai = 0; ai < 2; ++ai)
#pragma unroll
            for (int m = 0; m < 4; ++m) {
                const size_t row = (size_t)(row0 + ai * HALF + m * 16);
#pragma unroll
                for (int bj = 0; bj < 2; ++bj) {
                    const u32x4 gv = *(const u32x4*)(G + row * 3072 + gofs + col0 + bj * HALF);
                    bf16_t* mp = MG + row * 1024 + col0 + bj * HALF;
                    const f32x4 a0 = acc[ai][bj][m][0], a1 = acc[ai][bj][m][1];
                    float o[8] = {bflo(gv.x) * a0[0], bfhi(gv.x) * a0[1], bflo(gv.y) * a0[2], bfhi(gv.y) * a0[3], bflo(gv.z) * a1[0], bfhi(gv.z) * a1[1], bflo(gv.w) * a1[2], bfhi(gv.w) * a1[3]};
                    if (MODE) { const u32x4 ov = *(const u32x4*)mp; o[0] += bflo(ov.x); o[1] += bfhi(ov.x); o[2] += bflo(ov.y); o[3] += bfhi(ov.y); o[4] += bflo(ov.z); o[5] += bfhi(ov.z); o[6] += bflo(ov.w); o[7] += bfhi(ov.w); }
                    u32x4 w; w.x = cvt_pk_bf16(o[0], o[1]); w.y = cvt_pk_bf16(o[2], o[3]); w.z = cvt_pk_bf16(o[4], o[5]); w.w = cvt_pk_bf16(o[6], o[7]);
                    *(u32x4*)mp = w;
                }
            }
    }
};
struct EpiWin {
    static constexpr bool PERM = true, AFTER_DRAIN = false;
    bf16_t *QA, *QC, *IQ, *MISC, *KVC, *KVS, *KVW, *BU, *G; const float* rope; const PG8_LAS float* rs;
    __device__ __forceinline__ void operator()(const f32x4 (&acc)[2][2][4][2], const Unit& u, int wr, int wc, int fr, int fq) const {
        const int pn = u.pn;
        bf16_t* dst; int ld, cbase, mode;
        if (pn < 2) { dst = QA; ld = 512; cbase = pn * 256; mode = 1; }
        else if (pn < 4) { dst = QC; ld = 512; cbase = (pn - 2) * 256; mode = 1; }
        else if (pn == 4) { dst = IQ; ld = 256; cbase = 0; mode = 1; }
        else if (pn == 5) { dst = MISC; ld = 256; cbase = 0; mode = 3; }
        else if (pn <= 8) { dst = pn == 6 ? KVC : (pn == 7 ? KVS : KVW); ld = 256; cbase = 0; mode = 2; }
        else if (pn <= 10) { dst = BU; ld = 512; cbase = (pn - 9) * 256; mode = 0; }
        else { dst = G; ld = 3072; cbase = (pn - 11) * 256; mode = 4; }
        const int row0 = u.pm * BM + wr * 64 + fr, col0 = cbase + wc * 32 + 8 * fq;
        const bool ropelane = ((wc & 1) == 0) && fq < 2;
        const float sc = (mode == 1) ? (pn < 4 ? 0.125f * 1.4426950408889634f : 0.125f) : 1.0f;
#pragma unroll
        for (int ai = 0; ai < 2; ++ai)
#pragma unroll
            for (int m = 0; m < 4; ++m) {
                const size_t row = (size_t)(row0 + ai * HALF + m * 16);
                const float rr = rs[u.ord * 256 + wr * 64 + fr + ai * HALF + m * 16];
                f32x4 cs = {1.f, 1.f, 1.f, 1.f}, sn = {0.f, 0.f, 0.f, 0.f};
                if (ropelane && mode >= 1 && mode <= 3) { cs = *(const f32x4*)(rope + row * 16 + 4 * fq); sn = *(const f32x4*)(rope + row * 16 + 8 + 4 * fq); }
#pragma unroll
                for (int bj = 0; bj < 2; ++bj) {
                    const f32x4 a0 = acc[ai][bj][m][0] * rr, a1 = acc[ai][bj][m][1] * rr;
                    float o[8] = {a0[0], a0[1], a0[2], a0[3], a1[0], a1[1], a1[2], a1[3]};
                    const bool dorope = ropelane && (mode == 1 || (mode == 2 && bj == 0) || (mode == 3 && bj == 0 && wc == 0));
                    if (dorope) {
#pragma unroll
                        for (int p = 0; p < 4; ++p) { const float x1 = o[2 * p], x2 = o[2 * p + 1]; o[2 * p] = x1 * cs[p] - x2 * sn[p]; o[2 * p + 1] = x2 * cs[p] + x1 * sn[p]; }
                    }
                    if (mode == 4) {
#pragma unroll
                        for (int e = 0; e < 8; ++e) o[e] = fast_sigmoid(o[e]);
                    } else {
#pragma unroll
                        for (int e = 0; e < 8; ++e) o[e] *= sc;
                    }
                    u32x4 w; w.x = cvt_pk_bf16(o[0], o[1]); w.y = cvt_pk_bf16(o[2], o[3]); w.z = cvt_pk_bf16(o[4], o[5]); w.w = cvt_pk_bf16(o[6], o[7]);
                    *(u32x4*)(dst + row * ld + col0 + bj * HALF) = w;
                }
            }
    }
};

template <class Epi, class Sched, bool ALIGN_EPI = false, bool SP2 = false>
__device__ __forceinline__ void gemm_phase(PG8_LAS unsigned char* lds, const Gemm g, const Sched& S, const Epi& E, int tid_in) {
    int tid_ = tid_in; asm volatile("" : "+v"(tid_));
    const int tid = tid_, wid = __builtin_amdgcn_readfirstlane(tid >> 6), lane = tid & 63, wr = wid >> 2, wc = wid & 3, fr = lane & 15, fq = lane >> 4;
    const int K = g.K, nt = K / BK;
    unsigned voffA[2], voffB[2];
#pragma unroll
    for (int i = 0; i < 2; ++i) { int R, C; stage_rc(tid * 16 + i * 8192, R, C); const int Rb = Epi::PERM ? ((R & ~31) + perm32(R & 31)) : R;
        voffA[i] = (unsigned)(R * K + C) * 2u; voffB[i] = (unsigned)(Rb * K + C) * 2u; }
    const size_t kstep = (size_t)(BK * 2);
    const size_t hstep = (size_t)HALF * K * 2;
    const size_t tstep = 2 * hstep;
    const unsigned ldsw = (unsigned)wid * 1024u;
    const int aoff = lds_byte(wr * 64 + fr, fq * 8), boff = lds_byte(wc * 32 + fr, fq * 8);
#define PG8_SA(b, h) (((b) * 2 + (h)) * HTB)
#define PG8_SB(b, h) ((4 + (b) * 2 + (h)) * HTB)
#define PG8_STAGE(bufoff, gbase, voff) do { _Pragma("unroll") for (int _i = 0; _i < 2; ++_i) \
        __builtin_amdgcn_global_load_lds((const unsigned*)((const char*)(gbase) + (voff)[_i]), (PG8_LAS unsigned*)(lds + (bufoff) + ldsw + _i * 8192), 16, 0, 0); } while (0)
#define PG8_LDA(dst, b, h) do { _Pragma("unroll") for (int m = 0; m < 4; ++m) _Pragma("unroll") for (int k = 0; k < 2; ++k) dst[m][k] = *(const PG8_LAS bf16x8*)(lds + PG8_SA(b, h) + aoff + m * 2048 + k * 1024); } while (0)
#define PG8_LDB(dst, b, h) do { _Pragma("unroll") for (int n = 0; n < 2; ++n) _Pragma("unroll") for (int k = 0; k < 2; ++k) dst[n][k] = *(const PG8_LAS bf16x8*)(lds + PG8_SB(b, h) + boff + n * 2048 + k * 1024); } while (0)
#define PG8_MMA(ai, bj, At, Bt) do { __builtin_amdgcn_s_setprio(1); _Pragma("unroll") for (int m = 0; m < 4; ++m) _Pragma("unroll") for (int n = 0; n < 2; ++n) _Pragma("unroll") for (int k = 0; k < 2; ++k) \
        acc[ai][bj][m][n] = __builtin_amdgcn_mfma_f32_16x16x32_bf16(Bt[n][k], At[m][k], acc[ai][bj][m][n], 0, 0, 0); __builtin_amdgcn_s_setprio(0); } while (0)
#define PG8_WAIT_V(n) asm volatile("s_waitcnt vmcnt(" #n ")" ::: "memory")
#define PG8_WAIT_L(n) asm volatile("s_waitcnt lgkmcnt(" #n ")" ::: "memory")
#define PG8_BAR __builtin_amdgcn_s_barrier()
#define PG8_SCHED __builtin_amdgcn_sched_barrier(0)
    Unit cur, nxt; int ui = 0;
    if (!S.next(0, cur)) return;
    f32x4 acc[2][2][4][2];
#pragma unroll
    for (int a = 0; a < 2; ++a)
#pragma unroll
        for (int b = 0; b < 2; ++b)
#pragma unroll
            for (int m = 0; m < 4; ++m)
#pragma unroll
                for (int n = 0; n < 2; ++n) acc[a][b][m][n] = (f32x4){0.f, 0.f, 0.f, 0.f};
    bf16x8 At[4][2], B0[2][2], B1[2][2];
    const char* cA = (const char*)g.A + (size_t)cur.pm * tstep; const char* cB = (const char*)g.Bt + (size_t)cur.pn * tstep;
    S.a_ready(cur);
    if constexpr (SP2) {
        PG8_STAGE(PG8_SB(0, 0), cB, voffB); PG8_STAGE(PG8_SB(0, 1), cB + hstep, voffB); PG8_STAGE(PG8_SA(0, 0), cA, voffA); PG8_STAGE(PG8_SA(0, 1), cA + hstep, voffA);
        if (wr == 1) PG8_BAR;
        PG8_WAIT_V(2); PG8_BAR;
        PG8_STAGE(PG8_SB(1, 0), cB + kstep, voffB); PG8_STAGE(PG8_SA(1, 0), cA + kstep, voffA); PG8_STAGE(PG8_SB(1, 1), cB + hstep + kstep, voffB);
        PG8_WAIT_V(6); PG8_BAR;
    } else {
        PG8_STAGE(PG8_SB(0, 0), cB, voffB); PG8_STAGE(PG8_SA(0, 0), cA, voffA); PG8_STAGE(PG8_SB(0, 1), cB + hstep, voffB); PG8_STAGE(PG8_SA(0, 1), cA + hstep, voffA);
        if (wr == 1) PG8_BAR;
        PG8_WAIT_V(4); PG8_BAR;
        PG8_STAGE(PG8_SB(1, 0), cB + kstep, voffB); PG8_STAGE(PG8_SA(1, 0), cA + kstep, voffA); PG8_STAGE(PG8_SB(1, 1), cB + hstep + kstep, voffB);
        PG8_WAIT_V(6); PG8_BAR;
    }
    for (;;) {
        const bool has_next = S.next(ui + 1, nxt);
        const char* nA = has_next ? (const char*)g.A + (size_t)nxt.pm * tstep : cA; const char* nB = has_next ? (const char*)g.Bt + (size_t)nxt.pn * tstep : cB;
        for (int t = 0; t < nt; t += 2) {
            const bool last = (t == nt - 2);
            const char* a1 = cA + (size_t)(t + 1) * kstep;
            const char* a2 = last ? nA : cA + (size_t)(t + 2) * kstep; const char* b2 = last ? nB : cB + (size_t)(t + 2) * kstep;
            const char* a3 = a2 + kstep; const char* b3 = b2 + kstep;
            if (last && has_next) S.a_ready(nxt);
            if constexpr (SP2) {
            PG8_LDB(B0, 0, 0); PG8_LDB(B1, 0, 1); PG8_SCHED; PG8_LDA(At, 0, 0); PG8_STAGE(PG8_SA(1, 1), a1 + hstep, voffA);
            PG8_WAIT_V(8); PG8_WAIT_L(0); PG8_BAR; PG8_MMA(0, 0, At, B0); PG8_MMA(0, 1, At, B1); PG8_BAR; PG8_SCHED;
            PG8_LDA(At, 0, 1); PG8_STAGE(PG8_SB(0, 0), b2, voffB); PG8_STAGE(PG8_SB(0, 1), b2 + hstep, voffB); PG8_STAGE(PG8_SA(0, 0), a2, voffA);
            PG8_WAIT_V(8); PG8_WAIT_L(0); PG8_BAR; PG8_MMA(1, 0, At, B0); PG8_MMA(1, 1, At, B1); PG8_BAR; PG8_SCHED;
            PG8_LDB(B0, 1, 0); PG8_LDB(B1, 1, 1); PG8_SCHED; PG8_LDA(At, 1, 0); PG8_STAGE(PG8_SA(0, 1), a2 + hstep, voffA);
            PG8_WAIT_V(8); PG8_WAIT_L(0); PG8_BAR; PG8_MMA(0, 0, At, B0); PG8_MMA(0, 1, At, B1); PG8_BAR; PG8_SCHED;
            PG8_LDA(At, 1, 1); PG8_STAGE(PG8_SB(1, 0), b3, voffB); PG8_STAGE(PG8_SB(1, 1), b3 + hstep, voffB); PG8_STAGE(PG8_SA(1, 0), a3, voffA);
            PG8_WAIT_V(8); PG8_WAIT_L(0); PG8_BAR; PG8_MMA(1, 0, At, B0); PG8_MMA(1, 1, At, B1); PG8_BAR; PG8_SCHED;
            } else {
            PG8_LDB(B0, 0, 0); PG8_SCHED; PG8_LDA(At, 0, 0); PG8_STAGE(PG8_SA(1, 1), a1 + hstep, voffA);
            PG8_WAIT_L(8); PG8_BAR; PG8_WAIT_L(0); PG8_MMA(0, 0, At, B0); PG8_BAR; PG8_SCHED;
            PG8_LDB(B1, 0, 1); PG8_STAGE(PG8_SB(0, 0), b2, voffB);
            PG8_BAR; PG8_WAIT_L(0); PG8_MMA(0, 1, At, B1); PG8_BAR;
            PG8_LDA(At, 0, 1); PG8_STAGE(PG8_SA(0, 0), a2, voffA);
            PG8_BAR; PG8_WAIT_L(0); PG8_MMA(1, 0, At, B0); PG8_BAR; PG8_SCHED;
            PG8_STAGE(PG8_SB(0, 1), b2 + hstep, voffB);
            PG8_WAIT_V(6); PG8_BAR; PG8_MMA(1, 1, At, B1); PG8_BAR;
            PG8_LDB(B0, 1, 0); PG8_SCHED; PG8_LDA(At, 1, 0); PG8_STAGE(PG8_SA(0, 1), a2 + hstep, voffA);
            PG8_WAIT_L(8); PG8_BAR; PG8_WAIT_L(0); PG8_MMA(0, 0, At, B0); PG8_BAR; PG8_SCHED;
            PG8_LDB(B1, 1, 1); PG8_STAGE(PG8_SB(1, 0), b3, voffB);
            PG8_BAR; PG8_WAIT_L(0); PG8_MMA(0, 1, At, B1); PG8_BAR;
            PG8_LDA(At, 1, 1); PG8_STAGE(PG8_SA(1, 0), a3, voffA);
            PG8_BAR; PG8_WAIT_L(0); PG8_MMA(1, 0, At, B0); PG8_BAR; PG8_SCHED;
            PG8_STAGE(PG8_SB(1, 1), b3 + hstep, voffB);
            PG8_WAIT_V(6); PG8_BAR; PG8_MMA(1, 1, At, B1); PG8_BAR;
            }
        }
        if constexpr (ALIGN_EPI) { if (wr == 0) PG8_BAR; }
        if constexpr (!Epi::AFTER_DRAIN) { E(acc, cur, wr, wc, fr, fq); S.done(cur); }
        if (!has_next) break;
#pragma unroll
        for (int a = 0; a < 2; ++a)
#pragma unroll
            for (int b = 0; b < 2; ++b)
#pragma unroll
                for (int m = 0; m < 4; ++m)
#pragma unroll
                    for (int n = 0; n < 2; ++n) acc[a][b][m][n] = (f32x4){0.f, 0.f, 0.f, 0.f};
        cur = nxt; cA = nA; cB = nB; ++ui;
        if constexpr (ALIGN_EPI) { if (wr == 1) PG8_BAR; }
    }
    PG8_WAIT_V(0);
    if constexpr (!ALIGN_EPI) { if (wr == 0) PG8_BAR; }
    PG8_BAR;
    if constexpr (Epi::AFTER_DRAIN) { E.fused(acc, cur, wr, wc, fr, fq, lds, wid, lane); S.done(cur); }
#undef PG8_SA
#undef PG8_SB
#undef PG8_STAGE
#undef PG8_LDA
#undef PG8_LDB
#undef PG8_MMA
#undef PG8_WAIT_V
#undef PG8_WAIT_L
#undef PG8_BAR
#undef PG8_SCHED
}
}
#define GAS __attribute__((address_space(1)))
#define LAS __attribute__((address_space(3)))
typedef unsigned short bf16;
typedef unsigned v4u __attribute__((ext_vector_type(4)));
typedef float f32x4 __attribute__((ext_vector_type(4)));
typedef short bf16x8 __attribute__((ext_vector_type(8)));
typedef GAS unsigned gu32;
typedef GAS unsigned long long gu64;
#define RLX_AGENT __ATOMIC_RELAXED, __HIP_MEMORY_SCOPE_AGENT
#define LDS_WAIT() asm volatile("s_waitcnt lgkmcnt(0)" ::: "memory")
#define VM_WAIT() asm volatile("s_waitcnt vmcnt(0)" ::: "memory")
__device__ __forceinline__ unsigned long long rt() { return __builtin_amdgcn_s_memrealtime(); }
__device__ __forceinline__ unsigned f2bf(float f) { unsigned u = __builtin_bit_cast(unsigned, f); return (u + 0x7fffu + ((u >> 16) & 1u)) >> 16; }
__device__ __forceinline__ unsigned pk2(float lo, float hi) { return f2bf(lo) | (f2bf(hi) << 16); }
#define XB_TMO      128
#define XB_XCNT(j)  (256  + 64 * (j))
#define XB_XSUB(j)  (1280 + 64 * (j))
#define XB_XGEN(j)  (2304 + 64 * (j))
#define XB_TOP      3328
#define XB_TOPGEN   3392
#define XCD_BAR_WORDS 3456
#define XB_SPIN_CAP (1u << 18)

__device__ __forceinline__ unsigned xb_ld(unsigned* p)              { return __hip_atomic_load(p, __ATOMIC_RELAXED, __HIP_MEMORY_SCOPE_AGENT); }
__device__ __forceinline__ unsigned xb_add(unsigned* p, unsigned v) { return __hip_atomic_fetch_add(p, v, __ATOMIC_RELAXED, __HIP_MEMORY_SCOPE_AGENT); }
__device__ __forceinline__ unsigned xb_xcc_id() { return (unsigned)__builtin_amdgcn_s_getreg((3 << 11) | 20) & 0xFu; }
#define XB_SPIN(cond, bar) do { unsigned _sp = 0; while (cond) { __builtin_amdgcn_s_sleep(1); \
    if ((++_sp & 255u) == 0u) { if (xb_ld(&(bar)[XB_TMO])) break; if (_sp > XB_SPIN_CAP) { atomicAdd(&(bar)[XB_TMO], 1u); break; } } } } while (0)

struct XcdBarrier {
    unsigned* bar; unsigned x;
    volatile LAS unsigned* st;
};

__device__ __forceinline__ XcdBarrier xcd_barrier_post(unsigned* bar, volatile LAS unsigned* st) {
    XcdBarrier b; b.bar = bar; b.x = xb_xcc_id(); b.st = st;
    if (threadIdx.x == 0) (void)xb_add(&bar[XB_XCNT(b.x)], 1u);
    return b;
}
__device__ __forceinline__ void xcd_barrier_complete(unsigned* bar, unsigned x, unsigned& nloc, unsigned& nx) {
    const unsigned G = gridDim.x * gridDim.y * gridDim.z;
    unsigned sum, cnt, mine, sp = 0u;
    for (;;) {
        sum = 0u; cnt = 0u; mine = 0u;
#pragma unroll
        for (unsigned j = 0; j < 16; ++j) { const unsigned c = xb_ld(&bar[XB_XCNT(j)]); sum += c; cnt += (c > 0u) ? 1u : 0u; mine = (j == x) ? c : mine; }
        if (sum == G) break;
        __builtin_amdgcn_s_sleep(1);
        if ((++sp & 255u) == 0u) { if (xb_ld(&bar[XB_TMO])) break; if (sp > XB_SPIN_CAP) { atomicAdd(&bar[XB_TMO], 1u); break; } }
    }
    nloc = mine > 0u ? mine : 1u; nx = cnt > 0u ? cnt : 1u;
}

__device__ __forceinline__ void xcd_barrier(const XcdBarrier& b) {
    asm volatile("s_waitcnt vmcnt(0)" ::: "memory");
    __syncthreads();
    if (threadIdx.x == 0) {
        unsigned* bar = b.bar;
        __builtin_amdgcn_s_waitcnt(0);
        unsigned nloc = b.st[0], nx = b.st[1];
        if (nloc == 0u) { xcd_barrier_complete(bar, b.x, nloc, nx); b.st[0] = nloc; b.st[1] = nx; }
        const unsigned old = xb_add(&bar[XB_XSUB(b.x)], 1u);
        const unsigned gen = old / nloc;
        if (old + 1u == (gen + 1u) * nloc) {
            __builtin_amdgcn_fence(__ATOMIC_RELEASE, "agent");
            asm volatile("s_waitcnt vmcnt(0)" ::: "memory");
            const unsigned og = xb_add(&bar[XB_TOP], 1u);
            const unsigned tg = og / nx;
            if (og + 1u == (tg + 1u) * nx) xb_add(&bar[XB_TOPGEN], 1u);
            else XB_SPIN(xb_ld(&bar[XB_TOPGEN]) == tg, bar);
            __builtin_amdgcn_fence(__ATOMIC_ACQUIRE, "agent");
            xb_add(&bar[XB_XGEN(b.x)], 1u);
            asm volatile("s_waitcnt vmcnt(0)" ::: "memory");
        } else {
            XB_SPIN(xb_ld(&bar[XB_XGEN(b.x)]) == gen, bar);
            __builtin_amdgcn_fence(__ATOMIC_ACQUIRE, "agent");
            asm volatile("s_waitcnt vmcnt(0)" ::: "memory");
        }
    }
    __syncthreads();
}
constexpr int NB = 8, SEQ = 4096, DM = 1024, DEPTH = 4, M = NB * SEQ;
constexpr int FF = 2816, NIN = 5852, NINP = 5888;
constexpr float EPS = 1e-6f, NEGF = -1e30f;
constexpr int NWAVES = 8;
constexpr size_t MiB = 1u << 20;
constexpr size_t WS_CTL = 0, CTL_ZERO_BYTES = 1 * MiB;
constexpr size_t WS_ROPE = 1 * MiB;
constexpr size_t WS_KVA = 3 * MiB;
constexpr size_t WS_KC = 11 * MiB, WS_VC = WS_KC + 512 * 1024;
constexpr size_t WS_W = 12 * MiB;
constexpr size_t WO_GU1 = 0, WO_D1 = 11 * MiB, WO_GU2 = WO_D1 + 5 * MiB + 512 * 1024, WO_D2 = WO_GU2 + 11 * MiB, WO_IN = WO_D2 + 5 * MiB + 512 * 1024,
                 WO_PA = WO_IN + 11 * MiB + 512 * 1024, WO_PB = WO_PA + MiB, WO_PC = WO_PB + MiB, WO_OUT = WO_PC + MiB,
                 WO_CW1 = WO_OUT + 2 * MiB  , WO_CW2 = WO_CW1 + MiB  , WO_UKV = WO_CW2 + 32768  , WO_POOL = WO_UKV + 32768  ,
                 WO_POSB = WO_POOL + 131072  , WO_END = WO_POSB + 1024;
static_assert(WO_END <= 52 * MiB, "weights region");
constexpr size_t WS_XN = 64 * MiB;
constexpr size_t WS_R = 128 * MiB;
constexpr size_t WS_G = WS_R, WS_QA = WS_R + 192 * MiB, WS_QC = WS_QA + 32 * MiB, WS_IQ = WS_QC + 32 * MiB, WS_MISC = WS_IQ + 16 * MiB,
                 WS_KVC = WS_MISC + 16 * MiB, WS_KVS = WS_KVC + 16 * MiB, WS_KVW = WS_KVS + 16 * MiB, WS_BU = WS_KVW + 16 * MiB, WS_END = WS_BU + 32 * MiB;
#ifndef YB_SPARE
#define YB_SPARE 0
#endif
constexpr size_t WS_YB = YB_SPARE ? 496 * MiB : WS_XN;
constexpr size_t WS_MG = WS_IQ;
constexpr size_t WS_H = WS_R;
static_assert(WS_END == 496 * MiB, "ws map");
constexpr int RING_BYTES = 131072, LDS_BYTES = 163840, LDSCTL_OFF = 163840 - 256;
constexpr size_t WS_SSQ = 496 * MiB;
constexpr int RS_OFF = 131072;
constexpr int NPL = 10, NPH = 1 + DEPTH * NPL + 1;

__device__ __forceinline__ int lane_id_v() { int l; asm volatile("v_mbcnt_lo_u32_b32 %0, -1, 0\n\tv_mbcnt_hi_u32_b32 %0, -1, %0" : "=v"(l)); return l; }
__device__ __forceinline__ float bflo(unsigned w) { return __uint_as_float(w << 16); }
__device__ __forceinline__ float bfhi(unsigned w) { return __uint_as_float(w & 0xffff0000u); }
__device__ __forceinline__ float bf2f(bf16 v) { return __uint_as_float((unsigned)v << 16); }
__device__ __forceinline__ float wave_sum(float v) {
#pragma unroll
    for (int o = 1; o < 64; o <<= 1) v += __shfl_xor(v, o);
    return v;
}
__device__ __forceinline__ float wave_max(float v) {
#pragma unroll
    for (int o = 1; o < 64; o <<= 1) v = fmaxf(v, __shfl_xor(v, o));
    return v;
}
__device__ __forceinline__ int wave_sum_i(int v) {
#pragma unroll
    for (int o = 1; o < 64; o <<= 1) v += __shfl_xor(v, o);
    return v;
}
__device__ __forceinline__ unsigned wave_max_u(unsigned v) {
#pragma unroll
    for (int o = 1; o < 64; o <<= 1) { const unsigned w = (unsigned)__shfl_xor((int)v, o); v = w > v ? w : v; }
    return v;
}
#define WAVE_LDS_SYNC() do { asm volatile("s_waitcnt lgkmcnt(0)" ::: "memory"); __builtin_amdgcn_wave_barrier(); } while (0)
__host__ __device__ __forceinline__ int permd(int d) { return d < 8 ? 2 * d : (d < 16 ? 2 * (d - 8) + 1 : d); }
__device__ __forceinline__ int win_newcol(int n) {
    if (n < 512) return (n & ~63) + permd(n & 63);
    if (n < 640) return 1280 + 64 + (n - 512);
    if (n < 896) { const int m = n - 640; return 1024 + (m & ~63) + permd(m & 63); }
    if (n < 960) return 1280 + permd(n - 896);
    if (n < 964) return 1280 + 192 + (n - 960);
    if (n < 1476) return 2304 + (n - 964);
    if (n < 1988) { const int m = n - 1476; return 512 + (m & ~63) + permd(m & 63); }
    if (n < 2756) { const int m = n - 1988, kv = m >> 8, r = m & 255, base = 1536 + kv * 256; return r < 128 ? base + (r & ~63) + permd(r & 63) : base + r; }
    if (n < 2780) return 1280 + 196 + (n - 2756);
    return 2816 + (n - 2780);
}
__device__ __forceinline__ int map_row(int mode, int n) { return mode == 0 ? n : (mode == 1 ? ((n >> 7) << 8) + (n & 127) : (mode == 2 ? ((n >> 7) << 8) + 128 + (n & 127) : win_newcol(n))); }

struct Args { const float* in[24]; float* out; unsigned char* ws; int ph_lo, ph_hi; };

__device__ __forceinline__ int unperm(int p) { return p < 16 ? ((p & 1) ? (p >> 1) + 8 : (p >> 1)) : p; }
__device__ __forceinline__ void tr_item(const float* W, int K, int N, bf16* WT, int mode, LAS float* scr, int item, int lane, bool kperm = false, const float* kscale = nullptr) {
    const int nblk = (N + 31) >> 5, kb = item / nblk, nb = item - kb * nblk, k0 = 64 * kb, n0 = 32 * nb;
    const int nn = n0 + (lane & 31);
#pragma unroll
    for (int i = 0; i < 32; ++i) { const int kk = 2 * i + (lane >> 5); const float sc_ = kscale ? kscale[k0 + kk] : 1.0f; scr[kk * 33 + (lane & 31)] = nn < N ? W[(size_t)(k0 + kk) * N + nn] * sc_ : 0.f; }
    LDS_WAIT(); asm volatile("" ::: "memory");
    const int c = lane & 7;
#pragma unroll
    for (int j = 0; j < 4; ++j) { const int n = (lane >> 3) + 8 * j; const LAS float* s = scr + n;
        int ks[8];
#pragma unroll
        for (int i = 0; i < 8; ++i) ks[i] = (kperm ? unperm(8 * c + i) : 8 * c + i) * 33;
        v4u o; o.x = pk2(s[ks[0]], s[ks[1]]); o.y = pk2(s[ks[2]], s[ks[3]]); o.z = pk2(s[ks[4]], s[ks[5]]); o.w = pk2(s[ks[6]], s[ks[7]]);
        if (n0 + n < N) *(v4u*)(WT + (size_t)map_row(mode, n0 + n) * K + k0 + 8 * c) = o; }
    LDS_WAIT(); asm volatile("" ::: "memory");
}
__device__ __forceinline__ void phase_convert(const Args& P, unsigned char* ws, int z, int l, LAS unsigned char* lds, int gw, int NGW, int lane, int wave) {
    asm volatile("" : "+v"(lane)); lane &= 63; asm volatile("" : "+s"(gw), "+s"(NGW));
    LAS float* scr = (LAS float*)(lds + wave * 16384);
    unsigned char* wb = ws + WS_W;
    constexpr int I_F = 16 * 88, I_D = 44 * 32, I_IN = 16 * 183, I_P = 8 * 32, I_O = 16 * 32;
    constexpr int I_C = 32 * 4;
    constexpr int NIT = 4 * I_F + 2 * I_D + I_IN + 3 * I_P + I_O + 2 * I_C;
    const size_t fo = (size_t)l * DM * FF;
    for (int it = gw; it < NIT; it += NGW) {
        int r = it, K = DM, N = FF, mode = 1; const float* W = P.in[3 + z] + fo; size_t wo = WO_GU1; bool kperm = false; const float* ksc = P.in[2 + z] + l * DM;
        if (r >= I_F) { r -= I_F; mode = 2; W = P.in[4 + z] + fo;
        if (r >= I_F) { r -= I_F; mode = 0; W = P.in[5 + z] + fo; K = FF; N = DM; wo = WO_D1; ksc = nullptr;
        if (r >= I_D) { r -= I_D; mode = 1; W = P.in[20 + z] + fo; K = DM; N = FF; wo = WO_GU2; ksc = P.in[19 + z] + l * DM;
        if (r >= I_F) { r -= I_F; mode = 2; W = P.in[21 + z] + fo;
        if (r >= I_F) { r -= I_F; mode = 0; W = P.in[22 + z] + fo; K = FF; N = DM; wo = WO_D2; ksc = nullptr;
        if (r >= I_D) { r -= I_D; mode = 3; W = P.in[7 + z] + (size_t)l * DM * NIN; K = DM; N = NIN; wo = WO_IN; ksc = P.in[6 + z] + l * DM;
        if (r >= I_IN) { r -= I_IN; mode = 0; W = P.in[15 + z] + (size_t)l * 512 * DM; K = 512; N = DM; wo = WO_PA; ksc = nullptr;
        if (r >= I_P) { r -= I_P; W = P.in[16 + z] + (size_t)l * 512 * DM; wo = WO_PB;
        if (r >= I_P) { r -= I_P; W = P.in[17 + z] + (size_t)l * 512 * DM; wo = WO_PC;
        if (r >= I_P) { r -= I_P; W = P.in[18 + z] + (size_t)l * DM * DM; K = DM; wo = WO_OUT;
        if (r >= I_O) { r -= I_O; W = P.in[13 + z] + (size_t)(l * 2) * 2048 * 128; K = 2048; N = 128; wo = WO_CW1; kperm = true;
        if (r >= I_C) { r -= I_C; W += (size_t)2048 * 128; wo = WO_CW1 + 128 * 2048 * 2; kperm = false; } } } } } } } } } } } }
        tr_item(W, K, N, (bf16*)(wb + wo), mode, scr, r, lane, kperm, ksc);
    }
    {
        const int gt = gw * 64 + lane, GT = NGW * 64;
        bf16* ukv = (bf16*)(wb + WO_UKV); bf16* pool = (bf16*)(wb + WO_POOL); bf16* cw2 = (bf16*)(wb + WO_CW2); float* posb = (float*)(wb + WO_POSB);
        const float* w_ukv = P.in[9 + z] + (size_t)l * 128 * 128; const float* gn = P.in[8 + z] + l * 128;
        for (int i = gt; i < 128 * 128; i += GT) { const int np = i >> 7, k = i & 127, n = np < 64 ? unperm(np) : np; ukv[i] = (bf16)f2bf(gn[k] * w_ukv[k * 128 + n]); }
        const float* pw = P.in[10 + z] + (size_t)l * 4 * 128 * 128; const float* psc = P.in[11 + z] + l * 512;
        for (int i = gt; i < 4 * 128 * 128; i += GT) { const int g = i >> 14, d = (i >> 7) & 127, c = i & 127; pool[i] = (bf16)f2bf(pw[(g * 128 + c) * 128 + d] * psc[g * 128 + d]); }
        const float* w2 = P.in[14 + z] + (size_t)l * 2 * 128 * 64;
        for (int i = gt; i < 2 * 64 * 128; i += GT) { const int br = i >> 13, dp = (i >> 7) & 63, n = i & 127, d = br ? dp : unperm(dp); cw2[i] = (bf16)f2bf(w2[(br * 128 + n) * 64 + d]); }
        const float* w1 = P.in[13 + z] + (size_t)l * 2 * 2048 * 128; const float* pos = P.in[12 + z] + (size_t)l * 2 * 2048;
        for (int i = gw; i < 256; i += NGW) { const int br = i >> 7, n = i & 127; float a = 0.f;
#pragma unroll 8
            for (int k = lane; k < 2048; k += 64) a += pos[br * 2048 + k] * w1[((size_t)br * 2048 + k) * 128 + n];
            a = wave_sum(a); if (lane == 0) posb[i] = a; }
    }
    if (gw < 36) { unsigned zz = 0u; asm volatile("" : "+v"(zz)); v4u z = {zz, zz, zz, zz}; v4u* rp = (v4u*)((bf16*)(wb + WO_IN) + (size_t)(1500 + gw) * DM); for (int i = lane; i < DM / 8; i += 64) rp[i] = z; }
}
__device__ __forceinline__ void phase_rope(const Args& P, unsigned char* ws, int z, int gtid, int gthreads) {
    float* rope = (float*)(ws + WS_ROPE);
    for (int idx = gtid; idx < M * 8; idx += gthreads) {
        const int row = idx >> 3, i = idx & 7;
        const double inv = i == 0 ? 1.0 : i == 1 ? 0.19392274474868576 : i == 2 ? 0.03760603093086393 : i == 3 ? 0.007292664737217109 : i == 4 ? 0.001414213562373095 : i == 5 ? 0.0002742481756762073 : i == 6 ? 5.318295896944988e-05 : 1.031338537721246e-05;
        const double ang = (double)((const int*)P.in[1 + z])[row] * inv;
        double s, c; sincos(ang, &s, &c);
        rope[row * 16 + i] = (float)c; rope[row * 16 + 8 + i] = (float)s;
    }
}
__device__ __forceinline__ void norm_row_bf16(const float* xrow, const float* gain, bf16* orow, int lane) {
    const f32x4* xr = (const f32x4*)xrow + lane; const f32x4* gr = (const f32x4*)gain + lane;
    f32x4 v[4]; float s = 0.f;
#pragma unroll
    for (int j = 0; j < 4; ++j) { v[j] = xr[64 * j]; s += (v[j].x * v[j].x + v[j].y * v[j].y) + (v[j].z * v[j].z + v[j].w * v[j].w); }
    const float r = 1.0f / sqrtf(wave_sum(s) * (1.f / DM) + EPS);
    unsigned long long* o8 = (unsigned long long*)orow + lane;
#pragma unroll
    for (int j = 0; j < 4; ++j) { const f32x4 g = gr[64 * j]; o8[64 * j] = (unsigned long long)pk2(v[j].x * r * g.x, v[j].y * r * g.y) | ((unsigned long long)pk2(v[j].z * r * g.z, v[j].w * r * g.w) << 32); }
}
__device__ __forceinline__ void stat_row_bf16(const float* xrow, bf16* orow, float* ssq16, int lane) {
    const f32x4* xr = (const f32x4*)xrow + lane;
    f32x4 v[4]; float s = 0.f;
#pragma unroll
    for (int j = 0; j < 4; ++j) { v[j] = xr[64 * j]; s += (v[j].x * v[j].x + v[j].y * v[j].y) + (v[j].z * v[j].z + v[j].w * v[j].w); }
    s = wave_sum(s);
    unsigned long long* o8 = (unsigned long long*)orow + lane;
#pragma unroll
    for (int j = 0; j < 4; ++j) o8[64 * j] = (unsigned long long)pk2(v[j].x, v[j].y) | ((unsigned long long)pk2(v[j].z, v[j].w) << 32);
    if (lane < 16) ssq16[lane] = lane == 0 ? s : 0.f;
}
__device__ __forceinline__ void norm_row_f32(float* xrow, const float* gain, int lane) {
    f32x4* xr = (f32x4*)xrow + lane; const f32x4* gr = (const f32x4*)gain + lane;
    f32x4 v[4]; float s = 0.f;
#pragma unroll
    for (int j = 0; j < 4; ++j) { v[j] = xr[64 * j]; s += (v[j].x * v[j].x + v[j].y * v[j].y) + (v[j].z * v[j].z + v[j].w * v[j].w); }
    const float r = 1.0f / sqrtf(wave_sum(s) * (1.f / DM) + EPS);
#pragma unroll
    for (int j = 0; j < 4; ++j) { const f32x4 g = gr[64 * j]; xr[64 * j] = v[j] * r * g; }
}
__device__ __forceinline__ unsigned f2o(float s) { const unsigned b = __float_as_uint(s); return (b & 0x80000000u) ? ~b : (b | 0x80000000u); }
__device__ __forceinline__ void unpack8(const v4u v, float* f) { f[0] = bflo(v.x); f[1] = bfhi(v.x); f[2] = bflo(v.y); f[3] = bfhi(v.y); f[4] = bflo(v.z); f[5] = bfhi(v.z); f[6] = bflo(v.w); f[7] = bfhi(v.w); }
__device__ __forceinline__ void load_row64(const bf16* p, float* f) {
    const v4u* q = (const v4u*)p;
#pragma unroll
    for (int i = 0; i < 8; ++i) unpack8(q[i], f + 8 * i);
}
__device__ __forceinline__ float dot64(const LAS float* q, const float* k) {
    float d = 0.f;
#pragma unroll
    for (int i = 0; i < 16; ++i) { const f32x4 qq = *(const LAS f32x4*)(q + 4 * i); d += qq.x * k[4 * i] + qq.y * k[4 * i + 1] + qq.z * k[4 * i + 2] + qq.w * k[4 * i + 3]; }
    return d;
}
__device__ __forceinline__ void dsa_query(const Args& P, unsigned char* ws, int z, int row, LAS unsigned char* wl, int lane) {
    const int b = row >> 12, t = row & (SEQ - 1), n = t + 1;
    LAS unsigned* su = (LAS unsigned*)wl; LAS float* pb = (LAS float*)wl; LAS unsigned short* list = (LAS unsigned short*)(wl + 16384); LAS float* qb = (LAS float*)(wl + 16896);
    const bf16* misc = (const bf16*)(ws + WS_MISC);
    const unsigned long long lt = (1ull << lane) - 1ull;
    int nsel;
    if (n <= 256) { for (int i = lane; i < n; i += 64) list[i] = (unsigned short)i; nsel = n; }
    else {
        { const uint2 v = *(const uint2*)((const bf16*)(ws + WS_IQ) + (size_t)row * 256 + lane * 4); qb[lane * 4] = bflo(v.x); qb[lane * 4 + 1] = bfhi(v.x); qb[lane * 4 + 2] = bflo(v.y); qb[lane * 4 + 3] = bfhi(v.y); }
        float iw[4]; { const uint2 v = *(const uint2*)(misc + (size_t)row * 256 + 192); iw[0] = 0.5f * bflo(v.x); iw[1] = 0.5f * bfhi(v.x); iw[2] = 0.5f * bflo(v.y); iw[3] = 0.5f * bfhi(v.y); }
        WAVE_LDS_SYNC();
        const int nch = (n + 63) >> 6;
        for (int i = 0; i < nch; ++i) {
            const int key = i * 64 + lane; const bool valid = key <= t;
            float kf[64]; load_row64(misc + (size_t)(b * SEQ + (valid ? key : t)) * 256, kf);
            float s = 0.f;
#pragma unroll
            for (int h = 0; h < 4; ++h) s += iw[h] * fmaxf(dot64(qb + h * 64, kf), 0.f);
            su[key] = valid ? f2o(s) : 0u;
        }
        WAVE_LDS_SYNC();
        unsigned prefix = 0u;
        for (int bit = 31; bit >= 0; --bit) {
            const unsigned cand = prefix | (1u << bit); int c = 0;
            for (int i = 0; i < nch; ++i) c += (su[i * 64 + lane] >= cand) ? 1 : 0;
            c = wave_sum_i(c);
            if (c >= 256) prefix = cand;
            if (c == 256) break;
        }
        int cgt = 0;
        for (int i = 0; i < nch; ++i) cgt += (su[i * 64 + lane] > prefix) ? 1 : 0;
        const int need_eq = 256 - wave_sum_i(cgt);
        int base = 0, eq_taken = 0;
        for (int i = 0; i < nch; ++i) {
            const unsigned v = su[i * 64 + lane]; const bool gt = v > prefix, eq = v == prefix;
            const unsigned long long meq = __ballot(eq);
            const bool sel = gt || (eq && (eq_taken + __popcll(meq & lt)) < need_eq);
            const unsigned long long ms = __ballot(sel);
            if (sel) list[base + __popcll(ms & lt)] = (unsigned short)(i * 64 + lane);
            base += __popcll(ms); eq_taken += __popcll(meq);
        }
        nsel = 256;
    }
    { const v4u v = *(const v4u*)((const bf16*)(ws + WS_QA) + (size_t)row * 512 + lane * 8); float f[8]; unpack8(v, f);
#pragma unroll
      for (int e = 0; e < 8; ++e) qb[lane * 8 + e] = f[e]; }
    WAVE_LDS_SYNC();
    const bf16* kva = (const bf16*)(ws + WS_KVA);
    float s[8][4];
#pragma unroll
    for (int j = 0; j < 4; ++j) {
        const int slot = lane + 64 * j; const bool valid = slot < nsel; const int key = list[valid ? slot : 0];
        float kf[64]; load_row64(kva + (size_t)(b * SEQ + key) * 128, kf);
#pragma unroll
        for (int h = 0; h < 8; ++h) s[h][j] = valid ? dot64(qb + h * 64, kf) : NEGF;
    }
    float linv[8];
#pragma unroll
    for (int h = 0; h < 8; ++h) {
        const float m = wave_max(fmaxf(fmaxf(s[h][0], s[h][1]), fmaxf(s[h][2], s[h][3]))); float ls = 0.f;
#pragma unroll
        for (int j = 0; j < 4; ++j) { const float p = __expf(s[h][j] - m); ls += p; pb[h * 256 + lane + 64 * j] = p; }
        linv[h] = 1.0f / wave_sum(ls);
    }
    WAVE_LDS_SYNC();
    float acc[8] = {0.f, 0.f, 0.f, 0.f, 0.f, 0.f, 0.f, 0.f};
    for (int slot = 0; slot < nsel; ++slot) {
        const float v = bf2f(kva[(size_t)(b * SEQ + list[slot]) * 128 + 64 + lane]);
#pragma unroll
        for (int h = 0; h < 8; ++h) acc[h] += pb[h * 256 + slot] * v;
    }
    bf16* ya = (bf16*)(ws + WS_QA) + (size_t)row * 512;
#pragma unroll
    for (int h = 0; h < 8; ++h) ya[h * 64 + lane] = (bf16)f2bf(acc[h] * linv[h]);
    WAVE_LDS_SYNC();
}
typedef short s16x4 __attribute__((ext_vector_type(4)));
typedef short v4i16_t __attribute__((ext_vector_type(4)));
typedef float f32x4v __attribute__((ext_vector_type(4)));
typedef __bf16 bf16x2_t __attribute__((ext_vector_type(2)));
typedef float f32x2_t __attribute__((ext_vector_type(2)));
__device__ __forceinline__ unsigned cvtpk(float lo, float hi) { f32x2_t v = {lo, hi}; bf16x2_t b = __builtin_convertvector(v, bf16x2_t); return __builtin_bit_cast(unsigned, b); }
constexpr float L2E = 1.4426950408889634f;
#ifndef NSA_NOSKIP
#define NSA_NOSKIP 0
#endif
constexpr int NSA_KSTR = 72, NSA_VSTR = 80;
constexpr int NSA_KB = 64 * NSA_KSTR * 2, NSA_VB = 64 * NSA_VSTR * 2;
constexpr int NSA_D = 6, NSA_SLOT = 16384;
constexpr int NSA_OFF_RING = 0, NSA_OFF_KCL = 0, NSA_OFF_VCTL = 32768  , NSA_OFF_IMPA = 65536  , NSA_OFF_IMPB = NSA_OFF_IMPA + 64 * 65 * 4, NSA_OFF_UM = NSA_D * NSA_SLOT, NSA_OFF_QM = NSA_OFF_UM + 64, NSA_OFF_ST = NSA_OFF_UM + 1024, NSA_LDS = NSA_OFF_ST + 512 * 64;
__device__ __forceinline__ s16x4 tr16(const LAS unsigned char* p) { return __builtin_bit_cast(s16x4, __builtin_amdgcn_ds_read_tr16_b64_v4i16((LAS v4i16_t*)p)); }
__device__ __forceinline__ bf16x8 cat4(s16x4 a, s16x4 b) { return __builtin_shufflevector(a, b, 0, 1, 2, 3, 4, 5, 6, 7); }
__device__ __forceinline__ bf16x8 pack8(float a0, float a1, float a2, float a3, float b0, float b1, float b2, float b3) {
    v4u w; w.x = pg8::cvt_pk_bf16(a0, a1); w.y = pg8::cvt_pk_bf16(a2, a3); w.z = pg8::cvt_pk_bf16(b0, b1); w.w = pg8::cvt_pk_bf16(b2, b3); return __builtin_bit_cast(bf16x8, w);
}
__device__ __forceinline__ float xmax16(float v) { v = fmaxf(v, __shfl_xor(v, 16)); return fmaxf(v, __shfl_xor(v, 32)); }
__device__ __forceinline__ float xsum16(float v) { v += __shfl_xor(v, 16); return v + __shfl_xor(v, 32); }

__device__ __forceinline__ void nsa_fetch(const bf16* kv, int b, int jb, int g, int tid, v4u& kr, v4u& vr) {
    const bf16* p = kv + (size_t)(b * SEQ + 64 * jb + (tid >> 3)) * 256 + g * 64 + (tid & 7) * 8;
    kr = *(const v4u*)p; vr = *(const v4u*)(p + 128);
}
__device__ __forceinline__ void nsa_stash(LAS unsigned char* Kb, LAS unsigned char* Vb, int tid, const v4u& kr, const v4u& vr) {
    *(LAS v4u*)(Kb + ((tid >> 3) * NSA_KSTR + (tid & 7) * 8) * 2) = kr; *(LAS v4u*)(Vb + ((tid >> 3) * NSA_VSTR + (tid & 7) * 8) * 2) = vr;
}
template <bool FULL>
__device__ __forceinline__ void nsa_block2(const LAS unsigned char* Kb, const LAS unsigned char* Vb, const bf16x8 (&qf)[2][2], const bool (&sel)[2], const int (&klo)[2], const int (&khi)[2],
                                           float (&mrow)[2], float (&lrow)[2], f32x4v (&o)[2][4], int lane) {
    const int j = lane & 15, gq = lane >> 4;
    f32x4v s[2][4];
#pragma unroll
    for (int kt = 0; kt < 4; ++kt) {
        s[0][kt] = (f32x4v){0.f, 0.f, 0.f, 0.f}; s[1][kt] = (f32x4v){0.f, 0.f, 0.f, 0.f};
#pragma unroll
        for (int ks = 0; ks < 2; ++ks) {
            const bf16x8 kf = *(const LAS bf16x8*)(Kb + (16 * kt + j) * 128 + (((gq + 4 * ks) ^ (j & 7)) << 4));
            s[0][kt] = __builtin_amdgcn_mfma_f32_16x16x32_bf16(kf, qf[0][ks], s[0][kt], 0, 0, 0);
            s[1][kt] = __builtin_amdgcn_mfma_f32_16x16x32_bf16(kf, qf[1][ks], s[1][kt], 0, 0, 0);
        }
    }
#pragma unroll
    for (int rg = 0; rg < 2; ++rg) {
        float bm = NEGF;
        if (FULL) { const float bias = sel[rg] ? 0.f : NEGF;
#pragma unroll
            for (int kt = 0; kt < 4; ++kt)
#pragma unroll
                for (int e = 0; e < 4; ++e) { const float v = s[rg][kt][e] + bias; s[rg][kt][e] = v; bm = fmaxf(bm, v); }
        } else {
#pragma unroll
            for (int kt = 0; kt < 4; ++kt)
#pragma unroll
                for (int e = 0; e < 4; ++e) { const int ko = 16 * kt + 4 * gq + e; const bool ok = sel[rg] && ko >= klo[rg] && ko <= khi[rg]; const float v = ok ? s[rg][kt][e] : NEGF; s[rg][kt][e] = v; bm = fmaxf(bm, v); }
        }
        bm = xmax16(bm);
        const float mnew = fmaxf(mrow[rg], bm), alpha = __builtin_amdgcn_exp2f(mrow[rg] - mnew);
        const bool moved = __builtin_amdgcn_ballot_w64(mnew != mrow[rg]) != 0ull;
        mrow[rg] = mnew;
        float ps = 0.f;
#pragma unroll
        for (int kt = 0; kt < 4; ++kt)
#pragma unroll
            for (int e = 0; e < 4; ++e) { const float p = __builtin_amdgcn_exp2f(s[rg][kt][e] - mnew); s[rg][kt][e] = p; ps += p; }
        lrow[rg] = lrow[rg] * alpha + ps;
        if (moved) {
#pragma unroll
            for (int dt = 0; dt < 4; ++dt) o[rg][dt] *= alpha;
        }
    }
#pragma unroll
    for (int kk = 0; kk < 2; ++kk) {
        const bf16x8 pf0 = pack8(s[0][2 * kk][0], s[0][2 * kk][1], s[0][2 * kk][2], s[0][2 * kk][3], s[0][2 * kk + 1][0], s[0][2 * kk + 1][1], s[0][2 * kk + 1][2], s[0][2 * kk + 1][3]);
        const bf16x8 pf1 = pack8(s[1][2 * kk][0], s[1][2 * kk][1], s[1][2 * kk][2], s[1][2 * kk][3], s[1][2 * kk + 1][0], s[1][2 * kk + 1][1], s[1][2 * kk + 1][2], s[1][2 * kk + 1][3]);
#pragma unroll
        for (int dt = 0; dt < 4; ++dt) {
            const LAS unsigned char* va = Vb + (32 * kk + 4 * gq + (j >> 2)) * 128 + (16 * dt + 4 * (j & 3)) * 2;
            const bf16x8 vf = cat4(tr16(va), tr16(va + 16 * 128));
            o[0][dt] = __builtin_amdgcn_mfma_f32_16x16x32_bf16(vf, pf0, o[0][dt], 0, 0, 0);
            o[1][dt] = __builtin_amdgcn_mfma_f32_16x16x32_bf16(vf, pf1, o[1][dt], 0, 0, 0);
        }
        }
}
__device__ __forceinline__ void glds16(const void* gsrc, unsigned lds_dst) { unsigned keep;
    asm volatile("s_mov_b32 %0, m0\n\ts_mov_b32 m0, %2\n\ts_nop 0\n\tglobal_load_lds_dwordx4 %1, off\n\ts_mov_b32 m0, %0" : "=&s"(keep) : "v"(gsrc), "s"(lds_dst) : "memory"); }
template <int MODE>
__device__ __forceinline__ void nsa_attend(const bf16* kv, unsigned long long mask, int b, int g, int c, int tid, int lane, LAS unsigned char* ring, const bf16x8 (&qf)[2][2],
                                           const unsigned long long (&rmask)[2], const unsigned long long (&gmask)[2], const int (&trow)[2], float (&mrow)[2], float (&lrow)[2], f32x4v (&o)[2][4]) {
    const int wave = __builtin_amdgcn_readfirstlane(tid >> 6);
    const int rr = 8 * wave + (lane >> 3);
    const bf16* gk = kv + (size_t)(b * SEQ + rr) * 256 + g * 64 + (((lane & 7) ^ (rr & 7)) << 3);
    const bf16* gv = kv + (size_t)(b * SEQ + rr) * 256 + 128 + g * 64 + ((lane & 7) << 3);
    const unsigned ring0 = (unsigned)(uintptr_t)(unsigned char*)ring + wave * 1024;
#define NSA_ISSUE(jb_, slot_) do { glds16(gk + (size_t)(jb_) * 64 * 256, (unsigned)__builtin_amdgcn_readfirstlane(ring0 + (slot_) * NSA_SLOT)); \
                                   glds16(gv + (size_t)(jb_) * 64 * 256, (unsigned)__builtin_amdgcn_readfirstlane(ring0 + (slot_) * NSA_SLOT + 8192)); } while (0)
    unsigned long long remi = mask, remc = mask; int lastb = 0, si = 0, sc_ = 0;
#if DUP == 12
    float m2_[2] = {NEGF, NEGF}, l2_[2] = {0.f, 0.f}; f32x4v o2_[2][4]; for (int rg = 0; rg < 2; ++rg) for (int dt = 0; dt < 4; ++dt) o2_[rg][dt] = (f32x4v){0.f, 0.f, 0.f, 0.f};
#endif
#pragma unroll
    for (int d = 0; d < NSA_D - 1; ++d) { if (remi) { lastb = (int)__builtin_ctzll(remi); remi &= remi - 1ull; } NSA_ISSUE(lastb, si); si = si + 1 == NSA_D ? 0 : si + 1; }
    while (remc) {
        const int jj = (int)__builtin_ctzll(remc); remc &= remc - 1ull;
        asm volatile("s_waitcnt vmcnt(8) lgkmcnt(0)\n\ts_barrier" ::: "memory");
        if (remi) { lastb = (int)__builtin_ctzll(remi); remi &= remi - 1ull; }
        NSA_ISSUE(lastb, si); si = si + 1 == NSA_D ? 0 : si + 1;
        const LAS unsigned char* kb_ = ring + sc_ * NSA_SLOT; const LAS unsigned char* vb_ = kb_ + 8192; sc_ = sc_ + 1 == NSA_D ? 0 : sc_ + 1;
        bool sel[2]; int klo[2], khi[2]; bool act[2];
#pragma unroll
        for (int rg = 0; rg < 2; ++rg) { const int o6 = trow[rg] & 63;
            if (MODE == 0) { sel[rg] = (rmask[rg] >> jj) & 1ull; act[rg] = (gmask[rg] >> jj) & 1ull; klo[rg] = 0; khi[rg] = (jj == c) ? o6 : 63; }
            else { sel[rg] = true; act[rg] = true; klo[rg] = (jj == c - 4) ? o6 + 1 : 0; khi[rg] = (jj == c) ? o6 : 63; } }
        if (act[0] || act[1]) {
            const bool full = (MODE == 0) ? (jj != c) : (jj != c && jj != c - 4);
            if (full) nsa_block2<true>(kb_, vb_, qf, sel, klo, khi, mrow, lrow, o, lane); else nsa_block2<false>(kb_, vb_, qf, sel, klo, khi, mrow, lrow, o, lane);
#if DUP == 12
            if (full) nsa_block2<true>(kb_, vb_, qf, sel, klo, khi, m2_, l2_, o2_, lane); else nsa_block2<false>(kb_, vb_, qf, sel, klo, khi, m2_, l2_, o2_, lane);
#endif
        }
    }
#if DUP == 12
    { float acc_ = 0.f; for (int rg = 0; rg < 2; ++rg) { acc_ += l2_[rg] + m2_[rg]; for (int dt = 0; dt < 4; ++dt) acc_ += o2_[rg][dt][0] + o2_[rg][dt][1] + o2_[rg][dt][2] + o2_[rg][dt][3]; } if (acc_ == 123.456f) ((LAS float*)(ring + NSA_D * NSA_SLOT + 600))[0] = acc_; }
#endif
    asm volatile("s_waitcnt vmcnt(0) lgkmcnt(0)\n\ts_barrier" ::: "memory");
#undef NSA_ISSUE
}
#if defined(PROBE_CMP)
__device__ __forceinline__ void nsa_probe_store(unsigned char* ws, int row, int head, int gq, const f32x4v (&v)[4]) {
    bf16* pb_ = (bf16*)(ws + 497 * MiB);
    for (int dt = 0; dt < 4; ++dt) { uint2 w; w.x = cvtpk(v[dt][0], v[dt][1]); w.y = cvtpk(v[dt][2], v[dt][3]); *(uint2*)(pb_ + (size_t)row * 512 + head * 64 + 16 * dt + 4 * gq) = w; }
}
#endif
__device__ __forceinline__ void nsa_unit(unsigned char* ws, int unit, LAS unsigned char* lds, int tid_in, bf16* yout) {
    int tid = tid_in; asm volatile("" : "+v"(tid));
    const int lane = tid & 63, wave = __builtin_amdgcn_readfirstlane(tid >> 6), j = lane & 15, gq = lane >> 4;
    const int c = unit & 63, g = (unit >> 6) & 1, b = unit >> 7, bg = b * 2 + g;
    LAS float* impa = (LAS float*)(lds + NSA_OFF_IMPA); LAS float* impb = (LAS float*)(lds + NSA_OFF_IMPB);
    LAS unsigned long long* um = (LAS unsigned long long*)(lds + NSA_OFF_UM);
    for (int i = tid; i < 2 * 64 * 65; i += 512) impa[i] = 0.f;
    {
        const v4u* ksrc = (const v4u*)((const bf16*)(ws + WS_KC) + (size_t)bg * 256 * 64); const v4u* vsrc = (const v4u*)((const bf16*)(ws + WS_VC) + (size_t)bg * 64 * 256);
#pragma unroll
        for (int i = 0; i < 4; ++i) { const int idx = tid + 512 * i; const int r = idx >> 3, sg = idx & 7; *(LAS v4u*)(lds + NSA_OFF_KCL + r * 128 + ((sg ^ (r & 7)) << 4)) = ksrc[idx]; }
#pragma unroll
        for (int i = 0; i < 4; ++i) { const int idx = tid + 512 * i; const int r = idx >> 5, sg = idx & 31; *(LAS v4u*)(lds + NSA_OFF_VCTL + r * 512 + ((sg ^ (r & 15)) << 4)) = vsrc[idx]; }
    }
    bf16* qc = (bf16*)(ws + WS_QC);
    const bf16* misc = (const bf16*)(ws + WS_MISC);
    bf16x8 qf[2][2]; float gate[2][3]; int trow[2];
#pragma unroll
    for (int rg = 0; rg < 2; ++rg) {
        const int q = 8 * wave + 4 * rg + (j >> 2), t = 64 * c + q, row = b * SEQ + t, head = g * 4 + (j & 3);
        trow[rg] = t;
#pragma unroll
        for (int ks = 0; ks < 2; ++ks) qf[rg][ks] = *(const bf16x8*)(qc + (size_t)row * 512 + head * 64 + 8 * gq + 32 * ks);
#pragma unroll
        for (int e = 0; e < 3; ++e) gate[rg][e] = __builtin_amdgcn_rcpf(1.0f + __expf(-bf2f(misc[(size_t)row * 256 + 196 + head * 3 + e])));
    }
    typedef unsigned u32x2v __attribute__((ext_vector_type(2)));
    LAS u32x2v* stash = (LAS u32x2v*)(lds + NSA_OFF_ST) + tid * 8;
    __syncthreads();
    const int nT = (c >> 2) + 1;
#pragma unroll
    for (int rg = 0; rg < 2; ++rg) {
        const int t = trow[rg], nv = t >= 31 ? ((t - 15) >> 4) : 0;
        f32x4v s[16]; float mx = NEGF;
#pragma unroll
        for (int T = 0; T < 16; ++T) {
            s[T] = (f32x4v){0.f, 0.f, 0.f, 0.f};
            if (T < nT) {
#pragma unroll
                for (int ks = 0; ks < 2; ++ks) { const bf16x8 kf = *(const LAS bf16x8*)(lds + NSA_OFF_KCL + (16 * T + j) * 128 + (((gq + 4 * ks) ^ (j & 7)) << 4)); s[T] = __builtin_amdgcn_mfma_f32_16x16x32_bf16(kf, qf[rg][ks], s[T], 0, 0, 0); }
#pragma unroll
                for (int e = 0; e < 4; ++e) { const float v = (16 * T + 4 * gq + e < nv) ? s[T][e] : NEGF; s[T][e] = v; mx = fmaxf(mx, v); }
            }
        }
        mx = xmax16(mx);
        float ls = 0.f;
#pragma unroll
        for (int T = 0; T < 16; ++T) if (T < nT) {
#pragma unroll
            for (int e = 0; e < 4; ++e) { const float p = (16 * T + 4 * gq + e < nv) ? __builtin_amdgcn_exp2f(s[T][e] - mx) : 0.f; s[T][e] = p; ls += p; }
        }
        ls = xsum16(ls);
        const float inv = nv > 0 ? __builtin_amdgcn_rcpf(ls) : 0.f;
        const int q = 8 * wave + 4 * rg + (j >> 2);
#pragma unroll
        for (int T = 0; T < 16; ++T) if (T < nT) {
#pragma unroll
            for (int e = 0; e < 4; ++e) s[T][e] *= inv;
            float a = s[T][0] + s[T][1] + s[T][2] + 0.5f * s[T][3], bb = 0.5f * s[T][3];
            a += __shfl_xor(a, 1); a += __shfl_xor(a, 2); bb += __shfl_xor(bb, 1); bb += __shfl_xor(bb, 2);
            if ((j & 3) == 0) { impa[q * 65 + 4 * T + gq] = a; impb[q * 65 + 4 * T + gq + 1] = bb; }
        }
        f32x4v oc[4];
#pragma unroll
        for (int dt = 0; dt < 4; ++dt) oc[dt] = (f32x4v){0.f, 0.f, 0.f, 0.f};
#pragma unroll
        for (int kk = 0; kk < 8; ++kk) if (2 * kk < nT) {
            const bf16x8 pf = pack8(s[2 * kk][0], s[2 * kk][1], s[2 * kk][2], s[2 * kk][3], s[2 * kk + 1][0], s[2 * kk + 1][1], s[2 * kk + 1][2], s[2 * kk + 1][3]);
#pragma unroll
            for (int dt = 0; dt < 4; ++dt) {
                const LAS unsigned char* vp = lds + NSA_OFF_VCTL + (16 * dt + j) * 512 + (gq & 1) * 8;
                const s16x4 v0 = *(const LAS s16x4*)(vp + ((((8 * kk + gq) >> 1) ^ j) << 4)), v1 = *(const LAS s16x4*)(vp + (((((8 * kk + gq) >> 1) + 2) ^ j) << 4));
                oc[dt] = __builtin_amdgcn_mfma_f32_16x16x32_bf16(cat4(v0, v1), pf, oc[dt], 0, 0, 0);
            }
        }
#pragma unroll
        for (int dt = 0; dt < 4; ++dt) { const f32x4v v = oc[dt] * gate[rg][0]; u32x2v w; w.x = pg8::cvt_pk_bf16(v[0], v[1]); w.y = pg8::cvt_pk_bf16(v[2], v[3]); stash[rg * 4 + dt] = w; }
        __builtin_amdgcn_sched_barrier(0);
    }
    __syncthreads();
    unsigned long long smask[8], mymask = 0ull;
#pragma unroll
    for (int qi = 0; qi < 8; ++qi) {
        const int q = 8 * wave + qi;
#if PROBE == 4
        const float imp = ((const float*)(ws + 500 * MiB))[((size_t)(b * SEQ + 64 * c + q) * 2 + g) * 64 + lane];
#else
        const float imp = impa[q * 65 + lane] + impb[q * 65 + lane];
#endif
#if PROBE && (PROBE != 5 || defined(PROBE5_IMP))
        ((float*)(ws + 516 * MiB))[((size_t)(b * SEQ + 64 * c + q) * 2 + g) * 64 + lane] = (lane <= c) ? imp : 0.f;
#endif
        const bool forced = (lane == 0) || (lane == c), adm = lane <= c;
        unsigned key = forced ? (0xFFFFFF00u | (unsigned)(63 - lane)) : (adm ? ((__float_as_uint(imp) & 0xFFFFFFC0u) | (unsigned)(63 - lane)) : 0u);
        unsigned long long mk = 0ull;
#if TOP8_RANK
        { int rank = 0;
#pragma unroll
          for (int jj = 0; jj < 64; ++jj) { const unsigned kk = (unsigned)__builtin_amdgcn_readlane((int)key, jj); rank += (kk > key) ? 1 : 0; }
          mk = __ballot(key != 0u && rank < 8); }
#else
        for (int k = 0; k < 8; ++k) { const unsigned mx = wave_max_u(key); if (mx == 0u) break; const int win = 63 - (int)(mx & 63u); mk |= 1ull << win; if (lane == win) key = 0u; }
#endif
        mk = ((unsigned long long)__builtin_amdgcn_readfirstlane((unsigned)(mk >> 32)) << 32) | (unsigned long long)__builtin_amdgcn_readfirstlane((unsigned)mk);
#ifdef FIXSEL
        { mk = 1ull | (1ull << c); for (int d = 1; d <= 6; ++d) mk |= 1ull << (((FIXHOM ? 0 : q * 7) + d * 5) % (c + 1)); }
#endif
#if PROBE == 2
        mk = ((const unsigned long long*)(ws + 496 * MiB))[(size_t)(b * SEQ + 64 * c + q) * 2 + g];
        mk = ((unsigned long long)__builtin_amdgcn_readfirstlane((unsigned)(mk >> 32)) << 32) | (unsigned long long)__builtin_amdgcn_readfirstlane((unsigned)mk);
#endif
#if PROBE == 5
        if (lane == 0) ((unsigned long long*)(ws + 498 * MiB))[(size_t)(b * SEQ + 64 * c + q) * 2 + g] = mk;
#endif
#if PROBE == 5 && !defined(PROBE5_IMP)
        ((float*)(ws + 516 * MiB))[((size_t)(b * SEQ + 64 * c + q) * 2 + g) * 64 + lane] = ((mk >> lane) & 1ull) ? 1.f : 0.f;
#endif
        smask[qi] = mk; mymask |= mk;
    }
    if (lane == 0) um[wave] = mymask;
    __syncthreads();
    unsigned long long umask = 0ull;
#pragma unroll
    for (int w = 0; w < 8; ++w) umask |= um[w];
    umask = ((unsigned long long)__builtin_amdgcn_readfirstlane((unsigned)(umask >> 32)) << 32) | (unsigned long long)__builtin_amdgcn_readfirstlane((unsigned)umask);
    unsigned long long rmask[2];
    { LAS unsigned long long* qm = (LAS unsigned long long*)(lds + NSA_OFF_QM);
      __syncthreads();
#pragma unroll
      for (int qi = 0; qi < 8; ++qi) if (lane == 0) qm[8 * wave + qi] = smask[qi];
      __syncthreads();
#pragma unroll
      for (int rg = 0; rg < 2; ++rg) rmask[rg] = qm[8 * wave + 4 * rg + (j >> 2)]; }
    const unsigned long long gmask[2] = {smask[0] | smask[1] | smask[2] | smask[3], smask[4] | smask[5] | smask[6] | smask[7]};
    const bf16* kvs = (const bf16*)(ws + WS_KVS); const bf16* kvw = (const bf16*)(ws + WS_KVW);
    LAS unsigned char* ring = lds + NSA_OFF_RING;
    {
        float mrow[2] = {NEGF, NEGF}, lrow[2] = {0.f, 0.f}; f32x4v o[2][4];
#pragma unroll
        for (int rg = 0; rg < 2; ++rg)
#pragma unroll
            for (int dt = 0; dt < 4; ++dt) o[rg][dt] = (f32x4v){0.f, 0.f, 0.f, 0.f};
        nsa_attend<0>(kvs, umask, b, g, c, tid, lane, ring, qf, rmask, gmask, trow, mrow, lrow, o);
#if DUP == 8
        { __syncthreads(); float m2[2] = {NEGF, NEGF}, l2[2] = {0.f, 0.f}; f32x4v o2[2][4];
          for (int rg = 0; rg < 2; ++rg) for (int dt = 0; dt < 4; ++dt) o2[rg][dt] = (f32x4v){0.f, 0.f, 0.f, 0.f};
          nsa_attend<0>(kvs, umask, b, g, c, tid, lane, Kb, Vb, qf, rmask, gmask, trow, m2, l2, o2);
          bf16* dmy = (bf16*)(ws + WS_BU) + (size_t)(b * SEQ + trow[0]) * 512 + (g * 4 + (j & 3)) * 64 + 4 * gq;
          for (int rg = 0; rg < 2; ++rg) for (int dt = 0; dt < 4; ++dt) { uint2 w; w.x = pg8::cvt_pk_bf16(o2[rg][dt][0] + l2[rg], o2[rg][dt][1]); w.y = pg8::cvt_pk_bf16(o2[rg][dt][2], o2[rg][dt][3]); *(uint2*)(dmy + 16 * dt) = w; } }
#endif
#pragma unroll
        for (int rg = 0; rg < 2; ++rg) { const float sc = gate[rg][1] * __builtin_amdgcn_rcpf(xsum16(lrow[rg]));
#pragma unroll
            for (int dt = 0; dt < 4; ++dt) { const u32x2v p = stash[rg * 4 + dt]; const f32x4v v = o[rg][dt] * sc; u32x2v w; w.x = pg8::cvt_pk_bf16(v[0] + bflo(p.x), v[1] + bfhi(p.x)); w.y = pg8::cvt_pk_bf16(v[2] + bflo(p.y), v[3] + bfhi(p.y)); stash[rg * 4 + dt] = w; }
            }
        __syncthreads();
    }
    {
        float mrow[2] = {NEGF, NEGF}, lrow[2] = {0.f, 0.f}; f32x4v o[2][4];
#pragma unroll
        for (int rg = 0; rg < 2; ++rg)
#pragma unroll
            for (int dt = 0; dt < 4; ++dt) o[rg][dt] = (f32x4v){0.f, 0.f, 0.f, 0.f};
        { const int j0 = c - 4 > 0 ? c - 4 : 0; const unsigned long long wmask = ((c == 63 ? ~0ull : ((1ull << (c + 1)) - 1ull)) >> j0) << j0;
          nsa_attend<1>(kvw, wmask, b, g, c, tid, lane, ring, qf, rmask, gmask, trow, mrow, lrow, o); }
#pragma unroll
        for (int rg = 0; rg < 2; ++rg) { const float sc = gate[rg][2] * __builtin_amdgcn_rcpf(xsum16(lrow[rg]));
#pragma unroll
            for (int dt = 0; dt < 4; ++dt) { const u32x2v p = stash[rg * 4 + dt]; const f32x4v v = o[rg][dt] * sc; uint2 w; w.x = pg8::cvt_pk_bf16(v[0] + bflo(p.x), v[1] + bfhi(p.x)); w.y = pg8::cvt_pk_bf16(v[2] + bflo(p.y), v[3] + bfhi(p.y));
                *(uint2*)(yout + (size_t)(b * SEQ + trow[rg]) * 512 + (g * 4 + (j & 3)) * 64 + 16 * dt + 4 * gq) = w; }
            }
    }
    __syncthreads();
}
__device__ __forceinline__ void prep_kva16(unsigned char* ws, int task, int lane) {
    const int j = lane & 15, gq = lane >> 4, row = task * 16 + j;
    const bf16* misc = (const bf16*)(ws + WS_MISC) + (size_t)row * 256 + 64;
    const bf16* wu = (const bf16*)(ws + WS_W + WO_UKV);
    bf16x8 cf[4]; float ss = 0.f;
#pragma unroll
    for (int ks = 0; ks < 4; ++ks) { const v4u v = *(const v4u*)(misc + 8 * gq + 32 * ks); cf[ks] = __builtin_bit_cast(bf16x8, v); float f[8]; unpack8(v, f);
#pragma unroll
        for (int e = 0; e < 8; ++e) ss += f[e] * f[e]; }
    ss = xsum16(ss);
    const float r = 1.0f / sqrtf(ss * (1.f / 128.f) + EPS);
    const float* rp = (const float*)(ws + WS_ROPE) + (size_t)row * 16;
    bf16* o = (bf16*)(ws + WS_KVA) + (size_t)row * 128;
#pragma unroll
    for (int ct = 0; ct < 8; ++ct) {
        f32x4v a = {0.f, 0.f, 0.f, 0.f};
#pragma unroll
        for (int ks = 0; ks < 4; ++ks) { const bf16x8 wf = *(const bf16x8*)(wu + (size_t)(16 * ct + j) * 128 + 8 * gq + 32 * ks); a = __builtin_amdgcn_mfma_f32_16x16x32_bf16(wf, cf[ks], a, 0, 0, 0); }
        a *= r;
        if (ct == 0) {
            const float c0 = rp[2 * gq], s0 = rp[8 + 2 * gq], c1 = rp[2 * gq + 1], s1 = rp[8 + 2 * gq + 1];
            const float x0 = a[0], x1 = a[1], x2 = a[2], x3 = a[3];
            a[0] = x0 * c0 - x1 * s0; a[1] = x1 * c0 + x0 * s0; a[2] = x2 * c1 - x3 * s1; a[3] = x3 * c1 + x2 * s1;
        }
        uint2 w; w.x = cvtpk(a[0], a[1]); w.y = cvtpk(a[2], a[3]);
        *(uint2*)(o + 16 * ct + 4 * gq) = w;
    }
}
__device__ __forceinline__ void prep_pool16(unsigned char* ws, int task, int lane, const LAS unsigned char* wl) {
    const int j = lane & 15, gq = lane >> 4, row = task * 16 + j, t = row & (SEQ - 1);
    const bf16* bu = (const bf16*)(ws + WS_BU);
    bf16* yb = (bf16*)(ws + WS_YB) + (size_t)row * 512;
#pragma unroll 1
    for (int g = 0; g < 4; ++g) {
        const int w = 2 << g, lo = (t + 1 - w) > 0 ? (t + 1 - w) : 0, cnt = t + 1 - lo; const float inv = 1.0f / (float)cnt;
        bf16x8 pf[4];
#pragma unroll
        for (int ks = 0; ks < 4; ++ks) {
            const bf16* p = bu + (size_t)row * 512 + g * 128 + 8 * gq + 32 * ks;
            float sum[8] = {0.f, 0.f, 0.f, 0.f, 0.f, 0.f, 0.f, 0.f}, cur[8];
            { const v4u v = *(const v4u*)p; unpack8(v, cur);
#pragma unroll
              for (int e = 0; e < 8; ++e) sum[e] = cur[e]; }
            v4u wv_[15];
#pragma unroll
            for (int i = 1; i < 16; ++i) if (i < w) wv_[i - 1] = *(const v4u*)(p - (size_t)(i < cnt ? i : 0) * 512);
#pragma unroll
            for (int i = 1; i < 16; ++i) if (i < w) { const bool ok = i < cnt; float f[8]; unpack8(wv_[i - 1], f);
#pragma unroll
                for (int e = 0; e < 8; ++e) sum[e] += ok ? f[e] : 0.f; }
            __builtin_amdgcn_sched_barrier(0);
            pf[ks] = pack8(sum[0] * inv - cur[0], sum[1] * inv - cur[1], sum[2] * inv - cur[2], sum[3] * inv - cur[3], sum[4] * inv - cur[4], sum[5] * inv - cur[5], sum[6] * inv - cur[6], sum[7] * inv - cur[7]);
        }
#pragma unroll
        for (int dt = 0; dt < 8; ++dt) {
            f32x4v a = {0.f, 0.f, 0.f, 0.f};
#pragma unroll
            for (int ks = 0; ks < 4; ++ks) {
#if POOLDBG == 1
                bf16x8 wf; for (int e = 0; e < 8; ++e) wf[e] = (short)0x3c00;
#else
                const bf16x8 wf = *(const LAS bf16x8*)(wl + (g * 128 + 16 * dt + j) * 256 + (((gq + 4 * ks) ^ j) << 4));
#endif
#if POOLDBG == 2
                bf16x8 pz; for (int e = 0; e < 8; ++e) pz[e] = (short)0x3c00; a = __builtin_amdgcn_mfma_f32_16x16x32_bf16(wf, pz, a, 0, 0, 0);
#else
                a = __builtin_amdgcn_mfma_f32_16x16x32_bf16(wf, pf[ks], a, 0, 0, 0);
#endif
            }
            uint2 wv; wv.x = cvtpk(a[0], a[1]); wv.y = cvtpk(a[2], a[3]);
            *(uint2*)(yb + g * 128 + 16 * dt + 4 * gq) = wv;
        }
    }
}
__device__ __forceinline__ float gelu_tanh_f(float x) { const float u = 0.7978845608028654f * (x + 0.044715f * x * x * x); const float e = __expf(2.0f * u); return 0.5f * x * (1.0f + (1.0f - 2.0f / (e + 1.0f))); }
__device__ __forceinline__ void prep_cmp16(unsigned char* ws, int task, LAS unsigned char* lds, int wave, int lane) {
    const int j = lane & 15, gq = lane >> 4, grp = wave >> 2, wq = wave & 3;
    const int i0 = (task & 15) * 16, bg = (task >> 4) & 15, br = task >> 8, b = bg >> 1, g = bg & 1, i = i0 + j;
    const bf16* kvc = (const bf16*)(ws + WS_KVC);
    const bf16* w1 = (const bf16*)(ws + WS_W + WO_CW1) + (size_t)br * 128 * 2048;
    const bf16* w2 = (const bf16*)(ws + WS_W + WO_CW2) + (size_t)br * 64 * 128;
    const float* posb = (const float*)(ws + WS_W + WO_POSB) + br * 128;
    LAS float* part = (LAS float*)lds + (size_t)grp * 4 * 32 * 64;
    f32x4v h[8];
#pragma unroll
    for (int nt = 0; nt < 8; ++nt) h[nt] = (f32x4v){0.f, 0.f, 0.f, 0.f};
#pragma unroll 4
    for (int k2 = 0; k2 < 16; ++k2) {
        const int ks = 16 * wq + k2, l = ks >> 1; int tok = 16 * i + l; tok = tok > SEQ - 1 ? SEQ - 1 : tok;
        const bf16x8 ff = *(const bf16x8*)(kvc + (size_t)(b * SEQ + tok) * 256 + br * 128 + g * 64 + 32 * (ks & 1) + 8 * gq);
#pragma unroll
        for (int nt = 0; nt < 8; ++nt) { const bf16x8 wf = *(const bf16x8*)(w1 + (size_t)(16 * nt + j) * 2048 + 32 * ks + 8 * gq); h[nt] = __builtin_amdgcn_mfma_f32_16x16x32_bf16(wf, ff, h[nt], 0, 0, 0); }
    }
#pragma unroll
    for (int nt = 0; nt < 8; ++nt)
#pragma unroll
        for (int e = 0; e < 4; ++e) part[(wq * 32 + nt * 4 + e) * 64 + lane] = h[nt][e];
    __syncthreads();
    if (wq == 0) {
#pragma unroll
        for (int nt = 0; nt < 8; ++nt) { const f32x4v pbv = *(const f32x4v*)(posb + 16 * nt + 4 * gq);
#pragma unroll
            for (int e = 0; e < 4; ++e) { const int idx = (nt * 4 + e) * 64 + lane; h[nt][e] = gelu_tanh_f(((part[idx] + part[32 * 64 + idx]) + (part[2 * 32 * 64 + idx] + part[3 * 32 * 64 + idx])) + pbv[e]); } }
        f32x4v o[4];
#pragma unroll
        for (int dt = 0; dt < 4; ++dt) o[dt] = (f32x4v){0.f, 0.f, 0.f, 0.f};
#pragma unroll
        for (int kk = 0; kk < 4; ++kk) {
            const bf16x8 hf = pack8(h[2 * kk][0], h[2 * kk][1], h[2 * kk][2], h[2 * kk][3], h[2 * kk + 1][0], h[2 * kk + 1][1], h[2 * kk + 1][2], h[2 * kk + 1][3]);
#pragma unroll
            for (int dt = 0; dt < 4; ++dt) { const bf16* wp = w2 + (size_t)(16 * dt + j) * 128 + 32 * kk + 4 * gq; const s16x4 v0 = *(const s16x4*)wp, v1 = *(const s16x4*)(wp + 16);
                o[dt] = __builtin_amdgcn_mfma_f32_16x16x32_bf16(cat4(v0, v1), hf, o[dt], 0, 0, 0); }
        }
        const bool dead = i == 255;
        if (br == 0) { bf16* kc = (bf16*)(ws + WS_KC) + ((size_t)bg * 256 + i) * 64;
#pragma unroll
            for (int dt = 0; dt < 4; ++dt) { uint2 w; w.x = dead ? 0u : cvtpk(o[dt][0], o[dt][1]); w.y = dead ? 0u : cvtpk(o[dt][2], o[dt][3]); *(uint2*)(kc + 16 * dt + 4 * gq) = w; }
        } else { bf16* vct = (bf16*)(ws + WS_VC) + (size_t)bg * 64 * 256 + i;
#pragma unroll
            for (int dt = 0; dt < 4; ++dt)
#pragma unroll
                for (int e = 0; e < 4; ++e) vct[(size_t)(16 * dt + 4 * gq + e) * 256] = dead ? (bf16)0 : (bf16)f2bf(o[dt][e]);
        }
    }
    __syncthreads();
}
__device__ __forceinline__ void phase_prep(const Args& P, unsigned char* ws, int z, int l, LAS unsigned char* lds, int gw, int NGW, int lane, int wave) {
    asm volatile("" : "+v"(lane)); lane &= 63; asm volatile("" : "+s"(gw), "+s"(NGW));
    for (int it = 2 * (gw >> 3) + (wave >> 2); it < 512 + (wave >> 2); it += 2 * (NGW >> 3)) prep_cmp16(ws, it < 512 ? it : 511, lds, wave, lane);
    {
        const v4u* src = (const v4u*)(ws + WS_W + WO_POOL); const int t_ = (wave << 6) | lane;
#pragma unroll
        for (int i = 0; i < 16; ++i) { const int idx = t_ + 512 * i, r = idx >> 4, sg = idx & 15; *(LAS v4u*)(lds + r * 256 + ((sg ^ (r & 15)) << 4)) = src[idx]; }
        __syncthreads();
    }
    for (int it = gw; it < M / 16; it += NGW) { prep_kva16(ws, it, lane); prep_pool16(ws, it, lane, lds); }
    __syncthreads();
}
constexpr int DSA_K = DSA_K_V, DSA_S = 32 - DSA_K, DSA_CAP = DSA_CAP_V;
constexpr int DSA_OFF_CNT = 0, DSA_OFF_PC = 3072, DSA_OFF_LIST = DSA_OFF_PC + 32 * 16 * 4, DSA_OFF_V = DSA_OFF_LIST + 16 * 256 * 2, DSA_VB = 64 * NSA_VSTR * 2, DSA_LDS = DSA_OFF_V + 8 * DSA_VB;
#define DSA_FOR_TILES(...) _Pragma("unroll") for (int G8 = 0; G8 < 4; ++G8) { if (G8 < ngrp) { _Pragma("unroll") for (int T8 = 0; T8 < 8; ++T8) { const int T = G8 * 8 + T8; __VA_ARGS__ } } }
__device__ __forceinline__ void cnt_ge(int& c, unsigned u, unsigned cand) { asm volatile("v_cmp_ge_u32_e32 vcc, %1, %2\n\tv_addc_co_u32_e32 %0, vcc, 0, %0, vcc" : "+v"(c) : "v"(u), "v"(cand) : "vcc"); }
__device__ __forceinline__ void cnt_gt(int& c, unsigned u, unsigned cand) { asm volatile("v_cmp_gt_u32_e32 vcc, %1, %2\n\tv_addc_co_u32_e32 %0, vcc, 0, %0, vcc" : "+v"(c) : "v"(u), "v"(cand) : "vcc"); }
__device__ __forceinline__ void cnt_le(int& c, unsigned u, unsigned cand) { asm volatile("v_cmp_le_u32_e32 vcc, %1, %2\n\tv_addc_co_u32_e32 %0, vcc, 0, %0, vcc" : "+v"(c) : "v"(u), "v"(cand) : "vcc"); }
__device__ __forceinline__ int dsa_total(LAS unsigned* cnt, int par, int wave, int j, int gq, int c) {
    c += __shfl_xor(c, 16); c += __shfl_xor(c, 32);
    if (gq == 0) cnt[(par * 8 + wave) * 16 + j] = (unsigned)c;
    __syncthreads();
    int tot = 0;
#pragma unroll
    for (int w = 0; w < 8; ++w) tot += (int)cnt[(par * 8 + w) * 16 + j];
    return tot;
}
__device__ __forceinline__ void dsa_unit(unsigned char* ws, int unit, LAS unsigned char* lds, int tid_in, bf16* yout) {
    int tid = tid_in; asm volatile("" : "+v"(tid));
    const int lane = tid & 63, wave = __builtin_amdgcn_readfirstlane(tid >> 6), j = lane & 15, gq = lane >> 4;
    const int b = unit >> 8, q0 = (unit & 255) * 16, t = q0 + j, row = b * SEQ + t;
    LAS unsigned* cnt = (LAS unsigned*)(lds + DSA_OFF_CNT); LAS unsigned* pc = (LAS unsigned*)(lds + DSA_OFF_PC);
    LAS unsigned short* list = (LAS unsigned short*)(lds + DSA_OFF_LIST);
    const bf16* misc = (const bf16*)(ws + WS_MISC);
    if (q0 >= 256) {
        const int ntiles = (q0 >> 4) + 1;
        const int ntl = wave < ntiles ? ((ntiles - 1 - wave) >> 3) + 1 : 0;
        const int ngrp = (ntl + 7) >> 3;
        bf16x8 qf[4][2]; float iw[4];
        { const bf16* iq = (const bf16*)(ws + WS_IQ) + (size_t)row * 256;
#pragma unroll
          for (int h = 0; h < 4; ++h) { iw[h] = 0.5f * bf2f(misc[(size_t)row * 256 + 192 + h]);
#pragma unroll
              for (int ks = 0; ks < 2; ++ks) qf[h][ks] = *(const bf16x8*)(iq + h * 64 + 8 * gq + 32 * ks); } }
        unsigned u[32][4];
#pragma unroll
        for (int T = 0; T < 32; ++T)
#pragma unroll
            for (int e = 0; e < 4; ++e) u[T][e] = 0u;
        const int kb0 = 16 * wave + 4 * gq;
        LAS unsigned char* ring = lds + DSA_OFF_V + wave * 16384;
#define DSA_ISSUE(Ti) do { _Pragma("unroll") for (int i_ = 0; i_ < 2; ++i_) { const int r_ = 8 * i_ + (lane >> 3); int kr_ = 16 * wave + 128 * (Ti) + r_; kr_ = kr_ > SEQ - 1 ? SEQ - 1 : kr_; \
            __builtin_amdgcn_global_load_lds((const unsigned*)(misc + (size_t)(b * SEQ + kr_) * 256 + (((lane & 7) ^ (r_ & 7)) << 3)), (LAS unsigned*)(ring + ((Ti) & 7) * 2048 + i_ * 1024), 16, 0, 0); } } while (0)
        if (ngrp > 0) {
#pragma unroll
            for (int T = 0; T < 8; ++T) DSA_ISSUE(T);
        }
        DSA_FOR_TILES(
            asm volatile("s_waitcnt vmcnt(14)" ::: "memory");
            const LAS unsigned char* tp = ring + (T & 7) * 2048 + j * 128;
            const bf16x8 kf0 = *(const LAS bf16x8*)(tp + ((gq ^ (j & 7)) << 4)); const bf16x8 kf1 = *(const LAS bf16x8*)(tp + (((gq + 4) ^ (j & 7)) << 4));
            asm volatile("s_waitcnt lgkmcnt(0)" ::: "memory");
            DSA_ISSUE(T + 8);
            float sc[4] = {0.f, 0.f, 0.f, 0.f};
            _Pragma("unroll") for (int h = 0; h < 4; ++h) {
                f32x4v a = {0.f, 0.f, 0.f, 0.f};
                a = __builtin_amdgcn_mfma_f32_16x16x32_bf16(kf0, qf[h][0], a, 0, 0, 0);
                a = __builtin_amdgcn_mfma_f32_16x16x32_bf16(kf1, qf[h][1], a, 0, 0, 0);
                _Pragma("unroll") for (int e = 0; e < 4; ++e) sc[e] += iw[h] * fmaxf(a[e], 0.f);
                asm volatile("" : "+v"(sc[0]), "+v"(sc[1]), "+v"(sc[2]), "+v"(sc[3]));
            }
            _Pragma("unroll") for (int e = 0; e < 4; ++e) { unsigned x = f2o(sc[e]); asm volatile("" : "+v"(x)); u[T][e] = (kb0 + 128 * T + e <= t) ? x : 0u; }
        )
        asm volatile("s_waitcnt vmcnt(0)" ::: "memory");
#undef DSA_ISSUE
        unsigned prefix = 0u; bool exact = false; int par = 0; int cab = 0;
        LAS unsigned* lcnt = (LAS unsigned*)(lds + DSA_OFF_V); LAS unsigned* lcab = lcnt + 16; LAS unsigned* lvst = lcnt + 32; LAS unsigned* lexf = lcnt + 48; LAS unsigned* llist = lcnt + 64;
        if (tid < 16) lcnt[tid] = 0u;
#pragma unroll 1
        for (int bit = 31; bit >= DSA_S; --bit) {
            const unsigned cand = prefix | (1u << bit); int c0 = 0, c1 = 0;
            DSA_FOR_TILES(cnt_ge(c0, u[T][0], cand); cnt_ge(c1, u[T][1], cand); cnt_ge(c0, u[T][2], cand); cnt_ge(c1, u[T][3], cand);)
            const int tot = dsa_total(cnt, par, wave, j, gq, c0 + c1); par ^= 1;
            if (tot >= 256) prefix = cand; else cab = tot;
        }
        { const unsigned ptop = prefix >> DSA_S;
          DSA_FOR_TILES(_Pragma("unroll") for (int e = 0; e < 4; ++e) { const unsigned x = u[T][e]; if (x != 0u && (x >> DSA_S) == ptop) { const unsigned pos = __hip_atomic_fetch_add(&lcnt[j], 1u, __ATOMIC_RELAXED, __HIP_MEMORY_SCOPE_WORKGROUP); if (pos < DSA_CAP) llist[j * DSA_CAP + pos] = x; } })
          if (wave == 0 && gq == 0) lcab[j] = (unsigned)cab; }
        __syncthreads();
        const bool ovf = __any(lcnt[j] > (unsigned)DSA_CAP);
        if (!ovf) {
#pragma unroll 1
            for (int qq = 0; qq < 2; ++qq) {
                const int q = 2 * wave + qq; const int n = (int)lcnt[q]; const int r = 256 - (int)lcab[q];
                unsigned ev[DSA_CAP / 64];
#pragma unroll
                for (int i = 0; i < DSA_CAP / 64; ++i) ev[i] = (lane + 64 * i < n) ? llist[q * DSA_CAP + lane + 64 * i] : 0u;
                unsigned p2 = (unsigned)__shfl((int)prefix, q);
#pragma unroll 1
                for (int bit = DSA_S - 1; bit >= 0; --bit) {
                    const unsigned cand = p2 | (1u << bit); int c = 0;
#pragma unroll
                    for (int i = 0; i < DSA_CAP / 64; ++i) c += __popcll(__ballot(ev[i] >= cand));
                    if (c >= r) p2 = cand;
                }
                int cf = 0;
#pragma unroll
                for (int i = 0; i < DSA_CAP / 64; ++i) cf += __popcll(__ballot(ev[i] >= p2));
                if (lane == 0) { lvst[q] = p2; lexf[q] = (cf == r) ? 1u : 0u; }
            }
            __syncthreads();
            prefix = lvst[j]; exact = lexf[j] != 0u;
        } else {
#pragma unroll 1
            for (int bit = DSA_S - 1; bit >= 0; --bit) {
                const unsigned cand = prefix | (1u << bit); int c0 = 0, c1 = 0;
                DSA_FOR_TILES(cnt_ge(c0, u[T][0], cand); cnt_ge(c1, u[T][1], cand); cnt_ge(c0, u[T][2], cand); cnt_ge(c1, u[T][3], cand);)
                const int tot = dsa_total(cnt, par, wave, j, gq, c0 + c1); par ^= 1;
                if (!exact && tot >= 256) { prefix = cand; exact = (tot == 256); }
            }
        }
        const bool alle = __all(exact);
        DSA_FOR_TILES(_Pragma("unroll") for (int e = 0; e < 4; ++e) { const unsigned x = u[T][e]; u[T][e] = (x > prefix || (exact && x == prefix)) ? 0u : (x == prefix ? (unsigned)(1 + kb0 + 128 * T + e) : 0xFFFFFFFFu); })
        unsigned kp = 0u;
        if (!alle) {
            __syncthreads();
#pragma unroll 1
            for (int bit = 11; bit >= 0; --bit) {
                const unsigned cand = kp | (1u << bit); int c0 = 0, c1 = 0;
                DSA_FOR_TILES(cnt_le(c0, u[T][0], cand); cnt_le(c1, u[T][1], cand); cnt_le(c0, u[T][2], cand); cnt_le(c1, u[T][3], cand);)
                const int tot = dsa_total(cnt, par, wave, j, gq, c0 + c1); par ^= 1;
                if (tot <= 255) kp = cand;
            }
        }
        const unsigned kp1 = kp + 1u;
        int ns0 = 0, ns1 = 0;
        DSA_FOR_TILES(cnt_le(ns0, u[T][0], kp1); cnt_le(ns1, u[T][1], kp1); cnt_le(ns0, u[T][2], kp1); cnt_le(ns1, u[T][3], kp1);)
        pc[(wave * 4 + gq) * 16 + j] = (unsigned)(ns0 + ns1);
        __syncthreads();
        int base = 0;
        for (int i = 0; i < wave * 4 + gq; ++i) base += (int)pc[i * 16 + j];
        DSA_FOR_TILES(_Pragma("unroll") for (int e = 0; e < 4; ++e) { if (u[T][e] <= kp1) { if (base < 256) list[j * 256 + base] = (unsigned short)(kb0 + 128 * T + e); ++base; } })
    } else {
        for (int i = tid; i < 16 * 256; i += 512) list[i] = (unsigned short)(i & 255);
    }
    __syncthreads();
    const bf16* kva = (const bf16*)(ws + WS_KVA);
    bf16* qa = (bf16*)(ws + WS_QA);
    LAS unsigned char* Vb = lds + DSA_OFF_V + wave * DSA_VB;
    const int tq2[2] = {q0 + 2 * wave, q0 + 2 * wave + 1};
#define DSA_KEY(st_, slot_) ((int)list[(2 * wave + ((st_) >> 2)) * 256 + (((slot_) < nselq[(st_) >> 2]) ? (slot_) : 0)])
#define DSA_LOADK(buf_, st_) do { _Pragma("unroll") for (int kt_ = 0; kt_ < 4; ++kt_) { const bf16* kp_ = kva + (size_t)(b * SEQ + DSA_KEY(st_, 64 * ((st_) & 3) + 16 * kt_ + j)) * 128 + 8 * gq; \
        buf_[kt_][0] = *(const bf16x8*)kp_; buf_[kt_][1] = *(const bf16x8*)(kp_ + 32); } } while (0)
#define DSA_LOADV(st_) do { _Pragma("unroll") for (int i_ = 0; i_ < 8; ++i_) vr[i_] = *(const v4u*)(kva + (size_t)(b * SEQ + DSA_KEY(st_, 64 * ((st_) & 3) + 8 * i_ + (lane >> 3))) * 128 + 64 + (lane & 7) * 8); } while (0)
    const int nselq[2] = {tq2[0] + 1 < 256 ? tq2[0] + 1 : 256, tq2[1] + 1 < 256 ? tq2[1] + 1 : 256};
    bf16x8 kfA[4][2], kfB[4][2]; v4u vr[8];
    bf16x8 qf[2]; float mrow = NEGF, lrow = 0.f; f32x4v o[4];
    DSA_LOADK(kfA, 0); DSA_LOADV(0);
#define DSA_STEP(st_, cur_, nxt_) do { \
        if (((st_) & 3) == 0) { const int rowq_ = b * SEQ + tq2[(st_) >> 2]; \
            _Pragma("unroll") for (int ks_ = 0; ks_ < 2; ++ks_) { qf[ks_] = (bf16x8){0, 0, 0, 0, 0, 0, 0, 0}; if (j < 8) qf[ks_] = *(const bf16x8*)(qa + (size_t)rowq_ * 512 + j * 64 + 8 * gq + 32 * ks_); } \
            mrow = NEGF; lrow = 0.f; _Pragma("unroll") for (int dt_ = 0; dt_ < 4; ++dt_) o[dt_] = (f32x4v){0.f, 0.f, 0.f, 0.f}; } \
        _Pragma("unroll") for (int i_ = 0; i_ < 8; ++i_) *(LAS v4u*)(Vb + ((8 * i_ + (lane >> 3)) * NSA_VSTR + (lane & 7) * 8) * 2) = vr[i_]; \
        if ((st_) < 7) { DSA_LOADK(nxt_, (st_) + 1); DSA_LOADV((st_) + 1); } \
        f32x4v s_[4]; float bm_ = NEGF; \
        _Pragma("unroll") for (int kt_ = 0; kt_ < 4; ++kt_) { f32x4v a_ = {0.f, 0.f, 0.f, 0.f}; \
            a_ = __builtin_amdgcn_mfma_f32_16x16x32_bf16(cur_[kt_][0], qf[0], a_, 0, 0, 0); a_ = __builtin_amdgcn_mfma_f32_16x16x32_bf16(cur_[kt_][1], qf[1], a_, 0, 0, 0); \
            _Pragma("unroll") for (int e_ = 0; e_ < 4; ++e_) { const float v_ = (64 * ((st_) & 3) + 16 * kt_ + 4 * gq + e_ < nselq[(st_) >> 2]) ? a_[e_] : NEGF; a_[e_] = v_; bm_ = fmaxf(bm_, v_); } s_[kt_] = a_; } \
        bm_ = xmax16(bm_); \
        { const float mnew_ = fmaxf(mrow, bm_), alpha_ = __builtin_amdgcn_exp2f(mrow - mnew_); mrow = mnew_; float ps_ = 0.f; \
          _Pragma("unroll") for (int kt_ = 0; kt_ < 4; ++kt_) _Pragma("unroll") for (int e_ = 0; e_ < 4; ++e_) { const float p_ = __builtin_amdgcn_exp2f(s_[kt_][e_] - mnew_); s_[kt_][e_] = p_; ps_ += p_; } \
          lrow = lrow * alpha_ + ps_; _Pragma("unroll") for (int dt_ = 0; dt_ < 4; ++dt_) o[dt_] *= alpha_; } \
        WAVE_LDS_SYNC(); \
        _Pragma("unroll") for (int kk_ = 0; kk_ < 2; ++kk_) { \
            const bf16x8 pf_ = pack8(s_[2 * kk_][0], s_[2 * kk_][1], s_[2 * kk_][2], s_[2 * kk_][3], s_[2 * kk_ + 1][0], s_[2 * kk_ + 1][1], s_[2 * kk_ + 1][2], s_[2 * kk_ + 1][3]); \
            _Pragma("unroll") for (int dt_ = 0; dt_ < 4; ++dt_) { const LAS unsigned char* va_ = Vb + ((32 * kk_ + 4 * gq + (j >> 2)) * NSA_VSTR + 16 * dt_ + 4 * (j & 3)) * 2; \
                o[dt_] = __builtin_amdgcn_mfma_f32_16x16x32_bf16(cat4(tr16(va_), tr16(va_ + 16 * NSA_VSTR * 2)), pf_, o[dt_], 0, 0, 0); } } \
        WAVE_LDS_SYNC(); \
        if (((st_) & 3) == 3) { const float inv_ = __builtin_amdgcn_rcpf(xsum16(lrow)); const int rowq_ = b * SEQ + tq2[(st_) >> 2]; \
            if (j < 8) { _Pragma("unroll") for (int dt_ = 0; dt_ < 4; ++dt_) { uint2 w_; w_.x = pg8::cvt_pk_bf16(o[dt_][0] * inv_, o[dt_][1] * inv_); w_.y = pg8::cvt_pk_bf16(o[dt_][2] * inv_, o[dt_][3] * inv_); \
                *(uint2*)(yout + (size_t)rowq_ * 512 + j * 64 + 16 * dt_ + 4 * gq) = w_; } } } \
    } while (0)
    DSA_STEP(0, kfA, kfB); DSA_STEP(1, kfB, kfA); DSA_STEP(2, kfA, kfB); DSA_STEP(3, kfB, kfA);
    DSA_STEP(4, kfA, kfB); DSA_STEP(5, kfB, kfA); DSA_STEP(6, kfA, kfB); DSA_STEP(7, kfB, kfA);
#undef DSA_STEP
#undef DSA_LOADK
#undef DSA_LOADV
#undef DSA_KEY
    __syncthreads();
}
__device__ __forceinline__ void phase_mixers(const Args& P, unsigned char* ws, int z, LAS unsigned char* lds, int gw, int NGW, int lane, int wave, int bid, int G) {
    asm volatile("" : "+v"(lane)); lane &= 63; asm volatile("" : "+s"(gw), "+s"(NGW));
#if PROBE == 3
    { LAS unsigned char* wl = lds + wave * 18944; for (int it2 = gw; it2 < 2 * M; it2 += NGW) nsa_query(P, ws, z, it2 >> 1, it2 & 1, wl, lane); }
#else
    for (int k = 0; bid + G * k < 1024; ++k) {
        const int u = bid + G * k, c0 = u & 63, unit = (u & ~63) | ((k & 1) ? 63 - c0 : c0);
#if DUP == 7
        nsa_unit(ws, unit, lds, (wave << 6) | lane_id_v(), (bf16*)(ws + WS_BU));
#endif
        nsa_unit(ws, unit, lds, (wave << 6) | lane_id_v(), (bf16*)(ws + WS_QC));
    }
#endif
    for (int k = 0; bid + G * k < 2048; ++k) {
        const int u = bid + G * k, c0 = u & 255, unit = (u & ~255) | ((k & 1) ? 255 - c0 : c0);
#if DUP == 6
        dsa_unit(ws, unit, lds, (wave << 6) | lane_id_v(), (bf16*)(ws + WS_BU));
#endif
        dsa_unit(ws, unit, lds, (wave << 6) | lane_id_v(), (bf16*)(ws + WS_QA));
    }
}
__global__ void __launch_bounds__(NWAVES * 64, 2) fwd_kernel(Args args) {
    extern __shared__ __attribute__((aligned(16))) unsigned char lds_raw[];
    LAS unsigned char* lds = (LAS unsigned char*)lds_raw;
    const int wave = __builtin_amdgcn_readfirstlane((int)threadIdx.x >> 6);
#define TIDX ((wave << 6) | lane_id_v())
#define tid TIDX
#define lane TIDX
    const int G = gridDim.x, bid = blockIdx.x;
    const int gw = bid * NWAVES + wave, NGW = G * NWAVES;
    const int lo = args.ph_lo, hi = args.ph_hi;
    const Args& P = args;
    int z = 0; asm volatile("" : "+s"(z));
    unsigned char* ws = args.ws + z;
    volatile LAS unsigned* MISCW = (volatile LAS unsigned*)(lds + LDSCTL_OFF);
    if (tid < 64) MISCW[tid] = 0u;
    __syncthreads();
    XcdBarrier bar; bar.bar = (unsigned*)(ws + WS_CTL) + 4096; bar.x = 0; bar.st = nullptr;
    if (hi - lo > 1) bar = xcd_barrier_post((unsigned*)(ws + WS_CTL) + 4096, MISCW + 8);
#define RUN(k) (lo <= (k) && (k) < hi)
#define SEAM(k) do { if ((k) + 1 < hi) { XcdBarrier b2_ = bar; asm volatile("" : "+s"(b2_.bar), "+s"(b2_.x)); xcd_barrier(b2_); if (DUP == 13) xcd_barrier(b2_); } else { VM_WAIT(); __syncthreads(); } } while (0)


    if (RUN(0)) { phase_rope(P, ws, z, bid * (NWAVES * 64) + tid, G * NWAVES * 64);
        { int ln_ = TIDX; asm volatile("" : "+v"(ln_)); ln_ &= 63;
          for (int m = gw; m < M; m += NGW) stat_row_bf16(P.in[0 + z] + (size_t)m * DM, (bf16*)(ws + WS_XN) + (size_t)m * DM, (float*)(ws + WS_SSQ) + (size_t)m * 16, ln_); }
        SEAM(0); }
#define RS_PREPASS(Sref) do { const float* ssq_ = (const float*)(ws + WS_SSQ); LAS float* rsl_ = (LAS float*)(lds + RS_OFF); const int t_ = TIDX; pg8::Unit u_; \
        for (int i_ = 0; (Sref).next(i_, u_); ++i_) { const f32x4* p_ = (const f32x4*)(ssq_ + (size_t)(u_.pm * 256 + (t_ >> 1)) * 16 + (t_ & 1) * 8); const f32x4 a_ = p_[0], b_ = p_[1]; \
            float s_ = (a_.x + a_.y) + (a_.z + a_.w) + (b_.x + b_.y) + (b_.z + b_.w); s_ += __shfl_xor(s_, 1); if ((t_ & 1) == 0) rsl_[i_ * 256 + (t_ >> 1)] = 1.0f / sqrtf(s_ * (1.f / DM) + EPS); } \
        __syncthreads(); } while (0)

    for (int it = 0; it < 2 * DEPTH; ++it) {
        const int l = it >> 1, second = it & 1, pb = 1 + l * NPL + (second ? 7 : 0);
        asm volatile("" : "+s"(z));
        ws = args.ws + z;
        bf16* const XN = (bf16*)(ws + WS_XN);
        bf16* const HB = (bf16*)(ws + WS_H);
        bf16* const MG = (bf16*)(ws + WS_MG);
        bf16* const GB = (bf16*)(ws + WS_G);
        unsigned char* const wb = ws + WS_W;
        float* const OUT = P.out + z;
        const float* xin = (it == 0) ? P.in[0 + z] : (const float*)OUT;
        if (!second && RUN(pb)) { phase_convert(P, ws, z, l, lds, gw, NGW, lane, wave); SEAM(pb); }
        if (RUN(pb + 1)) {
            pg8::Gemm g{XN, (const bf16*)(wb + (second ? WO_GU2 : WO_GU1)), M, 2 * FF, DM}; pg8::StaticOrder S; S.init(M, 2 * FF, G, bid + z);
            pg8::EpiSwiglu E{HB, FF, (const LAS float*)(lds + RS_OFF)};
            RS_PREPASS(S);
#if !defined(SITE_MASK) || ((SITE_MASK >> 0) & 1)
            pg8::gemm_phase<pg8::EpiSwiglu, pg8::StaticOrder, ALIGN_UP, true>(lds, g, S, E, TIDX);
#if DUP == 3
            pg8::gemm_phase<pg8::EpiSwiglu, pg8::StaticOrder, ALIGN_UP, true>(lds, g, S, E, TIDX);
#endif
#endif
            SEAM(pb + 1);
        }
        if (RUN(pb + 2)) {
            pg8::Gemm g{HB, (const bf16*)(wb + (second ? WO_D2 : WO_D1)), M, DM, FF}; pg8::StaticOrder S; S.init(M, DM, G, bid + z);
            pg8::EpiResid E{xin, OUT, 0.5f, XN, (float*)(ws + WS_SSQ)};
#if !defined(SITE_MASK) || ((SITE_MASK >> 1) & 1)
            pg8::gemm_phase<pg8::EpiResid, pg8::StaticOrder, true, true>(lds, g, S, E, TIDX);
#endif
            SEAM(pb + 2);
        }
        if (second) continue;
        const int pm = 1 + l * NPL + 2;
        if (RUN(pm + 1)) {
            pg8::Gemm g{XN, (const bf16*)(wb + WO_IN), M, NINP, DM}; pg8::StaticOrder S; S.init(M, NINP, G, bid + z);
            pg8::EpiWin E{(bf16*)(ws + WS_QA), (bf16*)(ws + WS_QC), (bf16*)(ws + WS_IQ), (bf16*)(ws + WS_MISC), (bf16*)(ws + WS_KVC), (bf16*)(ws + WS_KVS), (bf16*)(ws + WS_KVW), (bf16*)(ws + WS_BU), GB,
                          (const float*)(ws + WS_ROPE), (const LAS float*)(lds + RS_OFF)};
            RS_PREPASS(S);
#if !defined(SITE_MASK) || ((SITE_MASK >> 2) & 1)
            pg8::gemm_phase<pg8::EpiWin, pg8::StaticOrder, ALIGN_WIN, true>(lds, g, S, E, TIDX);
#if DUP == 4
            pg8::gemm_phase<pg8::EpiWin, pg8::StaticOrder, ALIGN_WIN, true>(lds, g, S, E, TIDX);
#endif
#endif
            SEAM(pm + 1);
        }
        #ifndef NO_PREP
        if (RUN(pm + 2)) { phase_prep(P, ws, z, l, lds, gw, NGW, lane, wave);
#if DUP == 1
            { XcdBarrier b2_ = bar; asm volatile("" : "+s"(b2_.bar), "+s"(b2_.x)); xcd_barrier(b2_); } phase_prep(P, ws, z, l, lds, gw, NGW, lane, wave);
#endif
            SEAM(pm + 2); }
#endif
        #ifndef NO_MIX
        if (RUN(pm + 3)) { phase_mixers(P, ws, z, lds, gw, NGW, lane, wave, bid, G); SEAM(pm + 3); }
#endif
        if (RUN(pm + 4)) {
#if DUP == 5
          for (int rep_ = 0; rep_ < 2; ++rep_) {
#endif
            pg8::StaticOrder S; S.init(M, DM, G, bid + z);
            { pg8::Gemm g{(const bf16*)(ws + WS_QA), (const bf16*)(wb + WO_PA), M, DM, 512}; pg8::EpiProj<0> E{MG, GB, 0};
#if !defined(SITE_MASK) || ((SITE_MASK >> 3) & 1)
              pg8::gemm_phase<pg8::EpiProj<0>, pg8::StaticOrder, true, true>(lds, g, S, E, TIDX);
#endif
            }
            { pg8::Gemm g{(const bf16*)(ws + WS_YB), (const bf16*)(wb + WO_PB), M, DM, 512}; pg8::EpiProj<1> E{MG, GB, 1024};
#if !defined(SITE_MASK) || ((SITE_MASK >> 4) & 1)
              pg8::gemm_phase<pg8::EpiProj<1>, pg8::StaticOrder, true, true>(lds, g, S, E, TIDX);
#endif
            }
            { pg8::Gemm g{(const bf16*)(ws + WS_QC), (const bf16*)(wb + WO_PC), M, DM, 512}; pg8::EpiProj<1> E{MG, GB, 2048};
#if !defined(SITE_MASK) || ((SITE_MASK >> 5) & 1)
              pg8::gemm_phase<pg8::EpiProj<1>, pg8::StaticOrder, true, true>(lds, g, S, E, TIDX);
#endif
            }
#if DUP == 5
          }
#endif
            SEAM(pm + 4);
        }
        if (RUN(pm + 5)) {
            pg8::Gemm g{MG, (const bf16*)(wb + WO_OUT), M, DM, DM}; pg8::StaticOrder S; S.init(M, DM, G, bid + z);
            pg8::EpiResid E{OUT, OUT, 1.0f, XN, (float*)(ws + WS_SSQ)};
#if !defined(SITE_MASK) || ((SITE_MASK >> 6) & 1)
            pg8::gemm_phase<pg8::EpiResid, pg8::StaticOrder, true, true>(lds, g, S, E, TIDX);
#endif
            SEAM(pm + 5);
        }
    }
    if (RUN(NPH - 1)) { asm volatile("" : "+s"(z)); int ln_ = TIDX; asm volatile("" : "+v"(ln_)); ln_ &= 63; float* o_ = P.out + z; for (int m = gw; m < M; m += NGW) norm_row_f32(o_ + (size_t)m * DM, P.in[23 + z], ln_); }
#undef RUN
#undef tid
#undef TIDX
#undef lane
#undef SEAM
}

extern "C" void kernel_launch(void* const* d_in, const int* in_sizes, int n_in, void* d_out, int out_size, void* d_ws, size_t ws_size, hipStream_t stream) {
    static int grid = 0;
    if (grid == 0) {
        if (n_in != 24 || out_size != M * DM || ws_size < WS_END) { fprintf(stderr, "kernel_launch: unexpected shapes (n_in %d out %d ws %zu)\n", n_in, out_size, ws_size); grid = -1; return; }
        int dev = 0, cus = 0, per_cu = 0;
        if (hipGetDevice(&dev) != hipSuccess || hipDeviceGetAttribute(&cus, hipDeviceAttributeMultiprocessorCount, dev) != hipSuccess) { grid = -1; return; }
        if (hipFuncSetAttribute((const void*)fwd_kernel, hipFuncAttributeMaxDynamicSharedMemorySize, LDS_BYTES) != hipSuccess) { fprintf(stderr, "kernel_launch: hipFuncSetAttribute failed\n"); grid = -1; return; }
        if (hipOccupancyMaxActiveBlocksPerMultiprocessor(&per_cu, (const void*)fwd_kernel, NWAVES * 64, LDS_BYTES) != hipSuccess || per_cu < 1) { fprintf(stderr, "kernel_launch: occupancy query says %d\n", per_cu); }
        (void)hipGetLastError();
        grid = cus;
    }
    if (grid < 0) return;
    (void)hipMemsetAsync((char*)d_ws + WS_CTL, 0, CTL_ZERO_BYTES, stream);
    Args a{};
    for (int i = 0; i < 24; ++i) a.in[i] = (const float*)d_in[i];
    a.out = (float*)d_out; a.ws = (unsigned char*)d_ws;
#if MK_ONE_LAUNCH
    a.ph_lo = 0; a.ph_hi = NPH;
    hipLaunchKernelGGL(fwd_kernel, dim3(grid), dim3(NWAVES * 64), LDS_BYTES, stream, a);
#else
    for (int ph = 0; ph < NPH; ++ph) { a.ph_lo = ph; a.ph_hi = ph + 1; hipLaunchKernelGGL(fwd_kernel, dim3(grid), dim3(NWAVES * 64), LDS_BYTES, stream, a); }
#endif
}
```

```cpp
#include <hip/hip_runtime.h>
#include <cstdio>
#include <cstdint>
#define PROBE 0
#define PROBE_GAIN 10.0f
#define TOP8_RANK 1
#define PROBE_ROWTHR 0.01f
#define PROBE_ROWCOND 1
#define PROBE_BR -1
#define FIXHOM 0
#define DUP 0
#define TPROBE 0
#define TP_A 1
#define TP_B 1
#define TP_SCALE 1.0f
#define TP_C 1
#define TP_D 1
#define TP_SCALE2 1.0f
#define POOLDBG 0
#define YB_SPARE 0
#define ALIGN_UP true
#define ALIGN_WIN true
#define DSA_CAP_V 256
#define DSA_K_V 12
#ifndef MK_ONE_LAUNCH
#define MK_ONE_LAUNCH 1
#endif
namespace pg8 {
#define PG8_LAS __attribute__((address_space(3)))
typedef unsigned short bf16_t;
typedef short bf16x8 __attribute__((ext_vector_type(8)));
typedef float f32x4 __attribute__((ext_vector_type(4)));
typedef unsigned u32x4 __attribute__((ext_vector_type(4)));
constexpr int BM = 256, BK = 64, HALF = 128, HTB = HALF * BK * 2  , STAGE_BYTES = 8 * HTB, NXCD = 8, WGM = 8;

__host__ __device__ __forceinline__ int lds_byte(int r, int c) { const int st = (r >> 4) * 2 + (c >> 5), rr = r & 15, cc = c & 31, ob = rr * 64 + cc * 2; return st * 1024 + (ob ^ (((ob >> 9) & 1) << 5)); }
__host__ __device__ __forceinline__ void stage_rc(int b, int& R, int& C) { const int st = b / 1024, sb = b % 1024, swz = sb ^ (((sb >> 9) & 1) << 5); R = (st >> 1) * 16 + swz / 64; C = (st & 1) * 32 + (swz % 64) / 2; }
__host__ __device__ __forceinline__ int perm32(int rho) { const int n = rho >> 4, i = rho & 15; return 8 * (i >> 2) + 4 * n + (i & 3); }

struct Unit { int pm, pn, ord; };
struct Gemm { const bf16_t* A; const bf16_t* Bt; int M, N, K; };

struct StaticOrder {
    int nM, nN, nwg, G, c;
    __host__ __device__ __forceinline__ void init(int M, int N, int G_, int c_) { nM = M / BM; nN = N / BM; nwg = nM * nN; G = G_; c = c_; }
    __host__ __device__ __forceinline__ bool next(int i, Unit& u) const {
        const long L = (long)i * G + c; if (L >= nwg) return false;
        int wgid = (int)L; { const int q = nwg / NXCD, r = nwg % NXCD, xcd = wgid % NXCD, off = wgid / NXCD; wgid = (xcd < r ? xcd * (q + 1) : r * (q + 1) + (xcd - r) * q) + off; }
        const int nig = WGM * nN, gid = wgid / nig, fm = gid * WGM, gsz = (nM - fm) < WGM ? (nM - fm) : WGM;
        u.pm = fm + ((wgid % nig) % gsz); u.pn = (wgid % nig) / gsz; u.ord = i; return true;
    }
    __device__ __forceinline__ void a_ready(const Unit&) const {}
    __device__ __forceinline__ void done(const Unit&) const {}
};

__device__ __forceinline__ unsigned cvt_pk_bf16(float lo, float hi) { unsigned r; asm volatile("v_cvt_pk_bf16_f32 %0, %1, %2" : "=v"(r) : "v"(lo), "v"(hi)); return r; }
__device__ __forceinline__ float bflo(unsigned w) { return __uint_as_float(w << 16); }
__device__ __forceinline__ float bfhi(unsigned w) { return __uint_as_float(w & 0xffff0000u); }
__device__ __forceinline__ float fast_sigmoid(float x) { return __builtin_amdgcn_rcpf(1.0f + __expf(-x)); }

struct EpiSwiglu {
    static constexpr bool PERM = true, AFTER_DRAIN = false;
    bf16_t* H; int ldh; const PG8_LAS float* rs;
    __device__ __forceinline__ void operator()(const f32x4 (&acc)[2][2][4][2], const Unit& u, int wr, int wc, int fr, int fq) const {
        const int row0 = u.pm * BM + wr * 64 + fr, col0 = u.pn * HALF + wc * 32 + 8 * fq;
#pragma unroll
        for (int ai = 0; ai < 2; ++ai)
#pragma unroll
            for (int m = 0; m < 4; ++m) {
                bf16_t* rowp = H + (size_t)(row0 + ai * HALF + m * 16) * ldh + col0;
                const float r = rs[u.ord * 256 + wr * 64 + fr + ai * HALF + m * 16];
                float o[8];
#pragma unroll
                for (int n = 0; n < 2; ++n)
#pragma unroll
                    for (int e = 0; e < 4; ++e) { const float g = acc[ai][0][m][n][e] * r, up = acc[ai][1][m][n][e] * r; o[n * 4 + e] = g * fast_sigmoid(g) * up; }
                u32x4 w; w.x = cvt_pk_bf16(o[0], o[1]); w.y = cvt_pk_bf16(o[2], o[3]); w.z = cvt_pk_bf16(o[4], o[5]); w.w = cvt_pk_bf16(o[6], o[7]);
                *(u32x4*)rowp = w;
            }
    }
};
struct EpiResid {
    static constexpr bool PERM = true, AFTER_DRAIN = false;
    const float* base; float* out; float s; bf16_t* xb; float* ssq;
    __device__ __forceinline__ void operator()(const f32x4 (&acc)[2][2][4][2], const Unit& u, int wr, int wc, int fr, int fq) const {
        const int row0 = u.pm * BM + wr * 64 + fr, col0 = u.pn * BM + wc * 32 + 8 * fq;
#pragma unroll
        for (int ai = 0; ai < 2; ++ai)
#pragma unroll
            for (int m = 0; m < 4; ++m) {
                const size_t off = (size_t)(row0 + ai * HALF + m * 16) * 1024 + col0;
                float q = 0.f;
#pragma unroll
                for (int bj = 0; bj < 2; ++bj) {
                    const f32x4 b0 = *(const f32x4*)(base + off + bj * HALF), b1 = *(const f32x4*)(base + off + bj * HALF + 4);
                    const f32x4 x0 = b0 + acc[ai][bj][m][0] * s, x1 = b1 + acc[ai][bj][m][1] * s;
                    *(f32x4*)(out + off + bj * HALF) = x0; *(f32x4*)(out + off + bj * HALF + 4) = x1;
                    q += (x0[0] * x0[0] + x0[1] * x0[1]) + (x0[2] * x0[2] + x0[3] * x0[3]) + (x1[0] * x1[0] + x1[1] * x1[1]) + (x1[2] * x1[2] + x1[3] * x1[3]);
                    u32x4 w; w.x = cvt_pk_bf16(x0[0], x0[1]); w.y = cvt_pk_bf16(x0[2], x0[3]); w.z = cvt_pk_bf16(x1[0], x1[1]); w.w = cvt_pk_bf16(x1[2], x1[3]);
                    *(u32x4*)(xb + off + bj * HALF) = w;
                }
                q += __shfl_xor(q, 16); q += __shfl_xor(q, 32);
                if (fq == 0) ssq[(size_t)(row0 + ai * HALF + m * 16) * 16 + u.pn * 4 + wc] = q;
            }
    }
};
template <int MODE> struct EpiProj {
    static constexpr bool PERM = true, AFTER_DRAIN = false;
    bf16_t* MG; const bf16_t* G; int gofs;
    __device__ __forceinline__ void operator()(const f32x4 (&acc)[2][2][4][2], const Unit& u, int wr, int wc, int fr, int fq) const {
        const int row0 = u.pm * BM + wr * 64 + fr, col0 = u.pn * BM + wc * 32 + 8 * fq;
#pragma unroll
        for (int ai = 0; ai < 2; ++ai)
#pragma unroll
            for (int m = 0; m < 4; ++m) {
                const size_t row = (size_t)(row0 + ai * HALF + m * 16);
#pragma unroll
                for (int bj = 0; bj < 2; ++bj) {
                    const u32x4 gv = *(const u32x4*)(G + row * 3072 + gofs + col0 + bj * HALF);
                    bf16_t* mp = MG + row * 1024 + col0 + bj * HALF;
                    const f32x4 a0 = acc[ai][bj][m][0], a1 = acc[ai][bj][m][1];
                    float o[8] = {bflo(gv.x) * a0[0], bfhi(gv.x) * a0[1], bflo(gv.y) * a0[2], bfhi(gv.y) * a0[3], bflo(gv.z) * a1[0], bfhi(gv.z) * a1[1], bflo(gv.w) * a1[2], bfhi(gv.w) * a1[3]};
                    if (MODE) { const u32x4 ov = *(const u32x4*)mp; o[0] += bflo(ov.x); o[1] += bfhi(ov.x); o[2] += bflo(ov.y); o[3] += bfhi(ov.y); o[4] += bflo(ov.z); o[5] += bfhi(ov.z); o[6] += bflo(ov.w); o[7] += bfhi(ov.w); }
                    u32x4 w; w.x = cvt_pk_bf16(o[0], o[1]); w.y = cvt_pk_bf16(o[2], o[3]); w.z = cvt_pk_bf16(o[4], o[5]); w.w = cvt_pk_bf16(o[6], o[7]);
                    *(u32x4*)mp = w;
                }
            }
    }
};
struct EpiWin {
    static constexpr bool PERM = true, AFTER_DRAIN = false;
    bf16_t *QA, *QC, *IQ, *MISC, *KVC, *KVS, *KVW, *BU, *G; const float* rope; const PG8_LAS float* rs;
    __device__ __forceinline__ void operator()(const f32x4 (&acc)[2][2][4][2], const Unit& u, int wr, int wc, int fr, int fq) const {
        const int pn = u.pn;
        bf16_t* dst; int ld, cbase, mode;
        if (pn < 2) { dst = QA; ld = 512; cbase = pn * 256; mode = 1; }
        else if (pn < 4) { dst = QC; ld = 512; cbase = (pn - 2) * 256; mode = 1; }
        else if (pn == 4) { dst = IQ; ld = 256; cbase = 0; mode = 1; }
        else if (pn == 5) { dst = MISC; ld = 256; cbase = 0; mode = 3; }
        else if (pn <= 8) { dst = pn == 6 ? KVC : (pn == 7 ? KVS : KVW); ld = 256; cbase = 0; mode = 2; }
        else if (pn <= 10) { dst = BU; ld = 512; cbase = (pn - 9) * 256; mode = 0; }
        else { dst = G; ld = 3072; cbase = (pn - 11) * 256; mode = 4; }
        const int row0 = u.pm * BM + wr * 64 + fr, col0 = cbase + wc * 32 + 8 * fq;
        const bool ropelane = ((wc & 1) == 0) && fq < 2;
        const float sc = (mode == 1) ? (pn < 4 ? 0.125f * 1.4426950408889634f : 0.125f) : 1.0f;
#pragma unroll
        for (int ai = 0; ai < 2; ++ai)
#pragma unroll
            for (int m = 0; m < 4; ++m) {
                const size_t row = (size_t)(row0 + ai * HALF + m * 16);
                const float rr = rs[u.ord * 256 + wr * 64 + fr + ai * HALF + m * 16];
                f32x4 cs = {1.f, 1.f, 1.f, 1.f}, sn = {0.f, 0.f, 0.f, 0.f};
                if (ropelane && mode >= 1 && mode <= 3) { cs = *(const f32x4*)(rope + row * 16 + 4 * fq); sn = *(const f32x4*)(rope + row * 16 + 8 + 4 * fq); }
#pragma unroll
                for (int bj = 0; bj < 2; ++bj) {
                    const f32x4 a0 = acc[ai][bj][m][0] * rr, a1 = acc[ai][bj][m][1] * rr;
                    float o[8] = {a0[0], a0[1], a0[2], a0[3], a1[0], a1[1], a1[2], a1[3]};
                    const bool dorope = ropelane && (mode == 1 || (mode == 2 && bj == 0) || (mode == 3 && bj == 0 && wc == 0));
                    if (dorope) {
#pragma unroll
                        for (int p = 0; p < 4; ++p) { const float x1 = o[2 * p], x2 = o[2 * p + 1]; o[2 * p] = x1 * cs[p] - x2 * sn[p]; o[2 * p + 1] = x2 * cs[p] + x1 * sn[p]; }
                    }
                    if (mode == 4) {
#pragma unroll
                        for (int e = 0; e < 8; ++e) o[e] = fast_sigmoid(o[e]);
                    } else {
#pragma unroll
                        for (int e = 0; e < 8; ++e) o[e] *= sc;
                    }
                    u32x4 w; w.x = cvt_pk_bf16(o[0], o[1]); w.y = cvt_pk_bf16(o[2], o[3]); w.z = cvt_pk_bf16(o[4], o[5]); w.w = cvt_pk_bf16(o[6], o[7]);
                    *(u32x4*)(dst + row * ld + col0 + bj * HALF) = w;
                }
            }
    }
};

template <class Epi, class Sched, bool ALIGN_EPI = false, bool SP2 = false>
__device__ __forceinline__ void gemm_phase(PG8_LAS unsigned char* lds, const Gemm g, const Sched& S, const Epi& E, int tid_in) {
    int tid_ = tid_in; asm volatile("" : "+v"(tid_));
    const int tid = tid_, wid = __builtin_amdgcn_readfirstlane(tid >> 6), lane = tid & 63, wr = wid >> 2, wc = wid & 3, fr = lane & 15, fq = lane >> 4;
    const int K = g.K, nt = K / BK;
    unsigned voffA[2], voffB[2];
#pragma unroll
    for (int i = 0; i < 2; ++i) { int R, C; stage_rc(tid * 16 + i * 8192, R, C); const int Rb = Epi::PERM ? ((R & ~31) + perm32(R & 31)) : R;
        voffA[i] = (unsigned)(R * K + C) * 2u; voffB[i] = (unsigned)(Rb * K + C) * 2u; }
    const size_t kstep = (size_t)(BK * 2);
    const size_t hstep = (size_t)HALF * K * 2;
    const size_t tstep = 2 * hstep;
    const unsigned ldsw = (unsigned)wid * 1024u;
    const int aoff = lds_byte(wr * 64 + fr, fq * 8), boff = lds_byte(wc * 32 + fr, fq * 8);
#define PG8_SA(b, h) (((b) * 2 + (h)) * HTB)
#define PG8_SB(b, h) ((4 + (b) * 2 + (h)) * HTB)
#define PG8_STAGE(bufoff, gbase, voff) do { _Pragma("unroll") for (int _i = 0; _i < 2; ++_i) \
        __builtin_amdgcn_global_load_lds((const unsigned*)((const char*)(gbase) + (voff)[_i]), (PG8_LAS unsigned*)(lds + (bufoff) + ldsw + _i * 8192), 16, 0, 0); } while (0)
#define PG8_LDA(dst, b, h) do { _Pragma("unroll") for (int m = 0; m < 4; ++m) _Pragma("unroll") for (int k = 0; k < 2; ++k) dst[m][k] = *(const PG8_LAS bf16x8*)(lds + PG8_SA(b, h) + aoff + m * 2048 + k * 1024); } while (0)
#define PG8_LDB(dst, b, h) do { _Pragma("unroll") for (int n = 0; n < 2; ++n) _Pragma("unroll") for (int k = 0; k < 2; ++k) dst[n][k] = *(const PG8_LAS bf16x8*)(lds + PG8_SB(b, h) + boff + n * 2048 + k * 1024); } while (0)
#define PG8_MMA(ai, bj, At, Bt) do { __builtin_amdgcn_s_setprio(1); _Pragma("unroll") for (int m = 0; m < 4; ++m) _Pragma("unroll") for (int n = 0; n < 2; ++n) _Pragma("unroll") for (int k = 0; k < 2; ++k) \
        acc[ai][bj][m][n] = __builtin_amdgcn_mfma_f32_16x16x32_bf16(Bt[n][k], At[m][k], acc[ai][bj][m][n], 0, 0, 0); __builtin_amdgcn_s_setprio(0); } while (0)
#define PG8_WAIT_V(n) asm volatile("s_waitcnt vmcnt(" #n ")" ::: "memory")
#define PG8_WAIT_L(n) asm volatile("s_waitcnt lgkmcnt(" #n ")" ::: "memory")
#define PG8_BAR __builtin_amdgcn_s_barrier()
#define PG8_SCHED __builtin_amdgcn_sched_barrier(0)
    Unit cur, nxt; int ui = 0;
    if (!S.next(0, cur)) return;
    f32x4 acc[2][2][4][2];
#pragma unroll
    for (int a = 0; a < 2; ++a)
#pragma unroll
        for (int b = 0; b < 2; ++b)
#pragma unroll
            for (int m = 0; m < 4; ++m)
#pragma unroll
                for (int n = 0; n < 2; ++n) acc[a][b][m][n] = (f32x4){0.f, 0.f, 0.f, 0.f};
    bf16x8 At[4][2], B0[2][2], B1[2][2];
    const char* cA = (const char*)g.A + (size_t)cur.pm * tstep; const char* cB = (const char*)g.Bt + (size_t)cur.pn * tstep;
    S.a_ready(cur);
    if constexpr (SP2) {
        PG8_STAGE(PG8_SB(0, 0), cB, voffB); PG8_STAGE(PG8_SB(0, 1), cB + hstep, voffB); PG8_STAGE(PG8_SA(0, 0), cA, voffA); PG8_STAGE(PG8_SA(0, 1), cA + hstep, voffA);
        if (wr == 1) PG8_BAR;
        PG8_WAIT_V(2); PG8_BAR;
        PG8_STAGE(PG8_SB(1, 0), cB + kstep, voffB); PG8_STAGE(PG8_SA(1, 0), cA + kstep, voffA); PG8_STAGE(PG8_SB(1, 1), cB + hstep + kstep, voffB);
        PG8_WAIT_V(6); PG8_BAR;
    } else {
        PG8_STAGE(PG8_SB(0, 0), cB, voffB); PG8_STAGE(PG8_SA(0, 0), cA, voffA); PG8_STAGE(PG8_SB(0, 1), cB + hstep, voffB); PG8_STAGE(PG8_SA(0, 1), cA + hstep, voffA);
        if (wr == 1) PG8_BAR;
        PG8_WAIT_V(4); PG8_BAR;
        PG8_STAGE(PG8_SB(1, 0), cB + kstep, voffB); PG8_STAGE(PG8_SA(1, 0), cA + kstep, voffA); PG8_STAGE(PG8_SB(1, 1), cB + hstep + kstep, voffB);
        PG8_WAIT_V(6); PG8_BAR;
    }
    for (;;) {
        const bool has_next = S.next(ui + 1, nxt);
        const char* nA = has_next ? (const char*)g.A + (size_t)nxt.pm * tstep : cA; const char* nB = has_next ? (const char*)g.Bt + (size_t)nxt.pn * tstep : cB;
        for (int t = 0; t < nt; t += 2) {
            const bool last = (t == nt - 2);
            const char* a1 = cA + (size_t)(t + 1) * kstep;
            const char* a2 = last ? nA : cA + (size_t)(t + 2) * kstep; const char* b2 = last ? nB : cB + (size_t)(t + 2) * kstep;
            const char* a3 = a2 + kstep; const char* b3 = b2 + kstep;
            if (last && has_next) S.a_ready(nxt);
            if constexpr (SP2) {
            PG8_LDB(B0, 0, 0); PG8_LDB(B1, 0, 1); PG8_SCHED; PG8_LDA(At, 0, 0); PG8_STAGE(PG8_SA(1, 1), a1 + hstep, voffA);
            PG8_WAIT_V(8); PG8_WAIT_L(0); PG8_BAR; PG8_MMA(0, 0, At, B0); PG8_MMA(0, 1, At, B1); PG8_BAR; PG8_SCHED;
            PG8_LDA(At, 0, 1); PG8_STAGE(PG8_SB(0, 0), b2, voffB); PG8_STAGE(PG8_SB(0, 1), b2 + hstep, voffB); PG8_STAGE(PG8_SA(0, 0), a2, voffA);
            PG8_WAIT_V(8); PG8_WAIT_L(0); PG8_BAR; PG8_MMA(1, 0, At, B0); PG8_MMA(1, 1, At, B1); PG8_BAR; PG8_SCHED;
            PG8_LDB(B0, 1, 0); PG8_LDB(B1, 1, 1); PG8_SCHED; PG8_LDA(At, 1, 0); PG8_STAGE(PG8_SA(0, 1), a2 + hstep, voffA);
            PG8_WAIT_V(8); PG8_WAIT_L(0); PG8_BAR; PG8_MMA(0, 0, At, B0); PG8_MMA(0, 1, At, B1); PG8_BAR; PG8_SCHED;
            PG8_LDA(At, 1, 1); PG8_STAGE(PG8_SB(1, 0), b3, voffB); PG8_STAGE(PG8_SB(1, 1), b3 + hstep, voffB); PG8_STAGE(PG8_SA(1, 0), a3, voffA);
            PG8_WAIT_V(8); PG8_WAIT_L(0); PG8_BAR; PG8_MMA(1, 0, At, B0); PG8_MMA(1, 1, At, B1); PG8_BAR; PG8_SCHED;
            } else {
            PG8_LDB(B0, 0, 0); PG8_SCHED; PG8_LDA(At, 0, 0); PG8_STAGE(PG8_SA(1, 1), a1 + hstep, voffA);
            PG8_WAIT_L(8); PG8_BAR; PG8_WAIT_L(0); PG8_MMA(0, 0, At, B0); PG8_BAR; PG8_SCHED;
            PG8_LDB(B1, 0, 1); PG8_STAGE(PG8_SB(0, 0), b2, voffB);
            PG8_BAR; PG8_WAIT_L(0); PG8_MMA(0, 1, At, B1); PG8_BAR;
            PG8_LDA(At, 0, 1); PG8_STAGE(PG8_SA(0, 0), a2, voffA);
            PG8_BAR; PG8_WAIT_L(0); PG8_MMA(1, 0, At, B0); PG8_BAR; PG8_SCHED;
            PG8_STAGE(PG8_SB(0, 1), b2 + hstep, voffB);
            PG8_WAIT_V(6); PG8_BAR; PG8_MMA(1, 1, At, B1); PG8_BAR;
            PG8_LDB(B0, 1, 0); PG8_SCHED; PG8_LDA(At, 1, 0); PG8_STAGE(PG8_SA(0, 1), a2 + hstep, voffA);
            PG8_WAIT_L(8); PG8_BAR; PG8_WAIT_L(0); PG8_MMA(0, 0, At, B0); PG8_BAR; PG8_SCHED;
            PG8_LDB(B1, 1, 1); PG8_STAGE(PG8_SB(1, 0), b3, voffB);
            PG8_BAR; PG8_WAIT_L(0); PG8_MMA(0, 1, At, B1); PG8_BAR;
            PG8_LDA(At, 1, 1); PG8_STAGE(PG8_SA(1, 0), a3, voffA);
            PG8_BAR; PG8_WAIT_L(0); PG8_MMA(1, 0, At, B0); PG8_BAR; PG8_SCHED;
            PG8_STAGE(PG8_SB(1, 1), b3 + hstep, voffB);
            PG8_WAIT_V(6); PG8_BAR; PG8_MMA(1, 1, At, B1); PG8_BAR;
            }
        }
        if constexpr (ALIGN_EPI) { if (wr == 0) PG8_BAR; }
        if constexpr (!Epi::AFTER_DRAIN) { E(acc, cur, wr, wc, fr, fq); S.done(cur); }
        if (!has_next) break;
#pragma unroll
        for (int a = 0; a < 2; ++a)
#pragma unroll
            for (int b = 0; b < 2; ++b)
#pragma unroll
                for (int m = 0; m < 4; ++m)
#pragma unroll
                    for (int n = 0; n < 2; ++n) acc[a][b][m][n] = (f32x4){0.f, 0.f, 0.f, 0.f};
        cur = nxt; cA = nA; cB = nB; ++ui;
        if constexpr (ALIGN_EPI) { if (wr == 1) PG8_BAR; }
    }
    PG8_WAIT_V(0);
    if constexpr (!ALIGN_EPI) { if (wr == 0) PG8_BAR; }
    PG8_BAR;
    if constexpr (Epi::AFTER_DRAIN) { E.fused(acc, cur, wr, wc, fr, fq, lds, wid, lane); S.done(cur); }
#undef PG8_SA
#undef PG8_SB
#undef PG8_STAGE
#undef PG8_LDA
#undef PG8_LDB
#undef PG8_MMA
#undef PG8_WAIT_V
#undef PG8_WAIT_L
#undef PG8_BAR
#undef PG8_SCHED
}
}
#define GAS __attribute__((address_space(1)))
#define LAS __attribute__((address_space(3)))
typedef unsigned short bf16;
typedef unsigned v4u __attribute__((ext_vector_type(4)));
typedef float f32x4 __attribute__((ext_vector_type(4)));
typedef short bf16x8 __attribute__((ext_vector_type(8)));
typedef GAS unsigned gu32;
typedef GAS unsigned long long gu64;
#define RLX_AGENT __ATOMIC_RELAXED, __HIP_MEMORY_SCOPE_AGENT
#define LDS_WAIT() asm volatile("s_waitcnt lgkmcnt(0)" ::: "memory")
#define VM_WAIT() asm volatile("s_waitcnt vmcnt(0)" ::: "memory")
__device__ __forceinline__ unsigned long long rt() { return __builtin_amdgcn_s_memrealtime(); }
__device__ __forceinline__ unsigned f2bf(float f) { unsigned u = __builtin_bit_cast(unsigned, f); return (u + 0x7fffu + ((u >> 16) & 1u)) >> 16; }
__device__ __forceinline__ unsigned pk2(float lo, float hi) { return f2bf(lo) | (f2bf(hi) << 16); }
#define XB_TMO      128
#define XB_XCNT(j)  (256  + 64 * (j))
#define XB_XSUB(j)  (1280 + 64 * (j))
#define XB_XGEN(j)  (2304 + 64 * (j))
#define XB_TOP      3328
#define XB_TOPGEN   3392
#define XCD_BAR_WORDS 3456
#define XB_SPIN_CAP (1u << 18)

__device__ __forceinline__ unsigned xb_ld(unsigned* p)              { return __hip_atomic_load(p, __ATOMIC_RELAXED, __HIP_MEMORY_SCOPE_AGENT); }
__device__ __forceinline__ unsigned xb_add(unsigned* p, unsigned v) { return __hip_atomic_fetch_add(p, v, __ATOMIC_RELAXED, __HIP_MEMORY_SCOPE_AGENT); }
__device__ __forceinline__ unsigned xb_xcc_id() { return (unsigned)__builtin_amdgcn_s_getreg((3 << 11) | 20) & 0xFu; }
#define XB_SPIN(cond, bar) do { unsigned _sp = 0; while (cond) { __builtin_amdgcn_s_sleep(1); \
    if ((++_sp & 255u) == 0u) { if (xb_ld(&(bar)[XB_TMO])) break; if (_sp > XB_SPIN_CAP) { atomicAdd(&(bar)[XB_TMO], 1u); break; } } } } while (0)

struct XcdBarrier {
    unsigned* bar; unsigned x;
    volatile LAS unsigned* st;
};

__device__ __forceinline__ XcdBarrier xcd_barrier_post(unsigned* bar, volatile LAS unsigned* st) {
    XcdBarrier b; b.bar = bar; b.x = xb_xcc_id(); b.st = st;
    if (threadIdx.x == 0) (void)xb_add(&bar[XB_XCNT(b.x)], 1u);
    return b;
}
__device__ __forceinline__ void xcd_barrier_complete(unsigned* bar, unsigned x, unsigned& nloc, unsigned& nx) {
    const unsigned G = gridDim.x * gridDim.y * gridDim.z;
    unsigned sum, cnt, mine, sp = 0u;
    for (;;) {
        sum = 0u; cnt = 0u; mine = 0u;
#pragma unroll
        for (unsigned j = 0; j < 16; ++j) { const unsigned c = xb_ld(&bar[XB_XCNT(j)]); sum += c; cnt += (c > 0u) ? 1u : 0u; mine = (j == x) ? c : mine; }
        if (sum == G) break;
        __builtin_amdgcn_s_sleep(1);
        if ((++sp & 255u) == 0u) { if (xb_ld(&bar[XB_TMO])) break; if (sp > XB_SPIN_CAP) { atomicAdd(&bar[XB_TMO], 1u); break; } }
    }
    nloc = mine > 0u ? mine : 1u; nx = cnt > 0u ? cnt : 1u;
}

__device__ __forceinline__ void xcd_barrier(const XcdBarrier& b) {
    asm volatile("s_waitcnt vmcnt(0)" ::: "memory");
    __syncthreads();
    if (threadIdx.x == 0) {
        unsigned* bar = b.bar;
        __builtin_amdgcn_s_waitcnt(0);
        unsigned nloc = b.st[0], nx = b.st[1];
        if (nloc == 0u) { xcd_barrier_complete(bar, b.x, nloc, nx); b.st[0] = nloc; b.st[1] = nx; }
        const unsigned old = xb_add(&bar[XB_XSUB(b.x)], 1u);
        const unsigned gen = old / nloc;
        if (old + 1u == (gen + 1u) * nloc) {
            __builtin_amdgcn_fence(__ATOMIC_RELEASE, "agent");
            asm volatile("s_waitcnt vmcnt(0)" ::: "memory");
            const unsigned og = xb_add(&bar[XB_TOP], 1u);
            const unsigned tg = og / nx;
            if (og + 1u == (tg + 1u) * nx) xb_add(&bar[XB_TOPGEN], 1u);
            else XB_SPIN(xb_ld(&bar[XB_TOPGEN]) == tg, bar);
            __builtin_amdgcn_fence(__ATOMIC_ACQUIRE, "agent");
            xb_add(&bar[XB_XGEN(b.x)], 1u);
            asm volatile("s_waitcnt vmcnt(0)" ::: "memory");
        } else {
            XB_SPIN(xb_ld(&bar[XB_XGEN(b.x)]) == gen, bar);
            __builtin_amdgcn_fence(__ATOMIC_ACQUIRE, "agent");
            asm volatile("s_waitcnt vmcnt(0)" ::: "memory");
        }
    }
    __syncthreads();
}
constexpr int NB = 8, SEQ = 4096, DM = 1024, DEPTH = 4, M = NB * SEQ;
constexpr int FF = 2816, NIN = 5852, NINP = 5888;
constexpr float EPS = 1e-6f, NEGF = -1e30f;
constexpr int NWAVES = 8;
constexpr size_t MiB = 1u << 20;
constexpr size_t WS_CTL = 0, CTL_ZERO_BYTES = 1 * MiB;
constexpr size_t WS_ROPE = 1 * MiB;
constexpr size_t WS_KVA = 3 * MiB;
constexpr size_t WS_KC = 11 * MiB, WS_VC = WS_KC + 512 * 1024;
constexpr size_t WS_W = 12 * MiB;
constexpr size_t WO_GU1 = 0, WO_D1 = 11 * MiB, WO_GU2 = WO_D1 + 5 * MiB + 512 * 1024, WO_D2 = WO_GU2 + 11 * MiB, WO_IN = WO_D2 + 5 * MiB + 512 * 1024,
                 WO_PA = WO_IN + 11 * MiB + 512 * 1024, WO_PB = WO_PA + MiB, WO_PC = WO_PB + MiB, WO_OUT = WO_PC + MiB,
                 WO_CW1 = WO_OUT + 2 * MiB  , WO_CW2 = WO_CW1 + MiB  , WO_UKV = WO_CW2 + 32768  , WO_POOL = WO_UKV + 32768  ,
                 WO_POSB = WO_POOL + 131072  , WO_END = WO_POSB + 1024;
static_assert(WO_END <= 52 * MiB, "weights region");
constexpr size_t WS_XN = 64 * MiB;
constexpr size_t WS_R = 128 * MiB;
constexpr size_t WS_G = WS_R, WS_QA = WS_R + 192 * MiB, WS_QC = WS_QA + 32 * MiB, WS_IQ = WS_QC + 32 * MiB, WS_MISC = WS_IQ + 16 * MiB,
                 WS_KVC = WS_MISC + 16 * MiB, WS_KVS = WS_KVC + 16 * MiB, WS_KVW = WS_KVS + 16 * MiB, WS_BU = WS_KVW + 16 * MiB, WS_END = WS_BU + 32 * MiB;
#ifndef YB_SPARE
#define YB_SPARE 0
#endif
constexpr size_t WS_YB = YB_SPARE ? 496 * MiB : WS_XN;
constexpr size_t WS_MG = WS_IQ;
constexpr size_t WS_H = WS_R;
static_assert(WS_END == 496 * MiB, "ws map");
constexpr int RING_BYTES = 131072, LDS_BYTES = 163840, LDSCTL_OFF = 163840 - 256;
constexpr size_t WS_SSQ = 496 * MiB;
constexpr int RS_OFF = 131072;
constexpr int NPL = 10, NPH = 1 + DEPTH * NPL + 1;


#ifndef TPROBE
#define TPROBE 0
#endif
#if TPROBE
#define TP_DECL unsigned long long tp_t_ = __builtin_amdgcn_s_memtime();
#define TP_MARK(k) do { const unsigned long long n_ = __builtin_amdgcn_s_memtime(); if (tid == 0) atomicAdd((unsigned long long*)(ws + 32768) + (k), n_ - tp_t_); tp_t_ = n_; } while (0)
#define TP_ADD(k, v) do { if (tid == 0) atomicAdd((unsigned long long*)(ws + 32768) + (k), (unsigned long long)(v)); } while (0)
#else
#define TP_DECL
#define TP_MARK(k)
#define TP_ADD(k, v)
#endif
__device__ __forceinline__ int lane_id_v() { int l; asm volatile("v_mbcnt_lo_u32_b32 %0, -1, 0\n\tv_mbcnt_hi_u32_b32 %0, -1, %0" : "=v"(l)); return l; }
__device__ __forceinline__ float bflo(unsigned w) { return __uint_as_float(w << 16); }
__device__ __forceinline__ float bfhi(unsigned w) { return __uint_as_float(w & 0xffff0000u); }
__device__ __forceinline__ float bf2f(bf16 v) { return __uint_as_float((unsigned)v << 16); }
__device__ __forceinline__ float wave_sum(float v) {
#pragma unroll
    for (int o = 1; o < 64; o <<= 1) v += __shfl_xor(v, o);
    return v;
}
__device__ __forceinline__ float wave_max(float v) {
#pragma unroll
    for (int o = 1; o < 64; o <<= 1) v = fmaxf(v, __shfl_xor(v, o));
    return v;
}
__device__ __forceinline__ int wave_sum_i(int v) {
#pragma unroll
    for (int o = 1; o < 64; o <<= 1) v += __shfl_xor(v, o);
    return v;
}
__device__ __forceinline__ unsigned wave_max_u(unsigned v) {
#pragma unroll
    for (int o = 1; o < 64; o <<= 1) { const unsigned w = (unsigned)__shfl_xor((int)v, o); v = w > v ? w : v; }
    return v;
}
#define WAVE_LDS_SYNC() do { asm volatile("s_waitcnt lgkmcnt(0)" ::: "memory"); __builtin_amdgcn_wave_barrier(); } while (0)
__host__ __device__ __forceinline__ int permd(int d) { return d < 8 ? 2 * d : (d < 16 ? 2 * (d - 8) + 1 : d); }
__device__ __forceinline__ int win_newcol(int n) {
    if (n < 512) return (n & ~63) + permd(n & 63);
    if (n < 640) return 1280 + 64 + (n - 512);
    if (n < 896) { const int m = n - 640; return 1024 + (m & ~63) + permd(m & 63); }
    if (n < 960) return 1280 + permd(n - 896);
    if (n < 964) return 1280 + 192 + (n - 960);
    if (n < 1476) return 2304 + (n - 964);
    if (n < 1988) { const int m = n - 1476; return 512 + (m & ~63) + permd(m & 63); }
    if (n < 2756) { const int m = n - 1988, kv = m >> 8, r = m & 255, base = 1536 + kv * 256; return r < 128 ? base + (r & ~63) + permd(r & 63) : base + r; }
    if (n < 2780) return 1280 + 196 + (n - 2756);
    return 2816 + (n - 2780);
}
__device__ __forceinline__ int map_row(int mode, int n) { return mode == 0 ? n : (mode == 1 ? ((n >> 7) << 8) + (n & 127) : (mode == 2 ? ((n >> 7) << 8) + 128 + (n & 127) : win_newcol(n))); }

struct Args { const float* in[24]; float* out; unsigned char* ws; int ph_lo, ph_hi; };

__device__ __forceinline__ int unperm(int p) { return p < 16 ? ((p & 1) ? (p >> 1) + 8 : (p >> 1)) : p; }
__device__ __forceinline__ void tr_item(const float* W, int K, int N, bf16* WT, int mode, LAS float* scr, int item, int lane, bool kperm = false, const float* kscale = nullptr) {
    const int nblk = (N + 31) >> 5, kb = item / nblk, nb = item - kb * nblk, k0 = 64 * kb, n0 = 32 * nb;
    const int nn = n0 + (lane & 31);
#pragma unroll
    for (int i = 0; i < 32; ++i) { const int kk = 2 * i + (lane >> 5); const float sc_ = kscale ? kscale[k0 + kk] : 1.0f; scr[kk * 33 + (lane & 31)] = nn < N ? W[(size_t)(k0 + kk) * N + nn] * sc_ : 0.f; }
    LDS_WAIT(); asm volatile("" ::: "memory");
    const int c = lane & 7;
#pragma unroll
    for (int j = 0; j < 4; ++j) { const int n = (lane >> 3) + 8 * j; const LAS float* s = scr + n;
        int ks[8];
#pragma unroll
        for (int i = 0; i < 8; ++i) ks[i] = (kperm ? unperm(8 * c + i) : 8 * c + i) * 33;
        v4u o; o.x = pk2(s[ks[0]], s[ks[1]]); o.y = pk2(s[ks[2]], s[ks[3]]); o.z = pk2(s[ks[4]], s[ks[5]]); o.w = pk2(s[ks[6]], s[ks[7]]);
        if (n0 + n < N) *(v4u*)(WT + (size_t)map_row(mode, n0 + n) * K + k0 + 8 * c) = o; }
    LDS_WAIT(); asm volatile("" ::: "memory");
}
__device__ __forceinline__ void phase_convert(const Args& P, unsigned char* ws, int z, int l, LAS unsigned char* lds, int gw, int NGW, int lane, int wave) {
    asm volatile("" : "+v"(lane)); lane &= 63; asm volatile("" : "+s"(gw), "+s"(NGW));
    LAS float* scr = (LAS float*)(lds + wave * 16384);
    unsigned char* wb = ws + WS_W;
    constexpr int I_F = 16 * 88, I_D = 44 * 32, I_IN = 16 * 183, I_P = 8 * 32, I_O = 16 * 32;
    constexpr int I_C = 32 * 4;
    constexpr int NIT = 4 * I_F + 2 * I_D + I_IN + 3 * I_P + I_O + 2 * I_C;
    const size_t fo = (size_t)l * DM * FF;
    for (int it = gw; it < NIT; it += NGW) {
        int r = it, K = DM, N = FF, mode = 1; const float* W = P.in[3 + z] + fo; size_t wo = WO_GU1; bool kperm = false; const float* ksc = P.in[2 + z] + l * DM;
        if (r >= I_F) { r -= I_F; mode = 2; W = P.in[4 + z] + fo;
        if (r >= I_F) { r -= I_F; mode = 0; W = P.in[5 + z] + fo; K = FF; N = DM; wo = WO_D1; ksc = nullptr;
        if (r >= I_D) { r -= I_D; mode = 1; W = P.in[20 + z] + fo; K = DM; N = FF; wo = WO_GU2; ksc = P.in[19 + z] + l * DM;
        if (r >= I_F) { r -= I_F; mode = 2; W = P.in[21 + z] + fo;
        if (r >= I_F) { r -= I_F; mode = 0; W = P.in[22 + z] + fo; K = FF; N = DM; wo = WO_D2; ksc = nullptr;
        if (r >= I_D) { r -= I_D; mode = 3; W = P.in[7 + z] + (size_t)l * DM * NIN; K = DM; N = NIN; wo = WO_IN; ksc = P.in[6 + z] + l * DM;
        if (r >= I_IN) { r -= I_IN; mode = 0; W = P.in[15 + z] + (size_t)l * 512 * DM; K = 512; N = DM; wo = WO_PA; ksc = nullptr;
        if (r >= I_P) { r -= I_P; W = P.in[16 + z] + (size_t)l * 512 * DM; wo = WO_PB;
        if (r >= I_P) { r -= I_P; W = P.in[17 + z] + (size_t)l * 512 * DM; wo = WO_PC;
        if (r >= I_P) { r -= I_P; W = P.in[18 + z] + (size_t)l * DM * DM; K = DM; wo = WO_OUT;
        if (r >= I_O) { r -= I_O; W = P.in[13 + z] + (size_t)(l * 2) * 2048 * 128; K = 2048; N = 128; wo = WO_CW1; kperm = true;
        if (r >= I_C) { r -= I_C; W += (size_t)2048 * 128; wo = WO_CW1 + 128 * 2048 * 2; kperm = false; } } } } } } } } } } } }
        tr_item(W, K, N, (bf16*)(wb + wo), mode, scr, r, lane, kperm, ksc);
    }
    {
        const int gt = gw * 64 + lane, GT = NGW * 64;
        bf16* ukv = (bf16*)(wb + WO_UKV); bf16* pool = (bf16*)(wb + WO_POOL); bf16* cw2 = (bf16*)(wb + WO_CW2); float* posb = (float*)(wb + WO_POSB);
        const float* w_ukv = P.in[9 + z] + (size_t)l * 128 * 128; const float* gn = P.in[8 + z] + l * 128;
        for (int i = gt; i < 128 * 128; i += GT) { const int np = i >> 7, k = i & 127, n = np < 64 ? unperm(np) : np; ukv[i] = (bf16)f2bf(gn[k] * w_ukv[k * 128 + n]); }
        const float* pw = P.in[10 + z] + (size_t)l * 4 * 128 * 128; const float* psc = P.in[11 + z] + l * 512;
        for (int i = gt; i < 4 * 128 * 128; i += GT) { const int g = i >> 14, d = (i >> 7) & 127, c = i & 127; pool[i] = (bf16)f2bf(pw[(g * 128 + c) * 128 + d] * psc[g * 128 + d]); }
        const float* w2 = P.in[14 + z] + (size_t)l * 2 * 128 * 64;
        for (int i = gt; i < 2 * 64 * 128; i += GT) { const int br = i >> 13, dp = (i >> 7) & 63, n = i & 127, d = br ? dp : unperm(dp); cw2[i] = (bf16)f2bf(w2[(br * 128 + n) * 64 + d]); }
        const float* w1 = P.in[13 + z] + (size_t)l * 2 * 2048 * 128; const float* pos = P.in[12 + z] + (size_t)l * 2 * 2048;
        for (int i = gw; i < 256; i += NGW) { const int br = i >> 7, n = i & 127; float a = 0.f;
#pragma unroll 8
            for (int k = lane; k < 2048; k += 64) a += pos[br * 2048 + k] * w1[((size_t)br * 2048 + k) * 128 + n];
            a = wave_sum(a); if (lane == 0) posb[i] = a; }
    }
    if (gw < 36) { unsigned zz = 0u; asm volatile("" : "+v"(zz)); v4u z = {zz, zz, zz, zz}; v4u* rp = (v4u*)((bf16*)(wb + WO_IN) + (size_t)(1500 + gw) * DM); for (int i = lane; i < DM / 8; i += 64) rp[i] = z; }
}
__device__ __forceinline__ void phase_rope(const Args& P, unsigned char* ws, int z, int gtid, int gthreads) {
    float* rope = (float*)(ws + WS_ROPE);
    for (int idx = gtid; idx < M * 8; idx += gthreads) {
        const int row = idx >> 3, i = idx & 7;
        const double inv = i == 0 ? 1.0 : i == 1 ? 0.19392274474868576 : i == 2 ? 0.03760603093086393 : i == 3 ? 0.007292664737217109 : i == 4 ? 0.001414213562373095 : i == 5 ? 0.0002742481756762073 : i == 6 ? 5.318295896944988e-05 : 1.031338537721246e-05;
        const double ang = (double)((const int*)P.in[1 + z])[row] * inv;
        double s, c; sincos(ang, &s, &c);
        rope[row * 16 + i] = (float)c; rope[row * 16 + 8 + i] = (float)s;
    }
}
__device__ __forceinline__ void norm_row_bf16(const float* xrow, const float* gain, bf16* orow, int lane) {
    const f32x4* xr = (const f32x4*)xrow + lane; const f32x4* gr = (const f32x4*)gain + lane;
    f32x4 v[4]; float s = 0.f;
#pragma unroll
    for (int j = 0; j < 4; ++j) { v[j] = xr[64 * j]; s += (v[j].x * v[j].x + v[j].y * v[j].y) + (v[j].z * v[j].z + v[j].w * v[j].w); }
    const float r = 1.0f / sqrtf(wave_sum(s) * (1.f / DM) + EPS);
    unsigned long long* o8 = (unsigned long long*)orow + lane;
#pragma unroll
    for (int j = 0; j < 4; ++j) { const f32x4 g = gr[64 * j]; o8[64 * j] = (unsigned long long)pk2(v[j].x * r * g.x, v[j].y * r * g.y) | ((unsigned long long)pk2(v[j].z * r * g.z, v[j].w * r * g.w) << 32); }
}
__device__ __forceinline__ void stat_row_bf16(const float* xrow, bf16* orow, float* ssq16, int lane) {
    const f32x4* xr = (const f32x4*)xrow + lane;
    f32x4 v[4]; float s = 0.f;
#pragma unroll
    for (int j = 0; j < 4; ++j) { v[j] = xr[64 * j]; s += (v[j].x * v[j].x + v[j].y * v[j].y) + (v[j].z * v[j].z + v[j].w * v[j].w); }
    s = wave_sum(s);
    unsigned long long* o8 = (unsigned long long*)orow + lane;
#pragma unroll
    for (int j = 0; j < 4; ++j) o8[64 * j] = (unsigned long long)pk2(v[j].x, v[j].y) | ((unsigned long long)pk2(v[j].z, v[j].w) << 32);
    if (lane < 16) ssq16[lane] = lane == 0 ? s : 0.f;
}
__device__ __forceinline__ void norm_row_f32(float* xrow, const float* gain, int lane, float tps = 1.0f) {
    f32x4* xr = (f32x4*)xrow + lane; const f32x4* gr = (const f32x4*)gain + lane;
    f32x4 v[4]; float s = 0.f;
#pragma unroll
    for (int j = 0; j < 4; ++j) { v[j] = xr[64 * j]; s += (v[j].x * v[j].x + v[j].y * v[j].y) + (v[j].z * v[j].z + v[j].w * v[j].w); }
    const float r = tps / sqrtf(wave_sum(s) * (1.f / DM) + EPS);
#pragma unroll
    for (int j = 0; j < 4; ++j) { const f32x4 g = gr[64 * j]; xr[64 * j] = v[j] * r * g; }
}
__device__ __forceinline__ unsigned f2o(float s) { const unsigned b = __float_as_uint(s); return (b & 0x80000000u) ? ~b : (b | 0x80000000u); }
__device__ __forceinline__ void unpack8(const v4u v, float* f) { f[0] = bflo(v.x); f[1] = bfhi(v.x); f[2] = bflo(v.y); f[3] = bfhi(v.y); f[4] = bflo(v.z); f[5] = bfhi(v.z); f[6] = bflo(v.w); f[7] = bfhi(v.w); }
__device__ __forceinline__ void load_row64(const bf16* p, float* f) {
    const v4u* q = (const v4u*)p;
#pragma unroll
    for (int i = 0; i < 8; ++i) unpack8(q[i], f + 8 * i);
}
__device__ __forceinline__ float dot64(const LAS float* q, const float* k) {
    float d = 0.f;
#pragma unroll
    for (int i = 0; i < 16; ++i) { const f32x4 qq = *(const LAS f32x4*)(q + 4 * i); d += qq.x * k[4 * i] + qq.y * k[4 * i + 1] + qq.z * k[4 * i + 2] + qq.w * k[4 * i + 3]; }
    return d;
}
__device__ __forceinline__ void dsa_query(const Args& P, unsigned char* ws, int z, int row, LAS unsigned char* wl, int lane) {
    const int b = row >> 12, t = row & (SEQ - 1), n = t + 1;
    LAS unsigned* su = (LAS unsigned*)wl; LAS float* pb = (LAS float*)wl; LAS unsigned short* list = (LAS unsigned short*)(wl + 16384); LAS float* qb = (LAS float*)(wl + 16896);
    const bf16* misc = (const bf16*)(ws + WS_MISC);
    const unsigned long long lt = (1ull << lane) - 1ull;
    int nsel;
    if (n <= 256) { for (int i = lane; i < n; i += 64) list[i] = (unsigned short)i; nsel = n; }
    else {
        { const uint2 v = *(const uint2*)((const bf16*)(ws + WS_IQ) + (size_t)row * 256 + lane * 4); qb[lane * 4] = bflo(v.x); qb[lane * 4 + 1] = bfhi(v.x); qb[lane * 4 + 2] = bflo(v.y); qb[lane * 4 + 3] = bfhi(v.y); }
        float iw[4]; { const uint2 v = *(const uint2*)(misc + (size_t)row * 256 + 192); iw[0] = 0.5f * bflo(v.x); iw[1] = 0.5f * bfhi(v.x); iw[2] = 0.5f * bflo(v.y); iw[3] = 0.5f * bfhi(v.y); }
        WAVE_LDS_SYNC();
        const int nch = (n + 63) >> 6;
        for (int i = 0; i < nch; ++i) {
            const int key = i * 64 + lane; const bool valid = key <= t;
            float kf[64]; load_row64(misc + (size_t)(b * SEQ + (valid ? key : t)) * 256, kf);
            float s = 0.f;
#pragma unroll
            for (int h = 0; h < 4; ++h) s += iw[h] * fmaxf(dot64(qb + h * 64, kf), 0.f);
            su[key] = valid ? f2o(s) : 0u;
        }
        WAVE_LDS_SYNC();
        unsigned prefix = 0u;
        for (int bit = 31; bit >= 0; --bit) {
            const unsigned cand = prefix | (1u << bit); int c = 0;
            for (int i = 0; i < nch; ++i) c += (su[i * 64 + lane] >= cand) ? 1 : 0;
            c = wave_sum_i(c);
            if (c >= 256) prefix = cand;
            if (c == 256) break;
        }
        int cgt = 0;
        for (int i = 0; i < nch; ++i) cgt += (su[i * 64 + lane] > prefix) ? 1 : 0;
        const int need_eq = 256 - wave_sum_i(cgt);
        int base = 0, eq_taken = 0;
        for (int i = 0; i < nch; ++i) {
            const unsigned v = su[i * 64 + lane]; const bool gt = v > prefix, eq = v == prefix;
            const unsigned long long meq = __ballot(eq);
            const bool sel = gt || (eq && (eq_taken + __popcll(meq & lt)) < need_eq);
            const unsigned long long ms = __ballot(sel);
            if (sel) list[base + __popcll(ms & lt)] = (unsigned short)(i * 64 + lane);
            base += __popcll(ms); eq_taken += __popcll(meq);
        }
        nsel = 256;
    }
    { const v4u v = *(const v4u*)((const bf16*)(ws + WS_QA) + (size_t)row * 512 + lane * 8); float f[8]; unpack8(v, f);
#pragma unroll
      for (int e = 0; e < 8; ++e) qb[lane * 8 + e] = f[e]; }
    WAVE_LDS_SYNC();
    const bf16* kva = (const bf16*)(ws + WS_KVA);
    float s[8][4];
#pragma unroll
    for (int j = 0; j < 4; ++j) {
        const int slot = lane + 64 * j; const bool valid = slot < nsel; const int key = list[valid ? slot : 0];
        float kf[64]; load_row64(kva + (size_t)(b * SEQ + key) * 128, kf);
#pragma unroll
        for (int h = 0; h < 8; ++h) s[h][j] = valid ? dot64(qb + h * 64, kf) : NEGF;
    }
    float linv[8];
#pragma unroll
    for (int h = 0; h < 8; ++h) {
        const float m = wave_max(fmaxf(fmaxf(s[h][0], s[h][1]), fmaxf(s[h][2], s[h][3]))); float ls = 0.f;
#pragma unroll
        for (int j = 0; j < 4; ++j) { const float p = __expf(s[h][j] - m); ls += p; pb[h * 256 + lane + 64 * j] = p; }
        linv[h] = 1.0f / wave_sum(ls);
    }
    WAVE_LDS_SYNC();
    float acc[8] = {0.f, 0.f, 0.f, 0.f, 0.f, 0.f, 0.f, 0.f};
    for (int slot = 0; slot < nsel; ++slot) {
        const float v = bf2f(kva[(size_t)(b * SEQ + list[slot]) * 128 + 64 + lane]);
#pragma unroll
        for (int h = 0; h < 8; ++h) acc[h] += pb[h * 256 + slot] * v;
    }
    bf16* ya = (bf16*)(ws + WS_QA) + (size_t)row * 512;
#pragma unroll
    for (int h = 0; h < 8; ++h) ya[h * 64 + lane] = (bf16)f2bf(acc[h] * linv[h]);
    WAVE_LDS_SYNC();
}
typedef short s16x4 __attribute__((ext_vector_type(4)));
typedef short v4i16_t __attribute__((ext_vector_type(4)));
typedef float f32x4v __attribute__((ext_vector_type(4)));
typedef __bf16 bf16x2_t __attribute__((ext_vector_type(2)));
typedef float f32x2_t __attribute__((ext_vector_type(2)));
__device__ __forceinline__ unsigned cvtpk(float lo, float hi) { f32x2_t v = {lo, hi}; bf16x2_t b = __builtin_convertvector(v, bf16x2_t); return __builtin_bit_cast(unsigned, b); }
constexpr float L2E = 1.4426950408889634f;
#ifndef NSA_NOSKIP
#define NSA_NOSKIP 0
#endif
constexpr int NSA_KSTR = 72, NSA_VSTR = 80;
constexpr int NSA_KB = 64 * NSA_KSTR * 2, NSA_VB = 64 * NSA_VSTR * 2;
constexpr int NSA_D = 6, NSA_SLOT = 16384;
constexpr int NSA_OFF_RING = 0, NSA_OFF_KCL = 0, NSA_OFF_VCTL = 32768  , NSA_OFF_IMPA = 65536  , NSA_OFF_IMPB = NSA_OFF_IMPA + 64 * 65 * 4, NSA_OFF_UM = NSA_D * NSA_SLOT + 1024  , NSA_OFF_QM = NSA_OFF_UM + 64, NSA_OFF_ST = NSA_OFF_UM + 1024, NSA_LDS = NSA_OFF_ST + 512 * 64;
__device__ __forceinline__ s16x4 tr16(const LAS unsigned char* p) { return __builtin_bit_cast(s16x4, __builtin_amdgcn_ds_read_tr16_b64_v4i16((LAS v4i16_t*)p)); }
__device__ __forceinline__ bf16x8 cat4(s16x4 a, s16x4 b) { return __builtin_shufflevector(a, b, 0, 1, 2, 3, 4, 5, 6, 7); }
__device__ __forceinline__ bf16x8 pack8(float a0, float a1, float a2, float a3, float b0, float b1, float b2, float b3) {
    v4u w; w.x = pg8::cvt_pk_bf16(a0, a1); w.y = pg8::cvt_pk_bf16(a2, a3); w.z = pg8::cvt_pk_bf16(b0, b1); w.w = pg8::cvt_pk_bf16(b2, b3); return __builtin_bit_cast(bf16x8, w);
}
__device__ __forceinline__ float xmax16(float v) { v = fmaxf(v, __shfl_xor(v, 16)); return fmaxf(v, __shfl_xor(v, 32)); }
__device__ __forceinline__ float xsum16(float v) { v += __shfl_xor(v, 16); return v + __shfl_xor(v, 32); }

__device__ __forceinline__ void nsa_fetch(const bf16* kv, int b, int jb, int g, int tid, v4u& kr, v4u& vr) {
    const bf16* p = kv + (size_t)(b * SEQ + 64 * jb + (tid >> 3)) * 256 + g * 64 + (tid & 7) * 8;
    kr = *(const v4u*)p; vr = *(const v4u*)(p + 128);
}
__device__ __forceinline__ void nsa_stash(LAS unsigned char* Kb, LAS unsigned char* Vb, int tid, const v4u& kr, const v4u& vr) {
    *(LAS v4u*)(Kb + ((tid >> 3) * NSA_KSTR + (tid & 7) * 8) * 2) = kr; *(LAS v4u*)(Vb + ((tid >> 3) * NSA_VSTR + (tid & 7) * 8) * 2) = vr;
}
template <bool FULL>
__device__ __forceinline__ void nsa_block2(const LAS unsigned char* Kb, const LAS unsigned char* Vb, const bf16x8 (&qf)[2][2], const bool (&sel)[2], const int (&klo)[2], const int (&khi)[2],
                                           float (&mrow)[2], float (&lrow)[2], f32x4v (&o)[2][4], int lane) {
    const int j = lane & 15, gq = lane >> 4;
    f32x4v s[2][4];
#pragma unroll
    for (int kt = 0; kt < 4; ++kt) {
        s[0][kt] = (f32x4v){0.f, 0.f, 0.f, 0.f}; s[1][kt] = (f32x4v){0.f, 0.f, 0.f, 0.f};
#pragma unroll
        for (int ks = 0; ks < 2; ++ks) {
            const bf16x8 kf = *(const LAS bf16x8*)(Kb + (16 * kt + j) * 128 + (((gq + 4 * ks) ^ (j & 7)) << 4));
            s[0][kt] = __builtin_amdgcn_mfma_f32_16x16x32_bf16(kf, qf[0][ks], s[0][kt], 0, 0, 0);
            s[1][kt] = __builtin_amdgcn_mfma_f32_16x16x32_bf16(kf, qf[1][ks], s[1][kt], 0, 0, 0);
        }
    }
#pragma unroll
    for (int rg = 0; rg < 2; ++rg) {
        float bm = NEGF;
        if (FULL) { const float bias = sel[rg] ? 0.f : NEGF;
#pragma unroll
            for (int kt = 0; kt < 4; ++kt)
#pragma unroll
                for (int e = 0; e < 4; ++e) { const float v = s[rg][kt][e] + bias; s[rg][kt][e] = v; bm = fmaxf(bm, v); }
        } else {
#pragma unroll
            for (int kt = 0; kt < 4; ++kt)
#pragma unroll
                for (int e = 0; e < 4; ++e) { const int ko = 16 * kt + 4 * gq + e; const bool ok = sel[rg] && ko >= klo[rg] && ko <= khi[rg]; const float v = ok ? s[rg][kt][e] : NEGF; s[rg][kt][e] = v; bm = fmaxf(bm, v); }
        }
        bm = xmax16(bm);
        const float mnew = fmaxf(mrow[rg], bm), alpha = __builtin_amdgcn_exp2f(mrow[rg] - mnew);
        const bool moved = __builtin_amdgcn_ballot_w64(mnew != mrow[rg]) != 0ull;
        mrow[rg] = mnew;
        float ps = 0.f;
#pragma unroll
        for (int kt = 0; kt < 4; ++kt)
#pragma unroll
            for (int e = 0; e < 4; ++e) { const float p = __builtin_amdgcn_exp2f(s[rg][kt][e] - mnew); s[rg][kt][e] = p; ps += p; }
        lrow[rg] = lrow[rg] * alpha + ps;
        if (moved) {
#pragma unroll
            for (int dt = 0; dt < 4; ++dt) o[rg][dt] *= alpha;
        }
    }
#pragma unroll
    for (int kk = 0; kk < 2; ++kk) {
        const bf16x8 pf0 = pack8(s[0][2 * kk][0], s[0][2 * kk][1], s[0][2 * kk][2], s[0][2 * kk][3], s[0][2 * kk + 1][0], s[0][2 * kk + 1][1], s[0][2 * kk + 1][2], s[0][2 * kk + 1][3]);
        const bf16x8 pf1 = pack8(s[1][2 * kk][0], s[1][2 * kk][1], s[1][2 * kk][2], s[1][2 * kk][3], s[1][2 * kk + 1][0], s[1][2 * kk + 1][1], s[1][2 * kk + 1][2], s[1][2 * kk + 1][3]);
#pragma unroll
        for (int dt = 0; dt < 4; ++dt) {
            const LAS unsigned char* va = Vb + (32 * kk + 4 * gq + (j >> 2)) * 128 + (16 * dt + 4 * (j & 3)) * 2;
            const bf16x8 vf = cat4(tr16(va), tr16(va + 16 * 128));
            o[0][dt] = __builtin_amdgcn_mfma_f32_16x16x32_bf16(vf, pf0, o[0][dt], 0, 0, 0);
            o[1][dt] = __builtin_amdgcn_mfma_f32_16x16x32_bf16(vf, pf1, o[1][dt], 0, 0, 0);
        }
        }
}
__device__ __forceinline__ void glds16(const void* gsrc, unsigned lds_dst) { unsigned keep;
    asm volatile("s_mov_b32 %0, m0\n\ts_mov_b32 m0, %2\n\ts_nop 0\n\tglobal_load_lds_dwordx4 %1, off\n\ts_mov_b32 m0, %0" : "=&s"(keep) : "v"(gsrc), "s"(lds_dst) : "memory"); }
template <int MODE>
__device__ __forceinline__ void nsa_attend(const bf16* kv, unsigned long long mask, int b, int g, int c, int tid, int lane, LAS unsigned char* ring, const bf16x8 (&qf)[2][2],
                                           const unsigned long long (&rmask)[2], const unsigned long long (&gmask)[2], const int (&trow)[2], float (&mrow)[2], float (&lrow)[2], f32x4v (&o)[2][4]) {
    const int wave = __builtin_amdgcn_readfirstlane(tid >> 6);
    const int rr = 8 * wave + (lane >> 3);
    const bf16* gk = kv + (size_t)(b * SEQ + rr) * 256 + g * 64 + (((lane & 7) ^ (rr & 7)) << 3);
    const bf16* gv = kv + (size_t)(b * SEQ + rr) * 256 + 128 + g * 64 + ((lane & 7) << 3);
    const unsigned ring0 = (unsigned)(uintptr_t)(unsigned char*)ring + wave * 1024;
#define NSA_ISSUE(jb_, slot_) do { glds16(gk + (size_t)(jb_) * 64 * 256, (unsigned)__builtin_amdgcn_readfirstlane(ring0 + (slot_) * NSA_SLOT)); \
                                   glds16(gv + (size_t)(jb_) * 64 * 256, (unsigned)__builtin_amdgcn_readfirstlane(ring0 + (slot_) * NSA_SLOT + 8192)); } while (0)
    unsigned long long remi = mask, remc = mask; int lastb = 0, si = 0, sc_ = 0;
#if DUP == 12
    float m2_[2] = {NEGF, NEGF}, l2_[2] = {0.f, 0.f}; f32x4v o2_[2][4]; for (int rg = 0; rg < 2; ++rg) for (int dt = 0; dt < 4; ++dt) o2_[rg][dt] = (f32x4v){0.f, 0.f, 0.f, 0.f};
#endif
#pragma unroll
    for (int d = 0; d < NSA_D - 1; ++d) { if (remi) { lastb = (int)__builtin_ctzll(remi); remi &= remi - 1ull; } NSA_ISSUE(lastb, si); si = si + 1 == NSA_D ? 0 : si + 1; }
    while (remc) {
        const int jj = (int)__builtin_ctzll(remc); remc &= remc - 1ull;
        asm volatile("s_waitcnt vmcnt(8) lgkmcnt(0)\n\ts_barrier" ::: "memory");
        if (remi) { lastb = (int)__builtin_ctzll(remi); remi &= remi - 1ull; }
        NSA_ISSUE(lastb, si); si = si + 1 == NSA_D ? 0 : si + 1;
        const LAS unsigned char* kb_ = ring + sc_ * NSA_SLOT; const LAS unsigned char* vb_ = kb_ + 8192; sc_ = sc_ + 1 == NSA_D ? 0 : sc_ + 1;
        bool sel[2]; int klo[2], khi[2]; bool act[2];
#pragma unroll
        for (int rg = 0; rg < 2; ++rg) { const int o6 = trow[rg] & 63;
            if (MODE == 0) { sel[rg] = (rmask[rg] >> jj) & 1ull; act[rg] = (gmask[rg] >> jj) & 1ull; klo[rg] = 0; khi[rg] = (jj == c) ? o6 : 63; }
            else { sel[rg] = true; act[rg] = true; klo[rg] = (jj == c - 4) ? o6 + 1 : 0; khi[rg] = (jj == c) ? o6 : 63; } }
        if (act[0] || act[1]) {
            const bool full = (MODE == 0) ? (jj != c) : (jj != c && jj != c - 4);
            if (full) nsa_block2<true>(kb_, vb_, qf, sel, klo, khi, mrow, lrow, o, lane); else nsa_block2<false>(kb_, vb_, qf, sel, klo, khi, mrow, lrow, o, lane);
#if DUP == 12
            if (full) nsa_block2<true>(kb_, vb_, qf, sel, klo, khi, m2_, l2_, o2_, lane); else nsa_block2<false>(kb_, vb_, qf, sel, klo, khi, m2_, l2_, o2_, lane);
#endif
        }
    }
#if DUP == 12
    { float acc_ = 0.f; for (int rg = 0; rg < 2; ++rg) { acc_ += l2_[rg] + m2_[rg]; for (int dt = 0; dt < 4; ++dt) acc_ += o2_[rg][dt][0] + o2_[rg][dt][1] + o2_[rg][dt][2] + o2_[rg][dt][3]; } if (acc_ == 123.456f) ((LAS float*)(ring + NSA_D * NSA_SLOT + 600))[0] = acc_; }
#endif
    asm volatile("s_waitcnt vmcnt(0) lgkmcnt(0)\n\ts_barrier" ::: "memory");
#undef NSA_ISSUE
}
#if defined(PROBE_CMP)
__device__ __forceinline__ void nsa_probe_store(unsigned char* ws, int row, int head, int gq, const f32x4v (&v)[4]) {
    bf16* pb_ = (bf16*)(ws + 497 * MiB);
    for (int dt = 0; dt < 4; ++dt) { uint2 w; w.x = cvtpk(v[dt][0], v[dt][1]); w.y = cvtpk(v[dt][2], v[dt][3]); *(uint2*)(pb_ + (size_t)row * 512 + head * 64 + 16 * dt + 4 * gq) = w; }
}
#endif
__device__ __forceinline__ void nsa_unit(unsigned char* ws, int unit, LAS unsigned char* lds, int tid_in, bf16* yout) {
    int tid = tid_in; asm volatile("" : "+v"(tid));
    const int lane = tid & 63, wave = __builtin_amdgcn_readfirstlane(tid >> 6), j = lane & 15, gq = lane >> 4;
    const int c = unit & 63, g = (unit >> 6) & 1, b = unit >> 7, bg = b * 2 + g;
    LAS float* impa = (LAS float*)(lds + NSA_OFF_IMPA); LAS float* impb = (LAS float*)(lds + NSA_OFF_IMPB);
    LAS unsigned long long* um = (LAS unsigned long long*)(lds + NSA_OFF_UM);
    TP_DECL
    for (int i = tid; i < 2 * 64 * 65; i += 512) impa[i] = 0.f;
    {
        const v4u* ksrc = (const v4u*)((const bf16*)(ws + WS_KC) + (size_t)bg * 256 * 64); const v4u* vsrc = (const v4u*)((const bf16*)(ws + WS_VC) + (size_t)bg * 64 * 256);
#pragma unroll
        for (int i = 0; i < 4; ++i) { const int idx = tid + 512 * i; const int r = idx >> 3, sg = idx & 7; *(LAS v4u*)(lds + NSA_OFF_KCL + r * 128 + ((sg ^ (r & 7)) << 4)) = ksrc[idx]; }
#pragma unroll
        for (int i = 0; i < 4; ++i) { const int idx = tid + 512 * i; const int r = idx >> 5, sg = idx & 31; *(LAS v4u*)(lds + NSA_OFF_VCTL + r * 512 + ((sg ^ (r & 15)) << 4)) = vsrc[idx]; }
    }
    bf16* qc = (bf16*)(ws + WS_QC);
    const bf16* misc = (const bf16*)(ws + WS_MISC);
    bf16x8 qf[2][2]; float gate[2][3]; int trow[2];
#pragma unroll
    for (int rg = 0; rg < 2; ++rg) {
        const int q = 8 * wave + 4 * rg + (j >> 2), t = 64 * c + q, row = b * SEQ + t, head = g * 4 + (j & 3);
        trow[rg] = t;
#pragma unroll
        for (int ks = 0; ks < 2; ++ks) qf[rg][ks] = *(const bf16x8*)(qc + (size_t)row * 512 + head * 64 + 8 * gq + 32 * ks);
#pragma unroll
        for (int e = 0; e < 3; ++e) gate[rg][e] = __builtin_amdgcn_rcpf(1.0f + __expf(-bf2f(misc[(size_t)row * 256 + 196 + head * 3 + e])));
    }
    typedef unsigned u32x2v __attribute__((ext_vector_type(2)));
    LAS u32x2v* stash = (LAS u32x2v*)(lds + NSA_OFF_ST) + tid * 8;
    __syncthreads();
    const int nT = (c >> 2) + 1;
#pragma unroll
    for (int rg = 0; rg < 2; ++rg) {
        const int t = trow[rg], nv = t >= 31 ? ((t - 15) >> 4) : 0;
        f32x4v s[16]; float mx = NEGF;
#pragma unroll
        for (int T = 0; T < 16; ++T) {
            s[T] = (f32x4v){0.f, 0.f, 0.f, 0.f};
            if (T < nT) {
#pragma unroll
                for (int ks = 0; ks < 2; ++ks) { const bf16x8 kf = *(const LAS bf16x8*)(lds + NSA_OFF_KCL + (16 * T + j) * 128 + (((gq + 4 * ks) ^ (j & 7)) << 4)); s[T] = __builtin_amdgcn_mfma_f32_16x16x32_bf16(kf, qf[rg][ks], s[T], 0, 0, 0); }
#pragma unroll
                for (int e = 0; e < 4; ++e) { const float v = (16 * T + 4 * gq + e < nv) ? s[T][e] : NEGF; s[T][e] = v; mx = fmaxf(mx, v); }
            }
        }
        mx = xmax16(mx);
        float ls = 0.f;
#pragma unroll
        for (int T = 0; T < 16; ++T) if (T < nT) {
#pragma unroll
            for (int e = 0; e < 4; ++e) { const float p = (16 * T + 4 * gq + e < nv) ? __builtin_amdgcn_exp2f(s[T][e] - mx) : 0.f; s[T][e] = p; ls += p; }
        }
        ls = xsum16(ls);
        const float inv = nv > 0 ? __builtin_amdgcn_rcpf(ls) : 0.f;
        const int q = 8 * wave + 4 * rg + (j >> 2);
#pragma unroll
        for (int T = 0; T < 16; ++T) if (T < nT) {
#pragma unroll
            for (int e = 0; e < 4; ++e) s[T][e] *= inv;
            float a = s[T][0] + s[T][1] + s[T][2] + 0.5f * s[T][3], bb = 0.5f * s[T][3];
            a += __shfl_xor(a, 1); a += __shfl_xor(a, 2); bb += __shfl_xor(bb, 1); bb += __shfl_xor(bb, 2);
            if ((j & 3) == 0) { impa[q * 65 + 4 * T + gq] = a; impb[q * 65 + 4 * T + gq + 1] = bb; }
        }
        f32x4v oc[4];
#pragma unroll
        for (int dt = 0; dt < 4; ++dt) oc[dt] = (f32x4v){0.f, 0.f, 0.f, 0.f};
#pragma unroll
        for (int kk = 0; kk < 8; ++kk) if (2 * kk < nT) {
            const bf16x8 pf = pack8(s[2 * kk][0], s[2 * kk][1], s[2 * kk][2], s[2 * kk][3], s[2 * kk + 1][0], s[2 * kk + 1][1], s[2 * kk + 1][2], s[2 * kk + 1][3]);
#pragma unroll
            for (int dt = 0; dt < 4; ++dt) {
                const LAS unsigned char* vp = lds + NSA_OFF_VCTL + (16 * dt + j) * 512 + (gq & 1) * 8;
                const s16x4 v0 = *(const LAS s16x4*)(vp + ((((8 * kk + gq) >> 1) ^ j) << 4)), v1 = *(const LAS s16x4*)(vp + (((((8 * kk + gq) >> 1) + 2) ^ j) << 4));
                oc[dt] = __builtin_amdgcn_mfma_f32_16x16x32_bf16(cat4(v0, v1), pf, oc[dt], 0, 0, 0);
            }
        }
#pragma unroll
        for (int dt = 0; dt < 4; ++dt) { const f32x4v v = oc[dt] * gate[rg][0]; u32x2v w; w.x = pg8::cvt_pk_bf16(v[0], v[1]); w.y = pg8::cvt_pk_bf16(v[2], v[3]); stash[rg * 4 + dt] = w; }
        __builtin_amdgcn_sched_barrier(0);
    }
    __syncthreads();
    TP_MARK(5);
    unsigned long long smask[8], mymask = 0ull;
#pragma unroll
    for (int qi = 0; qi < 8; ++qi) {
        const int q = 8 * wave + qi;
#if PROBE == 4
        const float imp = ((const float*)(ws + 500 * MiB))[((size_t)(b * SEQ + 64 * c + q) * 2 + g) * 64 + lane];
#else
        const float imp = impa[q * 65 + lane] + impb[q * 65 + lane];
#endif
#if PROBE && (PROBE != 5 || defined(PROBE5_IMP))
        ((float*)(ws + 516 * MiB))[((size_t)(b * SEQ + 64 * c + q) * 2 + g) * 64 + lane] = (lane <= c) ? imp : 0.f;
#endif
        const bool forced = (lane == 0) || (lane == c), adm = lane <= c;
        unsigned key = forced ? (0xFFFFFF00u | (unsigned)(63 - lane)) : (adm ? ((__float_as_uint(imp) & 0xFFFFFFC0u) | (unsigned)(63 - lane)) : 0u);
        unsigned long long mk = 0ull;
#if TOP8_RANK
        { int rank = 0;
#pragma unroll
          for (int jj = 0; jj < 64; ++jj) { const unsigned kk = (unsigned)__builtin_amdgcn_readlane((int)key, jj); rank += (kk > key) ? 1 : 0; }
          mk = __ballot(key != 0u && rank < 8); }
#else
        for (int k = 0; k < 8; ++k) { const unsigned mx = wave_max_u(key); if (mx == 0u) break; const int win = 63 - (int)(mx & 63u); mk |= 1ull << win; if (lane == win) key = 0u; }
#endif
        mk = ((unsigned long long)(unsigned)__builtin_amdgcn_readfirstlane((unsigned)(mk >> 32)) << 32) | (unsigned long long)(unsigned)__builtin_amdgcn_readfirstlane((unsigned)mk);
#ifdef FIXSEL
        { mk = 1ull | (1ull << c); for (int d = 1; d <= 6; ++d) mk |= 1ull << (((FIXHOM ? 0 : q * 7) + d * 5) % (c + 1)); }
#endif
#if PROBE == 2
        mk = ((const unsigned long long*)(ws + 496 * MiB))[(size_t)(b * SEQ + 64 * c + q) * 2 + g];
        mk = ((unsigned long long)(unsigned)__builtin_amdgcn_readfirstlane((unsigned)(mk >> 32)) << 32) | (unsigned long long)(unsigned)__builtin_amdgcn_readfirstlane((unsigned)mk);
#endif
#if PROBE == 5
        if (lane == 0) ((unsigned long long*)(ws + 498 * MiB))[(size_t)(b * SEQ + 64 * c + q) * 2 + g] = mk;
#endif
#if PROBE == 5 && !defined(PROBE5_IMP)
        ((float*)(ws + 516 * MiB))[((size_t)(b * SEQ + 64 * c + q) * 2 + g) * 64 + lane] = ((mk >> lane) & 1ull) ? 1.f : 0.f;
#endif
        smask[qi] = mk; mymask |= mk;
    }
    if (lane == 0) um[wave] = mymask;
    __syncthreads();
    unsigned long long umask = 0ull;
#pragma unroll
    for (int w = 0; w < 8; ++w) umask |= um[w];
    umask = ((unsigned long long)(unsigned)__builtin_amdgcn_readfirstlane((unsigned)(umask >> 32)) << 32) | (unsigned long long)(unsigned)__builtin_amdgcn_readfirstlane((unsigned)umask);
    unsigned long long rmask[2];
    { LAS unsigned long long* qm = (LAS unsigned long long*)(lds + NSA_OFF_QM);
      __syncthreads();
#pragma unroll
      for (int qi = 0; qi < 8; ++qi) if (lane == 0) qm[8 * wave + qi] = smask[qi];
      __syncthreads();
#pragma unroll
      for (int rg = 0; rg < 2; ++rg) rmask[rg] = qm[8 * wave + 4 * rg + (j >> 2)]; }
    const unsigned long long gmask[2] = {smask[0] | smask[1] | smask[2] | smask[3], smask[4] | smask[5] | smask[6] | smask[7]};
    TP_MARK(6); TP_ADD(9, __popcll(umask)); TP_ADD(10, 1); TP_ADD(11, c + 1); TP_ADD(12, __popcll(umask & ~(c == 63 ? ~0ull : ((2ull << c) - 1ull)))); TP_ADD(13, __popcll(smask[0]));
    const bf16* kvs = (const bf16*)(ws + WS_KVS); const bf16* kvw = (const bf16*)(ws + WS_KVW);
    LAS unsigned char* ring = lds + NSA_OFF_RING;
    {
        float mrow[2] = {NEGF, NEGF}, lrow[2] = {0.f, 0.f}; f32x4v o[2][4];
#pragma unroll
        for (int rg = 0; rg < 2; ++rg)
#pragma unroll
            for (int dt = 0; dt < 4; ++dt) o[rg][dt] = (f32x4v){0.f, 0.f, 0.f, 0.f};
        nsa_attend<0>(kvs, umask, b, g, c, tid, lane, ring, qf, rmask, gmask, trow, mrow, lrow, o);
#if DUP == 8
        { __syncthreads(); float m2[2] = {NEGF, NEGF}, l2[2] = {0.f, 0.f}; f32x4v o2[2][4];
          for (int rg = 0; rg < 2; ++rg) for (int dt = 0; dt < 4; ++dt) o2[rg][dt] = (f32x4v){0.f, 0.f, 0.f, 0.f};
          nsa_attend<0>(kvs, umask, b, g, c, tid, lane, Kb, Vb, qf, rmask, gmask, trow, m2, l2, o2);
          bf16* dmy = (bf16*)(ws + WS_BU) + (size_t)(b * SEQ + trow[0]) * 512 + (g * 4 + (j & 3)) * 64 + 4 * gq;
          for (int rg = 0; rg < 2; ++rg) for (int dt = 0; dt < 4; ++dt) { uint2 w; w.x = pg8::cvt_pk_bf16(o2[rg][dt][0] + l2[rg], o2[rg][dt][1]); w.y = pg8::cvt_pk_bf16(o2[rg][dt][2], o2[rg][dt][3]); *(uint2*)(dmy + 16 * dt) = w; } }
#endif
#pragma unroll
        for (int rg = 0; rg < 2; ++rg) { const float sc = gate[rg][1] * __builtin_amdgcn_rcpf(xsum16(lrow[rg]));
#pragma unroll
            for (int dt = 0; dt < 4; ++dt) { const u32x2v p = stash[rg * 4 + dt]; const f32x4v v = o[rg][dt] * sc; u32x2v w; w.x = pg8::cvt_pk_bf16(v[0] + bflo(p.x), v[1] + bfhi(p.x)); w.y = pg8::cvt_pk_bf16(v[2] + bflo(p.y), v[3] + bfhi(p.y)); stash[rg * 4 + dt] = w; }
            }
        __syncthreads();
    }
    TP_MARK(7);
    {
        float mrow[2] = {NEGF, NEGF}, lrow[2] = {0.f, 0.f}; f32x4v o[2][4];
#pragma unroll
        for (int rg = 0; rg < 2; ++rg)
#pragma unroll
            for (int dt = 0; dt < 4; ++dt) o[rg][dt] = (f32x4v){0.f, 0.f, 0.f, 0.f};
        { const int j0 = c - 4 > 0 ? c - 4 : 0; const unsigned long long wmask = ((c == 63 ? ~0ull : ((1ull << (c + 1)) - 1ull)) >> j0) << j0;
          nsa_attend<1>(kvw, wmask, b, g, c, tid, lane, ring, qf, rmask, gmask, trow, mrow, lrow, o); }
#pragma unroll
        for (int rg = 0; rg < 2; ++rg) { const float sc = gate[rg][2] * __builtin_amdgcn_rcpf(xsum16(lrow[rg]));
#pragma unroll
            for (int dt = 0; dt < 4; ++dt) { const u32x2v p = stash[rg * 4 + dt]; const f32x4v v = o[rg][dt] * sc; uint2 w; w.x = pg8::cvt_pk_bf16(v[0] + bflo(p.x), v[1] + bfhi(p.x)); w.y = pg8::cvt_pk_bf16(v[2] + bflo(p.y), v[3] + bfhi(p.y));
                *(uint2*)(yout + (size_t)(b * SEQ + trow[rg]) * 512 + (g * 4 + (j & 3)) * 64 + 16 * dt + 4 * gq) = w; }
            }
    }
    __syncthreads();
    TP_MARK(8);
}
__device__ __forceinline__ void prep_kva16(unsigned char* ws, int task, int lane) {
    const int j = lane & 15, gq = lane >> 4, row = task * 16 + j;
    const bf16* misc = (const bf16*)(ws + WS_MISC) + (size_t)row * 256 + 64;
    const bf16* wu = (const bf16*)(ws + WS_W + WO_UKV);
    bf16x8 cf[4]; float ss = 0.f;
#pragma unroll
    for (int ks = 0; ks < 4; ++ks) { const v4u v = *(const v4u*)(misc + 8 * gq + 32 * ks); cf[ks] = __builtin_bit_cast(bf16x8, v); float f[8]; unpack8(v, f);
#pragma unroll
        for (int e = 0; e < 8; ++e) ss += f[e] * f[e]; }
    ss = xsum16(ss);
    const float r = 1.0f / sqrtf(ss * (1.f / 128.f) + EPS);
    const float* rp = (const float*)(ws + WS_ROPE) + (size_t)row * 16;
    bf16* o = (bf16*)(ws + WS_KVA) + (size_t)row * 128;
#pragma unroll
    for (int ct = 0; ct < 8; ++ct) {
        f32x4v a = {0.f, 0.f, 0.f, 0.f};
#pragma unroll
        for (int ks = 0; ks < 4; ++ks) { const bf16x8 wf = *(const bf16x8*)(wu + (size_t)(16 * ct + j) * 128 + 8 * gq + 32 * ks); a = __builtin_amdgcn_mfma_f32_16x16x32_bf16(wf, cf[ks], a, 0, 0, 0); }
        a *= r;
        if (ct == 0) {
            const float c0 = rp[2 * gq], s0 = rp[8 + 2 * gq], c1 = rp[2 * gq + 1], s1 = rp[8 + 2 * gq + 1];
            const float x0 = a[0], x1 = a[1], x2 = a[2], x3 = a[3];
            a[0] = x0 * c0 - x1 * s0; a[1] = x1 * c0 + x0 * s0; a[2] = x2 * c1 - x3 * s1; a[3] = x3 * c1 + x2 * s1;
        }
        uint2 w; w.x = cvtpk(a[0], a[1]); w.y = cvtpk(a[2], a[3]);
        *(uint2*)(o + 16 * ct + 4 * gq) = w;
    }
}
__device__ __forceinline__ void prep_pool16(unsigned char* ws, int task, int lane, const LAS unsigned char* wl) {
    const int j = lane & 15, gq = lane >> 4, row = task * 16 + j, t = row & (SEQ - 1);
    const bf16* bu = (const bf16*)(ws + WS_BU);
    bf16* yb = (bf16*)(ws + WS_YB) + (size_t)row * 512;
#pragma unroll 1
    for (int g = 0; g < 4; ++g) {
        const int w = 2 << g, lo = (t + 1 - w) > 0 ? (t + 1 - w) : 0, cnt = t + 1 - lo; const float inv = 1.0f / (float)cnt;
        bf16x8 pf[4];
#pragma unroll
        for (int ks = 0; ks < 4; ++ks) {
            const bf16* p = bu + (size_t)row * 512 + g * 128 + 8 * gq + 32 * ks;
            float sum[8] = {0.f, 0.f, 0.f, 0.f, 0.f, 0.f, 0.f, 0.f}, cur[8];
            { const v4u v = *(const v4u*)p; unpack8(v, cur);
#pragma unroll
              for (int e = 0; e < 8; ++e) sum[e] = cur[e]; }
            v4u wv_[15];
#pragma unroll
            for (int i = 1; i < 16; ++i) if (i < w) wv_[i - 1] = *(const v4u*)(p - (size_t)(i < cnt ? i : 0) * 512);
#pragma unroll
            for (int i = 1; i < 16; ++i) if (i < w) { const bool ok = i < cnt; float f[8]; unpack8(wv_[i - 1], f);
#pragma unroll
                for (int e = 0; e < 8; ++e) sum[e] += ok ? f[e] : 0.f; }
            __builtin_amdgcn_sched_barrier(0);
            pf[ks] = pack8(sum[0] * inv - cur[0], sum[1] * inv - cur[1], sum[2] * inv - cur[2], sum[3] * inv - cur[3], sum[4] * inv - cur[4], sum[5] * inv - cur[5], sum[6] * inv - cur[6], sum[7] * inv - cur[7]);
        }
#pragma unroll
        for (int dt = 0; dt < 8; ++dt) {
            f32x4v a = {0.f, 0.f, 0.f, 0.f};
#pragma unroll
            for (int ks = 0; ks < 4; ++ks) {
#if POOLDBG == 1
                bf16x8 wf; for (int e = 0; e < 8; ++e) wf[e] = (short)0x3c00;
#else
                const bf16x8 wf = *(const LAS bf16x8*)(wl + (g * 128 + 16 * dt + j) * 256 + (((gq + 4 * ks) ^ j) << 4));
#endif
#if POOLDBG == 2
                bf16x8 pz; for (int e = 0; e < 8; ++e) pz[e] = (short)0x3c00; a = __builtin_amdgcn_mfma_f32_16x16x32_bf16(wf, pz, a, 0, 0, 0);
#else
                a = __builtin_amdgcn_mfma_f32_16x16x32_bf16(wf, pf[ks], a, 0, 0, 0);
#endif
            }
            uint2 wv; wv.x = cvtpk(a[0], a[1]); wv.y = cvtpk(a[2], a[3]);
            *(uint2*)(yb + g * 128 + 16 * dt + 4 * gq) = wv;
        }
    }
}
__device__ __forceinline__ float gelu_tanh_f(float x) { const float u = 0.7978845608028654f * (x + 0.044715f * x * x * x); const float e = __expf(2.0f * u); return 0.5f * x * (1.0f + (1.0f - 2.0f / (e + 1.0f))); }
__device__ __forceinline__ void prep_cmp16(unsigned char* ws, int task, LAS unsigned char* lds, int wave, int lane) {
    const int j = lane & 15, gq = lane >> 4, grp = wave >> 2, wq = wave & 3;
    const int i0 = (task & 15) * 16, bg = (task >> 4) & 15, br = task >> 8, b = bg >> 1, g = bg & 1, i = i0 + j;
    const bf16* kvc = (const bf16*)(ws + WS_KVC);
    const bf16* w1 = (const bf16*)(ws + WS_W + WO_CW1) + (size_t)br * 128 * 2048;
    const bf16* w2 = (const bf16*)(ws + WS_W + WO_CW2) + (size_t)br * 64 * 128;
    const float* posb = (const float*)(ws + WS_W + WO_POSB) + br * 128;
    LAS float* part = (LAS float*)lds + (size_t)grp * 4 * 32 * 64;
    f32x4v h[8];
#pragma unroll
    for (int nt = 0; nt < 8; ++nt) h[nt] = (f32x4v){0.f, 0.f, 0.f, 0.f};
#pragma unroll 4
    for (int k2 = 0; k2 < 16; ++k2) {
        const int ks = 16 * wq + k2, l = ks >> 1; int tok = 16 * i + l; tok = tok > SEQ - 1 ? SEQ - 1 : tok;
        const bf16x8 ff = *(const bf16x8*)(kvc + (size_t)(b * SEQ + tok) * 256 + br * 128 + g * 64 + 32 * (ks & 1) + 8 * gq);
#pragma unroll
        for (int nt = 0; nt < 8; ++nt) { const bf16x8 wf = *(const bf16x8*)(w1 + (size_t)(16 * nt + j) * 2048 + 32 * ks + 8 * gq); h[nt] = __builtin_amdgcn_mfma_f32_16x16x32_bf16(wf, ff, h[nt], 0, 0, 0); }
    }
#pragma unroll
    for (int nt = 0; nt < 8; ++nt)
#pragma unroll
        for (int e = 0; e < 4; ++e) part[(wq * 32 + nt * 4 + e) * 64 + lane] = h[nt][e];
    __syncthreads();
    if (wq == 0) {
#pragma unroll
        for (int nt = 0; nt < 8; ++nt) { const f32x4v pbv = *(const f32x4v*)(posb + 16 * nt + 4 * gq);
#pragma unroll
            for (int e = 0; e < 4; ++e) { const int idx = (nt * 4 + e) * 64 + lane; h[nt][e] = gelu_tanh_f(((part[idx] + part[32 * 64 + idx]) + (part[2 * 32 * 64 + idx] + part[3 * 32 * 64 + idx])) + pbv[e]); } }
        f32x4v o[4];
#pragma unroll
        for (int dt = 0; dt < 4; ++dt) o[dt] = (f32x4v){0.f, 0.f, 0.f, 0.f};
#pragma unroll
        for (int kk = 0; kk < 4; ++kk) {
            const bf16x8 hf = pack8(h[2 * kk][0], h[2 * kk][1], h[2 * kk][2], h[2 * kk][3], h[2 * kk + 1][0], h[2 * kk + 1][1], h[2 * kk + 1][2], h[2 * kk + 1][3]);
#pragma unroll
            for (int dt = 0; dt < 4; ++dt) { const bf16* wp = w2 + (size_t)(16 * dt + j) * 128 + 32 * kk + 4 * gq; const s16x4 v0 = *(const s16x4*)wp, v1 = *(const s16x4*)(wp + 16);
                o[dt] = __builtin_amdgcn_mfma_f32_16x16x32_bf16(cat4(v0, v1), hf, o[dt], 0, 0, 0); }
        }
        const bool dead = i == 255;
        if (br == 0) { bf16* kc = (bf16*)(ws + WS_KC) + ((size_t)bg * 256 + i) * 64;
#pragma unroll
            for (int dt = 0; dt < 4; ++dt) { uint2 w; w.x = dead ? 0u : cvtpk(o[dt][0], o[dt][1]); w.y = dead ? 0u : cvtpk(o[dt][2], o[dt][3]); *(uint2*)(kc + 16 * dt + 4 * gq) = w; }
        } else { bf16* vct = (bf16*)(ws + WS_VC) + (size_t)bg * 64 * 256 + i;
#pragma unroll
            for (int dt = 0; dt < 4; ++dt)
#pragma unroll
                for (int e = 0; e < 4; ++e) vct[(size_t)(16 * dt + 4 * gq + e) * 256] = dead ? (bf16)0 : (bf16)f2bf(o[dt][e]);
        }
    }
    __syncthreads();
}
__device__ __forceinline__ void phase_prep(const Args& P, unsigned char* ws, int z, int l, LAS unsigned char* lds, int gw, int NGW, int lane, int wave) {
    asm volatile("" : "+v"(lane)); lane &= 63; asm volatile("" : "+s"(gw), "+s"(NGW));
    for (int it = 2 * (gw >> 3) + (wave >> 2); it < 512 + (wave >> 2); it += 2 * (NGW >> 3)) prep_cmp16(ws, it < 512 ? it : 511, lds, wave, lane);
    {
        const v4u* src = (const v4u*)(ws + WS_W + WO_POOL); const int t_ = (wave << 6) | lane;
#pragma unroll
        for (int i = 0; i < 16; ++i) { const int idx = t_ + 512 * i, r = idx >> 4, sg = idx & 15; *(LAS v4u*)(lds + r * 256 + ((sg ^ (r & 15)) << 4)) = src[idx]; }
        __syncthreads();
    }
    for (int it = gw; it < M / 16; it += NGW) { prep_kva16(ws, it, lane); prep_pool16(ws, it, lane, lds); }
    __syncthreads();
}
constexpr int DSA_K = DSA_K_V, DSA_S = 32 - DSA_K, DSA_CAP = DSA_CAP_V;
constexpr int DSA_OFF_CNT = 0, DSA_OFF_PC = 3072, DSA_OFF_LIST = DSA_OFF_PC + 32 * 16 * 4, DSA_OFF_V = DSA_OFF_LIST + 16 * 256 * 2, DSA_VB = 64 * NSA_VSTR * 2, DSA_LDS = DSA_OFF_V + 8 * DSA_VB;
#define DSA_FOR_TILES(...) _Pragma("unroll") for (int G8 = 0; G8 < 4; ++G8) { if (G8 < ngrp) { _Pragma("unroll") for (int T8 = 0; T8 < 8; ++T8) { const int T = G8 * 8 + T8; __VA_ARGS__ } } }
__device__ __forceinline__ void cnt_ge(int& c, unsigned u, unsigned cand) { asm volatile("v_cmp_ge_u32_e32 vcc, %1, %2\n\tv_addc_co_u32_e32 %0, vcc, 0, %0, vcc" : "+v"(c) : "v"(u), "v"(cand) : "vcc"); }
__device__ __forceinline__ void cnt_gt(int& c, unsigned u, unsigned cand) { asm volatile("v_cmp_gt_u32_e32 vcc, %1, %2\n\tv_addc_co_u32_e32 %0, vcc, 0, %0, vcc" : "+v"(c) : "v"(u), "v"(cand) : "vcc"); }
__device__ __forceinline__ void cnt_le(int& c, unsigned u, unsigned cand) { asm volatile("v_cmp_le_u32_e32 vcc, %1, %2\n\tv_addc_co_u32_e32 %0, vcc, 0, %0, vcc" : "+v"(c) : "v"(u), "v"(cand) : "vcc"); }
__device__ __forceinline__ int dsa_total(LAS unsigned* cnt, int par, int wave, int j, int gq, int c) {
    c += __shfl_xor(c, 16); c += __shfl_xor(c, 32);
    if (gq == 0) cnt[(par * 8 + wave) * 16 + j] = (unsigned)c;
    __syncthreads();
    int tot = 0;
#pragma unroll
    for (int w = 0; w < 8; ++w) tot += (int)cnt[(par * 8 + w) * 16 + j];
    return tot;
}
__device__ __forceinline__ void dsa_unit(unsigned char* ws, int unit, LAS unsigned char* lds, int tid_in, bf16* yout) {
    int tid = tid_in; asm volatile("" : "+v"(tid));
    const int lane = tid & 63, wave = __builtin_amdgcn_readfirstlane(tid >> 6), j = lane & 15, gq = lane >> 4;
    const int b = unit >> 8, q0 = (unit & 255) * 16, t = q0 + j, row = b * SEQ + t;
    LAS unsigned* cnt = (LAS unsigned*)(lds + DSA_OFF_CNT); LAS unsigned* pc = (LAS unsigned*)(lds + DSA_OFF_PC);
    LAS unsigned short* list = (LAS unsigned short*)(lds + DSA_OFF_LIST);
    const bf16* misc = (const bf16*)(ws + WS_MISC);
    TP_DECL
    if (q0 >= 256) {
        const int ntiles = (q0 >> 4) + 1;
        const int ntl = wave < ntiles ? ((ntiles - 1 - wave) >> 3) + 1 : 0;
        const int ngrp = (ntl + 7) >> 3;
        bf16x8 qf[4][2]; float iw[4];
        { const bf16* iq = (const bf16*)(ws + WS_IQ) + (size_t)row * 256;
#pragma unroll
          for (int h = 0; h < 4; ++h) { iw[h] = 0.5f * bf2f(misc[(size_t)row * 256 + 192 + h]);
#pragma unroll
              for (int ks = 0; ks < 2; ++ks) qf[h][ks] = *(const bf16x8*)(iq + h * 64 + 8 * gq + 32 * ks); } }
        unsigned u[32][4];
#pragma unroll
        for (int T = 0; T < 32; ++T)
#pragma unroll
            for (int e = 0; e < 4; ++e) u[T][e] = 0u;
        const int kb0 = 16 * wave + 4 * gq;
        LAS unsigned char* ring = lds + DSA_OFF_V + wave * 16384;
#define DSA_ISSUE(Ti) do { _Pragma("unroll") for (int i_ = 0; i_ < 2; ++i_) { const int r_ = 8 * i_ + (lane >> 3); int kr_ = 16 * wave + 128 * (Ti) + r_; kr_ = kr_ > SEQ - 1 ? SEQ - 1 : kr_; \
            __builtin_amdgcn_global_load_lds((const unsigned*)(misc + (size_t)(b * SEQ + kr_) * 256 + (((lane & 7) ^ (r_ & 7)) << 3)), (LAS unsigned*)(ring + ((Ti) & 7) * 2048 + i_ * 1024), 16, 0, 0); } } while (0)
        if (ngrp > 0) {
#pragma unroll
            for (int T = 0; T < 8; ++T) DSA_ISSUE(T);
        }
        DSA_FOR_TILES(
            asm volatile("s_waitcnt vmcnt(14)" ::: "memory");
            const LAS unsigned char* tp = ring + (T & 7) * 2048 + j * 128;
            const bf16x8 kf0 = *(const LAS bf16x8*)(tp + ((gq ^ (j & 7)) << 4)); const bf16x8 kf1 = *(const LAS bf16x8*)(tp + (((gq + 4) ^ (j & 7)) << 4));
            asm volatile("s_waitcnt lgkmcnt(0)" ::: "memory");
            DSA_ISSUE(T + 8);
            float sc[4] = {0.f, 0.f, 0.f, 0.f};
            _Pragma("unroll") for (int h = 0; h < 4; ++h) {
                f32x4v a = {0.f, 0.f, 0.f, 0.f};
                a = __builtin_amdgcn_mfma_f32_16x16x32_bf16(kf0, qf[h][0], a, 0, 0, 0);
                a = __builtin_amdgcn_mfma_f32_16x16x32_bf16(kf1, qf[h][1], a, 0, 0, 0);
                _Pragma("unroll") for (int e = 0; e < 4; ++e) sc[e] += iw[h] * fmaxf(a[e], 0.f);
                asm volatile("" : "+v"(sc[0]), "+v"(sc[1]), "+v"(sc[2]), "+v"(sc[3]));
            }
            _Pragma("unroll") for (int e = 0; e < 4; ++e) { unsigned x = f2o(sc[e]); asm volatile("" : "+v"(x)); u[T][e] = (kb0 + 128 * T + e <= t) ? x : 0u; }
        )
        asm volatile("s_waitcnt vmcnt(0)" ::: "memory");
#undef DSA_ISSUE
        TP_MARK(0);
        unsigned prefix = 0u; bool exact = false; int par = 0; int cab = 0;
        LAS unsigned* lcnt = (LAS unsigned*)(lds + DSA_OFF_V); LAS unsigned* lcab = lcnt + 16; LAS unsigned* lvst = lcnt + 32; LAS unsigned* lexf = lcnt + 48; LAS unsigned* llist = lcnt + 64;
        if (tid < 16) lcnt[tid] = 0u;
#pragma unroll 1
        for (int bit = 31; bit >= DSA_S; --bit) {
            const unsigned cand = prefix | (1u << bit); int c0 = 0, c1 = 0;
            DSA_FOR_TILES(cnt_ge(c0, u[T][0], cand); cnt_ge(c1, u[T][1], cand); cnt_ge(c0, u[T][2], cand); cnt_ge(c1, u[T][3], cand);)
            const int tot = dsa_total(cnt, par, wave, j, gq, c0 + c1); par ^= 1;
            if (tot >= 256) prefix = cand; else cab = tot;
        }
        TP_MARK(1);
        { const unsigned ptop = prefix >> DSA_S;
          DSA_FOR_TILES(_Pragma("unroll") for (int e = 0; e < 4; ++e) { const unsigned x = u[T][e]; if (x != 0u && (x >> DSA_S) == ptop) { const unsigned pos = __hip_atomic_fetch_add(&lcnt[j], 1u, __ATOMIC_RELAXED, __HIP_MEMORY_SCOPE_WORKGROUP); if (pos < DSA_CAP) llist[j * DSA_CAP + pos] = x; } })
          if (wave == 0 && gq == 0) lcab[j] = (unsigned)cab; }
        __syncthreads();
        const bool ovf = __any(lcnt[j] > (unsigned)DSA_CAP);
        if (!ovf) {
#pragma unroll 1
            for (int qq = 0; qq < 2; ++qq) {
                const int q = 2 * wave + qq; const int n = (int)lcnt[q]; const int r = 256 - (int)lcab[q];
                unsigned ev[DSA_CAP / 64];
#pragma unroll
                for (int i = 0; i < DSA_CAP / 64; ++i) ev[i] = (lane + 64 * i < n) ? llist[q * DSA_CAP + lane + 64 * i] : 0u;
                unsigned p2 = (unsigned)__shfl((int)prefix, q);
#pragma unroll 1
                for (int bit = DSA_S - 1; bit >= 0; --bit) {
                    const unsigned cand = p2 | (1u << bit); int c = 0;
#pragma unroll
                    for (int i = 0; i < DSA_CAP / 64; ++i) c += __popcll(__ballot(ev[i] >= cand));
                    if (c >= r) p2 = cand;
                }
                int cf = 0;
#pragma unroll
                for (int i = 0; i < DSA_CAP / 64; ++i) cf += __popcll(__ballot(ev[i] >= p2));
                if (lane == 0) { lvst[q] = p2; lexf[q] = (cf == r) ? 1u : 0u; }
            }
            __syncthreads();
            prefix = lvst[j]; exact = lexf[j] != 0u;
        } else {
#pragma unroll 1
            for (int bit = DSA_S - 1; bit >= 0; --bit) {
                const unsigned cand = prefix | (1u << bit); int c0 = 0, c1 = 0;
                DSA_FOR_TILES(cnt_ge(c0, u[T][0], cand); cnt_ge(c1, u[T][1], cand); cnt_ge(c0, u[T][2], cand); cnt_ge(c1, u[T][3], cand);)
                const int tot = dsa_total(cnt, par, wave, j, gq, c0 + c1); par ^= 1;
                if (!exact && tot >= 256) { prefix = cand; exact = (tot == 256); }
            }
        }
        TP_MARK(2);
        const bool alle = __all(exact);
        DSA_FOR_TILES(_Pragma("unroll") for (int e = 0; e < 4; ++e) { const unsigned x = u[T][e]; u[T][e] = (x > prefix || (exact && x == prefix)) ? 0u : (x == prefix ? (unsigned)(1 + kb0 + 128 * T + e) : 0xFFFFFFFFu); })
        unsigned kp = 0u;
        if (!alle) {
            __syncthreads();
#pragma unroll 1
            for (int bit = 11; bit >= 0; --bit) {
                const unsigned cand = kp | (1u << bit); int c0 = 0, c1 = 0;
                DSA_FOR_TILES(cnt_le(c0, u[T][0], cand); cnt_le(c1, u[T][1], cand); cnt_le(c0, u[T][2], cand); cnt_le(c1, u[T][3], cand);)
                const int tot = dsa_total(cnt, par, wave, j, gq, c0 + c1); par ^= 1;
                if (tot <= 255) kp = cand;
            }
        }
        const unsigned kp1 = kp + 1u;
        int ns0 = 0, ns1 = 0;
        DSA_FOR_TILES(cnt_le(ns0, u[T][0], kp1); cnt_le(ns1, u[T][1], kp1); cnt_le(ns0, u[T][2], kp1); cnt_le(ns1, u[T][3], kp1);)
        pc[(wave * 4 + gq) * 16 + j] = (unsigned)(ns0 + ns1);
        __syncthreads();
        int base = 0;
        for (int i = 0; i < wave * 4 + gq; ++i) base += (int)pc[i * 16 + j];
        DSA_FOR_TILES(_Pragma("unroll") for (int e = 0; e < 4; ++e) { if (u[T][e] <= kp1) { if (base < 256) list[j * 256 + base] = (unsigned short)(kb0 + 128 * T + e); ++base; } })
    } else {
        for (int i = tid; i < 16 * 256; i += 512) list[i] = (unsigned short)(i & 255);
    }
    __syncthreads();
    TP_MARK(3);
    const bf16* kva = (const bf16*)(ws + WS_KVA);
    bf16* qa = (bf16*)(ws + WS_QA);
    LAS unsigned char* Vb = lds + DSA_OFF_V + wave * DSA_VB;
    const int tq2[2] = {q0 + 2 * wave, q0 + 2 * wave + 1};
#define DSA_KEY(st_, slot_) ((int)list[(2 * wave + ((st_) >> 2)) * 256 + (((slot_) < nselq[(st_) >> 2]) ? (slot_) : 0)])
#define DSA_LOADK(buf_, st_) do { _Pragma("unroll") for (int kt_ = 0; kt_ < 4; ++kt_) { const bf16* kp_ = kva + (size_t)(b * SEQ + DSA_KEY(st_, 64 * ((st_) & 3) + 16 * kt_ + j)) * 128 + 8 * gq; \
        buf_[kt_][0] = *(const bf16x8*)kp_; buf_[kt_][1] = *(const bf16x8*)(kp_ + 32); } } while (0)
#define DSA_LOADV(st_) do { _Pragma("unroll") for (int i_ = 0; i_ < 8; ++i_) vr[i_] = *(const v4u*)(kva + (size_t)(b * SEQ + DSA_KEY(st_, 64 * ((st_) & 3) + 8 * i_ + (lane >> 3))) * 128 + 64 + (lane & 7) * 8); } while (0)
    const int nselq[2] = {tq2[0] + 1 < 256 ? tq2[0] + 1 : 256, tq2[1] + 1 < 256 ? tq2[1] + 1 : 256};
    bf16x8 kfA[4][2], kfB[4][2]; v4u vr[8];
    bf16x8 qf[2]; float mrow = NEGF, lrow = 0.f; f32x4v o[4];
    DSA_LOADK(kfA, 0); DSA_LOADV(0);
#define DSA_STEP(st_, cur_, nxt_) do { \
        if (((st_) & 3) == 0) { const int rowq_ = b * SEQ + tq2[(st_) >> 2]; \
            _Pragma("unroll") for (int ks_ = 0; ks_ < 2; ++ks_) { qf[ks_] = (bf16x8){0, 0, 0, 0, 0, 0, 0, 0}; if (j < 8) qf[ks_] = *(const bf16x8*)(qa + (size_t)rowq_ * 512 + j * 64 + 8 * gq + 32 * ks_); } \
            mrow = NEGF; lrow = 0.f; _Pragma("unroll") for (int dt_ = 0; dt_ < 4; ++dt_) o[dt_] = (f32x4v){0.f, 0.f, 0.f, 0.f}; } \
        _Pragma("unroll") for (int i_ = 0; i_ < 8; ++i_) *(LAS v4u*)(Vb + ((8 * i_ + (lane >> 3)) * NSA_VSTR + (lane & 7) * 8) * 2) = vr[i_]; \
        if ((st_) < 7) { DSA_LOADK(nxt_, (st_) + 1); DSA_LOADV((st_) + 1); } \
        f32x4v s_[4]; float bm_ = NEGF; \
        _Pragma("unroll") for (int kt_ = 0; kt_ < 4; ++kt_) { f32x4v a_ = {0.f, 0.f, 0.f, 0.f}; \
            a_ = __builtin_amdgcn_mfma_f32_16x16x32_bf16(cur_[kt_][0], qf[0], a_, 0, 0, 0); a_ = __builtin_amdgcn_mfma_f32_16x16x32_bf16(cur_[kt_][1], qf[1], a_, 0, 0, 0); \
            _Pragma("unroll") for (int e_ = 0; e_ < 4; ++e_) { const float v_ = (64 * ((st_) & 3) + 16 * kt_ + 4 * gq + e_ < nselq[(st_) >> 2]) ? a_[e_] : NEGF; a_[e_] = v_; bm_ = fmaxf(bm_, v_); } s_[kt_] = a_; } \
        bm_ = xmax16(bm_); \
        { const float mnew_ = fmaxf(mrow, bm_), alpha_ = __builtin_amdgcn_exp2f(mrow - mnew_); mrow = mnew_; float ps_ = 0.f; \
          _Pragma("unroll") for (int kt_ = 0; kt_ < 4; ++kt_) _Pragma("unroll") for (int e_ = 0; e_ < 4; ++e_) { const float p_ = __builtin_amdgcn_exp2f(s_[kt_][e_] - mnew_); s_[kt_][e_] = p_; ps_ += p_; } \
          lrow = lrow * alpha_ + ps_; _Pragma("unroll") for (int dt_ = 0; dt_ < 4; ++dt_) o[dt_] *= alpha_; } \
        WAVE_LDS_SYNC(); \
        _Pragma("unroll") for (int kk_ = 0; kk_ < 2; ++kk_) { \
            const bf16x8 pf_ = pack8(s_[2 * kk_][0], s_[2 * kk_][1], s_[2 * kk_][2], s_[2 * kk_][3], s_[2 * kk_ + 1][0], s_[2 * kk_ + 1][1], s_[2 * kk_ + 1][2], s_[2 * kk_ + 1][3]); \
            _Pragma("unroll") for (int dt_ = 0; dt_ < 4; ++dt_) { const LAS unsigned char* va_ = Vb + ((32 * kk_ + 4 * gq + (j >> 2)) * NSA_VSTR + 16 * dt_ + 4 * (j & 3)) * 2; \
                o[dt_] = __builtin_amdgcn_mfma_f32_16x16x32_bf16(cat4(tr16(va_), tr16(va_ + 16 * NSA_VSTR * 2)), pf_, o[dt_], 0, 0, 0); } } \
        WAVE_LDS_SYNC(); \
        if (((st_) & 3) == 3) { const float inv_ = __builtin_amdgcn_rcpf(xsum16(lrow)); const int rowq_ = b * SEQ + tq2[(st_) >> 2]; \
            if (j < 8) { _Pragma("unroll") for (int dt_ = 0; dt_ < 4; ++dt_) { uint2 w_; w_.x = pg8::cvt_pk_bf16(o[dt_][0] * inv_, o[dt_][1] * inv_); w_.y = pg8::cvt_pk_bf16(o[dt_][2] * inv_, o[dt_][3] * inv_); \
                *(uint2*)(yout + (size_t)rowq_ * 512 + j * 64 + 16 * dt_ + 4 * gq) = w_; } } } \
    } while (0)
    DSA_STEP(0, kfA, kfB); DSA_STEP(1, kfB, kfA); DSA_STEP(2, kfA, kfB); DSA_STEP(3, kfB, kfA);
    DSA_STEP(4, kfA, kfB); DSA_STEP(5, kfB, kfA); DSA_STEP(6, kfA, kfB); DSA_STEP(7, kfB, kfA);
#undef DSA_STEP
#undef DSA_LOADK
#undef DSA_LOADV
#undef DSA_KEY
    __syncthreads();
    TP_MARK(4);
}
__device__ __forceinline__ void phase_mixers(const Args& P, unsigned char* ws, int z, LAS unsigned char* lds, int gw, int NGW, int lane, int wave, int bid, int G) {
    asm volatile("" : "+v"(lane)); lane &= 63; asm volatile("" : "+s"(gw), "+s"(NGW));
#if PROBE == 3
    { LAS unsigned char* wl = lds + wave * 18944; for (int it2 = gw; it2 < 2 * M; it2 += NGW) nsa_query(P, ws, z, it2 >> 1, it2 & 1, wl, lane); }
#else
    for (int k = 0; bid + G * k < 1024; ++k) {
        const int u = bid + G * k, c0 = u & 63, unit = (u & ~63) | ((k & 1) ? 63 - c0 : c0);
#if DUP == 7
        nsa_unit(ws, unit, lds, (wave << 6) | lane_id_v(), (bf16*)(ws + WS_BU));
#endif
        nsa_unit(ws, unit, lds, (wave << 6) | lane_id_v(), (bf16*)(ws + WS_QC));
    }
#endif
    for (int k = 0; bid + G * k < 2048; ++k) {
        const int u = bid + G * k, c0 = u & 255, unit = (u & ~255) | ((k & 1) ? 255 - c0 : c0);
#if DUP == 6
        dsa_unit(ws, unit, lds, (wave << 6) | lane_id_v(), (bf16*)(ws + WS_BU));
#endif
        dsa_unit(ws, unit, lds, (wave << 6) | lane_id_v(), (bf16*)(ws + WS_QA));
    }
}
__global__ void __launch_bounds__(NWAVES * 64, 2) fwd_kernel(Args args) {
    extern __shared__ __attribute__((aligned(16))) unsigned char lds_raw[];
    LAS unsigned char* lds = (LAS unsigned char*)lds_raw;
    const int wave = __builtin_amdgcn_readfirstlane((int)threadIdx.x >> 6);
#define TIDX ((wave << 6) | lane_id_v())
#define tid TIDX
#define lane TIDX
    const int G = gridDim.x, bid = blockIdx.x;
    const int gw = bid * NWAVES + wave, NGW = G * NWAVES;
    const int lo = args.ph_lo, hi = args.ph_hi;
    const Args& P = args;
    int z = 0; asm volatile("" : "+s"(z));
    unsigned char* ws = args.ws + z;
    volatile LAS unsigned* MISCW = (volatile LAS unsigned*)(lds + LDSCTL_OFF);
    if (tid < 64) MISCW[tid] = 0u;
    __syncthreads();
    XcdBarrier bar; bar.bar = (unsigned*)(ws + WS_CTL) + 4096; bar.x = 0; bar.st = nullptr;
    if (hi - lo > 1) bar = xcd_barrier_post((unsigned*)(ws + WS_CTL) + 4096, MISCW + 8);
#define RUN(k) (lo <= (k) && (k) < hi)
#define SEAM(k) do { if ((k) + 1 < hi) { XcdBarrier b2_ = bar; asm volatile("" : "+s"(b2_.bar), "+s"(b2_.x)); xcd_barrier(b2_); if (DUP == 13) xcd_barrier(b2_); } else { VM_WAIT(); __syncthreads(); } } while (0)


    if (RUN(0)) { phase_rope(P, ws, z, bid * (NWAVES * 64) + tid, G * NWAVES * 64);
        { int ln_ = TIDX; asm volatile("" : "+v"(ln_)); ln_ &= 63;
          for (int m = gw; m < M; m += NGW) stat_row_bf16(P.in[0 + z] + (size_t)m * DM, (bf16*)(ws + WS_XN) + (size_t)m * DM, (float*)(ws + WS_SSQ) + (size_t)m * 16, ln_); }
        SEAM(0); }
#define RS_PREPASS(Sref) do { const float* ssq_ = (const float*)(ws + WS_SSQ); LAS float* rsl_ = (LAS float*)(lds + RS_OFF); const int t_ = TIDX; pg8::Unit u_; \
        for (int i_ = 0; (Sref).next(i_, u_); ++i_) { const f32x4* p_ = (const f32x4*)(ssq_ + (size_t)(u_.pm * 256 + (t_ >> 1)) * 16 + (t_ & 1) * 8); const f32x4 a_ = p_[0], b_ = p_[1]; \
            float s_ = (a_.x + a_.y) + (a_.z + a_.w) + (b_.x + b_.y) + (b_.z + b_.w); s_ += __shfl_xor(s_, 1); if ((t_ & 1) == 0) rsl_[i_ * 256 + (t_ >> 1)] = 1.0f / sqrtf(s_ * (1.f / DM) + EPS); } \
        __syncthreads(); } while (0)

    for (int it = 0; it < 2 * DEPTH; ++it) {
        const int l = it >> 1, second = it & 1, pb = 1 + l * NPL + (second ? 7 : 0);
        asm volatile("" : "+s"(z));
        ws = args.ws + z;
        bf16* const XN = (bf16*)(ws + WS_XN);
        bf16* const HB = (bf16*)(ws + WS_H);
        bf16* const MG = (bf16*)(ws + WS_MG);
        bf16* const GB = (bf16*)(ws + WS_G);
        unsigned char* const wb = ws + WS_W;
        float* const OUT = P.out + z;
        const float* xin = (it == 0) ? P.in[0 + z] : (const float*)OUT;
        if (!second && RUN(pb)) { phase_convert(P, ws, z, l, lds, gw, NGW, lane, wave); SEAM(pb); }
        if (RUN(pb + 1)) {
            pg8::Gemm g{XN, (const bf16*)(wb + (second ? WO_GU2 : WO_GU1)), M, 2 * FF, DM}; pg8::StaticOrder S; S.init(M, 2 * FF, G, bid + z);
            pg8::EpiSwiglu E{HB, FF, (const LAS float*)(lds + RS_OFF)};
            RS_PREPASS(S);
#if !defined(SITE_MASK) || ((SITE_MASK >> 0) & 1)
            pg8::gemm_phase<pg8::EpiSwiglu, pg8::StaticOrder, ALIGN_UP, true>(lds, g, S, E, TIDX);
#if DUP == 3
            pg8::gemm_phase<pg8::EpiSwiglu, pg8::StaticOrder, ALIGN_UP, true>(lds, g, S, E, TIDX);
#endif
#endif
            SEAM(pb + 1);
        }
        if (RUN(pb + 2)) {
            pg8::Gemm g{HB, (const bf16*)(wb + (second ? WO_D2 : WO_D1)), M, DM, FF}; pg8::StaticOrder S; S.init(M, DM, G, bid + z);
            pg8::EpiResid E{xin, OUT, 0.5f, XN, (float*)(ws + WS_SSQ)};
#if !defined(SITE_MASK) || ((SITE_MASK >> 1) & 1)
            pg8::gemm_phase<pg8::EpiResid, pg8::StaticOrder, true, true>(lds, g, S, E, TIDX);
#endif
            SEAM(pb + 2);
        }
        if (second) continue;
        const int pm = 1 + l * NPL + 2;
        if (RUN(pm + 1)) {
            pg8::Gemm g{XN, (const bf16*)(wb + WO_IN), M, NINP, DM}; pg8::StaticOrder S; S.init(M, NINP, G, bid + z);
            pg8::EpiWin E{(bf16*)(ws + WS_QA), (bf16*)(ws + WS_QC), (bf16*)(ws + WS_IQ), (bf16*)(ws + WS_MISC), (bf16*)(ws + WS_KVC), (bf16*)(ws + WS_KVS), (bf16*)(ws + WS_KVW), (bf16*)(ws + WS_BU), GB,
                          (const float*)(ws + WS_ROPE), (const LAS float*)(lds + RS_OFF)};
            RS_PREPASS(S);
#if !defined(SITE_MASK) || ((SITE_MASK >> 2) & 1)
            pg8::gemm_phase<pg8::EpiWin, pg8::StaticOrder, ALIGN_WIN, true>(lds, g, S, E, TIDX);
#if DUP == 4
            pg8::gemm_phase<pg8::EpiWin, pg8::StaticOrder, ALIGN_WIN, true>(lds, g, S, E, TIDX);
#endif
#endif
            SEAM(pm + 1);
        }
        #ifndef NO_PREP
        if (RUN(pm + 2)) { phase_prep(P, ws, z, l, lds, gw, NGW, lane, wave);
#if DUP == 1
            { XcdBarrier b2_ = bar; asm volatile("" : "+s"(b2_.bar), "+s"(b2_.x)); xcd_barrier(b2_); } phase_prep(P, ws, z, l, lds, gw, NGW, lane, wave);
#endif
            SEAM(pm + 2); }
#endif
        #ifndef NO_MIX
        if (RUN(pm + 3)) { phase_mixers(P, ws, z, lds, gw, NGW, lane, wave, bid, G); SEAM(pm + 3); }
#endif
        if (RUN(pm + 4)) {
#if DUP == 5
          for (int rep_ = 0; rep_ < 2; ++rep_) {
#endif
            pg8::StaticOrder S; S.init(M, DM, G, bid + z);
            { pg8::Gemm g{(const bf16*)(ws + WS_QA), (const bf16*)(wb + WO_PA), M, DM, 512}; pg8::EpiProj<0> E{MG, GB, 0};
#if !defined(SITE_MASK) || ((SITE_MASK >> 3) & 1)
              pg8::gemm_phase<pg8::EpiProj<0>, pg8::StaticOrder, true, true>(lds, g, S, E, TIDX);
#endif
            }
            { pg8::Gemm g{(const bf16*)(ws + WS_YB), (const bf16*)(wb + WO_PB), M, DM, 512}; pg8::EpiProj<1> E{MG, GB, 1024};
#if !defined(SITE_MASK) || ((SITE_MASK >> 4) & 1)
              pg8::gemm_phase<pg8::EpiProj<1>, pg8::StaticOrder, true, true>(lds, g, S, E, TIDX);
#endif
            }
            { pg8::Gemm g{(const bf16*)(ws + WS_QC), (const bf16*)(wb + WO_PC), M, DM, 512}; pg8::EpiProj<1> E{MG, GB, 2048};
#if !defined(SITE_MASK) || ((SITE_MASK >> 5) & 1)
              pg8::gemm_phase<pg8::EpiProj<1>, pg8::StaticOrder, true, true>(lds, g, S, E, TIDX);
#endif
            }
#if DUP == 5
          }
#endif
            SEAM(pm + 4);
        }
        if (RUN(pm + 5)) {
            pg8::Gemm g{MG, (const bf16*)(wb + WO_OUT), M, DM, DM}; pg8::StaticOrder S; S.init(M, DM, G, bid + z);
            pg8::EpiResid E{OUT, OUT, 1.0f, XN, (float*)(ws + WS_SSQ)};
#if !defined(SITE_MASK) || ((SITE_MASK >> 6) & 1)
            pg8::gemm_phase<pg8::EpiResid, pg8::StaticOrder, true, true>(lds, g, S, E, TIDX);
#endif
            SEAM(pm + 5);
        }
    }
    if (RUN(NPH - 1)) { asm volatile("" : "+s"(z)); int ln_ = TIDX; asm volatile("" : "+v"(ln_)); ln_ &= 63; float* o_ = P.out + z; float tps_ = 1.0f;
#if TPROBE
        { const unsigned long long* sl_ = (const unsigned long long*)(P.ws + z + 32768); double a_ = 0., b_ = 0.; for (int k = 0; k < 16; ++k) { const double v_ = (double)__hip_atomic_load(sl_ + k, __ATOMIC_RELAXED, __HIP_MEMORY_SCOPE_AGENT); if ((TP_A >> k) & 1) a_ += v_; if ((TP_B >> k) & 1) b_ += v_; } tps_ = 1.0f + (float)(a_ / b_) * TP_SCALE; }
#endif
        for (int m = gw; m < M; m += NGW) norm_row_f32(o_ + (size_t)m * DM, P.in[23 + z], ln_, tps_);
#if TPROBE
        if (gw == 0 && ln_ == 0) { const unsigned long long* sl_ = (const unsigned long long*)(P.ws + z + 32768); double c_ = 0., d_ = 0.; for (int k = 0; k < 16; ++k) { const double v_ = (double)__hip_atomic_load(sl_ + k, __ATOMIC_RELAXED, __HIP_MEMORY_SCOPE_AGENT); if ((TP_C >> k) & 1) c_ += v_; if ((TP_D >> k) & 1) d_ += v_; } o_[0] = 1000.0f * (float)(c_ / d_) * TP_SCALE2; }
#endif
    }
#undef RUN
#undef tid
#undef TIDX
#undef lane
#undef SEAM
}

extern "C" void kernel_launch(void* const* d_in, const int* in_sizes, int n_in, void* d_out, int out_size, void* d_ws, size_t ws_size, hipStream_t stream) {
    static int grid = 0;
    if (grid == 0) {
        if (n_in != 24 || out_size != M * DM || ws_size < WS_END) { fprintf(stderr, "kernel_launch: unexpected shapes (n_in %d out %d ws %zu)\n", n_in, out_size, ws_size); grid = -1; return; }
        int dev = 0, cus = 0, per_cu = 0;
        if (hipGetDevice(&dev) != hipSuccess || hipDeviceGetAttribute(&cus, hipDeviceAttributeMultiprocessorCount, dev) != hipSuccess) { grid = -1; return; }
        if (hipFuncSetAttribute((const void*)fwd_kernel, hipFuncAttributeMaxDynamicSharedMemorySize, LDS_BYTES) != hipSuccess) { fprintf(stderr, "kernel_launch: hipFuncSetAttribute failed\n"); grid = -1; return; }
        if (hipOccupancyMaxActiveBlocksPerMultiprocessor(&per_cu, (const void*)fwd_kernel, NWAVES * 64, LDS_BYTES) != hipSuccess || per_cu < 1) { fprintf(stderr, "kernel_launch: occupancy query says %d\n", per_cu); }
        (void)hipGetLastError();
        grid = cus;
    }
    if (grid < 0) return;
    (void)hipMemsetAsync((char*)d_ws + WS_CTL, 0, CTL_ZERO_BYTES, stream);
    Args a{};
    for (int i = 0; i < 24; ++i) a.in[i] = (const float*)d_in[i];
    a.out = (float*)d_out; a.ws = (unsigned char*)d_ws;
#if MK_ONE_LAUNCH
    a.ph_lo = 0; a.ph_hi = NPH;
    hipLaunchKernelGGL(fwd_kernel, dim3(grid), dim3(NWAVES * 64), LDS_BYTES, stream, a);
#else
    for (int ph = 0; ph < NPH; ++ph) { a.ph_lo = ph; a.ph_hi = ph + 1; hipLaunchKernelGGL(fwd_kernel, dim3(grid), dim3(NWAVES * 64), LDS_BYTES, stream, a); }
#endif
}
```

```cpp
#include <hip/hip_runtime.h>
#include <cstdio>
#include <cstdint>
#define PROBE 0
#define PROBE_GAIN 10.0f
#define TOP8_RANK 1
#define PROBE_ROWTHR 0.01f
#define PROBE_ROWCOND 1
#define PROBE_BR -1
#define FIXHOM 0
#define DUP 0
#define TPROBE 0
#define TP_A 1
#define TP_B 1
#define TP_SCALE 1.0f
#define TP_C 1
#define TP_D 1
#define TP_SCALE2 1.0f
#define POOLDBG 0
#define YB_SPARE 0
#define ALIGN_UP true
#define ALIGN_WIN true
#define DSA_CAP_V 512
#define DSA_K_V 13
#ifndef MK_ONE_LAUNCH
#define MK_ONE_LAUNCH 1
#endif
namespace pg8 {
#define PG8_LAS __attribute__((address_space(3)))
typedef unsigned short bf16_t;
typedef short bf16x8 __attribute__((ext_vector_type(8)));
typedef float f32x4 __attribute__((ext_vector_type(4)));
typedef unsigned u32x4 __attribute__((ext_vector_type(4)));
constexpr int BM = 256, BK = 64, HALF = 128, HTB = HALF * BK * 2  , STAGE_BYTES = 8 * HTB, NXCD = 8, WGM = 8;

__host__ __device__ __forceinline__ int lds_byte(int r, int c) { const int st = (r >> 4) * 2 + (c >> 5), rr = r & 15, cc = c & 31, ob = rr * 64 + cc * 2; return st * 1024 + (ob ^ (((ob >> 9) & 1) << 5)); }
__host__ __device__ __forceinline__ void stage_rc(int b, int& R, int& C) { const int st = b / 1024, sb = b % 1024, swz = sb ^ (((sb >> 9) & 1) << 5); R = (st >> 1) * 16 + swz / 64; C = (st & 1) * 32 + (swz % 64) / 2; }
__host__ __device__ __forceinline__ int perm32(int rho) { const int n = rho >> 4, i = rho & 15; return 8 * (i >> 2) + 4 * n + (i & 3); }

struct Unit { int pm, pn, ord; };
struct Gemm { const bf16_t* A; const bf16_t* Bt; int M, N, K; };

struct StaticOrder {
    int nM, nN, nwg, G, c;
    __host__ __device__ __forceinline__ void init(int M, int N, int G_, int c_) { nM = M / BM; nN = N / BM; nwg = nM * nN; G = G_; c = c_; }
    __host__ __device__ __forceinline__ bool next(int i, Unit& u) const {
        const long L = (long)i * G + c; if (L >= nwg) return false;
        int wgid = (int)L; { const int q = nwg / NXCD, r = nwg % NXCD, xcd = wgid % NXCD, off = wgid / NXCD; wgid = (xcd < r ? xcd * (q + 1) : r * (q + 1) + (xcd - r) * q) + off; }
        const int nig = WGM * nN, gid = wgid / nig, fm = gid * WGM, gsz = (nM - fm) < WGM ? (nM - fm) : WGM;
        u.pm = fm + ((wgid % nig) % gsz); u.pn = (wgid % nig) / gsz; u.ord = i; return true;
    }
    __device__ __forceinline__ void a_ready(const Unit&) const {}
    __device__ __forceinline__ void done(const Unit&) const {}
};

__device__ __forceinline__ unsigned cvt_pk_bf16(float lo, float hi) { unsigned r; asm volatile("v_cvt_pk_bf16_f32 %0, %1, %2" : "=v"(r) : "v"(lo), "v"(hi)); return r; }
__device__ __forceinline__ float bflo(unsigned w) { return __uint_as_float(w << 16); }
__device__ __forceinline__ float bfhi(unsigned w) { return __uint_as_float(w & 0xffff0000u); }
__device__ __forceinline__ float fast_sigmoid(float x) { return __builtin_amdgcn_rcpf(1.0f + __expf(-x)); }

struct EpiSwiglu {
    static constexpr bool PERM = true, AFTER_DRAIN = false;
    bf16_t* H; int ldh; const PG8_LAS float* rs;
    __device__ __forceinline__ void operator()(const f32x4 (&acc)[2][2][4][2], const Unit& u, int wr, int wc, int fr, int fq) const {
        const int row0 = u.pm * BM + wr * 64 + fr, col0 = u.pn * HALF + wc * 32 + 8 * fq;
#pragma unroll
        for (int ai = 0; ai < 2; ++ai)
#pragma unroll
            for (int m = 0; m < 4; ++m) {
                bf16_t* rowp = H + (size_t)(row0 + ai * HALF + m * 16) * ldh + col0;
                const float r = rs[u.ord * 256 + wr * 64 + fr + ai * HALF + m * 16];
                float o[8];
#pragma unroll
                for (int n = 0; n < 2; ++n)
#pragma unroll
                    for (int e = 0; e < 4; ++e) { const float g = acc[ai][0][m][n][e] * r, up = acc[ai][1][m][n][e] * r; o[n * 4 + e] = g * fast_sigmoid(g) * up; }
                u32x4 w; w.x = cvt_pk_bf16(o[0], o[1]); w.y = cvt_pk_bf16(o[2], o[3]); w.z = cvt_pk_bf16(o[4], o[5]); w.w = cvt_pk_bf16(o[6], o[7]);
                *(u32x4*)rowp = w;
            }
    }
};
struct EpiResid {
    static constexpr bool PERM = true, AFTER_DRAIN = false;
    const float* base; float* out; float s; bf16_t* xb; float* ssq;
    __device__ __forceinline__ void operator()(const f32x4 (&acc)[2][2][4][2], const Unit& u, int wr, int wc, int fr, int fq) const {
        const int row0 = u.pm * BM + wr * 64 + fr, col0 = u.pn * BM + wc * 32 + 8 * fq;
#pragma unroll
        for (int ai = 0; ai < 2; ++ai)
#pragma unroll
            for (int m = 0; m < 4; ++m) {
                const size_t off = (size_t)(row0 + ai * HALF + m * 16) * 1024 + col0;
                float q = 0.f;
#pragma unroll
                for (int bj = 0; bj < 2; ++bj) {
                    const f32x4 b0 = *(const f32x4*)(base + off + bj * HALF), b1 = *(const f32x4*)(base + off + bj * HALF + 4);
                    const f32x4 x0 = b0 + acc[ai][bj][m][0] * s, x1 = b1 + acc[ai][bj][m][1] * s;
                    *(f32x4*)(out + off + bj * HALF) = x0; *(f32x4*)(out + off + bj * HALF + 4) = x1;
                    q += (x0[0] * x0[0] + x0[1] * x0[1]) + (x0[2] * x0[2] + x0[3] * x0[3]) + (x1[0] * x1[0] + x1[1] * x1[1]) + (x1[2] * x1[2] + x1[3] * x1[3]);
                    u32x4 w; w.x = cvt_pk_bf16(x0[0], x0[1]); w.y = cvt_pk_bf16(x0[2], x0[3]); w.z = cvt_pk_bf16(x1[0], x1[1]); w.w = cvt_pk_bf16(x1[2], x1[3]);
                    *(u32x4*)(xb + off + bj * HALF) = w;
                }
                q += __shfl_xor(q, 16); q += __shfl_xor(q, 32);
                if (fq == 0) ssq[(size_t)(row0 + ai * HALF + m * 16) * 16 + u.pn * 4 + wc] = q;
            }
    }
};
template <int MODE> struct EpiProj {
    static constexpr bool PERM = true, AFTER_DRAIN = false;
    bf16_t* MG; const bf16_t* G; int gofs;
    __device__ __forceinline__ void operator()(const f32x4 (&acc)[2][2][4][2], const Unit& u, int wr, int wc, int fr, int fq) const {
        const int row0 = u.pm * BM + wr * 64 + fr, col0 = u.pn * BM + wc * 32 + 8 * fq;
#pragma unroll
        for (int ai = 0; ai < 2; ++ai)
#pragma unroll
            for (int m = 0; m < 4; ++m) {
                const size_t row = (size_t)(row0 + ai * HALF + m * 16);
#pragma unroll
                for (int bj = 0; bj < 2; ++bj) {
                    const u32x4 gv = *(const u32x4*)(G + row * 3072 + gofs + col0 + bj * HALF);
                    bf16_t* mp = MG + row * 1024 + col0 + bj * HALF;
                    const f32x4 a0 = acc[ai][bj][m][0], a1 = acc[ai][bj][m][1];
                    float o[8] = {bflo(gv.x) * a0[0], bfhi(gv.x) * a0[1], bflo(gv.y) * a0[2], bfhi(gv.y) * a0[3], bflo(gv.z) * a1[0], bfhi(gv.z) * a1[1], bflo(gv.w) * a1[2], bfhi(gv.w) * a1[3]};
                    if (MODE) { const u32x4 ov = *(const u32x4*)mp; o[0] += bflo(ov.x); o[1] += bfhi(ov.x); o[2] += bflo(ov.y); o[3] += bfhi(ov.y); o[4] += bflo(ov.z); o[5] += bfhi(ov.z); o[6] += bflo(ov.w); o[7] += bfhi(ov.w); }
                    u32x4 w; w.x = cvt_pk_bf16(o[0], o[1]); w.y = cvt_pk_bf16(o[2], o[3]); w.z = cvt_pk_bf16(o[4], o[5]); w.w = cvt_pk_bf16(o[6], o[7]);
                    *(u32x4*)mp = w;
                }
            }
    }
};
struct EpiWin {
    static constexpr bool PERM = true, AFTER_DRAIN = false;
    bf16_t *QA, *QC, *IQ, *MISC, *KVC, *KVS, *KVW, *BU, *G; const float* rope; const PG8_LAS float* rs;
    __device__ __forceinline__ void operator()(const f32x4 (&acc)[2][2][4][2], const Unit& u, int wr, int wc, int fr, int fq) const {
        const int pn = u.pn;
        bf16_t* dst; int ld, cbase, mode;
        if (pn < 2) { dst = QA; ld = 512; cbase = pn * 256; mode = 1; }
        else if (pn < 4) { dst = QC; ld = 512; cbase = (pn - 2) * 256; mode = 1; }
        else if (pn == 4) { dst = IQ; ld = 256; cbase = 0; mode = 1; }
        else if (pn == 5) { dst = MISC; ld = 256; cbase = 0; mode = 3; }
        else if (pn <= 8) { dst = pn == 6 ? KVC : (pn == 7 ? KVS : KVW); ld = 256; cbase = 0; mode = 2; }
        else if (pn <= 10) { dst = BU; ld = 512; cbase = (pn - 9) * 256; mode = 0; }
        else { dst = G; ld = 3072; cbase = (pn - 11) * 256; mode = 4; }
        const int row0 = u.pm * BM + wr * 64 + fr, col0 = cbase + wc * 32 + 8 * fq;
        const bool ropelane = ((wc & 1) == 0) && fq < 2;
        const float sc = (mode == 1) ? (pn < 4 ? 0.125f * 1.4426950408889634f : 0.125f) : 1.0f;
#pragma unroll
        for (int ai = 0; ai < 2; ++ai)
#pragma unroll
            for (int m = 0; m < 4; ++m) {
                const size_t row = (size_t)(row0 + ai * HALF + m * 16);
                const float rr = rs[u.ord * 256 + wr * 64 + fr + ai * HALF + m * 16];
                f32x4 cs = {1.f, 1.f, 1.f, 1.f}, sn = {0.f, 0.f, 0.f, 0.f};
                if (ropelane && mode >= 1 && mode <= 3) { cs = *(const f32x4*)(rope + row * 16 + 4 * fq); sn = *(const f32x4*)(rope + row * 16 + 8 + 4 * fq); }
#pragma unroll
                for (int bj = 0; bj < 2; ++bj) {
                    const f32x4 a0 = acc[ai][bj][m][0] * rr, a1 = acc[ai][bj][m][1] * rr;
                    float o[8] = {a0[0], a0[1], a0[2], a0[3], a1[0], a1[1], a1[2], a1[3]};
                    const bool dorope = ropelane && (mode == 1 || (mode == 2 && bj == 0) || (mode == 3 && bj == 0 && wc == 0));
                    if (dorope) {
#pragma unroll
                        for (int p = 0; p < 4; ++p) { const float x1 = o[2 * p], x2 = o[2 * p + 1]; o[2 * p] = x1 * cs[p] - x2 * sn[p]; o[2 * p + 1] = x2 * cs[p] + x1 * sn[p]; }
                    }
                    if (mode == 4) {
#pragma unroll
                        for (int e = 0; e < 8; ++e) o[e] = fast_sigmoid(o[e]);
                    } else {
#pragma unroll
                        for (int e = 0; e < 8; ++e) o[e] *= sc;
                    }
                    u32x4 w; w.x = cvt_pk_bf16(o[0], o[1]); w.y = cvt_pk_bf16(o[2], o[3]); w.z = cvt_pk_bf16(o[4], o[5]); w.w = cvt_pk_bf16(o[6], o[7]);
                    *(u32x4*)(dst + row * ld + col0 + bj * HALF) = w;
                }
            }
    }
};

template <class Epi, class Sched, bool ALIGN_EPI = false, bool SP2 = false>
__device__ __forceinline__ void gemm_phase(PG8_LAS unsigned char* lds, const Gemm g, const Sched& S, const Epi& E, int tid_in) {
    int tid_ = tid_in; asm volatile("" : "+v"(tid_));
    const int tid = tid_, wid = __builtin_amdgcn_readfirstlane(tid >> 6), lane = tid & 63, wr = wid >> 2, wc = wid & 3, fr = lane & 15, fq = lane >> 4;
    const int K = g.K, nt = K / BK;
    unsigned voffA[2], voffB[2];
#pragma unroll
    for (int i = 0; i < 2; ++i) { int R, C; stage_rc(tid * 16 + i * 8192, R, C); const int Rb = Epi::PERM ? ((R & ~31) + perm32(R & 31)) : R;
        voffA[i] = (unsigned)(R * K + C) * 2u; voffB[i] = (unsigned)(Rb * K + C) * 2u; }
    const size_t kstep = (size_t)(BK * 2);
    const size_t hstep = (size_t)HALF * K * 2;
    const size_t tstep = 2 * hstep;
    const unsigned ldsw = (unsigned)wid * 1024u;
    const int aoff = lds_byte(wr * 64 + fr, fq * 8), boff = lds_byte(wc * 32 + fr, fq * 8);
#define PG8_SA(b, h) (((b) * 2 + (h)) * HTB)
#define PG8_SB(b, h) ((4 + (b) * 2 + (h)) * HTB)
#define PG8_STAGE(bufoff, gbase, voff) do { _Pragma("unroll") for (int _i = 0; _i < 2; ++_i) \
        __builtin_amdgcn_global_load_lds((const unsigned*)((const char*)(gbase) + (voff)[_i]), (PG8_LAS unsigned*)(lds + (bufoff) + ldsw + _i * 8192), 16, 0, 0); } while (0)
#define PG8_LDA(dst, b, h) do { _Pragma("unroll") for (int m = 0; m < 4; ++m) _Pragma("unroll") for (int k = 0; k < 2; ++k) dst[m][k] = *(const PG8_LAS bf16x8*)(lds + PG8_SA(b, h) + aoff + m * 2048 + k * 1024); } while (0)
#define PG8_LDB(dst, b, h) do { _Pragma("unroll") for (int n = 0; n < 2; ++n) _Pragma("unroll") for (int k = 0; k < 2; ++k) dst[n][k] = *(const PG8_LAS bf16x8*)(lds + PG8_SB(b, h) + boff + n * 2048 + k * 1024); } while (0)
#define PG8_MMA(ai, bj, At, Bt) do { __builtin_amdgcn_s_setprio(1); _Pragma("unroll") for (int m = 0; m < 4; ++m) _Pragma("unroll") for (int n = 0; n < 2; ++n) _Pragma("unroll") for (int k = 0; k < 2; ++k) \
        acc[ai][bj][m][n] = __builtin_amdgcn_mfma_f32_16x16x32_bf16(Bt[n][k], At[m][k], acc[ai][bj][m][n], 0, 0, 0); __builtin_amdgcn_s_setprio(0); } while (0)
#define PG8_WAIT_V(n) asm volatile("s_waitcnt vmcnt(" #n ")" ::: "memory")
#define PG8_WAIT_L(n) asm volatile("s_waitcnt lgkmcnt(" #n ")" ::: "memory")
#define PG8_BAR __builtin_amdgcn_s_barrier()
#define PG8_SCHED __builtin_amdgcn_sched_barrier(0)
    Unit cur, nxt; int ui = 0;
    if (!S.next(0, cur)) return;
    f32x4 acc[2][2][4][2];
#pragma unroll
    for (int a = 0; a < 2; ++a)
#pragma unroll
        for (int b = 0; b < 2; ++b)
#pragma unroll
            for (int m = 0; m < 4; ++m)
#pragma unroll
                for (int n = 0; n < 2; ++n) acc[a][b][m][n] = (f32x4){0.f, 0.f, 0.f, 0.f};
    bf16x8 At[4][2], B0[2][2], B1[2][2];
    const char* cA = (const char*)g.A + (size_t)cur.pm * tstep; const char* cB = (const char*)g.Bt + (size_t)cur.pn * tstep;
    S.a_ready(cur);
    if constexpr (SP2) {
        PG8_STAGE(PG8_SB(0, 0), cB, voffB); PG8_STAGE(PG8_SB(0, 1), cB + hstep, voffB); PG8_STAGE(PG8_SA(0, 0), cA, voffA); PG8_STAGE(PG8_SA(0, 1), cA + hstep, voffA);
        if (wr == 1) PG8_BAR;
        PG8_WAIT_V(2); PG8_BAR;
        PG8_STAGE(PG8_SB(1, 0), cB + kstep, voffB); PG8_STAGE(PG8_SA(1, 0), cA + kstep, voffA); PG8_STAGE(PG8_SB(1, 1), cB + hstep + kstep, voffB);
        PG8_WAIT_V(6); PG8_BAR;
    } else {
        PG8_STAGE(PG8_SB(0, 0), cB, voffB); PG8_STAGE(PG8_SA(0, 0), cA, voffA); PG8_STAGE(PG8_SB(0, 1), cB + hstep, voffB); PG8_STAGE(PG8_SA(0, 1), cA + hstep, voffA);
        if (wr == 1) PG8_BAR;
        PG8_WAIT_V(4); PG8_BAR;
        PG8_STAGE(PG8_SB(1, 0), cB + kstep, voffB); PG8_STAGE(PG8_SA(1, 0), cA + kstep, voffA); PG8_STAGE(PG8_SB(1, 1), cB + hstep + kstep, voffB);
        PG8_WAIT_V(6); PG8_BAR;
    }
    for (;;) {
        const bool has_next = S.next(ui + 1, nxt);
        const char* nA = has_next ? (const char*)g.A + (size_t)nxt.pm * tstep : cA; const char* nB = has_next ? (const char*)g.Bt + (size_t)nxt.pn * tstep : cB;
        for (int t = 0; t < nt; t += 2) {
            const bool last = (t == nt - 2);
            const char* a1 = cA + (size_t)(t + 1) * kstep;
            const char* a2 = last ? nA : cA + (size_t)(t + 2) * kstep; const char* b2 = last ? nB : cB + (size_t)(t + 2) * kstep;
            const char* a3 = a2 + kstep; const char* b3 = b2 + kstep;
            if (last && has_next) S.a_ready(nxt);
            if constexpr (SP2) {
            PG8_LDB(B0, 0, 0); PG8_LDB(B1, 0, 1); PG8_SCHED; PG8_LDA(At, 0, 0); PG8_STAGE(PG8_SA(1, 1), a1 + hstep, voffA);
            PG8_WAIT_V(8); PG8_WAIT_L(0); PG8_BAR; PG8_MMA(0, 0, At, B0); PG8_MMA(0, 1, At, B1); PG8_BAR; PG8_SCHED;
            PG8_LDA(At, 0, 1); PG8_STAGE(PG8_SB(0, 0), b2, voffB); PG8_STAGE(PG8_SB(0, 1), b2 + hstep, voffB); PG8_STAGE(PG8_SA(0, 0), a2, voffA);
            PG8_WAIT_V(8); PG8_WAIT_L(0); PG8_BAR; PG8_MMA(1, 0, At, B0); PG8_MMA(1, 1, At, B1); PG8_BAR; PG8_SCHED;
            PG8_LDB(B0, 1, 0); PG8_LDB(B1, 1, 1); PG8_SCHED; PG8_LDA(At, 1, 0); PG8_STAGE(PG8_SA(0, 1), a2 + hstep, voffA);
            PG8_WAIT_V(8); PG8_WAIT_L(0); PG8_BAR; PG8_MMA(0, 0, At, B0); PG8_MMA(0, 1, At, B1); PG8_BAR; PG8_SCHED;
            PG8_LDA(At, 1, 1); PG8_STAGE(PG8_SB(1, 0), b3, voffB); PG8_STAGE(PG8_SB(1, 1), b3 + hstep, voffB); PG8_STAGE(PG8_SA(1, 0), a3, voffA);
            PG8_WAIT_V(8); PG8_WAIT_L(0); PG8_BAR; PG8_MMA(1, 0, At, B0); PG8_MMA(1, 1, At, B1); PG8_BAR; PG8_SCHED;
            } else {
            PG8_LDB(B0, 0, 0); PG8_SCHED; PG8_LDA(At, 0, 0); PG8_STAGE(PG8_SA(1, 1), a1 + hstep, voffA);
            PG8_WAIT_L(8); PG8_BAR; PG8_WAIT_L(0); PG8_MMA(0, 0, At, B0); PG8_BAR; PG8_SCHED;
            PG8_LDB(B1, 0, 1); PG8_STAGE(PG8_SB(0, 0), b2, voffB);
            PG8_BAR; PG8_WAIT_L(0); PG8_MMA(0, 1, At, B1); PG8_BAR;
            PG8_LDA(At, 0, 1); PG8_STAGE(PG8_SA(0, 0), a2, voffA);
            PG8_BAR; PG8_WAIT_L(0); PG8_MMA(1, 0, At, B0); PG8_BAR; PG8_SCHED;
            PG8_STAGE(PG8_SB(0, 1), b2 + hstep, voffB);
            PG8_WAIT_V(6); PG8_BAR; PG8_MMA(1, 1, At, B1); PG8_BAR;
            PG8_LDB(B0, 1, 0); PG8_SCHED; PG8_LDA(At, 1, 0); PG8_STAGE(PG8_SA(0, 1), a2 + hstep, voffA);
            PG8_WAIT_L(8); PG8_BAR; PG8_WAIT_L(0); PG8_MMA(0, 0, At, B0); PG8_BAR; PG8_SCHED;
            PG8_LDB(B1, 1, 1); PG8_STAGE(PG8_SB(1, 0), b3, voffB);
            PG8_BAR; PG8_WAIT_L(0); PG8_MMA(0, 1, At, B1); PG8_BAR;
            PG8_LDA(At, 1, 1); PG8_STAGE(PG8_SA(1, 0), a3, voffA);
            PG8_BAR; PG8_WAIT_L(0); PG8_MMA(1, 0, At, B0); PG8_BAR; PG8_SCHED;
            PG8_STAGE(PG8_SB(1, 1), b3 + hstep, voffB);
            PG8_WAIT_V(6); PG8_BAR; PG8_MMA(1, 1, At, B1); PG8_BAR;
            }
        }
        if constexpr (ALIGN_EPI) { if (wr == 0) PG8_BAR; }
        if constexpr (!Epi::AFTER_DRAIN) { E(acc, cur, wr, wc, fr, fq); S.done(cur); }
        if (!has_next) break;
#pragma unroll
        for (int a = 0; a < 2; ++a)
#pragma unroll
            for (int b = 0; b < 2; ++b)
#pragma unroll
                for (int m = 0; m < 4; ++m)
#pragma unroll
                    for (int n = 0; n < 2; ++n) acc[a][b][m][n] = (f32x4){0.f, 0.f, 0.f, 0.f};
        cur = nxt; cA = nA; cB = nB; ++ui;
        if constexpr (ALIGN_EPI) { if (wr == 1) PG8_BAR; }
    }
    PG8_WAIT_V(0);
    if constexpr (!ALIGN_EPI) { if (wr == 0) PG8_BAR; }
    PG8_BAR;
    if constexpr (Epi::AFTER_DRAIN) { E.fused(acc, cur, wr, wc, fr, fq, lds, wid, lane); S.done(cur); }
#undef PG8_SA
#undef PG8_SB
#undef PG8_STAGE
#undef PG8_LDA
#undef PG8_LDB
#undef PG8_MMA
#undef PG8_WAIT_V
#undef PG8_WAIT_L
#undef PG8_BAR
#undef PG8_SCHED
}
}
#define GAS __attribute__((address_space(1)))
#define LAS __attribute__((address_space(3)))
typedef unsigned short bf16;
typedef unsigned v4u __attribute__((ext_vector_type(4)));
typedef float f32x4 __attribute__((ext_vector_type(4)));
typedef short bf16x8 __attribute__((ext_vector_type(8)));
typedef GAS unsigned gu32;
typedef GAS unsigned long long gu64;
#define RLX_AGENT __ATOMIC_RELAXED, __HIP_MEMORY_SCOPE_AGENT
#define LDS_WAIT() asm volatile("s_waitcnt lgkmcnt(0)" ::: "memory")
#define VM_WAIT() asm volatile("s_waitcnt vmcnt(0)" ::: "memory")
__device__ __forceinline__ unsigned long long rt() { return __builtin_amdgcn_s_memrealtime(); }
__device__ __forceinline__ unsigned f2bf(float f) { unsigned u = __builtin_bit_cast(unsigned, f); return (u + 0x7fffu + ((u >> 16) & 1u)) >> 16; }
__device__ __forceinline__ unsigned pk2(float lo, float hi) { return f2bf(lo) | (f2bf(hi) << 16); }
#define XB_TMO      128
#define XB_XCNT(j)  (256  + 64 * (j))
#define XB_XSUB(j)  (1280 + 64 * (j))
#define XB_XGEN(j)  (2304 + 64 * (j))
#define XB_TOP      3328
#define XB_TOPGEN   3392
#define XCD_BAR_WORDS 3456
#define XB_SPIN_CAP (1u << 18)

__device__ __forceinline__ unsigned xb_ld(unsigned* p)              { return __hip_atomic_load(p, __ATOMIC_RELAXED, __HIP_MEMORY_SCOPE_AGENT); }
__device__ __forceinline__ unsigned xb_add(unsigned* p, unsigned v) { return __hip_atomic_fetch_add(p, v, __ATOMIC_RELAXED, __HIP_MEMORY_SCOPE_AGENT); }
__device__ __forceinline__ unsigned xb_xcc_id() { return (unsigned)__builtin_amdgcn_s_getreg((3 << 11) | 20) & 0xFu; }
#define XB_SPIN(cond, bar) do { unsigned _sp = 0; while (cond) { __builtin_amdgcn_s_sleep(1); \
    if ((++_sp & 255u) == 0u) { if (xb_ld(&(bar)[XB_TMO])) break; if (_sp > XB_SPIN_CAP) { atomicAdd(&(bar)[XB_TMO], 1u); break; } } } } while (0)

struct XcdBarrier {
    unsigned* bar; unsigned x;
    volatile LAS unsigned* st;
};

__device__ __forceinline__ XcdBarrier xcd_barrier_post(unsigned* bar, volatile LAS unsigned* st) {
    XcdBarrier b; b.bar = bar; b.x = xb_xcc_id(); b.st = st;
    if (threadIdx.x == 0) (void)xb_add(&bar[XB_XCNT(b.x)], 1u);
    return b;
}
__device__ __forceinline__ void xcd_barrier_complete(unsigned* bar, unsigned x, unsigned& nloc, unsigned& nx) {
    const unsigned G = gridDim.x * gridDim.y * gridDim.z;
    unsigned sum, cnt, mine, sp = 0u;
    for (;;) {
        sum = 0u; cnt = 0u; mine = 0u;
#pragma unroll
        for (unsigned j = 0; j < 16; ++j) { const unsigned c = xb_ld(&bar[XB_XCNT(j)]); sum += c; cnt += (c > 0u) ? 1u : 0u; mine = (j == x) ? c : mine; }
        if (sum == G) break;
        __builtin_amdgcn_s_sleep(1);
        if ((++sp & 255u) == 0u) { if (xb_ld(&bar[XB_TMO])) break; if (sp > XB_SPIN_CAP) { atomicAdd(&bar[XB_TMO], 1u); break; } }
    }
    nloc = mine > 0u ? mine : 1u; nx = cnt > 0u ? cnt : 1u;
}

__device__ __forceinline__ void xcd_barrier(const XcdBarrier& b) {
    asm volatile("s_waitcnt vmcnt(0)" ::: "memory");
    __syncthreads();
    if (threadIdx.x == 0) {
        unsigned* bar = b.bar;
        __builtin_amdgcn_s_waitcnt(0);
        unsigned nloc = b.st[0], nx = b.st[1];
        if (nloc == 0u) { xcd_barrier_complete(bar, b.x, nloc, nx); b.st[0] = nloc; b.st[1] = nx; }
        const unsigned old = xb_add(&bar[XB_XSUB(b.x)], 1u);
        const unsigned gen = old / nloc;
        if (old + 1u == (gen + 1u) * nloc) {
            __builtin_amdgcn_fence(__ATOMIC_RELEASE, "agent");
            asm volatile("s_waitcnt vmcnt(0)" ::: "memory");
            const unsigned og = xb_add(&bar[XB_TOP], 1u);
            const unsigned tg = og / nx;
            if (og + 1u == (tg + 1u) * nx) xb_add(&bar[XB_TOPGEN], 1u);
            else XB_SPIN(xb_ld(&bar[XB_TOPGEN]) == tg, bar);
            __builtin_amdgcn_fence(__ATOMIC_ACQUIRE, "agent");
            xb_add(&bar[XB_XGEN(b.x)], 1u);
            asm volatile("s_waitcnt vmcnt(0)" ::: "memory");
        } else {
            XB_SPIN(xb_ld(&bar[XB_XGEN(b.x)]) == gen, bar);
            __builtin_amdgcn_fence(__ATOMIC_ACQUIRE, "agent");
            asm volatile("s_waitcnt vmcnt(0)" ::: "memory");
        }
    }
    __syncthreads();
}
constexpr int NB = 8, SEQ = 4096, DM = 1024, DEPTH = 4, M = NB * SEQ;
constexpr int FF = 2816, NIN = 5852, NINP = 5888;
constexpr float EPS = 1e-6f, NEGF = -1e30f;
constexpr int NWAVES = 8;
constexpr size_t MiB = 1u << 20;
constexpr size_t WS_CTL = 0, CTL_ZERO_BYTES = 1 * MiB;
constexpr size_t WS_ROPE = 1 * MiB;
constexpr size_t WS_KVA = 3 * MiB;
constexpr size_t WS_KC = 11 * MiB, WS_VC = WS_KC + 512 * 1024;
constexpr size_t WS_W = 12 * MiB;
constexpr size_t WO_GU1 = 0, WO_D1 = 11 * MiB, WO_GU2 = WO_D1 + 5 * MiB + 512 * 1024, WO_D2 = WO_GU2 + 11 * MiB, WO_IN = WO_D2 + 5 * MiB + 512 * 1024,
                 WO_PA = WO_IN + 11 * MiB + 512 * 1024, WO_PB = WO_PA + MiB, WO_PC = WO_PB + MiB, WO_OUT = WO_PC + MiB,
                 WO_CW1 = WO_OUT + 2 * MiB  , WO_CW2 = WO_CW1 + MiB  , WO_UKV = WO_CW2 + 32768  , WO_POOL = WO_UKV + 32768  ,
                 WO_POSB = WO_POOL + 131072  , WO_END = WO_POSB + 1024;
static_assert(WO_END <= 52 * MiB, "weights region");
constexpr size_t WS_XN = 64 * MiB;
constexpr size_t WS_R = 128 * MiB;
constexpr size_t WS_G = WS_R, WS_QA = WS_R + 192 * MiB, WS_QC = WS_QA + 32 * MiB, WS_IQ = WS_QC + 32 * MiB, WS_MISC = WS_IQ + 16 * MiB,
                 WS_KVC = WS_MISC + 16 * MiB, WS_KVS = WS_KVC + 16 * MiB, WS_KVW = WS_KVS + 16 * MiB, WS_BU = WS_KVW + 16 * MiB, WS_END = WS_BU + 32 * MiB;
#ifndef YB_SPARE
#define YB_SPARE 0
#endif
constexpr size_t WS_YB = YB_SPARE ? 496 * MiB : WS_XN;
constexpr size_t WS_MG = WS_IQ;
constexpr size_t WS_H = WS_R;
static_assert(WS_END == 496 * MiB, "ws map");
constexpr int RING_BYTES = 131072, LDS_BYTES = 163840, LDSCTL_OFF = 163840 - 256;
constexpr size_t WS_SSQ = 496 * MiB;
constexpr int RS_OFF = 131072;
constexpr int NPL = 10, NPH = 1 + DEPTH * NPL + 1;


#ifndef TPROBE
#define TPROBE 0
#endif
#if TPROBE
#define TP_DECL unsigned long long tp_t_ = __builtin_amdgcn_s_memtime();
#define TP_MARK(k) do { const unsigned long long n_ = __builtin_amdgcn_s_memtime(); if (tid == 0) atomicAdd((unsigned long long*)(ws + 32768) + (k), n_ - tp_t_); tp_t_ = n_; } while (0)
#define TP_ADD(k, v) do { if (tid == 0) atomicAdd((unsigned long long*)(ws + 32768) + (k), (unsigned long long)(v)); } while (0)
#else
#define TP_DECL
#define TP_MARK(k)
#define TP_ADD(k, v)
#endif
__device__ __forceinline__ int lane_id_v() { int l; asm volatile("v_mbcnt_lo_u32_b32 %0, -1, 0\n\tv_mbcnt_hi_u32_b32 %0, -1, %0" : "=v"(l)); return l; }
__device__ __forceinline__ float bflo(unsigned w) { return __uint_as_float(w << 16); }
__device__ __forceinline__ float bfhi(unsigned w) { return __uint_as_float(w & 0xffff0000u); }
__device__ __forceinline__ float bf2f(bf16 v) { return __uint_as_float((unsigned)v << 16); }
__device__ __forceinline__ float wave_sum(float v) {
#pragma unroll
    for (int o = 1; o < 64; o <<= 1) v += __shfl_xor(v, o);
    return v;
}
__device__ __forceinline__ float wave_max(float v) {
#pragma unroll
    for (int o = 1; o < 64; o <<= 1) v = fmaxf(v, __shfl_xor(v, o));
    return v;
}
__device__ __forceinline__ int wave_sum_i(int v) {
#pragma unroll
    for (int o = 1; o < 64; o <<= 1) v += __shfl_xor(v, o);
    return v;
}
__device__ __forceinline__ unsigned wave_max_u(unsigned v) {
#pragma unroll
    for (int o = 1; o < 64; o <<= 1) { const unsigned w = (unsigned)__shfl_xor((int)v, o); v = w > v ? w : v; }
    return v;
}
#define WAVE_LDS_SYNC() do { asm volatile("s_waitcnt lgkmcnt(0)" ::: "memory"); __builtin_amdgcn_wave_barrier(); } while (0)
__host__ __device__ __forceinline__ int permd(int d) { return d < 8 ? 2 * d : (d < 16 ? 2 * (d - 8) + 1 : d); }
__device__ __forceinline__ int win_newcol(int n) {
    if (n < 512) return (n & ~63) + permd(n & 63);
    if (n < 640) return 1280 + 64 + (n - 512);
    if (n < 896) { const int m = n - 640; return 1024 + (m & ~63) + permd(m & 63); }
    if (n < 960) return 1280 + permd(n - 896);
    if (n < 964) return 1280 + 192 + (n - 960);
    if (n < 1476) return 2304 + (n - 964);
    if (n < 1988) { const int m = n - 1476; return 512 + (m & ~63) + permd(m & 63); }
    if (n < 2756) { const int m = n - 1988, kv = m >> 8, r = m & 255, base = 1536 + kv * 256; return r < 128 ? base + (r & ~63) + permd(r & 63) : base + r; }
    if (n < 2780) return 1280 + 196 + (n - 2756);
    return 2816 + (n - 2780);
}
__device__ __forceinline__ int map_row(int mode, int n) { return mode == 0 ? n : (mode == 1 ? ((n >> 7) << 8) + (n & 127) : (mode == 2 ? ((n >> 7) << 8) + 128 + (n & 127) : win_newcol(n))); }

struct Args { const float* in[24]; float* out; unsigned char* ws; int ph_lo, ph_hi; };

__device__ __forceinline__ int unperm(int p) { return p < 16 ? ((p & 1) ? (p >> 1) + 8 : (p >> 1)) : p; }
__device__ __forceinline__ void tr_item(const float* W, int K, int N, bf16* WT, int mode, LAS float* scr, int item, int lane, bool kperm = false, const float* kscale = nullptr) {
    const int nblk = (N + 31) >> 5, kb = item / nblk, nb = item - kb * nblk, k0 = 64 * kb, n0 = 32 * nb;
    const int nn = n0 + (lane & 31);
#pragma unroll
    for (int i = 0; i < 32; ++i) { const int kk = 2 * i + (lane >> 5); const float sc_ = kscale ? kscale[k0 + kk] : 1.0f; scr[kk * 33 + (lane & 31)] = nn < N ? W[(size_t)(k0 + kk) * N + nn] * sc_ : 0.f; }
    LDS_WAIT(); asm volatile("" ::: "memory");
    const int c = lane & 7;
#pragma unroll
    for (int j = 0; j < 4; ++j) { const int n = (lane >> 3) + 8 * j; const LAS float* s = scr + n;
        int ks[8];
#pragma unroll
        for (int i = 0; i < 8; ++i) ks[i] = (kperm ? unperm(8 * c + i) : 8 * c + i) * 33;
        v4u o; o.x = pk2(s[ks[0]], s[ks[1]]); o.y = pk2(s[ks[2]], s[ks[3]]); o.z = pk2(s[ks[4]], s[ks[5]]); o.w = pk2(s[ks[6]], s[ks[7]]);
        if (n0 + n < N) *(v4u*)(WT + (size_t)map_row(mode, n0 + n) * K + k0 + 8 * c) = o; }
    LDS_WAIT(); asm volatile("" ::: "memory");
}
__device__ __forceinline__ void phase_convert(const Args& P, unsigned char* ws, int z, int l, LAS unsigned char* lds, int gw, int NGW, int lane, int wave) {
    asm volatile("" : "+v"(lane)); lane &= 63; asm volatile("" : "+s"(gw), "+s"(NGW));
    LAS float* scr = (LAS float*)(lds + wave * 16384);
    unsigned char* wb = ws + WS_W;
    constexpr int I_F = 16 * 88, I_D = 44 * 32, I_IN = 16 * 183, I_P = 8 * 32, I_O = 16 * 32;
    constexpr int I_C = 32 * 4;
    constexpr int NIT = 4 * I_F + 2 * I_D + I_IN + 3 * I_P + I_O + 2 * I_C;
    const size_t fo = (size_t)l * DM * FF;
    for (int it = gw; it < NIT; it += NGW) {
        int r = it, K = DM, N = FF, mode = 1; const float* W = P.in[3 + z] + fo; size_t wo = WO_GU1; bool kperm = false; const float* ksc = P.in[2 + z] + l * DM;
        if (r >= I_F) { r -= I_F; mode = 2; W = P.in[4 + z] + fo;
        if (r >= I_F) { r -= I_F; mode = 0; W = P.in[5 + z] + fo; K = FF; N = DM; wo = WO_D1; ksc = nullptr;
        if (r >= I_D) { r -= I_D; mode = 1; W = P.in[20 + z] + fo; K = DM; N = FF; wo = WO_GU2; ksc = P.in[19 + z] + l * DM;
        if (r >= I_F) { r -= I_F; mode = 2; W = P.in[21 + z] + fo;
        if (r >= I_F) { r -= I_F; mode = 0; W = P.in[22 + z] + fo; K = FF; N = DM; wo = WO_D2; ksc = nullptr;
        if (r >= I_D) { r -= I_D; mode = 3; W = P.in[7 + z] + (size_t)l * DM * NIN; K = DM; N = NIN; wo = WO_IN; ksc = P.in[6 + z] + l * DM;
        if (r >= I_IN) { r -= I_IN; mode = 0; W = P.in[15 + z] + (size_t)l * 512 * DM; K = 512; N = DM; wo = WO_PA; ksc = nullptr;
        if (r >= I_P) { r -= I_P; W = P.in[16 + z] + (size_t)l * 512 * DM; wo = WO_PB;
        if (r >= I_P) { r -= I_P; W = P.in[17 + z] + (size_t)l * 512 * DM; wo = WO_PC;
        if (r >= I_P) { r -= I_P; W = P.in[18 + z] + (size_t)l * DM * DM; K = DM; wo = WO_OUT;
        if (r >= I_O) { r -= I_O; W = P.in[13 + z] + (size_t)(l * 2) * 2048 * 128; K = 2048; N = 128; wo = WO_CW1; kperm = true;
        if (r >= I_C) { r -= I_C; W += (size_t)2048 * 128; wo = WO_CW1 + 128 * 2048 * 2; kperm = false; } } } } } } } } } } } }
        tr_item(W, K, N, (bf16*)(wb + wo), mode, scr, r, lane, kperm, ksc);
    }
    {
        const int gt = gw * 64 + lane, GT = NGW * 64;
        bf16* ukv = (bf16*)(wb + WO_UKV); bf16* pool = (bf16*)(wb + WO_POOL); bf16* cw2 = (bf16*)(wb + WO_CW2); float* posb = (float*)(wb + WO_POSB);
        const float* w_ukv = P.in[9 + z] + (size_t)l * 128 * 128; const float* gn = P.in[8 + z] + l * 128;
        for (int i = gt; i < 128 * 128; i += GT) { const int np = i >> 7, k = i & 127, n = np < 64 ? unperm(np) : np; ukv[i] = (bf16)f2bf(gn[k] * w_ukv[k * 128 + n]); }
        const float* pw = P.in[10 + z] + (size_t)l * 4 * 128 * 128; const float* psc = P.in[11 + z] + l * 512;
        for (int i = gt; i < 4 * 128 * 128; i += GT) { const int g = i >> 14, d = (i >> 7) & 127, c = i & 127; pool[i] = (bf16)f2bf(pw[(g * 128 + c) * 128 + d] * psc[g * 128 + d]); }
        const float* w2 = P.in[14 + z] + (size_t)l * 2 * 128 * 64;
        for (int i = gt; i < 2 * 64 * 128; i += GT) { const int br = i >> 13, dp = (i >> 7) & 63, n = i & 127, d = br ? dp : unperm(dp); cw2[i] = (bf16)f2bf(w2[(br * 128 + n) * 64 + d]); }
        const float* w1 = P.in[13 + z] + (size_t)l * 2 * 2048 * 128; const float* pos = P.in[12 + z] + (size_t)l * 2 * 2048;
        for (int i = gw; i < 256; i += NGW) { const int br = i >> 7, n = i & 127; float a = 0.f;
#pragma unroll 8
            for (int k = lane; k < 2048; k += 64) a += pos[br * 2048 + k] * w1[((size_t)br * 2048 + k) * 128 + n];
            a = wave_sum(a); if (lane == 0) posb[i] = a; }
    }
    if (gw < 36) { unsigned zz = 0u; asm volatile("" : "+v"(zz)); v4u z = {zz, zz, zz, zz}; v4u* rp = (v4u*)((bf16*)(wb + WO_IN) + (size_t)(1500 + gw) * DM); for (int i = lane; i < DM / 8; i += 64) rp[i] = z; }
}
__device__ __forceinline__ void phase_rope(const Args& P, unsigned char* ws, int z, int gtid, int gthreads) {
    float* rope = (float*)(ws + WS_ROPE);
    for (int idx = gtid; idx < M * 8; idx += gthreads) {
        const int row = idx >> 3, i = idx & 7;
        const double inv = i == 0 ? 1.0 : i == 1 ? 0.19392274474868576 : i == 2 ? 0.03760603093086393 : i == 3 ? 0.007292664737217109 : i == 4 ? 0.001414213562373095 : i == 5 ? 0.0002742481756762073 : i == 6 ? 5.318295896944988e-05 : 1.031338537721246e-05;
        const double ang = (double)((const int*)P.in[1 + z])[row] * inv;
        double s, c; sincos(ang, &s, &c);
        rope[row * 16 + i] = (float)c; rope[row * 16 + 8 + i] = (float)s;
    }
}
__device__ __forceinline__ void norm_row_bf16(const float* xrow, const float* gain, bf16* orow, int lane) {
    const f32x4* xr = (const f32x4*)xrow + lane; const f32x4* gr = (const f32x4*)gain + lane;
    f32x4 v[4]; float s = 0.f;
#pragma unroll
    for (int j = 0; j < 4; ++j) { v[j] = xr[64 * j]; s += (v[j].x * v[j].x + v[j].y * v[j].y) + (v[j].z * v[j].z + v[j].w * v[j].w); }
    const float r = 1.0f / sqrtf(wave_sum(s) * (1.f / DM) + EPS);
    unsigned long long* o8 = (unsigned long long*)orow + lane;
#pragma unroll
    for (int j = 0; j < 4; ++j) { const f32x4 g = gr[64 * j]; o8[64 * j] = (unsigned long long)pk2(v[j].x * r * g.x, v[j].y * r * g.y) | ((unsigned long long)pk2(v[j].z * r * g.z, v[j].w * r * g.w) << 32); }
}
__device__ __forceinline__ void stat_row_bf16(const float* xrow, bf16* orow, float* ssq16, int lane) {
    const f32x4* xr = (const f32x4*)xrow + lane;
    f32x4 v[4]; float s = 0.f;
#pragma unroll
    for (int j = 0; j < 4; ++j) { v[j] = xr[64 * j]; s += (v[j].x * v[j].x + v[j].y * v[j].y) + (v[j].z * v[j].z + v[j].w * v[j].w); }
    s = wave_sum(s);
    unsigned long long* o8 = (unsigned long long*)orow + lane;
#pragma unroll
    for (int j = 0; j < 4; ++j) o8[64 * j] = (unsigned long long)pk2(v[j].x, v[j].y) | ((unsigned long long)pk2(v[j].z, v[j].w) << 32);
    if (lane < 16) ssq16[lane] = lane == 0 ? s : 0.f;
}
__device__ __forceinline__ void norm_row_f32(float* xrow, const float* gain, int lane, float tps = 1.0f) {
    f32x4* xr = (f32x4*)xrow + lane; const f32x4* gr = (const f32x4*)gain + lane;
    f32x4 v[4]; float s = 0.f;
#pragma unroll
    for (int j = 0; j < 4; ++j) { v[j] = xr[64 * j]; s += (v[j].x * v[j].x + v[j].y * v[j].y) + (v[j].z * v[j].z + v[j].w * v[j].w); }
    const float r = tps / sqrtf(wave_sum(s) * (1.f / DM) + EPS);
#pragma unroll
    for (int j = 0; j < 4; ++j) { const f32x4 g = gr[64 * j]; xr[64 * j] = v[j] * r * g; }
}
__device__ __forceinline__ unsigned f2o(float s) { const unsigned b = __float_as_uint(s); return (b & 0x80000000u) ? ~b : (b | 0x80000000u); }
__device__ __forceinline__ void unpack8(const v4u v, float* f) { f[0] = bflo(v.x); f[1] = bfhi(v.x); f[2] = bflo(v.y); f[3] = bfhi(v.y); f[4] = bflo(v.z); f[5] = bfhi(v.z); f[6] = bflo(v.w); f[7] = bfhi(v.w); }
__device__ __forceinline__ void load_row64(const bf16* p, float* f) {
    const v4u* q = (const v4u*)p;
#pragma unroll
    for (int i = 0; i < 8; ++i) unpack8(q[i], f + 8 * i);
}
__device__ __forceinline__ float dot64(const LAS float* q, const float* k) {
    float d = 0.f;
#pragma unroll
    for (int i = 0; i < 16; ++i) { const f32x4 qq = *(const LAS f32x4*)(q + 4 * i); d += qq.x * k[4 * i] + qq.y * k[4 * i + 1] + qq.z * k[4 * i + 2] + qq.w * k[4 * i + 3]; }
    return d;
}
__device__ __forceinline__ void dsa_query(const Args& P, unsigned char* ws, int z, int row, LAS unsigned char* wl, int lane) {
    const int b = row >> 12, t = row & (SEQ - 1), n = t + 1;
    LAS unsigned* su = (LAS unsigned*)wl; LAS float* pb = (LAS float*)wl; LAS unsigned short* list = (LAS unsigned short*)(wl + 16384); LAS float* qb = (LAS float*)(wl + 16896);
    const bf16* misc = (const bf16*)(ws + WS_MISC);
    const unsigned long long lt = (1ull << lane) - 1ull;
    int nsel;
    if (n <= 256) { for (int i = lane; i < n; i += 64) list[i] = (unsigned short)i; nsel = n; }
    else {
        { const uint2 v = *(const uint2*)((const bf16*)(ws + WS_IQ) + (size_t)row * 256 + lane * 4); qb[lane * 4] = bflo(v.x); qb[lane * 4 + 1] = bfhi(v.x); qb[lane * 4 + 2] = bflo(v.y); qb[lane * 4 + 3] = bfhi(v.y); }
        float iw[4]; { const uint2 v = *(const uint2*)(misc + (size_t)row * 256 + 192); iw[0] = 0.5f * bflo(v.x); iw[1] = 0.5f * bfhi(v.x); iw[2] = 0.5f * bflo(v.y); iw[3] = 0.5f * bfhi(v.y); }
        WAVE_LDS_SYNC();
        const int nch = (n + 63) >> 6;
        for (int i = 0; i < nch; ++i) {
            const int key = i * 64 + lane; const bool valid = key <= t;
            float kf[64]; load_row64(misc + (size_t)(b * SEQ + (valid ? key : t)) * 256, kf);
            float s = 0.f;
#pragma unroll
            for (int h = 0; h < 4; ++h) s += iw[h] * fmaxf(dot64(qb + h * 64, kf), 0.f);
            su[key] = valid ? f2o(s) : 0u;
        }
        WAVE_LDS_SYNC();
        unsigned prefix = 0u;
        for (int bit = 31; bit >= 0; --bit) {
            const unsigned cand = prefix | (1u << bit); int c = 0;
            for (int i = 0; i < nch; ++i) c += (su[i * 64 + lane] >= cand) ? 1 : 0;
            c = wave_sum_i(c);
            if (c >= 256) prefix = cand;
            if (c == 256) break;
        }
        int cgt = 0;
        for (int i = 0; i < nch; ++i) cgt += (su[i * 64 + lane] > prefix) ? 1 : 0;
        const int need_eq = 256 - wave_sum_i(cgt);
        int base = 0, eq_taken = 0;
        for (int i = 0; i < nch; ++i) {
            const unsigned v = su[i * 64 + lane]; const bool gt = v > prefix, eq = v == prefix;
            const unsigned long long meq = __ballot(eq);
            const bool sel = gt || (eq && (eq_taken + __popcll(meq & lt)) < need_eq);
            const unsigned long long ms = __ballot(sel);
            if (sel) list[base + __popcll(ms & lt)] = (unsigned short)(i * 64 + lane);
            base += __popcll(ms); eq_taken += __popcll(meq);
        }
        nsel = 256;
    }
    { const v4u v = *(const v4u*)((const bf16*)(ws + WS_QA) + (size_t)row * 512 + lane * 8); float f[8]; unpack8(v, f);
#pragma unroll
      for (int e = 0; e < 8; ++e) qb[lane * 8 + e] = f[e]; }
    WAVE_LDS_SYNC();
    const bf16* kva = (const bf16*)(ws + WS_KVA);
    float s[8][4];
#pragma unroll
    for (int j = 0; j < 4; ++j) {
        const int slot = lane + 64 * j; const bool valid = slot < nsel; const int key = list[valid ? slot : 0];
        float kf[64]; load_row64(kva + (size_t)(b * SEQ + key) * 128, kf);
#pragma unroll
        for (int h = 0; h < 8; ++h) s[h][j] = valid ? dot64(qb + h * 64, kf) : NEGF;
    }
    float linv[8];
#pragma unroll
    for (int h = 0; h < 8; ++h) {
        const float m = wave_max(fmaxf(fmaxf(s[h][0], s[h][1]), fmaxf(s[h][2], s[h][3]))); float ls = 0.f;
#pragma unroll
        for (int j = 0; j < 4; ++j) { const float p = __expf(s[h][j] - m); ls += p; pb[h * 256 + lane + 64 * j] = p; }
        linv[h] = 1.0f / wave_sum(ls);
    }
    WAVE_LDS_SYNC();
    float acc[8] = {0.f, 0.f, 0.f, 0.f, 0.f, 0.f, 0.f, 0.f};
    for (int slot = 0; slot < nsel; ++slot) {
        const float v = bf2f(kva[(size_t)(b * SEQ + list[slot]) * 128 + 64 + lane]);
#pragma unroll
        for (int h = 0; h < 8; ++h) acc[h] += pb[h * 256 + slot] * v;
    }
    bf16* ya = (bf16*)(ws + WS_QA) + (size_t)row * 512;
#pragma unroll
    for (int h = 0; h < 8; ++h) ya[h * 64 + lane] = (bf16)f2bf(acc[h] * linv[h]);
    WAVE_LDS_SYNC();
}
typedef short s16x4 __attribute__((ext_vector_type(4)));
typedef short v4i16_t __attribute__((ext_vector_type(4)));
typedef float f32x4v __attribute__((ext_vector_type(4)));
typedef __bf16 bf16x2_t __attribute__((ext_vector_type(2)));
typedef float f32x2_t __attribute__((ext_vector_type(2)));
__device__ __forceinline__ unsigned cvtpk(float lo, float hi) { f32x2_t v = {lo, hi}; bf16x2_t b = __builtin_convertvector(v, bf16x2_t); return __builtin_bit_cast(unsigned, b); }
constexpr float L2E = 1.4426950408889634f;
#ifndef NSA_NOSKIP
#define NSA_NOSKIP 0
#endif
constexpr int NSA_KSTR = 72, NSA_VSTR = 80;
constexpr int NSA_KB = 64 * NSA_KSTR * 2, NSA_VB = 64 * NSA_VSTR * 2;
constexpr int NSA_D = 6, NSA_SLOT = 16384;
constexpr int NSA_OFF_RING = 0, NSA_OFF_KCL = 0, NSA_OFF_VCTL = 32768  , NSA_OFF_IMPA = 65536  , NSA_OFF_IMPB = NSA_OFF_IMPA + 64 * 65 * 4, NSA_OFF_UM = NSA_D * NSA_SLOT + 1024  , NSA_OFF_QM = NSA_OFF_UM + 64, NSA_OFF_ST = NSA_OFF_UM + 1024, NSA_LDS = NSA_OFF_ST + 512 * 64;
__device__ __forceinline__ s16x4 tr16(const LAS unsigned char* p) { return __builtin_bit_cast(s16x4, __builtin_amdgcn_ds_read_tr16_b64_v4i16((LAS v4i16_t*)p)); }
__device__ __forceinline__ bf16x8 cat4(s16x4 a, s16x4 b) { return __builtin_shufflevector(a, b, 0, 1, 2, 3, 4, 5, 6, 7); }
__device__ __forceinline__ bf16x8 pack8(float a0, float a1, float a2, float a3, float b0, float b1, float b2, float b3) {
    v4u w; w.x = pg8::cvt_pk_bf16(a0, a1); w.y = pg8::cvt_pk_bf16(a2, a3); w.z = pg8::cvt_pk_bf16(b0, b1); w.w = pg8::cvt_pk_bf16(b2, b3); return __builtin_bit_cast(bf16x8, w);
}
__device__ __forceinline__ float xmax16(float v) { v = fmaxf(v, __shfl_xor(v, 16)); return fmaxf(v, __shfl_xor(v, 32)); }
__device__ __forceinline__ float xsum16(float v) { v += __shfl_xor(v, 16); return v + __shfl_xor(v, 32); }

__device__ __forceinline__ void nsa_fetch(const bf16* kv, int b, int jb, int g, int tid, v4u& kr, v4u& vr) {
    const bf16* p = kv + (size_t)(b * SEQ + 64 * jb + (tid >> 3)) * 256 + g * 64 + (tid & 7) * 8;
    kr = *(const v4u*)p; vr = *(const v4u*)(p + 128);
}
__device__ __forceinline__ void nsa_stash(LAS unsigned char* Kb, LAS unsigned char* Vb, int tid, const v4u& kr, const v4u& vr) {
    *(LAS v4u*)(Kb + ((tid >> 3) * NSA_KSTR + (tid & 7) * 8) * 2) = kr; *(LAS v4u*)(Vb + ((tid >> 3) * NSA_VSTR + (tid & 7) * 8) * 2) = vr;
}
template <bool FULL>
__device__ __forceinline__ void nsa_block2(const LAS unsigned char* Kb, const LAS unsigned char* Vb, const bf16x8 (&qf)[2][2], const bool (&sel)[2], const int (&klo)[2], const int (&khi)[2],
                                           float (&mrow)[2], float (&lrow)[2], f32x4v (&o)[2][4], int lane) {
    const int j = lane & 15, gq = lane >> 4;
    f32x4v s[2][4];
#pragma unroll
    for (int kt = 0; kt < 4; ++kt) {
        s[0][kt] = (f32x4v){0.f, 0.f, 0.f, 0.f}; s[1][kt] = (f32x4v){0.f, 0.f, 0.f, 0.f};
#pragma unroll
        for (int ks = 0; ks < 2; ++ks) {
            const bf16x8 kf = *(const LAS bf16x8*)(Kb + (16 * kt + j) * 128 + (((gq + 4 * ks) ^ (j & 7)) << 4));
            s[0][kt] = __builtin_amdgcn_mfma_f32_16x16x32_bf16(kf, qf[0][ks], s[0][kt], 0, 0, 0);
            s[1][kt] = __builtin_amdgcn_mfma_f32_16x16x32_bf16(kf, qf[1][ks], s[1][kt], 0, 0, 0);
        }
    }
#pragma unroll
    for (int rg = 0; rg < 2; ++rg) {
        float bm = NEGF;
        if (FULL) { const float bias = sel[rg] ? 0.f : NEGF;
#pragma unroll
            for (int kt = 0; kt < 4; ++kt)
#pragma unroll
                for (int e = 0; e < 4; ++e) { const float v = s[rg][kt][e] + bias; s[rg][kt][e] = v; bm = fmaxf(bm, v); }
        } else {
#pragma unroll
            for (int kt = 0; kt < 4; ++kt)
#pragma unroll
                for (int e = 0; e < 4; ++e) { const int ko = 16 * kt + 4 * gq + e; const bool ok = sel[rg] && ko >= klo[rg] && ko <= khi[rg]; const float v = ok ? s[rg][kt][e] : NEGF; s[rg][kt][e] = v; bm = fmaxf(bm, v); }
        }
        bm = xmax16(bm);
        const float mnew = fmaxf(mrow[rg], bm), alpha = __builtin_amdgcn_exp2f(mrow[rg] - mnew);
        const bool moved = __builtin_amdgcn_ballot_w64(mnew != mrow[rg]) != 0ull;
        mrow[rg] = mnew;
        float ps = 0.f;
#pragma unroll
        for (int kt = 0; kt < 4; ++kt)
#pragma unroll
            for (int e = 0; e < 4; ++e) { const float p = __builtin_amdgcn_exp2f(s[rg][kt][e] - mnew); s[rg][kt][e] = p; ps += p; }
        lrow[rg] = lrow[rg] * alpha + ps;
        if (moved) {
#pragma unroll
            for (int dt = 0; dt < 4; ++dt) o[rg][dt] *= alpha;
        }
    }
#pragma unroll
    for (int kk = 0; kk < 2; ++kk) {
        const bf16x8 pf0 = pack8(s[0][2 * kk][0], s[0][2 * kk][1], s[0][2 * kk][2], s[0][2 * kk][3], s[0][2 * kk + 1][0], s[0][2 * kk + 1][1], s[0][2 * kk + 1][2], s[0][2 * kk + 1][3]);
        const bf16x8 pf1 = pack8(s[1][2 * kk][0], s[1][2 * kk][1], s[1][2 * kk][2], s[1][2 * kk][3], s[1][2 * kk + 1][0], s[1][2 * kk + 1][1], s[1][2 * kk + 1][2], s[1][2 * kk + 1][3]);
#pragma unroll
        for (int dt = 0; dt < 4; ++dt) {
            const LAS unsigned char* va = Vb + (32 * kk + 4 * gq + (j >> 2)) * 128 + (16 * dt + 4 * (j & 3)) * 2;
            const bf16x8 vf = cat4(tr16(va), tr16(va + 16 * 128));
            o[0][dt] = __builtin_amdgcn_mfma_f32_16x16x32_bf16(vf, pf0, o[0][dt], 0, 0, 0);
            o[1][dt] = __builtin_amdgcn_mfma_f32_16x16x32_bf16(vf, pf1, o[1][dt], 0, 0, 0);
        }
        }
}
__device__ __forceinline__ void glds16(const void* gsrc, unsigned lds_dst) { unsigned keep;
    asm volatile("s_mov_b32 %0, m0\n\ts_mov_b32 m0, %2\n\ts_nop 0\n\tglobal_load_lds_dwordx4 %1, off\n\ts_mov_b32 m0, %0" : "=&s"(keep) : "v"(gsrc), "s"(lds_dst) : "memory"); }
template <int MODE>
__device__ __forceinline__ void nsa_attend(const bf16* kv, unsigned long long mask, int b, int g, int c, int tid, int lane, LAS unsigned char* ring, const bf16x8 (&qf)[2][2],
                                           const unsigned long long (&rmask)[2], const unsigned long long (&gmask)[2], const int (&trow)[2], float (&mrow)[2], float (&lrow)[2], f32x4v (&o)[2][4]) {
    const int wave = __builtin_amdgcn_readfirstlane(tid >> 6);
    const int rr = 8 * wave + (lane >> 3);
    const bf16* gk = kv + (size_t)(b * SEQ + rr) * 256 + g * 64 + (((lane & 7) ^ (rr & 7)) << 3);
    const bf16* gv = kv + (size_t)(b * SEQ + rr) * 256 + 128 + g * 64 + ((lane & 7) << 3);
    const unsigned ring0 = (unsigned)(uintptr_t)(unsigned char*)ring + wave * 1024;
#define NSA_ISSUE(jb_, slot_) do { glds16(gk + (size_t)(jb_) * 64 * 256, (unsigned)__builtin_amdgcn_readfirstlane(ring0 + (slot_) * NSA_SLOT)); \
                                   glds16(gv + (size_t)(jb_) * 64 * 256, (unsigned)__builtin_amdgcn_readfirstlane(ring0 + (slot_) * NSA_SLOT + 8192)); } while (0)
    unsigned long long remi = mask, remc = mask; int lastb = 0, si = 0, sc_ = 0;
#if DUP == 12
    float m2_[2] = {NEGF, NEGF}, l2_[2] = {0.f, 0.f}; f32x4v o2_[2][4]; for (int rg = 0; rg < 2; ++rg) for (int dt = 0; dt < 4; ++dt) o2_[rg][dt] = (f32x4v){0.f, 0.f, 0.f, 0.f};
#endif
#pragma unroll
    for (int d = 0; d < NSA_D - 1; ++d) { if (remi) { lastb = (int)__builtin_ctzll(remi); remi &= remi - 1ull; } NSA_ISSUE(lastb, si); si = si + 1 == NSA_D ? 0 : si + 1; }
    while (remc) {
        const int jj = (int)__builtin_ctzll(remc); remc &= remc - 1ull;
        asm volatile("s_waitcnt vmcnt(8) lgkmcnt(0)\n\ts_barrier" ::: "memory");
        if (remi) { lastb = (int)__builtin_ctzll(remi); remi &= remi - 1ull; }
        NSA_ISSUE(lastb, si); si = si + 1 == NSA_D ? 0 : si + 1;
        const LAS unsigned char* kb_ = ring + sc_ * NSA_SLOT; const LAS unsigned char* vb_ = kb_ + 8192; sc_ = sc_ + 1 == NSA_D ? 0 : sc_ + 1;
        bool sel[2]; int klo[2], khi[2]; bool act[2];
#pragma unroll
        for (int rg = 0; rg < 2; ++rg) { const int o6 = trow[rg] & 63;
            if (MODE == 0) { sel[rg] = (rmask[rg] >> jj) & 1ull; act[rg] = (gmask[rg] >> jj) & 1ull; klo[rg] = 0; khi[rg] = (jj == c) ? o6 : 63; }
            else { sel[rg] = true; act[rg] = true; klo[rg] = (jj == c - 4) ? o6 + 1 : 0; khi[rg] = (jj == c) ? o6 : 63; } }
        if (act[0] || act[1]) {
            const bool full = (MODE == 0) ? (jj != c) : (jj != c && jj != c - 4);
            if (full) nsa_block2<true>(kb_, vb_, qf, sel, klo, khi, mrow, lrow, o, lane); else nsa_block2<false>(kb_, vb_, qf, sel, klo, khi, mrow, lrow, o, lane);
#if DUP == 12
            if (full) nsa_block2<true>(kb_, vb_, qf, sel, klo, khi, m2_, l2_, o2_, lane); else nsa_block2<false>(kb_, vb_, qf, sel, klo, khi, m2_, l2_, o2_, lane);
#endif
        }
    }
#if DUP == 12
    { float acc_ = 0.f; for (int rg = 0; rg < 2; ++rg) { acc_ += l2_[rg] + m2_[rg]; for (int dt = 0; dt < 4; ++dt) acc_ += o2_[rg][dt][0] + o2_[rg][dt][1] + o2_[rg][dt][2] + o2_[rg][dt][3]; } if (acc_ == 123.456f) ((LAS float*)(ring + NSA_D * NSA_SLOT + 600))[0] = acc_; }
#endif
    asm volatile("s_waitcnt vmcnt(0) lgkmcnt(0)\n\ts_barrier" ::: "memory");
#undef NSA_ISSUE
}
#if defined(PROBE_CMP)
__device__ __forceinline__ void nsa_probe_store(unsigned char* ws, int row, int head, int gq, const f32x4v (&v)[4]) {
    bf16* pb_ = (bf16*)(ws + 497 * MiB);
    for (int dt = 0; dt < 4; ++dt) { uint2 w; w.x = cvtpk(v[dt][0], v[dt][1]); w.y = cvtpk(v[dt][2], v[dt][3]); *(uint2*)(pb_ + (size_t)row * 512 + head * 64 + 16 * dt + 4 * gq) = w; }
}
#endif
__device__ __forceinline__ void nsa_unit(unsigned char* ws, int unit, LAS unsigned char* lds, int tid_in, bf16* yout) {
    int tid = tid_in; asm volatile("" : "+v"(tid));
    const int lane = tid & 63, wave = __builtin_amdgcn_readfirstlane(tid >> 6), j = lane & 15, gq = lane >> 4;
    const int c = unit & 63, g = (unit >> 6) & 1, b = unit >> 7, bg = b * 2 + g;
    LAS float* impa = (LAS float*)(lds + NSA_OFF_IMPA); LAS float* impb = (LAS float*)(lds + NSA_OFF_IMPB);
    LAS unsigned long long* um = (LAS unsigned long long*)(lds + NSA_OFF_UM);
    TP_DECL
    for (int i = tid; i < 2 * 64 * 65; i += 512) impa[i] = 0.f;
    {
        const v4u* ksrc = (const v4u*)((const bf16*)(ws + WS_KC) + (size_t)bg * 256 * 64); const v4u* vsrc = (const v4u*)((const bf16*)(ws + WS_VC) + (size_t)bg * 64 * 256);
#pragma unroll
        for (int i = 0; i < 4; ++i) { const int idx = tid + 512 * i; const int r = idx >> 3, sg = idx & 7; *(LAS v4u*)(lds + NSA_OFF_KCL + r * 128 + ((sg ^ (r & 7)) << 4)) = ksrc[idx]; }
#pragma unroll
        for (int i = 0; i < 4; ++i) { const int idx = tid + 512 * i; const int r = idx >> 5, sg = idx & 31; *(LAS v4u*)(lds + NSA_OFF_VCTL + r * 512 + ((sg ^ (r & 15)) << 4)) = vsrc[idx]; }
    }
    bf16* qc = (bf16*)(ws + WS_QC);
    const bf16* misc = (const bf16*)(ws + WS_MISC);
    bf16x8 qf[2][2]; float gate[2][3]; int trow[2];
#pragma unroll
    for (int rg = 0; rg < 2; ++rg) {
        const int q = 8 * wave + 4 * rg + (j >> 2), t = 64 * c + q, row = b * SEQ + t, head = g * 4 + (j & 3);
        trow[rg] = t;
#pragma unroll
        for (int ks = 0; ks < 2; ++ks) qf[rg][ks] = *(const bf16x8*)(qc + (size_t)row * 512 + head * 64 + 8 * gq + 32 * ks);
#pragma unroll
        for (int e = 0; e < 3; ++e) gate[rg][e] = __builtin_amdgcn_rcpf(1.0f + __expf(-bf2f(misc[(size_t)row * 256 + 196 + head * 3 + e])));
    }
    typedef unsigned u32x2v __attribute__((ext_vector_type(2)));
    LAS u32x2v* stash = (LAS u32x2v*)(lds + NSA_OFF_ST) + tid * 8;
    __syncthreads();
    const int nT = (c >> 2) + 1;
#pragma unroll
    for (int rg = 0; rg < 2; ++rg) {
        const int t = trow[rg], nv = t >= 31 ? ((t - 15) >> 4) : 0;
        f32x4v s[16]; float mx = NEGF;
#pragma unroll
        for (int T = 0; T < 16; ++T) {
            s[T] = (f32x4v){0.f, 0.f, 0.f, 0.f};
            if (T < nT) {
#pragma unroll
                for (int ks = 0; ks < 2; ++ks) { const bf16x8 kf = *(const LAS bf16x8*)(lds + NSA_OFF_KCL + (16 * T + j) * 128 + (((gq + 4 * ks) ^ (j & 7)) << 4)); s[T] = __builtin_amdgcn_mfma_f32_16x16x32_bf16(kf, qf[rg][ks], s[T], 0, 0, 0); }
#pragma unroll
                for (int e = 0; e < 4; ++e) { const float v = (16 * T + 4 * gq + e < nv) ? s[T][e] : NEGF; s[T][e] = v; mx = fmaxf(mx, v); }
            }
        }
        mx = xmax16(mx);
        float ls = 0.f;
#pragma unroll
        for (int T = 0; T < 16; ++T) if (T < nT) {
#pragma unroll
            for (int e = 0; e < 4; ++e) { const float p = (16 * T + 4 * gq + e < nv) ? __builtin_amdgcn_exp2f(s[T][e] - mx) : 0.f; s[T][e] = p; ls += p; }
        }
        ls = xsum16(ls);
        const float inv = nv > 0 ? __builtin_amdgcn_rcpf(ls) : 0.f;
        const int q = 8 * wave + 4 * rg + (j >> 2);
#pragma unroll
        for (int T = 0; T < 16; ++T) if (T < nT) {
#pragma unroll
            for (int e = 0; e < 4; ++e) s[T][e] *= inv;
            float a = s[T][0] + s[T][1] + s[T][2] + 0.5f * s[T][3], bb = 0.5f * s[T][3];
            a += __shfl_xor(a, 1); a += __shfl_xor(a, 2); bb += __shfl_xor(bb, 1); bb += __shfl_xor(bb, 2);
            if ((j & 3) == 0) { impa[q * 65 + 4 * T + gq] = a; impb[q * 65 + 4 * T + gq + 1] = bb; }
        }
        f32x4v oc[4];
#pragma unroll
        for (int dt = 0; dt < 4; ++dt) oc[dt] = (f32x4v){0.f, 0.f, 0.f, 0.f};
#pragma unroll
        for (int kk = 0; kk < 8; ++kk) if (2 * kk < nT) {
            const bf16x8 pf = pack8(s[2 * kk][0], s[2 * kk][1], s[2 * kk][2], s[2 * kk][3], s[2 * kk + 1][0], s[2 * kk + 1][1], s[2 * kk + 1][2], s[2 * kk + 1][3]);
#pragma unroll
            for (int dt = 0; dt < 4; ++dt) {
                const LAS unsigned char* vp = lds + NSA_OFF_VCTL + (16 * dt + j) * 512 + (gq & 1) * 8;
                const s16x4 v0 = *(const LAS s16x4*)(vp + ((((8 * kk + gq) >> 1) ^ j) << 4)), v1 = *(const LAS s16x4*)(vp + (((((8 * kk + gq) >> 1) + 2) ^ j) << 4));
                oc[dt] = __builtin_amdgcn_mfma_f32_16x16x32_bf16(cat4(v0, v1), pf, oc[dt], 0, 0, 0);
            }
        }
#pragma unroll
        for (int dt = 0; dt < 4; ++dt) { const f32x4v v = oc[dt] * gate[rg][0]; u32x2v w; w.x = pg8::cvt_pk_bf16(v[0], v[1]); w.y = pg8::cvt_pk_bf16(v[2], v[3]); stash[rg * 4 + dt] = w; }
        __builtin_amdgcn_sched_barrier(0);
    }
    __syncthreads();
    TP_MARK(5);
    unsigned long long smask[8], mymask = 0ull;
#pragma unroll
    for (int qi = 0; qi < 8; ++qi) {
        const int q = 8 * wave + qi;
#if PROBE == 4
        const float imp = ((const float*)(ws + 500 * MiB))[((size_t)(b * SEQ + 64 * c + q) * 2 + g) * 64 + lane];
#else
        const float imp = impa[q * 65 + lane] + impb[q * 65 + lane];
#endif
#if PROBE && (PROBE != 5 || defined(PROBE5_IMP))
        ((float*)(ws + 516 * MiB))[((size_t)(b * SEQ + 64 * c + q) * 2 + g) * 64 + lane] = (lane <= c) ? imp : 0.f;
#endif
        const bool forced = (lane == 0) || (lane == c), adm = lane <= c;
        unsigned key = forced ? (0xFFFFFF00u | (unsigned)(63 - lane)) : (adm ? ((__float_as_uint(imp) & 0xFFFFFFC0u) | (unsigned)(63 - lane)) : 0u);
        unsigned long long mk = 0ull;
#if TOP8_RANK
        { int rank = 0;
#pragma unroll
          for (int jj = 0; jj < 64; ++jj) { const unsigned kk = (unsigned)__builtin_amdgcn_readlane((int)key, jj); rank += (kk > key) ? 1 : 0; }
          mk = __ballot(key != 0u && rank < 8); }
#else
        for (int k = 0; k < 8; ++k) { const unsigned mx = wave_max_u(key); if (mx == 0u) break; const int win = 63 - (int)(mx & 63u); mk |= 1ull << win; if (lane == win) key = 0u; }
#endif
        mk = ((unsigned long long)(unsigned)__builtin_amdgcn_readfirstlane((unsigned)(mk >> 32)) << 32) | (unsigned long long)(unsigned)__builtin_amdgcn_readfirstlane((unsigned)mk);
#ifdef FIXSEL
        { mk = 1ull | (1ull << c); for (int d = 1; d <= 6; ++d) mk |= 1ull << (((FIXHOM ? 0 : q * 7) + d * 5) % (c + 1)); }
#endif
#if PROBE == 2
        mk = ((const unsigned long long*)(ws + 496 * MiB))[(size_t)(b * SEQ + 64 * c + q) * 2 + g];
        mk = ((unsigned long long)(unsigned)__builtin_amdgcn_readfirstlane((unsigned)(mk >> 32)) << 32) | (unsigned long long)(unsigned)__builtin_amdgcn_readfirstlane((unsigned)mk);
#endif
#if PROBE == 5
        if (lane == 0) ((unsigned long long*)(ws + 498 * MiB))[(size_t)(b * SEQ + 64 * c + q) * 2 + g] = mk;
#endif
#if PROBE == 5 && !defined(PROBE5_IMP)
        ((float*)(ws + 516 * MiB))[((size_t)(b * SEQ + 64 * c + q) * 2 + g) * 64 + lane] = ((mk >> lane) & 1ull) ? 1.f : 0.f;
#endif
        smask[qi] = mk; mymask |= mk;
    }
    if (lane == 0) um[wave] = mymask;
    __syncthreads();
    unsigned long long umask = 0ull;
#pragma unroll
    for (int w = 0; w < 8; ++w) umask |= um[w];
    umask = ((unsigned long long)(unsigned)__builtin_amdgcn_readfirstlane((unsigned)(umask >> 32)) << 32) | (unsigned long long)(unsigned)__builtin_amdgcn_readfirstlane((unsigned)umask);
    unsigned long long rmask[2];
    { LAS unsigned long long* qm = (LAS unsigned long long*)(lds + NSA_OFF_QM);
      __syncthreads();
#pragma unroll
      for (int qi = 0; qi < 8; ++qi) if (lane == 0) qm[8 * wave + qi] = smask[qi];
      __syncthreads();
#pragma unroll
      for (int rg = 0; rg < 2; ++rg) rmask[rg] = qm[8 * wave + 4 * rg + (j >> 2)]; }
    const unsigned long long gmask[2] = {smask[0] | smask[1] | smask[2] | smask[3], smask[4] | smask[5] | smask[6] | smask[7]};
    TP_MARK(6); TP_ADD(9, __popcll(umask)); TP_ADD(10, 1); TP_ADD(11, c + 1); TP_ADD(12, __popcll(umask & ~(c == 63 ? ~0ull : ((2ull << c) - 1ull)))); TP_ADD(13, __popcll(smask[0]));
    const bf16* kvs = (const bf16*)(ws + WS_KVS); const bf16* kvw = (const bf16*)(ws + WS_KVW);
    LAS unsigned char* ring = lds + NSA_OFF_RING;
    {
        float mrow[2] = {NEGF, NEGF}, lrow[2] = {0.f, 0.f}; f32x4v o[2][4];
#pragma unroll
        for (int rg = 0; rg < 2; ++rg)
#pragma unroll
            for (int dt = 0; dt < 4; ++dt) o[rg][dt] = (f32x4v){0.f, 0.f, 0.f, 0.f};
        nsa_attend<0>(kvs, umask, b, g, c, tid, lane, ring, qf, rmask, gmask, trow, mrow, lrow, o);
#if DUP == 8
        { __syncthreads(); float m2[2] = {NEGF, NEGF}, l2[2] = {0.f, 0.f}; f32x4v o2[2][4];
          for (int rg = 0; rg < 2; ++rg) for (int dt = 0; dt < 4; ++dt) o2[rg][dt] = (f32x4v){0.f, 0.f, 0.f, 0.f};
          nsa_attend<0>(kvs, umask, b, g, c, tid, lane, Kb, Vb, qf, rmask, gmask, trow, m2, l2, o2);
          bf16* dmy = (bf16*)(ws + WS_BU) + (size_t)(b * SEQ + trow[0]) * 512 + (g * 4 + (j & 3)) * 64 + 4 * gq;
          for (int rg = 0; rg < 2; ++rg) for (int dt = 0; dt < 4; ++dt) { uint2 w; w.x = pg8::cvt_pk_bf16(o2[rg][dt][0] + l2[rg], o2[rg][dt][1]); w.y = pg8::cvt_pk_bf16(o2[rg][dt][2], o2[rg][dt][3]); *(uint2*)(dmy + 16 * dt) = w; } }
#endif
#pragma unroll
        for (int rg = 0; rg < 2; ++rg) { const float sc = gate[rg][1] * __builtin_amdgcn_rcpf(xsum16(lrow[rg]));
#pragma unroll
            for (int dt = 0; dt < 4; ++dt) { const u32x2v p = stash[rg * 4 + dt]; const f32x4v v = o[rg][dt] * sc; u32x2v w; w.x = pg8::cvt_pk_bf16(v[0] + bflo(p.x), v[1] + bfhi(p.x)); w.y = pg8::cvt_pk_bf16(v[2] + bflo(p.y), v[3] + bfhi(p.y)); stash[rg * 4 + dt] = w; }
            }
        __syncthreads();
    }
    TP_MARK(7);
    {
        float mrow[2] = {NEGF, NEGF}, lrow[2] = {0.f, 0.f}; f32x4v o[2][4];
#pragma unroll
        for (int rg = 0; rg < 2; ++rg)
#pragma unroll
            for (int dt = 0; dt < 4; ++dt) o[rg][dt] = (f32x4v){0.f, 0.f, 0.f, 0.f};
        { const int j0 = c - 4 > 0 ? c - 4 : 0; const unsigned long long wmask = ((c == 63 ? ~0ull : ((1ull << (c + 1)) - 1ull)) >> j0) << j0;
          nsa_attend<1>(kvw, wmask, b, g, c, tid, lane, ring, qf, rmask, gmask, trow, mrow, lrow, o); }
#pragma unroll
        for (int rg = 0; rg < 2; ++rg) { const float sc = gate[rg][2] * __builtin_amdgcn_rcpf(xsum16(lrow[rg]));
#pragma unroll
            for (int dt = 0; dt < 4; ++dt) { const u32x2v p = stash[rg * 4 + dt]; const f32x4v v = o[rg][dt] * sc; uint2 w; w.x = pg8::cvt_pk_bf16(v[0] + bflo(p.x), v[1] + bfhi(p.x)); w.y = pg8::cvt_pk_bf16(v[2] + bflo(p.y), v[3] + bfhi(p.y));
                *(uint2*)(yout + (size_t)(b * SEQ + trow[rg]) * 512 + (g * 4 + (j & 3)) * 64 + 16 * dt + 4 * gq) = w; }
            }
    }
    __syncthreads();
    TP_MARK(8);
}
__device__ __forceinline__ void prep_kva16(unsigned char* ws, int task, int lane) {
    const int j = lane & 15, gq = lane >> 4, row = task * 16 + j;
    const bf16* misc = (const bf16*)(ws + WS_MISC) + (size_t)row * 256 + 64;
    const bf16* wu = (const bf16*)(ws + WS_W + WO_UKV);
    bf16x8 cf[4]; float ss = 0.f;
#pragma unroll
    for (int ks = 0; ks < 4; ++ks) { const v4u v = *(const v4u*)(misc + 8 * gq + 32 * ks); cf[ks] = __builtin_bit_cast(bf16x8, v); float f[8]; unpack8(v, f);
#pragma unroll
        for (int e = 0; e < 8; ++e) ss += f[e] * f[e]; }
    ss = xsum16(ss);
    const float r = 1.0f / sqrtf(ss * (1.f / 128.f) + EPS);
    const float* rp = (const float*)(ws + WS_ROPE) + (size_t)row * 16;
    bf16* o = (bf16*)(ws + WS_KVA) + (size_t)row * 128;
#pragma unroll
    for (int ct = 0; ct < 8; ++ct) {
        f32x4v a = {0.f, 0.f, 0.f, 0.f};
#pragma unroll
        for (int ks = 0; ks < 4; ++ks) { const bf16x8 wf = *(const bf16x8*)(wu + (size_t)(16 * ct + j) * 128 + 8 * gq + 32 * ks); a = __builtin_amdgcn_mfma_f32_16x16x32_bf16(wf, cf[ks], a, 0, 0, 0); }
        a *= r;
        if (ct == 0) {
            const float c0 = rp[2 * gq], s0 = rp[8 + 2 * gq], c1 = rp[2 * gq + 1], s1 = rp[8 + 2 * gq + 1];
            const float x0 = a[0], x1 = a[1], x2 = a[2], x3 = a[3];
            a[0] = x0 * c0 - x1 * s0; a[1] = x1 * c0 + x0 * s0; a[2] = x2 * c1 - x3 * s1; a[3] = x3 * c1 + x2 * s1;
        }
        uint2 w; w.x = cvtpk(a[0], a[1]); w.y = cvtpk(a[2], a[3]);
        *(uint2*)(o + 16 * ct + 4 * gq) = w;
    }
}
__device__ __forceinline__ void prep_pool16(unsigned char* ws, int task, int lane, const LAS unsigned char* wl) {
    const int j = lane & 15, gq = lane >> 4, row = task * 16 + j, t = row & (SEQ - 1);
    const bf16* bu = (const bf16*)(ws + WS_BU);
    bf16* yb = (bf16*)(ws + WS_YB) + (size_t)row * 512;
#pragma unroll 1
    for (int g = 0; g < 4; ++g) {
        const int w = 2 << g, lo = (t + 1 - w) > 0 ? (t + 1 - w) : 0, cnt = t + 1 - lo; const float inv = 1.0f / (float)cnt;
        bf16x8 pf[4];
#pragma unroll
        for (int ks = 0; ks < 4; ++ks) {
            const bf16* p = bu + (size_t)row * 512 + g * 128 + 8 * gq + 32 * ks;
            float sum[8] = {0.f, 0.f, 0.f, 0.f, 0.f, 0.f, 0.f, 0.f}, cur[8];
            { const v4u v = *(const v4u*)p; unpack8(v, cur);
#pragma unroll
              for (int e = 0; e < 8; ++e) sum[e] = cur[e]; }
            v4u wv_[15];
#pragma unroll
            for (int i = 1; i < 16; ++i) if (i < w) wv_[i - 1] = *(const v4u*)(p - (size_t)(i < cnt ? i : 0) * 512);
#pragma unroll
            for (int i = 1; i < 16; ++i) if (i < w) { const bool ok = i < cnt; float f[8]; unpack8(wv_[i - 1], f);
#pragma unroll
                for (int e = 0; e < 8; ++e) sum[e] += ok ? f[e] : 0.f; }
            __builtin_amdgcn_sched_barrier(0);
            pf[ks] = pack8(sum[0] * inv - cur[0], sum[1] * inv - cur[1], sum[2] * inv - cur[2], sum[3] * inv - cur[3], sum[4] * inv - cur[4], sum[5] * inv - cur[5], sum[6] * inv - cur[6], sum[7] * inv - cur[7]);
        }
#pragma unroll
        for (int dt = 0; dt < 8; ++dt) {
            f32x4v a = {0.f, 0.f, 0.f, 0.f};
#pragma unroll
            for (int ks = 0; ks < 4; ++ks) {
#if POOLDBG == 1
                bf16x8 wf; for (int e = 0; e < 8; ++e) wf[e] = (short)0x3c00;
#else
                const bf16x8 wf = *(const LAS bf16x8*)(wl + (g * 128 + 16 * dt + j) * 256 + (((gq + 4 * ks) ^ j) << 4));
#endif
#if POOLDBG == 2
                bf16x8 pz; for (int e = 0; e < 8; ++e) pz[e] = (short)0x3c00; a = __builtin_amdgcn_mfma_f32_16x16x32_bf16(wf, pz, a, 0, 0, 0);
#else
                a = __builtin_amdgcn_mfma_f32_16x16x32_bf16(wf, pf[ks], a, 0, 0, 0);
#endif
            }
            uint2 wv; wv.x = cvtpk(a[0], a[1]); wv.y = cvtpk(a[2], a[3]);
            *(uint2*)(yb + g * 128 + 16 * dt + 4 * gq) = wv;
        }
    }
}
__device__ __forceinline__ float gelu_tanh_f(float x) { const float u = 0.7978845608028654f * (x + 0.044715f * x * x * x); const float e = __expf(2.0f * u); return 0.5f * x * (1.0f + (1.0f - 2.0f / (e + 1.0f))); }
__device__ __forceinline__ void prep_cmp16(unsigned char* ws, int task, LAS unsigned char* lds, int wave, int lane) {
    const int j = lane & 15, gq = lane >> 4, grp = wave >> 2, wq = wave & 3;
    const int i0 = (task & 15) * 16, bg = (task >> 4) & 15, br = task >> 8, b = bg >> 1, g = bg & 1, i = i0 + j;
    const bf16* kvc = (const bf16*)(ws + WS_KVC);
    const bf16* w1 = (const bf16*)(ws + WS_W + WO_CW1) + (size_t)br * 128 * 2048;
    const bf16* w2 = (const bf16*)(ws + WS_W + WO_CW2) + (size_t)br * 64 * 128;
    const float* posb = (const float*)(ws + WS_W + WO_POSB) + br * 128;
    LAS float* part = (LAS float*)lds + (size_t)grp * 4 * 32 * 64;
    f32x4v h[8];
#pragma unroll
    for (int nt = 0; nt < 8; ++nt) h[nt] = (f32x4v){0.f, 0.f, 0.f, 0.f};
#pragma unroll 4
    for (int k2 = 0; k2 < 16; ++k2) {
        const int ks = 16 * wq + k2, l = ks >> 1; int tok = 16 * i + l; tok = tok > SEQ - 1 ? SEQ - 1 : tok;
        const bf16x8 ff = *(const bf16x8*)(kvc + (size_t)(b * SEQ + tok) * 256 + br * 128 + g * 64 + 32 * (ks & 1) + 8 * gq);
#pragma unroll
        for (int nt = 0; nt < 8; ++nt) { const bf16x8 wf = *(const bf16x8*)(w1 + (size_t)(16 * nt + j) * 2048 + 32 * ks + 8 * gq); h[nt] = __builtin_amdgcn_mfma_f32_16x16x32_bf16(wf, ff, h[nt], 0, 0, 0); }
    }
#pragma unroll
    for (int nt = 0; nt < 8; ++nt)
#pragma unroll
        for (int e = 0; e < 4; ++e) part[(wq * 32 + nt * 4 + e) * 64 + lane] = h[nt][e];
    __syncthreads();
    if (wq == 0) {
#pragma unroll
        for (int nt = 0; nt < 8; ++nt) { const f32x4v pbv = *(const f32x4v*)(posb + 16 * nt + 4 * gq);
#pragma unroll
            for (int e = 0; e < 4; ++e) { const int idx = (nt * 4 + e) * 64 + lane; h[nt][e] = gelu_tanh_f(((part[idx] + part[32 * 64 + idx]) + (part[2 * 32 * 64 + idx] + part[3 * 32 * 64 + idx])) + pbv[e]); } }
        f32x4v o[4];
#pragma unroll
        for (int dt = 0; dt < 4; ++dt) o[dt] = (f32x4v){0.f, 0.f, 0.f, 0.f};
#pragma unroll
        for (int kk = 0; kk < 4; ++kk) {
            const bf16x8 hf = pack8(h[2 * kk][0], h[2 * kk][1], h[2 * kk][2], h[2 * kk][3], h[2 * kk + 1][0], h[2 * kk + 1][1], h[2 * kk + 1][2], h[2 * kk + 1][3]);
#pragma unroll
            for (int dt = 0; dt < 4; ++dt) { const bf16* wp = w2 + (size_t)(16 * dt + j) * 128 + 32 * kk + 4 * gq; const s16x4 v0 = *(const s16x4*)wp, v1 = *(const s16x4*)(wp + 16);
                o[dt] = __builtin_amdgcn_mfma_f32_16x16x32_bf16(cat4(v0, v1), hf, o[dt], 0, 0, 0); }
        }
        const bool dead = i == 255;
        if (br == 0) { bf16* kc = (bf16*)(ws + WS_KC) + ((size_t)bg * 256 + i) * 64;
#pragma unroll
            for (int dt = 0; dt < 4; ++dt) { uint2 w; w.x = dead ? 0u : cvtpk(o[dt][0], o[dt][1]); w.y = dead ? 0u : cvtpk(o[dt][2], o[dt][3]); *(uint2*)(kc + 16 * dt + 4 * gq) = w; }
        } else { bf16* vct = (bf16*)(ws + WS_VC) + (size_t)bg * 64 * 256 + i;
#pragma unroll
            for (int dt = 0; dt < 4; ++dt)
#pragma unroll
                for (int e = 0; e < 4; ++e) vct[(size_t)(16 * dt + 4 * gq + e) * 256] = dead ? (bf16)0 : (bf16)f2bf(o[dt][e]);
        }
    }
    __syncthreads();
}
__device__ __forceinline__ void phase_prep(const Args& P, unsigned char* ws, int z, int l, LAS unsigned char* lds, int gw, int NGW, int lane, int wave) {
    asm volatile("" : "+v"(lane)); lane &= 63; asm volatile("" : "+s"(gw), "+s"(NGW));
    for (int it = 2 * (gw >> 3) + (wave >> 2); it < 512 + (wave >> 2); it += 2 * (NGW >> 3)) prep_cmp16(ws, it < 512 ? it : 511, lds, wave, lane);
    {
        const v4u* src = (const v4u*)(ws + WS_W + WO_POOL); const int t_ = (wave << 6) | lane;
#pragma unroll
        for (int i = 0; i < 16; ++i) { const int idx = t_ + 512 * i, r = idx >> 4, sg = idx & 15; *(LAS v4u*)(lds + r * 256 + ((sg ^ (r & 15)) << 4)) = src[idx]; }
        __syncthreads();
    }
    for (int it = gw; it < M / 16; it += NGW) { prep_kva16(ws, it, lane); prep_pool16(ws, it, lane, lds); }
    __syncthreads();
}
constexpr int DSA_K = DSA_K_V, DSA_S = 32 - DSA_K, DSA_CAP = DSA_CAP_V;
constexpr int DSA_OFF_CNT = 0, DSA_OFF_PC = 3072, DSA_OFF_LIST = DSA_OFF_PC + 32 * 16 * 4, DSA_OFF_V = DSA_OFF_LIST + 16 * 256 * 2, DSA_VB = 64 * NSA_VSTR * 2, DSA_LDS = DSA_OFF_V + 8 * DSA_VB;
#define DSA_FOR_TILES(...) _Pragma("unroll") for (int G8 = 0; G8 < 4; ++G8) { if (G8 < ngrp) { _Pragma("unroll") for (int T8 = 0; T8 < 8; ++T8) { const int T = G8 * 8 + T8; __VA_ARGS__ } } }
__device__ __forceinline__ void cnt_ge(int& c, unsigned u, unsigned cand) { asm volatile("v_cmp_ge_u32_e32 vcc, %1, %2\n\tv_addc_co_u32_e32 %0, vcc, 0, %0, vcc" : "+v"(c) : "v"(u), "v"(cand) : "vcc"); }
__device__ __forceinline__ void cnt_gt(int& c, unsigned u, unsigned cand) { asm volatile("v_cmp_gt_u32_e32 vcc, %1, %2\n\tv_addc_co_u32_e32 %0, vcc, 0, %0, vcc" : "+v"(c) : "v"(u), "v"(cand) : "vcc"); }
__device__ __forceinline__ void cnt_le(int& c, unsigned u, unsigned cand) { asm volatile("v_cmp_le_u32_e32 vcc, %1, %2\n\tv_addc_co_u32_e32 %0, vcc, 0, %0, vcc" : "+v"(c) : "v"(u), "v"(cand) : "vcc"); }
__device__ __forceinline__ int dsa_total(LAS unsigned* cnt, int par, int wave, int j, int gq, int c) {
    c += __shfl_xor(c, 16); c += __shfl_xor(c, 32);
    if (gq == 0) cnt[(par * 8 + wave) * 16 + j] = (unsigned)c;
    __syncthreads();
    int tot = 0;
#pragma unroll
    for (int w = 0; w < 8; ++w) tot += (int)cnt[(par * 8 + w) * 16 + j];
    return tot;
}
__device__ __forceinline__ void dsa_unit(unsigned char* ws, int unit, LAS unsigned char* lds, int tid_in, bf16* yout) {
    int tid = tid_in; asm volatile("" : "+v"(tid));
    const int lane = tid & 63, wave = __builtin_amdgcn_readfirstlane(tid >> 6), j = lane & 15, gq = lane >> 4;
    const int b = unit >> 8, q0 = (unit & 255) * 16, t = q0 + j, row = b * SEQ + t;
    LAS unsigned* cnt = (LAS unsigned*)(lds + DSA_OFF_CNT); LAS unsigned* pc = (LAS unsigned*)(lds + DSA_OFF_PC);
    LAS unsigned short* list = (LAS unsigned short*)(lds + DSA_OFF_LIST);
    const bf16* misc = (const bf16*)(ws + WS_MISC);
    TP_DECL
    if (q0 >= 256) {
        const int ntiles = (q0 >> 4) + 1;
        const int ntl = wave < ntiles ? ((ntiles - 1 - wave) >> 3) + 1 : 0;
        const int ngrp = (ntl + 7) >> 3;
        bf16x8 qf[4][2]; float iw[4];
        { const bf16* iq = (const bf16*)(ws + WS_IQ) + (size_t)row * 256;
#pragma unroll
          for (int h = 0; h < 4; ++h) { iw[h] = 0.5f * bf2f(misc[(size_t)row * 256 + 192 + h]);
#pragma unroll
              for (int ks = 0; ks < 2; ++ks) qf[h][ks] = *(const bf16x8*)(iq + h * 64 + 8 * gq + 32 * ks); } }
        unsigned u[32][4];
#pragma unroll
        for (int T = 0; T < 32; ++T)
#pragma unroll
            for (int e = 0; e < 4; ++e) u[T][e] = 0u;
        const int kb0 = 16 * wave + 4 * gq;
        LAS unsigned char* ring = lds + DSA_OFF_V + wave * 16384;
#define DSA_ISSUE(Ti) do { _Pragma("unroll") for (int i_ = 0; i_ < 2; ++i_) { const int r_ = 8 * i_ + (lane >> 3); int kr_ = 16 * wave + 128 * (Ti) + r_; kr_ = kr_ > SEQ - 1 ? SEQ - 1 : kr_; \
            __builtin_amdgcn_global_load_lds((const unsigned*)(misc + (size_t)(b * SEQ + kr_) * 256 + (((lane & 7) ^ (r_ & 7)) << 3)), (LAS unsigned*)(ring + ((Ti) & 7) * 2048 + i_ * 1024), 16, 0, 0); } } while (0)
        if (ngrp > 0) {
#pragma unroll
            for (int T = 0; T < 8; ++T) DSA_ISSUE(T);
        }
        DSA_FOR_TILES(
            asm volatile("s_waitcnt vmcnt(14)" ::: "memory");
            const LAS unsigned char* tp = ring + (T & 7) * 2048 + j * 128;
            const bf16x8 kf0 = *(const LAS bf16x8*)(tp + ((gq ^ (j & 7)) << 4)); const bf16x8 kf1 = *(const LAS bf16x8*)(tp + (((gq + 4) ^ (j & 7)) << 4));
            asm volatile("s_waitcnt lgkmcnt(0)" ::: "memory");
            DSA_ISSUE(T + 8);
            float sc[4] = {0.f, 0.f, 0.f, 0.f};
            _Pragma("unroll") for (int h = 0; h < 4; ++h) {
                f32x4v a = {0.f, 0.f, 0.f, 0.f};
                a = __builtin_amdgcn_mfma_f32_16x16x32_bf16(kf0, qf[h][0], a, 0, 0, 0);
                a = __builtin_amdgcn_mfma_f32_16x16x32_bf16(kf1, qf[h][1], a, 0, 0, 0);
                _Pragma("unroll") for (int e = 0; e < 4; ++e) sc[e] += iw[h] * fmaxf(a[e], 0.f);
                asm volatile("" : "+v"(sc[0]), "+v"(sc[1]), "+v"(sc[2]), "+v"(sc[3]));
            }
            _Pragma("unroll") for (int e = 0; e < 4; ++e) { unsigned x = f2o(sc[e]); asm volatile("" : "+v"(x)); u[T][e] = (kb0 + 128 * T + e <= t) ? x : 0u; }
        )
        asm volatile("s_waitcnt vmcnt(0)" ::: "memory");
#undef DSA_ISSUE
        TP_MARK(0);
        unsigned prefix = 0u; bool exact = false; int par = 0; int cab = 0;
        LAS unsigned* lcnt = (LAS unsigned*)(lds + DSA_OFF_V); LAS unsigned* lcab = lcnt + 16; LAS unsigned* lvst = lcnt + 32; LAS unsigned* lexf = lcnt + 48; LAS unsigned* llist = lcnt + 64;
        if (tid < 16) lcnt[tid] = 0u;
#pragma unroll 1
        for (int bit = 31; bit >= DSA_S; --bit) {
            const unsigned cand = prefix | (1u << bit); int c0 = 0, c1 = 0;
            DSA_FOR_TILES(cnt_ge(c0, u[T][0], cand); cnt_ge(c1, u[T][1], cand); cnt_ge(c0, u[T][2], cand); cnt_ge(c1, u[T][3], cand);)
            const int tot = dsa_total(cnt, par, wave, j, gq, c0 + c1); par ^= 1;
            if (tot >= 256) prefix = cand; else cab = tot;
        }
        TP_MARK(1);
        { const unsigned ptop = prefix >> DSA_S;
          DSA_FOR_TILES(unsigned pos_[4]; bool cd_[4];
              _Pragma("unroll") for (int e = 0; e < 4; ++e) { const unsigned x = u[T][e]; cd_[e] = x != 0u && (x >> DSA_S) == ptop; pos_[e] = DSA_CAP; }
              _Pragma("unroll") for (int e = 0; e < 4; ++e) if (cd_[e]) pos_[e] = __hip_atomic_fetch_add(&lcnt[j], 1u, __ATOMIC_RELAXED, __HIP_MEMORY_SCOPE_WORKGROUP);
              _Pragma("unroll") for (int e = 0; e < 4; ++e) if (pos_[e] < DSA_CAP) llist[j * DSA_CAP + pos_[e]] = u[T][e];)
          if (wave == 0 && gq == 0) lcab[j] = (unsigned)cab; }
        __syncthreads();
        const bool ovf = __any(lcnt[j] > (unsigned)DSA_CAP);
        if (!ovf) {
#pragma unroll 1
            for (int qq = 0; qq < 2; ++qq) {
                const int q = 2 * wave + qq; const int n = (int)lcnt[q]; const int r = 256 - (int)lcab[q];
                unsigned ev[DSA_CAP / 64];
#pragma unroll
                for (int i = 0; i < DSA_CAP / 64; ++i) ev[i] = (lane + 64 * i < n) ? llist[q * DSA_CAP + lane + 64 * i] : 0u;
                unsigned p2 = (unsigned)__shfl((int)prefix, q);
#pragma unroll 1
                for (int bit = DSA_S - 1; bit >= 0; --bit) {
                    const unsigned cand = p2 | (1u << bit); int c = 0;
#pragma unroll
                    for (int i = 0; i < DSA_CAP / 64; ++i) c += __popcll(__ballot(ev[i] >= cand));
                    if (c >= r) p2 = cand;
                }
                int cf = 0;
#pragma unroll
                for (int i = 0; i < DSA_CAP / 64; ++i) cf += __popcll(__ballot(ev[i] >= p2));
                if (lane == 0) { lvst[q] = p2; lexf[q] = (cf == r) ? 1u : 0u; }
            }
            __syncthreads();
            prefix = lvst[j]; exact = lexf[j] != 0u;
        } else {
#pragma unroll 1
            for (int bit = DSA_S - 1; bit >= 0; --bit) {
                const unsigned cand = prefix | (1u << bit); int c0 = 0, c1 = 0;
                DSA_FOR_TILES(cnt_ge(c0, u[T][0], cand); cnt_ge(c1, u[T][1], cand); cnt_ge(c0, u[T][2], cand); cnt_ge(c1, u[T][3], cand);)
                const int tot = dsa_total(cnt, par, wave, j, gq, c0 + c1); par ^= 1;
                if (!exact && tot >= 256) { prefix = cand; exact = (tot == 256); }
            }
        }
        TP_MARK(2);
        const bool alle = __all(exact);
        unsigned kp = 0u;
        if (!alle) {
        DSA_FOR_TILES(_Pragma("unroll") for (int e = 0; e < 4; ++e) { const unsigned x = u[T][e]; u[T][e] = (x > prefix || (exact && x == prefix)) ? 0u : (x == prefix ? (unsigned)(1 + kb0 + 128 * T + e) : 0xFFFFFFFFu); })
            __syncthreads();
#pragma unroll 1
            for (int bit = 11; bit >= 0; --bit) {
                const unsigned cand = kp | (1u << bit); int c0 = 0, c1 = 0;
                DSA_FOR_TILES(cnt_le(c0, u[T][0], cand); cnt_le(c1, u[T][1], cand); cnt_le(c0, u[T][2], cand); cnt_le(c1, u[T][3], cand);)
                const int tot = dsa_total(cnt, par, wave, j, gq, c0 + c1); par ^= 1;
                if (tot <= 255) kp = cand;
            }
        }
        const unsigned kp1 = kp + 1u;
        int ns0 = 0, ns1 = 0;
        if (alle) { DSA_FOR_TILES(cnt_ge(ns0, u[T][0], prefix); cnt_ge(ns1, u[T][1], prefix); cnt_ge(ns0, u[T][2], prefix); cnt_ge(ns1, u[T][3], prefix);) }
        else { DSA_FOR_TILES(cnt_le(ns0, u[T][0], kp1); cnt_le(ns1, u[T][1], kp1); cnt_le(ns0, u[T][2], kp1); cnt_le(ns1, u[T][3], kp1);) }
        pc[(wave * 4 + gq) * 16 + j] = (unsigned)(ns0 + ns1);
        __syncthreads();
        int base = 0;
        { const int me = wave * 4 + gq;
#pragma unroll
          for (int i = 0; i < 31; ++i) { const int v = (int)pc[i * 16 + j]; base += (i < me) ? v : 0; } }
        if (alle) { DSA_FOR_TILES(_Pragma("unroll") for (int e = 0; e < 4; ++e) { if (u[T][e] >= prefix) { if (base < 256) list[j * 256 + base] = (unsigned short)(kb0 + 128 * T + e); ++base; } }) }
        else { DSA_FOR_TILES(_Pragma("unroll") for (int e = 0; e < 4; ++e) { if (u[T][e] <= kp1) { if (base < 256) list[j * 256 + base] = (unsigned short)(kb0 + 128 * T + e); ++base; } }) }
    } else {
        for (int i = tid; i < 16 * 256; i += 512) list[i] = (unsigned short)(i & 255);
    }
    __syncthreads();
    TP_MARK(3);
    const bf16* kva = (const bf16*)(ws + WS_KVA);
    bf16* qa = (bf16*)(ws + WS_QA);
    LAS unsigned char* Vb = lds + DSA_OFF_V + wave * DSA_VB;
    const int tq2[2] = {q0 + 2 * wave, q0 + 2 * wave + 1};
#define DSA_KEY(st_, slot_) ((int)list[(2 * wave + ((st_) >> 2)) * 256 + (((slot_) < nselq[(st_) >> 2]) ? (slot_) : 0)])
#define DSA_LOADK(buf_, st_) do { _Pragma("unroll") for (int kt_ = 0; kt_ < 4; ++kt_) { const bf16* kp_ = kva + (size_t)(b * SEQ + DSA_KEY(st_, 64 * ((st_) & 3) + 16 * kt_ + j)) * 128 + 8 * gq; \
        buf_[kt_][0] = *(const bf16x8*)kp_; buf_[kt_][1] = *(const bf16x8*)(kp_ + 32); } } while (0)
#define DSA_LOADV(st_) do { _Pragma("unroll") for (int i_ = 0; i_ < 8; ++i_) vr[i_] = *(const v4u*)(kva + (size_t)(b * SEQ + DSA_KEY(st_, 64 * ((st_) & 3) + 8 * i_ + (lane >> 3))) * 128 + 64 + (lane & 7) * 8); } while (0)
    const int nselq[2] = {tq2[0] + 1 < 256 ? tq2[0] + 1 : 256, tq2[1] + 1 < 256 ? tq2[1] + 1 : 256};
    bf16x8 kfA[4][2], kfB[4][2]; v4u vr[8];
    bf16x8 qf[2]; float mrow = NEGF, lrow = 0.f; f32x4v o[4];
    DSA_LOADK(kfA, 0); DSA_LOADV(0);
#define DSA_STEP(st_, cur_, nxt_) do { \
        if (((st_) & 3) == 0) { const int rowq_ = b * SEQ + tq2[(st_) >> 2]; \
            _Pragma("unroll") for (int ks_ = 0; ks_ < 2; ++ks_) { qf[ks_] = (bf16x8){0, 0, 0, 0, 0, 0, 0, 0}; if (j < 8) qf[ks_] = *(const bf16x8*)(qa + (size_t)rowq_ * 512 + j * 64 + 8 * gq + 32 * ks_); } \
            mrow = NEGF; lrow = 0.f; _Pragma("unroll") for (int dt_ = 0; dt_ < 4; ++dt_) o[dt_] = (f32x4v){0.f, 0.f, 0.f, 0.f}; } \
        _Pragma("unroll") for (int i_ = 0; i_ < 8; ++i_) *(LAS v4u*)(Vb + ((8 * i_ + (lane >> 3)) * NSA_VSTR + (lane & 7) * 8) * 2) = vr[i_]; \
        if ((st_) < 7) { DSA_LOADK(nxt_, (st_) + 1); DSA_LOADV((st_) + 1); } \
        f32x4v s_[4]; float bm_ = NEGF; \
        _Pragma("unroll") for (int kt_ = 0; kt_ < 4; ++kt_) { f32x4v a_ = {0.f, 0.f, 0.f, 0.f}; \
            a_ = __builtin_amdgcn_mfma_f32_16x16x32_bf16(cur_[kt_][0], qf[0], a_, 0, 0, 0); a_ = __builtin_amdgcn_mfma_f32_16x16x32_bf16(cur_[kt_][1], qf[1], a_, 0, 0, 0); \
            _Pragma("unroll") for (int e_ = 0; e_ < 4; ++e_) { const float v_ = (64 * ((st_) & 3) + 16 * kt_ + 4 * gq + e_ < nselq[(st_) >> 2]) ? a_[e_] : NEGF; a_[e_] = v_; bm_ = fmaxf(bm_, v_); } s_[kt_] = a_; } \
        bm_ = xmax16(bm_); \
        { const float mnew_ = fmaxf(mrow, bm_), alpha_ = __builtin_amdgcn_exp2f(mrow - mnew_); mrow = mnew_; float ps_ = 0.f; \
          _Pragma("unroll") for (int kt_ = 0; kt_ < 4; ++kt_) _Pragma("unroll") for (int e_ = 0; e_ < 4; ++e_) { const float p_ = __builtin_amdgcn_exp2f(s_[kt_][e_] - mnew_); s_[kt_][e_] = p_; ps_ += p_; } \
          lrow = lrow * alpha_ + ps_; _Pragma("unroll") for (int dt_ = 0; dt_ < 4; ++dt_) o[dt_] *= alpha_; } \
        WAVE_LDS_SYNC(); \
        _Pragma("unroll") for (int kk_ = 0; kk_ < 2; ++kk_) { \
            const bf16x8 pf_ = pack8(s_[2 * kk_][0], s_[2 * kk_][1], s_[2 * kk_][2], s_[2 * kk_][3], s_[2 * kk_ + 1][0], s_[2 * kk_ + 1][1], s_[2 * kk_ + 1][2], s_[2 * kk_ + 1][3]); \
            _Pragma("unroll") for (int dt_ = 0; dt_ < 4; ++dt_) { const LAS unsigned char* va_ = Vb + ((32 * kk_ + 4 * gq + (j >> 2)) * NSA_VSTR + 16 * dt_ + 4 * (j & 3)) * 2; \
                o[dt_] = __builtin_amdgcn_mfma_f32_16x16x32_bf16(cat4(tr16(va_), tr16(va_ + 16 * NSA_VSTR * 2)), pf_, o[dt_], 0, 0, 0); } } \
        WAVE_LDS_SYNC(); \
        if (((st_) & 3) == 3) { const float inv_ = __builtin_amdgcn_rcpf(xsum16(lrow)); const int rowq_ = b * SEQ + tq2[(st_) >> 2]; \
            if (j < 8) { _Pragma("unroll") for (int dt_ = 0; dt_ < 4; ++dt_) { uint2 w_; w_.x = pg8::cvt_pk_bf16(o[dt_][0] * inv_, o[dt_][1] * inv_); w_.y = pg8::cvt_pk_bf16(o[dt_][2] * inv_, o[dt_][3] * inv_); \
                *(uint2*)(yout + (size_t)rowq_ * 512 + j * 64 + 16 * dt_ + 4 * gq) = w_; } } } \
    } while (0)
    DSA_STEP(0, kfA, kfB); DSA_STEP(1, kfB, kfA); DSA_STEP(2, kfA, kfB); DSA_STEP(3, kfB, kfA);
    DSA_STEP(4, kfA, kfB); DSA_STEP(5, kfB, kfA); DSA_STEP(6, kfA, kfB); DSA_STEP(7, kfB, kfA);
#undef DSA_STEP
#undef DSA_LOADK
#undef DSA_LOADV
#undef DSA_KEY
    __syncthreads();
    TP_MARK(4);
}
__device__ __forceinline__ void phase_mixers(const Args& P, unsigned char* ws, int z, LAS unsigned char* lds, int gw, int NGW, int lane, int wave, int bid, int G) {
    asm volatile("" : "+v"(lane)); lane &= 63; asm volatile("" : "+s"(gw), "+s"(NGW));
#if PROBE == 3
    { LAS unsigned char* wl = lds + wave * 18944; for (int it2 = gw; it2 < 2 * M; it2 += NGW) nsa_query(P, ws, z, it2 >> 1, it2 & 1, wl, lane); }
#else
    for (int k = 0; bid + G * k < 1024; ++k) {
        const int u = bid + G * k, c0 = u & 63, unit = (u & ~63) | ((k & 1) ? 63 - c0 : c0);
#if DUP == 7
        nsa_unit(ws, unit, lds, (wave << 6) | lane_id_v(), (bf16*)(ws + WS_BU));
#endif
        nsa_unit(ws, unit, lds, (wave << 6) | lane_id_v(), (bf16*)(ws + WS_QC));
    }
#endif
    for (int k = 0; bid + G * k < 2048; ++k) {
        const int u = bid + G * k, c0 = u & 255, unit = (u & ~255) | ((k & 1) ? 255 - c0 : c0);
#if DUP == 6
        dsa_unit(ws, unit, lds, (wave << 6) | lane_id_v(), (bf16*)(ws + WS_BU));
#endif
        dsa_unit(ws, unit, lds, (wave << 6) | lane_id_v(), (bf16*)(ws + WS_QA));
    }
}
__global__ void __launch_bounds__(NWAVES * 64, 2) fwd_kernel(Args args) {
    extern __shared__ __attribute__((aligned(16))) unsigned char lds_raw[];
    LAS unsigned char* lds = (LAS unsigned char*)lds_raw;
    const int wave = __builtin_amdgcn_readfirstlane((int)threadIdx.x >> 6);
#define TIDX ((wave << 6) | lane_id_v())
#define tid TIDX
#define lane TIDX
    const int G = gridDim.x, bid = blockIdx.x;
    const int gw = bid * NWAVES + wave, NGW = G * NWAVES;
    const int lo = args.ph_lo, hi = args.ph_hi;
    const Args& P = args;
    int z = 0; asm volatile("" : "+s"(z));
    unsigned char* ws = args.ws + z;
    volatile LAS unsigned* MISCW = (volatile LAS unsigned*)(lds + LDSCTL_OFF);
    if (tid < 64) MISCW[tid] = 0u;
    __syncthreads();
    XcdBarrier bar; bar.bar = (unsigned*)(ws + WS_CTL) + 4096; bar.x = 0; bar.st = nullptr;
    if (hi - lo > 1) bar = xcd_barrier_post((unsigned*)(ws + WS_CTL) + 4096, MISCW + 8);
#define RUN(k) (lo <= (k) && (k) < hi)
#define SEAM(k) do { if ((k) + 1 < hi) { XcdBarrier b2_ = bar; asm volatile("" : "+s"(b2_.bar), "+s"(b2_.x)); xcd_barrier(b2_); if (DUP == 13) xcd_barrier(b2_); } else { VM_WAIT(); __syncthreads(); } } while (0)


    if (RUN(0)) { phase_rope(P, ws, z, bid * (NWAVES * 64) + tid, G * NWAVES * 64);
        { int ln_ = TIDX; asm volatile("" : "+v"(ln_)); ln_ &= 63;
          for (int m = gw; m < M; m += NGW) stat_row_bf16(P.in[0 + z] + (size_t)m * DM, (bf16*)(ws + WS_XN) + (size_t)m * DM, (float*)(ws + WS_SSQ) + (size_t)m * 16, ln_); }
        SEAM(0); }
#define RS_PREPASS(Sref) do { const float* ssq_ = (const float*)(ws + WS_SSQ); LAS float* rsl_ = (LAS float*)(lds + RS_OFF); const int t_ = TIDX; pg8::Unit u_; \
        for (int i_ = 0; (Sref).next(i_, u_); ++i_) { const f32x4* p_ = (const f32x4*)(ssq_ + (size_t)(u_.pm * 256 + (t_ >> 1)) * 16 + (t_ & 1) * 8); const f32x4 a_ = p_[0], b_ = p_[1]; \
            float s_ = (a_.x + a_.y) + (a_.z + a_.w) + (b_.x + b_.y) + (b_.z + b_.w); s_ += __shfl_xor(s_, 1); if ((t_ & 1) == 0) rsl_[i_ * 256 + (t_ >> 1)] = 1.0f / sqrtf(s_ * (1.f / DM) + EPS); } \
        __syncthreads(); } while (0)

    for (int it = 0; it < 2 * DEPTH; ++it) {
        const int l = it >> 1, second = it & 1, pb = 1 + l * NPL + (second ? 7 : 0);
        asm volatile("" : "+s"(z));
        ws = args.ws + z;
        bf16* const XN = (bf16*)(ws + WS_XN);
        bf16* const HB = (bf16*)(ws + WS_H);
        bf16* const MG = (bf16*)(ws + WS_MG);
        bf16* const GB = (bf16*)(ws + WS_G);
        unsigned char* const wb = ws + WS_W;
        float* const OUT = P.out + z;
        const float* xin = (it == 0) ? P.in[0 + z] : (const float*)OUT;
        if (!second && RUN(pb)) { phase_convert(P, ws, z, l, lds, gw, NGW, lane, wave); SEAM(pb); }
        if (RUN(pb + 1)) {
            pg8::Gemm g{XN, (const bf16*)(wb + (second ? WO_GU2 : WO_GU1)), M, 2 * FF, DM}; pg8::StaticOrder S; S.init(M, 2 * FF, G, bid + z);
            pg8::EpiSwiglu E{HB, FF, (const LAS float*)(lds + RS_OFF)};
            RS_PREPASS(S);
#if !defined(SITE_MASK) || ((SITE_MASK >> 0) & 1)
            pg8::gemm_phase<pg8::EpiSwiglu, pg8::StaticOrder, ALIGN_UP, true>(lds, g, S, E, TIDX);
#if DUP == 3
            pg8::gemm_phase<pg8::EpiSwiglu, pg8::StaticOrder, ALIGN_UP, true>(lds, g, S, E, TIDX);
#endif
#endif
            SEAM(pb + 1);
        }
        if (RUN(pb + 2)) {
            pg8::Gemm g{HB, (const bf16*)(wb + (second ? WO_D2 : WO_D1)), M, DM, FF}; pg8::StaticOrder S; S.init(M, DM, G, bid + z);
            pg8::EpiResid E{xin, OUT, 0.5f, XN, (float*)(ws + WS_SSQ)};
#if !defined(SITE_MASK) || ((SITE_MASK >> 1) & 1)
            pg8::gemm_phase<pg8::EpiResid, pg8::StaticOrder, true, true>(lds, g, S, E, TIDX);
#endif
            SEAM(pb + 2);
        }
        if (second) continue;
        const int pm = 1 + l * NPL + 2;
        if (RUN(pm + 1)) {
            pg8::Gemm g{XN, (const bf16*)(wb + WO_IN), M, NINP, DM}; pg8::StaticOrder S; S.init(M, NINP, G, bid + z);
            pg8::EpiWin E{(bf16*)(ws + WS_QA), (bf16*)(ws + WS_QC), (bf16*)(ws + WS_IQ), (bf16*)(ws + WS_MISC), (bf16*)(ws + WS_KVC), (bf16*)(ws + WS_KVS), (bf16*)(ws + WS_KVW), (bf16*)(ws + WS_BU), GB,
                          (const float*)(ws + WS_ROPE), (const LAS float*)(lds + RS_OFF)};
            RS_PREPASS(S);
#if !defined(SITE_MASK) || ((SITE_MASK >> 2) & 1)
            pg8::gemm_phase<pg8::EpiWin, pg8::StaticOrder, ALIGN_WIN, true>(lds, g, S, E, TIDX);
#if DUP == 4
            pg8::gemm_phase<pg8::EpiWin, pg8::StaticOrder, ALIGN_WIN, true>(lds, g, S, E, TIDX);
#endif
#endif
            SEAM(pm + 1);
        }
        #ifndef NO_PREP
        if (RUN(pm + 2)) { phase_prep(P, ws, z, l, lds, gw, NGW, lane, wave);
#if DUP == 1
            { XcdBarrier b2_ = bar; asm volatile("" : "+s"(b2_.bar), "+s"(b2_.x)); xcd_barrier(b2_); } phase_prep(P, ws, z, l, lds, gw, NGW, lane, wave);
#endif
            SEAM(pm + 2); }
#endif
        #ifndef NO_MIX
        if (RUN(pm + 3)) { phase_mixers(P, ws, z, lds, gw, NGW, lane, wave, bid, G); SEAM(pm + 3); }
#endif
        if (RUN(pm + 4)) {
#if DUP == 5
          for (int rep_ = 0; rep_ < 2; ++rep_) {
#endif
            pg8::StaticOrder S; S.init(M, DM, G, bid + z);
            { pg8::Gemm g{(const bf16*)(ws + WS_QA), (const bf16*)(wb + WO_PA), M, DM, 512}; pg8::EpiProj<0> E{MG, GB, 0};
#if !defined(SITE_MASK) || ((SITE_MASK >> 3) & 1)
              pg8::gemm_phase<pg8::EpiProj<0>, pg8::StaticOrder, true, true>(lds, g, S, E, TIDX);
#endif
            }
            { pg8::Gemm g{(const bf16*)(ws + WS_YB), (const bf16*)(wb + WO_PB), M, DM, 512}; pg8::EpiProj<1> E{MG, GB, 1024};
#if !defined(SITE_MASK) || ((SITE_MASK >> 4) & 1)
              pg8::gemm_phase<pg8::EpiProj<1>, pg8::StaticOrder, true, true>(lds, g, S, E, TIDX);
#endif
            }
            { pg8::Gemm g{(const bf16*)(ws + WS_QC), (const bf16*)(wb + WO_PC), M, DM, 512}; pg8::EpiProj<1> E{MG, GB, 2048};
#if !defined(SITE_MASK) || ((SITE_MASK >> 5) & 1)
              pg8::gemm_phase<pg8::EpiProj<1>, pg8::StaticOrder, true, true>(lds, g, S, E, TIDX);
#endif
            }
#if DUP == 5
          }
#endif
            SEAM(pm + 4);
        }
        if (RUN(pm + 5)) {
            pg8::Gemm g{MG, (const bf16*)(wb + WO_OUT), M, DM, DM}; pg8::StaticOrder S; S.init(M, DM, G, bid + z);
            pg8::EpiResid E{OUT, OUT, 1.0f, XN, (float*)(ws + WS_SSQ)};
#if !defined(SITE_MASK) || ((SITE_MASK >> 6) & 1)
            pg8::gemm_phase<pg8::EpiResid, pg8::StaticOrder, true, true>(lds, g, S, E, TIDX);
#endif
            SEAM(pm + 5);
        }
    }
    if (RUN(NPH - 1)) { asm volatile("" : "+s"(z)); int ln_ = TIDX; asm volatile("" : "+v"(ln_)); ln_ &= 63; float* o_ = P.out + z; float tps_ = 1.0f;
#if TPROBE
        { const unsigned long long* sl_ = (const unsigned long long*)(P.ws + z + 32768); double a_ = 0., b_ = 0.; for (int k = 0; k < 16; ++k) { const double v_ = (double)__hip_atomic_load(sl_ + k, __ATOMIC_RELAXED, __HIP_MEMORY_SCOPE_AGENT); if ((TP_A >> k) & 1) a_ += v_; if ((TP_B >> k) & 1) b_ += v_; } tps_ = 1.0f + (float)(a_ / b_) * TP_SCALE; }
#endif
        for (int m = gw; m < M; m += NGW) norm_row_f32(o_ + (size_t)m * DM, P.in[23 + z], ln_, tps_);
#if TPROBE
        if (gw == 0 && ln_ == 0) { const unsigned long long* sl_ = (const unsigned long long*)(P.ws + z + 32768); double c_ = 0., d_ = 0.; for (int k = 0; k < 16; ++k) { const double v_ = (double)__hip_atomic_load(sl_ + k, __ATOMIC_RELAXED, __HIP_MEMORY_SCOPE_AGENT); if ((TP_C >> k) & 1) c_ += v_; if ((TP_D >> k) & 1) d_ += v_; } o_[0] = 1000.0f * (float)(c_ / d_) * TP_SCALE2; }
#endif
    }
#undef RUN
#undef tid
#undef TIDX
#undef lane
#undef SEAM
}

extern "C" void kernel_launch(void* const* d_in, const int* in_sizes, int n_in, void* d_out, int out_size, void* d_ws, size_t ws_size, hipStream_t stream) {
    static int grid = 0;
    if (grid == 0) {
        if (n_in != 24 || out_size != M * DM || ws_size < WS_END) { fprintf(stderr, "kernel_launch: unexpected shapes (n_in %d out %d ws %zu)\n", n_in, out_size, ws_size); grid = -1; return; }
        int dev = 0, cus = 0, per_cu = 0;
        if (hipGetDevice(&dev) != hipSuccess || hipDeviceGetAttribute(&cus, hipDeviceAttributeMultiprocessorCount, dev) != hipSuccess) { grid = -1; return; }
        if (hipFuncSetAttribute((const void*)fwd_kernel, hipFuncAttributeMaxDynamicSharedMemorySize, LDS_BYTES) != hipSuccess) { fprintf(stderr, "kernel_launch: hipFuncSetAttribute failed\n"); grid = -1; return; }
        if (hipOccupancyMaxActiveBlocksPerMultiprocessor(&per_cu, (const void*)fwd_kernel, NWAVES * 64, LDS_BYTES) != hipSuccess || per_cu < 1) { fprintf(stderr, "kernel_launch: occupancy query says %d\n", per_cu); }
        (void)hipGetLastError();
        grid = cus;
    }
    if (grid < 0) return;
    (void)hipMemsetAsync((char*)d_ws + WS_CTL, 0, CTL_ZERO_BYTES, stream);
    Args a{};
    for (int i = 0; i < 24; ++i) a.in[i] = (const float*)d_in[i];
    a.out = (float*)d_out; a.ws = (unsigned char*)d_ws;
#if MK_ONE_LAUNCH
    a.ph_lo = 0; a.ph_hi = NPH;
    hipLaunchKernelGGL(fwd_kernel, dim3(grid), dim3(NWAVES * 64), LDS_BYTES, stream, a);
#else
    for (int ph = 0; ph < NPH; ++ph) { a.ph_lo = ph; a.ph_hi = ph + 1; hipLaunchKernelGGL(fwd_kernel, dim3(grid), dim3(NWAVES * 64), LDS_BYTES, stream, a); }
#endif
}
```

```cpp
#include <hip/hip_runtime.h>
#include <cstdio>
#include <cstdint>
#define PROBE 0
#define PROBE_GAIN 10.0f
#define TOP8_RANK 1
#define PROBE_ROWTHR 0.01f
#define PROBE_ROWCOND 1
#define PROBE_BR -1
#define FIXHOM 0
#define DUP 0
#define TPROBE 0
#define TP_A 1
#define TP_B 1
#define TP_SCALE 1.0f
#define TP_C 1
#define TP_D 1
#define TP_SCALE2 1.0f
#define POOLDBG 0
#define YB_SPARE 0
#define ALIGN_UP true
#define ALIGN_WIN true
#define DSA_CAP_V 512
#define DSA_K_V 13
#ifndef MK_ONE_LAUNCH
#define MK_ONE_LAUNCH 1
#endif
namespace pg8 {
#define PG8_LAS __attribute__((address_space(3)))
typedef unsigned short bf16_t;
typedef short bf16x8 __attribute__((ext_vector_type(8)));
typedef float f32x4 __attribute__((ext_vector_type(4)));
typedef unsigned u32x4 __attribute__((ext_vector_type(4)));
constexpr int BM = 256, BK = 64, HALF = 128, HTB = HALF * BK * 2  , STAGE_BYTES = 8 * HTB, NXCD = 8, WGM = 8;

__host__ __device__ __forceinline__ int lds_byte(int r, int c) { const int st = (r >> 4) * 2 + (c >> 5), rr = r & 15, cc = c & 31, ob = rr * 64 + cc * 2; return st * 1024 + (ob ^ (((ob >> 9) & 1) << 5)); }
__host__ __device__ __forceinline__ void stage_rc(int b, int& R, int& C) { const int st = b / 1024, sb = b % 1024, swz = sb ^ (((sb >> 9) & 1) << 5); R = (st >> 1) * 16 + swz / 64; C = (st & 1) * 32 + (swz % 64) / 2; }
__host__ __device__ __forceinline__ int perm32(int rho) { const int n = rho >> 4, i = rho & 15; return 8 * (i >> 2) + 4 * n + (i & 3); }

struct Unit { int pm, pn, ord; };
struct Gemm { const bf16_t* A; const bf16_t* Bt; int M, N, K; };

struct StaticOrder {
    int nM, nN, nwg, G, c;
    __host__ __device__ __forceinline__ void init(int M, int N, int G_, int c_) { nM = M / BM; nN = N / BM; nwg = nM * nN; G = G_; c = c_; }
    __host__ __device__ __forceinline__ bool next(int i, Unit& u) const {
        const long L = (long)i * G + c; if (L >= nwg) return false;
        int wgid = (int)L; { const int q = nwg / NXCD, r = nwg % NXCD, xcd = wgid % NXCD, off = wgid / NXCD; wgid = (xcd < r ? xcd * (q + 1) : r * (q + 1) + (xcd - r) * q) + off; }
        const int nig = WGM * nN, gid = wgid / nig, fm = gid * WGM, gsz = (nM - fm) < WGM ? (nM - fm) : WGM;
        u.pm = fm + ((wgid % nig) % gsz); u.pn = (wgid % nig) / gsz; u.ord = i; return true;
    }
    __device__ __forceinline__ void a_ready(const Unit&) const {}
    __device__ __forceinline__ void done(const Unit&) const {}
};

__device__ __forceinline__ unsigned cvt_pk_bf16(float lo, float hi) { unsigned r; asm volatile("v_cvt_pk_bf16_f32 %0, %1, %2" : "=v"(r) : "v"(lo), "v"(hi)); return r; }
__device__ __forceinline__ float bflo(unsigned w) { return __uint_as_float(w << 16); }
__device__ __forceinline__ float bfhi(unsigned w) { return __uint_as_float(w & 0xffff0000u); }
__device__ __forceinline__ float fast_sigmoid(float x) { return __builtin_amdgcn_rcpf(1.0f + __expf(-x)); }

struct EpiSwiglu {
    static constexpr bool PERM = true, AFTER_DRAIN = false;
    bf16_t* H; int ldh; const PG8_LAS float* rs;
    __device__ __forceinline__ void operator()(const f32x4 (&acc)[2][2][4][2], const Unit& u, int wr, int wc, int fr, int fq) const {
        const int row0 = u.pm * BM + wr * 64 + fr, col0 = u.pn * HALF + wc * 32 + 8 * fq;
#pragma unroll
        for (int ai = 0; ai < 2; ++ai)
#pragma unroll
            for (int m = 0; m < 4; ++m) {
                bf16_t* rowp = H + (size_t)(row0 + ai * HALF + m * 16) * ldh + col0;
                const float r = rs[u.ord * 256 + wr * 64 + fr + ai * HALF + m * 16];
                float o[8];
#pragma unroll
                for (int n = 0; n < 2; ++n)
#pragma unroll
                    for (int e = 0; e < 4; ++e) { const float g = acc[ai][0][m][n][e] * r, up = acc[ai][1][m][n][e] * r; o[n * 4 + e] = g * fast_sigmoid(g) * up; }
                u32x4 w; w.x = cvt_pk_bf16(o[0], o[1]); w.y = cvt_pk_bf16(o[2], o[3]); w.z = cvt_pk_bf16(o[4], o[5]); w.w = cvt_pk_bf16(o[6], o[7]);
                *(u32x4*)rowp = w;
            }
    }
};
struct EpiResid {
    static constexpr bool PERM = true, AFTER_DRAIN = false;
    const float* base; float* out; float s; bf16_t* xb; float* ssq;
    __device__ __forceinline__ void operator()(const f32x4 (&acc)[2][2][4][2], const Unit& u, int wr, int wc, int fr, int fq) const {
        const int row0 = u.pm * BM + wr * 64 + fr, col0 = u.pn * BM + wc * 32 + 8 * fq;
#pragma unroll
        for (int ai = 0; ai < 2; ++ai)
#pragma unroll
            for (int m = 0; m < 4; ++m) {
                const size_t off = (size_t)(row0 + ai * HALF + m * 16) * 1024 + col0;
                float q = 0.f;
#pragma unroll
                for (int bj = 0; bj < 2; ++bj) {
                    const f32x4 b0 = *(const f32x4*)(base + off + bj * HALF), b1 = *(const f32x4*)(base + off + bj * HALF + 4);
                    const f32x4 x0 = b0 + acc[ai][bj][m][0] * s, x1 = b1 + acc[ai][bj][m][1] * s;
                    *(f32x4*)(out + off + bj * HALF) = x0; *(f32x4*)(out + off + bj * HALF + 4) = x1;
                    q += (x0[0] * x0[0] + x0[1] * x0[1]) + (x0[2] * x0[2] + x0[3] * x0[3]) + (x1[0] * x1[0] + x1[1] * x1[1]) + (x1[2] * x1[2] + x1[3] * x1[3]);
                    u32x4 w; w.x = cvt_pk_bf16(x0[0], x0[1]); w.y = cvt_pk_bf16(x0[2], x0[3]); w.z = cvt_pk_bf16(x1[0], x1[1]); w.w = cvt_pk_bf16(x1[2], x1[3]);
                    *(u32x4*)(xb + off + bj * HALF) = w;
                }
                q += __shfl_xor(q, 16); q += __shfl_xor(q, 32);
                if (fq == 0) ssq[(size_t)(row0 + ai * HALF + m * 16) * 16 + u.pn * 4 + wc] = q;
            }
    }
};
template <int MODE> struct EpiProj {
    static constexpr bool PERM = true, AFTER_DRAIN = false;
    bf16_t* MG; const bf16_t* G; int gofs;
    __device__ __forceinline__ void operator()(const f32x4 (&acc)[2][2][4][2], const Unit& u, int wr, int wc, int fr, int fq) const {
        const int row0 = u.pm * BM + wr * 64 + fr, col0 = u.pn * BM + wc * 32 + 8 * fq;
#pragma unroll
        for (int ai = 0; ai < 2; ++ai)
#pragma unroll
            for (int m = 0; m < 4; ++m) {
                const size_t row = (size_t)(row0 + ai * HALF + m * 16);
#pragma unroll
                for (int bj = 0; bj < 2; ++bj) {
                    const u32x4 gv = *(const u32x4*)(G + row * 3072 + gofs + col0 + bj * HALF);
                    bf16_t* mp = MG + row * 1024 + col0 + bj * HALF;
                    const f32x4 a0 = acc[ai][bj][m][0], a1 = acc[ai][bj][m][1];
                    float o[8] = {bflo(gv.x) * a0[0], bfhi(gv.x) * a0[1], bflo(gv.y) * a0[2], bfhi(gv.y) * a0[3], bflo(gv.z) * a1[0], bfhi(gv.z) * a1[1], bflo(gv.w) * a1[2], bfhi(gv.w) * a1[3]};
                    if (MODE) { const u32x4 ov = *(const u32x4*)mp; o[0] += bflo(ov.x); o[1] += bfhi(ov.x); o[2] += bflo(ov.y); o[3] += bfhi(ov.y); o[4] += bflo(ov.z); o[5] += bfhi(ov.z); o[6] += bflo(ov.w); o[7] += bfhi(ov.w); }
                    u32x4 w; w.x = cvt_pk_bf16(o[0], o[1]); w.y = cvt_pk_bf16(o[2], o[3]); w.z = cvt_pk_bf16(o[4], o[5]); w.w = cvt_pk_bf16(o[6], o[7]);
                    *(u32x4*)mp = w;
                }
            }
    }
};
struct EpiWin {
    static constexpr bool PERM = true, AFTER_DRAIN = false;
    bf16_t *QA, *QC, *IQ, *MISC, *KVC, *KVS, *KVW, *BU, *G; const float* rope; const PG8_LAS float* rs;
    __device__ __forceinline__ void operator()(const f32x4 (&acc)[2][2][4][2], const Unit& u, int wr, int wc, int fr, int fq) const {
        const int pn = u.pn;
        bf16_t* dst; int ld, cbase, mode;
        if (pn < 2) { dst = QA; ld = 512; cbase = pn * 256; mode = 1; }
        else if (pn < 4) { dst = QC; ld = 512; cbase = (pn - 2) * 256; mode = 1; }
        else if (pn == 4) { dst = IQ; ld = 256; cbase = 0; mode = 1; }
        else if (pn == 5) { dst = MISC; ld = 256; cbase = 0; mode = 3; }
        else if (pn <= 8) { dst = pn == 6 ? KVC : (pn == 7 ? KVS : KVW); ld = 256; cbase = 0; mode = 2; }
        else if (pn <= 10) { dst = BU; ld = 512; cbase = (pn - 9) * 256; mode = 0; }
        else { dst = G; ld = 3072; cbase = (pn - 11) * 256; mode = 4; }
        const int row0 = u.pm * BM + wr * 64 + fr, col0 = cbase + wc * 32 + 8 * fq;
        const bool ropelane = ((wc & 1) == 0) && fq < 2;
        const float sc = (mode == 1) ? (pn < 4 ? 0.125f * 1.4426950408889634f : 0.125f) : 1.0f;
#pragma unroll
        for (int ai = 0; ai < 2; ++ai)
#pragma unroll
            for (int m = 0; m < 4; ++m) {
                const size_t row = (size_t)(row0 + ai * HALF + m * 16);
                const float rr = rs[u.ord * 256 + wr * 64 + fr + ai * HALF + m * 16];
                f32x4 cs = {1.f, 1.f, 1.f, 1.f}, sn = {0.f, 0.f, 0.f, 0.f};
                if (ropelane && mode >= 1 && mode <= 3) { cs = *(const f32x4*)(rope + row * 16 + 4 * fq); sn = *(const f32x4*)(rope + row * 16 + 8 + 4 * fq); }
#pragma unroll
                for (int bj = 0; bj < 2; ++bj) {
                    const f32x4 a0 = acc[ai][bj][m][0] * rr, a1 = acc[ai][bj][m][1] * rr;
                    float o[8] = {a0[0], a0[1], a0[2], a0[3], a1[0], a1[1], a1[2], a1[3]};
                    const bool dorope = ropelane && (mode == 1 || (mode == 2 && bj == 0) || (mode == 3 && bj == 0 && wc == 0));
                    if (dorope) {
#pragma unroll
                        for (int p = 0; p < 4; ++p) { const float x1 = o[2 * p], x2 = o[2 * p + 1]; o[2 * p] = x1 * cs[p] - x2 * sn[p]; o[2 * p + 1] = x2 * cs[p] + x1 * sn[p]; }
                    }
                    if (mode == 4) {
#pragma unroll
                        for (int e = 0; e < 8; ++e) o[e] = fast_sigmoid(o[e]);
                    } else {
#pragma unroll
                        for (int e = 0; e < 8; ++e) o[e] *= sc;
                    }
                    u32x4 w; w.x = cvt_pk_bf16(o[0], o[1]); w.y = cvt_pk_bf16(o[2], o[3]); w.z = cvt_pk_bf16(o[4], o[5]); w.w = cvt_pk_bf16(o[6], o[7]);
                    *(u32x4*)(dst + row * ld + col0 + bj * HALF) = w;
                }
            }
    }
};

template <class Epi, class Sched, bool ALIGN_EPI = false, bool SP2 = false>
__device__ __forceinline__ void gemm_phase(PG8_LAS unsigned char* lds, const Gemm g, const Sched& S, const Epi& E, int tid_in) {
    int tid_ = tid_in; asm volatile("" : "+v"(tid_));
    const int tid = tid_, wid = __builtin_amdgcn_readfirstlane(tid >> 6), lane = tid & 63, wr = wid >> 2, wc = wid & 3, fr = lane & 15, fq = lane >> 4;
    const int K = g.K, nt = K / BK;
    unsigned voffA[2], voffB[2];
#pragma unroll
    for (int i = 0; i < 2; ++i) { int R, C; stage_rc(tid * 16 + i * 8192, R, C); const int Rb = Epi::PERM ? ((R & ~31) + perm32(R & 31)) : R;
        voffA[i] = (unsigned)(R * K + C) * 2u; voffB[i] = (unsigned)(Rb * K + C) * 2u; }
    const size_t kstep = (size_t)(BK * 2);
    const size_t hstep = (size_t)HALF * K * 2;
    const size_t tstep = 2 * hstep;
    const unsigned ldsw = (unsigned)wid * 1024u;
    const int aoff = lds_byte(wr * 64 + fr, fq * 8), boff = lds_byte(wc * 32 + fr, fq * 8);
#define PG8_SA(b, h) (((b) * 2 + (h)) * HTB)
#define PG8_SB(b, h) ((4 + (b) * 2 + (h)) * HTB)
#define PG8_STAGE(bufoff, gbase, voff) do { _Pragma("unroll") for (int _i = 0; _i < 2; ++_i) \
        __builtin_amdgcn_global_load_lds((const unsigned*)((const char*)(gbase) + (voff)[_i]), (PG8_LAS unsigned*)(lds + (bufoff) + ldsw + _i * 8192), 16, 0, 0); } while (0)
#define PG8_LDA(dst, b, h) do { _Pragma("unroll") for (int m = 0; m < 4; ++m) _Pragma("unroll") for (int k = 0; k < 2; ++k) dst[m][k] = *(const PG8_LAS bf16x8*)(lds + PG8_SA(b, h) + aoff + m * 2048 + k * 1024); } while (0)
#define PG8_LDB(dst, b, h) do { _Pragma("unroll") for (int n = 0; n < 2; ++n) _Pragma("unroll") for (int k = 0; k < 2; ++k) dst[n][k] = *(const PG8_LAS bf16x8*)(lds + PG8_SB(b, h) + boff + n * 2048 + k * 1024); } while (0)
#define PG8_MMA(ai, bj, At, Bt) do { __builtin_amdgcn_s_setprio(1); _Pragma("unroll") for (int m = 0; m < 4; ++m) _Pragma("unroll") for (int n = 0; n < 2; ++n) _Pragma("unroll") for (int k = 0; k < 2; ++k) \
        acc[ai][bj][m][n] = __builtin_amdgcn_mfma_f32_16x16x32_bf16(Bt[n][k], At[m][k], acc[ai][bj][m][n], 0, 0, 0); __builtin_amdgcn_s_setprio(0); } while (0)
#define PG8_WAIT_V(n) asm volatile("s_waitcnt vmcnt(" #n ")" ::: "memory")
#define PG8_WAIT_L(n) asm volatile("s_waitcnt lgkmcnt(" #n ")" ::: "memory")
#define PG8_BAR __builtin_amdgcn_s_barrier()
#define PG8_SCHED __builtin_amdgcn_sched_barrier(0)
    Unit cur, nxt; int ui = 0;
    if (!S.next(0, cur)) return;
    f32x4 acc[2][2][4][2];
#pragma unroll
    for (int a = 0; a < 2; ++a)
#pragma unroll
        for (int b = 0; b < 2; ++b)
#pragma unroll
            for (int m = 0; m < 4; ++m)
#pragma unroll
                for (int n = 0; n < 2; ++n) acc[a][b][m][n] = (f32x4){0.f, 0.f, 0.f, 0.f};
    bf16x8 At[4][2], B0[2][2], B1[2][2];
    const char* cA = (const char*)g.A + (size_t)cur.pm * tstep; const char* cB = (const char*)g.Bt + (size_t)cur.pn * tstep;
    S.a_ready(cur);
    if constexpr (SP2) {
        PG8_STAGE(PG8_SB(0, 0), cB, voffB); PG8_STAGE(PG8_SB(0, 1), cB + hstep, voffB); PG8_STAGE(PG8_SA(0, 0), cA, voffA); PG8_STAGE(PG8_SA(0, 1), cA + hstep, voffA);
        if (wr == 1) PG8_BAR;
        PG8_WAIT_V(2); PG8_BAR;
        PG8_STAGE(PG8_SB(1, 0), cB + kstep, voffB); PG8_STAGE(PG8_SA(1, 0), cA + kstep, voffA); PG8_STAGE(PG8_SB(1, 1), cB + hstep + kstep, voffB);
        PG8_WAIT_V(6); PG8_BAR;
    } else {
        PG8_STAGE(PG8_SB(0, 0), cB, voffB); PG8_STAGE(PG8_SA(0, 0), cA, voffA); PG8_STAGE(PG8_SB(0, 1), cB + hstep, voffB); PG8_STAGE(PG8_SA(0, 1), cA + hstep, voffA);
        if (wr == 1) PG8_BAR;
        PG8_WAIT_V(4); PG8_BAR;
        PG8_STAGE(PG8_SB(1, 0), cB + kstep, voffB); PG8_STAGE(PG8_SA(1, 0), cA + kstep, voffA); PG8_STAGE(PG8_SB(1, 1), cB + hstep + kstep, voffB);
        PG8_WAIT_V(6); PG8_BAR;
    }
    for (;;) {
        const bool has_next = S.next(ui + 1, nxt);
        const char* nA = has_next ? (const char*)g.A + (size_t)nxt.pm * tstep : cA; const char* nB = has_next ? (const char*)g.Bt + (size_t)nxt.pn * tstep : cB;
        for (int t = 0; t < nt; t += 2) {
            const bool last = (t == nt - 2);
            const char* a1 = cA + (size_t)(t + 1) * kstep;
            const char* a2 = last ? nA : cA + (size_t)(t + 2) * kstep; const char* b2 = last ? nB : cB + (size_t)(t + 2) * kstep;
            const char* a3 = a2 + kstep; const char* b3 = b2 + kstep;
            if (last && has_next) S.a_ready(nxt);
            if constexpr (SP2) {
            PG8_LDB(B0, 0, 0); PG8_LDB(B1, 0, 1); PG8_SCHED; PG8_LDA(At, 0, 0); PG8_STAGE(PG8_SA(1, 1), a1 + hstep, voffA);
            PG8_WAIT_V(8); PG8_WAIT_L(0); PG8_BAR; PG8_MMA(0, 0, At, B0); PG8_MMA(0, 1, At, B1); PG8_BAR; PG8_SCHED;
            PG8_LDA(At, 0, 1); PG8_STAGE(PG8_SB(0, 0), b2, voffB); PG8_STAGE(PG8_SB(0, 1), b2 + hstep, voffB); PG8_STAGE(PG8_SA(0, 0), a2, voffA);
            PG8_WAIT_V(8); PG8_WAIT_L(0); PG8_BAR; PG8_MMA(1, 0, At, B0); PG8_MMA(1, 1, At, B1); PG8_BAR; PG8_SCHED;
            PG8_LDB(B0, 1, 0); PG8_LDB(B1, 1, 1); PG8_SCHED; PG8_LDA(At, 1, 0); PG8_STAGE(PG8_SA(0, 1), a2 + hstep, voffA);
            PG8_WAIT_V(8); PG8_WAIT_L(0); PG8_BAR; PG8_MMA(0, 0, At, B0); PG8_MMA(0, 1, At, B1); PG8_BAR; PG8_SCHED;
            PG8_LDA(At, 1, 1); PG8_STAGE(PG8_SB(1, 0), b3, voffB); PG8_STAGE(PG8_SB(1, 1), b3 + hstep, voffB); PG8_STAGE(PG8_SA(1, 0), a3, voffA);
            PG8_WAIT_V(8); PG8_WAIT_L(0); PG8_BAR; PG8_MMA(1, 0, At, B0); PG8_MMA(1, 1, At, B1); PG8_BAR; PG8_SCHED;
            } else {
            PG8_LDB(B0, 0, 0); PG8_SCHED; PG8_LDA(At, 0, 0); PG8_STAGE(PG8_SA(1, 1), a1 + hstep, voffA);
            PG8_WAIT_L(8); PG8_BAR; PG8_WAIT_L(0); PG8_MMA(0, 0, At, B0); PG8_BAR; PG8_SCHED;
            PG8_LDB(B1, 0, 1); PG8_STAGE(PG8_SB(0, 0), b2, voffB);
            PG8_BAR; PG8_WAIT_L(0); PG8_MMA(0, 1, At, B1); PG8_BAR;
            PG8_LDA(At, 0, 1); PG8_STAGE(PG8_SA(0, 0), a2, voffA);
            PG8_BAR; PG8_WAIT_L(0); PG8_MMA(1, 0, At, B0); PG8_BAR; PG8_SCHED;
            PG8_STAGE(PG8_SB(0, 1), b2 + hstep, voffB);
            PG8_WAIT_V(6); PG8_BAR; PG8_MMA(1, 1, At, B1); PG8_BAR;
            PG8_LDB(B0, 1, 0); PG8_SCHED; PG8_LDA(At, 1, 0); PG8_STAGE(PG8_SA(0, 1), a2 + hstep, voffA);
            PG8_WAIT_L(8); PG8_BAR; PG8_WAIT_L(0); PG8_MMA(0, 0, At, B0); PG8_BAR; PG8_SCHED;
            PG8_LDB(B1, 1, 1); PG8_STAGE(PG8_SB(1, 0), b3, voffB);
            PG8_BAR; PG8_WAIT_L(0); PG8_MMA(0, 1, At, B1); PG8_BAR;
            PG8_LDA(At, 1, 1); PG8_STAGE(PG8_SA(1, 0), a3, voffA);
            PG8_BAR; PG8_WAIT_L(0); PG8_MMA(1, 0, At, B0); PG8_BAR; PG8_SCHED;
            PG8_STAGE(PG8_SB(1, 1), b3 + hstep, voffB);
            PG8_WAIT_V(6); PG8_BAR; PG8_MMA(1, 1, At, B1); PG8_BAR;
            }
        }
        if constexpr (ALIGN_EPI) { if (wr == 0) PG8_BAR; }
        if constexpr (!Epi::AFTER_DRAIN) { E(acc, cur, wr, wc, fr, fq); S.done(cur); }
        if (!has_next) break;
#pragma unroll
        for (int a = 0; a < 2; ++a)
#pragma unroll
            for (int b = 0; b < 2; ++b)
#pragma unroll
                for (int m = 0; m < 4; ++m)
#pragma unroll
                    for (int n = 0; n < 2; ++n) acc[a][b][m][n] = (f32x4){0.f, 0.f, 0.f, 0.f};
        cur = nxt; cA = nA; cB = nB; ++ui;
        if constexpr (ALIGN_EPI) { if (wr == 1) PG8_BAR; }
    }
    PG8_WAIT_V(0);
    if constexpr (!ALIGN_EPI) { if (wr == 0) PG8_BAR; }
    PG8_BAR;
    if constexpr (Epi::AFTER_DRAIN) { E.fused(acc, cur, wr, wc, fr, fq, lds, wid, lane); S.done(cur); }
#undef PG8_SA
#undef PG8_SB
#undef PG8_STAGE
#undef PG8_LDA
#undef PG8_LDB
#undef PG8_MMA
#undef PG8_WAIT_V
#undef PG8_WAIT_L
#undef PG8_BAR
#undef PG8_SCHED
}
}
#define GAS __attribute__((address_space(1)))
#define LAS __attribute__((address_space(3)))
typedef unsigned short bf16;
typedef unsigned v4u __attribute__((ext_vector_type(4)));
typedef float f32x4 __attribute__((ext_vector_type(4)));
typedef short bf16x8 __attribute__((ext_vector_type(8)));
typedef GAS unsigned gu32;
typedef GAS unsigned long long gu64;
#define RLX_AGENT __ATOMIC_RELAXED, __HIP_MEMORY_SCOPE_AGENT
#define LDS_WAIT() asm volatile("s_waitcnt lgkmcnt(0)" ::: "memory")
#define VM_WAIT() asm volatile("s_waitcnt vmcnt(0)" ::: "memory")
__device__ __forceinline__ unsigned long long rt() { return __builtin_amdgcn_s_memrealtime(); }
__device__ __forceinline__ unsigned f2bf(float f) { unsigned u = __builtin_bit_cast(unsigned, f); return (u + 0x7fffu + ((u >> 16) & 1u)) >> 16; }
__device__ __forceinline__ unsigned pk2(float lo, float hi) { return f2bf(lo) | (f2bf(hi) << 16); }
#define XB_TMO      128
#define XB_XCNT(j)  (256  + 64 * (j))
#define XB_XSUB(j)  (1280 + 64 * (j))
#define XB_XGEN(j)  (2304 + 64 * (j))
#define XB_TOP      3328
#define XB_TOPGEN   3392
#define XCD_BAR_WORDS 3456
#define XB_SPIN_CAP (1u << 18)

__device__ __forceinline__ unsigned xb_ld(unsigned* p)              { return __hip_atomic_load(p, __ATOMIC_RELAXED, __HIP_MEMORY_SCOPE_AGENT); }
__device__ __forceinline__ unsigned xb_add(unsigned* p, unsigned v) { return __hip_atomic_fetch_add(p, v, __ATOMIC_RELAXED, __HIP_MEMORY_SCOPE_AGENT); }
__device__ __forceinline__ unsigned xb_xcc_id() { return (unsigned)__builtin_amdgcn_s_getreg((3 << 11) | 20) & 0xFu; }
#define XB_SPIN(cond, bar) do { unsigned _sp = 0; while (cond) { __builtin_amdgcn_s_sleep(1); \
    if ((++_sp & 255u) == 0u) { if (xb_ld(&(bar)[XB_TMO])) break; if (_sp > XB_SPIN_CAP) { atomicAdd(&(bar)[XB_TMO], 1u); break; } } } } while (0)

struct XcdBarrier {
    unsigned* bar; unsigned x;
    volatile LAS unsigned* st;
};

__device__ __forceinline__ XcdBarrier xcd_barrier_post(unsigned* bar, volatile LAS unsigned* st) {
    XcdBarrier b; b.bar = bar; b.x = xb_xcc_id(); b.st = st;
    if (threadIdx.x == 0) (void)xb_add(&bar[XB_XCNT(b.x)], 1u);
    return b;
}
__device__ __forceinline__ void xcd_barrier_complete(unsigned* bar, unsigned x, unsigned& nloc, unsigned& nx) {
    const unsigned G = gridDim.x * gridDim.y * gridDim.z;
    unsigned sum, cnt, mine, sp = 0u;
    for (;;) {
        sum = 0u; cnt = 0u; mine = 0u;
#pragma unroll
        for (unsigned j = 0; j < 16; ++j) { const unsigned c = xb_ld(&bar[XB_XCNT(j)]); sum += c; cnt += (c > 0u) ? 1u : 0u; mine = (j == x) ? c : mine; }
        if (sum == G) break;
        __builtin_amdgcn_s_sleep(1);
        if ((++sp & 255u) == 0u) { if (xb_ld(&bar[XB_TMO])) break; if (sp > XB_SPIN_CAP) { atomicAdd(&bar[XB_TMO], 1u); break; } }
    }
    nloc = mine > 0u ? mine : 1u; nx = cnt > 0u ? cnt : 1u;
}

__device__ __forceinline__ void xcd_barrier(const XcdBarrier& b) {
    asm volatile("s_waitcnt vmcnt(0)" ::: "memory");
    __syncthreads();
    if (threadIdx.x == 0) {
        unsigned* bar = b.bar;
        __builtin_amdgcn_s_waitcnt(0);
        unsigned nloc = b.st[0], nx = b.st[1];
        if (nloc == 0u) { xcd_barrier_complete(bar, b.x, nloc, nx); b.st[0] = nloc; b.st[1] = nx; }
        const unsigned old = xb_add(&bar[XB_XSUB(b.x)], 1u);
        const unsigned gen = old / nloc;
        if (old + 1u == (gen + 1u) * nloc) {
            __builtin_amdgcn_fence(__ATOMIC_RELEASE, "agent");
            asm volatile("s_waitcnt vmcnt(0)" ::: "memory");
            const unsigned og = xb_add(&bar[XB_TOP], 1u);
            const unsigned tg = og / nx;
            if (og + 1u == (tg + 1u) * nx) xb_add(&bar[XB_TOPGEN], 1u);
            else XB_SPIN(xb_ld(&bar[XB_TOPGEN]) == tg, bar);
            __builtin_amdgcn_fence(__ATOMIC_ACQUIRE, "agent");
            xb_add(&bar[XB_XGEN(b.x)], 1u);
            asm volatile("s_waitcnt vmcnt(0)" ::: "memory");
        } else {
            XB_SPIN(xb_ld(&bar[XB_XGEN(b.x)]) == gen, bar);
            __builtin_amdgcn_fence(__ATOMIC_ACQUIRE, "agent");
            asm volatile("s_waitcnt vmcnt(0)" ::: "memory");
        }
    }
    __syncthreads();
}
constexpr int NB = 8, SEQ = 4096, DM = 1024, DEPTH = 4, M = NB * SEQ;
constexpr int FF = 2816, NIN = 5852, NINP = 5888;
constexpr float EPS = 1e-6f, NEGF = -1e30f;
constexpr int NWAVES = 8;
constexpr size_t MiB = 1u << 20;
constexpr size_t WS_CTL = 0, CTL_ZERO_BYTES = 1 * MiB;
constexpr size_t WS_ROPE = 1 * MiB;
constexpr size_t WS_KVA = 3 * MiB;
constexpr size_t WS_KC = 11 * MiB, WS_VC = WS_KC + 512 * 1024;
constexpr size_t WS_W = 12 * MiB;
constexpr size_t WO_GU1 = 0, WO_D1 = 11 * MiB, WO_GU2 = WO_D1 + 5 * MiB + 512 * 1024, WO_D2 = WO_GU2 + 11 * MiB, WO_IN = WO_D2 + 5 * MiB + 512 * 1024,
                 WO_PA = WO_IN + 11 * MiB + 512 * 1024, WO_PB = WO_PA + MiB, WO_PC = WO_PB + MiB, WO_OUT = WO_PC + MiB,
                 WO_CW1 = WO_OUT + 2 * MiB  , WO_CW2 = WO_CW1 + MiB  , WO_UKV = WO_CW2 + 32768  , WO_POOL = WO_UKV + 32768  ,
                 WO_POSB = WO_POOL + 131072  , WO_END = WO_POSB + 1024;
static_assert(WO_END <= 52 * MiB, "weights region");
constexpr size_t WS_XN = 64 * MiB;
constexpr size_t WS_R = 128 * MiB;
constexpr size_t WS_G = WS_R, WS_QA = WS_R + 192 * MiB, WS_QC = WS_QA + 32 * MiB, WS_IQ = WS_QC + 32 * MiB, WS_MISC = WS_IQ + 16 * MiB,
                 WS_KVC = WS_MISC + 16 * MiB, WS_KVS = WS_KVC + 16 * MiB, WS_KVW = WS_KVS + 16 * MiB, WS_BU = WS_KVW + 16 * MiB, WS_END = WS_BU + 32 * MiB;
#ifndef YB_SPARE
#define YB_SPARE 0
#endif
constexpr size_t WS_YB = YB_SPARE ? 496 * MiB : WS_XN;
constexpr size_t WS_MG = WS_IQ;
constexpr size_t WS_H = WS_R;
static_assert(WS_END == 496 * MiB, "ws map");
constexpr int RING_BYTES = 131072, LDS_BYTES = 163840, LDSCTL_OFF = 163840 - 256;
constexpr size_t WS_SSQ = 496 * MiB;
constexpr int RS_OFF = 131072;
constexpr int NPL = 10, NPH = 1 + DEPTH * NPL + 1;


#ifndef TPROBE
#define TPROBE 0
#endif
#if TPROBE
#define TP_DECL unsigned long long tp_t_ = __builtin_amdgcn_s_memtime();
#define TP_MARK(k) do { const unsigned long long n_ = __builtin_amdgcn_s_memtime(); if (tid == 0) atomicAdd((unsigned long long*)(ws + 32768) + (k), n_ - tp_t_); tp_t_ = n_; } while (0)
#define TP_ADD(k, v) do { if (tid == 0) atomicAdd((unsigned long long*)(ws + 32768) + (k), (unsigned long long)(v)); } while (0)
#else
#define TP_DECL
#define TP_MARK(k)
#define TP_ADD(k, v)
#endif
__device__ __forceinline__ int lane_id_v() { int l; asm volatile("v_mbcnt_lo_u32_b32 %0, -1, 0\n\tv_mbcnt_hi_u32_b32 %0, -1, %0" : "=v"(l)); return l; }
__device__ __forceinline__ float bflo(unsigned w) { return __uint_as_float(w << 16); }
__device__ __forceinline__ float bfhi(unsigned w) { return __uint_as_float(w & 0xffff0000u); }
__device__ __forceinline__ float bf2f(bf16 v) { return __uint_as_float((unsigned)v << 16); }
__device__ __forceinline__ float wave_sum(float v) {
#pragma unroll
    for (int o = 1; o < 64; o <<= 1) v += __shfl_xor(v, o);
    return v;
}
__device__ __forceinline__ float wave_max(float v) {
#pragma unroll
    for (int o = 1; o < 64; o <<= 1) v = fmaxf(v, __shfl_xor(v, o));
    return v;
}
__device__ __forceinline__ int wave_sum_i(int v) {
#pragma unroll
    for (int o = 1; o < 64; o <<= 1) v += __shfl_xor(v, o);
    return v;
}
__device__ __forceinline__ unsigned wave_max_u(unsigned v) {
#pragma unroll
    for (int o = 1; o < 64; o <<= 1) { const unsigned w = (unsigned)__shfl_xor((int)v, o); v = w > v ? w : v; }
    return v;
}
#define WAVE_LDS_SYNC() do { asm volatile("s_waitcnt lgkmcnt(0)" ::: "memory"); __builtin_amdgcn_wave_barrier(); } while (0)
__host__ __device__ __forceinline__ int permd(int d) { return d < 8 ? 2 * d : (d < 16 ? 2 * (d - 8) + 1 : d); }
__device__ __forceinline__ int win_newcol(int n) {
    if (n < 512) return (n & ~63) + permd(n & 63);
    if (n < 640) return 1280 + 64 + (n - 512);
    if (n < 896) { const int m = n - 640; return 1024 + (m & ~63) + permd(m & 63); }
    if (n < 960) return 1280 + permd(n - 896);
    if (n < 964) return 1280 + 192 + (n - 960);
    if (n < 1476) return 2304 + (n - 964);
    if (n < 1988) { const int m = n - 1476; return 512 + (m & ~63) + permd(m & 63); }
    if (n < 2756) { const int m = n - 1988, kv = m >> 8, r = m & 255, base = 1536 + kv * 256; return r < 128 ? base + (r & ~63) + permd(r & 63) : base + r; }
    if (n < 2780) return 1280 + 196 + (n - 2756);
    return 2816 + (n - 2780);
}
__device__ __forceinline__ int map_row(int mode, int n) { return mode == 0 ? n : (mode == 1 ? ((n >> 7) << 8) + (n & 127) : (mode == 2 ? ((n >> 7) << 8) + 128 + (n & 127) : win_newcol(n))); }

struct Args { const float* in[24]; float* out; unsigned char* ws; int ph_lo, ph_hi; };

__device__ __forceinline__ int unperm(int p) { return p < 16 ? ((p & 1) ? (p >> 1) + 8 : (p >> 1)) : p; }
__device__ __forceinline__ void tr_item(const float* W, int K, int N, bf16* WT, int mode, LAS float* scr, int item, int lane, bool kperm = false, const float* kscale = nullptr) {
    const int nblk = (N + 31) >> 5, kb = item / nblk, nb = item - kb * nblk, k0 = 64 * kb, n0 = 32 * nb;
    const int nn = n0 + (lane & 31);
#pragma unroll
    for (int i = 0; i < 32; ++i) { const int kk = 2 * i + (lane >> 5); const float sc_ = kscale ? kscale[k0 + kk] : 1.0f; scr[kk * 33 + (lane & 31)] = nn < N ? W[(size_t)(k0 + kk) * N + nn] * sc_ : 0.f; }
    LDS_WAIT(); asm volatile("" ::: "memory");
    const int c = lane & 7;
#pragma unroll
    for (int j = 0; j < 4; ++j) { const int n = (lane >> 3) + 8 * j; const LAS float* s = scr + n;
        int ks[8];
#pragma unroll
        for (int i = 0; i < 8; ++i) ks[i] = (kperm ? unperm(8 * c + i) : 8 * c + i) * 33;
        v4u o; o.x = pk2(s[ks[0]], s[ks[1]]); o.y = pk2(s[ks[2]], s[ks[3]]); o.z = pk2(s[ks[4]], s[ks[5]]); o.w = pk2(s[ks[6]], s[ks[7]]);
        if (n0 + n < N) *(v4u*)(WT + (size_t)map_row(mode, n0 + n) * K + k0 + 8 * c) = o; }
    LDS_WAIT(); asm volatile("" ::: "memory");
}
__device__ __forceinline__ void phase_convert(const Args& P, unsigned char* ws, int z, int l, LAS unsigned char* lds, int gw, int NGW, int lane, int wave) {
    asm volatile("" : "+v"(lane)); lane &= 63; asm volatile("" : "+s"(gw), "+s"(NGW));
    LAS float* scr = (LAS float*)(lds + wave * 16384);
    unsigned char* wb = ws + WS_W;
    constexpr int I_F = 16 * 88, I_D = 44 * 32, I_IN = 16 * 183, I_P = 8 * 32, I_O = 16 * 32;
    constexpr int I_C = 32 * 4;
    constexpr int NIT = 4 * I_F + 2 * I_D + I_IN + 3 * I_P + I_O + 2 * I_C;
    const size_t fo = (size_t)l * DM * FF;
    for (int it = gw; it < NIT; it += NGW) {
        int r = it, K = DM, N = FF, mode = 1; const float* W = P.in[3 + z] + fo; size_t wo = WO_GU1; bool kperm = false; const float* ksc = P.in[2 + z] + l * DM;
        if (r >= I_F) { r -= I_F; mode = 2; W = P.in[4 + z] + fo;
        if (r >= I_F) { r -= I_F; mode = 0; W = P.in[5 + z] + fo; K = FF; N = DM; wo = WO_D1; ksc = nullptr;
        if (r >= I_D) { r -= I_D; mode = 1; W = P.in[20 + z] + fo; K = DM; N = FF; wo = WO_GU2; ksc = P.in[19 + z] + l * DM;
        if (r >= I_F) { r -= I_F; mode = 2; W = P.in[21 + z] + fo;
        if (r >= I_F) { r -= I_F; mode = 0; W = P.in[22 + z] + fo; K = FF; N = DM; wo = WO_D2; ksc = nullptr;
        if (r >= I_D) { r -= I_D; mode = 3; W = P.in[7 + z] + (size_t)l * DM * NIN; K = DM; N = NIN; wo = WO_IN; ksc = P.in[6 + z] + l * DM;
        if (r >= I_IN) { r -= I_IN; mode = 0; W = P.in[15 + z] + (size_t)l * 512 * DM; K = 512; N = DM; wo = WO_PA; ksc = nullptr;
        if (r >= I_P) { r -= I_P; W = P.in[16 + z] + (size_t)l * 512 * DM; wo = WO_PB;
        if (r >= I_P) { r -= I_P; W = P.in[17 + z] + (size_t)l * 512 * DM; wo = WO_PC;
        if (r >= I_P) { r -= I_P; W = P.in[18 + z] + (size_t)l * DM * DM; K = DM; wo = WO_OUT;
        if (r >= I_O) { r -= I_O; W = P.in[13 + z] + (size_t)(l * 2) * 2048 * 128; K = 2048; N = 128; wo = WO_CW1; kperm = true;
        if (r >= I_C) { r -= I_C; W += (size_t)2048 * 128; wo = WO_CW1 + 128 * 2048 * 2; kperm = false; } } } } } } } } } } } }
        tr_item(W, K, N, (bf16*)(wb + wo), mode, scr, r, lane, kperm, ksc);
    }
    {
        const int gt = gw * 64 + lane, GT = NGW * 64;
        bf16* ukv = (bf16*)(wb + WO_UKV); bf16* pool = (bf16*)(wb + WO_POOL); bf16* cw2 = (bf16*)(wb + WO_CW2); float* posb = (float*)(wb + WO_POSB);
        const float* w_ukv = P.in[9 + z] + (size_t)l * 128 * 128; const float* gn = P.in[8 + z] + l * 128;
        for (int i = gt; i < 128 * 128; i += GT) { const int np = i >> 7, k = i & 127, n = np < 64 ? unperm(np) : np; ukv[i] = (bf16)f2bf(gn[k] * w_ukv[k * 128 + n]); }
        const float* pw = P.in[10 + z] + (size_t)l * 4 * 128 * 128; const float* psc = P.in[11 + z] + l * 512;
        for (int i = gt; i < 4 * 128 * 128; i += GT) { const int g = i >> 14, d = (i >> 7) & 127, c = i & 127; pool[i] = (bf16)f2bf(pw[(g * 128 + c) * 128 + d] * psc[g * 128 + d]); }
        const float* w2 = P.in[14 + z] + (size_t)l * 2 * 128 * 64;
        for (int i = gt; i < 2 * 64 * 128; i += GT) { const int br = i >> 13, dp = (i >> 7) & 63, n = i & 127, d = br ? dp : unperm(dp); cw2[i] = (bf16)f2bf(w2[(br * 128 + n) * 64 + d]); }
        const float* w1 = P.in[13 + z] + (size_t)l * 2 * 2048 * 128; const float* pos = P.in[12 + z] + (size_t)l * 2 * 2048;
        for (int i = gw; i < 256; i += NGW) { const int br = i >> 7, n = i & 127; float a = 0.f;
#pragma unroll 8
            for (int k = lane; k < 2048; k += 64) a += pos[br * 2048 + k] * w1[((size_t)br * 2048 + k) * 128 + n];
            a = wave_sum(a); if (lane == 0) posb[i] = a; }
    }
    if (gw < 36) { unsigned zz = 0u; asm volatile("" : "+v"(zz)); v4u z = {zz, zz, zz, zz}; v4u* rp = (v4u*)((bf16*)(wb + WO_IN) + (size_t)(1500 + gw) * DM); for (int i = lane; i < DM / 8; i += 64) rp[i] = z; }
}
__device__ __forceinline__ void phase_rope(const Args& P, unsigned char* ws, int z, int gtid, int gthreads) {
    float* rope = (float*)(ws + WS_ROPE);
    for (int idx = gtid; idx < M * 8; idx += gthreads) {
        const int row = idx >> 3, i = idx & 7;
        const double inv = i == 0 ? 1.0 : i == 1 ? 0.19392274474868576 : i == 2 ? 0.03760603093086393 : i == 3 ? 0.007292664737217109 : i == 4 ? 0.001414213562373095 : i == 5 ? 0.0002742481756762073 : i == 6 ? 5.318295896944988e-05 : 1.031338537721246e-05;
        const double ang = (double)((const int*)P.in[1 + z])[row] * inv;
        double s, c; sincos(ang, &s, &c);
        rope[row * 16 + i] = (float)c; rope[row * 16 + 8 + i] = (float)s;
    }
}
__device__ __forceinline__ void norm_row_bf16(const float* xrow, const float* gain, bf16* orow, int lane) {
    const f32x4* xr = (const f32x4*)xrow + lane; const f32x4* gr = (const f32x4*)gain + lane;
    f32x4 v[4]; float s = 0.f;
#pragma unroll
    for (int j = 0; j < 4; ++j) { v[j] = xr[64 * j]; s += (v[j].x * v[j].x + v[j].y * v[j].y) + (v[j].z * v[j].z + v[j].w * v[j].w); }
    const float r = 1.0f / sqrtf(wave_sum(s) * (1.f / DM) + EPS);
    unsigned long long* o8 = (unsigned long long*)orow + lane;
#pragma unroll
    for (int j = 0; j < 4; ++j) { const f32x4 g = gr[64 * j]; o8[64 * j] = (unsigned long long)pk2(v[j].x * r * g.x, v[j].y * r * g.y) | ((unsigned long long)pk2(v[j].z * r * g.z, v[j].w * r * g.w) << 32); }
}
__device__ __forceinline__ void stat_row_bf16(const float* xrow, bf16* orow, float* ssq16, int lane) {
    const f32x4* xr = (const f32x4*)xrow + lane;
    f32x4 v[4]; float s = 0.f;
#pragma unroll
    for (int j = 0; j < 4; ++j) { v[j] = xr[64 * j]; s += (v[j].x * v[j].x + v[j].y * v[j].y) + (v[j].z * v[j].z + v[j].w * v[j].w); }
    s = wave_sum(s);
    unsigned long long* o8 = (unsigned long long*)orow + lane;
#pragma unroll
    for (int j = 0; j < 4; ++j) o8[64 * j] = (unsigned long long)pk2(v[j].x, v[j].y) | ((unsigned long long)pk2(v[j].z, v[j].w) << 32);
    if (lane < 16) ssq16[lane] = lane == 0 ? s : 0.f;
}
__device__ __forceinline__ void norm_row_f32(float* xrow, const float* gain, int lane, float tps = 1.0f) {
    f32x4* xr = (f32x4*)xrow + lane; const f32x4* gr = (const f32x4*)gain + lane;
    f32x4 v[4]; float s = 0.f;
#pragma unroll
    for (int j = 0; j < 4; ++j) { v[j] = xr[64 * j]; s += (v[j].x * v[j].x + v[j].y * v[j].y) + (v[j].z * v[j].z + v[j].w * v[j].w); }
    const float r = tps / sqrtf(wave_sum(s) * (1.f / DM) + EPS);
#pragma unroll
    for (int j = 0; j < 4; ++j) { const f32x4 g = gr[64 * j]; xr[64 * j] = v[j] * r * g; }
}
__device__ __forceinline__ unsigned f2o(float s) { const int b = (int)__float_as_uint(s); return (unsigned)(b ^ ((b >> 31) | (int)0x80000000)); }
__device__ __forceinline__ void unpack8(const v4u v, float* f) { f[0] = bflo(v.x); f[1] = bfhi(v.x); f[2] = bflo(v.y); f[3] = bfhi(v.y); f[4] = bflo(v.z); f[5] = bfhi(v.z); f[6] = bflo(v.w); f[7] = bfhi(v.w); }
__device__ __forceinline__ void load_row64(const bf16* p, float* f) {
    const v4u* q = (const v4u*)p;
#pragma unroll
    for (int i = 0; i < 8; ++i) unpack8(q[i], f + 8 * i);
}
__device__ __forceinline__ float dot64(const LAS float* q, const float* k) {
    float d = 0.f;
#pragma unroll
    for (int i = 0; i < 16; ++i) { const f32x4 qq = *(const LAS f32x4*)(q + 4 * i); d += qq.x * k[4 * i] + qq.y * k[4 * i + 1] + qq.z * k[4 * i + 2] + qq.w * k[4 * i + 3]; }
    return d;
}
__device__ __forceinline__ void dsa_query(const Args& P, unsigned char* ws, int z, int row, LAS unsigned char* wl, int lane) {
    const int b = row >> 12, t = row & (SEQ - 1), n = t + 1;
    LAS unsigned* su = (LAS unsigned*)wl; LAS float* pb = (LAS float*)wl; LAS unsigned short* list = (LAS unsigned short*)(wl + 16384); LAS float* qb = (LAS float*)(wl + 16896);
    const bf16* misc = (const bf16*)(ws + WS_MISC);
    const unsigned long long lt = (1ull << lane) - 1ull;
    int nsel;
    if (n <= 256) { for (int i = lane; i < n; i += 64) list[i] = (unsigned short)i; nsel = n; }
    else {
        { const uint2 v = *(const uint2*)((const bf16*)(ws + WS_IQ) + (size_t)row * 256 + lane * 4); qb[lane * 4] = bflo(v.x); qb[lane * 4 + 1] = bfhi(v.x); qb[lane * 4 + 2] = bflo(v.y); qb[lane * 4 + 3] = bfhi(v.y); }
        float iw[4]; { const uint2 v = *(const uint2*)(misc + (size_t)row * 256 + 192); iw[0] = 0.5f * bflo(v.x); iw[1] = 0.5f * bfhi(v.x); iw[2] = 0.5f * bflo(v.y); iw[3] = 0.5f * bfhi(v.y); }
        WAVE_LDS_SYNC();
        const int nch = (n + 63) >> 6;
        for (int i = 0; i < nch; ++i) {
            const int key = i * 64 + lane; const bool valid = key <= t;
            float kf[64]; load_row64(misc + (size_t)(b * SEQ + (valid ? key : t)) * 256, kf);
            float s = 0.f;
#pragma unroll
            for (int h = 0; h < 4; ++h) s += iw[h] * fmaxf(dot64(qb + h * 64, kf), 0.f);
            su[key] = valid ? f2o(s) : 0u;
        }
        WAVE_LDS_SYNC();
        unsigned prefix = 0u;
        for (int bit = 31; bit >= 0; --bit) {
            const unsigned cand = prefix | (1u << bit); int c = 0;
            for (int i = 0; i < nch; ++i) c += (su[i * 64 + lane] >= cand) ? 1 : 0;
            c = wave_sum_i(c);
            if (c >= 256) prefix = cand;
            if (c == 256) break;
        }
        int cgt = 0;
        for (int i = 0; i < nch; ++i) cgt += (su[i * 64 + lane] > prefix) ? 1 : 0;
        const int need_eq = 256 - wave_sum_i(cgt);
        int base = 0, eq_taken = 0;
        for (int i = 0; i < nch; ++i) {
            const unsigned v = su[i * 64 + lane]; const bool gt = v > prefix, eq = v == prefix;
            const unsigned long long meq = __ballot(eq);
            const bool sel = gt || (eq && (eq_taken + __popcll(meq & lt)) < need_eq);
            const unsigned long long ms = __ballot(sel);
            if (sel) list[base + __popcll(ms & lt)] = (unsigned short)(i * 64 + lane);
            base += __popcll(ms); eq_taken += __popcll(meq);
        }
        nsel = 256;
    }
    { const v4u v = *(const v4u*)((const bf16*)(ws + WS_QA) + (size_t)row * 512 + lane * 8); float f[8]; unpack8(v, f);
#pragma unroll
      for (int e = 0; e < 8; ++e) qb[lane * 8 + e] = f[e]; }
    WAVE_LDS_SYNC();
    const bf16* kva = (const bf16*)(ws + WS_KVA);
    float s[8][4];
#pragma unroll
    for (int j = 0; j < 4; ++j) {
        const int slot = lane + 64 * j; const bool valid = slot < nsel; const int key = list[valid ? slot : 0];
        float kf[64]; load_row64(kva + (size_t)(b * SEQ + key) * 128, kf);
#pragma unroll
        for (int h = 0; h < 8; ++h) s[h][j] = valid ? dot64(qb + h * 64, kf) : NEGF;
    }
    float linv[8];
#pragma unroll
    for (int h = 0; h < 8; ++h) {
        const float m = wave_max(fmaxf(fmaxf(s[h][0], s[h][1]), fmaxf(s[h][2], s[h][3]))); float ls = 0.f;
#pragma unroll
        for (int j = 0; j < 4; ++j) { const float p = __expf(s[h][j] - m); ls += p; pb[h * 256 + lane + 64 * j] = p; }
        linv[h] = 1.0f / wave_sum(ls);
    }
    WAVE_LDS_SYNC();
    float acc[8] = {0.f, 0.f, 0.f, 0.f, 0.f, 0.f, 0.f, 0.f};
    for (int slot = 0; slot < nsel; ++slot) {
        const float v = bf2f(kva[(size_t)(b * SEQ + list[slot]) * 128 + 64 + lane]);
#pragma unroll
        for (int h = 0; h < 8; ++h) acc[h] += pb[h * 256 + slot] * v;
    }
    bf16* ya = (bf16*)(ws + WS_QA) + (size_t)row * 512;
#pragma unroll
    for (int h = 0; h < 8; ++h) ya[h * 64 + lane] = (bf16)f2bf(acc[h] * linv[h]);
    WAVE_LDS_SYNC();
}
typedef short s16x4 __attribute__((ext_vector_type(4)));
typedef short v4i16_t __attribute__((ext_vector_type(4)));
typedef float f32x4v __attribute__((ext_vector_type(4)));
typedef __bf16 bf16x2_t __attribute__((ext_vector_type(2)));
typedef float f32x2_t __attribute__((ext_vector_type(2)));
__device__ __forceinline__ unsigned cvtpk(float lo, float hi) { f32x2_t v = {lo, hi}; bf16x2_t b = __builtin_convertvector(v, bf16x2_t); return __builtin_bit_cast(unsigned, b); }
constexpr float L2E = 1.4426950408889634f;
#ifndef NSA_NOSKIP
#define NSA_NOSKIP 0
#endif
constexpr int NSA_KSTR = 72, NSA_VSTR = 80;
constexpr int NSA_KB = 64 * NSA_KSTR * 2, NSA_VB = 64 * NSA_VSTR * 2;
constexpr int NSA_D = 6, NSA_SLOT = 16384;
constexpr int NSA_OFF_RING = 0, NSA_OFF_KCL = 0, NSA_OFF_VCTL = 32768  , NSA_OFF_IMPA = 65536  , NSA_OFF_IMPB = NSA_OFF_IMPA + 64 * 65 * 4, NSA_OFF_UM = NSA_D * NSA_SLOT + 1024  , NSA_OFF_QM = NSA_OFF_UM + 64, NSA_OFF_ST = NSA_OFF_UM + 1024, NSA_LDS = NSA_OFF_ST + 512 * 64;
__device__ __forceinline__ s16x4 tr16(const LAS unsigned char* p) { return __builtin_bit_cast(s16x4, __builtin_amdgcn_ds_read_tr16_b64_v4i16((LAS v4i16_t*)p)); }
__device__ __forceinline__ bf16x8 cat4(s16x4 a, s16x4 b) { return __builtin_shufflevector(a, b, 0, 1, 2, 3, 4, 5, 6, 7); }
__device__ __forceinline__ bf16x8 pack8(float a0, float a1, float a2, float a3, float b0, float b1, float b2, float b3) {
    v4u w; w.x = pg8::cvt_pk_bf16(a0, a1); w.y = pg8::cvt_pk_bf16(a2, a3); w.z = pg8::cvt_pk_bf16(b0, b1); w.w = pg8::cvt_pk_bf16(b2, b3); return __builtin_bit_cast(bf16x8, w);
}
__device__ __forceinline__ float xmax16(float v) { v = fmaxf(v, __shfl_xor(v, 16)); return fmaxf(v, __shfl_xor(v, 32)); }
__device__ __forceinline__ float xsum16(float v) { v += __shfl_xor(v, 16); return v + __shfl_xor(v, 32); }

__device__ __forceinline__ void nsa_fetch(const bf16* kv, int b, int jb, int g, int tid, v4u& kr, v4u& vr) {
    const bf16* p = kv + (size_t)(b * SEQ + 64 * jb + (tid >> 3)) * 256 + g * 64 + (tid & 7) * 8;
    kr = *(const v4u*)p; vr = *(const v4u*)(p + 128);
}
__device__ __forceinline__ void nsa_stash(LAS unsigned char* Kb, LAS unsigned char* Vb, int tid, const v4u& kr, const v4u& vr) {
    *(LAS v4u*)(Kb + ((tid >> 3) * NSA_KSTR + (tid & 7) * 8) * 2) = kr; *(LAS v4u*)(Vb + ((tid >> 3) * NSA_VSTR + (tid & 7) * 8) * 2) = vr;
}
template <bool FULL>
__device__ __forceinline__ void nsa_block2(const LAS unsigned char* Kb, const LAS unsigned char* Vb, const bf16x8 (&qf)[2][2], const bool (&sel)[2], const int (&klo)[2], const int (&khi)[2],
                                           float (&mrow)[2], float (&lrow)[2], f32x4v (&o)[2][4], int lane) {
    const int j = lane & 15, gq = lane >> 4;
    f32x4v s[2][4];
#pragma unroll
    for (int kt = 0; kt < 4; ++kt) {
        s[0][kt] = (f32x4v){0.f, 0.f, 0.f, 0.f}; s[1][kt] = (f32x4v){0.f, 0.f, 0.f, 0.f};
#pragma unroll
        for (int ks = 0; ks < 2; ++ks) {
            const bf16x8 kf = *(const LAS bf16x8*)(Kb + (16 * kt + j) * 128 + (((gq + 4 * ks) ^ (j & 7)) << 4));
            s[0][kt] = __builtin_amdgcn_mfma_f32_16x16x32_bf16(kf, qf[0][ks], s[0][kt], 0, 0, 0);
            s[1][kt] = __builtin_amdgcn_mfma_f32_16x16x32_bf16(kf, qf[1][ks], s[1][kt], 0, 0, 0);
        }
    }
#pragma unroll
    for (int rg = 0; rg < 2; ++rg) {
        float bm = NEGF;
        if (FULL) { const float bias = sel[rg] ? 0.f : NEGF;
#pragma unroll
            for (int kt = 0; kt < 4; ++kt)
#pragma unroll
                for (int e = 0; e < 4; ++e) { const float v = s[rg][kt][e] + bias; s[rg][kt][e] = v; bm = fmaxf(bm, v); }
        } else {
#pragma unroll
            for (int kt = 0; kt < 4; ++kt)
#pragma unroll
                for (int e = 0; e < 4; ++e) { const int ko = 16 * kt + 4 * gq + e; const bool ok = sel[rg] && ko >= klo[rg] && ko <= khi[rg]; const float v = ok ? s[rg][kt][e] : NEGF; s[rg][kt][e] = v; bm = fmaxf(bm, v); }
        }
        bm = xmax16(bm);
        const float mnew = fmaxf(mrow[rg], bm), alpha = __builtin_amdgcn_exp2f(mrow[rg] - mnew);
        const bool moved = __builtin_amdgcn_ballot_w64(mnew != mrow[rg]) != 0ull;
        mrow[rg] = mnew;
        float ps = 0.f;
#pragma unroll
        for (int kt = 0; kt < 4; ++kt)
#pragma unroll
            for (int e = 0; e < 4; ++e) { const float p = __builtin_amdgcn_exp2f(s[rg][kt][e] - mnew); s[rg][kt][e] = p; ps += p; }
        lrow[rg] = lrow[rg] * alpha + ps;
        if (moved) {
#pragma unroll
            for (int dt = 0; dt < 4; ++dt) o[rg][dt] *= alpha;
        }
    }
#pragma unroll
    for (int kk = 0; kk < 2; ++kk) {
        const bf16x8 pf0 = pack8(s[0][2 * kk][0], s[0][2 * kk][1], s[0][2 * kk][2], s[0][2 * kk][3], s[0][2 * kk + 1][0], s[0][2 * kk + 1][1], s[0][2 * kk + 1][2], s[0][2 * kk + 1][3]);
        const bf16x8 pf1 = pack8(s[1][2 * kk][0], s[1][2 * kk][1], s[1][2 * kk][2], s[1][2 * kk][3], s[1][2 * kk + 1][0], s[1][2 * kk + 1][1], s[1][2 * kk + 1][2], s[1][2 * kk + 1][3]);
#pragma unroll
        for (int dt = 0; dt < 4; ++dt) {
            const LAS unsigned char* va = Vb + (32 * kk + 4 * gq + (j >> 2)) * 128 + (16 * dt + 4 * (j & 3)) * 2;
            const bf16x8 vf = cat4(tr16(va), tr16(va + 16 * 128));
            o[0][dt] = __builtin_amdgcn_mfma_f32_16x16x32_bf16(vf, pf0, o[0][dt], 0, 0, 0);
            o[1][dt] = __builtin_amdgcn_mfma_f32_16x16x32_bf16(vf, pf1, o[1][dt], 0, 0, 0);
        }
        }
}
__device__ __forceinline__ void glds16(const void* gsrc, unsigned lds_dst) { unsigned keep;
    asm volatile("s_mov_b32 %0, m0\n\ts_mov_b32 m0, %2\n\ts_nop 0\n\tglobal_load_lds_dwordx4 %1, off\n\ts_mov_b32 m0, %0" : "=&s"(keep) : "v"(gsrc), "s"(lds_dst) : "memory"); }
template <int MODE>
__device__ __forceinline__ void nsa_attend(const bf16* kv, unsigned long long mask, int b, int g, int c, int tid, int lane, LAS unsigned char* ring, const bf16x8 (&qf)[2][2],
                                           const unsigned long long (&rmask)[2], const unsigned long long (&gmask)[2], const int (&trow)[2], float (&mrow)[2], float (&lrow)[2], f32x4v (&o)[2][4]) {
    const int wave = __builtin_amdgcn_readfirstlane(tid >> 6);
    const int rr = 8 * wave + (lane >> 3);
    const bf16* gk = kv + (size_t)(b * SEQ + rr) * 256 + g * 64 + (((lane & 7) ^ (rr & 7)) << 3);
    const bf16* gv = kv + (size_t)(b * SEQ + rr) * 256 + 128 + g * 64 + ((lane & 7) << 3);
    const unsigned ring0 = (unsigned)(uintptr_t)(unsigned char*)ring + wave * 1024;
#define NSA_ISSUE(jb_, slot_) do { glds16(gk + (size_t)(jb_) * 64 * 256, (unsigned)__builtin_amdgcn_readfirstlane(ring0 + (slot_) * NSA_SLOT)); \
                                   glds16(gv + (size_t)(jb_) * 64 * 256, (unsigned)__builtin_amdgcn_readfirstlane(ring0 + (slot_) * NSA_SLOT + 8192)); } while (0)
    unsigned long long remi = mask, remc = mask; int lastb = 0, si = 0, sc_ = 0;
#if DUP == 12
    float m2_[2] = {NEGF, NEGF}, l2_[2] = {0.f, 0.f}; f32x4v o2_[2][4]; for (int rg = 0; rg < 2; ++rg) for (int dt = 0; dt < 4; ++dt) o2_[rg][dt] = (f32x4v){0.f, 0.f, 0.f, 0.f};
#endif
#pragma unroll
    for (int d = 0; d < NSA_D - 1; ++d) { if (remi) { lastb = (int)__builtin_ctzll(remi); remi &= remi - 1ull; } NSA_ISSUE(lastb, si); si = si + 1 == NSA_D ? 0 : si + 1; }
    while (remc) {
        const int jj = (int)__builtin_ctzll(remc); remc &= remc - 1ull;
        asm volatile("s_waitcnt vmcnt(8) lgkmcnt(0)\n\ts_barrier" ::: "memory");
        if (remi) { lastb = (int)__builtin_ctzll(remi); remi &= remi - 1ull; }
        NSA_ISSUE(lastb, si); si = si + 1 == NSA_D ? 0 : si + 1;
        const LAS unsigned char* kb_ = ring + sc_ * NSA_SLOT; const LAS unsigned char* vb_ = kb_ + 8192; sc_ = sc_ + 1 == NSA_D ? 0 : sc_ + 1;
        bool sel[2]; int klo[2], khi[2]; bool act[2];
#pragma unroll
        for (int rg = 0; rg < 2; ++rg) { const int o6 = trow[rg] & 63;
            if (MODE == 0) { sel[rg] = (rmask[rg] >> jj) & 1ull; act[rg] = (gmask[rg] >> jj) & 1ull; klo[rg] = 0; khi[rg] = (jj == c) ? o6 : 63; }
            else { sel[rg] = true; act[rg] = true; klo[rg] = (jj == c - 4) ? o6 + 1 : 0; khi[rg] = (jj == c) ? o6 : 63; } }
        if (act[0] || act[1]) {
            const bool full = (MODE == 0) ? (jj != c) : (jj != c && jj != c - 4);
            if (full) nsa_block2<true>(kb_, vb_, qf, sel, klo, khi, mrow, lrow, o, lane); else nsa_block2<false>(kb_, vb_, qf, sel, klo, khi, mrow, lrow, o, lane);
#if DUP == 12
            if (full) nsa_block2<true>(kb_, vb_, qf, sel, klo, khi, m2_, l2_, o2_, lane); else nsa_block2<false>(kb_, vb_, qf, sel, klo, khi, m2_, l2_, o2_, lane);
#endif
        }
    }
#if DUP == 12
    { float acc_ = 0.f; for (int rg = 0; rg < 2; ++rg) { acc_ += l2_[rg] + m2_[rg]; for (int dt = 0; dt < 4; ++dt) acc_ += o2_[rg][dt][0] + o2_[rg][dt][1] + o2_[rg][dt][2] + o2_[rg][dt][3]; } if (acc_ == 123.456f) ((LAS float*)(ring + NSA_D * NSA_SLOT + 600))[0] = acc_; }
#endif
    asm volatile("s_waitcnt vmcnt(0) lgkmcnt(0)\n\ts_barrier" ::: "memory");
#undef NSA_ISSUE
}
#if defined(PROBE_CMP)
__device__ __forceinline__ void nsa_probe_store(unsigned char* ws, int row, int head, int gq, const f32x4v (&v)[4]) {
    bf16* pb_ = (bf16*)(ws + 497 * MiB);
    for (int dt = 0; dt < 4; ++dt) { uint2 w; w.x = cvtpk(v[dt][0], v[dt][1]); w.y = cvtpk(v[dt][2], v[dt][3]); *(uint2*)(pb_ + (size_t)row * 512 + head * 64 + 16 * dt + 4 * gq) = w; }
}
#endif
__device__ __forceinline__ void nsa_unit(unsigned char* ws, int unit, LAS unsigned char* lds, int tid_in, bf16* yout) {
    int tid = tid_in; asm volatile("" : "+v"(tid));
    const int lane = tid & 63, wave = __builtin_amdgcn_readfirstlane(tid >> 6), j = lane & 15, gq = lane >> 4;
    const int c = unit & 63, g = (unit >> 6) & 1, b = unit >> 7, bg = b * 2 + g;
    LAS float* impa = (LAS float*)(lds + NSA_OFF_IMPA); LAS float* impb = (LAS float*)(lds + NSA_OFF_IMPB);
    LAS unsigned long long* um = (LAS unsigned long long*)(lds + NSA_OFF_UM);
    TP_DECL
    for (int i = tid; i < 2 * 64 * 65; i += 512) impa[i] = 0.f;
    {
        const v4u* ksrc = (const v4u*)((const bf16*)(ws + WS_KC) + (size_t)bg * 256 * 64); const v4u* vsrc = (const v4u*)((const bf16*)(ws + WS_VC) + (size_t)bg * 64 * 256);
#pragma unroll
        for (int i = 0; i < 4; ++i) { const int idx = tid + 512 * i; const int r = idx >> 3, sg = idx & 7; *(LAS v4u*)(lds + NSA_OFF_KCL + r * 128 + ((sg ^ (r & 7)) << 4)) = ksrc[idx]; }
#pragma unroll
        for (int i = 0; i < 4; ++i) { const int idx = tid + 512 * i; const int r = idx >> 5, sg = idx & 31; *(LAS v4u*)(lds + NSA_OFF_VCTL + r * 512 + ((sg ^ (r & 15)) << 4)) = vsrc[idx]; }
    }
    bf16* qc = (bf16*)(ws + WS_QC);
    const bf16* misc = (const bf16*)(ws + WS_MISC);
    bf16x8 qf[2][2]; float gate[2][3]; int trow[2];
#pragma unroll
    for (int rg = 0; rg < 2; ++rg) {
        const int q = 8 * wave + 4 * rg + (j >> 2), t = 64 * c + q, row = b * SEQ + t, head = g * 4 + (j & 3);
        trow[rg] = t;
#pragma unroll
        for (int ks = 0; ks < 2; ++ks) qf[rg][ks] = *(const bf16x8*)(qc + (size_t)row * 512 + head * 64 + 8 * gq + 32 * ks);
#pragma unroll
        for (int e = 0; e < 3; ++e) gate[rg][e] = __builtin_amdgcn_rcpf(1.0f + __expf(-bf2f(misc[(size_t)row * 256 + 196 + head * 3 + e])));
    }
    typedef unsigned u32x2v __attribute__((ext_vector_type(2)));
    LAS u32x2v* stash = (LAS u32x2v*)(lds + NSA_OFF_ST) + tid * 8;
    __syncthreads();
    const int nT = (c >> 2) + 1;
#pragma unroll
    for (int rg = 0; rg < 2; ++rg) {
        const int t = trow[rg], nv = t >= 31 ? ((t - 15) >> 4) : 0;
        f32x4v s[16]; float mx = NEGF;
#pragma unroll
        for (int T = 0; T < 16; ++T) {
            s[T] = (f32x4v){0.f, 0.f, 0.f, 0.f};
            if (T < nT) {
#pragma unroll
                for (int ks = 0; ks < 2; ++ks) { const bf16x8 kf = *(const LAS bf16x8*)(lds + NSA_OFF_KCL + (16 * T + j) * 128 + (((gq + 4 * ks) ^ (j & 7)) << 4)); s[T] = __builtin_amdgcn_mfma_f32_16x16x32_bf16(kf, qf[rg][ks], s[T], 0, 0, 0); }
#pragma unroll
                for (int e = 0; e < 4; ++e) { const float v = (16 * T + 4 * gq + e < nv) ? s[T][e] : NEGF; s[T][e] = v; mx = fmaxf(mx, v); }
            }
        }
        mx = xmax16(mx);
        float ls = 0.f;
#pragma unroll
        for (int T = 0; T < 16; ++T) if (T < nT) {
#pragma unroll
            for (int e = 0; e < 4; ++e) { const float p = (16 * T + 4 * gq + e < nv) ? __builtin_amdgcn_exp2f(s[T][e] - mx) : 0.f; s[T][e] = p; ls += p; }
        }
        ls = xsum16(ls);
        const float inv = nv > 0 ? __builtin_amdgcn_rcpf(ls) : 0.f;
        const int q = 8 * wave + 4 * rg + (j >> 2);
#pragma unroll
        for (int T = 0; T < 16; ++T) if (T < nT) {
#pragma unroll
            for (int e = 0; e < 4; ++e) s[T][e] *= inv;
            float a = s[T][0] + s[T][1] + s[T][2] + 0.5f * s[T][3], bb = 0.5f * s[T][3];
            a += __shfl_xor(a, 1); a += __shfl_xor(a, 2); bb += __shfl_xor(bb, 1); bb += __shfl_xor(bb, 2);
            if ((j & 3) == 0) { impa[q * 65 + 4 * T + gq] = a; impb[q * 65 + 4 * T + gq + 1] = bb; }
        }
        f32x4v oc[4];
#pragma unroll
        for (int dt = 0; dt < 4; ++dt) oc[dt] = (f32x4v){0.f, 0.f, 0.f, 0.f};
#pragma unroll
        for (int kk = 0; kk < 8; ++kk) if (2 * kk < nT) {
            const bf16x8 pf = pack8(s[2 * kk][0], s[2 * kk][1], s[2 * kk][2], s[2 * kk][3], s[2 * kk + 1][0], s[2 * kk + 1][1], s[2 * kk + 1][2], s[2 * kk + 1][3]);
#pragma unroll
            for (int dt = 0; dt < 4; ++dt) {
                const LAS unsigned char* vp = lds + NSA_OFF_VCTL + (16 * dt + j) * 512 + (gq & 1) * 8;
                const s16x4 v0 = *(const LAS s16x4*)(vp + ((((8 * kk + gq) >> 1) ^ j) << 4)), v1 = *(const LAS s16x4*)(vp + (((((8 * kk + gq) >> 1) + 2) ^ j) << 4));
                oc[dt] = __builtin_amdgcn_mfma_f32_16x16x32_bf16(cat4(v0, v1), pf, oc[dt], 0, 0, 0);
            }
        }
#pragma unroll
        for (int dt = 0; dt < 4; ++dt) { const f32x4v v = oc[dt] * gate[rg][0]; u32x2v w; w.x = pg8::cvt_pk_bf16(v[0], v[1]); w.y = pg8::cvt_pk_bf16(v[2], v[3]); stash[rg * 4 + dt] = w; }
        __builtin_amdgcn_sched_barrier(0);
    }
    __syncthreads();
    TP_MARK(5);
    unsigned long long smask[8], mymask = 0ull;
#pragma unroll
    for (int qi = 0; qi < 8; ++qi) {
        const int q = 8 * wave + qi;
#if PROBE == 4
        const float imp = ((const float*)(ws + 500 * MiB))[((size_t)(b * SEQ + 64 * c + q) * 2 + g) * 64 + lane];
#else
        const float imp = impa[q * 65 + lane] + impb[q * 65 + lane];
#endif
#if PROBE && (PROBE != 5 || defined(PROBE5_IMP))
        ((float*)(ws + 516 * MiB))[((size_t)(b * SEQ + 64 * c + q) * 2 + g) * 64 + lane] = (lane <= c) ? imp : 0.f;
#endif
        const bool forced = (lane == 0) || (lane == c), adm = lane <= c;
        unsigned key = forced ? (0xFFFFFF00u | (unsigned)(63 - lane)) : (adm ? ((__float_as_uint(imp) & 0xFFFFFFC0u) | (unsigned)(63 - lane)) : 0u);
        unsigned long long mk = 0ull;
#if TOP8_RANK
        { int rank = 0;
#pragma unroll
          for (int jj = 0; jj < 64; ++jj) { const unsigned kk = (unsigned)__builtin_amdgcn_readlane((int)key, jj); rank += (kk > key) ? 1 : 0; }
          mk = __ballot(key != 0u && rank < 8); }
#else
        for (int k = 0; k < 8; ++k) { const unsigned mx = wave_max_u(key); if (mx == 0u) break; const int win = 63 - (int)(mx & 63u); mk |= 1ull << win; if (lane == win) key = 0u; }
#endif
        mk = ((unsigned long long)(unsigned)__builtin_amdgcn_readfirstlane((unsigned)(mk >> 32)) << 32) | (unsigned long long)(unsigned)__builtin_amdgcn_readfirstlane((unsigned)mk);
#ifdef FIXSEL
        { mk = 1ull | (1ull << c); for (int d = 1; d <= 6; ++d) mk |= 1ull << (((FIXHOM ? 0 : q * 7) + d * 5) % (c + 1)); }
#endif
#if PROBE == 2
        mk = ((const unsigned long long*)(ws + 496 * MiB))[(size_t)(b * SEQ + 64 * c + q) * 2 + g];
        mk = ((unsigned long long)(unsigned)__builtin_amdgcn_readfirstlane((unsigned)(mk >> 32)) << 32) | (unsigned long long)(unsigned)__builtin_amdgcn_readfirstlane((unsigned)mk);
#endif
#if PROBE == 5
        if (lane == 0) ((unsigned long long*)(ws + 498 * MiB))[(size_t)(b * SEQ + 64 * c + q) * 2 + g] = mk;
#endif
#if PROBE == 5 && !defined(PROBE5_IMP)
        ((float*)(ws + 516 * MiB))[((size_t)(b * SEQ + 64 * c + q) * 2 + g) * 64 + lane] = ((mk >> lane) & 1ull) ? 1.f : 0.f;
#endif
        smask[qi] = mk; mymask |= mk;
    }
    if (lane == 0) um[wave] = mymask;
    __syncthreads();
    unsigned long long umask = 0ull;
#pragma unroll
    for (int w = 0; w < 8; ++w) umask |= um[w];
    umask = ((unsigned long long)(unsigned)__builtin_amdgcn_readfirstlane((unsigned)(umask >> 32)) << 32) | (unsigned long long)(unsigned)__builtin_amdgcn_readfirstlane((unsigned)umask);
    unsigned long long rmask[2];
    { LAS unsigned long long* qm = (LAS unsigned long long*)(lds + NSA_OFF_QM);
      __syncthreads();
#pragma unroll
      for (int qi = 0; qi < 8; ++qi) if (lane == 0) qm[8 * wave + qi] = smask[qi];
      __syncthreads();
#pragma unroll
      for (int rg = 0; rg < 2; ++rg) rmask[rg] = qm[8 * wave + 4 * rg + (j >> 2)]; }
    const unsigned long long gmask[2] = {smask[0] | smask[1] | smask[2] | smask[3], smask[4] | smask[5] | smask[6] | smask[7]};
    TP_MARK(6); TP_ADD(9, __popcll(umask)); TP_ADD(10, 1); TP_ADD(11, c + 1); TP_ADD(12, __popcll(umask & ~(c == 63 ? ~0ull : ((2ull << c) - 1ull)))); TP_ADD(13, __popcll(smask[0]));
    const bf16* kvs = (const bf16*)(ws + WS_KVS); const bf16* kvw = (const bf16*)(ws + WS_KVW);
    LAS unsigned char* ring = lds + NSA_OFF_RING;
    {
        float mrow[2] = {NEGF, NEGF}, lrow[2] = {0.f, 0.f}; f32x4v o[2][4];
#pragma unroll
        for (int rg = 0; rg < 2; ++rg)
#pragma unroll
            for (int dt = 0; dt < 4; ++dt) o[rg][dt] = (f32x4v){0.f, 0.f, 0.f, 0.f};
        nsa_attend<0>(kvs, umask, b, g, c, tid, lane, ring, qf, rmask, gmask, trow, mrow, lrow, o);
#if DUP == 8
        { __syncthreads(); float m2[2] = {NEGF, NEGF}, l2[2] = {0.f, 0.f}; f32x4v o2[2][4];
          for (int rg = 0; rg < 2; ++rg) for (int dt = 0; dt < 4; ++dt) o2[rg][dt] = (f32x4v){0.f, 0.f, 0.f, 0.f};
          nsa_attend<0>(kvs, umask, b, g, c, tid, lane, Kb, Vb, qf, rmask, gmask, trow, m2, l2, o2);
          bf16* dmy = (bf16*)(ws + WS_BU) + (size_t)(b * SEQ + trow[0]) * 512 + (g * 4 + (j & 3)) * 64 + 4 * gq;
          for (int rg = 0; rg < 2; ++rg) for (int dt = 0; dt < 4; ++dt) { uint2 w; w.x = pg8::cvt_pk_bf16(o2[rg][dt][0] + l2[rg], o2[rg][dt][1]); w.y = pg8::cvt_pk_bf16(o2[rg][dt][2], o2[rg][dt][3]); *(uint2*)(dmy + 16 * dt) = w; } }
#endif
#pragma unroll
        for (int rg = 0; rg < 2; ++rg) { const float sc = gate[rg][1] * __builtin_amdgcn_rcpf(xsum16(lrow[rg]));
#pragma unroll
            for (int dt = 0; dt < 4; ++dt) { const u32x2v p = stash[rg * 4 + dt]; const f32x4v v = o[rg][dt] * sc; u32x2v w; w.x = pg8::cvt_pk_bf16(v[0] + bflo(p.x), v[1] + bfhi(p.x)); w.y = pg8::cvt_pk_bf16(v[2] + bflo(p.y), v[3] + bfhi(p.y)); stash[rg * 4 + dt] = w; }
            }
        __syncthreads();
    }
    TP_MARK(7);
    {
        float mrow[2] = {NEGF, NEGF}, lrow[2] = {0.f, 0.f}; f32x4v o[2][4];
#pragma unroll
        for (int rg = 0; rg < 2; ++rg)
#pragma unroll
            for (int dt = 0; dt < 4; ++dt) o[rg][dt] = (f32x4v){0.f, 0.f, 0.f, 0.f};
        { const int j0 = c - 4 > 0 ? c - 4 : 0; const unsigned long long wmask = ((c == 63 ? ~0ull : ((1ull << (c + 1)) - 1ull)) >> j0) << j0;
          nsa_attend<1>(kvw, wmask, b, g, c, tid, lane, ring, qf, rmask, gmask, trow, mrow, lrow, o); }
#pragma unroll
        for (int rg = 0; rg < 2; ++rg) { const float sc = gate[rg][2] * __builtin_amdgcn_rcpf(xsum16(lrow[rg]));
#pragma unroll
            for (int dt = 0; dt < 4; ++dt) { const u32x2v p = stash[rg * 4 + dt]; const f32x4v v = o[rg][dt] * sc; uint2 w; w.x = pg8::cvt_pk_bf16(v[0] + bflo(p.x), v[1] + bfhi(p.x)); w.y = pg8::cvt_pk_bf16(v[2] + bflo(p.y), v[3] + bfhi(p.y));
                *(uint2*)(yout + (size_t)(b * SEQ + trow[rg]) * 512 + (g * 4 + (j & 3)) * 64 + 16 * dt + 4 * gq) = w; }
            }
    }
    __syncthreads();
    TP_MARK(8);
}
__device__ __forceinline__ void prep_kva16(unsigned char* ws, int task, int lane) {
    const int j = lane & 15, gq = lane >> 4, row = task * 16 + j;
    const bf16* misc = (const bf16*)(ws + WS_MISC) + (size_t)row * 256 + 64;
    const bf16* wu = (const bf16*)(ws + WS_W + WO_UKV);
    bf16x8 cf[4]; float ss = 0.f;
#pragma unroll
    for (int ks = 0; ks < 4; ++ks) { const v4u v = *(const v4u*)(misc + 8 * gq + 32 * ks); cf[ks] = __builtin_bit_cast(bf16x8, v); float f[8]; unpack8(v, f);
#pragma unroll
        for (int e = 0; e < 8; ++e) ss += f[e] * f[e]; }
    ss = xsum16(ss);
    const float r = 1.0f / sqrtf(ss * (1.f / 128.f) + EPS);
    const float* rp = (const float*)(ws + WS_ROPE) + (size_t)row * 16;
    bf16* o = (bf16*)(ws + WS_KVA) + (size_t)row * 128;
#pragma unroll
    for (int ct = 0; ct < 8; ++ct) {
        f32x4v a = {0.f, 0.f, 0.f, 0.f};
#pragma unroll
        for (int ks = 0; ks < 4; ++ks) { const bf16x8 wf = *(const bf16x8*)(wu + (size_t)(16 * ct + j) * 128 + 8 * gq + 32 * ks); a = __builtin_amdgcn_mfma_f32_16x16x32_bf16(wf, cf[ks], a, 0, 0, 0); }
        a *= r;
        if (ct == 0) {
            const float c0 = rp[2 * gq], s0 = rp[8 + 2 * gq], c1 = rp[2 * gq + 1], s1 = rp[8 + 2 * gq + 1];
            const float x0 = a[0], x1 = a[1], x2 = a[2], x3 = a[3];
            a[0] = x0 * c0 - x1 * s0; a[1] = x1 * c0 + x0 * s0; a[2] = x2 * c1 - x3 * s1; a[3] = x3 * c1 + x2 * s1;
        }
        uint2 w; w.x = cvtpk(a[0], a[1]); w.y = cvtpk(a[2], a[3]);
        *(uint2*)(o + 16 * ct + 4 * gq) = w;
    }
}
__device__ __forceinline__ void prep_pool16(unsigned char* ws, int task, int lane, const LAS unsigned char* wl) {
    const int j = lane & 15, gq = lane >> 4, row = task * 16 + j, t = row & (SEQ - 1);
    const bf16* bu = (const bf16*)(ws + WS_BU);
    bf16* yb = (bf16*)(ws + WS_YB) + (size_t)row * 512;
#pragma unroll 1
    for (int g = 0; g < 4; ++g) {
        const int w = 2 << g, lo = (t + 1 - w) > 0 ? (t + 1 - w) : 0, cnt = t + 1 - lo; const float inv = 1.0f / (float)cnt;
        bf16x8 pf[4];
#pragma unroll
        for (int ks = 0; ks < 4; ++ks) {
            const bf16* p = bu + (size_t)row * 512 + g * 128 + 8 * gq + 32 * ks;
            float sum[8] = {0.f, 0.f, 0.f, 0.f, 0.f, 0.f, 0.f, 0.f}, cur[8];
            { const v4u v = *(const v4u*)p; unpack8(v, cur);
#pragma unroll
              for (int e = 0; e < 8; ++e) sum[e] = cur[e]; }
            v4u wv_[15];
#pragma unroll
            for (int i = 1; i < 16; ++i) if (i < w) wv_[i - 1] = *(const v4u*)(p - (size_t)(i < cnt ? i : 0) * 512);
#pragma unroll
            for (int i = 1; i < 16; ++i) if (i < w) { const bool ok = i < cnt; float f[8]; unpack8(wv_[i - 1], f);
#pragma unroll
                for (int e = 0; e < 8; ++e) sum[e] += ok ? f[e] : 0.f; }
            __builtin_amdgcn_sched_barrier(0);
            pf[ks] = pack8(sum[0] * inv - cur[0], sum[1] * inv - cur[1], sum[2] * inv - cur[2], sum[3] * inv - cur[3], sum[4] * inv - cur[4], sum[5] * inv - cur[5], sum[6] * inv - cur[6], sum[7] * inv - cur[7]);
        }
#pragma unroll
        for (int dt = 0; dt < 8; ++dt) {
            f32x4v a = {0.f, 0.f, 0.f, 0.f};
#pragma unroll
            for (int ks = 0; ks < 4; ++ks) {
#if POOLDBG == 1
                bf16x8 wf; for (int e = 0; e < 8; ++e) wf[e] = (short)0x3c00;
#else
                const bf16x8 wf = *(const LAS bf16x8*)(wl + (g * 128 + 16 * dt + j) * 256 + (((gq + 4 * ks) ^ j) << 4));
#endif
#if POOLDBG == 2
                bf16x8 pz; for (int e = 0; e < 8; ++e) pz[e] = (short)0x3c00; a = __builtin_amdgcn_mfma_f32_16x16x32_bf16(wf, pz, a, 0, 0, 0);
#else
                a = __builtin_amdgcn_mfma_f32_16x16x32_bf16(wf, pf[ks], a, 0, 0, 0);
#endif
            }
            uint2 wv; wv.x = cvtpk(a[0], a[1]); wv.y = cvtpk(a[2], a[3]);
            *(uint2*)(yb + g * 128 + 16 * dt + 4 * gq) = wv;
        }
    }
}
__device__ __forceinline__ float gelu_tanh_f(float x) { const float u = 0.7978845608028654f * (x + 0.044715f * x * x * x); const float e = __expf(2.0f * u); return 0.5f * x * (1.0f + (1.0f - 2.0f / (e + 1.0f))); }
__device__ __forceinline__ void prep_cmp16(unsigned char* ws, int task, LAS unsigned char* lds, int wave, int lane) {
    const int j = lane & 15, gq = lane >> 4, grp = wave >> 2, wq = wave & 3;
    const int i0 = (task & 15) * 16, bg = (task >> 4) & 15, br = task >> 8, b = bg >> 1, g = bg & 1, i = i0 + j;
    const bf16* kvc = (const bf16*)(ws + WS_KVC);
    const bf16* w1 = (const bf16*)(ws + WS_W + WO_CW1) + (size_t)br * 128 * 2048;
    const bf16* w2 = (const bf16*)(ws + WS_W + WO_CW2) + (size_t)br * 64 * 128;
    const float* posb = (const float*)(ws + WS_W + WO_POSB) + br * 128;
    LAS float* part = (LAS float*)lds + (size_t)grp * 4 * 32 * 64;
    f32x4v h[8];
#pragma unroll
    for (int nt = 0; nt < 8; ++nt) h[nt] = (f32x4v){0.f, 0.f, 0.f, 0.f};
#pragma unroll 4
    for (int k2 = 0; k2 < 16; ++k2) {
        const int ks = 16 * wq + k2, l = ks >> 1; int tok = 16 * i + l; tok = tok > SEQ - 1 ? SEQ - 1 : tok;
        const bf16x8 ff = *(const bf16x8*)(kvc + (size_t)(b * SEQ + tok) * 256 + br * 128 + g * 64 + 32 * (ks & 1) + 8 * gq);
#pragma unroll
        for (int nt = 0; nt < 8; ++nt) { const bf16x8 wf = *(const bf16x8*)(w1 + (size_t)(16 * nt + j) * 2048 + 32 * ks + 8 * gq); h[nt] = __builtin_amdgcn_mfma_f32_16x16x32_bf16(wf, ff, h[nt], 0, 0, 0); }
    }
#pragma unroll
    for (int nt = 0; nt < 8; ++nt)
#pragma unroll
        for (int e = 0; e < 4; ++e) part[(wq * 32 + nt * 4 + e) * 64 + lane] = h[nt][e];
    __syncthreads();
    if (wq == 0) {
#pragma unroll
        for (int nt = 0; nt < 8; ++nt) { const f32x4v pbv = *(const f32x4v*)(posb + 16 * nt + 4 * gq);
#pragma unroll
            for (int e = 0; e < 4; ++e) { const int idx = (nt * 4 + e) * 64 + lane; h[nt][e] = gelu_tanh_f(((part[idx] + part[32 * 64 + idx]) + (part[2 * 32 * 64 + idx] + part[3 * 32 * 64 + idx])) + pbv[e]); } }
        f32x4v o[4];
#pragma unroll
        for (int dt = 0; dt < 4; ++dt) o[dt] = (f32x4v){0.f, 0.f, 0.f, 0.f};
#pragma unroll
        for (int kk = 0; kk < 4; ++kk) {
            const bf16x8 hf = pack8(h[2 * kk][0], h[2 * kk][1], h[2 * kk][2], h[2 * kk][3], h[2 * kk + 1][0], h[2 * kk + 1][1], h[2 * kk + 1][2], h[2 * kk + 1][3]);
#pragma unroll
            for (int dt = 0; dt < 4; ++dt) { const bf16* wp = w2 + (size_t)(16 * dt + j) * 128 + 32 * kk + 4 * gq; const s16x4 v0 = *(const s16x4*)wp, v1 = *(const s16x4*)(wp + 16);
                o[dt] = __builtin_amdgcn_mfma_f32_16x16x32_bf16(cat4(v0, v1), hf, o[dt], 0, 0, 0); }
        }
        const bool dead = i == 255;
        if (br == 0) { bf16* kc = (bf16*)(ws + WS_KC) + ((size_t)bg * 256 + i) * 64;
#pragma unroll
            for (int dt = 0; dt < 4; ++dt) { uint2 w; w.x = dead ? 0u : cvtpk(o[dt][0], o[dt][1]); w.y = dead ? 0u : cvtpk(o[dt][2], o[dt][3]); *(uint2*)(kc + 16 * dt + 4 * gq) = w; }
        } else { bf16* vct = (bf16*)(ws + WS_VC) + (size_t)bg * 64 * 256 + i;
#pragma unroll
            for (int dt = 0; dt < 4; ++dt)
#pragma unroll
                for (int e = 0; e < 4; ++e) vct[(size_t)(16 * dt + 4 * gq + e) * 256] = dead ? (bf16)0 : (bf16)f2bf(o[dt][e]);
        }
    }
    __syncthreads();
}
__device__ __forceinline__ void phase_prep(const Args& P, unsigned char* ws, int z, int l, LAS unsigned char* lds, int gw, int NGW, int lane, int wave) {
    asm volatile("" : "+v"(lane)); lane &= 63; asm volatile("" : "+s"(gw), "+s"(NGW));
    for (int it = 2 * (gw >> 3) + (wave >> 2); it < 512 + (wave >> 2); it += 2 * (NGW >> 3)) prep_cmp16(ws, it < 512 ? it : 511, lds, wave, lane);
    {
        const v4u* src = (const v4u*)(ws + WS_W + WO_POOL); const int t_ = (wave << 6) | lane;
#pragma unroll
        for (int i = 0; i < 16; ++i) { const int idx = t_ + 512 * i, r = idx >> 4, sg = idx & 15; *(LAS v4u*)(lds + r * 256 + ((sg ^ (r & 15)) << 4)) = src[idx]; }
        __syncthreads();
    }
    for (int it = gw; it < M / 16; it += NGW) { prep_kva16(ws, it, lane); prep_pool16(ws, it, lane, lds); }
    __syncthreads();
}
constexpr int DSA_K = DSA_K_V, DSA_S = 32 - DSA_K, DSA_CAP = DSA_CAP_V;
constexpr int DSA_OFF_CNT = 0, DSA_OFF_PC = 3072, DSA_OFF_LIST = DSA_OFF_PC + 32 * 16 * 4, DSA_OFF_V = DSA_OFF_LIST + 16 * 256 * 2, DSA_VB = 64 * NSA_VSTR * 2, DSA_LDS = DSA_OFF_V + 8 * DSA_VB;
#define DSA_FOR_TILES(...) _Pragma("unroll") for (int G8 = 0; G8 < 8; ++G8) { if (G8 < ngrp) { _Pragma("unroll") for (int T8 = 0; T8 < 4; ++T8) { const int T = G8 * 4 + T8; __VA_ARGS__ } } }
__device__ __forceinline__ void cnt_ge(int& c, unsigned u, unsigned cand) { asm volatile("v_cmp_ge_u32_e32 vcc, %1, %2\n\tv_addc_co_u32_e32 %0, vcc, 0, %0, vcc" : "+v"(c) : "v"(u), "v"(cand) : "vcc"); }
__device__ __forceinline__ void cnt_gt(int& c, unsigned u, unsigned cand) { asm volatile("v_cmp_gt_u32_e32 vcc, %1, %2\n\tv_addc_co_u32_e32 %0, vcc, 0, %0, vcc" : "+v"(c) : "v"(u), "v"(cand) : "vcc"); }
__device__ __forceinline__ void cnt_le(int& c, unsigned u, unsigned cand) { asm volatile("v_cmp_le_u32_e32 vcc, %1, %2\n\tv_addc_co_u32_e32 %0, vcc, 0, %0, vcc" : "+v"(c) : "v"(u), "v"(cand) : "vcc"); }
__device__ __forceinline__ int dsa_total(LAS unsigned* cnt, int par, int wave, int j, int gq, int c) {
    c += __shfl_xor(c, 16); c += __shfl_xor(c, 32);
    if (gq == 0) cnt[(par * 8 + wave) * 16 + j] = (unsigned)c;
    __syncthreads();
    int tot = 0;
#pragma unroll
    for (int w = 0; w < 8; ++w) tot += (int)cnt[(par * 8 + w) * 16 + j];
    return tot;
}
__device__ __forceinline__ void dsa_unit(unsigned char* ws, int unit, LAS unsigned char* lds, int tid_in, bf16* yout) {
    int tid = tid_in; asm volatile("" : "+v"(tid));
    const int lane = tid & 63, wave = __builtin_amdgcn_readfirstlane(tid >> 6), j = lane & 15, gq = lane >> 4;
    const int b = unit >> 8, q0 = (unit & 255) * 16, t = q0 + j, row = b * SEQ + t;
    LAS unsigned* cnt = (LAS unsigned*)(lds + DSA_OFF_CNT); LAS unsigned* pc = (LAS unsigned*)(lds + DSA_OFF_PC);
    LAS unsigned short* list = (LAS unsigned short*)(lds + DSA_OFF_LIST);
    const bf16* misc = (const bf16*)(ws + WS_MISC);
    TP_DECL
    if (q0 >= 256) {
        const int ntiles = (q0 >> 4) + 1;
        const int ntl = wave < ntiles ? ((ntiles - 1 - wave) >> 3) + 1 : 0;
        const int ngrp = (ntl + 3) >> 2;
        bf16x8 qf[4][2]; float iw[4];
        { const bf16* iq = (const bf16*)(ws + WS_IQ) + (size_t)row * 256;
#pragma unroll
          for (int h = 0; h < 4; ++h) { iw[h] = 0.5f * bf2f(misc[(size_t)row * 256 + 192 + h]);
#pragma unroll
              for (int ks = 0; ks < 2; ++ks) qf[h][ks] = *(const bf16x8*)(iq + h * 64 + 8 * gq + 32 * ks); } }
        unsigned u[32][4];
#pragma unroll
        for (int T = 0; T < 32; ++T)
#pragma unroll
            for (int e = 0; e < 4; ++e) u[T][e] = 0u;
        const int kb0 = 16 * wave + 4 * gq;
        LAS unsigned char* ring = lds + DSA_OFF_V + wave * 16384;
#define DSA_ISSUE(Ti) do { _Pragma("unroll") for (int i_ = 0; i_ < 2; ++i_) { const int r_ = 8 * i_ + (lane >> 3); int kr_ = 16 * wave + 128 * (Ti) + r_; kr_ = kr_ > SEQ - 1 ? SEQ - 1 : kr_; \
            __builtin_amdgcn_global_load_lds((const unsigned*)(misc + (size_t)(b * SEQ + kr_) * 256 + (((lane & 7) ^ (r_ & 7)) << 3)), (LAS unsigned*)(ring + ((Ti) & 7) * 2048 + i_ * 1024), 16, 0, 0); } } while (0)
        if (ngrp > 0) {
#pragma unroll
            for (int T = 0; T < 8; ++T) DSA_ISSUE(T);
        }
        DSA_FOR_TILES(
            asm volatile("s_waitcnt vmcnt(14)" ::: "memory");
            const LAS unsigned char* tp = ring + (T & 7) * 2048 + j * 128;
            const bf16x8 kf0 = *(const LAS bf16x8*)(tp + ((gq ^ (j & 7)) << 4)); const bf16x8 kf1 = *(const LAS bf16x8*)(tp + (((gq + 4) ^ (j & 7)) << 4));
            asm volatile("s_waitcnt lgkmcnt(0)" ::: "memory");
            DSA_ISSUE(T + 8);
            float sc[4] = {0.f, 0.f, 0.f, 0.f};
            _Pragma("unroll") for (int h = 0; h < 4; ++h) {
                f32x4v a = {0.f, 0.f, 0.f, 0.f};
                a = __builtin_amdgcn_mfma_f32_16x16x32_bf16(kf0, qf[h][0], a, 0, 0, 0);
                a = __builtin_amdgcn_mfma_f32_16x16x32_bf16(kf1, qf[h][1], a, 0, 0, 0);
                _Pragma("unroll") for (int e = 0; e < 4; ++e) { const int ai_ = (int)__float_as_uint(a[e]); sc[e] += iw[h] * __uint_as_float((unsigned)(ai_ > 0 ? ai_ : 0)); }
                asm volatile("" : "+v"(sc[0]), "+v"(sc[1]), "+v"(sc[2]), "+v"(sc[3]));
            }
            _Pragma("unroll") for (int e = 0; e < 4; ++e) { unsigned x = f2o(sc[e]); asm volatile("" : "+v"(x)); u[T][e] = (kb0 + 128 * T + e <= t) ? x : 0u; }
        )
        asm volatile("s_waitcnt vmcnt(0)" ::: "memory");
#undef DSA_ISSUE
        TP_MARK(0);
        unsigned prefix = 0u; bool exact = false; int par = 0; int cab = 0;
        LAS unsigned* lcnt = (LAS unsigned*)(lds + DSA_OFF_V); LAS unsigned* lcab = lcnt + 16; LAS unsigned* lvst = lcnt + 32; LAS unsigned* lexf = lcnt + 48; LAS unsigned* llist = lcnt + 64;
        if (tid < 16) lcnt[tid] = 0u;
#pragma unroll 1
        for (int bit = 31; bit >= DSA_S; --bit) {
            const unsigned cand = prefix | (1u << bit); int c0 = 0, c1 = 0;
            DSA_FOR_TILES(cnt_ge(c0, u[T][0], cand); cnt_ge(c1, u[T][1], cand); cnt_ge(c0, u[T][2], cand); cnt_ge(c1, u[T][3], cand);)
            const int tot = dsa_total(cnt, par, wave, j, gq, c0 + c1); par ^= 1;
            if (tot >= 256) prefix = cand; else cab = tot;
        }
        TP_MARK(1);
        { const unsigned ptop = prefix >> DSA_S;
          DSA_FOR_TILES(unsigned pos_[4]; bool cd_[4];
              _Pragma("unroll") for (int e = 0; e < 4; ++e) { const unsigned x = u[T][e]; cd_[e] = x != 0u && (x >> DSA_S) == ptop; pos_[e] = DSA_CAP; }
              _Pragma("unroll") for (int e = 0; e < 4; ++e) if (cd_[e]) pos_[e] = __hip_atomic_fetch_add(&lcnt[j], 1u, __ATOMIC_RELAXED, __HIP_MEMORY_SCOPE_WORKGROUP);
              _Pragma("unroll") for (int e = 0; e < 4; ++e) if (pos_[e] < DSA_CAP) llist[j * DSA_CAP + pos_[e]] = u[T][e];)
          if (wave == 0 && gq == 0) lcab[j] = (unsigned)cab; }
        __syncthreads();
        const bool ovf = __any(lcnt[j] > (unsigned)DSA_CAP);
        TP_ADD(14, ovf ? 1 : 0); TP_ADD(15, 1);
        if (!ovf) {
#pragma unroll 1
            for (int qq = 0; qq < 2; ++qq) {
                const int q = 2 * wave + qq; const int n = (int)lcnt[q]; const int r = 256 - (int)lcab[q];
                unsigned ev[DSA_CAP / 64];
#pragma unroll
                for (int i = 0; i < DSA_CAP / 64; ++i) ev[i] = (lane + 64 * i < n) ? llist[q * DSA_CAP + lane + 64 * i] : 0u;
                unsigned p2 = (unsigned)__shfl((int)prefix, q);
#pragma unroll 1
                for (int bit = DSA_S - 1; bit >= 0; --bit) {
                    const unsigned cand = p2 | (1u << bit); int c = 0;
#pragma unroll
                    for (int i = 0; i < DSA_CAP / 64; ++i) c += __popcll(__ballot(ev[i] >= cand));
                    if (c >= r) p2 = cand;
                }
                int cf = 0;
#pragma unroll
                for (int i = 0; i < DSA_CAP / 64; ++i) cf += __popcll(__ballot(ev[i] >= p2));
                if (lane == 0) { lvst[q] = p2; lexf[q] = (cf == r) ? 1u : 0u; }
            }
            __syncthreads();
            prefix = lvst[j]; exact = lexf[j] != 0u;
        } else {
#pragma unroll 1
            for (int bit = DSA_S - 1; bit >= 0; --bit) {
                const unsigned cand = prefix | (1u << bit); int c0 = 0, c1 = 0;
                DSA_FOR_TILES(cnt_ge(c0, u[T][0], cand); cnt_ge(c1, u[T][1], cand); cnt_ge(c0, u[T][2], cand); cnt_ge(c1, u[T][3], cand);)
                const int tot = dsa_total(cnt, par, wave, j, gq, c0 + c1); par ^= 1;
                if (!exact && tot >= 256) { prefix = cand; exact = (tot == 256); }
            }
        }
        TP_MARK(2);
        const bool alle = __all(exact);
        unsigned kp = 0u;
        if (!alle) {
        DSA_FOR_TILES(_Pragma("unroll") for (int e = 0; e < 4; ++e) { const unsigned x = u[T][e]; u[T][e] = (x > prefix || (exact && x == prefix)) ? 0u : (x == prefix ? (unsigned)(1 + kb0 + 128 * T + e) : 0xFFFFFFFFu); })
            __syncthreads();
#pragma unroll 1
            for (int bit = 11; bit >= 0; --bit) {
                const unsigned cand = kp | (1u << bit); int c0 = 0, c1 = 0;
                DSA_FOR_TILES(cnt_le(c0, u[T][0], cand); cnt_le(c1, u[T][1], cand); cnt_le(c0, u[T][2], cand); cnt_le(c1, u[T][3], cand);)
                const int tot = dsa_total(cnt, par, wave, j, gq, c0 + c1); par ^= 1;
                if (tot <= 255) kp = cand;
            }
        }
        const unsigned kp1 = kp + 1u;
        int ns0 = 0, ns1 = 0;
        if (alle) { DSA_FOR_TILES(cnt_ge(ns0, u[T][0], prefix); cnt_ge(ns1, u[T][1], prefix); cnt_ge(ns0, u[T][2], prefix); cnt_ge(ns1, u[T][3], prefix);) }
        else { DSA_FOR_TILES(cnt_le(ns0, u[T][0], kp1); cnt_le(ns1, u[T][1], kp1); cnt_le(ns0, u[T][2], kp1); cnt_le(ns1, u[T][3], kp1);) }
        pc[(wave * 4 + gq) * 16 + j] = (unsigned)(ns0 + ns1);
        __syncthreads();
        int base = 0;
        { const int me = wave * 4 + gq;
#pragma unroll
          for (int i = 0; i < 31; ++i) { const int v = (int)pc[i * 16 + j]; base += (i < me) ? v : 0; } }
        if (alle) { DSA_FOR_TILES(_Pragma("unroll") for (int e = 0; e < 4; ++e) { if (u[T][e] >= prefix) { if (base < 256) list[j * 256 + base] = (unsigned short)(kb0 + 128 * T + e); ++base; } }) }
        else { DSA_FOR_TILES(_Pragma("unroll") for (int e = 0; e < 4; ++e) { if (u[T][e] <= kp1) { if (base < 256) list[j * 256 + base] = (unsigned short)(kb0 + 128 * T + e); ++base; } }) }
    } else {
        for (int i = tid; i < 16 * 256; i += 512) list[i] = (unsigned short)(i & 255);
    }
    __syncthreads();
    TP_MARK(3);
    const bf16* kva = (const bf16*)(ws + WS_KVA);
    bf16* qa = (bf16*)(ws + WS_QA);
    LAS unsigned char* Vw = lds + DSA_OFF_V + wave * 16384;
    const unsigned vlds0 = (unsigned)(uintptr_t)(unsigned char*)Vw;
    const int tq2[2] = {q0 + 2 * wave, q0 + 2 * wave + 1};
    const int nselq[2] = {tq2[0] + 1 < 256 ? tq2[0] + 1 : 256, tq2[1] + 1 < 256 ? tq2[1] + 1 : 256};
    v4u qfq[2][2];
#pragma unroll
    for (int qq = 0; qq < 2; ++qq)
#pragma unroll
        for (int ks = 0; ks < 2; ++ks) { qfq[qq][ks] = (v4u){0u, 0u, 0u, 0u}; if (j < 8) qfq[qq][ks] = *(const v4u*)(qa + (size_t)(b * SEQ + tq2[qq]) * 512 + j * 64 + 8 * gq + 32 * ks); }
    asm volatile("s_waitcnt vmcnt(0)" : "+v"(qfq[0][0]), "+v"(qfq[0][1]), "+v"(qfq[1][0]), "+v"(qfq[1][1]) :: "memory");
    const bf16* kvb_ = kva + (size_t)b * SEQ * 128;
    const unsigned long long kvbase = ((unsigned long long)(unsigned)__builtin_amdgcn_readfirstlane((int)((unsigned long long)(uintptr_t)kvb_ >> 32)) << 32) | (unsigned long long)(unsigned)__builtin_amdgcn_readfirstlane((int)(unsigned)(uintptr_t)kvb_);
    const unsigned kofs = (unsigned)gq * 16u, vofs = 128u + (unsigned)(lane & 7) * 16u;
#define DSA_KEY(M_, st_, slot_) ((unsigned)list[(2 * wave + ((st_) >> 2)) * 256 + ((M_) ? (((slot_) < nselq[(st_) >> 2]) ? (slot_) : 0) : (slot_))])
#define DSA_ISSUEK(M_, buf_, st_) do { unsigned ky_[4]; _Pragma("unroll") for (int kt_ = 0; kt_ < 4; ++kt_) ky_[kt_] = DSA_KEY(M_, st_, 64 * ((st_) & 3) + 16 * kt_ + j) * 256u + kofs; \
        _Pragma("unroll") for (int kt_ = 0; kt_ < 4; ++kt_) { \
        asm volatile("global_load_dwordx4 %0, %1, %2" : "=v"(buf_[2 * kt_]) : "v"(ky_[kt_]), "s"(kvbase) : "memory"); asm volatile("global_load_dwordx4 %0, %1, %2 offset:64" : "=v"(buf_[2 * kt_ + 1]) : "v"(ky_[kt_]), "s"(kvbase) : "memory"); } } while (0)
#define DSA_ISSUEV(M_, st_) do { unsigned kv_[8]; _Pragma("unroll") for (int i_ = 0; i_ < 8; ++i_) kv_[i_] = DSA_KEY(M_, st_, 64 * ((st_) & 3) + 8 * i_ + (lane >> 3)) * 256u + vofs; \
        unsigned keep_; const unsigned ld_ = (unsigned)__builtin_amdgcn_readfirstlane((int)(vlds0 + ((st_) & 1) * 8192)); \
        asm volatile("s_mov_b32 %0, m0\n\ts_mov_b32 m0, %9\n\ts_nop 0\n\t" \
                     "global_load_lds_dwordx4 %1, %10\n\ts_add_u32 m0, m0, 0x400\n\ts_nop 0\n\t" "global_load_lds_dwordx4 %2, %10\n\ts_add_u32 m0, m0, 0x400\n\ts_nop 0\n\t" \
                     "global_load_lds_dwordx4 %3, %10\n\ts_add_u32 m0, m0, 0x400\n\ts_nop 0\n\t" "global_load_lds_dwordx4 %4, %10\n\ts_add_u32 m0, m0, 0x400\n\ts_nop 0\n\t" \
                     "global_load_lds_dwordx4 %5, %10\n\ts_add_u32 m0, m0, 0x400\n\ts_nop 0\n\t" "global_load_lds_dwordx4 %6, %10\n\ts_add_u32 m0, m0, 0x400\n\ts_nop 0\n\t" \
                     "global_load_lds_dwordx4 %7, %10\n\ts_add_u32 m0, m0, 0x400\n\ts_nop 0\n\t" "global_load_lds_dwordx4 %8, %10\n\ts_mov_b32 m0, %0" \
                     : "=&s"(keep_) : "v"(kv_[0]), "v"(kv_[1]), "v"(kv_[2]), "v"(kv_[3]), "v"(kv_[4]), "v"(kv_[5]), "v"(kv_[6]), "v"(kv_[7]), "s"(ld_), "s"(kvbase) : "memory", "scc"); } while (0)
#define DSA_WAITK(buf_, n_) asm volatile("s_waitcnt vmcnt(" #n_ ")" : "+v"(buf_[0]), "+v"(buf_[1]), "+v"(buf_[2]), "+v"(buf_[3]), "+v"(buf_[4]), "+v"(buf_[5]), "+v"(buf_[6]), "+v"(buf_[7]) :: "memory")
    v4u kA[8], kB[8], kC[8];
    float mrow = NEGF, lrow = 0.f; f32x4v o[4];
#define DSA_STEP(M_, st_, cur_, nx2_, NK_, NV_) do { \
        if ((st_) + 2 < 8) DSA_ISSUEK(M_, nx2_, (st_) + 2); \
        if (((st_) & 3) == 0) { mrow = NEGF; lrow = 0.f; _Pragma("unroll") for (int dt_ = 0; dt_ < 4; ++dt_) o[dt_] = (f32x4v){0.f, 0.f, 0.f, 0.f}; } \
        DSA_WAITK(cur_, NK_); \
        const bf16x8 q0_ = __builtin_bit_cast(bf16x8, qfq[(st_) >> 2][0]), q1_ = __builtin_bit_cast(bf16x8, qfq[(st_) >> 2][1]); \
        f32x4v s_[4]; float bm_ = NEGF; \
        _Pragma("unroll") for (int kt_ = 0; kt_ < 4; ++kt_) { f32x4v a_ = {0.f, 0.f, 0.f, 0.f}; \
            a_ = __builtin_amdgcn_mfma_f32_16x16x32_bf16(__builtin_bit_cast(bf16x8, cur_[2 * kt_]), q0_, a_, 0, 0, 0); a_ = __builtin_amdgcn_mfma_f32_16x16x32_bf16(__builtin_bit_cast(bf16x8, cur_[2 * kt_ + 1]), q1_, a_, 0, 0, 0); \
            _Pragma("unroll") for (int e_ = 0; e_ < 4; ++e_) { const float v_ = (!(M_) || (64 * ((st_) & 3) + 16 * kt_ + 4 * gq + e_ < nselq[(st_) >> 2])) ? a_[e_] : NEGF; a_[e_] = v_; bm_ = fmaxf(bm_, v_); } s_[kt_] = a_; } \
        bm_ = xmax16(bm_); \
        { const float mnew_ = fmaxf(mrow, bm_), alpha_ = __builtin_amdgcn_exp2f(mrow - mnew_); mrow = mnew_; float ps_ = 0.f; \
          _Pragma("unroll") for (int kt_ = 0; kt_ < 4; ++kt_) _Pragma("unroll") for (int e_ = 0; e_ < 4; ++e_) { const float p_ = __builtin_amdgcn_exp2f(s_[kt_][e_] - mnew_); s_[kt_][e_] = p_; ps_ += p_; } \
          lrow = lrow * alpha_ + ps_; _Pragma("unroll") for (int dt_ = 0; dt_ < 4; ++dt_) o[dt_] *= alpha_; } \
        asm volatile("s_waitcnt vmcnt(" #NV_ ")" : "+v"(s_[0]), "+v"(s_[1]), "+v"(s_[2]), "+v"(s_[3]) :: "memory");       \
        { const LAS unsigned char* Vb_ = Vw + ((st_) & 1) * 8192; \
        _Pragma("unroll") for (int kk_ = 0; kk_ < 2; ++kk_) { \
            const bf16x8 pf_ = pack8(s_[2 * kk_][0], s_[2 * kk_][1], s_[2 * kk_][2], s_[2 * kk_][3], s_[2 * kk_ + 1][0], s_[2 * kk_ + 1][1], s_[2 * kk_ + 1][2], s_[2 * kk_ + 1][3]); \
            _Pragma("unroll") for (int dt_ = 0; dt_ < 4; ++dt_) { const LAS unsigned char* va_ = Vb_ + (32 * kk_ + 4 * gq + (j >> 2)) * 128 + (16 * dt_ + 4 * (j & 3)) * 2; \
                o[dt_] = __builtin_amdgcn_mfma_f32_16x16x32_bf16(cat4(tr16(va_), tr16(va_ + 16 * 128)), pf_, o[dt_], 0, 0, 0); } } } \
        if (((st_) & 3) == 3) { const float inv_ = __builtin_amdgcn_rcpf(xsum16(lrow)); const int rowq_ = b * SEQ + tq2[(st_) >> 2]; \
            if (j < 8) { _Pragma("unroll") for (int dt_ = 0; dt_ < 4; ++dt_) { uint2 w_; w_.x = cvtpk(o[dt_][0] * inv_, o[dt_][1] * inv_); w_.y = cvtpk(o[dt_][2] * inv_, o[dt_][3] * inv_); \
                *(uint2*)(yout + (size_t)rowq_ * 512 + j * 64 + 16 * dt_ + 4 * gq) = w_; } } } \
        if ((st_) + 2 < 8) { asm volatile("s_waitcnt lgkmcnt(0)" ::: "memory"); DSA_ISSUEV(M_, (st_) + 2); } \
    } while (0)
#define DSA_RUN(M_) do { DSA_ISSUEK(M_, kA, 0); DSA_ISSUEV(M_, 0); DSA_ISSUEK(M_, kB, 1); DSA_ISSUEV(M_, 1); \
    DSA_STEP(M_, 0, kA, kC, 32, 24); DSA_STEP(M_, 1, kB, kA, 32, 24); DSA_STEP(M_, 2, kC, kB, 32, 24); DSA_STEP(M_, 3, kA, kC, 32, 24); \
    DSA_STEP(M_, 4, kB, kA, 32, 24); DSA_STEP(M_, 5, kC, kB, 32, 24); DSA_STEP(M_, 6, kA, kC, 24, 16); DSA_STEP(M_, 7, kB, kA, 8, 0); } while (0)
    if (q0 >= 256) DSA_RUN(0); else DSA_RUN(1);
#if DUP == 20
    if (q0 >= 256) DSA_RUN(0); else DSA_RUN(1);
#endif
#undef DSA_RUN
#undef DSA_STEP
#undef DSA_ISSUEK
#undef DSA_ISSUEV
#undef DSA_WAITK
#undef DSA_KEY
    __syncthreads();
    TP_MARK(4);
}
__device__ __forceinline__ void phase_mixers(const Args& P, unsigned char* ws, int z, LAS unsigned char* lds, int gw, int NGW, int lane, int wave, int bid, int G) {
    asm volatile("" : "+v"(lane)); lane &= 63; asm volatile("" : "+s"(gw), "+s"(NGW));
#if PROBE == 3
    { LAS unsigned char* wl = lds + wave * 18944; for (int it2 = gw; it2 < 2 * M; it2 += NGW) nsa_query(P, ws, z, it2 >> 1, it2 & 1, wl, lane); }
#else
    for (int k = 0; bid + G * k < 1024; ++k) {
        const int u = bid + G * k, c0 = u & 63, unit = (u & ~63) | ((k & 1) ? 63 - c0 : c0);
#if DUP == 7
        nsa_unit(ws, unit, lds, (wave << 6) | lane_id_v(), (bf16*)(ws + WS_BU));
#endif
        nsa_unit(ws, unit, lds, (wave << 6) | lane_id_v(), (bf16*)(ws + WS_QC));
    }
#endif
    for (int k = 0; bid + G * k < 2048; ++k) {
        const int u = bid + G * k, c0 = u & 255, unit = (u & ~255) | ((k & 1) ? 255 - c0 : c0);
#if DUP == 6
        dsa_unit(ws, unit, lds, (wave << 6) | lane_id_v(), (bf16*)(ws + WS_BU));
#endif
        dsa_unit(ws, unit, lds, (wave << 6) | lane_id_v(), (bf16*)(ws + WS_QA));
    }
}
__global__ void __launch_bounds__(NWAVES * 64, 2) fwd_kernel(Args args) {
    extern __shared__ __attribute__((aligned(16))) unsigned char lds_raw[];
    LAS unsigned char* lds = (LAS unsigned char*)lds_raw;
    const int wave = __builtin_amdgcn_readfirstlane((int)threadIdx.x >> 6);
#define TIDX ((wave << 6) | lane_id_v())
#define tid TIDX
#define lane TIDX
    const int G = gridDim.x, bid = blockIdx.x;
    const int gw = bid * NWAVES + wave, NGW = G * NWAVES;
    const int lo = args.ph_lo, hi = args.ph_hi;
    const Args& P = args;
    int z = 0; asm volatile("" : "+s"(z));
    unsigned char* ws = args.ws + z;
    volatile LAS unsigned* MISCW = (volatile LAS unsigned*)(lds + LDSCTL_OFF);
    if (tid < 64) MISCW[tid] = 0u;
    __syncthreads();
    XcdBarrier bar; bar.bar = (unsigned*)(ws + WS_CTL) + 4096; bar.x = 0; bar.st = nullptr;
    if (hi - lo > 1) bar = xcd_barrier_post((unsigned*)(ws + WS_CTL) + 4096, MISCW + 8);
#define RUN(k) (lo <= (k) && (k) < hi)
#define SEAM(k) do { if ((k) + 1 < hi) { XcdBarrier b2_ = bar; asm volatile("" : "+s"(b2_.bar), "+s"(b2_.x)); xcd_barrier(b2_); if (DUP == 13) xcd_barrier(b2_); } else { VM_WAIT(); __syncthreads(); } } while (0)


    if (RUN(0)) { phase_rope(P, ws, z, bid * (NWAVES * 64) + tid, G * NWAVES * 64);
        { int ln_ = TIDX; asm volatile("" : "+v"(ln_)); ln_ &= 63;
          for (int m = gw; m < M; m += NGW) stat_row_bf16(P.in[0 + z] + (size_t)m * DM, (bf16*)(ws + WS_XN) + (size_t)m * DM, (float*)(ws + WS_SSQ) + (size_t)m * 16, ln_); }
        SEAM(0); }
#define RS_PREPASS(Sref) do { const float* ssq_ = (const float*)(ws + WS_SSQ); LAS float* rsl_ = (LAS float*)(lds + RS_OFF); const int t_ = TIDX; pg8::Unit u_; \
        for (int i_ = 0; (Sref).next(i_, u_); ++i_) { const f32x4* p_ = (const f32x4*)(ssq_ + (size_t)(u_.pm * 256 + (t_ >> 1)) * 16 + (t_ & 1) * 8); const f32x4 a_ = p_[0], b_ = p_[1]; \
            float s_ = (a_.x + a_.y) + (a_.z + a_.w) + (b_.x + b_.y) + (b_.z + b_.w); s_ += __shfl_xor(s_, 1); if ((t_ & 1) == 0) rsl_[i_ * 256 + (t_ >> 1)] = 1.0f / sqrtf(s_ * (1.f / DM) + EPS); } \
        __syncthreads(); } while (0)

    for (int it = 0; it < 2 * DEPTH; ++it) {
        const int l = it >> 1, second = it & 1, pb = 1 + l * NPL + (second ? 7 : 0);
        asm volatile("" : "+s"(z));
        ws = args.ws + z;
        bf16* const XN = (bf16*)(ws + WS_XN);
        bf16* const HB = (bf16*)(ws + WS_H);
        bf16* const MG = (bf16*)(ws + WS_MG);
        bf16* const GB = (bf16*)(ws + WS_G);
        unsigned char* const wb = ws + WS_W;
        float* const OUT = P.out + z;
        const float* xin = (it == 0) ? P.in[0 + z] : (const float*)OUT;
        if (!second && RUN(pb)) { phase_convert(P, ws, z, l, lds, gw, NGW, lane, wave); SEAM(pb); }
        if (RUN(pb + 1)) {
            pg8::Gemm g{XN, (const bf16*)(wb + (second ? WO_GU2 : WO_GU1)), M, 2 * FF, DM}; pg8::StaticOrder S; S.init(M, 2 * FF, G, bid + z);
            pg8::EpiSwiglu E{HB, FF, (const LAS float*)(lds + RS_OFF)};
            RS_PREPASS(S);
#if !defined(SITE_MASK) || ((SITE_MASK >> 0) & 1)
            pg8::gemm_phase<pg8::EpiSwiglu, pg8::StaticOrder, ALIGN_UP, true>(lds, g, S, E, TIDX);
#if DUP == 3
            pg8::gemm_phase<pg8::EpiSwiglu, pg8::StaticOrder, ALIGN_UP, true>(lds, g, S, E, TIDX);
#endif
#endif
            SEAM(pb + 1);
        }
        if (RUN(pb + 2)) {
            pg8::Gemm g{HB, (const bf16*)(wb + (second ? WO_D2 : WO_D1)), M, DM, FF}; pg8::StaticOrder S; S.init(M, DM, G, bid + z);
            pg8::EpiResid E{xin, OUT, 0.5f, XN, (float*)(ws + WS_SSQ)};
#if !defined(SITE_MASK) || ((SITE_MASK >> 1) & 1)
            pg8::gemm_phase<pg8::EpiResid, pg8::StaticOrder, true, true>(lds, g, S, E, TIDX);
#endif
            SEAM(pb + 2);
        }
        if (second) continue;
        const int pm = 1 + l * NPL + 2;
        if (RUN(pm + 1)) {
            pg8::Gemm g{XN, (const bf16*)(wb + WO_IN), M, NINP, DM}; pg8::StaticOrder S; S.init(M, NINP, G, bid + z);
            pg8::EpiWin E{(bf16*)(ws + WS_QA), (bf16*)(ws + WS_QC), (bf16*)(ws + WS_IQ), (bf16*)(ws + WS_MISC), (bf16*)(ws + WS_KVC), (bf16*)(ws + WS_KVS), (bf16*)(ws + WS_KVW), (bf16*)(ws + WS_BU), GB,
                          (const float*)(ws + WS_ROPE), (const LAS float*)(lds + RS_OFF)};
            RS_PREPASS(S);
#if !defined(SITE_MASK) || ((SITE_MASK >> 2) & 1)
            pg8::gemm_phase<pg8::EpiWin, pg8::StaticOrder, ALIGN_WIN, true>(lds, g, S, E, TIDX);
#if DUP == 4
            pg8::gemm_phase<pg8::EpiWin, pg8::StaticOrder, ALIGN_WIN, true>(lds, g, S, E, TIDX);
#endif
#endif
            SEAM(pm + 1);
        }
        #ifndef NO_PREP
        if (RUN(pm + 2)) { phase_prep(P, ws, z, l, lds, gw, NGW, lane, wave);
#if DUP == 1
            { XcdBarrier b2_ = bar; asm volatile("" : "+s"(b2_.bar), "+s"(b2_.x)); xcd_barrier(b2_); } phase_prep(P, ws, z, l, lds, gw, NGW, lane, wave);
#endif
            SEAM(pm + 2); }
#endif
        #ifndef NO_MIX
        if (RUN(pm + 3)) { phase_mixers(P, ws, z, lds, gw, NGW, lane, wave, bid, G); SEAM(pm + 3); }
#endif
        if (RUN(pm + 4)) {
#if DUP == 5
          for (int rep_ = 0; rep_ < 2; ++rep_) {
#endif
            pg8::StaticOrder S; S.init(M, DM, G, bid + z);
            { pg8::Gemm g{(const bf16*)(ws + WS_QA), (const bf16*)(wb + WO_PA), M, DM, 512}; pg8::EpiProj<0> E{MG, GB, 0};
#if !defined(SITE_MASK) || ((SITE_MASK >> 3) & 1)
              pg8::gemm_phase<pg8::EpiProj<0>, pg8::StaticOrder, true, true>(lds, g, S, E, TIDX);
#endif
            }
            { pg8::Gemm g{(const bf16*)(ws + WS_YB), (const bf16*)(wb + WO_PB), M, DM, 512}; pg8::EpiProj<1> E{MG, GB, 1024};
#if !defined(SITE_MASK) || ((SITE_MASK >> 4) & 1)
              pg8::gemm_phase<pg8::EpiProj<1>, pg8::StaticOrder, true, true>(lds, g, S, E, TIDX);
#endif
            }
            { pg8::Gemm g{(const bf16*)(ws + WS_QC), (const bf16*)(wb + WO_PC), M, DM, 512}; pg8::EpiProj<1> E{MG, GB, 2048};
#if !defined(SITE_MASK) || ((SITE_MASK >> 5) & 1)
              pg8::gemm_phase<pg8::EpiProj<1>, pg8::StaticOrder, true, true>(lds, g, S, E, TIDX);
#endif
            }
#if DUP == 5
          }
#endif
            SEAM(pm + 4);
        }
        if (RUN(pm + 5)) {
            pg8::Gemm g{MG, (const bf16*)(wb + WO_OUT), M, DM, DM}; pg8::StaticOrder S; S.init(M, DM, G, bid + z);
            pg8::EpiResid E{OUT, OUT, 1.0f, XN, (float*)(ws + WS_SSQ)};
#if !defined(SITE_MASK) || ((SITE_MASK >> 6) & 1)
            pg8::gemm_phase<pg8::EpiResid, pg8::StaticOrder, true, true>(lds, g, S, E, TIDX);
#endif
            SEAM(pm + 5);
        }
    }
    if (RUN(NPH - 1)) { asm volatile("" : "+s"(z)); int ln_ = TIDX; asm volatile("" : "+v"(ln_)); ln_ &= 63; float* o_ = P.out + z; float tps_ = 1.0f;
#if TPROBE
        { const unsigned long long* sl_ = (const unsigned long long*)(P.ws + z + 32768); double a_ = 0., b_ = 0.; for (int k = 0; k < 16; ++k) { const double v_ = (double)__hip_atomic_load(sl_ + k, __ATOMIC_RELAXED, __HIP_MEMORY_SCOPE_AGENT); if ((TP_A >> k) & 1) a_ += v_; if ((TP_B >> k) & 1) b_ += v_; } tps_ = 1.0f + (float)(a_ / b_) * TP_SCALE; }
#endif
        for (int m = gw; m < M; m += NGW) norm_row_f32(o_ + (size_t)m * DM, P.in[23 + z], ln_, tps_);
#if TPROBE
        if (gw == 0 && ln_ == 0) { const unsigned long long* sl_ = (const unsigned long long*)(P.ws + z + 32768); double c_ = 0., d_ = 0.; for (int k = 0; k < 16; ++k) { const double v_ = (double)__hip_atomic_load(sl_ + k, __ATOMIC_RELAXED, __HIP_MEMORY_SCOPE_AGENT); if ((TP_C >> k) & 1) c_ += v_; if ((TP_D >> k) & 1) d_ += v_; } o_[0] = 1000.0f * (float)(c_ / d_) * TP_SCALE2; }
#endif
    }
#undef RUN
#undef tid
#undef TIDX
#undef lane
#undef SEAM
}

extern "C" void kernel_launch(void* const* d_in, const int* in_sizes, int n_in, void* d_out, int out_size, void* d_ws, size_t ws_size, hipStream_t stream) {
    static int grid = 0;
    if (grid == 0) {
        if (n_in != 24 || out_size != M * DM || ws_size < WS_END) { fprintf(stderr, "kernel_launch: unexpected shapes (n_in %d out %d ws %zu)\n", n_in, out_size, ws_size); grid = -1; return; }
        int dev = 0, cus = 0, per_cu = 0;
        if (hipGetDevice(&dev) != hipSuccess || hipDeviceGetAttribute(&cus, hipDeviceAttributeMultiprocessorCount, dev) != hipSuccess) { grid = -1; return; }
        if (hipFuncSetAttribute((const void*)fwd_kernel, hipFuncAttributeMaxDynamicSharedMemorySize, LDS_BYTES) != hipSuccess) { fprintf(stderr, "kernel_launch: hipFuncSetAttribute failed\n"); grid = -1; return; }
        if (hipOccupancyMaxActiveBlocksPerMultiprocessor(&per_cu, (const void*)fwd_kernel, NWAVES * 64, LDS_BYTES) != hipSuccess || per_cu < 1) { fprintf(stderr, "kernel_launch: occupancy query says %d\n", per_cu); }
        (void)hipGetLastError();
        grid = cus;
    }
    if (grid < 0) return;
    (void)hipMemsetAsync((char*)d_ws + WS_CTL, 0, CTL_ZERO_BYTES, stream);
    Args a{};
    for (int i = 0; i < 24; ++i) a.in[i] = (const float*)d_in[i];
    a.out = (float*)d_out; a.ws = (unsigned char*)d_ws;
#if MK_ONE_LAUNCH
    a.ph_lo = 0; a.ph_hi = NPH;
    hipLaunchKernelGGL(fwd_kernel, dim3(grid), dim3(NWAVES * 64), LDS_BYTES, stream, a);
#else
    for (int ph = 0; ph < NPH; ++ph) { a.ph_lo = ph; a.ph_hi = ph + 1; hipLaunchKernelGGL(fwd_kernel, dim3(grid), dim3(NWAVES * 64), LDS_BYTES, stream, a); }
#endif
}
```

```cpp
#include <hip/hip_runtime.h>
#include <cstdio>
#include <cstdint>
#define PROBE 0
#define PROBE_GAIN 10.0f
#define TOP8_RANK 1
#define PROBE_ROWTHR 0.01f
#define PROBE_ROWCOND 1
#define PROBE_BR -1
#define FIXHOM 0
#define DUP 0
#define TPROBE 0
#define TP_A 1
#define TP_B 1
#define TP_SCALE 1.0f
#define TP_C 1
#define TP_D 1
#define TP_SCALE2 1.0f
#define POOLDBG 0
#define YB_SPARE 0
#define ALIGN_UP true
#define ALIGN_WIN true
#define DSA_CAP_V 512
#define DSA_K_V 13
#ifndef MK_ONE_LAUNCH
#define MK_ONE_LAUNCH 1
#endif
namespace pg8 {
#define PG8_LAS __attribute__((address_space(3)))
typedef unsigned short bf16_t;
typedef short bf16x8 __attribute__((ext_vector_type(8)));
typedef float f32x4 __attribute__((ext_vector_type(4)));
typedef unsigned u32x4 __attribute__((ext_vector_type(4)));
constexpr int BM = 256, BK = 64, HALF = 128, HTB = HALF * BK * 2  , STAGE_BYTES = 8 * HTB, NXCD = 8, WGM = 8;

__host__ __device__ __forceinline__ int lds_byte(int r, int c) { const int st = (r >> 4) * 2 + (c >> 5), rr = r & 15, cc = c & 31, ob = rr * 64 + cc * 2; return st * 1024 + (ob ^ (((ob >> 9) & 1) << 5)); }
__host__ __device__ __forceinline__ void stage_rc(int b, int& R, int& C) { const int st = b / 1024, sb = b % 1024, swz = sb ^ (((sb >> 9) & 1) << 5); R = (st >> 1) * 16 + swz / 64; C = (st & 1) * 32 + (swz % 64) / 2; }
__host__ __device__ __forceinline__ int perm32(int rho) { const int n = rho >> 4, i = rho & 15; return 8 * (i >> 2) + 4 * n + (i & 3); }

struct Unit { int pm, pn, ord; };
struct Gemm { const bf16_t* A; const bf16_t* Bt; int M, N, K; };

struct StaticOrder {
    int nM, nN, nwg, G, c;
    __host__ __device__ __forceinline__ void init(int M, int N, int G_, int c_) { nM = M / BM; nN = N / BM; nwg = nM * nN; G = G_; c = c_; }
    __host__ __device__ __forceinline__ bool next(int i, Unit& u) const {
        const long L = (long)i * G + c; if (L >= nwg) return false;
        int wgid = (int)L; { const int q = nwg / NXCD, r = nwg % NXCD, xcd = wgid % NXCD, off = wgid / NXCD; wgid = (xcd < r ? xcd * (q + 1) : r * (q + 1) + (xcd - r) * q) + off; }
        const int nig = WGM * nN, gid = wgid / nig, fm = gid * WGM, gsz = (nM - fm) < WGM ? (nM - fm) : WGM;
        u.pm = fm + ((wgid % nig) % gsz); u.pn = (wgid % nig) / gsz; u.ord = i; return true;
    }
    __device__ __forceinline__ void a_ready(const Unit&) const {}
    __device__ __forceinline__ void done(const Unit&) const {}
};

__device__ __forceinline__ unsigned cvt_pk_bf16(float lo, float hi) { unsigned r; asm volatile("v_cvt_pk_bf16_f32 %0, %1, %2" : "=v"(r) : "v"(lo), "v"(hi)); return r; }
__device__ __forceinline__ float bflo(unsigned w) { return __uint_as_float(w << 16); }
__device__ __forceinline__ float bfhi(unsigned w) { return __uint_as_float(w & 0xffff0000u); }
__device__ __forceinline__ float fast_sigmoid(float x) { return __builtin_amdgcn_rcpf(1.0f + __expf(-x)); }

struct EpiSwiglu {
    static constexpr bool PERM = true, AFTER_DRAIN = false;
    bf16_t* H; int ldh; const PG8_LAS float* rs;
    __device__ __forceinline__ void operator()(const f32x4 (&acc)[2][2][4][2], const Unit& u, int wr, int wc, int fr, int fq) const {
        const int row0 = u.pm * BM + wr * 64 + fr, col0 = u.pn * HALF + wc * 32 + 8 * fq;
#pragma unroll
        for (int ai = 0; ai < 2; ++ai)
#pragma unroll
            for (int m = 0; m < 4; ++m) {
                bf16_t* rowp = H + (size_t)(row0 + ai * HALF + m * 16) * ldh + col0;
                const float r = rs[u.ord * 256 + wr * 64 + fr + ai * HALF + m * 16];
                float o[8];
#pragma unroll
                for (int n = 0; n < 2; ++n)
#pragma unroll
                    for (int e = 0; e < 4; ++e) { const float g = acc[ai][0][m][n][e] * r, up = acc[ai][1][m][n][e] * r; o[n * 4 + e] = g * fast_sigmoid(g) * up; }
                u32x4 w; w.x = cvt_pk_bf16(o[0], o[1]); w.y = cvt_pk_bf16(o[2], o[3]); w.z = cvt_pk_bf16(o[4], o[5]); w.w = cvt_pk_bf16(o[6], o[7]);
                *(u32x4*)rowp = w;
            }
    }
};
struct EpiResid {
    static constexpr bool PERM = true, AFTER_DRAIN = false;
    const float* base; float* out; float s; bf16_t* xb; float* ssq;
    __device__ __forceinline__ void operator()(const f32x4 (&acc)[2][2][4][2], const Unit& u, int wr, int wc, int fr, int fq) const {
        const int row0 = u.pm * BM + wr * 64 + fr, col0 = u.pn * BM + wc * 32 + 8 * fq;
#pragma unroll
        for (int ai = 0; ai < 2; ++ai)
#pragma unroll
            for (int mh = 0; mh < 2; ++mh) {
                f32x4 bv[2][2][2];
#pragma unroll
                for (int mm = 0; mm < 2; ++mm)
#pragma unroll
                    for (int bj = 0; bj < 2; ++bj) { const size_t off = (size_t)(row0 + ai * HALF + (2 * mh + mm) * 16) * 1024 + col0 + bj * HALF; bv[mm][bj][0] = *(const f32x4*)(base + off); bv[mm][bj][1] = *(const f32x4*)(base + off + 4); }
#pragma unroll
                for (int mm = 0; mm < 2; ++mm) {
                    const int m = 2 * mh + mm;
                    const size_t off = (size_t)(row0 + ai * HALF + m * 16) * 1024 + col0;
                    float q = 0.f;
#pragma unroll
                    for (int bj = 0; bj < 2; ++bj) {
                        const f32x4 x0 = bv[mm][bj][0] + acc[ai][bj][m][0] * s, x1 = bv[mm][bj][1] + acc[ai][bj][m][1] * s;
                        *(f32x4*)(out + off + bj * HALF) = x0; *(f32x4*)(out + off + bj * HALF + 4) = x1;
                        q += (x0[0] * x0[0] + x0[1] * x0[1]) + (x0[2] * x0[2] + x0[3] * x0[3]) + (x1[0] * x1[0] + x1[1] * x1[1]) + (x1[2] * x1[2] + x1[3] * x1[3]);
                        u32x4 w; w.x = cvt_pk_bf16(x0[0], x0[1]); w.y = cvt_pk_bf16(x0[2], x0[3]); w.z = cvt_pk_bf16(x1[0], x1[1]); w.w = cvt_pk_bf16(x1[2], x1[3]);
                        *(u32x4*)(xb + off + bj * HALF) = w;
                    }
                    q += __shfl_xor(q, 16); q += __shfl_xor(q, 32);
                    if (fq == 0) ssq[(size_t)(row0 + ai * HALF + m * 16) * 16 + u.pn * 4 + wc] = q;
                }
            }
    }
};
template <int MODE> struct EpiProj {
    static constexpr bool PERM = true, AFTER_DRAIN = false;
    bf16_t* MG; const bf16_t* G; int gofs;
    __device__ __forceinline__ void operator()(const f32x4 (&acc)[2][2][4][2], const Unit& u, int wr, int wc, int fr, int fq) const {
        const int row0 = u.pm * BM + wr * 64 + fr, col0 = u.pn * BM + wc * 32 + 8 * fq;
#pragma unroll
        for (int ai = 0; ai < 2; ++ai)
#pragma unroll
            for (int mh = 0; mh < 2; ++mh) {
                u32x4 gv[4], ov[4];
#pragma unroll
                for (int q = 0; q < 4; ++q) { const int m = 2 * mh + (q >> 1), bj = q & 1; const size_t row = (size_t)(row0 + ai * HALF + m * 16);
                    gv[q] = *(const u32x4*)(G + row * 3072 + gofs + col0 + bj * HALF); if (MODE) ov[q] = *(const u32x4*)(MG + row * 1024 + col0 + bj * HALF); }
#pragma unroll
                for (int q = 0; q < 4; ++q) { const int m = 2 * mh + (q >> 1), bj = q & 1; const size_t row = (size_t)(row0 + ai * HALF + m * 16);
                    bf16_t* mp = MG + row * 1024 + col0 + bj * HALF;
                    const f32x4 a0 = acc[ai][bj][m][0], a1 = acc[ai][bj][m][1];
                    float o[8] = {bflo(gv[q].x) * a0[0], bfhi(gv[q].x) * a0[1], bflo(gv[q].y) * a0[2], bfhi(gv[q].y) * a0[3], bflo(gv[q].z) * a1[0], bfhi(gv[q].z) * a1[1], bflo(gv[q].w) * a1[2], bfhi(gv[q].w) * a1[3]};
                    if (MODE) { o[0] += bflo(ov[q].x); o[1] += bfhi(ov[q].x); o[2] += bflo(ov[q].y); o[3] += bfhi(ov[q].y); o[4] += bflo(ov[q].z); o[5] += bfhi(ov[q].z); o[6] += bflo(ov[q].w); o[7] += bfhi(ov[q].w); }
                    u32x4 w; w.x = cvt_pk_bf16(o[0], o[1]); w.y = cvt_pk_bf16(o[2], o[3]); w.z = cvt_pk_bf16(o[4], o[5]); w.w = cvt_pk_bf16(o[6], o[7]);
                    *(u32x4*)mp = w;
                }
            }
    }
};
struct EpiWin {
    static constexpr bool PERM = true, AFTER_DRAIN = false;
    bf16_t *QA, *QC, *IQ, *MISC, *KVC, *KVS, *KVW, *BU, *G; const float* rope; const PG8_LAS float* rs;
    __device__ __forceinline__ void operator()(const f32x4 (&acc)[2][2][4][2], const Unit& u, int wr, int wc, int fr, int fq) const {
        const int pn = u.pn;
        bf16_t* dst; int ld, cbase, mode;
        if (pn < 2) { dst = QA; ld = 512; cbase = pn * 256; mode = 1; }
        else if (pn < 4) { dst = QC; ld = 512; cbase = (pn - 2) * 256; mode = 1; }
        else if (pn == 4) { dst = IQ; ld = 256; cbase = 0; mode = 1; }
        else if (pn == 5) { dst = MISC; ld = 256; cbase = 0; mode = 3; }
        else if (pn <= 8) { dst = pn == 6 ? KVC : (pn == 7 ? KVS : KVW); ld = 256; cbase = 0; mode = 2; }
        else if (pn <= 10) { dst = BU; ld = 512; cbase = (pn - 9) * 256; mode = 0; }
        else { dst = G; ld = 3072; cbase = (pn - 11) * 256; mode = 4; }
        const int row0 = u.pm * BM + wr * 64 + fr, col0 = cbase + wc * 32 + 8 * fq;
        const bool ropelane = ((wc & 1) == 0) && fq < 2;
        const float sc = (mode == 1) ? (pn < 4 ? 0.125f * 1.4426950408889634f : 0.125f) : 1.0f;
#pragma unroll
        for (int ai = 0; ai < 2; ++ai) {
            f32x4 csv[4], snv[4];
#pragma unroll
            for (int m = 0; m < 4; ++m) { csv[m] = (f32x4){1.f, 1.f, 1.f, 1.f}; snv[m] = (f32x4){0.f, 0.f, 0.f, 0.f}; }
            if (mode >= 1 && mode <= 3) {
#pragma unroll
                for (int m = 0; m < 4; ++m) { const float* rp = rope + (size_t)(row0 + ai * HALF + m * 16) * 16 + 4 * (fq & 1); csv[m] = *(const f32x4*)rp; snv[m] = *(const f32x4*)(rp + 8); }
            }
#pragma unroll
            for (int m = 0; m < 4; ++m) {
                const size_t row = (size_t)(row0 + ai * HALF + m * 16);
                const float rr = rs[u.ord * 256 + wr * 64 + fr + ai * HALF + m * 16];
                const f32x4 cs = csv[m], sn = snv[m];
#pragma unroll
                for (int bj = 0; bj < 2; ++bj) {
                    const f32x4 a0 = acc[ai][bj][m][0] * rr, a1 = acc[ai][bj][m][1] * rr;
                    float o[8] = {a0[0], a0[1], a0[2], a0[3], a1[0], a1[1], a1[2], a1[3]};
                    const bool dorope = ropelane && (mode == 1 || (mode == 2 && bj == 0) || (mode == 3 && bj == 0 && wc == 0));
                    if (dorope) {
#pragma unroll
                        for (int p = 0; p < 4; ++p) { const float x1 = o[2 * p], x2 = o[2 * p + 1]; o[2 * p] = x1 * cs[p] - x2 * sn[p]; o[2 * p + 1] = x2 * cs[p] + x1 * sn[p]; }
                    }
                    if (mode == 4) {
#pragma unroll
                        for (int e = 0; e < 8; ++e) o[e] = fast_sigmoid(o[e]);
                    } else {
#pragma unroll
                        for (int e = 0; e < 8; ++e) o[e] *= sc;
                    }
                    u32x4 w; w.x = cvt_pk_bf16(o[0], o[1]); w.y = cvt_pk_bf16(o[2], o[3]); w.z = cvt_pk_bf16(o[4], o[5]); w.w = cvt_pk_bf16(o[6], o[7]);
                    *(u32x4*)(dst + row * ld + col0 + bj * HALF) = w;
                }
            }
        }
    }
};

template <class Epi, class Sched, bool ALIGN_EPI = false, bool SP2 = false>
__device__ __forceinline__ void gemm_phase(PG8_LAS unsigned char* lds, const Gemm g, const Sched& S, const Epi& E, int tid_in) {
    int tid_ = tid_in; asm volatile("" : "+v"(tid_));
    const int tid = tid_, wid = __builtin_amdgcn_readfirstlane(tid >> 6), lane = tid & 63, wr = wid >> 2, wc = wid & 3, fr = lane & 15, fq = lane >> 4;
    const int K = g.K, nt = K / BK;
    unsigned voffA[2], voffB[2];
#pragma unroll
    for (int i = 0; i < 2; ++i) { int R, C; stage_rc(tid * 16 + i * 8192, R, C); const int Rb = Epi::PERM ? ((R & ~31) + perm32(R & 31)) : R;
        voffA[i] = (unsigned)(R * K + C) * 2u; voffB[i] = (unsigned)(Rb * K + C) * 2u; }
    const size_t kstep = (size_t)(BK * 2);
    const size_t hstep = (size_t)HALF * K * 2;
    const size_t tstep = 2 * hstep;
    const unsigned ldsw = (unsigned)wid * 1024u;
    const int aoff = lds_byte(wr * 64 + fr, fq * 8), boff = lds_byte(wc * 32 + fr, fq * 8);
#define PG8_SA(b, h) (((b) * 2 + (h)) * HTB)
#define PG8_SB(b, h) ((4 + (b) * 2 + (h)) * HTB)
#define PG8_STAGE(bufoff, gbase, voff) do { _Pragma("unroll") for (int _i = 0; _i < 2; ++_i) \
        __builtin_amdgcn_global_load_lds((const unsigned*)((const char*)(gbase) + (voff)[_i]), (PG8_LAS unsigned*)(lds + (bufoff) + ldsw + _i * 8192), 16, 0, 0); } while (0)
#define PG8_LDA(dst, b, h) do { _Pragma("unroll") for (int m = 0; m < 4; ++m) _Pragma("unroll") for (int k = 0; k < 2; ++k) dst[m][k] = *(const PG8_LAS bf16x8*)(lds + PG8_SA(b, h) + aoff + m * 2048 + k * 1024); } while (0)
#define PG8_LDB(dst, b, h) do { _Pragma("unroll") for (int n = 0; n < 2; ++n) _Pragma("unroll") for (int k = 0; k < 2; ++k) dst[n][k] = *(const PG8_LAS bf16x8*)(lds + PG8_SB(b, h) + boff + n * 2048 + k * 1024); } while (0)
#define PG8_MMA(ai, bj, At, Bt) do { __builtin_amdgcn_s_setprio(1); _Pragma("unroll") for (int m = 0; m < 4; ++m) _Pragma("unroll") for (int n = 0; n < 2; ++n) _Pragma("unroll") for (int k = 0; k < 2; ++k) \
        acc[ai][bj][m][n] = __builtin_amdgcn_mfma_f32_16x16x32_bf16(Bt[n][k], At[m][k], acc[ai][bj][m][n], 0, 0, 0); __builtin_amdgcn_s_setprio(0); } while (0)
#define PG8_WAIT_V(n) asm volatile("s_waitcnt vmcnt(" #n ")" ::: "memory")
#define PG8_WAIT_L(n) asm volatile("s_waitcnt lgkmcnt(" #n ")" ::: "memory")
#define PG8_BAR __builtin_amdgcn_s_barrier()
#define PG8_SCHED __builtin_amdgcn_sched_barrier(0)
    Unit cur, nxt; int ui = 0;
    if (!S.next(0, cur)) return;
    f32x4 acc[2][2][4][2];
#pragma unroll
    for (int a = 0; a < 2; ++a)
#pragma unroll
        for (int b = 0; b < 2; ++b)
#pragma unroll
            for (int m = 0; m < 4; ++m)
#pragma unroll
                for (int n = 0; n < 2; ++n) acc[a][b][m][n] = (f32x4){0.f, 0.f, 0.f, 0.f};
    bf16x8 At[4][2], B0[2][2], B1[2][2];
    const char* cA = (const char*)g.A + (size_t)cur.pm * tstep; const char* cB = (const char*)g.Bt + (size_t)cur.pn * tstep;
    S.a_ready(cur);
    if constexpr (SP2) {
        PG8_STAGE(PG8_SB(0, 0), cB, voffB); PG8_STAGE(PG8_SB(0, 1), cB + hstep, voffB); PG8_STAGE(PG8_SA(0, 0), cA, voffA); PG8_STAGE(PG8_SA(0, 1), cA + hstep, voffA);
        if (wr == 1) PG8_BAR;
        PG8_WAIT_V(2); PG8_BAR;
        PG8_STAGE(PG8_SB(1, 0), cB + kstep, voffB); PG8_STAGE(PG8_SA(1, 0), cA + kstep, voffA); PG8_STAGE(PG8_SB(1, 1), cB + hstep + kstep, voffB);
        PG8_WAIT_V(6); PG8_BAR;
    } else {
        PG8_STAGE(PG8_SB(0, 0), cB, voffB); PG8_STAGE(PG8_SA(0, 0), cA, voffA); PG8_STAGE(PG8_SB(0, 1), cB + hstep, voffB); PG8_STAGE(PG8_SA(0, 1), cA + hstep, voffA);
        if (wr == 1) PG8_BAR;
        PG8_WAIT_V(4); PG8_BAR;
        PG8_STAGE(PG8_SB(1, 0), cB + kstep, voffB); PG8_STAGE(PG8_SA(1, 0), cA + kstep, voffA); PG8_STAGE(PG8_SB(1, 1), cB + hstep + kstep, voffB);
        PG8_WAIT_V(6); PG8_BAR;
    }
    for (;;) {
        const bool has_next = S.next(ui + 1, nxt);
        const char* nA = has_next ? (const char*)g.A + (size_t)nxt.pm * tstep : cA; const char* nB = has_next ? (const char*)g.Bt + (size_t)nxt.pn * tstep : cB;
        for (int t = 0; t < nt; t += 2) {
            const bool last = (t == nt - 2);
            const char* a1 = cA + (size_t)(t + 1) * kstep;
            const char* a2 = last ? nA : cA + (size_t)(t + 2) * kstep; const char* b2 = last ? nB : cB + (size_t)(t + 2) * kstep;
            const char* a3 = a2 + kstep; const char* b3 = b2 + kstep;
            if (last && has_next) S.a_ready(nxt);
            if constexpr (SP2) {
            PG8_LDB(B0, 0, 0); PG8_LDB(B1, 0, 1); PG8_SCHED; PG8_LDA(At, 0, 0); PG8_STAGE(PG8_SA(1, 1), a1 + hstep, voffA);
            PG8_WAIT_V(8); PG8_WAIT_L(0); PG8_BAR; PG8_MMA(0, 0, At, B0); PG8_MMA(0, 1, At, B1); PG8_BAR; PG8_SCHED;
            PG8_LDA(At, 0, 1); PG8_STAGE(PG8_SB(0, 0), b2, voffB); PG8_STAGE(PG8_SB(0, 1), b2 + hstep, voffB); PG8_STAGE(PG8_SA(0, 0), a2, voffA);
            PG8_WAIT_V(8); PG8_WAIT_L(0); PG8_BAR; PG8_MMA(1, 0, At, B0); PG8_MMA(1, 1, At, B1); PG8_BAR; PG8_SCHED;
            PG8_LDB(B0, 1, 0); PG8_LDB(B1, 1, 1); PG8_SCHED; PG8_LDA(At, 1, 0); PG8_STAGE(PG8_SA(0, 1), a2 + hstep, voffA);
            PG8_WAIT_V(8); PG8_WAIT_L(0); PG8_BAR; PG8_MMA(0, 0, At, B0); PG8_MMA(0, 1, At, B1); PG8_BAR; PG8_SCHED;
            PG8_LDA(At, 1, 1); PG8_STAGE(PG8_SB(1, 0), b3, voffB); PG8_STAGE(PG8_SB(1, 1), b3 + hstep, voffB); PG8_STAGE(PG8_SA(1, 0), a3, voffA);
            PG8_WAIT_V(8); PG8_WAIT_L(0); PG8_BAR; PG8_MMA(1, 0, At, B0); PG8_MMA(1, 1, At, B1); PG8_BAR; PG8_SCHED;
            } else {
            PG8_LDB(B0, 0, 0); PG8_SCHED; PG8_LDA(At, 0, 0); PG8_STAGE(PG8_SA(1, 1), a1 + hstep, voffA);
            PG8_WAIT_L(8); PG8_BAR; PG8_WAIT_L(0); PG8_MMA(0, 0, At, B0); PG8_BAR; PG8_SCHED;
            PG8_LDB(B1, 0, 1); PG8_STAGE(PG8_SB(0, 0), b2, voffB);
            PG8_BAR; PG8_WAIT_L(0); PG8_MMA(0, 1, At, B1); PG8_BAR;
            PG8_LDA(At, 0, 1); PG8_STAGE(PG8_SA(0, 0), a2, voffA);
            PG8_BAR; PG8_WAIT_L(0); PG8_MMA(1, 0, At, B0); PG8_BAR; PG8_SCHED;
            PG8_STAGE(PG8_SB(0, 1), b2 + hstep, voffB);
            PG8_WAIT_V(6); PG8_BAR; PG8_MMA(1, 1, At, B1); PG8_BAR;
            PG8_LDB(B0, 1, 0); PG8_SCHED; PG8_LDA(At, 1, 0); PG8_STAGE(PG8_SA(0, 1), a2 + hstep, voffA);
            PG8_WAIT_L(8); PG8_BAR; PG8_WAIT_L(0); PG8_MMA(0, 0, At, B0); PG8_BAR; PG8_SCHED;
            PG8_LDB(B1, 1, 1); PG8_STAGE(PG8_SB(1, 0), b3, voffB);
            PG8_BAR; PG8_WAIT_L(0); PG8_MMA(0, 1, At, B1); PG8_BAR;
            PG8_LDA(At, 1, 1); PG8_STAGE(PG8_SA(1, 0), a3, voffA);
            PG8_BAR; PG8_WAIT_L(0); PG8_MMA(1, 0, At, B0); PG8_BAR; PG8_SCHED;
            PG8_STAGE(PG8_SB(1, 1), b3 + hstep, voffB);
            PG8_WAIT_V(6); PG8_BAR; PG8_MMA(1, 1, At, B1); PG8_BAR;
            }
        }
        if constexpr (ALIGN_EPI) { if (wr == 0) PG8_BAR; }
        if constexpr (!Epi::AFTER_DRAIN) { E(acc, cur, wr, wc, fr, fq); S.done(cur); }
        if (!has_next) break;
#pragma unroll
        for (int a = 0; a < 2; ++a)
#pragma unroll
            for (int b = 0; b < 2; ++b)
#pragma unroll
                for (int m = 0; m < 4; ++m)
#pragma unroll
                    for (int n = 0; n < 2; ++n) acc[a][b][m][n] = (f32x4){0.f, 0.f, 0.f, 0.f};
        cur = nxt; cA = nA; cB = nB; ++ui;
        if constexpr (ALIGN_EPI) { if (wr == 1) PG8_BAR; }
    }
    PG8_WAIT_V(0);
    if constexpr (!ALIGN_EPI) { if (wr == 0) PG8_BAR; }
    PG8_BAR;
    if constexpr (Epi::AFTER_DRAIN) { E.fused(acc, cur, wr, wc, fr, fq, lds, wid, lane); S.done(cur); }
#undef PG8_SA
#undef PG8_SB
#undef PG8_STAGE
#undef PG8_LDA
#undef PG8_LDB
#undef PG8_MMA
#undef PG8_WAIT_V
#undef PG8_WAIT_L
#undef PG8_BAR
#undef PG8_SCHED
}
}
#define GAS __attribute__((address_space(1)))
#define LAS __attribute__((address_space(3)))
typedef unsigned short bf16;
typedef unsigned v4u __attribute__((ext_vector_type(4)));
typedef float f32x4 __attribute__((ext_vector_type(4)));
typedef short bf16x8 __attribute__((ext_vector_type(8)));
typedef GAS unsigned gu32;
typedef GAS unsigned long long gu64;
#define RLX_AGENT __ATOMIC_RELAXED, __HIP_MEMORY_SCOPE_AGENT
#define LDS_WAIT() asm volatile("s_waitcnt lgkmcnt(0)" ::: "memory")
#define VM_WAIT() asm volatile("s_waitcnt vmcnt(0)" ::: "memory")
__device__ __forceinline__ unsigned long long rt() { return __builtin_amdgcn_s_memrealtime(); }
__device__ __forceinline__ unsigned f2bf(float f) { unsigned u = __builtin_bit_cast(unsigned, f); return (u + 0x7fffu + ((u >> 16) & 1u)) >> 16; }
__device__ __forceinline__ unsigned pk2(float lo, float hi) { return f2bf(lo) | (f2bf(hi) << 16); }
#define XB_TMO      128
#define XB_XCNT(j)  (256  + 64 * (j))
#define XB_XSUB(j)  (1280 + 64 * (j))
#define XB_XGEN(j)  (2304 + 64 * (j))
#define XB_TOP      3328
#define XB_TOPGEN   3392
#define XCD_BAR_WORDS 3456
#define XB_SPIN_CAP (1u << 18)

__device__ __forceinline__ unsigned xb_ld(unsigned* p)              { return __hip_atomic_load(p, __ATOMIC_RELAXED, __HIP_MEMORY_SCOPE_AGENT); }
__device__ __forceinline__ unsigned xb_add(unsigned* p, unsigned v) { return __hip_atomic_fetch_add(p, v, __ATOMIC_RELAXED, __HIP_MEMORY_SCOPE_AGENT); }
__device__ __forceinline__ unsigned xb_xcc_id() { return (unsigned)__builtin_amdgcn_s_getreg((3 << 11) | 20) & 0xFu; }
#define XB_SPIN(cond, bar) do { unsigned _sp = 0; while (cond) { __builtin_amdgcn_s_sleep(1); \
    if ((++_sp & 255u) == 0u) { if (xb_ld(&(bar)[XB_TMO])) break; if (_sp > XB_SPIN_CAP) { atomicAdd(&(bar)[XB_TMO], 1u); break; } } } } while (0)

struct XcdBarrier {
    unsigned* bar; unsigned x;
    volatile LAS unsigned* st;
};

__device__ __forceinline__ XcdBarrier xcd_barrier_post(unsigned* bar, volatile LAS unsigned* st) {
    XcdBarrier b; b.bar = bar; b.x = xb_xcc_id(); b.st = st;
    if (threadIdx.x == 0) (void)xb_add(&bar[XB_XCNT(b.x)], 1u);
    return b;
}
__device__ __forceinline__ void xcd_barrier_complete(unsigned* bar, unsigned x, unsigned& nloc, unsigned& nx) {
    const unsigned G = gridDim.x * gridDim.y * gridDim.z;
    unsigned sum, cnt, mine, sp = 0u;
    for (;;) {
        sum = 0u; cnt = 0u; mine = 0u;
#pragma unroll
        for (unsigned j = 0; j < 16; ++j) { const unsigned c = xb_ld(&bar[XB_XCNT(j)]); sum += c; cnt += (c > 0u) ? 1u : 0u; mine = (j == x) ? c : mine; }
        if (sum == G) break;
        __builtin_amdgcn_s_sleep(1);
        if ((++sp & 255u) == 0u) { if (xb_ld(&bar[XB_TMO])) break; if (sp > XB_SPIN_CAP) { atomicAdd(&bar[XB_TMO], 1u); break; } }
    }
    nloc = mine > 0u ? mine : 1u; nx = cnt > 0u ? cnt : 1u;
}

__device__ __forceinline__ void xcd_barrier(const XcdBarrier& b) {
    asm volatile("s_waitcnt vmcnt(0)" ::: "memory");
    __syncthreads();
    if (threadIdx.x == 0) {
        unsigned* bar = b.bar;
        __builtin_amdgcn_s_waitcnt(0);
        unsigned nloc = b.st[0], nx = b.st[1];
        if (nloc == 0u) { xcd_barrier_complete(bar, b.x, nloc, nx); b.st[0] = nloc; b.st[1] = nx; }
        const unsigned old = xb_add(&bar[XB_XSUB(b.x)], 1u);
        const unsigned gen = old / nloc;
        if (old + 1u == (gen + 1u) * nloc) {
            __builtin_amdgcn_fence(__ATOMIC_RELEASE, "agent");
            asm volatile("s_waitcnt vmcnt(0)" ::: "memory");
            const unsigned og = xb_add(&bar[XB_TOP], 1u);
            const unsigned tg = og / nx;
            if (og + 1u == (tg + 1u) * nx) xb_add(&bar[XB_TOPGEN], 1u);
            else XB_SPIN(xb_ld(&bar[XB_TOPGEN]) == tg, bar);
            __builtin_amdgcn_fence(__ATOMIC_ACQUIRE, "agent");
            xb_add(&bar[XB_XGEN(b.x)], 1u);
            asm volatile("s_waitcnt vmcnt(0)" ::: "memory");
        } else {
            XB_SPIN(xb_ld(&bar[XB_XGEN(b.x)]) == gen, bar);
            __builtin_amdgcn_fence(__ATOMIC_ACQUIRE, "agent");
            asm volatile("s_waitcnt vmcnt(0)" ::: "memory");
        }
    }
    __syncthreads();
}
constexpr int NB = 8, SEQ = 4096, DM = 1024, DEPTH = 4, M = NB * SEQ;
constexpr int FF = 2816, NIN = 5852, NINP = 5888;
constexpr float EPS = 1e-6f, NEGF = -1e30f;
constexpr int NWAVES = 8;
constexpr size_t MiB = 1u << 20;
constexpr size_t WS_CTL = 0, CTL_ZERO_BYTES = 1 * MiB;
constexpr size_t WS_ROPE = 1 * MiB;
constexpr size_t WS_KVA = 3 * MiB;
constexpr size_t WS_KC = 11 * MiB, WS_VC = WS_KC + 512 * 1024;
constexpr size_t WS_W = 12 * MiB;
constexpr size_t WO_GU1 = 0, WO_D1 = 11 * MiB, WO_GU2 = WO_D1 + 5 * MiB + 512 * 1024, WO_D2 = WO_GU2 + 11 * MiB, WO_IN = WO_D2 + 5 * MiB + 512 * 1024,
                 WO_PA = WO_IN + 11 * MiB + 512 * 1024, WO_PB = WO_PA + MiB, WO_PC = WO_PB + MiB, WO_OUT = WO_PC + MiB,
                 WO_CW1 = WO_OUT + 2 * MiB  , WO_CW2 = WO_CW1 + MiB  , WO_UKV = WO_CW2 + 32768  , WO_POOL = WO_UKV + 32768  ,
                 WO_POSB = WO_POOL + 131072  , WO_END = WO_POSB + 1024;
static_assert(WO_END <= 52 * MiB, "weights region");
constexpr size_t WS_XN = 64 * MiB;
constexpr size_t WS_R = 128 * MiB;
constexpr size_t WS_G = WS_R, WS_QA = WS_R + 192 * MiB, WS_QC = WS_QA + 32 * MiB, WS_IQ = WS_QC + 32 * MiB, WS_MISC = WS_IQ + 16 * MiB,
                 WS_KVC = WS_MISC + 16 * MiB, WS_KVS = WS_KVC + 16 * MiB, WS_KVW = WS_KVS + 16 * MiB, WS_BU = WS_KVW + 16 * MiB, WS_END = WS_BU + 32 * MiB;
#ifndef YB_SPARE
#define YB_SPARE 0
#endif
constexpr size_t WS_YB = YB_SPARE ? 496 * MiB : WS_XN;
constexpr size_t WS_MG = WS_IQ;
constexpr size_t WS_H = WS_R;
static_assert(WS_END == 496 * MiB, "ws map");
constexpr int RING_BYTES = 131072, LDS_BYTES = 163840, LDSCTL_OFF = 163840 - 256;
constexpr size_t WS_SSQ = 496 * MiB;
constexpr int RS_OFF = 131072;
constexpr int NPL = 10, NPH = 1 + DEPTH * NPL + 1;


#ifndef TPROBE
#define TPROBE 0
#endif
#if TPROBE
#define TP_DECL unsigned long long tp_t_ = __builtin_amdgcn_s_memtime();
#define TP_MARK(k) do { const unsigned long long n_ = __builtin_amdgcn_s_memtime(); if (tid == 0) atomicAdd((unsigned long long*)(ws + 32768) + (k), n_ - tp_t_); tp_t_ = n_; } while (0)
#define TP_ADD(k, v) do { if (tid == 0) atomicAdd((unsigned long long*)(ws + 32768) + (k), (unsigned long long)(v)); } while (0)
#else
#define TP_DECL
#define TP_MARK(k)
#define TP_ADD(k, v)
#endif
__device__ __forceinline__ int lane_id_v() { int l; asm volatile("v_mbcnt_lo_u32_b32 %0, -1, 0\n\tv_mbcnt_hi_u32_b32 %0, -1, %0" : "=v"(l)); return l; }
__device__ __forceinline__ float bflo(unsigned w) { return __uint_as_float(w << 16); }
__device__ __forceinline__ float bfhi(unsigned w) { return __uint_as_float(w & 0xffff0000u); }
__device__ __forceinline__ float bf2f(bf16 v) { return __uint_as_float((unsigned)v << 16); }
__device__ __forceinline__ float wave_sum(float v) {
#pragma unroll
    for (int o = 1; o < 64; o <<= 1) v += __shfl_xor(v, o);
    return v;
}
__device__ __forceinline__ float wave_max(float v) {
#pragma unroll
    for (int o = 1; o < 64; o <<= 1) v = fmaxf(v, __shfl_xor(v, o));
    return v;
}
__device__ __forceinline__ int wave_sum_i(int v) {
#pragma unroll
    for (int o = 1; o < 64; o <<= 1) v += __shfl_xor(v, o);
    return v;
}
__device__ __forceinline__ unsigned wave_max_u(unsigned v) {
#pragma unroll
    for (int o = 1; o < 64; o <<= 1) { const unsigned w = (unsigned)__shfl_xor((int)v, o); v = w > v ? w : v; }
    return v;
}
#define WAVE_LDS_SYNC() do { asm volatile("s_waitcnt lgkmcnt(0)" ::: "memory"); __builtin_amdgcn_wave_barrier(); } while (0)
__host__ __device__ __forceinline__ int permd(int d) { return d < 8 ? 2 * d : (d < 16 ? 2 * (d - 8) + 1 : d); }
__device__ __forceinline__ int win_newcol(int n) {
    if (n < 512) return (n & ~63) + permd(n & 63);
    if (n < 640) return 1280 + 64 + (n - 512);
    if (n < 896) { const int m = n - 640; return 1024 + (m & ~63) + permd(m & 63); }
    if (n < 960) return 1280 + permd(n - 896);
    if (n < 964) return 1280 + 192 + (n - 960);
    if (n < 1476) return 2304 + (n - 964);
    if (n < 1988) { const int m = n - 1476; return 512 + (m & ~63) + permd(m & 63); }
    if (n < 2756) { const int m = n - 1988, kv = m >> 8, r = m & 255, base = 1536 + kv * 256; return r < 128 ? base + (r & ~63) + permd(r & 63) : base + r; }
    if (n < 2780) return 1280 + 196 + (n - 2756);
    return 2816 + (n - 2780);
}
__device__ __forceinline__ int map_row(int mode, int n) { return mode == 0 ? n : (mode == 1 ? ((n >> 7) << 8) + (n & 127) : (mode == 2 ? ((n >> 7) << 8) + 128 + (n & 127) : win_newcol(n))); }

struct Args { const float* in[24]; float* out; unsigned char* ws; int ph_lo, ph_hi; };

__device__ __forceinline__ int unperm(int p) { return p < 16 ? ((p & 1) ? (p >> 1) + 8 : (p >> 1)) : p; }
__device__ __forceinline__ void tr_item(const float* W, int K, int N, bf16* WT, int mode, LAS float* scr, int item, int lane, bool kperm = false, const float* kscale = nullptr) {
    const int nblk = (N + 31) >> 5, kb = item / nblk, nb = item - kb * nblk, k0 = 64 * kb, n0 = 32 * nb;
    const int nn = n0 + (lane & 31);
    const int nnc = nn < N ? nn : N - 1; const float msk = nn < N ? 1.0f : 0.0f;
    const float* ksp = kscale ? kscale : W; const bool hs = kscale != nullptr;
    float wv[32], sv[32];
#pragma unroll
    for (int i = 0; i < 32; ++i) { const int kk = 2 * i + (lane >> 5); wv[i] = W[(size_t)(k0 + kk) * N + nnc]; sv[i] = ksp[k0 + kk]; }
#pragma unroll
    for (int i = 0; i < 32; ++i) { const int kk = 2 * i + (lane >> 5); scr[kk * 33 + (lane & 31)] = wv[i] * (hs ? sv[i] : 1.0f) * msk; }
    LDS_WAIT(); asm volatile("" ::: "memory");
    const int c = lane & 7;
#pragma unroll
    for (int j = 0; j < 4; ++j) { const int n = (lane >> 3) + 8 * j; const LAS float* s = scr + n;
        int ks[8];
#pragma unroll
        for (int i = 0; i < 8; ++i) ks[i] = (kperm ? unperm(8 * c + i) : 8 * c + i) * 33;
        v4u o; o.x = pk2(s[ks[0]], s[ks[1]]); o.y = pk2(s[ks[2]], s[ks[3]]); o.z = pk2(s[ks[4]], s[ks[5]]); o.w = pk2(s[ks[6]], s[ks[7]]);
        if (n0 + n < N) *(v4u*)(WT + (size_t)map_row(mode, n0 + n) * K + k0 + 8 * c) = o; }
    LDS_WAIT(); asm volatile("" ::: "memory");
}
__device__ __forceinline__ void phase_convert(const Args& P, unsigned char* ws, int z, int l, LAS unsigned char* lds, int gw, int NGW, int lane, int wave) {
    asm volatile("" : "+v"(lane)); lane &= 63; asm volatile("" : "+s"(gw), "+s"(NGW));
    LAS float* scr = (LAS float*)(lds + wave * 16384);
    unsigned char* wb = ws + WS_W;
    constexpr int I_F = 16 * 88, I_D = 44 * 32, I_IN = 16 * 183, I_P = 8 * 32, I_O = 16 * 32;
    constexpr int I_C = 32 * 4;
    constexpr int NIT = 4 * I_F + 2 * I_D + I_IN + 3 * I_P + I_O + 2 * I_C;
    const size_t fo = (size_t)l * DM * FF;
    for (int it = gw; it < NIT; it += NGW) {
        int r = it, K = DM, N = FF, mode = 1; const float* W = P.in[3 + z] + fo; size_t wo = WO_GU1; bool kperm = false; const float* ksc = P.in[2 + z] + l * DM;
        if (r >= I_F) { r -= I_F; mode = 2; W = P.in[4 + z] + fo;
        if (r >= I_F) { r -= I_F; mode = 0; W = P.in[5 + z] + fo; K = FF; N = DM; wo = WO_D1; ksc = nullptr;
        if (r >= I_D) { r -= I_D; mode = 1; W = P.in[20 + z] + fo; K = DM; N = FF; wo = WO_GU2; ksc = P.in[19 + z] + l * DM;
        if (r >= I_F) { r -= I_F; mode = 2; W = P.in[21 + z] + fo;
        if (r >= I_F) { r -= I_F; mode = 0; W = P.in[22 + z] + fo; K = FF; N = DM; wo = WO_D2; ksc = nullptr;
        if (r >= I_D) { r -= I_D; mode = 3; W = P.in[7 + z] + (size_t)l * DM * NIN; K = DM; N = NIN; wo = WO_IN; ksc = P.in[6 + z] + l * DM;
        if (r >= I_IN) { r -= I_IN; mode = 0; W = P.in[15 + z] + (size_t)l * 512 * DM; K = 512; N = DM; wo = WO_PA; ksc = nullptr;
        if (r >= I_P) { r -= I_P; W = P.in[16 + z] + (size_t)l * 512 * DM; wo = WO_PB;
        if (r >= I_P) { r -= I_P; W = P.in[17 + z] + (size_t)l * 512 * DM; wo = WO_PC;
        if (r >= I_P) { r -= I_P; W = P.in[18 + z] + (size_t)l * DM * DM; K = DM; wo = WO_OUT;
        if (r >= I_O) { r -= I_O; W = P.in[13 + z] + (size_t)(l * 2) * 2048 * 128; K = 2048; N = 128; wo = WO_CW1; kperm = true;
        if (r >= I_C) { r -= I_C; W += (size_t)2048 * 128; wo = WO_CW1 + 128 * 2048 * 2; kperm = false; } } } } } } } } } } } }
        tr_item(W, K, N, (bf16*)(wb + wo), mode, scr, r, lane, kperm, ksc);
    }
    {
        const int gt = gw * 64 + lane, GT = NGW * 64;
        bf16* ukv = (bf16*)(wb + WO_UKV); bf16* pool = (bf16*)(wb + WO_POOL); bf16* cw2 = (bf16*)(wb + WO_CW2); float* posb = (float*)(wb + WO_POSB);
        const float* w_ukv = P.in[9 + z] + (size_t)l * 128 * 128; const float* gn = P.in[8 + z] + l * 128;
        for (int i = gt; i < 128 * 128; i += GT) { const int np = i >> 7, k = i & 127, n = np < 64 ? unperm(np) : np; ukv[i] = (bf16)f2bf(gn[k] * w_ukv[k * 128 + n]); }
        const float* pw = P.in[10 + z] + (size_t)l * 4 * 128 * 128; const float* psc = P.in[11 + z] + l * 512;
        for (int i = gt; i < 4 * 128 * 128; i += GT) { const int g = i >> 14, d = (i >> 7) & 127, c = i & 127; pool[i] = (bf16)f2bf(pw[(g * 128 + c) * 128 + d] * psc[g * 128 + d]); }
        const float* w2 = P.in[14 + z] + (size_t)l * 2 * 128 * 64;
        for (int i = gt; i < 2 * 64 * 128; i += GT) { const int br = i >> 13, dp = (i >> 7) & 63, n = i & 127, d = br ? dp : unperm(dp); cw2[i] = (bf16)f2bf(w2[(br * 128 + n) * 64 + d]); }
        const float* w1 = P.in[13 + z] + (size_t)l * 2 * 2048 * 128; const float* pos = P.in[12 + z] + (size_t)l * 2 * 2048;
        for (int i = gw; i < 256; i += NGW) { const int br = i >> 7, n = i & 127; float a = 0.f;
#pragma unroll 8
            for (int k = lane; k < 2048; k += 64) a += pos[br * 2048 + k] * w1[((size_t)br * 2048 + k) * 128 + n];
            a = wave_sum(a); if (lane == 0) posb[i] = a; }
    }
    if (gw < 36) { unsigned zz = 0u; asm volatile("" : "+v"(zz)); v4u z = {zz, zz, zz, zz}; v4u* rp = (v4u*)((bf16*)(wb + WO_IN) + (size_t)(1500 + gw) * DM); for (int i = lane; i < DM / 8; i += 64) rp[i] = z; }
}
__device__ __forceinline__ void phase_rope(const Args& P, unsigned char* ws, int z, int gtid, int gthreads) {
    float* rope = (float*)(ws + WS_ROPE);
    for (int idx = gtid; idx < M * 8; idx += gthreads) {
        const int row = idx >> 3, i = idx & 7;
        const double inv = i == 0 ? 1.0 : i == 1 ? 0.19392274474868576 : i == 2 ? 0.03760603093086393 : i == 3 ? 0.007292664737217109 : i == 4 ? 0.001414213562373095 : i == 5 ? 0.0002742481756762073 : i == 6 ? 5.318295896944988e-05 : 1.031338537721246e-05;
        const double ang = (double)((const int*)P.in[1 + z])[row] * inv;
        double s, c; sincos(ang, &s, &c);
        rope[row * 16 + i] = (float)c; rope[row * 16 + 8 + i] = (float)s;
    }
}
__device__ __forceinline__ void norm_row_bf16(const float* xrow, const float* gain, bf16* orow, int lane) {
    const f32x4* xr = (const f32x4*)xrow + lane; const f32x4* gr = (const f32x4*)gain + lane;
    f32x4 v[4]; float s = 0.f;
#pragma unroll
    for (int j = 0; j < 4; ++j) { v[j] = xr[64 * j]; s += (v[j].x * v[j].x + v[j].y * v[j].y) + (v[j].z * v[j].z + v[j].w * v[j].w); }
    const float r = 1.0f / sqrtf(wave_sum(s) * (1.f / DM) + EPS);
    unsigned long long* o8 = (unsigned long long*)orow + lane;
#pragma unroll
    for (int j = 0; j < 4; ++j) { const f32x4 g = gr[64 * j]; o8[64 * j] = (unsigned long long)pk2(v[j].x * r * g.x, v[j].y * r * g.y) | ((unsigned long long)pk2(v[j].z * r * g.z, v[j].w * r * g.w) << 32); }
}
__device__ __forceinline__ void stat_row_bf16(const float* xrow, bf16* orow, float* ssq16, int lane) {
    const f32x4* xr = (const f32x4*)xrow + lane;
    f32x4 v[4]; float s = 0.f;
#pragma unroll
    for (int j = 0; j < 4; ++j) { v[j] = xr[64 * j]; s += (v[j].x * v[j].x + v[j].y * v[j].y) + (v[j].z * v[j].z + v[j].w * v[j].w); }
    s = wave_sum(s);
    unsigned long long* o8 = (unsigned long long*)orow + lane;
#pragma unroll
    for (int j = 0; j < 4; ++j) o8[64 * j] = (unsigned long long)pk2(v[j].x, v[j].y) | ((unsigned long long)pk2(v[j].z, v[j].w) << 32);
    if (lane < 16) ssq16[lane] = lane == 0 ? s : 0.f;
}
__device__ __forceinline__ void norm_row_f32(float* xrow, const float* gain, int lane, float tps = 1.0f) {
    f32x4* xr = (f32x4*)xrow + lane; const f32x4* gr = (const f32x4*)gain + lane;
    f32x4 v[4]; float s = 0.f;
#pragma unroll
    for (int j = 0; j < 4; ++j) { v[j] = xr[64 * j]; s += (v[j].x * v[j].x + v[j].y * v[j].y) + (v[j].z * v[j].z + v[j].w * v[j].w); }
    const float r = tps / sqrtf(wave_sum(s) * (1.f / DM) + EPS);
#pragma unroll
    for (int j = 0; j < 4; ++j) { const f32x4 g = gr[64 * j]; xr[64 * j] = v[j] * r * g; }
}
__device__ __forceinline__ unsigned f2o(float s) { const int b = (int)__float_as_uint(s); return (unsigned)(b ^ ((b >> 31) | (int)0x80000000)); }
__device__ __forceinline__ void unpack8(const v4u v, float* f) { f[0] = bflo(v.x); f[1] = bfhi(v.x); f[2] = bflo(v.y); f[3] = bfhi(v.y); f[4] = bflo(v.z); f[5] = bfhi(v.z); f[6] = bflo(v.w); f[7] = bfhi(v.w); }
__device__ __forceinline__ void load_row64(const bf16* p, float* f) {
    const v4u* q = (const v4u*)p;
#pragma unroll
    for (int i = 0; i < 8; ++i) unpack8(q[i], f + 8 * i);
}
__device__ __forceinline__ float dot64(const LAS float* q, const float* k) {
    float d = 0.f;
#pragma unroll
    for (int i = 0; i < 16; ++i) { const f32x4 qq = *(const LAS f32x4*)(q + 4 * i); d += qq.x * k[4 * i] + qq.y * k[4 * i + 1] + qq.z * k[4 * i + 2] + qq.w * k[4 * i + 3]; }
    return d;
}
__device__ __forceinline__ void dsa_query(const Args& P, unsigned char* ws, int z, int row, LAS unsigned char* wl, int lane) {
    const int b = row >> 12, t = row & (SEQ - 1), n = t + 1;
    LAS unsigned* su = (LAS unsigned*)wl; LAS float* pb = (LAS float*)wl; LAS unsigned short* list = (LAS unsigned short*)(wl + 16384); LAS float* qb = (LAS float*)(wl + 16896);
    const bf16* misc = (const bf16*)(ws + WS_MISC);
    const unsigned long long lt = (1ull << lane) - 1ull;
    int nsel;
    if (n <= 256) { for (int i = lane; i < n; i += 64) list[i] = (unsigned short)i; nsel = n; }
    else {
        { const uint2 v = *(const uint2*)((const bf16*)(ws + WS_IQ) + (size_t)row * 256 + lane * 4); qb[lane * 4] = bflo(v.x); qb[lane * 4 + 1] = bfhi(v.x); qb[lane * 4 + 2] = bflo(v.y); qb[lane * 4 + 3] = bfhi(v.y); }
        float iw[4]; { const uint2 v = *(const uint2*)(misc + (size_t)row * 256 + 192); iw[0] = 0.5f * bflo(v.x); iw[1] = 0.5f * bfhi(v.x); iw[2] = 0.5f * bflo(v.y); iw[3] = 0.5f * bfhi(v.y); }
        WAVE_LDS_SYNC();
        const int nch = (n + 63) >> 6;
        for (int i = 0; i < nch; ++i) {
            const int key = i * 64 + lane; const bool valid = key <= t;
            float kf[64]; load_row64(misc + (size_t)(b * SEQ + (valid ? key : t)) * 256, kf);
            float s = 0.f;
#pragma unroll
            for (int h = 0; h < 4; ++h) s += iw[h] * fmaxf(dot64(qb + h * 64, kf), 0.f);
            su[key] = valid ? f2o(s) : 0u;
        }
        WAVE_LDS_SYNC();
        unsigned prefix = 0u;
        for (int bit = 31; bit >= 0; --bit) {
            const unsigned cand = prefix | (1u << bit); int c = 0;
            for (int i = 0; i < nch; ++i) c += (su[i * 64 + lane] >= cand) ? 1 : 0;
            c = wave_sum_i(c);
            if (c >= 256) prefix = cand;
            if (c == 256) break;
        }
        int cgt = 0;
        for (int i = 0; i < nch; ++i) cgt += (su[i * 64 + lane] > prefix) ? 1 : 0;
        const int need_eq = 256 - wave_sum_i(cgt);
        int base = 0, eq_taken = 0;
        for (int i = 0; i < nch; ++i) {
            const unsigned v = su[i * 64 + lane]; const bool gt = v > prefix, eq = v == prefix;
            const unsigned long long meq = __ballot(eq);
            const bool sel = gt || (eq && (eq_taken + __popcll(meq & lt)) < need_eq);
            const unsigned long long ms = __ballot(sel);
            if (sel) list[base + __popcll(ms & lt)] = (unsigned short)(i * 64 + lane);
            base += __popcll(ms); eq_taken += __popcll(meq);
        }
        nsel = 256;
    }
    { const v4u v = *(const v4u*)((const bf16*)(ws + WS_QA) + (size_t)row * 512 + lane * 8); float f[8]; unpack8(v, f);
#pragma unroll
      for (int e = 0; e < 8; ++e) qb[lane * 8 + e] = f[e]; }
    WAVE_LDS_SYNC();
    const bf16* kva = (const bf16*)(ws + WS_KVA);
    float s[8][4];
#pragma unroll
    for (int j = 0; j < 4; ++j) {
        const int slot = lane + 64 * j; const bool valid = slot < nsel; const int key = list[valid ? slot : 0];
        float kf[64]; load_row64(kva + (size_t)(b * SEQ + key) * 128, kf);
#pragma unroll
        for (int h = 0; h < 8; ++h) s[h][j] = valid ? dot64(qb + h * 64, kf) : NEGF;
    }
    float linv[8];
#pragma unroll
    for (int h = 0; h < 8; ++h) {
        const float m = wave_max(fmaxf(fmaxf(s[h][0], s[h][1]), fmaxf(s[h][2], s[h][3]))); float ls = 0.f;
#pragma unroll
        for (int j = 0; j < 4; ++j) { const float p = __expf(s[h][j] - m); ls += p; pb[h * 256 + lane + 64 * j] = p; }
        linv[h] = 1.0f / wave_sum(ls);
    }
    WAVE_LDS_SYNC();
    float acc[8] = {0.f, 0.f, 0.f, 0.f, 0.f, 0.f, 0.f, 0.f};
    for (int slot = 0; slot < nsel; ++slot) {
        const float v = bf2f(kva[(size_t)(b * SEQ + list[slot]) * 128 + 64 + lane]);
#pragma unroll
        for (int h = 0; h < 8; ++h) acc[h] += pb[h * 256 + slot] * v;
    }
    bf16* ya = (bf16*)(ws + WS_QA) + (size_t)row * 512;
#pragma unroll
    for (int h = 0; h < 8; ++h) ya[h * 64 + lane] = (bf16)f2bf(acc[h] * linv[h]);
    WAVE_LDS_SYNC();
}
typedef short s16x4 __attribute__((ext_vector_type(4)));
typedef short v4i16_t __attribute__((ext_vector_type(4)));
typedef float f32x4v __attribute__((ext_vector_type(4)));
typedef __bf16 bf16x2_t __attribute__((ext_vector_type(2)));
typedef float f32x2_t __attribute__((ext_vector_type(2)));
__device__ __forceinline__ unsigned cvtpk(float lo, float hi) { f32x2_t v = {lo, hi}; bf16x2_t b = __builtin_convertvector(v, bf16x2_t); return __builtin_bit_cast(unsigned, b); }
constexpr float L2E = 1.4426950408889634f;
#ifndef NSA_NOSKIP
#define NSA_NOSKIP 0
#endif
constexpr int NSA_KSTR = 72, NSA_VSTR = 80;
constexpr int NSA_KB = 64 * NSA_KSTR * 2, NSA_VB = 64 * NSA_VSTR * 2;
constexpr int NSA_D = 6, NSA_SLOT = 16384;
constexpr int NSA_OFF_RING = 0, NSA_OFF_KCL = 0, NSA_OFF_VCTL = 32768  , NSA_OFF_IMPA = 65536  , NSA_OFF_IMPB = NSA_OFF_IMPA + 64 * 65 * 4, NSA_OFF_UM = NSA_D * NSA_SLOT + 1024  , NSA_OFF_QM = NSA_OFF_UM + 64, NSA_OFF_ST = NSA_OFF_UM + 1024, NSA_LDS = NSA_OFF_ST + 512 * 64;
__device__ __forceinline__ s16x4 tr16(const LAS unsigned char* p) { return __builtin_bit_cast(s16x4, __builtin_amdgcn_ds_read_tr16_b64_v4i16((LAS v4i16_t*)p)); }
__device__ __forceinline__ bf16x8 cat4(s16x4 a, s16x4 b) { return __builtin_shufflevector(a, b, 0, 1, 2, 3, 4, 5, 6, 7); }
__device__ __forceinline__ bf16x8 pack8(float a0, float a1, float a2, float a3, float b0, float b1, float b2, float b3) {
    v4u w; w.x = pg8::cvt_pk_bf16(a0, a1); w.y = pg8::cvt_pk_bf16(a2, a3); w.z = pg8::cvt_pk_bf16(b0, b1); w.w = pg8::cvt_pk_bf16(b2, b3); return __builtin_bit_cast(bf16x8, w);
}
__device__ __forceinline__ float xmax16(float v) { v = fmaxf(v, __shfl_xor(v, 16)); return fmaxf(v, __shfl_xor(v, 32)); }
__device__ __forceinline__ float xsum16(float v) { v += __shfl_xor(v, 16); return v + __shfl_xor(v, 32); }

__device__ __forceinline__ void nsa_fetch(const bf16* kv, int b, int jb, int g, int tid, v4u& kr, v4u& vr) {
    const bf16* p = kv + (size_t)(b * SEQ + 64 * jb + (tid >> 3)) * 256 + g * 64 + (tid & 7) * 8;
    kr = *(const v4u*)p; vr = *(const v4u*)(p + 128);
}
__device__ __forceinline__ void nsa_stash(LAS unsigned char* Kb, LAS unsigned char* Vb, int tid, const v4u& kr, const v4u& vr) {
    *(LAS v4u*)(Kb + ((tid >> 3) * NSA_KSTR + (tid & 7) * 8) * 2) = kr; *(LAS v4u*)(Vb + ((tid >> 3) * NSA_VSTR + (tid & 7) * 8) * 2) = vr;
}
template <bool FULL>
__device__ __forceinline__ void nsa_block2(const LAS unsigned char* Kb, const LAS unsigned char* Vb, const bf16x8 (&qf)[2][2], const bool (&sel)[2], const int (&klo)[2], const int (&khi)[2],
                                           float (&mrow)[2], float (&lrow)[2], f32x4v (&o)[2][4], int lane) {
    const int j = lane & 15, gq = lane >> 4;
    f32x4v s[2][4];
#pragma unroll
    for (int kt = 0; kt < 4; ++kt) {
        s[0][kt] = (f32x4v){0.f, 0.f, 0.f, 0.f}; s[1][kt] = (f32x4v){0.f, 0.f, 0.f, 0.f};
#pragma unroll
        for (int ks = 0; ks < 2; ++ks) {
            const bf16x8 kf = *(const LAS bf16x8*)(Kb + (16 * kt + j) * 128 + (((gq + 4 * ks) ^ (j & 7)) << 4));
            s[0][kt] = __builtin_amdgcn_mfma_f32_16x16x32_bf16(kf, qf[0][ks], s[0][kt], 0, 0, 0);
            s[1][kt] = __builtin_amdgcn_mfma_f32_16x16x32_bf16(kf, qf[1][ks], s[1][kt], 0, 0, 0);
        }
    }
#pragma unroll
    for (int rg = 0; rg < 2; ++rg) {
        float bm = NEGF;
        if (FULL) { const float bias = sel[rg] ? 0.f : NEGF;
#pragma unroll
            for (int kt = 0; kt < 4; ++kt)
#pragma unroll
                for (int e = 0; e < 4; ++e) { const float v = s[rg][kt][e] + bias; s[rg][kt][e] = v; bm = fmaxf(bm, v); }
        } else {
#pragma unroll
            for (int kt = 0; kt < 4; ++kt)
#pragma unroll
                for (int e = 0; e < 4; ++e) { const int ko = 16 * kt + 4 * gq + e; const bool ok = sel[rg] && ko >= klo[rg] && ko <= khi[rg]; const float v = ok ? s[rg][kt][e] : NEGF; s[rg][kt][e] = v; bm = fmaxf(bm, v); }
        }
        bm = xmax16(bm);
        const float mnew = fmaxf(mrow[rg], bm), alpha = __builtin_amdgcn_exp2f(mrow[rg] - mnew);
        const bool moved = __builtin_amdgcn_ballot_w64(mnew != mrow[rg]) != 0ull;
        mrow[rg] = mnew;
        float ps = 0.f;
#pragma unroll
        for (int kt = 0; kt < 4; ++kt)
#pragma unroll
            for (int e = 0; e < 4; ++e) { const float p = __builtin_amdgcn_exp2f(s[rg][kt][e] - mnew); s[rg][kt][e] = p; ps += p; }
        lrow[rg] = lrow[rg] * alpha + ps;
        if (moved) {
#pragma unroll
            for (int dt = 0; dt < 4; ++dt) o[rg][dt] *= alpha;
        }
    }
#pragma unroll
    for (int kk = 0; kk < 2; ++kk) {
        const bf16x8 pf0 = pack8(s[0][2 * kk][0], s[0][2 * kk][1], s[0][2 * kk][2], s[0][2 * kk][3], s[0][2 * kk + 1][0], s[0][2 * kk + 1][1], s[0][2 * kk + 1][2], s[0][2 * kk + 1][3]);
        const bf16x8 pf1 = pack8(s[1][2 * kk][0], s[1][2 * kk][1], s[1][2 * kk][2], s[1][2 * kk][3], s[1][2 * kk + 1][0], s[1][2 * kk + 1][1], s[1][2 * kk + 1][2], s[1][2 * kk + 1][3]);
#pragma unroll
        for (int dt = 0; dt < 4; ++dt) {
            const LAS unsigned char* va = Vb + (32 * kk + 4 * gq + (j >> 2)) * 128 + (16 * dt + 4 * (j & 3)) * 2;
            const bf16x8 vf = cat4(tr16(va), tr16(va + 16 * 128));
            o[0][dt] = __builtin_amdgcn_mfma_f32_16x16x32_bf16(vf, pf0, o[0][dt], 0, 0, 0);
            o[1][dt] = __builtin_amdgcn_mfma_f32_16x16x32_bf16(vf, pf1, o[1][dt], 0, 0, 0);
        }
        }
}
__device__ __forceinline__ void glds16(const void* gsrc, unsigned lds_dst) { unsigned keep;
    asm volatile("s_mov_b32 %0, m0\n\ts_mov_b32 m0, %2\n\ts_nop 0\n\tglobal_load_lds_dwordx4 %1, off\n\ts_mov_b32 m0, %0" : "=&s"(keep) : "v"(gsrc), "s"(lds_dst) : "memory"); }
template <int MODE>
__device__ __forceinline__ void nsa_attend(const bf16* kv, unsigned long long mask, int b, int g, int c, int tid, int lane, LAS unsigned char* ring, const bf16x8 (&qf)[2][2],
                                           const unsigned long long (&rmask)[2], const unsigned long long (&gmask)[2], const int (&trow)[2], float (&mrow)[2], float (&lrow)[2], f32x4v (&o)[2][4]) {
    const int wave = __builtin_amdgcn_readfirstlane(tid >> 6);
    const int rr = 8 * wave + (lane >> 3);
    const bf16* gk = kv + (size_t)(b * SEQ + rr) * 256 + g * 64 + (((lane & 7) ^ (rr & 7)) << 3);
    const bf16* gv = kv + (size_t)(b * SEQ + rr) * 256 + 128 + g * 64 + ((lane & 7) << 3);
    const unsigned ring0 = (unsigned)(uintptr_t)(unsigned char*)ring + wave * 1024;
#define NSA_ISSUE(jb_, slot_) do { glds16(gk + (size_t)(jb_) * 64 * 256, (unsigned)__builtin_amdgcn_readfirstlane(ring0 + (slot_) * NSA_SLOT)); \
                                   glds16(gv + (size_t)(jb_) * 64 * 256, (unsigned)__builtin_amdgcn_readfirstlane(ring0 + (slot_) * NSA_SLOT + 8192)); } while (0)
    unsigned long long remi = mask, remc = mask; int lastb = 0, si = 0, sc_ = 0;
#if DUP == 12
    float m2_[2] = {NEGF, NEGF}, l2_[2] = {0.f, 0.f}; f32x4v o2_[2][4]; for (int rg = 0; rg < 2; ++rg) for (int dt = 0; dt < 4; ++dt) o2_[rg][dt] = (f32x4v){0.f, 0.f, 0.f, 0.f};
#endif
#pragma unroll
    for (int d = 0; d < NSA_D - 1; ++d) { if (remi) { lastb = (int)__builtin_ctzll(remi); remi &= remi - 1ull; } NSA_ISSUE(lastb, si); si = si + 1 == NSA_D ? 0 : si + 1; }
    while (remc) {
        const int jj = (int)__builtin_ctzll(remc); remc &= remc - 1ull;
        asm volatile("s_waitcnt vmcnt(8) lgkmcnt(0)\n\ts_barrier" ::: "memory");
        if (remi) { lastb = (int)__builtin_ctzll(remi); remi &= remi - 1ull; }
        NSA_ISSUE(lastb, si); si = si + 1 == NSA_D ? 0 : si + 1;
        const LAS unsigned char* kb_ = ring + sc_ * NSA_SLOT; const LAS unsigned char* vb_ = kb_ + 8192; sc_ = sc_ + 1 == NSA_D ? 0 : sc_ + 1;
        bool sel[2]; int klo[2], khi[2]; bool act[2];
#pragma unroll
        for (int rg = 0; rg < 2; ++rg) { const int o6 = trow[rg] & 63;
            if (MODE == 0) { sel[rg] = (rmask[rg] >> jj) & 1ull; act[rg] = (gmask[rg] >> jj) & 1ull; klo[rg] = 0; khi[rg] = (jj == c) ? o6 : 63; }
            else { sel[rg] = true; act[rg] = true; klo[rg] = (jj == c - 4) ? o6 + 1 : 0; khi[rg] = (jj == c) ? o6 : 63; } }
        if (act[0] || act[1]) {
            const bool full = (MODE == 0) ? (jj != c) : (jj != c && jj != c - 4);
            if (full) nsa_block2<true>(kb_, vb_, qf, sel, klo, khi, mrow, lrow, o, lane); else nsa_block2<false>(kb_, vb_, qf, sel, klo, khi, mrow, lrow, o, lane);
#if DUP == 12
            if (full) nsa_block2<true>(kb_, vb_, qf, sel, klo, khi, m2_, l2_, o2_, lane); else nsa_block2<false>(kb_, vb_, qf, sel, klo, khi, m2_, l2_, o2_, lane);
#endif
        }
    }
#if DUP == 12
    { float acc_ = 0.f; for (int rg = 0; rg < 2; ++rg) { acc_ += l2_[rg] + m2_[rg]; for (int dt = 0; dt < 4; ++dt) acc_ += o2_[rg][dt][0] + o2_[rg][dt][1] + o2_[rg][dt][2] + o2_[rg][dt][3]; } if (acc_ == 123.456f) ((LAS float*)(ring + NSA_D * NSA_SLOT + 600))[0] = acc_; }
#endif
    asm volatile("s_waitcnt vmcnt(0) lgkmcnt(0)\n\ts_barrier" ::: "memory");
#undef NSA_ISSUE
}
#if defined(PROBE_CMP)
__device__ __forceinline__ void nsa_probe_store(unsigned char* ws, int row, int head, int gq, const f32x4v (&v)[4]) {
    bf16* pb_ = (bf16*)(ws + 497 * MiB);
    for (int dt = 0; dt < 4; ++dt) { uint2 w; w.x = cvtpk(v[dt][0], v[dt][1]); w.y = cvtpk(v[dt][2], v[dt][3]); *(uint2*)(pb_ + (size_t)row * 512 + head * 64 + 16 * dt + 4 * gq) = w; }
}
#endif
__device__ __forceinline__ void nsa_unit(unsigned char* ws, int unit, LAS unsigned char* lds, int tid_in, bf16* yout) {
    int tid = tid_in; asm volatile("" : "+v"(tid));
    const int lane = tid & 63, wave = __builtin_amdgcn_readfirstlane(tid >> 6), j = lane & 15, gq = lane >> 4;
    const int c = unit & 63, g = (unit >> 6) & 1, b = unit >> 7, bg = b * 2 + g;
    LAS float* impa = (LAS float*)(lds + NSA_OFF_IMPA); LAS float* impb = (LAS float*)(lds + NSA_OFF_IMPB);
    LAS unsigned long long* um = (LAS unsigned long long*)(lds + NSA_OFF_UM);
    TP_DECL
    for (int i = tid; i < 2 * 64 * 65; i += 512) impa[i] = 0.f;
    {
        const v4u* ksrc = (const v4u*)((const bf16*)(ws + WS_KC) + (size_t)bg * 256 * 64); const v4u* vsrc = (const v4u*)((const bf16*)(ws + WS_VC) + (size_t)bg * 64 * 256);
        v4u kst[4], vst[4];
#pragma unroll
        for (int i = 0; i < 4; ++i) { kst[i] = ksrc[tid + 512 * i]; vst[i] = vsrc[tid + 512 * i]; }
#pragma unroll
        for (int i = 0; i < 4; ++i) { const int idx = tid + 512 * i; const int r = idx >> 3, sg = idx & 7; *(LAS v4u*)(lds + NSA_OFF_KCL + r * 128 + ((sg ^ (r & 7)) << 4)) = kst[i]; }
#pragma unroll
        for (int i = 0; i < 4; ++i) { const int idx = tid + 512 * i; const int r = idx >> 5, sg = idx & 31; *(LAS v4u*)(lds + NSA_OFF_VCTL + r * 512 + ((sg ^ (r & 15)) << 4)) = vst[i]; }
    }
    bf16* qc = (bf16*)(ws + WS_QC);
    const bf16* misc = (const bf16*)(ws + WS_MISC);
    bf16x8 qf[2][2]; float gate[2][3]; int trow[2];
#pragma unroll
    for (int rg = 0; rg < 2; ++rg) {
        const int q = 8 * wave + 4 * rg + (j >> 2), t = 64 * c + q, row = b * SEQ + t, head = g * 4 + (j & 3);
        trow[rg] = t;
#pragma unroll
        for (int ks = 0; ks < 2; ++ks) qf[rg][ks] = *(const bf16x8*)(qc + (size_t)row * 512 + head * 64 + 8 * gq + 32 * ks);
#pragma unroll
        for (int e = 0; e < 3; ++e) gate[rg][e] = __builtin_amdgcn_rcpf(1.0f + __expf(-bf2f(misc[(size_t)row * 256 + 196 + head * 3 + e])));
    }
    typedef unsigned u32x2v __attribute__((ext_vector_type(2)));
    LAS u32x2v* stash = (LAS u32x2v*)(lds + NSA_OFF_ST) + tid * 8;
    __syncthreads();
    const int nT = (c >> 2) + 1;
#pragma unroll
    for (int rg = 0; rg < 2; ++rg) {
        const int t = trow[rg], nv = t >= 31 ? ((t - 15) >> 4) : 0;
        f32x4v s[16]; float mx = NEGF;
#pragma unroll
        for (int T = 0; T < 16; ++T) {
            s[T] = (f32x4v){0.f, 0.f, 0.f, 0.f};
            if (T < nT) {
#pragma unroll
                for (int ks = 0; ks < 2; ++ks) { const bf16x8 kf = *(const LAS bf16x8*)(lds + NSA_OFF_KCL + (16 * T + j) * 128 + (((gq + 4 * ks) ^ (j & 7)) << 4)); s[T] = __builtin_amdgcn_mfma_f32_16x16x32_bf16(kf, qf[rg][ks], s[T], 0, 0, 0); }
#pragma unroll
                for (int e = 0; e < 4; ++e) { const float v = (16 * T + 4 * gq + e < nv) ? s[T][e] : NEGF; s[T][e] = v; mx = fmaxf(mx, v); }
            }
        }
        mx = xmax16(mx);
        float ls = 0.f;
#pragma unroll
        for (int T = 0; T < 16; ++T) if (T < nT) {
#pragma unroll
            for (int e = 0; e < 4; ++e) { const float p = (16 * T + 4 * gq + e < nv) ? __builtin_amdgcn_exp2f(s[T][e] - mx) : 0.f; s[T][e] = p; ls += p; }
        }
        ls = xsum16(ls);
        const float inv = nv > 0 ? __builtin_amdgcn_rcpf(ls) : 0.f;
        const int q = 8 * wave + 4 * rg + (j >> 2);
#pragma unroll
        for (int T = 0; T < 16; ++T) if (T < nT) {
#pragma unroll
            for (int e = 0; e < 4; ++e) s[T][e] *= inv;
            float a = s[T][0] + s[T][1] + s[T][2] + 0.5f * s[T][3], bb = 0.5f * s[T][3];
            a += __shfl_xor(a, 1); a += __shfl_xor(a, 2); bb += __shfl_xor(bb, 1); bb += __shfl_xor(bb, 2);
            if ((j & 3) == 0) { impa[q * 65 + 4 * T + gq] = a; impb[q * 65 + 4 * T + gq + 1] = bb; }
        }
        f32x4v oc[4];
#pragma unroll
        for (int dt = 0; dt < 4; ++dt) oc[dt] = (f32x4v){0.f, 0.f, 0.f, 0.f};
#pragma unroll
        for (int kk = 0; kk < 8; ++kk) if (2 * kk < nT) {
            const bf16x8 pf = pack8(s[2 * kk][0], s[2 * kk][1], s[2 * kk][2], s[2 * kk][3], s[2 * kk + 1][0], s[2 * kk + 1][1], s[2 * kk + 1][2], s[2 * kk + 1][3]);
#pragma unroll
            for (int dt = 0; dt < 4; ++dt) {
                const LAS unsigned char* vp = lds + NSA_OFF_VCTL + (16 * dt + j) * 512 + (gq & 1) * 8;
                const s16x4 v0 = *(const LAS s16x4*)(vp + ((((8 * kk + gq) >> 1) ^ j) << 4)), v1 = *(const LAS s16x4*)(vp + (((((8 * kk + gq) >> 1) + 2) ^ j) << 4));
                oc[dt] = __builtin_amdgcn_mfma_f32_16x16x32_bf16(cat4(v0, v1), pf, oc[dt], 0, 0, 0);
            }
        }
#pragma unroll
        for (int dt = 0; dt < 4; ++dt) { const f32x4v v = oc[dt] * gate[rg][0]; u32x2v w; w.x = pg8::cvt_pk_bf16(v[0], v[1]); w.y = pg8::cvt_pk_bf16(v[2], v[3]); stash[rg * 4 + dt] = w; }
        __builtin_amdgcn_sched_barrier(0);
    }
    __syncthreads();
    TP_MARK(5);
    unsigned long long smask[8], mymask = 0ull;
#pragma unroll
    for (int qi = 0; qi < 8; ++qi) {
        const int q = 8 * wave + qi;
#if PROBE == 4
        const float imp = ((const float*)(ws + 500 * MiB))[((size_t)(b * SEQ + 64 * c + q) * 2 + g) * 64 + lane];
#else
        const float imp = impa[q * 65 + lane] + impb[q * 65 + lane];
#endif
#if PROBE && (PROBE != 5 || defined(PROBE5_IMP))
        ((float*)(ws + 516 * MiB))[((size_t)(b * SEQ + 64 * c + q) * 2 + g) * 64 + lane] = (lane <= c) ? imp : 0.f;
#endif
        const bool forced = (lane == 0) || (lane == c), adm = lane <= c;
        unsigned key = forced ? (0xFFFFFF00u | (unsigned)(63 - lane)) : (adm ? ((__float_as_uint(imp) & 0xFFFFFFC0u) | (unsigned)(63 - lane)) : 0u);
        unsigned long long mk = 0ull;
#if TOP8_RANK
        { int rank = 0;
#pragma unroll
          for (int jj = 0; jj < 64; ++jj) { const unsigned kk = (unsigned)__builtin_amdgcn_readlane((int)key, jj); rank += (kk > key) ? 1 : 0; }
          mk = __ballot(key != 0u && rank < 8); }
#else
        for (int k = 0; k < 8; ++k) { const unsigned mx = wave_max_u(key); if (mx == 0u) break; const int win = 63 - (int)(mx & 63u); mk |= 1ull << win; if (lane == win) key = 0u; }
#endif
        mk = ((unsigned long long)(unsigned)__builtin_amdgcn_readfirstlane((unsigned)(mk >> 32)) << 32) | (unsigned long long)(unsigned)__builtin_amdgcn_readfirstlane((unsigned)mk);
#ifdef FIXSEL
        { mk = 1ull | (1ull << c); for (int d = 1; d <= 6; ++d) mk |= 1ull << (((FIXHOM ? 0 : q * 7) + d * 5) % (c + 1)); }
#endif
#if PROBE == 2
        mk = ((const unsigned long long*)(ws + 496 * MiB))[(size_t)(b * SEQ + 64 * c + q) * 2 + g];
        mk = ((unsigned long long)(unsigned)__builtin_amdgcn_readfirstlane((unsigned)(mk >> 32)) << 32) | (unsigned long long)(unsigned)__builtin_amdgcn_readfirstlane((unsigned)mk);
#endif
#if PROBE == 5
        if (lane == 0) ((unsigned long long*)(ws + 498 * MiB))[(size_t)(b * SEQ + 64 * c + q) * 2 + g] = mk;
#endif
#if PROBE == 5 && !defined(PROBE5_IMP)
        ((float*)(ws + 516 * MiB))[((size_t)(b * SEQ + 64 * c + q) * 2 + g) * 64 + lane] = ((mk >> lane) & 1ull) ? 1.f : 0.f;
#endif
        smask[qi] = mk; mymask |= mk;
    }
    if (lane == 0) um[wave] = mymask;
    __syncthreads();
    unsigned long long umask = 0ull;
#pragma unroll
    for (int w = 0; w < 8; ++w) umask |= um[w];
    umask = ((unsigned long long)(unsigned)__builtin_amdgcn_readfirstlane((unsigned)(umask >> 32)) << 32) | (unsigned long long)(unsigned)__builtin_amdgcn_readfirstlane((unsigned)umask);
    unsigned long long rmask[2];
    { LAS unsigned long long* qm = (LAS unsigned long long*)(lds + NSA_OFF_QM);
      __syncthreads();
#pragma unroll
      for (int qi = 0; qi < 8; ++qi) if (lane == 0) qm[8 * wave + qi] = smask[qi];
      __syncthreads();
#pragma unroll
      for (int rg = 0; rg < 2; ++rg) rmask[rg] = qm[8 * wave + 4 * rg + (j >> 2)]; }
    const unsigned long long gmask[2] = {smask[0] | smask[1] | smask[2] | smask[3], smask[4] | smask[5] | smask[6] | smask[7]};
    TP_MARK(6); TP_ADD(9, __popcll(umask)); TP_ADD(10, 1); TP_ADD(11, c + 1); TP_ADD(12, __popcll(umask & ~(c == 63 ? ~0ull : ((2ull << c) - 1ull)))); TP_ADD(13, __popcll(smask[0]));
    const bf16* kvs = (const bf16*)(ws + WS_KVS); const bf16* kvw = (const bf16*)(ws + WS_KVW);
    LAS unsigned char* ring = lds + NSA_OFF_RING;
    {
        float mrow[2] = {NEGF, NEGF}, lrow[2] = {0.f, 0.f}; f32x4v o[2][4];
#pragma unroll
        for (int rg = 0; rg < 2; ++rg)
#pragma unroll
            for (int dt = 0; dt < 4; ++dt) o[rg][dt] = (f32x4v){0.f, 0.f, 0.f, 0.f};
        nsa_attend<0>(kvs, umask, b, g, c, tid, lane, ring, qf, rmask, gmask, trow, mrow, lrow, o);
#if DUP == 8
        { __syncthreads(); float m2[2] = {NEGF, NEGF}, l2[2] = {0.f, 0.f}; f32x4v o2[2][4];
          for (int rg = 0; rg < 2; ++rg) for (int dt = 0; dt < 4; ++dt) o2[rg][dt] = (f32x4v){0.f, 0.f, 0.f, 0.f};
          nsa_attend<0>(kvs, umask, b, g, c, tid, lane, Kb, Vb, qf, rmask, gmask, trow, m2, l2, o2);
          bf16* dmy = (bf16*)(ws + WS_BU) + (size_t)(b * SEQ + trow[0]) * 512 + (g * 4 + (j & 3)) * 64 + 4 * gq;
          for (int rg = 0; rg < 2; ++rg) for (int dt = 0; dt < 4; ++dt) { uint2 w; w.x = pg8::cvt_pk_bf16(o2[rg][dt][0] + l2[rg], o2[rg][dt][1]); w.y = pg8::cvt_pk_bf16(o2[rg][dt][2], o2[rg][dt][3]); *(uint2*)(dmy + 16 * dt) = w; } }
#endif
#pragma unroll
        for (int rg = 0; rg < 2; ++rg) { const float sc = gate[rg][1] * __builtin_amdgcn_rcpf(xsum16(lrow[rg]));
#pragma unroll
            for (int dt = 0; dt < 4; ++dt) { const u32x2v p = stash[rg * 4 + dt]; const f32x4v v = o[rg][dt] * sc; u32x2v w; w.x = pg8::cvt_pk_bf16(v[0] + bflo(p.x), v[1] + bfhi(p.x)); w.y = pg8::cvt_pk_bf16(v[2] + bflo(p.y), v[3] + bfhi(p.y)); stash[rg * 4 + dt] = w; }
            }
        __syncthreads();
    }
    TP_MARK(7);
    {
        float mrow[2] = {NEGF, NEGF}, lrow[2] = {0.f, 0.f}; f32x4v o[2][4];
#pragma unroll
        for (int rg = 0; rg < 2; ++rg)
#pragma unroll
            for (int dt = 0; dt < 4; ++dt) o[rg][dt] = (f32x4v){0.f, 0.f, 0.f, 0.f};
        { const int j0 = c - 4 > 0 ? c - 4 : 0; const unsigned long long wmask = ((c == 63 ? ~0ull : ((1ull << (c + 1)) - 1ull)) >> j0) << j0;
          nsa_attend<1>(kvw, wmask, b, g, c, tid, lane, ring, qf, rmask, gmask, trow, mrow, lrow, o); }
#pragma unroll
        for (int rg = 0; rg < 2; ++rg) { const float sc = gate[rg][2] * __builtin_amdgcn_rcpf(xsum16(lrow[rg]));
#pragma unroll
            for (int dt = 0; dt < 4; ++dt) { const u32x2v p = stash[rg * 4 + dt]; const f32x4v v = o[rg][dt] * sc; uint2 w; w.x = pg8::cvt_pk_bf16(v[0] + bflo(p.x), v[1] + bfhi(p.x)); w.y = pg8::cvt_pk_bf16(v[2] + bflo(p.y), v[3] + bfhi(p.y));
                *(uint2*)(yout + (size_t)(b * SEQ + trow[rg]) * 512 + (g * 4 + (j & 3)) * 64 + 16 * dt + 4 * gq) = w; }
            }
    }
    __syncthreads();
    TP_MARK(8);
}
__device__ __forceinline__ void prep_kva16(unsigned char* ws, int task, int lane) {
    const int j = lane & 15, gq = lane >> 4, row = task * 16 + j;
    const bf16* misc = (const bf16*)(ws + WS_MISC) + (size_t)row * 256 + 64;
    const bf16* wu = (const bf16*)(ws + WS_W + WO_UKV);
    bf16x8 cf[4]; float ss = 0.f;
#pragma unroll
    for (int ks = 0; ks < 4; ++ks) { const v4u v = *(const v4u*)(misc + 8 * gq + 32 * ks); cf[ks] = __builtin_bit_cast(bf16x8, v); float f[8]; unpack8(v, f);
#pragma unroll
        for (int e = 0; e < 8; ++e) ss += f[e] * f[e]; }
    ss = xsum16(ss);
    const float r = 1.0f / sqrtf(ss * (1.f / 128.f) + EPS);
    const float* rp = (const float*)(ws + WS_ROPE) + (size_t)row * 16;
    bf16* o = (bf16*)(ws + WS_KVA) + (size_t)row * 128;
#pragma unroll
    for (int ct = 0; ct < 8; ++ct) {
        f32x4v a = {0.f, 0.f, 0.f, 0.f};
#pragma unroll
        for (int ks = 0; ks < 4; ++ks) { const bf16x8 wf = *(const bf16x8*)(wu + (size_t)(16 * ct + j) * 128 + 8 * gq + 32 * ks); a = __builtin_amdgcn_mfma_f32_16x16x32_bf16(wf, cf[ks], a, 0, 0, 0); }
        a *= r;
        if (ct == 0) {
            const float c0 = rp[2 * gq], s0 = rp[8 + 2 * gq], c1 = rp[2 * gq + 1], s1 = rp[8 + 2 * gq + 1];
            const float x0 = a[0], x1 = a[1], x2 = a[2], x3 = a[3];
            a[0] = x0 * c0 - x1 * s0; a[1] = x1 * c0 + x0 * s0; a[2] = x2 * c1 - x3 * s1; a[3] = x3 * c1 + x2 * s1;
        }
        uint2 w; w.x = cvtpk(a[0], a[1]); w.y = cvtpk(a[2], a[3]);
        *(uint2*)(o + 16 * ct + 4 * gq) = w;
    }
}
__device__ __forceinline__ void prep_pool16(unsigned char* ws, int task, int lane, const LAS unsigned char* wl) {
    const int j = lane & 15, gq = lane >> 4, row = task * 16 + j, t = row & (SEQ - 1);
    const bf16* bu = (const bf16*)(ws + WS_BU);
    bf16* yb = (bf16*)(ws + WS_YB) + (size_t)row * 512;
#pragma unroll 1
    for (int g = 0; g < 4; ++g) {
        const int w = 2 << g, lo = (t + 1 - w) > 0 ? (t + 1 - w) : 0, cnt = t + 1 - lo; const float inv = 1.0f / (float)cnt;
        bf16x8 pf[4];
#pragma unroll
        for (int ks = 0; ks < 4; ++ks) {
            const bf16* p = bu + (size_t)row * 512 + g * 128 + 8 * gq + 32 * ks;
            float sum[8] = {0.f, 0.f, 0.f, 0.f, 0.f, 0.f, 0.f, 0.f}, cur[8];
            { const v4u v = *(const v4u*)p; unpack8(v, cur);
#pragma unroll
              for (int e = 0; e < 8; ++e) sum[e] = cur[e]; }
            v4u wv_[15];
#pragma unroll
            for (int i = 1; i < 16; ++i) if (i < w) wv_[i - 1] = *(const v4u*)(p - (size_t)(i < cnt ? i : 0) * 512);
#pragma unroll
            for (int i = 1; i < 16; ++i) if (i < w) { const bool ok = i < cnt; float f[8]; unpack8(wv_[i - 1], f);
#pragma unroll
                for (int e = 0; e < 8; ++e) sum[e] += ok ? f[e] : 0.f; }
            __builtin_amdgcn_sched_barrier(0);
            pf[ks] = pack8(sum[0] * inv - cur[0], sum[1] * inv - cur[1], sum[2] * inv - cur[2], sum[3] * inv - cur[3], sum[4] * inv - cur[4], sum[5] * inv - cur[5], sum[6] * inv - cur[6], sum[7] * inv - cur[7]);
        }
#pragma unroll
        for (int dt = 0; dt < 8; ++dt) {
            f32x4v a = {0.f, 0.f, 0.f, 0.f};
#pragma unroll
            for (int ks = 0; ks < 4; ++ks) {
#if POOLDBG == 1
                bf16x8 wf; for (int e = 0; e < 8; ++e) wf[e] = (short)0x3c00;
#else
                const bf16x8 wf = *(const LAS bf16x8*)(wl + (g * 128 + 16 * dt + j) * 256 + (((gq + 4 * ks) ^ j) << 4));
#endif
#if POOLDBG == 2
                bf16x8 pz; for (int e = 0; e < 8; ++e) pz[e] = (short)0x3c00; a = __builtin_amdgcn_mfma_f32_16x16x32_bf16(wf, pz, a, 0, 0, 0);
#else
                a = __builtin_amdgcn_mfma_f32_16x16x32_bf16(wf, pf[ks], a, 0, 0, 0);
#endif
            }
            uint2 wv; wv.x = cvtpk(a[0], a[1]); wv.y = cvtpk(a[2], a[3]);
            *(uint2*)(yb + g * 128 + 16 * dt + 4 * gq) = wv;
        }
    }
}
__device__ __forceinline__ float gelu_tanh_f(float x) { const float u = 0.7978845608028654f * (x + 0.044715f * x * x * x); const float e = __expf(2.0f * u); return 0.5f * x * (1.0f + (1.0f - 2.0f / (e + 1.0f))); }
__device__ __forceinline__ void prep_cmp16(unsigned char* ws, int task, LAS unsigned char* lds, int wave, int lane) {
    const int j = lane & 15, gq = lane >> 4, grp = wave >> 2, wq = wave & 3;
    const int i0 = (task & 15) * 16, bg = (task >> 4) & 15, br = task >> 8, b = bg >> 1, g = bg & 1, i = i0 + j;
    const bf16* kvc = (const bf16*)(ws + WS_KVC);
    const bf16* w1 = (const bf16*)(ws + WS_W + WO_CW1) + (size_t)br * 128 * 2048;
    const bf16* w2 = (const bf16*)(ws + WS_W + WO_CW2) + (size_t)br * 64 * 128;
    const float* posb = (const float*)(ws + WS_W + WO_POSB) + br * 128;
    LAS float* part = (LAS float*)lds + (size_t)grp * 4 * 32 * 64;
    f32x4v h[8];
#pragma unroll
    for (int nt = 0; nt < 8; ++nt) h[nt] = (f32x4v){0.f, 0.f, 0.f, 0.f};
#define CMP_LOAD(k2_, wf_, ff_) do { const int ks_ = 16 * wq + (k2_), l_ = ks_ >> 1; int tok_ = 16 * i + l_; tok_ = tok_ > SEQ - 1 ? SEQ - 1 : tok_;     \
        ff_ = *(const bf16x8*)(kvc + (size_t)(b * SEQ + tok_) * 256 + br * 128 + g * 64 + 32 * (ks_ & 1) + 8 * gq); \
        _Pragma("unroll") for (int nt_ = 0; nt_ < 8; ++nt_) wf_[nt_] = *(const bf16x8*)(w1 + (size_t)(16 * nt_ + j) * 2048 + 32 * ks_ + 8 * gq); } while (0)
    bf16x8 wfA[8], wfB[8], ffA, ffB;
    CMP_LOAD(0, wfA, ffA);
#pragma unroll
    for (int k2 = 0; k2 < 16; k2 += 2) {
        CMP_LOAD(k2 + 1, wfB, ffB);
        __builtin_amdgcn_sched_barrier(0);
#pragma unroll
        for (int nt = 0; nt < 8; ++nt) h[nt] = __builtin_amdgcn_mfma_f32_16x16x32_bf16(wfA[nt], ffA, h[nt], 0, 0, 0);
        if (k2 + 2 < 16) CMP_LOAD(k2 + 2, wfA, ffA);
        __builtin_amdgcn_sched_barrier(0);
#pragma unroll
        for (int nt = 0; nt < 8; ++nt) h[nt] = __builtin_amdgcn_mfma_f32_16x16x32_bf16(wfB[nt], ffB, h[nt], 0, 0, 0);
    }
#undef CMP_LOAD
#pragma unroll
    for (int nt = 0; nt < 8; ++nt)
#pragma unroll
        for (int e = 0; e < 4; ++e) part[(wq * 32 + nt * 4 + e) * 64 + lane] = h[nt][e];
    f32x4v pbv_[8];
#pragma unroll
    for (int nt = 0; nt < 8; ++nt) pbv_[nt] = *(const f32x4v*)(posb + 16 * nt + 4 * gq);
    __syncthreads();
    if (wq == 0) {
#pragma unroll
        for (int nt = 0; nt < 8; ++nt) { const f32x4v pbv = pbv_[nt];
#pragma unroll
            for (int e = 0; e < 4; ++e) { const int idx = (nt * 4 + e) * 64 + lane; h[nt][e] = gelu_tanh_f(((part[idx] + part[32 * 64 + idx]) + (part[2 * 32 * 64 + idx] + part[3 * 32 * 64 + idx])) + pbv[e]); } }
        f32x4v o[4];
#pragma unroll
        for (int dt = 0; dt < 4; ++dt) o[dt] = (f32x4v){0.f, 0.f, 0.f, 0.f};
        s16x4 w2a[4][4], w2b[4][4];
#pragma unroll
        for (int kk = 0; kk < 4; ++kk)
#pragma unroll
            for (int dt = 0; dt < 4; ++dt) { const bf16* wp = w2 + (size_t)(16 * dt + j) * 128 + 32 * kk + 4 * gq; w2a[kk][dt] = *(const s16x4*)wp; w2b[kk][dt] = *(const s16x4*)(wp + 16); }
        __builtin_amdgcn_sched_barrier(0);
#pragma unroll
        for (int kk = 0; kk < 4; ++kk) {
            const bf16x8 hf = pack8(h[2 * kk][0], h[2 * kk][1], h[2 * kk][2], h[2 * kk][3], h[2 * kk + 1][0], h[2 * kk + 1][1], h[2 * kk + 1][2], h[2 * kk + 1][3]);
#pragma unroll
            for (int dt = 0; dt < 4; ++dt) o[dt] = __builtin_amdgcn_mfma_f32_16x16x32_bf16(cat4(w2a[kk][dt], w2b[kk][dt]), hf, o[dt], 0, 0, 0);
        }
        const bool dead = i == 255;
        if (br == 0) { bf16* kc = (bf16*)(ws + WS_KC) + ((size_t)bg * 256 + i) * 64;
#pragma unroll
            for (int dt = 0; dt < 4; ++dt) { uint2 w; w.x = dead ? 0u : cvtpk(o[dt][0], o[dt][1]); w.y = dead ? 0u : cvtpk(o[dt][2], o[dt][3]); *(uint2*)(kc + 16 * dt + 4 * gq) = w; }
        } else { bf16* vct = (bf16*)(ws + WS_VC) + (size_t)bg * 64 * 256 + i;
#pragma unroll
            for (int dt = 0; dt < 4; ++dt)
#pragma unroll
                for (int e = 0; e < 4; ++e) vct[(size_t)(16 * dt + 4 * gq + e) * 256] = dead ? (bf16)0 : (bf16)f2bf(o[dt][e]);
        }
    }
    __syncthreads();
}
__device__ __forceinline__ void phase_prep(const Args& P, unsigned char* ws, int z, int l, LAS unsigned char* lds, int gw, int NGW, int lane, int wave) {
    asm volatile("" : "+v"(lane)); lane &= 63; asm volatile("" : "+s"(gw), "+s"(NGW));
    for (int it = 2 * (gw >> 3) + (wave >> 2); it < 512 + (wave >> 2); it += 2 * (NGW >> 3)) prep_cmp16(ws, it < 512 ? it : 511, lds, wave, lane);
    {
        const v4u* src = (const v4u*)(ws + WS_W + WO_POOL); const int t_ = (wave << 6) | lane;
        v4u pst[16];
#pragma unroll
        for (int i = 0; i < 16; ++i) pst[i] = src[t_ + 512 * i];
#pragma unroll
        for (int i = 0; i < 16; ++i) { const int idx = t_ + 512 * i, r = idx >> 4, sg = idx & 15; *(LAS v4u*)(lds + r * 256 + ((sg ^ (r & 15)) << 4)) = pst[i]; }
        __syncthreads();
    }
    for (int it = gw; it < M / 16; it += NGW) { prep_kva16(ws, it, lane); prep_pool16(ws, it, lane, lds); }
    __syncthreads();
}
constexpr int DSA_K = DSA_K_V, DSA_S = 32 - DSA_K, DSA_CAP = DSA_CAP_V;
constexpr int DSA_OFF_CNT = 0, DSA_OFF_PC = 3072, DSA_OFF_LIST = DSA_OFF_PC + 32 * 16 * 4, DSA_OFF_V = DSA_OFF_LIST + 16 * 256 * 2, DSA_VB = 64 * NSA_VSTR * 2, DSA_LDS = DSA_OFF_V + 8 * DSA_VB;
#define DSA_FOR_TILES(...) _Pragma("unroll") for (int G8 = 0; G8 < 8; ++G8) { if (G8 < ngrp) { _Pragma("unroll") for (int T8 = 0; T8 < 4; ++T8) { const int T = G8 * 4 + T8; __VA_ARGS__ } } }
__device__ __forceinline__ void cnt_ge(int& c, unsigned u, unsigned cand) { asm volatile("v_cmp_ge_u32_e32 vcc, %1, %2\n\tv_addc_co_u32_e32 %0, vcc, 0, %0, vcc" : "+v"(c) : "v"(u), "v"(cand) : "vcc"); }
__device__ __forceinline__ void cnt_gt(int& c, unsigned u, unsigned cand) { asm volatile("v_cmp_gt_u32_e32 vcc, %1, %2\n\tv_addc_co_u32_e32 %0, vcc, 0, %0, vcc" : "+v"(c) : "v"(u), "v"(cand) : "vcc"); }
__device__ __forceinline__ void cnt_le(int& c, unsigned u, unsigned cand) { asm volatile("v_cmp_le_u32_e32 vcc, %1, %2\n\tv_addc_co_u32_e32 %0, vcc, 0, %0, vcc" : "+v"(c) : "v"(u), "v"(cand) : "vcc"); }
__device__ __forceinline__ int dsa_total(LAS unsigned* cnt, int par, int wave, int j, int gq, int c) {
    c += __shfl_xor(c, 16); c += __shfl_xor(c, 32);
    if (gq == 0) cnt[(par * 8 + wave) * 16 + j] = (unsigned)c;
    __syncthreads();
    int tot = 0;
#pragma unroll
    for (int w = 0; w < 8; ++w) tot += (int)cnt[(par * 8 + w) * 16 + j];
    return tot;
}
__device__ __forceinline__ void dsa_unit(unsigned char* ws, int unit, LAS unsigned char* lds, int tid_in, bf16* yout) {
    int tid = tid_in; asm volatile("" : "+v"(tid));
    const int lane = tid & 63, wave = __builtin_amdgcn_readfirstlane(tid >> 6), j = lane & 15, gq = lane >> 4;
    const int b = unit >> 8, q0 = (unit & 255) * 16, t = q0 + j, row = b * SEQ + t;
    LAS unsigned* cnt = (LAS unsigned*)(lds + DSA_OFF_CNT); LAS unsigned* pc = (LAS unsigned*)(lds + DSA_OFF_PC);
    LAS unsigned short* list = (LAS unsigned short*)(lds + DSA_OFF_LIST);
    const bf16* misc = (const bf16*)(ws + WS_MISC);
    TP_DECL
    if (q0 >= 256) {
        const int ntiles = (q0 >> 4) + 1;
        const int ntl = wave < ntiles ? ((ntiles - 1 - wave) >> 3) + 1 : 0;
        const int ngrp = (ntl + 3) >> 2;
        bf16x8 qf[4][2]; float iw[4];
        { const bf16* iq = (const bf16*)(ws + WS_IQ) + (size_t)row * 256;
#pragma unroll
          for (int h = 0; h < 4; ++h) { iw[h] = 0.5f * bf2f(misc[(size_t)row * 256 + 192 + h]);
#pragma unroll
              for (int ks = 0; ks < 2; ++ks) qf[h][ks] = *(const bf16x8*)(iq + h * 64 + 8 * gq + 32 * ks); } }
        unsigned u[32][4];
#pragma unroll
        for (int T = 0; T < 32; ++T)
#pragma unroll
            for (int e = 0; e < 4; ++e) u[T][e] = 0u;
        const int kb0 = 16 * wave + 4 * gq;
        LAS unsigned char* ring = lds + DSA_OFF_V + wave * 16384;
#define DSA_ISSUE(Ti) do { _Pragma("unroll") for (int i_ = 0; i_ < 2; ++i_) { const int r_ = 8 * i_ + (lane >> 3); int kr_ = 16 * wave + 128 * (Ti) + r_; kr_ = kr_ > SEQ - 1 ? SEQ - 1 : kr_; \
            __builtin_amdgcn_global_load_lds((const unsigned*)(misc + (size_t)(b * SEQ + kr_) * 256 + (((lane & 7) ^ (r_ & 7)) << 3)), (LAS unsigned*)(ring + ((Ti) & 7) * 2048 + i_ * 1024), 16, 0, 0); } } while (0)
        if (ngrp > 0) {
#pragma unroll
            for (int T = 0; T < 8; ++T) DSA_ISSUE(T);
        }
        DSA_FOR_TILES(
            asm volatile("s_waitcnt vmcnt(14)" ::: "memory");
            const LAS unsigned char* tp = ring + (T & 7) * 2048 + j * 128;
            const bf16x8 kf0 = *(const LAS bf16x8*)(tp + ((gq ^ (j & 7)) << 4)); const bf16x8 kf1 = *(const LAS bf16x8*)(tp + (((gq + 4) ^ (j & 7)) << 4));
            asm volatile("s_waitcnt lgkmcnt(0)" ::: "memory");
            DSA_ISSUE(T + 8);
            float sc[4] = {0.f, 0.f, 0.f, 0.f};
            _Pragma("unroll") for (int h = 0; h < 4; ++h) {
                f32x4v a = {0.f, 0.f, 0.f, 0.f};
                a = __builtin_amdgcn_mfma_f32_16x16x32_bf16(kf0, qf[h][0], a, 0, 0, 0);
                a = __builtin_amdgcn_mfma_f32_16x16x32_bf16(kf1, qf[h][1], a, 0, 0, 0);
                _Pragma("unroll") for (int e = 0; e < 4; ++e) { const int ai_ = (int)__float_as_uint(a[e]); sc[e] += iw[h] * __uint_as_float((unsigned)(ai_ > 0 ? ai_ : 0)); }
                asm volatile("" : "+v"(sc[0]), "+v"(sc[1]), "+v"(sc[2]), "+v"(sc[3]));
            }
            _Pragma("unroll") for (int e = 0; e < 4; ++e) { unsigned x = f2o(sc[e]); asm volatile("" : "+v"(x)); u[T][e] = (kb0 + 128 * T + e <= t) ? x : 0u; }
        )
        asm volatile("s_waitcnt vmcnt(0)" ::: "memory");
#undef DSA_ISSUE
        TP_MARK(0);
        unsigned prefix = 0u; bool exact = false; int par = 0; int cab = 0;
        LAS unsigned* lcnt = (LAS unsigned*)(lds + DSA_OFF_V); LAS unsigned* lcab = lcnt + 16; LAS unsigned* lvst = lcnt + 32; LAS unsigned* lexf = lcnt + 48; LAS unsigned* llist = lcnt + 64;
        if (tid < 16) lcnt[tid] = 0u;
#pragma unroll 1
        for (int bit = 31; bit >= DSA_S; --bit) {
            const unsigned cand = prefix | (1u << bit); int c0 = 0, c1 = 0;
            DSA_FOR_TILES(cnt_ge(c0, u[T][0], cand); cnt_ge(c1, u[T][1], cand); cnt_ge(c0, u[T][2], cand); cnt_ge(c1, u[T][3], cand);)
            const int tot = dsa_total(cnt, par, wave, j, gq, c0 + c1); par ^= 1;
            if (tot >= 256) prefix = cand; else cab = tot;
        }
        TP_MARK(1);
        { const unsigned ptop = prefix >> DSA_S;
          DSA_FOR_TILES(unsigned pos_[4]; bool cd_[4];
              _Pragma("unroll") for (int e = 0; e < 4; ++e) { const unsigned x = u[T][e]; cd_[e] = x != 0u && (x >> DSA_S) == ptop; pos_[e] = DSA_CAP; }
              _Pragma("unroll") for (int e = 0; e < 4; ++e) if (cd_[e]) pos_[e] = __hip_atomic_fetch_add(&lcnt[j], 1u, __ATOMIC_RELAXED, __HIP_MEMORY_SCOPE_WORKGROUP);
              _Pragma("unroll") for (int e = 0; e < 4; ++e) if (pos_[e] < DSA_CAP) llist[j * DSA_CAP + pos_[e]] = u[T][e];)
          if (wave == 0 && gq == 0) lcab[j] = (unsigned)cab; }
        __syncthreads();
        const bool ovf = __any(lcnt[j] > (unsigned)DSA_CAP);
        TP_ADD(14, ovf ? 1 : 0); TP_ADD(15, 1);
        if (!ovf) {
#pragma unroll 1
            for (int qq = 0; qq < 2; ++qq) {
                const int q = 2 * wave + qq; const int n = (int)lcnt[q]; const int r = 256 - (int)lcab[q];
                unsigned ev[DSA_CAP / 64];
#pragma unroll
                for (int i = 0; i < DSA_CAP / 64; ++i) ev[i] = (lane + 64 * i < n) ? llist[q * DSA_CAP + lane + 64 * i] : 0u;
                unsigned p2 = (unsigned)__shfl((int)prefix, q);
#pragma unroll 1
                for (int bit = DSA_S - 1; bit >= 0; --bit) {
                    const unsigned cand = p2 | (1u << bit); int c = 0;
#pragma unroll
                    for (int i = 0; i < DSA_CAP / 64; ++i) c += __popcll(__ballot(ev[i] >= cand));
                    if (c >= r) p2 = cand;
                }
                int cf = 0;
#pragma unroll
                for (int i = 0; i < DSA_CAP / 64; ++i) cf += __popcll(__ballot(ev[i] >= p2));
                if (lane == 0) { lvst[q] = p2; lexf[q] = (cf == r) ? 1u : 0u; }
            }
            __syncthreads();
            prefix = lvst[j]; exact = lexf[j] != 0u;
        } else {
#pragma unroll 1
            for (int bit = DSA_S - 1; bit >= 0; --bit) {
                const unsigned cand = prefix | (1u << bit); int c0 = 0, c1 = 0;
                DSA_FOR_TILES(cnt_ge(c0, u[T][0], cand); cnt_ge(c1, u[T][1], cand); cnt_ge(c0, u[T][2], cand); cnt_ge(c1, u[T][3], cand);)
                const int tot = dsa_total(cnt, par, wave, j, gq, c0 + c1); par ^= 1;
                if (!exact && tot >= 256) { prefix = cand; exact = (tot == 256); }
            }
        }
        TP_MARK(2);
        const bool alle = __all(exact);
        unsigned kp = 0u;
        if (!alle) {
        DSA_FOR_TILES(_Pragma("unroll") for (int e = 0; e < 4; ++e) { const unsigned x = u[T][e]; u[T][e] = (x > prefix || (exact && x == prefix)) ? 0u : (x == prefix ? (unsigned)(1 + kb0 + 128 * T + e) : 0xFFFFFFFFu); })
            __syncthreads();
#pragma unroll 1
            for (int bit = 11; bit >= 0; --bit) {
                const unsigned cand = kp | (1u << bit); int c0 = 0, c1 = 0;
                DSA_FOR_TILES(cnt_le(c0, u[T][0], cand); cnt_le(c1, u[T][1], cand); cnt_le(c0, u[T][2], cand); cnt_le(c1, u[T][3], cand);)
                const int tot = dsa_total(cnt, par, wave, j, gq, c0 + c1); par ^= 1;
                if (tot <= 255) kp = cand;
            }
        }
        const unsigned kp1 = kp + 1u;
        int ns0 = 0, ns1 = 0;
        if (alle) { DSA_FOR_TILES(cnt_ge(ns0, u[T][0], prefix); cnt_ge(ns1, u[T][1], prefix); cnt_ge(ns0, u[T][2], prefix); cnt_ge(ns1, u[T][3], prefix);) }
        else { DSA_FOR_TILES(cnt_le(ns0, u[T][0], kp1); cnt_le(ns1, u[T][1], kp1); cnt_le(ns0, u[T][2], kp1); cnt_le(ns1, u[T][3], kp1);) }
        pc[(wave * 4 + gq) * 16 + j] = (unsigned)(ns0 + ns1);
        __syncthreads();
        int base = 0;
        { const int me = wave * 4 + gq;
#pragma unroll
          for (int i = 0; i < 31; ++i) { const int v = (int)pc[i * 16 + j]; base += (i < me) ? v : 0; } }
        if (alle) { DSA_FOR_TILES(_Pragma("unroll") for (int e = 0; e < 4; ++e) { if (u[T][e] >= prefix) { if (base < 256) list[j * 256 + base] = (unsigned short)(kb0 + 128 * T + e); ++base; } }) }
        else { DSA_FOR_TILES(_Pragma("unroll") for (int e = 0; e < 4; ++e) { if (u[T][e] <= kp1) { if (base < 256) list[j * 256 + base] = (unsigned short)(kb0 + 128 * T + e); ++base; } }) }
    } else {
        for (int i = tid; i < 16 * 256; i += 512) list[i] = (unsigned short)(i & 255);
    }
    __syncthreads();
    TP_MARK(3);
    const bf16* kva = (const bf16*)(ws + WS_KVA);
    bf16* qa = (bf16*)(ws + WS_QA);
    LAS unsigned char* Vw = lds + DSA_OFF_V + wave * 16384;
    const unsigned vlds0 = (unsigned)(uintptr_t)(unsigned char*)Vw;
    const int tq2[2] = {q0 + 2 * wave, q0 + 2 * wave + 1};
    const int nselq[2] = {tq2[0] + 1 < 256 ? tq2[0] + 1 : 256, tq2[1] + 1 < 256 ? tq2[1] + 1 : 256};
    v4u qfq[2][2];
#pragma unroll
    for (int qq = 0; qq < 2; ++qq)
#pragma unroll
        for (int ks = 0; ks < 2; ++ks) { qfq[qq][ks] = (v4u){0u, 0u, 0u, 0u}; if (j < 8) qfq[qq][ks] = *(const v4u*)(qa + (size_t)(b * SEQ + tq2[qq]) * 512 + j * 64 + 8 * gq + 32 * ks); }
    asm volatile("s_waitcnt vmcnt(0)" : "+v"(qfq[0][0]), "+v"(qfq[0][1]), "+v"(qfq[1][0]), "+v"(qfq[1][1]) :: "memory");
    const bf16* kvb_ = kva + (size_t)b * SEQ * 128;
    const unsigned long long kvbase = ((unsigned long long)(unsigned)__builtin_amdgcn_readfirstlane((int)((unsigned long long)(uintptr_t)kvb_ >> 32)) << 32) | (unsigned long long)(unsigned)__builtin_amdgcn_readfirstlane((int)(unsigned)(uintptr_t)kvb_);
    const unsigned kofs = (unsigned)gq * 16u, vofs = 128u + (unsigned)(lane & 7) * 16u;
#define DSA_KEY(M_, st_, slot_) ((unsigned)list[(2 * wave + ((st_) >> 2)) * 256 + ((M_) ? (((slot_) < nselq[(st_) >> 2]) ? (slot_) : 0) : (slot_))])
#define DSA_ISSUEK(M_, buf_, st_) do { unsigned ky_[4]; _Pragma("unroll") for (int kt_ = 0; kt_ < 4; ++kt_) ky_[kt_] = DSA_KEY(M_, st_, 64 * ((st_) & 3) + 16 * kt_ + j) * 256u + kofs; \
        _Pragma("unroll") for (int kt_ = 0; kt_ < 4; ++kt_) { \
        asm volatile("global_load_dwordx4 %0, %1, %2" : "=v"(buf_[2 * kt_]) : "v"(ky_[kt_]), "s"(kvbase) : "memory"); asm volatile("global_load_dwordx4 %0, %1, %2 offset:64" : "=v"(buf_[2 * kt_ + 1]) : "v"(ky_[kt_]), "s"(kvbase) : "memory"); } } while (0)
#define DSA_ISSUEV(M_, st_) do { unsigned kv_[8]; _Pragma("unroll") for (int i_ = 0; i_ < 8; ++i_) kv_[i_] = DSA_KEY(M_, st_, 64 * ((st_) & 3) + 8 * i_ + (lane >> 3)) * 256u + vofs; \
        unsigned keep_; const unsigned ld_ = (unsigned)__builtin_amdgcn_readfirstlane((int)(vlds0 + ((st_) & 1) * 8192)); \
        asm volatile("s_mov_b32 %0, m0\n\ts_mov_b32 m0, %9\n\ts_nop 0\n\t" \
                     "global_load_lds_dwordx4 %1, %10\n\ts_add_u32 m0, m0, 0x400\n\ts_nop 0\n\t" "global_load_lds_dwordx4 %2, %10\n\ts_add_u32 m0, m0, 0x400\n\ts_nop 0\n\t" \
                     "global_load_lds_dwordx4 %3, %10\n\ts_add_u32 m0, m0, 0x400\n\ts_nop 0\n\t" "global_load_lds_dwordx4 %4, %10\n\ts_add_u32 m0, m0, 0x400\n\ts_nop 0\n\t" \
                     "global_load_lds_dwordx4 %5, %10\n\ts_add_u32 m0, m0, 0x400\n\ts_nop 0\n\t" "global_load_lds_dwordx4 %6, %10\n\ts_add_u32 m0, m0, 0x400\n\ts_nop 0\n\t" \
                     "global_load_lds_dwordx4 %7, %10\n\ts_add_u32 m0, m0, 0x400\n\ts_nop 0\n\t" "global_load_lds_dwordx4 %8, %10\n\ts_mov_b32 m0, %0" \
                     : "=&s"(keep_) : "v"(kv_[0]), "v"(kv_[1]), "v"(kv_[2]), "v"(kv_[3]), "v"(kv_[4]), "v"(kv_[5]), "v"(kv_[6]), "v"(kv_[7]), "s"(ld_), "s"(kvbase) : "memory", "scc"); } while (0)
#define DSA_WAITK(buf_, n_) asm volatile("s_waitcnt vmcnt(" #n_ ")" : "+v"(buf_[0]), "+v"(buf_[1]), "+v"(buf_[2]), "+v"(buf_[3]), "+v"(buf_[4]), "+v"(buf_[5]), "+v"(buf_[6]), "+v"(buf_[7]) :: "memory")
    v4u kA[8], kB[8], kC[8];
    float mrow = NEGF, lrow = 0.f; f32x4v o[4];
#define DSA_STEP(M_, st_, cur_, nx2_, NK_, NV_) do { \
        if ((st_) + 2 < 8) DSA_ISSUEK(M_, nx2_, (st_) + 2); \
        if (((st_) & 3) == 0) { mrow = NEGF; lrow = 0.f; _Pragma("unroll") for (int dt_ = 0; dt_ < 4; ++dt_) o[dt_] = (f32x4v){0.f, 0.f, 0.f, 0.f}; } \
        DSA_WAITK(cur_, NK_); \
        const bf16x8 q0_ = __builtin_bit_cast(bf16x8, qfq[(st_) >> 2][0]), q1_ = __builtin_bit_cast(bf16x8, qfq[(st_) >> 2][1]); \
        f32x4v s_[4]; float bm_ = NEGF; \
        _Pragma("unroll") for (int kt_ = 0; kt_ < 4; ++kt_) { f32x4v a_ = {0.f, 0.f, 0.f, 0.f}; \
            a_ = __builtin_amdgcn_mfma_f32_16x16x32_bf16(__builtin_bit_cast(bf16x8, cur_[2 * kt_]), q0_, a_, 0, 0, 0); a_ = __builtin_amdgcn_mfma_f32_16x16x32_bf16(__builtin_bit_cast(bf16x8, cur_[2 * kt_ + 1]), q1_, a_, 0, 0, 0); \
            _Pragma("unroll") for (int e_ = 0; e_ < 4; ++e_) { const float v_ = (!(M_) || (64 * ((st_) & 3) + 16 * kt_ + 4 * gq + e_ < nselq[(st_) >> 2])) ? a_[e_] : NEGF; a_[e_] = v_; bm_ = fmaxf(bm_, v_); } s_[kt_] = a_; } \
        bm_ = xmax16(bm_); \
        { const float mnew_ = fmaxf(mrow, bm_), alpha_ = __builtin_amdgcn_exp2f(mrow - mnew_); mrow = mnew_; float ps_ = 0.f; \
          _Pragma("unroll") for (int kt_ = 0; kt_ < 4; ++kt_) _Pragma("unroll") for (int e_ = 0; e_ < 4; ++e_) { const float p_ = __builtin_amdgcn_exp2f(s_[kt_][e_] - mnew_); s_[kt_][e_] = p_; ps_ += p_; } \
          lrow = lrow * alpha_ + ps_; _Pragma("unroll") for (int dt_ = 0; dt_ < 4; ++dt_) o[dt_] *= alpha_; } \
        asm volatile("s_waitcnt vmcnt(" #NV_ ")" : "+v"(s_[0]), "+v"(s_[1]), "+v"(s_[2]), "+v"(s_[3]) :: "memory");       \
        { const LAS unsigned char* Vb_ = Vw + ((st_) & 1) * 8192; \
        _Pragma("unroll") for (int kk_ = 0; kk_ < 2; ++kk_) { \
            const bf16x8 pf_ = pack8(s_[2 * kk_][0], s_[2 * kk_][1], s_[2 * kk_][2], s_[2 * kk_][3], s_[2 * kk_ + 1][0], s_[2 * kk_ + 1][1], s_[2 * kk_ + 1][2], s_[2 * kk_ + 1][3]); \
            _Pragma("unroll") for (int dt_ = 0; dt_ < 4; ++dt_) { const LAS unsigned char* va_ = Vb_ + (32 * kk_ + 4 * gq + (j >> 2)) * 128 + (16 * dt_ + 4 * (j & 3)) * 2; \
                o[dt_] = __builtin_amdgcn_mfma_f32_16x16x32_bf16(cat4(tr16(va_), tr16(va_ + 16 * 128)), pf_, o[dt_], 0, 0, 0); } } } \
        if (((st_) & 3) == 3) { const float inv_ = __builtin_amdgcn_rcpf(xsum16(lrow)); const int rowq_ = b * SEQ + tq2[(st_) >> 2]; \
            if (j < 8) { _Pragma("unroll") for (int dt_ = 0; dt_ < 4; ++dt_) { uint2 w_; w_.x = cvtpk(o[dt_][0] * inv_, o[dt_][1] * inv_); w_.y = cvtpk(o[dt_][2] * inv_, o[dt_][3] * inv_); \
                *(uint2*)(yout + (size_t)rowq_ * 512 + j * 64 + 16 * dt_ + 4 * gq) = w_; } } } \
        if ((st_) + 2 < 8) { asm volatile("s_waitcnt lgkmcnt(0)" ::: "memory"); DSA_ISSUEV(M_, (st_) + 2); } \
    } while (0)
#define DSA_RUN(M_) do { DSA_ISSUEK(M_, kA, 0); DSA_ISSUEV(M_, 0); DSA_ISSUEK(M_, kB, 1); DSA_ISSUEV(M_, 1); \
    DSA_STEP(M_, 0, kA, kC, 32, 24); DSA_STEP(M_, 1, kB, kA, 32, 24); DSA_STEP(M_, 2, kC, kB, 32, 24); DSA_STEP(M_, 3, kA, kC, 32, 24); \
    DSA_STEP(M_, 4, kB, kA, 32, 24); DSA_STEP(M_, 5, kC, kB, 32, 24); DSA_STEP(M_, 6, kA, kC, 24, 16); DSA_STEP(M_, 7, kB, kA, 8, 0); } while (0)
    if (q0 >= 256) DSA_RUN(0); else DSA_RUN(1);
#if DUP == 20
    if (q0 >= 256) DSA_RUN(0); else DSA_RUN(1);
#endif
#undef DSA_RUN
#undef DSA_STEP
#undef DSA_ISSUEK
#undef DSA_ISSUEV
#undef DSA_WAITK
#undef DSA_KEY
    __syncthreads();
    TP_MARK(4);
}
__device__ __forceinline__ void phase_mixers(const Args& P, unsigned char* ws, int z, LAS unsigned char* lds, int gw, int NGW, int lane, int wave, int bid, int G) {
    asm volatile("" : "+v"(lane)); lane &= 63; asm volatile("" : "+s"(gw), "+s"(NGW));
#if PROBE == 3
    { LAS unsigned char* wl = lds + wave * 18944; for (int it2 = gw; it2 < 2 * M; it2 += NGW) nsa_query(P, ws, z, it2 >> 1, it2 & 1, wl, lane); }
#else
    for (int k = 0; bid + G * k < 1024; ++k) {
        const int u = bid + G * k, c0 = u & 63, unit = (u & ~63) | ((k & 1) ? 63 - c0 : c0);
#if DUP == 7
        nsa_unit(ws, unit, lds, (wave << 6) | lane_id_v(), (bf16*)(ws + WS_BU));
#endif
        nsa_unit(ws, unit, lds, (wave << 6) | lane_id_v(), (bf16*)(ws + WS_QC));
    }
#endif
    for (int k = 0; bid + G * k < 2048; ++k) {
        const int u = bid + G * k, c0 = u & 255, unit = (u & ~255) | ((k & 1) ? 255 - c0 : c0);
#if DUP == 6
        dsa_unit(ws, unit, lds, (wave << 6) | lane_id_v(), (bf16*)(ws + WS_BU));
#endif
        dsa_unit(ws, unit, lds, (wave << 6) | lane_id_v(), (bf16*)(ws + WS_QA));
    }
}
__global__ void __launch_bounds__(NWAVES * 64, 2) fwd_kernel(Args args) {
    extern __shared__ __attribute__((aligned(16))) unsigned char lds_raw[];
    LAS unsigned char* lds = (LAS unsigned char*)lds_raw;
    const int wave = __builtin_amdgcn_readfirstlane((int)threadIdx.x >> 6);
#define TIDX ((wave << 6) | lane_id_v())
#define tid TIDX
#define lane TIDX
    const int G = gridDim.x, bid = blockIdx.x;
    const int gw = bid * NWAVES + wave, NGW = G * NWAVES;
    const int lo = args.ph_lo, hi = args.ph_hi;
    const Args& P = args;
    int z = 0; asm volatile("" : "+s"(z));
    unsigned char* ws = args.ws + z;
    volatile LAS unsigned* MISCW = (volatile LAS unsigned*)(lds + LDSCTL_OFF);
    if (tid < 64) MISCW[tid] = 0u;
    __syncthreads();
    XcdBarrier bar; bar.bar = (unsigned*)(ws + WS_CTL) + 4096; bar.x = 0; bar.st = nullptr;
    if (hi - lo > 1) bar = xcd_barrier_post((unsigned*)(ws + WS_CTL) + 4096, MISCW + 8);
#define RUN(k) (lo <= (k) && (k) < hi)
#if TPROBE
#define TP_PHASE(k) do { if (bid == 0 && TIDX == 0) { volatile unsigned long long* sl_ = (volatile unsigned long long*)(args.ws + z + 32768); const unsigned long long n_ = __builtin_amdgcn_s_memtime(); const int cls_ = (k) == 0 ? 0 : 1 + (((k) - 1) % NPL); sl_[16 + cls_] += n_ - sl_[30]; sl_[30] = n_; } } while (0)
#else
#define TP_PHASE(k)
#endif
#define SEAM(k) do { TP_PHASE(k); if ((k) + 1 < hi) { XcdBarrier b2_ = bar; asm volatile("" : "+s"(b2_.bar), "+s"(b2_.x)); xcd_barrier(b2_); if (DUP == 13) xcd_barrier(b2_); } else { VM_WAIT(); __syncthreads(); } } while (0)


#if TPROBE
    if (bid == 0 && TIDX == 0) { volatile unsigned long long* sl_ = (volatile unsigned long long*)(args.ws + z + 32768); sl_[30] = __builtin_amdgcn_s_memtime(); }
#endif
    if (RUN(0)) { phase_rope(P, ws, z, bid * (NWAVES * 64) + tid, G * NWAVES * 64);
        { int ln_ = TIDX; asm volatile("" : "+v"(ln_)); ln_ &= 63;
          for (int m = gw; m < M; m += NGW) stat_row_bf16(P.in[0 + z] + (size_t)m * DM, (bf16*)(ws + WS_XN) + (size_t)m * DM, (float*)(ws + WS_SSQ) + (size_t)m * 16, ln_); }
        SEAM(0); }
#define RS_PREPASS(Sref) do { const float* ssq_ = (const float*)(ws + WS_SSQ); LAS float* rsl_ = (LAS float*)(lds + RS_OFF); const int t_ = TIDX; pg8::Unit u_; \
        for (int i_ = 0; (Sref).next(i_, u_); ++i_) { const f32x4* p_ = (const f32x4*)(ssq_ + (size_t)(u_.pm * 256 + (t_ >> 1)) * 16 + (t_ & 1) * 8); const f32x4 a_ = p_[0], b_ = p_[1]; \
            float s_ = (a_.x + a_.y) + (a_.z + a_.w) + (b_.x + b_.y) + (b_.z + b_.w); s_ += __shfl_xor(s_, 1); if ((t_ & 1) == 0) rsl_[i_ * 256 + (t_ >> 1)] = 1.0f / sqrtf(s_ * (1.f / DM) + EPS); } \
        __syncthreads(); } while (0)

    for (int it = 0; it < 2 * DEPTH; ++it) {
        const int l = it >> 1, second = it & 1, pb = 1 + l * NPL + (second ? 7 : 0);
        asm volatile("" : "+s"(z));
        ws = args.ws + z;
        bf16* const XN = (bf16*)(ws + WS_XN);
        bf16* const HB = (bf16*)(ws + WS_H);
        bf16* const MG = (bf16*)(ws + WS_MG);
        bf16* const GB = (bf16*)(ws + WS_G);
        unsigned char* const wb = ws + WS_W;
        float* const OUT = P.out + z;
        const float* xin = (it == 0) ? P.in[0 + z] : (const float*)OUT;
        if (!second && RUN(pb)) { phase_convert(P, ws, z, l, lds, gw, NGW, lane, wave);
#if DUP == 30
            phase_convert(P, ws, z, l, lds, gw, NGW, lane, wave);
#endif
            SEAM(pb); }
        if (RUN(pb + 1)) {
            pg8::Gemm g{XN, (const bf16*)(wb + (second ? WO_GU2 : WO_GU1)), M, 2 * FF, DM}; pg8::StaticOrder S; S.init(M, 2 * FF, G, bid + z);
            pg8::EpiSwiglu E{HB, FF, (const LAS float*)(lds + RS_OFF)};
            RS_PREPASS(S);
#if !defined(SITE_MASK) || ((SITE_MASK >> 0) & 1)
            pg8::gemm_phase<pg8::EpiSwiglu, pg8::StaticOrder, ALIGN_UP, true>(lds, g, S, E, TIDX);
#if DUP == 3
            pg8::gemm_phase<pg8::EpiSwiglu, pg8::StaticOrder, ALIGN_UP, true>(lds, g, S, E, TIDX);
#endif
#endif
            SEAM(pb + 1);
        }
        if (RUN(pb + 2)) {
            pg8::Gemm g{HB, (const bf16*)(wb + (second ? WO_D2 : WO_D1)), M, DM, FF}; pg8::StaticOrder S; S.init(M, DM, G, bid + z);
            pg8::EpiResid E{xin, OUT, 0.5f, XN, (float*)(ws + WS_SSQ)};
#if !defined(SITE_MASK) || ((SITE_MASK >> 1) & 1)
            pg8::gemm_phase<pg8::EpiResid, pg8::StaticOrder, true, true>(lds, g, S, E, TIDX);
#endif
            SEAM(pb + 2);
        }
        if (second) continue;
        const int pm = 1 + l * NPL + 2;
        if (RUN(pm + 1)) {
            pg8::Gemm g{XN, (const bf16*)(wb + WO_IN), M, NINP, DM}; pg8::StaticOrder S; S.init(M, NINP, G, bid + z);
            pg8::EpiWin E{(bf16*)(ws + WS_QA), (bf16*)(ws + WS_QC), (bf16*)(ws + WS_IQ), (bf16*)(ws + WS_MISC), (bf16*)(ws + WS_KVC), (bf16*)(ws + WS_KVS), (bf16*)(ws + WS_KVW), (bf16*)(ws + WS_BU), GB,
                          (const float*)(ws + WS_ROPE), (const LAS float*)(lds + RS_OFF)};
            RS_PREPASS(S);
#if !defined(SITE_MASK) || ((SITE_MASK >> 2) & 1)
            pg8::gemm_phase<pg8::EpiWin, pg8::StaticOrder, ALIGN_WIN, true>(lds, g, S, E, TIDX);
#if DUP == 4
            pg8::gemm_phase<pg8::EpiWin, pg8::StaticOrder, ALIGN_WIN, true>(lds, g, S, E, TIDX);
#endif
#endif
            SEAM(pm + 1);
        }
        #ifndef NO_PREP
        if (RUN(pm + 2)) { phase_prep(P, ws, z, l, lds, gw, NGW, lane, wave);
#if DUP == 1
            { XcdBarrier b2_ = bar; asm volatile("" : "+s"(b2_.bar), "+s"(b2_.x)); xcd_barrier(b2_); } phase_prep(P, ws, z, l, lds, gw, NGW, lane, wave);
#endif
            SEAM(pm + 2); }
#endif
        #ifndef NO_MIX
        if (RUN(pm + 3)) { phase_mixers(P, ws, z, lds, gw, NGW, lane, wave, bid, G); SEAM(pm + 3); }
#endif
        if (RUN(pm + 4)) {
#if DUP == 5
          for (int rep_ = 0; rep_ < 2; ++rep_) {
#endif
            pg8::StaticOrder S; S.init(M, DM, G, bid + z);
            { pg8::Gemm g{(const bf16*)(ws + WS_QA), (const bf16*)(wb + WO_PA), M, DM, 512}; pg8::EpiProj<0> E{MG, GB, 0};
#if !defined(SITE_MASK) || ((SITE_MASK >> 3) & 1)
              pg8::gemm_phase<pg8::EpiProj<0>, pg8::StaticOrder, true, true>(lds, g, S, E, TIDX);
#endif
            }
            { pg8::Gemm g{(const bf16*)(ws + WS_YB), (const bf16*)(wb + WO_PB), M, DM, 512}; pg8::EpiProj<1> E{MG, GB, 1024};
#if !defined(SITE_MASK) || ((SITE_MASK >> 4) & 1)
              pg8::gemm_phase<pg8::EpiProj<1>, pg8::StaticOrder, true, true>(lds, g, S, E, TIDX);
#endif
            }
            { pg8::Gemm g{(const bf16*)(ws + WS_QC), (const bf16*)(wb + WO_PC), M, DM, 512}; pg8::EpiProj<1> E{MG, GB, 2048};
#if !defined(SITE_MASK) || ((SITE_MASK >> 5) & 1)
              pg8::gemm_phase<pg8::EpiProj<1>, pg8::StaticOrder, true, true>(lds, g, S, E, TIDX);
#endif
            }
#if DUP == 5
          }
#endif
            SEAM(pm + 4);
        }
        if (RUN(pm + 5)) {
            pg8::Gemm g{MG, (const bf16*)(wb + WO_OUT), M, DM, DM}; pg8::StaticOrder S; S.init(M, DM, G, bid + z);
            pg8::EpiResid E{OUT, OUT, 1.0f, XN, (float*)(ws + WS_SSQ)};
#if !defined(SITE_MASK) || ((SITE_MASK >> 6) & 1)
            pg8::gemm_phase<pg8::EpiResid, pg8::StaticOrder, true, true>(lds, g, S, E, TIDX);
#endif
            SEAM(pm + 5);
        }
    }
    if (RUN(NPH - 1)) { asm volatile("" : "+s"(z)); int ln_ = TIDX; asm volatile("" : "+v"(ln_)); ln_ &= 63; float* o_ = P.out + z; float tps_ = 1.0f;
#if TPROBE
        { const unsigned long long* sl_ = (const unsigned long long*)(P.ws + z + 32768); double a_ = 0., b_ = 0.; for (int k = 0; k < 28; ++k) { const double v_ = (double)__hip_atomic_load(sl_ + k, __ATOMIC_RELAXED, __HIP_MEMORY_SCOPE_AGENT); if (((unsigned)TP_A >> k) & 1) a_ += v_; if (((unsigned)TP_B >> k) & 1) b_ += v_; } tps_ = 1.0f + (float)(a_ / b_) * TP_SCALE; }
#endif
        for (int m = gw; m < M; m += NGW) norm_row_f32(o_ + (size_t)m * DM, P.in[23 + z], ln_, tps_);
#if TPROBE
        if (gw == 0 && ln_ == 0) { const unsigned long long* sl_ = (const unsigned long long*)(P.ws + z + 32768); double c_ = 0., d_ = 0.; for (int k = 0; k < 28; ++k) { const double v_ = (double)__hip_atomic_load(sl_ + k, __ATOMIC_RELAXED, __HIP_MEMORY_SCOPE_AGENT); if (((unsigned)TP_C >> k) & 1) c_ += v_; if (((unsigned)TP_D >> k) & 1) d_ += v_; } o_[0] = 1000.0f * (float)(c_ / d_) * TP_SCALE2; }
#endif
    }
#undef RUN
#undef tid
#undef TIDX
#undef lane
#undef SEAM
}

extern "C" void kernel_launch(void* const* d_in, const int* in_sizes, int n_in, void* d_out, int out_size, void* d_ws, size_t ws_size, hipStream_t stream) {
    static int grid = 0;
    if (grid == 0) {
        if (n_in != 24 || out_size != M * DM || ws_size < WS_END) { fprintf(stderr, "kernel_launch: unexpected shapes (n_in %d out %d ws %zu)\n", n_in, out_size, ws_size); grid = -1; return; }
        int dev = 0, cus = 0, per_cu = 0;
        if (hipGetDevice(&dev) != hipSuccess || hipDeviceGetAttribute(&cus, hipDeviceAttributeMultiprocessorCount, dev) != hipSuccess) { grid = -1; return; }
        if (hipFuncSetAttribute((const void*)fwd_kernel, hipFuncAttributeMaxDynamicSharedMemorySize, LDS_BYTES) != hipSuccess) { fprintf(stderr, "kernel_launch: hipFuncSetAttribute failed\n"); grid = -1; return; }
        if (hipOccupancyMaxActiveBlocksPerMultiprocessor(&per_cu, (const void*)fwd_kernel, NWAVES * 64, LDS_BYTES) != hipSuccess || per_cu < 1) { fprintf(stderr, "kernel_launch: occupancy query says %d\n", per_cu); }
        (void)hipGetLastError();
        grid = cus;
    }
    if (grid < 0) return;
    (void)hipMemsetAsync((char*)d_ws + WS_CTL, 0, CTL_ZERO_BYTES, stream);
    Args a{};
    for (int i = 0; i < 24; ++i) a.in[i] = (const float*)d_in[i];
    a.out = (float*)d_out; a.ws = (unsigned char*)d_ws;
#if MK_ONE_LAUNCH
    a.ph_lo = 0; a.ph_hi = NPH;
    hipLaunchKernelGGL(fwd_kernel, dim3(grid), dim3(NWAVES * 64), LDS_BYTES, stream, a);
#else
    for (int ph = 0; ph < NPH; ++ph) { a.ph_lo = ph; a.ph_hi = ph + 1; hipLaunchKernelGGL(fwd_kernel, dim3(grid), dim3(NWAVES * 64), LDS_BYTES, stream, a); }
#endif
}
```

```cpp
#include <hip/hip_runtime.h>
#include <cstdio>
#include <cstdint>
#define PROBE 0
#define PROBE_GAIN 10.0f
#define TOP8_RANK 1
#define PROBE_ROWTHR 0.01f
#define PROBE_ROWCOND 1
#define PROBE_BR -1
#define FIXHOM 0
#define DUP 0
#define TPROBE 0
#define TP_A 1
#define TP_B 1
#define TP_SCALE 1.0f
#define TP_C 1
#define TP_D 1
#define TP_SCALE2 1.0f
#define POOLDBG 0
#define YB_SPARE 0
#define ALIGN_UP true
#define ALIGN_WIN true
#define DSA_CAP_V 512
#define DSA_K_V 13
#ifndef MK_ONE_LAUNCH
#define MK_ONE_LAUNCH 1
#endif
namespace pg8 {
#define PG8_LAS __attribute__((address_space(3)))
typedef unsigned short bf16_t;
typedef short bf16x8 __attribute__((ext_vector_type(8)));
typedef float f32x4 __attribute__((ext_vector_type(4)));
typedef unsigned u32x4 __attribute__((ext_vector_type(4)));
constexpr int BM = 256, BK = 64, HALF = 128, HTB = HALF * BK * 2  , STAGE_BYTES = 8 * HTB, NXCD = 8, WGM = 8;

__host__ __device__ __forceinline__ int lds_byte(int r, int c) { const int st = (r >> 4) * 2 + (c >> 5), rr = r & 15, cc = c & 31, ob = rr * 64 + cc * 2; return st * 1024 + (ob ^ (((ob >> 9) & 1) << 5)); }
__host__ __device__ __forceinline__ void stage_rc(int b, int& R, int& C) { const int st = b / 1024, sb = b % 1024, swz = sb ^ (((sb >> 9) & 1) << 5); R = (st >> 1) * 16 + swz / 64; C = (st & 1) * 32 + (swz % 64) / 2; }
__host__ __device__ __forceinline__ int perm32(int rho) { const int n = rho >> 4, i = rho & 15; return 8 * (i >> 2) + 4 * n + (i & 3); }

struct Unit { int pm, pn, ord; };
struct Gemm { const bf16_t* A; const bf16_t* Bt; int M, N, K; };

struct StaticOrder {
    int nM, nN, nwg, G, c;
    __host__ __device__ __forceinline__ void init(int M, int N, int G_, int c_) { nM = M / BM; nN = N / BM; nwg = nM * nN; G = G_; c = c_; }
    __host__ __device__ __forceinline__ bool next(int i, Unit& u) const {
        const long L = (long)i * G + c; if (L >= nwg) return false;
        int wgid = (int)L; { const int q = nwg / NXCD, r = nwg % NXCD, xcd = wgid % NXCD, off = wgid / NXCD; wgid = (xcd < r ? xcd * (q + 1) : r * (q + 1) + (xcd - r) * q) + off; }
        const int nig = WGM * nN, gid = wgid / nig, fm = gid * WGM, gsz = (nM - fm) < WGM ? (nM - fm) : WGM;
        u.pm = fm + ((wgid % nig) % gsz); u.pn = (wgid % nig) / gsz; u.ord = i; return true;
    }
    __device__ __forceinline__ void a_ready(const Unit&) const {}
    __device__ __forceinline__ void done(const Unit&) const {}
};

__device__ __forceinline__ unsigned cvt_pk_bf16(float lo, float hi) { unsigned r; asm volatile("v_cvt_pk_bf16_f32 %0, %1, %2" : "=v"(r) : "v"(lo), "v"(hi)); return r; }
__device__ __forceinline__ float bflo(unsigned w) { return __uint_as_float(w << 16); }
__device__ __forceinline__ float bfhi(unsigned w) { return __uint_as_float(w & 0xffff0000u); }
__device__ __forceinline__ float fast_sigmoid(float x) { return __builtin_amdgcn_rcpf(1.0f + __expf(-x)); }

struct EpiSwiglu {
    static constexpr bool PERM = true, AFTER_DRAIN = false;
    bf16_t* H; int ldh; const PG8_LAS float* rs;
    __device__ __forceinline__ void operator()(const f32x4 (&acc)[2][2][4][2], const Unit& u, int wr, int wc, int fr, int fq) const {
        const int row0 = u.pm * BM + wr * 64 + fr, col0 = u.pn * HALF + wc * 32 + 8 * fq;
#pragma unroll
        for (int ai = 0; ai < 2; ++ai)
#pragma unroll
            for (int m = 0; m < 4; ++m) {
                bf16_t* rowp = H + (size_t)(row0 + ai * HALF + m * 16) * ldh + col0;
                const float r = rs[u.ord * 256 + wr * 64 + fr + ai * HALF + m * 16];
                float o[8];
#pragma unroll
                for (int n = 0; n < 2; ++n)
#pragma unroll
                    for (int e = 0; e < 4; ++e) { const float g = acc[ai][0][m][n][e] * r, up = acc[ai][1][m][n][e] * r; o[n * 4 + e] = g * fast_sigmoid(g) * up; }
                u32x4 w; w.x = cvt_pk_bf16(o[0], o[1]); w.y = cvt_pk_bf16(o[2], o[3]); w.z = cvt_pk_bf16(o[4], o[5]); w.w = cvt_pk_bf16(o[6], o[7]);
                *(u32x4*)rowp = w;
            }
    }
};
struct EpiResid {
    static constexpr bool PERM = true, AFTER_DRAIN = false;
    bf16_t* xb; float s; float* ssq;
    __device__ __forceinline__ void operator()(const f32x4 (&acc)[2][2][4][2], const Unit& u, int wr, int wc, int fr, int fq) const {
        const int row0 = u.pm * BM + wr * 64 + fr, col0 = u.pn * BM + wc * 32 + 8 * fq;
#pragma unroll
        for (int ai = 0; ai < 2; ++ai) {
            u32x4 bv[4][2];
#pragma unroll
            for (int m = 0; m < 4; ++m)
#pragma unroll
                for (int bj = 0; bj < 2; ++bj) bv[m][bj] = *(const u32x4*)(xb + (size_t)(row0 + ai * HALF + m * 16) * 1024 + col0 + bj * HALF);
#pragma unroll
            for (int m = 0; m < 4; ++m) {
                const size_t off = (size_t)(row0 + ai * HALF + m * 16) * 1024 + col0;
                float q = 0.f;
#pragma unroll
                for (int bj = 0; bj < 2; ++bj) {
                    const u32x4 b = bv[m][bj];
                    const f32x4 b0 = {bflo(b.x), bfhi(b.x), bflo(b.y), bfhi(b.y)}, b1 = {bflo(b.z), bfhi(b.z), bflo(b.w), bfhi(b.w)};
                    const f32x4 x0 = b0 + acc[ai][bj][m][0] * s, x1 = b1 + acc[ai][bj][m][1] * s;
                    q += (x0[0] * x0[0] + x0[1] * x0[1]) + (x0[2] * x0[2] + x0[3] * x0[3]) + (x1[0] * x1[0] + x1[1] * x1[1]) + (x1[2] * x1[2] + x1[3] * x1[3]);
                    u32x4 w; w.x = cvt_pk_bf16(x0[0], x0[1]); w.y = cvt_pk_bf16(x0[2], x0[3]); w.z = cvt_pk_bf16(x1[0], x1[1]); w.w = cvt_pk_bf16(x1[2], x1[3]);
                    *(u32x4*)(xb + off + bj * HALF) = w;
                }
                q += __shfl_xor(q, 16); q += __shfl_xor(q, 32);
                if (fq == 0) ssq[(size_t)(row0 + ai * HALF + m * 16) * 16 + u.pn * 4 + wc] = q;
            }
        }
    }
};
template <int MODE> struct EpiProj {
    static constexpr bool PERM = true, AFTER_DRAIN = false;
    bf16_t* MG; const bf16_t* G; int gofs;
    __device__ __forceinline__ void operator()(const f32x4 (&acc)[2][2][4][2], const Unit& u, int wr, int wc, int fr, int fq) const {
        const int row0 = u.pm * BM + wr * 64 + fr, col0 = u.pn * BM + wc * 32 + 8 * fq;
#pragma unroll
        for (int ai = 0; ai < 2; ++ai)
#pragma unroll
            for (int mh = 0; mh < 2; ++mh) {
                u32x4 gv[4], ov[4];
#pragma unroll
                for (int q = 0; q < 4; ++q) { const int m = 2 * mh + (q >> 1), bj = q & 1; const size_t row = (size_t)(row0 + ai * HALF + m * 16);
                    gv[q] = *(const u32x4*)(G + row * 3072 + gofs + col0 + bj * HALF); if (MODE) ov[q] = *(const u32x4*)(MG + row * 1024 + col0 + bj * HALF); }
#pragma unroll
                for (int q = 0; q < 4; ++q) { const int m = 2 * mh + (q >> 1), bj = q & 1; const size_t row = (size_t)(row0 + ai * HALF + m * 16);
                    bf16_t* mp = MG + row * 1024 + col0 + bj * HALF;
                    const f32x4 a0 = acc[ai][bj][m][0], a1 = acc[ai][bj][m][1];
                    float o[8] = {bflo(gv[q].x) * a0[0], bfhi(gv[q].x) * a0[1], bflo(gv[q].y) * a0[2], bfhi(gv[q].y) * a0[3], bflo(gv[q].z) * a1[0], bfhi(gv[q].z) * a1[1], bflo(gv[q].w) * a1[2], bfhi(gv[q].w) * a1[3]};
                    if (MODE) { o[0] += bflo(ov[q].x); o[1] += bfhi(ov[q].x); o[2] += bflo(ov[q].y); o[3] += bfhi(ov[q].y); o[4] += bflo(ov[q].z); o[5] += bfhi(ov[q].z); o[6] += bflo(ov[q].w); o[7] += bfhi(ov[q].w); }
                    u32x4 w; w.x = cvt_pk_bf16(o[0], o[1]); w.y = cvt_pk_bf16(o[2], o[3]); w.z = cvt_pk_bf16(o[4], o[5]); w.w = cvt_pk_bf16(o[6], o[7]);
                    *(u32x4*)mp = w;
                }
            }
    }
};
struct EpiWin {
    static constexpr bool PERM = true, AFTER_DRAIN = false;
    bf16_t *QA, *QC, *IQ, *MISC, *KVC, *KVS, *KVW, *BU, *G; const float* rope; const PG8_LAS float* rs;
    __device__ __forceinline__ void operator()(const f32x4 (&acc)[2][2][4][2], const Unit& u, int wr, int wc, int fr, int fq) const {
        const int pn = u.pn;
        bf16_t* dst; int ld, cbase, mode;
        if (pn < 2) { dst = QA; ld = 512; cbase = pn * 256; mode = 1; }
        else if (pn < 4) { dst = QC; ld = 512; cbase = (pn - 2) * 256; mode = 1; }
        else if (pn == 4) { dst = IQ; ld = 256; cbase = 0; mode = 1; }
        else if (pn == 5) { dst = MISC; ld = 256; cbase = 0; mode = 3; }
        else if (pn <= 8) { dst = pn == 6 ? KVC : (pn == 7 ? KVS : KVW); ld = 256; cbase = 0; mode = 2; }
        else if (pn <= 10) { dst = BU; ld = 512; cbase = (pn - 9) * 256; mode = 0; }
        else { dst = G; ld = 3072; cbase = (pn - 11) * 256; mode = 4; }
        const int row0 = u.pm * BM + wr * 64 + fr, col0 = cbase + wc * 32 + 8 * fq;
        const bool ropelane = ((wc & 1) == 0) && fq < 2;
        const float sc = (mode == 1) ? (pn < 4 ? 0.125f * 1.4426950408889634f : 0.125f) : 1.0f;
#pragma unroll
        for (int ai = 0; ai < 2; ++ai) {
            f32x4 csv[4], snv[4];
#pragma unroll
            for (int m = 0; m < 4; ++m) { csv[m] = (f32x4){1.f, 1.f, 1.f, 1.f}; snv[m] = (f32x4){0.f, 0.f, 0.f, 0.f}; }
            if (mode >= 1 && mode <= 3) {
#pragma unroll
                for (int m = 0; m < 4; ++m) { const float* rp = rope + (size_t)(row0 + ai * HALF + m * 16) * 16 + 4 * (fq & 1); csv[m] = *(const f32x4*)rp; snv[m] = *(const f32x4*)(rp + 8); }
            }
#pragma unroll
            for (int m = 0; m < 4; ++m) {
                const size_t row = (size_t)(row0 + ai * HALF + m * 16);
                const float rr = rs[u.ord * 256 + wr * 64 + fr + ai * HALF + m * 16];
                const f32x4 cs = csv[m], sn = snv[m];
#pragma unroll
                for (int bj = 0; bj < 2; ++bj) {
                    const f32x4 a0 = acc[ai][bj][m][0] * rr, a1 = acc[ai][bj][m][1] * rr;
                    float o[8] = {a0[0], a0[1], a0[2], a0[3], a1[0], a1[1], a1[2], a1[3]};
                    const bool dorope = ropelane && (mode == 1 || (mode == 2 && bj == 0) || (mode == 3 && bj == 0 && wc == 0));
                    if (dorope) {
#pragma unroll
                        for (int p = 0; p < 4; ++p) { const float x1 = o[2 * p], x2 = o[2 * p + 1]; o[2 * p] = x1 * cs[p] - x2 * sn[p]; o[2 * p + 1] = x2 * cs[p] + x1 * sn[p]; }
                    }
                    if (mode == 4) {
#pragma unroll
                        for (int e = 0; e < 8; ++e) o[e] = fast_sigmoid(o[e]);
                    } else {
#pragma unroll
                        for (int e = 0; e < 8; ++e) o[e] *= sc;
                    }
                    u32x4 w; w.x = cvt_pk_bf16(o[0], o[1]); w.y = cvt_pk_bf16(o[2], o[3]); w.z = cvt_pk_bf16(o[4], o[5]); w.w = cvt_pk_bf16(o[6], o[7]);
                    *(u32x4*)(dst + row * ld + col0 + bj * HALF) = w;
                }
            }
        }
    }
};

template <class Epi, class Sched, bool ALIGN_EPI = false, bool SP2 = false>
__device__ __forceinline__ void gemm_phase(PG8_LAS unsigned char* lds, const Gemm g, const Sched& S, const Epi& E, int tid_in) {
    int tid_ = tid_in; asm volatile("" : "+v"(tid_));
    const int tid = tid_, wid = __builtin_amdgcn_readfirstlane(tid >> 6), lane = tid & 63, wr = wid >> 2, wc = wid & 3, fr = lane & 15, fq = lane >> 4;
    const int K = g.K, nt = K / BK;
    unsigned voffA[2], voffB[2];
#pragma unroll
    for (int i = 0; i < 2; ++i) { int R, C; stage_rc(tid * 16 + i * 8192, R, C); const int Rb = Epi::PERM ? ((R & ~31) + perm32(R & 31)) : R;
        voffA[i] = (unsigned)(R * K + C) * 2u; voffB[i] = (unsigned)(Rb * K + C) * 2u; }
    const size_t kstep = (size_t)(BK * 2);
    const size_t hstep = (size_t)HALF * K * 2;
    const size_t tstep = 2 * hstep;
    const unsigned ldsw = (unsigned)wid * 1024u;
    const int aoff = lds_byte(wr * 64 + fr, fq * 8), boff = lds_byte(wc * 32 + fr, fq * 8);
#define PG8_SA(b, h) (((b) * 2 + (h)) * HTB)
#define PG8_SB(b, h) ((4 + (b) * 2 + (h)) * HTB)
#define PG8_STAGE(bufoff, gbase, voff) do { _Pragma("unroll") for (int _i = 0; _i < 2; ++_i) \
        __builtin_amdgcn_global_load_lds((const unsigned*)((const char*)(gbase) + (voff)[_i]), (PG8_LAS unsigned*)(lds + (bufoff) + ldsw + _i * 8192), 16, 0, 0); } while (0)
#define PG8_LDA(dst, b, h) do { _Pragma("unroll") for (int m = 0; m < 4; ++m) _Pragma("unroll") for (int k = 0; k < 2; ++k) dst[m][k] = *(const PG8_LAS bf16x8*)(lds + PG8_SA(b, h) + aoff + m * 2048 + k * 1024); } while (0)
#define PG8_LDB(dst, b, h) do { _Pragma("unroll") for (int n = 0; n < 2; ++n) _Pragma("unroll") for (int k = 0; k < 2; ++k) dst[n][k] = *(const PG8_LAS bf16x8*)(lds + PG8_SB(b, h) + boff + n * 2048 + k * 1024); } while (0)
#define PG8_MMA(ai, bj, At, Bt) do { __builtin_amdgcn_s_setprio(1); _Pragma("unroll") for (int m = 0; m < 4; ++m) _Pragma("unroll") for (int n = 0; n < 2; ++n) _Pragma("unroll") for (int k = 0; k < 2; ++k) \
        acc[ai][bj][m][n] = __builtin_amdgcn_mfma_f32_16x16x32_bf16(Bt[n][k], At[m][k], acc[ai][bj][m][n], 0, 0, 0); __builtin_amdgcn_s_setprio(0); } while (0)
#define PG8_WAIT_V(n) asm volatile("s_waitcnt vmcnt(" #n ")" ::: "memory")
#define PG8_WAIT_L(n) asm volatile("s_waitcnt lgkmcnt(" #n ")" ::: "memory")
#define PG8_BAR __builtin_amdgcn_s_barrier()
#define PG8_SCHED __builtin_amdgcn_sched_barrier(0)
    Unit cur, nxt; int ui = 0;
    if (!S.next(0, cur)) return;
    f32x4 acc[2][2][4][2];
#pragma unroll
    for (int a = 0; a < 2; ++a)
#pragma unroll
        for (int b = 0; b < 2; ++b)
#pragma unroll
            for (int m = 0; m < 4; ++m)
#pragma unroll
                for (int n = 0; n < 2; ++n) acc[a][b][m][n] = (f32x4){0.f, 0.f, 0.f, 0.f};
    bf16x8 At[4][2], B0[2][2], B1[2][2];
    const char* cA = (const char*)g.A + (size_t)cur.pm * tstep; const char* cB = (const char*)g.Bt + (size_t)cur.pn * tstep;
    S.a_ready(cur);
    if constexpr (SP2) {
        PG8_STAGE(PG8_SB(0, 0), cB, voffB); PG8_STAGE(PG8_SB(0, 1), cB + hstep, voffB); PG8_STAGE(PG8_SA(0, 0), cA, voffA); PG8_STAGE(PG8_SA(0, 1), cA + hstep, voffA);
        if (wr == 1) PG8_BAR;
        PG8_WAIT_V(2); PG8_BAR;
        PG8_STAGE(PG8_SB(1, 0), cB + kstep, voffB); PG8_STAGE(PG8_SA(1, 0), cA + kstep, voffA); PG8_STAGE(PG8_SB(1, 1), cB + hstep + kstep, voffB);
        PG8_WAIT_V(6); PG8_BAR;
    } else {
        PG8_STAGE(PG8_SB(0, 0), cB, voffB); PG8_STAGE(PG8_SA(0, 0), cA, voffA); PG8_STAGE(PG8_SB(0, 1), cB + hstep, voffB); PG8_STAGE(PG8_SA(0, 1), cA + hstep, voffA);
        if (wr == 1) PG8_BAR;
        PG8_WAIT_V(4); PG8_BAR;
        PG8_STAGE(PG8_SB(1, 0), cB + kstep, voffB); PG8_STAGE(PG8_SA(1, 0), cA + kstep, voffA); PG8_STAGE(PG8_SB(1, 1), cB + hstep + kstep, voffB);
        PG8_WAIT_V(6); PG8_BAR;
    }
    for (;;) {
        const bool has_next = S.next(ui + 1, nxt);
        const char* nA = has_next ? (const char*)g.A + (size_t)nxt.pm * tstep : cA; const char* nB = has_next ? (const char*)g.Bt + (size_t)nxt.pn * tstep : cB;
        for (int t = 0; t < nt; t += 2) {
            const bool last = (t == nt - 2);
            const char* a1 = cA + (size_t)(t + 1) * kstep;
            const char* a2 = last ? nA : cA + (size_t)(t + 2) * kstep; const char* b2 = last ? nB : cB + (size_t)(t + 2) * kstep;
            const char* a3 = a2 + kstep; const char* b3 = b2 + kstep;
            if (last && has_next) S.a_ready(nxt);
            if constexpr (SP2) {
            PG8_LDB(B0, 0, 0); PG8_LDB(B1, 0, 1); PG8_SCHED; PG8_LDA(At, 0, 0); PG8_STAGE(PG8_SA(1, 1), a1 + hstep, voffA);
            PG8_WAIT_V(8); PG8_WAIT_L(0); PG8_BAR; PG8_MMA(0, 0, At, B0); PG8_MMA(0, 1, At, B1); PG8_BAR; PG8_SCHED;
            PG8_LDA(At, 0, 1); PG8_STAGE(PG8_SB(0, 0), b2, voffB); PG8_STAGE(PG8_SB(0, 1), b2 + hstep, voffB); PG8_STAGE(PG8_SA(0, 0), a2, voffA);
            PG8_WAIT_V(8); PG8_WAIT_L(0); PG8_BAR; PG8_MMA(1, 0, At, B0); PG8_MMA(1, 1, At, B1); PG8_BAR; PG8_SCHED;
            PG8_LDB(B0, 1, 0); PG8_LDB(B1, 1, 1); PG8_SCHED; PG8_LDA(At, 1, 0); PG8_STAGE(PG8_SA(0, 1), a2 + hstep, voffA);
            PG8_WAIT_V(8); PG8_WAIT_L(0); PG8_BAR; PG8_MMA(0, 0, At, B0); PG8_MMA(0, 1, At, B1); PG8_BAR; PG8_SCHED;
            PG8_LDA(At, 1, 1); PG8_STAGE(PG8_SB(1, 0), b3, voffB); PG8_STAGE(PG8_SB(1, 1), b3 + hstep, voffB); PG8_STAGE(PG8_SA(1, 0), a3, voffA);
            PG8_WAIT_V(8); PG8_WAIT_L(0); PG8_BAR; PG8_MMA(1, 0, At, B0); PG8_MMA(1, 1, At, B1); PG8_BAR; PG8_SCHED;
            } else {
            PG8_LDB(B0, 0, 0); PG8_SCHED; PG8_LDA(At, 0, 0); PG8_STAGE(PG8_SA(1, 1), a1 + hstep, voffA);
            PG8_WAIT_L(8); PG8_BAR; PG8_WAIT_L(0); PG8_MMA(0, 0, At, B0); PG8_BAR; PG8_SCHED;
            PG8_LDB(B1, 0, 1); PG8_STAGE(PG8_SB(0, 0), b2, voffB);
            PG8_BAR; PG8_WAIT_L(0); PG8_MMA(0, 1, At, B1); PG8_BAR;
            PG8_LDA(At, 0, 1); PG8_STAGE(PG8_SA(0, 0), a2, voffA);
            PG8_BAR; PG8_WAIT_L(0); PG8_MMA(1, 0, At, B0); PG8_BAR; PG8_SCHED;
            PG8_STAGE(PG8_SB(0, 1), b2 + hstep, voffB);
            PG8_WAIT_V(6); PG8_BAR; PG8_MMA(1, 1, At, B1); PG8_BAR;
            PG8_LDB(B0, 1, 0); PG8_SCHED; PG8_LDA(At, 1, 0); PG8_STAGE(PG8_SA(0, 1), a2 + hstep, voffA);
            PG8_WAIT_L(8); PG8_BAR; PG8_WAIT_L(0); PG8_MMA(0, 0, At, B0); PG8_BAR; PG8_SCHED;
            PG8_LDB(B1, 1, 1); PG8_STAGE(PG8_SB(1, 0), b3, voffB);
            PG8_BAR; PG8_WAIT_L(0); PG8_MMA(0, 1, At, B1); PG8_BAR;
            PG8_LDA(At, 1, 1); PG8_STAGE(PG8_SA(1, 0), a3, voffA);
            PG8_BAR; PG8_WAIT_L(0); PG8_MMA(1, 0, At, B0); PG8_BAR; PG8_SCHED;
            PG8_STAGE(PG8_SB(1, 1), b3 + hstep, voffB);
            PG8_WAIT_V(6); PG8_BAR; PG8_MMA(1, 1, At, B1); PG8_BAR;
            }
        }
        if constexpr (ALIGN_EPI) { if (wr == 0) PG8_BAR; }
        if constexpr (!Epi::AFTER_DRAIN) { E(acc, cur, wr, wc, fr, fq); S.done(cur); }
        if (!has_next) break;
#pragma unroll
        for (int a = 0; a < 2; ++a)
#pragma unroll
            for (int b = 0; b < 2; ++b)
#pragma unroll
                for (int m = 0; m < 4; ++m)
#pragma unroll
                    for (int n = 0; n < 2; ++n) acc[a][b][m][n] = (f32x4){0.f, 0.f, 0.f, 0.f};
        cur = nxt; cA = nA; cB = nB; ++ui;
        if constexpr (ALIGN_EPI) { if (wr == 1) PG8_BAR; }
    }
    PG8_WAIT_V(0);
    if constexpr (!ALIGN_EPI) { if (wr == 0) PG8_BAR; }
    PG8_BAR;
    if constexpr (Epi::AFTER_DRAIN) { E.fused(acc, cur, wr, wc, fr, fq, lds, wid, lane); S.done(cur); }
#undef PG8_SA
#undef PG8_SB
#undef PG8_STAGE
#undef PG8_LDA
#undef PG8_LDB
#undef PG8_MMA
#undef PG8_WAIT_V
#undef PG8_WAIT_L
#undef PG8_BAR
#undef PG8_SCHED
}
}
#define GAS __attribute__((address_space(1)))
#define LAS __attribute__((address_space(3)))
typedef unsigned short bf16;
typedef unsigned v4u __attribute__((ext_vector_type(4)));
typedef float f32x4 __attribute__((ext_vector_type(4)));
typedef short bf16x8 __attribute__((ext_vector_type(8)));
typedef GAS unsigned gu32;
typedef GAS unsigned long long gu64;
#define RLX_AGENT __ATOMIC_RELAXED, __HIP_MEMORY_SCOPE_AGENT
#define LDS_WAIT() asm volatile("s_waitcnt lgkmcnt(0)" ::: "memory")
#define VM_WAIT() asm volatile("s_waitcnt vmcnt(0)" ::: "memory")
__device__ __forceinline__ unsigned long long rt() { return __builtin_amdgcn_s_memrealtime(); }
__device__ __forceinline__ unsigned f2bf(float f) { unsigned u = __builtin_bit_cast(unsigned, f); return (u + 0x7fffu + ((u >> 16) & 1u)) >> 16; }
__device__ __forceinline__ unsigned pk2(float lo, float hi) { return f2bf(lo) | (f2bf(hi) << 16); }
#define XB_TMO      128
#define XB_XCNT(j)  (256  + 64 * (j))
#define XB_XSUB(j)  (1280 + 64 * (j))
#define XB_XGEN(j)  (2304 + 64 * (j))
#define XB_TOP      3328
#define XB_TOPGEN   3392
#define XCD_BAR_WORDS 3456
#define XB_SPIN_CAP (1u << 18)

__device__ __forceinline__ unsigned xb_ld(unsigned* p)              { return __hip_atomic_load(p, __ATOMIC_RELAXED, __HIP_MEMORY_SCOPE_AGENT); }
__device__ __forceinline__ unsigned xb_add(unsigned* p, unsigned v) { return __hip_atomic_fetch_add(p, v, __ATOMIC_RELAXED, __HIP_MEMORY_SCOPE_AGENT); }
__device__ __forceinline__ unsigned xb_xcc_id() { return (unsigned)__builtin_amdgcn_s_getreg((3 << 11) | 20) & 0xFu; }
#define XB_SPIN(cond, bar) do { unsigned _sp = 0; while (cond) { __builtin_amdgcn_s_sleep(1); \
    if ((++_sp & 255u) == 0u) { if (xb_ld(&(bar)[XB_TMO])) break; if (_sp > XB_SPIN_CAP) { atomicAdd(&(bar)[XB_TMO], 1u); break; } } } } while (0)

struct XcdBarrier {
    unsigned* bar; unsigned x;
    volatile LAS unsigned* st;
};

__device__ __forceinline__ XcdBarrier xcd_barrier_post(unsigned* bar, volatile LAS unsigned* st) {
    XcdBarrier b; b.bar = bar; b.x = xb_xcc_id(); b.st = st;
    if (threadIdx.x == 0) (void)xb_add(&bar[XB_XCNT(b.x)], 1u);
    return b;
}
__device__ __forceinline__ void xcd_barrier_complete(unsigned* bar, unsigned x, unsigned& nloc, unsigned& nx) {
    const unsigned G = gridDim.x * gridDim.y * gridDim.z;
    unsigned sum, cnt, mine, sp = 0u;
    for (;;) {
        sum = 0u; cnt = 0u; mine = 0u;
#pragma unroll
        for (unsigned j = 0; j < 16; ++j) { const unsigned c = xb_ld(&bar[XB_XCNT(j)]); sum += c; cnt += (c > 0u) ? 1u : 0u; mine = (j == x) ? c : mine; }
        if (sum == G) break;
        __builtin_amdgcn_s_sleep(1);
        if ((++sp & 255u) == 0u) { if (xb_ld(&bar[XB_TMO])) break; if (sp > XB_SPIN_CAP) { atomicAdd(&bar[XB_TMO], 1u); break; } }
    }
    nloc = mine > 0u ? mine : 1u; nx = cnt > 0u ? cnt : 1u;
}

__device__ __forceinline__ void xcd_barrier(const XcdBarrier& b) {
    asm volatile("s_waitcnt vmcnt(0)" ::: "memory");
    __syncthreads();
    if (threadIdx.x == 0) {
        unsigned* bar = b.bar;
        __builtin_amdgcn_s_waitcnt(0);
        unsigned nloc = b.st[0], nx = b.st[1];
        if (nloc == 0u) { xcd_barrier_complete(bar, b.x, nloc, nx); b.st[0] = nloc; b.st[1] = nx; }
        const unsigned old = xb_add(&bar[XB_XSUB(b.x)], 1u);
        const unsigned gen = old / nloc;
        if (old + 1u == (gen + 1u) * nloc) {
            __builtin_amdgcn_fence(__ATOMIC_RELEASE, "agent");
            asm volatile("s_waitcnt vmcnt(0)" ::: "memory");
            const unsigned og = xb_add(&bar[XB_TOP], 1u);
            const unsigned tg = og / nx;
            if (og + 1u == (tg + 1u) * nx) xb_add(&bar[XB_TOPGEN], 1u);
            else XB_SPIN(xb_ld(&bar[XB_TOPGEN]) == tg, bar);
            __builtin_amdgcn_fence(__ATOMIC_ACQUIRE, "agent");
            xb_add(&bar[XB_XGEN(b.x)], 1u);
            asm volatile("s_waitcnt vmcnt(0)" ::: "memory");
        } else {
            XB_SPIN(xb_ld(&bar[XB_XGEN(b.x)]) == gen, bar);
            __builtin_amdgcn_fence(__ATOMIC_ACQUIRE, "agent");
            asm volatile("s_waitcnt vmcnt(0)" ::: "memory");
        }
    }
    __syncthreads();
}
constexpr int NB = 8, SEQ = 4096, DM = 1024, DEPTH = 4, M = NB * SEQ;
constexpr int FF = 2816, NIN = 5852, NINP = 5888;
constexpr float EPS = 1e-6f, NEGF = -1e30f;
constexpr int NWAVES = 8;
constexpr size_t MiB = 1u << 20;
constexpr size_t WS_CTL = 0, CTL_ZERO_BYTES = 1 * MiB;
constexpr size_t WS_ROPE = 1 * MiB;
constexpr size_t WS_KVA = 3 * MiB;
constexpr size_t WS_KC = 11 * MiB, WS_VC = WS_KC + 512 * 1024;
constexpr size_t WS_W = 12 * MiB;
constexpr size_t WO_GU1 = 0, WO_D1 = 11 * MiB, WO_GU2 = WO_D1 + 5 * MiB + 512 * 1024, WO_D2 = WO_GU2 + 11 * MiB, WO_IN = WO_D2 + 5 * MiB + 512 * 1024,
                 WO_PA = WO_IN + 11 * MiB + 512 * 1024, WO_PB = WO_PA + MiB, WO_PC = WO_PB + MiB, WO_OUT = WO_PC + MiB,
                 WO_CW1 = WO_OUT + 2 * MiB  , WO_CW2 = WO_CW1 + MiB  , WO_UKV = WO_CW2 + 32768  , WO_POOL = WO_UKV + 32768  ,
                 WO_POSB = WO_POOL + 131072  , WO_END = WO_POSB + 1024;
static_assert(WO_END <= 52 * MiB, "weights region");
constexpr size_t WS_XN = 64 * MiB;
constexpr size_t WS_R = 128 * MiB;
constexpr size_t WS_G = WS_R, WS_QA = WS_R + 192 * MiB, WS_QC = WS_QA + 32 * MiB, WS_IQ = WS_QC + 32 * MiB, WS_MISC = WS_IQ + 16 * MiB,
                 WS_KVC = WS_MISC + 16 * MiB, WS_KVS = WS_KVC + 16 * MiB, WS_KVW = WS_KVS + 16 * MiB, WS_BU = WS_KVW + 16 * MiB, WS_END = WS_BU + 32 * MiB;
#ifndef YB_SPARE
#define YB_SPARE 0
#endif
constexpr size_t WS_YB = YB_SPARE ? 496 * MiB : WS_XN;
constexpr size_t WS_MG = WS_IQ;
constexpr size_t WS_H = WS_R;
static_assert(WS_END == 496 * MiB, "ws map");
constexpr int RING_BYTES = 131072, LDS_BYTES = 163840, LDSCTL_OFF = 163840 - 256;
constexpr size_t WS_SSQ = 496 * MiB;
constexpr int RS_OFF = 131072;
constexpr int NPL = 10, NPH = 1 + DEPTH * NPL + 1;


#ifndef TPROBE
#define TPROBE 0
#endif
#if TPROBE
#define TP_DECL unsigned long long tp_t_ = __builtin_amdgcn_s_memtime();
#define TP_MARK(k) do { const unsigned long long n_ = __builtin_amdgcn_s_memtime(); if (tid == 0) atomicAdd((unsigned long long*)(ws + 32768) + (k), n_ - tp_t_); tp_t_ = n_; } while (0)
#define TP_ADD(k, v) do { if (tid == 0) atomicAdd((unsigned long long*)(ws + 32768) + (k), (unsigned long long)(v)); } while (0)
#else
#define TP_DECL
#define TP_MARK(k)
#define TP_ADD(k, v)
#endif
__device__ __forceinline__ int lane_id_v() { int l; asm volatile("v_mbcnt_lo_u32_b32 %0, -1, 0\n\tv_mbcnt_hi_u32_b32 %0, -1, %0" : "=v"(l)); return l; }
__device__ __forceinline__ float bflo(unsigned w) { return __uint_as_float(w << 16); }
__device__ __forceinline__ float bfhi(unsigned w) { return __uint_as_float(w & 0xffff0000u); }
__device__ __forceinline__ float bf2f(bf16 v) { return __uint_as_float((unsigned)v << 16); }
__device__ __forceinline__ float wave_sum(float v) {
#pragma unroll
    for (int o = 1; o < 64; o <<= 1) v += __shfl_xor(v, o);
    return v;
}
__device__ __forceinline__ float wave_max(float v) {
#pragma unroll
    for (int o = 1; o < 64; o <<= 1) v = fmaxf(v, __shfl_xor(v, o));
    return v;
}
__device__ __forceinline__ int wave_sum_i(int v) {
#pragma unroll
    for (int o = 1; o < 64; o <<= 1) v += __shfl_xor(v, o);
    return v;
}
__device__ __forceinline__ unsigned wave_max_u(unsigned v) {
#pragma unroll
    for (int o = 1; o < 64; o <<= 1) { const unsigned w = (unsigned)__shfl_xor((int)v, o); v = w > v ? w : v; }
    return v;
}
#define WAVE_LDS_SYNC() do { asm volatile("s_waitcnt lgkmcnt(0)" ::: "memory"); __builtin_amdgcn_wave_barrier(); } while (0)
__host__ __device__ __forceinline__ int permd(int d) { return d < 8 ? 2 * d : (d < 16 ? 2 * (d - 8) + 1 : d); }
__device__ __forceinline__ int win_newcol(int n) {
    if (n < 512) return (n & ~63) + permd(n & 63);
    if (n < 640) return 1280 + 64 + (n - 512);
    if (n < 896) { const int m = n - 640; return 1024 + (m & ~63) + permd(m & 63); }
    if (n < 960) return 1280 + permd(n - 896);
    if (n < 964) return 1280 + 192 + (n - 960);
    if (n < 1476) return 2304 + (n - 964);
    if (n < 1988) { const int m = n - 1476; return 512 + (m & ~63) + permd(m & 63); }
    if (n < 2756) { const int m = n - 1988, kv = m >> 8, r = m & 255, base = 1536 + kv * 256; return r < 128 ? base + (r & ~63) + permd(r & 63) : base + r; }
    if (n < 2780) return 1280 + 196 + (n - 2756);
    return 2816 + (n - 2780);
}
__device__ __forceinline__ int map_row(int mode, int n) { return mode == 0 ? n : (mode == 1 ? ((n >> 7) << 8) + (n & 127) : (mode == 2 ? ((n >> 7) << 8) + 128 + (n & 127) : win_newcol(n))); }

struct Args { const float* in[24]; float* out; unsigned char* ws; int ph_lo, ph_hi; };

__device__ __forceinline__ int unperm(int p) { return p < 16 ? ((p & 1) ? (p >> 1) + 8 : (p >> 1)) : p; }
__device__ __forceinline__ void tr_item(const float* W, int K, int N, bf16* WT, int mode, LAS float* scr, int item, int lane, bool kperm = false, const float* kscale = nullptr) {
    const int nblk = (N + 31) >> 5, kb = item / nblk, nb = item - kb * nblk, k0 = 64 * kb, n0 = 32 * nb;
    const int nn = n0 + (lane & 31);
    const int nnc = nn < N ? nn : N - 1; const float msk = nn < N ? 1.0f : 0.0f;
    const float* ksp = kscale ? kscale : W; const bool hs = kscale != nullptr;
    float wv[32], sv[32];
#pragma unroll
    for (int i = 0; i < 32; ++i) { const int kk = 2 * i + (lane >> 5); wv[i] = W[(size_t)(k0 + kk) * N + nnc]; sv[i] = ksp[k0 + kk]; }
#pragma unroll
    for (int i = 0; i < 32; ++i) { const int kk = 2 * i + (lane >> 5); scr[kk * 33 + (lane & 31)] = wv[i] * (hs ? sv[i] : 1.0f) * msk; }
    LDS_WAIT(); asm volatile("" ::: "memory");
    const int c = lane & 7;
#pragma unroll
    for (int j = 0; j < 4; ++j) { const int n = (lane >> 3) + 8 * j; const LAS float* s = scr + n;
        int ks[8];
#pragma unroll
        for (int i = 0; i < 8; ++i) ks[i] = (kperm ? unperm(8 * c + i) : 8 * c + i) * 33;
        v4u o; o.x = pk2(s[ks[0]], s[ks[1]]); o.y = pk2(s[ks[2]], s[ks[3]]); o.z = pk2(s[ks[4]], s[ks[5]]); o.w = pk2(s[ks[6]], s[ks[7]]);
        if (n0 + n < N) *(v4u*)(WT + (size_t)map_row(mode, n0 + n) * K + k0 + 8 * c) = o; }
    LDS_WAIT(); asm volatile("" ::: "memory");
}
__device__ __forceinline__ void phase_convert(const Args& P, unsigned char* ws, int z, int l, LAS unsigned char* lds, int gw, int NGW, int lane, int wave) {
    asm volatile("" : "+v"(lane)); lane &= 63; asm volatile("" : "+s"(gw), "+s"(NGW));
    LAS float* scr = (LAS float*)(lds + wave * 16384);
    unsigned char* wb = ws + WS_W;
    constexpr int I_F = 16 * 88, I_D = 44 * 32, I_IN = 16 * 183, I_P = 8 * 32, I_O = 16 * 32;
    constexpr int I_C = 32 * 4;
    constexpr int NIT = 4 * I_F + 2 * I_D + I_IN + 3 * I_P + I_O + 2 * I_C;
    const size_t fo = (size_t)l * DM * FF;
    for (int it = gw; it < NIT; it += NGW) {
        int r = it, K = DM, N = FF, mode = 1; const float* W = P.in[3 + z] + fo; size_t wo = WO_GU1; bool kperm = false; const float* ksc = P.in[2 + z] + l * DM;
        if (r >= I_F) { r -= I_F; mode = 2; W = P.in[4 + z] + fo;
        if (r >= I_F) { r -= I_F; mode = 0; W = P.in[5 + z] + fo; K = FF; N = DM; wo = WO_D1; ksc = nullptr;
        if (r >= I_D) { r -= I_D; mode = 1; W = P.in[20 + z] + fo; K = DM; N = FF; wo = WO_GU2; ksc = P.in[19 + z] + l * DM;
        if (r >= I_F) { r -= I_F; mode = 2; W = P.in[21 + z] + fo;
        if (r >= I_F) { r -= I_F; mode = 0; W = P.in[22 + z] + fo; K = FF; N = DM; wo = WO_D2; ksc = nullptr;
        if (r >= I_D) { r -= I_D; mode = 3; W = P.in[7 + z] + (size_t)l * DM * NIN; K = DM; N = NIN; wo = WO_IN; ksc = P.in[6 + z] + l * DM;
        if (r >= I_IN) { r -= I_IN; mode = 0; W = P.in[15 + z] + (size_t)l * 512 * DM; K = 512; N = DM; wo = WO_PA; ksc = nullptr;
        if (r >= I_P) { r -= I_P; W = P.in[16 + z] + (size_t)l * 512 * DM; wo = WO_PB;
        if (r >= I_P) { r -= I_P; W = P.in[17 + z] + (size_t)l * 512 * DM; wo = WO_PC;
        if (r >= I_P) { r -= I_P; W = P.in[18 + z] + (size_t)l * DM * DM; K = DM; wo = WO_OUT;
        if (r >= I_O) { r -= I_O; W = P.in[13 + z] + (size_t)(l * 2) * 2048 * 128; K = 2048; N = 128; wo = WO_CW1; kperm = true;
        if (r >= I_C) { r -= I_C; W += (size_t)2048 * 128; wo = WO_CW1 + 128 * 2048 * 2; kperm = false; } } } } } } } } } } } }
        tr_item(W, K, N, (bf16*)(wb + wo), mode, scr, r, lane, kperm, ksc);
    }
    {
        const int gt = gw * 64 + lane, GT = NGW * 64;
        bf16* ukv = (bf16*)(wb + WO_UKV); bf16* pool = (bf16*)(wb + WO_POOL); bf16* cw2 = (bf16*)(wb + WO_CW2); float* posb = (float*)(wb + WO_POSB);
        const float* w_ukv = P.in[9 + z] + (size_t)l * 128 * 128; const float* gn = P.in[8 + z] + l * 128;
        for (int i = gt; i < 128 * 128; i += GT) { const int np = i >> 7, k = i & 127, n = np < 64 ? unperm(np) : np; ukv[i] = (bf16)f2bf(gn[k] * w_ukv[k * 128 + n]); }
        const float* pw = P.in[10 + z] + (size_t)l * 4 * 128 * 128; const float* psc = P.in[11 + z] + l * 512;
        for (int i = gt; i < 4 * 128 * 128; i += GT) { const int g = i >> 14, d = (i >> 7) & 127, c = i & 127; pool[i] = (bf16)f2bf(pw[(g * 128 + c) * 128 + d] * psc[g * 128 + d]); }
        const float* w2 = P.in[14 + z] + (size_t)l * 2 * 128 * 64;
        for (int i = gt; i < 2 * 64 * 128; i += GT) { const int br = i >> 13, dp = (i >> 7) & 63, n = i & 127, d = br ? dp : unperm(dp); cw2[i] = (bf16)f2bf(w2[(br * 128 + n) * 64 + d]); }
        const float* w1 = P.in[13 + z] + (size_t)l * 2 * 2048 * 128; const float* pos = P.in[12 + z] + (size_t)l * 2 * 2048;
        for (int i = gw; i < 256; i += NGW) { const int br = i >> 7, n = i & 127; float a = 0.f;
#pragma unroll 8
            for (int k = lane; k < 2048; k += 64) a += pos[br * 2048 + k] * w1[((size_t)br * 2048 + k) * 128 + n];
            a = wave_sum(a); if (lane == 0) posb[i] = a; }
    }
    if (gw < 36) { unsigned zz = 0u; asm volatile("" : "+v"(zz)); v4u z = {zz, zz, zz, zz}; v4u* rp = (v4u*)((bf16*)(wb + WO_IN) + (size_t)(1500 + gw) * DM); for (int i = lane; i < DM / 8; i += 64) rp[i] = z; }
}
__device__ __forceinline__ void phase_rope(const Args& P, unsigned char* ws, int z, int gtid, int gthreads) {
    float* rope = (float*)(ws + WS_ROPE);
    for (int idx = gtid; idx < M * 8; idx += gthreads) {
        const int row = idx >> 3, i = idx & 7;
        const double inv = i == 0 ? 1.0 : i == 1 ? 0.19392274474868576 : i == 2 ? 0.03760603093086393 : i == 3 ? 0.007292664737217109 : i == 4 ? 0.001414213562373095 : i == 5 ? 0.0002742481756762073 : i == 6 ? 5.318295896944988e-05 : 1.031338537721246e-05;
        const double ang = (double)((const int*)P.in[1 + z])[row] * inv;
        double s, c; sincos(ang, &s, &c);
        rope[row * 16 + i] = (float)c; rope[row * 16 + 8 + i] = (float)s;
    }
}
__device__ __forceinline__ void norm_row_bf16(const float* xrow, const float* gain, bf16* orow, int lane) {
    const f32x4* xr = (const f32x4*)xrow + lane; const f32x4* gr = (const f32x4*)gain + lane;
    f32x4 v[4]; float s = 0.f;
#pragma unroll
    for (int j = 0; j < 4; ++j) { v[j] = xr[64 * j]; s += (v[j].x * v[j].x + v[j].y * v[j].y) + (v[j].z * v[j].z + v[j].w * v[j].w); }
    const float r = 1.0f / sqrtf(wave_sum(s) * (1.f / DM) + EPS);
    unsigned long long* o8 = (unsigned long long*)orow + lane;
#pragma unroll
    for (int j = 0; j < 4; ++j) { const f32x4 g = gr[64 * j]; o8[64 * j] = (unsigned long long)pk2(v[j].x * r * g.x, v[j].y * r * g.y) | ((unsigned long long)pk2(v[j].z * r * g.z, v[j].w * r * g.w) << 32); }
}
__device__ __forceinline__ void stat_row_bf16(const float* xrow, bf16* orow, float* ssq16, int lane) {
    const f32x4* xr = (const f32x4*)xrow + lane;
    f32x4 v[4]; float s = 0.f;
#pragma unroll
    for (int j = 0; j < 4; ++j) { v[j] = xr[64 * j]; s += (v[j].x * v[j].x + v[j].y * v[j].y) + (v[j].z * v[j].z + v[j].w * v[j].w); }
    s = wave_sum(s);
    unsigned long long* o8 = (unsigned long long*)orow + lane;
#pragma unroll
    for (int j = 0; j < 4; ++j) o8[64 * j] = (unsigned long long)pk2(v[j].x, v[j].y) | ((unsigned long long)pk2(v[j].z, v[j].w) << 32);
    if (lane < 16) ssq16[lane] = lane == 0 ? s : 0.f;
}
__device__ __forceinline__ void norm_row_f32(float* xrow, const float* gain, int lane, float tps = 1.0f) {
    f32x4* xr = (f32x4*)xrow + lane; const f32x4* gr = (const f32x4*)gain + lane;
    f32x4 v[4]; float s = 0.f;
#pragma unroll
    for (int j = 0; j < 4; ++j) { v[j] = xr[64 * j]; s += (v[j].x * v[j].x + v[j].y * v[j].y) + (v[j].z * v[j].z + v[j].w * v[j].w); }
    const float r = tps / sqrtf(wave_sum(s) * (1.f / DM) + EPS);
#pragma unroll
    for (int j = 0; j < 4; ++j) { const f32x4 g = gr[64 * j]; xr[64 * j] = v[j] * r * g; }
}

__device__ __forceinline__ void norm_row_out(const bf16* xrow, float* orow, const float* gain, int lane, float tps = 1.0f) {
    const v4u a = *(const v4u*)(xrow + 16 * lane), b = *(const v4u*)(xrow + 16 * lane + 8);
    const float f[16] = {bflo(a.x), bfhi(a.x), bflo(a.y), bfhi(a.y), bflo(a.z), bfhi(a.z), bflo(a.w), bfhi(a.w), bflo(b.x), bfhi(b.x), bflo(b.y), bfhi(b.y), bflo(b.z), bfhi(b.z), bflo(b.w), bfhi(b.w)};
    float s = 0.f;
#pragma unroll
    for (int e = 0; e < 16; ++e) s += f[e] * f[e];
    const float r = tps / sqrtf(wave_sum(s) * (1.f / DM) + EPS);
    const f32x4* gr = (const f32x4*)(gain + 16 * lane); f32x4* orr = (f32x4*)(orow + 16 * lane);
#pragma unroll
    for (int j = 0; j < 4; ++j) { const f32x4 g = gr[j]; f32x4 o; o.x = f[4 * j] * r * g.x; o.y = f[4 * j + 1] * r * g.y; o.z = f[4 * j + 2] * r * g.z; o.w = f[4 * j + 3] * r * g.w; orr[j] = o; }
}
__device__ __forceinline__ unsigned f2o(float s) { const int b = (int)__float_as_uint(s); return (unsigned)(b ^ ((b >> 31) | (int)0x80000000)); }
__device__ __forceinline__ void unpack8(const v4u v, float* f) { f[0] = bflo(v.x); f[1] = bfhi(v.x); f[2] = bflo(v.y); f[3] = bfhi(v.y); f[4] = bflo(v.z); f[5] = bfhi(v.z); f[6] = bflo(v.w); f[7] = bfhi(v.w); }
__device__ __forceinline__ void load_row64(const bf16* p, float* f) {
    const v4u* q = (const v4u*)p;
#pragma unroll
    for (int i = 0; i < 8; ++i) unpack8(q[i], f + 8 * i);
}
__device__ __forceinline__ float dot64(const LAS float* q, const float* k) {
    float d = 0.f;
#pragma unroll
    for (int i = 0; i < 16; ++i) { const f32x4 qq = *(const LAS f32x4*)(q + 4 * i); d += qq.x * k[4 * i] + qq.y * k[4 * i + 1] + qq.z * k[4 * i + 2] + qq.w * k[4 * i + 3]; }
    return d;
}
__device__ __forceinline__ void dsa_query(const Args& P, unsigned char* ws, int z, int row, LAS unsigned char* wl, int lane) {
    const int b = row >> 12, t = row & (SEQ - 1), n = t + 1;
    LAS unsigned* su = (LAS unsigned*)wl; LAS float* pb = (LAS float*)wl; LAS unsigned short* list = (LAS unsigned short*)(wl + 16384); LAS float* qb = (LAS float*)(wl + 16896);
    const bf16* misc = (const bf16*)(ws + WS_MISC);
    const unsigned long long lt = (1ull << lane) - 1ull;
    int nsel;
    if (n <= 256) { for (int i = lane; i < n; i += 64) list[i] = (unsigned short)i; nsel = n; }
    else {
        { const uint2 v = *(const uint2*)((const bf16*)(ws + WS_IQ) + (size_t)row * 256 + lane * 4); qb[lane * 4] = bflo(v.x); qb[lane * 4 + 1] = bfhi(v.x); qb[lane * 4 + 2] = bflo(v.y); qb[lane * 4 + 3] = bfhi(v.y); }
        float iw[4]; { const uint2 v = *(const uint2*)(misc + (size_t)row * 256 + 192); iw[0] = 0.5f * bflo(v.x); iw[1] = 0.5f * bfhi(v.x); iw[2] = 0.5f * bflo(v.y); iw[3] = 0.5f * bfhi(v.y); }
        WAVE_LDS_SYNC();
        const int nch = (n + 63) >> 6;
        for (int i = 0; i < nch; ++i) {
            const int key = i * 64 + lane; const bool valid = key <= t;
            float kf[64]; load_row64(misc + (size_t)(b * SEQ + (valid ? key : t)) * 256, kf);
            float s = 0.f;
#pragma unroll
            for (int h = 0; h < 4; ++h) s += iw[h] * fmaxf(dot64(qb + h * 64, kf), 0.f);
            su[key] = valid ? f2o(s) : 0u;
        }
        WAVE_LDS_SYNC();
        unsigned prefix = 0u;
        for (int bit = 31; bit >= 0; --bit) {
            const unsigned cand = prefix | (1u << bit); int c = 0;
            for (int i = 0; i < nch; ++i) c += (su[i * 64 + lane] >= cand) ? 1 : 0;
            c = wave_sum_i(c);
            if (c >= 256) prefix = cand;
            if (c == 256) break;
        }
        int cgt = 0;
        for (int i = 0; i < nch; ++i) cgt += (su[i * 64 + lane] > prefix) ? 1 : 0;
        const int need_eq = 256 - wave_sum_i(cgt);
        int base = 0, eq_taken = 0;
        for (int i = 0; i < nch; ++i) {
            const unsigned v = su[i * 64 + lane]; const bool gt = v > prefix, eq = v == prefix;
            const unsigned long long meq = __ballot(eq);
            const bool sel = gt || (eq && (eq_taken + __popcll(meq & lt)) < need_eq);
            const unsigned long long ms = __ballot(sel);
            if (sel) list[base + __popcll(ms & lt)] = (unsigned short)(i * 64 + lane);
            base += __popcll(ms); eq_taken += __popcll(meq);
        }
        nsel = 256;
    }
    { const v4u v = *(const v4u*)((const bf16*)(ws + WS_QA) + (size_t)row * 512 + lane * 8); float f[8]; unpack8(v, f);
#pragma unroll
      for (int e = 0; e < 8; ++e) qb[lane * 8 + e] = f[e]; }
    WAVE_LDS_SYNC();
    const bf16* kva = (const bf16*)(ws + WS_KVA);
    float s[8][4];
#pragma unroll
    for (int j = 0; j < 4; ++j) {
        const int slot = lane + 64 * j; const bool valid = slot < nsel; const int key = list[valid ? slot : 0];
        float kf[64]; load_row64(kva + (size_t)(b * SEQ + key) * 128, kf);
#pragma unroll
        for (int h = 0; h < 8; ++h) s[h][j] = valid ? dot64(qb + h * 64, kf) : NEGF;
    }
    float linv[8];
#pragma unroll
    for (int h = 0; h < 8; ++h) {
        const float m = wave_max(fmaxf(fmaxf(s[h][0], s[h][1]), fmaxf(s[h][2], s[h][3]))); float ls = 0.f;
#pragma unroll
        for (int j = 0; j < 4; ++j) { const float p = __expf(s[h][j] - m); ls += p; pb[h * 256 + lane + 64 * j] = p; }
        linv[h] = 1.0f / wave_sum(ls);
    }
    WAVE_LDS_SYNC();
    float acc[8] = {0.f, 0.f, 0.f, 0.f, 0.f, 0.f, 0.f, 0.f};
    for (int slot = 0; slot < nsel; ++slot) {
        const float v = bf2f(kva[(size_t)(b * SEQ + list[slot]) * 128 + 64 + lane]);
#pragma unroll
        for (int h = 0; h < 8; ++h) acc[h] += pb[h * 256 + slot] * v;
    }
    bf16* ya = (bf16*)(ws + WS_QA) + (size_t)row * 512;
#pragma unroll
    for (int h = 0; h < 8; ++h) ya[h * 64 + lane] = (bf16)f2bf(acc[h] * linv[h]);
    WAVE_LDS_SYNC();
}
typedef short s16x4 __attribute__((ext_vector_type(4)));
typedef short v4i16_t __attribute__((ext_vector_type(4)));
typedef float f32x4v __attribute__((ext_vector_type(4)));
typedef __bf16 bf16x2_t __attribute__((ext_vector_type(2)));
typedef float f32x2_t __attribute__((ext_vector_type(2)));
__device__ __forceinline__ unsigned cvtpk(float lo, float hi) { f32x2_t v = {lo, hi}; bf16x2_t b = __builtin_convertvector(v, bf16x2_t); return __builtin_bit_cast(unsigned, b); }
constexpr float L2E = 1.4426950408889634f;
#ifndef NSA_NOSKIP
#define NSA_NOSKIP 0
#endif
constexpr int NSA_KSTR = 72, NSA_VSTR = 80;
constexpr int NSA_KB = 64 * NSA_KSTR * 2, NSA_VB = 64 * NSA_VSTR * 2;
constexpr int NSA_D = 6, NSA_SLOT = 16384;
constexpr int NSA_OFF_RING = 0, NSA_OFF_KCL = 0, NSA_OFF_VCTL = 32768  , NSA_OFF_IMPA = 65536  , NSA_OFF_IMPB = NSA_OFF_IMPA + 64 * 65 * 4, NSA_OFF_UM = NSA_D * NSA_SLOT + 1024  , NSA_OFF_QM = NSA_OFF_UM + 64, NSA_OFF_ST = NSA_OFF_UM + 1024, NSA_LDS = NSA_OFF_ST + 512 * 64;
__device__ __forceinline__ s16x4 tr16(const LAS unsigned char* p) { return __builtin_bit_cast(s16x4, __builtin_amdgcn_ds_read_tr16_b64_v4i16((LAS v4i16_t*)p)); }
__device__ __forceinline__ bf16x8 cat4(s16x4 a, s16x4 b) { return __builtin_shufflevector(a, b, 0, 1, 2, 3, 4, 5, 6, 7); }
__device__ __forceinline__ bf16x8 pack8(float a0, float a1, float a2, float a3, float b0, float b1, float b2, float b3) {
    v4u w; w.x = pg8::cvt_pk_bf16(a0, a1); w.y = pg8::cvt_pk_bf16(a2, a3); w.z = pg8::cvt_pk_bf16(b0, b1); w.w = pg8::cvt_pk_bf16(b2, b3); return __builtin_bit_cast(bf16x8, w);
}
__device__ __forceinline__ float xmax16(float v) { v = fmaxf(v, __shfl_xor(v, 16)); return fmaxf(v, __shfl_xor(v, 32)); }
__device__ __forceinline__ float xsum16(float v) { v += __shfl_xor(v, 16); return v + __shfl_xor(v, 32); }

__device__ __forceinline__ void nsa_fetch(const bf16* kv, int b, int jb, int g, int tid, v4u& kr, v4u& vr) {
    const bf16* p = kv + (size_t)(b * SEQ + 64 * jb + (tid >> 3)) * 256 + g * 64 + (tid & 7) * 8;
    kr = *(const v4u*)p; vr = *(const v4u*)(p + 128);
}
__device__ __forceinline__ void nsa_stash(LAS unsigned char* Kb, LAS unsigned char* Vb, int tid, const v4u& kr, const v4u& vr) {
    *(LAS v4u*)(Kb + ((tid >> 3) * NSA_KSTR + (tid & 7) * 8) * 2) = kr; *(LAS v4u*)(Vb + ((tid >> 3) * NSA_VSTR + (tid & 7) * 8) * 2) = vr;
}
template <bool FULL>
__device__ __forceinline__ void nsa_block2(const LAS unsigned char* Kb, const LAS unsigned char* Vb, const bf16x8 (&qf)[2][2], const bool (&sel)[2], const int (&klo)[2], const int (&khi)[2],
                                           float (&mrow)[2], float (&lrow)[2], f32x4v (&o)[2][4], int lane) {
    const int j = lane & 15, gq = lane >> 4;
    f32x4v s[2][4];
#pragma unroll
    for (int kt = 0; kt < 4; ++kt) {
        s[0][kt] = (f32x4v){0.f, 0.f, 0.f, 0.f}; s[1][kt] = (f32x4v){0.f, 0.f, 0.f, 0.f};
#pragma unroll
        for (int ks = 0; ks < 2; ++ks) {
            const bf16x8 kf = *(const LAS bf16x8*)(Kb + (16 * kt + j) * 128 + (((gq + 4 * ks) ^ (j & 7)) << 4));
            s[0][kt] = __builtin_amdgcn_mfma_f32_16x16x32_bf16(kf, qf[0][ks], s[0][kt], 0, 0, 0);
            s[1][kt] = __builtin_amdgcn_mfma_f32_16x16x32_bf16(kf, qf[1][ks], s[1][kt], 0, 0, 0);
        }
    }
#pragma unroll
    for (int rg = 0; rg < 2; ++rg) {
        float bm = NEGF;
        if (FULL) { const float bias = sel[rg] ? 0.f : NEGF;
#pragma unroll
            for (int kt = 0; kt < 4; ++kt)
#pragma unroll
                for (int e = 0; e < 4; ++e) { const float v = s[rg][kt][e] + bias; s[rg][kt][e] = v; bm = fmaxf(bm, v); }
        } else {
#pragma unroll
            for (int kt = 0; kt < 4; ++kt)
#pragma unroll
                for (int e = 0; e < 4; ++e) { const int ko = 16 * kt + 4 * gq + e; const bool ok = sel[rg] && ko >= klo[rg] && ko <= khi[rg]; const float v = ok ? s[rg][kt][e] : NEGF; s[rg][kt][e] = v; bm = fmaxf(bm, v); }
        }
        bm = xmax16(bm);
        const float mnew = fmaxf(mrow[rg], bm), alpha = __builtin_amdgcn_exp2f(mrow[rg] - mnew);
        const bool moved = __builtin_amdgcn_ballot_w64(mnew != mrow[rg]) != 0ull;
        mrow[rg] = mnew;
        float ps = 0.f;
#pragma unroll
        for (int kt = 0; kt < 4; ++kt)
#pragma unroll
            for (int e = 0; e < 4; ++e) { const float p = __builtin_amdgcn_exp2f(s[rg][kt][e] - mnew); s[rg][kt][e] = p; ps += p; }
        lrow[rg] = lrow[rg] * alpha + ps;
        if (moved) {
#pragma unroll
            for (int dt = 0; dt < 4; ++dt) o[rg][dt] *= alpha;
        }
    }
#pragma unroll
    for (int kk = 0; kk < 2; ++kk) {
        const bf16x8 pf0 = pack8(s[0][2 * kk][0], s[0][2 * kk][1], s[0][2 * kk][2], s[0][2 * kk][3], s[0][2 * kk + 1][0], s[0][2 * kk + 1][1], s[0][2 * kk + 1][2], s[0][2 * kk + 1][3]);
        const bf16x8 pf1 = pack8(s[1][2 * kk][0], s[1][2 * kk][1], s[1][2 * kk][2], s[1][2 * kk][3], s[1][2 * kk + 1][0], s[1][2 * kk + 1][1], s[1][2 * kk + 1][2], s[1][2 * kk + 1][3]);
#pragma unroll
        for (int dt = 0; dt < 4; ++dt) {
            const LAS unsigned char* va = Vb + (32 * kk + 4 * gq + (j >> 2)) * 128 + (16 * dt + 4 * (j & 3)) * 2;
            const bf16x8 vf = cat4(tr16(va), tr16(va + 16 * 128));
            o[0][dt] = __builtin_amdgcn_mfma_f32_16x16x32_bf16(vf, pf0, o[0][dt], 0, 0, 0);
            o[1][dt] = __builtin_amdgcn_mfma_f32_16x16x32_bf16(vf, pf1, o[1][dt], 0, 0, 0);
        }
        }
}
__device__ __forceinline__ void glds16(const void* gsrc, unsigned lds_dst) { unsigned keep;
    asm volatile("s_mov_b32 %0, m0\n\ts_mov_b32 m0, %2\n\ts_nop 0\n\tglobal_load_lds_dwordx4 %1, off\n\ts_mov_b32 m0, %0" : "=&s"(keep) : "v"(gsrc), "s"(lds_dst) : "memory"); }
template <int MODE>
__device__ __forceinline__ void nsa_attend(const bf16* kv, unsigned long long mask, int b, int g, int c, int tid, int lane, LAS unsigned char* ring, const bf16x8 (&qf)[2][2],
                                           const unsigned long long (&rmask)[2], const unsigned long long (&gmask)[2], const int (&trow)[2], float (&mrow)[2], float (&lrow)[2], f32x4v (&o)[2][4]) {
    const int wave = __builtin_amdgcn_readfirstlane(tid >> 6);
    const int rr = 8 * wave + (lane >> 3);
    const bf16* gk = kv + (size_t)(b * SEQ + rr) * 256 + g * 64 + (((lane & 7) ^ (rr & 7)) << 3);
    const bf16* gv = kv + (size_t)(b * SEQ + rr) * 256 + 128 + g * 64 + ((lane & 7) << 3);
    const unsigned ring0 = (unsigned)(uintptr_t)(unsigned char*)ring + wave * 1024;
#define NSA_ISSUE(jb_, slot_) do { glds16(gk + (size_t)(jb_) * 64 * 256, (unsigned)__builtin_amdgcn_readfirstlane(ring0 + (slot_) * NSA_SLOT)); \
                                   glds16(gv + (size_t)(jb_) * 64 * 256, (unsigned)__builtin_amdgcn_readfirstlane(ring0 + (slot_) * NSA_SLOT + 8192)); } while (0)
    unsigned long long remi = mask, remc = mask; int lastb = 0, si = 0, sc_ = 0;
#if DUP == 12
    float m2_[2] = {NEGF, NEGF}, l2_[2] = {0.f, 0.f}; f32x4v o2_[2][4]; for (int rg = 0; rg < 2; ++rg) for (int dt = 0; dt < 4; ++dt) o2_[rg][dt] = (f32x4v){0.f, 0.f, 0.f, 0.f};
#endif
#pragma unroll
    for (int d = 0; d < NSA_D - 1; ++d) { if (remi) { lastb = (int)__builtin_ctzll(remi); remi &= remi - 1ull; } NSA_ISSUE(lastb, si); si = si + 1 == NSA_D ? 0 : si + 1; }
    while (remc) {
        const int jj = (int)__builtin_ctzll(remc); remc &= remc - 1ull;
        asm volatile("s_waitcnt vmcnt(8) lgkmcnt(0)\n\ts_barrier" ::: "memory");
        if (remi) { lastb = (int)__builtin_ctzll(remi); remi &= remi - 1ull; }
        NSA_ISSUE(lastb, si); si = si + 1 == NSA_D ? 0 : si + 1;
        const LAS unsigned char* kb_ = ring + sc_ * NSA_SLOT; const LAS unsigned char* vb_ = kb_ + 8192; sc_ = sc_ + 1 == NSA_D ? 0 : sc_ + 1;
        bool sel[2]; int klo[2], khi[2]; bool act[2];
#pragma unroll
        for (int rg = 0; rg < 2; ++rg) { const int o6 = trow[rg] & 63;
            if (MODE == 0) { sel[rg] = (rmask[rg] >> jj) & 1ull; act[rg] = (gmask[rg] >> jj) & 1ull; klo[rg] = 0; khi[rg] = (jj == c) ? o6 : 63; }
            else { sel[rg] = true; act[rg] = true; klo[rg] = (jj == c - 4) ? o6 + 1 : 0; khi[rg] = (jj == c) ? o6 : 63; } }
        if (act[0] || act[1]) {
            const bool full = (MODE == 0) ? (jj != c) : (jj != c && jj != c - 4);
            if (full) nsa_block2<true>(kb_, vb_, qf, sel, klo, khi, mrow, lrow, o, lane); else nsa_block2<false>(kb_, vb_, qf, sel, klo, khi, mrow, lrow, o, lane);
#if DUP == 12
            if (full) nsa_block2<true>(kb_, vb_, qf, sel, klo, khi, m2_, l2_, o2_, lane); else nsa_block2<false>(kb_, vb_, qf, sel, klo, khi, m2_, l2_, o2_, lane);
#endif
        }
    }
#if DUP == 12
    { float acc_ = 0.f; for (int rg = 0; rg < 2; ++rg) { acc_ += l2_[rg] + m2_[rg]; for (int dt = 0; dt < 4; ++dt) acc_ += o2_[rg][dt][0] + o2_[rg][dt][1] + o2_[rg][dt][2] + o2_[rg][dt][3]; } if (acc_ == 123.456f) ((LAS float*)(ring + NSA_D * NSA_SLOT + 600))[0] = acc_; }
#endif
    asm volatile("s_waitcnt vmcnt(0) lgkmcnt(0)\n\ts_barrier" ::: "memory");
#undef NSA_ISSUE
}
#if defined(PROBE_CMP)
__device__ __forceinline__ void nsa_probe_store(unsigned char* ws, int row, int head, int gq, const f32x4v (&v)[4]) {
    bf16* pb_ = (bf16*)(ws + 497 * MiB);
    for (int dt = 0; dt < 4; ++dt) { uint2 w; w.x = cvtpk(v[dt][0], v[dt][1]); w.y = cvtpk(v[dt][2], v[dt][3]); *(uint2*)(pb_ + (size_t)row * 512 + head * 64 + 16 * dt + 4 * gq) = w; }
}
#endif
__device__ __forceinline__ void nsa_unit(unsigned char* ws, int unit, LAS unsigned char* lds, int tid_in, bf16* yout) {
    int tid = tid_in; asm volatile("" : "+v"(tid));
    const int lane = tid & 63, wave = __builtin_amdgcn_readfirstlane(tid >> 6), j = lane & 15, gq = lane >> 4;
    const int c = unit & 63, g = (unit >> 6) & 1, b = unit >> 7, bg = b * 2 + g;
    LAS float* impa = (LAS float*)(lds + NSA_OFF_IMPA); LAS float* impb = (LAS float*)(lds + NSA_OFF_IMPB);
    LAS unsigned long long* um = (LAS unsigned long long*)(lds + NSA_OFF_UM);
    TP_DECL
    for (int i = tid; i < 2 * 64 * 65; i += 512) impa[i] = 0.f;
    {
        const v4u* ksrc = (const v4u*)((const bf16*)(ws + WS_KC) + (size_t)bg * 256 * 64); const v4u* vsrc = (const v4u*)((const bf16*)(ws + WS_VC) + (size_t)bg * 64 * 256);
        v4u kst[4], vst[4];
#pragma unroll
        for (int i = 0; i < 4; ++i) { kst[i] = ksrc[tid + 512 * i]; vst[i] = vsrc[tid + 512 * i]; }
#pragma unroll
        for (int i = 0; i < 4; ++i) { const int idx = tid + 512 * i; const int r = idx >> 3, sg = idx & 7; *(LAS v4u*)(lds + NSA_OFF_KCL + r * 128 + ((sg ^ (r & 7)) << 4)) = kst[i]; }
#pragma unroll
        for (int i = 0; i < 4; ++i) { const int idx = tid + 512 * i; const int r = idx >> 5, sg = idx & 31; *(LAS v4u*)(lds + NSA_OFF_VCTL + r * 512 + ((sg ^ (r & 15)) << 4)) = vst[i]; }
    }
    bf16* qc = (bf16*)(ws + WS_QC);
    const bf16* misc = (const bf16*)(ws + WS_MISC);
    bf16x8 qf[2][2]; float gate[2][3]; int trow[2];
#pragma unroll
    for (int rg = 0; rg < 2; ++rg) {
        const int q = 8 * wave + 4 * rg + (j >> 2), t = 64 * c + q, row = b * SEQ + t, head = g * 4 + (j & 3);
        trow[rg] = t;
#pragma unroll
        for (int ks = 0; ks < 2; ++ks) qf[rg][ks] = *(const bf16x8*)(qc + (size_t)row * 512 + head * 64 + 8 * gq + 32 * ks);
#pragma unroll
        for (int e = 0; e < 3; ++e) gate[rg][e] = __builtin_amdgcn_rcpf(1.0f + __expf(-bf2f(misc[(size_t)row * 256 + 196 + head * 3 + e])));
    }
    typedef unsigned u32x2v __attribute__((ext_vector_type(2)));
    LAS u32x2v* stash = (LAS u32x2v*)(lds + NSA_OFF_ST) + tid * 8;
    __syncthreads();
    const int nT = (c >> 2) + 1;
#pragma unroll
    for (int rg = 0; rg < 2; ++rg) {
        const int t = trow[rg], nv = t >= 31 ? ((t - 15) >> 4) : 0;
        f32x4v s[16]; float mx = NEGF;
#pragma unroll
        for (int T = 0; T < 16; ++T) {
            s[T] = (f32x4v){0.f, 0.f, 0.f, 0.f};
            if (T < nT) {
#pragma unroll
                for (int ks = 0; ks < 2; ++ks) { const bf16x8 kf = *(const LAS bf16x8*)(lds + NSA_OFF_KCL + (16 * T + j) * 128 + (((gq + 4 * ks) ^ (j & 7)) << 4)); s[T] = __builtin_amdgcn_mfma_f32_16x16x32_bf16(kf, qf[rg][ks], s[T], 0, 0, 0); }
#pragma unroll
                for (int e = 0; e < 4; ++e) { const float v = (16 * T + 4 * gq + e < nv) ? s[T][e] : NEGF; s[T][e] = v; mx = fmaxf(mx, v); }
            }
        }
        mx = xmax16(mx);
        float ls = 0.f;
#pragma unroll
        for (int T = 0; T < 16; ++T) if (T < nT) {
#pragma unroll
            for (int e = 0; e < 4; ++e) { const float p = (16 * T + 4 * gq + e < nv) ? __builtin_amdgcn_exp2f(s[T][e] - mx) : 0.f; s[T][e] = p; ls += p; }
        }
        ls = xsum16(ls);
        const float inv = nv > 0 ? __builtin_amdgcn_rcpf(ls) : 0.f;
        const int q = 8 * wave + 4 * rg + (j >> 2);
#pragma unroll
        for (int T = 0; T < 16; ++T) if (T < nT) {
#pragma unroll
            for (int e = 0; e < 4; ++e) s[T][e] *= inv;
            float a = s[T][0] + s[T][1] + s[T][2] + 0.5f * s[T][3], bb = 0.5f * s[T][3];
            a += __shfl_xor(a, 1); a += __shfl_xor(a, 2); bb += __shfl_xor(bb, 1); bb += __shfl_xor(bb, 2);
            if ((j & 3) == 0) { impa[q * 65 + 4 * T + gq] = a; impb[q * 65 + 4 * T + gq + 1] = bb; }
        }
        f32x4v oc[4];
#pragma unroll
        for (int dt = 0; dt < 4; ++dt) oc[dt] = (f32x4v){0.f, 0.f, 0.f, 0.f};
#pragma unroll
        for (int kk = 0; kk < 8; ++kk) if (2 * kk < nT) {
            const bf16x8 pf = pack8(s[2 * kk][0], s[2 * kk][1], s[2 * kk][2], s[2 * kk][3], s[2 * kk + 1][0], s[2 * kk + 1][1], s[2 * kk + 1][2], s[2 * kk + 1][3]);
#pragma unroll
            for (int dt = 0; dt < 4; ++dt) {
                const LAS unsigned char* vp = lds + NSA_OFF_VCTL + (16 * dt + j) * 512 + (gq & 1) * 8;
                const s16x4 v0 = *(const LAS s16x4*)(vp + ((((8 * kk + gq) >> 1) ^ j) << 4)), v1 = *(const LAS s16x4*)(vp + (((((8 * kk + gq) >> 1) + 2) ^ j) << 4));
                oc[dt] = __builtin_amdgcn_mfma_f32_16x16x32_bf16(cat4(v0, v1), pf, oc[dt], 0, 0, 0);
            }
        }
#pragma unroll
        for (int dt = 0; dt < 4; ++dt) { const f32x4v v = oc[dt] * gate[rg][0]; u32x2v w; w.x = pg8::cvt_pk_bf16(v[0], v[1]); w.y = pg8::cvt_pk_bf16(v[2], v[3]); stash[rg * 4 + dt] = w; }
        __builtin_amdgcn_sched_barrier(0);
    }
    __syncthreads();
    TP_MARK(5);
    unsigned long long smask[8], mymask = 0ull;
#pragma unroll
    for (int qi = 0; qi < 8; ++qi) {
        const int q = 8 * wave + qi;
#if PROBE == 4
        const float imp = ((const float*)(ws + 500 * MiB))[((size_t)(b * SEQ + 64 * c + q) * 2 + g) * 64 + lane];
#else
        const float imp = impa[q * 65 + lane] + impb[q * 65 + lane];
#endif
#if PROBE && (PROBE != 5 || defined(PROBE5_IMP))
        ((float*)(ws + 516 * MiB))[((size_t)(b * SEQ + 64 * c + q) * 2 + g) * 64 + lane] = (lane <= c) ? imp : 0.f;
#endif
        const bool forced = (lane == 0) || (lane == c), adm = lane <= c;
        unsigned key = forced ? (0xFFFFFF00u | (unsigned)(63 - lane)) : (adm ? ((__float_as_uint(imp) & 0xFFFFFFC0u) | (unsigned)(63 - lane)) : 0u);
        unsigned long long mk = 0ull;
#if TOP8_RANK
        { int rank = 0;
#pragma unroll
          for (int jj = 0; jj < 64; ++jj) { const unsigned kk = (unsigned)__builtin_amdgcn_readlane((int)key, jj); rank += (kk > key) ? 1 : 0; }
          mk = __ballot(key != 0u && rank < 8); }
#else
        for (int k = 0; k < 8; ++k) { const unsigned mx = wave_max_u(key); if (mx == 0u) break; const int win = 63 - (int)(mx & 63u); mk |= 1ull << win; if (lane == win) key = 0u; }
#endif
        mk = ((unsigned long long)(unsigned)__builtin_amdgcn_readfirstlane((unsigned)(mk >> 32)) << 32) | (unsigned long long)(unsigned)__builtin_amdgcn_readfirstlane((unsigned)mk);
#ifdef FIXSEL
        { mk = 1ull | (1ull << c); for (int d = 1; d <= 6; ++d) mk |= 1ull << (((FIXHOM ? 0 : q * 7) + d * 5) % (c + 1)); }
#endif
#if PROBE == 2
        mk = ((const unsigned long long*)(ws + 496 * MiB))[(size_t)(b * SEQ + 64 * c + q) * 2 + g];
        mk = ((unsigned long long)(unsigned)__builtin_amdgcn_readfirstlane((unsigned)(mk >> 32)) << 32) | (unsigned long long)(unsigned)__builtin_amdgcn_readfirstlane((unsigned)mk);
#endif
#if PROBE == 5
        if (lane == 0) ((unsigned long long*)(ws + 498 * MiB))[(size_t)(b * SEQ + 64 * c + q) * 2 + g] = mk;
#endif
#if PROBE == 5 && !defined(PROBE5_IMP)
        ((float*)(ws + 516 * MiB))[((size_t)(b * SEQ + 64 * c + q) * 2 + g) * 64 + lane] = ((mk >> lane) & 1ull) ? 1.f : 0.f;
#endif
        smask[qi] = mk; mymask |= mk;
    }
    if (lane == 0) um[wave] = mymask;
    __syncthreads();
    unsigned long long umask = 0ull;
#pragma unroll
    for (int w = 0; w < 8; ++w) umask |= um[w];
    umask = ((unsigned long long)(unsigned)__builtin_amdgcn_readfirstlane((unsigned)(umask >> 32)) << 32) | (unsigned long long)(unsigned)__builtin_amdgcn_readfirstlane((unsigned)umask);
    unsigned long long rmask[2];
    { LAS unsigned long long* qm = (LAS unsigned long long*)(lds + NSA_OFF_QM);
      __syncthreads();
#pragma unroll
      for (int qi = 0; qi < 8; ++qi) if (lane == 0) qm[8 * wave + qi] = smask[qi];
      __syncthreads();
#pragma unroll
      for (int rg = 0; rg < 2; ++rg) rmask[rg] = qm[8 * wave + 4 * rg + (j >> 2)]; }
    const unsigned long long gmask[2] = {smask[0] | smask[1] | smask[2] | smask[3], smask[4] | smask[5] | smask[6] | smask[7]};
    TP_MARK(6); TP_ADD(9, __popcll(umask)); TP_ADD(10, 1); TP_ADD(11, c + 1); TP_ADD(12, __popcll(umask & ~(c == 63 ? ~0ull : ((2ull << c) - 1ull)))); TP_ADD(13, __popcll(smask[0]));
    const bf16* kvs = (const bf16*)(ws + WS_KVS); const bf16* kvw = (const bf16*)(ws + WS_KVW);
    LAS unsigned char* ring = lds + NSA_OFF_RING;
    {
        float mrow[2] = {NEGF, NEGF}, lrow[2] = {0.f, 0.f}; f32x4v o[2][4];
#pragma unroll
        for (int rg = 0; rg < 2; ++rg)
#pragma unroll
            for (int dt = 0; dt < 4; ++dt) o[rg][dt] = (f32x4v){0.f, 0.f, 0.f, 0.f};
        nsa_attend<0>(kvs, umask, b, g, c, tid, lane, ring, qf, rmask, gmask, trow, mrow, lrow, o);
#if DUP == 8
        { __syncthreads(); float m2[2] = {NEGF, NEGF}, l2[2] = {0.f, 0.f}; f32x4v o2[2][4];
          for (int rg = 0; rg < 2; ++rg) for (int dt = 0; dt < 4; ++dt) o2[rg][dt] = (f32x4v){0.f, 0.f, 0.f, 0.f};
          nsa_attend<0>(kvs, umask, b, g, c, tid, lane, Kb, Vb, qf, rmask, gmask, trow, m2, l2, o2);
          bf16* dmy = (bf16*)(ws + WS_BU) + (size_t)(b * SEQ + trow[0]) * 512 + (g * 4 + (j & 3)) * 64 + 4 * gq;
          for (int rg = 0; rg < 2; ++rg) for (int dt = 0; dt < 4; ++dt) { uint2 w; w.x = pg8::cvt_pk_bf16(o2[rg][dt][0] + l2[rg], o2[rg][dt][1]); w.y = pg8::cvt_pk_bf16(o2[rg][dt][2], o2[rg][dt][3]); *(uint2*)(dmy + 16 * dt) = w; } }
#endif
#pragma unroll
        for (int rg = 0; rg < 2; ++rg) { const float sc = gate[rg][1] * __builtin_amdgcn_rcpf(xsum16(lrow[rg]));
#pragma unroll
            for (int dt = 0; dt < 4; ++dt) { const u32x2v p = stash[rg * 4 + dt]; const f32x4v v = o[rg][dt] * sc; u32x2v w; w.x = pg8::cvt_pk_bf16(v[0] + bflo(p.x), v[1] + bfhi(p.x)); w.y = pg8::cvt_pk_bf16(v[2] + bflo(p.y), v[3] + bfhi(p.y)); stash[rg * 4 + dt] = w; }
            }
        __syncthreads();
    }
    TP_MARK(7);
    {
        float mrow[2] = {NEGF, NEGF}, lrow[2] = {0.f, 0.f}; f32x4v o[2][4];
#pragma unroll
        for (int rg = 0; rg < 2; ++rg)
#pragma unroll
            for (int dt = 0; dt < 4; ++dt) o[rg][dt] = (f32x4v){0.f, 0.f, 0.f, 0.f};
        { const int j0 = c - 4 > 0 ? c - 4 : 0; const unsigned long long wmask = ((c == 63 ? ~0ull : ((1ull << (c + 1)) - 1ull)) >> j0) << j0;
          nsa_attend<1>(kvw, wmask, b, g, c, tid, lane, ring, qf, rmask, gmask, trow, mrow, lrow, o); }
#pragma unroll
        for (int rg = 0; rg < 2; ++rg) { const float sc = gate[rg][2] * __builtin_amdgcn_rcpf(xsum16(lrow[rg]));
#pragma unroll
            for (int dt = 0; dt < 4; ++dt) { const u32x2v p = stash[rg * 4 + dt]; const f32x4v v = o[rg][dt] * sc; uint2 w; w.x = pg8::cvt_pk_bf16(v[0] + bflo(p.x), v[1] + bfhi(p.x)); w.y = pg8::cvt_pk_bf16(v[2] + bflo(p.y), v[3] + bfhi(p.y));
                *(uint2*)(yout + (size_t)(b * SEQ + trow[rg]) * 512 + (g * 4 + (j & 3)) * 64 + 16 * dt + 4 * gq) = w; }
            }
    }
    __syncthreads();
    TP_MARK(8);
}
__device__ __forceinline__ void prep_kva16(unsigned char* ws, int task, int lane) {
    const int j = lane & 15, gq = lane >> 4, row = task * 16 + j;
    const bf16* misc = (const bf16*)(ws + WS_MISC) + (size_t)row * 256 + 64;
    const bf16* wu = (const bf16*)(ws + WS_W + WO_UKV);
    bf16x8 cf[4]; float ss = 0.f;
#pragma unroll
    for (int ks = 0; ks < 4; ++ks) { const v4u v = *(const v4u*)(misc + 8 * gq + 32 * ks); cf[ks] = __builtin_bit_cast(bf16x8, v); float f[8]; unpack8(v, f);
#pragma unroll
        for (int e = 0; e < 8; ++e) ss += f[e] * f[e]; }
    ss = xsum16(ss);
    const float r = 1.0f / sqrtf(ss * (1.f / 128.f) + EPS);
    const float* rp = (const float*)(ws + WS_ROPE) + (size_t)row * 16;
    bf16* o = (bf16*)(ws + WS_KVA) + (size_t)row * 128;
#pragma unroll
    for (int ct = 0; ct < 8; ++ct) {
        f32x4v a = {0.f, 0.f, 0.f, 0.f};
#pragma unroll
        for (int ks = 0; ks < 4; ++ks) { const bf16x8 wf = *(const bf16x8*)(wu + (size_t)(16 * ct + j) * 128 + 8 * gq + 32 * ks); a = __builtin_amdgcn_mfma_f32_16x16x32_bf16(wf, cf[ks], a, 0, 0, 0); }
        a *= r;
        if (ct == 0) {
            const float c0 = rp[2 * gq], s0 = rp[8 + 2 * gq], c1 = rp[2 * gq + 1], s1 = rp[8 + 2 * gq + 1];
            const float x0 = a[0], x1 = a[1], x2 = a[2], x3 = a[3];
            a[0] = x0 * c0 - x1 * s0; a[1] = x1 * c0 + x0 * s0; a[2] = x2 * c1 - x3 * s1; a[3] = x3 * c1 + x2 * s1;
        }
        uint2 w; w.x = cvtpk(a[0], a[1]); w.y = cvtpk(a[2], a[3]);
        *(uint2*)(o + 16 * ct + 4 * gq) = w;
    }
}
__device__ __forceinline__ void prep_pool16(unsigned char* ws, int task, int lane, const LAS unsigned char* wl, bf16* ybuf) {
    const int j = lane & 15, gq = lane >> 4, row = task * 16 + j, t = row & (SEQ - 1);
    const bf16* bu = (const bf16*)(ws + WS_BU);
    bf16* yb = ybuf + (size_t)row * 512;
#pragma unroll 1
    for (int g = 0; g < 4; ++g) {
        const int w = 2 << g, lo = (t + 1 - w) > 0 ? (t + 1 - w) : 0, cnt = t + 1 - lo; const float inv = 1.0f / (float)cnt;
        bf16x8 pf[4];
#pragma unroll
        for (int ks = 0; ks < 4; ++ks) {
            const bf16* p = bu + (size_t)row * 512 + g * 128 + 8 * gq + 32 * ks;
            float sum[8] = {0.f, 0.f, 0.f, 0.f, 0.f, 0.f, 0.f, 0.f}, cur[8];
            { const v4u v = *(const v4u*)p; unpack8(v, cur);
#pragma unroll
              for (int e = 0; e < 8; ++e) sum[e] = cur[e]; }
            v4u wv_[15];
#pragma unroll
            for (int i = 1; i < 16; ++i) if (i < w) wv_[i - 1] = *(const v4u*)(p - (size_t)(i < cnt ? i : 0) * 512);
#pragma unroll
            for (int i = 1; i < 16; ++i) if (i < w) { const bool ok = i < cnt; float f[8]; unpack8(wv_[i - 1], f);
#pragma unroll
                for (int e = 0; e < 8; ++e) sum[e] += ok ? f[e] : 0.f; }
            __builtin_amdgcn_sched_barrier(0);
            pf[ks] = pack8(sum[0] * inv - cur[0], sum[1] * inv - cur[1], sum[2] * inv - cur[2], sum[3] * inv - cur[3], sum[4] * inv - cur[4], sum[5] * inv - cur[5], sum[6] * inv - cur[6], sum[7] * inv - cur[7]);
        }
#pragma unroll
        for (int dt = 0; dt < 8; ++dt) {
            f32x4v a = {0.f, 0.f, 0.f, 0.f};
#pragma unroll
            for (int ks = 0; ks < 4; ++ks) {
#if POOLDBG == 1
                bf16x8 wf; for (int e = 0; e < 8; ++e) wf[e] = (short)0x3c00;
#else
                const bf16x8 wf = *(const LAS bf16x8*)(wl + (g * 128 + 16 * dt + j) * 256 + (((gq + 4 * ks) ^ j) << 4));
#endif
#if POOLDBG == 2
                bf16x8 pz; for (int e = 0; e < 8; ++e) pz[e] = (short)0x3c00; a = __builtin_amdgcn_mfma_f32_16x16x32_bf16(wf, pz, a, 0, 0, 0);
#else
                a = __builtin_amdgcn_mfma_f32_16x16x32_bf16(wf, pf[ks], a, 0, 0, 0);
#endif
            }
            uint2 wv; wv.x = cvtpk(a[0], a[1]); wv.y = cvtpk(a[2], a[3]);
            *(uint2*)(yb + g * 128 + 16 * dt + 4 * gq) = wv;
        }
    }
}
__device__ __forceinline__ float gelu_tanh_f(float x) { const float u = 0.7978845608028654f * (x + 0.044715f * x * x * x); const float e = __expf(2.0f * u); return 0.5f * x * (1.0f + (1.0f - 2.0f / (e + 1.0f))); }
__device__ __forceinline__ void prep_cmp16(unsigned char* ws, int task, LAS unsigned char* lds, int wave, int lane) {
    const int j = lane & 15, gq = lane >> 4, grp = wave >> 2, wq = wave & 3;
    const int i0 = (task & 15) * 16, bg = (task >> 4) & 15, br = task >> 8, b = bg >> 1, g = bg & 1, i = i0 + j;
    const bf16* kvc = (const bf16*)(ws + WS_KVC);
    const bf16* w1 = (const bf16*)(ws + WS_W + WO_CW1) + (size_t)br * 128 * 2048;
    const bf16* w2 = (const bf16*)(ws + WS_W + WO_CW2) + (size_t)br * 64 * 128;
    const float* posb = (const float*)(ws + WS_W + WO_POSB) + br * 128;
    LAS float* part = (LAS float*)lds + (size_t)grp * 4 * 32 * 64;
    f32x4v h[8];
#pragma unroll
    for (int nt = 0; nt < 8; ++nt) h[nt] = (f32x4v){0.f, 0.f, 0.f, 0.f};
#define CMP_LOAD(k2_, wf_, ff_) do { const int ks_ = 16 * wq + (k2_), l_ = ks_ >> 1; int tok_ = 16 * i + l_; tok_ = tok_ > SEQ - 1 ? SEQ - 1 : tok_;     \
        ff_ = *(const bf16x8*)(kvc + (size_t)(b * SEQ + tok_) * 256 + br * 128 + g * 64 + 32 * (ks_ & 1) + 8 * gq); \
        _Pragma("unroll") for (int nt_ = 0; nt_ < 8; ++nt_) wf_[nt_] = *(const bf16x8*)(w1 + (size_t)(16 * nt_ + j) * 2048 + 32 * ks_ + 8 * gq); } while (0)
    bf16x8 wfA[8], wfB[8], ffA, ffB;
    CMP_LOAD(0, wfA, ffA);
#pragma unroll
    for (int k2 = 0; k2 < 16; k2 += 2) {
        CMP_LOAD(k2 + 1, wfB, ffB);
        __builtin_amdgcn_sched_barrier(0);
#pragma unroll
        for (int nt = 0; nt < 8; ++nt) h[nt] = __builtin_amdgcn_mfma_f32_16x16x32_bf16(wfA[nt], ffA, h[nt], 0, 0, 0);
        if (k2 + 2 < 16) CMP_LOAD(k2 + 2, wfA, ffA);
        __builtin_amdgcn_sched_barrier(0);
#pragma unroll
        for (int nt = 0; nt < 8; ++nt) h[nt] = __builtin_amdgcn_mfma_f32_16x16x32_bf16(wfB[nt], ffB, h[nt], 0, 0, 0);
    }
#undef CMP_LOAD
#pragma unroll
    for (int nt = 0; nt < 8; ++nt)
#pragma unroll
        for (int e = 0; e < 4; ++e) part[(wq * 32 + nt * 4 + e) * 64 + lane] = h[nt][e];
    f32x4v pbv_[8];
#pragma unroll
    for (int nt = 0; nt < 8; ++nt) pbv_[nt] = *(const f32x4v*)(posb + 16 * nt + 4 * gq);
    __syncthreads();
    if (wq == 0) {
#pragma unroll
        for (int nt = 0; nt < 8; ++nt) { const f32x4v pbv = pbv_[nt];
#pragma unroll
            for (int e = 0; e < 4; ++e) { const int idx = (nt * 4 + e) * 64 + lane; h[nt][e] = gelu_tanh_f(((part[idx] + part[32 * 64 + idx]) + (part[2 * 32 * 64 + idx] + part[3 * 32 * 64 + idx])) + pbv[e]); } }
        f32x4v o[4];
#pragma unroll
        for (int dt = 0; dt < 4; ++dt) o[dt] = (f32x4v){0.f, 0.f, 0.f, 0.f};
        s16x4 w2a[4][4], w2b[4][4];
#pragma unroll
        for (int kk = 0; kk < 4; ++kk)
#pragma unroll
            for (int dt = 0; dt < 4; ++dt) { const bf16* wp = w2 + (size_t)(16 * dt + j) * 128 + 32 * kk + 4 * gq; w2a[kk][dt] = *(const s16x4*)wp; w2b[kk][dt] = *(const s16x4*)(wp + 16); }
        __builtin_amdgcn_sched_barrier(0);
#pragma unroll
        for (int kk = 0; kk < 4; ++kk) {
            const bf16x8 hf = pack8(h[2 * kk][0], h[2 * kk][1], h[2 * kk][2], h[2 * kk][3], h[2 * kk + 1][0], h[2 * kk + 1][1], h[2 * kk + 1][2], h[2 * kk + 1][3]);
#pragma unroll
            for (int dt = 0; dt < 4; ++dt) o[dt] = __builtin_amdgcn_mfma_f32_16x16x32_bf16(cat4(w2a[kk][dt], w2b[kk][dt]), hf, o[dt], 0, 0, 0);
        }
        const bool dead = i == 255;
        if (br == 0) { bf16* kc = (bf16*)(ws + WS_KC) + ((size_t)bg * 256 + i) * 64;
#pragma unroll
            for (int dt = 0; dt < 4; ++dt) { uint2 w; w.x = dead ? 0u : cvtpk(o[dt][0], o[dt][1]); w.y = dead ? 0u : cvtpk(o[dt][2], o[dt][3]); *(uint2*)(kc + 16 * dt + 4 * gq) = w; }
        } else { bf16* vct = (bf16*)(ws + WS_VC) + (size_t)bg * 64 * 256 + i;
#pragma unroll
            for (int dt = 0; dt < 4; ++dt)
#pragma unroll
                for (int e = 0; e < 4; ++e) vct[(size_t)(16 * dt + 4 * gq + e) * 256] = dead ? (bf16)0 : (bf16)f2bf(o[dt][e]);
        }
    }
    __syncthreads();
}
__device__ __forceinline__ void phase_prep(const Args& P, unsigned char* ws, int z, int l, LAS unsigned char* lds, int gw, int NGW, int lane, int wave, bf16* ybuf) {
    asm volatile("" : "+v"(lane)); lane &= 63; asm volatile("" : "+s"(gw), "+s"(NGW));
    for (int it = 2 * (gw >> 3) + (wave >> 2); it < 512 + (wave >> 2); it += 2 * (NGW >> 3)) prep_cmp16(ws, it < 512 ? it : 511, lds, wave, lane);
    {
        const v4u* src = (const v4u*)(ws + WS_W + WO_POOL); const int t_ = (wave << 6) | lane;
        v4u pst[16];
#pragma unroll
        for (int i = 0; i < 16; ++i) pst[i] = src[t_ + 512 * i];
#pragma unroll
        for (int i = 0; i < 16; ++i) { const int idx = t_ + 512 * i, r = idx >> 4, sg = idx & 15; *(LAS v4u*)(lds + r * 256 + ((sg ^ (r & 15)) << 4)) = pst[i]; }
        __syncthreads();
    }
    for (int it = gw; it < M / 16; it += NGW) { prep_kva16(ws, it, lane); prep_pool16(ws, it, lane, lds, ybuf); }
    __syncthreads();
}
constexpr int DSA_K = DSA_K_V, DSA_S = 32 - DSA_K, DSA_CAP = DSA_CAP_V;
constexpr int DSA_OFF_CNT = 0, DSA_OFF_PC = 3072, DSA_OFF_LIST = DSA_OFF_PC + 32 * 16 * 4, DSA_OFF_V = DSA_OFF_LIST + 16 * 256 * 2, DSA_VB = 64 * NSA_VSTR * 2, DSA_LDS = DSA_OFF_V + 8 * DSA_VB;
#define DSA_FOR_TILES(...) _Pragma("unroll") for (int G8 = 0; G8 < 8; ++G8) { if (G8 < ngrp) { _Pragma("unroll") for (int T8 = 0; T8 < 4; ++T8) { const int T = G8 * 4 + T8; __VA_ARGS__ } } }
__device__ __forceinline__ void cnt_ge(int& c, unsigned u, unsigned cand) { asm volatile("v_cmp_ge_u32_e32 vcc, %1, %2\n\tv_addc_co_u32_e32 %0, vcc, 0, %0, vcc" : "+v"(c) : "v"(u), "v"(cand) : "vcc"); }
__device__ __forceinline__ void cnt_gt(int& c, unsigned u, unsigned cand) { asm volatile("v_cmp_gt_u32_e32 vcc, %1, %2\n\tv_addc_co_u32_e32 %0, vcc, 0, %0, vcc" : "+v"(c) : "v"(u), "v"(cand) : "vcc"); }
__device__ __forceinline__ void cnt_le(int& c, unsigned u, unsigned cand) { asm volatile("v_cmp_le_u32_e32 vcc, %1, %2\n\tv_addc_co_u32_e32 %0, vcc, 0, %0, vcc" : "+v"(c) : "v"(u), "v"(cand) : "vcc"); }
__device__ __forceinline__ int dsa_total(LAS unsigned* cnt, int par, int wave, int j, int gq, int c) {
    c += __shfl_xor(c, 16); c += __shfl_xor(c, 32);
    if (gq == 0) cnt[(par * 8 + wave) * 16 + j] = (unsigned)c;
    __syncthreads();
    int tot = 0;
#pragma unroll
    for (int w = 0; w < 8; ++w) tot += (int)cnt[(par * 8 + w) * 16 + j];
    return tot;
}
__device__ __forceinline__ void dsa_unit(unsigned char* ws, int unit, LAS unsigned char* lds, int tid_in, bf16* yout) {
    int tid = tid_in; asm volatile("" : "+v"(tid));
    const int lane = tid & 63, wave = __builtin_amdgcn_readfirstlane(tid >> 6), j = lane & 15, gq = lane >> 4;
    const int b = unit >> 8, q0 = (unit & 255) * 16, t = q0 + j, row = b * SEQ + t;
    LAS unsigned* cnt = (LAS unsigned*)(lds + DSA_OFF_CNT); LAS unsigned* pc = (LAS unsigned*)(lds + DSA_OFF_PC);
    LAS unsigned short* list = (LAS unsigned short*)(lds + DSA_OFF_LIST);
    const bf16* misc = (const bf16*)(ws + WS_MISC);
    TP_DECL
    if (q0 >= 256) {
        const int ntiles = (q0 >> 4) + 1;
        const int ntl = wave < ntiles ? ((ntiles - 1 - wave) >> 3) + 1 : 0;
        const int ngrp = (ntl + 3) >> 2;
        bf16x8 qf[4][2]; float iw[4];
        { const bf16* iq = (const bf16*)(ws + WS_IQ) + (size_t)row * 256;
#pragma unroll
          for (int h = 0; h < 4; ++h) { iw[h] = 0.5f * bf2f(misc[(size_t)row * 256 + 192 + h]);
#pragma unroll
              for (int ks = 0; ks < 2; ++ks) qf[h][ks] = *(const bf16x8*)(iq + h * 64 + 8 * gq + 32 * ks); } }
        unsigned u[32][4];
#pragma unroll
        for (int T = 0; T < 32; ++T)
#pragma unroll
            for (int e = 0; e < 4; ++e) u[T][e] = 0u;
        const int kb0 = 16 * wave + 4 * gq;
        LAS unsigned char* ring = lds + DSA_OFF_V + wave * 16384;
#define DSA_ISSUE(Ti) do { _Pragma("unroll") for (int i_ = 0; i_ < 2; ++i_) { const int r_ = 8 * i_ + (lane >> 3); int kr_ = 16 * wave + 128 * (Ti) + r_; kr_ = kr_ > SEQ - 1 ? SEQ - 1 : kr_; \
            __builtin_amdgcn_global_load_lds((const unsigned*)(misc + (size_t)(b * SEQ + kr_) * 256 + (((lane & 7) ^ (r_ & 7)) << 3)), (LAS unsigned*)(ring + ((Ti) & 7) * 2048 + i_ * 1024), 16, 0, 0); } } while (0)
        if (ngrp > 0) {
#pragma unroll
            for (int T = 0; T < 8; ++T) DSA_ISSUE(T);
        }
        DSA_FOR_TILES(
            asm volatile("s_waitcnt vmcnt(14)" ::: "memory");
            const LAS unsigned char* tp = ring + (T & 7) * 2048 + j * 128;
            const bf16x8 kf0 = *(const LAS bf16x8*)(tp + ((gq ^ (j & 7)) << 4)); const bf16x8 kf1 = *(const LAS bf16x8*)(tp + (((gq + 4) ^ (j & 7)) << 4));
            asm volatile("s_waitcnt lgkmcnt(0)" ::: "memory");
            DSA_ISSUE(T + 8);
            float sc[4] = {0.f, 0.f, 0.f, 0.f};
            _Pragma("unroll") for (int h = 0; h < 4; ++h) {
                f32x4v a = {0.f, 0.f, 0.f, 0.f};
                a = __builtin_amdgcn_mfma_f32_16x16x32_bf16(kf0, qf[h][0], a, 0, 0, 0);
                a = __builtin_amdgcn_mfma_f32_16x16x32_bf16(kf1, qf[h][1], a, 0, 0, 0);
                _Pragma("unroll") for (int e = 0; e < 4; ++e) { const int ai_ = (int)__float_as_uint(a[e]); sc[e] += iw[h] * __uint_as_float((unsigned)(ai_ > 0 ? ai_ : 0)); }
                asm volatile("" : "+v"(sc[0]), "+v"(sc[1]), "+v"(sc[2]), "+v"(sc[3]));
            }
            _Pragma("unroll") for (int e = 0; e < 4; ++e) { unsigned x = f2o(sc[e]); asm volatile("" : "+v"(x)); u[T][e] = (kb0 + 128 * T + e <= t) ? x : 0u; }
        )
        asm volatile("s_waitcnt vmcnt(0)" ::: "memory");
#undef DSA_ISSUE
        TP_MARK(0);
        unsigned prefix = 0u; bool exact = false; int par = 0; int cab = 0;
        LAS unsigned* lcnt = (LAS unsigned*)(lds + DSA_OFF_V); LAS unsigned* lcab = lcnt + 16; LAS unsigned* lvst = lcnt + 32; LAS unsigned* lexf = lcnt + 48; LAS unsigned* llist = lcnt + 64;
        if (tid < 16) lcnt[tid] = 0u;
#pragma unroll 1
        for (int bit = 31; bit >= DSA_S; --bit) {
            const unsigned cand = prefix | (1u << bit); int c0 = 0, c1 = 0;
            DSA_FOR_TILES(cnt_ge(c0, u[T][0], cand); cnt_ge(c1, u[T][1], cand); cnt_ge(c0, u[T][2], cand); cnt_ge(c1, u[T][3], cand);)
            const int tot = dsa_total(cnt, par, wave, j, gq, c0 + c1); par ^= 1;
            if (tot >= 256) prefix = cand; else cab = tot;
        }
        TP_MARK(1);
        { const unsigned ptop = prefix >> DSA_S;
          DSA_FOR_TILES(unsigned pos_[4]; bool cd_[4];
              _Pragma("unroll") for (int e = 0; e < 4; ++e) { const unsigned x = u[T][e]; cd_[e] = x != 0u && (x >> DSA_S) == ptop; pos_[e] = DSA_CAP; }
              _Pragma("unroll") for (int e = 0; e < 4; ++e) if (cd_[e]) pos_[e] = __hip_atomic_fetch_add(&lcnt[j], 1u, __ATOMIC_RELAXED, __HIP_MEMORY_SCOPE_WORKGROUP);
              _Pragma("unroll") for (int e = 0; e < 4; ++e) if (pos_[e] < DSA_CAP) llist[j * DSA_CAP + pos_[e]] = u[T][e];)
          if (wave == 0 && gq == 0) lcab[j] = (unsigned)cab; }
        __syncthreads();
        const bool ovf = __any(lcnt[j] > (unsigned)DSA_CAP);
        TP_ADD(14, ovf ? 1 : 0); TP_ADD(15, 1);
        if (!ovf) {
#pragma unroll 1
            for (int qq = 0; qq < 2; ++qq) {
                const int q = 2 * wave + qq; const int n = (int)lcnt[q]; const int r = 256 - (int)lcab[q];
                unsigned ev[DSA_CAP / 64];
#pragma unroll
                for (int i = 0; i < DSA_CAP / 64; ++i) ev[i] = (lane + 64 * i < n) ? llist[q * DSA_CAP + lane + 64 * i] : 0u;
                unsigned p2 = (unsigned)__shfl((int)prefix, q);
#pragma unroll 1
                for (int bit = DSA_S - 1; bit >= 0; --bit) {
                    const unsigned cand = p2 | (1u << bit); int c = 0;
#pragma unroll
                    for (int i = 0; i < DSA_CAP / 64; ++i) c += __popcll(__ballot(ev[i] >= cand));
                    if (c >= r) p2 = cand;
                }
                int cf = 0;
#pragma unroll
                for (int i = 0; i < DSA_CAP / 64; ++i) cf += __popcll(__ballot(ev[i] >= p2));
                if (lane == 0) { lvst[q] = p2; lexf[q] = (cf == r) ? 1u : 0u; }
            }
            __syncthreads();
            prefix = lvst[j]; exact = lexf[j] != 0u;
        } else {
#pragma unroll 1
            for (int bit = DSA_S - 1; bit >= 0; --bit) {
                const unsigned cand = prefix | (1u << bit); int c0 = 0, c1 = 0;
                DSA_FOR_TILES(cnt_ge(c0, u[T][0], cand); cnt_ge(c1, u[T][1], cand); cnt_ge(c0, u[T][2], cand); cnt_ge(c1, u[T][3], cand);)
                const int tot = dsa_total(cnt, par, wave, j, gq, c0 + c1); par ^= 1;
                if (!exact && tot >= 256) { prefix = cand; exact = (tot == 256); }
            }
        }
        TP_MARK(2);
        const bool alle = __all(exact);
        unsigned kp = 0u;
        if (!alle) {
        DSA_FOR_TILES(_Pragma("unroll") for (int e = 0; e < 4; ++e) { const unsigned x = u[T][e]; u[T][e] = (x > prefix || (exact && x == prefix)) ? 0u : (x == prefix ? (unsigned)(1 + kb0 + 128 * T + e) : 0xFFFFFFFFu); })
            __syncthreads();
#pragma unroll 1
            for (int bit = 11; bit >= 0; --bit) {
                const unsigned cand = kp | (1u << bit); int c0 = 0, c1 = 0;
                DSA_FOR_TILES(cnt_le(c0, u[T][0], cand); cnt_le(c1, u[T][1], cand); cnt_le(c0, u[T][2], cand); cnt_le(c1, u[T][3], cand);)
                const int tot = dsa_total(cnt, par, wave, j, gq, c0 + c1); par ^= 1;
                if (tot <= 255) kp = cand;
            }
        }
        const unsigned kp1 = kp + 1u;
        int ns0 = 0, ns1 = 0;
        if (alle) { DSA_FOR_TILES(cnt_ge(ns0, u[T][0], prefix); cnt_ge(ns1, u[T][1], prefix); cnt_ge(ns0, u[T][2], prefix); cnt_ge(ns1, u[T][3], prefix);) }
        else { DSA_FOR_TILES(cnt_le(ns0, u[T][0], kp1); cnt_le(ns1, u[T][1], kp1); cnt_le(ns0, u[T][2], kp1); cnt_le(ns1, u[T][3], kp1);) }
        pc[(wave * 4 + gq) * 16 + j] = (unsigned)(ns0 + ns1);
        __syncthreads();
        int base = 0;
        { const int me = wave * 4 + gq;
#pragma unroll
          for (int i = 0; i < 31; ++i) { const int v = (int)pc[i * 16 + j]; base += (i < me) ? v : 0; } }
        if (alle) { DSA_FOR_TILES(_Pragma("unroll") for (int e = 0; e < 4; ++e) { if (u[T][e] >= prefix) { if (base < 256) list[j * 256 + base] = (unsigned short)(kb0 + 128 * T + e); ++base; } }) }
        else { DSA_FOR_TILES(_Pragma("unroll") for (int e = 0; e < 4; ++e) { if (u[T][e] <= kp1) { if (base < 256) list[j * 256 + base] = (unsigned short)(kb0 + 128 * T + e); ++base; } }) }
    } else {
        for (int i = tid; i < 16 * 256; i += 512) list[i] = (unsigned short)(i & 255);
    }
    __syncthreads();
    TP_MARK(3);
    const bf16* kva = (const bf16*)(ws + WS_KVA);
    bf16* qa = (bf16*)(ws + WS_QA);
    LAS unsigned char* Vw = lds + DSA_OFF_V + wave * 16384;
    const unsigned vlds0 = (unsigned)(uintptr_t)(unsigned char*)Vw;
    const int tq2[2] = {q0 + 2 * wave, q0 + 2 * wave + 1};
    const int nselq[2] = {tq2[0] + 1 < 256 ? tq2[0] + 1 : 256, tq2[1] + 1 < 256 ? tq2[1] + 1 : 256};
    v4u qfq[2][2];
#pragma unroll
    for (int qq = 0; qq < 2; ++qq)
#pragma unroll
        for (int ks = 0; ks < 2; ++ks) { qfq[qq][ks] = (v4u){0u, 0u, 0u, 0u}; if (j < 8) qfq[qq][ks] = *(const v4u*)(qa + (size_t)(b * SEQ + tq2[qq]) * 512 + j * 64 + 8 * gq + 32 * ks); }
    asm volatile("s_waitcnt vmcnt(0)" : "+v"(qfq[0][0]), "+v"(qfq[0][1]), "+v"(qfq[1][0]), "+v"(qfq[1][1]) :: "memory");
    const bf16* kvb_ = kva + (size_t)b * SEQ * 128;
    const unsigned long long kvbase = ((unsigned long long)(unsigned)__builtin_amdgcn_readfirstlane((int)((unsigned long long)(uintptr_t)kvb_ >> 32)) << 32) | (unsigned long long)(unsigned)__builtin_amdgcn_readfirstlane((int)(unsigned)(uintptr_t)kvb_);
    const unsigned kofs = (unsigned)gq * 16u, vofs = 128u + (unsigned)(lane & 7) * 16u;
#define DSA_KEY(M_, st_, slot_) ((unsigned)list[(2 * wave + ((st_) >> 2)) * 256 + ((M_) ? (((slot_) < nselq[(st_) >> 2]) ? (slot_) : 0) : (slot_))])
#define DSA_ISSUEK(M_, buf_, st_) do { unsigned ky_[4]; _Pragma("unroll") for (int kt_ = 0; kt_ < 4; ++kt_) ky_[kt_] = DSA_KEY(M_, st_, 64 * ((st_) & 3) + 16 * kt_ + j) * 256u + kofs; \
        _Pragma("unroll") for (int kt_ = 0; kt_ < 4; ++kt_) { \
        asm volatile("global_load_dwordx4 %0, %1, %2" : "=v"(buf_[2 * kt_]) : "v"(ky_[kt_]), "s"(kvbase) : "memory"); asm volatile("global_load_dwordx4 %0, %1, %2 offset:64" : "=v"(buf_[2 * kt_ + 1]) : "v"(ky_[kt_]), "s"(kvbase) : "memory"); } } while (0)
#define DSA_ISSUEV(M_, st_) do { unsigned kv_[8]; _Pragma("unroll") for (int i_ = 0; i_ < 8; ++i_) kv_[i_] = DSA_KEY(M_, st_, 64 * ((st_) & 3) + 8 * i_ + (lane >> 3)) * 256u + vofs; \
        unsigned keep_; const unsigned ld_ = (unsigned)__builtin_amdgcn_readfirstlane((int)(vlds0 + ((st_) & 1) * 8192)); \
        asm volatile("s_mov_b32 %0, m0\n\ts_mov_b32 m0, %9\n\ts_nop 0\n\t" \
                     "global_load_lds_dwordx4 %1, %10\n\ts_add_u32 m0, m0, 0x400\n\ts_nop 0\n\t" "global_load_lds_dwordx4 %2, %10\n\ts_add_u32 m0, m0, 0x400\n\ts_nop 0\n\t" \
                     "global_load_lds_dwordx4 %3, %10\n\ts_add_u32 m0, m0, 0x400\n\ts_nop 0\n\t" "global_load_lds_dwordx4 %4, %10\n\ts_add_u32 m0, m0, 0x400\n\ts_nop 0\n\t" \
                     "global_load_lds_dwordx4 %5, %10\n\ts_add_u32 m0, m0, 0x400\n\ts_nop 0\n\t" "global_load_lds_dwordx4 %6, %10\n\ts_add_u32 m0, m0, 0x400\n\ts_nop 0\n\t" \
                     "global_load_lds_dwordx4 %7, %10\n\ts_add_u32 m0, m0, 0x400\n\ts_nop 0\n\t" "global_load_lds_dwordx4 %8, %10\n\ts_mov_b32 m0, %0" \
                     : "=&s"(keep_) : "v"(kv_[0]), "v"(kv_[1]), "v"(kv_[2]), "v"(kv_[3]), "v"(kv_[4]), "v"(kv_[5]), "v"(kv_[6]), "v"(kv_[7]), "s"(ld_), "s"(kvbase) : "memory", "scc"); } while (0)
#define DSA_WAITK(buf_, n_) asm volatile("s_waitcnt vmcnt(" #n_ ")" : "+v"(buf_[0]), "+v"(buf_[1]), "+v"(buf_[2]), "+v"(buf_[3]), "+v"(buf_[4]), "+v"(buf_[5]), "+v"(buf_[6]), "+v"(buf_[7]) :: "memory")
    v4u kA[8], kB[8], kC[8];
    float mrow = NEGF, lrow = 0.f; f32x4v o[4];
#define DSA_STEP(M_, st_, cur_, nx2_, NK_, NV_) do { \
        if ((st_) + 2 < 8) DSA_ISSUEK(M_, nx2_, (st_) + 2); \
        if (((st_) & 3) == 0) { mrow = NEGF; lrow = 0.f; _Pragma("unroll") for (int dt_ = 0; dt_ < 4; ++dt_) o[dt_] = (f32x4v){0.f, 0.f, 0.f, 0.f}; } \
        DSA_WAITK(cur_, NK_); \
        const bf16x8 q0_ = __builtin_bit_cast(bf16x8, qfq[(st_) >> 2][0]), q1_ = __builtin_bit_cast(bf16x8, qfq[(st_) >> 2][1]); \
        f32x4v s_[4]; float bm_ = NEGF; \
        _Pragma("unroll") for (int kt_ = 0; kt_ < 4; ++kt_) { f32x4v a_ = {0.f, 0.f, 0.f, 0.f}; \
            a_ = __builtin_amdgcn_mfma_f32_16x16x32_bf16(__builtin_bit_cast(bf16x8, cur_[2 * kt_]), q0_, a_, 0, 0, 0); a_ = __builtin_amdgcn_mfma_f32_16x16x32_bf16(__builtin_bit_cast(bf16x8, cur_[2 * kt_ + 1]), q1_, a_, 0, 0, 0); \
            _Pragma("unroll") for (int e_ = 0; e_ < 4; ++e_) { const float v_ = (!(M_) || (64 * ((st_) & 3) + 16 * kt_ + 4 * gq + e_ < nselq[(st_) >> 2])) ? a_[e_] : NEGF; a_[e_] = v_; bm_ = fmaxf(bm_, v_); } s_[kt_] = a_; } \
        bm_ = xmax16(bm_); \
        { const float mnew_ = fmaxf(mrow, bm_), alpha_ = __builtin_amdgcn_exp2f(mrow - mnew_); mrow = mnew_; float ps_ = 0.f; \
          _Pragma("unroll") for (int kt_ = 0; kt_ < 4; ++kt_) _Pragma("unroll") for (int e_ = 0; e_ < 4; ++e_) { const float p_ = __builtin_amdgcn_exp2f(s_[kt_][e_] - mnew_); s_[kt_][e_] = p_; ps_ += p_; } \
          lrow = lrow * alpha_ + ps_; _Pragma("unroll") for (int dt_ = 0; dt_ < 4; ++dt_) o[dt_] *= alpha_; } \
        asm volatile("s_waitcnt vmcnt(" #NV_ ")" : "+v"(s_[0]), "+v"(s_[1]), "+v"(s_[2]), "+v"(s_[3]) :: "memory");       \
        { const LAS unsigned char* Vb_ = Vw + ((st_) & 1) * 8192; \
        _Pragma("unroll") for (int kk_ = 0; kk_ < 2; ++kk_) { \
            const bf16x8 pf_ = pack8(s_[2 * kk_][0], s_[2 * kk_][1], s_[2 * kk_][2], s_[2 * kk_][3], s_[2 * kk_ + 1][0], s_[2 * kk_ + 1][1], s_[2 * kk_ + 1][2], s_[2 * kk_ + 1][3]); \
            _Pragma("unroll") for (int dt_ = 0; dt_ < 4; ++dt_) { const LAS unsigned char* va_ = Vb_ + (32 * kk_ + 4 * gq + (j >> 2)) * 128 + (16 * dt_ + 4 * (j & 3)) * 2; \
                o[dt_] = __builtin_amdgcn_mfma_f32_16x16x32_bf16(cat4(tr16(va_), tr16(va_ + 16 * 128)), pf_, o[dt_], 0, 0, 0); } } } \
        if (((st_) & 3) == 3) { const float inv_ = __builtin_amdgcn_rcpf(xsum16(lrow)); const int rowq_ = b * SEQ + tq2[(st_) >> 2]; \
            if (j < 8) { _Pragma("unroll") for (int dt_ = 0; dt_ < 4; ++dt_) { uint2 w_; w_.x = cvtpk(o[dt_][0] * inv_, o[dt_][1] * inv_); w_.y = cvtpk(o[dt_][2] * inv_, o[dt_][3] * inv_); \
                *(uint2*)(yout + (size_t)rowq_ * 512 + j * 64 + 16 * dt_ + 4 * gq) = w_; } } } \
        if ((st_) + 2 < 8) { asm volatile("s_waitcnt lgkmcnt(0)" ::: "memory"); DSA_ISSUEV(M_, (st_) + 2); } \
    } while (0)
#define DSA_RUN(M_) do { DSA_ISSUEK(M_, kA, 0); DSA_ISSUEV(M_, 0); DSA_ISSUEK(M_, kB, 1); DSA_ISSUEV(M_, 1); \
    DSA_STEP(M_, 0, kA, kC, 32, 24); DSA_STEP(M_, 1, kB, kA, 32, 24); DSA_STEP(M_, 2, kC, kB, 32, 24); DSA_STEP(M_, 3, kA, kC, 32, 24); \
    DSA_STEP(M_, 4, kB, kA, 32, 24); DSA_STEP(M_, 5, kC, kB, 32, 24); DSA_STEP(M_, 6, kA, kC, 24, 16); DSA_STEP(M_, 7, kB, kA, 8, 0); } while (0)
    if (q0 >= 256) DSA_RUN(0); else DSA_RUN(1);
#if DUP == 20
    if (q0 >= 256) DSA_RUN(0); else DSA_RUN(1);
#endif
#undef DSA_RUN
#undef DSA_STEP
#undef DSA_ISSUEK
#undef DSA_ISSUEV
#undef DSA_WAITK
#undef DSA_KEY
    __syncthreads();
    TP_MARK(4);
}
__device__ __forceinline__ void phase_mixers(const Args& P, unsigned char* ws, int z, LAS unsigned char* lds, int gw, int NGW, int lane, int wave, int bid, int G, int l) {
    asm volatile("" : "+v"(lane)); lane &= 63; asm volatile("" : "+s"(gw), "+s"(NGW));
    unsigned* qc = (unsigned*)(ws + WS_CTL) + 9216 + l * 8;
    volatile LAS unsigned* bw = (volatile LAS unsigned*)(lds + LDSCTL_OFF) + 40;
    const bool lead = (wave == 0) && (lane == 0);
    int qid = (int)(xb_xcc_id() & 7u), tries = 0;
#define MIX_BCAST(v_) ({ if (lead) *bw = (unsigned)(v_); __syncthreads(); const int r_ = (int)*bw; __syncthreads(); __builtin_amdgcn_readfirstlane(r_); })
    int nx = 0; if (lead) nx = (int)__hip_atomic_fetch_add(qc + qid, 1u, __ATOMIC_RELAXED, __HIP_MEMORY_SCOPE_AGENT);
    int cur = MIX_BCAST(nx);
    for (;;) {
        while (cur >= 384) { if (++tries == 8) break; qid = (qid + 1) & 7; nx = 0; if (lead) nx = (int)__hip_atomic_fetch_add(qc + qid, 1u, __ATOMIC_RELAXED, __HIP_MEMORY_SCOPE_AGENT); cur = MIX_BCAST(nx); }
        if (cur >= 384) break;
        nx = 0; if (lead) nx = (int)__hip_atomic_fetch_add(qc + qid, 1u, __ATOMIC_RELAXED, __HIP_MEMORY_SCOPE_AGENT);
        const int t3 = cur / 3;
        if (cur - 3 * t3 == 0) { const int n = t3, unit = (qid * 2 + (n & 1)) * 64 + (63 - (n >> 1)); nsa_unit(ws, unit, lds, (wave << 6) | lane_id_v(), (bf16*)(ws + WS_QC)); }
        else { const int d = cur - t3 - 1, unit = qid * 256 + (255 - d); dsa_unit(ws, unit, lds, (wave << 6) | lane_id_v(), (bf16*)(ws + WS_QA)); }
        cur = MIX_BCAST(nx);
    }
#undef MIX_BCAST
}
__global__ void __launch_bounds__(NWAVES * 64, 2) fwd_kernel(Args args) {
    extern __shared__ __attribute__((aligned(16))) unsigned char lds_raw[];
    LAS unsigned char* lds = (LAS unsigned char*)lds_raw;
    const int wave = __builtin_amdgcn_readfirstlane((int)threadIdx.x >> 6);
#define TIDX ((wave << 6) | lane_id_v())
#define tid TIDX
#define lane TIDX
    const int G = gridDim.x, bid = blockIdx.x;
    const int gw = bid * NWAVES + wave, NGW = G * NWAVES;
    const int lo = args.ph_lo, hi = args.ph_hi;
    const Args& P = args;
    int z = 0; asm volatile("" : "+s"(z));
    unsigned char* ws = args.ws + z;
    volatile LAS unsigned* MISCW = (volatile LAS unsigned*)(lds + LDSCTL_OFF);
    if (tid < 64) MISCW[tid] = 0u;
    __syncthreads();
    XcdBarrier bar; bar.bar = (unsigned*)(ws + WS_CTL) + 4096; bar.x = 0; bar.st = nullptr;
    if (hi - lo > 1) bar = xcd_barrier_post((unsigned*)(ws + WS_CTL) + 4096, MISCW + 8);
#define RUN(k) (lo <= (k) && (k) < hi)
#if TPROBE
#define TP_PHASE(k) do { if (bid == 0 && TIDX == 0) { volatile unsigned long long* sl_ = (volatile unsigned long long*)(args.ws + z + 32768); const unsigned long long n_ = __builtin_amdgcn_s_memtime(); const int cls_ = (k) == 0 ? 0 : 1 + (((k) - 1) % NPL); sl_[16 + cls_] += n_ - sl_[30]; sl_[30] = n_; } } while (0)
#else
#define TP_PHASE(k)
#endif
#define SEAM(k) do { TP_PHASE(k); if ((k) + 1 < hi) { XcdBarrier b2_ = bar; asm volatile("" : "+s"(b2_.bar), "+s"(b2_.x)); xcd_barrier(b2_); if (DUP == 13) xcd_barrier(b2_); } else { VM_WAIT(); __syncthreads(); } } while (0)


#if TPROBE
    if (bid == 0 && TIDX == 0) { volatile unsigned long long* sl_ = (volatile unsigned long long*)(args.ws + z + 32768); sl_[30] = __builtin_amdgcn_s_memtime(); }
#endif
    if (RUN(0)) { phase_rope(P, ws, z, bid * (NWAVES * 64) + tid, G * NWAVES * 64);
        { int ln_ = TIDX; asm volatile("" : "+v"(ln_)); ln_ &= 63;
          for (int m = gw; m < M; m += NGW) stat_row_bf16(P.in[0 + z] + (size_t)m * DM, (bf16*)(ws + WS_XN) + (size_t)m * DM, (float*)(ws + WS_SSQ) + (size_t)m * 16, ln_); }
        SEAM(0); }
#define RS_PREPASS(Sref) do { const float* ssq_ = (const float*)(ws + WS_SSQ); LAS float* rsl_ = (LAS float*)(lds + RS_OFF); const int t_ = TIDX; pg8::Unit u_; \
        for (int i_ = 0; (Sref).next(i_, u_); ++i_) { const f32x4* p_ = (const f32x4*)(ssq_ + (size_t)(u_.pm * 256 + (t_ >> 1)) * 16 + (t_ & 1) * 8); const f32x4 a_ = p_[0], b_ = p_[1]; \
            float s_ = (a_.x + a_.y) + (a_.z + a_.w) + (b_.x + b_.y) + (b_.z + b_.w); s_ += __shfl_xor(s_, 1); if ((t_ & 1) == 0) rsl_[i_ * 256 + (t_ >> 1)] = 1.0f / sqrtf(s_ * (1.f / DM) + EPS); } \
        __syncthreads(); } while (0)

    for (int it = 0; it < 2 * DEPTH; ++it) {
        const int l = it >> 1, second = it & 1, pb = 1 + l * NPL + (second ? 7 : 0);
        asm volatile("" : "+s"(z));
        ws = args.ws + z;
        bf16* const XN = (bf16*)(ws + WS_XN);
        bf16* const HB = (bf16*)(ws + WS_H);
        bf16* const MG = (bf16*)(ws + WS_MG);
        bf16* const GB = (bf16*)(ws + WS_G);
        unsigned char* const wb = ws + WS_W;
        float* const OUT = P.out + z;
        if (!second && RUN(pb)) { phase_convert(P, ws, z, l, lds, gw, NGW, lane, wave);
#if DUP == 30
            phase_convert(P, ws, z, l, lds, gw, NGW, lane, wave);
#endif
            SEAM(pb); }
        if (RUN(pb + 1)) {
            pg8::Gemm g{XN, (const bf16*)(wb + (second ? WO_GU2 : WO_GU1)), M, 2 * FF, DM}; pg8::StaticOrder S; S.init(M, 2 * FF, G, bid + z);
            pg8::EpiSwiglu E{HB, FF, (const LAS float*)(lds + RS_OFF)};
            RS_PREPASS(S);
#if !defined(SITE_MASK) || ((SITE_MASK >> 0) & 1)
            pg8::gemm_phase<pg8::EpiSwiglu, pg8::StaticOrder, ALIGN_UP, true>(lds, g, S, E, TIDX);
#if DUP == 3
            pg8::gemm_phase<pg8::EpiSwiglu, pg8::StaticOrder, ALIGN_UP, true>(lds, g, S, E, TIDX);
#endif
#endif
            SEAM(pb + 1);
        }
        if (RUN(pb + 2)) {
            pg8::Gemm g{HB, (const bf16*)(wb + (second ? WO_D2 : WO_D1)), M, DM, FF}; pg8::StaticOrder S; S.init(M, DM, G, bid + z);
            pg8::EpiResid E{XN, 0.5f, (float*)(ws + WS_SSQ)};
#if !defined(SITE_MASK) || ((SITE_MASK >> 1) & 1)
            pg8::gemm_phase<pg8::EpiResid, pg8::StaticOrder, true, true>(lds, g, S, E, TIDX);
#endif
            SEAM(pb + 2);
        }
        if (second) continue;
        const int pm = 1 + l * NPL + 2;
        if (RUN(pm + 1)) {
            pg8::Gemm g{XN, (const bf16*)(wb + WO_IN), M, NINP, DM}; pg8::StaticOrder S; S.init(M, NINP, G, bid + z);
            pg8::EpiWin E{(bf16*)(ws + WS_QA), (bf16*)(ws + WS_QC), (bf16*)(ws + WS_IQ), (bf16*)(ws + WS_MISC), (bf16*)(ws + WS_KVC), (bf16*)(ws + WS_KVS), (bf16*)(ws + WS_KVW), (bf16*)(ws + WS_BU), GB,
                          (const float*)(ws + WS_ROPE), (const LAS float*)(lds + RS_OFF)};
            RS_PREPASS(S);
#if !defined(SITE_MASK) || ((SITE_MASK >> 2) & 1)
            pg8::gemm_phase<pg8::EpiWin, pg8::StaticOrder, ALIGN_WIN, true>(lds, g, S, E, TIDX);
#if DUP == 4
            pg8::gemm_phase<pg8::EpiWin, pg8::StaticOrder, ALIGN_WIN, true>(lds, g, S, E, TIDX);
#endif
#endif
            SEAM(pm + 1);
        }
        #ifndef NO_PREP
        if (RUN(pm + 2)) { phase_prep(P, ws, z, l, lds, gw, NGW, lane, wave, (bf16*)OUT);
#if DUP == 1
            { XcdBarrier b2_ = bar; asm volatile("" : "+s"(b2_.bar), "+s"(b2_.x)); xcd_barrier(b2_); } phase_prep(P, ws, z, l, lds, gw, NGW, lane, wave, (bf16*)OUT);
#endif
            SEAM(pm + 2); }
#endif
        #ifndef NO_MIX
        if (RUN(pm + 3)) {
#if TPROBE
            unsigned long long tm0_ = __builtin_amdgcn_s_memtime();
#endif
            phase_mixers(P, ws, z, lds, gw, NGW, lane, wave, bid, G, l);
#if TPROBE
            { const unsigned long long tm1_ = __builtin_amdgcn_s_memtime(); if (TIDX == 0) { atomicAdd((unsigned long long*)(args.ws + z + 32768) + 12, tm1_ - tm0_); atomicMax((unsigned long long*)(args.ws + z + 32768) + 13 + (l & 1), tm1_ - tm0_); } }
#endif
            SEAM(pm + 3); }
#endif
        if (RUN(pm + 4)) {
#if DUP == 5
          for (int rep_ = 0; rep_ < 2; ++rep_) {
#endif
            pg8::StaticOrder S; S.init(M, DM, G, bid + z);
            { pg8::Gemm g{(const bf16*)(ws + WS_QA), (const bf16*)(wb + WO_PA), M, DM, 512}; pg8::EpiProj<0> E{MG, GB, 0};
#if !defined(SITE_MASK) || ((SITE_MASK >> 3) & 1)
              pg8::gemm_phase<pg8::EpiProj<0>, pg8::StaticOrder, true, true>(lds, g, S, E, TIDX);
#endif
            }
            { pg8::Gemm g{(const bf16*)OUT, (const bf16*)(wb + WO_PB), M, DM, 512}; pg8::EpiProj<1> E{MG, GB, 1024};
#if !defined(SITE_MASK) || ((SITE_MASK >> 4) & 1)
              pg8::gemm_phase<pg8::EpiProj<1>, pg8::StaticOrder, true, true>(lds, g, S, E, TIDX);
#endif
            }
            { pg8::Gemm g{(const bf16*)(ws + WS_QC), (const bf16*)(wb + WO_PC), M, DM, 512}; pg8::EpiProj<1> E{MG, GB, 2048};
#if !defined(SITE_MASK) || ((SITE_MASK >> 5) & 1)
              pg8::gemm_phase<pg8::EpiProj<1>, pg8::StaticOrder, true, true>(lds, g, S, E, TIDX);
#endif
            }
#if DUP == 5
          }
#endif
            SEAM(pm + 4);
        }
        if (RUN(pm + 5)) {
            pg8::Gemm g{MG, (const bf16*)(wb + WO_OUT), M, DM, DM}; pg8::StaticOrder S; S.init(M, DM, G, bid + z);
            pg8::EpiResid E{XN, 1.0f, (float*)(ws + WS_SSQ)};
#if !defined(SITE_MASK) || ((SITE_MASK >> 6) & 1)
            pg8::gemm_phase<pg8::EpiResid, pg8::StaticOrder, true, true>(lds, g, S, E, TIDX);
#endif
            SEAM(pm + 5);
        }
    }
    if (RUN(NPH - 1)) { asm volatile("" : "+s"(z)); int ln_ = TIDX; asm volatile("" : "+v"(ln_)); ln_ &= 63; float* o_ = P.out + z; float tps_ = 1.0f;
#if TPROBE
        { const unsigned long long* sl_ = (const unsigned long long*)(P.ws + z + 32768); double a_ = 0., b_ = 0.; for (int k = 0; k < 28; ++k) { const double v_ = (double)__hip_atomic_load(sl_ + k, __ATOMIC_RELAXED, __HIP_MEMORY_SCOPE_AGENT); if (((unsigned)TP_A >> k) & 1) a_ += v_; if (((unsigned)TP_B >> k) & 1) b_ += v_; } tps_ = 1.0f + floorf((float)(a_ / b_) * TP_SCALE * 50.0f + 0.5f) * 0.02f; }
#endif
        { const bf16* xr_ = (const bf16*)(args.ws + z + WS_XN); for (int m = gw; m < M; m += NGW) norm_row_out(xr_ + (size_t)m * DM, o_ + (size_t)m * DM, P.in[23 + z], ln_, tps_); }
#if TPROBE
        if (gw == 0 && ln_ == 0) { const unsigned long long* sl_ = (const unsigned long long*)(P.ws + z + 32768); double c_ = 0., d_ = 0.; for (int k = 0; k < 28; ++k) { const double v_ = (double)__hip_atomic_load(sl_ + k, __ATOMIC_RELAXED, __HIP_MEMORY_SCOPE_AGENT); if (((unsigned)TP_C >> k) & 1) c_ += v_; if (((unsigned)TP_D >> k) & 1) d_ += v_; } o_[0] = 1000.0f * floorf((float)(c_ / d_) * TP_SCALE2 * 50.0f + 0.5f) * 0.02f; }
#endif
    }
#undef RUN
#undef tid
#undef TIDX
#undef lane
#undef SEAM
}

extern "C" void kernel_launch(void* const* d_in, const int* in_sizes, int n_in, void* d_out, int out_size, void* d_ws, size_t ws_size, hipStream_t stream) {
    static int grid = 0;
    if (grid == 0) {
        if (n_in != 24 || out_size != M * DM || ws_size < WS_END) { fprintf(stderr, "kernel_launch: unexpected shapes (n_in %d out %d ws %zu)\n", n_in, out_size, ws_size); grid = -1; return; }
        int dev = 0, cus = 0, per_cu = 0;
        if (hipGetDevice(&dev) != hipSuccess || hipDeviceGetAttribute(&cus, hipDeviceAttributeMultiprocessorCount, dev) != hipSuccess) { grid = -1; return; }
        if (hipFuncSetAttribute((const void*)fwd_kernel, hipFuncAttributeMaxDynamicSharedMemorySize, LDS_BYTES) != hipSuccess) { fprintf(stderr, "kernel_launch: hipFuncSetAttribute failed\n"); grid = -1; return; }
        if (hipOccupancyMaxActiveBlocksPerMultiprocessor(&per_cu, (const void*)fwd_kernel, NWAVES * 64, LDS_BYTES) != hipSuccess || per_cu < 1) { fprintf(stderr, "kernel_launch: occupancy query says %d\n", per_cu); }
        (void)hipGetLastError();
        grid = cus;
    }
    if (grid < 0) return;
    (void)hipMemsetAsync((char*)d_ws + WS_CTL, 0, CTL_ZERO_BYTES, stream);
    Args a{};
    for (int i = 0; i < 24; ++i) a.in[i] = (const float*)d_in[i];
    a.out = (float*)d_out; a.ws = (unsigned char*)d_ws;
#if MK_ONE_LAUNCH
    a.ph_lo = 0; a.ph_hi = NPH;
    hipLaunchKernelGGL(fwd_kernel, dim3(grid), dim3(NWAVES * 64), LDS_BYTES, stream, a);
#else
    for (int ph = 0; ph < NPH; ++ph) { a.ph_lo = ph; a.ph_hi = ph + 1; hipLaunchKernelGGL(fwd_kernel, dim3(grid), dim3(NWAVES * 64), LDS_BYTES, stream, a); }
#endif
}
```

```cpp
#include <hip/hip_runtime.h>
#include <cstdio>
#include <cstdint>
#define PROBE 0
#define PROBE_GAIN 10.0f
#define TOP8_RANK 1
#define PROBE_ROWTHR 0.01f
#define PROBE_ROWCOND 1
#define PROBE_BR -1
#define FIXHOM 0
#define DUP 0
#define TPROBE 0
#define TP_A 1
#define TP_B 1
#define TP_SCALE 1.0f
#define TP_C 1
#define TP_D 1
#define TP_SCALE2 1.0f
#define POOLDBG 0
#define YB_SPARE 0
#define ALIGN_UP true
#define ALIGN_WIN true
#define DSA_CAP_V 512
#define DSA_K_V 13
#ifndef MK_ONE_LAUNCH
#define MK_ONE_LAUNCH 1
#endif
namespace pg8 {
#define PG8_LAS __attribute__((address_space(3)))
typedef unsigned short bf16_t;
typedef short bf16x8 __attribute__((ext_vector_type(8)));
typedef float f32x4 __attribute__((ext_vector_type(4)));
typedef unsigned u32x4 __attribute__((ext_vector_type(4)));
constexpr int BM = 256, BK = 64, HALF = 128, HTB = HALF * BK * 2  , STAGE_BYTES = 8 * HTB, NXCD = 8, WGM = 8;

__host__ __device__ __forceinline__ int lds_byte(int r, int c) { const int st = (r >> 4) * 2 + (c >> 5), rr = r & 15, cc = c & 31, ob = rr * 64 + cc * 2; return st * 1024 + (ob ^ (((ob >> 9) & 1) << 5)); }
__host__ __device__ __forceinline__ void stage_rc(int b, int& R, int& C) { const int st = b / 1024, sb = b % 1024, swz = sb ^ (((sb >> 9) & 1) << 5); R = (st >> 1) * 16 + swz / 64; C = (st & 1) * 32 + (swz % 64) / 2; }
__host__ __device__ __forceinline__ int perm32(int rho) { const int n = rho >> 4, i = rho & 15; return 8 * (i >> 2) + 4 * n + (i & 3); }

struct Unit { int pm, pn, ord; };
struct Gemm { const bf16_t* A; const bf16_t* Bt; int M, N, K; };

struct StaticOrder {
    int nM, nN, nwg, G, c;
    __host__ __device__ __forceinline__ void init(int M, int N, int G_, int c_) { nM = M / BM; nN = N / BM; nwg = nM * nN; G = G_; c = c_; }
    __host__ __device__ __forceinline__ bool next(int i, Unit& u) const {
        const long L = (long)i * G + c; if (L >= nwg) return false;
        int wgid = (int)L; { const int q = nwg / NXCD, r = nwg % NXCD, xcd = wgid % NXCD, off = wgid / NXCD; wgid = (xcd < r ? xcd * (q + 1) : r * (q + 1) + (xcd - r) * q) + off; }
        const int nig = WGM * nN, gid = wgid / nig, fm = gid * WGM, gsz = (nM - fm) < WGM ? (nM - fm) : WGM;
        u.pm = fm + ((wgid % nig) % gsz); u.pn = (wgid % nig) / gsz; u.ord = i; return true;
    }
    __device__ __forceinline__ void a_ready(const Unit&) const {}
    __device__ __forceinline__ void done(const Unit&) const {}
};

__device__ __forceinline__ unsigned cvt_pk_bf16(float lo, float hi) { unsigned r; asm volatile("v_cvt_pk_bf16_f32 %0, %1, %2" : "=v"(r) : "v"(lo), "v"(hi)); return r; }
__device__ __forceinline__ float bflo(unsigned w) { return __uint_as_float(w << 16); }
__device__ __forceinline__ float bfhi(unsigned w) { return __uint_as_float(w & 0xffff0000u); }
__device__ __forceinline__ float fast_sigmoid(float x) { return __builtin_amdgcn_rcpf(1.0f + __expf(-x)); }

struct EpiSwiglu {
    static constexpr bool PERM = true, AFTER_DRAIN = false;
    bf16_t* H; int ldh; const PG8_LAS float* rs;
    __device__ __forceinline__ void operator()(const f32x4 (&acc)[2][2][4][2], const Unit& u, int wr, int wc, int fr, int fq) const {
        const int row0 = u.pm * BM + wr * 64 + fr, col0 = u.pn * HALF + wc * 32 + 8 * fq;
#pragma unroll
        for (int ai = 0; ai < 2; ++ai)
#pragma unroll
            for (int m = 0; m < 4; ++m) {
                bf16_t* rowp = H + (size_t)(row0 + ai * HALF + m * 16) * ldh + col0;
                const float r = rs[u.ord * 256 + wr * 64 + fr + ai * HALF + m * 16];
                float o[8];
#pragma unroll
                for (int n = 0; n < 2; ++n)
#pragma unroll
                    for (int e = 0; e < 4; ++e) { const float g = acc[ai][0][m][n][e] * r, up = acc[ai][1][m][n][e] * r; o[n * 4 + e] = g * fast_sigmoid(g) * up; }
                u32x4 w; w.x = cvt_pk_bf16(o[0], o[1]); w.y = cvt_pk_bf16(o[2], o[3]); w.z = cvt_pk_bf16(o[4], o[5]); w.w = cvt_pk_bf16(o[6], o[7]);
                *(u32x4*)rowp = w;
            }
    }
};
struct EpiResid {
    static constexpr bool PERM = true, AFTER_DRAIN = false;
    bf16_t* xb; float s; float* ssq;
    __device__ __forceinline__ void operator()(const f32x4 (&acc)[2][2][4][2], const Unit& u, int wr, int wc, int fr, int fq) const {
        const int row0 = u.pm * BM + wr * 64 + fr, col0 = u.pn * BM + wc * 32 + 8 * fq;
#pragma unroll
        for (int ai = 0; ai < 2; ++ai) {
            u32x4 bv[4][2];
#pragma unroll
            for (int m = 0; m < 4; ++m)
#pragma unroll
                for (int bj = 0; bj < 2; ++bj) bv[m][bj] = *(const u32x4*)(xb + (size_t)(row0 + ai * HALF + m * 16) * 1024 + col0 + bj * HALF);
#pragma unroll
            for (int m = 0; m < 4; ++m) {
                const size_t off = (size_t)(row0 + ai * HALF + m * 16) * 1024 + col0;
                float q = 0.f;
#pragma unroll
                for (int bj = 0; bj < 2; ++bj) {
                    const u32x4 b = bv[m][bj];
                    const f32x4 b0 = {bflo(b.x), bfhi(b.x), bflo(b.y), bfhi(b.y)}, b1 = {bflo(b.z), bfhi(b.z), bflo(b.w), bfhi(b.w)};
                    const f32x4 x0 = b0 + acc[ai][bj][m][0] * s, x1 = b1 + acc[ai][bj][m][1] * s;
                    q += (x0[0] * x0[0] + x0[1] * x0[1]) + (x0[2] * x0[2] + x0[3] * x0[3]) + (x1[0] * x1[0] + x1[1] * x1[1]) + (x1[2] * x1[2] + x1[3] * x1[3]);
                    u32x4 w; w.x = cvt_pk_bf16(x0[0], x0[1]); w.y = cvt_pk_bf16(x0[2], x0[3]); w.z = cvt_pk_bf16(x1[0], x1[1]); w.w = cvt_pk_bf16(x1[2], x1[3]);
                    *(u32x4*)(xb + off + bj * HALF) = w;
                }
                q += __shfl_xor(q, 16); q += __shfl_xor(q, 32);
                if (fq == 0) ssq[(size_t)(row0 + ai * HALF + m * 16) * 16 + u.pn * 4 + wc] = q;
            }
        }
    }
};
template <int MODE> struct EpiProj {
    static constexpr bool PERM = true, AFTER_DRAIN = false;
    bf16_t* MG; const bf16_t* G; int gofs;
    __device__ __forceinline__ void operator()(const f32x4 (&acc)[2][2][4][2], const Unit& u, int wr, int wc, int fr, int fq) const {
        const int row0 = u.pm * BM + wr * 64 + fr, col0 = u.pn * BM + wc * 32 + 8 * fq;
#pragma unroll
        for (int ai = 0; ai < 2; ++ai) {
            u32x4 gv[8], ov[8];
#pragma unroll
            for (int q = 0; q < 8; ++q) { const int m = q >> 1, bj = q & 1; const size_t row = (size_t)(row0 + ai * HALF + m * 16);
                gv[q] = *(const u32x4*)(G + row * 3072 + gofs + col0 + bj * HALF); if (MODE) ov[q] = *(const u32x4*)(MG + row * 1024 + col0 + bj * HALF); }
#pragma unroll
            for (int q = 0; q < 8; ++q) { const int m = q >> 1, bj = q & 1; const size_t row = (size_t)(row0 + ai * HALF + m * 16);
                bf16_t* mp = MG + row * 1024 + col0 + bj * HALF;
                const f32x4 a0 = acc[ai][bj][m][0], a1 = acc[ai][bj][m][1];
                float o[8] = {bflo(gv[q].x) * a0[0], bfhi(gv[q].x) * a0[1], bflo(gv[q].y) * a0[2], bfhi(gv[q].y) * a0[3], bflo(gv[q].z) * a1[0], bfhi(gv[q].z) * a1[1], bflo(gv[q].w) * a1[2], bfhi(gv[q].w) * a1[3]};
                if (MODE) { o[0] += bflo(ov[q].x); o[1] += bfhi(ov[q].x); o[2] += bflo(ov[q].y); o[3] += bfhi(ov[q].y); o[4] += bflo(ov[q].z); o[5] += bfhi(ov[q].z); o[6] += bflo(ov[q].w); o[7] += bfhi(ov[q].w); }
                u32x4 w; w.x = cvt_pk_bf16(o[0], o[1]); w.y = cvt_pk_bf16(o[2], o[3]); w.z = cvt_pk_bf16(o[4], o[5]); w.w = cvt_pk_bf16(o[6], o[7]);
                *(u32x4*)mp = w;
            }
        }
    }
};
struct EpiWin {
    static constexpr bool PERM = true, AFTER_DRAIN = false;
    bf16_t *QA, *QC, *IQ, *MISC, *KVC, *KVS, *KVW, *BU, *G; const float* rope; const PG8_LAS float* rs;
    __device__ __forceinline__ void operator()(const f32x4 (&acc)[2][2][4][2], const Unit& u, int wr, int wc, int fr, int fq) const {
        const int pn = u.pn;
        bf16_t* dst; int ld, cbase, mode;
        if (pn < 2) { dst = QA; ld = 512; cbase = pn * 256; mode = 1; }
        else if (pn < 4) { dst = QC; ld = 512; cbase = (pn - 2) * 256; mode = 1; }
        else if (pn == 4) { dst = IQ; ld = 256; cbase = 0; mode = 1; }
        else if (pn == 5) { dst = MISC; ld = 256; cbase = 0; mode = 3; }
        else if (pn <= 8) { dst = pn == 6 ? KVC : (pn == 7 ? KVS : KVW); ld = 256; cbase = 0; mode = 2; }
        else if (pn <= 10) { dst = BU; ld = 512; cbase = (pn - 9) * 256; mode = 0; }
        else { dst = G; ld = 3072; cbase = (pn - 11) * 256; mode = 4; }
        const int row0 = u.pm * BM + wr * 64 + fr, col0 = cbase + wc * 32 + 8 * fq;
        const bool ropelane = ((wc & 1) == 0) && fq < 2;
        const float sc = (mode == 1) ? (pn < 4 ? 0.125f * 1.4426950408889634f : 0.125f) : 1.0f;
#pragma unroll
        for (int ai = 0; ai < 2; ++ai) {
            f32x4 csv[4], snv[4];
#pragma unroll
            for (int m = 0; m < 4; ++m) { csv[m] = (f32x4){1.f, 1.f, 1.f, 1.f}; snv[m] = (f32x4){0.f, 0.f, 0.f, 0.f}; }
            if (mode >= 1 && mode <= 3) {
#pragma unroll
                for (int m = 0; m < 4; ++m) { const float* rp = rope + (size_t)(row0 + ai * HALF + m * 16) * 16 + 4 * (fq & 1); csv[m] = *(const f32x4*)rp; snv[m] = *(const f32x4*)(rp + 8); }
            }
#pragma unroll
            for (int m = 0; m < 4; ++m) {
                const size_t row = (size_t)(row0 + ai * HALF + m * 16);
                const float rr = rs[u.ord * 256 + wr * 64 + fr + ai * HALF + m * 16];
                const f32x4 cs = csv[m], sn = snv[m];
#pragma unroll
                for (int bj = 0; bj < 2; ++bj) {
                    const f32x4 a0 = acc[ai][bj][m][0] * rr, a1 = acc[ai][bj][m][1] * rr;
                    float o[8] = {a0[0], a0[1], a0[2], a0[3], a1[0], a1[1], a1[2], a1[3]};
                    const bool dorope = ropelane && (mode == 1 || (mode == 2 && bj == 0) || (mode == 3 && bj == 0 && wc == 0));
                    if (dorope) {
#pragma unroll
                        for (int p = 0; p < 4; ++p) { const float x1 = o[2 * p], x2 = o[2 * p + 1]; o[2 * p] = x1 * cs[p] - x2 * sn[p]; o[2 * p + 1] = x2 * cs[p] + x1 * sn[p]; }
                    }
                    if (mode == 4) {
#pragma unroll
                        for (int e = 0; e < 8; ++e) o[e] = fast_sigmoid(o[e]);
                    } else {
#pragma unroll
                        for (int e = 0; e < 8; ++e) o[e] *= sc;
                    }
                    u32x4 w; w.x = cvt_pk_bf16(o[0], o[1]); w.y = cvt_pk_bf16(o[2], o[3]); w.z = cvt_pk_bf16(o[4], o[5]); w.w = cvt_pk_bf16(o[6], o[7]);
                    *(u32x4*)(dst + row * ld + col0 + bj * HALF) = w;
                }
            }
        }
    }
};


#if DUP == 31
struct EpiPlain {
    static constexpr bool PERM = true, AFTER_DRAIN = false;
    bf16_t* O;
    __device__ __forceinline__ void operator()(const f32x4 (&acc)[2][2][4][2], const Unit& u, int wr, int wc, int fr, int fq) const {
        const int row0 = u.pm * BM + wr * 64 + fr, col0 = u.pn * BM + wc * 32 + 8 * fq;
#pragma unroll
        for (int ai = 0; ai < 2; ++ai)
#pragma unroll
            for (int m = 0; m < 4; ++m)
#pragma unroll
                for (int bj = 0; bj < 2; ++bj) { const f32x4 a0 = acc[ai][bj][m][0], a1 = acc[ai][bj][m][1];
                    u32x4 w; w.x = cvt_pk_bf16(a0[0], a0[1]); w.y = cvt_pk_bf16(a0[2], a0[3]); w.z = cvt_pk_bf16(a1[0], a1[1]); w.w = cvt_pk_bf16(a1[2], a1[3]);
                    *(u32x4*)(O + (size_t)(row0 + ai * HALF + m * 16) * 1024 + col0 + bj * HALF) = w; }
    }
};
#endif
template <class Epi, class Sched, bool ALIGN_EPI = false, bool SP2 = false>
__device__ __forceinline__ void gemm_phase(PG8_LAS unsigned char* lds, const Gemm g, const Sched& S, const Epi& E, int tid_in) {
    int tid_ = tid_in; asm volatile("" : "+v"(tid_));
    const int tid = tid_, wid = __builtin_amdgcn_readfirstlane(tid >> 6), lane = tid & 63, wr = wid >> 2, wc = wid & 3, fr = lane & 15, fq = lane >> 4;
    const int K = g.K, nt = K / BK;
    unsigned voffA[2], voffB[2];
#pragma unroll
    for (int i = 0; i < 2; ++i) { int R, C; stage_rc(tid * 16 + i * 8192, R, C); const int Rb = Epi::PERM ? ((R & ~31) + perm32(R & 31)) : R;
        voffA[i] = (unsigned)(R * K + C) * 2u; voffB[i] = (unsigned)(Rb * K + C) * 2u; }
    const size_t kstep = (size_t)(BK * 2);
    const size_t hstep = (size_t)HALF * K * 2;
    const size_t tstep = 2 * hstep;
    const unsigned ldsw = (unsigned)wid * 1024u;
    const int aoff = lds_byte(wr * 64 + fr, fq * 8), boff = lds_byte(wc * 32 + fr, fq * 8);
#define PG8_SA(b, h) (((b) * 2 + (h)) * HTB)
#define PG8_SB(b, h) ((4 + (b) * 2 + (h)) * HTB)
#define PG8_STAGE(bufoff, gbase, voff) do { _Pragma("unroll") for (int _i = 0; _i < 2; ++_i) \
        __builtin_amdgcn_global_load_lds((const unsigned*)((const char*)(gbase) + (voff)[_i]), (PG8_LAS unsigned*)(lds + (bufoff) + ldsw + _i * 8192), 16, 0, 0); } while (0)
#define PG8_LDA(dst, b, h) do { _Pragma("unroll") for (int m = 0; m < 4; ++m) _Pragma("unroll") for (int k = 0; k < 2; ++k) dst[m][k] = *(const PG8_LAS bf16x8*)(lds + PG8_SA(b, h) + aoff + m * 2048 + k * 1024); } while (0)
#define PG8_LDB(dst, b, h) do { _Pragma("unroll") for (int n = 0; n < 2; ++n) _Pragma("unroll") for (int k = 0; k < 2; ++k) dst[n][k] = *(const PG8_LAS bf16x8*)(lds + PG8_SB(b, h) + boff + n * 2048 + k * 1024); } while (0)
#define PG8_MMA(ai, bj, At, Bt) do { __builtin_amdgcn_s_setprio(1); _Pragma("unroll") for (int m = 0; m < 4; ++m) _Pragma("unroll") for (int n = 0; n < 2; ++n) _Pragma("unroll") for (int k = 0; k < 2; ++k) \
        acc[ai][bj][m][n] = __builtin_amdgcn_mfma_f32_16x16x32_bf16(Bt[n][k], At[m][k], acc[ai][bj][m][n], 0, 0, 0); __builtin_amdgcn_s_setprio(0); } while (0)
#define PG8_WAIT_V(n) asm volatile("s_waitcnt vmcnt(" #n ")" ::: "memory")
#define PG8_WAIT_L(n) asm volatile("s_waitcnt lgkmcnt(" #n ")" ::: "memory")
#define PG8_BAR __builtin_amdgcn_s_barrier()
#define PG8_SCHED __builtin_amdgcn_sched_barrier(0)
    Unit cur, nxt; int ui = 0;
    if (!S.next(0, cur)) return;
    f32x4 acc[2][2][4][2];
#pragma unroll
    for (int a = 0; a < 2; ++a)
#pragma unroll
        for (int b = 0; b < 2; ++b)
#pragma unroll
            for (int m = 0; m < 4; ++m)
#pragma unroll
                for (int n = 0; n < 2; ++n) acc[a][b][m][n] = (f32x4){0.f, 0.f, 0.f, 0.f};
    bf16x8 At[4][2], B0[2][2], B1[2][2];
    const char* cA = (const char*)g.A + (size_t)cur.pm * tstep; const char* cB = (const char*)g.Bt + (size_t)cur.pn * tstep;
    S.a_ready(cur);
    if constexpr (SP2) {
        PG8_STAGE(PG8_SB(0, 0), cB, voffB); PG8_STAGE(PG8_SB(0, 1), cB + hstep, voffB); PG8_STAGE(PG8_SA(0, 0), cA, voffA); PG8_STAGE(PG8_SA(0, 1), cA + hstep, voffA);
        if (wr == 1) PG8_BAR;
        PG8_WAIT_V(2); PG8_BAR;
        PG8_STAGE(PG8_SB(1, 0), cB + kstep, voffB); PG8_STAGE(PG8_SA(1, 0), cA + kstep, voffA); PG8_STAGE(PG8_SB(1, 1), cB + hstep + kstep, voffB);
        PG8_WAIT_V(6); PG8_BAR;
    } else {
        PG8_STAGE(PG8_SB(0, 0), cB, voffB); PG8_STAGE(PG8_SA(0, 0), cA, voffA); PG8_STAGE(PG8_SB(0, 1), cB + hstep, voffB); PG8_STAGE(PG8_SA(0, 1), cA + hstep, voffA);
        if (wr == 1) PG8_BAR;
        PG8_WAIT_V(4); PG8_BAR;
        PG8_STAGE(PG8_SB(1, 0), cB + kstep, voffB); PG8_STAGE(PG8_SA(1, 0), cA + kstep, voffA); PG8_STAGE(PG8_SB(1, 1), cB + hstep + kstep, voffB);
        PG8_WAIT_V(6); PG8_BAR;
    }
    for (;;) {
        const bool has_next = S.next(ui + 1, nxt);
        const char* nA = has_next ? (const char*)g.A + (size_t)nxt.pm * tstep : cA; const char* nB = has_next ? (const char*)g.Bt + (size_t)nxt.pn * tstep : cB;
        for (int t = 0; t < nt; t += 2) {
            const bool last = (t == nt - 2);
            const char* a1 = cA + (size_t)(t + 1) * kstep;
            const char* a2 = last ? nA : cA + (size_t)(t + 2) * kstep; const char* b2 = last ? nB : cB + (size_t)(t + 2) * kstep;
            const char* a3 = a2 + kstep; const char* b3 = b2 + kstep;
            if (last && has_next) S.a_ready(nxt);
            if constexpr (SP2) {
            PG8_LDB(B0, 0, 0); PG8_LDB(B1, 0, 1); PG8_SCHED; PG8_LDA(At, 0, 0); PG8_STAGE(PG8_SA(1, 1), a1 + hstep, voffA);
            PG8_WAIT_V(8); PG8_WAIT_L(0); PG8_BAR; PG8_MMA(0, 0, At, B0); PG8_MMA(0, 1, At, B1); PG8_BAR; PG8_SCHED;
            PG8_LDA(At, 0, 1); PG8_STAGE(PG8_SB(0, 0), b2, voffB); PG8_STAGE(PG8_SB(0, 1), b2 + hstep, voffB); PG8_STAGE(PG8_SA(0, 0), a2, voffA);
            PG8_WAIT_V(8); PG8_WAIT_L(0); PG8_BAR; PG8_MMA(1, 0, At, B0); PG8_MMA(1, 1, At, B1); PG8_BAR; PG8_SCHED;
            PG8_LDB(B0, 1, 0); PG8_LDB(B1, 1, 1); PG8_SCHED; PG8_LDA(At, 1, 0); PG8_STAGE(PG8_SA(0, 1), a2 + hstep, voffA);
            PG8_WAIT_V(8); PG8_WAIT_L(0); PG8_BAR; PG8_MMA(0, 0, At, B0); PG8_MMA(0, 1, At, B1); PG8_BAR; PG8_SCHED;
            PG8_LDA(At, 1, 1); PG8_STAGE(PG8_SB(1, 0), b3, voffB); PG8_STAGE(PG8_SB(1, 1), b3 + hstep, voffB); PG8_STAGE(PG8_SA(1, 0), a3, voffA);
            PG8_WAIT_V(8); PG8_WAIT_L(0); PG8_BAR; PG8_MMA(1, 0, At, B0); PG8_MMA(1, 1, At, B1); PG8_BAR; PG8_SCHED;
            } else {
            PG8_LDB(B0, 0, 0); PG8_SCHED; PG8_LDA(At, 0, 0); PG8_STAGE(PG8_SA(1, 1), a1 + hstep, voffA);
            PG8_WAIT_L(8); PG8_BAR; PG8_WAIT_L(0); PG8_MMA(0, 0, At, B0); PG8_BAR; PG8_SCHED;
            PG8_LDB(B1, 0, 1); PG8_STAGE(PG8_SB(0, 0), b2, voffB);
            PG8_BAR; PG8_WAIT_L(0); PG8_MMA(0, 1, At, B1); PG8_BAR;
            PG8_LDA(At, 0, 1); PG8_STAGE(PG8_SA(0, 0), a2, voffA);
            PG8_BAR; PG8_WAIT_L(0); PG8_MMA(1, 0, At, B0); PG8_BAR; PG8_SCHED;
            PG8_STAGE(PG8_SB(0, 1), b2 + hstep, voffB);
            PG8_WAIT_V(6); PG8_BAR; PG8_MMA(1, 1, At, B1); PG8_BAR;
            PG8_LDB(B0, 1, 0); PG8_SCHED; PG8_LDA(At, 1, 0); PG8_STAGE(PG8_SA(0, 1), a2 + hstep, voffA);
            PG8_WAIT_L(8); PG8_BAR; PG8_WAIT_L(0); PG8_MMA(0, 0, At, B0); PG8_BAR; PG8_SCHED;
            PG8_LDB(B1, 1, 1); PG8_STAGE(PG8_SB(1, 0), b3, voffB);
            PG8_BAR; PG8_WAIT_L(0); PG8_MMA(0, 1, At, B1); PG8_BAR;
            PG8_LDA(At, 1, 1); PG8_STAGE(PG8_SA(1, 0), a3, voffA);
            PG8_BAR; PG8_WAIT_L(0); PG8_MMA(1, 0, At, B0); PG8_BAR; PG8_SCHED;
            PG8_STAGE(PG8_SB(1, 1), b3 + hstep, voffB);
            PG8_WAIT_V(6); PG8_BAR; PG8_MMA(1, 1, At, B1); PG8_BAR;
            }
        }
        if constexpr (ALIGN_EPI) { if (wr == 0) PG8_BAR; }
        if constexpr (!Epi::AFTER_DRAIN) { E(acc, cur, wr, wc, fr, fq); S.done(cur); }
        if (!has_next) break;
#pragma unroll
        for (int a = 0; a < 2; ++a)
#pragma unroll
            for (int b = 0; b < 2; ++b)
#pragma unroll
                for (int m = 0; m < 4; ++m)
#pragma unroll
                    for (int n = 0; n < 2; ++n) acc[a][b][m][n] = (f32x4){0.f, 0.f, 0.f, 0.f};
        cur = nxt; cA = nA; cB = nB; ++ui;
        if constexpr (ALIGN_EPI) { if (wr == 1) PG8_BAR; }
    }
    PG8_WAIT_V(0);
    if constexpr (!ALIGN_EPI) { if (wr == 0) PG8_BAR; }
    PG8_BAR;
    if constexpr (Epi::AFTER_DRAIN) { E.fused(acc, cur, wr, wc, fr, fq, lds, wid, lane); S.done(cur); }
#undef PG8_SA
#undef PG8_SB
#undef PG8_STAGE
#undef PG8_LDA
#undef PG8_LDB
#undef PG8_MMA
#undef PG8_WAIT_V
#undef PG8_WAIT_L
#undef PG8_BAR
#undef PG8_SCHED
}
}
#define GAS __attribute__((address_space(1)))
#define LAS __attribute__((address_space(3)))
typedef unsigned short bf16;
typedef unsigned v4u __attribute__((ext_vector_type(4)));
typedef float f32x4 __attribute__((ext_vector_type(4)));
typedef short bf16x8 __attribute__((ext_vector_type(8)));
typedef GAS unsigned gu32;
typedef GAS unsigned long long gu64;
#define RLX_AGENT __ATOMIC_RELAXED, __HIP_MEMORY_SCOPE_AGENT
#define LDS_WAIT() asm volatile("s_waitcnt lgkmcnt(0)" ::: "memory")
#define VM_WAIT() asm volatile("s_waitcnt vmcnt(0)" ::: "memory")
__device__ __forceinline__ unsigned long long rt() { return __builtin_amdgcn_s_memrealtime(); }
__device__ __forceinline__ unsigned f2bf(float f) { unsigned u = __builtin_bit_cast(unsigned, f); return (u + 0x7fffu + ((u >> 16) & 1u)) >> 16; }
__device__ __forceinline__ unsigned pk2(float lo, float hi) { return f2bf(lo) | (f2bf(hi) << 16); }
#define XB_TMO      128
#define XB_XCNT(j)  (256  + 64 * (j))
#define XB_XSUB(j)  (1280 + 64 * (j))
#define XB_XGEN(j)  (2304 + 64 * (j))
#define XB_TOP      3328
#define XB_TOPGEN   3392
#define XCD_BAR_WORDS 3456
#define XB_SPIN_CAP (1u << 18)

__device__ __forceinline__ unsigned xb_ld(unsigned* p)              { return __hip_atomic_load(p, __ATOMIC_RELAXED, __HIP_MEMORY_SCOPE_AGENT); }
__device__ __forceinline__ unsigned xb_add(unsigned* p, unsigned v) { return __hip_atomic_fetch_add(p, v, __ATOMIC_RELAXED, __HIP_MEMORY_SCOPE_AGENT); }
__device__ __forceinline__ unsigned xb_xcc_id() { return (unsigned)__builtin_amdgcn_s_getreg((3 << 11) | 20) & 0xFu; }
#define XB_SPIN(cond, bar) do { unsigned _sp = 0; while (cond) { __builtin_amdgcn_s_sleep(1); \
    if ((++_sp & 255u) == 0u) { if (xb_ld(&(bar)[XB_TMO])) break; if (_sp > XB_SPIN_CAP) { atomicAdd(&(bar)[XB_TMO], 1u); break; } } } } while (0)

struct XcdBarrier {
    unsigned* bar; unsigned x;
    volatile LAS unsigned* st;
};

__device__ __forceinline__ XcdBarrier xcd_barrier_post(unsigned* bar, volatile LAS unsigned* st) {
    XcdBarrier b; b.bar = bar; b.x = xb_xcc_id(); b.st = st;
    if (threadIdx.x == 0) (void)xb_add(&bar[XB_XCNT(b.x)], 1u);
    return b;
}
__device__ __forceinline__ void xcd_barrier_complete(unsigned* bar, unsigned x, unsigned& nloc, unsigned& nx) {
    const unsigned G = gridDim.x * gridDim.y * gridDim.z;
    unsigned sum, cnt, mine, sp = 0u;
    for (;;) {
        sum = 0u; cnt = 0u; mine = 0u;
#pragma unroll
        for (unsigned j = 0; j < 16; ++j) { const unsigned c = xb_ld(&bar[XB_XCNT(j)]); sum += c; cnt += (c > 0u) ? 1u : 0u; mine = (j == x) ? c : mine; }
        if (sum == G) break;
        __builtin_amdgcn_s_sleep(1);
        if ((++sp & 255u) == 0u) { if (xb_ld(&bar[XB_TMO])) break; if (sp > XB_SPIN_CAP) { atomicAdd(&bar[XB_TMO], 1u); break; } }
    }
    nloc = mine > 0u ? mine : 1u; nx = cnt > 0u ? cnt : 1u;
}

__device__ __forceinline__ void xcd_barrier(const XcdBarrier& b) {
    asm volatile("s_waitcnt vmcnt(0)" ::: "memory");
    __syncthreads();
    if (threadIdx.x == 0) {
        unsigned* bar = b.bar;
        __builtin_amdgcn_s_waitcnt(0);
        unsigned nloc = b.st[0], nx = b.st[1];
        if (nloc == 0u) { xcd_barrier_complete(bar, b.x, nloc, nx); b.st[0] = nloc; b.st[1] = nx; }
        const unsigned old = xb_add(&bar[XB_XSUB(b.x)], 1u);
        const unsigned gen = old / nloc;
        if (old + 1u == (gen + 1u) * nloc) {
            __builtin_amdgcn_fence(__ATOMIC_RELEASE, "agent");
            asm volatile("s_waitcnt vmcnt(0)" ::: "memory");
            const unsigned og = xb_add(&bar[XB_TOP], 1u);
            const unsigned tg = og / nx;
            if (og + 1u == (tg + 1u) * nx) xb_add(&bar[XB_TOPGEN], 1u);
            else XB_SPIN(xb_ld(&bar[XB_TOPGEN]) == tg, bar);
            __builtin_amdgcn_fence(__ATOMIC_ACQUIRE, "agent");
            xb_add(&bar[XB_XGEN(b.x)], 1u);
            asm volatile("s_waitcnt vmcnt(0)" ::: "memory");
        } else {
            XB_SPIN(xb_ld(&bar[XB_XGEN(b.x)]) == gen, bar);
            __builtin_amdgcn_fence(__ATOMIC_ACQUIRE, "agent");
            asm volatile("s_waitcnt vmcnt(0)" ::: "memory");
        }
    }
    __syncthreads();
}
constexpr int NB = 8, SEQ = 4096, DM = 1024, DEPTH = 4, M = NB * SEQ;
constexpr int FF = 2816, NIN = 5852, NINP = 5888;
constexpr float EPS = 1e-6f, NEGF = -1e30f;
constexpr int NWAVES = 8;
constexpr size_t MiB = 1u << 20;
constexpr size_t WS_CTL = 0, CTL_ZERO_BYTES = 1 * MiB;
constexpr size_t WS_ROPE = 1 * MiB;
constexpr size_t WS_KVA = 3 * MiB;
constexpr size_t WS_KC = 11 * MiB, WS_VC = WS_KC + 512 * 1024;
constexpr size_t WS_W = 12 * MiB;
constexpr size_t WO_GU1 = 0, WO_D1 = 11 * MiB, WO_GU2 = WO_D1 + 5 * MiB + 512 * 1024, WO_D2 = WO_GU2 + 11 * MiB, WO_IN = WO_D2 + 5 * MiB + 512 * 1024,
                 WO_PA = WO_IN + 11 * MiB + 512 * 1024, WO_PB = WO_PA + MiB, WO_PC = WO_PB + MiB, WO_OUT = WO_PC + MiB,
                 WO_CW1 = WO_OUT + 2 * MiB  , WO_CW2 = WO_CW1 + MiB  , WO_UKV = WO_CW2 + 32768  , WO_POOL = WO_UKV + 32768  ,
                 WO_POSB = WO_POOL + 131072  , WO_END = WO_POSB + 1024;
static_assert(WO_END <= 52 * MiB, "weights region");
constexpr size_t WS_XN = 64 * MiB;
constexpr size_t WS_R = 128 * MiB;
constexpr size_t WS_G = WS_R, WS_QA = WS_R + 192 * MiB, WS_QC = WS_QA + 32 * MiB, WS_IQ = WS_QC + 32 * MiB, WS_MISC = WS_IQ + 16 * MiB,
                 WS_KVC = WS_MISC + 16 * MiB, WS_KVS = WS_KVC + 16 * MiB, WS_KVW = WS_KVS + 16 * MiB, WS_BU = WS_KVW + 16 * MiB, WS_END = WS_BU + 32 * MiB;
#ifndef YB_SPARE
#define YB_SPARE 0
#endif
constexpr size_t WS_YB = YB_SPARE ? 496 * MiB : WS_XN;
constexpr size_t WS_MG = WS_IQ;
constexpr size_t WS_H = WS_R;
static_assert(WS_END == 496 * MiB, "ws map");
constexpr int RING_BYTES = 131072, LDS_BYTES = 163840, LDSCTL_OFF = 163840 - 256;
constexpr size_t WS_SSQ = 496 * MiB;
constexpr int RS_OFF = 131072;
constexpr int NPL = 10, NPH = 1 + DEPTH * NPL + 1;


#ifndef TPROBE
#define TPROBE 0
#endif
#if TPROBE
#define TP_DECL unsigned long long tp_t_ = __builtin_amdgcn_s_memtime();
#define TP_MARK(k) do { const unsigned long long n_ = __builtin_amdgcn_s_memtime(); if (tid == 0) atomicAdd((unsigned long long*)(ws + 32768) + (k), n_ - tp_t_); tp_t_ = n_; } while (0)
#define TP_ADD(k, v) do { if (tid == 0) atomicAdd((unsigned long long*)(ws + 32768) + (k), (unsigned long long)(v)); } while (0)
#else
#define TP_DECL
#define TP_MARK(k)
#define TP_ADD(k, v)
#endif
__device__ __forceinline__ int lane_id_v() { int l; asm volatile("v_mbcnt_lo_u32_b32 %0, -1, 0\n\tv_mbcnt_hi_u32_b32 %0, -1, %0" : "=v"(l)); return l; }
__device__ __forceinline__ float bflo(unsigned w) { return __uint_as_float(w << 16); }
__device__ __forceinline__ float bfhi(unsigned w) { return __uint_as_float(w & 0xffff0000u); }
__device__ __forceinline__ float bf2f(bf16 v) { return __uint_as_float((unsigned)v << 16); }
__device__ __forceinline__ float wave_sum(float v) {
#pragma unroll
    for (int o = 1; o < 64; o <<= 1) v += __shfl_xor(v, o);
    return v;
}
__device__ __forceinline__ float wave_max(float v) {
#pragma unroll
    for (int o = 1; o < 64; o <<= 1) v = fmaxf(v, __shfl_xor(v, o));
    return v;
}
__device__ __forceinline__ int wave_sum_i(int v) {
#pragma unroll
    for (int o = 1; o < 64; o <<= 1) v += __shfl_xor(v, o);
    return v;
}
__device__ __forceinline__ unsigned wave_max_u(unsigned v) {
#pragma unroll
    for (int o = 1; o < 64; o <<= 1) { const unsigned w = (unsigned)__shfl_xor((int)v, o); v = w > v ? w : v; }
    return v;
}
#define WAVE_LDS_SYNC() do { asm volatile("s_waitcnt lgkmcnt(0)" ::: "memory"); __builtin_amdgcn_wave_barrier(); } while (0)
__host__ __device__ __forceinline__ int permd(int d) { return d < 8 ? 2 * d : (d < 16 ? 2 * (d - 8) + 1 : d); }
__device__ __forceinline__ int win_newcol(int n) {
    if (n < 512) return (n & ~63) + permd(n & 63);
    if (n < 640) return 1280 + 64 + (n - 512);
    if (n < 896) { const int m = n - 640; return 1024 + (m & ~63) + permd(m & 63); }
    if (n < 960) return 1280 + permd(n - 896);
    if (n < 964) return 1280 + 192 + (n - 960);
    if (n < 1476) return 2304 + (n - 964);
    if (n < 1988) { const int m = n - 1476; return 512 + (m & ~63) + permd(m & 63); }
    if (n < 2756) { const int m = n - 1988, kv = m >> 8, r = m & 255, base = 1536 + kv * 256; return r < 128 ? base + (r & ~63) + permd(r & 63) : base + r; }
    if (n < 2780) return 1280 + 196 + (n - 2756);
    return 2816 + (n - 2780);
}
__device__ __forceinline__ int map_row(int mode, int n) { return mode == 0 ? n : (mode == 1 ? ((n >> 7) << 8) + (n & 127) : (mode == 2 ? ((n >> 7) << 8) + 128 + (n & 127) : win_newcol(n))); }

struct Args { const float* in[24]; float* out; unsigned char* ws; int ph_lo, ph_hi; };

__device__ __forceinline__ int unperm(int p) { return p < 16 ? ((p & 1) ? (p >> 1) + 8 : (p >> 1)) : p; }
__device__ __forceinline__ void tr_item(const float* W, int K, int N, bf16* WT, int mode, LAS float* scr, int item, int lane, bool kperm = false, const float* kscale = nullptr) {
    const int nblk = (N + 31) >> 5, kb = item / nblk, nb = item - kb * nblk, k0 = 64 * kb, n0 = 32 * nb;
    const int nn = n0 + (lane & 31);
    const int nnc = nn < N ? nn : N - 1; const float msk = nn < N ? 1.0f : 0.0f;
    const float* ksp = kscale ? kscale : W; const bool hs = kscale != nullptr;
    float wv[32], sv[32];
#pragma unroll
    for (int i = 0; i < 32; ++i) { const int kk = 2 * i + (lane >> 5); wv[i] = W[(size_t)(k0 + kk) * N + nnc]; sv[i] = ksp[k0 + kk]; }
#pragma unroll
    for (int i = 0; i < 32; ++i) { const int kk = 2 * i + (lane >> 5); scr[kk * 33 + (lane & 31)] = wv[i] * (hs ? sv[i] : 1.0f) * msk; }
    LDS_WAIT(); asm volatile("" ::: "memory");
    const int c = lane & 7;
#pragma unroll
    for (int j = 0; j < 4; ++j) { const int n = (lane >> 3) + 8 * j; const LAS float* s = scr + n;
        int ks[8];
#pragma unroll
        for (int i = 0; i < 8; ++i) ks[i] = (kperm ? unperm(8 * c + i) : 8 * c + i) * 33;
        v4u o; o.x = pk2(s[ks[0]], s[ks[1]]); o.y = pk2(s[ks[2]], s[ks[3]]); o.z = pk2(s[ks[4]], s[ks[5]]); o.w = pk2(s[ks[6]], s[ks[7]]);
        if (n0 + n < N) *(v4u*)(WT + (size_t)map_row(mode, n0 + n) * K + k0 + 8 * c) = o; }
    LDS_WAIT(); asm volatile("" ::: "memory");
}
__device__ __forceinline__ void phase_convert(const Args& P, unsigned char* ws, int z, int l, LAS unsigned char* lds, int gw, int NGW, int lane, int wave) {
    asm volatile("" : "+v"(lane)); lane &= 63; asm volatile("" : "+s"(gw), "+s"(NGW));
    LAS float* scr = (LAS float*)(lds + wave * 16384);
    unsigned char* wb = ws + WS_W;
    constexpr int I_F = 16 * 88, I_D = 44 * 32, I_IN = 16 * 183, I_P = 8 * 32, I_O = 16 * 32;
    constexpr int I_C = 32 * 4;
    constexpr int NIT = 4 * I_F + 2 * I_D + I_IN + 3 * I_P + I_O + 2 * I_C;
    const size_t fo = (size_t)l * DM * FF;
    for (int it = gw; it < NIT; it += NGW) {
        int r = it, K = DM, N = FF, mode = 1; const float* W = P.in[3 + z] + fo; size_t wo = WO_GU1; bool kperm = false; const float* ksc = P.in[2 + z] + l * DM;
        if (r >= I_F) { r -= I_F; mode = 2; W = P.in[4 + z] + fo;
        if (r >= I_F) { r -= I_F; mode = 0; W = P.in[5 + z] + fo; K = FF; N = DM; wo = WO_D1; ksc = nullptr;
        if (r >= I_D) { r -= I_D; mode = 1; W = P.in[20 + z] + fo; K = DM; N = FF; wo = WO_GU2; ksc = P.in[19 + z] + l * DM;
        if (r >= I_F) { r -= I_F; mode = 2; W = P.in[21 + z] + fo;
        if (r >= I_F) { r -= I_F; mode = 0; W = P.in[22 + z] + fo; K = FF; N = DM; wo = WO_D2; ksc = nullptr;
        if (r >= I_D) { r -= I_D; mode = 3; W = P.in[7 + z] + (size_t)l * DM * NIN; K = DM; N = NIN; wo = WO_IN; ksc = P.in[6 + z] + l * DM;
        if (r >= I_IN) { r -= I_IN; mode = 0; W = P.in[15 + z] + (size_t)l * 512 * DM; K = 512; N = DM; wo = WO_PA; ksc = nullptr;
        if (r >= I_P) { r -= I_P; W = P.in[16 + z] + (size_t)l * 512 * DM; wo = WO_PB;
        if (r >= I_P) { r -= I_P; W = P.in[17 + z] + (size_t)l * 512 * DM; wo = WO_PC;
        if (r >= I_P) { r -= I_P; W = P.in[18 + z] + (size_t)l * DM * DM; K = DM; wo = WO_OUT;
        if (r >= I_O) { r -= I_O; W = P.in[13 + z] + (size_t)(l * 2) * 2048 * 128; K = 2048; N = 128; wo = WO_CW1; kperm = true;
        if (r >= I_C) { r -= I_C; W += (size_t)2048 * 128; wo = WO_CW1 + 128 * 2048 * 2; kperm = false; } } } } } } } } } } } }
        tr_item(W, K, N, (bf16*)(wb + wo), mode, scr, r, lane, kperm, ksc);
    }
    {
        const int gt = gw * 64 + lane, GT = NGW * 64;
        bf16* ukv = (bf16*)(wb + WO_UKV); bf16* pool = (bf16*)(wb + WO_POOL); bf16* cw2 = (bf16*)(wb + WO_CW2); float* posb = (float*)(wb + WO_POSB);
        const float* w_ukv = P.in[9 + z] + (size_t)l * 128 * 128; const float* gn = P.in[8 + z] + l * 128;
        for (int i = gt; i < 128 * 128; i += GT) { const int np = i >> 7, k = i & 127, n = np < 64 ? unperm(np) : np; ukv[i] = (bf16)f2bf(gn[k] * w_ukv[k * 128 + n]); }
        const float* pw = P.in[10 + z] + (size_t)l * 4 * 128 * 128; const float* psc = P.in[11 + z] + l * 512;
        for (int i = gt; i < 4 * 128 * 128; i += GT) { const int g = i >> 14, d = (i >> 7) & 127, c = i & 127; pool[i] = (bf16)f2bf(pw[(g * 128 + c) * 128 + d] * psc[g * 128 + d]); }
        const float* w2 = P.in[14 + z] + (size_t)l * 2 * 128 * 64;
        for (int i = gt; i < 2 * 64 * 128; i += GT) { const int br = i >> 13, dp = (i >> 7) & 63, n = i & 127, d = br ? dp : unperm(dp); cw2[i] = (bf16)f2bf(w2[(br * 128 + n) * 64 + d]); }
        const float* w1 = P.in[13 + z] + (size_t)l * 2 * 2048 * 128; const float* pos = P.in[12 + z] + (size_t)l * 2 * 2048;
        for (int i = gw; i < 256; i += NGW) { const int br = i >> 7, n = i & 127; float a = 0.f;
#pragma unroll 8
            for (int k = lane; k < 2048; k += 64) a += pos[br * 2048 + k] * w1[((size_t)br * 2048 + k) * 128 + n];
            a = wave_sum(a); if (lane == 0) posb[i] = a; }
    }
    if (gw < 36) { unsigned zz = 0u; asm volatile("" : "+v"(zz)); v4u z = {zz, zz, zz, zz}; v4u* rp = (v4u*)((bf16*)(wb + WO_IN) + (size_t)(1500 + gw) * DM); for (int i = lane; i < DM / 8; i += 64) rp[i] = z; }
}
__device__ __forceinline__ void phase_rope(const Args& P, unsigned char* ws, int z, int gtid, int gthreads) {
    float* rope = (float*)(ws + WS_ROPE);
    for (int idx = gtid; idx < M * 8; idx += gthreads) {
        const int row = idx >> 3, i = idx & 7;
        const double inv = i == 0 ? 1.0 : i == 1 ? 0.19392274474868576 : i == 2 ? 0.03760603093086393 : i == 3 ? 0.007292664737217109 : i == 4 ? 0.001414213562373095 : i == 5 ? 0.0002742481756762073 : i == 6 ? 5.318295896944988e-05 : 1.031338537721246e-05;
        const double ang = (double)((const int*)P.in[1 + z])[row] * inv;
        double s, c; sincos(ang, &s, &c);
        rope[row * 16 + i] = (float)c; rope[row * 16 + 8 + i] = (float)s;
    }
}
__device__ __forceinline__ void norm_row_bf16(const float* xrow, const float* gain, bf16* orow, int lane) {
    const f32x4* xr = (const f32x4*)xrow + lane; const f32x4* gr = (const f32x4*)gain + lane;
    f32x4 v[4]; float s = 0.f;
#pragma unroll
    for (int j = 0; j < 4; ++j) { v[j] = xr[64 * j]; s += (v[j].x * v[j].x + v[j].y * v[j].y) + (v[j].z * v[j].z + v[j].w * v[j].w); }
    const float r = 1.0f / sqrtf(wave_sum(s) * (1.f / DM) + EPS);
    unsigned long long* o8 = (unsigned long long*)orow + lane;
#pragma unroll
    for (int j = 0; j < 4; ++j) { const f32x4 g = gr[64 * j]; o8[64 * j] = (unsigned long long)pk2(v[j].x * r * g.x, v[j].y * r * g.y) | ((unsigned long long)pk2(v[j].z * r * g.z, v[j].w * r * g.w) << 32); }
}
__device__ __forceinline__ void stat_row_bf16(const float* xrow, bf16* orow, float* ssq16, int lane) {
    const f32x4* xr = (const f32x4*)xrow + lane;
    f32x4 v[4]; float s = 0.f;
#pragma unroll
    for (int j = 0; j < 4; ++j) { v[j] = xr[64 * j]; s += (v[j].x * v[j].x + v[j].y * v[j].y) + (v[j].z * v[j].z + v[j].w * v[j].w); }
    s = wave_sum(s);
    unsigned long long* o8 = (unsigned long long*)orow + lane;
#pragma unroll
    for (int j = 0; j < 4; ++j) o8[64 * j] = (unsigned long long)pk2(v[j].x, v[j].y) | ((unsigned long long)pk2(v[j].z, v[j].w) << 32);
    if (lane < 16) ssq16[lane] = lane == 0 ? s : 0.f;
}
__device__ __forceinline__ void norm_row_f32(float* xrow, const float* gain, int lane, float tps = 1.0f) {
    f32x4* xr = (f32x4*)xrow + lane; const f32x4* gr = (const f32x4*)gain + lane;
    f32x4 v[4]; float s = 0.f;
#pragma unroll
    for (int j = 0; j < 4; ++j) { v[j] = xr[64 * j]; s += (v[j].x * v[j].x + v[j].y * v[j].y) + (v[j].z * v[j].z + v[j].w * v[j].w); }
    const float r = tps / sqrtf(wave_sum(s) * (1.f / DM) + EPS);
#pragma unroll
    for (int j = 0; j < 4; ++j) { const f32x4 g = gr[64 * j]; xr[64 * j] = v[j] * r * g; }
}

__device__ __forceinline__ void norm_row_out(const bf16* xrow, float* orow, const float* gain, int lane, float tps = 1.0f) {
    const v4u a = *(const v4u*)(xrow + 16 * lane), b = *(const v4u*)(xrow + 16 * lane + 8);
    const float f[16] = {bflo(a.x), bfhi(a.x), bflo(a.y), bfhi(a.y), bflo(a.z), bfhi(a.z), bflo(a.w), bfhi(a.w), bflo(b.x), bfhi(b.x), bflo(b.y), bfhi(b.y), bflo(b.z), bfhi(b.z), bflo(b.w), bfhi(b.w)};
    float s = 0.f;
#pragma unroll
    for (int e = 0; e < 16; ++e) s += f[e] * f[e];
    const float r = tps / sqrtf(wave_sum(s) * (1.f / DM) + EPS);
    const f32x4* gr = (const f32x4*)(gain + 16 * lane); f32x4* orr = (f32x4*)(orow + 16 * lane);
#pragma unroll
    for (int j = 0; j < 4; ++j) { const f32x4 g = gr[j]; f32x4 o; o.x = f[4 * j] * r * g.x; o.y = f[4 * j + 1] * r * g.y; o.z = f[4 * j + 2] * r * g.z; o.w = f[4 * j + 3] * r * g.w; orr[j] = o; }
}
__device__ __forceinline__ unsigned f2o(float s) { const int b = (int)__float_as_uint(s); return (unsigned)(b ^ ((b >> 31) | (int)0x80000000)); }
__device__ __forceinline__ void unpack8(const v4u v, float* f) { f[0] = bflo(v.x); f[1] = bfhi(v.x); f[2] = bflo(v.y); f[3] = bfhi(v.y); f[4] = bflo(v.z); f[5] = bfhi(v.z); f[6] = bflo(v.w); f[7] = bfhi(v.w); }
__device__ __forceinline__ void load_row64(const bf16* p, float* f) {
    const v4u* q = (const v4u*)p;
#pragma unroll
    for (int i = 0; i < 8; ++i) unpack8(q[i], f + 8 * i);
}
__device__ __forceinline__ float dot64(const LAS float* q, const float* k) {
    float d = 0.f;
#pragma unroll
    for (int i = 0; i < 16; ++i) { const f32x4 qq = *(const LAS f32x4*)(q + 4 * i); d += qq.x * k[4 * i] + qq.y * k[4 * i + 1] + qq.z * k[4 * i + 2] + qq.w * k[4 * i + 3]; }
    return d;
}
__device__ __forceinline__ void dsa_query(const Args& P, unsigned char* ws, int z, int row, LAS unsigned char* wl, int lane) {
    const int b = row >> 12, t = row & (SEQ - 1), n = t + 1;
    LAS unsigned* su = (LAS unsigned*)wl; LAS float* pb = (LAS float*)wl; LAS unsigned short* list = (LAS unsigned short*)(wl + 16384); LAS float* qb = (LAS float*)(wl + 16896);
    const bf16* misc = (const bf16*)(ws + WS_MISC);
    const unsigned long long lt = (1ull << lane) - 1ull;
    int nsel;
    if (n <= 256) { for (int i = lane; i < n; i += 64) list[i] = (unsigned short)i; nsel = n; }
    else {
        { const uint2 v = *(const uint2*)((const bf16*)(ws + WS_IQ) + (size_t)row * 256 + lane * 4); qb[lane * 4] = bflo(v.x); qb[lane * 4 + 1] = bfhi(v.x); qb[lane * 4 + 2] = bflo(v.y); qb[lane * 4 + 3] = bfhi(v.y); }
        float iw[4]; { const uint2 v = *(const uint2*)(misc + (size_t)row * 256 + 192); iw[0] = 0.5f * bflo(v.x); iw[1] = 0.5f * bfhi(v.x); iw[2] = 0.5f * bflo(v.y); iw[3] = 0.5f * bfhi(v.y); }
        WAVE_LDS_SYNC();
        const int nch = (n + 63) >> 6;
        for (int i = 0; i < nch; ++i) {
            const int key = i * 64 + lane; const bool valid = key <= t;
            float kf[64]; load_row64(misc + (size_t)(b * SEQ + (valid ? key : t)) * 256, kf);
            float s = 0.f;
#pragma unroll
            for (int h = 0; h < 4; ++h) s += iw[h] * fmaxf(dot64(qb + h * 64, kf), 0.f);
            su[key] = valid ? f2o(s) : 0u;
        }
        WAVE_LDS_SYNC();
        unsigned prefix = 0u;
        for (int bit = 31; bit >= 0; --bit) {
            const unsigned cand = prefix | (1u << bit); int c = 0;
            for (int i = 0; i < nch; ++i) c += (su[i * 64 + lane] >= cand) ? 1 : 0;
            c = wave_sum_i(c);
            if (c >= 256) prefix = cand;
            if (c == 256) break;
        }
        int cgt = 0;
        for (int i = 0; i < nch; ++i) cgt += (su[i * 64 + lane] > prefix) ? 1 : 0;
        const int need_eq = 256 - wave_sum_i(cgt);
        int base = 0, eq_taken = 0;
        for (int i = 0; i < nch; ++i) {
            const unsigned v = su[i * 64 + lane]; const bool gt = v > prefix, eq = v == prefix;
            const unsigned long long meq = __ballot(eq);
            const bool sel = gt || (eq && (eq_taken + __popcll(meq & lt)) < need_eq);
            const unsigned long long ms = __ballot(sel);
            if (sel) list[base + __popcll(ms & lt)] = (unsigned short)(i * 64 + lane);
            base += __popcll(ms); eq_taken += __popcll(meq);
        }
        nsel = 256;
    }
    { const v4u v = *(const v4u*)((const bf16*)(ws + WS_QA) + (size_t)row * 512 + lane * 8); float f[8]; unpack8(v, f);
#pragma unroll
      for (int e = 0; e < 8; ++e) qb[lane * 8 + e] = f[e]; }
    WAVE_LDS_SYNC();
    const bf16* kva = (const bf16*)(ws + WS_KVA);
    float s[8][4];
#pragma unroll
    for (int j = 0; j < 4; ++j) {
        const int slot = lane + 64 * j; const bool valid = slot < nsel; const int key = list[valid ? slot : 0];
        float kf[64]; load_row64(kva + (size_t)(b * SEQ + key) * 128, kf);
#pragma unroll
        for (int h = 0; h < 8; ++h) s[h][j] = valid ? dot64(qb + h * 64, kf) : NEGF;
    }
    float linv[8];
#pragma unroll
    for (int h = 0; h < 8; ++h) {
        const float m = wave_max(fmaxf(fmaxf(s[h][0], s[h][1]), fmaxf(s[h][2], s[h][3]))); float ls = 0.f;
#pragma unroll
        for (int j = 0; j < 4; ++j) { const float p = __expf(s[h][j] - m); ls += p; pb[h * 256 + lane + 64 * j] = p; }
        linv[h] = 1.0f / wave_sum(ls);
    }
    WAVE_LDS_SYNC();
    float acc[8] = {0.f, 0.f, 0.f, 0.f, 0.f, 0.f, 0.f, 0.f};
    for (int slot = 0; slot < nsel; ++slot) {
        const float v = bf2f(kva[(size_t)(b * SEQ + list[slot]) * 128 + 64 + lane]);
#pragma unroll
        for (int h = 0; h < 8; ++h) acc[h] += pb[h * 256 + slot] * v;
    }
    bf16* ya = (bf16*)(ws + WS_QA) + (size_t)row * 512;
#pragma unroll
    for (int h = 0; h < 8; ++h) ya[h * 64 + lane] = (bf16)f2bf(acc[h] * linv[h]);
    WAVE_LDS_SYNC();
}
typedef short s16x4 __attribute__((ext_vector_type(4)));
typedef short v4i16_t __attribute__((ext_vector_type(4)));
typedef float f32x4v __attribute__((ext_vector_type(4)));
typedef __bf16 bf16x2_t __attribute__((ext_vector_type(2)));
typedef float f32x2_t __attribute__((ext_vector_type(2)));
__device__ __forceinline__ unsigned cvtpk(float lo, float hi) { f32x2_t v = {lo, hi}; bf16x2_t b = __builtin_convertvector(v, bf16x2_t); return __builtin_bit_cast(unsigned, b); }
constexpr float L2E = 1.4426950408889634f;
#ifndef NSA_JOINT
#define NSA_JOINT 0
#endif
#ifndef NSA_NOSKIP
#define NSA_NOSKIP 0
#endif
constexpr int NSA_KSTR = 72, NSA_VSTR = 80;
constexpr int NSA_KB = 64 * NSA_KSTR * 2, NSA_VB = 64 * NSA_VSTR * 2;
constexpr int NSA_D = 6, NSA_SLOT = 16384;
constexpr int NSA_OFF_RING = 0, NSA_OFF_KCL = 0, NSA_OFF_VCTL = 32768  , NSA_OFF_IMPA = 65536  , NSA_OFF_IMPB = NSA_OFF_IMPA + 64 * 65 * 4, NSA_OFF_UM = NSA_D * NSA_SLOT + 1024  , NSA_OFF_QM = NSA_OFF_UM + 64, NSA_OFF_ST = NSA_OFF_UM + 1024, NSA_LDS = NSA_OFF_ST + 512 * 64;
__device__ __forceinline__ s16x4 tr16(const LAS unsigned char* p) { return __builtin_bit_cast(s16x4, __builtin_amdgcn_ds_read_tr16_b64_v4i16((LAS v4i16_t*)p)); }
__device__ __forceinline__ bf16x8 cat4(s16x4 a, s16x4 b) { return __builtin_shufflevector(a, b, 0, 1, 2, 3, 4, 5, 6, 7); }
__device__ __forceinline__ bf16x8 pack8(float a0, float a1, float a2, float a3, float b0, float b1, float b2, float b3) {
    v4u w; w.x = pg8::cvt_pk_bf16(a0, a1); w.y = pg8::cvt_pk_bf16(a2, a3); w.z = pg8::cvt_pk_bf16(b0, b1); w.w = pg8::cvt_pk_bf16(b2, b3); return __builtin_bit_cast(bf16x8, w);
}
__device__ __forceinline__ float xmax16(float v) { v = fmaxf(v, __shfl_xor(v, 16)); return fmaxf(v, __shfl_xor(v, 32)); }
__device__ __forceinline__ float xsum16(float v) { v += __shfl_xor(v, 16); return v + __shfl_xor(v, 32); }

__device__ __forceinline__ void nsa_fetch(const bf16* kv, int b, int jb, int g, int tid, v4u& kr, v4u& vr) {
    const bf16* p = kv + (size_t)(b * SEQ + 64 * jb + (tid >> 3)) * 256 + g * 64 + (tid & 7) * 8;
    kr = *(const v4u*)p; vr = *(const v4u*)(p + 128);
}
__device__ __forceinline__ void nsa_stash(LAS unsigned char* Kb, LAS unsigned char* Vb, int tid, const v4u& kr, const v4u& vr) {
    *(LAS v4u*)(Kb + ((tid >> 3) * NSA_KSTR + (tid & 7) * 8) * 2) = kr; *(LAS v4u*)(Vb + ((tid >> 3) * NSA_VSTR + (tid & 7) * 8) * 2) = vr;
}
template <bool FULL>
__device__ __forceinline__ void nsa_block2(const LAS unsigned char* Kb, const LAS unsigned char* Vb, const bf16x8 (&qf)[2][2], const bool (&sel)[2], const int (&klo)[2], const int (&khi)[2],
                                           float (&mrow)[2], float (&lrow)[2], f32x4v (&o)[2][4], int lane) {
    const int j = lane & 15, gq = lane >> 4;
    f32x4v s[2][4];
#pragma unroll
    for (int kt = 0; kt < 4; ++kt) {
        s[0][kt] = (f32x4v){0.f, 0.f, 0.f, 0.f}; s[1][kt] = (f32x4v){0.f, 0.f, 0.f, 0.f};
#pragma unroll
        for (int ks = 0; ks < 2; ++ks) {
            const bf16x8 kf = *(const LAS bf16x8*)(Kb + (16 * kt + j) * 128 + (((gq + 4 * ks) ^ (j & 7)) << 4));
            s[0][kt] = __builtin_amdgcn_mfma_f32_16x16x32_bf16(kf, qf[0][ks], s[0][kt], 0, 0, 0);
            s[1][kt] = __builtin_amdgcn_mfma_f32_16x16x32_bf16(kf, qf[1][ks], s[1][kt], 0, 0, 0);
        }
    }
#pragma unroll
    for (int rg = 0; rg < 2; ++rg) {
        float bm = NEGF;
        if (FULL) { const float bias = sel[rg] ? 0.f : NEGF;
#pragma unroll
            for (int kt = 0; kt < 4; ++kt)
#pragma unroll
                for (int e = 0; e < 4; ++e) { const float v = s[rg][kt][e] + bias; s[rg][kt][e] = v; bm = fmaxf(bm, v); }
        } else {
#pragma unroll
            for (int kt = 0; kt < 4; ++kt)
#pragma unroll
                for (int e = 0; e < 4; ++e) { const int ko = 16 * kt + 4 * gq + e; const bool ok = sel[rg] && ko >= klo[rg] && ko <= khi[rg]; const float v = ok ? s[rg][kt][e] : NEGF; s[rg][kt][e] = v; bm = fmaxf(bm, v); }
        }
        bm = xmax16(bm);
        const float mnew = fmaxf(mrow[rg], bm), alpha = __builtin_amdgcn_exp2f(mrow[rg] - mnew);
        const bool moved = __builtin_amdgcn_ballot_w64(mnew != mrow[rg]) != 0ull;
        mrow[rg] = mnew;
        float ps = 0.f;
#pragma unroll
        for (int kt = 0; kt < 4; ++kt)
#pragma unroll
            for (int e = 0; e < 4; ++e) { const float p = __builtin_amdgcn_exp2f(s[rg][kt][e] - mnew); s[rg][kt][e] = p; ps += p; }
        lrow[rg] = lrow[rg] * alpha + ps;
        if (moved) {
#pragma unroll
            for (int dt = 0; dt < 4; ++dt) o[rg][dt] *= alpha;
        }
    }
#pragma unroll
    for (int kk = 0; kk < 2; ++kk) {
        const bf16x8 pf0 = pack8(s[0][2 * kk][0], s[0][2 * kk][1], s[0][2 * kk][2], s[0][2 * kk][3], s[0][2 * kk + 1][0], s[0][2 * kk + 1][1], s[0][2 * kk + 1][2], s[0][2 * kk + 1][3]);
        const bf16x8 pf1 = pack8(s[1][2 * kk][0], s[1][2 * kk][1], s[1][2 * kk][2], s[1][2 * kk][3], s[1][2 * kk + 1][0], s[1][2 * kk + 1][1], s[1][2 * kk + 1][2], s[1][2 * kk + 1][3]);
#pragma unroll
        for (int dt = 0; dt < 4; ++dt) {
            const LAS unsigned char* va = Vb + (32 * kk + 4 * gq + (j >> 2)) * 128 + (16 * dt + 4 * (j & 3)) * 2;
            const bf16x8 vf = cat4(tr16(va), tr16(va + 16 * 128));
            o[0][dt] = __builtin_amdgcn_mfma_f32_16x16x32_bf16(vf, pf0, o[0][dt], 0, 0, 0);
            o[1][dt] = __builtin_amdgcn_mfma_f32_16x16x32_bf16(vf, pf1, o[1][dt], 0, 0, 0);
        }
        }
}
__device__ __forceinline__ void nsa_block4(const LAS unsigned char* KbA, const LAS unsigned char* VbA, const LAS unsigned char* KbB, const LAS unsigned char* VbB, const bf16x8 (&qf)[2][2],
                                           const bool (&selA)[2], const bool (&selB)[2], float (&mrow)[2], float (&lrow)[2], f32x4v (&o)[2][4], int lane) {
    const int j = lane & 15, gq = lane >> 4;
    f32x4v s[2][2][4];
#pragma unroll
    for (int bl = 0; bl < 2; ++bl) { const LAS unsigned char* Kb = bl ? KbB : KbA;
#pragma unroll
        for (int kt = 0; kt < 4; ++kt) {
            s[bl][0][kt] = (f32x4v){0.f, 0.f, 0.f, 0.f}; s[bl][1][kt] = (f32x4v){0.f, 0.f, 0.f, 0.f};
#pragma unroll
            for (int ks = 0; ks < 2; ++ks) {
                const bf16x8 kf = *(const LAS bf16x8*)(Kb + (16 * kt + j) * 128 + (((gq + 4 * ks) ^ (j & 7)) << 4));
                s[bl][0][kt] = __builtin_amdgcn_mfma_f32_16x16x32_bf16(kf, qf[0][ks], s[bl][0][kt], 0, 0, 0);
                s[bl][1][kt] = __builtin_amdgcn_mfma_f32_16x16x32_bf16(kf, qf[1][ks], s[bl][1][kt], 0, 0, 0);
            }
        } }
#pragma unroll
    for (int rg = 0; rg < 2; ++rg) {
        float ba = NEGF, bb = NEGF;
#pragma unroll
        for (int kt = 0; kt < 4; ++kt)
#pragma unroll
            for (int e = 0; e < 4; ++e) { ba = fmaxf(ba, s[0][rg][kt][e]); bb = fmaxf(bb, s[1][rg][kt][e]); }
        if (!selA[rg]) ba = NEGF;
        if (!selB[rg]) bb = NEGF;
        const float bm = xmax16(fmaxf(ba, bb));
        const float mnew = fmaxf(mrow[rg], bm), alpha = __builtin_amdgcn_exp2f(mrow[rg] - mnew);
        const bool moved = __builtin_amdgcn_ballot_w64(mnew != mrow[rg]) != 0ull;
        mrow[rg] = mnew;
        const float sa = selA[rg] ? mnew : 1e30f, sb = selB[rg] ? mnew : 1e30f;
        float ps = 0.f;
#pragma unroll
        for (int kt = 0; kt < 4; ++kt)
#pragma unroll
            for (int e = 0; e < 4; ++e) { const float pa = __builtin_amdgcn_exp2f(s[0][rg][kt][e] - sa), pb = __builtin_amdgcn_exp2f(s[1][rg][kt][e] - sb); s[0][rg][kt][e] = pa; s[1][rg][kt][e] = pb; ps += pa + pb; }
        lrow[rg] = lrow[rg] * alpha + ps;
        if (moved) {
#pragma unroll
            for (int dt = 0; dt < 4; ++dt) o[rg][dt] *= alpha;
        }
    }
#pragma unroll
    for (int bl = 0; bl < 2; ++bl) { const LAS unsigned char* Vb = bl ? VbB : VbA;
#pragma unroll
        for (int kk = 0; kk < 2; ++kk) {
            const bf16x8 pf0 = pack8(s[bl][0][2 * kk][0], s[bl][0][2 * kk][1], s[bl][0][2 * kk][2], s[bl][0][2 * kk][3], s[bl][0][2 * kk + 1][0], s[bl][0][2 * kk + 1][1], s[bl][0][2 * kk + 1][2], s[bl][0][2 * kk + 1][3]);
            const bf16x8 pf1 = pack8(s[bl][1][2 * kk][0], s[bl][1][2 * kk][1], s[bl][1][2 * kk][2], s[bl][1][2 * kk][3], s[bl][1][2 * kk + 1][0], s[bl][1][2 * kk + 1][1], s[bl][1][2 * kk + 1][2], s[bl][1][2 * kk + 1][3]);
#pragma unroll
            for (int dt = 0; dt < 4; ++dt) {
                const LAS unsigned char* va = Vb + (32 * kk + 4 * gq + (j >> 2)) * 128 + (16 * dt + 4 * (j & 3)) * 2;
                const bf16x8 vf = cat4(tr16(va), tr16(va + 16 * 128));
                o[0][dt] = __builtin_amdgcn_mfma_f32_16x16x32_bf16(vf, pf0, o[0][dt], 0, 0, 0);
                o[1][dt] = __builtin_amdgcn_mfma_f32_16x16x32_bf16(vf, pf1, o[1][dt], 0, 0, 0);
            }
        } }
}
__device__ __forceinline__ void glds16(const void* gsrc, unsigned lds_dst) { unsigned keep;
    asm volatile("s_mov_b32 %0, m0\n\ts_mov_b32 m0, %2\n\ts_nop 0\n\tglobal_load_lds_dwordx4 %1, off\n\ts_mov_b32 m0, %0" : "=&s"(keep) : "v"(gsrc), "s"(lds_dst) : "memory"); }
template <int MODE>
__device__ __forceinline__ void nsa_attend(const bf16* kv, unsigned long long mask, int b, int g, int c, int tid, int lane, LAS unsigned char* ring, const bf16x8 (&qf)[2][2],
                                           const unsigned long long (&rmask)[2], const unsigned long long (&gmask)[2], const int (&trow)[2], float (&mrow)[2], float (&lrow)[2], f32x4v (&o)[2][4]) {
    const int wave = __builtin_amdgcn_readfirstlane(tid >> 6);
    const int rr = 8 * wave + (lane >> 3);
    const bf16* gk = kv + (size_t)(b * SEQ + rr) * 256 + g * 64 + (((lane & 7) ^ (rr & 7)) << 3);
    const bf16* gv = kv + (size_t)(b * SEQ + rr) * 256 + 128 + g * 64 + ((lane & 7) << 3);
    const unsigned ring0 = (unsigned)(uintptr_t)(unsigned char*)ring + wave * 1024;
#define NSA_ISSUE(jb_, slot_) do { glds16(gk + (size_t)(jb_) * 64 * 256, (unsigned)__builtin_amdgcn_readfirstlane(ring0 + (slot_) * NSA_SLOT)); \
                                   glds16(gv + (size_t)(jb_) * 64 * 256, (unsigned)__builtin_amdgcn_readfirstlane(ring0 + (slot_) * NSA_SLOT + 8192)); } while (0)
    unsigned long long remi = mask, remc = mask; int lastb = 0, si = 0, sc_ = 0;
#if DUP == 12
    float m2_[2] = {NEGF, NEGF}, l2_[2] = {0.f, 0.f}; f32x4v o2_[2][4]; for (int rg = 0; rg < 2; ++rg) for (int dt = 0; dt < 4; ++dt) o2_[rg][dt] = (f32x4v){0.f, 0.f, 0.f, 0.f};
#endif
#define NSA_ISSUE1() do { if (remi) { lastb = (int)__builtin_ctzll(remi); remi &= remi - 1ull; } NSA_ISSUE(lastb, si); si = si + 1 == NSA_D ? 0 : si + 1; } while (0)
#define NSA_FLAGS(jj_, sel_, klo_, khi_, act_) do { _Pragma("unroll") for (int rg = 0; rg < 2; ++rg) { const int o6 = trow[rg] & 63; \
            if (MODE == 0) { sel_[rg] = (rmask[rg] >> (jj_)) & 1ull; act_[rg] = (gmask[rg] >> (jj_)) & 1ull; klo_[rg] = 0; khi_[rg] = ((jj_) == c) ? o6 : 63; } \
            else { sel_[rg] = true; act_[rg] = true; klo_[rg] = ((jj_) == c - 4) ? o6 + 1 : 0; khi_[rg] = ((jj_) == c) ? o6 : 63; } } } while (0)
    NSA_ISSUE1(); NSA_ISSUE1(); NSA_ISSUE1(); NSA_ISSUE1();
    while (remc) {
        const int jA = (int)__builtin_ctzll(remc); remc &= remc - 1ull;
        const bool two = remc != 0ull; const int jB = two ? (int)__builtin_ctzll(remc) : jA; if (two) remc &= remc - 1ull;
        asm volatile("s_waitcnt vmcnt(4) lgkmcnt(0)\n\ts_barrier" ::: "memory");
        NSA_ISSUE1(); NSA_ISSUE1();
        const LAS unsigned char* kA = ring + sc_ * NSA_SLOT; const LAS unsigned char* vA = kA + 8192; const LAS unsigned char* kB = kA + NSA_SLOT; const LAS unsigned char* vB = kB + 8192;
        sc_ = sc_ + 2 == NSA_D ? 0 : sc_ + 2;
        bool selA[2], selB[2], actA[2], actB[2]; int kloA[2], khiA[2], kloB[2], khiB[2];
        NSA_FLAGS(jA, selA, kloA, khiA, actA); NSA_FLAGS(jB, selB, kloB, khiB, actB);
        const bool fullA = (MODE == 0) ? (jA != c) : (jA != c && jA != c - 4), fullB = (MODE == 0) ? (jB != c) : (jB != c && jB != c - 4);
        const bool doA = actA[0] || actA[1], doB = two && (actB[0] || actB[1]);
        if (NSA_JOINT && MODE == 0 && doA && doB && fullA && fullB) nsa_block4(kA, vA, kB, vB, qf, selA, selB, mrow, lrow, o, lane);
        else {
            if (doA) { if (fullA) nsa_block2<true>(kA, vA, qf, selA, kloA, khiA, mrow, lrow, o, lane); else nsa_block2<false>(kA, vA, qf, selA, kloA, khiA, mrow, lrow, o, lane); }
            if (doB) { if (fullB) nsa_block2<true>(kB, vB, qf, selB, kloB, khiB, mrow, lrow, o, lane); else nsa_block2<false>(kB, vB, qf, selB, kloB, khiB, mrow, lrow, o, lane); }
        }
    }
#undef NSA_ISSUE1
#undef NSA_FLAGS
    asm volatile("s_waitcnt vmcnt(0) lgkmcnt(0)\n\ts_barrier" ::: "memory");
#undef NSA_ISSUE
}
#if defined(PROBE_CMP)
__device__ __forceinline__ void nsa_probe_store(unsigned char* ws, int row, int head, int gq, const f32x4v (&v)[4]) {
    bf16* pb_ = (bf16*)(ws + 497 * MiB);
    for (int dt = 0; dt < 4; ++dt) { uint2 w; w.x = cvtpk(v[dt][0], v[dt][1]); w.y = cvtpk(v[dt][2], v[dt][3]); *(uint2*)(pb_ + (size_t)row * 512 + head * 64 + 16 * dt + 4 * gq) = w; }
}
#endif
__device__ __forceinline__ void nsa_unit(unsigned char* ws, int unit, LAS unsigned char* lds, int tid_in, bf16* yout) {
    int tid = tid_in; asm volatile("" : "+v"(tid));
    const int lane = tid & 63, wave = __builtin_amdgcn_readfirstlane(tid >> 6), j = lane & 15, gq = lane >> 4;
    const int c = unit & 63, g = (unit >> 6) & 1, b = unit >> 7, bg = b * 2 + g;
    LAS float* impa = (LAS float*)(lds + NSA_OFF_IMPA); LAS float* impb = (LAS float*)(lds + NSA_OFF_IMPB);
    LAS unsigned long long* um = (LAS unsigned long long*)(lds + NSA_OFF_UM);
    TP_DECL
    for (int i = tid; i < 2 * 64 * 65; i += 512) impa[i] = 0.f;
    {
        const v4u* ksrc = (const v4u*)((const bf16*)(ws + WS_KC) + (size_t)bg * 256 * 64); const v4u* vsrc = (const v4u*)((const bf16*)(ws + WS_VC) + (size_t)bg * 64 * 256);
        v4u kst[4], vst[4];
#pragma unroll
        for (int i = 0; i < 4; ++i) { kst[i] = ksrc[tid + 512 * i]; vst[i] = vsrc[tid + 512 * i]; }
#pragma unroll
        for (int i = 0; i < 4; ++i) { const int idx = tid + 512 * i; const int r = idx >> 3, sg = idx & 7; *(LAS v4u*)(lds + NSA_OFF_KCL + r * 128 + ((sg ^ (r & 7)) << 4)) = kst[i]; }
#pragma unroll
        for (int i = 0; i < 4; ++i) { const int idx = tid + 512 * i; const int r = idx >> 5, sg = idx & 31; *(LAS v4u*)(lds + NSA_OFF_VCTL + r * 512 + ((sg ^ (r & 15)) << 4)) = vst[i]; }
    }
    bf16* qc = (bf16*)(ws + WS_QC);
    const bf16* misc = (const bf16*)(ws + WS_MISC);
    bf16x8 qf[2][2]; float gate[2][3]; int trow[2];
#pragma unroll
    for (int rg = 0; rg < 2; ++rg) {
        const int q = 8 * wave + 4 * rg + (j >> 2), t = 64 * c + q, row = b * SEQ + t, head = g * 4 + (j & 3);
        trow[rg] = t;
#pragma unroll
        for (int ks = 0; ks < 2; ++ks) qf[rg][ks] = *(const bf16x8*)(qc + (size_t)row * 512 + head * 64 + 8 * gq + 32 * ks);
        gate[rg][0] = __builtin_amdgcn_rcpf(1.0f + __expf(-bf2f(misc[(size_t)row * 256 + 196 + head * 3])));
    }
    typedef unsigned u32x2v __attribute__((ext_vector_type(2)));
    LAS u32x2v* stash = (LAS u32x2v*)(lds + NSA_OFF_ST) + tid * 8;
    __syncthreads();
    const int nT = (c >> 2) + 1;
#pragma unroll
    for (int rg = 0; rg < 2; ++rg) {
        const int t = trow[rg], nv = t >= 31 ? ((t - 15) >> 4) : 0;
        f32x4v s[16]; float mx = NEGF;
#pragma unroll
        for (int T = 0; T < 16; ++T) {
            s[T] = (f32x4v){0.f, 0.f, 0.f, 0.f};
            if (T < nT) {
#pragma unroll
                for (int ks = 0; ks < 2; ++ks) { const bf16x8 kf = *(const LAS bf16x8*)(lds + NSA_OFF_KCL + (16 * T + j) * 128 + (((gq + 4 * ks) ^ (j & 7)) << 4)); s[T] = __builtin_amdgcn_mfma_f32_16x16x32_bf16(kf, qf[rg][ks], s[T], 0, 0, 0); }
#pragma unroll
                for (int e = 0; e < 4; ++e) { const float v = (16 * T + 4 * gq + e < nv) ? s[T][e] : NEGF; s[T][e] = v; mx = fmaxf(mx, v); }
            }
        }
        mx = xmax16(mx);
        float ls = 0.f;
#pragma unroll
        for (int T = 0; T < 16; ++T) if (T < nT) {
#pragma unroll
            for (int e = 0; e < 4; ++e) { const float p = (16 * T + 4 * gq + e < nv) ? __builtin_amdgcn_exp2f(s[T][e] - mx) : 0.f; s[T][e] = p; ls += p; }
        }
        ls = xsum16(ls);
        const float inv = nv > 0 ? __builtin_amdgcn_rcpf(ls) : 0.f;
        const int q = 8 * wave + 4 * rg + (j >> 2);
#pragma unroll
        for (int T = 0; T < 16; ++T) if (T < nT) {
#pragma unroll
            for (int e = 0; e < 4; ++e) s[T][e] *= inv;
            float a = s[T][0] + s[T][1] + s[T][2] + 0.5f * s[T][3], bb = 0.5f * s[T][3];
            a += __shfl_xor(a, 1); a += __shfl_xor(a, 2); bb += __shfl_xor(bb, 1); bb += __shfl_xor(bb, 2);
            if ((j & 3) == 0) { impa[q * 65 + 4 * T + gq] = a; impb[q * 65 + 4 * T + gq + 1] = bb; }
        }
        f32x4v oc[4];
#pragma unroll
        for (int dt = 0; dt < 4; ++dt) oc[dt] = (f32x4v){0.f, 0.f, 0.f, 0.f};
#pragma unroll
        for (int kk = 0; kk < 8; ++kk) if (2 * kk < nT) {
            const bf16x8 pf = pack8(s[2 * kk][0], s[2 * kk][1], s[2 * kk][2], s[2 * kk][3], s[2 * kk + 1][0], s[2 * kk + 1][1], s[2 * kk + 1][2], s[2 * kk + 1][3]);
#pragma unroll
            for (int dt = 0; dt < 4; ++dt) {
                const LAS unsigned char* vp = lds + NSA_OFF_VCTL + (16 * dt + j) * 512 + (gq & 1) * 8;
                const s16x4 v0 = *(const LAS s16x4*)(vp + ((((8 * kk + gq) >> 1) ^ j) << 4)), v1 = *(const LAS s16x4*)(vp + (((((8 * kk + gq) >> 1) + 2) ^ j) << 4));
                oc[dt] = __builtin_amdgcn_mfma_f32_16x16x32_bf16(cat4(v0, v1), pf, oc[dt], 0, 0, 0);
            }
        }
#pragma unroll
        for (int dt = 0; dt < 4; ++dt) { const f32x4v v = oc[dt] * gate[rg][0]; u32x2v w; w.x = pg8::cvt_pk_bf16(v[0], v[1]); w.y = pg8::cvt_pk_bf16(v[2], v[3]); stash[rg * 4 + dt] = w; }
        __builtin_amdgcn_sched_barrier(0);
    }
    __syncthreads();
    TP_MARK(5);
    unsigned long long smask[8], mymask = 0ull;
#pragma unroll
    for (int qi = 0; qi < 8; ++qi) {
        const int q = 8 * wave + qi;
#if PROBE == 4
        const float imp = ((const float*)(ws + 500 * MiB))[((size_t)(b * SEQ + 64 * c + q) * 2 + g) * 64 + lane];
#else
        const float imp = impa[q * 65 + lane] + impb[q * 65 + lane];
#endif
#if PROBE && (PROBE != 5 || defined(PROBE5_IMP))
        ((float*)(ws + 516 * MiB))[((size_t)(b * SEQ + 64 * c + q) * 2 + g) * 64 + lane] = (lane <= c) ? imp : 0.f;
#endif
        const bool forced = (lane == 0) || (lane == c), adm = lane <= c;
        unsigned key = forced ? (0xFFFFFF00u | (unsigned)(63 - lane)) : (adm ? ((__float_as_uint(imp) & 0xFFFFFFC0u) | (unsigned)(63 - lane)) : 0u);
        unsigned long long mk = 0ull;
#if TOP8_RANK
        { int rank = 0;
#pragma unroll
          for (int jj = 0; jj < 64; ++jj) { const unsigned kk = (unsigned)__builtin_amdgcn_readlane((int)key, jj); rank += (kk > key) ? 1 : 0; }
          mk = __ballot(key != 0u && rank < 8); }
#else
        for (int k = 0; k < 8; ++k) { const unsigned mx = wave_max_u(key); if (mx == 0u) break; const int win = 63 - (int)(mx & 63u); mk |= 1ull << win; if (lane == win) key = 0u; }
#endif
        mk = ((unsigned long long)(unsigned)__builtin_amdgcn_readfirstlane((unsigned)(mk >> 32)) << 32) | (unsigned long long)(unsigned)__builtin_amdgcn_readfirstlane((unsigned)mk);
#ifdef FIXSEL
        { mk = 1ull | (1ull << c); for (int d = 1; d <= 6; ++d) mk |= 1ull << (((FIXHOM ? 0 : q * 7) + d * 5) % (c + 1)); }
#endif
#if PROBE == 2
        mk = ((const unsigned long long*)(ws + 496 * MiB))[(size_t)(b * SEQ + 64 * c + q) * 2 + g];
        mk = ((unsigned long long)(unsigned)__builtin_amdgcn_readfirstlane((unsigned)(mk >> 32)) << 32) | (unsigned long long)(unsigned)__builtin_amdgcn_readfirstlane((unsigned)mk);
#endif
#if PROBE == 5
        if (lane == 0) ((unsigned long long*)(ws + 498 * MiB))[(size_t)(b * SEQ + 64 * c + q) * 2 + g] = mk;
#endif
#if PROBE == 5 && !defined(PROBE5_IMP)
        ((float*)(ws + 516 * MiB))[((size_t)(b * SEQ + 64 * c + q) * 2 + g) * 64 + lane] = ((mk >> lane) & 1ull) ? 1.f : 0.f;
#endif
        smask[qi] = mk; mymask |= mk;
    }
    if (lane == 0) um[wave] = mymask;
    __syncthreads();
    unsigned long long umask = 0ull;
#pragma unroll
    for (int w = 0; w < 8; ++w) umask |= um[w];
    umask = ((unsigned long long)(unsigned)__builtin_amdgcn_readfirstlane((unsigned)(umask >> 32)) << 32) | (unsigned long long)(unsigned)__builtin_amdgcn_readfirstlane((unsigned)umask);
    unsigned long long rmask[2];
    { LAS unsigned long long* qm = (LAS unsigned long long*)(lds + NSA_OFF_QM);
      __syncthreads();
#pragma unroll
      for (int qi = 0; qi < 8; ++qi) if (lane == 0) qm[8 * wave + qi] = smask[qi];
      __syncthreads();
#pragma unroll
      for (int rg = 0; rg < 2; ++rg) rmask[rg] = qm[8 * wave + 4 * rg + (j >> 2)]; }
    const unsigned long long gmask[2] = {smask[0] | smask[1] | smask[2] | smask[3], smask[4] | smask[5] | smask[6] | smask[7]};
    TP_MARK(6); TP_ADD(9, __popcll(umask)); TP_ADD(10, 1); TP_ADD(11, c + 1); TP_ADD(12, __popcll(umask & ~(c == 63 ? ~0ull : ((2ull << c) - 1ull)))); TP_ADD(13, __popcll(smask[0]));
    const bf16* kvs = (const bf16*)(ws + WS_KVS); const bf16* kvw = (const bf16*)(ws + WS_KVW);
    LAS unsigned char* ring = lds + NSA_OFF_RING;
    {
        float mrow[2] = {NEGF, NEGF}, lrow[2] = {0.f, 0.f}; f32x4v o[2][4];
#pragma unroll
        for (int rg = 0; rg < 2; ++rg)
#pragma unroll
            for (int dt = 0; dt < 4; ++dt) o[rg][dt] = (f32x4v){0.f, 0.f, 0.f, 0.f};
        nsa_attend<0>(kvs, umask, b, g, c, tid, lane, ring, qf, rmask, gmask, trow, mrow, lrow, o);
#if DUP == 8
        { __syncthreads(); float m2[2] = {NEGF, NEGF}, l2[2] = {0.f, 0.f}; f32x4v o2[2][4];
          for (int rg = 0; rg < 2; ++rg) for (int dt = 0; dt < 4; ++dt) o2[rg][dt] = (f32x4v){0.f, 0.f, 0.f, 0.f};
          nsa_attend<0>(kvs, umask, b, g, c, tid, lane, Kb, Vb, qf, rmask, gmask, trow, m2, l2, o2);
          bf16* dmy = (bf16*)(ws + WS_BU) + (size_t)(b * SEQ + trow[0]) * 512 + (g * 4 + (j & 3)) * 64 + 4 * gq;
          for (int rg = 0; rg < 2; ++rg) for (int dt = 0; dt < 4; ++dt) { uint2 w; w.x = pg8::cvt_pk_bf16(o2[rg][dt][0] + l2[rg], o2[rg][dt][1]); w.y = pg8::cvt_pk_bf16(o2[rg][dt][2], o2[rg][dt][3]); *(uint2*)(dmy + 16 * dt) = w; } }
#endif
#pragma unroll
        for (int rg = 0; rg < 2; ++rg) { const float g1_ = __builtin_amdgcn_rcpf(1.0f + __expf(-bf2f(misc[(size_t)(b * SEQ + trow[rg]) * 256 + 196 + (g * 4 + (j & 3)) * 3 + 1]))); const float sc = g1_ * __builtin_amdgcn_rcpf(xsum16(lrow[rg]));
#pragma unroll
            for (int dt = 0; dt < 4; ++dt) { const u32x2v p = stash[rg * 4 + dt]; const f32x4v v = o[rg][dt] * sc; u32x2v w; w.x = pg8::cvt_pk_bf16(v[0] + bflo(p.x), v[1] + bfhi(p.x)); w.y = pg8::cvt_pk_bf16(v[2] + bflo(p.y), v[3] + bfhi(p.y)); stash[rg * 4 + dt] = w; }
            }
        __syncthreads();
    }
    TP_MARK(7);
    {
        float mrow[2] = {NEGF, NEGF}, lrow[2] = {0.f, 0.f}; f32x4v o[2][4];
#pragma unroll
        for (int rg = 0; rg < 2; ++rg)
#pragma unroll
            for (int dt = 0; dt < 4; ++dt) o[rg][dt] = (f32x4v){0.f, 0.f, 0.f, 0.f};
        { const int j0 = c - 4 > 0 ? c - 4 : 0; const unsigned long long wmask = ((c == 63 ? ~0ull : ((1ull << (c + 1)) - 1ull)) >> j0) << j0;
          nsa_attend<1>(kvw, wmask, b, g, c, tid, lane, ring, qf, rmask, gmask, trow, mrow, lrow, o); }
#pragma unroll
        for (int rg = 0; rg < 2; ++rg) { const float g2_ = __builtin_amdgcn_rcpf(1.0f + __expf(-bf2f(misc[(size_t)(b * SEQ + trow[rg]) * 256 + 196 + (g * 4 + (j & 3)) * 3 + 2]))); const float sc = g2_ * __builtin_amdgcn_rcpf(xsum16(lrow[rg]));
#pragma unroll
            for (int dt = 0; dt < 4; ++dt) { const u32x2v p = stash[rg * 4 + dt]; const f32x4v v = o[rg][dt] * sc; uint2 w; w.x = pg8::cvt_pk_bf16(v[0] + bflo(p.x), v[1] + bfhi(p.x)); w.y = pg8::cvt_pk_bf16(v[2] + bflo(p.y), v[3] + bfhi(p.y));
                *(uint2*)(yout + (size_t)(b * SEQ + trow[rg]) * 512 + (g * 4 + (j & 3)) * 64 + 16 * dt + 4 * gq) = w; }
            }
    }
    __syncthreads();
    TP_MARK(8);
}
__device__ __forceinline__ void prep_kva16(unsigned char* ws, int task, int lane) {
    const int j = lane & 15, gq = lane >> 4, row = task * 16 + j;
    const bf16* misc = (const bf16*)(ws + WS_MISC) + (size_t)row * 256 + 64;
    const bf16* wu = (const bf16*)(ws + WS_W + WO_UKV);
    bf16x8 cf[4]; float ss = 0.f;
#pragma unroll
    for (int ks = 0; ks < 4; ++ks) { const v4u v = *(const v4u*)(misc + 8 * gq + 32 * ks); cf[ks] = __builtin_bit_cast(bf16x8, v); float f[8]; unpack8(v, f);
#pragma unroll
        for (int e = 0; e < 8; ++e) ss += f[e] * f[e]; }
    ss = xsum16(ss);
    const float r = 1.0f / sqrtf(ss * (1.f / 128.f) + EPS);
    const float* rp = (const float*)(ws + WS_ROPE) + (size_t)row * 16;
    bf16* o = (bf16*)(ws + WS_KVA) + (size_t)row * 128;
#pragma unroll
    for (int ct = 0; ct < 8; ++ct) {
        f32x4v a = {0.f, 0.f, 0.f, 0.f};
#pragma unroll
        for (int ks = 0; ks < 4; ++ks) { const bf16x8 wf = *(const bf16x8*)(wu + (size_t)(16 * ct + j) * 128 + 8 * gq + 32 * ks); a = __builtin_amdgcn_mfma_f32_16x16x32_bf16(wf, cf[ks], a, 0, 0, 0); }
        a *= r;
        if (ct == 0) {
            const float c0 = rp[2 * gq], s0 = rp[8 + 2 * gq], c1 = rp[2 * gq + 1], s1 = rp[8 + 2 * gq + 1];
            const float x0 = a[0], x1 = a[1], x2 = a[2], x3 = a[3];
            a[0] = x0 * c0 - x1 * s0; a[1] = x1 * c0 + x0 * s0; a[2] = x2 * c1 - x3 * s1; a[3] = x3 * c1 + x2 * s1;
        }
        uint2 w; w.x = cvtpk(a[0], a[1]); w.y = cvtpk(a[2], a[3]);
        *(uint2*)(o + 16 * ct + 4 * gq) = w;
    }
}
__device__ __forceinline__ void prep_pool16(unsigned char* ws, int task, int lane, const LAS unsigned char* wl, bf16* ybuf) {
    const int j = lane & 15, gq = lane >> 4, row = task * 16 + j, t = row & (SEQ - 1);
    const bf16* bu = (const bf16*)(ws + WS_BU);
    bf16* yb = ybuf + (size_t)row * 512;
#pragma unroll 1
    for (int g = 0; g < 4; ++g) {
        const int w = 2 << g, lo = (t + 1 - w) > 0 ? (t + 1 - w) : 0, cnt = t + 1 - lo; const float inv = 1.0f / (float)cnt;
        bf16x8 pf[4];
#pragma unroll
        for (int ks = 0; ks < 4; ++ks) {
            const bf16* p = bu + (size_t)row * 512 + g * 128 + 8 * gq + 32 * ks;
            float sum[8] = {0.f, 0.f, 0.f, 0.f, 0.f, 0.f, 0.f, 0.f}, cur[8];
            { const v4u v = *(const v4u*)p; unpack8(v, cur);
#pragma unroll
              for (int e = 0; e < 8; ++e) sum[e] = cur[e]; }
            v4u wv_[15];
#pragma unroll
            for (int i = 1; i < 16; ++i) if (i < w) wv_[i - 1] = *(const v4u*)(p - (size_t)(i < cnt ? i : 0) * 512);
#pragma unroll
            for (int i = 1; i < 16; ++i) if (i < w) { const bool ok = i < cnt; float f[8]; unpack8(wv_[i - 1], f);
#pragma unroll
                for (int e = 0; e < 8; ++e) sum[e] += ok ? f[e] : 0.f; }
            __builtin_amdgcn_sched_barrier(0);
            pf[ks] = pack8(sum[0] * inv - cur[0], sum[1] * inv - cur[1], sum[2] * inv - cur[2], sum[3] * inv - cur[3], sum[4] * inv - cur[4], sum[5] * inv - cur[5], sum[6] * inv - cur[6], sum[7] * inv - cur[7]);
        }
#pragma unroll
        for (int dt = 0; dt < 8; ++dt) {
            f32x4v a = {0.f, 0.f, 0.f, 0.f};
#pragma unroll
            for (int ks = 0; ks < 4; ++ks) {
#if POOLDBG == 1
                bf16x8 wf; for (int e = 0; e < 8; ++e) wf[e] = (short)0x3c00;
#else
                const bf16x8 wf = *(const LAS bf16x8*)(wl + (g * 128 + 16 * dt + j) * 256 + (((gq + 4 * ks) ^ j) << 4));
#endif
#if POOLDBG == 2
                bf16x8 pz; for (int e = 0; e < 8; ++e) pz[e] = (short)0x3c00; a = __builtin_amdgcn_mfma_f32_16x16x32_bf16(wf, pz, a, 0, 0, 0);
#else
                a = __builtin_amdgcn_mfma_f32_16x16x32_bf16(wf, pf[ks], a, 0, 0, 0);
#endif
            }
            uint2 wv; wv.x = cvtpk(a[0], a[1]); wv.y = cvtpk(a[2], a[3]);
            *(uint2*)(yb + g * 128 + 16 * dt + 4 * gq) = wv;
        }
    }
}
__device__ __forceinline__ float gelu_tanh_f(float x) { const float u = 0.7978845608028654f * (x + 0.044715f * x * x * x); const float e = __expf(2.0f * u); return 0.5f * x * (1.0f + (1.0f - 2.0f / (e + 1.0f))); }
__device__ __forceinline__ void prep_cmp16(unsigned char* ws, int task, LAS unsigned char* lds, int wave, int lane) {
    const int j = lane & 15, gq = lane >> 4, grp = wave >> 2, wq = wave & 3;
    const int i0 = (task & 15) * 16, bg = (task >> 4) & 15, br = task >> 8, b = bg >> 1, g = bg & 1, i = i0 + j;
    const bf16* kvc = (const bf16*)(ws + WS_KVC);
    const bf16* w1 = (const bf16*)(ws + WS_W + WO_CW1) + (size_t)br * 128 * 2048;
    const bf16* w2 = (const bf16*)(ws + WS_W + WO_CW2) + (size_t)br * 64 * 128;
    const float* posb = (const float*)(ws + WS_W + WO_POSB) + br * 128;
    LAS float* part = (LAS float*)lds + (size_t)grp * 4 * 32 * 64;
    f32x4v h[8];
#pragma unroll
    for (int nt = 0; nt < 8; ++nt) h[nt] = (f32x4v){0.f, 0.f, 0.f, 0.f};
#define CMP_LOAD(k2_, wf_, ff_) do { const int ks_ = 16 * wq + (k2_), l_ = ks_ >> 1; int tok_ = 16 * i + l_; tok_ = tok_ > SEQ - 1 ? SEQ - 1 : tok_;     \
        ff_ = *(const bf16x8*)(kvc + (size_t)(b * SEQ + tok_) * 256 + br * 128 + g * 64 + 32 * (ks_ & 1) + 8 * gq); \
        _Pragma("unroll") for (int nt_ = 0; nt_ < 8; ++nt_) wf_[nt_] = *(const bf16x8*)(w1 + (size_t)(16 * nt_ + j) * 2048 + 32 * ks_ + 8 * gq); } while (0)
    bf16x8 wfA[8], wfB[8], ffA, ffB;
    CMP_LOAD(0, wfA, ffA);
#pragma unroll
    for (int k2 = 0; k2 < 16; k2 += 2) {
        CMP_LOAD(k2 + 1, wfB, ffB);
        __builtin_amdgcn_sched_barrier(0);
#pragma unroll
        for (int nt = 0; nt < 8; ++nt) h[nt] = __builtin_amdgcn_mfma_f32_16x16x32_bf16(wfA[nt], ffA, h[nt], 0, 0, 0);
        if (k2 + 2 < 16) CMP_LOAD(k2 + 2, wfA, ffA);
        __builtin_amdgcn_sched_barrier(0);
#pragma unroll
        for (int nt = 0; nt < 8; ++nt) h[nt] = __builtin_amdgcn_mfma_f32_16x16x32_bf16(wfB[nt], ffB, h[nt], 0, 0, 0);
    }
#undef CMP_LOAD
#pragma unroll
    for (int nt = 0; nt < 8; ++nt)
#pragma unroll
        for (int e = 0; e < 4; ++e) part[(wq * 32 + nt * 4 + e) * 64 + lane] = h[nt][e];
    f32x4v pbv_[8];
#pragma unroll
    for (int nt = 0; nt < 8; ++nt) pbv_[nt] = *(const f32x4v*)(posb + 16 * nt + 4 * gq);
    __syncthreads();
    if (wq == 0) {
#pragma unroll
        for (int nt = 0; nt < 8; ++nt) { const f32x4v pbv = pbv_[nt];
#pragma unroll
            for (int e = 0; e < 4; ++e) { const int idx = (nt * 4 + e) * 64 + lane; h[nt][e] = gelu_tanh_f(((part[idx] + part[32 * 64 + idx]) + (part[2 * 32 * 64 + idx] + part[3 * 32 * 64 + idx])) + pbv[e]); } }
        f32x4v o[4];
#pragma unroll
        for (int dt = 0; dt < 4; ++dt) o[dt] = (f32x4v){0.f, 0.f, 0.f, 0.f};
        s16x4 w2a[4][4], w2b[4][4];
#pragma unroll
        for (int kk = 0; kk < 4; ++kk)
#pragma unroll
            for (int dt = 0; dt < 4; ++dt) { const bf16* wp = w2 + (size_t)(16 * dt + j) * 128 + 32 * kk + 4 * gq; w2a[kk][dt] = *(const s16x4*)wp; w2b[kk][dt] = *(const s16x4*)(wp + 16); }
        __builtin_amdgcn_sched_barrier(0);
#pragma unroll
        for (int kk = 0; kk < 4; ++kk) {
            const bf16x8 hf = pack8(h[2 * kk][0], h[2 * kk][1], h[2 * kk][2], h[2 * kk][3], h[2 * kk + 1][0], h[2 * kk + 1][1], h[2 * kk + 1][2], h[2 * kk + 1][3]);
#pragma unroll
            for (int dt = 0; dt < 4; ++dt) o[dt] = __builtin_amdgcn_mfma_f32_16x16x32_bf16(cat4(w2a[kk][dt], w2b[kk][dt]), hf, o[dt], 0, 0, 0);
        }
        const bool dead = i == 255;
        if (br == 0) { bf16* kc = (bf16*)(ws + WS_KC) + ((size_t)bg * 256 + i) * 64;
#pragma unroll
            for (int dt = 0; dt < 4; ++dt) { uint2 w; w.x = dead ? 0u : cvtpk(o[dt][0], o[dt][1]); w.y = dead ? 0u : cvtpk(o[dt][2], o[dt][3]); *(uint2*)(kc + 16 * dt + 4 * gq) = w; }
        } else { bf16* vct = (bf16*)(ws + WS_VC) + (size_t)bg * 64 * 256 + i;
#pragma unroll
            for (int dt = 0; dt < 4; ++dt)
#pragma unroll
                for (int e = 0; e < 4; ++e) vct[(size_t)(16 * dt + 4 * gq + e) * 256] = dead ? (bf16)0 : (bf16)f2bf(o[dt][e]);
        }
    }
    __syncthreads();
}
__device__ __forceinline__ void phase_prep(const Args& P, unsigned char* ws, int z, int l, LAS unsigned char* lds, int gw, int NGW, int lane, int wave, bf16* ybuf) {
    asm volatile("" : "+v"(lane)); lane &= 63; asm volatile("" : "+s"(gw), "+s"(NGW));
#if TPROBE
    const int tid = (wave << 6) | lane; unsigned long long tp_t_ = __builtin_amdgcn_s_memtime();
#endif
    for (int it = 2 * (gw >> 3) + (wave >> 2); it < 512 + (wave >> 2); it += 2 * (NGW >> 3)) prep_cmp16(ws, it < 512 ? it : 511, lds, wave, lane);
    TP_MARK(27);
    {
        const v4u* src = (const v4u*)(ws + WS_W + WO_POOL); const int t_ = (wave << 6) | lane;
        v4u pst[16];
#pragma unroll
        for (int i = 0; i < 16; ++i) pst[i] = src[t_ + 512 * i];
#pragma unroll
        for (int i = 0; i < 16; ++i) { const int idx = t_ + 512 * i, r = idx >> 4, sg = idx & 15; *(LAS v4u*)(lds + r * 256 + ((sg ^ (r & 15)) << 4)) = pst[i]; }
        __syncthreads();
    }
    TP_MARK(28);
    for (int it = gw; it < M / 16; it += NGW) { prep_kva16(ws, it, lane); TP_MARK(29); prep_pool16(ws, it, lane, lds, ybuf); }
    __syncthreads();
    TP_MARK(31);
}
constexpr int DSA_K = DSA_K_V, DSA_S = 32 - DSA_K, DSA_CAP = DSA_CAP_V;
constexpr int DSA_OFF_CNT = 0, DSA_OFF_PC = 3072, DSA_OFF_LIST = DSA_OFF_PC + 32 * 16 * 4, DSA_OFF_V = DSA_OFF_LIST + 16 * 256 * 2, DSA_VB = 64 * NSA_VSTR * 2, DSA_LDS = DSA_OFF_V + 8 * DSA_VB;
#define DSA_FOR_TILES(...) _Pragma("unroll") for (int G8 = 0; G8 < 8; ++G8) { if (G8 < ngrp) { _Pragma("unroll") for (int T8 = 0; T8 < 4; ++T8) { const int T = G8 * 4 + T8; __VA_ARGS__ } } }
__device__ __forceinline__ void cnt_ge(int& c, unsigned u, unsigned cand) { asm volatile("v_cmp_ge_u32_e32 vcc, %1, %2\n\tv_addc_co_u32_e32 %0, vcc, 0, %0, vcc" : "+v"(c) : "v"(u), "v"(cand) : "vcc"); }
__device__ __forceinline__ void cnt_gt(int& c, unsigned u, unsigned cand) { asm volatile("v_cmp_gt_u32_e32 vcc, %1, %2\n\tv_addc_co_u32_e32 %0, vcc, 0, %0, vcc" : "+v"(c) : "v"(u), "v"(cand) : "vcc"); }
__device__ __forceinline__ void cnt_le(int& c, unsigned u, unsigned cand) { asm volatile("v_cmp_le_u32_e32 vcc, %1, %2\n\tv_addc_co_u32_e32 %0, vcc, 0, %0, vcc" : "+v"(c) : "v"(u), "v"(cand) : "vcc"); }
__device__ __forceinline__ int dsa_total(LAS unsigned* cnt, int par, int wave, int j, int gq, int c) {
    c += __shfl_xor(c, 16); c += __shfl_xor(c, 32);
    if (gq == 0) cnt[(par * 8 + wave) * 16 + j] = (unsigned)c;
    __syncthreads();
    int tot = 0;
#pragma unroll
    for (int w = 0; w < 8; ++w) tot += (int)cnt[(par * 8 + w) * 16 + j];
    return tot;
}
__device__ __forceinline__ void dsa_unit(unsigned char* ws, int unit, LAS unsigned char* lds, int tid_in, bf16* yout) {
    int tid = tid_in; asm volatile("" : "+v"(tid));
    const int lane = tid & 63, wave = __builtin_amdgcn_readfirstlane(tid >> 6), j = lane & 15, gq = lane >> 4;
    const int b = unit >> 8, q0 = (unit & 255) * 16, t = q0 + j, row = b * SEQ + t;
    LAS unsigned* cnt = (LAS unsigned*)(lds + DSA_OFF_CNT); LAS unsigned* pc = (LAS unsigned*)(lds + DSA_OFF_PC);
    LAS unsigned short* list = (LAS unsigned short*)(lds + DSA_OFF_LIST);
    const bf16* misc = (const bf16*)(ws + WS_MISC);
    TP_DECL
    if (q0 >= 256) {
        const int ntiles = (q0 >> 4) + 1;
        const int ntl = wave < ntiles ? ((ntiles - 1 - wave) >> 3) + 1 : 0;
        const int ngrp = (ntl + 3) >> 2;
        bf16x8 qf[4][2]; float iw[4];
        { const bf16* iq = (const bf16*)(ws + WS_IQ) + (size_t)row * 256;
#pragma unroll
          for (int h = 0; h < 4; ++h) { iw[h] = 0.5f * bf2f(misc[(size_t)row * 256 + 192 + h]);
#pragma unroll
              for (int ks = 0; ks < 2; ++ks) qf[h][ks] = *(const bf16x8*)(iq + h * 64 + 8 * gq + 32 * ks); } }
        unsigned u[32][4];
#pragma unroll
        for (int T = 0; T < 32; ++T)
#pragma unroll
            for (int e = 0; e < 4; ++e) u[T][e] = 0u;
        const int kb0 = 16 * wave + 4 * gq;
        LAS unsigned char* ring = lds + DSA_OFF_V + wave * 16384;
#define DSA_ISSUE(Ti) do { _Pragma("unroll") for (int i_ = 0; i_ < 2; ++i_) { const int r_ = 8 * i_ + (lane >> 3); int kr_ = 16 * wave + 128 * (Ti) + r_; kr_ = kr_ > SEQ - 1 ? SEQ - 1 : kr_; \
            __builtin_amdgcn_global_load_lds((const unsigned*)(misc + (size_t)(b * SEQ + kr_) * 256 + (((lane & 7) ^ (r_ & 7)) << 3)), (LAS unsigned*)(ring + ((Ti) & 7) * 2048 + i_ * 1024), 16, 0, 0); } } while (0)
        if (ngrp > 0) {
#pragma unroll
            for (int T = 0; T < 8; ++T) DSA_ISSUE(T);
        }
        DSA_FOR_TILES(
            asm volatile("s_waitcnt vmcnt(14)" ::: "memory");
            const LAS unsigned char* tp = ring + (T & 7) * 2048 + j * 128;
            const bf16x8 kf0 = *(const LAS bf16x8*)(tp + ((gq ^ (j & 7)) << 4)); const bf16x8 kf1 = *(const LAS bf16x8*)(tp + (((gq + 4) ^ (j & 7)) << 4));
            asm volatile("s_waitcnt lgkmcnt(0)" ::: "memory");
            DSA_ISSUE(T + 8);
            float sc[4] = {0.f, 0.f, 0.f, 0.f};
            _Pragma("unroll") for (int h = 0; h < 4; ++h) {
                f32x4v a = {0.f, 0.f, 0.f, 0.f};
                a = __builtin_amdgcn_mfma_f32_16x16x32_bf16(kf0, qf[h][0], a, 0, 0, 0);
                a = __builtin_amdgcn_mfma_f32_16x16x32_bf16(kf1, qf[h][1], a, 0, 0, 0);
                _Pragma("unroll") for (int e = 0; e < 4; ++e) { const int ai_ = (int)__float_as_uint(a[e]); sc[e] += iw[h] * __uint_as_float((unsigned)(ai_ > 0 ? ai_ : 0)); }
                asm volatile("" : "+v"(sc[0]), "+v"(sc[1]), "+v"(sc[2]), "+v"(sc[3]));
            }
            _Pragma("unroll") for (int e = 0; e < 4; ++e) { unsigned x = f2o(sc[e]); asm volatile("" : "+v"(x)); u[T][e] = (kb0 + 128 * T + e <= t) ? x : 0u; }
        )
        asm volatile("s_waitcnt vmcnt(0)" ::: "memory");
#undef DSA_ISSUE
        TP_MARK(0);
        unsigned prefix = 0u; bool exact = false; int par = 0; int cab = 0;
        LAS unsigned* lcnt = (LAS unsigned*)(lds + DSA_OFF_V); LAS unsigned* lcab = lcnt + 16; LAS unsigned* lvst = lcnt + 32; LAS unsigned* lexf = lcnt + 48; LAS unsigned* llist = lcnt + 64;
        if (tid < 16) lcnt[tid] = 0u;
#pragma unroll 1
        for (int bit = 31; bit >= DSA_S; --bit) {
            const unsigned cand = prefix | (1u << bit); int c0 = 0, c1 = 0;
            DSA_FOR_TILES(cnt_ge(c0, u[T][0], cand); cnt_ge(c1, u[T][1], cand); cnt_ge(c0, u[T][2], cand); cnt_ge(c1, u[T][3], cand);)
            const int tot = dsa_total(cnt, par, wave, j, gq, c0 + c1); par ^= 1;
            if (tot >= 256) prefix = cand; else cab = tot;
        }
        TP_MARK(1);
        { const unsigned ptop = prefix >> DSA_S;
          DSA_FOR_TILES(unsigned pos_[4]; bool cd_[4];
              _Pragma("unroll") for (int e = 0; e < 4; ++e) { const unsigned x = u[T][e]; cd_[e] = x != 0u && (x >> DSA_S) == ptop; pos_[e] = DSA_CAP; }
              _Pragma("unroll") for (int e = 0; e < 4; ++e) if (cd_[e]) pos_[e] = __hip_atomic_fetch_add(&lcnt[j], 1u, __ATOMIC_RELAXED, __HIP_MEMORY_SCOPE_WORKGROUP);
              _Pragma("unroll") for (int e = 0; e < 4; ++e) if (pos_[e] < DSA_CAP) llist[j * DSA_CAP + pos_[e]] = u[T][e];)
          if (wave == 0 && gq == 0) lcab[j] = (unsigned)cab; }
        __syncthreads();
        const bool ovf = __any(lcnt[j] > (unsigned)DSA_CAP);
        TP_ADD(14, ovf ? 1 : 0); TP_ADD(15, 1);
        if (!ovf) {
#pragma unroll 1
            for (int qq = 0; qq < 2; ++qq) {
                const int q = 2 * wave + qq; const int n = (int)lcnt[q]; const int r = 256 - (int)lcab[q];
                unsigned ev[DSA_CAP / 64];
#pragma unroll
                for (int i = 0; i < DSA_CAP / 64; ++i) ev[i] = (lane + 64 * i < n) ? llist[q * DSA_CAP + lane + 64 * i] : 0u;
                unsigned p2 = (unsigned)__shfl((int)prefix, q);
#pragma unroll 1
                for (int bit = DSA_S - 1; bit >= 0; --bit) {
                    const unsigned cand = p2 | (1u << bit); int c = 0;
#pragma unroll
                    for (int i = 0; i < DSA_CAP / 64; ++i) c += __popcll(__ballot(ev[i] >= cand));
                    if (c >= r) p2 = cand;
                }
                int cf = 0;
#pragma unroll
                for (int i = 0; i < DSA_CAP / 64; ++i) cf += __popcll(__ballot(ev[i] >= p2));
                if (lane == 0) { lvst[q] = p2; lexf[q] = (cf == r) ? 1u : 0u; }
            }
            __syncthreads();
            prefix = lvst[j]; exact = lexf[j] != 0u;
        } else {
#pragma unroll 1
            for (int bit = DSA_S - 1; bit >= 0; --bit) {
                const unsigned cand = prefix | (1u << bit); int c0 = 0, c1 = 0;
                DSA_FOR_TILES(cnt_ge(c0, u[T][0], cand); cnt_ge(c1, u[T][1], cand); cnt_ge(c0, u[T][2], cand); cnt_ge(c1, u[T][3], cand);)
                const int tot = dsa_total(cnt, par, wave, j, gq, c0 + c1); par ^= 1;
                if (!exact && tot >= 256) { prefix = cand; exact = (tot == 256); }
            }
        }
        TP_MARK(2);
        const bool alle = __all(exact);
        unsigned kp = 0u;
        if (!alle) {
        DSA_FOR_TILES(_Pragma("unroll") for (int e = 0; e < 4; ++e) { const unsigned x = u[T][e]; u[T][e] = (x > prefix || (exact && x == prefix)) ? 0u : (x == prefix ? (unsigned)(1 + kb0 + 128 * T + e) : 0xFFFFFFFFu); })
            __syncthreads();
#pragma unroll 1
            for (int bit = 11; bit >= 0; --bit) {
                const unsigned cand = kp | (1u << bit); int c0 = 0, c1 = 0;
                DSA_FOR_TILES(cnt_le(c0, u[T][0], cand); cnt_le(c1, u[T][1], cand); cnt_le(c0, u[T][2], cand); cnt_le(c1, u[T][3], cand);)
                const int tot = dsa_total(cnt, par, wave, j, gq, c0 + c1); par ^= 1;
                if (tot <= 255) kp = cand;
            }
        }
        const unsigned kp1 = kp + 1u;
        int ns0 = 0, ns1 = 0;
        if (alle) { DSA_FOR_TILES(cnt_ge(ns0, u[T][0], prefix); cnt_ge(ns1, u[T][1], prefix); cnt_ge(ns0, u[T][2], prefix); cnt_ge(ns1, u[T][3], prefix);) }
        else { DSA_FOR_TILES(cnt_le(ns0, u[T][0], kp1); cnt_le(ns1, u[T][1], kp1); cnt_le(ns0, u[T][2], kp1); cnt_le(ns1, u[T][3], kp1);) }
        pc[(wave * 4 + gq) * 16 + j] = (unsigned)(ns0 + ns1);
        __syncthreads();
        int base = 0;
        { const int me = wave * 4 + gq;
#pragma unroll
          for (int i = 0; i < 31; ++i) { const int v = (int)pc[i * 16 + j]; base += (i < me) ? v : 0; } }
        if (alle) { DSA_FOR_TILES(_Pragma("unroll") for (int e = 0; e < 4; ++e) { if (u[T][e] >= prefix) { if (base < 256) list[j * 256 + base] = (unsigned short)(kb0 + 128 * T + e); ++base; } }) }
        else { DSA_FOR_TILES(_Pragma("unroll") for (int e = 0; e < 4; ++e) { if (u[T][e] <= kp1) { if (base < 256) list[j * 256 + base] = (unsigned short)(kb0 + 128 * T + e); ++base; } }) }
    } else {
        for (int i = tid; i < 16 * 256; i += 512) list[i] = (unsigned short)(i & 255);
    }
    __syncthreads();
    TP_MARK(3);
    {
    const int lane4_ = lane_id_v(); const int lane = lane4_, j = lane4_ & 15, gq = lane4_ >> 4;
    const bf16* kva = (const bf16*)(ws + WS_KVA);
    bf16* qa = (bf16*)(ws + WS_QA);
    LAS unsigned char* Vw = lds + DSA_OFF_V + wave * 16384;
    const unsigned vlds0 = (unsigned)(uintptr_t)(unsigned char*)Vw;
    const int tq2[2] = {q0 + 2 * wave, q0 + 2 * wave + 1};
    const int nselq[2] = {tq2[0] + 1 < 256 ? tq2[0] + 1 : 256, tq2[1] + 1 < 256 ? tq2[1] + 1 : 256};
    v4u qfq[2][2];
#pragma unroll
    for (int qq = 0; qq < 2; ++qq)
#pragma unroll
        for (int ks = 0; ks < 2; ++ks) { qfq[qq][ks] = (v4u){0u, 0u, 0u, 0u}; if (j < 8) qfq[qq][ks] = *(const v4u*)(qa + (size_t)(b * SEQ + tq2[qq]) * 512 + j * 64 + 8 * gq + 32 * ks); }
    asm volatile("s_waitcnt vmcnt(0)" : "+v"(qfq[0][0]), "+v"(qfq[0][1]), "+v"(qfq[1][0]), "+v"(qfq[1][1]) :: "memory");
    const bf16* kvb_ = kva + (size_t)b * SEQ * 128;
    const unsigned long long kvbase = ((unsigned long long)(unsigned)__builtin_amdgcn_readfirstlane((int)((unsigned long long)(uintptr_t)kvb_ >> 32)) << 32) | (unsigned long long)(unsigned)__builtin_amdgcn_readfirstlane((int)(unsigned)(uintptr_t)kvb_);
    const unsigned kofs = (unsigned)gq * 16u, vofs = 128u + (unsigned)(lane & 7) * 16u;
#define DSA_KEY(M_, st_, slot_) ((unsigned)list[(2 * wave + ((st_) >> 2)) * 256 + ((M_) ? (((slot_) < nselq[(st_) >> 2]) ? (slot_) : 0) : (slot_))])
#define DSA_ISSUEK(M_, buf_, st_) do { unsigned ky_[4]; _Pragma("unroll") for (int kt_ = 0; kt_ < 4; ++kt_) ky_[kt_] = DSA_KEY(M_, st_, 64 * ((st_) & 3) + 16 * kt_ + j) * 256u + kofs; \
        _Pragma("unroll") for (int kt_ = 0; kt_ < 4; ++kt_) { \
        asm volatile("global_load_dwordx4 %0, %1, %2" : "=v"(buf_[2 * kt_]) : "v"(ky_[kt_]), "s"(kvbase) : "memory"); asm volatile("global_load_dwordx4 %0, %1, %2 offset:64" : "=v"(buf_[2 * kt_ + 1]) : "v"(ky_[kt_]), "s"(kvbase) : "memory"); } } while (0)
#define DSA_ISSUEV(M_, st_) do { unsigned kv_[8]; _Pragma("unroll") for (int i_ = 0; i_ < 8; ++i_) kv_[i_] = DSA_KEY(M_, st_, 64 * ((st_) & 3) + 8 * i_ + (lane >> 3)) * 256u + vofs; \
        unsigned keep_; const unsigned ld_ = (unsigned)__builtin_amdgcn_readfirstlane((int)(vlds0 + ((st_) & 1) * 8192)); \
        asm volatile("s_mov_b32 %0, m0\n\ts_mov_b32 m0, %9\n\ts_nop 0\n\t" \
                     "global_load_lds_dwordx4 %1, %10\n\ts_add_u32 m0, m0, 0x400\n\ts_nop 0\n\t" "global_load_lds_dwordx4 %2, %10\n\ts_add_u32 m0, m0, 0x400\n\ts_nop 0\n\t" \
                     "global_load_lds_dwordx4 %3, %10\n\ts_add_u32 m0, m0, 0x400\n\ts_nop 0\n\t" "global_load_lds_dwordx4 %4, %10\n\ts_add_u32 m0, m0, 0x400\n\ts_nop 0\n\t" \
                     "global_load_lds_dwordx4 %5, %10\n\ts_add_u32 m0, m0, 0x400\n\ts_nop 0\n\t" "global_load_lds_dwordx4 %6, %10\n\ts_add_u32 m0, m0, 0x400\n\ts_nop 0\n\t" \
                     "global_load_lds_dwordx4 %7, %10\n\ts_add_u32 m0, m0, 0x400\n\ts_nop 0\n\t" "global_load_lds_dwordx4 %8, %10\n\ts_mov_b32 m0, %0" \
                     : "=&s"(keep_) : "v"(kv_[0]), "v"(kv_[1]), "v"(kv_[2]), "v"(kv_[3]), "v"(kv_[4]), "v"(kv_[5]), "v"(kv_[6]), "v"(kv_[7]), "s"(ld_), "s"(kvbase) : "memory", "scc"); } while (0)
#define DSA_WAITK(buf_, n_) asm volatile("s_waitcnt vmcnt(" #n_ ")" : "+v"(buf_[0]), "+v"(buf_[1]), "+v"(buf_[2]), "+v"(buf_[3]), "+v"(buf_[4]), "+v"(buf_[5]), "+v"(buf_[6]), "+v"(buf_[7]) :: "memory")
    v4u kA[8], kB[8], kC[8];
    float mrow = NEGF, lrow = 0.f; f32x4v o[4];
#define DSA_STEP(M_, st_, cur_, nx2_, NK_, NV_) do { \
        if ((st_) + 2 < 8) DSA_ISSUEK(M_, nx2_, (st_) + 2); \
        if (((st_) & 3) == 0) { mrow = NEGF; lrow = 0.f; _Pragma("unroll") for (int dt_ = 0; dt_ < 4; ++dt_) o[dt_] = (f32x4v){0.f, 0.f, 0.f, 0.f}; } \
        DSA_WAITK(cur_, NK_); \
        const bf16x8 q0_ = __builtin_bit_cast(bf16x8, qfq[(st_) >> 2][0]), q1_ = __builtin_bit_cast(bf16x8, qfq[(st_) >> 2][1]); \
        f32x4v s_[4]; float bm_ = NEGF; \
        _Pragma("unroll") for (int kt_ = 0; kt_ < 4; ++kt_) { f32x4v a_ = {0.f, 0.f, 0.f, 0.f}; \
            a_ = __builtin_amdgcn_mfma_f32_16x16x32_bf16(__builtin_bit_cast(bf16x8, cur_[2 * kt_]), q0_, a_, 0, 0, 0); a_ = __builtin_amdgcn_mfma_f32_16x16x32_bf16(__builtin_bit_cast(bf16x8, cur_[2 * kt_ + 1]), q1_, a_, 0, 0, 0); \
            _Pragma("unroll") for (int e_ = 0; e_ < 4; ++e_) { const float v_ = (!(M_) || (64 * ((st_) & 3) + 16 * kt_ + 4 * gq + e_ < nselq[(st_) >> 2])) ? a_[e_] : NEGF; a_[e_] = v_; bm_ = fmaxf(bm_, v_); } s_[kt_] = a_; } \
        bm_ = xmax16(bm_); \
        { const float mnew_ = fmaxf(mrow, bm_), alpha_ = __builtin_amdgcn_exp2f(mrow - mnew_); mrow = mnew_; float ps_ = 0.f; \
          _Pragma("unroll") for (int kt_ = 0; kt_ < 4; ++kt_) _Pragma("unroll") for (int e_ = 0; e_ < 4; ++e_) { const float p_ = __builtin_amdgcn_exp2f(s_[kt_][e_] - mnew_); s_[kt_][e_] = p_; ps_ += p_; } \
          lrow = lrow * alpha_ + ps_; _Pragma("unroll") for (int dt_ = 0; dt_ < 4; ++dt_) o[dt_] *= alpha_; } \
        asm volatile("s_waitcnt vmcnt(" #NV_ ")" : "+v"(s_[0]), "+v"(s_[1]), "+v"(s_[2]), "+v"(s_[3]) :: "memory");       \
        { const LAS unsigned char* Vb_ = Vw + ((st_) & 1) * 8192; \
        _Pragma("unroll") for (int kk_ = 0; kk_ < 2; ++kk_) { \
            const bf16x8 pf_ = pack8(s_[2 * kk_][0], s_[2 * kk_][1], s_[2 * kk_][2], s_[2 * kk_][3], s_[2 * kk_ + 1][0], s_[2 * kk_ + 1][1], s_[2 * kk_ + 1][2], s_[2 * kk_ + 1][3]); \
            _Pragma("unroll") for (int dt_ = 0; dt_ < 4; ++dt_) { const LAS unsigned char* va_ = Vb_ + (32 * kk_ + 4 * gq + (j >> 2)) * 128 + (16 * dt_ + 4 * (j & 3)) * 2; \
                o[dt_] = __builtin_amdgcn_mfma_f32_16x16x32_bf16(cat4(tr16(va_), tr16(va_ + 16 * 128)), pf_, o[dt_], 0, 0, 0); } } } \
        if (((st_) & 3) == 3) { const float inv_ = __builtin_amdgcn_rcpf(xsum16(lrow)); const int rowq_ = b * SEQ + tq2[(st_) >> 2]; \
            if (j < 8) { _Pragma("unroll") for (int dt_ = 0; dt_ < 4; ++dt_) { uint2 w_; w_.x = cvtpk(o[dt_][0] * inv_, o[dt_][1] * inv_); w_.y = cvtpk(o[dt_][2] * inv_, o[dt_][3] * inv_); \
                *(uint2*)(yout + (size_t)rowq_ * 512 + j * 64 + 16 * dt_ + 4 * gq) = w_; } } } \
        if ((st_) + 2 < 8) { asm volatile("s_waitcnt lgkmcnt(0)" ::: "memory"); DSA_ISSUEV(M_, (st_) + 2); } \
    } while (0)
#define DSA_RUN(M_) do { DSA_ISSUEK(M_, kA, 0); DSA_ISSUEV(M_, 0); DSA_ISSUEK(M_, kB, 1); DSA_ISSUEV(M_, 1); \
    DSA_STEP(M_, 0, kA, kC, 32, 24); DSA_STEP(M_, 1, kB, kA, 32, 24); DSA_STEP(M_, 2, kC, kB, 32, 24); DSA_STEP(M_, 3, kA, kC, 32, 24); \
    DSA_STEP(M_, 4, kB, kA, 32, 24); DSA_STEP(M_, 5, kC, kB, 32, 24); DSA_STEP(M_, 6, kA, kC, 24, 16); DSA_STEP(M_, 7, kB, kA, 8, 0); } while (0)
    if (q0 >= 256) DSA_RUN(0); else DSA_RUN(1);
#if DUP == 20
    if (q0 >= 256) DSA_RUN(0); else DSA_RUN(1);
#endif
#undef DSA_RUN
#undef DSA_STEP
#undef DSA_ISSUEK
#undef DSA_ISSUEV
#undef DSA_WAITK
#undef DSA_KEY
    }
    __syncthreads();
    TP_MARK(4);
}
__device__ __forceinline__ void phase_mixers(const Args& P, unsigned char* ws, int z, LAS unsigned char* lds, int gw, int NGW, int lane, int wave, int bid, int G, int l) {
    asm volatile("" : "+v"(lane)); lane &= 63; asm volatile("" : "+s"(gw), "+s"(NGW));
    unsigned* qc = (unsigned*)(ws + WS_CTL) + 9216 + l * 8;
    volatile LAS unsigned* bw = (volatile LAS unsigned*)(lds + LDSCTL_OFF) + 40;
    const bool lead = (wave == 0) && (lane == 0);
    int qid = (int)(xb_xcc_id() & 7u), tries = 0;
#define MIX_BCAST(v_) ({ if (lead) *bw = (unsigned)(v_); __syncthreads(); const int r_ = (int)*bw; __syncthreads(); __builtin_amdgcn_readfirstlane(r_); })
    int nx = 0; if (lead) nx = (int)__hip_atomic_fetch_add(qc + qid, 1u, __ATOMIC_RELAXED, __HIP_MEMORY_SCOPE_AGENT);
    int cur = MIX_BCAST(nx);
    for (;;) {
        while (cur >= 384) { if (++tries == 8) break; qid = (qid + 1) & 7; nx = 0; if (lead) nx = (int)__hip_atomic_fetch_add(qc + qid, 1u, __ATOMIC_RELAXED, __HIP_MEMORY_SCOPE_AGENT); cur = MIX_BCAST(nx); }
        if (cur >= 384) break;
        nx = 0; if (lead) nx = (int)__hip_atomic_fetch_add(qc + qid, 1u, __ATOMIC_RELAXED, __HIP_MEMORY_SCOPE_AGENT);
        const int t3 = cur / 3;
        if (cur - 3 * t3 == 0) { const int n = t3, unit = (qid * 2 + (n & 1)) * 64 + (63 - (n >> 1)); nsa_unit(ws, unit, lds, (wave << 6) | lane_id_v(), (bf16*)(ws + WS_QC)); }
        else { const int d = cur - t3 - 1, unit = qid * 256 + (255 - d); dsa_unit(ws, unit, lds, (wave << 6) | lane_id_v(), (bf16*)(ws + WS_QA)); }
        cur = MIX_BCAST(nx);
    }
#undef MIX_BCAST
}
__global__ void __launch_bounds__(NWAVES * 64, 2) fwd_kernel(Args args) {
    extern __shared__ __attribute__((aligned(16))) unsigned char lds_raw[];
    LAS unsigned char* lds = (LAS unsigned char*)lds_raw;
    const int wave = __builtin_amdgcn_readfirstlane((int)threadIdx.x >> 6);
#define TIDX ((wave << 6) | lane_id_v())
#define tid TIDX
#define lane TIDX
    const int G = gridDim.x, bid = blockIdx.x;
    const int gw = bid * NWAVES + wave, NGW = G * NWAVES;
    const int lo = args.ph_lo, hi = args.ph_hi;
    const Args& P = args;
    int z = 0; asm volatile("" : "+s"(z));
    unsigned char* ws = args.ws + z;
    volatile LAS unsigned* MISCW = (volatile LAS unsigned*)(lds + LDSCTL_OFF);
    if (tid < 64) MISCW[tid] = 0u;
    __syncthreads();
    XcdBarrier bar; bar.bar = (unsigned*)(ws + WS_CTL) + 4096; bar.x = 0; bar.st = nullptr;
    if (hi - lo > 1) bar = xcd_barrier_post((unsigned*)(ws + WS_CTL) + 4096, MISCW + 8);
#define RUN(k) (lo <= (k) && (k) < hi)
#if TPROBE
#define TP_PHASE(k) do { if (bid == 0 && TIDX == 0) { volatile unsigned long long* sl_ = (volatile unsigned long long*)(args.ws + z + 32768); const unsigned long long n_ = __builtin_amdgcn_s_memtime(); const int cls_ = (k) == 0 ? 0 : 1 + (((k) - 1) % NPL); sl_[16 + cls_] += n_ - sl_[30]; sl_[30] = n_; } } while (0)
#else
#define TP_PHASE(k)
#endif
#define SEAM(k) do { TP_PHASE(k); if ((k) + 1 < hi) { XcdBarrier b2_ = bar; asm volatile("" : "+s"(b2_.bar), "+s"(b2_.x)); xcd_barrier(b2_); if (DUP == 13) xcd_barrier(b2_); } else { VM_WAIT(); __syncthreads(); } } while (0)


#if TPROBE
    if (bid == 0 && TIDX == 0) { volatile unsigned long long* sl_ = (volatile unsigned long long*)(args.ws + z + 32768); sl_[30] = __builtin_amdgcn_s_memtime(); }
#endif
    if (RUN(0)) { phase_rope(P, ws, z, bid * (NWAVES * 64) + tid, G * NWAVES * 64);
        { int ln_ = TIDX; asm volatile("" : "+v"(ln_)); ln_ &= 63;
          for (int m = gw; m < M; m += NGW) stat_row_bf16(P.in[0 + z] + (size_t)m * DM, (bf16*)(ws + WS_XN) + (size_t)m * DM, (float*)(ws + WS_SSQ) + (size_t)m * 16, ln_); }
        SEAM(0); }
#define RS_PREPASS(Sref) do { const float* ssq_ = (const float*)(ws + WS_SSQ); LAS float* rsl_ = (LAS float*)(lds + RS_OFF); const int t_ = TIDX; pg8::Unit u_; \
        for (int i_ = 0; (Sref).next(i_, u_); ++i_) { const f32x4* p_ = (const f32x4*)(ssq_ + (size_t)(u_.pm * 256 + (t_ >> 1)) * 16 + (t_ & 1) * 8); const f32x4 a_ = p_[0], b_ = p_[1]; \
            float s_ = (a_.x + a_.y) + (a_.z + a_.w) + (b_.x + b_.y) + (b_.z + b_.w); s_ += __shfl_xor(s_, 1); if ((t_ & 1) == 0) rsl_[i_ * 256 + (t_ >> 1)] = 1.0f / sqrtf(s_ * (1.f / DM) + EPS); } \
        __syncthreads(); } while (0)

    for (int it = 0; it < 2 * DEPTH; ++it) {
        const int l = it >> 1, second = it & 1, pb = 1 + l * NPL + (second ? 7 : 0);
        asm volatile("" : "+s"(z));
        ws = args.ws + z;
        bf16* const XN = (bf16*)(ws + WS_XN);
        bf16* const HB = (bf16*)(ws + WS_H);
        bf16* const MG = (bf16*)(ws + WS_MG);
        bf16* const GB = (bf16*)(ws + WS_G);
        unsigned char* const wb = ws + WS_W;
        float* const OUT = P.out + z;
        if (!second && RUN(pb)) { phase_convert(P, ws, z, l, lds, gw, NGW, lane, wave);
#if DUP == 30
            phase_convert(P, ws, z, l, lds, gw, NGW, lane, wave);
#endif
            SEAM(pb); }
        if (RUN(pb + 1)) {
            pg8::Gemm g{XN, (const bf16*)(wb + (second ? WO_GU2 : WO_GU1)), M, 2 * FF, DM}; pg8::StaticOrder S; S.init(M, 2 * FF, G, bid + z);
            pg8::EpiSwiglu E{HB, FF, (const LAS float*)(lds + RS_OFF)};
            RS_PREPASS(S);
#if !defined(SITE_MASK) || ((SITE_MASK >> 0) & 1)
            pg8::gemm_phase<pg8::EpiSwiglu, pg8::StaticOrder, ALIGN_UP, true>(lds, g, S, E, TIDX);
#if DUP == 3
            pg8::gemm_phase<pg8::EpiSwiglu, pg8::StaticOrder, ALIGN_UP, true>(lds, g, S, E, TIDX);
#endif
#endif
            SEAM(pb + 1);
        }
        if (RUN(pb + 2)) {
            pg8::Gemm g{HB, (const bf16*)(wb + (second ? WO_D2 : WO_D1)), M, DM, FF}; pg8::StaticOrder S; S.init(M, DM, G, bid + z);
            pg8::EpiResid E{XN, 0.5f, (float*)(ws + WS_SSQ)};
#if !defined(SITE_MASK) || ((SITE_MASK >> 1) & 1)
            pg8::gemm_phase<pg8::EpiResid, pg8::StaticOrder, true, true>(lds, g, S, E, TIDX);
#endif
            SEAM(pb + 2);
        }
        if (second) continue;
        const int pm = 1 + l * NPL + 2;
        if (RUN(pm + 1)) {
            pg8::Gemm g{XN, (const bf16*)(wb + WO_IN), M, NINP, DM}; pg8::StaticOrder S; S.init(M, NINP, G, bid + z);
            pg8::EpiWin E{(bf16*)(ws + WS_QA), (bf16*)(ws + WS_QC), (bf16*)(ws + WS_IQ), (bf16*)(ws + WS_MISC), (bf16*)(ws + WS_KVC), (bf16*)(ws + WS_KVS), (bf16*)(ws + WS_KVW), (bf16*)(ws + WS_BU), GB,
                          (const float*)(ws + WS_ROPE), (const LAS float*)(lds + RS_OFF)};
            RS_PREPASS(S);
#if !defined(SITE_MASK) || ((SITE_MASK >> 2) & 1)
            pg8::gemm_phase<pg8::EpiWin, pg8::StaticOrder, ALIGN_WIN, true>(lds, g, S, E, TIDX);
#if DUP == 4
            pg8::gemm_phase<pg8::EpiWin, pg8::StaticOrder, ALIGN_WIN, true>(lds, g, S, E, TIDX);
#endif
#endif
            SEAM(pm + 1);
        }
        #ifndef NO_PREP
        if (RUN(pm + 2)) { phase_prep(P, ws, z, l, lds, gw, NGW, lane, wave, (bf16*)OUT);
#if DUP == 1
            { XcdBarrier b2_ = bar; asm volatile("" : "+s"(b2_.bar), "+s"(b2_.x)); xcd_barrier(b2_); } phase_prep(P, ws, z, l, lds, gw, NGW, lane, wave, (bf16*)OUT);
#endif
            SEAM(pm + 2); }
#endif
        #ifndef NO_MIX
        if (RUN(pm + 3)) {
#if TPROBE
            unsigned long long tm0_ = __builtin_amdgcn_s_memtime();
#endif
            phase_mixers(P, ws, z, lds, gw, NGW, lane, wave, bid, G, l);
#if TPROBE
            { const unsigned long long tm1_ = __builtin_amdgcn_s_memtime(); if (TIDX == 0) { atomicAdd((unsigned long long*)(args.ws + z + 32768) + 12, tm1_ - tm0_); atomicMax((unsigned long long*)(args.ws + z + 32768) + 13 + (l & 1), tm1_ - tm0_); } }
#endif
            SEAM(pm + 3); }
#endif
        if (RUN(pm + 4)) {
#if DUP == 5
          for (int rep_ = 0; rep_ < 2; ++rep_) {
#endif
            pg8::StaticOrder S; S.init(M, DM, G, bid + z);
            { pg8::Gemm g{(const bf16*)(ws + WS_QA), (const bf16*)(wb + WO_PA), M, DM, 512}; pg8::EpiProj<0> E{MG, GB, 0};
#if !defined(SITE_MASK) || ((SITE_MASK >> 3) & 1)
              pg8::gemm_phase<pg8::EpiProj<0>, pg8::StaticOrder, true, true>(lds, g, S, E, TIDX);
#endif
            }
            { pg8::Gemm g{(const bf16*)OUT, (const bf16*)(wb + WO_PB), M, DM, 512}; pg8::EpiProj<1> E{MG, GB, 1024};
#if !defined(SITE_MASK) || ((SITE_MASK >> 4) & 1)
              pg8::gemm_phase<pg8::EpiProj<1>, pg8::StaticOrder, true, true>(lds, g, S, E, TIDX);
#endif
            }
            { pg8::Gemm g{(const bf16*)(ws + WS_QC), (const bf16*)(wb + WO_PC), M, DM, 512}; pg8::EpiProj<1> E{MG, GB, 2048};
#if !defined(SITE_MASK) || ((SITE_MASK >> 5) & 1)
              pg8::gemm_phase<pg8::EpiProj<1>, pg8::StaticOrder, true, true>(lds, g, S, E, TIDX);
#endif
            }
#if DUP == 5
          }
#endif
#if DUP == 31
            { pg8::Gemm g{(const bf16*)(ws + WS_QC), (const bf16*)(wb + WO_PC), M, DM, 512}; pg8::EpiPlain E{(bf16*)OUT + (size_t)32 * 1024 * 1024 / 2};
              pg8::gemm_phase<pg8::EpiPlain, pg8::StaticOrder, true, true>(lds, g, S, E, TIDX); }
#endif
            SEAM(pm + 4);
        }
        if (RUN(pm + 5)) {
            pg8::Gemm g{MG, (const bf16*)(wb + WO_OUT), M, DM, DM}; pg8::StaticOrder S; S.init(M, DM, G, bid + z);
            pg8::EpiResid E{XN, 1.0f, (float*)(ws + WS_SSQ)};
#if !defined(SITE_MASK) || ((SITE_MASK >> 6) & 1)
            pg8::gemm_phase<pg8::EpiResid, pg8::StaticOrder, true, true>(lds, g, S, E, TIDX);
#endif
            SEAM(pm + 5);
        }
    }
    if (RUN(NPH - 1)) { asm volatile("" : "+s"(z)); int ln_ = TIDX; asm volatile("" : "+v"(ln_)); ln_ &= 63; float* o_ = P.out + z; float tps_ = 1.0f;
#if TPROBE
        { const unsigned long long* sl_ = (const unsigned long long*)(P.ws + z + 32768); double a_ = 0., b_ = 0.; for (int k = 0; k < 32; ++k) { const double v_ = (double)__hip_atomic_load(sl_ + k, __ATOMIC_RELAXED, __HIP_MEMORY_SCOPE_AGENT); if (((unsigned)TP_A >> k) & 1) a_ += v_; if (((unsigned)TP_B >> k) & 1) b_ += v_; } tps_ = 1.0f + floorf((float)(a_ / b_) * TP_SCALE * 20.0f + 0.5f) * 0.05f; }
#endif
        { const bf16* xr_ = (const bf16*)(args.ws + z + WS_XN); for (int m = gw; m < M; m += NGW) norm_row_out(xr_ + (size_t)m * DM, o_ + (size_t)m * DM, P.in[23 + z], ln_, tps_); }
#if TPROBE
        if (gw == 0 && ln_ == 0) { const unsigned long long* sl_ = (const unsigned long long*)(P.ws + z + 32768); double c_ = 0., d_ = 0.; for (int k = 0; k < 32; ++k) { const double v_ = (double)__hip_atomic_load(sl_ + k, __ATOMIC_RELAXED, __HIP_MEMORY_SCOPE_AGENT); if (((unsigned)TP_C >> k) & 1) c_ += v_; if (((unsigned)TP_D >> k) & 1) d_ += v_; } o_[0] = 1000.0f * floorf((float)(c_ / d_) * TP_SCALE2 * 20.0f + 0.5f) * 0.05f; }
#endif
    }
#undef RUN
#undef tid
#undef TIDX
#undef lane
#undef SEAM
}

extern "C" void kernel_launch(void* const* d_in, const int* in_sizes, int n_in, void* d_out, int out_size, void* d_ws, size_t ws_size, hipStream_t stream) {
    static int grid = 0;
    if (grid == 0) {
        if (n_in != 24 || out_size != M * DM || ws_size < WS_END) { fprintf(stderr, "kernel_launch: unexpected shapes (n_in %d out %d ws %zu)\n", n_in, out_size, ws_size); grid = -1; return; }
        int dev = 0, cus = 0, per_cu = 0;
        if (hipGetDevice(&dev) != hipSuccess || hipDeviceGetAttribute(&cus, hipDeviceAttributeMultiprocessorCount, dev) != hipSuccess) { grid = -1; return; }
        if (hipFuncSetAttribute((const void*)fwd_kernel, hipFuncAttributeMaxDynamicSharedMemorySize, LDS_BYTES) != hipSuccess) { fprintf(stderr, "kernel_launch: hipFuncSetAttribute failed\n"); grid = -1; return; }
        if (hipOccupancyMaxActiveBlocksPerMultiprocessor(&per_cu, (const void*)fwd_kernel, NWAVES * 64, LDS_BYTES) != hipSuccess || per_cu < 1) { fprintf(stderr, "kernel_launch: occupancy query says %d\n", per_cu); }
        (void)hipGetLastError();
        grid = cus;
    }
    if (grid < 0) return;
    (void)hipMemsetAsync((char*)d_ws + WS_CTL, 0, CTL_ZERO_BYTES, stream);
    Args a{};
    for (int i = 0; i < 24; ++i) a.in[i] = (const float*)d_in[i];
    a.out = (float*)d_out; a.ws = (unsigned char*)d_ws;
#if MK_ONE_LAUNCH
    a.ph_lo = 0; a.ph_hi = NPH;
    hipLaunchKernelGGL(fwd_kernel, dim3(grid), dim3(NWAVES * 64), LDS_BYTES, stream, a);
#else
    for (int ph = 0; ph < NPH; ++ph) { a.ph_lo = ph; a.ph_hi = ph + 1; hipLaunchKernelGGL(fwd_kernel, dim3(grid), dim3(NWAVES * 64), LDS_BYTES, stream, a); }
#endif
}
```

```cpp
#include <hip/hip_runtime.h>
#include <cstdio>
#include <cstdint>
#define PROBE 0
#define PROBE_GAIN 10.0f
#define TOP8_RANK 1
#define PROBE_ROWTHR 0.01f
#define PROBE_ROWCOND 1
#define PROBE_BR -1
#define FIXHOM 0
#define DUP 0
#define TPROBE 0
#define TP_A 1
#define TP_B 1
#define TP_SCALE 1.0f
#define TP_C 1
#define TP_D 1
#define TP_SCALE2 1.0f
#define POOLDBG 0
#define YB_SPARE 0
#define ALIGN_UP true
#define ALIGN_WIN true
#define DSA_CAP_V 512
#define DSA_K_V 13
#ifndef MK_ONE_LAUNCH
#define MK_ONE_LAUNCH 1
#endif
namespace pg8 {
#define PG8_LAS __attribute__((address_space(3)))
typedef unsigned short bf16_t;
typedef short bf16x8 __attribute__((ext_vector_type(8)));
typedef float f32x4 __attribute__((ext_vector_type(4)));
typedef unsigned u32x4 __attribute__((ext_vector_type(4)));
constexpr int BM = 256, BK = 64, HALF = 128, HTB = HALF * BK * 2  , STAGE_BYTES = 8 * HTB, NXCD = 8, WGM = 8;

__host__ __device__ __forceinline__ int lds_byte(int r, int c) { const int st = (r >> 4) * 2 + (c >> 5), rr = r & 15, cc = c & 31, ob = rr * 64 + cc * 2; return st * 1024 + (ob ^ (((ob >> 9) & 1) << 5)); }
__host__ __device__ __forceinline__ void stage_rc(int b, int& R, int& C) { const int st = b / 1024, sb = b % 1024, swz = sb ^ (((sb >> 9) & 1) << 5); R = (st >> 1) * 16 + swz / 64; C = (st & 1) * 32 + (swz % 64) / 2; }
__host__ __device__ __forceinline__ int perm32(int rho) { const int n = rho >> 4, i = rho & 15; return 8 * (i >> 2) + 4 * n + (i & 3); }

struct Unit { int pm, pn, ord; };
struct Gemm { const bf16_t* A; const bf16_t* Bt; int M, N, K; };

struct StaticOrder {
    int nM, nN, nwg, G, c;
    __host__ __device__ __forceinline__ void init(int M, int N, int G_, int c_) { nM = M / BM; nN = N / BM; nwg = nM * nN; G = G_; c = c_; }
    __host__ __device__ __forceinline__ bool next(int i, Unit& u) const {
        const long L = (long)i * G + c; if (L >= nwg) return false;
        int wgid = (int)L; { const int q = nwg / NXCD, r = nwg % NXCD, xcd = wgid % NXCD, off = wgid / NXCD; wgid = (xcd < r ? xcd * (q + 1) : r * (q + 1) + (xcd - r) * q) + off; }
        const int nig = WGM * nN, gid = wgid / nig, fm = gid * WGM, gsz = (nM - fm) < WGM ? (nM - fm) : WGM;
        u.pm = fm + ((wgid % nig) % gsz); u.pn = (wgid % nig) / gsz; u.ord = i; return true;
    }
    __device__ __forceinline__ void a_ready(const Unit&) const {}
    __device__ __forceinline__ void done(const Unit&) const {}
};

__device__ __forceinline__ unsigned cvt_pk_bf16(float lo, float hi) { unsigned r; asm volatile("v_cvt_pk_bf16_f32 %0, %1, %2" : "=v"(r) : "v"(lo), "v"(hi)); return r; }
__device__ __forceinline__ float bflo(unsigned w) { return __uint_as_float(w << 16); }
__device__ __forceinline__ float bfhi(unsigned w) { return __uint_as_float(w & 0xffff0000u); }
__device__ __forceinline__ float fast_sigmoid(float x) { return __builtin_amdgcn_rcpf(1.0f + __expf(-x)); }

struct EpiSwiglu {
    static constexpr bool PERM = true, AFTER_DRAIN = false;
    bf16_t* H; int ldh; const PG8_LAS float* rs;
    __device__ __forceinline__ void operator()(const f32x4 (&acc)[2][2][4][2], const Unit& u, int wr, int wc, int fr, int fq) const {
        const int row0 = u.pm * BM + wr * 64 + fr, col0 = u.pn * HALF + wc * 32 + 8 * fq;
#pragma unroll
        for (int ai = 0; ai < 2; ++ai)
#pragma unroll
            for (int m = 0; m < 4; ++m) {
                bf16_t* rowp = H + (size_t)(row0 + ai * HALF + m * 16) * ldh + col0;
                const float r = rs[u.ord * 256 + wr * 64 + fr + ai * HALF + m * 16];
                float o[8];
#pragma unroll
                for (int n = 0; n < 2; ++n)
#pragma unroll
                    for (int e = 0; e < 4; ++e) { const float g = acc[ai][0][m][n][e] * r, up = acc[ai][1][m][n][e] * r; o[n * 4 + e] = g * fast_sigmoid(g) * up; }
                u32x4 w; w.x = cvt_pk_bf16(o[0], o[1]); w.y = cvt_pk_bf16(o[2], o[3]); w.z = cvt_pk_bf16(o[4], o[5]); w.w = cvt_pk_bf16(o[6], o[7]);
                *(u32x4*)rowp = w;
            }
    }
};
struct EpiResid {
    static constexpr bool PERM = true, AFTER_DRAIN = false;
    bf16_t* xb; float s; float* ssq;
    __device__ __forceinline__ void operator()(const f32x4 (&acc)[2][2][4][2], const Unit& u, int wr, int wc, int fr, int fq) const {
        const int row0 = u.pm * BM + wr * 64 + fr, col0 = u.pn * BM + wc * 32 + 8 * fq;
#pragma unroll
        for (int ai = 0; ai < 2; ++ai) {
            u32x4 bv[4][2];
#pragma unroll
            for (int m = 0; m < 4; ++m)
#pragma unroll
                for (int bj = 0; bj < 2; ++bj) bv[m][bj] = *(const u32x4*)(xb + (size_t)(row0 + ai * HALF + m * 16) * 1024 + col0 + bj * HALF);
#pragma unroll
            for (int m = 0; m < 4; ++m) {
                const size_t off = (size_t)(row0 + ai * HALF + m * 16) * 1024 + col0;
                float q = 0.f;
#pragma unroll
                for (int bj = 0; bj < 2; ++bj) {
                    const u32x4 b = bv[m][bj];
                    const f32x4 b0 = {bflo(b.x), bfhi(b.x), bflo(b.y), bfhi(b.y)}, b1 = {bflo(b.z), bfhi(b.z), bflo(b.w), bfhi(b.w)};
                    const f32x4 x0 = b0 + acc[ai][bj][m][0] * s, x1 = b1 + acc[ai][bj][m][1] * s;
                    q += (x0[0] * x0[0] + x0[1] * x0[1]) + (x0[2] * x0[2] + x0[3] * x0[3]) + (x1[0] * x1[0] + x1[1] * x1[1]) + (x1[2] * x1[2] + x1[3] * x1[3]);
                    u32x4 w; w.x = cvt_pk_bf16(x0[0], x0[1]); w.y = cvt_pk_bf16(x0[2], x0[3]); w.z = cvt_pk_bf16(x1[0], x1[1]); w.w = cvt_pk_bf16(x1[2], x1[3]);
                    *(u32x4*)(xb + off + bj * HALF) = w;
                }
                q += __shfl_xor(q, 16); q += __shfl_xor(q, 32);
                if (fq == 0) ssq[(size_t)(row0 + ai * HALF + m * 16) * 16 + u.pn * 4 + wc] = q;
            }
        }
    }
};
template <int MODE> struct EpiProj {
    static constexpr bool PERM = true, AFTER_DRAIN = false;
    bf16_t* MG; const bf16_t* G; int gofs;
    __device__ __forceinline__ void operator()(const f32x4 (&acc)[2][2][4][2], const Unit& u, int wr, int wc, int fr, int fq) const {
        const int row0 = u.pm * BM + wr * 64 + fr, col0 = u.pn * BM + wc * 32 + 8 * fq;
#pragma unroll
        for (int ai = 0; ai < 2; ++ai) {
            u32x4 gv[8], ov[8];
#pragma unroll
            for (int q = 0; q < 8; ++q) { const int m = q >> 1, bj = q & 1; const size_t row = (size_t)(row0 + ai * HALF + m * 16);
                gv[q] = *(const u32x4*)(G + row * 3072 + gofs + col0 + bj * HALF); if (MODE) ov[q] = *(const u32x4*)(MG + row * 1024 + col0 + bj * HALF); }
#pragma unroll
            for (int q = 0; q < 8; ++q) { const int m = q >> 1, bj = q & 1; const size_t row = (size_t)(row0 + ai * HALF + m * 16);
                bf16_t* mp = MG + row * 1024 + col0 + bj * HALF;
                const f32x4 a0 = acc[ai][bj][m][0], a1 = acc[ai][bj][m][1];
                float o[8] = {bflo(gv[q].x) * a0[0], bfhi(gv[q].x) * a0[1], bflo(gv[q].y) * a0[2], bfhi(gv[q].y) * a0[3], bflo(gv[q].z) * a1[0], bfhi(gv[q].z) * a1[1], bflo(gv[q].w) * a1[2], bfhi(gv[q].w) * a1[3]};
                if (MODE) { o[0] += bflo(ov[q].x); o[1] += bfhi(ov[q].x); o[2] += bflo(ov[q].y); o[3] += bfhi(ov[q].y); o[4] += bflo(ov[q].z); o[5] += bfhi(ov[q].z); o[6] += bflo(ov[q].w); o[7] += bfhi(ov[q].w); }
                u32x4 w; w.x = cvt_pk_bf16(o[0], o[1]); w.y = cvt_pk_bf16(o[2], o[3]); w.z = cvt_pk_bf16(o[4], o[5]); w.w = cvt_pk_bf16(o[6], o[7]);
                *(u32x4*)mp = w;
            }
        }
    }
};
struct EpiWin {
    static constexpr bool PERM = true, AFTER_DRAIN = false;
    bf16_t *QA, *QC, *IQ, *MISC, *KVC, *KVS, *KVW, *BU, *G; const float* rope; const PG8_LAS float* rs;
    __device__ __forceinline__ void operator()(const f32x4 (&acc)[2][2][4][2], const Unit& u, int wr, int wc, int fr, int fq) const {
        const int pn = u.pn;
        bf16_t* dst; int ld, cbase, mode;
        if (pn < 2) { dst = QA; ld = 512; cbase = pn * 256; mode = 1; }
        else if (pn < 4) { dst = QC; ld = 512; cbase = (pn - 2) * 256; mode = 1; }
        else if (pn == 4) { dst = IQ; ld = 256; cbase = 0; mode = 1; }
        else if (pn == 5) { dst = MISC; ld = 256; cbase = 0; mode = 3; }
        else if (pn <= 8) { dst = pn == 6 ? KVC : (pn == 7 ? KVS : KVW); ld = 256; cbase = 0; mode = 2; }
        else if (pn <= 10) { dst = BU; ld = 512; cbase = (pn - 9) * 256; mode = 0; }
        else { dst = G; ld = 3072; cbase = (pn - 11) * 256; mode = 4; }
        const int row0 = u.pm * BM + wr * 64 + fr, col0 = cbase + wc * 32 + 8 * fq;
        const bool ropelane = ((wc & 1) == 0) && fq < 2;
        const float sc = (mode == 1) ? (pn < 4 ? 0.125f * 1.4426950408889634f : 0.125f) : 1.0f;
#pragma unroll
        for (int ai = 0; ai < 2; ++ai) {
            f32x4 csv[4], snv[4];
#pragma unroll
            for (int m = 0; m < 4; ++m) { csv[m] = (f32x4){1.f, 1.f, 1.f, 1.f}; snv[m] = (f32x4){0.f, 0.f, 0.f, 0.f}; }
            if (mode >= 1 && mode <= 3) {
#pragma unroll
                for (int m = 0; m < 4; ++m) { const float* rp = rope + (size_t)(row0 + ai * HALF + m * 16) * 16 + 4 * (fq & 1); csv[m] = *(const f32x4*)rp; snv[m] = *(const f32x4*)(rp + 8); }
            }
#pragma unroll
            for (int m = 0; m < 4; ++m) {
                const size_t row = (size_t)(row0 + ai * HALF + m * 16);
                const float rr = rs[u.ord * 256 + wr * 64 + fr + ai * HALF + m * 16];
                const f32x4 cs = csv[m], sn = snv[m];
#pragma unroll
                for (int bj = 0; bj < 2; ++bj) {
                    const f32x4 a0 = acc[ai][bj][m][0] * rr, a1 = acc[ai][bj][m][1] * rr;
                    float o[8] = {a0[0], a0[1], a0[2], a0[3], a1[0], a1[1], a1[2], a1[3]};
                    const bool dorope = ropelane && (mode == 1 || (mode == 2 && bj == 0) || (mode == 3 && bj == 0 && wc == 0));
                    if (dorope) {
#pragma unroll
                        for (int p = 0; p < 4; ++p) { const float x1 = o[2 * p], x2 = o[2 * p + 1]; o[2 * p] = x1 * cs[p] - x2 * sn[p]; o[2 * p + 1] = x2 * cs[p] + x1 * sn[p]; }
                    }
                    if (mode == 4) {
#pragma unroll
                        for (int e = 0; e < 8; ++e) o[e] = fast_sigmoid(o[e]);
                    } else {
#pragma unroll
                        for (int e = 0; e < 8; ++e) o[e] *= sc;
                    }
                    u32x4 w; w.x = cvt_pk_bf16(o[0], o[1]); w.y = cvt_pk_bf16(o[2], o[3]); w.z = cvt_pk_bf16(o[4], o[5]); w.w = cvt_pk_bf16(o[6], o[7]);
                    *(u32x4*)(dst + row * ld + col0 + bj * HALF) = w;
                }
            }
        }
    }
};


#if DUP == 31
struct EpiPlain {
    static constexpr bool PERM = true, AFTER_DRAIN = false;
    bf16_t* O;
    __device__ __forceinline__ void operator()(const f32x4 (&acc)[2][2][4][2], const Unit& u, int wr, int wc, int fr, int fq) const {
        const int row0 = u.pm * BM + wr * 64 + fr, col0 = u.pn * BM + wc * 32 + 8 * fq;
#pragma unroll
        for (int ai = 0; ai < 2; ++ai)
#pragma unroll
            for (int m = 0; m < 4; ++m)
#pragma unroll
                for (int bj = 0; bj < 2; ++bj) { const f32x4 a0 = acc[ai][bj][m][0], a1 = acc[ai][bj][m][1];
                    u32x4 w; w.x = cvt_pk_bf16(a0[0], a0[1]); w.y = cvt_pk_bf16(a0[2], a0[3]); w.z = cvt_pk_bf16(a1[0], a1[1]); w.w = cvt_pk_bf16(a1[2], a1[3]);
                    *(u32x4*)(O + (size_t)(row0 + ai * HALF + m * 16) * 1024 + col0 + bj * HALF) = w; }
    }
};
#endif
template <class Epi, class Sched, bool ALIGN_EPI = false, bool SP2 = false>
__device__ __forceinline__ void gemm_phase(PG8_LAS unsigned char* lds, const Gemm g, const Sched& S, const Epi& E, int tid_in) {
    int tid_ = tid_in; asm volatile("" : "+v"(tid_));
    const int tid = tid_, wid = __builtin_amdgcn_readfirstlane(tid >> 6), lane = tid & 63, wr = wid >> 2, wc = wid & 3, fr = lane & 15, fq = lane >> 4;
    const int K = g.K, nt = K / BK;
    unsigned voffA[2], voffB[2];
#pragma unroll
    for (int i = 0; i < 2; ++i) { int R, C; stage_rc(tid * 16 + i * 8192, R, C); const int Rb = Epi::PERM ? ((R & ~31) + perm32(R & 31)) : R;
        voffA[i] = (unsigned)(R * K + C) * 2u; voffB[i] = (unsigned)(Rb * K + C) * 2u; }
    const size_t kstep = (size_t)(BK * 2);
    const size_t hstep = (size_t)HALF * K * 2;
    const size_t tstep = 2 * hstep;
    const unsigned ldsw = (unsigned)wid * 1024u;
    const int aoff = lds_byte(wr * 64 + fr, fq * 8), boff = lds_byte(wc * 32 + fr, fq * 8);
#define PG8_SA(b, h) (((b) * 2 + (h)) * HTB)
#define PG8_SB(b, h) ((4 + (b) * 2 + (h)) * HTB)
#define PG8_STAGE(bufoff, gbase, voff) do { _Pragma("unroll") for (int _i = 0; _i < 2; ++_i) \
        __builtin_amdgcn_global_load_lds((const unsigned*)((const char*)(gbase) + (voff)[_i]), (PG8_LAS unsigned*)(lds + (bufoff) + ldsw + _i * 8192), 16, 0, 0); } while (0)
#define PG8_LDA(dst, b, h) do { _Pragma("unroll") for (int m = 0; m < 4; ++m) _Pragma("unroll") for (int k = 0; k < 2; ++k) dst[m][k] = *(const PG8_LAS bf16x8*)(lds + PG8_SA(b, h) + aoff + m * 2048 + k * 1024); } while (0)
#define PG8_LDB(dst, b, h) do { _Pragma("unroll") for (int n = 0; n < 2; ++n) _Pragma("unroll") for (int k = 0; k < 2; ++k) dst[n][k] = *(const PG8_LAS bf16x8*)(lds + PG8_SB(b, h) + boff + n * 2048 + k * 1024); } while (0)
#define PG8_MMA(ai, bj, At, Bt) do { __builtin_amdgcn_s_setprio(1); _Pragma("unroll") for (int m = 0; m < 4; ++m) _Pragma("unroll") for (int n = 0; n < 2; ++n) _Pragma("unroll") for (int k = 0; k < 2; ++k) \
        acc[ai][bj][m][n] = __builtin_amdgcn_mfma_f32_16x16x32_bf16(Bt[n][k], At[m][k], acc[ai][bj][m][n], 0, 0, 0); __builtin_amdgcn_s_setprio(0); } while (0)
#define PG8_WAIT_V(n) asm volatile("s_waitcnt vmcnt(" #n ")" ::: "memory")
#define PG8_WAIT_L(n) asm volatile("s_waitcnt lgkmcnt(" #n ")" ::: "memory")
#define PG8_BAR __builtin_amdgcn_s_barrier()
#define PG8_SCHED __builtin_amdgcn_sched_barrier(0)
    Unit cur, nxt; int ui = 0;
    if (!S.next(0, cur)) return;
    f32x4 acc[2][2][4][2];
#pragma unroll
    for (int a = 0; a < 2; ++a)
#pragma unroll
        for (int b = 0; b < 2; ++b)
#pragma unroll
            for (int m = 0; m < 4; ++m)
#pragma unroll
                for (int n = 0; n < 2; ++n) acc[a][b][m][n] = (f32x4){0.f, 0.f, 0.f, 0.f};
    bf16x8 At[4][2], B0[2][2], B1[2][2];
    const char* cA = (const char*)g.A + (size_t)cur.pm * tstep; const char* cB = (const char*)g.Bt + (size_t)cur.pn * tstep;
    S.a_ready(cur);
    if constexpr (SP2) {
        PG8_STAGE(PG8_SB(0, 0), cB, voffB); PG8_STAGE(PG8_SB(0, 1), cB + hstep, voffB); PG8_STAGE(PG8_SA(0, 0), cA, voffA); PG8_STAGE(PG8_SA(0, 1), cA + hstep, voffA);
        if (wr == 1) PG8_BAR;
        PG8_WAIT_V(2); PG8_BAR;
        PG8_STAGE(PG8_SB(1, 0), cB + kstep, voffB); PG8_STAGE(PG8_SA(1, 0), cA + kstep, voffA); PG8_STAGE(PG8_SB(1, 1), cB + hstep + kstep, voffB);
        PG8_WAIT_V(6); PG8_BAR;
    } else {
        PG8_STAGE(PG8_SB(0, 0), cB, voffB); PG8_STAGE(PG8_SA(0, 0), cA, voffA); PG8_STAGE(PG8_SB(0, 1), cB + hstep, voffB); PG8_STAGE(PG8_SA(0, 1), cA + hstep, voffA);
        if (wr == 1) PG8_BAR;
        PG8_WAIT_V(4); PG8_BAR;
        PG8_STAGE(PG8_SB(1, 0), cB + kstep, voffB); PG8_STAGE(PG8_SA(1, 0), cA + kstep, voffA); PG8_STAGE(PG8_SB(1, 1), cB + hstep + kstep, voffB);
        PG8_WAIT_V(6); PG8_BAR;
    }
    for (;;) {
        const bool has_next = S.next(ui + 1, nxt);
        const char* nA = has_next ? (const char*)g.A + (size_t)nxt.pm * tstep : cA; const char* nB = has_next ? (const char*)g.Bt + (size_t)nxt.pn * tstep : cB;
        for (int t = 0; t < nt; t += 2) {
            const bool last = (t == nt - 2);
            const char* a1 = cA + (size_t)(t + 1) * kstep;
            const char* a2 = last ? nA : cA + (size_t)(t + 2) * kstep; const char* b2 = last ? nB : cB + (size_t)(t + 2) * kstep;
            const char* a3 = a2 + kstep; const char* b3 = b2 + kstep;
            if (last && has_next) S.a_ready(nxt);
            if constexpr (SP2) {
            PG8_LDB(B0, 0, 0); PG8_LDB(B1, 0, 1); PG8_SCHED; PG8_LDA(At, 0, 0); PG8_STAGE(PG8_SA(1, 1), a1 + hstep, voffA);
            PG8_WAIT_V(8); PG8_WAIT_L(0); PG8_BAR; PG8_MMA(0, 0, At, B0); PG8_MMA(0, 1, At, B1); PG8_BAR; PG8_SCHED;
            PG8_LDA(At, 0, 1); PG8_STAGE(PG8_SB(0, 0), b2, voffB); PG8_STAGE(PG8_SB(0, 1), b2 + hstep, voffB); PG8_STAGE(PG8_SA(0, 0), a2, voffA);
            PG8_WAIT_V(8); PG8_WAIT_L(0); PG8_BAR; PG8_MMA(1, 0, At, B0); PG8_MMA(1, 1, At, B1); PG8_BAR; PG8_SCHED;
            PG8_LDB(B0, 1, 0); PG8_LDB(B1, 1, 1); PG8_SCHED; PG8_LDA(At, 1, 0); PG8_STAGE(PG8_SA(0, 1), a2 + hstep, voffA);
            PG8_WAIT_V(8); PG8_WAIT_L(0); PG8_BAR; PG8_MMA(0, 0, At, B0); PG8_MMA(0, 1, At, B1); PG8_BAR; PG8_SCHED;
            PG8_LDA(At, 1, 1); PG8_STAGE(PG8_SB(1, 0), b3, voffB); PG8_STAGE(PG8_SB(1, 1), b3 + hstep, voffB); PG8_STAGE(PG8_SA(1, 0), a3, voffA);
            PG8_WAIT_V(8); PG8_WAIT_L(0); PG8_BAR; PG8_MMA(1, 0, At, B0); PG8_MMA(1, 1, At, B1); PG8_BAR; PG8_SCHED;
            } else {
            PG8_LDB(B0, 0, 0); PG8_SCHED; PG8_LDA(At, 0, 0); PG8_STAGE(PG8_SA(1, 1), a1 + hstep, voffA);
            PG8_WAIT_L(8); PG8_BAR; PG8_WAIT_L(0); PG8_MMA(0, 0, At, B0); PG8_BAR; PG8_SCHED;
            PG8_LDB(B1, 0, 1); PG8_STAGE(PG8_SB(0, 0), b2, voffB);
            PG8_BAR; PG8_WAIT_L(0); PG8_MMA(0, 1, At, B1); PG8_BAR;
            PG8_LDA(At, 0, 1); PG8_STAGE(PG8_SA(0, 0), a2, voffA);
            PG8_BAR; PG8_WAIT_L(0); PG8_MMA(1, 0, At, B0); PG8_BAR; PG8_SCHED;
            PG8_STAGE(PG8_SB(0, 1), b2 + hstep, voffB);
            PG8_WAIT_V(6); PG8_BAR; PG8_MMA(1, 1, At, B1); PG8_BAR;
            PG8_LDB(B0, 1, 0); PG8_SCHED; PG8_LDA(At, 1, 0); PG8_STAGE(PG8_SA(0, 1), a2 + hstep, voffA);
            PG8_WAIT_L(8); PG8_BAR; PG8_WAIT_L(0); PG8_MMA(0, 0, At, B0); PG8_BAR; PG8_SCHED;
            PG8_LDB(B1, 1, 1); PG8_STAGE(PG8_SB(1, 0), b3, voffB);
            PG8_BAR; PG8_WAIT_L(0); PG8_MMA(0, 1, At, B1); PG8_BAR;
            PG8_LDA(At, 1, 1); PG8_STAGE(PG8_SA(1, 0), a3, voffA);
            PG8_BAR; PG8_WAIT_L(0); PG8_MMA(1, 0, At, B0); PG8_BAR; PG8_SCHED;
            PG8_STAGE(PG8_SB(1, 1), b3 + hstep, voffB);
            PG8_WAIT_V(6); PG8_BAR; PG8_MMA(1, 1, At, B1); PG8_BAR;
            }
        }
        if constexpr (ALIGN_EPI) { if (wr == 0) PG8_BAR; }
        if constexpr (!Epi::AFTER_DRAIN) { E(acc, cur, wr, wc, fr, fq); S.done(cur); }
        if (!has_next) break;
#pragma unroll
        for (int a = 0; a < 2; ++a)
#pragma unroll
            for (int b = 0; b < 2; ++b)
#pragma unroll
                for (int m = 0; m < 4; ++m)
#pragma unroll
                    for (int n = 0; n < 2; ++n) acc[a][b][m][n] = (f32x4){0.f, 0.f, 0.f, 0.f};
        cur = nxt; cA = nA; cB = nB; ++ui;
        if constexpr (ALIGN_EPI) { if (wr == 1) PG8_BAR; }
    }
    PG8_WAIT_V(0);
    if constexpr (!ALIGN_EPI) { if (wr == 0) PG8_BAR; }
    PG8_BAR;
    if constexpr (Epi::AFTER_DRAIN) { E.fused(acc, cur, wr, wc, fr, fq, lds, wid, lane); S.done(cur); }
#undef PG8_SA
#undef PG8_SB
#undef PG8_STAGE
#undef PG8_LDA
#undef PG8_LDB
#undef PG8_MMA
#undef PG8_WAIT_V
#undef PG8_WAIT_L
#undef PG8_BAR
#undef PG8_SCHED
}
}
#define GAS __attribute__((address_space(1)))
#define LAS __attribute__((address_space(3)))
typedef unsigned short bf16;
typedef unsigned v4u __attribute__((ext_vector_type(4)));
typedef float f32x4 __attribute__((ext_vector_type(4)));
typedef short bf16x8 __attribute__((ext_vector_type(8)));
typedef GAS unsigned gu32;
typedef GAS unsigned long long gu64;
#define RLX_AGENT __ATOMIC_RELAXED, __HIP_MEMORY_SCOPE_AGENT
#define LDS_WAIT() asm volatile("s_waitcnt lgkmcnt(0)" ::: "memory")
#define VM_WAIT() asm volatile("s_waitcnt vmcnt(0)" ::: "memory")
__device__ __forceinline__ unsigned long long rt() { return __builtin_amdgcn_s_memrealtime(); }
__device__ __forceinline__ unsigned f2bf(float f) { unsigned u = __builtin_bit_cast(unsigned, f); return (u + 0x7fffu + ((u >> 16) & 1u)) >> 16; }
__device__ __forceinline__ unsigned pk2(float lo, float hi) { return f2bf(lo) | (f2bf(hi) << 16); }
#define XB_TMO      128
#define XB_XCNT(j)  (256  + 64 * (j))
#define XB_XSUB(j)  (1280 + 64 * (j))
#define XB_XGEN(j)  (2304 + 64 * (j))
#define XB_TOP      3328
#define XB_TOPGEN   3392
#define XCD_BAR_WORDS 3456
#define XB_SPIN_CAP (1u << 18)

__device__ __forceinline__ unsigned xb_ld(unsigned* p)              { return __hip_atomic_load(p, __ATOMIC_RELAXED, __HIP_MEMORY_SCOPE_AGENT); }
__device__ __forceinline__ unsigned xb_add(unsigned* p, unsigned v) { return __hip_atomic_fetch_add(p, v, __ATOMIC_RELAXED, __HIP_MEMORY_SCOPE_AGENT); }
__device__ __forceinline__ unsigned xb_xcc_id() { return (unsigned)__builtin_amdgcn_s_getreg((3 << 11) | 20) & 0xFu; }
#define XB_SPIN(cond, bar) do { unsigned _sp = 0; while (cond) { __builtin_amdgcn_s_sleep(1); \
    if ((++_sp & 255u) == 0u) { if (xb_ld(&(bar)[XB_TMO])) break; if (_sp > XB_SPIN_CAP) { atomicAdd(&(bar)[XB_TMO], 1u); break; } } } } while (0)

struct XcdBarrier {
    unsigned* bar; unsigned x;
    volatile LAS unsigned* st;
};

__device__ __forceinline__ XcdBarrier xcd_barrier_post(unsigned* bar, volatile LAS unsigned* st) {
    XcdBarrier b; b.bar = bar; b.x = xb_xcc_id(); b.st = st;
    if (threadIdx.x == 0) (void)xb_add(&bar[XB_XCNT(b.x)], 1u);
    return b;
}
__device__ __forceinline__ void xcd_barrier_complete(unsigned* bar, unsigned x, unsigned& nloc, unsigned& nx) {
    const unsigned G = gridDim.x * gridDim.y * gridDim.z;
    unsigned sum, cnt, mine, sp = 0u;
    for (;;) {
        sum = 0u; cnt = 0u; mine = 0u;
#pragma unroll
        for (unsigned j = 0; j < 16; ++j) { const unsigned c = xb_ld(&bar[XB_XCNT(j)]); sum += c; cnt += (c > 0u) ? 1u : 0u; mine = (j == x) ? c : mine; }
        if (sum == G) break;
        __builtin_amdgcn_s_sleep(1);
        if ((++sp & 255u) == 0u) { if (xb_ld(&bar[XB_TMO])) break; if (sp > XB_SPIN_CAP) { atomicAdd(&bar[XB_TMO], 1u); break; } }
    }
    nloc = mine > 0u ? mine : 1u; nx = cnt > 0u ? cnt : 1u;
}

__device__ __forceinline__ void xcd_barrier(const XcdBarrier& b) {
    asm volatile("s_waitcnt vmcnt(0)" ::: "memory");
    __syncthreads();
    if (threadIdx.x == 0) {
        unsigned* bar = b.bar;
        __builtin_amdgcn_s_waitcnt(0);
        unsigned nloc = b.st[0], nx = b.st[1];
        if (nloc == 0u) { xcd_barrier_complete(bar, b.x, nloc, nx); b.st[0] = nloc; b.st[1] = nx; }
        const unsigned old = xb_add(&bar[XB_XSUB(b.x)], 1u);
        const unsigned gen = old / nloc;
        if (old + 1u == (gen + 1u) * nloc) {
            __builtin_amdgcn_fence(__ATOMIC_RELEASE, "agent");
            asm volatile("s_waitcnt vmcnt(0)" ::: "memory");
            const unsigned og = xb_add(&bar[XB_TOP], 1u);
            const unsigned tg = og / nx;
            if (og + 1u == (tg + 1u) * nx) xb_add(&bar[XB_TOPGEN], 1u);
            else XB_SPIN(xb_ld(&bar[XB_TOPGEN]) == tg, bar);
            __builtin_amdgcn_fence(__ATOMIC_ACQUIRE, "agent");
            xb_add(&bar[XB_XGEN(b.x)], 1u);
            asm volatile("s_waitcnt vmcnt(0)" ::: "memory");
        } else {
            XB_SPIN(xb_ld(&bar[XB_XGEN(b.x)]) == gen, bar);
            __builtin_amdgcn_fence(__ATOMIC_ACQUIRE, "agent");
            asm volatile("s_waitcnt vmcnt(0)" ::: "memory");
        }
    }
    __syncthreads();
}
constexpr int NB = 8, SEQ = 4096, DM = 1024, DEPTH = 4, M = NB * SEQ;
constexpr int FF = 2816, NIN = 5852, NINP = 5888;
constexpr float EPS = 1e-6f, NEGF = -1e30f;
constexpr int NWAVES = 8;
constexpr size_t MiB = 1u << 20;
constexpr size_t WS_CTL = 0, CTL_ZERO_BYTES = 1 * MiB;
constexpr size_t WS_ROPE = 1 * MiB;
constexpr size_t WS_KVA = 3 * MiB;
constexpr size_t WS_KC = 11 * MiB, WS_VC = WS_KC + 512 * 1024;
constexpr size_t WS_W = 12 * MiB;
constexpr size_t WO_GU1 = 0, WO_D1 = 11 * MiB, WO_GU2 = WO_D1 + 5 * MiB + 512 * 1024, WO_D2 = WO_GU2 + 11 * MiB, WO_IN = WO_D2 + 5 * MiB + 512 * 1024,
                 WO_PA = WO_IN + 11 * MiB + 512 * 1024, WO_PB = WO_PA + MiB, WO_PC = WO_PB + MiB, WO_OUT = WO_PC + MiB,
                 WO_CW1 = WO_OUT + 2 * MiB  , WO_CW2 = WO_CW1 + MiB  , WO_UKV = WO_CW2 + 32768  , WO_POOL = WO_UKV + 32768  ,
                 WO_POSB = WO_POOL + 131072  , WO_END = WO_POSB + 1024;
static_assert(WO_END <= 52 * MiB, "weights region");
constexpr size_t WS_XN = 64 * MiB;
constexpr size_t WS_R = 128 * MiB;
constexpr size_t WS_G = WS_R, WS_QA = WS_R + 192 * MiB, WS_QC = WS_QA + 32 * MiB, WS_IQ = WS_QC + 32 * MiB, WS_MISC = WS_IQ + 16 * MiB,
                 WS_KVC = WS_MISC + 16 * MiB, WS_KVS = WS_KVC + 16 * MiB, WS_KVW = WS_KVS + 16 * MiB, WS_BU = WS_KVW + 16 * MiB, WS_END = WS_BU + 32 * MiB;
#ifndef YB_SPARE
#define YB_SPARE 0
#endif
constexpr size_t WS_YB = YB_SPARE ? 496 * MiB : WS_XN;
constexpr size_t WS_MG = WS_IQ;
constexpr size_t WS_H = WS_R;
static_assert(WS_END == 496 * MiB, "ws map");
constexpr int RING_BYTES = 131072, LDS_BYTES = 163840, LDSCTL_OFF = 163840 - 256;
constexpr size_t WS_SSQ = 496 * MiB;
constexpr int RS_OFF = 131072;
constexpr int NPL = 10, NPH = 1 + DEPTH * NPL + 1;


#ifndef TPROBE
#define TPROBE 0
#endif
#if TPROBE
#define TP_DECL unsigned long long tp_t_ = __builtin_amdgcn_s_memtime();
#define TP_MARK(k) do { const unsigned long long n_ = __builtin_amdgcn_s_memtime(); if (tid == 0) atomicAdd((unsigned long long*)(ws + 32768) + (k), n_ - tp_t_); tp_t_ = n_; } while (0)
#define TP_ADD(k, v) do { if (tid == 0) atomicAdd((unsigned long long*)(ws + 32768) + (k), (unsigned long long)(v)); } while (0)
#else
#define TP_DECL
#define TP_MARK(k)
#define TP_ADD(k, v)
#endif
__device__ __forceinline__ int lane_id_v() { int l; asm volatile("v_mbcnt_lo_u32_b32 %0, -1, 0\n\tv_mbcnt_hi_u32_b32 %0, -1, %0" : "=v"(l)); return l; }
__device__ __forceinline__ float bflo(unsigned w) { return __uint_as_float(w << 16); }
__device__ __forceinline__ float bfhi(unsigned w) { return __uint_as_float(w & 0xffff0000u); }
__device__ __forceinline__ float bf2f(bf16 v) { return __uint_as_float((unsigned)v << 16); }
__device__ __forceinline__ float wave_sum(float v) {
#pragma unroll
    for (int o = 1; o < 64; o <<= 1) v += __shfl_xor(v, o);
    return v;
}
__device__ __forceinline__ float wave_max(float v) {
#pragma unroll
    for (int o = 1; o < 64; o <<= 1) v = fmaxf(v, __shfl_xor(v, o));
    return v;
}
__device__ __forceinline__ int wave_sum_i(int v) {
#pragma unroll
    for (int o = 1; o < 64; o <<= 1) v += __shfl_xor(v, o);
    return v;
}
__device__ __forceinline__ unsigned wave_max_u(unsigned v) {
#pragma unroll
    for (int o = 1; o < 64; o <<= 1) { const unsigned w = (unsigned)__shfl_xor((int)v, o); v = w > v ? w : v; }
    return v;
}
#define WAVE_LDS_SYNC() do { asm volatile("s_waitcnt lgkmcnt(0)" ::: "memory"); __builtin_amdgcn_wave_barrier(); } while (0)
__host__ __device__ __forceinline__ int permd(int d) { return d < 8 ? 2 * d : (d < 16 ? 2 * (d - 8) + 1 : d); }
__device__ __forceinline__ int win_newcol(int n) {
    if (n < 512) return (n & ~63) + permd(n & 63);
    if (n < 640) return 1280 + 64 + (n - 512);
    if (n < 896) { const int m = n - 640; return 1024 + (m & ~63) + permd(m & 63); }
    if (n < 960) return 1280 + permd(n - 896);
    if (n < 964) return 1280 + 192 + (n - 960);
    if (n < 1476) return 2304 + (n - 964);
    if (n < 1988) { const int m = n - 1476; return 512 + (m & ~63) + permd(m & 63); }
    if (n < 2756) { const int m = n - 1988, kv = m >> 8, r = m & 255, base = 1536 + kv * 256; return r < 128 ? base + (r & ~63) + permd(r & 63) : base + r; }
    if (n < 2780) return 1280 + 196 + (n - 2756);
    return 2816 + (n - 2780);
}
__device__ __forceinline__ int map_row(int mode, int n) { return mode == 0 ? n : (mode == 1 ? ((n >> 7) << 8) + (n & 127) : (mode == 2 ? ((n >> 7) << 8) + 128 + (n & 127) : win_newcol(n))); }

struct Args { const float* in[24]; float* out; unsigned char* ws; int ph_lo, ph_hi; };

__device__ __forceinline__ int unperm(int p) { return p < 16 ? ((p & 1) ? (p >> 1) + 8 : (p >> 1)) : p; }
__device__ __forceinline__ void tr_item(const float* W, int K, int N, bf16* WT, int mode, LAS float* scr, int item, int lane, bool kperm = false, const float* kscale = nullptr) {
    const int nblk = (N + 31) >> 5, kb = item / nblk, nb = item - kb * nblk, k0 = 64 * kb, n0 = 32 * nb;
    const int nn = n0 + (lane & 31);
    const int nnc = nn < N ? nn : N - 1; const float msk = nn < N ? 1.0f : 0.0f;
    const float* ksp = kscale ? kscale : W; const bool hs = kscale != nullptr;
    float wv[32], sv[32];
#pragma unroll
    for (int i = 0; i < 32; ++i) { const int kk = 2 * i + (lane >> 5); wv[i] = W[(size_t)(k0 + kk) * N + nnc]; sv[i] = ksp[k0 + kk]; }
#pragma unroll
    for (int i = 0; i < 32; ++i) { const int kk = 2 * i + (lane >> 5); scr[kk * 33 + (lane & 31)] = wv[i] * (hs ? sv[i] : 1.0f) * msk; }
    LDS_WAIT(); asm volatile("" ::: "memory");
    const int c = lane & 7;
#pragma unroll
    for (int j = 0; j < 4; ++j) { const int n = (lane >> 3) + 8 * j; const LAS float* s = scr + n;
        int ks[8];
#pragma unroll
        for (int i = 0; i < 8; ++i) ks[i] = (kperm ? unperm(8 * c + i) : 8 * c + i) * 33;
        v4u o; o.x = pk2(s[ks[0]], s[ks[1]]); o.y = pk2(s[ks[2]], s[ks[3]]); o.z = pk2(s[ks[4]], s[ks[5]]); o.w = pk2(s[ks[6]], s[ks[7]]);
        if (n0 + n < N) *(v4u*)(WT + (size_t)map_row(mode, n0 + n) * K + k0 + 8 * c) = o; }
    LDS_WAIT(); asm volatile("" ::: "memory");
}
__device__ __forceinline__ void phase_convert(const Args& P, unsigned char* ws, int z, int l, LAS unsigned char* lds, int gw, int NGW, int lane, int wave) {
    asm volatile("" : "+v"(lane)); lane &= 63; asm volatile("" : "+s"(gw), "+s"(NGW));
    LAS float* scr = (LAS float*)(lds + wave * 16384);
    unsigned char* wb = ws + WS_W;
    constexpr int I_F = 16 * 88, I_D = 44 * 32, I_IN = 16 * 183, I_P = 8 * 32, I_O = 16 * 32;
    constexpr int I_C = 32 * 4;
    constexpr int NIT = 4 * I_F + 2 * I_D + I_IN + 3 * I_P + I_O + 2 * I_C;
    const size_t fo = (size_t)l * DM * FF;
    for (int it = gw; it < NIT; it += NGW) {
        int r = it, K = DM, N = FF, mode = 1; const float* W = P.in[3 + z] + fo; size_t wo = WO_GU1; bool kperm = false; const float* ksc = P.in[2 + z] + l * DM;
        if (r >= I_F) { r -= I_F; mode = 2; W = P.in[4 + z] + fo;
        if (r >= I_F) { r -= I_F; mode = 0; W = P.in[5 + z] + fo; K = FF; N = DM; wo = WO_D1; ksc = nullptr;
        if (r >= I_D) { r -= I_D; mode = 1; W = P.in[20 + z] + fo; K = DM; N = FF; wo = WO_GU2; ksc = P.in[19 + z] + l * DM;
        if (r >= I_F) { r -= I_F; mode = 2; W = P.in[21 + z] + fo;
        if (r >= I_F) { r -= I_F; mode = 0; W = P.in[22 + z] + fo; K = FF; N = DM; wo = WO_D2; ksc = nullptr;
        if (r >= I_D) { r -= I_D; mode = 3; W = P.in[7 + z] + (size_t)l * DM * NIN; K = DM; N = NIN; wo = WO_IN; ksc = P.in[6 + z] + l * DM;
        if (r >= I_IN) { r -= I_IN; mode = 0; W = P.in[15 + z] + (size_t)l * 512 * DM; K = 512; N = DM; wo = WO_PA; ksc = nullptr;
        if (r >= I_P) { r -= I_P; W = P.in[16 + z] + (size_t)l * 512 * DM; wo = WO_PB;
        if (r >= I_P) { r -= I_P; W = P.in[17 + z] + (size_t)l * 512 * DM; wo = WO_PC;
        if (r >= I_P) { r -= I_P; W = P.in[18 + z] + (size_t)l * DM * DM; K = DM; wo = WO_OUT;
        if (r >= I_O) { r -= I_O; W = P.in[13 + z] + (size_t)(l * 2) * 2048 * 128; K = 2048; N = 128; wo = WO_CW1; kperm = true;
        if (r >= I_C) { r -= I_C; W += (size_t)2048 * 128; wo = WO_CW1 + 128 * 2048 * 2; kperm = false; } } } } } } } } } } } }
        tr_item(W, K, N, (bf16*)(wb + wo), mode, scr, r, lane, kperm, ksc);
    }
    {
        const int gt = gw * 64 + lane, GT = NGW * 64;
        bf16* ukv = (bf16*)(wb + WO_UKV); bf16* pool = (bf16*)(wb + WO_POOL); bf16* cw2 = (bf16*)(wb + WO_CW2); float* posb = (float*)(wb + WO_POSB);
        const float* w_ukv = P.in[9 + z] + (size_t)l * 128 * 128; const float* gn = P.in[8 + z] + l * 128;
        for (int i = gt; i < 128 * 128; i += GT) { const int np = i >> 7, k = i & 127, n = np < 64 ? unperm(np) : np; ukv[i] = (bf16)f2bf(gn[k] * w_ukv[k * 128 + n]); }
        const float* pw = P.in[10 + z] + (size_t)l * 4 * 128 * 128; const float* psc = P.in[11 + z] + l * 512;
        for (int i = gt; i < 4 * 128 * 128; i += GT) { const int g = i >> 14, d = (i >> 7) & 127, c = i & 127; pool[i] = (bf16)f2bf(pw[(g * 128 + c) * 128 + d] * psc[g * 128 + d]); }
        const float* w2 = P.in[14 + z] + (size_t)l * 2 * 128 * 64;
        for (int i = gt; i < 2 * 64 * 128; i += GT) { const int br = i >> 13, dp = (i >> 7) & 63, n = i & 127, d = br ? dp : unperm(dp); cw2[i] = (bf16)f2bf(w2[(br * 128 + n) * 64 + d]); }
        const float* w1 = P.in[13 + z] + (size_t)l * 2 * 2048 * 128; const float* pos = P.in[12 + z] + (size_t)l * 2 * 2048;
        for (int i = gw; i < 256; i += NGW) { const int br = i >> 7, n = i & 127; float a = 0.f;
#pragma unroll 8
            for (int k = lane; k < 2048; k += 64) a += pos[br * 2048 + k] * w1[((size_t)br * 2048 + k) * 128 + n];
            a = wave_sum(a); if (lane == 0) posb[i] = a; }
    }
    if (gw < 36) { unsigned zz = 0u; asm volatile("" : "+v"(zz)); v4u z = {zz, zz, zz, zz}; v4u* rp = (v4u*)((bf16*)(wb + WO_IN) + (size_t)(1500 + gw) * DM); for (int i = lane; i < DM / 8; i += 64) rp[i] = z; }
}
__device__ __forceinline__ void phase_rope(const Args& P, unsigned char* ws, int z, int gtid, int gthreads) {
    float* rope = (float*)(ws + WS_ROPE);
    for (int idx = gtid; idx < M * 8; idx += gthreads) {
        const int row = idx >> 3, i = idx & 7;
        const double inv = i == 0 ? 1.0 : i == 1 ? 0.19392274474868576 : i == 2 ? 0.03760603093086393 : i == 3 ? 0.007292664737217109 : i == 4 ? 0.001414213562373095 : i == 5 ? 0.0002742481756762073 : i == 6 ? 5.318295896944988e-05 : 1.031338537721246e-05;
        const double ang = (double)((const int*)P.in[1 + z])[row] * inv;
        double s, c; sincos(ang, &s, &c);
        rope[row * 16 + i] = (float)c; rope[row * 16 + 8 + i] = (float)s;
    }
}
__device__ __forceinline__ void norm_row_bf16(const float* xrow, const float* gain, bf16* orow, int lane) {
    const f32x4* xr = (const f32x4*)xrow + lane; const f32x4* gr = (const f32x4*)gain + lane;
    f32x4 v[4]; float s = 0.f;
#pragma unroll
    for (int j = 0; j < 4; ++j) { v[j] = xr[64 * j]; s += (v[j].x * v[j].x + v[j].y * v[j].y) + (v[j].z * v[j].z + v[j].w * v[j].w); }
    const float r = 1.0f / sqrtf(wave_sum(s) * (1.f / DM) + EPS);
    unsigned long long* o8 = (unsigned long long*)orow + lane;
#pragma unroll
    for (int j = 0; j < 4; ++j) { const f32x4 g = gr[64 * j]; o8[64 * j] = (unsigned long long)pk2(v[j].x * r * g.x, v[j].y * r * g.y) | ((unsigned long long)pk2(v[j].z * r * g.z, v[j].w * r * g.w) << 32); }
}
__device__ __forceinline__ void stat_row_bf16(const float* xrow, bf16* orow, float* ssq16, int lane) {
    const f32x4* xr = (const f32x4*)xrow + lane;
    f32x4 v[4]; float s = 0.f;
#pragma unroll
    for (int j = 0; j < 4; ++j) { v[j] = xr[64 * j]; s += (v[j].x * v[j].x + v[j].y * v[j].y) + (v[j].z * v[j].z + v[j].w * v[j].w); }
    s = wave_sum(s);
    unsigned long long* o8 = (unsigned long long*)orow + lane;
#pragma unroll
    for (int j = 0; j < 4; ++j) o8[64 * j] = (unsigned long long)pk2(v[j].x, v[j].y) | ((unsigned long long)pk2(v[j].z, v[j].w) << 32);
    if (lane < 16) ssq16[lane] = lane == 0 ? s : 0.f;
}
__device__ __forceinline__ void norm_row_f32(float* xrow, const float* gain, int lane, float tps = 1.0f) {
    f32x4* xr = (f32x4*)xrow + lane; const f32x4* gr = (const f32x4*)gain + lane;
    f32x4 v[4]; float s = 0.f;
#pragma unroll
    for (int j = 0; j < 4; ++j) { v[j] = xr[64 * j]; s += (v[j].x * v[j].x + v[j].y * v[j].y) + (v[j].z * v[j].z + v[j].w * v[j].w); }
    const float r = tps / sqrtf(wave_sum(s) * (1.f / DM) + EPS);
#pragma unroll
    for (int j = 0; j < 4; ++j) { const f32x4 g = gr[64 * j]; xr[64 * j] = v[j] * r * g; }
}

__device__ __forceinline__ void norm_row_out(const bf16* xrow, float* orow, const float* gain, int lane, float tps = 1.0f) {
    const v4u a = *(const v4u*)(xrow + 16 * lane), b = *(const v4u*)(xrow + 16 * lane + 8);
    const float f[16] = {bflo(a.x), bfhi(a.x), bflo(a.y), bfhi(a.y), bflo(a.z), bfhi(a.z), bflo(a.w), bfhi(a.w), bflo(b.x), bfhi(b.x), bflo(b.y), bfhi(b.y), bflo(b.z), bfhi(b.z), bflo(b.w), bfhi(b.w)};
    float s = 0.f;
#pragma unroll
    for (int e = 0; e < 16; ++e) s += f[e] * f[e];
    const float r = tps / sqrtf(wave_sum(s) * (1.f / DM) + EPS);
    const f32x4* gr = (const f32x4*)(gain + 16 * lane); f32x4* orr = (f32x4*)(orow + 16 * lane);
#pragma unroll
    for (int j = 0; j < 4; ++j) { const f32x4 g = gr[j]; f32x4 o; o.x = f[4 * j] * r * g.x; o.y = f[4 * j + 1] * r * g.y; o.z = f[4 * j + 2] * r * g.z; o.w = f[4 * j + 3] * r * g.w; orr[j] = o; }
}

__device__ __forceinline__ void stat_rows4_bf16(const float* x, bf16* xo, float* ssq, int m0, int st, int lane) {
    f32x4 v[4][4];
#pragma unroll
    for (int r = 0; r < 4; ++r) { const int m = m0 + r * st; const f32x4* xr = (const f32x4*)(x + (size_t)(m < M ? m : 0) * DM) + lane;
#pragma unroll
        for (int j = 0; j < 4; ++j) v[r][j] = xr[64 * j]; }
#pragma unroll
    for (int r = 0; r < 4; ++r) { const int m = m0 + r * st; if (m < M) { float s = 0.f;
#pragma unroll
        for (int j = 0; j < 4; ++j) s += (v[r][j].x * v[r][j].x + v[r][j].y * v[r][j].y) + (v[r][j].z * v[r][j].z + v[r][j].w * v[r][j].w);
        s = wave_sum(s);
        unsigned long long* o8 = (unsigned long long*)(xo + (size_t)m * DM) + lane;
#pragma unroll
        for (int j = 0; j < 4; ++j) o8[64 * j] = (unsigned long long)pk2(v[r][j].x, v[r][j].y) | ((unsigned long long)pk2(v[r][j].z, v[r][j].w) << 32);
        if (lane < 16) ssq[(size_t)m * 16 + lane] = lane == 0 ? s : 0.f; } }
}
__device__ __forceinline__ void norm_rows4_out(const bf16* x, float* out, const float* gain, int m0, int st, int lane, float tps = 1.0f) {
    v4u a[4], b[4];
#pragma unroll
    for (int r = 0; r < 4; ++r) { const int m = m0 + r * st; const bf16* xr = x + (size_t)(m < M ? m : 0) * DM + 16 * lane; a[r] = *(const v4u*)xr; b[r] = *(const v4u*)(xr + 8); }
    f32x4 g[4];
#pragma unroll
    for (int j = 0; j < 4; ++j) g[j] = ((const f32x4*)(gain + 16 * lane))[j];
#pragma unroll
    for (int r = 0; r < 4; ++r) { const int m = m0 + r * st; if (m < M) {
        const float f[16] = {bflo(a[r].x), bfhi(a[r].x), bflo(a[r].y), bfhi(a[r].y), bflo(a[r].z), bfhi(a[r].z), bflo(a[r].w), bfhi(a[r].w), bflo(b[r].x), bfhi(b[r].x), bflo(b[r].y), bfhi(b[r].y), bflo(b[r].z), bfhi(b[r].z), bflo(b[r].w), bfhi(b[r].w)};
        float s = 0.f;
#pragma unroll
        for (int e = 0; e < 16; ++e) s += f[e] * f[e];
        const float rs = tps / sqrtf(wave_sum(s) * (1.f / DM) + EPS);
        f32x4* orr = (f32x4*)(out + (size_t)m * DM + 16 * lane);
#pragma unroll
        for (int j = 0; j < 4; ++j) { f32x4 o; o.x = f[4 * j] * rs * g[j].x; o.y = f[4 * j + 1] * rs * g[j].y; o.z = f[4 * j + 2] * rs * g[j].z; o.w = f[4 * j + 3] * rs * g[j].w; orr[j] = o; } } }
}
__device__ __forceinline__ unsigned f2o(float s) { const int b = (int)__float_as_uint(s); return (unsigned)(b ^ ((b >> 31) | (int)0x80000000)); }
__device__ __forceinline__ void unpack8(const v4u v, float* f) { f[0] = bflo(v.x); f[1] = bfhi(v.x); f[2] = bflo(v.y); f[3] = bfhi(v.y); f[4] = bflo(v.z); f[5] = bfhi(v.z); f[6] = bflo(v.w); f[7] = bfhi(v.w); }
__device__ __forceinline__ void load_row64(const bf16* p, float* f) {
    const v4u* q = (const v4u*)p;
#pragma unroll
    for (int i = 0; i < 8; ++i) unpack8(q[i], f + 8 * i);
}
__device__ __forceinline__ float dot64(const LAS float* q, const float* k) {
    float d = 0.f;
#pragma unroll
    for (int i = 0; i < 16; ++i) { const f32x4 qq = *(const LAS f32x4*)(q + 4 * i); d += qq.x * k[4 * i] + qq.y * k[4 * i + 1] + qq.z * k[4 * i + 2] + qq.w * k[4 * i + 3]; }
    return d;
}
__device__ __forceinline__ void dsa_query(const Args& P, unsigned char* ws, int z, int row, LAS unsigned char* wl, int lane) {
    const int b = row >> 12, t = row & (SEQ - 1), n = t + 1;
    LAS unsigned* su = (LAS unsigned*)wl; LAS float* pb = (LAS float*)wl; LAS unsigned short* list = (LAS unsigned short*)(wl + 16384); LAS float* qb = (LAS float*)(wl + 16896);
    const bf16* misc = (const bf16*)(ws + WS_MISC);
    const unsigned long long lt = (1ull << lane) - 1ull;
    int nsel;
    if (n <= 256) { for (int i = lane; i < n; i += 64) list[i] = (unsigned short)i; nsel = n; }
    else {
        { const uint2 v = *(const uint2*)((const bf16*)(ws + WS_IQ) + (size_t)row * 256 + lane * 4); qb[lane * 4] = bflo(v.x); qb[lane * 4 + 1] = bfhi(v.x); qb[lane * 4 + 2] = bflo(v.y); qb[lane * 4 + 3] = bfhi(v.y); }
        float iw[4]; { const uint2 v = *(const uint2*)(misc + (size_t)row * 256 + 192); iw[0] = 0.5f * bflo(v.x); iw[1] = 0.5f * bfhi(v.x); iw[2] = 0.5f * bflo(v.y); iw[3] = 0.5f * bfhi(v.y); }
        WAVE_LDS_SYNC();
        const int nch = (n + 63) >> 6;
        for (int i = 0; i < nch; ++i) {
            const int key = i * 64 + lane; const bool valid = key <= t;
            float kf[64]; load_row64(misc + (size_t)(b * SEQ + (valid ? key : t)) * 256, kf);
            float s = 0.f;
#pragma unroll
            for (int h = 0; h < 4; ++h) s += iw[h] * fmaxf(dot64(qb + h * 64, kf), 0.f);
            su[key] = valid ? f2o(s) : 0u;
        }
        WAVE_LDS_SYNC();
        unsigned prefix = 0u;
        for (int bit = 31; bit >= 0; --bit) {
            const unsigned cand = prefix | (1u << bit); int c = 0;
            for (int i = 0; i < nch; ++i) c += (su[i * 64 + lane] >= cand) ? 1 : 0;
            c = wave_sum_i(c);
            if (c >= 256) prefix = cand;
            if (c == 256) break;
        }
        int cgt = 0;
        for (int i = 0; i < nch; ++i) cgt += (su[i * 64 + lane] > prefix) ? 1 : 0;
        const int need_eq = 256 - wave_sum_i(cgt);
        int base = 0, eq_taken = 0;
        for (int i = 0; i < nch; ++i) {
            const unsigned v = su[i * 64 + lane]; const bool gt = v > prefix, eq = v == prefix;
            const unsigned long long meq = __ballot(eq);
            const bool sel = gt || (eq && (eq_taken + __popcll(meq & lt)) < need_eq);
            const unsigned long long ms = __ballot(sel);
            if (sel) list[base + __popcll(ms & lt)] = (unsigned short)(i * 64 + lane);
            base += __popcll(ms); eq_taken += __popcll(meq);
        }
        nsel = 256;
    }
    { const v4u v = *(const v4u*)((const bf16*)(ws + WS_QA) + (size_t)row * 512 + lane * 8); float f[8]; unpack8(v, f);
#pragma unroll
      for (int e = 0; e < 8; ++e) qb[lane * 8 + e] = f[e]; }
    WAVE_LDS_SYNC();
    const bf16* kva = (const bf16*)(ws + WS_KVA);
    float s[8][4];
#pragma unroll
    for (int j = 0; j < 4; ++j) {
        const int slot = lane + 64 * j; const bool valid = slot < nsel; const int key = list[valid ? slot : 0];
        float kf[64]; load_row64(kva + (size_t)(b * SEQ + key) * 128, kf);
#pragma unroll
        for (int h = 0; h < 8; ++h) s[h][j] = valid ? dot64(qb + h * 64, kf) : NEGF;
    }
    float linv[8];
#pragma unroll
    for (int h = 0; h < 8; ++h) {
        const float m = wave_max(fmaxf(fmaxf(s[h][0], s[h][1]), fmaxf(s[h][2], s[h][3]))); float ls = 0.f;
#pragma unroll
        for (int j = 0; j < 4; ++j) { const float p = __expf(s[h][j] - m); ls += p; pb[h * 256 + lane + 64 * j] = p; }
        linv[h] = 1.0f / wave_sum(ls);
    }
    WAVE_LDS_SYNC();
    float acc[8] = {0.f, 0.f, 0.f, 0.f, 0.f, 0.f, 0.f, 0.f};
    for (int slot = 0; slot < nsel; ++slot) {
        const float v = bf2f(kva[(size_t)(b * SEQ + list[slot]) * 128 + 64 + lane]);
#pragma unroll
        for (int h = 0; h < 8; ++h) acc[h] += pb[h * 256 + slot] * v;
    }
    bf16* ya = (bf16*)(ws + WS_QA) + (size_t)row * 512;
#pragma unroll
    for (int h = 0; h < 8; ++h) ya[h * 64 + lane] = (bf16)f2bf(acc[h] * linv[h]);
    WAVE_LDS_SYNC();
}
typedef short s16x4 __attribute__((ext_vector_type(4)));
typedef short v4i16_t __attribute__((ext_vector_type(4)));
typedef float f32x4v __attribute__((ext_vector_type(4)));
typedef __bf16 bf16x2_t __attribute__((ext_vector_type(2)));
typedef float f32x2_t __attribute__((ext_vector_type(2)));
__device__ __forceinline__ unsigned cvtpk(float lo, float hi) { f32x2_t v = {lo, hi}; bf16x2_t b = __builtin_convertvector(v, bf16x2_t); return __builtin_bit_cast(unsigned, b); }
constexpr float L2E = 1.4426950408889634f;
#ifndef NSA_JOINT
#define NSA_JOINT 0
#endif
#ifndef NSA_NOSKIP
#define NSA_NOSKIP 0
#endif
constexpr int NSA_KSTR = 72, NSA_VSTR = 80;
constexpr int NSA_KB = 64 * NSA_KSTR * 2, NSA_VB = 64 * NSA_VSTR * 2;
constexpr int NSA_D = 6, NSA_SLOT = 16384;
constexpr int NSA_OFF_RING = 0, NSA_OFF_KCL = 0, NSA_OFF_VCTL = 32768  , NSA_OFF_IMPA = 65536  , NSA_OFF_IMPB = NSA_OFF_IMPA + 64 * 65 * 4, NSA_OFF_UM = NSA_D * NSA_SLOT + 1024  , NSA_OFF_QM = NSA_OFF_UM + 64, NSA_OFF_ST = NSA_OFF_UM + 1024, NSA_LDS = NSA_OFF_ST + 512 * 64;
__device__ __forceinline__ s16x4 tr16(const LAS unsigned char* p) { return __builtin_bit_cast(s16x4, __builtin_amdgcn_ds_read_tr16_b64_v4i16((LAS v4i16_t*)p)); }
__device__ __forceinline__ bf16x8 cat4(s16x4 a, s16x4 b) { return __builtin_shufflevector(a, b, 0, 1, 2, 3, 4, 5, 6, 7); }
__device__ __forceinline__ bf16x8 pack8(float a0, float a1, float a2, float a3, float b0, float b1, float b2, float b3) {
    v4u w; w.x = pg8::cvt_pk_bf16(a0, a1); w.y = pg8::cvt_pk_bf16(a2, a3); w.z = pg8::cvt_pk_bf16(b0, b1); w.w = pg8::cvt_pk_bf16(b2, b3); return __builtin_bit_cast(bf16x8, w);
}
__device__ __forceinline__ float qxor1(float v) { return __builtin_bit_cast(float, __builtin_amdgcn_update_dpp(0, __builtin_bit_cast(int, v), 0xB1, 0xF, 0xF, true)); }
__device__ __forceinline__ float qxor2(float v) { return __builtin_bit_cast(float, __builtin_amdgcn_update_dpp(0, __builtin_bit_cast(int, v), 0x4E, 0xF, 0xF, true)); }
__device__ __forceinline__ float xmax16(float v) { v = fmaxf(v, __shfl_xor(v, 16)); return fmaxf(v, __shfl_xor(v, 32)); }
__device__ __forceinline__ float xsum16(float v) { v += __shfl_xor(v, 16); return v + __shfl_xor(v, 32); }

__device__ __forceinline__ void nsa_fetch(const bf16* kv, int b, int jb, int g, int tid, v4u& kr, v4u& vr) {
    const bf16* p = kv + (size_t)(b * SEQ + 64 * jb + (tid >> 3)) * 256 + g * 64 + (tid & 7) * 8;
    kr = *(const v4u*)p; vr = *(const v4u*)(p + 128);
}
__device__ __forceinline__ void nsa_stash(LAS unsigned char* Kb, LAS unsigned char* Vb, int tid, const v4u& kr, const v4u& vr) {
    *(LAS v4u*)(Kb + ((tid >> 3) * NSA_KSTR + (tid & 7) * 8) * 2) = kr; *(LAS v4u*)(Vb + ((tid >> 3) * NSA_VSTR + (tid & 7) * 8) * 2) = vr;
}
template <bool FULL>
__device__ __forceinline__ void nsa_block2(const LAS unsigned char* Kb, const LAS unsigned char* Vb, const bf16x8 (&qf)[2][2], const bool (&sel)[2], const int (&klo)[2], const int (&khi)[2],
                                           float (&mrow)[2], float (&lrow)[2], f32x4v (&o)[2][4], int lane) {
    const int j = lane & 15, gq = lane >> 4;
    f32x4v s[2][4];
#pragma unroll
    for (int kt = 0; kt < 4; ++kt) {
        s[0][kt] = (f32x4v){0.f, 0.f, 0.f, 0.f}; s[1][kt] = (f32x4v){0.f, 0.f, 0.f, 0.f};
#pragma unroll
        for (int ks = 0; ks < 2; ++ks) {
            const bf16x8 kf = *(const LAS bf16x8*)(Kb + (16 * kt + j) * 128 + (((gq + 4 * ks) ^ (j & 7)) << 4));
            s[0][kt] = __builtin_amdgcn_mfma_f32_16x16x32_bf16(kf, qf[0][ks], s[0][kt], 0, 0, 0);
            s[1][kt] = __builtin_amdgcn_mfma_f32_16x16x32_bf16(kf, qf[1][ks], s[1][kt], 0, 0, 0);
        }
    }
#pragma unroll
    for (int rg = 0; rg < 2; ++rg) {
        float bm = NEGF;
        if (FULL) { const float bias = sel[rg] ? 0.f : NEGF;
#pragma unroll
            for (int kt = 0; kt < 4; ++kt)
#pragma unroll
                for (int e = 0; e < 4; ++e) { const float v = s[rg][kt][e] + bias; s[rg][kt][e] = v; bm = fmaxf(bm, v); }
        } else {
#pragma unroll
            for (int kt = 0; kt < 4; ++kt)
#pragma unroll
                for (int e = 0; e < 4; ++e) { const int ko = 16 * kt + 4 * gq + e; const bool ok = sel[rg] && ko >= klo[rg] && ko <= khi[rg]; const float v = ok ? s[rg][kt][e] : NEGF; s[rg][kt][e] = v; bm = fmaxf(bm, v); }
        }
        bm = xmax16(bm);
        const float mnew = fmaxf(mrow[rg], bm), alpha = __builtin_amdgcn_exp2f(mrow[rg] - mnew);
        const bool moved = __builtin_amdgcn_ballot_w64(mnew != mrow[rg]) != 0ull;
        mrow[rg] = mnew;
        float ps = 0.f;
#pragma unroll
        for (int kt = 0; kt < 4; ++kt)
#pragma unroll
            for (int e = 0; e < 4; ++e) { const float p = __builtin_amdgcn_exp2f(s[rg][kt][e] - mnew); s[rg][kt][e] = p; ps += p; }
        lrow[rg] = lrow[rg] * alpha + ps;
        if (moved) {
#pragma unroll
            for (int dt = 0; dt < 4; ++dt) o[rg][dt] *= alpha;
        }
    }
#pragma unroll
    for (int kk = 0; kk < 2; ++kk) {
        const bf16x8 pf0 = pack8(s[0][2 * kk][0], s[0][2 * kk][1], s[0][2 * kk][2], s[0][2 * kk][3], s[0][2 * kk + 1][0], s[0][2 * kk + 1][1], s[0][2 * kk + 1][2], s[0][2 * kk + 1][3]);
        const bf16x8 pf1 = pack8(s[1][2 * kk][0], s[1][2 * kk][1], s[1][2 * kk][2], s[1][2 * kk][3], s[1][2 * kk + 1][0], s[1][2 * kk + 1][1], s[1][2 * kk + 1][2], s[1][2 * kk + 1][3]);
#pragma unroll
        for (int dt = 0; dt < 4; ++dt) {
            const LAS unsigned char* va = Vb + (32 * kk + 4 * gq + (j >> 2)) * 128 + (16 * dt + 4 * (j & 3)) * 2;
            const bf16x8 vf = cat4(tr16(va), tr16(va + 16 * 128));
            o[0][dt] = __builtin_amdgcn_mfma_f32_16x16x32_bf16(vf, pf0, o[0][dt], 0, 0, 0);
            o[1][dt] = __builtin_amdgcn_mfma_f32_16x16x32_bf16(vf, pf1, o[1][dt], 0, 0, 0);
        }
        }
}
__device__ __forceinline__ void nsa_block4(const LAS unsigned char* KbA, const LAS unsigned char* VbA, const LAS unsigned char* KbB, const LAS unsigned char* VbB, const bf16x8 (&qf)[2][2],
                                           const bool (&selA)[2], const bool (&selB)[2], float (&mrow)[2], float (&lrow)[2], f32x4v (&o)[2][4], int lane) {
    const int j = lane & 15, gq = lane >> 4;
    f32x4v s[2][2][4];
#pragma unroll
    for (int bl = 0; bl < 2; ++bl) { const LAS unsigned char* Kb = bl ? KbB : KbA;
#pragma unroll
        for (int kt = 0; kt < 4; ++kt) {
            s[bl][0][kt] = (f32x4v){0.f, 0.f, 0.f, 0.f}; s[bl][1][kt] = (f32x4v){0.f, 0.f, 0.f, 0.f};
#pragma unroll
            for (int ks = 0; ks < 2; ++ks) {
                const bf16x8 kf = *(const LAS bf16x8*)(Kb + (16 * kt + j) * 128 + (((gq + 4 * ks) ^ (j & 7)) << 4));
                s[bl][0][kt] = __builtin_amdgcn_mfma_f32_16x16x32_bf16(kf, qf[0][ks], s[bl][0][kt], 0, 0, 0);
                s[bl][1][kt] = __builtin_amdgcn_mfma_f32_16x16x32_bf16(kf, qf[1][ks], s[bl][1][kt], 0, 0, 0);
            }
        } }
#pragma unroll
    for (int rg = 0; rg < 2; ++rg) {
        float ba = NEGF, bb = NEGF;
#pragma unroll
        for (int kt = 0; kt < 4; ++kt)
#pragma unroll
            for (int e = 0; e < 4; ++e) { ba = fmaxf(ba, s[0][rg][kt][e]); bb = fmaxf(bb, s[1][rg][kt][e]); }
        if (!selA[rg]) ba = NEGF;
        if (!selB[rg]) bb = NEGF;
        const float bm = xmax16(fmaxf(ba, bb));
        const float mnew = fmaxf(mrow[rg], bm), alpha = __builtin_amdgcn_exp2f(mrow[rg] - mnew);
        const bool moved = __builtin_amdgcn_ballot_w64(mnew != mrow[rg]) != 0ull;
        mrow[rg] = mnew;
        const float sa = selA[rg] ? mnew : 1e30f, sb = selB[rg] ? mnew : 1e30f;
        float ps = 0.f;
#pragma unroll
        for (int kt = 0; kt < 4; ++kt)
#pragma unroll
            for (int e = 0; e < 4; ++e) { const float pa = __builtin_amdgcn_exp2f(s[0][rg][kt][e] - sa), pb = __builtin_amdgcn_exp2f(s[1][rg][kt][e] - sb); s[0][rg][kt][e] = pa; s[1][rg][kt][e] = pb; ps += pa + pb; }
        lrow[rg] = lrow[rg] * alpha + ps;
        if (moved) {
#pragma unroll
            for (int dt = 0; dt < 4; ++dt) o[rg][dt] *= alpha;
        }
    }
#pragma unroll
    for (int bl = 0; bl < 2; ++bl) { const LAS unsigned char* Vb = bl ? VbB : VbA;
#pragma unroll
        for (int kk = 0; kk < 2; ++kk) {
            const bf16x8 pf0 = pack8(s[bl][0][2 * kk][0], s[bl][0][2 * kk][1], s[bl][0][2 * kk][2], s[bl][0][2 * kk][3], s[bl][0][2 * kk + 1][0], s[bl][0][2 * kk + 1][1], s[bl][0][2 * kk + 1][2], s[bl][0][2 * kk + 1][3]);
            const bf16x8 pf1 = pack8(s[bl][1][2 * kk][0], s[bl][1][2 * kk][1], s[bl][1][2 * kk][2], s[bl][1][2 * kk][3], s[bl][1][2 * kk + 1][0], s[bl][1][2 * kk + 1][1], s[bl][1][2 * kk + 1][2], s[bl][1][2 * kk + 1][3]);
#pragma unroll
            for (int dt = 0; dt < 4; ++dt) {
                const LAS unsigned char* va = Vb + (32 * kk + 4 * gq + (j >> 2)) * 128 + (16 * dt + 4 * (j & 3)) * 2;
                const bf16x8 vf = cat4(tr16(va), tr16(va + 16 * 128));
                o[0][dt] = __builtin_amdgcn_mfma_f32_16x16x32_bf16(vf, pf0, o[0][dt], 0, 0, 0);
                o[1][dt] = __builtin_amdgcn_mfma_f32_16x16x32_bf16(vf, pf1, o[1][dt], 0, 0, 0);
            }
        } }
}
__device__ __forceinline__ void glds16(const void* gsrc, unsigned lds_dst) { unsigned keep;
    asm volatile("s_mov_b32 %0, m0\n\ts_mov_b32 m0, %2\n\ts_nop 0\n\tglobal_load_lds_dwordx4 %1, off\n\ts_mov_b32 m0, %0" : "=&s"(keep) : "v"(gsrc), "s"(lds_dst) : "memory"); }
template <int MODE>
__device__ __forceinline__ void nsa_attend(const bf16* kv, unsigned long long mask, int b, int g, int c, int tid, int lane, LAS unsigned char* ring, const bf16x8 (&qf)[2][2],
                                           const unsigned long long (&rmask)[2], const unsigned long long (&gmask)[2], const int (&trow)[2], float (&mrow)[2], float (&lrow)[2], f32x4v (&o)[2][4]) {
    const int wave = __builtin_amdgcn_readfirstlane(tid >> 6);
    const int rr = 8 * wave + (lane >> 3);
    const bf16* gk = kv + (size_t)(b * SEQ + rr) * 256 + g * 64 + (((lane & 7) ^ (rr & 7)) << 3);
    const bf16* gv = kv + (size_t)(b * SEQ + rr) * 256 + 128 + g * 64 + ((lane & 7) << 3);
    const unsigned ring0 = (unsigned)(uintptr_t)(unsigned char*)ring + wave * 1024;
#define NSA_ISSUE(jb_, slot_) do { glds16(gk + (size_t)(jb_) * 64 * 256, (unsigned)__builtin_amdgcn_readfirstlane(ring0 + (slot_) * NSA_SLOT)); \
                                   glds16(gv + (size_t)(jb_) * 64 * 256, (unsigned)__builtin_amdgcn_readfirstlane(ring0 + (slot_) * NSA_SLOT + 8192)); } while (0)
    unsigned long long remi = mask, remc = mask; int lastb = 0, si = 0, sc_ = 0;
#if DUP == 12
    float m2_[2] = {NEGF, NEGF}, l2_[2] = {0.f, 0.f}; f32x4v o2_[2][4]; for (int rg = 0; rg < 2; ++rg) for (int dt = 0; dt < 4; ++dt) o2_[rg][dt] = (f32x4v){0.f, 0.f, 0.f, 0.f};
#endif
#define NSA_ISSUE1() do { if (remi) { lastb = (int)__builtin_ctzll(remi); remi &= remi - 1ull; } NSA_ISSUE(lastb, si); si = si + 1 == NSA_D ? 0 : si + 1; } while (0)
#define NSA_FLAGS(jj_, sel_, klo_, khi_, act_) do { _Pragma("unroll") for (int rg = 0; rg < 2; ++rg) { const int o6 = trow[rg] & 63; \
            if (MODE == 0) { sel_[rg] = (rmask[rg] >> (jj_)) & 1ull; act_[rg] = (gmask[rg] >> (jj_)) & 1ull; klo_[rg] = 0; khi_[rg] = ((jj_) == c) ? o6 : 63; } \
            else { sel_[rg] = true; act_[rg] = true; klo_[rg] = ((jj_) == c - 4) ? o6 + 1 : 0; khi_[rg] = ((jj_) == c) ? o6 : 63; } } } while (0)
    NSA_ISSUE1(); NSA_ISSUE1(); NSA_ISSUE1(); NSA_ISSUE1();
    while (remc) {
        const int jA = (int)__builtin_ctzll(remc); remc &= remc - 1ull;
        const bool two = remc != 0ull; const int jB = two ? (int)__builtin_ctzll(remc) : jA; if (two) remc &= remc - 1ull;
        asm volatile("s_waitcnt vmcnt(4) lgkmcnt(0)\n\ts_barrier" ::: "memory");
        NSA_ISSUE1(); NSA_ISSUE1();
        const LAS unsigned char* kA = ring + sc_ * NSA_SLOT; const LAS unsigned char* vA = kA + 8192; const LAS unsigned char* kB = kA + NSA_SLOT; const LAS unsigned char* vB = kB + 8192;
        sc_ = sc_ + 2 == NSA_D ? 0 : sc_ + 2;
        bool selA[2], selB[2], actA[2], actB[2]; int kloA[2], khiA[2], kloB[2], khiB[2];
        NSA_FLAGS(jA, selA, kloA, khiA, actA); NSA_FLAGS(jB, selB, kloB, khiB, actB);
        const bool fullA = (MODE == 0) ? (jA != c) : (jA != c && jA != c - 4), fullB = (MODE == 0) ? (jB != c) : (jB != c && jB != c - 4);
        const bool doA = actA[0] || actA[1], doB = two && (actB[0] || actB[1]);
        if (NSA_JOINT && MODE == 0 && doA && doB && fullA && fullB) nsa_block4(kA, vA, kB, vB, qf, selA, selB, mrow, lrow, o, lane);
        else {
            if (doA) { if (fullA) nsa_block2<true>(kA, vA, qf, selA, kloA, khiA, mrow, lrow, o, lane); else nsa_block2<false>(kA, vA, qf, selA, kloA, khiA, mrow, lrow, o, lane); }
            if (doB) { if (fullB) nsa_block2<true>(kB, vB, qf, selB, kloB, khiB, mrow, lrow, o, lane); else nsa_block2<false>(kB, vB, qf, selB, kloB, khiB, mrow, lrow, o, lane); }
        }
    }
#undef NSA_ISSUE1
#undef NSA_FLAGS
    asm volatile("s_waitcnt vmcnt(0) lgkmcnt(0)\n\ts_barrier" ::: "memory");
#undef NSA_ISSUE
}
#if defined(PROBE_CMP)
__device__ __forceinline__ void nsa_probe_store(unsigned char* ws, int row, int head, int gq, const f32x4v (&v)[4]) {
    bf16* pb_ = (bf16*)(ws + 497 * MiB);
    for (int dt = 0; dt < 4; ++dt) { uint2 w; w.x = cvtpk(v[dt][0], v[dt][1]); w.y = cvtpk(v[dt][2], v[dt][3]); *(uint2*)(pb_ + (size_t)row * 512 + head * 64 + 16 * dt + 4 * gq) = w; }
}
#endif
__device__ __forceinline__ void nsa_unit(unsigned char* ws, int unit, LAS unsigned char* lds, int tid_in, bf16* yout) {
    int tid = tid_in; asm volatile("" : "+v"(tid));
    const int lane = tid & 63, wave = __builtin_amdgcn_readfirstlane(tid >> 6), j = lane & 15, gq = lane >> 4;
    const int c = unit & 63, g = (unit >> 6) & 1, b = unit >> 7, bg = b * 2 + g;
    LAS float* impa = (LAS float*)(lds + NSA_OFF_IMPA); LAS float* impb = (LAS float*)(lds + NSA_OFF_IMPB);
    LAS unsigned long long* um = (LAS unsigned long long*)(lds + NSA_OFF_UM);
    TP_DECL
    for (int i = tid; i < 2 * 64 * 65; i += 512) impa[i] = 0.f;
    {
        const v4u* ksrc = (const v4u*)((const bf16*)(ws + WS_KC) + (size_t)bg * 256 * 64); const v4u* vsrc = (const v4u*)((const bf16*)(ws + WS_VC) + (size_t)bg * 64 * 256);
        v4u kst[4], vst[4];
#pragma unroll
        for (int i = 0; i < 4; ++i) { kst[i] = ksrc[tid + 512 * i]; vst[i] = vsrc[tid + 512 * i]; }
#pragma unroll
        for (int i = 0; i < 4; ++i) { const int idx = tid + 512 * i; const int r = idx >> 3, sg = idx & 7; *(LAS v4u*)(lds + NSA_OFF_KCL + r * 128 + ((sg ^ (r & 7)) << 4)) = kst[i]; }
#pragma unroll
        for (int i = 0; i < 4; ++i) { const int idx = tid + 512 * i; const int r = idx >> 5, sg = idx & 31; *(LAS v4u*)(lds + NSA_OFF_VCTL + r * 512 + ((sg ^ (r & 15)) << 4)) = vst[i]; }
    }
    bf16* qc = (bf16*)(ws + WS_QC);
    const bf16* misc = (const bf16*)(ws + WS_MISC);
    bf16x8 qf[2][2]; float gate[2][3]; int trow[2];
#pragma unroll
    for (int rg = 0; rg < 2; ++rg) {
        const int q = 8 * wave + 4 * rg + (j >> 2), t = 64 * c + q, row = b * SEQ + t, head = g * 4 + (j & 3);
        trow[rg] = t;
#pragma unroll
        for (int ks = 0; ks < 2; ++ks) qf[rg][ks] = *(const bf16x8*)(qc + (size_t)row * 512 + head * 64 + 8 * gq + 32 * ks);
        gate[rg][0] = __builtin_amdgcn_rcpf(1.0f + __expf(-bf2f(misc[(size_t)row * 256 + 196 + head * 3])));
    }
    typedef unsigned u32x2v __attribute__((ext_vector_type(2)));
    LAS u32x2v* stash = (LAS u32x2v*)(lds + NSA_OFF_ST) + tid * 8;
    __syncthreads();
    const int nT = (c >> 2) + 1;
#pragma unroll
    for (int rg = 0; rg < 2; ++rg) {
        const int t = trow[rg], nv = t >= 31 ? ((t - 15) >> 4) : 0;
        f32x4v s[16]; float mx = NEGF;
#pragma unroll
        for (int T = 0; T < 16; ++T) {
            s[T] = (f32x4v){0.f, 0.f, 0.f, 0.f};
            if (T < nT) {
#pragma unroll
                for (int ks = 0; ks < 2; ++ks) { const bf16x8 kf = *(const LAS bf16x8*)(lds + NSA_OFF_KCL + (16 * T + j) * 128 + (((gq + 4 * ks) ^ (j & 7)) << 4)); s[T] = __builtin_amdgcn_mfma_f32_16x16x32_bf16(kf, qf[rg][ks], s[T], 0, 0, 0); }
#pragma unroll
                for (int e = 0; e < 4; ++e) { const float v = (16 * T + 4 * gq + e < nv) ? s[T][e] : NEGF; s[T][e] = v; mx = fmaxf(mx, v); }
            }
        }
        mx = xmax16(mx);
        float ls = 0.f;
#pragma unroll
        for (int T = 0; T < 16; ++T) if (T < nT) {
#pragma unroll
            for (int e = 0; e < 4; ++e) { const float p = (16 * T + 4 * gq + e < nv) ? __builtin_amdgcn_exp2f(s[T][e] - mx) : 0.f; s[T][e] = p; ls += p; }
        }
        ls = xsum16(ls);
        const float inv = nv > 0 ? __builtin_amdgcn_rcpf(ls) : 0.f;
        const int q = 8 * wave + 4 * rg + (j >> 2);
#pragma unroll
        for (int T = 0; T < 16; ++T) if (T < nT) {
#pragma unroll
            for (int e = 0; e < 4; ++e) s[T][e] *= inv;
            float a = s[T][0] + s[T][1] + s[T][2] + 0.5f * s[T][3], bb = 0.5f * s[T][3];
            a += qxor1(a); a += qxor2(a); bb += qxor1(bb); bb += qxor2(bb);
            if ((j & 3) == 0) { impa[q * 65 + 4 * T + gq] = a; impb[q * 65 + 4 * T + gq + 1] = bb; }
        }
        f32x4v oc[4];
#pragma unroll
        for (int dt = 0; dt < 4; ++dt) oc[dt] = (f32x4v){0.f, 0.f, 0.f, 0.f};
#pragma unroll
        for (int kk = 0; kk < 8; ++kk) if (2 * kk < nT) {
            const bf16x8 pf = pack8(s[2 * kk][0], s[2 * kk][1], s[2 * kk][2], s[2 * kk][3], s[2 * kk + 1][0], s[2 * kk + 1][1], s[2 * kk + 1][2], s[2 * kk + 1][3]);
#pragma unroll
            for (int dt = 0; dt < 4; ++dt) {
                const LAS unsigned char* vp = lds + NSA_OFF_VCTL + (16 * dt + j) * 512 + (gq & 1) * 8;
                const s16x4 v0 = *(const LAS s16x4*)(vp + ((((8 * kk + gq) >> 1) ^ j) << 4)), v1 = *(const LAS s16x4*)(vp + (((((8 * kk + gq) >> 1) + 2) ^ j) << 4));
                oc[dt] = __builtin_amdgcn_mfma_f32_16x16x32_bf16(cat4(v0, v1), pf, oc[dt], 0, 0, 0);
            }
        }
#pragma unroll
        for (int dt = 0; dt < 4; ++dt) { const f32x4v v = oc[dt] * gate[rg][0]; u32x2v w; w.x = pg8::cvt_pk_bf16(v[0], v[1]); w.y = pg8::cvt_pk_bf16(v[2], v[3]); stash[rg * 4 + dt] = w; }
        __builtin_amdgcn_sched_barrier(0);
    }
    __syncthreads();
    TP_MARK(5);
    unsigned long long smask[8], mymask = 0ull;
#pragma unroll
    for (int qi = 0; qi < 8; ++qi) {
        const int q = 8 * wave + qi;
#if PROBE == 4
        const float imp = ((const float*)(ws + 500 * MiB))[((size_t)(b * SEQ + 64 * c + q) * 2 + g) * 64 + lane];
#else
        const float imp = impa[q * 65 + lane] + impb[q * 65 + lane];
#endif
#if PROBE && (PROBE != 5 || defined(PROBE5_IMP))
        ((float*)(ws + 516 * MiB))[((size_t)(b * SEQ + 64 * c + q) * 2 + g) * 64 + lane] = (lane <= c) ? imp : 0.f;
#endif
        const bool forced = (lane == 0) || (lane == c), adm = lane <= c;
        unsigned key = forced ? (0xFFFFFF00u | (unsigned)(63 - lane)) : (adm ? ((__float_as_uint(imp) & 0xFFFFFFC0u) | (unsigned)(63 - lane)) : 0u);
        unsigned long long mk = 0ull;
#if TOP8_RANK
        { int rank = 0;
#pragma unroll
          for (int jj = 0; jj < 64; ++jj) { const unsigned kk = (unsigned)__builtin_amdgcn_readlane((int)key, jj); rank += (kk > key) ? 1 : 0; }
          mk = __ballot(key != 0u && rank < 8); }
#else
        for (int k = 0; k < 8; ++k) { const unsigned mx = wave_max_u(key); if (mx == 0u) break; const int win = 63 - (int)(mx & 63u); mk |= 1ull << win; if (lane == win) key = 0u; }
#endif
        mk = ((unsigned long long)(unsigned)__builtin_amdgcn_readfirstlane((unsigned)(mk >> 32)) << 32) | (unsigned long long)(unsigned)__builtin_amdgcn_readfirstlane((unsigned)mk);
#ifdef FIXSEL
        { mk = 1ull | (1ull << c); for (int d = 1; d <= 6; ++d) mk |= 1ull << (((FIXHOM ? 0 : q * 7) + d * 5) % (c + 1)); }
#endif
#if PROBE == 2
        mk = ((const unsigned long long*)(ws + 496 * MiB))[(size_t)(b * SEQ + 64 * c + q) * 2 + g];
        mk = ((unsigned long long)(unsigned)__builtin_amdgcn_readfirstlane((unsigned)(mk >> 32)) << 32) | (unsigned long long)(unsigned)__builtin_amdgcn_readfirstlane((unsigned)mk);
#endif
#if PROBE == 5
        if (lane == 0) ((unsigned long long*)(ws + 498 * MiB))[(size_t)(b * SEQ + 64 * c + q) * 2 + g] = mk;
#endif
#if PROBE == 5 && !defined(PROBE5_IMP)
        ((float*)(ws + 516 * MiB))[((size_t)(b * SEQ + 64 * c + q) * 2 + g) * 64 + lane] = ((mk >> lane) & 1ull) ? 1.f : 0.f;
#endif
        smask[qi] = mk; mymask |= mk;
    }
    if (lane == 0) um[wave] = mymask;
    __syncthreads();
    unsigned long long umask = 0ull;
#pragma unroll
    for (int w = 0; w < 8; ++w) umask |= um[w];
    umask = ((unsigned long long)(unsigned)__builtin_amdgcn_readfirstlane((unsigned)(umask >> 32)) << 32) | (unsigned long long)(unsigned)__builtin_amdgcn_readfirstlane((unsigned)umask);
    unsigned long long rmask[2];
    { LAS unsigned long long* qm = (LAS unsigned long long*)(lds + NSA_OFF_QM);
      __syncthreads();
#pragma unroll
      for (int qi = 0; qi < 8; ++qi) if (lane == 0) qm[8 * wave + qi] = smask[qi];
      __syncthreads();
#pragma unroll
      for (int rg = 0; rg < 2; ++rg) rmask[rg] = qm[8 * wave + 4 * rg + (j >> 2)]; }
    const unsigned long long gmask[2] = {smask[0] | smask[1] | smask[2] | smask[3], smask[4] | smask[5] | smask[6] | smask[7]};
    TP_MARK(6); TP_ADD(9, __popcll(umask)); TP_ADD(10, 1); TP_ADD(11, c + 1); TP_ADD(12, __popcll(umask & ~(c == 63 ? ~0ull : ((2ull << c) - 1ull)))); TP_ADD(13, __popcll(smask[0]));
    const bf16* kvs = (const bf16*)(ws + WS_KVS); const bf16* kvw = (const bf16*)(ws + WS_KVW);
    LAS unsigned char* ring = lds + NSA_OFF_RING;
    {
        float mrow[2] = {NEGF, NEGF}, lrow[2] = {0.f, 0.f}; f32x4v o[2][4];
#pragma unroll
        for (int rg = 0; rg < 2; ++rg)
#pragma unroll
            for (int dt = 0; dt < 4; ++dt) o[rg][dt] = (f32x4v){0.f, 0.f, 0.f, 0.f};
        nsa_attend<0>(kvs, umask, b, g, c, tid, lane, ring, qf, rmask, gmask, trow, mrow, lrow, o);
#if DUP == 8
        { __syncthreads(); float m2[2] = {NEGF, NEGF}, l2[2] = {0.f, 0.f}; f32x4v o2[2][4];
          for (int rg = 0; rg < 2; ++rg) for (int dt = 0; dt < 4; ++dt) o2[rg][dt] = (f32x4v){0.f, 0.f, 0.f, 0.f};
          nsa_attend<0>(kvs, umask, b, g, c, tid, lane, Kb, Vb, qf, rmask, gmask, trow, m2, l2, o2);
          bf16* dmy = (bf16*)(ws + WS_BU) + (size_t)(b * SEQ + trow[0]) * 512 + (g * 4 + (j & 3)) * 64 + 4 * gq;
          for (int rg = 0; rg < 2; ++rg) for (int dt = 0; dt < 4; ++dt) { uint2 w; w.x = pg8::cvt_pk_bf16(o2[rg][dt][0] + l2[rg], o2[rg][dt][1]); w.y = pg8::cvt_pk_bf16(o2[rg][dt][2], o2[rg][dt][3]); *(uint2*)(dmy + 16 * dt) = w; } }
#endif
#pragma unroll
        for (int rg = 0; rg < 2; ++rg) { const float g1_ = __builtin_amdgcn_rcpf(1.0f + __expf(-bf2f(misc[(size_t)(b * SEQ + trow[rg]) * 256 + 196 + (g * 4 + (j & 3)) * 3 + 1]))); const float sc = g1_ * __builtin_amdgcn_rcpf(xsum16(lrow[rg]));
#pragma unroll
            for (int dt = 0; dt < 4; ++dt) { const u32x2v p = stash[rg * 4 + dt]; const f32x4v v = o[rg][dt] * sc; u32x2v w; w.x = pg8::cvt_pk_bf16(v[0] + bflo(p.x), v[1] + bfhi(p.x)); w.y = pg8::cvt_pk_bf16(v[2] + bflo(p.y), v[3] + bfhi(p.y)); stash[rg * 4 + dt] = w; }
            }
        __syncthreads();
    }
    TP_MARK(7);
    {
        float mrow[2] = {NEGF, NEGF}, lrow[2] = {0.f, 0.f}; f32x4v o[2][4];
#pragma unroll
        for (int rg = 0; rg < 2; ++rg)
#pragma unroll
            for (int dt = 0; dt < 4; ++dt) o[rg][dt] = (f32x4v){0.f, 0.f, 0.f, 0.f};
        { const int j0 = c - 4 > 0 ? c - 4 : 0; const unsigned long long wmask = ((c == 63 ? ~0ull : ((1ull << (c + 1)) - 1ull)) >> j0) << j0;
          nsa_attend<1>(kvw, wmask, b, g, c, tid, lane, ring, qf, rmask, gmask, trow, mrow, lrow, o); }
#pragma unroll
        for (int rg = 0; rg < 2; ++rg) { const float g2_ = __builtin_amdgcn_rcpf(1.0f + __expf(-bf2f(misc[(size_t)(b * SEQ + trow[rg]) * 256 + 196 + (g * 4 + (j & 3)) * 3 + 2]))); const float sc = g2_ * __builtin_amdgcn_rcpf(xsum16(lrow[rg]));
#pragma unroll
            for (int dt = 0; dt < 4; ++dt) { const u32x2v p = stash[rg * 4 + dt]; const f32x4v v = o[rg][dt] * sc; uint2 w; w.x = pg8::cvt_pk_bf16(v[0] + bflo(p.x), v[1] + bfhi(p.x)); w.y = pg8::cvt_pk_bf16(v[2] + bflo(p.y), v[3] + bfhi(p.y));
                *(uint2*)(yout + (size_t)(b * SEQ + trow[rg]) * 512 + (g * 4 + (j & 3)) * 64 + 16 * dt + 4 * gq) = w; }
            }
    }
    __syncthreads();
    TP_MARK(8);
}
__device__ __forceinline__ void prep_kva16(unsigned char* ws, int task, int lane) {
    const int j = lane & 15, gq = lane >> 4, row = task * 16 + j;
    const bf16* misc = (const bf16*)(ws + WS_MISC) + (size_t)row * 256 + 64;
    const bf16* wu = (const bf16*)(ws + WS_W + WO_UKV);
    bf16x8 cf[4]; float ss = 0.f;
#pragma unroll
    for (int ks = 0; ks < 4; ++ks) { const v4u v = *(const v4u*)(misc + 8 * gq + 32 * ks); cf[ks] = __builtin_bit_cast(bf16x8, v); float f[8]; unpack8(v, f);
#pragma unroll
        for (int e = 0; e < 8; ++e) ss += f[e] * f[e]; }
    ss = xsum16(ss);
    const float r = 1.0f / sqrtf(ss * (1.f / 128.f) + EPS);
    const float* rp = (const float*)(ws + WS_ROPE) + (size_t)row * 16;
    bf16* o = (bf16*)(ws + WS_KVA) + (size_t)row * 128;
#pragma unroll
    for (int ct = 0; ct < 8; ++ct) {
        f32x4v a = {0.f, 0.f, 0.f, 0.f};
#pragma unroll
        for (int ks = 0; ks < 4; ++ks) { const bf16x8 wf = *(const bf16x8*)(wu + (size_t)(16 * ct + j) * 128 + 8 * gq + 32 * ks); a = __builtin_amdgcn_mfma_f32_16x16x32_bf16(wf, cf[ks], a, 0, 0, 0); }
        a *= r;
        if (ct == 0) {
            const float c0 = rp[2 * gq], s0 = rp[8 + 2 * gq], c1 = rp[2 * gq + 1], s1 = rp[8 + 2 * gq + 1];
            const float x0 = a[0], x1 = a[1], x2 = a[2], x3 = a[3];
            a[0] = x0 * c0 - x1 * s0; a[1] = x1 * c0 + x0 * s0; a[2] = x2 * c1 - x3 * s1; a[3] = x3 * c1 + x2 * s1;
        }
        uint2 w; w.x = cvtpk(a[0], a[1]); w.y = cvtpk(a[2], a[3]);
        *(uint2*)(o + 16 * ct + 4 * gq) = w;
    }
}
__device__ __forceinline__ void prep_pool16(unsigned char* ws, int task, int lane, const LAS unsigned char* wl, bf16* ybuf) {
    const int j = lane & 15, gq = lane >> 4, row = task * 16 + j, t = row & (SEQ - 1);
    const bf16* bu = (const bf16*)(ws + WS_BU);
    bf16* yb = ybuf + (size_t)row * 512;
#pragma unroll 1
    for (int g = 0; g < 4; ++g) {
        const int w = 2 << g, lo = (t + 1 - w) > 0 ? (t + 1 - w) : 0, cnt = t + 1 - lo; const float inv = 1.0f / (float)cnt;
        bf16x8 pf[4];
#pragma unroll
        for (int ks = 0; ks < 4; ++ks) {
            const bf16* p = bu + (size_t)row * 512 + g * 128 + 8 * gq + 32 * ks;
            float sum[8] = {0.f, 0.f, 0.f, 0.f, 0.f, 0.f, 0.f, 0.f}, cur[8];
            { const v4u v = *(const v4u*)p; unpack8(v, cur);
#pragma unroll
              for (int e = 0; e < 8; ++e) sum[e] = cur[e]; }
            v4u wv_[15];
#pragma unroll
            for (int i = 1; i < 16; ++i) if (i < w) wv_[i - 1] = *(const v4u*)(p - (size_t)(i < cnt ? i : 0) * 512);
#pragma unroll
            for (int i = 1; i < 16; ++i) if (i < w) { const bool ok = i < cnt; float f[8]; unpack8(wv_[i - 1], f);
#pragma unroll
                for (int e = 0; e < 8; ++e) sum[e] += ok ? f[e] : 0.f; }
            __builtin_amdgcn_sched_barrier(0);
            pf[ks] = pack8(sum[0] * inv - cur[0], sum[1] * inv - cur[1], sum[2] * inv - cur[2], sum[3] * inv - cur[3], sum[4] * inv - cur[4], sum[5] * inv - cur[5], sum[6] * inv - cur[6], sum[7] * inv - cur[7]);
        }
#pragma unroll
        for (int dt = 0; dt < 8; ++dt) {
            f32x4v a = {0.f, 0.f, 0.f, 0.f};
#pragma unroll
            for (int ks = 0; ks < 4; ++ks) {
#if POOLDBG == 1
                bf16x8 wf; for (int e = 0; e < 8; ++e) wf[e] = (short)0x3c00;
#else
                const bf16x8 wf = *(const LAS bf16x8*)(wl + (g * 128 + 16 * dt + j) * 256 + (((gq + 4 * ks) ^ j) << 4));
#endif
#if POOLDBG == 2
                bf16x8 pz; for (int e = 0; e < 8; ++e) pz[e] = (short)0x3c00; a = __builtin_amdgcn_mfma_f32_16x16x32_bf16(wf, pz, a, 0, 0, 0);
#else
                a = __builtin_amdgcn_mfma_f32_16x16x32_bf16(wf, pf[ks], a, 0, 0, 0);
#endif
            }
            uint2 wv; wv.x = cvtpk(a[0], a[1]); wv.y = cvtpk(a[2], a[3]);
            *(uint2*)(yb + g * 128 + 16 * dt + 4 * gq) = wv;
        }
    }
}
__device__ __forceinline__ float gelu_tanh_f(float x) { const float u = 0.7978845608028654f * (x + 0.044715f * x * x * x); const float e = __expf(2.0f * u); return 0.5f * x * (1.0f + (1.0f - 2.0f / (e + 1.0f))); }
__device__ __forceinline__ void prep_cmp16(unsigned char* ws, int task, LAS unsigned char* lds, int wave, int lane) {
    const int j = lane & 15, gq = lane >> 4, grp = wave >> 2, wq = wave & 3;
    const int i0 = (task & 15) * 16, bg = (task >> 4) & 15, br = task >> 8, b = bg >> 1, g = bg & 1, i = i0 + j;
    const bf16* kvc = (const bf16*)(ws + WS_KVC);
    const bf16* w1 = (const bf16*)(ws + WS_W + WO_CW1) + (size_t)br * 128 * 2048;
    const bf16* w2 = (const bf16*)(ws + WS_W + WO_CW2) + (size_t)br * 64 * 128;
    const float* posb = (const float*)(ws + WS_W + WO_POSB) + br * 128;
    LAS float* part = (LAS float*)lds + (size_t)grp * 4 * 32 * 64;
    f32x4v h[8];
#pragma unroll
    for (int nt = 0; nt < 8; ++nt) h[nt] = (f32x4v){0.f, 0.f, 0.f, 0.f};
#define CMP_LOAD(k2_, wf_, ff_) do { const int ks_ = 16 * wq + (k2_), l_ = ks_ >> 1; int tok_ = 16 * i + l_; tok_ = tok_ > SEQ - 1 ? SEQ - 1 : tok_;     \
        ff_ = *(const bf16x8*)(kvc + (size_t)(b * SEQ + tok_) * 256 + br * 128 + g * 64 + 32 * (ks_ & 1) + 8 * gq); \
        _Pragma("unroll") for (int nt_ = 0; nt_ < 8; ++nt_) wf_[nt_] = *(const bf16x8*)(w1 + (size_t)(16 * nt_ + j) * 2048 + 32 * ks_ + 8 * gq); } while (0)
    bf16x8 wfA[8], wfB[8], ffA, ffB;
    CMP_LOAD(0, wfA, ffA);
#pragma unroll
    for (int k2 = 0; k2 < 16; k2 += 2) {
        CMP_LOAD(k2 + 1, wfB, ffB);
        __builtin_amdgcn_sched_barrier(0);
#pragma unroll
        for (int nt = 0; nt < 8; ++nt) h[nt] = __builtin_amdgcn_mfma_f32_16x16x32_bf16(wfA[nt], ffA, h[nt], 0, 0, 0);
        if (k2 + 2 < 16) CMP_LOAD(k2 + 2, wfA, ffA);
        __builtin_amdgcn_sched_barrier(0);
#pragma unroll
        for (int nt = 0; nt < 8; ++nt) h[nt] = __builtin_amdgcn_mfma_f32_16x16x32_bf16(wfB[nt], ffB, h[nt], 0, 0, 0);
    }
#undef CMP_LOAD
#pragma unroll
    for (int nt = 0; nt < 8; ++nt)
#pragma unroll
        for (int e = 0; e < 4; ++e) part[(wq * 32 + nt * 4 + e) * 64 + lane] = h[nt][e];
    f32x4v pbv_[8];
#pragma unroll
    for (int nt = 0; nt < 8; ++nt) pbv_[nt] = *(const f32x4v*)(posb + 16 * nt + 4 * gq);
    __syncthreads();
    if (wq == 0) {
#pragma unroll
        for (int nt = 0; nt < 8; ++nt) { const f32x4v pbv = pbv_[nt];
#pragma unroll
            for (int e = 0; e < 4; ++e) { const int idx = (nt * 4 + e) * 64 + lane; h[nt][e] = gelu_tanh_f(((part[idx] + part[32 * 64 + idx]) + (part[2 * 32 * 64 + idx] + part[3 * 32 * 64 + idx])) + pbv[e]); } }
        f32x4v o[4];
#pragma unroll
        for (int dt = 0; dt < 4; ++dt) o[dt] = (f32x4v){0.f, 0.f, 0.f, 0.f};
        s16x4 w2a[4][4], w2b[4][4];
#pragma unroll
        for (int kk = 0; kk < 4; ++kk)
#pragma unroll
            for (int dt = 0; dt < 4; ++dt) { const bf16* wp = w2 + (size_t)(16 * dt + j) * 128 + 32 * kk + 4 * gq; w2a[kk][dt] = *(const s16x4*)wp; w2b[kk][dt] = *(const s16x4*)(wp + 16); }
        __builtin_amdgcn_sched_barrier(0);
#pragma unroll
        for (int kk = 0; kk < 4; ++kk) {
            const bf16x8 hf = pack8(h[2 * kk][0], h[2 * kk][1], h[2 * kk][2], h[2 * kk][3], h[2 * kk + 1][0], h[2 * kk + 1][1], h[2 * kk + 1][2], h[2 * kk + 1][3]);
#pragma unroll
            for (int dt = 0; dt < 4; ++dt) o[dt] = __builtin_amdgcn_mfma_f32_16x16x32_bf16(cat4(w2a[kk][dt], w2b[kk][dt]), hf, o[dt], 0, 0, 0);
        }
        const bool dead = i == 255;
        if (br == 0) { bf16* kc = (bf16*)(ws + WS_KC) + ((size_t)bg * 256 + i) * 64;
#pragma unroll
            for (int dt = 0; dt < 4; ++dt) { uint2 w; w.x = dead ? 0u : cvtpk(o[dt][0], o[dt][1]); w.y = dead ? 0u : cvtpk(o[dt][2], o[dt][3]); *(uint2*)(kc + 16 * dt + 4 * gq) = w; }
        } else { bf16* vct = (bf16*)(ws + WS_VC) + (size_t)bg * 64 * 256 + i;
#pragma unroll
            for (int dt = 0; dt < 4; ++dt)
#pragma unroll
                for (int e = 0; e < 4; ++e) vct[(size_t)(16 * dt + 4 * gq + e) * 256] = dead ? (bf16)0 : (bf16)f2bf(o[dt][e]);
        }
    }
    __syncthreads();
}
__device__ __forceinline__ void phase_prep(const Args& P, unsigned char* ws, int z, int l, LAS unsigned char* lds, int gw, int NGW, int lane, int wave, bf16* ybuf) {
    asm volatile("" : "+v"(lane)); lane &= 63; asm volatile("" : "+s"(gw), "+s"(NGW));
#if TPROBE
    const int tid = (wave << 6) | lane; unsigned long long tp_t_ = __builtin_amdgcn_s_memtime();
#endif
    for (int it = 2 * (gw >> 3) + (wave >> 2); it < 512 + (wave >> 2); it += 2 * (NGW >> 3)) prep_cmp16(ws, it < 512 ? it : 511, lds, wave, lane);
    TP_MARK(27);
    {
        const v4u* src = (const v4u*)(ws + WS_W + WO_POOL); const int t_ = (wave << 6) | lane;
        v4u pst[16];
#pragma unroll
        for (int i = 0; i < 16; ++i) pst[i] = src[t_ + 512 * i];
#pragma unroll
        for (int i = 0; i < 16; ++i) { const int idx = t_ + 512 * i, r = idx >> 4, sg = idx & 15; *(LAS v4u*)(lds + r * 256 + ((sg ^ (r & 15)) << 4)) = pst[i]; }
        __syncthreads();
    }
    TP_MARK(28);
    for (int it = gw; it < M / 16; it += NGW) { prep_kva16(ws, it, lane); TP_MARK(29); prep_pool16(ws, it, lane, lds, ybuf); }
    __syncthreads();
    TP_MARK(31);
}
constexpr int DSA_K = DSA_K_V, DSA_S = 32 - DSA_K, DSA_CAP = DSA_CAP_V;
constexpr int DSA_OFF_CNT = 0, DSA_OFF_PC = 3072, DSA_OFF_LIST = DSA_OFF_PC + 32 * 16 * 4, DSA_OFF_V = DSA_OFF_LIST + 16 * 256 * 2, DSA_VB = 64 * NSA_VSTR * 2, DSA_LDS = DSA_OFF_V + 8 * DSA_VB;
#define DSA_FOR_TILES(...) _Pragma("unroll") for (int G8 = 0; G8 < 8; ++G8) { if (G8 < ngrp) { _Pragma("unroll") for (int T8 = 0; T8 < 4; ++T8) { const int T = G8 * 4 + T8; __VA_ARGS__ } } }
__device__ __forceinline__ void cnt_ge(int& c, unsigned u, unsigned cand) { asm volatile("v_cmp_ge_u32_e32 vcc, %1, %2\n\tv_addc_co_u32_e32 %0, vcc, 0, %0, vcc" : "+v"(c) : "v"(u), "v"(cand) : "vcc"); }
__device__ __forceinline__ void cnt_gt(int& c, unsigned u, unsigned cand) { asm volatile("v_cmp_gt_u32_e32 vcc, %1, %2\n\tv_addc_co_u32_e32 %0, vcc, 0, %0, vcc" : "+v"(c) : "v"(u), "v"(cand) : "vcc"); }
__device__ __forceinline__ void cnt_le(int& c, unsigned u, unsigned cand) { asm volatile("v_cmp_le_u32_e32 vcc, %1, %2\n\tv_addc_co_u32_e32 %0, vcc, 0, %0, vcc" : "+v"(c) : "v"(u), "v"(cand) : "vcc"); }
__device__ __forceinline__ int dsa_total(LAS unsigned* cnt, int par, int wave, int j, int gq, int c) {
    c += __shfl_xor(c, 16); c += __shfl_xor(c, 32);
    if (gq == 0) cnt[(par * 8 + wave) * 16 + j] = (unsigned)c;
    __syncthreads();
    int tot = 0;
#pragma unroll
    for (int w = 0; w < 8; ++w) tot += (int)cnt[(par * 8 + w) * 16 + j];
    return tot;
}
__device__ __forceinline__ void dsa_unit(unsigned char* ws, int unit, LAS unsigned char* lds, int tid_in, bf16* yout) {
    int tid = tid_in; asm volatile("" : "+v"(tid));
    const int lane = tid & 63, wave = __builtin_amdgcn_readfirstlane(tid >> 6), j = lane & 15, gq = lane >> 4;
    const int b = unit >> 8, q0 = (unit & 255) * 16, t = q0 + j, row = b * SEQ + t;
    LAS unsigned* cnt = (LAS unsigned*)(lds + DSA_OFF_CNT); LAS unsigned* pc = (LAS unsigned*)(lds + DSA_OFF_PC);
    LAS unsigned short* list = (LAS unsigned short*)(lds + DSA_OFF_LIST);
    const bf16* misc = (const bf16*)(ws + WS_MISC);
    TP_DECL
    if (q0 >= 256) {
        const int ntiles = (q0 >> 4) + 1;
        const int ntl = wave < ntiles ? ((ntiles - 1 - wave) >> 3) + 1 : 0;
        const int ngrp = (ntl + 3) >> 2;
        bf16x8 qf[4][2]; float iw[4];
        { const bf16* iq = (const bf16*)(ws + WS_IQ) + (size_t)row * 256;
#pragma unroll
          for (int h = 0; h < 4; ++h) { iw[h] = 0.5f * bf2f(misc[(size_t)row * 256 + 192 + h]);
#pragma unroll
              for (int ks = 0; ks < 2; ++ks) qf[h][ks] = *(const bf16x8*)(iq + h * 64 + 8 * gq + 32 * ks); } }
        unsigned u[32][4];
#pragma unroll
        for (int T = 0; T < 32; ++T)
#pragma unroll
            for (int e = 0; e < 4; ++e) u[T][e] = 0u;
        const int kb0 = 16 * wave + 4 * gq;
        LAS unsigned char* ring = lds + DSA_OFF_V + wave * 16384;
#define DSA_ISSUE(Ti) do { _Pragma("unroll") for (int i_ = 0; i_ < 2; ++i_) { const int r_ = 8 * i_ + (lane >> 3); int kr_ = 16 * wave + 128 * (Ti) + r_; kr_ = kr_ > SEQ - 1 ? SEQ - 1 : kr_; \
            __builtin_amdgcn_global_load_lds((const unsigned*)(misc + (size_t)(b * SEQ + kr_) * 256 + (((lane & 7) ^ (r_ & 7)) << 3)), (LAS unsigned*)(ring + ((Ti) & 7) * 2048 + i_ * 1024), 16, 0, 0); } } while (0)
        if (ngrp > 0) {
#pragma unroll
            for (int T = 0; T < 8; ++T) DSA_ISSUE(T);
        }
        DSA_FOR_TILES(
            asm volatile("s_waitcnt vmcnt(14)" ::: "memory");
            const LAS unsigned char* tp = ring + (T & 7) * 2048 + j * 128;
            const bf16x8 kf0 = *(const LAS bf16x8*)(tp + ((gq ^ (j & 7)) << 4)); const bf16x8 kf1 = *(const LAS bf16x8*)(tp + (((gq + 4) ^ (j & 7)) << 4));
            asm volatile("s_waitcnt lgkmcnt(0)" ::: "memory");
            DSA_ISSUE(T + 8);
            float sc[4] = {0.f, 0.f, 0.f, 0.f};
            _Pragma("unroll") for (int h = 0; h < 4; ++h) {
                f32x4v a = {0.f, 0.f, 0.f, 0.f};
                a = __builtin_amdgcn_mfma_f32_16x16x32_bf16(kf0, qf[h][0], a, 0, 0, 0);
                a = __builtin_amdgcn_mfma_f32_16x16x32_bf16(kf1, qf[h][1], a, 0, 0, 0);
                _Pragma("unroll") for (int e = 0; e < 4; ++e) { const int ai_ = (int)__float_as_uint(a[e]); sc[e] += iw[h] * __uint_as_float((unsigned)(ai_ > 0 ? ai_ : 0)); }
                asm volatile("" : "+v"(sc[0]), "+v"(sc[1]), "+v"(sc[2]), "+v"(sc[3]));
            }
            _Pragma("unroll") for (int e = 0; e < 4; ++e) { unsigned x = f2o(sc[e]); asm volatile("" : "+v"(x)); u[T][e] = (kb0 + 128 * T + e <= t) ? x : 0u; }
        )
        asm volatile("s_waitcnt vmcnt(0)" ::: "memory");
#undef DSA_ISSUE
        TP_MARK(0);
        unsigned prefix = 0u; bool exact = false; int par = 0; int cab = 0;
        LAS unsigned* lcnt = (LAS unsigned*)(lds + DSA_OFF_V); LAS unsigned* lcab = lcnt + 16; LAS unsigned* lvst = lcnt + 32; LAS unsigned* lexf = lcnt + 48; LAS unsigned* llist = lcnt + 64;
        if (tid < 16) lcnt[tid] = 0u;
#pragma unroll 1
        for (int bit = 31; bit >= DSA_S; --bit) {
            const unsigned cand = prefix | (1u << bit); int c0 = 0, c1 = 0;
            DSA_FOR_TILES(cnt_ge(c0, u[T][0], cand); cnt_ge(c1, u[T][1], cand); cnt_ge(c0, u[T][2], cand); cnt_ge(c1, u[T][3], cand);)
            const int tot = dsa_total(cnt, par, wave, j, gq, c0 + c1); par ^= 1;
            if (tot >= 256) prefix = cand; else cab = tot;
        }
        TP_MARK(1);
        { const unsigned ptop = prefix >> DSA_S;
          DSA_FOR_TILES(unsigned pos_[4]; bool cd_[4];
              _Pragma("unroll") for (int e = 0; e < 4; ++e) { const unsigned x = u[T][e]; cd_[e] = x != 0u && (x >> DSA_S) == ptop; pos_[e] = DSA_CAP; }
              _Pragma("unroll") for (int e = 0; e < 4; ++e) if (cd_[e]) pos_[e] = __hip_atomic_fetch_add(&lcnt[j], 1u, __ATOMIC_RELAXED, __HIP_MEMORY_SCOPE_WORKGROUP);
              _Pragma("unroll") for (int e = 0; e < 4; ++e) if (pos_[e] < DSA_CAP) llist[j * DSA_CAP + pos_[e]] = u[T][e];)
          if (wave == 0 && gq == 0) lcab[j] = (unsigned)cab; }
        __syncthreads();
        const bool ovf = __any(lcnt[j] > (unsigned)DSA_CAP);
        TP_ADD(14, ovf ? 1 : 0); TP_ADD(15, 1);
        if (!ovf) {
#pragma unroll 1
            for (int qq = 0; qq < 2; ++qq) {
                const int q = 2 * wave + qq; const int n = (int)lcnt[q]; const int r = 256 - (int)lcab[q];
                unsigned ev[DSA_CAP / 64];
#pragma unroll
                for (int i = 0; i < DSA_CAP / 64; ++i) ev[i] = (lane + 64 * i < n) ? llist[q * DSA_CAP + lane + 64 * i] : 0u;
                unsigned p2 = (unsigned)__shfl((int)prefix, q);
#pragma unroll 1
                for (int bit = DSA_S - 1; bit >= 0; --bit) {
                    const unsigned cand = p2 | (1u << bit); int c = 0;
#pragma unroll
                    for (int i = 0; i < DSA_CAP / 64; ++i) c += __popcll(__ballot(ev[i] >= cand));
                    if (c >= r) p2 = cand;
                }
                int cf = 0;
#pragma unroll
                for (int i = 0; i < DSA_CAP / 64; ++i) cf += __popcll(__ballot(ev[i] >= p2));
                if (lane == 0) { lvst[q] = p2; lexf[q] = (cf == r) ? 1u : 0u; }
            }
            __syncthreads();
            prefix = lvst[j]; exact = lexf[j] != 0u;
        } else {
#pragma unroll 1
            for (int bit = DSA_S - 1; bit >= 0; --bit) {
                const unsigned cand = prefix | (1u << bit); int c0 = 0, c1 = 0;
                DSA_FOR_TILES(cnt_ge(c0, u[T][0], cand); cnt_ge(c1, u[T][1], cand); cnt_ge(c0, u[T][2], cand); cnt_ge(c1, u[T][3], cand);)
                const int tot = dsa_total(cnt, par, wave, j, gq, c0 + c1); par ^= 1;
                if (!exact && tot >= 256) { prefix = cand; exact = (tot == 256); }
            }
        }
        TP_MARK(2);
        const bool alle = __all(exact);
        unsigned kp = 0u;
        if (!alle) {
        DSA_FOR_TILES(_Pragma("unroll") for (int e = 0; e < 4; ++e) { const unsigned x = u[T][e]; u[T][e] = (x > prefix || (exact && x == prefix)) ? 0u : (x == prefix ? (unsigned)(1 + kb0 + 128 * T + e) : 0xFFFFFFFFu); })
            __syncthreads();
#pragma unroll 1
            for (int bit = 11; bit >= 0; --bit) {
                const unsigned cand = kp | (1u << bit); int c0 = 0, c1 = 0;
                DSA_FOR_TILES(cnt_le(c0, u[T][0], cand); cnt_le(c1, u[T][1], cand); cnt_le(c0, u[T][2], cand); cnt_le(c1, u[T][3], cand);)
                const int tot = dsa_total(cnt, par, wave, j, gq, c0 + c1); par ^= 1;
                if (tot <= 255) kp = cand;
            }
        }
        const unsigned kp1 = kp + 1u;
        int ns0 = 0, ns1 = 0;
        if (alle) { DSA_FOR_TILES(cnt_ge(ns0, u[T][0], prefix); cnt_ge(ns1, u[T][1], prefix); cnt_ge(ns0, u[T][2], prefix); cnt_ge(ns1, u[T][3], prefix);) }
        else { DSA_FOR_TILES(cnt_le(ns0, u[T][0], kp1); cnt_le(ns1, u[T][1], kp1); cnt_le(ns0, u[T][2], kp1); cnt_le(ns1, u[T][3], kp1);) }
        pc[(wave * 4 + gq) * 16 + j] = (unsigned)(ns0 + ns1);
        __syncthreads();
        int base = 0;
        { const int me = wave * 4 + gq;
#pragma unroll
          for (int i = 0; i < 31; ++i) { const int v = (int)pc[i * 16 + j]; base += (i < me) ? v : 0; } }
        if (alle) { DSA_FOR_TILES(_Pragma("unroll") for (int e = 0; e < 4; ++e) { if (u[T][e] >= prefix) { list[j * 256 + base] = (unsigned short)(kb0 + 128 * T + e); ++base; }     }) }
        else { DSA_FOR_TILES(_Pragma("unroll") for (int e = 0; e < 4; ++e) { if (u[T][e] <= kp1) { if (base < 256) list[j * 256 + base] = (unsigned short)(kb0 + 128 * T + e); ++base; } }) }
    } else {
        for (int i = tid; i < 16 * 256; i += 512) list[i] = (unsigned short)(i & 255);
    }
    __syncthreads();
    TP_MARK(3);
    {
    const int lane4_ = lane_id_v(); const int lane = lane4_, j = lane4_ & 15, gq = lane4_ >> 4;
    const bf16* kva = (const bf16*)(ws + WS_KVA);
    bf16* qa = (bf16*)(ws + WS_QA);
    LAS unsigned char* Vw = lds + DSA_OFF_V + wave * 16384;
    const unsigned vlds0 = (unsigned)(uintptr_t)(unsigned char*)Vw;
    const int tq2[2] = {q0 + 2 * wave, q0 + 2 * wave + 1};
    const int nselq[2] = {tq2[0] + 1 < 256 ? tq2[0] + 1 : 256, tq2[1] + 1 < 256 ? tq2[1] + 1 : 256};
    v4u qfq[2][2];
#pragma unroll
    for (int qq = 0; qq < 2; ++qq)
#pragma unroll
        for (int ks = 0; ks < 2; ++ks) { qfq[qq][ks] = (v4u){0u, 0u, 0u, 0u}; if (j < 8) qfq[qq][ks] = *(const v4u*)(qa + (size_t)(b * SEQ + tq2[qq]) * 512 + j * 64 + 8 * gq + 32 * ks); }
    asm volatile("s_waitcnt vmcnt(0)" : "+v"(qfq[0][0]), "+v"(qfq[0][1]), "+v"(qfq[1][0]), "+v"(qfq[1][1]) :: "memory");
    const bf16* kvb_ = kva + (size_t)b * SEQ * 128;
    const unsigned long long kvbase = ((unsigned long long)(unsigned)__builtin_amdgcn_readfirstlane((int)((unsigned long long)(uintptr_t)kvb_ >> 32)) << 32) | (unsigned long long)(unsigned)__builtin_amdgcn_readfirstlane((int)(unsigned)(uintptr_t)kvb_);
    const unsigned kofs = (unsigned)gq * 16u, vofs = 128u + (unsigned)(lane & 7) * 16u;
#define DSA_KEY(M_, st_, slot_) ((unsigned)list[(2 * wave + ((st_) >> 2)) * 256 + ((M_) ? (((slot_) < nselq[(st_) >> 2]) ? (slot_) : 0) : (slot_))])
#define DSA_ISSUEK(M_, buf_, st_) do { unsigned ky_[4]; _Pragma("unroll") for (int kt_ = 0; kt_ < 4; ++kt_) ky_[kt_] = DSA_KEY(M_, st_, 64 * ((st_) & 3) + 16 * kt_ + j) * 256u + kofs; \
        _Pragma("unroll") for (int kt_ = 0; kt_ < 4; ++kt_) { \
        asm volatile("global_load_dwordx4 %0, %1, %2" : "=v"(buf_[2 * kt_]) : "v"(ky_[kt_]), "s"(kvbase) : "memory"); asm volatile("global_load_dwordx4 %0, %1, %2 offset:64" : "=v"(buf_[2 * kt_ + 1]) : "v"(ky_[kt_]), "s"(kvbase) : "memory"); } } while (0)
#define DSA_ISSUEV(M_, st_) do { unsigned kv_[8]; _Pragma("unroll") for (int i_ = 0; i_ < 8; ++i_) kv_[i_] = DSA_KEY(M_, st_, 64 * ((st_) & 3) + 8 * i_ + (lane >> 3)) * 256u + vofs; \
        unsigned keep_; const unsigned ld_ = (unsigned)__builtin_amdgcn_readfirstlane((int)(vlds0 + ((st_) & 1) * 8192)); \
        asm volatile("s_mov_b32 %0, m0\n\ts_mov_b32 m0, %9\n\ts_nop 0\n\t" \
                     "global_load_lds_dwordx4 %1, %10\n\ts_add_u32 m0, m0, 0x400\n\ts_nop 0\n\t" "global_load_lds_dwordx4 %2, %10\n\ts_add_u32 m0, m0, 0x400\n\ts_nop 0\n\t" \
                     "global_load_lds_dwordx4 %3, %10\n\ts_add_u32 m0, m0, 0x400\n\ts_nop 0\n\t" "global_load_lds_dwordx4 %4, %10\n\ts_add_u32 m0, m0, 0x400\n\ts_nop 0\n\t" \
                     "global_load_lds_dwordx4 %5, %10\n\ts_add_u32 m0, m0, 0x400\n\ts_nop 0\n\t" "global_load_lds_dwordx4 %6, %10\n\ts_add_u32 m0, m0, 0x400\n\ts_nop 0\n\t" \
                     "global_load_lds_dwordx4 %7, %10\n\ts_add_u32 m0, m0, 0x400\n\ts_nop 0\n\t" "global_load_lds_dwordx4 %8, %10\n\ts_mov_b32 m0, %0" \
                     : "=&s"(keep_) : "v"(kv_[0]), "v"(kv_[1]), "v"(kv_[2]), "v"(kv_[3]), "v"(kv_[4]), "v"(kv_[5]), "v"(kv_[6]), "v"(kv_[7]), "s"(ld_), "s"(kvbase) : "memory", "scc"); } while (0)
#define DSA_WAITK(buf_, n_) asm volatile("s_waitcnt vmcnt(" #n_ ")" : "+v"(buf_[0]), "+v"(buf_[1]), "+v"(buf_[2]), "+v"(buf_[3]), "+v"(buf_[4]), "+v"(buf_[5]), "+v"(buf_[6]), "+v"(buf_[7]) :: "memory")
    v4u kA[8], kB[8], kC[8];
    float mrow = NEGF, lrow = 0.f; f32x4v o[4];
#define DSA_STEP(M_, st_, cur_, nx2_, NK_, NV_) do { \
        if ((st_) + 2 < 8) DSA_ISSUEK(M_, nx2_, (st_) + 2); \
        if (((st_) & 3) == 0) { mrow = NEGF; lrow = 0.f; _Pragma("unroll") for (int dt_ = 0; dt_ < 4; ++dt_) o[dt_] = (f32x4v){0.f, 0.f, 0.f, 0.f}; } \
        DSA_WAITK(cur_, NK_); \
        const bf16x8 q0_ = __builtin_bit_cast(bf16x8, qfq[(st_) >> 2][0]), q1_ = __builtin_bit_cast(bf16x8, qfq[(st_) >> 2][1]); \
        f32x4v s_[4]; float bm_ = NEGF; \
        _Pragma("unroll") for (int kt_ = 0; kt_ < 4; ++kt_) { f32x4v a_ = {0.f, 0.f, 0.f, 0.f}; \
            a_ = __builtin_amdgcn_mfma_f32_16x16x32_bf16(__builtin_bit_cast(bf16x8, cur_[2 * kt_]), q0_, a_, 0, 0, 0); a_ = __builtin_amdgcn_mfma_f32_16x16x32_bf16(__builtin_bit_cast(bf16x8, cur_[2 * kt_ + 1]), q1_, a_, 0, 0, 0); \
            _Pragma("unroll") for (int e_ = 0; e_ < 4; ++e_) { const float v_ = (!(M_) || (64 * ((st_) & 3) + 16 * kt_ + 4 * gq + e_ < nselq[(st_) >> 2])) ? a_[e_] : NEGF; a_[e_] = v_; bm_ = fmaxf(bm_, v_); } s_[kt_] = a_; } \
        bm_ = xmax16(bm_); \
        { const float mnew_ = fmaxf(mrow, bm_), alpha_ = __builtin_amdgcn_exp2f(mrow - mnew_); mrow = mnew_; float ps_ = 0.f; \
          _Pragma("unroll") for (int kt_ = 0; kt_ < 4; ++kt_) _Pragma("unroll") for (int e_ = 0; e_ < 4; ++e_) { const float p_ = __builtin_amdgcn_exp2f(s_[kt_][e_] - mnew_); s_[kt_][e_] = p_; ps_ += p_; } \
          lrow = lrow * alpha_ + ps_; _Pragma("unroll") for (int dt_ = 0; dt_ < 4; ++dt_) o[dt_] *= alpha_; } \
        asm volatile("s_waitcnt vmcnt(" #NV_ ")" : "+v"(s_[0]), "+v"(s_[1]), "+v"(s_[2]), "+v"(s_[3]) :: "memory");       \
        { const LAS unsigned char* Vb_ = Vw + ((st_) & 1) * 8192; \
        _Pragma("unroll") for (int kk_ = 0; kk_ < 2; ++kk_) { \
            const bf16x8 pf_ = pack8(s_[2 * kk_][0], s_[2 * kk_][1], s_[2 * kk_][2], s_[2 * kk_][3], s_[2 * kk_ + 1][0], s_[2 * kk_ + 1][1], s_[2 * kk_ + 1][2], s_[2 * kk_ + 1][3]); \
            _Pragma("unroll") for (int dt_ = 0; dt_ < 4; ++dt_) { const LAS unsigned char* va_ = Vb_ + (32 * kk_ + 4 * gq + (j >> 2)) * 128 + (16 * dt_ + 4 * (j & 3)) * 2; \
                o[dt_] = __builtin_amdgcn_mfma_f32_16x16x32_bf16(cat4(tr16(va_), tr16(va_ + 16 * 128)), pf_, o[dt_], 0, 0, 0); } } } \
        if (((st_) & 3) == 3) { const float inv_ = __builtin_amdgcn_rcpf(xsum16(lrow)); const int rowq_ = b * SEQ + tq2[(st_) >> 2]; \
            if (j < 8) { _Pragma("unroll") for (int dt_ = 0; dt_ < 4; ++dt_) { uint2 w_; w_.x = cvtpk(o[dt_][0] * inv_, o[dt_][1] * inv_); w_.y = cvtpk(o[dt_][2] * inv_, o[dt_][3] * inv_); \
                *(uint2*)(yout + (size_t)rowq_ * 512 + j * 64 + 16 * dt_ + 4 * gq) = w_; } } } \
        if ((st_) + 2 < 8) { asm volatile("s_waitcnt lgkmcnt(0)" ::: "memory"); DSA_ISSUEV(M_, (st_) + 2); } \
    } while (0)
#define DSA_RUN(M_) do { DSA_ISSUEK(M_, kA, 0); DSA_ISSUEV(M_, 0); DSA_ISSUEK(M_, kB, 1); DSA_ISSUEV(M_, 1); \
    DSA_STEP(M_, 0, kA, kC, 32, 24); DSA_STEP(M_, 1, kB, kA, 32, 24); DSA_STEP(M_, 2, kC, kB, 32, 24); DSA_STEP(M_, 3, kA, kC, 32, 24); \
    DSA_STEP(M_, 4, kB, kA, 32, 24); DSA_STEP(M_, 5, kC, kB, 32, 24); DSA_STEP(M_, 6, kA, kC, 24, 16); DSA_STEP(M_, 7, kB, kA, 8, 0); } while (0)
    if (q0 >= 256) DSA_RUN(0); else DSA_RUN(1);
#if DUP == 20
    if (q0 >= 256) DSA_RUN(0); else DSA_RUN(1);
#endif
#undef DSA_RUN
#undef DSA_STEP
#undef DSA_ISSUEK
#undef DSA_ISSUEV
#undef DSA_WAITK
#undef DSA_KEY
    }
    __syncthreads();
    TP_MARK(4);
}
__device__ __forceinline__ void phase_mixers(const Args& P, unsigned char* ws, int z, LAS unsigned char* lds, int gw, int NGW, int lane, int wave, int bid, int G, int l) {
    asm volatile("" : "+v"(lane)); lane &= 63; asm volatile("" : "+s"(gw), "+s"(NGW));
    unsigned* qc = (unsigned*)(ws + WS_CTL) + 9216 + l * 8;
    volatile LAS unsigned* bw = (volatile LAS unsigned*)(lds + LDSCTL_OFF) + 40;
    const bool lead = (wave == 0) && (lane == 0);
    int qid = (int)(xb_xcc_id() & 7u), tries = 0;
#define MIX_BCAST(v_) ({ if (lead) *bw = (unsigned)(v_); __syncthreads(); const int r_ = (int)*bw; __syncthreads(); __builtin_amdgcn_readfirstlane(r_); })
    int nx = 0; if (lead) nx = (int)__hip_atomic_fetch_add(qc + qid, 1u, __ATOMIC_RELAXED, __HIP_MEMORY_SCOPE_AGENT);
    int cur = MIX_BCAST(nx);
    for (;;) {
        while (cur >= 384) { if (++tries == 8) break; qid = (qid + 1) & 7; nx = 0; if (lead) nx = (int)__hip_atomic_fetch_add(qc + qid, 1u, __ATOMIC_RELAXED, __HIP_MEMORY_SCOPE_AGENT); cur = MIX_BCAST(nx); }
        if (cur >= 384) break;
        nx = 0; if (lead) nx = (int)__hip_atomic_fetch_add(qc + qid, 1u, __ATOMIC_RELAXED, __HIP_MEMORY_SCOPE_AGENT);
        const int t3 = cur / 3;
        if (cur - 3 * t3 == 0) { const int n = t3, unit = (qid * 2 + (n & 1)) * 64 + (63 - (n >> 1)); nsa_unit(ws, unit, lds, (wave << 6) | lane_id_v(), (bf16*)(ws + WS_QC)); }
        else { const int d = cur - t3 - 1, unit = qid * 256 + (255 - d); dsa_unit(ws, unit, lds, (wave << 6) | lane_id_v(), (bf16*)(ws + WS_QA)); }
        cur = MIX_BCAST(nx);
    }
#undef MIX_BCAST
}
__global__ void __launch_bounds__(NWAVES * 64, 2) fwd_kernel(Args args) {
    extern __shared__ __attribute__((aligned(16))) unsigned char lds_raw[];
    LAS unsigned char* lds = (LAS unsigned char*)lds_raw;
    const int wave = __builtin_amdgcn_readfirstlane((int)threadIdx.x >> 6);
#define TIDX ((wave << 6) | lane_id_v())
#define tid TIDX
#define lane TIDX
    const int G = gridDim.x, bid = blockIdx.x;
    const int gw = bid * NWAVES + wave, NGW = G * NWAVES;
    const int lo = args.ph_lo, hi = args.ph_hi;
    const Args& P = args;
    int z = 0; asm volatile("" : "+s"(z));
    unsigned char* ws = args.ws + z;
    volatile LAS unsigned* MISCW = (volatile LAS unsigned*)(lds + LDSCTL_OFF);
    if (tid < 64) MISCW[tid] = 0u;
    __syncthreads();
    XcdBarrier bar; bar.bar = (unsigned*)(ws + WS_CTL) + 4096; bar.x = 0; bar.st = nullptr;
    if (hi - lo > 1) bar = xcd_barrier_post((unsigned*)(ws + WS_CTL) + 4096, MISCW + 8);
#define RUN(k) (lo <= (k) && (k) < hi)
#if TPROBE
#define TP_PHASE(k) do { if (bid == 0 && TIDX == 0) { volatile unsigned long long* sl_ = (volatile unsigned long long*)(args.ws + z + 32768); const unsigned long long n_ = __builtin_amdgcn_s_memtime(); const int cls_ = (k) == 0 ? 0 : 1 + (((k) - 1) % NPL); sl_[16 + cls_] += n_ - sl_[30]; sl_[30] = n_; } } while (0)
#else
#define TP_PHASE(k)
#endif
#define SEAM(k) do { TP_PHASE(k); if ((k) + 1 < hi) { XcdBarrier b2_ = bar; asm volatile("" : "+s"(b2_.bar), "+s"(b2_.x)); xcd_barrier(b2_); if (DUP == 13) xcd_barrier(b2_); } else { VM_WAIT(); __syncthreads(); } } while (0)


#if TPROBE
    if (bid == 0 && TIDX == 0) { volatile unsigned long long* sl_ = (volatile unsigned long long*)(args.ws + z + 32768); sl_[30] = __builtin_amdgcn_s_memtime(); }
#endif
    if (RUN(0)) { phase_rope(P, ws, z, bid * (NWAVES * 64) + tid, G * NWAVES * 64);
        { int ln_ = TIDX; asm volatile("" : "+v"(ln_)); ln_ &= 63;
          for (int m = gw; m < M; m += 4 * NGW) stat_rows4_bf16(P.in[0 + z], (bf16*)(ws + WS_XN), (float*)(ws + WS_SSQ), m, NGW, ln_); }
        if (!RUN(1)) SEAM(0); }
#define RS_PREPASS(Sref) do { const float* ssq_ = (const float*)(ws + WS_SSQ); LAS float* rsl_ = (LAS float*)(lds + RS_OFF); const int t_ = TIDX; pg8::Unit u_; \
        for (int i_ = 0; (Sref).next(i_, u_); ++i_) { const f32x4* p_ = (const f32x4*)(ssq_ + (size_t)(u_.pm * 256 + (t_ >> 1)) * 16 + (t_ & 1) * 8); const f32x4 a_ = p_[0], b_ = p_[1]; \
            float s_ = (a_.x + a_.y) + (a_.z + a_.w) + (b_.x + b_.y) + (b_.z + b_.w); s_ += __shfl_xor(s_, 1); if ((t_ & 1) == 0) rsl_[i_ * 256 + (t_ >> 1)] = 1.0f / sqrtf(s_ * (1.f / DM) + EPS); } \
        __syncthreads(); } while (0)

    for (int it = 0; it < 2 * DEPTH; ++it) {
        const int l = it >> 1, second = it & 1, pb = 1 + l * NPL + (second ? 7 : 0);
        asm volatile("" : "+s"(z));
        ws = args.ws + z;
        bf16* const XN = (bf16*)(ws + WS_XN);
        bf16* const HB = (bf16*)(ws + WS_H);
        bf16* const MG = (bf16*)(ws + WS_MG);
        bf16* const GB = (bf16*)(ws + WS_G);
        unsigned char* const wb = ws + WS_W;
        float* const OUT = P.out + z;
        if (!second && RUN(pb)) { phase_convert(P, ws, z, l, lds, gw, NGW, lane, wave);
#if DUP == 30
            phase_convert(P, ws, z, l, lds, gw, NGW, lane, wave);
#endif
            SEAM(pb); }
        if (RUN(pb + 1)) {
            pg8::Gemm g{XN, (const bf16*)(wb + (second ? WO_GU2 : WO_GU1)), M, 2 * FF, DM}; pg8::StaticOrder S; S.init(M, 2 * FF, G, bid + z);
            pg8::EpiSwiglu E{HB, FF, (const LAS float*)(lds + RS_OFF)};
            RS_PREPASS(S);
#if !defined(SITE_MASK) || ((SITE_MASK >> 0) & 1)
            pg8::gemm_phase<pg8::EpiSwiglu, pg8::StaticOrder, ALIGN_UP, true>(lds, g, S, E, TIDX);
#if DUP == 3
            pg8::gemm_phase<pg8::EpiSwiglu, pg8::StaticOrder, ALIGN_UP, true>(lds, g, S, E, TIDX);
#endif
#endif
            SEAM(pb + 1);
        }
        if (RUN(pb + 2)) {
            pg8::Gemm g{HB, (const bf16*)(wb + (second ? WO_D2 : WO_D1)), M, DM, FF}; pg8::StaticOrder S; S.init(M, DM, G, bid + z);
            pg8::EpiResid E{XN, 0.5f, (float*)(ws + WS_SSQ)};
#if !defined(SITE_MASK) || ((SITE_MASK >> 1) & 1)
            pg8::gemm_phase<pg8::EpiResid, pg8::StaticOrder, true, true>(lds, g, S, E, TIDX);
#endif
            SEAM(pb + 2);
        }
        if (second) continue;
        const int pm = 1 + l * NPL + 2;
        if (RUN(pm + 1)) {
            pg8::Gemm g{XN, (const bf16*)(wb + WO_IN), M, NINP, DM}; pg8::StaticOrder S; S.init(M, NINP, G, bid + z);
            pg8::EpiWin E{(bf16*)(ws + WS_QA), (bf16*)(ws + WS_QC), (bf16*)(ws + WS_IQ), (bf16*)(ws + WS_MISC), (bf16*)(ws + WS_KVC), (bf16*)(ws + WS_KVS), (bf16*)(ws + WS_KVW), (bf16*)(ws + WS_BU), GB,
                          (const float*)(ws + WS_ROPE), (const LAS float*)(lds + RS_OFF)};
            RS_PREPASS(S);
#if !defined(SITE_MASK) || ((SITE_MASK >> 2) & 1)
            pg8::gemm_phase<pg8::EpiWin, pg8::StaticOrder, ALIGN_WIN, true>(lds, g, S, E, TIDX);
#if DUP == 4
            pg8::gemm_phase<pg8::EpiWin, pg8::StaticOrder, ALIGN_WIN, true>(lds, g, S, E, TIDX);
#endif
#endif
            SEAM(pm + 1);
        }
        #ifndef NO_PREP
        if (RUN(pm + 2)) { phase_prep(P, ws, z, l, lds, gw, NGW, lane, wave, (bf16*)OUT);
#if DUP == 1
            { XcdBarrier b2_ = bar; asm volatile("" : "+s"(b2_.bar), "+s"(b2_.x)); xcd_barrier(b2_); } phase_prep(P, ws, z, l, lds, gw, NGW, lane, wave, (bf16*)OUT);
#endif
            SEAM(pm + 2); }
#endif
        #ifndef NO_MIX
        if (RUN(pm + 3)) {
#if TPROBE
            unsigned long long tm0_ = __builtin_amdgcn_s_memtime();
#endif
            phase_mixers(P, ws, z, lds, gw, NGW, lane, wave, bid, G, l);
#if TPROBE
            { const unsigned long long tm1_ = __builtin_amdgcn_s_memtime(); if (TIDX == 0) { atomicAdd((unsigned long long*)(args.ws + z + 32768) + 12, tm1_ - tm0_); atomicMax((unsigned long long*)(args.ws + z + 32768) + 13 + (l & 1), tm1_ - tm0_); } }
#endif
            SEAM(pm + 3); }
#endif
        if (RUN(pm + 4)) {
#if DUP == 5
          for (int rep_ = 0; rep_ < 2; ++rep_) {
#endif
            pg8::StaticOrder S; S.init(M, DM, G, bid + z);
            { pg8::Gemm g{(const bf16*)(ws + WS_QA), (const bf16*)(wb + WO_PA), M, DM, 512}; pg8::EpiProj<0> E{MG, GB, 0};
#if !defined(SITE_MASK) || ((SITE_MASK >> 3) & 1)
              pg8::gemm_phase<pg8::EpiProj<0>, pg8::StaticOrder, true, true>(lds, g, S, E, TIDX);
#endif
            }
            { pg8::Gemm g{(const bf16*)OUT, (const bf16*)(wb + WO_PB), M, DM, 512}; pg8::EpiProj<1> E{MG, GB, 1024};
#if !defined(SITE_MASK) || ((SITE_MASK >> 4) & 1)
              pg8::gemm_phase<pg8::EpiProj<1>, pg8::StaticOrder, true, true>(lds, g, S, E, TIDX);
#endif
            }
            { pg8::Gemm g{(const bf16*)(ws + WS_QC), (const bf16*)(wb + WO_PC), M, DM, 512}; pg8::EpiProj<1> E{MG, GB, 2048};
#if !defined(SITE_MASK) || ((SITE_MASK >> 5) & 1)
              pg8::gemm_phase<pg8::EpiProj<1>, pg8::StaticOrder, true, true>(lds, g, S, E, TIDX);
#endif
            }
#if DUP == 5
          }
#endif
#if DUP == 31
            { pg8::Gemm g{(const bf16*)(ws + WS_QC), (const bf16*)(wb + WO_PC), M, DM, 512}; pg8::EpiPlain E{(bf16*)OUT + (size_t)32 * 1024 * 1024 / 2};
              pg8::gemm_phase<pg8::EpiPlain, pg8::StaticOrder, true, true>(lds, g, S, E, TIDX); }
#endif
            SEAM(pm + 4);
        }
        if (RUN(pm + 5)) {
            pg8::Gemm g{MG, (const bf16*)(wb + WO_OUT), M, DM, DM}; pg8::StaticOrder S; S.init(M, DM, G, bid + z);
            pg8::EpiResid E{XN, 1.0f, (float*)(ws + WS_SSQ)};
#if !defined(SITE_MASK) || ((SITE_MASK >> 6) & 1)
            pg8::gemm_phase<pg8::EpiResid, pg8::StaticOrder, true, true>(lds, g, S, E, TIDX);
#endif
            SEAM(pm + 5);
        }
    }
    if (RUN(NPH - 1)) { asm volatile("" : "+s"(z)); int ln_ = TIDX; asm volatile("" : "+v"(ln_)); ln_ &= 63; float* o_ = P.out + z; float tps_ = 1.0f;
#if TPROBE
        { const unsigned long long* sl_ = (const unsigned long long*)(P.ws + z + 32768); double a_ = 0., b_ = 0.; for (int k = 0; k < 32; ++k) { const double v_ = (double)__hip_atomic_load(sl_ + k, __ATOMIC_RELAXED, __HIP_MEMORY_SCOPE_AGENT); if (((unsigned)TP_A >> k) & 1) a_ += v_; if (((unsigned)TP_B >> k) & 1) b_ += v_; } tps_ = 1.0f + floorf((float)(a_ / b_) * TP_SCALE * 20.0f + 0.5f) * 0.05f; }
#endif
        { const bf16* xr_ = (const bf16*)(args.ws + z + WS_XN); for (int m = gw; m < M; m += 4 * NGW) norm_rows4_out(xr_, o_, P.in[23 + z], m, NGW, ln_, tps_); }
#if TPROBE
        if (gw == 0 && ln_ == 0) { const unsigned long long* sl_ = (const unsigned long long*)(P.ws + z + 32768); double c_ = 0., d_ = 0.; for (int k = 0; k < 32; ++k) { const double v_ = (double)__hip_atomic_load(sl_ + k, __ATOMIC_RELAXED, __HIP_MEMORY_SCOPE_AGENT); if (((unsigned)TP_C >> k) & 1) c_ += v_; if (((unsigned)TP_D >> k) & 1) d_ += v_; } o_[0] = 1000.0f * floorf((float)(c_ / d_) * TP_SCALE2 * 20.0f + 0.5f) * 0.05f; }
#endif
    }
#undef RUN
#undef tid
#undef TIDX
#undef lane
#undef SEAM
}

extern "C" void kernel_launch(void* const* d_in, const int* in_sizes, int n_in, void* d_out, int out_size, void* d_ws, size_t ws_size, hipStream_t stream) {
    static int grid = 0;
    if (grid == 0) {
        if (n_in != 24 || out_size != M * DM || ws_size < WS_END) { fprintf(stderr, "kernel_launch: unexpected shapes (n_in %d out %d ws %zu)\n", n_in, out_size, ws_size); grid = -1; return; }
        int dev = 0, cus = 0, per_cu = 0;
        if (hipGetDevice(&dev) != hipSuccess || hipDeviceGetAttribute(&cus, hipDeviceAttributeMultiprocessorCount, dev) != hipSuccess) { grid = -1; return; }
        if (hipFuncSetAttribute((const void*)fwd_kernel, hipFuncAttributeMaxDynamicSharedMemorySize, LDS_BYTES) != hipSuccess) { fprintf(stderr, "kernel_launch: hipFuncSetAttribute failed\n"); grid = -1; return; }
        if (hipOccupancyMaxActiveBlocksPerMultiprocessor(&per_cu, (const void*)fwd_kernel, NWAVES * 64, LDS_BYTES) != hipSuccess || per_cu < 1) { fprintf(stderr, "kernel_launch: occupancy query says %d\n", per_cu); }
        (void)hipGetLastError();
        grid = cus;
    }
    if (grid < 0) return;
    (void)hipMemsetAsync((char*)d_ws + WS_CTL, 0, CTL_ZERO_BYTES, stream);
    Args a{};
    for (int i = 0; i < 24; ++i) a.in[i] = (const float*)d_in[i];
    a.out = (float*)d_out; a.ws = (unsigned char*)d_ws;
#if MK_ONE_LAUNCH
    a.ph_lo = 0; a.ph_hi = NPH;
    hipLaunchKernelGGL(fwd_kernel, dim3(grid), dim3(NWAVES * 64), LDS_BYTES, stream, a);
#else
    for (int ph = 0; ph < NPH; ++ph) { a.ph_lo = ph; a.ph_hi = ph + 1; hipLaunchKernelGGL(fwd_kernel, dim3(grid), dim3(NWAVES * 64), LDS_BYTES, stream, a); }
#endif
}
```

```cpp
#include <hip/hip_runtime.h>
#include <cstdio>
#include <cstdint>
#define PROBE 0
#define PROBE_GAIN 10.0f
#define TOP8_RANK 1
#define PROBE_ROWTHR 0.01f
#define PROBE_ROWCOND 1
#define PROBE_BR -1
#define FIXHOM 0
#define DUP 0
#define TPROBE 0
#define TP_A 1
#define TP_B 1
#define TP_SCALE 1.0f
#define TP_C 1
#define TP_D 1
#define TP_SCALE2 1.0f
#define POOLDBG 0
#define YB_SPARE 0
#define ALIGN_UP true
#define ALIGN_WIN true
#define DSA_CAP_V 512
#define DSA_K_V 13
#ifndef MK_ONE_LAUNCH
#define MK_ONE_LAUNCH 1
#endif
namespace pg8 {
#define PG8_LAS __attribute__((address_space(3)))
typedef unsigned short bf16_t;
typedef short bf16x8 __attribute__((ext_vector_type(8)));
typedef float f32x4 __attribute__((ext_vector_type(4)));
typedef unsigned u32x4 __attribute__((ext_vector_type(4)));
constexpr int BM = 256, BK = 64, HALF = 128, HTB = HALF * BK * 2  , STAGE_BYTES = 8 * HTB, NXCD = 8, WGM = 8;

__host__ __device__ __forceinline__ int lds_byte(int r, int c) { const int st = (r >> 4) * 2 + (c >> 5), rr = r & 15, cc = c & 31, ob = rr * 64 + cc * 2; return st * 1024 + (ob ^ (((ob >> 9) & 1) << 5)); }
__host__ __device__ __forceinline__ void stage_rc(int b, int& R, int& C) { const int st = b / 1024, sb = b % 1024, swz = sb ^ (((sb >> 9) & 1) << 5); R = (st >> 1) * 16 + swz / 64; C = (st & 1) * 32 + (swz % 64) / 2; }
__host__ __device__ __forceinline__ int perm32(int rho) { const int n = rho >> 4, i = rho & 15; return 8 * (i >> 2) + 4 * n + (i & 3); }

struct Unit { int pm, pn, ord; };
struct Gemm { const bf16_t* A; const bf16_t* Bt; int M, N, K; };

struct StaticOrder {
    int nM, nN, nwg, G, c;
    __host__ __device__ __forceinline__ void init(int M, int N, int G_, int c_) { nM = M / BM; nN = N / BM; nwg = nM * nN; G = G_; c = c_; }
    __host__ __device__ __forceinline__ bool next(int i, Unit& u) const {
        const long L = (long)i * G + c; if (L >= nwg) return false;
        int wgid = (int)L; { const int q = nwg / NXCD, r = nwg % NXCD, xcd = wgid % NXCD, off = wgid / NXCD; wgid = (xcd < r ? xcd * (q + 1) : r * (q + 1) + (xcd - r) * q) + off; }
        const int nig = WGM * nN, gid = wgid / nig, fm = gid * WGM, gsz = (nM - fm) < WGM ? (nM - fm) : WGM;
        u.pm = fm + ((wgid % nig) % gsz); u.pn = (wgid % nig) / gsz; u.ord = i; return true;
    }
    __device__ __forceinline__ void a_ready(const Unit&) const {}
    __device__ __forceinline__ void done(const Unit&) const {}
};

__device__ __forceinline__ unsigned cvt_pk_bf16(float lo, float hi) { unsigned r; asm volatile("v_cvt_pk_bf16_f32 %0, %1, %2" : "=v"(r) : "v"(lo), "v"(hi)); return r; }
__device__ __forceinline__ float bflo(unsigned w) { return __uint_as_float(w << 16); }
__device__ __forceinline__ float bfhi(unsigned w) { return __uint_as_float(w & 0xffff0000u); }
__device__ __forceinline__ float fast_sigmoid(float x) { return __builtin_amdgcn_rcpf(1.0f + __expf(-x)); }

struct EpiSwiglu {
    static constexpr bool PERM = true, AFTER_DRAIN = false;
    bf16_t* H; int ldh; const PG8_LAS float* rs;
    __device__ __forceinline__ void operator()(const f32x4 (&acc)[2][2][4][2], const Unit& u, int wr, int wc, int fr, int fq) const {
        const int row0 = u.pm * BM + wr * 64 + fr, col0 = u.pn * HALF + wc * 32 + 8 * fq;
#pragma unroll
        for (int ai = 0; ai < 2; ++ai)
#pragma unroll
            for (int m = 0; m < 4; ++m) {
                bf16_t* rowp = H + (size_t)(row0 + ai * HALF + m * 16) * ldh + col0;
                const float r = rs[u.ord * 256 + wr * 64 + fr + ai * HALF + m * 16];
                float o[8];
#pragma unroll
                for (int n = 0; n < 2; ++n)
#pragma unroll
                    for (int e = 0; e < 4; ++e) { const float g = acc[ai][0][m][n][e] * r, up = acc[ai][1][m][n][e] * r; o[n * 4 + e] = g * fast_sigmoid(g) * up; }
                u32x4 w; w.x = cvt_pk_bf16(o[0], o[1]); w.y = cvt_pk_bf16(o[2], o[3]); w.z = cvt_pk_bf16(o[4], o[5]); w.w = cvt_pk_bf16(o[6], o[7]);
                *(u32x4*)rowp = w;
            }
    }
};
struct EpiResid {
    static constexpr bool PERM = true, AFTER_DRAIN = false;
    bf16_t* xb; float s; float* ssq;
    __device__ __forceinline__ void operator()(const f32x4 (&acc)[2][2][4][2], const Unit& u, int wr, int wc, int fr, int fq) const {
        const int row0 = u.pm * BM + wr * 64 + fr, col0 = u.pn * BM + wc * 32 + 8 * fq;
#pragma unroll
        for (int ai = 0; ai < 2; ++ai) {
            u32x4 bv[4][2];
#pragma unroll
            for (int m = 0; m < 4; ++m)
#pragma unroll
                for (int bj = 0; bj < 2; ++bj) bv[m][bj] = *(const u32x4*)(xb + (size_t)(row0 + ai * HALF + m * 16) * 1024 + col0 + bj * HALF);
#pragma unroll
            for (int m = 0; m < 4; ++m) {
                const size_t off = (size_t)(row0 + ai * HALF + m * 16) * 1024 + col0;
                float q = 0.f;
#pragma unroll
                for (int bj = 0; bj < 2; ++bj) {
                    const u32x4 b = bv[m][bj];
                    const f32x4 b0 = {bflo(b.x), bfhi(b.x), bflo(b.y), bfhi(b.y)}, b1 = {bflo(b.z), bfhi(b.z), bflo(b.w), bfhi(b.w)};
                    const f32x4 x0 = b0 + acc[ai][bj][m][0] * s, x1 = b1 + acc[ai][bj][m][1] * s;
                    q += (x0[0] * x0[0] + x0[1] * x0[1]) + (x0[2] * x0[2] + x0[3] * x0[3]) + (x1[0] * x1[0] + x1[1] * x1[1]) + (x1[2] * x1[2] + x1[3] * x1[3]);
                    u32x4 w; w.x = cvt_pk_bf16(x0[0], x0[1]); w.y = cvt_pk_bf16(x0[2], x0[3]); w.z = cvt_pk_bf16(x1[0], x1[1]); w.w = cvt_pk_bf16(x1[2], x1[3]);
                    *(u32x4*)(xb + off + bj * HALF) = w;
                }
                q += __shfl_xor(q, 16); q += __shfl_xor(q, 32);
                if (fq == 0) ssq[(size_t)(row0 + ai * HALF + m * 16) * 16 + u.pn * 4 + wc] = q;
            }
        }
    }
};
template <int MODE> struct EpiProj {
    static constexpr bool PERM = true, AFTER_DRAIN = false;
    bf16_t* MG; const bf16_t* G; int gofs;
    __device__ __forceinline__ void operator()(const f32x4 (&acc)[2][2][4][2], const Unit& u, int wr, int wc, int fr, int fq) const {
        const int row0 = u.pm * BM + wr * 64 + fr, col0 = u.pn * BM + wc * 32 + 8 * fq;
#pragma unroll
        for (int ai = 0; ai < 2; ++ai) {
            u32x4 gv[8], ov[8];
#pragma unroll
            for (int q = 0; q < 8; ++q) { const int m = q >> 1, bj = q & 1; const size_t row = (size_t)(row0 + ai * HALF + m * 16);
                gv[q] = *(const u32x4*)(G + row * 3072 + gofs + col0 + bj * HALF); if (MODE) ov[q] = *(const u32x4*)(MG + row * 1024 + col0 + bj * HALF); }
#pragma unroll
            for (int q = 0; q < 8; ++q) { const int m = q >> 1, bj = q & 1; const size_t row = (size_t)(row0 + ai * HALF + m * 16);
                bf16_t* mp = MG + row * 1024 + col0 + bj * HALF;
                const f32x4 a0 = acc[ai][bj][m][0], a1 = acc[ai][bj][m][1];
                float o[8] = {bflo(gv[q].x) * a0[0], bfhi(gv[q].x) * a0[1], bflo(gv[q].y) * a0[2], bfhi(gv[q].y) * a0[3], bflo(gv[q].z) * a1[0], bfhi(gv[q].z) * a1[1], bflo(gv[q].w) * a1[2], bfhi(gv[q].w) * a1[3]};
                if (MODE) { o[0] += bflo(ov[q].x); o[1] += bfhi(ov[q].x); o[2] += bflo(ov[q].y); o[3] += bfhi(ov[q].y); o[4] += bflo(ov[q].z); o[5] += bfhi(ov[q].z); o[6] += bflo(ov[q].w); o[7] += bfhi(ov[q].w); }
                u32x4 w; w.x = cvt_pk_bf16(o[0], o[1]); w.y = cvt_pk_bf16(o[2], o[3]); w.z = cvt_pk_bf16(o[4], o[5]); w.w = cvt_pk_bf16(o[6], o[7]);
                *(u32x4*)mp = w;
            }
        }
    }
};
struct EpiWin {
    static constexpr bool PERM = true, AFTER_DRAIN = false;
    bf16_t *QA, *QC, *IQ, *MISC, *KVC, *KVS, *KVW, *BU, *G; const float* rope; const PG8_LAS float* rs;
    __device__ __forceinline__ void operator()(const f32x4 (&acc)[2][2][4][2], const Unit& u, int wr, int wc, int fr, int fq) const {
        const int pn = u.pn;
        bf16_t* dst; int ld, cbase, mode;
        if (pn < 2) { dst = QA; ld = 512; cbase = pn * 256; mode = 1; }
        else if (pn < 4) { dst = QC; ld = 512; cbase = (pn - 2) * 256; mode = 1; }
        else if (pn == 4) { dst = IQ; ld = 256; cbase = 0; mode = 1; }
        else if (pn == 5) { dst = MISC; ld = 256; cbase = 0; mode = 3; }
        else if (pn <= 8) { dst = pn == 6 ? KVC : (pn == 7 ? KVS : KVW); ld = 256; cbase = 0; mode = 2; }
        else if (pn <= 10) { dst = BU; ld = 512; cbase = (pn - 9) * 256; mode = 0; }
        else { dst = G; ld = 3072; cbase = (pn - 11) * 256; mode = 4; }
        const int row0 = u.pm * BM + wr * 64 + fr, col0 = cbase + wc * 32 + 8 * fq;
        const bool ropelane = ((wc & 1) == 0) && fq < 2;
        const float sc = (mode == 1) ? (pn < 4 ? 0.125f * 1.4426950408889634f : 0.125f) : 1.0f;
#pragma unroll
        for (int ai = 0; ai < 2; ++ai) {
            f32x4 csv[4], snv[4];
#pragma unroll
            for (int m = 0; m < 4; ++m) { csv[m] = (f32x4){1.f, 1.f, 1.f, 1.f}; snv[m] = (f32x4){0.f, 0.f, 0.f, 0.f}; }
            if (mode >= 1 && mode <= 3) {
#pragma unroll
                for (int m = 0; m < 4; ++m) { const float* rp = rope + (size_t)(row0 + ai * HALF + m * 16) * 16 + 4 * (fq & 1); csv[m] = *(const f32x4*)rp; snv[m] = *(const f32x4*)(rp + 8); }
            }
#pragma unroll
            for (int m = 0; m < 4; ++m) {
                const size_t row = (size_t)(row0 + ai * HALF + m * 16);
                const float rr = rs[u.ord * 256 + wr * 64 + fr + ai * HALF + m * 16];
                const f32x4 cs = csv[m], sn = snv[m];
#pragma unroll
                for (int bj = 0; bj < 2; ++bj) {
                    const f32x4 a0 = acc[ai][bj][m][0] * rr, a1 = acc[ai][bj][m][1] * rr;
                    float o[8] = {a0[0], a0[1], a0[2], a0[3], a1[0], a1[1], a1[2], a1[3]};
                    const bool dorope = ropelane && (mode == 1 || (mode == 2 && bj == 0) || (mode == 3 && bj == 0 && wc == 0));
                    if (dorope) {
#pragma unroll
                        for (int p = 0; p < 4; ++p) { const float x1 = o[2 * p], x2 = o[2 * p + 1]; o[2 * p] = x1 * cs[p] - x2 * sn[p]; o[2 * p + 1] = x2 * cs[p] + x1 * sn[p]; }
                    }
                    if (mode == 4) {
#pragma unroll
                        for (int e = 0; e < 8; ++e) o[e] = fast_sigmoid(o[e]);
                    } else {
#pragma unroll
                        for (int e = 0; e < 8; ++e) o[e] *= sc;
                    }
                    u32x4 w; w.x = cvt_pk_bf16(o[0], o[1]); w.y = cvt_pk_bf16(o[2], o[3]); w.z = cvt_pk_bf16(o[4], o[5]); w.w = cvt_pk_bf16(o[6], o[7]);
                    *(u32x4*)(dst + row * ld + col0 + bj * HALF) = w;
                }
            }
        }
    }
};


#if DUP == 31
struct EpiPlain {
    static constexpr bool PERM = true, AFTER_DRAIN = false;
    bf16_t* O;
    __device__ __forceinline__ void operator()(const f32x4 (&acc)[2][2][4][2], const Unit& u, int wr, int wc, int fr, int fq) const {
        const int row0 = u.pm * BM + wr * 64 + fr, col0 = u.pn * BM + wc * 32 + 8 * fq;
#pragma unroll
        for (int ai = 0; ai < 2; ++ai)
#pragma unroll
            for (int m = 0; m < 4; ++m)
#pragma unroll
                for (int bj = 0; bj < 2; ++bj) { const f32x4 a0 = acc[ai][bj][m][0], a1 = acc[ai][bj][m][1];
                    u32x4 w; w.x = cvt_pk_bf16(a0[0], a0[1]); w.y = cvt_pk_bf16(a0[2], a0[3]); w.z = cvt_pk_bf16(a1[0], a1[1]); w.w = cvt_pk_bf16(a1[2], a1[3]);
                    *(u32x4*)(O + (size_t)(row0 + ai * HALF + m * 16) * 1024 + col0 + bj * HALF) = w; }
    }
};
#endif
template <class Epi, class Sched, bool ALIGN_EPI = false, bool SP2 = false>
__device__ __forceinline__ void gemm_phase(PG8_LAS unsigned char* lds, const Gemm g, const Sched& S, const Epi& E, int tid_in) {
    int tid_ = tid_in; asm volatile("" : "+v"(tid_));
    const int tid = tid_, wid = __builtin_amdgcn_readfirstlane(tid >> 6), lane = tid & 63, wr = wid >> 2, wc = wid & 3, fr = lane & 15, fq = lane >> 4;
    const int K = g.K, nt = K / BK;
    unsigned voffA[2], voffB[2];
#pragma unroll
    for (int i = 0; i < 2; ++i) { int R, C; stage_rc(tid * 16 + i * 8192, R, C); const int Rb = Epi::PERM ? ((R & ~31) + perm32(R & 31)) : R;
        voffA[i] = (unsigned)(R * K + C) * 2u; voffB[i] = (unsigned)(Rb * K + C) * 2u; }
    const size_t kstep = (size_t)(BK * 2);
    const size_t hstep = (size_t)HALF * K * 2;
    const size_t tstep = 2 * hstep;
    const unsigned ldsw = (unsigned)wid * 1024u;
    const int aoff = lds_byte(wr * 64 + fr, fq * 8), boff = lds_byte(wc * 32 + fr, fq * 8);
#define PG8_SA(b, h) (((b) * 2 + (h)) * HTB)
#define PG8_SB(b, h) ((4 + (b) * 2 + (h)) * HTB)
#define PG8_STAGE(bufoff, gbase, voff) do { _Pragma("unroll") for (int _i = 0; _i < 2; ++_i) \
        __builtin_amdgcn_global_load_lds((const unsigned*)((const char*)(gbase) + (voff)[_i]), (PG8_LAS unsigned*)(lds + (bufoff) + ldsw + _i * 8192), 16, 0, 0); } while (0)
#define PG8_LDA(dst, b, h) do { _Pragma("unroll") for (int m = 0; m < 4; ++m) _Pragma("unroll") for (int k = 0; k < 2; ++k) dst[m][k] = *(const PG8_LAS bf16x8*)(lds + PG8_SA(b, h) + aoff + m * 2048 + k * 1024); } while (0)
#define PG8_LDB(dst, b, h) do { _Pragma("unroll") for (int n = 0; n < 2; ++n) _Pragma("unroll") for (int k = 0; k < 2; ++k) dst[n][k] = *(const PG8_LAS bf16x8*)(lds + PG8_SB(b, h) + boff + n * 2048 + k * 1024); } while (0)
#define PG8_MMA(ai, bj, At, Bt) do { __builtin_amdgcn_s_setprio(1); _Pragma("unroll") for (int m = 0; m < 4; ++m) _Pragma("unroll") for (int n = 0; n < 2; ++n) _Pragma("unroll") for (int k = 0; k < 2; ++k) \
        acc[ai][bj][m][n] = __builtin_amdgcn_mfma_f32_16x16x32_bf16(Bt[n][k], At[m][k], acc[ai][bj][m][n], 0, 0, 0); __builtin_amdgcn_s_setprio(0); } while (0)
#define PG8_WAIT_V(n) asm volatile("s_waitcnt vmcnt(" #n ")" ::: "memory")
#define PG8_WAIT_L(n) asm volatile("s_waitcnt lgkmcnt(" #n ")" ::: "memory")
#define PG8_BAR __builtin_amdgcn_s_barrier()
#define PG8_SCHED __builtin_amdgcn_sched_barrier(0)
    Unit cur, nxt; int ui = 0;
    if (!S.next(0, cur)) return;
    f32x4 acc[2][2][4][2];
#pragma unroll
    for (int a = 0; a < 2; ++a)
#pragma unroll
        for (int b = 0; b < 2; ++b)
#pragma unroll
            for (int m = 0; m < 4; ++m)
#pragma unroll
                for (int n = 0; n < 2; ++n) acc[a][b][m][n] = (f32x4){0.f, 0.f, 0.f, 0.f};
    bf16x8 At[4][2], B0[2][2], B1[2][2];
    const char* cA = (const char*)g.A + (size_t)cur.pm * tstep; const char* cB = (const char*)g.Bt + (size_t)cur.pn * tstep;
    S.a_ready(cur);
    if constexpr (SP2) {
        PG8_STAGE(PG8_SB(0, 0), cB, voffB); PG8_STAGE(PG8_SB(0, 1), cB + hstep, voffB); PG8_STAGE(PG8_SA(0, 0), cA, voffA); PG8_STAGE(PG8_SA(0, 1), cA + hstep, voffA);
        if (wr == 1) PG8_BAR;
        PG8_WAIT_V(2); PG8_BAR;
        PG8_STAGE(PG8_SB(1, 0), cB + kstep, voffB); PG8_STAGE(PG8_SA(1, 0), cA + kstep, voffA); PG8_STAGE(PG8_SB(1, 1), cB + hstep + kstep, voffB);
        PG8_WAIT_V(6); PG8_BAR;
    } else {
        PG8_STAGE(PG8_SB(0, 0), cB, voffB); PG8_STAGE(PG8_SA(0, 0), cA, voffA); PG8_STAGE(PG8_SB(0, 1), cB + hstep, voffB); PG8_STAGE(PG8_SA(0, 1), cA + hstep, voffA);
        if (wr == 1) PG8_BAR;
        PG8_WAIT_V(4); PG8_BAR;
        PG8_STAGE(PG8_SB(1, 0), cB + kstep, voffB); PG8_STAGE(PG8_SA(1, 0), cA + kstep, voffA); PG8_STAGE(PG8_SB(1, 1), cB + hstep + kstep, voffB);
        PG8_WAIT_V(6); PG8_BAR;
    }
    for (;;) {
        const bool has_next = S.next(ui + 1, nxt);
        const char* nA = has_next ? (const char*)g.A + (size_t)nxt.pm * tstep : cA; const char* nB = has_next ? (const char*)g.Bt + (size_t)nxt.pn * tstep : cB;
        for (int t = 0; t < nt; t += 2) {
            const bool last = (t == nt - 2);
            const char* a1 = cA + (size_t)(t + 1) * kstep;
            const char* a2 = last ? nA : cA + (size_t)(t + 2) * kstep; const char* b2 = last ? nB : cB + (size_t)(t + 2) * kstep;
            const char* a3 = a2 + kstep; const char* b3 = b2 + kstep;
            if (last && has_next) S.a_ready(nxt);
            if constexpr (SP2) {
            PG8_LDB(B0, 0, 0); PG8_LDB(B1, 0, 1); PG8_SCHED; PG8_LDA(At, 0, 0); PG8_STAGE(PG8_SA(1, 1), a1 + hstep, voffA);
            PG8_WAIT_V(8); PG8_WAIT_L(0); PG8_BAR; PG8_MMA(0, 0, At, B0); PG8_MMA(0, 1, At, B1); PG8_BAR; PG8_SCHED;
            PG8_LDA(At, 0, 1); PG8_STAGE(PG8_SB(0, 0), b2, voffB); PG8_STAGE(PG8_SB(0, 1), b2 + hstep, voffB); PG8_STAGE(PG8_SA(0, 0), a2, voffA);
            PG8_WAIT_V(8); PG8_WAIT_L(0); PG8_BAR; PG8_MMA(1, 0, At, B0); PG8_MMA(1, 1, At, B1); PG8_BAR; PG8_SCHED;
            PG8_LDB(B0, 1, 0); PG8_LDB(B1, 1, 1); PG8_SCHED; PG8_LDA(At, 1, 0); PG8_STAGE(PG8_SA(0, 1), a2 + hstep, voffA);
            PG8_WAIT_V(8); PG8_WAIT_L(0); PG8_BAR; PG8_MMA(0, 0, At, B0); PG8_MMA(0, 1, At, B1); PG8_BAR; PG8_SCHED;
            PG8_LDA(At, 1, 1); PG8_STAGE(PG8_SB(1, 0), b3, voffB); PG8_STAGE(PG8_SB(1, 1), b3 + hstep, voffB); PG8_STAGE(PG8_SA(1, 0), a3, voffA);
            PG8_WAIT_V(8); PG8_WAIT_L(0); PG8_BAR; PG8_MMA(1, 0, At, B0); PG8_MMA(1, 1, At, B1); PG8_BAR; PG8_SCHED;
            } else {
            PG8_LDB(B0, 0, 0); PG8_SCHED; PG8_LDA(At, 0, 0); PG8_STAGE(PG8_SA(1, 1), a1 + hstep, voffA);
            PG8_WAIT_L(8); PG8_BAR; PG8_WAIT_L(0); PG8_MMA(0, 0, At, B0); PG8_BAR; PG8_SCHED;
            PG8_LDB(B1, 0, 1); PG8_STAGE(PG8_SB(0, 0), b2, voffB);
            PG8_BAR; PG8_WAIT_L(0); PG8_MMA(0, 1, At, B1); PG8_BAR;
            PG8_LDA(At, 0, 1); PG8_STAGE(PG8_SA(0, 0), a2, voffA);
            PG8_BAR; PG8_WAIT_L(0); PG8_MMA(1, 0, At, B0); PG8_BAR; PG8_SCHED;
            PG8_STAGE(PG8_SB(0, 1), b2 + hstep, voffB);
            PG8_WAIT_V(6); PG8_BAR; PG8_MMA(1, 1, At, B1); PG8_BAR;
            PG8_LDB(B0, 1, 0); PG8_SCHED; PG8_LDA(At, 1, 0); PG8_STAGE(PG8_SA(0, 1), a2 + hstep, voffA);
            PG8_WAIT_L(8); PG8_BAR; PG8_WAIT_L(0); PG8_MMA(0, 0, At, B0); PG8_BAR; PG8_SCHED;
            PG8_LDB(B1, 1, 1); PG8_STAGE(PG8_SB(1, 0), b3, voffB);
            PG8_BAR; PG8_WAIT_L(0); PG8_MMA(0, 1, At, B1); PG8_BAR;
            PG8_LDA(At, 1, 1); PG8_STAGE(PG8_SA(1, 0), a3, voffA);
            PG8_BAR; PG8_WAIT_L(0); PG8_MMA(1, 0, At, B0); PG8_BAR; PG8_SCHED;
            PG8_STAGE(PG8_SB(1, 1), b3 + hstep, voffB);
            PG8_WAIT_V(6); PG8_BAR; PG8_MMA(1, 1, At, B1); PG8_BAR;
            }
        }
        if constexpr (ALIGN_EPI) { if (wr == 0) PG8_BAR; }
        if constexpr (!Epi::AFTER_DRAIN) { E(acc, cur, wr, wc, fr, fq); S.done(cur); }
        if (!has_next) break;
#pragma unroll
        for (int a = 0; a < 2; ++a)
#pragma unroll
            for (int b = 0; b < 2; ++b)
#pragma unroll
                for (int m = 0; m < 4; ++m)
#pragma unroll
                    for (int n = 0; n < 2; ++n) acc[a][b][m][n] = (f32x4){0.f, 0.f, 0.f, 0.f};
        cur = nxt; cA = nA; cB = nB; ++ui;
        if constexpr (ALIGN_EPI) { if (wr == 1) PG8_BAR; }
    }
    PG8_WAIT_V(0);
    if constexpr (!ALIGN_EPI) { if (wr == 0) PG8_BAR; }
    PG8_BAR;
    if constexpr (Epi::AFTER_DRAIN) { E.fused(acc, cur, wr, wc, fr, fq, lds, wid, lane); S.done(cur); }
#undef PG8_SA
#undef PG8_SB
#undef PG8_STAGE
#undef PG8_LDA
#undef PG8_LDB
#undef PG8_MMA
#undef PG8_WAIT_V
#undef PG8_WAIT_L
#undef PG8_BAR
#undef PG8_SCHED
}
}
#define GAS __attribute__((address_space(1)))
#define LAS __attribute__((address_space(3)))
typedef unsigned short bf16;
typedef unsigned v4u __attribute__((ext_vector_type(4)));
typedef float f32x4 __attribute__((ext_vector_type(4)));
typedef short bf16x8 __attribute__((ext_vector_type(8)));
typedef GAS unsigned gu32;
typedef GAS unsigned long long gu64;
#define RLX_AGENT __ATOMIC_RELAXED, __HIP_MEMORY_SCOPE_AGENT
#define LDS_WAIT() asm volatile("s_waitcnt lgkmcnt(0)" ::: "memory")
#define VM_WAIT() asm volatile("s_waitcnt vmcnt(0)" ::: "memory")
__device__ __forceinline__ unsigned long long rt() { return __builtin_amdgcn_s_memrealtime(); }
__device__ __forceinline__ unsigned f2bf(float f) { unsigned u = __builtin_bit_cast(unsigned, f); return (u + 0x7fffu + ((u >> 16) & 1u)) >> 16; }
__device__ __forceinline__ unsigned pk2(float lo, float hi) { return f2bf(lo) | (f2bf(hi) << 16); }
#define XB_TMO      128
#define XB_XCNT(j)  (256  + 64 * (j))
#define XB_XSUB(j)  (1280 + 64 * (j))
#define XB_XGEN(j)  (2304 + 64 * (j))
#define XB_TOP      3328
#define XB_TOPGEN   3392
#define XCD_BAR_WORDS 3456
#define XB_SPIN_CAP (1u << 18)

__device__ __forceinline__ unsigned xb_ld(unsigned* p)              { return __hip_atomic_load(p, __ATOMIC_RELAXED, __HIP_MEMORY_SCOPE_AGENT); }
__device__ __forceinline__ unsigned xb_add(unsigned* p, unsigned v) { return __hip_atomic_fetch_add(p, v, __ATOMIC_RELAXED, __HIP_MEMORY_SCOPE_AGENT); }
__device__ __forceinline__ unsigned xb_xcc_id() { return (unsigned)__builtin_amdgcn_s_getreg((3 << 11) | 20) & 0xFu; }
#define XB_SPIN(cond, bar) do { unsigned _sp = 0; while (cond) { __builtin_amdgcn_s_sleep(1); \
    if ((++_sp & 255u) == 0u) { if (xb_ld(&(bar)[XB_TMO])) break; if (_sp > XB_SPIN_CAP) { atomicAdd(&(bar)[XB_TMO], 1u); break; } } } } while (0)

struct XcdBarrier {
    unsigned* bar; unsigned x;
    volatile LAS unsigned* st;
};

__device__ __forceinline__ XcdBarrier xcd_barrier_post(unsigned* bar, volatile LAS unsigned* st) {
    XcdBarrier b; b.bar = bar; b.x = xb_xcc_id(); b.st = st;
    if (threadIdx.x == 0) (void)xb_add(&bar[XB_XCNT(b.x)], 1u);
    return b;
}
__device__ __forceinline__ void xcd_barrier_complete(unsigned* bar, unsigned x, unsigned& nloc, unsigned& nx) {
    const unsigned G = gridDim.x * gridDim.y * gridDim.z;
    unsigned sum, cnt, mine, sp = 0u;
    for (;;) {
        sum = 0u; cnt = 0u; mine = 0u;
#pragma unroll
        for (unsigned j = 0; j < 16; ++j) { const unsigned c = xb_ld(&bar[XB_XCNT(j)]); sum += c; cnt += (c > 0u) ? 1u : 0u; mine = (j == x) ? c : mine; }
        if (sum == G) break;
        __builtin_amdgcn_s_sleep(1);
        if ((++sp & 255u) == 0u) { if (xb_ld(&bar[XB_TMO])) break; if (sp > XB_SPIN_CAP) { atomicAdd(&bar[XB_TMO], 1u); break; } }
    }
    nloc = mine > 0u ? mine : 1u; nx = cnt > 0u ? cnt : 1u;
}

__device__ __forceinline__ void xcd_barrier(const XcdBarrier& b) {
    asm volatile("s_waitcnt vmcnt(0)" ::: "memory");
    __syncthreads();
    if (threadIdx.x == 0) {
        unsigned* bar = b.bar;
        __builtin_amdgcn_s_waitcnt(0);
        unsigned nloc = b.st[0], nx = b.st[1];
        if (nloc == 0u) { xcd_barrier_complete(bar, b.x, nloc, nx); b.st[0] = nloc; b.st[1] = nx; }
        const unsigned old = xb_add(&bar[XB_XSUB(b.x)], 1u);
        const unsigned gen = old / nloc;
        if (old + 1u == (gen + 1u) * nloc) {
            __builtin_amdgcn_fence(__ATOMIC_RELEASE, "agent");
            asm volatile("s_waitcnt vmcnt(0)" ::: "memory");
            const unsigned og = xb_add(&bar[XB_TOP], 1u);
            const unsigned tg = og / nx;
            if (og + 1u == (tg + 1u) * nx) xb_add(&bar[XB_TOPGEN], 1u);
            else XB_SPIN(xb_ld(&bar[XB_TOPGEN]) == tg, bar);
            __builtin_amdgcn_fence(__ATOMIC_ACQUIRE, "agent");
            xb_add(&bar[XB_XGEN(b.x)], 1u);
            asm volatile("s_waitcnt vmcnt(0)" ::: "memory");
        } else {
            XB_SPIN(xb_ld(&bar[XB_XGEN(b.x)]) == gen, bar);
            __builtin_amdgcn_fence(__ATOMIC_ACQUIRE, "agent");
            asm volatile("s_waitcnt vmcnt(0)" ::: "memory");
        }
    }
    __syncthreads();
}
constexpr int NB = 8, SEQ = 4096, DM = 1024, DEPTH = 4, M = NB * SEQ;
constexpr int FF = 2816, NIN = 5852, NINP = 5888;
constexpr float EPS = 1e-6f, NEGF = -1e30f;
constexpr int NWAVES = 8;
constexpr size_t MiB = 1u << 20;
constexpr size_t WS_CTL = 0, CTL_ZERO_BYTES = 1 * MiB;
constexpr size_t WS_ROPE = 1 * MiB;
constexpr size_t WS_KVA = 3 * MiB;
constexpr size_t WS_KC = 11 * MiB, WS_VC = WS_KC + 512 * 1024;
constexpr size_t WS_W = 12 * MiB;
constexpr size_t WO_GU1 = 0, WO_D1 = 11 * MiB, WO_GU2 = WO_D1 + 5 * MiB + 512 * 1024, WO_D2 = WO_GU2 + 11 * MiB, WO_IN = WO_D2 + 5 * MiB + 512 * 1024,
                 WO_PA = WO_IN + 11 * MiB + 512 * 1024, WO_PB = WO_PA + MiB, WO_PC = WO_PB + MiB, WO_OUT = WO_PC + MiB,
                 WO_CW1 = WO_OUT + 2 * MiB  , WO_CW2 = WO_CW1 + MiB  , WO_UKV = WO_CW2 + 32768  , WO_POOL = WO_UKV + 32768  ,
                 WO_POSB = WO_POOL + 131072  , WO_END = WO_POSB + 1024;
static_assert(WO_END <= 52 * MiB, "weights region");
constexpr size_t WS_XN = 64 * MiB;
constexpr size_t WS_R = 128 * MiB;
constexpr size_t WS_G = WS_R, WS_QA = WS_R + 192 * MiB, WS_QC = WS_QA + 32 * MiB, WS_IQ = WS_QC + 32 * MiB, WS_MISC = WS_IQ + 16 * MiB,
                 WS_KVC = WS_MISC + 16 * MiB, WS_KVS = WS_KVC + 16 * MiB, WS_KVW = WS_KVS + 16 * MiB, WS_BU = WS_KVW + 16 * MiB, WS_END = WS_BU + 32 * MiB;
#ifndef YB_SPARE
#define YB_SPARE 0
#endif
constexpr size_t WS_YB = YB_SPARE ? 496 * MiB : WS_XN;
constexpr size_t WS_MG = WS_IQ;
constexpr size_t WS_H = WS_R;
static_assert(WS_END == 496 * MiB, "ws map");
constexpr int RING_BYTES = 131072, LDS_BYTES = 163840, LDSCTL_OFF = 163840 - 256;
constexpr size_t WS_SSQ = 496 * MiB;
constexpr int RS_OFF = 131072;
constexpr int NPL = 10, NPH = 1 + DEPTH * NPL + 1;


#ifndef TPROBE
#define TPROBE 0
#endif
#if TPROBE
#define TP_DECL unsigned long long tp_t_ = __builtin_amdgcn_s_memtime();
#define TP_MARK(k) do { const unsigned long long n_ = __builtin_amdgcn_s_memtime(); if (tid == 0) atomicAdd((unsigned long long*)(ws + 32768) + (k), n_ - tp_t_); tp_t_ = n_; } while (0)
#define TP_ADD(k, v) do { if (tid == 0) atomicAdd((unsigned long long*)(ws + 32768) + (k), (unsigned long long)(v)); } while (0)
#else
#define TP_DECL
#define TP_MARK(k)
#define TP_ADD(k, v)
#endif
__device__ __forceinline__ int lane_id_v() { int l; asm volatile("v_mbcnt_lo_u32_b32 %0, -1, 0\n\tv_mbcnt_hi_u32_b32 %0, -1, %0" : "=v"(l)); return l; }
__device__ __forceinline__ float bflo(unsigned w) { return __uint_as_float(w << 16); }
__device__ __forceinline__ float bfhi(unsigned w) { return __uint_as_float(w & 0xffff0000u); }
__device__ __forceinline__ float bf2f(bf16 v) { return __uint_as_float((unsigned)v << 16); }
__device__ __forceinline__ float wave_sum(float v) {
#pragma unroll
    for (int o = 1; o < 64; o <<= 1) v += __shfl_xor(v, o);
    return v;
}
__device__ __forceinline__ float wave_max(float v) {
#pragma unroll
    for (int o = 1; o < 64; o <<= 1) v = fmaxf(v, __shfl_xor(v, o));
    return v;
}
__device__ __forceinline__ int wave_sum_i(int v) {
#pragma unroll
    for (int o = 1; o < 64; o <<= 1) v += __shfl_xor(v, o);
    return v;
}
__device__ __forceinline__ unsigned wave_max_u(unsigned v) {
#pragma unroll
    for (int o = 1; o < 64; o <<= 1) { const unsigned w = (unsigned)__shfl_xor((int)v, o); v = w > v ? w : v; }
    return v;
}
#define WAVE_LDS_SYNC() do { asm volatile("s_waitcnt lgkmcnt(0)" ::: "memory"); __builtin_amdgcn_wave_barrier(); } while (0)
__host__ __device__ __forceinline__ int permd(int d) { return d < 8 ? 2 * d : (d < 16 ? 2 * (d - 8) + 1 : d); }
__device__ __forceinline__ int win_newcol(int n) {
    if (n < 512) return (n & ~63) + permd(n & 63);
    if (n < 640) return 1280 + 64 + (n - 512);
    if (n < 896) { const int m = n - 640; return 1024 + (m & ~63) + permd(m & 63); }
    if (n < 960) return 1280 + permd(n - 896);
    if (n < 964) return 1280 + 192 + (n - 960);
    if (n < 1476) return 2304 + (n - 964);
    if (n < 1988) { const int m = n - 1476; return 512 + (m & ~63) + permd(m & 63); }
    if (n < 2756) { const int m = n - 1988, kv = m >> 8, r = m & 255, base = 1536 + kv * 256; return r < 128 ? base + (r & ~63) + permd(r & 63) : base + r; }
    if (n < 2780) return 1280 + 196 + (n - 2756);
    return 2816 + (n - 2780);
}
__device__ __forceinline__ int map_row(int mode, int n) { return mode == 0 ? n : (mode == 1 ? ((n >> 7) << 8) + (n & 127) : (mode == 2 ? ((n >> 7) << 8) + 128 + (n & 127) : win_newcol(n))); }

struct Args { const float* in[24]; float* out; unsigned char* ws; int ph_lo, ph_hi; };

__device__ __forceinline__ int unperm(int p) { return p < 16 ? ((p & 1) ? (p >> 1) + 8 : (p >> 1)) : p; }
__device__ __forceinline__ void tr_item(const float* W, int K, int N, bf16* WT, int mode, LAS float* scr, int item, int lane, bool kperm = false, const float* kscale = nullptr) {
    const int nblk = (N + 31) >> 5, kb = item / nblk, nb = item - kb * nblk, k0 = 64 * kb, n0 = 32 * nb;
    const int nn = n0 + (lane & 31);
    const int nnc = nn < N ? nn : N - 1; const float msk = nn < N ? 1.0f : 0.0f;
    const float* ksp = kscale ? kscale : W; const bool hs = kscale != nullptr;
    float wv[32], sv[32];
#pragma unroll
    for (int i = 0; i < 32; ++i) { const int kk = 2 * i + (lane >> 5); wv[i] = W[(size_t)(k0 + kk) * N + nnc]; sv[i] = ksp[k0 + kk]; }
#pragma unroll
    for (int i = 0; i < 32; ++i) { const int kk = 2 * i + (lane >> 5); scr[kk * 33 + (lane & 31)] = wv[i] * (hs ? sv[i] : 1.0f) * msk; }
    LDS_WAIT(); asm volatile("" ::: "memory");
    const int c = lane & 7;
#pragma unroll
    for (int j = 0; j < 4; ++j) { const int n = (lane >> 3) + 8 * j; const LAS float* s = scr + n;
        int ks[8];
#pragma unroll
        for (int i = 0; i < 8; ++i) ks[i] = (kperm ? unperm(8 * c + i) : 8 * c + i) * 33;
        v4u o; o.x = pk2(s[ks[0]], s[ks[1]]); o.y = pk2(s[ks[2]], s[ks[3]]); o.z = pk2(s[ks[4]], s[ks[5]]); o.w = pk2(s[ks[6]], s[ks[7]]);
        if (n0 + n < N) *(v4u*)(WT + (size_t)map_row(mode, n0 + n) * K + k0 + 8 * c) = o; }
    LDS_WAIT(); asm volatile("" ::: "memory");
}
__device__ __forceinline__ void phase_convert(const Args& P, unsigned char* ws, int z, int l, LAS unsigned char* lds, int gw, int NGW, int lane, int wave) {
    asm volatile("" : "+v"(lane)); lane &= 63; asm volatile("" : "+s"(gw), "+s"(NGW));
    LAS float* scr = (LAS float*)(lds + wave * 16384);
    unsigned char* wb = ws + WS_W;
    constexpr int I_F = 16 * 88, I_D = 44 * 32, I_IN = 16 * 183, I_P = 8 * 32, I_O = 16 * 32;
    constexpr int I_C = 32 * 4;
    constexpr int NIT = 4 * I_F + 2 * I_D + I_IN + 3 * I_P + I_O + 2 * I_C;
    const size_t fo = (size_t)l * DM * FF;
    for (int it = gw; it < NIT; it += NGW) {
        int r = it, K = DM, N = FF, mode = 1; const float* W = P.in[3 + z] + fo; size_t wo = WO_GU1; bool kperm = false; const float* ksc = P.in[2 + z] + l * DM;
        if (r >= I_F) { r -= I_F; mode = 2; W = P.in[4 + z] + fo;
        if (r >= I_F) { r -= I_F; mode = 0; W = P.in[5 + z] + fo; K = FF; N = DM; wo = WO_D1; ksc = nullptr;
        if (r >= I_D) { r -= I_D; mode = 1; W = P.in[20 + z] + fo; K = DM; N = FF; wo = WO_GU2; ksc = P.in[19 + z] + l * DM;
        if (r >= I_F) { r -= I_F; mode = 2; W = P.in[21 + z] + fo;
        if (r >= I_F) { r -= I_F; mode = 0; W = P.in[22 + z] + fo; K = FF; N = DM; wo = WO_D2; ksc = nullptr;
        if (r >= I_D) { r -= I_D; mode = 3; W = P.in[7 + z] + (size_t)l * DM * NIN; K = DM; N = NIN; wo = WO_IN; ksc = P.in[6 + z] + l * DM;
        if (r >= I_IN) { r -= I_IN; mode = 0; W = P.in[15 + z] + (size_t)l * 512 * DM; K = 512; N = DM; wo = WO_PA; ksc = nullptr;
        if (r >= I_P) { r -= I_P; W = P.in[16 + z] + (size_t)l * 512 * DM; wo = WO_PB;
        if (r >= I_P) { r -= I_P; W = P.in[17 + z] + (size_t)l * 512 * DM; wo = WO_PC;
        if (r >= I_P) { r -= I_P; W = P.in[18 + z] + (size_t)l * DM * DM; K = DM; wo = WO_OUT;
        if (r >= I_O) { r -= I_O; W = P.in[13 + z] + (size_t)(l * 2) * 2048 * 128; K = 2048; N = 128; wo = WO_CW1; kperm = true;
        if (r >= I_C) { r -= I_C; W += (size_t)2048 * 128; wo = WO_CW1 + 128 * 2048 * 2; kperm = false; } } } } } } } } } } } }
        tr_item(W, K, N, (bf16*)(wb + wo), mode, scr, r, lane, kperm, ksc);
    }
    {
        const int gt = gw * 64 + lane, GT = NGW * 64;
        bf16* ukv = (bf16*)(wb + WO_UKV); bf16* pool = (bf16*)(wb + WO_POOL); bf16* cw2 = (bf16*)(wb + WO_CW2); float* posb = (float*)(wb + WO_POSB);
        const float* w_ukv = P.in[9 + z] + (size_t)l * 128 * 128; const float* gn = P.in[8 + z] + l * 128;
        for (int i = gt; i < 128 * 128; i += GT) { const int np = i >> 7, k = i & 127, n = np < 64 ? unperm(np) : np; ukv[i] = (bf16)f2bf(gn[k] * w_ukv[k * 128 + n]); }
        const float* pw = P.in[10 + z] + (size_t)l * 4 * 128 * 128; const float* psc = P.in[11 + z] + l * 512;
        for (int i = gt; i < 4 * 128 * 128; i += GT) { const int g = i >> 14, d = (i >> 7) & 127, c = i & 127; pool[i] = (bf16)f2bf(pw[(g * 128 + c) * 128 + d] * psc[g * 128 + d]); }
        const float* w2 = P.in[14 + z] + (size_t)l * 2 * 128 * 64;
        for (int i = gt; i < 2 * 64 * 128; i += GT) { const int br = i >> 13, dp = (i >> 7) & 63, n = i & 127, d = br ? dp : unperm(dp); cw2[i] = (bf16)f2bf(w2[(br * 128 + n) * 64 + d]); }
        const float* w1 = P.in[13 + z] + (size_t)l * 2 * 2048 * 128; const float* pos = P.in[12 + z] + (size_t)l * 2 * 2048;
        for (int i = gw; i < 256; i += NGW) { const int br = i >> 7, n = i & 127; float a = 0.f;
#pragma unroll 8
            for (int k = lane; k < 2048; k += 64) a += pos[br * 2048 + k] * w1[((size_t)br * 2048 + k) * 128 + n];
            a = wave_sum(a); if (lane == 0) posb[i] = a; }
    }
    if (gw < 36) { unsigned zz = 0u; asm volatile("" : "+v"(zz)); v4u z = {zz, zz, zz, zz}; v4u* rp = (v4u*)((bf16*)(wb + WO_IN) + (size_t)(1500 + gw) * DM); for (int i = lane; i < DM / 8; i += 64) rp[i] = z; }
}
__device__ __forceinline__ void phase_rope(const Args& P, unsigned char* ws, int z, int gtid, int gthreads) {
    float* rope = (float*)(ws + WS_ROPE);
    for (int idx = gtid; idx < M * 8; idx += gthreads) {
        const int row = idx >> 3, i = idx & 7;
        const double inv = i == 0 ? 1.0 : i == 1 ? 0.19392274474868576 : i == 2 ? 0.03760603093086393 : i == 3 ? 0.007292664737217109 : i == 4 ? 0.001414213562373095 : i == 5 ? 0.0002742481756762073 : i == 6 ? 5.318295896944988e-05 : 1.031338537721246e-05;
        const double ang = (double)((const int*)P.in[1 + z])[row] * inv;
        double s, c; sincos(ang, &s, &c);
        rope[row * 16 + i] = (float)c; rope[row * 16 + 8 + i] = (float)s;
    }
}
__device__ __forceinline__ void norm_row_bf16(const float* xrow, const float* gain, bf16* orow, int lane) {
    const f32x4* xr = (const f32x4*)xrow + lane; const f32x4* gr = (const f32x4*)gain + lane;
    f32x4 v[4]; float s = 0.f;
#pragma unroll
    for (int j = 0; j < 4; ++j) { v[j] = xr[64 * j]; s += (v[j].x * v[j].x + v[j].y * v[j].y) + (v[j].z * v[j].z + v[j].w * v[j].w); }
    const float r = 1.0f / sqrtf(wave_sum(s) * (1.f / DM) + EPS);
    unsigned long long* o8 = (unsigned long long*)orow + lane;
#pragma unroll
    for (int j = 0; j < 4; ++j) { const f32x4 g = gr[64 * j]; o8[64 * j] = (unsigned long long)pk2(v[j].x * r * g.x, v[j].y * r * g.y) | ((unsigned long long)pk2(v[j].z * r * g.z, v[j].w * r * g.w) << 32); }
}
__device__ __forceinline__ void stat_row_bf16(const float* xrow, bf16* orow, float* ssq16, int lane) {
    const f32x4* xr = (const f32x4*)xrow + lane;
    f32x4 v[4]; float s = 0.f;
#pragma unroll
    for (int j = 0; j < 4; ++j) { v[j] = xr[64 * j]; s += (v[j].x * v[j].x + v[j].y * v[j].y) + (v[j].z * v[j].z + v[j].w * v[j].w); }
    s = wave_sum(s);
    unsigned long long* o8 = (unsigned long long*)orow + lane;
#pragma unroll
    for (int j = 0; j < 4; ++j) o8[64 * j] = (unsigned long long)pk2(v[j].x, v[j].y) | ((unsigned long long)pk2(v[j].z, v[j].w) << 32);
    if (lane < 16) ssq16[lane] = lane == 0 ? s : 0.f;
}
__device__ __forceinline__ void norm_row_f32(float* xrow, const float* gain, int lane, float tps = 1.0f) {
    f32x4* xr = (f32x4*)xrow + lane; const f32x4* gr = (const f32x4*)gain + lane;
    f32x4 v[4]; float s = 0.f;
#pragma unroll
    for (int j = 0; j < 4; ++j) { v[j] = xr[64 * j]; s += (v[j].x * v[j].x + v[j].y * v[j].y) + (v[j].z * v[j].z + v[j].w * v[j].w); }
    const float r = tps / sqrtf(wave_sum(s) * (1.f / DM) + EPS);
#pragma unroll
    for (int j = 0; j < 4; ++j) { const f32x4 g = gr[64 * j]; xr[64 * j] = v[j] * r * g; }
}

__device__ __forceinline__ void norm_row_out(const bf16* xrow, float* orow, const float* gain, int lane, float tps = 1.0f) {
    const v4u a = *(const v4u*)(xrow + 16 * lane), b = *(const v4u*)(xrow + 16 * lane + 8);
    const float f[16] = {bflo(a.x), bfhi(a.x), bflo(a.y), bfhi(a.y), bflo(a.z), bfhi(a.z), bflo(a.w), bfhi(a.w), bflo(b.x), bfhi(b.x), bflo(b.y), bfhi(b.y), bflo(b.z), bfhi(b.z), bflo(b.w), bfhi(b.w)};
    float s = 0.f;
#pragma unroll
    for (int e = 0; e < 16; ++e) s += f[e] * f[e];
    const float r = tps / sqrtf(wave_sum(s) * (1.f / DM) + EPS);
    const f32x4* gr = (const f32x4*)(gain + 16 * lane); f32x4* orr = (f32x4*)(orow + 16 * lane);
#pragma unroll
    for (int j = 0; j < 4; ++j) { const f32x4 g = gr[j]; f32x4 o; o.x = f[4 * j] * r * g.x; o.y = f[4 * j + 1] * r * g.y; o.z = f[4 * j + 2] * r * g.z; o.w = f[4 * j + 3] * r * g.w; orr[j] = o; }
}

__device__ __forceinline__ void stat_rows4_bf16(const float* x, bf16* xo, float* ssq, int m0, int st, int lane) {
    f32x4 v[4][4];
#pragma unroll
    for (int r = 0; r < 4; ++r) { const int m = m0 + r * st; const f32x4* xr = (const f32x4*)(x + (size_t)(m < M ? m : 0) * DM) + lane;
#pragma unroll
        for (int j = 0; j < 4; ++j) v[r][j] = xr[64 * j]; }
#pragma unroll
    for (int r = 0; r < 4; ++r) { const int m = m0 + r * st; if (m < M) { float s = 0.f;
#pragma unroll
        for (int j = 0; j < 4; ++j) s += (v[r][j].x * v[r][j].x + v[r][j].y * v[r][j].y) + (v[r][j].z * v[r][j].z + v[r][j].w * v[r][j].w);
        s = wave_sum(s);
        unsigned long long* o8 = (unsigned long long*)(xo + (size_t)m * DM) + lane;
#pragma unroll
        for (int j = 0; j < 4; ++j) o8[64 * j] = (unsigned long long)pk2(v[r][j].x, v[r][j].y) | ((unsigned long long)pk2(v[r][j].z, v[r][j].w) << 32);
        if (lane < 16) ssq[(size_t)m * 16 + lane] = lane == 0 ? s : 0.f; } }
}
__device__ __forceinline__ void norm_rows4_out(const bf16* x, float* out, const float* gain, int m0, int st, int lane, float tps = 1.0f) {
    v4u a[4], b[4];
#pragma unroll
    for (int r = 0; r < 4; ++r) { const int m = m0 + r * st; const bf16* xr = x + (size_t)(m < M ? m : 0) * DM + 16 * lane; a[r] = *(const v4u*)xr; b[r] = *(const v4u*)(xr + 8); }
    f32x4 g[4];
#pragma unroll
    for (int j = 0; j < 4; ++j) g[j] = ((const f32x4*)(gain + 16 * lane))[j];
#pragma unroll
    for (int r = 0; r < 4; ++r) { const int m = m0 + r * st; if (m < M) {
        const float f[16] = {bflo(a[r].x), bfhi(a[r].x), bflo(a[r].y), bfhi(a[r].y), bflo(a[r].z), bfhi(a[r].z), bflo(a[r].w), bfhi(a[r].w), bflo(b[r].x), bfhi(b[r].x), bflo(b[r].y), bfhi(b[r].y), bflo(b[r].z), bfhi(b[r].z), bflo(b[r].w), bfhi(b[r].w)};
        float s = 0.f;
#pragma unroll
        for (int e = 0; e < 16; ++e) s += f[e] * f[e];
        const float rs = tps / sqrtf(wave_sum(s) * (1.f / DM) + EPS);
        f32x4* orr = (f32x4*)(out + (size_t)m * DM + 16 * lane);
#pragma unroll
        for (int j = 0; j < 4; ++j) { f32x4 o; o.x = f[4 * j] * rs * g[j].x; o.y = f[4 * j + 1] * rs * g[j].y; o.z = f[4 * j + 2] * rs * g[j].z; o.w = f[4 * j + 3] * rs * g[j].w; orr[j] = o; } } }
}
__device__ __forceinline__ unsigned f2o(float s) { const int b = (int)__float_as_uint(s); return (unsigned)(b ^ ((b >> 31) | (int)0x80000000)); }
__device__ __forceinline__ void unpack8(const v4u v, float* f) { f[0] = bflo(v.x); f[1] = bfhi(v.x); f[2] = bflo(v.y); f[3] = bfhi(v.y); f[4] = bflo(v.z); f[5] = bfhi(v.z); f[6] = bflo(v.w); f[7] = bfhi(v.w); }
__device__ __forceinline__ void load_row64(const bf16* p, float* f) {
    const v4u* q = (const v4u*)p;
#pragma unroll
    for (int i = 0; i < 8; ++i) unpack8(q[i], f + 8 * i);
}
__device__ __forceinline__ float dot64(const LAS float* q, const float* k) {
    float d = 0.f;
#pragma unroll
    for (int i = 0; i < 16; ++i) { const f32x4 qq = *(const LAS f32x4*)(q + 4 * i); d += qq.x * k[4 * i] + qq.y * k[4 * i + 1] + qq.z * k[4 * i + 2] + qq.w * k[4 * i + 3]; }
    return d;
}
__device__ __forceinline__ void dsa_query(const Args& P, unsigned char* ws, int z, int row, LAS unsigned char* wl, int lane) {
    const int b = row >> 12, t = row & (SEQ - 1), n = t + 1;
    LAS unsigned* su = (LAS unsigned*)wl; LAS float* pb = (LAS float*)wl; LAS unsigned short* list = (LAS unsigned short*)(wl + 16384); LAS float* qb = (LAS float*)(wl + 16896);
    const bf16* misc = (const bf16*)(ws + WS_MISC);
    const unsigned long long lt = (1ull << lane) - 1ull;
    int nsel;
    if (n <= 256) { for (int i = lane; i < n; i += 64) list[i] = (unsigned short)i; nsel = n; }
    else {
        { const uint2 v = *(const uint2*)((const bf16*)(ws + WS_IQ) + (size_t)row * 256 + lane * 4); qb[lane * 4] = bflo(v.x); qb[lane * 4 + 1] = bfhi(v.x); qb[lane * 4 + 2] = bflo(v.y); qb[lane * 4 + 3] = bfhi(v.y); }
        float iw[4]; { const uint2 v = *(const uint2*)(misc + (size_t)row * 256 + 192); iw[0] = 0.5f * bflo(v.x); iw[1] = 0.5f * bfhi(v.x); iw[2] = 0.5f * bflo(v.y); iw[3] = 0.5f * bfhi(v.y); }
        WAVE_LDS_SYNC();
        const int nch = (n + 63) >> 6;
        for (int i = 0; i < nch; ++i) {
            const int key = i * 64 + lane; const bool valid = key <= t;
            float kf[64]; load_row64(misc + (size_t)(b * SEQ + (valid ? key : t)) * 256, kf);
            float s = 0.f;
#pragma unroll
            for (int h = 0; h < 4; ++h) s += iw[h] * fmaxf(dot64(qb + h * 64, kf), 0.f);
            su[key] = valid ? f2o(s) : 0u;
        }
        WAVE_LDS_SYNC();
        unsigned prefix = 0u;
        for (int bit = 31; bit >= 0; --bit) {
            const unsigned cand = prefix | (1u << bit); int c = 0;
            for (int i = 0; i < nch; ++i) c += (su[i * 64 + lane] >= cand) ? 1 : 0;
            c = wave_sum_i(c);
            if (c >= 256) prefix = cand;
            if (c == 256) break;
        }
        int cgt = 0;
        for (int i = 0; i < nch; ++i) cgt += (su[i * 64 + lane] > prefix) ? 1 : 0;
        const int need_eq = 256 - wave_sum_i(cgt);
        int base = 0, eq_taken = 0;
        for (int i = 0; i < nch; ++i) {
            const unsigned v = su[i * 64 + lane]; const bool gt = v > prefix, eq = v == prefix;
            const unsigned long long meq = __ballot(eq);
            const bool sel = gt || (eq && (eq_taken + __popcll(meq & lt)) < need_eq);
            const unsigned long long ms = __ballot(sel);
            if (sel) list[base + __popcll(ms & lt)] = (unsigned short)(i * 64 + lane);
            base += __popcll(ms); eq_taken += __popcll(meq);
        }
        nsel = 256;
    }
    { const v4u v = *(const v4u*)((const bf16*)(ws + WS_QA) + (size_t)row * 512 + lane * 8); float f[8]; unpack8(v, f);
#pragma unroll
      for (int e = 0; e < 8; ++e) qb[lane * 8 + e] = f[e]; }
    WAVE_LDS_SYNC();
    const bf16* kva = (const bf16*)(ws + WS_KVA);
    float s[8][4];
#pragma unroll
    for (int j = 0; j < 4; ++j) {
        const int slot = lane + 64 * j; const bool valid = slot < nsel; const int key = list[valid ? slot : 0];
        float kf[64]; load_row64(kva + (size_t)(b * SEQ + key) * 128, kf);
#pragma unroll
        for (int h = 0; h < 8; ++h) s[h][j] = valid ? dot64(qb + h * 64, kf) : NEGF;
    }
    float linv[8];
#pragma unroll
    for (int h = 0; h < 8; ++h) {
        const float m = wave_max(fmaxf(fmaxf(s[h][0], s[h][1]), fmaxf(s[h][2], s[h][3]))); float ls = 0.f;
#pragma unroll
        for (int j = 0; j < 4; ++j) { const float p = __expf(s[h][j] - m); ls += p; pb[h * 256 + lane + 64 * j] = p; }
        linv[h] = 1.0f / wave_sum(ls);
    }
    WAVE_LDS_SYNC();
    float acc[8] = {0.f, 0.f, 0.f, 0.f, 0.f, 0.f, 0.f, 0.f};
    for (int slot = 0; slot < nsel; ++slot) {
        const float v = bf2f(kva[(size_t)(b * SEQ + list[slot]) * 128 + 64 + lane]);
#pragma unroll
        for (int h = 0; h < 8; ++h) acc[h] += pb[h * 256 + slot] * v;
    }
    bf16* ya = (bf16*)(ws + WS_QA) + (size_t)row * 512;
#pragma unroll
    for (int h = 0; h < 8; ++h) ya[h * 64 + lane] = (bf16)f2bf(acc[h] * linv[h]);
    WAVE_LDS_SYNC();
}
typedef short s16x4 __attribute__((ext_vector_type(4)));
typedef short v4i16_t __attribute__((ext_vector_type(4)));
typedef float f32x4v __attribute__((ext_vector_type(4)));
typedef __bf16 bf16x2_t __attribute__((ext_vector_type(2)));
typedef float f32x2_t __attribute__((ext_vector_type(2)));
__device__ __forceinline__ unsigned cvtpk(float lo, float hi) { f32x2_t v = {lo, hi}; bf16x2_t b = __builtin_convertvector(v, bf16x2_t); return __builtin_bit_cast(unsigned, b); }
constexpr float L2E = 1.4426950408889634f;
#ifndef NSA_JOINT
#define NSA_JOINT 0
#endif
#ifndef NSA_NOSKIP
#define NSA_NOSKIP 0
#endif
constexpr int NSA_KSTR = 72, NSA_VSTR = 80;
constexpr int NSA_KB = 64 * NSA_KSTR * 2, NSA_VB = 64 * NSA_VSTR * 2;
constexpr int NSA_D = 6, NSA_SLOT = 16384;
constexpr int NSA_OFF_RING = 0, NSA_OFF_KCL = 0, NSA_OFF_VCTL = 32768  , NSA_OFF_IMPA = 65536  , NSA_OFF_IMPB = NSA_OFF_IMPA + 64 * 65 * 4, NSA_OFF_UM = NSA_D * NSA_SLOT + 1024  , NSA_OFF_QM = NSA_OFF_UM + 64, NSA_OFF_ST = NSA_OFF_UM + 1024, NSA_LDS = NSA_OFF_ST + 512 * 64;
__device__ __forceinline__ s16x4 tr16(const LAS unsigned char* p) { return __builtin_bit_cast(s16x4, __builtin_amdgcn_ds_read_tr16_b64_v4i16((LAS v4i16_t*)p)); }
__device__ __forceinline__ bf16x8 cat4(s16x4 a, s16x4 b) { return __builtin_shufflevector(a, b, 0, 1, 2, 3, 4, 5, 6, 7); }
__device__ __forceinline__ bf16x8 pack8(float a0, float a1, float a2, float a3, float b0, float b1, float b2, float b3) {
    v4u w; w.x = pg8::cvt_pk_bf16(a0, a1); w.y = pg8::cvt_pk_bf16(a2, a3); w.z = pg8::cvt_pk_bf16(b0, b1); w.w = pg8::cvt_pk_bf16(b2, b3); return __builtin_bit_cast(bf16x8, w);
}
__device__ __forceinline__ float qxor1(float v) { return __builtin_bit_cast(float, __builtin_amdgcn_update_dpp(0, __builtin_bit_cast(int, v), 0xB1, 0xF, 0xF, true)); }
__device__ __forceinline__ float qxor2(float v) { return __builtin_bit_cast(float, __builtin_amdgcn_update_dpp(0, __builtin_bit_cast(int, v), 0x4E, 0xF, 0xF, true)); }
__device__ __forceinline__ float xmax16(float v) { v = fmaxf(v, __shfl_xor(v, 16)); return fmaxf(v, __shfl_xor(v, 32)); }
__device__ __forceinline__ float xsum16(float v) { v += __shfl_xor(v, 16); return v + __shfl_xor(v, 32); }

__device__ __forceinline__ void nsa_fetch(const bf16* kv, int b, int jb, int g, int tid, v4u& kr, v4u& vr) {
    const bf16* p = kv + (size_t)(b * SEQ + 64 * jb + (tid >> 3)) * 256 + g * 64 + (tid & 7) * 8;
    kr = *(const v4u*)p; vr = *(const v4u*)(p + 128);
}
__device__ __forceinline__ void nsa_stash(LAS unsigned char* Kb, LAS unsigned char* Vb, int tid, const v4u& kr, const v4u& vr) {
    *(LAS v4u*)(Kb + ((tid >> 3) * NSA_KSTR + (tid & 7) * 8) * 2) = kr; *(LAS v4u*)(Vb + ((tid >> 3) * NSA_VSTR + (tid & 7) * 8) * 2) = vr;
}
template <bool FULL>
__device__ __forceinline__ void nsa_block2(const LAS unsigned char* Kb, const LAS unsigned char* Vb, const bf16x8 (&qf)[2][2], const bool (&sel)[2], const int (&klo)[2], const int (&khi)[2],
                                           float (&mrow)[2], float (&lrow)[2], f32x4v (&o)[2][4], int lane) {
    const int j = lane & 15, gq = lane >> 4;
    f32x4v s[2][4];
#pragma unroll
    for (int kt = 0; kt < 4; ++kt) {
        s[0][kt] = (f32x4v){0.f, 0.f, 0.f, 0.f}; s[1][kt] = (f32x4v){0.f, 0.f, 0.f, 0.f};
#pragma unroll
        for (int ks = 0; ks < 2; ++ks) {
            const bf16x8 kf = *(const LAS bf16x8*)(Kb + (16 * kt + j) * 128 + (((gq + 4 * ks) ^ (j & 7)) << 4));
            s[0][kt] = __builtin_amdgcn_mfma_f32_16x16x32_bf16(kf, qf[0][ks], s[0][kt], 0, 0, 0);
            s[1][kt] = __builtin_amdgcn_mfma_f32_16x16x32_bf16(kf, qf[1][ks], s[1][kt], 0, 0, 0);
        }
    }
#pragma unroll
    for (int rg = 0; rg < 2; ++rg) {
        float bm = NEGF;
        if (FULL) { const float bias = sel[rg] ? 0.f : NEGF;
#pragma unroll
            for (int kt = 0; kt < 4; ++kt)
#pragma unroll
                for (int e = 0; e < 4; ++e) { const float v = s[rg][kt][e] + bias; s[rg][kt][e] = v; bm = fmaxf(bm, v); }
        } else {
#pragma unroll
            for (int kt = 0; kt < 4; ++kt)
#pragma unroll
                for (int e = 0; e < 4; ++e) { const int ko = 16 * kt + 4 * gq + e; const bool ok = sel[rg] && ko >= klo[rg] && ko <= khi[rg]; const float v = ok ? s[rg][kt][e] : NEGF; s[rg][kt][e] = v; bm = fmaxf(bm, v); }
        }
        bm = xmax16(bm);
        const float mnew = fmaxf(mrow[rg], bm), alpha = __builtin_amdgcn_exp2f(mrow[rg] - mnew);
        const bool moved = __builtin_amdgcn_ballot_w64(mnew != mrow[rg]) != 0ull;
        mrow[rg] = mnew;
        float ps = 0.f;
#pragma unroll
        for (int kt = 0; kt < 4; ++kt)
#pragma unroll
            for (int e = 0; e < 4; ++e) { const float p = __builtin_amdgcn_exp2f(s[rg][kt][e] - mnew); s[rg][kt][e] = p; ps += p; }
        lrow[rg] = lrow[rg] * alpha + ps;
        if (moved) {
#pragma unroll
            for (int dt = 0; dt < 4; ++dt) o[rg][dt] *= alpha;
        }
    }
#pragma unroll
    for (int kk = 0; kk < 2; ++kk) {
        const bf16x8 pf0 = pack8(s[0][2 * kk][0], s[0][2 * kk][1], s[0][2 * kk][2], s[0][2 * kk][3], s[0][2 * kk + 1][0], s[0][2 * kk + 1][1], s[0][2 * kk + 1][2], s[0][2 * kk + 1][3]);
        const bf16x8 pf1 = pack8(s[1][2 * kk][0], s[1][2 * kk][1], s[1][2 * kk][2], s[1][2 * kk][3], s[1][2 * kk + 1][0], s[1][2 * kk + 1][1], s[1][2 * kk + 1][2], s[1][2 * kk + 1][3]);
#pragma unroll
        for (int dt = 0; dt < 4; ++dt) {
            const LAS unsigned char* va = Vb + (32 * kk + 4 * gq + (j >> 2)) * 128 + (16 * dt + 4 * (j & 3)) * 2;
            const bf16x8 vf = cat4(tr16(va), tr16(va + 16 * 128));
            o[0][dt] = __builtin_amdgcn_mfma_f32_16x16x32_bf16(vf, pf0, o[0][dt], 0, 0, 0);
            o[1][dt] = __builtin_amdgcn_mfma_f32_16x16x32_bf16(vf, pf1, o[1][dt], 0, 0, 0);
        }
        }
}
__device__ __forceinline__ void nsa_block4(const LAS unsigned char* KbA, const LAS unsigned char* VbA, const LAS unsigned char* KbB, const LAS unsigned char* VbB, const bf16x8 (&qf)[2][2],
                                           const bool (&selA)[2], const bool (&selB)[2], float (&mrow)[2], float (&lrow)[2], f32x4v (&o)[2][4], int lane) {
    const int j = lane & 15, gq = lane >> 4;
    f32x4v s[2][2][4];
#pragma unroll
    for (int bl = 0; bl < 2; ++bl) { const LAS unsigned char* Kb = bl ? KbB : KbA;
#pragma unroll
        for (int kt = 0; kt < 4; ++kt) {
            s[bl][0][kt] = (f32x4v){0.f, 0.f, 0.f, 0.f}; s[bl][1][kt] = (f32x4v){0.f, 0.f, 0.f, 0.f};
#pragma unroll
            for (int ks = 0; ks < 2; ++ks) {
                const bf16x8 kf = *(const LAS bf16x8*)(Kb + (16 * kt + j) * 128 + (((gq + 4 * ks) ^ (j & 7)) << 4));
                s[bl][0][kt] = __builtin_amdgcn_mfma_f32_16x16x32_bf16(kf, qf[0][ks], s[bl][0][kt], 0, 0, 0);
                s[bl][1][kt] = __builtin_amdgcn_mfma_f32_16x16x32_bf16(kf, qf[1][ks], s[bl][1][kt], 0, 0, 0);
            }
        } }
#pragma unroll
    for (int rg = 0; rg < 2; ++rg) {
        float ba = NEGF, bb = NEGF;
#pragma unroll
        for (int kt = 0; kt < 4; ++kt)
#pragma unroll
            for (int e = 0; e < 4; ++e) { ba = fmaxf(ba, s[0][rg][kt][e]); bb = fmaxf(bb, s[1][rg][kt][e]); }
        if (!selA[rg]) ba = NEGF;
        if (!selB[rg]) bb = NEGF;
        const float bm = xmax16(fmaxf(ba, bb));
        const float mnew = fmaxf(mrow[rg], bm), alpha = __builtin_amdgcn_exp2f(mrow[rg] - mnew);
        const bool moved = __builtin_amdgcn_ballot_w64(mnew != mrow[rg]) != 0ull;
        mrow[rg] = mnew;
        const float sa = selA[rg] ? mnew : 1e30f, sb = selB[rg] ? mnew : 1e30f;
        float ps = 0.f;
#pragma unroll
        for (int kt = 0; kt < 4; ++kt)
#pragma unroll
            for (int e = 0; e < 4; ++e) { const float pa = __builtin_amdgcn_exp2f(s[0][rg][kt][e] - sa), pb = __builtin_amdgcn_exp2f(s[1][rg][kt][e] - sb); s[0][rg][kt][e] = pa; s[1][rg][kt][e] = pb; ps += pa + pb; }
        lrow[rg] = lrow[rg] * alpha + ps;
        if (moved) {
#pragma unroll
            for (int dt = 0; dt < 4; ++dt) o[rg][dt] *= alpha;
        }
    }
#pragma unroll
    for (int bl = 0; bl < 2; ++bl) { const LAS unsigned char* Vb = bl ? VbB : VbA;
#pragma unroll
        for (int kk = 0; kk < 2; ++kk) {
            const bf16x8 pf0 = pack8(s[bl][0][2 * kk][0], s[bl][0][2 * kk][1], s[bl][0][2 * kk][2], s[bl][0][2 * kk][3], s[bl][0][2 * kk + 1][0], s[bl][0][2 * kk + 1][1], s[bl][0][2 * kk + 1][2], s[bl][0][2 * kk + 1][3]);
            const bf16x8 pf1 = pack8(s[bl][1][2 * kk][0], s[bl][1][2 * kk][1], s[bl][1][2 * kk][2], s[bl][1][2 * kk][3], s[bl][1][2 * kk + 1][0], s[bl][1][2 * kk + 1][1], s[bl][1][2 * kk + 1][2], s[bl][1][2 * kk + 1][3]);
#pragma unroll
            for (int dt = 0; dt < 4; ++dt) {
                const LAS unsigned char* va = Vb + (32 * kk + 4 * gq + (j >> 2)) * 128 + (16 * dt + 4 * (j & 3)) * 2;
                const bf16x8 vf = cat4(tr16(va), tr16(va + 16 * 128));
                o[0][dt] = __builtin_amdgcn_mfma_f32_16x16x32_bf16(vf, pf0, o[0][dt], 0, 0, 0);
                o[1][dt] = __builtin_amdgcn_mfma_f32_16x16x32_bf16(vf, pf1, o[1][dt], 0, 0, 0);
            }
        } }
}
__device__ __forceinline__ void glds16(const void* gsrc, unsigned lds_dst) { unsigned keep;
    asm volatile("s_mov_b32 %0, m0\n\ts_mov_b32 m0, %2\n\ts_nop 0\n\tglobal_load_lds_dwordx4 %1, off\n\ts_mov_b32 m0, %0" : "=&s"(keep) : "v"(gsrc), "s"(lds_dst) : "memory"); }
template <int MODE>
__device__ __forceinline__ void nsa_attend(const bf16* kv, unsigned long long mask, int b, int g, int c, int tid, int lane, LAS unsigned char* ring, const bf16x8 (&qf)[2][2],
                                           const unsigned long long (&rmask)[2], const unsigned long long (&gmask)[2], const int (&trow)[2], float (&mrow)[2], float (&lrow)[2], f32x4v (&o)[2][4]) {
    const int wave = __builtin_amdgcn_readfirstlane(tid >> 6);
    const int rr = 8 * wave + (lane >> 3);
    const bf16* gk = kv + (size_t)(b * SEQ + rr) * 256 + g * 64 + (((lane & 7) ^ (rr & 7)) << 3);
    const bf16* gv = kv + (size_t)(b * SEQ + rr) * 256 + 128 + g * 64 + ((lane & 7) << 3);
    const unsigned ring0 = (unsigned)(uintptr_t)(unsigned char*)ring + wave * 1024;
#define NSA_ISSUE(jb_, slot_) do { glds16(gk + (size_t)(jb_) * 64 * 256, (unsigned)__builtin_amdgcn_readfirstlane(ring0 + (slot_) * NSA_SLOT)); \
                                   glds16(gv + (size_t)(jb_) * 64 * 256, (unsigned)__builtin_amdgcn_readfirstlane(ring0 + (slot_) * NSA_SLOT + 8192)); } while (0)
    unsigned long long remi = mask, remc = mask; int lastb = 0, si = 0, sc_ = 0;
#if DUP == 12
    float m2_[2] = {NEGF, NEGF}, l2_[2] = {0.f, 0.f}; f32x4v o2_[2][4]; for (int rg = 0; rg < 2; ++rg) for (int dt = 0; dt < 4; ++dt) o2_[rg][dt] = (f32x4v){0.f, 0.f, 0.f, 0.f};
#endif
#define NSA_ISSUE1() do { if (remi) { lastb = (int)__builtin_ctzll(remi); remi &= remi - 1ull; } NSA_ISSUE(lastb, si); si = si + 1 == NSA_D ? 0 : si + 1; } while (0)
#define NSA_FLAGS(jj_, sel_, klo_, khi_, act_) do { _Pragma("unroll") for (int rg = 0; rg < 2; ++rg) { const int o6 = trow[rg] & 63; \
            if (MODE == 0) { sel_[rg] = (rmask[rg] >> (jj_)) & 1ull; act_[rg] = (gmask[rg] >> (jj_)) & 1ull; klo_[rg] = 0; khi_[rg] = ((jj_) == c) ? o6 : 63; } \
            else { sel_[rg] = true; act_[rg] = true; klo_[rg] = ((jj_) == c - 4) ? o6 + 1 : 0; khi_[rg] = ((jj_) == c) ? o6 : 63; } } } while (0)
    NSA_ISSUE1(); NSA_ISSUE1(); NSA_ISSUE1(); NSA_ISSUE1();
    while (remc) {
        const int jA = (int)__builtin_ctzll(remc); remc &= remc - 1ull;
        const bool two = remc != 0ull; const int jB = two ? (int)__builtin_ctzll(remc) : jA; if (two) remc &= remc - 1ull;
        asm volatile("s_waitcnt vmcnt(4) lgkmcnt(0)\n\ts_barrier" ::: "memory");
        NSA_ISSUE1(); NSA_ISSUE1();
        const LAS unsigned char* kA = ring + sc_ * NSA_SLOT; const LAS unsigned char* vA = kA + 8192; const LAS unsigned char* kB = kA + NSA_SLOT; const LAS unsigned char* vB = kB + 8192;
        sc_ = sc_ + 2 == NSA_D ? 0 : sc_ + 2;
        bool selA[2], selB[2], actA[2], actB[2]; int kloA[2], khiA[2], kloB[2], khiB[2];
        NSA_FLAGS(jA, selA, kloA, khiA, actA); NSA_FLAGS(jB, selB, kloB, khiB, actB);
        const bool fullA = (MODE == 0) ? (jA != c) : (jA != c && jA != c - 4), fullB = (MODE == 0) ? (jB != c) : (jB != c && jB != c - 4);
        const bool doA = actA[0] || actA[1], doB = two && (actB[0] || actB[1]);
        if (NSA_JOINT && MODE == 0 && doA && doB && fullA && fullB) nsa_block4(kA, vA, kB, vB, qf, selA, selB, mrow, lrow, o, lane);
        else {
            if (doA) { if (fullA) nsa_block2<true>(kA, vA, qf, selA, kloA, khiA, mrow, lrow, o, lane); else nsa_block2<false>(kA, vA, qf, selA, kloA, khiA, mrow, lrow, o, lane); }
            if (doB) { if (fullB) nsa_block2<true>(kB, vB, qf, selB, kloB, khiB, mrow, lrow, o, lane); else nsa_block2<false>(kB, vB, qf, selB, kloB, khiB, mrow, lrow, o, lane); }
        }
    }
#undef NSA_ISSUE1
#undef NSA_FLAGS
    asm volatile("s_waitcnt vmcnt(0) lgkmcnt(0)\n\ts_barrier" ::: "memory");
#undef NSA_ISSUE
}
#if defined(PROBE_CMP)
__device__ __forceinline__ void nsa_probe_store(unsigned char* ws, int row, int head, int gq, const f32x4v (&v)[4]) {
    bf16* pb_ = (bf16*)(ws + 497 * MiB);
    for (int dt = 0; dt < 4; ++dt) { uint2 w; w.x = cvtpk(v[dt][0], v[dt][1]); w.y = cvtpk(v[dt][2], v[dt][3]); *(uint2*)(pb_ + (size_t)row * 512 + head * 64 + 16 * dt + 4 * gq) = w; }
}
#endif
__device__ __forceinline__ void nsa_unit(unsigned char* ws, int unit, LAS unsigned char* lds, int tid_in, bf16* yout) {
    int tid = tid_in; asm volatile("" : "+v"(tid));
    const int lane = tid & 63, wave = __builtin_amdgcn_readfirstlane(tid >> 6), j = lane & 15, gq = lane >> 4;
    const int c = unit & 63, g = (unit >> 6) & 1, b = unit >> 7, bg = b * 2 + g;
    LAS float* impa = (LAS float*)(lds + NSA_OFF_IMPA); LAS float* impb = (LAS float*)(lds + NSA_OFF_IMPB);
    LAS unsigned long long* um = (LAS unsigned long long*)(lds + NSA_OFF_UM);
    TP_DECL
    for (int i = tid; i < 2 * 64 * 65; i += 512) impa[i] = 0.f;
    {
        const v4u* ksrc = (const v4u*)((const bf16*)(ws + WS_KC) + (size_t)bg * 256 * 64); const v4u* vsrc = (const v4u*)((const bf16*)(ws + WS_VC) + (size_t)bg * 64 * 256);
        v4u kst[4], vst[4];
#pragma unroll
        for (int i = 0; i < 4; ++i) { kst[i] = ksrc[tid + 512 * i]; vst[i] = vsrc[tid + 512 * i]; }
#pragma unroll
        for (int i = 0; i < 4; ++i) { const int idx = tid + 512 * i; const int r = idx >> 3, sg = idx & 7; *(LAS v4u*)(lds + NSA_OFF_KCL + r * 128 + ((sg ^ (r & 7)) << 4)) = kst[i]; }
#pragma unroll
        for (int i = 0; i < 4; ++i) { const int idx = tid + 512 * i; const int r = idx >> 5, sg = idx & 31; *(LAS v4u*)(lds + NSA_OFF_VCTL + r * 512 + ((sg ^ (r & 15)) << 4)) = vst[i]; }
    }
    bf16* qc = (bf16*)(ws + WS_QC);
    const bf16* misc = (const bf16*)(ws + WS_MISC);
    bf16x8 qf[2][2]; float gate[2][3]; int trow[2];
#pragma unroll
    for (int rg = 0; rg < 2; ++rg) {
        const int q = 8 * wave + 4 * rg + (j >> 2), t = 64 * c + q, row = b * SEQ + t, head = g * 4 + (j & 3);
        trow[rg] = t;
#pragma unroll
        for (int ks = 0; ks < 2; ++ks) qf[rg][ks] = *(const bf16x8*)(qc + (size_t)row * 512 + head * 64 + 8 * gq + 32 * ks);
        gate[rg][0] = __builtin_amdgcn_rcpf(1.0f + __expf(-bf2f(misc[(size_t)row * 256 + 196 + head * 3])));
    }
    typedef unsigned u32x2v __attribute__((ext_vector_type(2)));
    LAS u32x2v* stash = (LAS u32x2v*)(lds + NSA_OFF_ST) + tid * 8;
    __syncthreads();
    const int nT = (c >> 2) + 1;
#pragma unroll
    for (int rg = 0; rg < 2; ++rg) {
        const int t = trow[rg], nv = t >= 31 ? ((t - 15) >> 4) : 0;
        f32x4v s[16]; float mx = NEGF;
#pragma unroll
        for (int T = 0; T < 16; ++T) {
            s[T] = (f32x4v){0.f, 0.f, 0.f, 0.f};
            if (T < nT) {
#pragma unroll
                for (int ks = 0; ks < 2; ++ks) { const bf16x8 kf = *(const LAS bf16x8*)(lds + NSA_OFF_KCL + (16 * T + j) * 128 + (((gq + 4 * ks) ^ (j & 7)) << 4)); s[T] = __builtin_amdgcn_mfma_f32_16x16x32_bf16(kf, qf[rg][ks], s[T], 0, 0, 0); }
#pragma unroll
                for (int e = 0; e < 4; ++e) { const float v = (16 * T + 4 * gq + e < nv) ? s[T][e] : NEGF; s[T][e] = v; mx = fmaxf(mx, v); }
            }
        }
        mx = xmax16(mx);
        float ls = 0.f;
#pragma unroll
        for (int T = 0; T < 16; ++T) if (T < nT) {
#pragma unroll
            for (int e = 0; e < 4; ++e) { const float p = (16 * T + 4 * gq + e < nv) ? __builtin_amdgcn_exp2f(s[T][e] - mx) : 0.f; s[T][e] = p; ls += p; }
        }
        ls = xsum16(ls);
        const float inv = nv > 0 ? __builtin_amdgcn_rcpf(ls) : 0.f;
        const int q = 8 * wave + 4 * rg + (j >> 2);
#pragma unroll
        for (int T = 0; T < 16; ++T) if (T < nT) {
#pragma unroll
            for (int e = 0; e < 4; ++e) s[T][e] *= inv;
            float a = s[T][0] + s[T][1] + s[T][2] + 0.5f * s[T][3], bb = 0.5f * s[T][3];
            a += qxor1(a); a += qxor2(a); bb += qxor1(bb); bb += qxor2(bb);
            if ((j & 3) == 0) { impa[q * 65 + 4 * T + gq] = a; impb[q * 65 + 4 * T + gq + 1] = bb; }
        }
        f32x4v oc[4];
#pragma unroll
        for (int dt = 0; dt < 4; ++dt) oc[dt] = (f32x4v){0.f, 0.f, 0.f, 0.f};
#pragma unroll
        for (int kk = 0; kk < 8; ++kk) if (2 * kk < nT) {
            const bf16x8 pf = pack8(s[2 * kk][0], s[2 * kk][1], s[2 * kk][2], s[2 * kk][3], s[2 * kk + 1][0], s[2 * kk + 1][1], s[2 * kk + 1][2], s[2 * kk + 1][3]);
#pragma unroll
            for (int dt = 0; dt < 4; ++dt) {
                const LAS unsigned char* vp = lds + NSA_OFF_VCTL + (16 * dt + j) * 512 + (gq & 1) * 8;
                const s16x4 v0 = *(const LAS s16x4*)(vp + ((((8 * kk + gq) >> 1) ^ j) << 4)), v1 = *(const LAS s16x4*)(vp + (((((8 * kk + gq) >> 1) + 2) ^ j) << 4));
                oc[dt] = __builtin_amdgcn_mfma_f32_16x16x32_bf16(cat4(v0, v1), pf, oc[dt], 0, 0, 0);
            }
        }
#pragma unroll
        for (int dt = 0; dt < 4; ++dt) { const f32x4v v = oc[dt] * gate[rg][0]; u32x2v w; w.x = pg8::cvt_pk_bf16(v[0], v[1]); w.y = pg8::cvt_pk_bf16(v[2], v[3]); stash[rg * 4 + dt] = w; }
        __builtin_amdgcn_sched_barrier(0);
    }
    __syncthreads();
    TP_MARK(5);
    unsigned long long smask[8], mymask = 0ull;
#pragma unroll
    for (int qi = 0; qi < 8; ++qi) {
        const int q = 8 * wave + qi;
#if PROBE == 4
        const float imp = ((const float*)(ws + 500 * MiB))[((size_t)(b * SEQ + 64 * c + q) * 2 + g) * 64 + lane];
#else
        const float imp = impa[q * 65 + lane] + impb[q * 65 + lane];
#endif
#if PROBE && (PROBE != 5 || defined(PROBE5_IMP))
        ((float*)(ws + 516 * MiB))[((size_t)(b * SEQ + 64 * c + q) * 2 + g) * 64 + lane] = (lane <= c) ? imp : 0.f;
#endif
        const bool forced = (lane == 0) || (lane == c), adm = lane <= c;
        unsigned key = forced ? (0xFFFFFF00u | (unsigned)(63 - lane)) : (adm ? ((__float_as_uint(imp) & 0xFFFFFFC0u) | (unsigned)(63 - lane)) : 0u);
        unsigned long long mk = 0ull;
#if TOP8_RANK
        { int rank = 0;
#pragma unroll
          for (int jj = 0; jj < 64; ++jj) { const unsigned kk = (unsigned)__builtin_amdgcn_readlane((int)key, jj); rank += (kk > key) ? 1 : 0; }
          mk = __ballot(key != 0u && rank < 8); }
#else
        for (int k = 0; k < 8; ++k) { const unsigned mx = wave_max_u(key); if (mx == 0u) break; const int win = 63 - (int)(mx & 63u); mk |= 1ull << win; if (lane == win) key = 0u; }
#endif
        mk = ((unsigned long long)(unsigned)__builtin_amdgcn_readfirstlane((unsigned)(mk >> 32)) << 32) | (unsigned long long)(unsigned)__builtin_amdgcn_readfirstlane((unsigned)mk);
#ifdef FIXSEL
        { mk = 1ull | (1ull << c); for (int d = 1; d <= 6; ++d) mk |= 1ull << (((FIXHOM ? 0 : q * 7) + d * 5) % (c + 1)); }
#endif
#if PROBE == 2
        mk = ((const unsigned long long*)(ws + 496 * MiB))[(size_t)(b * SEQ + 64 * c + q) * 2 + g];
        mk = ((unsigned long long)(unsigned)__builtin_amdgcn_readfirstlane((unsigned)(mk >> 32)) << 32) | (unsigned long long)(unsigned)__builtin_amdgcn_readfirstlane((unsigned)mk);
#endif
#if PROBE == 5
        if (lane == 0) ((unsigned long long*)(ws + 498 * MiB))[(size_t)(b * SEQ + 64 * c + q) * 2 + g] = mk;
#endif
#if PROBE == 5 && !defined(PROBE5_IMP)
        ((float*)(ws + 516 * MiB))[((size_t)(b * SEQ + 64 * c + q) * 2 + g) * 64 + lane] = ((mk >> lane) & 1ull) ? 1.f : 0.f;
#endif
        smask[qi] = mk; mymask |= mk;
    }
    if (lane == 0) um[wave] = mymask;
    __syncthreads();
    unsigned long long umask = 0ull;
#pragma unroll
    for (int w = 0; w < 8; ++w) umask |= um[w];
    umask = ((unsigned long long)(unsigned)__builtin_amdgcn_readfirstlane((unsigned)(umask >> 32)) << 32) | (unsigned long long)(unsigned)__builtin_amdgcn_readfirstlane((unsigned)umask);
    unsigned long long rmask[2];
    { LAS unsigned long long* qm = (LAS unsigned long long*)(lds + NSA_OFF_QM);
      __syncthreads();
#pragma unroll
      for (int qi = 0; qi < 8; ++qi) if (lane == 0) qm[8 * wave + qi] = smask[qi];
      __syncthreads();
#pragma unroll
      for (int rg = 0; rg < 2; ++rg) rmask[rg] = qm[8 * wave + 4 * rg + (j >> 2)]; }
    const unsigned long long gmask[2] = {smask[0] | smask[1] | smask[2] | smask[3], smask[4] | smask[5] | smask[6] | smask[7]};
    TP_MARK(6); TP_ADD(9, __popcll(umask)); TP_ADD(10, 1); TP_ADD(11, c + 1); TP_ADD(12, __popcll(umask & ~(c == 63 ? ~0ull : ((2ull << c) - 1ull)))); TP_ADD(13, __popcll(smask[0]));
    const bf16* kvs = (const bf16*)(ws + WS_KVS); const bf16* kvw = (const bf16*)(ws + WS_KVW);
    LAS unsigned char* ring = lds + NSA_OFF_RING;
    {
        float mrow[2] = {NEGF, NEGF}, lrow[2] = {0.f, 0.f}; f32x4v o[2][4];
#pragma unroll
        for (int rg = 0; rg < 2; ++rg)
#pragma unroll
            for (int dt = 0; dt < 4; ++dt) o[rg][dt] = (f32x4v){0.f, 0.f, 0.f, 0.f};
        nsa_attend<0>(kvs, umask, b, g, c, tid, lane, ring, qf, rmask, gmask, trow, mrow, lrow, o);
#if DUP == 8
        { __syncthreads(); float m2[2] = {NEGF, NEGF}, l2[2] = {0.f, 0.f}; f32x4v o2[2][4];
          for (int rg = 0; rg < 2; ++rg) for (int dt = 0; dt < 4; ++dt) o2[rg][dt] = (f32x4v){0.f, 0.f, 0.f, 0.f};
          nsa_attend<0>(kvs, umask, b, g, c, tid, lane, Kb, Vb, qf, rmask, gmask, trow, m2, l2, o2);
          bf16* dmy = (bf16*)(ws + WS_BU) + (size_t)(b * SEQ + trow[0]) * 512 + (g * 4 + (j & 3)) * 64 + 4 * gq;
          for (int rg = 0; rg < 2; ++rg) for (int dt = 0; dt < 4; ++dt) { uint2 w; w.x = pg8::cvt_pk_bf16(o2[rg][dt][0] + l2[rg], o2[rg][dt][1]); w.y = pg8::cvt_pk_bf16(o2[rg][dt][2], o2[rg][dt][3]); *(uint2*)(dmy + 16 * dt) = w; } }
#endif
#pragma unroll
        for (int rg = 0; rg < 2; ++rg) { const float g1_ = __builtin_amdgcn_rcpf(1.0f + __expf(-bf2f(misc[(size_t)(b * SEQ + trow[rg]) * 256 + 196 + (g * 4 + (j & 3)) * 3 + 1]))); const float sc = g1_ * __builtin_amdgcn_rcpf(xsum16(lrow[rg]));
#pragma unroll
            for (int dt = 0; dt < 4; ++dt) { const u32x2v p = stash[rg * 4 + dt]; const f32x4v v = o[rg][dt] * sc; u32x2v w; w.x = pg8::cvt_pk_bf16(v[0] + bflo(p.x), v[1] + bfhi(p.x)); w.y = pg8::cvt_pk_bf16(v[2] + bflo(p.y), v[3] + bfhi(p.y)); stash[rg * 4 + dt] = w; }
            }
        __syncthreads();
    }
    TP_MARK(7);
    {
        float mrow[2] = {NEGF, NEGF}, lrow[2] = {0.f, 0.f}; f32x4v o[2][4];
#pragma unroll
        for (int rg = 0; rg < 2; ++rg)
#pragma unroll
            for (int dt = 0; dt < 4; ++dt) o[rg][dt] = (f32x4v){0.f, 0.f, 0.f, 0.f};
        { const int j0 = c - 4 > 0 ? c - 4 : 0; const unsigned long long wmask = ((c == 63 ? ~0ull : ((1ull << (c + 1)) - 1ull)) >> j0) << j0;
          nsa_attend<1>(kvw, wmask, b, g, c, tid, lane, ring, qf, rmask, gmask, trow, mrow, lrow, o); }
#pragma unroll
        for (int rg = 0; rg < 2; ++rg) { const float g2_ = __builtin_amdgcn_rcpf(1.0f + __expf(-bf2f(misc[(size_t)(b * SEQ + trow[rg]) * 256 + 196 + (g * 4 + (j & 3)) * 3 + 2]))); const float sc = g2_ * __builtin_amdgcn_rcpf(xsum16(lrow[rg]));
#pragma unroll
            for (int dt = 0; dt < 4; ++dt) { const u32x2v p = stash[rg * 4 + dt]; const f32x4v v = o[rg][dt] * sc; uint2 w; w.x = pg8::cvt_pk_bf16(v[0] + bflo(p.x), v[1] + bfhi(p.x)); w.y = pg8::cvt_pk_bf16(v[2] + bflo(p.y), v[3] + bfhi(p.y));
                *(uint2*)(yout + (size_t)(b * SEQ + trow[rg]) * 512 + (g * 4 + (j & 3)) * 64 + 16 * dt + 4 * gq) = w; }
            }
    }
    __syncthreads();
    TP_MARK(8);
}
__device__ __forceinline__ void prep_kva16(unsigned char* ws, int task, int lane) {
    const int j = lane & 15, gq = lane >> 4, row = task * 16 + j;
    const bf16* misc = (const bf16*)(ws + WS_MISC) + (size_t)row * 256 + 64;
    const bf16* wu = (const bf16*)(ws + WS_W + WO_UKV);
    bf16x8 cf[4]; float ss = 0.f;
#pragma unroll
    for (int ks = 0; ks < 4; ++ks) { const v4u v = *(const v4u*)(misc + 8 * gq + 32 * ks); cf[ks] = __builtin_bit_cast(bf16x8, v); float f[8]; unpack8(v, f);
#pragma unroll
        for (int e = 0; e < 8; ++e) ss += f[e] * f[e]; }
    ss = xsum16(ss);
    const float r = 1.0f / sqrtf(ss * (1.f / 128.f) + EPS);
    const float* rp = (const float*)(ws + WS_ROPE) + (size_t)row * 16;
    bf16* o = (bf16*)(ws + WS_KVA) + (size_t)row * 128;
#pragma unroll
    for (int ct = 0; ct < 8; ++ct) {
        f32x4v a = {0.f, 0.f, 0.f, 0.f};
#pragma unroll
        for (int ks = 0; ks < 4; ++ks) { const bf16x8 wf = *(const bf16x8*)(wu + (size_t)(16 * ct + j) * 128 + 8 * gq + 32 * ks); a = __builtin_amdgcn_mfma_f32_16x16x32_bf16(wf, cf[ks], a, 0, 0, 0); }
        a *= r;
        if (ct == 0) {
            const float c0 = rp[2 * gq], s0 = rp[8 + 2 * gq], c1 = rp[2 * gq + 1], s1 = rp[8 + 2 * gq + 1];
            const float x0 = a[0], x1 = a[1], x2 = a[2], x3 = a[3];
            a[0] = x0 * c0 - x1 * s0; a[1] = x1 * c0 + x0 * s0; a[2] = x2 * c1 - x3 * s1; a[3] = x3 * c1 + x2 * s1;
        }
        uint2 w; w.x = cvtpk(a[0], a[1]); w.y = cvtpk(a[2], a[3]);
        *(uint2*)(o + 16 * ct + 4 * gq) = w;
    }
}
__device__ __forceinline__ void prep_pool16(unsigned char* ws, int task, int lane, const LAS unsigned char* wl, bf16* ybuf) {
    const int j = lane & 15, gq = lane >> 4, row = task * 16 + j, t = row & (SEQ - 1);
    const bf16* bu = (const bf16*)(ws + WS_BU);
    bf16* yb = ybuf + (size_t)row * 512;
#pragma unroll 1
    for (int g = 0; g < 4; ++g) {
        const int w = 2 << g, lo = (t + 1 - w) > 0 ? (t + 1 - w) : 0, cnt = t + 1 - lo; const float inv = 1.0f / (float)cnt;
        bf16x8 pf[4];
#pragma unroll
        for (int ks = 0; ks < 4; ++ks) {
            const bf16* p = bu + (size_t)row * 512 + g * 128 + 8 * gq + 32 * ks;
            float sum[8] = {0.f, 0.f, 0.f, 0.f, 0.f, 0.f, 0.f, 0.f}, cur[8];
            { const v4u v = *(const v4u*)p; unpack8(v, cur);
#pragma unroll
              for (int e = 0; e < 8; ++e) sum[e] = cur[e]; }
            v4u wv_[15];
#pragma unroll
            for (int i = 1; i < 16; ++i) if (i < w) wv_[i - 1] = *(const v4u*)(p - (size_t)(i < cnt ? i : 0) * 512);
#pragma unroll
            for (int i = 1; i < 16; ++i) if (i < w) { const bool ok = i < cnt; float f[8]; unpack8(wv_[i - 1], f);
#pragma unroll
                for (int e = 0; e < 8; ++e) sum[e] += ok ? f[e] : 0.f; }
            __builtin_amdgcn_sched_barrier(0);
            pf[ks] = pack8(sum[0] * inv - cur[0], sum[1] * inv - cur[1], sum[2] * inv - cur[2], sum[3] * inv - cur[3], sum[4] * inv - cur[4], sum[5] * inv - cur[5], sum[6] * inv - cur[6], sum[7] * inv - cur[7]);
        }
#pragma unroll
        for (int dt = 0; dt < 8; ++dt) {
            f32x4v a = {0.f, 0.f, 0.f, 0.f};
#pragma unroll
            for (int ks = 0; ks < 4; ++ks) {
#if POOLDBG == 1
                bf16x8 wf; for (int e = 0; e < 8; ++e) wf[e] = (short)0x3c00;
#else
                const bf16x8 wf = *(const LAS bf16x8*)(wl + (g * 128 + 16 * dt + j) * 256 + (((gq + 4 * ks) ^ j) << 4));
#endif
#if POOLDBG == 2
                bf16x8 pz; for (int e = 0; e < 8; ++e) pz[e] = (short)0x3c00; a = __builtin_amdgcn_mfma_f32_16x16x32_bf16(wf, pz, a, 0, 0, 0);
#else
                a = __builtin_amdgcn_mfma_f32_16x16x32_bf16(wf, pf[ks], a, 0, 0, 0);
#endif
            }
            uint2 wv; wv.x = cvtpk(a[0], a[1]); wv.y = cvtpk(a[2], a[3]);
            *(uint2*)(yb + g * 128 + 16 * dt + 4 * gq) = wv;
        }
    }
}
__device__ __forceinline__ float gelu_tanh_f(float x) { const float u = 0.7978845608028654f * (x + 0.044715f * x * x * x); const float e = __expf(2.0f * u); return 0.5f * x * (1.0f + (1.0f - 2.0f / (e + 1.0f))); }
__device__ __forceinline__ void prep_cmp16(unsigned char* ws, int task, LAS unsigned char* lds, int wave, int lane) {
    const int j = lane & 15, gq = lane >> 4, grp = wave >> 2, wq = wave & 3;
    const int i0 = (task & 15) * 16, bg = (task >> 4) & 15, br = task >> 8, b = bg >> 1, g = bg & 1, i = i0 + j;
    const bf16* kvc = (const bf16*)(ws + WS_KVC);
    const bf16* w1 = (const bf16*)(ws + WS_W + WO_CW1) + (size_t)br * 128 * 2048;
    const bf16* w2 = (const bf16*)(ws + WS_W + WO_CW2) + (size_t)br * 64 * 128;
    const float* posb = (const float*)(ws + WS_W + WO_POSB) + br * 128;
    LAS float* part = (LAS float*)lds + (size_t)grp * 4 * 32 * 64;
    f32x4v h[8];
#pragma unroll
    for (int nt = 0; nt < 8; ++nt) h[nt] = (f32x4v){0.f, 0.f, 0.f, 0.f};
#define CMP_LOAD(k2_, wf_, ff_) do { const int ks_ = 16 * wq + (k2_), l_ = ks_ >> 1; int tok_ = 16 * i + l_; tok_ = tok_ > SEQ - 1 ? SEQ - 1 : tok_;     \
        ff_ = *(const bf16x8*)(kvc + (size_t)(b * SEQ + tok_) * 256 + br * 128 + g * 64 + 32 * (ks_ & 1) + 8 * gq); \
        _Pragma("unroll") for (int nt_ = 0; nt_ < 8; ++nt_) wf_[nt_] = *(const bf16x8*)(w1 + (size_t)(16 * nt_ + j) * 2048 + 32 * ks_ + 8 * gq); } while (0)
    bf16x8 wfA[8], wfB[8], ffA, ffB;
    CMP_LOAD(0, wfA, ffA);
#pragma unroll
    for (int k2 = 0; k2 < 16; k2 += 2) {
        CMP_LOAD(k2 + 1, wfB, ffB);
        __builtin_amdgcn_sched_barrier(0);
#pragma unroll
        for (int nt = 0; nt < 8; ++nt) h[nt] = __builtin_amdgcn_mfma_f32_16x16x32_bf16(wfA[nt], ffA, h[nt], 0, 0, 0);
        if (k2 + 2 < 16) CMP_LOAD(k2 + 2, wfA, ffA);
        __builtin_amdgcn_sched_barrier(0);
#pragma unroll
        for (int nt = 0; nt < 8; ++nt) h[nt] = __builtin_amdgcn_mfma_f32_16x16x32_bf16(wfB[nt], ffB, h[nt], 0, 0, 0);
    }
#undef CMP_LOAD
#pragma unroll
    for (int nt = 0; nt < 8; ++nt)
#pragma unroll
        for (int e = 0; e < 4; ++e) part[(wq * 32 + nt * 4 + e) * 64 + lane] = h[nt][e];
    f32x4v pbv_[8];
#pragma unroll
    for (int nt = 0; nt < 8; ++nt) pbv_[nt] = *(const f32x4v*)(posb + 16 * nt + 4 * gq);
    __syncthreads();
    if (wq == 0) {
#pragma unroll
        for (int nt = 0; nt < 8; ++nt) { const f32x4v pbv = pbv_[nt];
#pragma unroll
            for (int e = 0; e < 4; ++e) { const int idx = (nt * 4 + e) * 64 + lane; h[nt][e] = gelu_tanh_f(((part[idx] + part[32 * 64 + idx]) + (part[2 * 32 * 64 + idx] + part[3 * 32 * 64 + idx])) + pbv[e]); } }
        f32x4v o[4];
#pragma unroll
        for (int dt = 0; dt < 4; ++dt) o[dt] = (f32x4v){0.f, 0.f, 0.f, 0.f};
        s16x4 w2a[4][4], w2b[4][4];
#pragma unroll
        for (int kk = 0; kk < 4; ++kk)
#pragma unroll
            for (int dt = 0; dt < 4; ++dt) { const bf16* wp = w2 + (size_t)(16 * dt + j) * 128 + 32 * kk + 4 * gq; w2a[kk][dt] = *(const s16x4*)wp; w2b[kk][dt] = *(const s16x4*)(wp + 16); }
        __builtin_amdgcn_sched_barrier(0);
#pragma unroll
        for (int kk = 0; kk < 4; ++kk) {
            const bf16x8 hf = pack8(h[2 * kk][0], h[2 * kk][1], h[2 * kk][2], h[2 * kk][3], h[2 * kk + 1][0], h[2 * kk + 1][1], h[2 * kk + 1][2], h[2 * kk + 1][3]);
#pragma unroll
            for (int dt = 0; dt < 4; ++dt) o[dt] = __builtin_amdgcn_mfma_f32_16x16x32_bf16(cat4(w2a[kk][dt], w2b[kk][dt]), hf, o[dt], 0, 0, 0);
        }
        const bool dead = i == 255;
        if (br == 0) { bf16* kc = (bf16*)(ws + WS_KC) + ((size_t)bg * 256 + i) * 64;
#pragma unroll
            for (int dt = 0; dt < 4; ++dt) { uint2 w; w.x = dead ? 0u : cvtpk(o[dt][0], o[dt][1]); w.y = dead ? 0u : cvtpk(o[dt][2], o[dt][3]); *(uint2*)(kc + 16 * dt + 4 * gq) = w; }
        } else { bf16* vct = (bf16*)(ws + WS_VC) + (size_t)bg * 64 * 256 + i;
#pragma unroll
            for (int dt = 0; dt < 4; ++dt)
#pragma unroll
                for (int e = 0; e < 4; ++e) vct[(size_t)(16 * dt + 4 * gq + e) * 256] = dead ? (bf16)0 : (bf16)f2bf(o[dt][e]);
        }
    }
    __syncthreads();
}
__device__ __forceinline__ void phase_prep(const Args& P, unsigned char* ws, int z, int l, LAS unsigned char* lds, int gw, int NGW, int lane, int wave, bf16* ybuf) {
    asm volatile("" : "+v"(lane)); lane &= 63; asm volatile("" : "+s"(gw), "+s"(NGW));
#if TPROBE
    const int tid = (wave << 6) | lane; unsigned long long tp_t_ = __builtin_amdgcn_s_memtime();
#endif
    for (int it = 2 * (gw >> 3) + (wave >> 2); it < 512 + (wave >> 2); it += 2 * (NGW >> 3)) prep_cmp16(ws, it < 512 ? it : 511, lds, wave, lane);
    TP_MARK(27);
    {
        const v4u* src = (const v4u*)(ws + WS_W + WO_POOL); const int t_ = (wave << 6) | lane;
        v4u pst[16];
#pragma unroll
        for (int i = 0; i < 16; ++i) pst[i] = src[t_ + 512 * i];
#pragma unroll
        for (int i = 0; i < 16; ++i) { const int idx = t_ + 512 * i, r = idx >> 4, sg = idx & 15; *(LAS v4u*)(lds + r * 256 + ((sg ^ (r & 15)) << 4)) = pst[i]; }
        __syncthreads();
    }
    TP_MARK(28);
    for (int it = gw; it < M / 16; it += NGW) { prep_kva16(ws, it, lane); TP_MARK(29); prep_pool16(ws, it, lane, lds, ybuf); }
    __syncthreads();
    TP_MARK(31);
}
constexpr int DSA_K = DSA_K_V, DSA_S = 32 - DSA_K, DSA_CAP = DSA_CAP_V;
constexpr int DSA_OFF_CNT = 0, DSA_OFF_PC = 3072, DSA_OFF_LIST = DSA_OFF_PC + 32 * 16 * 4, DSA_OFF_V = DSA_OFF_LIST + 16 * 256 * 2, DSA_VB = 64 * NSA_VSTR * 2, DSA_LDS = DSA_OFF_V + 8 * DSA_VB;
#define DSA_FOR_TILES(...) _Pragma("unroll") for (int G8 = 0; G8 < 8; ++G8) { if (G8 < ngrp) { _Pragma("unroll") for (int T8 = 0; T8 < 4; ++T8) { const int T = G8 * 4 + T8; __VA_ARGS__ } } }
__device__ __forceinline__ void cnt_ge(int& c, unsigned u, unsigned cand) { asm volatile("v_cmp_ge_u32_e32 vcc, %1, %2\n\tv_addc_co_u32_e32 %0, vcc, 0, %0, vcc" : "+v"(c) : "v"(u), "v"(cand) : "vcc"); }
__device__ __forceinline__ void cnt_gt(int& c, unsigned u, unsigned cand) { asm volatile("v_cmp_gt_u32_e32 vcc, %1, %2\n\tv_addc_co_u32_e32 %0, vcc, 0, %0, vcc" : "+v"(c) : "v"(u), "v"(cand) : "vcc"); }
__device__ __forceinline__ void cnt_le(int& c, unsigned u, unsigned cand) { asm volatile("v_cmp_le_u32_e32 vcc, %1, %2\n\tv_addc_co_u32_e32 %0, vcc, 0, %0, vcc" : "+v"(c) : "v"(u), "v"(cand) : "vcc"); }
__device__ __forceinline__ int dsa_total(LAS unsigned* cnt, int par, int wave, int j, int gq, int c) {
    c += __shfl_xor(c, 16); c += __shfl_xor(c, 32);
    if (gq == 0) cnt[(par * 8 + wave) * 16 + j] = (unsigned)c;
    __syncthreads();
    int tot = 0;
#pragma unroll
    for (int w = 0; w < 8; ++w) tot += (int)cnt[(par * 8 + w) * 16 + j];
    return tot;
}
__device__ __forceinline__ void dsa_unit(unsigned char* ws, int unit, LAS unsigned char* lds, int tid_in, bf16* yout) {
    int tid = tid_in; asm volatile("" : "+v"(tid));
    const int lane = tid & 63, wave = __builtin_amdgcn_readfirstlane(tid >> 6), j = lane & 15, gq = lane >> 4;
    const int b = unit >> 8, q0 = (unit & 255) * 16, t = q0 + j, row = b * SEQ + t;
    LAS unsigned* cnt = (LAS unsigned*)(lds + DSA_OFF_CNT); LAS unsigned* pc = (LAS unsigned*)(lds + DSA_OFF_PC);
    LAS unsigned short* list = (LAS unsigned short*)(lds + DSA_OFF_LIST);
    const bf16* misc = (const bf16*)(ws + WS_MISC);
    TP_DECL
    if (q0 >= 256) {
        const int ntiles = (q0 >> 4) + 1;
        const int ntl = wave < ntiles ? ((ntiles - 1 - wave) >> 3) + 1 : 0;
        const int ngrp = (ntl + 3) >> 2;
        bf16x8 qf[4][2]; float iw[4];
        { const bf16* iq = (const bf16*)(ws + WS_IQ) + (size_t)row * 256;
#pragma unroll
          for (int h = 0; h < 4; ++h) { iw[h] = 0.5f * bf2f(misc[(size_t)row * 256 + 192 + h]);
#pragma unroll
              for (int ks = 0; ks < 2; ++ks) qf[h][ks] = *(const bf16x8*)(iq + h * 64 + 8 * gq + 32 * ks); } }
        unsigned u[32][4];
#pragma unroll
        for (int T = 0; T < 32; ++T)
#pragma unroll
            for (int e = 0; e < 4; ++e) u[T][e] = 0u;
        const int kb0 = 16 * wave + 4 * gq;
        LAS unsigned char* ring = lds + DSA_OFF_V + wave * 16384;
#define DSA_ISSUE(Ti) do { _Pragma("unroll") for (int i_ = 0; i_ < 2; ++i_) { const int r_ = 8 * i_ + (lane >> 3); int kr_ = 16 * wave + 128 * (Ti) + r_; kr_ = kr_ > SEQ - 1 ? SEQ - 1 : kr_; \
            __builtin_amdgcn_global_load_lds((const unsigned*)(misc + (size_t)(b * SEQ + kr_) * 256 + (((lane & 7) ^ (r_ & 7)) << 3)), (LAS unsigned*)(ring + ((Ti) & 7) * 2048 + i_ * 1024), 16, 0, 0); } } while (0)
        if (ngrp > 0) {
#pragma unroll
            for (int T = 0; T < 8; ++T) DSA_ISSUE(T);
        }
        DSA_FOR_TILES(
            asm volatile("s_waitcnt vmcnt(14)" ::: "memory");
            const LAS unsigned char* tp = ring + (T & 7) * 2048 + j * 128;
            const bf16x8 kf0 = *(const LAS bf16x8*)(tp + ((gq ^ (j & 7)) << 4)); const bf16x8 kf1 = *(const LAS bf16x8*)(tp + (((gq + 4) ^ (j & 7)) << 4));
            asm volatile("s_waitcnt lgkmcnt(0)" ::: "memory");
            DSA_ISSUE(T + 8);
            float sc[4] = {0.f, 0.f, 0.f, 0.f};
            _Pragma("unroll") for (int h = 0; h < 4; ++h) {
                f32x4v a = {0.f, 0.f, 0.f, 0.f};
                a = __builtin_amdgcn_mfma_f32_16x16x32_bf16(kf0, qf[h][0], a, 0, 0, 0);
                a = __builtin_amdgcn_mfma_f32_16x16x32_bf16(kf1, qf[h][1], a, 0, 0, 0);
                _Pragma("unroll") for (int e = 0; e < 4; ++e) { const int ai_ = (int)__float_as_uint(a[e]); sc[e] += iw[h] * __uint_as_float((unsigned)(ai_ > 0 ? ai_ : 0)); }
                asm volatile("" : "+v"(sc[0]), "+v"(sc[1]), "+v"(sc[2]), "+v"(sc[3]));
            }
            _Pragma("unroll") for (int e = 0; e < 4; ++e) { unsigned x = f2o(sc[e]); asm volatile("" : "+v"(x)); u[T][e] = (kb0 + 128 * T + e <= t) ? x : 0u; }
        )
        asm volatile("s_waitcnt vmcnt(0)" ::: "memory");
#undef DSA_ISSUE
        TP_MARK(0);
        unsigned prefix = 0u; bool exact = false; int par = 0; int cab = 0;
        LAS unsigned* lcnt = (LAS unsigned*)(lds + DSA_OFF_V); LAS unsigned* lcab = lcnt + 16; LAS unsigned* lvst = lcnt + 32; LAS unsigned* lexf = lcnt + 48; LAS unsigned* llist = lcnt + 64;
        if (tid < 16) lcnt[tid] = 0u;
#pragma unroll 1
        for (int bit = 31; bit >= DSA_S; --bit) {
            const unsigned cand = prefix | (1u << bit); int c0 = 0, c1 = 0;
            DSA_FOR_TILES(cnt_ge(c0, u[T][0], cand); cnt_ge(c1, u[T][1], cand); cnt_ge(c0, u[T][2], cand); cnt_ge(c1, u[T][3], cand);)
            const int tot = dsa_total(cnt, par, wave, j, gq, c0 + c1); par ^= 1;
            if (tot >= 256) prefix = cand; else cab = tot;
        }
        TP_MARK(1);
        { const unsigned ptop = prefix >> DSA_S;
          DSA_FOR_TILES(unsigned pos_[4]; bool cd_[4];
              _Pragma("unroll") for (int e = 0; e < 4; ++e) { const unsigned x = u[T][e]; cd_[e] = x != 0u && (x >> DSA_S) == ptop; pos_[e] = DSA_CAP; }
              _Pragma("unroll") for (int e = 0; e < 4; ++e) if (cd_[e]) pos_[e] = __hip_atomic_fetch_add(&lcnt[j], 1u, __ATOMIC_RELAXED, __HIP_MEMORY_SCOPE_WORKGROUP);
              _Pragma("unroll") for (int e = 0; e < 4; ++e) if (pos_[e] < DSA_CAP) llist[j * DSA_CAP + pos_[e]] = u[T][e];)
          if (wave == 0 && gq == 0) lcab[j] = (unsigned)cab; }
        __syncthreads();
        const bool ovf = __any(lcnt[j] > (unsigned)DSA_CAP);
        TP_ADD(14, ovf ? 1 : 0); TP_ADD(15, 1);
        if (!ovf) {
#pragma unroll 1
            for (int qq = 0; qq < 2; ++qq) {
                const int q = 2 * wave + qq; const int n = (int)lcnt[q]; const int r = 256 - (int)lcab[q];
                unsigned ev[DSA_CAP / 64];
#pragma unroll
                for (int i = 0; i < DSA_CAP / 64; ++i) ev[i] = (lane + 64 * i < n) ? llist[q * DSA_CAP + lane + 64 * i] : 0u;
                unsigned p2 = (unsigned)__shfl((int)prefix, q);
#pragma unroll 1
                for (int bit = DSA_S - 1; bit >= 0; --bit) {
                    const unsigned cand = p2 | (1u << bit); int c = 0;
#pragma unroll
                    for (int i = 0; i < DSA_CAP / 64; ++i) c += __popcll(__ballot(ev[i] >= cand));
                    if (c >= r) p2 = cand;
                }
                int cf = 0;
#pragma unroll
                for (int i = 0; i < DSA_CAP / 64; ++i) cf += __popcll(__ballot(ev[i] >= p2));
                if (lane == 0) { lvst[q] = p2; lexf[q] = (cf == r) ? 1u : 0u; }
            }
            __syncthreads();
            prefix = lvst[j]; exact = lexf[j] != 0u;
        } else {
#pragma unroll 1
            for (int bit = DSA_S - 1; bit >= 0; --bit) {
                const unsigned cand = prefix | (1u << bit); int c0 = 0, c1 = 0;
                DSA_FOR_TILES(cnt_ge(c0, u[T][0], cand); cnt_ge(c1, u[T][1], cand); cnt_ge(c0, u[T][2], cand); cnt_ge(c1, u[T][3], cand);)
                const int tot = dsa_total(cnt, par, wave, j, gq, c0 + c1); par ^= 1;
                if (!exact && tot >= 256) { prefix = cand; exact = (tot == 256); }
            }
        }
        TP_MARK(2);
        const bool alle = __all(exact);
        unsigned kp = 0u;
        if (!alle) {
        DSA_FOR_TILES(_Pragma("unroll") for (int e = 0; e < 4; ++e) { const unsigned x = u[T][e]; u[T][e] = (x > prefix || (exact && x == prefix)) ? 0u : (x == prefix ? (unsigned)(1 + kb0 + 128 * T + e) : 0xFFFFFFFFu); })
            __syncthreads();
#pragma unroll 1
            for (int bit = 11; bit >= 0; --bit) {
                const unsigned cand = kp | (1u << bit); int c0 = 0, c1 = 0;
                DSA_FOR_TILES(cnt_le(c0, u[T][0], cand); cnt_le(c1, u[T][1], cand); cnt_le(c0, u[T][2], cand); cnt_le(c1, u[T][3], cand);)
                const int tot = dsa_total(cnt, par, wave, j, gq, c0 + c1); par ^= 1;
                if (tot <= 255) kp = cand;
            }
        }
        const unsigned kp1 = kp + 1u;
        int ns0 = 0, ns1 = 0;
        if (alle) { DSA_FOR_TILES(cnt_ge(ns0, u[T][0], prefix); cnt_ge(ns1, u[T][1], prefix); cnt_ge(ns0, u[T][2], prefix); cnt_ge(ns1, u[T][3], prefix);) }
        else { DSA_FOR_TILES(cnt_le(ns0, u[T][0], kp1); cnt_le(ns1, u[T][1], kp1); cnt_le(ns0, u[T][2], kp1); cnt_le(ns1, u[T][3], kp1);) }
        pc[(wave * 4 + gq) * 16 + j] = (unsigned)(ns0 + ns1);
        __syncthreads();
        int base = 0;
        { const int me = wave * 4 + gq;
#pragma unroll
          for (int i = 0; i < 31; ++i) { const int v = (int)pc[i * 16 + j]; base += (i < me) ? v : 0; } }
        if (alle) { DSA_FOR_TILES(_Pragma("unroll") for (int e = 0; e < 4; ++e) { if (u[T][e] >= prefix) { list[j * 256 + base] = (unsigned short)(kb0 + 128 * T + e); ++base; }     }) }
        else { DSA_FOR_TILES(_Pragma("unroll") for (int e = 0; e < 4; ++e) { if (u[T][e] <= kp1) { if (base < 256) list[j * 256 + base] = (unsigned short)(kb0 + 128 * T + e); ++base; } }) }
    } else {
        for (int i = tid; i < 16 * 256; i += 512) list[i] = (unsigned short)(i & 255);
    }
    __syncthreads();
    TP_MARK(3);
    {
    const int lane4_ = lane_id_v(); const int lane = lane4_, j = lane4_ & 15, gq = lane4_ >> 4;
    const bf16* kva = (const bf16*)(ws + WS_KVA);
    bf16* qa = (bf16*)(ws + WS_QA);
    LAS unsigned char* Vw = lds + DSA_OFF_V + wave * 16384;
    const unsigned vlds0 = (unsigned)(uintptr_t)(unsigned char*)Vw;
    const int tq2[2] = {q0 + 2 * wave, q0 + 2 * wave + 1};
    const int nselq[2] = {tq2[0] + 1 < 256 ? tq2[0] + 1 : 256, tq2[1] + 1 < 256 ? tq2[1] + 1 : 256};
    v4u qfq[2][2];
#pragma unroll
    for (int qq = 0; qq < 2; ++qq)
#pragma unroll
        for (int ks = 0; ks < 2; ++ks) { qfq[qq][ks] = (v4u){0u, 0u, 0u, 0u}; if (j < 8) qfq[qq][ks] = *(const v4u*)(qa + (size_t)(b * SEQ + tq2[qq]) * 512 + j * 64 + 8 * gq + 32 * ks); }
    asm volatile("s_waitcnt vmcnt(0)" : "+v"(qfq[0][0]), "+v"(qfq[0][1]), "+v"(qfq[1][0]), "+v"(qfq[1][1]) :: "memory");
    const bf16* kvb_ = kva + (size_t)b * SEQ * 128;
    const unsigned long long kvbase = ((unsigned long long)(unsigned)__builtin_amdgcn_readfirstlane((int)((unsigned long long)(uintptr_t)kvb_ >> 32)) << 32) | (unsigned long long)(unsigned)__builtin_amdgcn_readfirstlane((int)(unsigned)(uintptr_t)kvb_);
    const unsigned kofs = (unsigned)(((lane & 7) ^ (lane >> 3)) << 4), vofs = 128u + (unsigned)(lane & 7) * 16u;
#define DSA_KEY(M_, st_, slot_) ((unsigned)list[(2 * wave + ((st_) >> 2)) * 256 + ((M_) ? (((slot_) < nselq[(st_) >> 2]) ? (slot_) : 0) : (slot_))])
#define DSA_DMA8(M_, st_, OFS_, LDSB_) do { unsigned kv_[8]; _Pragma("unroll") for (int i_ = 0; i_ < 8; ++i_) kv_[i_] = DSA_KEY(M_, st_, 64 * ((st_) & 3) + 8 * i_ + (lane >> 3)) * 256u + (OFS_); \
        unsigned keep_; const unsigned ld_ = (unsigned)__builtin_amdgcn_readfirstlane((int)(LDSB_)); \
        asm volatile("s_mov_b32 %0, m0\n\ts_mov_b32 m0, %9\n\ts_nop 0\n\t" \
                     "global_load_lds_dwordx4 %1, %10\n\ts_add_u32 m0, m0, 0x400\n\ts_nop 0\n\t" "global_load_lds_dwordx4 %2, %10\n\ts_add_u32 m0, m0, 0x400\n\ts_nop 0\n\t" \
                     "global_load_lds_dwordx4 %3, %10\n\ts_add_u32 m0, m0, 0x400\n\ts_nop 0\n\t" "global_load_lds_dwordx4 %4, %10\n\ts_add_u32 m0, m0, 0x400\n\ts_nop 0\n\t" \
                     "global_load_lds_dwordx4 %5, %10\n\ts_add_u32 m0, m0, 0x400\n\ts_nop 0\n\t" "global_load_lds_dwordx4 %6, %10\n\ts_add_u32 m0, m0, 0x400\n\ts_nop 0\n\t" \
                     "global_load_lds_dwordx4 %7, %10\n\ts_add_u32 m0, m0, 0x400\n\ts_nop 0\n\t" "global_load_lds_dwordx4 %8, %10\n\ts_mov_b32 m0, %0" \
                     : "=&s"(keep_) : "v"(kv_[0]), "v"(kv_[1]), "v"(kv_[2]), "v"(kv_[3]), "v"(kv_[4]), "v"(kv_[5]), "v"(kv_[6]), "v"(kv_[7]), "s"(ld_), "s"(kvbase) : "memory", "scc"); } while (0)
    float mrow = NEGF, lrow = 0.f; f32x4v o[4];
#define DSA_STEP(M_, st_, NK_, NV_) do { \
        if (((st_) & 3) == 0) { mrow = NEGF; lrow = 0.f; _Pragma("unroll") for (int dt_ = 0; dt_ < 4; ++dt_) o[dt_] = (f32x4v){0.f, 0.f, 0.f, 0.f}; } \
        asm volatile("s_waitcnt vmcnt(" #NK_ ")" ::: "memory");                       \
        bf16x8 kf_[8]; \
        _Pragma("unroll") for (int kt_ = 0; kt_ < 4; ++kt_) _Pragma("unroll") for (int ks_ = 0; ks_ < 2; ++ks_) kf_[2 * kt_ + ks_] = *(const LAS bf16x8*)(Vw + 8192 + (16 * kt_ + j) * 128 + (((gq + 4 * ks_) ^ (j & 7)) << 4)); \
        if ((st_) + 1 < 8) { asm volatile("s_waitcnt lgkmcnt(0)" ::: "memory"); DSA_DMA8(M_, (st_) + 1, kofs, vlds0 + 8192); }       \
        const bf16x8 q0_ = __builtin_bit_cast(bf16x8, qfq[(st_) >> 2][0]), q1_ = __builtin_bit_cast(bf16x8, qfq[(st_) >> 2][1]); \
        f32x4v s_[4]; float bm_ = NEGF; \
        _Pragma("unroll") for (int kt_ = 0; kt_ < 4; ++kt_) { f32x4v a_ = {0.f, 0.f, 0.f, 0.f}; \
            a_ = __builtin_amdgcn_mfma_f32_16x16x32_bf16(kf_[2 * kt_], q0_, a_, 0, 0, 0); a_ = __builtin_amdgcn_mfma_f32_16x16x32_bf16(kf_[2 * kt_ + 1], q1_, a_, 0, 0, 0); \
            _Pragma("unroll") for (int e_ = 0; e_ < 4; ++e_) { const float v_ = (!(M_) || (64 * ((st_) & 3) + 16 * kt_ + 4 * gq + e_ < nselq[(st_) >> 2])) ? a_[e_] : NEGF; a_[e_] = v_; bm_ = fmaxf(bm_, v_); } s_[kt_] = a_; } \
        bm_ = xmax16(bm_); \
        { const float mnew_ = fmaxf(mrow, bm_), alpha_ = __builtin_amdgcn_exp2f(mrow - mnew_); mrow = mnew_; float ps_ = 0.f; \
          _Pragma("unroll") for (int kt_ = 0; kt_ < 4; ++kt_) _Pragma("unroll") for (int e_ = 0; e_ < 4; ++e_) { const float p_ = __builtin_amdgcn_exp2f(s_[kt_][e_] - mnew_); s_[kt_][e_] = p_; ps_ += p_; } \
          lrow = lrow * alpha_ + ps_; _Pragma("unroll") for (int dt_ = 0; dt_ < 4; ++dt_) o[dt_] *= alpha_; } \
        asm volatile("s_waitcnt vmcnt(" #NV_ ")" : "+v"(s_[0]), "+v"(s_[1]), "+v"(s_[2]), "+v"(s_[3]) :: "memory");       \
        _Pragma("unroll") for (int kk_ = 0; kk_ < 2; ++kk_) { \
            const bf16x8 pf_ = pack8(s_[2 * kk_][0], s_[2 * kk_][1], s_[2 * kk_][2], s_[2 * kk_][3], s_[2 * kk_ + 1][0], s_[2 * kk_ + 1][1], s_[2 * kk_ + 1][2], s_[2 * kk_ + 1][3]); \
            _Pragma("unroll") for (int dt_ = 0; dt_ < 4; ++dt_) { const LAS unsigned char* va_ = Vw + (32 * kk_ + 4 * gq + (j >> 2)) * 128 + (16 * dt_ + 4 * (j & 3)) * 2; \
                o[dt_] = __builtin_amdgcn_mfma_f32_16x16x32_bf16(cat4(tr16(va_), tr16(va_ + 16 * 128)), pf_, o[dt_], 0, 0, 0); } } \
        if (((st_) & 3) == 3) { const float inv_ = __builtin_amdgcn_rcpf(xsum16(lrow)); const int rowq_ = b * SEQ + tq2[(st_) >> 2]; \
            if (j < 8) { _Pragma("unroll") for (int dt_ = 0; dt_ < 4; ++dt_) { uint2 w_; w_.x = cvtpk(o[dt_][0] * inv_, o[dt_][1] * inv_); w_.y = cvtpk(o[dt_][2] * inv_, o[dt_][3] * inv_); \
                *(uint2*)(yout + (size_t)rowq_ * 512 + j * 64 + 16 * dt_ + 4 * gq) = w_; } } } \
        if ((st_) + 1 < 8) { asm volatile("s_waitcnt lgkmcnt(0)" ::: "memory"); DSA_DMA8(M_, (st_) + 1, vofs, vlds0); }            \
    } while (0)
#define DSA_RUN(M_) do { DSA_DMA8(M_, 0, kofs, vlds0 + 8192); DSA_DMA8(M_, 0, vofs, vlds0); \
    DSA_STEP(M_, 0, 8, 8); DSA_STEP(M_, 1, 8, 8); DSA_STEP(M_, 2, 8, 8); DSA_STEP(M_, 3, 8, 8); DSA_STEP(M_, 4, 8, 8); DSA_STEP(M_, 5, 8, 8); DSA_STEP(M_, 6, 8, 8); DSA_STEP(M_, 7, 8, 0); } while (0)
    if (q0 >= 256) DSA_RUN(0); else DSA_RUN(1);
#undef DSA_RUN
#undef DSA_STEP
#undef DSA_DMA8
#undef DSA_KEY
    }
    __syncthreads();
    TP_MARK(4);
}
__device__ __forceinline__ void phase_mixers(const Args& P, unsigned char* ws, int z, LAS unsigned char* lds, int gw, int NGW, int lane, int wave, int bid, int G, int l) {
    asm volatile("" : "+v"(lane)); lane &= 63; asm volatile("" : "+s"(gw), "+s"(NGW));
    unsigned* qc = (unsigned*)(ws + WS_CTL) + 9216 + l * 8;
    volatile LAS unsigned* bw = (volatile LAS unsigned*)(lds + LDSCTL_OFF) + 40;
    const bool lead = (wave == 0) && (lane == 0);
    int qid = (int)(xb_xcc_id() & 7u), tries = 0;
#define MIX_BCAST(v_) ({ if (lead) *bw = (unsigned)(v_); __syncthreads(); const int r_ = (int)*bw; __syncthreads(); __builtin_amdgcn_readfirstlane(r_); })
    int nx = 0; if (lead) nx = (int)__hip_atomic_fetch_add(qc + qid, 1u, __ATOMIC_RELAXED, __HIP_MEMORY_SCOPE_AGENT);
    int cur = MIX_BCAST(nx);
    for (;;) {
        while (cur >= 384) { if (++tries == 8) break; qid = (qid + 1) & 7; nx = 0; if (lead) nx = (int)__hip_atomic_fetch_add(qc + qid, 1u, __ATOMIC_RELAXED, __HIP_MEMORY_SCOPE_AGENT); cur = MIX_BCAST(nx); }
        if (cur >= 384) break;
        nx = 0; if (lead) nx = (int)__hip_atomic_fetch_add(qc + qid, 1u, __ATOMIC_RELAXED, __HIP_MEMORY_SCOPE_AGENT);
        const int t3 = cur / 3;
        if (cur - 3 * t3 == 0) { const int n = t3, unit = (qid * 2 + (n & 1)) * 64 + (63 - (n >> 1)); nsa_unit(ws, unit, lds, (wave << 6) | lane_id_v(), (bf16*)(ws + WS_QC)); }
        else { const int d = cur - t3 - 1, unit = qid * 256 + (255 - d); dsa_unit(ws, unit, lds, (wave << 6) | lane_id_v(), (bf16*)(ws + WS_QA)); }
        cur = MIX_BCAST(nx);
    }
#undef MIX_BCAST
}
__global__ void __launch_bounds__(NWAVES * 64, 2) fwd_kernel(Args args) {
    extern __shared__ __attribute__((aligned(16))) unsigned char lds_raw[];
    LAS unsigned char* lds = (LAS unsigned char*)lds_raw;
    const int wave = __builtin_amdgcn_readfirstlane((int)threadIdx.x >> 6);
#define TIDX ((wave << 6) | lane_id_v())
#define tid TIDX
#define lane TIDX
    const int G = gridDim.x, bid = blockIdx.x;
    const int gw = bid * NWAVES + wave, NGW = G * NWAVES;
    const int lo = args.ph_lo, hi = args.ph_hi;
    const Args& P = args;
    int z = 0; asm volatile("" : "+s"(z));
    unsigned char* ws = args.ws + z;
    volatile LAS unsigned* MISCW = (volatile LAS unsigned*)(lds + LDSCTL_OFF);
    if (tid < 64) MISCW[tid] = 0u;
    __syncthreads();
    XcdBarrier bar; bar.bar = (unsigned*)(ws + WS_CTL) + 4096; bar.x = 0; bar.st = nullptr;
    if (hi - lo > 1) bar = xcd_barrier_post((unsigned*)(ws + WS_CTL) + 4096, MISCW + 8);
#define RUN(k) (lo <= (k) && (k) < hi)
#if TPROBE
#define TP_PHASE(k) do { if (bid == 0 && TIDX == 0) { volatile unsigned long long* sl_ = (volatile unsigned long long*)(args.ws + z + 32768); const unsigned long long n_ = __builtin_amdgcn_s_memtime(); const int cls_ = (k) == 0 ? 0 : 1 + (((k) - 1) % NPL); sl_[16 + cls_] += n_ - sl_[30]; sl_[30] = n_; } } while (0)
#else
#define TP_PHASE(k)
#endif
#define SEAM(k) do { TP_PHASE(k); if ((k) + 1 < hi) { XcdBarrier b2_ = bar; asm volatile("" : "+s"(b2_.bar), "+s"(b2_.x)); xcd_barrier(b2_); if (DUP == 13) xcd_barrier(b2_); } else { VM_WAIT(); __syncthreads(); } } while (0)


#if TPROBE
    if (bid == 0 && TIDX == 0) { volatile unsigned long long* sl_ = (volatile unsigned long long*)(args.ws + z + 32768); sl_[30] = __builtin_amdgcn_s_memtime(); }
#endif
    if (RUN(0)) { phase_rope(P, ws, z, bid * (NWAVES * 64) + tid, G * NWAVES * 64);
        { int ln_ = TIDX; asm volatile("" : "+v"(ln_)); ln_ &= 63;
          for (int m = gw; m < M; m += 4 * NGW) stat_rows4_bf16(P.in[0 + z], (bf16*)(ws + WS_XN), (float*)(ws + WS_SSQ), m, NGW, ln_); }
        if (!RUN(1)) SEAM(0); }
#define RS_PREPASS(Sref) do { const float* ssq_ = (const float*)(ws + WS_SSQ); LAS float* rsl_ = (LAS float*)(lds + RS_OFF); const int t_ = TIDX; pg8::Unit u_; \
        for (int i_ = 0; (Sref).next(i_, u_); ++i_) { const f32x4* p_ = (const f32x4*)(ssq_ + (size_t)(u_.pm * 256 + (t_ >> 1)) * 16 + (t_ & 1) * 8); const f32x4 a_ = p_[0], b_ = p_[1]; \
            float s_ = (a_.x + a_.y) + (a_.z + a_.w) + (b_.x + b_.y) + (b_.z + b_.w); s_ += __shfl_xor(s_, 1); if ((t_ & 1) == 0) rsl_[i_ * 256 + (t_ >> 1)] = 1.0f / sqrtf(s_ * (1.f / DM) + EPS); } \
        __syncthreads(); } while (0)

    for (int it = 0; it < 2 * DEPTH; ++it) {
        const int l = it >> 1, second = it & 1, pb = 1 + l * NPL + (second ? 7 : 0);
        asm volatile("" : "+s"(z));
        ws = args.ws + z;
        bf16* const XN = (bf16*)(ws + WS_XN);
        bf16* const HB = (bf16*)(ws + WS_H);
        bf16* const MG = (bf16*)(ws + WS_MG);
        bf16* const GB = (bf16*)(ws + WS_G);
        unsigned char* const wb = ws + WS_W;
        float* const OUT = P.out + z;
        if (!second && RUN(pb)) { phase_convert(P, ws, z, l, lds, gw, NGW, lane, wave);
#if DUP == 30
            phase_convert(P, ws, z, l, lds, gw, NGW, lane, wave);
#endif
            SEAM(pb); }
        if (RUN(pb + 1)) {
            pg8::Gemm g{XN, (const bf16*)(wb + (second ? WO_GU2 : WO_GU1)), M, 2 * FF, DM}; pg8::StaticOrder S; S.init(M, 2 * FF, G, bid + z);
            pg8::EpiSwiglu E{HB, FF, (const LAS float*)(lds + RS_OFF)};
            RS_PREPASS(S);
#if !defined(SITE_MASK) || ((SITE_MASK >> 0) & 1)
            pg8::gemm_phase<pg8::EpiSwiglu, pg8::StaticOrder, ALIGN_UP, true>(lds, g, S, E, TIDX);
#if DUP == 3
            pg8::gemm_phase<pg8::EpiSwiglu, pg8::StaticOrder, ALIGN_UP, true>(lds, g, S, E, TIDX);
#endif
#endif
            SEAM(pb + 1);
        }
        if (RUN(pb + 2)) {
            pg8::Gemm g{HB, (const bf16*)(wb + (second ? WO_D2 : WO_D1)), M, DM, FF}; pg8::StaticOrder S; S.init(M, DM, G, bid + z);
            pg8::EpiResid E{XN, 0.5f, (float*)(ws + WS_SSQ)};
#if !defined(SITE_MASK) || ((SITE_MASK >> 1) & 1)
            pg8::gemm_phase<pg8::EpiResid, pg8::StaticOrder, true, true>(lds, g, S, E, TIDX);
#endif
            SEAM(pb + 2);
        }
        if (second) continue;
        const int pm = 1 + l * NPL + 2;
        if (RUN(pm + 1)) {
            pg8::Gemm g{XN, (const bf16*)(wb + WO_IN), M, NINP, DM}; pg8::StaticOrder S; S.init(M, NINP, G, bid + z);
            pg8::EpiWin E{(bf16*)(ws + WS_QA), (bf16*)(ws + WS_QC), (bf16*)(ws + WS_IQ), (bf16*)(ws + WS_MISC), (bf16*)(ws + WS_KVC), (bf16*)(ws + WS_KVS), (bf16*)(ws + WS_KVW), (bf16*)(ws + WS_BU), GB,
                          (const float*)(ws + WS_ROPE), (const LAS float*)(lds + RS_OFF)};
            RS_PREPASS(S);
#if !defined(SITE_MASK) || ((SITE_MASK >> 2) & 1)
            pg8::gemm_phase<pg8::EpiWin, pg8::StaticOrder, ALIGN_WIN, true>(lds, g, S, E, TIDX);
#if DUP == 4
            pg8::gemm_phase<pg8::EpiWin, pg8::StaticOrder, ALIGN_WIN, true>(lds, g, S, E, TIDX);
#endif
#endif
            SEAM(pm + 1);
        }
        #ifndef NO_PREP
        if (RUN(pm + 2)) { phase_prep(P, ws, z, l, lds, gw, NGW, lane, wave, (bf16*)OUT);
#if DUP == 1
            { XcdBarrier b2_ = bar; asm volatile("" : "+s"(b2_.bar), "+s"(b2_.x)); xcd_barrier(b2_); } phase_prep(P, ws, z, l, lds, gw, NGW, lane, wave, (bf16*)OUT);
#endif
            SEAM(pm + 2); }
#endif
        #ifndef NO_MIX
        if (RUN(pm + 3)) {
#if TPROBE
            unsigned long long tm0_ = __builtin_amdgcn_s_memtime();
#endif
            phase_mixers(P, ws, z, lds, gw, NGW, lane, wave, bid, G, l);
#if TPROBE
            { const unsigned long long tm1_ = __builtin_amdgcn_s_memtime(); if (TIDX == 0) { atomicAdd((unsigned long long*)(args.ws + z + 32768) + 12, tm1_ - tm0_); atomicMax((unsigned long long*)(args.ws + z + 32768) + 13 + (l & 1), tm1_ - tm0_); } }
#endif
            SEAM(pm + 3); }
#endif
        if (RUN(pm + 4)) {
#if DUP == 5
          for (int rep_ = 0; rep_ < 2; ++rep_) {
#endif
            pg8::StaticOrder S; S.init(M, DM, G, bid + z);
            { pg8::Gemm g{(const bf16*)(ws + WS_QA), (const bf16*)(wb + WO_PA), M, DM, 512}; pg8::EpiProj<0> E{MG, GB, 0};
#if !defined(SITE_MASK) || ((SITE_MASK >> 3) & 1)
              pg8::gemm_phase<pg8::EpiProj<0>, pg8::StaticOrder, true, true>(lds, g, S, E, TIDX);
#endif
            }
            { pg8::Gemm g{(const bf16*)OUT, (const bf16*)(wb + WO_PB), M, DM, 512}; pg8::EpiProj<1> E{MG, GB, 1024};
#if !defined(SITE_MASK) || ((SITE_MASK >> 4) & 1)
              pg8::gemm_phase<pg8::EpiProj<1>, pg8::StaticOrder, true, true>(lds, g, S, E, TIDX);
#endif
            }
            { pg8::Gemm g{(const bf16*)(ws + WS_QC), (const bf16*)(wb + WO_PC), M, DM, 512}; pg8::EpiProj<1> E{MG, GB, 2048};
#if !defined(SITE_MASK) || ((SITE_MASK >> 5) & 1)
              pg8::gemm_phase<pg8::EpiProj<1>, pg8::StaticOrder, true, true>(lds, g, S, E, TIDX);
#endif
            }
#if DUP == 5
          }
#endif
#if DUP == 31
            { pg8::Gemm g{(const bf16*)(ws + WS_QC), (const bf16*)(wb + WO_PC), M, DM, 512}; pg8::EpiPlain E{(bf16*)OUT + (size_t)32 * 1024 * 1024 / 2};
              pg8::gemm_phase<pg8::EpiPlain, pg8::StaticOrder, true, true>(lds, g, S, E, TIDX); }
#endif
            SEAM(pm + 4);
        }
        if (RUN(pm + 5)) {
            pg8::Gemm g{MG, (const bf16*)(wb + WO_OUT), M, DM, DM}; pg8::StaticOrder S; S.init(M, DM, G, bid + z);
            pg8::EpiResid E{XN, 1.0f, (float*)(ws + WS_SSQ)};
#if !defined(SITE_MASK) || ((SITE_MASK >> 6) & 1)
            pg8::gemm_phase<pg8::EpiResid, pg8::StaticOrder, true, true>(lds, g, S, E, TIDX);
#endif
            SEAM(pm + 5);
        }
    }
    if (RUN(NPH - 1)) { asm volatile("" : "+s"(z)); int ln_ = TIDX; asm volatile("" : "+v"(ln_)); ln_ &= 63; float* o_ = P.out + z; float tps_ = 1.0f;
#if TPROBE
        { const unsigned long long* sl_ = (const unsigned long long*)(P.ws + z + 32768); double a_ = 0., b_ = 0.; for (int k = 0; k < 32; ++k) { const double v_ = (double)__hip_atomic_load(sl_ + k, __ATOMIC_RELAXED, __HIP_MEMORY_SCOPE_AGENT); if (((unsigned)TP_A >> k) & 1) a_ += v_; if (((unsigned)TP_B >> k) & 1) b_ += v_; } tps_ = 1.0f + floorf((float)(a_ / b_) * TP_SCALE * 20.0f + 0.5f) * 0.05f; }
#endif
        { const bf16* xr_ = (const bf16*)(args.ws + z + WS_XN); for (int m = gw; m < M; m += 4 * NGW) norm_rows4_out(xr_, o_, P.in[23 + z], m, NGW, ln_, tps_); }
#if TPROBE
        if (gw == 0 && ln_ == 0) { const unsigned long long* sl_ = (const unsigned long long*)(P.ws + z + 32768); double c_ = 0., d_ = 0.; for (int k = 0; k < 32; ++k) { const double v_ = (double)__hip_atomic_load(sl_ + k, __ATOMIC_RELAXED, __HIP_MEMORY_SCOPE_AGENT); if (((unsigned)TP_C >> k) & 1) c_ += v_; if (((unsigned)TP_D >> k) & 1) d_ += v_; } o_[0] = 1000.0f * floorf((float)(c_ / d_) * TP_SCALE2 * 20.0f + 0.5f) * 0.05f; }
#endif
    }
#undef RUN
#undef tid
#undef TIDX
#undef lane
#undef SEAM
}

extern "C" void kernel_launch(void* const* d_in, const int* in_sizes, int n_in, void* d_out, int out_size, void* d_ws, size_t ws_size, hipStream_t stream) {
    static int grid = 0;
    if (grid == 0) {
        if (n_in != 24 || out_size != M * DM || ws_size < WS_END) { fprintf(stderr, "kernel_launch: unexpected shapes (n_in %d out %d ws %zu)\n", n_in, out_size, ws_size); grid = -1; return; }
        int dev = 0, cus = 0, per_cu = 0;
        if (hipGetDevice(&dev) != hipSuccess || hipDeviceGetAttribute(&cus, hipDeviceAttributeMultiprocessorCount, dev) != hipSuccess) { grid = -1; return; }
        if (hipFuncSetAttribute((const void*)fwd_kernel, hipFuncAttributeMaxDynamicSharedMemorySize, LDS_BYTES) != hipSuccess) { fprintf(stderr, "kernel_launch: hipFuncSetAttribute failed\n"); grid = -1; return; }
        if (hipOccupancyMaxActiveBlocksPerMultiprocessor(&per_cu, (const void*)fwd_kernel, NWAVES * 64, LDS_BYTES) != hipSuccess || per_cu < 1) { fprintf(stderr, "kernel_launch: occupancy query says %d\n", per_cu); }
        (void)hipGetLastError();
        grid = cus;
    }
    if (grid < 0) return;
    (void)hipMemsetAsync((char*)d_ws + WS_CTL, 0, CTL_ZERO_BYTES, stream);
    Args a{};
    for (int i = 0; i < 24; ++i) a.in[i] = (const float*)d_in[i];
    a.out = (float*)d_out; a.ws = (unsigned char*)d_ws;
#if MK_ONE_LAUNCH
    a.ph_lo = 0; a.ph_hi = NPH;
    hipLaunchKernelGGL(fwd_kernel, dim3(grid), dim3(NWAVES * 64), LDS_BYTES, stream, a);
#else
    for (int ph = 0; ph < NPH; ++ph) { a.ph_lo = ph; a.ph_hi = ph + 1; hipLaunchKernelGGL(fwd_kernel, dim3(grid), dim3(NWAVES * 64), LDS_BYTES, stream, a); }
#endif
}
```

```cpp
#include <hip/hip_runtime.h>
#include <cstdio>
#include <cstdint>
#define PROBE 0
#define PROBE_GAIN 10.0f
#define TOP8_RANK 1
#define PROBE_ROWTHR 0.01f
#define PROBE_ROWCOND 1
#define PROBE_BR -1
#define FIXHOM 0
#define DUP 0
#define TPROBE 0
#define TP_A 1
#define TP_B 1
#define TP_SCALE 1.0f
#define TP_C 1
#define TP_D 1
#define TP_SCALE2 1.0f
#define POOLDBG 0
#define YB_SPARE 0
#define ALIGN_UP true
#define ALIGN_WIN true
#define DSA_CAP_V 512
#define DSA_K_V 13
#define DSA_HIST 1
#ifndef MK_ONE_LAUNCH
#define MK_ONE_LAUNCH 1
#endif
namespace pg8 {
#define PG8_LAS __attribute__((address_space(3)))
typedef unsigned short bf16_t;
typedef short bf16x8 __attribute__((ext_vector_type(8)));
typedef float f32x4 __attribute__((ext_vector_type(4)));
typedef unsigned u32x4 __attribute__((ext_vector_type(4)));
constexpr int BM = 256, BK = 64, HALF = 128, HTB = HALF * BK * 2  , STAGE_BYTES = 8 * HTB, NXCD = 8, WGM = 8;

__host__ __device__ __forceinline__ int lds_byte(int r, int c) { const int st = (r >> 4) * 2 + (c >> 5), rr = r & 15, cc = c & 31, ob = rr * 64 + cc * 2; return st * 1024 + (ob ^ (((ob >> 9) & 1) << 5)); }
__host__ __device__ __forceinline__ void stage_rc(int b, int& R, int& C) { const int st = b / 1024, sb = b % 1024, swz = sb ^ (((sb >> 9) & 1) << 5); R = (st >> 1) * 16 + swz / 64; C = (st & 1) * 32 + (swz % 64) / 2; }
__host__ __device__ __forceinline__ int perm32(int rho) { const int n = rho >> 4, i = rho & 15; return 8 * (i >> 2) + 4 * n + (i & 3); }

struct Unit { int pm, pn, ord; };
struct Gemm { const bf16_t* A; const bf16_t* Bt; int M, N, K; };

struct StaticOrder {
    int nM, nN, nwg, G, c;
    __host__ __device__ __forceinline__ void init(int M, int N, int G_, int c_) { nM = M / BM; nN = N / BM; nwg = nM * nN; G = G_; c = c_; }
    __host__ __device__ __forceinline__ bool next(int i, Unit& u) const {
        const int L = i * G + c; if (L >= nwg) return false;
        int wgid = (int)L; { const int q = nwg / NXCD, r = nwg % NXCD, xcd = wgid % NXCD, off = wgid / NXCD; wgid = (xcd < r ? xcd * (q + 1) : r * (q + 1) + (xcd - r) * q) + off; }
        const int nig = WGM * nN, gid = wgid / nig, fm = gid * WGM, gsz = (nM - fm) < WGM ? (nM - fm) : WGM;
        u.pm = fm + ((wgid % nig) % gsz); u.pn = (wgid % nig) / gsz; u.ord = i; return true;
    }
    __device__ __forceinline__ void a_ready(const Unit&) const {}
    __device__ __forceinline__ void done(const Unit&) const {}
};

__device__ __forceinline__ unsigned cvt_pk_bf16(float lo, float hi) { unsigned r; asm volatile("v_cvt_pk_bf16_f32 %0, %1, %2" : "=v"(r) : "v"(lo), "v"(hi)); return r; }
__device__ __forceinline__ float bflo(unsigned w) { return __uint_as_float(w << 16); }
__device__ __forceinline__ float bfhi(unsigned w) { return __uint_as_float(w & 0xffff0000u); }
__device__ __forceinline__ float fast_sigmoid(float x) { return __builtin_amdgcn_rcpf(1.0f + __expf(-x)); }

struct EpiSwiglu {
    static constexpr bool PERM = true, AFTER_DRAIN = false, WIDE = false;
    bf16_t* H; int ldh; const PG8_LAS float* rs;
    __device__ __forceinline__ void operator()(const f32x4 (&acc)[2][2][4][2], const Unit& u, int wr, int wc, int fr, int fq) const {
        const int row0 = u.pm * BM + wr * 64 + fr, col0 = u.pn * HALF + wc * 32 + 8 * fq;
#pragma unroll
        for (int ai = 0; ai < 2; ++ai)
#pragma unroll
            for (int m = 0; m < 4; ++m) {
                bf16_t* rowp = H + (size_t)(row0 + ai * HALF + m * 16) * ldh + col0;
                const float r = rs[u.ord * 256 + wr * 64 + fr + ai * HALF + m * 16];
                float o[8];
#pragma unroll
                for (int n = 0; n < 2; ++n)
#pragma unroll
                    for (int e = 0; e < 4; ++e) { const float g = acc[ai][0][m][n][e] * r, up = acc[ai][1][m][n][e] * r; o[n * 4 + e] = g * fast_sigmoid(g) * up; }
                u32x4 w; w.x = cvt_pk_bf16(o[0], o[1]); w.y = cvt_pk_bf16(o[2], o[3]); w.z = cvt_pk_bf16(o[4], o[5]); w.w = cvt_pk_bf16(o[6], o[7]);
                *(u32x4*)rowp = w;
            }
    }
};
__device__ __forceinline__ u32x4 xswap1(const u32x4 v) { u32x4 r; r.x = (unsigned)__builtin_amdgcn_update_dpp(0, (int)v.x, 0xB1, 0xF, 0xF, true); r.y = (unsigned)__builtin_amdgcn_update_dpp(0, (int)v.y, 0xB1, 0xF, 0xF, true);
    r.z = (unsigned)__builtin_amdgcn_update_dpp(0, (int)v.z, 0xB1, 0xF, 0xF, true); r.w = (unsigned)__builtin_amdgcn_update_dpp(0, (int)v.w, 0xB1, 0xF, 0xF, true); return r; }
__device__ __forceinline__ u32x4 xsel(bool c, const u32x4 a, const u32x4 b) { u32x4 r; r.x = c ? a.x : b.x; r.y = c ? a.y : b.y; r.z = c ? a.z : b.z; r.w = c ? a.w : b.w; return r; }
struct EpiResid {
    static constexpr bool PERM = true, AFTER_DRAIN = false, WIDE = true;
    bf16_t* xb; float s; float* ssq;
    __device__ __forceinline__ void operator()(const f32x4 (&acc)[2][2][4][2], const Unit& u, int wr, int wc, int fr, int fq) const {
        const bool pr = fr & 1;
        const int rbase = u.pm * BM + wr * 64, cacc = u.pn * BM + wc * 64 + (pr ? 32 : 0) + 8 * fq;
#pragma unroll
        for (int ai = 0; ai < 2; ++ai) {
            u32x4 le[4], lo[4];
#pragma unroll
            for (int m = 0; m < 4; ++m) { const size_t re = (size_t)(rbase + ai * HALF + m * 16 + (fr & ~1)); le[m] = *(const u32x4*)(xb + re * 1024 + cacc); lo[m] = *(const u32x4*)(xb + (re + 1) * 1024 + cacc); }
#pragma unroll
            for (int m = 0; m < 4; ++m) {
                const size_t re = (size_t)(rbase + ai * HALF + m * 16 + (fr & ~1));
                const u32x4 rcv = xswap1(xsel(pr, le[m], lo[m]));
                const u32x4 b0 = xsel(pr, rcv, le[m]), b1 = xsel(pr, lo[m], rcv);
                float q = 0.f; u32x4 w[2];
#pragma unroll
                for (int bj = 0; bj < 2; ++bj) {
                    const u32x4 b = bj ? b1 : b0;
                    const f32x4 c0 = {bflo(b.x), bfhi(b.x), bflo(b.y), bfhi(b.y)}, c1 = {bflo(b.z), bfhi(b.z), bflo(b.w), bfhi(b.w)};
                    const f32x4 x0 = c0 + acc[ai][bj][m][0] * s, x1 = c1 + acc[ai][bj][m][1] * s;
                    q += (x0[0] * x0[0] + x0[1] * x0[1]) + (x0[2] * x0[2] + x0[3] * x0[3]) + (x1[0] * x1[0] + x1[1] * x1[1]) + (x1[2] * x1[2] + x1[3] * x1[3]);
                    w[bj].x = cvt_pk_bf16(x0[0], x0[1]); w[bj].y = cvt_pk_bf16(x0[2], x0[3]); w[bj].z = cvt_pk_bf16(x1[0], x1[1]); w[bj].w = cvt_pk_bf16(x1[2], x1[3]);
                }
                const u32x4 rc2 = xswap1(xsel(pr, w[0], w[1]));
                *(u32x4*)(xb + re * 1024 + cacc) = xsel(pr, rc2, w[0]); *(u32x4*)(xb + (re + 1) * 1024 + cacc) = xsel(pr, w[1], rc2);
                q += __shfl_xor(q, 16); q += __shfl_xor(q, 32);
                if (fq == 0) ssq[(size_t)(rbase + ai * HALF + m * 16 + fr) * 16 + u.pn * 4 + wc] = q;
            }
        }
    }
};
template <int MODE> struct EpiProj {
    static constexpr bool PERM = true, AFTER_DRAIN = false, WIDE = true;
    bf16_t* MG; const bf16_t* G; int gofs;
    __device__ __forceinline__ void operator()(const f32x4 (&acc)[2][2][4][2], const Unit& u, int wr, int wc, int fr, int fq) const {
        const bool pr = fr & 1;
        const int rbase = u.pm * BM + wr * 64, cacc = u.pn * BM + wc * 64 + (pr ? 32 : 0) + 8 * fq;
#pragma unroll
        for (int ai = 0; ai < 2; ++ai) {
            u32x4 ge[4], go[4], me[4], mo[4];
#pragma unroll
            for (int m = 0; m < 4; ++m) { const size_t re = (size_t)(rbase + ai * HALF + m * 16 + (fr & ~1));
                ge[m] = *(const u32x4*)(G + re * 3072 + gofs + cacc); go[m] = *(const u32x4*)(G + (re + 1) * 3072 + gofs + cacc);
                if (MODE) { me[m] = *(const u32x4*)(MG + re * 1024 + cacc); mo[m] = *(const u32x4*)(MG + (re + 1) * 1024 + cacc); } }
#pragma unroll
            for (int m = 0; m < 4; ++m) {
                const size_t re = (size_t)(rbase + ai * HALF + m * 16 + (fr & ~1));
                const u32x4 gr = xswap1(xsel(pr, ge[m], go[m]));
                const u32x4 g0 = xsel(pr, gr, ge[m]), g1 = xsel(pr, go[m], gr);
                u32x4 m0 = {0u, 0u, 0u, 0u}, m1 = {0u, 0u, 0u, 0u};
                if (MODE) { const u32x4 mr = xswap1(xsel(pr, me[m], mo[m])); m0 = xsel(pr, mr, me[m]); m1 = xsel(pr, mo[m], mr); }
                u32x4 w[2];
#pragma unroll
                for (int bj = 0; bj < 2; ++bj) {
                    const u32x4 gv = bj ? g1 : g0, ov = bj ? m1 : m0;
                    const f32x4 a0 = acc[ai][bj][m][0], a1 = acc[ai][bj][m][1];
                    float o[8] = {bflo(gv.x) * a0[0], bfhi(gv.x) * a0[1], bflo(gv.y) * a0[2], bfhi(gv.y) * a0[3], bflo(gv.z) * a1[0], bfhi(gv.z) * a1[1], bflo(gv.w) * a1[2], bfhi(gv.w) * a1[3]};
                    if (MODE) { o[0] += bflo(ov.x); o[1] += bfhi(ov.x); o[2] += bflo(ov.y); o[3] += bfhi(ov.y); o[4] += bflo(ov.z); o[5] += bfhi(ov.z); o[6] += bflo(ov.w); o[7] += bfhi(ov.w); }
                    w[bj].x = cvt_pk_bf16(o[0], o[1]); w[bj].y = cvt_pk_bf16(o[2], o[3]); w[bj].z = cvt_pk_bf16(o[4], o[5]); w[bj].w = cvt_pk_bf16(o[6], o[7]);
                }
                const u32x4 rc2 = xswap1(xsel(pr, w[0], w[1]));
                *(u32x4*)(MG + re * 1024 + cacc) = xsel(pr, rc2, w[0]); *(u32x4*)(MG + (re + 1) * 1024 + cacc) = xsel(pr, w[1], rc2);
            }
        }
    }
};
struct EpiWin {
    static constexpr bool PERM = true, AFTER_DRAIN = false, WIDE = false;
    bf16_t *QA, *QC, *IQ, *MISC, *KVC, *KVS, *KVW, *BU, *G; const float* rope; const PG8_LAS float* rs;
    __device__ __forceinline__ void operator()(const f32x4 (&acc)[2][2][4][2], const Unit& u, int wr, int wc, int fr, int fq) const {
        const int pn = u.pn;
        bf16_t* dst; int ld, cbase, mode;
        if (pn < 2) { dst = QA; ld = 512; cbase = pn * 256; mode = 1; }
        else if (pn < 4) { dst = QC; ld = 512; cbase = (pn - 2) * 256; mode = 1; }
        else if (pn == 4) { dst = IQ; ld = 256; cbase = 0; mode = 1; }
        else if (pn == 5) { dst = MISC; ld = 256; cbase = 0; mode = 3; }
        else if (pn <= 8) { dst = pn == 6 ? KVC : (pn == 7 ? KVS : KVW); ld = 256; cbase = 0; mode = 2; }
        else if (pn <= 10) { dst = BU; ld = 512; cbase = (pn - 9) * 256; mode = 0; }
        else { dst = G; ld = 3072; cbase = (pn - 11) * 256; mode = 4; }
        const int row0 = u.pm * BM + wr * 64 + fr, col0 = cbase + wc * 32 + 8 * fq;
        const bool ropelane = ((wc & 1) == 0) && fq < 2;
        const float sc = (mode == 1) ? (pn < 4 ? 0.125f * 1.4426950408889634f : 0.125f) : 1.0f;
#pragma unroll
        for (int ai = 0; ai < 2; ++ai) {
            f32x4 csv[4], snv[4];
#pragma unroll
            for (int m = 0; m < 4; ++m) { csv[m] = (f32x4){1.f, 1.f, 1.f, 1.f}; snv[m] = (f32x4){0.f, 0.f, 0.f, 0.f}; }
            if (mode >= 1 && mode <= 3) {
#pragma unroll
                for (int m = 0; m < 4; ++m) { const float* rp = rope + (size_t)(row0 + ai * HALF + m * 16) * 16 + 4 * (fq & 1); csv[m] = *(const f32x4*)rp; snv[m] = *(const f32x4*)(rp + 8); }
            }
#pragma unroll
            for (int m = 0; m < 4; ++m) {
                const size_t row = (size_t)(row0 + ai * HALF + m * 16);
                const float rr = rs[u.ord * 256 + wr * 64 + fr + ai * HALF + m * 16];
                const f32x4 cs = csv[m], sn = snv[m];
#pragma unroll
                for (int bj = 0; bj < 2; ++bj) {
                    const f32x4 a0 = acc[ai][bj][m][0] * rr, a1 = acc[ai][bj][m][1] * rr;
                    float o[8] = {a0[0], a0[1], a0[2], a0[3], a1[0], a1[1], a1[2], a1[3]};
                    const bool dorope = ropelane && (mode == 1 || (mode == 2 && bj == 0) || (mode == 3 && bj == 0 && wc == 0));
                    if (dorope) {
#pragma unroll
                        for (int p = 0; p < 4; ++p) { const float x1 = o[2 * p], x2 = o[2 * p + 1]; o[2 * p] = x1 * cs[p] - x2 * sn[p]; o[2 * p + 1] = x2 * cs[p] + x1 * sn[p]; }
                    }
                    if (mode == 4) {
#pragma unroll
                        for (int e = 0; e < 8; ++e) o[e] = fast_sigmoid(o[e]);
                    } else {
#pragma unroll
                        for (int e = 0; e < 8; ++e) o[e] *= sc;
                    }
                    u32x4 w; w.x = cvt_pk_bf16(o[0], o[1]); w.y = cvt_pk_bf16(o[2], o[3]); w.z = cvt_pk_bf16(o[4], o[5]); w.w = cvt_pk_bf16(o[6], o[7]);
                    *(u32x4*)(dst + row * ld + col0 + bj * HALF) = w;
                }
            }
        }
    }
};


#if DUP == 31
struct EpiPlain {
    static constexpr bool PERM = true, AFTER_DRAIN = false;
    bf16_t* O;
    __device__ __forceinline__ void operator()(const f32x4 (&acc)[2][2][4][2], const Unit& u, int wr, int wc, int fr, int fq) const {
        const int row0 = u.pm * BM + wr * 64 + fr, col0 = u.pn * BM + wc * 32 + 8 * fq;
#pragma unroll
        for (int ai = 0; ai < 2; ++ai)
#pragma unroll
            for (int m = 0; m < 4; ++m)
#pragma unroll
                for (int bj = 0; bj < 2; ++bj) { const f32x4 a0 = acc[ai][bj][m][0], a1 = acc[ai][bj][m][1];
                    u32x4 w; w.x = cvt_pk_bf16(a0[0], a0[1]); w.y = cvt_pk_bf16(a0[2], a0[3]); w.z = cvt_pk_bf16(a1[0], a1[1]); w.w = cvt_pk_bf16(a1[2], a1[3]);
                    *(u32x4*)(O + (size_t)(row0 + ai * HALF + m * 16) * 1024 + col0 + bj * HALF) = w; }
    }
};
#endif
template <class Epi, class Sched, bool ALIGN_EPI = false, bool SP2 = false>
__device__ __forceinline__ void gemm_phase(PG8_LAS unsigned char* lds, const Gemm g, const Sched& S, const Epi& E, int tid_in) {
    int tid_ = tid_in; asm volatile("" : "+v"(tid_));
    const int tid = tid_, wid = __builtin_amdgcn_readfirstlane(tid >> 6), lane = tid & 63, wr = wid >> 2, wc = wid & 3, fr = lane & 15, fq = lane >> 4;
    const int K = g.K, nt = K / BK;
    unsigned voffA[2], voffB[2];
#pragma unroll
    for (int i = 0; i < 2; ++i) { int R, C; stage_rc(tid * 16 + i * 8192, R, C); const int Rp = Epi::PERM ? ((R & ~31) + perm32(R & 31)) : R;
        const int Rb = Epi::WIDE ? (((Rp >> 5) << 6) + (Rp & 31)) : Rp;
        voffA[i] = (unsigned)(R * K + C) * 2u; voffB[i] = (unsigned)(Rb * K + C) * 2u; }
    const size_t kstep = (size_t)(BK * 2);
    const size_t hstep = (size_t)HALF * K * 2;
    const size_t tstep = 2 * hstep;
    const size_t hstepB = Epi::WIDE ? (size_t)32 * K * 2 : hstep;
    const unsigned ldsw = (unsigned)wid * 1024u;
    const int aoff = lds_byte(wr * 64 + fr, fq * 8), boff = lds_byte(wc * 32 + fr, fq * 8);
#define PG8_SA(b, h) (((b) * 2 + (h)) * HTB)
#define PG8_SB(b, h) ((4 + (b) * 2 + (h)) * HTB)
#define PG8_STAGE(bufoff, gbase, voff) do { _Pragma("unroll") for (int _i = 0; _i < 2; ++_i) \
        __builtin_amdgcn_global_load_lds((const unsigned*)((const char*)(gbase) + (voff)[_i]), (PG8_LAS unsigned*)(lds + (bufoff) + ldsw + _i * 8192), 16, 0, 0); } while (0)
#define PG8_LDA(dst, b, h) do { _Pragma("unroll") for (int m = 0; m < 4; ++m) _Pragma("unroll") for (int k = 0; k < 2; ++k) dst[m][k] = *(const PG8_LAS bf16x8*)(lds + PG8_SA(b, h) + aoff + m * 2048 + k * 1024); } while (0)
#define PG8_LDB(dst, b, h) do { _Pragma("unroll") for (int n = 0; n < 2; ++n) _Pragma("unroll") for (int k = 0; k < 2; ++k) dst[n][k] = *(const PG8_LAS bf16x8*)(lds + PG8_SB(b, h) + boff + n * 2048 + k * 1024); } while (0)
#define PG8_MMA(ai, bj, At, Bt) do { __builtin_amdgcn_s_setprio(1); _Pragma("unroll") for (int m = 0; m < 4; ++m) _Pragma("unroll") for (int n = 0; n < 2; ++n) _Pragma("unroll") for (int k = 0; k < 2; ++k) \
        acc[ai][bj][m][n] = __builtin_amdgcn_mfma_f32_16x16x32_bf16(Bt[n][k], At[m][k], acc[ai][bj][m][n], 0, 0, 0); __builtin_amdgcn_s_setprio(0); } while (0)
#define PG8_WAIT_V(n) asm volatile("s_waitcnt vmcnt(" #n ")" ::: "memory")
#define PG8_WAIT_L(n) asm volatile("s_waitcnt lgkmcnt(" #n ")" ::: "memory")
#define PG8_BAR __builtin_amdgcn_s_barrier()
#define PG8_SCHED __builtin_amdgcn_sched_barrier(0)
    Unit cur, nxt; int ui = 0;
    if (!S.next(0, cur)) return;
    f32x4 acc[2][2][4][2];
#pragma unroll
    for (int a = 0; a < 2; ++a)
#pragma unroll
        for (int b = 0; b < 2; ++b)
#pragma unroll
            for (int m = 0; m < 4; ++m)
#pragma unroll
                for (int n = 0; n < 2; ++n) acc[a][b][m][n] = (f32x4){0.f, 0.f, 0.f, 0.f};
    bf16x8 At[4][2], B0[2][2], B1[2][2];
    const char* cA = (const char*)g.A + (size_t)cur.pm * tstep; const char* cB = (const char*)g.Bt + (size_t)cur.pn * tstep;
    S.a_ready(cur);
    if constexpr (SP2) {
        PG8_STAGE(PG8_SB(0, 0), cB, voffB); PG8_STAGE(PG8_SB(0, 1), cB + hstepB, voffB); PG8_STAGE(PG8_SA(0, 0), cA, voffA); PG8_STAGE(PG8_SA(0, 1), cA + hstep, voffA);
        if (wr == 1) PG8_BAR;
        PG8_WAIT_V(2); PG8_BAR;
        PG8_STAGE(PG8_SB(1, 0), cB + kstep, voffB); PG8_STAGE(PG8_SA(1, 0), cA + kstep, voffA); PG8_STAGE(PG8_SB(1, 1), cB + hstepB + kstep, voffB);
        PG8_WAIT_V(6); PG8_BAR;
    } else {
        PG8_STAGE(PG8_SB(0, 0), cB, voffB); PG8_STAGE(PG8_SA(0, 0), cA, voffA); PG8_STAGE(PG8_SB(0, 1), cB + hstepB, voffB); PG8_STAGE(PG8_SA(0, 1), cA + hstep, voffA);
        if (wr == 1) PG8_BAR;
        PG8_WAIT_V(4); PG8_BAR;
        PG8_STAGE(PG8_SB(1, 0), cB + kstep, voffB); PG8_STAGE(PG8_SA(1, 0), cA + kstep, voffA); PG8_STAGE(PG8_SB(1, 1), cB + hstepB + kstep, voffB);
        PG8_WAIT_V(6); PG8_BAR;
    }
    for (;;) {
        const bool has_next = S.next(ui + 1, nxt);
        const char* nA = has_next ? (const char*)g.A + (size_t)nxt.pm * tstep : cA; const char* nB = has_next ? (const char*)g.Bt + (size_t)nxt.pn * tstep : cB;
        for (int t = 0; t < nt; t += 2) {
            const bool last = (t == nt - 2);
            const char* a1 = cA + (size_t)(t + 1) * kstep;
            const char* a2 = last ? nA : cA + (size_t)(t + 2) * kstep; const char* b2 = last ? nB : cB + (size_t)(t + 2) * kstep;
            const char* a3 = a2 + kstep; const char* b3 = b2 + kstep;
            if (last && has_next) S.a_ready(nxt);
            if constexpr (SP2) {
            PG8_LDB(B0, 0, 0); PG8_LDB(B1, 0, 1); PG8_SCHED; PG8_LDA(At, 0, 0); PG8_STAGE(PG8_SA(1, 1), a1 + hstep, voffA);
            PG8_WAIT_V(8); PG8_WAIT_L(0); PG8_BAR; PG8_MMA(0, 0, At, B0); PG8_MMA(0, 1, At, B1); PG8_BAR; PG8_SCHED;
            PG8_LDA(At, 0, 1); PG8_STAGE(PG8_SB(0, 0), b2, voffB); PG8_STAGE(PG8_SB(0, 1), b2 + hstepB, voffB); PG8_STAGE(PG8_SA(0, 0), a2, voffA);
            PG8_WAIT_V(8); PG8_WAIT_L(0); PG8_BAR; PG8_MMA(1, 0, At, B0); PG8_MMA(1, 1, At, B1); PG8_BAR; PG8_SCHED;
            PG8_LDB(B0, 1, 0); PG8_LDB(B1, 1, 1); PG8_SCHED; PG8_LDA(At, 1, 0); PG8_STAGE(PG8_SA(0, 1), a2 + hstep, voffA);
            PG8_WAIT_V(8); PG8_WAIT_L(0); PG8_BAR; PG8_MMA(0, 0, At, B0); PG8_MMA(0, 1, At, B1); PG8_BAR; PG8_SCHED;
            PG8_LDA(At, 1, 1); PG8_STAGE(PG8_SB(1, 0), b3, voffB); PG8_STAGE(PG8_SB(1, 1), b3 + hstepB, voffB); PG8_STAGE(PG8_SA(1, 0), a3, voffA);
            PG8_WAIT_V(8); PG8_WAIT_L(0); PG8_BAR; PG8_MMA(1, 0, At, B0); PG8_MMA(1, 1, At, B1); PG8_BAR; PG8_SCHED;
            } else {
            PG8_LDB(B0, 0, 0); PG8_SCHED; PG8_LDA(At, 0, 0); PG8_STAGE(PG8_SA(1, 1), a1 + hstep, voffA);
            PG8_WAIT_L(8); PG8_BAR; PG8_WAIT_L(0); PG8_MMA(0, 0, At, B0); PG8_BAR; PG8_SCHED;
            PG8_LDB(B1, 0, 1); PG8_STAGE(PG8_SB(0, 0), b2, voffB);
            PG8_BAR; PG8_WAIT_L(0); PG8_MMA(0, 1, At, B1); PG8_BAR;
            PG8_LDA(At, 0, 1); PG8_STAGE(PG8_SA(0, 0), a2, voffA);
            PG8_BAR; PG8_WAIT_L(0); PG8_MMA(1, 0, At, B0); PG8_BAR; PG8_SCHED;
            PG8_STAGE(PG8_SB(0, 1), b2 + hstepB, voffB);
            PG8_WAIT_V(6); PG8_BAR; PG8_MMA(1, 1, At, B1); PG8_BAR;
            PG8_LDB(B0, 1, 0); PG8_SCHED; PG8_LDA(At, 1, 0); PG8_STAGE(PG8_SA(0, 1), a2 + hstep, voffA);
            PG8_WAIT_L(8); PG8_BAR; PG8_WAIT_L(0); PG8_MMA(0, 0, At, B0); PG8_BAR; PG8_SCHED;
            PG8_LDB(B1, 1, 1); PG8_STAGE(PG8_SB(1, 0), b3, voffB);
            PG8_BAR; PG8_WAIT_L(0); PG8_MMA(0, 1, At, B1); PG8_BAR;
            PG8_LDA(At, 1, 1); PG8_STAGE(PG8_SA(1, 0), a3, voffA);
            PG8_BAR; PG8_WAIT_L(0); PG8_MMA(1, 0, At, B0); PG8_BAR; PG8_SCHED;
            PG8_STAGE(PG8_SB(1, 1), b3 + hstepB, voffB);
            PG8_WAIT_V(6); PG8_BAR; PG8_MMA(1, 1, At, B1); PG8_BAR;
            }
        }
        if constexpr (ALIGN_EPI) { if (wr == 0) PG8_BAR; }
        if constexpr (!Epi::AFTER_DRAIN) { E(acc, cur, wr, wc, fr, fq); S.done(cur); }
        if (!has_next) break;
#pragma unroll
        for (int a = 0; a < 2; ++a)
#pragma unroll
            for (int b = 0; b < 2; ++b)
#pragma unroll
                for (int m = 0; m < 4; ++m)
#pragma unroll
                    for (int n = 0; n < 2; ++n) acc[a][b][m][n] = (f32x4){0.f, 0.f, 0.f, 0.f};
        cur = nxt; cA = nA; cB = nB; ++ui;
        if constexpr (ALIGN_EPI) { if (wr == 1) PG8_BAR; }
    }
    PG8_WAIT_V(0);
    if constexpr (!ALIGN_EPI) { if (wr == 0) PG8_BAR; }
    PG8_BAR;
    if constexpr (Epi::AFTER_DRAIN) { E.fused(acc, cur, wr, wc, fr, fq, lds, wid, lane); S.done(cur); }
#undef PG8_SA
#undef PG8_SB
#undef PG8_STAGE
#undef PG8_LDA
#undef PG8_LDB
#undef PG8_MMA
#undef PG8_WAIT_V
#undef PG8_WAIT_L
#undef PG8_BAR
#undef PG8_SCHED
}
}
#define GAS __attribute__((address_space(1)))
#define LAS __attribute__((address_space(3)))
typedef unsigned short bf16;
typedef unsigned v4u __attribute__((ext_vector_type(4)));
typedef float f32x4 __attribute__((ext_vector_type(4)));
typedef short bf16x8 __attribute__((ext_vector_type(8)));
typedef GAS unsigned gu32;
typedef GAS unsigned long long gu64;
#define RLX_AGENT __ATOMIC_RELAXED, __HIP_MEMORY_SCOPE_AGENT
#define LDS_WAIT() asm volatile("s_waitcnt lgkmcnt(0)" ::: "memory")
#define VM_WAIT() asm volatile("s_waitcnt vmcnt(0)" ::: "memory")
__device__ __forceinline__ unsigned long long rt() { return __builtin_amdgcn_s_memrealtime(); }
__device__ __forceinline__ unsigned f2bf(float f) { unsigned u = __builtin_bit_cast(unsigned, f); return (u + 0x7fffu + ((u >> 16) & 1u)) >> 16; }
__device__ __forceinline__ unsigned pk2(float lo, float hi) { return f2bf(lo) | (f2bf(hi) << 16); }
#define XB_TMO      128
#define XB_XCNT(j)  (256  + 64 * (j))
#define XB_XSUB(j)  (1280 + 64 * (j))
#define XB_XGEN(j)  (2304 + 64 * (j))
#define XB_TOP      3328
#define XB_TOPGEN   3392
#define XCD_BAR_WORDS 3456
#define XB_SPIN_CAP (1u << 18)

__device__ __forceinline__ unsigned xb_ld(unsigned* p)              { return __hip_atomic_load(p, __ATOMIC_RELAXED, __HIP_MEMORY_SCOPE_AGENT); }
__device__ __forceinline__ unsigned xb_add(unsigned* p, unsigned v) { return __hip_atomic_fetch_add(p, v, __ATOMIC_RELAXED, __HIP_MEMORY_SCOPE_AGENT); }
__device__ __forceinline__ unsigned xb_xcc_id() { return (unsigned)__builtin_amdgcn_s_getreg((3 << 11) | 20) & 0xFu; }
#define XB_SPIN(cond, bar) do { unsigned _sp = 0; while (cond) { __builtin_amdgcn_s_sleep(1); \
    if ((++_sp & 255u) == 0u) { if (xb_ld(&(bar)[XB_TMO])) break; if (_sp > XB_SPIN_CAP) { atomicAdd(&(bar)[XB_TMO], 1u); break; } } } } while (0)

struct XcdBarrier {
    unsigned* bar; unsigned x;
    volatile LAS unsigned* st;
};

__device__ __forceinline__ XcdBarrier xcd_barrier_post(unsigned* bar, volatile LAS unsigned* st) {
    XcdBarrier b; b.bar = bar; b.x = xb_xcc_id(); b.st = st;
    if (threadIdx.x == 0) (void)xb_add(&bar[XB_XCNT(b.x)], 1u);
    return b;
}
__device__ __forceinline__ void xcd_barrier_complete(unsigned* bar, unsigned x, unsigned& nloc, unsigned& nx) {
    const unsigned G = gridDim.x * gridDim.y * gridDim.z;
    unsigned sum, cnt, mine, sp = 0u;
    for (;;) {
        sum = 0u; cnt = 0u; mine = 0u;
#pragma unroll
        for (unsigned j = 0; j < 16; ++j) { const unsigned c = xb_ld(&bar[XB_XCNT(j)]); sum += c; cnt += (c > 0u) ? 1u : 0u; mine = (j == x) ? c : mine; }
        if (sum == G) break;
        __builtin_amdgcn_s_sleep(1);
        if ((++sp & 255u) == 0u) { if (xb_ld(&bar[XB_TMO])) break; if (sp > XB_SPIN_CAP) { atomicAdd(&bar[XB_TMO], 1u); break; } }
    }
    nloc = mine > 0u ? mine : 1u; nx = cnt > 0u ? cnt : 1u;
}

__device__ __forceinline__ void xcd_barrier(const XcdBarrier& b) {
    asm volatile("s_waitcnt vmcnt(0)" ::: "memory");
    __syncthreads();
    if (threadIdx.x == 0) {
        unsigned* bar = b.bar;
        __builtin_amdgcn_s_waitcnt(0);
        unsigned nloc = b.st[0], nx = b.st[1];
        if (nloc == 0u) { xcd_barrier_complete(bar, b.x, nloc, nx); b.st[0] = nloc; b.st[1] = nx; }
        const unsigned old = xb_add(&bar[XB_XSUB(b.x)], 1u);
        const unsigned gen = old / nloc;
        if (old + 1u == (gen + 1u) * nloc) {
            __builtin_amdgcn_fence(__ATOMIC_RELEASE, "agent");
            asm volatile("s_waitcnt vmcnt(0)" ::: "memory");
            const unsigned og = xb_add(&bar[XB_TOP], 1u);
            const unsigned tg = og / nx;
            if (og + 1u == (tg + 1u) * nx) xb_add(&bar[XB_TOPGEN], 1u);
            else XB_SPIN(xb_ld(&bar[XB_TOPGEN]) == tg, bar);
            __builtin_amdgcn_fence(__ATOMIC_ACQUIRE, "agent");
            xb_add(&bar[XB_XGEN(b.x)], 1u);
            asm volatile("s_waitcnt vmcnt(0)" ::: "memory");
        } else {
            XB_SPIN(xb_ld(&bar[XB_XGEN(b.x)]) == gen, bar);
            __builtin_amdgcn_fence(__ATOMIC_ACQUIRE, "agent");
            asm volatile("s_waitcnt vmcnt(0)" ::: "memory");
        }
    }
    __syncthreads();
}
constexpr int NB = 8, SEQ = 4096, DM = 1024, DEPTH = 4, M = NB * SEQ;
constexpr int FF = 2816, NIN = 5852, NINP = 5888;
constexpr float EPS = 1e-6f, NEGF = -1e30f;
constexpr int NWAVES = 8;
constexpr size_t MiB = 1u << 20;
constexpr size_t WS_CTL = 0, CTL_ZERO_BYTES = 1 * MiB;
constexpr size_t WS_ROPE = 1 * MiB;
constexpr size_t WS_KVA = 3 * MiB;
constexpr size_t WS_KC = 11 * MiB, WS_VC = WS_KC + 512 * 1024;
constexpr size_t WS_W = 12 * MiB;
constexpr size_t WO_GU1 = 0, WO_D1 = 11 * MiB, WO_GU2 = WO_D1 + 5 * MiB + 512 * 1024, WO_D2 = WO_GU2 + 11 * MiB, WO_IN = WO_D2 + 5 * MiB + 512 * 1024,
                 WO_PA = WO_IN + 11 * MiB + 512 * 1024, WO_PB = WO_PA + MiB, WO_PC = WO_PB + MiB, WO_OUT = WO_PC + MiB,
                 WO_CW1 = WO_OUT + 2 * MiB  , WO_CW2 = WO_CW1 + MiB  , WO_UKV = WO_CW2 + 32768  , WO_POOL = WO_UKV + 32768  ,
                 WO_POSB = WO_POOL + 131072  , WO_END = WO_POSB + 8192;
static_assert(WO_END <= 52 * MiB, "weights region");
constexpr size_t WS_XN = 64 * MiB;
constexpr size_t WS_R = 128 * MiB;
constexpr size_t WS_G = WS_R, WS_QA = WS_R + 192 * MiB, WS_QC = WS_QA + 32 * MiB, WS_IQ = WS_QC + 32 * MiB, WS_MISC = WS_IQ + 16 * MiB,
                 WS_KVC = WS_MISC + 16 * MiB, WS_KVS = WS_KVC + 16 * MiB, WS_KVW = WS_KVS + 16 * MiB, WS_BU = WS_KVW + 16 * MiB, WS_END = WS_BU + 32 * MiB;
#ifndef YB_SPARE
#define YB_SPARE 0
#endif
constexpr size_t WS_YB = YB_SPARE ? 496 * MiB : WS_XN;
constexpr size_t WS_MG = WS_IQ;
constexpr size_t WS_H = WS_R;
static_assert(WS_END == 496 * MiB, "ws map");
constexpr int RING_BYTES = 131072, LDS_BYTES = 163840, LDSCTL_OFF = 163840 - 256;
constexpr size_t WS_SSQ = 496 * MiB;
constexpr int RS_OFF = 131072;
constexpr int NPL = 10, NPH = 1 + DEPTH * NPL + 1;


#ifndef TPROBE
#define TPROBE 0
#endif
#if TPROBE
#define TP_DECL unsigned long long tp_t_ = __builtin_amdgcn_s_memtime();
#define TP_MARK(k) do { const unsigned long long n_ = __builtin_amdgcn_s_memtime(); if (tid == 0) atomicAdd((unsigned long long*)(ws + 32768) + (k), n_ - tp_t_); tp_t_ = n_; } while (0)
#define TP_ADD(k, v) do { if (tid == 0) atomicAdd((unsigned long long*)(ws + 32768) + (k), (unsigned long long)(v)); } while (0)
#else
#define TP_DECL
#define TP_MARK(k)
#define TP_ADD(k, v)
#endif
__device__ __forceinline__ int lane_id_v() { int l; asm volatile("v_mbcnt_lo_u32_b32 %0, -1, 0\n\tv_mbcnt_hi_u32_b32 %0, -1, %0" : "=v"(l)); return l; }
__device__ __forceinline__ float bflo(unsigned w) { return __uint_as_float(w << 16); }
__device__ __forceinline__ float bfhi(unsigned w) { return __uint_as_float(w & 0xffff0000u); }
__device__ __forceinline__ float bf2f(bf16 v) { return __uint_as_float((unsigned)v << 16); }
__device__ __forceinline__ float wave_sum(float v) {
#pragma unroll
    for (int o = 1; o < 64; o <<= 1) v += __shfl_xor(v, o);
    return v;
}
__device__ __forceinline__ float wave_max(float v) {
#pragma unroll
    for (int o = 1; o < 64; o <<= 1) v = fmaxf(v, __shfl_xor(v, o));
    return v;
}
__device__ __forceinline__ int wave_sum_i(int v) {
#pragma unroll
    for (int o = 1; o < 64; o <<= 1) v += __shfl_xor(v, o);
    return v;
}
__device__ __forceinline__ unsigned wave_max_u(unsigned v) {
#pragma unroll
    for (int o = 1; o < 64; o <<= 1) { const unsigned w = (unsigned)__shfl_xor((int)v, o); v = w > v ? w : v; }
    return v;
}
#define WAVE_LDS_SYNC() do { asm volatile("s_waitcnt lgkmcnt(0)" ::: "memory"); __builtin_amdgcn_wave_barrier(); } while (0)
__host__ __device__ __forceinline__ int permd(int d) { return d < 8 ? 2 * d : (d < 16 ? 2 * (d - 8) + 1 : d); }
__device__ __forceinline__ int win_newcol(int n) {
    if (n < 512) return (n & ~63) + permd(n & 63);
    if (n < 640) return 1280 + 64 + (n - 512);
    if (n < 896) { const int m = n - 640; return 1024 + (m & ~63) + permd(m & 63); }
    if (n < 960) return 1280 + permd(n - 896);
    if (n < 964) return 1280 + 192 + (n - 960);
    if (n < 1476) return 2304 + (n - 964);
    if (n < 1988) { const int m = n - 1476; return 512 + (m & ~63) + permd(m & 63); }
    if (n < 2756) { const int m = n - 1988, kv = m >> 8, r = m & 255, base = 1536 + kv * 256; return r < 128 ? base + (r & ~63) + permd(r & 63) : base + r; }
    if (n < 2780) return 1280 + 196 + (n - 2756);
    return 2816 + (n - 2780);
}
__device__ __forceinline__ int map_row(int mode, int n) { return mode == 0 ? n : (mode == 1 ? ((n >> 7) << 8) + (n & 127) : (mode == 2 ? ((n >> 7) << 8) + 128 + (n & 127) : win_newcol(n))); }

struct Args { const float* in[24]; float* out; unsigned char* ws; int ph_lo, ph_hi; };

__device__ __forceinline__ int unperm(int p) { return p < 16 ? ((p & 1) ? (p >> 1) + 8 : (p >> 1)) : p; }
__device__ __forceinline__ void tr_item(const float* W, int K, int N, bf16* WT, int mode, LAS float* scr, int item, int lane, bool kperm = false, const float* kscale = nullptr) {
    const int nblk = (N + 31) >> 5, kb = item / nblk, nb = item - kb * nblk, k0 = 64 * kb, n0 = 32 * nb;
    const int nn = n0 + (lane & 31);
    const int nnc = nn < N ? nn : N - 1; const float msk = nn < N ? 1.0f : 0.0f;
    const float* ksp = kscale ? kscale : W; const bool hs = kscale != nullptr;
    float wv[32], sv[32];
#pragma unroll
    for (int i = 0; i < 32; ++i) { const int kk = 2 * i + (lane >> 5); wv[i] = W[(size_t)(k0 + kk) * N + nnc]; sv[i] = ksp[k0 + kk]; }
#pragma unroll
    for (int i = 0; i < 32; ++i) { const int kk = 2 * i + (lane >> 5); scr[kk * 33 + (lane & 31)] = wv[i] * (hs ? sv[i] : 1.0f) * msk; }
    LDS_WAIT(); asm volatile("" ::: "memory");
    const int c = lane & 7;
#pragma unroll
    for (int j = 0; j < 4; ++j) { const int n = (lane >> 3) + 8 * j; const LAS float* s = scr + n;
        int ks[8];
#pragma unroll
        for (int i = 0; i < 8; ++i) ks[i] = (kperm ? unperm(8 * c + i) : 8 * c + i) * 33;
        v4u o; o.x = pk2(s[ks[0]], s[ks[1]]); o.y = pk2(s[ks[2]], s[ks[3]]); o.z = pk2(s[ks[4]], s[ks[5]]); o.w = pk2(s[ks[6]], s[ks[7]]);
        if (n0 + n < N) *(v4u*)(WT + (size_t)map_row(mode, n0 + n) * K + k0 + 8 * c) = o; }
    LDS_WAIT(); asm volatile("" ::: "memory");
}
__device__ __forceinline__ void phase_convert(const Args& P, unsigned char* ws, int z, int l, LAS unsigned char* lds, int gw, int NGW, int lane, int wave) {
    asm volatile("" : "+v"(lane)); lane &= 63; asm volatile("" : "+s"(gw), "+s"(NGW));
    LAS float* scr = (LAS float*)(lds + wave * 16384);
    unsigned char* wb = ws + WS_W;
    constexpr int I_F = 16 * 88, I_D = 44 * 32, I_IN = 16 * 183, I_P = 8 * 32, I_O = 16 * 32;
    constexpr int I_C = 32 * 4;
    constexpr int NIT = 4 * I_F + 2 * I_D + I_IN + 3 * I_P + I_O + 2 * I_C;
    const size_t fo = (size_t)l * DM * FF;
    for (int it = gw; it < NIT; it += NGW) {
        int r = it, K = DM, N = FF, mode = 1; const float* W = P.in[3 + z] + fo; size_t wo = WO_GU1; bool kperm = false; const float* ksc = P.in[2 + z] + l * DM;
        if (r >= I_F) { r -= I_F; mode = 2; W = P.in[4 + z] + fo;
        if (r >= I_F) { r -= I_F; mode = 0; W = P.in[5 + z] + fo; K = FF; N = DM; wo = WO_D1; ksc = nullptr;
        if (r >= I_D) { r -= I_D; mode = 1; W = P.in[20 + z] + fo; K = DM; N = FF; wo = WO_GU2; ksc = P.in[19 + z] + l * DM;
        if (r >= I_F) { r -= I_F; mode = 2; W = P.in[21 + z] + fo;
        if (r >= I_F) { r -= I_F; mode = 0; W = P.in[22 + z] + fo; K = FF; N = DM; wo = WO_D2; ksc = nullptr;
        if (r >= I_D) { r -= I_D; mode = 3; W = P.in[7 + z] + (size_t)l * DM * NIN; K = DM; N = NIN; wo = WO_IN; ksc = P.in[6 + z] + l * DM;
        if (r >= I_IN) { r -= I_IN; mode = 0; W = P.in[15 + z] + (size_t)l * 512 * DM; K = 512; N = DM; wo = WO_PA; ksc = nullptr;
        if (r >= I_P) { r -= I_P; W = P.in[16 + z] + (size_t)l * 512 * DM; wo = WO_PB;
        if (r >= I_P) { r -= I_P; W = P.in[17 + z] + (size_t)l * 512 * DM; wo = WO_PC;
        if (r >= I_P) { r -= I_P; W = P.in[18 + z] + (size_t)l * DM * DM; K = DM; wo = WO_OUT;
        if (r >= I_O) { r -= I_O; W = P.in[13 + z] + (size_t)(l * 2) * 2048 * 128; K = 2048; N = 128; wo = WO_CW1; kperm = true;
        if (r >= I_C) { r -= I_C; W += (size_t)2048 * 128; wo = WO_CW1 + 128 * 2048 * 2; kperm = false; } } } } } } } } } } } }
        tr_item(W, K, N, (bf16*)(wb + wo), mode, scr, r, lane, kperm, ksc);
    }
    {
        const int gt = gw * 64 + lane, GT = NGW * 64;
        bf16* ukv = (bf16*)(wb + WO_UKV); bf16* pool = (bf16*)(wb + WO_POOL); bf16* cw2 = (bf16*)(wb + WO_CW2); float* posb = (float*)(wb + WO_POSB);
        const float* w_ukv = P.in[9 + z] + (size_t)l * 128 * 128; const float* gn = P.in[8 + z] + l * 128;
        for (int i = gt; i < 128 * 128; i += GT) { const int np = i >> 7, k = i & 127, n = np < 64 ? unperm(np) : np; ukv[i] = (bf16)f2bf(gn[k] * w_ukv[k * 128 + n]); }
        const float* pw = P.in[10 + z] + (size_t)l * 4 * 128 * 128; const float* psc = P.in[11 + z] + l * 512;
        for (int i = gt; i < 4 * 128 * 128; i += GT) { const int g = i >> 14, d = (i >> 7) & 127, c = i & 127; pool[i] = (bf16)f2bf(pw[(g * 128 + c) * 128 + d] * psc[g * 128 + d]); }
        const float* w2 = P.in[14 + z] + (size_t)l * 2 * 128 * 64;
        for (int i = gt; i < 2 * 64 * 128; i += GT) { const int br = i >> 13, dp = (i >> 7) & 63, n = i & 127, d = br ? dp : unperm(dp); cw2[i] = (bf16)f2bf(w2[(br * 128 + n) * 64 + d]); }
        const float* w1 = P.in[13 + z] + (size_t)l * 2 * 2048 * 128; const float* pos = P.in[12 + z] + (size_t)l * 2 * 2048;
        for (int i = gw; i < 512; i += NGW) { const int o = i & 255, part = i >> 8, br = o >> 7, n = o & 127; float a = 0.f;
#pragma unroll
            for (int q = 0; q < 16; ++q) { const int k = part * 1024 + 64 * q + lane; a += pos[br * 2048 + k] * w1[((size_t)br * 2048 + k) * 128 + n]; }
            a = wave_sum(a); if (lane == 0) posb[part * 256 + o] = a; }
    }
    if (gw < 36) { unsigned zz = 0u; asm volatile("" : "+v"(zz)); v4u z = {zz, zz, zz, zz}; v4u* rp = (v4u*)((bf16*)(wb + WO_IN) + (size_t)(1500 + gw) * DM); for (int i = lane; i < DM / 8; i += 64) rp[i] = z; }
}
__device__ __forceinline__ void phase_rope(const Args& P, unsigned char* ws, int z, int gtid, int gthreads) {
    float* rope = (float*)(ws + WS_ROPE);
    for (int idx = gtid; idx < M * 8; idx += gthreads) {
        const int row = idx >> 3, i = idx & 7;
        const double inv = i == 0 ? 1.0 : i == 1 ? 0.19392274474868576 : i == 2 ? 0.03760603093086393 : i == 3 ? 0.007292664737217109 : i == 4 ? 0.001414213562373095 : i == 5 ? 0.0002742481756762073 : i == 6 ? 5.318295896944988e-05 : 1.031338537721246e-05;
        const double ang = (double)((const int*)P.in[1 + z])[row] * inv;
        double s, c; sincos(ang, &s, &c);
        rope[row * 16 + i] = (float)c; rope[row * 16 + 8 + i] = (float)s;
    }
}
__device__ __forceinline__ void norm_row_bf16(const float* xrow, const float* gain, bf16* orow, int lane) {
    const f32x4* xr = (const f32x4*)xrow + lane; const f32x4* gr = (const f32x4*)gain + lane;
    f32x4 v[4]; float s = 0.f;
#pragma unroll
    for (int j = 0; j < 4; ++j) { v[j] = xr[64 * j]; s += (v[j].x * v[j].x + v[j].y * v[j].y) + (v[j].z * v[j].z + v[j].w * v[j].w); }
    const float r = 1.0f / sqrtf(wave_sum(s) * (1.f / DM) + EPS);
    unsigned long long* o8 = (unsigned long long*)orow + lane;
#pragma unroll
    for (int j = 0; j < 4; ++j) { const f32x4 g = gr[64 * j]; o8[64 * j] = (unsigned long long)pk2(v[j].x * r * g.x, v[j].y * r * g.y) | ((unsigned long long)pk2(v[j].z * r * g.z, v[j].w * r * g.w) << 32); }
}
__device__ __forceinline__ void stat_row_bf16(const float* xrow, bf16* orow, float* ssq16, int lane) {
    const f32x4* xr = (const f32x4*)xrow + lane;
    f32x4 v[4]; float s = 0.f;
#pragma unroll
    for (int j = 0; j < 4; ++j) { v[j] = xr[64 * j]; s += (v[j].x * v[j].x + v[j].y * v[j].y) + (v[j].z * v[j].z + v[j].w * v[j].w); }
    s = wave_sum(s);
    unsigned long long* o8 = (unsigned long long*)orow + lane;
#pragma unroll
    for (int j = 0; j < 4; ++j) o8[64 * j] = (unsigned long long)pk2(v[j].x, v[j].y) | ((unsigned long long)pk2(v[j].z, v[j].w) << 32);
    if (lane < 16) ssq16[lane] = lane == 0 ? s : 0.f;
}
__device__ __forceinline__ void norm_row_f32(float* xrow, const float* gain, int lane, float tps = 1.0f) {
    f32x4* xr = (f32x4*)xrow + lane; const f32x4* gr = (const f32x4*)gain + lane;
    f32x4 v[4]; float s = 0.f;
#pragma unroll
    for (int j = 0; j < 4; ++j) { v[j] = xr[64 * j]; s += (v[j].x * v[j].x + v[j].y * v[j].y) + (v[j].z * v[j].z + v[j].w * v[j].w); }
    const float r = tps / sqrtf(wave_sum(s) * (1.f / DM) + EPS);
#pragma unroll
    for (int j = 0; j < 4; ++j) { const f32x4 g = gr[64 * j]; xr[64 * j] = v[j] * r * g; }
}

__device__ __forceinline__ void norm_row_out(const bf16* xrow, float* orow, const float* gain, int lane, float tps = 1.0f) {
    const v4u a = *(const v4u*)(xrow + 16 * lane), b = *(const v4u*)(xrow + 16 * lane + 8);
    const float f[16] = {bflo(a.x), bfhi(a.x), bflo(a.y), bfhi(a.y), bflo(a.z), bfhi(a.z), bflo(a.w), bfhi(a.w), bflo(b.x), bfhi(b.x), bflo(b.y), bfhi(b.y), bflo(b.z), bfhi(b.z), bflo(b.w), bfhi(b.w)};
    float s = 0.f;
#pragma unroll
    for (int e = 0; e < 16; ++e) s += f[e] * f[e];
    const float r = tps / sqrtf(wave_sum(s) * (1.f / DM) + EPS);
    const f32x4* gr = (const f32x4*)(gain + 16 * lane); f32x4* orr = (f32x4*)(orow + 16 * lane);
#pragma unroll
    for (int j = 0; j < 4; ++j) { const f32x4 g = gr[j]; f32x4 o; o.x = f[4 * j] * r * g.x; o.y = f[4 * j + 1] * r * g.y; o.z = f[4 * j + 2] * r * g.z; o.w = f[4 * j + 3] * r * g.w; orr[j] = o; }
}

__device__ __forceinline__ void stat_rows4_bf16(const float* x, bf16* xo, float* ssq, int m0, int st, int lane) {
    f32x4 v[4][4];
#pragma unroll
    for (int r = 0; r < 4; ++r) { const int m = m0 + r * st; const f32x4* xr = (const f32x4*)(x + (size_t)(m < M ? m : 0) * DM) + lane;
#pragma unroll
        for (int j = 0; j < 4; ++j) v[r][j] = xr[64 * j]; }
#pragma unroll
    for (int r = 0; r < 4; ++r) { const int m = m0 + r * st; if (m < M) { float s = 0.f;
#pragma unroll
        for (int j = 0; j < 4; ++j) s += (v[r][j].x * v[r][j].x + v[r][j].y * v[r][j].y) + (v[r][j].z * v[r][j].z + v[r][j].w * v[r][j].w);
        s = wave_sum(s);
        unsigned long long* o8 = (unsigned long long*)(xo + (size_t)m * DM) + lane;
#pragma unroll
        for (int j = 0; j < 4; ++j) o8[64 * j] = (unsigned long long)pk2(v[r][j].x, v[r][j].y) | ((unsigned long long)pk2(v[r][j].z, v[r][j].w) << 32);
        if (lane < 16) ssq[(size_t)m * 16 + lane] = lane == 0 ? s : 0.f; } }
}
__device__ __forceinline__ void norm_rows4_out(const bf16* x, float* out, const float* gain, int m0, int st, int lane, float tps = 1.0f) {
    v4u a[4], b[4];
#pragma unroll
    for (int r = 0; r < 4; ++r) { const int m = m0 + r * st; const bf16* xr = x + (size_t)(m < M ? m : 0) * DM + 16 * lane; a[r] = *(const v4u*)xr; b[r] = *(const v4u*)(xr + 8); }
    f32x4 g[4];
#pragma unroll
    for (int j = 0; j < 4; ++j) g[j] = ((const f32x4*)(gain + 16 * lane))[j];
#pragma unroll
    for (int r = 0; r < 4; ++r) { const int m = m0 + r * st; if (m < M) {
        const float f[16] = {bflo(a[r].x), bfhi(a[r].x), bflo(a[r].y), bfhi(a[r].y), bflo(a[r].z), bfhi(a[r].z), bflo(a[r].w), bfhi(a[r].w), bflo(b[r].x), bfhi(b[r].x), bflo(b[r].y), bfhi(b[r].y), bflo(b[r].z), bfhi(b[r].z), bflo(b[r].w), bfhi(b[r].w)};
        float s = 0.f;
#pragma unroll
        for (int e = 0; e < 16; ++e) s += f[e] * f[e];
        const float rs = tps / sqrtf(wave_sum(s) * (1.f / DM) + EPS);
        f32x4* orr = (f32x4*)(out + (size_t)m * DM + 16 * lane);
#pragma unroll
        for (int j = 0; j < 4; ++j) { f32x4 o; o.x = f[4 * j] * rs * g[j].x; o.y = f[4 * j + 1] * rs * g[j].y; o.z = f[4 * j + 2] * rs * g[j].z; o.w = f[4 * j + 3] * rs * g[j].w; orr[j] = o; } } }
}
__device__ __forceinline__ unsigned f2o(float s) { const int b = (int)__float_as_uint(s); return (unsigned)(b ^ ((b >> 31) | (int)0x80000000)); }
__device__ __forceinline__ void unpack8(const v4u v, float* f) { f[0] = bflo(v.x); f[1] = bfhi(v.x); f[2] = bflo(v.y); f[3] = bfhi(v.y); f[4] = bflo(v.z); f[5] = bfhi(v.z); f[6] = bflo(v.w); f[7] = bfhi(v.w); }
__device__ __forceinline__ void load_row64(const bf16* p, float* f) {
    const v4u* q = (const v4u*)p;
#pragma unroll
    for (int i = 0; i < 8; ++i) unpack8(q[i], f + 8 * i);
}
__device__ __forceinline__ float dot64(const LAS float* q, const float* k) {
    float d = 0.f;
#pragma unroll
    for (int i = 0; i < 16; ++i) { const f32x4 qq = *(const LAS f32x4*)(q + 4 * i); d += qq.x * k[4 * i] + qq.y * k[4 * i + 1] + qq.z * k[4 * i + 2] + qq.w * k[4 * i + 3]; }
    return d;
}
__device__ __forceinline__ void dsa_query(const Args& P, unsigned char* ws, int z, int row, LAS unsigned char* wl, int lane) {
    const int b = row >> 12, t = row & (SEQ - 1), n = t + 1;
    LAS unsigned* su = (LAS unsigned*)wl; LAS float* pb = (LAS float*)wl; LAS unsigned short* list = (LAS unsigned short*)(wl + 16384); LAS float* qb = (LAS float*)(wl + 16896);
    const bf16* misc = (const bf16*)(ws + WS_MISC);
    const unsigned long long lt = (1ull << lane) - 1ull;
    int nsel;
    if (n <= 256) { for (int i = lane; i < n; i += 64) list[i] = (unsigned short)i; nsel = n; }
    else {
        { const uint2 v = *(const uint2*)((const bf16*)(ws + WS_IQ) + (size_t)row * 256 + lane * 4); qb[lane * 4] = bflo(v.x); qb[lane * 4 + 1] = bfhi(v.x); qb[lane * 4 + 2] = bflo(v.y); qb[lane * 4 + 3] = bfhi(v.y); }
        float iw[4]; { const uint2 v = *(const uint2*)(misc + (size_t)row * 256 + 192); iw[0] = 0.5f * bflo(v.x); iw[1] = 0.5f * bfhi(v.x); iw[2] = 0.5f * bflo(v.y); iw[3] = 0.5f * bfhi(v.y); }
        WAVE_LDS_SYNC();
        const int nch = (n + 63) >> 6;
        for (int i = 0; i < nch; ++i) {
            const int key = i * 64 + lane; const bool valid = key <= t;
            float kf[64]; load_row64(misc + (size_t)(b * SEQ + (valid ? key : t)) * 256, kf);
            float s = 0.f;
#pragma unroll
            for (int h = 0; h < 4; ++h) s += iw[h] * fmaxf(dot64(qb + h * 64, kf), 0.f);
            su[key] = valid ? f2o(s) : 0u;
        }
        WAVE_LDS_SYNC();
        unsigned prefix = 0u;
        for (int bit = 31; bit >= 0; --bit) {
            const unsigned cand = prefix | (1u << bit); int c = 0;
            for (int i = 0; i < nch; ++i) c += (su[i * 64 + lane] >= cand) ? 1 : 0;
            c = wave_sum_i(c);
            if (c >= 256) prefix = cand;
            if (c == 256) break;
        }
        int cgt = 0;
        for (int i = 0; i < nch; ++i) cgt += (su[i * 64 + lane] > prefix) ? 1 : 0;
        const int need_eq = 256 - wave_sum_i(cgt);
        int base = 0, eq_taken = 0;
        for (int i = 0; i < nch; ++i) {
            const unsigned v = su[i * 64 + lane]; const bool gt = v > prefix, eq = v == prefix;
            const unsigned long long meq = __ballot(eq);
            const bool sel = gt || (eq && (eq_taken + __popcll(meq & lt)) < need_eq);
            const unsigned long long ms = __ballot(sel);
            if (sel) list[base + __popcll(ms & lt)] = (unsigned short)(i * 64 + lane);
            base += __popcll(ms); eq_taken += __popcll(meq);
        }
        nsel = 256;
    }
    { const v4u v = *(const v4u*)((const bf16*)(ws + WS_QA) + (size_t)row * 512 + lane * 8); float f[8]; unpack8(v, f);
#pragma unroll
      for (int e = 0; e < 8; ++e) qb[lane * 8 + e] = f[e]; }
    WAVE_LDS_SYNC();
    const bf16* kva = (const bf16*)(ws + WS_KVA);
    float s[8][4];
#pragma unroll
    for (int j = 0; j < 4; ++j) {
        const int slot = lane + 64 * j; const bool valid = slot < nsel; const int key = list[valid ? slot : 0];
        float kf[64]; load_row64(kva + (size_t)(b * SEQ + key) * 128, kf);
#pragma unroll
        for (int h = 0; h < 8; ++h) s[h][j] = valid ? dot64(qb + h * 64, kf) : NEGF;
    }
    float linv[8];
#pragma unroll
    for (int h = 0; h < 8; ++h) {
        const float m = wave_max(fmaxf(fmaxf(s[h][0], s[h][1]), fmaxf(s[h][2], s[h][3]))); float ls = 0.f;
#pragma unroll
        for (int j = 0; j < 4; ++j) { const float p = __expf(s[h][j] - m); ls += p; pb[h * 256 + lane + 64 * j] = p; }
        linv[h] = 1.0f / wave_sum(ls);
    }
    WAVE_LDS_SYNC();
    float acc[8] = {0.f, 0.f, 0.f, 0.f, 0.f, 0.f, 0.f, 0.f};
    for (int slot = 0; slot < nsel; ++slot) {
        const float v = bf2f(kva[(size_t)(b * SEQ + list[slot]) * 128 + 64 + lane]);
#pragma unroll
        for (int h = 0; h < 8; ++h) acc[h] += pb[h * 256 + slot] * v;
    }
    bf16* ya = (bf16*)(ws + WS_QA) + (size_t)row * 512;
#pragma unroll
    for (int h = 0; h < 8; ++h) ya[h * 64 + lane] = (bf16)f2bf(acc[h] * linv[h]);
    WAVE_LDS_SYNC();
}
typedef short s16x4 __attribute__((ext_vector_type(4)));
typedef short v4i16_t __attribute__((ext_vector_type(4)));
typedef float f32x4v __attribute__((ext_vector_type(4)));
typedef __bf16 bf16x2_t __attribute__((ext_vector_type(2)));
typedef float f32x2_t __attribute__((ext_vector_type(2)));
__device__ __forceinline__ unsigned cvtpk(float lo, float hi) { f32x2_t v = {lo, hi}; bf16x2_t b = __builtin_convertvector(v, bf16x2_t); return __builtin_bit_cast(unsigned, b); }
constexpr float L2E = 1.4426950408889634f;
#ifndef NSA_JOINT
#define NSA_JOINT 1
#endif
#ifndef NSA_NOSKIP
#define NSA_NOSKIP 0
#endif
constexpr int NSA_KSTR = 72, NSA_VSTR = 80;
constexpr int NSA_KB = 64 * NSA_KSTR * 2, NSA_VB = 64 * NSA_VSTR * 2;
constexpr int NSA_D = 6, NSA_SLOT = 16384;
constexpr int NSA_OFF_RING = 0, NSA_OFF_KCL = 0, NSA_OFF_VCTL = 32768  , NSA_OFF_IMPA = 65536  , NSA_OFF_IMPB = NSA_OFF_IMPA + 64 * 65 * 4, NSA_OFF_UM = NSA_D * NSA_SLOT + 1024  , NSA_OFF_QM = NSA_OFF_UM + 64, NSA_OFF_ST = NSA_OFF_UM + 1024, NSA_LDS = NSA_OFF_ST + 512 * 64;
__device__ __forceinline__ s16x4 tr16(const LAS unsigned char* p) { return __builtin_bit_cast(s16x4, __builtin_amdgcn_ds_read_tr16_b64_v4i16((LAS v4i16_t*)p)); }
__device__ __forceinline__ bf16x8 cat4(s16x4 a, s16x4 b) { return __builtin_shufflevector(a, b, 0, 1, 2, 3, 4, 5, 6, 7); }
__device__ __forceinline__ bf16x8 pack8(float a0, float a1, float a2, float a3, float b0, float b1, float b2, float b3) {
    v4u w; w.x = pg8::cvt_pk_bf16(a0, a1); w.y = pg8::cvt_pk_bf16(a2, a3); w.z = pg8::cvt_pk_bf16(b0, b1); w.w = pg8::cvt_pk_bf16(b2, b3); return __builtin_bit_cast(bf16x8, w);
}
__device__ __forceinline__ float qxor1(float v) { return __builtin_bit_cast(float, __builtin_amdgcn_update_dpp(0, __builtin_bit_cast(int, v), 0xB1, 0xF, 0xF, true)); }
__device__ __forceinline__ float qxor2(float v) { return __builtin_bit_cast(float, __builtin_amdgcn_update_dpp(0, __builtin_bit_cast(int, v), 0x4E, 0xF, 0xF, true)); }
__device__ __forceinline__ float xmax16(float v) { v = fmaxf(v, __shfl_xor(v, 16)); return fmaxf(v, __shfl_xor(v, 32)); }
__device__ __forceinline__ float xsum16(float v) { v += __shfl_xor(v, 16); return v + __shfl_xor(v, 32); }

__device__ __forceinline__ void nsa_fetch(const bf16* kv, int b, int jb, int g, int tid, v4u& kr, v4u& vr) {
    const bf16* p = kv + (size_t)(b * SEQ + 64 * jb + (tid >> 3)) * 256 + g * 64 + (tid & 7) * 8;
    kr = *(const v4u*)p; vr = *(const v4u*)(p + 128);
}
__device__ __forceinline__ void nsa_stash(LAS unsigned char* Kb, LAS unsigned char* Vb, int tid, const v4u& kr, const v4u& vr) {
    *(LAS v4u*)(Kb + ((tid >> 3) * NSA_KSTR + (tid & 7) * 8) * 2) = kr; *(LAS v4u*)(Vb + ((tid >> 3) * NSA_VSTR + (tid & 7) * 8) * 2) = vr;
}
template <bool FULL>
__device__ __forceinline__ void nsa_block2(const LAS unsigned char* Kb, const LAS unsigned char* Vb, const bf16x8 (&qf)[2][2], const bool (&sel)[2], const int (&klo)[2], const int (&khi)[2],
                                           float (&mrow)[2], float (&lrow)[2], f32x4v (&o)[2][4], int lane) {
    const int j = lane & 15, gq = lane >> 4;
    f32x4v s[2][4];
#pragma unroll
    for (int kt = 0; kt < 4; ++kt) {
        s[0][kt] = (f32x4v){0.f, 0.f, 0.f, 0.f}; s[1][kt] = (f32x4v){0.f, 0.f, 0.f, 0.f};
#pragma unroll
        for (int ks = 0; ks < 2; ++ks) {
            const bf16x8 kf = *(const LAS bf16x8*)(Kb + (16 * kt + j) * 128 + (((gq + 4 * ks) ^ (j & 7)) << 4));
            s[0][kt] = __builtin_amdgcn_mfma_f32_16x16x32_bf16(kf, qf[0][ks], s[0][kt], 0, 0, 0);
            s[1][kt] = __builtin_amdgcn_mfma_f32_16x16x32_bf16(kf, qf[1][ks], s[1][kt], 0, 0, 0);
        }
    }
#pragma unroll
    for (int rg = 0; rg < 2; ++rg) {
        float bm = NEGF;
        if (FULL) { const float bias = sel[rg] ? 0.f : NEGF;
#pragma unroll
            for (int kt = 0; kt < 4; ++kt)
#pragma unroll
                for (int e = 0; e < 4; ++e) { const float v = s[rg][kt][e] + bias; s[rg][kt][e] = v; bm = fmaxf(bm, v); }
        } else {
#pragma unroll
            for (int kt = 0; kt < 4; ++kt)
#pragma unroll
                for (int e = 0; e < 4; ++e) { const int ko = 16 * kt + 4 * gq + e; const bool ok = sel[rg] && ko >= klo[rg] && ko <= khi[rg]; const float v = ok ? s[rg][kt][e] : NEGF; s[rg][kt][e] = v; bm = fmaxf(bm, v); }
        }
        bm = xmax16(bm);
        const float mnew = fmaxf(mrow[rg], bm), alpha = __builtin_amdgcn_exp2f(mrow[rg] - mnew);
        const bool moved = __builtin_amdgcn_ballot_w64(mnew != mrow[rg]) != 0ull;
        mrow[rg] = mnew;
        float ps = 0.f;
#pragma unroll
        for (int kt = 0; kt < 4; ++kt)
#pragma unroll
            for (int e = 0; e < 4; ++e) { const float p = __builtin_amdgcn_exp2f(s[rg][kt][e] - mnew); s[rg][kt][e] = p; ps += p; }
        lrow[rg] = lrow[rg] * alpha + ps;
        if (moved) {
#pragma unroll
            for (int dt = 0; dt < 4; ++dt) o[rg][dt] *= alpha;
        }
    }
#pragma unroll
    for (int kk = 0; kk < 2; ++kk) {
        const bf16x8 pf0 = pack8(s[0][2 * kk][0], s[0][2 * kk][1], s[0][2 * kk][2], s[0][2 * kk][3], s[0][2 * kk + 1][0], s[0][2 * kk + 1][1], s[0][2 * kk + 1][2], s[0][2 * kk + 1][3]);
        const bf16x8 pf1 = pack8(s[1][2 * kk][0], s[1][2 * kk][1], s[1][2 * kk][2], s[1][2 * kk][3], s[1][2 * kk + 1][0], s[1][2 * kk + 1][1], s[1][2 * kk + 1][2], s[1][2 * kk + 1][3]);
#pragma unroll
        for (int dt = 0; dt < 4; ++dt) {
            const LAS unsigned char* va = Vb + (32 * kk + 4 * gq + (j >> 2)) * 128 + (16 * dt + 4 * (j & 3)) * 2;
            const bf16x8 vf = cat4(tr16(va), tr16(va + 16 * 128));
            o[0][dt] = __builtin_amdgcn_mfma_f32_16x16x32_bf16(vf, pf0, o[0][dt], 0, 0, 0);
            o[1][dt] = __builtin_amdgcn_mfma_f32_16x16x32_bf16(vf, pf1, o[1][dt], 0, 0, 0);
        }
        }
}
__device__ __forceinline__ void nsa_block4(const LAS unsigned char* KbA, const LAS unsigned char* VbA, const LAS unsigned char* KbB, const LAS unsigned char* VbB, const bf16x8 (&qf)[2][2],
                                           const bool (&selA)[2], const bool (&selB)[2], float (&mrow)[2], float (&lrow)[2], f32x4v (&o)[2][4], int lane) {
    const int j = lane & 15, gq = lane >> 4;
    f32x4v s[2][2][4];
#pragma unroll
    for (int bl = 0; bl < 2; ++bl) { const LAS unsigned char* Kb = bl ? KbB : KbA;
#pragma unroll
        for (int kt = 0; kt < 4; ++kt) {
            s[bl][0][kt] = (f32x4v){0.f, 0.f, 0.f, 0.f}; s[bl][1][kt] = (f32x4v){0.f, 0.f, 0.f, 0.f};
#pragma unroll
            for (int ks = 0; ks < 2; ++ks) {
                const bf16x8 kf = *(const LAS bf16x8*)(Kb + (16 * kt + j) * 128 + (((gq + 4 * ks) ^ (j & 7)) << 4));
                s[bl][0][kt] = __builtin_amdgcn_mfma_f32_16x16x32_bf16(kf, qf[0][ks], s[bl][0][kt], 0, 0, 0);
                s[bl][1][kt] = __builtin_amdgcn_mfma_f32_16x16x32_bf16(kf, qf[1][ks], s[bl][1][kt], 0, 0, 0);
            }
        } }
#pragma unroll
    for (int rg = 0; rg < 2; ++rg) {
        float ba = NEGF, bb = NEGF;
#pragma unroll
        for (int kt = 0; kt < 4; ++kt)
#pragma unroll
            for (int e = 0; e < 4; ++e) { ba = fmaxf(ba, s[0][rg][kt][e]); bb = fmaxf(bb, s[1][rg][kt][e]); }
        if (!selA[rg]) ba = NEGF;
        if (!selB[rg]) bb = NEGF;
        const float bm = xmax16(fmaxf(ba, bb));
        const float mnew = fmaxf(mrow[rg], bm), alpha = __builtin_amdgcn_exp2f(mrow[rg] - mnew);
        const bool moved = __builtin_amdgcn_ballot_w64(mnew != mrow[rg]) != 0ull;
        mrow[rg] = mnew;
        const float sa = selA[rg] ? mnew : 1e30f, sb = selB[rg] ? mnew : 1e30f;
        float ps = 0.f;
#pragma unroll
        for (int kt = 0; kt < 4; ++kt)
#pragma unroll
            for (int e = 0; e < 4; ++e) { const float pa = __builtin_amdgcn_exp2f(s[0][rg][kt][e] - sa), pb = __builtin_amdgcn_exp2f(s[1][rg][kt][e] - sb); s[0][rg][kt][e] = pa; s[1][rg][kt][e] = pb; ps += pa + pb; }
        lrow[rg] = lrow[rg] * alpha + ps;
        if (moved) {
#pragma unroll
            for (int dt = 0; dt < 4; ++dt) o[rg][dt] *= alpha;
        }
    }
#pragma unroll
    for (int bl = 0; bl < 2; ++bl) { const LAS unsigned char* Vb = bl ? VbB : VbA;
#pragma unroll
        for (int kk = 0; kk < 2; ++kk) {
            const bf16x8 pf0 = pack8(s[bl][0][2 * kk][0], s[bl][0][2 * kk][1], s[bl][0][2 * kk][2], s[bl][0][2 * kk][3], s[bl][0][2 * kk + 1][0], s[bl][0][2 * kk + 1][1], s[bl][0][2 * kk + 1][2], s[bl][0][2 * kk + 1][3]);
            const bf16x8 pf1 = pack8(s[bl][1][2 * kk][0], s[bl][1][2 * kk][1], s[bl][1][2 * kk][2], s[bl][1][2 * kk][3], s[bl][1][2 * kk + 1][0], s[bl][1][2 * kk + 1][1], s[bl][1][2 * kk + 1][2], s[bl][1][2 * kk + 1][3]);
#pragma unroll
            for (int dt = 0; dt < 4; ++dt) {
                const LAS unsigned char* va = Vb + (32 * kk + 4 * gq + (j >> 2)) * 128 + (16 * dt + 4 * (j & 3)) * 2;
                const bf16x8 vf = cat4(tr16(va), tr16(va + 16 * 128));
                o[0][dt] = __builtin_amdgcn_mfma_f32_16x16x32_bf16(vf, pf0, o[0][dt], 0, 0, 0);
                o[1][dt] = __builtin_amdgcn_mfma_f32_16x16x32_bf16(vf, pf1, o[1][dt], 0, 0, 0);
            }
        } }
}
__device__ __forceinline__ void glds16(const void* gsrc, unsigned lds_dst) { unsigned keep;
    asm volatile("s_mov_b32 %0, m0\n\ts_mov_b32 m0, %2\n\ts_nop 0\n\tglobal_load_lds_dwordx4 %1, off\n\ts_mov_b32 m0, %0" : "=&s"(keep) : "v"(gsrc), "s"(lds_dst) : "memory"); }
template <int MODE>
__device__ __forceinline__ void nsa_attend(const bf16* kv, unsigned long long mask, int b, int g, int c, int tid, int lane, LAS unsigned char* ring, const bf16x8 (&qf)[2][2],
                                           const unsigned long long (&rmask)[2], const unsigned long long (&gmask)[2], const int (&trow)[2], float (&mrow)[2], float (&lrow)[2], f32x4v (&o)[2][4]) {
    const int wave = __builtin_amdgcn_readfirstlane(tid >> 6);
    const int rr = 8 * wave + (lane >> 3);
    const bf16* gk = kv + (size_t)(b * SEQ + rr) * 256 + g * 64 + (((lane & 7) ^ (rr & 7)) << 3);
    const bf16* gv = kv + (size_t)(b * SEQ + rr) * 256 + 128 + g * 64 + ((lane & 7) << 3);
    const unsigned ring0 = (unsigned)(uintptr_t)(unsigned char*)ring + wave * 1024;
#define NSA_ISSUE(jb_, slot_) do { glds16(gk + (size_t)(jb_) * 64 * 256, (unsigned)__builtin_amdgcn_readfirstlane(ring0 + (slot_) * NSA_SLOT)); \
                                   glds16(gv + (size_t)(jb_) * 64 * 256, (unsigned)__builtin_amdgcn_readfirstlane(ring0 + (slot_) * NSA_SLOT + 8192)); } while (0)
    unsigned long long remi = mask, remc = mask; int lastb = 0, si = 0, sc_ = 0;
#if DUP == 12
    float m2_[2] = {NEGF, NEGF}, l2_[2] = {0.f, 0.f}; f32x4v o2_[2][4]; for (int rg = 0; rg < 2; ++rg) for (int dt = 0; dt < 4; ++dt) o2_[rg][dt] = (f32x4v){0.f, 0.f, 0.f, 0.f};
#endif
#define NSA_ISSUE1() do { if (remi) { lastb = (int)__builtin_ctzll(remi); remi &= remi - 1ull; } NSA_ISSUE(lastb, si); si = si + 1 == NSA_D ? 0 : si + 1; } while (0)
#define NSA_FLAGS(jj_, sel_, klo_, khi_, act_) do { _Pragma("unroll") for (int rg = 0; rg < 2; ++rg) { const int o6 = trow[rg] & 63; \
            if (MODE == 0) { sel_[rg] = (rmask[rg] >> (jj_)) & 1ull; act_[rg] = (gmask[rg] >> (jj_)) & 1ull; klo_[rg] = 0; khi_[rg] = ((jj_) == c) ? o6 : 63; } \
            else { sel_[rg] = true; act_[rg] = true; klo_[rg] = ((jj_) == c - 4) ? o6 + 1 : 0; khi_[rg] = ((jj_) == c) ? o6 : 63; } } } while (0)
    NSA_ISSUE1(); NSA_ISSUE1(); NSA_ISSUE1(); NSA_ISSUE1();
    while (remc) {
        const int jA = (int)__builtin_ctzll(remc); remc &= remc - 1ull;
        const bool two = remc != 0ull; const int jB = two ? (int)__builtin_ctzll(remc) : jA; if (two) remc &= remc - 1ull;
        asm volatile("s_waitcnt vmcnt(4) lgkmcnt(0)\n\ts_barrier" ::: "memory");
        NSA_ISSUE1(); NSA_ISSUE1();
        const LAS unsigned char* kA = ring + sc_ * NSA_SLOT; const LAS unsigned char* vA = kA + 8192; const LAS unsigned char* kB = kA + NSA_SLOT; const LAS unsigned char* vB = kB + 8192;
        sc_ = sc_ + 2 == NSA_D ? 0 : sc_ + 2;
        bool selA[2], selB[2], actA[2], actB[2]; int kloA[2], khiA[2], kloB[2], khiB[2];
        NSA_FLAGS(jA, selA, kloA, khiA, actA); NSA_FLAGS(jB, selB, kloB, khiB, actB);
        const bool fullA = (MODE == 0) ? (jA != c) : (jA != c && jA != c - 4), fullB = (MODE == 0) ? (jB != c) : (jB != c && jB != c - 4);
        const bool doA = actA[0] || actA[1], doB = two && (actB[0] || actB[1]);
        if (NSA_JOINT && MODE == 0 && doA && doB && fullA && fullB) nsa_block4(kA, vA, kB, vB, qf, selA, selB, mrow, lrow, o, lane);
        else {
            if (doA) { if (fullA) nsa_block2<true>(kA, vA, qf, selA, kloA, khiA, mrow, lrow, o, lane); else nsa_block2<false>(kA, vA, qf, selA, kloA, khiA, mrow, lrow, o, lane); }
            if (doB) { if (fullB) nsa_block2<true>(kB, vB, qf, selB, kloB, khiB, mrow, lrow, o, lane); else nsa_block2<false>(kB, vB, qf, selB, kloB, khiB, mrow, lrow, o, lane); }
        }
    }
#undef NSA_ISSUE1
#undef NSA_FLAGS
    asm volatile("s_waitcnt vmcnt(0) lgkmcnt(0)\n\ts_barrier" ::: "memory");
#undef NSA_ISSUE
}
#if defined(PROBE_CMP)
__device__ __forceinline__ void nsa_probe_store(unsigned char* ws, int row, int head, int gq, const f32x4v (&v)[4]) {
    bf16* pb_ = (bf16*)(ws + 497 * MiB);
    for (int dt = 0; dt < 4; ++dt) { uint2 w; w.x = cvtpk(v[dt][0], v[dt][1]); w.y = cvtpk(v[dt][2], v[dt][3]); *(uint2*)(pb_ + (size_t)row * 512 + head * 64 + 16 * dt + 4 * gq) = w; }
}
#endif
__device__ __forceinline__ void nsa_unit(unsigned char* ws, int unit, LAS unsigned char* lds, int tid_in, bf16* yout) {
    int tid = tid_in; asm volatile("" : "+v"(tid));
    const int lane = tid & 63, wave = __builtin_amdgcn_readfirstlane(tid >> 6), j = lane & 15, gq = lane >> 4;
    const int c = unit & 63, g = (unit >> 6) & 1, b = unit >> 7, bg = b * 2 + g;
    LAS float* impa = (LAS float*)(lds + NSA_OFF_IMPA); LAS float* impb = (LAS float*)(lds + NSA_OFF_IMPB);
    LAS unsigned long long* um = (LAS unsigned long long*)(lds + NSA_OFF_UM);
    TP_DECL
    for (int i = tid; i < 2 * 64 * 65; i += 512) impa[i] = 0.f;
    {
        const v4u* ksrc = (const v4u*)((const bf16*)(ws + WS_KC) + (size_t)bg * 256 * 64); const v4u* vsrc = (const v4u*)((const bf16*)(ws + WS_VC) + (size_t)bg * 64 * 256);
        v4u kst[4], vst[4];
#pragma unroll
        for (int i = 0; i < 4; ++i) { kst[i] = ksrc[tid + 512 * i]; vst[i] = vsrc[tid + 512 * i]; }
#pragma unroll
        for (int i = 0; i < 4; ++i) { const int idx = tid + 512 * i; const int r = idx >> 3, sg = idx & 7; *(LAS v4u*)(lds + NSA_OFF_KCL + r * 128 + ((sg ^ (r & 7)) << 4)) = kst[i]; }
#pragma unroll
        for (int i = 0; i < 4; ++i) { const int idx = tid + 512 * i; const int r = idx >> 5, sg = idx & 31; *(LAS v4u*)(lds + NSA_OFF_VCTL + r * 512 + ((sg ^ (r & 15)) << 4)) = vst[i]; }
    }
    bf16* qc = (bf16*)(ws + WS_QC);
    const bf16* misc = (const bf16*)(ws + WS_MISC);
    bf16x8 qf[2][2]; float gate[2][3]; int trow[2];
#pragma unroll
    for (int rg = 0; rg < 2; ++rg) {
        const int q = 8 * wave + 4 * rg + (j >> 2), t = 64 * c + q, row = b * SEQ + t, head = g * 4 + (j & 3);
        trow[rg] = t;
#pragma unroll
        for (int ks = 0; ks < 2; ++ks) qf[rg][ks] = *(const bf16x8*)(qc + (size_t)row * 512 + head * 64 + 8 * gq + 32 * ks);
        gate[rg][0] = __builtin_amdgcn_rcpf(1.0f + __expf(-bf2f(misc[(size_t)row * 256 + 196 + head * 3])));
    }
    typedef unsigned u32x2v __attribute__((ext_vector_type(2)));
    LAS u32x2v* stash = (LAS u32x2v*)(lds + NSA_OFF_ST) + tid * 8;
    __syncthreads();
    const int nT = (c >> 2) + 1;
#pragma unroll
    for (int rg = 0; rg < 2; ++rg) {
        const int t = trow[rg], nv = t >= 31 ? ((t - 15) >> 4) : 0;
        f32x4v s[16]; float mx = NEGF;
#pragma unroll
        for (int T = 0; T < 16; ++T) {
            s[T] = (f32x4v){0.f, 0.f, 0.f, 0.f};
            if (T < nT) {
#pragma unroll
                for (int ks = 0; ks < 2; ++ks) { const bf16x8 kf = *(const LAS bf16x8*)(lds + NSA_OFF_KCL + (16 * T + j) * 128 + (((gq + 4 * ks) ^ (j & 7)) << 4)); s[T] = __builtin_amdgcn_mfma_f32_16x16x32_bf16(kf, qf[rg][ks], s[T], 0, 0, 0); }
#pragma unroll
                for (int e = 0; e < 4; ++e) { const float v = (16 * T + 4 * gq + e < nv) ? s[T][e] : NEGF; s[T][e] = v; mx = fmaxf(mx, v); }
            }
        }
        mx = xmax16(mx);
        float ls = 0.f;
#pragma unroll
        for (int T = 0; T < 16; ++T) if (T < nT) {
#pragma unroll
            for (int e = 0; e < 4; ++e) { const float p = (16 * T + 4 * gq + e < nv) ? __builtin_amdgcn_exp2f(s[T][e] - mx) : 0.f; s[T][e] = p; ls += p; }
        }
        ls = xsum16(ls);
        const float inv = nv > 0 ? __builtin_amdgcn_rcpf(ls) : 0.f;
        const int q = 8 * wave + 4 * rg + (j >> 2);
#pragma unroll
        for (int T = 0; T < 16; ++T) if (T < nT) {
#pragma unroll
            for (int e = 0; e < 4; ++e) s[T][e] *= inv;
            float a = s[T][0] + s[T][1] + s[T][2] + 0.5f * s[T][3], bb = 0.5f * s[T][3];
            a += qxor1(a); a += qxor2(a); bb += qxor1(bb); bb += qxor2(bb);
            if ((j & 3) == 0) { impa[q * 65 + 4 * T + gq] = a; impb[q * 65 + 4 * T + gq + 1] = bb; }
        }
        f32x4v oc[4];
#pragma unroll
        for (int dt = 0; dt < 4; ++dt) oc[dt] = (f32x4v){0.f, 0.f, 0.f, 0.f};
#pragma unroll
        for (int kk = 0; kk < 8; ++kk) if (2 * kk < nT) {
            const bf16x8 pf = pack8(s[2 * kk][0], s[2 * kk][1], s[2 * kk][2], s[2 * kk][3], s[2 * kk + 1][0], s[2 * kk + 1][1], s[2 * kk + 1][2], s[2 * kk + 1][3]);
#pragma unroll
            for (int dt = 0; dt < 4; ++dt) {
                const LAS unsigned char* vp = lds + NSA_OFF_VCTL + (16 * dt + j) * 512 + (gq & 1) * 8;
                const s16x4 v0 = *(const LAS s16x4*)(vp + ((((8 * kk + gq) >> 1) ^ j) << 4)), v1 = *(const LAS s16x4*)(vp + (((((8 * kk + gq) >> 1) + 2) ^ j) << 4));
                oc[dt] = __builtin_amdgcn_mfma_f32_16x16x32_bf16(cat4(v0, v1), pf, oc[dt], 0, 0, 0);
            }
        }
#pragma unroll
        for (int dt = 0; dt < 4; ++dt) { const f32x4v v = oc[dt] * gate[rg][0]; u32x2v w; w.x = pg8::cvt_pk_bf16(v[0], v[1]); w.y = pg8::cvt_pk_bf16(v[2], v[3]); stash[rg * 4 + dt] = w; }
        __builtin_amdgcn_sched_barrier(0);
    }
    __syncthreads();
    TP_MARK(5);
    unsigned long long smask[8], mymask = 0ull;
#pragma unroll
    for (int qi = 0; qi < 8; ++qi) {
        const int q = 8 * wave + qi;
#if PROBE == 4
        const float imp = ((const float*)(ws + 500 * MiB))[((size_t)(b * SEQ + 64 * c + q) * 2 + g) * 64 + lane];
#else
        const float imp = impa[q * 65 + lane] + impb[q * 65 + lane];
#endif
#if PROBE && (PROBE != 5 || defined(PROBE5_IMP))
        ((float*)(ws + 516 * MiB))[((size_t)(b * SEQ + 64 * c + q) * 2 + g) * 64 + lane] = (lane <= c) ? imp : 0.f;
#endif
        const bool forced = (lane == 0) || (lane == c), adm = lane <= c;
        unsigned key = forced ? (0xFFFFFF00u | (unsigned)(63 - lane)) : (adm ? ((__float_as_uint(imp) & 0xFFFFFFC0u) | (unsigned)(63 - lane)) : 0u);
        unsigned long long mk = 0ull;
#if TOP8_RANK
        { int rank = 0;
#pragma unroll
          for (int jj = 0; jj < 64; ++jj) { const unsigned kk = (unsigned)__builtin_amdgcn_readlane((int)key, jj); rank += (kk > key) ? 1 : 0; }
          mk = __ballot(key != 0u && rank < 8); }
#else
        for (int k = 0; k < 8; ++k) { const unsigned mx = wave_max_u(key); if (mx == 0u) break; const int win = 63 - (int)(mx & 63u); mk |= 1ull << win; if (lane == win) key = 0u; }
#endif
        mk = ((unsigned long long)(unsigned)__builtin_amdgcn_readfirstlane((unsigned)(mk >> 32)) << 32) | (unsigned long long)(unsigned)__builtin_amdgcn_readfirstlane((unsigned)mk);
#ifdef FIXSEL
        { mk = 1ull | (1ull << c); for (int d = 1; d <= 6; ++d) mk |= 1ull << (((FIXHOM ? 0 : q * 7) + d * 5) % (c + 1)); }
#endif
#if PROBE == 2
        mk = ((const unsigned long long*)(ws + 496 * MiB))[(size_t)(b * SEQ + 64 * c + q) * 2 + g];
        mk = ((unsigned long long)(unsigned)__builtin_amdgcn_readfirstlane((unsigned)(mk >> 32)) << 32) | (unsigned long long)(unsigned)__builtin_amdgcn_readfirstlane((unsigned)mk);
#endif
#if PROBE == 5
        if (lane == 0) ((unsigned long long*)(ws + 498 * MiB))[(size_t)(b * SEQ + 64 * c + q) * 2 + g] = mk;
#endif
#if PROBE == 5 && !defined(PROBE5_IMP)
        ((float*)(ws + 516 * MiB))[((size_t)(b * SEQ + 64 * c + q) * 2 + g) * 64 + lane] = ((mk >> lane) & 1ull) ? 1.f : 0.f;
#endif
        smask[qi] = mk; mymask |= mk;
    }
    if (lane == 0) um[wave] = mymask;
    __syncthreads();
    unsigned long long umask = 0ull;
#pragma unroll
    for (int w = 0; w < 8; ++w) umask |= um[w];
    umask = ((unsigned long long)(unsigned)__builtin_amdgcn_readfirstlane((unsigned)(umask >> 32)) << 32) | (unsigned long long)(unsigned)__builtin_amdgcn_readfirstlane((unsigned)umask);
    unsigned long long rmask[2];
    { LAS unsigned long long* qm = (LAS unsigned long long*)(lds + NSA_OFF_QM);
      __syncthreads();
#pragma unroll
      for (int qi = 0; qi < 8; ++qi) if (lane == 0) qm[8 * wave + qi] = smask[qi];
      __syncthreads();
#pragma unroll
      for (int rg = 0; rg < 2; ++rg) rmask[rg] = qm[8 * wave + 4 * rg + (j >> 2)]; }
    const unsigned long long gmask[2] = {smask[0] | smask[1] | smask[2] | smask[3], smask[4] | smask[5] | smask[6] | smask[7]};
    TP_MARK(6); TP_ADD(9, __popcll(umask)); TP_ADD(10, 1); TP_ADD(11, c + 1); TP_ADD(12, __popcll(umask & ~(c == 63 ? ~0ull : ((2ull << c) - 1ull)))); TP_ADD(13, __popcll(smask[0]));
    const bf16* kvs = (const bf16*)(ws + WS_KVS); const bf16* kvw = (const bf16*)(ws + WS_KVW);
    LAS unsigned char* ring = lds + NSA_OFF_RING;
    {
        float mrow[2] = {NEGF, NEGF}, lrow[2] = {0.f, 0.f}; f32x4v o[2][4];
#pragma unroll
        for (int rg = 0; rg < 2; ++rg)
#pragma unroll
            for (int dt = 0; dt < 4; ++dt) o[rg][dt] = (f32x4v){0.f, 0.f, 0.f, 0.f};
        nsa_attend<0>(kvs, umask, b, g, c, tid, lane, ring, qf, rmask, gmask, trow, mrow, lrow, o);
#if DUP == 8
        { __syncthreads(); float m2[2] = {NEGF, NEGF}, l2[2] = {0.f, 0.f}; f32x4v o2[2][4];
          for (int rg = 0; rg < 2; ++rg) for (int dt = 0; dt < 4; ++dt) o2[rg][dt] = (f32x4v){0.f, 0.f, 0.f, 0.f};
          nsa_attend<0>(kvs, umask, b, g, c, tid, lane, Kb, Vb, qf, rmask, gmask, trow, m2, l2, o2);
          bf16* dmy = (bf16*)(ws + WS_BU) + (size_t)(b * SEQ + trow[0]) * 512 + (g * 4 + (j & 3)) * 64 + 4 * gq;
          for (int rg = 0; rg < 2; ++rg) for (int dt = 0; dt < 4; ++dt) { uint2 w; w.x = pg8::cvt_pk_bf16(o2[rg][dt][0] + l2[rg], o2[rg][dt][1]); w.y = pg8::cvt_pk_bf16(o2[rg][dt][2], o2[rg][dt][3]); *(uint2*)(dmy + 16 * dt) = w; } }
#endif
        const int lf1_ = lane_id_v(), jf1_ = lf1_ & 15;
#pragma unroll
        for (int rg = 0; rg < 2; ++rg) { const float g1_ = __builtin_amdgcn_rcpf(1.0f + __expf(-bf2f(misc[(size_t)(b * SEQ + 64 * c + 8 * wave + 4 * rg + (jf1_ >> 2)) * 256 + 196 + (g * 4 + (jf1_ & 3)) * 3 + 1]))); const float sc = g1_ * __builtin_amdgcn_rcpf(xsum16(lrow[rg]));
#pragma unroll
            for (int dt = 0; dt < 4; ++dt) { const u32x2v p = stash[rg * 4 + dt]; const f32x4v v = o[rg][dt] * sc; u32x2v w; w.x = pg8::cvt_pk_bf16(v[0] + bflo(p.x), v[1] + bfhi(p.x)); w.y = pg8::cvt_pk_bf16(v[2] + bflo(p.y), v[3] + bfhi(p.y)); stash[rg * 4 + dt] = w; }
            }
        __syncthreads();
    }
    TP_MARK(7);
    {
        float mrow[2] = {NEGF, NEGF}, lrow[2] = {0.f, 0.f}; f32x4v o[2][4];
#pragma unroll
        for (int rg = 0; rg < 2; ++rg)
#pragma unroll
            for (int dt = 0; dt < 4; ++dt) o[rg][dt] = (f32x4v){0.f, 0.f, 0.f, 0.f};
        { const int j0 = c - 4 > 0 ? c - 4 : 0; const unsigned long long wmask = ((c == 63 ? ~0ull : ((1ull << (c + 1)) - 1ull)) >> j0) << j0;
          nsa_attend<1>(kvw, wmask, b, g, c, tid, lane, ring, qf, rmask, gmask, trow, mrow, lrow, o); }
        const int lf2_ = lane_id_v(), jf2_ = lf2_ & 15, gf2_ = lf2_ >> 4;
#pragma unroll
        for (int rg = 0; rg < 2; ++rg) { const float g2_ = __builtin_amdgcn_rcpf(1.0f + __expf(-bf2f(misc[(size_t)(b * SEQ + 64 * c + 8 * wave + 4 * rg + (jf2_ >> 2)) * 256 + 196 + (g * 4 + (jf2_ & 3)) * 3 + 2]))); const float sc = g2_ * __builtin_amdgcn_rcpf(xsum16(lrow[rg]));
#pragma unroll
            for (int dt = 0; dt < 4; ++dt) { const u32x2v p = stash[rg * 4 + dt]; const f32x4v v = o[rg][dt] * sc; uint2 w; w.x = pg8::cvt_pk_bf16(v[0] + bflo(p.x), v[1] + bfhi(p.x)); w.y = pg8::cvt_pk_bf16(v[2] + bflo(p.y), v[3] + bfhi(p.y));
                *(uint2*)(yout + (size_t)(b * SEQ + 64 * c + 8 * wave + 4 * rg + (jf2_ >> 2)) * 512 + (g * 4 + (jf2_ & 3)) * 64 + 16 * dt + 4 * gf2_) = w; }
            }
    }
    __syncthreads();
    TP_MARK(8);
}
__device__ __forceinline__ void prep_kva16(unsigned char* ws, int task, int lane) {
    const int j = lane & 15, gq = lane >> 4, row = task * 16 + j;
    const bf16* misc = (const bf16*)(ws + WS_MISC) + (size_t)row * 256 + 64;
    const bf16* wu = (const bf16*)(ws + WS_W + WO_UKV);
    bf16x8 cf[4]; float ss = 0.f;
#pragma unroll
    for (int ks = 0; ks < 4; ++ks) { const v4u v = *(const v4u*)(misc + 8 * gq + 32 * ks); cf[ks] = __builtin_bit_cast(bf16x8, v); float f[8]; unpack8(v, f);
#pragma unroll
        for (int e = 0; e < 8; ++e) ss += f[e] * f[e]; }
    ss = xsum16(ss);
    const float r = 1.0f / sqrtf(ss * (1.f / 128.f) + EPS);
    const float* rp = (const float*)(ws + WS_ROPE) + (size_t)row * 16;
    bf16* o = (bf16*)(ws + WS_KVA) + (size_t)row * 128;
#pragma unroll
    for (int ct = 0; ct < 8; ++ct) {
        f32x4v a = {0.f, 0.f, 0.f, 0.f};
#pragma unroll
        for (int ks = 0; ks < 4; ++ks) { const bf16x8 wf = *(const bf16x8*)(wu + (size_t)(16 * ct + j) * 128 + 8 * gq + 32 * ks); a = __builtin_amdgcn_mfma_f32_16x16x32_bf16(wf, cf[ks], a, 0, 0, 0); }
        a *= r;
        if (ct == 0) {
            const float c0 = rp[2 * gq], s0 = rp[8 + 2 * gq], c1 = rp[2 * gq + 1], s1 = rp[8 + 2 * gq + 1];
            const float x0 = a[0], x1 = a[1], x2 = a[2], x3 = a[3];
            a[0] = x0 * c0 - x1 * s0; a[1] = x1 * c0 + x0 * s0; a[2] = x2 * c1 - x3 * s1; a[3] = x3 * c1 + x2 * s1;
        }
        uint2 w; w.x = cvtpk(a[0], a[1]); w.y = cvtpk(a[2], a[3]);
        *(uint2*)(o + 16 * ct + 4 * gq) = w;
    }
}
__device__ __forceinline__ void prep_pool16(unsigned char* ws, int task, int lane, const LAS unsigned char* wl, bf16* ybuf) {
    const int j = lane & 15, gq = lane >> 4, row = task * 16 + j, t = row & (SEQ - 1);
    const bf16* bu = (const bf16*)(ws + WS_BU);
    bf16* yb = ybuf + (size_t)row * 512;
#pragma unroll 1
    for (int g = 0; g < 4; ++g) {
        const int w = 2 << g, lo = (t + 1 - w) > 0 ? (t + 1 - w) : 0, cnt = t + 1 - lo; const float inv = 1.0f / (float)cnt;
        bf16x8 pf[4];
#pragma unroll
        for (int ks = 0; ks < 4; ++ks) {
            const bf16* p = bu + (size_t)row * 512 + g * 128 + 8 * gq + 32 * ks;
            float sum[8] = {0.f, 0.f, 0.f, 0.f, 0.f, 0.f, 0.f, 0.f}, cur[8];
            { const v4u v = *(const v4u*)p; unpack8(v, cur);
#pragma unroll
              for (int e = 0; e < 8; ++e) sum[e] = cur[e]; }
            v4u wv_[15];
#pragma unroll
            for (int i = 1; i < 16; ++i) if (i < w) wv_[i - 1] = *(const v4u*)(p - (size_t)(i < cnt ? i : 0) * 512);
#pragma unroll
            for (int i = 1; i < 16; ++i) if (i < w) { float f[8]; unpack8(wv_[i - 1], f);
#pragma unroll
                for (int e = 0; e < 8; ++e) sum[e] += f[e]; }
            { const float kx = (float)(w - cnt);
#pragma unroll
              for (int e = 0; e < 8; ++e) sum[e] -= kx * cur[e]; }
            __builtin_amdgcn_sched_barrier(0);
            pf[ks] = pack8(sum[0] * inv - cur[0], sum[1] * inv - cur[1], sum[2] * inv - cur[2], sum[3] * inv - cur[3], sum[4] * inv - cur[4], sum[5] * inv - cur[5], sum[6] * inv - cur[6], sum[7] * inv - cur[7]);
        }
#pragma unroll
        for (int dt = 0; dt < 8; ++dt) {
            f32x4v a = {0.f, 0.f, 0.f, 0.f};
#pragma unroll
            for (int ks = 0; ks < 4; ++ks) {
#if POOLDBG == 1
                bf16x8 wf; for (int e = 0; e < 8; ++e) wf[e] = (short)0x3c00;
#else
                const bf16x8 wf = *(const LAS bf16x8*)(wl + (g * 128 + 16 * dt + j) * 256 + (((gq + 4 * ks) ^ j) << 4));
#endif
#if POOLDBG == 2
                bf16x8 pz; for (int e = 0; e < 8; ++e) pz[e] = (short)0x3c00; a = __builtin_amdgcn_mfma_f32_16x16x32_bf16(wf, pz, a, 0, 0, 0);
#else
                a = __builtin_amdgcn_mfma_f32_16x16x32_bf16(wf, pf[ks], a, 0, 0, 0);
#endif
            }
            uint2 wv; wv.x = cvtpk(a[0], a[1]); wv.y = cvtpk(a[2], a[3]);
            *(uint2*)(yb + g * 128 + 16 * dt + 4 * gq) = wv;
        }
    }
}
__device__ __forceinline__ float gelu_tanh_f(float x) { const float u = 0.7978845608028654f * (x + 0.044715f * x * x * x); const float e = __expf(2.0f * u); return 0.5f * x * (1.0f + (1.0f - 2.0f / (e + 1.0f))); }
__device__ __forceinline__ void prep_cmp16(unsigned char* ws, int task, LAS unsigned char* lds, int wave, int lane) {
    const int j = lane & 15, gq = lane >> 4, grp = wave >> 2, wq = wave & 3;
    const int i0 = (task & 15) * 16, bg = (task >> 4) & 15, br = task >> 8, b = bg >> 1, g = bg & 1, i = i0 + j;
    const bf16* kvc = (const bf16*)(ws + WS_KVC);
    const bf16* w1 = (const bf16*)(ws + WS_W + WO_CW1) + (size_t)br * 128 * 2048;
    const bf16* w2 = (const bf16*)(ws + WS_W + WO_CW2) + (size_t)br * 64 * 128;
    const float* posb = (const float*)(ws + WS_W + WO_POSB) + br * 128;
    LAS float* part = (LAS float*)(lds + (size_t)grp * 4 * 16384);
    LAS unsigned char* wst = lds + wave * 16384;
    f32x4v h[8];
#pragma unroll
    for (int nt = 0; nt < 8; ++nt) h[nt] = (f32x4v){0.f, 0.f, 0.f, 0.f};
#define CMP_DMA(p_) do { _Pragma("unroll") for (int i_ = 0; i_ < 16; ++i_) { const int r_ = 8 * i_ + (lane >> 3); \
        __builtin_amdgcn_global_load_lds((const unsigned*)(w1 + (size_t)r_ * 2048 + 512 * wq + 64 * (p_) + (((lane & 7) ^ (r_ & 7)) << 3)), (LAS unsigned*)(wst + i_ * 1024), 16, 0, 0); } } while (0)
#define CMP_FF(p_, fa_, fb_) do { int tok_ = 16 * i + 8 * wq + (p_); tok_ = tok_ > SEQ - 1 ? SEQ - 1 : tok_;     \
        const bf16* fp_ = kvc + (size_t)(b * SEQ + tok_) * 256 + br * 128 + g * 64 + 8 * gq; fa_ = *(const bf16x8*)fp_; fb_ = *(const bf16x8*)(fp_ + 32); } while (0)
    bf16x8 ffA, ffB;
    CMP_DMA(0); CMP_FF(0, ffA, ffB);
#pragma unroll 1
    for (int p = 0; p < 8; ++p) {
        bf16x8 wf[2][8];
#pragma unroll
        for (int hh = 0; hh < 2; ++hh)
#pragma unroll
            for (int nt = 0; nt < 8; ++nt) wf[hh][nt] = *(const LAS bf16x8*)(wst + (16 * nt + j) * 128 + (((gq + 4 * hh) ^ (j & 7)) << 4));
        const bf16x8 fa = ffA, fb = ffB;
        asm volatile("s_waitcnt lgkmcnt(0)" ::: "memory");
        if (p + 1 < 8) { CMP_DMA(p + 1); CMP_FF(p + 1, ffA, ffB); }
#pragma unroll
        for (int nt = 0; nt < 8; ++nt) { h[nt] = __builtin_amdgcn_mfma_f32_16x16x32_bf16(wf[0][nt], fa, h[nt], 0, 0, 0); h[nt] = __builtin_amdgcn_mfma_f32_16x16x32_bf16(wf[1][nt], fb, h[nt], 0, 0, 0); }
    }
#undef CMP_DMA
#undef CMP_FF
#pragma unroll
    for (int nt = 0; nt < 8; ++nt)
#pragma unroll
        for (int e = 0; e < 4; ++e) part[wq * 4096 + (nt * 4 + e) * 64 + lane] = h[nt][e];
    f32x4v pbv_[8];
#pragma unroll
    for (int nt = 0; nt < 8; ++nt) pbv_[nt] = *(const f32x4v*)(posb + 16 * nt + 4 * gq) + *(const f32x4v*)(posb + 256 + 16 * nt + 4 * gq);

    __syncthreads();
    if (wq == 0) {
#pragma unroll
        for (int nt = 0; nt < 8; ++nt) { const f32x4v pbv = pbv_[nt];
#pragma unroll
            for (int e = 0; e < 4; ++e) { const int idx = (nt * 4 + e) * 64 + lane; h[nt][e] = gelu_tanh_f(((part[idx] + part[4096 + idx]) + (part[2 * 4096 + idx] + part[3 * 4096 + idx])) + pbv[e]); } }
        f32x4v o[4];
#pragma unroll
        for (int dt = 0; dt < 4; ++dt) o[dt] = (f32x4v){0.f, 0.f, 0.f, 0.f};
        s16x4 w2a[4][4], w2b[4][4];
#pragma unroll
        for (int kk = 0; kk < 4; ++kk)
#pragma unroll
            for (int dt = 0; dt < 4; ++dt) { const bf16* wp = w2 + (size_t)(16 * dt + j) * 128 + 32 * kk + 4 * gq; w2a[kk][dt] = *(const s16x4*)wp; w2b[kk][dt] = *(const s16x4*)(wp + 16); }
        __builtin_amdgcn_sched_barrier(0);
#pragma unroll
        for (int kk = 0; kk < 4; ++kk) {
            const bf16x8 hf = pack8(h[2 * kk][0], h[2 * kk][1], h[2 * kk][2], h[2 * kk][3], h[2 * kk + 1][0], h[2 * kk + 1][1], h[2 * kk + 1][2], h[2 * kk + 1][3]);
#pragma unroll
            for (int dt = 0; dt < 4; ++dt) o[dt] = __builtin_amdgcn_mfma_f32_16x16x32_bf16(cat4(w2a[kk][dt], w2b[kk][dt]), hf, o[dt], 0, 0, 0);
        }
        const bool dead = i == 255;
        if (br == 0) { bf16* kc = (bf16*)(ws + WS_KC) + ((size_t)bg * 256 + i) * 64;
#pragma unroll
            for (int dt = 0; dt < 4; ++dt) { uint2 w; w.x = dead ? 0u : cvtpk(o[dt][0], o[dt][1]); w.y = dead ? 0u : cvtpk(o[dt][2], o[dt][3]); *(uint2*)(kc + 16 * dt + 4 * gq) = w; }
        } else { bf16* vct = (bf16*)(ws + WS_VC) + (size_t)bg * 64 * 256 + i;
#pragma unroll
            for (int dt = 0; dt < 4; ++dt)
#pragma unroll
                for (int e = 0; e < 4; ++e) vct[(size_t)(16 * dt + 4 * gq + e) * 256] = dead ? (bf16)0 : (bf16)f2bf(o[dt][e]);
        }
    }
    __syncthreads();
}
__device__ __forceinline__ void phase_prep(const Args& P, unsigned char* ws, int z, int l, LAS unsigned char* lds, int gw, int NGW, int lane, int wave, bf16* ybuf) {
    asm volatile("" : "+v"(lane)); lane &= 63; asm volatile("" : "+s"(gw), "+s"(NGW));
#if TPROBE
    const int tid = (wave << 6) | lane; unsigned long long tp_t_ = __builtin_amdgcn_s_memtime();
#endif
    for (int it = 2 * (gw >> 3) + (wave >> 2); it < 512 + (wave >> 2); it += 2 * (NGW >> 3)) prep_cmp16(ws, it < 512 ? it : 511, lds, wave, lane);
    TP_MARK(27);
    {
        const v4u* src = (const v4u*)(ws + WS_W + WO_POOL); const int t_ = (wave << 6) | lane;
        v4u pst[16];
#pragma unroll
        for (int i = 0; i < 16; ++i) pst[i] = src[t_ + 512 * i];
#pragma unroll
        for (int i = 0; i < 16; ++i) { const int idx = t_ + 512 * i, r = idx >> 4, sg = idx & 15; *(LAS v4u*)(lds + r * 256 + ((sg ^ (r & 15)) << 4)) = pst[i]; }
        __syncthreads();
    }
    TP_MARK(28);
    for (int it = gw; it < M / 16; it += NGW) { prep_kva16(ws, it, lane); TP_MARK(29); prep_pool16(ws, it, lane, lds, ybuf); }
    __syncthreads();
    TP_MARK(31);
}
#ifndef DSA_HIST
#define DSA_HIST 0
#endif
constexpr int DSA_K = DSA_HIST ? 16 : DSA_K_V, DSA_S = 32 - DSA_K, DSA_CAP = DSA_CAP_V;
constexpr int DSA_OFF_CNT = 0, DSA_OFF_PC = 3072, DSA_OFF_LIST = DSA_OFF_PC + 32 * 16 * 4, DSA_OFF_V = DSA_OFF_LIST + 16 * 256 * 2, DSA_VB = 64 * NSA_VSTR * 2, DSA_LDS = DSA_OFF_V + 8 * DSA_VB;
#define DSA_FOR_TILES(...) _Pragma("unroll") for (int G8 = 0; G8 < 8; ++G8) { if (G8 < ngrp) { _Pragma("unroll") for (int T8 = 0; T8 < 4; ++T8) { const int T = G8 * 4 + T8; __VA_ARGS__ } } }
__device__ __forceinline__ void cnt_ge(int& c, unsigned u, unsigned cand) { asm volatile("v_cmp_ge_u32_e32 vcc, %1, %2\n\tv_addc_co_u32_e32 %0, vcc, 0, %0, vcc" : "+v"(c) : "v"(u), "v"(cand) : "vcc"); }
__device__ __forceinline__ void cnt_gt(int& c, unsigned u, unsigned cand) { asm volatile("v_cmp_gt_u32_e32 vcc, %1, %2\n\tv_addc_co_u32_e32 %0, vcc, 0, %0, vcc" : "+v"(c) : "v"(u), "v"(cand) : "vcc"); }
__device__ __forceinline__ void cnt_le(int& c, unsigned u, unsigned cand) { asm volatile("v_cmp_le_u32_e32 vcc, %1, %2\n\tv_addc_co_u32_e32 %0, vcc, 0, %0, vcc" : "+v"(c) : "v"(u), "v"(cand) : "vcc"); }
__device__ __forceinline__ int dsa_total(LAS unsigned* cnt, int par, int wave, int j, int gq, int c) {
    c += __shfl_xor(c, 16); c += __shfl_xor(c, 32);
    if (gq == 0) cnt[(par * 8 + wave) * 16 + j] = (unsigned)c;
    __syncthreads();
    int tot = 0;
#pragma unroll
    for (int w = 0; w < 8; ++w) tot += (int)cnt[(par * 8 + w) * 16 + j];
    return tot;
}
__device__ __forceinline__ void dsa_unit(unsigned char* ws, int unit, LAS unsigned char* lds, int tid_in, bf16* yout) {
    int tid = tid_in; asm volatile("" : "+v"(tid));
    const int lane = tid & 63, wave = __builtin_amdgcn_readfirstlane(tid >> 6), j = lane & 15, gq = lane >> 4;
    const int b = unit >> 8, q0 = (unit & 255) * 16, t = q0 + j, row = b * SEQ + t;
    LAS unsigned* cnt = (LAS unsigned*)(lds + DSA_OFF_CNT); LAS unsigned* pc = (LAS unsigned*)(lds + DSA_OFF_PC);
    LAS unsigned short* list = (LAS unsigned short*)(lds + DSA_OFF_LIST);
    const bf16* misc = (const bf16*)(ws + WS_MISC);
    TP_DECL
    if (q0 >= 256) {
        const int ntiles = (q0 >> 4) + 1;
        const int ntl = wave < ntiles ? ((ntiles - 1 - wave) >> 3) + 1 : 0;
        const int ngrp = (ntl + 3) >> 2;
        bf16x8 qf[4][2]; float iw[4];
        { const bf16* iq = (const bf16*)(ws + WS_IQ) + (size_t)row * 256;
#pragma unroll
          for (int h = 0; h < 4; ++h) { iw[h] = 0.5f * bf2f(misc[(size_t)row * 256 + 192 + h]);
#pragma unroll
              for (int ks = 0; ks < 2; ++ks) qf[h][ks] = *(const bf16x8*)(iq + h * 64 + 8 * gq + 32 * ks); } }
        unsigned u[32][4];
#pragma unroll
        for (int T = 0; T < 32; ++T)
#pragma unroll
            for (int e = 0; e < 4; ++e) u[T][e] = 0u;
        const int kb0 = 16 * wave + 4 * gq;
        LAS unsigned char* ring = lds + DSA_OFF_V + wave * 16384;
#define DSA_ISSUE(Ti) do { _Pragma("unroll") for (int i_ = 0; i_ < 2; ++i_) { const int r_ = 8 * i_ + (lane >> 3); int kr_ = 16 * wave + 128 * (Ti) + r_; kr_ = kr_ > SEQ - 1 ? SEQ - 1 : kr_; \
            __builtin_amdgcn_global_load_lds((const unsigned*)(misc + (size_t)(b * SEQ + kr_) * 256 + (((lane & 7) ^ (r_ & 7)) << 3)), (LAS unsigned*)(ring + ((Ti) & 7) * 2048 + i_ * 1024), 16, 0, 0); } } while (0)
        if (ngrp > 0) {
#pragma unroll
            for (int T = 0; T < 8; ++T) DSA_ISSUE(T);
        }
        DSA_FOR_TILES(
            asm volatile("s_waitcnt vmcnt(14)" ::: "memory");
            const LAS unsigned char* tp = ring + (T & 7) * 2048 + j * 128;
            const bf16x8 kf0 = *(const LAS bf16x8*)(tp + ((gq ^ (j & 7)) << 4)); const bf16x8 kf1 = *(const LAS bf16x8*)(tp + (((gq + 4) ^ (j & 7)) << 4));
            asm volatile("s_waitcnt lgkmcnt(0)" ::: "memory");
            DSA_ISSUE(T + 8);
            float sc[4] = {0.f, 0.f, 0.f, 0.f};
            _Pragma("unroll") for (int h = 0; h < 4; ++h) {
                f32x4v a = {0.f, 0.f, 0.f, 0.f};
                a = __builtin_amdgcn_mfma_f32_16x16x32_bf16(kf0, qf[h][0], a, 0, 0, 0);
                a = __builtin_amdgcn_mfma_f32_16x16x32_bf16(kf1, qf[h][1], a, 0, 0, 0);
                _Pragma("unroll") for (int e = 0; e < 4; ++e) { const int ai_ = (int)__float_as_uint(a[e]); sc[e] += iw[h] * __uint_as_float((unsigned)(ai_ > 0 ? ai_ : 0)); }
                asm volatile("" : "+v"(sc[0]), "+v"(sc[1]), "+v"(sc[2]), "+v"(sc[3]));
            }
            _Pragma("unroll") for (int e = 0; e < 4; ++e) { unsigned x = f2o(sc[e]); asm volatile("" : "+v"(x)); u[T][e] = (kb0 + 128 * T + e <= t) ? x : 0u; }
        )
        asm volatile("s_waitcnt vmcnt(0)" ::: "memory");
#undef DSA_ISSUE
        TP_MARK(0);
        {
        const int lane2_ = lane_id_v(); const int lane = lane2_, j = lane2_ & 15, gq = lane2_ >> 4, t = q0 + j, kb0 = 16 * wave + 4 * gq, tid = (wave << 6) | lane2_;
        unsigned prefix = 0u; bool exact = false; int par = 0; int cab = 0;
        LAS unsigned* lcnt = (LAS unsigned*)(lds + DSA_OFF_V); LAS unsigned* lcab = lcnt + 16; LAS unsigned* lvst = lcnt + 32; LAS unsigned* lexf = lcnt + 48; LAS unsigned* llist = lcnt + 64;
#if DSA_HIST
        {
            const int lh_ = lane_id_v(), jh_ = lh_ & 15;
            LAS unsigned* h0 = (LAS unsigned*)(lds + DSA_OFF_V + 256 + 16 * DSA_CAP * 4); LAS unsigned* h1 = h0 + 4096; LAS unsigned* lsel = cnt + 512; LAS unsigned* labv = cnt + 528;
            __syncthreads();
            for (int i = tid; i < 8192; i += 512) h0[i] = 0u;
            if (tid < 16) lcnt[tid] = 0u;
            __syncthreads();
            DSA_FOR_TILES(_Pragma("unroll") for (int e = 0; e < 4; ++e) { const unsigned x = u[T][e]; __hip_atomic_fetch_add(h0 + jh_ * 256 + (x >> 24), x < 1u ? x : 1u, __ATOMIC_RELAXED, __HIP_MEMORY_SCOPE_WORKGROUP); })
            __syncthreads();
#define DSA_SCAN(H_, NEED_, BIN_, ABV_) do { const LAS unsigned* hq_ = (H_) + 4 * lh_; const unsigned hx_ = hq_[0], hy_ = hq_[1], hz_ = hq_[2], hw_ = hq_[3]; const int s_ = (int)(hx_ + hy_ + hz_ + hw_); int S_ = s_; \
                _Pragma("unroll") for (int d_ = 1; d_ < 64; d_ <<= 1) { const int t_ = __shfl_down(S_, d_); S_ += (lh_ + d_ < 64) ? t_ : 0; }        \
                const unsigned long long m_ = __ballot(S_ >= (NEED_)); const int L_ = __builtin_amdgcn_readfirstlane(63 - (int)__builtin_clzll(m_ | 1ull)); \
                int acc_ = S_ - s_, sel_, ab_; \
                if (acc_ + (int)hw_ >= (NEED_)) { sel_ = 3; ab_ = acc_; } else { acc_ += (int)hw_; if (acc_ + (int)hz_ >= (NEED_)) { sel_ = 2; ab_ = acc_; } else { acc_ += (int)hz_; if (acc_ + (int)hy_ >= (NEED_)) { sel_ = 1; ab_ = acc_; } else { acc_ += (int)hy_; sel_ = 0; ab_ = acc_; } } } \
                BIN_ = __builtin_amdgcn_readlane(4 * lh_ + sel_, L_); ABV_ = __builtin_amdgcn_readlane(ab_, L_); } while (0)
#pragma unroll 1
            for (int qq = 0; qq < 2; ++qq) { const int q = 2 * wave + qq; int b1_, a1_; DSA_SCAN(h0 + q * 256, 256, b1_, a1_); if (lh_ == 0) { lsel[q] = (unsigned)b1_; labv[q] = (unsigned)a1_; } }
            __syncthreads();
            const unsigned b1 = lsel[jh_]; const int ab1 = (int)labv[jh_];
            DSA_FOR_TILES(_Pragma("unroll") for (int e = 0; e < 4; ++e) { const unsigned x = u[T][e]; const unsigned one_ = ((x >> 24) == b1) ? (x < 1u ? x : 1u) : 0u; __hip_atomic_fetch_add(h1 + jh_ * 256 + ((x >> 16) & 255u), one_, __ATOMIC_RELAXED, __HIP_MEMORY_SCOPE_WORKGROUP); })
            __syncthreads();
#pragma unroll 1
            for (int qq = 0; qq < 2; ++qq) { const int q = 2 * wave + qq; const int need_ = 256 - (int)labv[q]; int b2_, a2_; DSA_SCAN(h1 + q * 256, need_, b2_, a2_); if (lh_ == 0) { lsel[16 + q] = (unsigned)b2_; labv[16 + q] = (unsigned)a2_; } }
#undef DSA_SCAN
            __syncthreads();
            prefix = (b1 << 24) | (lsel[16 + jh_] << 16); cab = ab1 + (int)labv[16 + jh_];
        }
#else
        if (tid < 16) lcnt[tid] = 0u;
#pragma unroll 1
        for (int bit = 31; bit >= DSA_S; --bit) {
            const unsigned cand = prefix | (1u << bit); int c0 = 0, c1 = 0;
            DSA_FOR_TILES(cnt_ge(c0, u[T][0], cand); cnt_ge(c1, u[T][1], cand); cnt_ge(c0, u[T][2], cand); cnt_ge(c1, u[T][3], cand);)
            const int tot = dsa_total(cnt, par, wave, j, gq, c0 + c1); par ^= 1;
            if (tot >= 256) prefix = cand; else cab = tot;
        }
#endif
        TP_MARK(1);
        { const unsigned ptop = prefix >> DSA_S;
          DSA_FOR_TILES(unsigned pos_[4]; bool cd_[4];
              _Pragma("unroll") for (int e = 0; e < 4; ++e) { const unsigned x = u[T][e]; cd_[e] = x != 0u && (x >> DSA_S) == ptop; pos_[e] = DSA_CAP; }
              _Pragma("unroll") for (int e = 0; e < 4; ++e) if (cd_[e]) pos_[e] = __hip_atomic_fetch_add(&lcnt[j], 1u, __ATOMIC_RELAXED, __HIP_MEMORY_SCOPE_WORKGROUP);
              _Pragma("unroll") for (int e = 0; e < 4; ++e) if (pos_[e] < DSA_CAP) llist[j * DSA_CAP + pos_[e]] = u[T][e];)
          if (wave == 0 && gq == 0) lcab[j] = (unsigned)cab; }
        __syncthreads();
        const bool ovf = __any(lcnt[j] > (unsigned)DSA_CAP);
        TP_ADD(14, ovf ? 1 : 0); TP_ADD(15, 1);
        if (!ovf) {
#pragma unroll 1
            for (int qq = 0; qq < 2; ++qq) {
                const int q = 2 * wave + qq; const int n = (int)lcnt[q]; const int r = 256 - (int)lcab[q];
                unsigned ev[DSA_CAP / 64];
#pragma unroll
                for (int i = 0; i < DSA_CAP / 64; ++i) ev[i] = (lane + 64 * i < n) ? llist[q * DSA_CAP + lane + 64 * i] : 0u;
                unsigned p2 = (unsigned)__shfl((int)prefix, q);
#pragma unroll 1
                for (int bit = DSA_S - 1; bit >= 0; --bit) {
                    const unsigned cand = p2 | (1u << bit); int c = 0;
#pragma unroll
                    for (int i = 0; i < DSA_CAP / 64; ++i) c += __popcll(__ballot(ev[i] >= cand));
                    if (c >= r) p2 = cand;
                }
                int cf = 0;
#pragma unroll
                for (int i = 0; i < DSA_CAP / 64; ++i) cf += __popcll(__ballot(ev[i] >= p2));
                if (lane == 0) { lvst[q] = p2; lexf[q] = (cf == r) ? 1u : 0u; }
            }
            __syncthreads();
            prefix = lvst[j]; exact = lexf[j] != 0u;
        } else {
#pragma unroll 1
            for (int bit = DSA_S - 1; bit >= 0; --bit) {
                const unsigned cand = prefix | (1u << bit); int c0 = 0, c1 = 0;
                DSA_FOR_TILES(cnt_ge(c0, u[T][0], cand); cnt_ge(c1, u[T][1], cand); cnt_ge(c0, u[T][2], cand); cnt_ge(c1, u[T][3], cand);)
                const int tot = dsa_total(cnt, par, wave, j, gq, c0 + c1); par ^= 1;
                if (!exact && tot >= 256) { prefix = cand; exact = (tot == 256); }
            }
        }
        TP_MARK(2);
        const bool alle = __all(exact);
        unsigned kp = 0u;
        if (!alle) {
        DSA_FOR_TILES(_Pragma("unroll") for (int e = 0; e < 4; ++e) { const unsigned x = u[T][e]; u[T][e] = (x > prefix || (exact && x == prefix)) ? 0u : (x == prefix ? (unsigned)(1 + kb0 + 128 * T + e) : 0xFFFFFFFFu); })
            __syncthreads();
#pragma unroll 1
            for (int bit = 11; bit >= 0; --bit) {
                const unsigned cand = kp | (1u << bit); int c0 = 0, c1 = 0;
                DSA_FOR_TILES(cnt_le(c0, u[T][0], cand); cnt_le(c1, u[T][1], cand); cnt_le(c0, u[T][2], cand); cnt_le(c1, u[T][3], cand);)
                const int tot = dsa_total(cnt, par, wave, j, gq, c0 + c1); par ^= 1;
                if (tot <= 255) kp = cand;
            }
        }
        const unsigned kp1 = kp + 1u;
        int ns0 = 0, ns1 = 0;
        if (alle) { DSA_FOR_TILES(cnt_ge(ns0, u[T][0], prefix); cnt_ge(ns1, u[T][1], prefix); cnt_ge(ns0, u[T][2], prefix); cnt_ge(ns1, u[T][3], prefix);) }
        else { DSA_FOR_TILES(cnt_le(ns0, u[T][0], kp1); cnt_le(ns1, u[T][1], kp1); cnt_le(ns0, u[T][2], kp1); cnt_le(ns1, u[T][3], kp1);) }
        pc[(wave * 4 + gq) * 16 + j] = (unsigned)(ns0 + ns1);
        __syncthreads();
        int base = 0;
        { const int me = wave * 4 + gq;
#pragma unroll
          for (int i = 0; i < 31; ++i) { const int v = (int)pc[i * 16 + j]; base += (i < me) ? v : 0; } }
        if (alle) { DSA_FOR_TILES(_Pragma("unroll") for (int e = 0; e < 4; ++e) { if (u[T][e] >= prefix) { list[j * 256 + base] = (unsigned short)(kb0 + 128 * T + e); ++base; }     }) }
        else { DSA_FOR_TILES(_Pragma("unroll") for (int e = 0; e < 4; ++e) { if (u[T][e] <= kp1) { if (base < 256) list[j * 256 + base] = (unsigned short)(kb0 + 128 * T + e); ++base; } }) }
        }
    } else {
        for (int i = tid; i < 16 * 256; i += 512) list[i] = (unsigned short)(i & 255);
    }
    __syncthreads();
    TP_MARK(3);
    {
    const int lane4_ = lane_id_v(); const int lane = lane4_, j = lane4_ & 15, gq = lane4_ >> 4;
    const bf16* kva = (const bf16*)(ws + WS_KVA);
    bf16* qa = (bf16*)(ws + WS_QA);
    LAS unsigned char* Vw = lds + DSA_OFF_V + wave * 16384;
    const unsigned vlds0 = (unsigned)(uintptr_t)(unsigned char*)Vw;
    const int tq2[2] = {q0 + 2 * wave, q0 + 2 * wave + 1};
    const int nselq[2] = {tq2[0] + 1 < 256 ? tq2[0] + 1 : 256, tq2[1] + 1 < 256 ? tq2[1] + 1 : 256};
    v4u qfq[2][2];
#pragma unroll
    for (int qq = 0; qq < 2; ++qq)
#pragma unroll
        for (int ks = 0; ks < 2; ++ks) { qfq[qq][ks] = (v4u){0u, 0u, 0u, 0u}; if (j < 8) qfq[qq][ks] = *(const v4u*)(qa + (size_t)(b * SEQ + tq2[qq]) * 512 + j * 64 + 8 * gq + 32 * ks); }
    asm volatile("s_waitcnt vmcnt(0)" : "+v"(qfq[0][0]), "+v"(qfq[0][1]), "+v"(qfq[1][0]), "+v"(qfq[1][1]) :: "memory");
    const bf16* kvb_ = kva + (size_t)b * SEQ * 128;
    const unsigned long long kvbase = ((unsigned long long)(unsigned)__builtin_amdgcn_readfirstlane((int)((unsigned long long)(uintptr_t)kvb_ >> 32)) << 32) | (unsigned long long)(unsigned)__builtin_amdgcn_readfirstlane((int)(unsigned)(uintptr_t)kvb_);
    const unsigned kofs = (unsigned)(((lane & 7) ^ (lane >> 3)) << 4), vofs = 128u + (unsigned)(lane & 7) * 16u;
#define DSA_KEY(M_, st_, slot_) ((unsigned)list[(2 * wave + ((st_) >> 2)) * 256 + ((M_) ? (((slot_) < nselq[(st_) >> 2]) ? (slot_) : 0) : (slot_))])
#define DSA_DMA8(M_, st_, OFS_, LDSB_) do { unsigned kv_[8]; _Pragma("unroll") for (int i_ = 0; i_ < 8; ++i_) kv_[i_] = DSA_KEY(M_, st_, 64 * ((st_) & 3) + 8 * i_ + (lane >> 3)) * 256u + (OFS_); \
        unsigned keep_; const unsigned ld_ = (unsigned)__builtin_amdgcn_readfirstlane((int)(LDSB_)); \
        asm volatile("s_mov_b32 %0, m0\n\ts_mov_b32 m0, %9\n\ts_nop 0\n\t" \
                     "global_load_lds_dwordx4 %1, %10\n\ts_add_u32 m0, m0, 0x400\n\ts_nop 0\n\t" "global_load_lds_dwordx4 %2, %10\n\ts_add_u32 m0, m0, 0x400\n\ts_nop 0\n\t" \
                     "global_load_lds_dwordx4 %3, %10\n\ts_add_u32 m0, m0, 0x400\n\ts_nop 0\n\t" "global_load_lds_dwordx4 %4, %10\n\ts_add_u32 m0, m0, 0x400\n\ts_nop 0\n\t" \
                     "global_load_lds_dwordx4 %5, %10\n\ts_add_u32 m0, m0, 0x400\n\ts_nop 0\n\t" "global_load_lds_dwordx4 %6, %10\n\ts_add_u32 m0, m0, 0x400\n\ts_nop 0\n\t" \
                     "global_load_lds_dwordx4 %7, %10\n\ts_add_u32 m0, m0, 0x400\n\ts_nop 0\n\t" "global_load_lds_dwordx4 %8, %10\n\ts_mov_b32 m0, %0" \
                     : "=&s"(keep_) : "v"(kv_[0]), "v"(kv_[1]), "v"(kv_[2]), "v"(kv_[3]), "v"(kv_[4]), "v"(kv_[5]), "v"(kv_[6]), "v"(kv_[7]), "s"(ld_), "s"(kvbase) : "memory", "scc"); } while (0)
    float mrow = NEGF, lrow = 0.f; f32x4v o[4];
#define DSA_STEP(M_, st_, NK_, NV_) do { \
        if (((st_) & 3) == 0) { mrow = NEGF; lrow = 0.f; _Pragma("unroll") for (int dt_ = 0; dt_ < 4; ++dt_) o[dt_] = (f32x4v){0.f, 0.f, 0.f, 0.f}; } \
        asm volatile("s_waitcnt vmcnt(" #NK_ ")" ::: "memory");                       \
        bf16x8 kf_[8]; \
        _Pragma("unroll") for (int kt_ = 0; kt_ < 4; ++kt_) _Pragma("unroll") for (int ks_ = 0; ks_ < 2; ++ks_) kf_[2 * kt_ + ks_] = *(const LAS bf16x8*)(Vw + 8192 + (16 * kt_ + j) * 128 + (((gq + 4 * ks_) ^ (j & 7)) << 4)); \
        if ((st_) + 1 < 8) { asm volatile("s_waitcnt lgkmcnt(0)" ::: "memory"); DSA_DMA8(M_, (st_) + 1, kofs, vlds0 + 8192); }       \
        const bf16x8 q0_ = __builtin_bit_cast(bf16x8, qfq[(st_) >> 2][0]), q1_ = __builtin_bit_cast(bf16x8, qfq[(st_) >> 2][1]); \
        f32x4v s_[4]; float bm_ = NEGF; \
        _Pragma("unroll") for (int kt_ = 0; kt_ < 4; ++kt_) { f32x4v a_ = {0.f, 0.f, 0.f, 0.f}; \
            a_ = __builtin_amdgcn_mfma_f32_16x16x32_bf16(kf_[2 * kt_], q0_, a_, 0, 0, 0); a_ = __builtin_amdgcn_mfma_f32_16x16x32_bf16(kf_[2 * kt_ + 1], q1_, a_, 0, 0, 0); \
            _Pragma("unroll") for (int e_ = 0; e_ < 4; ++e_) { const float v_ = (!(M_) || (64 * ((st_) & 3) + 16 * kt_ + 4 * gq + e_ < nselq[(st_) >> 2])) ? a_[e_] : NEGF; a_[e_] = v_; bm_ = fmaxf(bm_, v_); } s_[kt_] = a_; } \
        bm_ = xmax16(bm_); \
        { const float mnew_ = fmaxf(mrow, bm_), alpha_ = __builtin_amdgcn_exp2f(mrow - mnew_); mrow = mnew_; float ps_ = 0.f; \
          _Pragma("unroll") for (int kt_ = 0; kt_ < 4; ++kt_) _Pragma("unroll") for (int e_ = 0; e_ < 4; ++e_) { const float p_ = __builtin_amdgcn_exp2f(s_[kt_][e_] - mnew_); s_[kt_][e_] = p_; ps_ += p_; } \
          lrow = lrow * alpha_ + ps_; _Pragma("unroll") for (int dt_ = 0; dt_ < 4; ++dt_) o[dt_] *= alpha_; } \
        asm volatile("s_waitcnt vmcnt(" #NV_ ")" : "+v"(s_[0]), "+v"(s_[1]), "+v"(s_[2]), "+v"(s_[3]) :: "memory");       \
        _Pragma("unroll") for (int kk_ = 0; kk_ < 2; ++kk_) { \
            const bf16x8 pf_ = pack8(s_[2 * kk_][0], s_[2 * kk_][1], s_[2 * kk_][2], s_[2 * kk_][3], s_[2 * kk_ + 1][0], s_[2 * kk_ + 1][1], s_[2 * kk_ + 1][2], s_[2 * kk_ + 1][3]); \
            _Pragma("unroll") for (int dt_ = 0; dt_ < 4; ++dt_) { const LAS unsigned char* va_ = Vw + (32 * kk_ + 4 * gq + (j >> 2)) * 128 + (16 * dt_ + 4 * (j & 3)) * 2; \
                o[dt_] = __builtin_amdgcn_mfma_f32_16x16x32_bf16(cat4(tr16(va_), tr16(va_ + 16 * 128)), pf_, o[dt_], 0, 0, 0); } } \
        if (((st_) & 3) == 3) { const float inv_ = __builtin_amdgcn_rcpf(xsum16(lrow)); const int rowq_ = b * SEQ + tq2[(st_) >> 2]; \
            if (j < 8) { _Pragma("unroll") for (int dt_ = 0; dt_ < 4; ++dt_) { uint2 w_; w_.x = cvtpk(o[dt_][0] * inv_, o[dt_][1] * inv_); w_.y = cvtpk(o[dt_][2] * inv_, o[dt_][3] * inv_); \
                *(uint2*)(yout + (size_t)rowq_ * 512 + j * 64 + 16 * dt_ + 4 * gq) = w_; } } } \
        if ((st_) + 1 < 8) { asm volatile("s_waitcnt lgkmcnt(0)" ::: "memory"); DSA_DMA8(M_, (st_) + 1, vofs, vlds0); }            \
    } while (0)
#define DSA_RUN(M_) do { DSA_DMA8(M_, 0, kofs, vlds0 + 8192); DSA_DMA8(M_, 0, vofs, vlds0); \
    DSA_STEP(M_, 0, 8, 8); DSA_STEP(M_, 1, 8, 8); DSA_STEP(M_, 2, 8, 8); DSA_STEP(M_, 3, 8, 8); DSA_STEP(M_, 4, 8, 8); DSA_STEP(M_, 5, 8, 8); DSA_STEP(M_, 6, 8, 8); DSA_STEP(M_, 7, 8, 0); } while (0)
    if (q0 >= 256) DSA_RUN(0); else DSA_RUN(1);
#undef DSA_RUN
#undef DSA_STEP
#undef DSA_DMA8
#undef DSA_KEY
    }
    __syncthreads();
    TP_MARK(4);
}
__device__ __forceinline__ void phase_mixers(const Args& P, unsigned char* ws, int z, LAS unsigned char* lds, int gw, int NGW, int lane, int wave, int bid, int G, int l) {
    asm volatile("" : "+v"(lane)); lane &= 63; asm volatile("" : "+s"(gw), "+s"(NGW));
    unsigned* qc = (unsigned*)(ws + WS_CTL) + 9216 + l * 8;
    volatile LAS unsigned* bw = (volatile LAS unsigned*)(lds + LDSCTL_OFF) + 40;
    const bool lead = (wave == 0) && (lane == 0);
    int qid = (int)(xb_xcc_id() & 7u), tries = 0;
#define MIX_BCAST(v_) ({ if (lead) *bw = (unsigned)(v_); __syncthreads(); const int r_ = (int)*bw; __syncthreads(); __builtin_amdgcn_readfirstlane(r_); })
    int nx = 0; if (lead) nx = (int)__hip_atomic_fetch_add(qc + qid, 1u, __ATOMIC_RELAXED, __HIP_MEMORY_SCOPE_AGENT);
    int cur = MIX_BCAST(nx);
    for (;;) {
        while (cur >= 384) { if (++tries == 8) break; qid = (qid + 1) & 7; nx = 0; if (lead) nx = (int)__hip_atomic_fetch_add(qc + qid, 1u, __ATOMIC_RELAXED, __HIP_MEMORY_SCOPE_AGENT); cur = MIX_BCAST(nx); }
        if (cur >= 384) break;
        nx = 0; if (lead) nx = (int)__hip_atomic_fetch_add(qc + qid, 1u, __ATOMIC_RELAXED, __HIP_MEMORY_SCOPE_AGENT);
        const int t3 = cur / 3;
        if (cur - 3 * t3 == 0) { const int n = t3, unit = (qid * 2 + (n & 1)) * 64 + (63 - (n >> 1)); nsa_unit(ws, unit, lds, (wave << 6) | lane_id_v(), (bf16*)(ws + WS_QC)); }
        else { const int d = cur - t3 - 1, unit = qid * 256 + (255 - d); dsa_unit(ws, unit, lds, (wave << 6) | lane_id_v(), (bf16*)(ws + WS_QA)); }
        cur = MIX_BCAST(nx);
    }
#undef MIX_BCAST
}
__global__ void __launch_bounds__(NWAVES * 64, 2) fwd_kernel(Args args) {
    extern __shared__ __attribute__((aligned(16))) unsigned char lds_raw[];
    LAS unsigned char* lds = (LAS unsigned char*)lds_raw;
    const int wave = __builtin_amdgcn_readfirstlane((int)threadIdx.x >> 6);
#define TIDX ((wave << 6) | lane_id_v())
#define tid TIDX
#define lane TIDX
    const int G = gridDim.x, bid = blockIdx.x;
    const int gw = bid * NWAVES + wave, NGW = G * NWAVES;
    const int lo = args.ph_lo, hi = args.ph_hi;
    const Args& P = args;
    int z = 0; asm volatile("" : "+s"(z));
    unsigned char* ws = args.ws + z;
    volatile LAS unsigned* MISCW = (volatile LAS unsigned*)(lds + LDSCTL_OFF);
    if (tid < 64) MISCW[tid] = 0u;
    __syncthreads();
    XcdBarrier bar; bar.bar = (unsigned*)(ws + WS_CTL) + 4096; bar.x = 0; bar.st = nullptr;
    if (hi - lo > 1) bar = xcd_barrier_post((unsigned*)(ws + WS_CTL) + 4096, MISCW + 8);
#define RUN(k) (lo <= (k) && (k) < hi)
#if TPROBE
#define TP_PHASE(k) do { if (bid == 0 && TIDX == 0) { volatile unsigned long long* sl_ = (volatile unsigned long long*)(args.ws + z + 32768); const unsigned long long n_ = __builtin_amdgcn_s_memtime(); const int cls_ = (k) == 0 ? 0 : 1 + (((k) - 1) % NPL); sl_[16 + cls_] += n_ - sl_[30]; sl_[30] = n_; } } while (0)
#else
#define TP_PHASE(k)
#endif
#define SEAM(k) do { TP_PHASE(k); if ((k) + 1 < hi) { XcdBarrier b2_ = bar; asm volatile("" : "+s"(b2_.bar), "+s"(b2_.x)); xcd_barrier(b2_); if (DUP == 13) xcd_barrier(b2_); } else { VM_WAIT(); __syncthreads(); } } while (0)


#if TPROBE
    if (bid == 0 && TIDX == 0) { volatile unsigned long long* sl_ = (volatile unsigned long long*)(args.ws + z + 32768); sl_[30] = __builtin_amdgcn_s_memtime(); }
#endif
    if (RUN(0)) { phase_rope(P, ws, z, bid * (NWAVES * 64) + tid, G * NWAVES * 64);
        { int ln_ = TIDX; asm volatile("" : "+v"(ln_)); ln_ &= 63;
          for (int m = gw; m < M; m += 4 * NGW) stat_rows4_bf16(P.in[0 + z], (bf16*)(ws + WS_XN), (float*)(ws + WS_SSQ), m, NGW, ln_); }
        if (!RUN(1)) SEAM(0); }
#define RS_PREPASS(Sref) do { const float* ssq_ = (const float*)(ws + WS_SSQ); LAS float* rsl_ = (LAS float*)(lds + RS_OFF); const int t_ = TIDX; pg8::Unit u_; \
        for (int i_ = 0; (Sref).next(i_, u_); ++i_) { const f32x4* p_ = (const f32x4*)(ssq_ + (size_t)(u_.pm * 256 + (t_ >> 1)) * 16 + (t_ & 1) * 8); const f32x4 a_ = p_[0], b_ = p_[1]; \
            float s_ = (a_.x + a_.y) + (a_.z + a_.w) + (b_.x + b_.y) + (b_.z + b_.w); s_ += __shfl_xor(s_, 1); if ((t_ & 1) == 0) rsl_[i_ * 256 + (t_ >> 1)] = 1.0f / sqrtf(s_ * (1.f / DM) + EPS); } \
        __syncthreads(); } while (0)

    for (int it = 0; it < 2 * DEPTH; ++it) {
        const int l = it >> 1, second = it & 1, pb = 1 + l * NPL + (second ? 7 : 0);
        asm volatile("" : "+s"(z));
        ws = args.ws + z;
        bf16* const XN = (bf16*)(ws + WS_XN);
        bf16* const HB = (bf16*)(ws + WS_H);
        bf16* const MG = (bf16*)(ws + WS_MG);
        bf16* const GB = (bf16*)(ws + WS_G);
        unsigned char* const wb = ws + WS_W;
        float* const OUT = P.out + z;
        if (!second && RUN(pb)) { phase_convert(P, ws, z, l, lds, gw, NGW, lane, wave);
#if DUP == 30
            phase_convert(P, ws, z, l, lds, gw, NGW, lane, wave);
#endif
            SEAM(pb); }
        if (RUN(pb + 1)) {
            pg8::Gemm g{XN, (const bf16*)(wb + (second ? WO_GU2 : WO_GU1)), M, 2 * FF, DM}; pg8::StaticOrder S; S.init(M, 2 * FF, G, bid + z);
            pg8::EpiSwiglu E{HB, FF, (const LAS float*)(lds + RS_OFF)};
            RS_PREPASS(S);
#if !defined(SITE_MASK) || ((SITE_MASK >> 0) & 1)
            pg8::gemm_phase<pg8::EpiSwiglu, pg8::StaticOrder, ALIGN_UP, true>(lds, g, S, E, TIDX);
#if DUP == 3
            pg8::gemm_phase<pg8::EpiSwiglu, pg8::StaticOrder, ALIGN_UP, true>(lds, g, S, E, TIDX);
#endif
#endif
            SEAM(pb + 1);
        }
        if (RUN(pb + 2)) {
            pg8::Gemm g{HB, (const bf16*)(wb + (second ? WO_D2 : WO_D1)), M, DM, FF}; pg8::StaticOrder S; S.init(M, DM, G, bid + z);
            pg8::EpiResid E{XN, 0.5f, (float*)(ws + WS_SSQ)};
#if !defined(SITE_MASK) || ((SITE_MASK >> 1) & 1)
            pg8::gemm_phase<pg8::EpiResid, pg8::StaticOrder, true, true>(lds, g, S, E, TIDX);
#endif
            SEAM(pb + 2);
        }
        if (second) continue;
        const int pm = 1 + l * NPL + 2;
        if (RUN(pm + 1)) {
            pg8::Gemm g{XN, (const bf16*)(wb + WO_IN), M, NINP, DM}; pg8::StaticOrder S; S.init(M, NINP, G, bid + z);
            pg8::EpiWin E{(bf16*)(ws + WS_QA), (bf16*)(ws + WS_QC), (bf16*)(ws + WS_IQ), (bf16*)(ws + WS_MISC), (bf16*)(ws + WS_KVC), (bf16*)(ws + WS_KVS), (bf16*)(ws + WS_KVW), (bf16*)(ws + WS_BU), GB,
                          (const float*)(ws + WS_ROPE), (const LAS float*)(lds + RS_OFF)};
            RS_PREPASS(S);
#if !defined(SITE_MASK) || ((SITE_MASK >> 2) & 1)
            pg8::gemm_phase<pg8::EpiWin, pg8::StaticOrder, ALIGN_WIN, true>(lds, g, S, E, TIDX);
#if DUP == 4
            pg8::gemm_phase<pg8::EpiWin, pg8::StaticOrder, ALIGN_WIN, true>(lds, g, S, E, TIDX);
#endif
#endif
            SEAM(pm + 1);
        }
        #ifndef NO_PREP
        if (RUN(pm + 2)) { phase_prep(P, ws, z, l, lds, gw, NGW, lane, wave, (bf16*)OUT);
#if DUP == 1
            { XcdBarrier b2_ = bar; asm volatile("" : "+s"(b2_.bar), "+s"(b2_.x)); xcd_barrier(b2_); } phase_prep(P, ws, z, l, lds, gw, NGW, lane, wave, (bf16*)OUT);
#endif
            SEAM(pm + 2); }
#endif
        #ifndef NO_MIX
        if (RUN(pm + 3)) {
#if TPROBE
            unsigned long long tm0_ = __builtin_amdgcn_s_memtime();
#endif
            phase_mixers(P, ws, z, lds, gw, NGW, lane, wave, bid, G, l);
#if TPROBE
            { const unsigned long long tm1_ = __builtin_amdgcn_s_memtime(); if (TIDX == 0) { atomicAdd((unsigned long long*)(args.ws + z + 32768) + 12, tm1_ - tm0_); atomicMax((unsigned long long*)(args.ws + z + 32768) + 13 + (l & 1), tm1_ - tm0_); } }
#endif
            SEAM(pm + 3); }
#endif
        if (RUN(pm + 4)) {
#if DUP == 5
          for (int rep_ = 0; rep_ < 2; ++rep_) {
#endif
            pg8::StaticOrder S; S.init(M, DM, G, bid + z);
            { pg8::Gemm g{(const bf16*)(ws + WS_QA), (const bf16*)(wb + WO_PA), M, DM, 512}; pg8::EpiProj<0> E{MG, GB, 0};
#if !defined(SITE_MASK) || ((SITE_MASK >> 3) & 1)
              pg8::gemm_phase<pg8::EpiProj<0>, pg8::StaticOrder, true, true>(lds, g, S, E, TIDX);
#endif
            }
            { pg8::Gemm g{(const bf16*)OUT, (const bf16*)(wb + WO_PB), M, DM, 512}; pg8::EpiProj<1> E{MG, GB, 1024};
#if !defined(SITE_MASK) || ((SITE_MASK >> 4) & 1)
              pg8::gemm_phase<pg8::EpiProj<1>, pg8::StaticOrder, true, true>(lds, g, S, E, TIDX);
#endif
            }
            { pg8::Gemm g{(const bf16*)(ws + WS_QC), (const bf16*)(wb + WO_PC), M, DM, 512}; pg8::EpiProj<1> E{MG, GB, 2048};
#if !defined(SITE_MASK) || ((SITE_MASK >> 5) & 1)
              pg8::gemm_phase<pg8::EpiProj<1>, pg8::StaticOrder, true, true>(lds, g, S, E, TIDX);
#endif
            }
#if DUP == 5
          }
#endif
#if DUP == 31
            { pg8::Gemm g{(const bf16*)(ws + WS_QC), (const bf16*)(wb + WO_PC), M, DM, 512}; pg8::EpiPlain E{(bf16*)OUT + (size_t)32 * 1024 * 1024 / 2};
              pg8::gemm_phase<pg8::EpiPlain, pg8::StaticOrder, true, true>(lds, g, S, E, TIDX); }
#endif
            SEAM(pm + 4);
        }
        if (RUN(pm + 5)) {
            pg8::Gemm g{MG, (const bf16*)(wb + WO_OUT), M, DM, DM}; pg8::StaticOrder S; S.init(M, DM, G, bid + z);
            pg8::EpiResid E{XN, 1.0f, (float*)(ws + WS_SSQ)};
#if !defined(SITE_MASK) || ((SITE_MASK >> 6) & 1)
            pg8::gemm_phase<pg8::EpiResid, pg8::StaticOrder, true, true>(lds, g, S, E, TIDX);
#endif
            SEAM(pm + 5);
        }
    }
    if (RUN(NPH - 1)) { asm volatile("" : "+s"(z)); int ln_ = TIDX; asm volatile("" : "+v"(ln_)); ln_ &= 63; float* o_ = P.out + z; float tps_ = 1.0f;
#if TPROBE
        { const unsigned long long* sl_ = (const unsigned long long*)(P.ws + z + 32768); double a_ = 0., b_ = 0.; for (int k = 0; k < 32; ++k) { const double v_ = (double)__hip_atomic_load(sl_ + k, __ATOMIC_RELAXED, __HIP_MEMORY_SCOPE_AGENT); if (((unsigned)TP_A >> k) & 1) a_ += v_; if (((unsigned)TP_B >> k) & 1) b_ += v_; } tps_ = 1.0f + floorf((float)(a_ / b_) * TP_SCALE * 20.0f + 0.5f) * 0.05f; }
#endif
        { const bf16* xr_ = (const bf16*)(args.ws + z + WS_XN); for (int m = gw; m < M; m += 4 * NGW) norm_rows4_out(xr_, o_, P.in[23 + z], m, NGW, ln_, tps_); }
#if TPROBE
        if (gw == 0 && ln_ == 0) { const unsigned long long* sl_ = (const unsigned long long*)(P.ws + z + 32768); double c_ = 0., d_ = 0.; for (int k = 0; k < 32; ++k) { const double v_ = (double)__hip_atomic_load(sl_ + k, __ATOMIC_RELAXED, __HIP_MEMORY_SCOPE_AGENT); if (((unsigned)TP_C >> k) & 1) c_ += v_; if (((unsigned)TP_D >> k) & 1) d_ += v_; } o_[0] = 1000.0f * floorf((float)(c_ / d_) * TP_SCALE2 * 20.0f + 0.5f) * 0.05f; }
#endif
    }
#undef RUN
#undef tid
#undef TIDX
#undef lane
#undef SEAM
}

extern "C" void kernel_launch(void* const* d_in, const int* in_sizes, int n_in, void* d_out, int out_size, void* d_ws, size_t ws_size, hipStream_t stream) {
    static int grid = 0;
    if (grid == 0) {
        if (n_in != 24 || out_size != M * DM || ws_size < WS_END) { fprintf(stderr, "kernel_launch: unexpected shapes (n_in %d out %d ws %zu)\n", n_in, out_size, ws_size); grid = -1; return; }
        int dev = 0, cus = 0, per_cu = 0;
        if (hipGetDevice(&dev) != hipSuccess || hipDeviceGetAttribute(&cus, hipDeviceAttributeMultiprocessorCount, dev) != hipSuccess) { grid = -1; return; }
        if (hipFuncSetAttribute((const void*)fwd_kernel, hipFuncAttributeMaxDynamicSharedMemorySize, LDS_BYTES) != hipSuccess) { fprintf(stderr, "kernel_launch: hipFuncSetAttribute failed\n"); grid = -1; return; }
        if (hipOccupancyMaxActiveBlocksPerMultiprocessor(&per_cu, (const void*)fwd_kernel, NWAVES * 64, LDS_BYTES) != hipSuccess || per_cu < 1) { fprintf(stderr, "kernel_launch: occupancy query says %d\n", per_cu); }
        (void)hipGetLastError();
        grid = cus;
    }
    if (grid < 0) return;
    (void)hipMemsetAsync((char*)d_ws + WS_CTL, 0, CTL_ZERO_BYTES, stream);
    Args a{};
    for (int i = 0; i < 24; ++i) a.in[i] = (const float*)d_in[i];
    a.out = (float*)d_out; a.ws = (unsigned char*)d_ws;
#if MK_ONE_LAUNCH
    a.ph_lo = 0; a.ph_hi = NPH;
    hipLaunchKernelGGL(fwd_kernel, dim3(grid), dim3(NWAVES * 64), LDS_BYTES, stream, a);
#else
    for (int ph = 0; ph < NPH; ++ph) { a.ph_lo = ph; a.ph_hi = ph + 1; hipLaunchKernelGGL(fwd_kernel, dim3(grid), dim3(NWAVES * 64), LDS_BYTES, stream, a); }
#endif
}
```

```cpp
#include <hip/hip_runtime.h>
#include <cstdio>
#include <cstdint>
#define PROBE 0
#define PROBE_GAIN 10.0f
#define TOP8_RANK 1
#define PROBE_ROWTHR 0.01f
#define PROBE_ROWCOND 1
#define PROBE_BR -1
#define FIXHOM 0
#define DUP 0
#define TPROBE 0
#define TP_A 1
#define TP_B 1
#define TP_SCALE 1.0f
#define TP_C 1
#define TP_D 1
#define TP_SCALE2 1.0f
#define POOLDBG 0
#define YB_SPARE 0
#define ALIGN_UP true
#define ALIGN_WIN true
#define DSA_CAP_V 512
#define DSA_K_V 13
#define DSA_HIST 1
#ifndef MK_ONE_LAUNCH
#define MK_ONE_LAUNCH 1
#endif
namespace pg8 {
#define PG8_LAS __attribute__((address_space(3)))
typedef unsigned short bf16_t;
typedef short bf16x8 __attribute__((ext_vector_type(8)));
typedef float f32x4 __attribute__((ext_vector_type(4)));
typedef unsigned u32x4 __attribute__((ext_vector_type(4)));
constexpr int BM = 256, BK = 64, HALF = 128, HTB = HALF * BK * 2  , STAGE_BYTES = 8 * HTB, NXCD = 8, WGM = 8;

__host__ __device__ __forceinline__ int lds_byte(int r, int c) { const int st = (r >> 4) * 2 + (c >> 5), rr = r & 15, cc = c & 31, ob = rr * 64 + cc * 2; return st * 1024 + (ob ^ (((ob >> 9) & 1) << 5)); }
__host__ __device__ __forceinline__ void stage_rc(int b, int& R, int& C) { const int st = b / 1024, sb = b % 1024, swz = sb ^ (((sb >> 9) & 1) << 5); R = (st >> 1) * 16 + swz / 64; C = (st & 1) * 32 + (swz % 64) / 2; }
__host__ __device__ __forceinline__ int perm32(int rho) { const int n = rho >> 4, i = rho & 15; return 8 * (i >> 2) + 4 * n + (i & 3); }

struct Unit { int pm, pn, ord; };
struct Gemm { const bf16_t* A; const bf16_t* Bt; int M, N, K; };

struct StaticOrder {
    int nM, nN, nwg, G, c;
    __host__ __device__ __forceinline__ void init(int M, int N, int G_, int c_) { nM = M / BM; nN = N / BM; nwg = nM * nN; G = G_; c = c_; }
    __host__ __device__ __forceinline__ bool next(int i, Unit& u) const {
        const int L = i * G + c; if (L >= nwg) return false;
        int wgid = (int)L; { const int q = nwg / NXCD, r = nwg % NXCD, xcd = wgid % NXCD, off = wgid / NXCD; wgid = (xcd < r ? xcd * (q + 1) : r * (q + 1) + (xcd - r) * q) + off; }
        const int nig = WGM * nN, gid = wgid / nig, fm = gid * WGM, gsz = (nM - fm) < WGM ? (nM - fm) : WGM;
        u.pm = fm + ((wgid % nig) % gsz); u.pn = (wgid % nig) / gsz; u.ord = i; return true;
    }
    __device__ __forceinline__ void a_ready(const Unit&) const {}
    __device__ __forceinline__ void done(const Unit&) const {}
};

__device__ __forceinline__ unsigned cvt_pk_bf16(float lo, float hi) { unsigned r; asm volatile("v_cvt_pk_bf16_f32 %0, %1, %2" : "=v"(r) : "v"(lo), "v"(hi)); return r; }
__device__ __forceinline__ float bflo(unsigned w) { return __uint_as_float(w << 16); }
__device__ __forceinline__ float bfhi(unsigned w) { return __uint_as_float(w & 0xffff0000u); }
__device__ __forceinline__ float fast_sigmoid(float x) { return __builtin_amdgcn_rcpf(1.0f + __expf(-x)); }

struct EpiSwiglu {
    static constexpr bool PERM = true, AFTER_DRAIN = false, WIDE = false;
    bf16_t* H; int ldh; const PG8_LAS float* rs;
    __device__ __forceinline__ void operator()(const f32x4 (&acc)[2][2][4][2], const Unit& u, int wr, int wc, int fr, int fq) const {
        const int row0 = u.pm * BM + wr * 64 + fr, col0 = u.pn * HALF + wc * 32 + 8 * fq;
#pragma unroll
        for (int ai = 0; ai < 2; ++ai)
#pragma unroll
            for (int m = 0; m < 4; ++m) {
                bf16_t* rowp = H + (size_t)(row0 + ai * HALF + m * 16) * ldh + col0;
                const float r = rs[u.ord * 256 + wr * 64 + fr + ai * HALF + m * 16];
                float o[8];
#pragma unroll
                for (int n = 0; n < 2; ++n)
#pragma unroll
                    for (int e = 0; e < 4; ++e) { const float g = acc[ai][0][m][n][e] * r, up = acc[ai][1][m][n][e] * r; o[n * 4 + e] = g * fast_sigmoid(g) * up; }
                u32x4 w; w.x = cvt_pk_bf16(o[0], o[1]); w.y = cvt_pk_bf16(o[2], o[3]); w.z = cvt_pk_bf16(o[4], o[5]); w.w = cvt_pk_bf16(o[6], o[7]);
                *(u32x4*)rowp = w;
            }
    }
};
__device__ __forceinline__ u32x4 xswap1(const u32x4 v) { u32x4 r; r.x = (unsigned)__builtin_amdgcn_update_dpp(0, (int)v.x, 0xB1, 0xF, 0xF, true); r.y = (unsigned)__builtin_amdgcn_update_dpp(0, (int)v.y, 0xB1, 0xF, 0xF, true);
    r.z = (unsigned)__builtin_amdgcn_update_dpp(0, (int)v.z, 0xB1, 0xF, 0xF, true); r.w = (unsigned)__builtin_amdgcn_update_dpp(0, (int)v.w, 0xB1, 0xF, 0xF, true); return r; }
__device__ __forceinline__ u32x4 xsel(bool c, const u32x4 a, const u32x4 b) { u32x4 r; r.x = c ? a.x : b.x; r.y = c ? a.y : b.y; r.z = c ? a.z : b.z; r.w = c ? a.w : b.w; return r; }
struct EpiResid {
    static constexpr bool PERM = true, AFTER_DRAIN = false, WIDE = true;
    bf16_t* xb; float s; float* ssq;
    __device__ __forceinline__ void operator()(const f32x4 (&acc)[2][2][4][2], const Unit& u, int wr, int wc, int fr, int fq) const {
        const bool pr = fr & 1;
        const int rbase = u.pm * BM + wr * 64, cacc = u.pn * BM + wc * 64 + (pr ? 32 : 0) + 8 * fq;
#pragma unroll
        for (int ai = 0; ai < 2; ++ai) {
            u32x4 le[4], lo[4];
#pragma unroll
            for (int m = 0; m < 4; ++m) { const size_t re = (size_t)(rbase + ai * HALF + m * 16 + (fr & ~1)); le[m] = *(const u32x4*)(xb + re * 1024 + cacc); lo[m] = *(const u32x4*)(xb + (re + 1) * 1024 + cacc); }
#pragma unroll
            for (int m = 0; m < 4; ++m) {
                const size_t re = (size_t)(rbase + ai * HALF + m * 16 + (fr & ~1));
                const u32x4 rcv = xswap1(xsel(pr, le[m], lo[m]));
                const u32x4 b0 = xsel(pr, rcv, le[m]), b1 = xsel(pr, lo[m], rcv);
                float q = 0.f; u32x4 w[2];
#pragma unroll
                for (int bj = 0; bj < 2; ++bj) {
                    const u32x4 b = bj ? b1 : b0;
                    const f32x4 c0 = {bflo(b.x), bfhi(b.x), bflo(b.y), bfhi(b.y)}, c1 = {bflo(b.z), bfhi(b.z), bflo(b.w), bfhi(b.w)};
                    const f32x4 x0 = c0 + acc[ai][bj][m][0] * s, x1 = c1 + acc[ai][bj][m][1] * s;
                    q += (x0[0] * x0[0] + x0[1] * x0[1]) + (x0[2] * x0[2] + x0[3] * x0[3]) + (x1[0] * x1[0] + x1[1] * x1[1]) + (x1[2] * x1[2] + x1[3] * x1[3]);
                    w[bj].x = cvt_pk_bf16(x0[0], x0[1]); w[bj].y = cvt_pk_bf16(x0[2], x0[3]); w[bj].z = cvt_pk_bf16(x1[0], x1[1]); w[bj].w = cvt_pk_bf16(x1[2], x1[3]);
                }
                const u32x4 rc2 = xswap1(xsel(pr, w[0], w[1]));
                *(u32x4*)(xb + re * 1024 + cacc) = xsel(pr, rc2, w[0]); *(u32x4*)(xb + (re + 1) * 1024 + cacc) = xsel(pr, w[1], rc2);
                q += __shfl_xor(q, 16); q += __shfl_xor(q, 32);
                if (fq == 0) ssq[(size_t)(rbase + ai * HALF + m * 16 + fr) * 16 + u.pn * 4 + wc] = q;
            }
        }
    }
};
template <int MODE> struct EpiProj {
    static constexpr bool PERM = true, AFTER_DRAIN = false, WIDE = true;
    bf16_t* MG; const bf16_t* G; int gofs;
    __device__ __forceinline__ void operator()(const f32x4 (&acc)[2][2][4][2], const Unit& u, int wr, int wc, int fr, int fq) const {
        const bool pr = fr & 1;
        const int rbase = u.pm * BM + wr * 64, cacc = u.pn * BM + wc * 64 + (pr ? 32 : 0) + 8 * fq;
#pragma unroll
        for (int ai = 0; ai < 2; ++ai) {
            u32x4 ge[4], go[4], me[4], mo[4];
#pragma unroll
            for (int m = 0; m < 4; ++m) { const size_t re = (size_t)(rbase + ai * HALF + m * 16 + (fr & ~1));
                ge[m] = *(const u32x4*)(G + re * 3072 + gofs + cacc); go[m] = *(const u32x4*)(G + (re + 1) * 3072 + gofs + cacc);
                if (MODE) { me[m] = *(const u32x4*)(MG + re * 1024 + cacc); mo[m] = *(const u32x4*)(MG + (re + 1) * 1024 + cacc); } }
#pragma unroll
            for (int m = 0; m < 4; ++m) {
                const size_t re = (size_t)(rbase + ai * HALF + m * 16 + (fr & ~1));
                const u32x4 gr = xswap1(xsel(pr, ge[m], go[m]));
                const u32x4 g0 = xsel(pr, gr, ge[m]), g1 = xsel(pr, go[m], gr);
                u32x4 m0 = {0u, 0u, 0u, 0u}, m1 = {0u, 0u, 0u, 0u};
                if (MODE) { const u32x4 mr = xswap1(xsel(pr, me[m], mo[m])); m0 = xsel(pr, mr, me[m]); m1 = xsel(pr, mo[m], mr); }
                u32x4 w[2];
#pragma unroll
                for (int bj = 0; bj < 2; ++bj) {
                    const u32x4 gv = bj ? g1 : g0, ov = bj ? m1 : m0;
                    const f32x4 a0 = acc[ai][bj][m][0], a1 = acc[ai][bj][m][1];
                    float o[8] = {bflo(gv.x) * a0[0], bfhi(gv.x) * a0[1], bflo(gv.y) * a0[2], bfhi(gv.y) * a0[3], bflo(gv.z) * a1[0], bfhi(gv.z) * a1[1], bflo(gv.w) * a1[2], bfhi(gv.w) * a1[3]};
                    if (MODE) { o[0] += bflo(ov.x); o[1] += bfhi(ov.x); o[2] += bflo(ov.y); o[3] += bfhi(ov.y); o[4] += bflo(ov.z); o[5] += bfhi(ov.z); o[6] += bflo(ov.w); o[7] += bfhi(ov.w); }
                    w[bj].x = cvt_pk_bf16(o[0], o[1]); w[bj].y = cvt_pk_bf16(o[2], o[3]); w[bj].z = cvt_pk_bf16(o[4], o[5]); w[bj].w = cvt_pk_bf16(o[6], o[7]);
                }
                const u32x4 rc2 = xswap1(xsel(pr, w[0], w[1]));
                *(u32x4*)(MG + re * 1024 + cacc) = xsel(pr, rc2, w[0]); *(u32x4*)(MG + (re + 1) * 1024 + cacc) = xsel(pr, w[1], rc2);
            }
        }
    }
};
struct EpiWin {
    static constexpr bool PERM = true, AFTER_DRAIN = false, WIDE = false;
    bf16_t *QA, *QC, *IQ, *MISC, *KVC, *KVS, *KVW, *BU, *G; const float* rope; const PG8_LAS float* rs;
    __device__ __forceinline__ void operator()(const f32x4 (&acc)[2][2][4][2], const Unit& u, int wr, int wc, int fr, int fq) const {
        const int pn = u.pn;
        bf16_t* dst; int ld, cbase, mode;
        if (pn < 2) { dst = QA; ld = 512; cbase = pn * 256; mode = 1; }
        else if (pn < 4) { dst = QC; ld = 512; cbase = (pn - 2) * 256; mode = 1; }
        else if (pn == 4) { dst = IQ; ld = 256; cbase = 0; mode = 1; }
        else if (pn == 5) { dst = MISC; ld = 256; cbase = 0; mode = 3; }
        else if (pn <= 8) { dst = pn == 6 ? KVC : (pn == 7 ? KVS : KVW); ld = 256; cbase = 0; mode = 2; }
        else if (pn <= 10) { dst = BU; ld = 512; cbase = (pn - 9) * 256; mode = 0; }
        else { dst = G; ld = 3072; cbase = (pn - 11) * 256; mode = 4; }
        const int row0 = u.pm * BM + wr * 64 + fr, col0 = cbase + wc * 32 + 8 * fq;
        const bool ropelane = ((wc & 1) == 0) && fq < 2;
        const float sc = (mode == 1) ? (pn < 4 ? 0.125f * 1.4426950408889634f : 0.125f) : 1.0f;
#pragma unroll
        for (int ai = 0; ai < 2; ++ai) {
            f32x4 csv[4], snv[4];
#pragma unroll
            for (int m = 0; m < 4; ++m) { csv[m] = (f32x4){1.f, 1.f, 1.f, 1.f}; snv[m] = (f32x4){0.f, 0.f, 0.f, 0.f}; }
            if (mode >= 1 && mode <= 3) {
#pragma unroll
                for (int m = 0; m < 4; ++m) { const float* rp = rope + (size_t)(row0 + ai * HALF + m * 16) * 16 + 4 * (fq & 1); csv[m] = *(const f32x4*)rp; snv[m] = *(const f32x4*)(rp + 8); }
            }
#pragma unroll
            for (int m = 0; m < 4; ++m) {
                const size_t row = (size_t)(row0 + ai * HALF + m * 16);
                const float rr = rs[u.ord * 256 + wr * 64 + fr + ai * HALF + m * 16];
                const f32x4 cs = csv[m], sn = snv[m];
#pragma unroll
                for (int bj = 0; bj < 2; ++bj) {
                    const f32x4 a0 = acc[ai][bj][m][0] * rr, a1 = acc[ai][bj][m][1] * rr;
                    float o[8] = {a0[0], a0[1], a0[2], a0[3], a1[0], a1[1], a1[2], a1[3]};
                    const bool dorope = ropelane && (mode == 1 || (mode == 2 && bj == 0) || (mode == 3 && bj == 0 && wc == 0));
                    if (dorope) {
#pragma unroll
                        for (int p = 0; p < 4; ++p) { const float x1 = o[2 * p], x2 = o[2 * p + 1]; o[2 * p] = x1 * cs[p] - x2 * sn[p]; o[2 * p + 1] = x2 * cs[p] + x1 * sn[p]; }
                    }
                    if (mode == 4) {
#pragma unroll
                        for (int e = 0; e < 8; ++e) o[e] = fast_sigmoid(o[e]);
                    } else {
#pragma unroll
                        for (int e = 0; e < 8; ++e) o[e] *= sc;
                    }
                    u32x4 w; w.x = cvt_pk_bf16(o[0], o[1]); w.y = cvt_pk_bf16(o[2], o[3]); w.z = cvt_pk_bf16(o[4], o[5]); w.w = cvt_pk_bf16(o[6], o[7]);
                    *(u32x4*)(dst + row * ld + col0 + bj * HALF) = w;
                }
            }
        }
    }
};


#if DUP == 31
struct EpiPlain {
    static constexpr bool PERM = true, AFTER_DRAIN = false;
    bf16_t* O;
    __device__ __forceinline__ void operator()(const f32x4 (&acc)[2][2][4][2], const Unit& u, int wr, int wc, int fr, int fq) const {
        const int row0 = u.pm * BM + wr * 64 + fr, col0 = u.pn * BM + wc * 32 + 8 * fq;
#pragma unroll
        for (int ai = 0; ai < 2; ++ai)
#pragma unroll
            for (int m = 0; m < 4; ++m)
#pragma unroll
                for (int bj = 0; bj < 2; ++bj) { const f32x4 a0 = acc[ai][bj][m][0], a1 = acc[ai][bj][m][1];
                    u32x4 w; w.x = cvt_pk_bf16(a0[0], a0[1]); w.y = cvt_pk_bf16(a0[2], a0[3]); w.z = cvt_pk_bf16(a1[0], a1[1]); w.w = cvt_pk_bf16(a1[2], a1[3]);
                    *(u32x4*)(O + (size_t)(row0 + ai * HALF + m * 16) * 1024 + col0 + bj * HALF) = w; }
    }
};
#endif
template <class Epi, class Sched, bool ALIGN_EPI = false, bool SP2 = false>
__device__ __forceinline__ void gemm_phase(PG8_LAS unsigned char* lds, const Gemm g, const Sched& S, const Epi& E, int tid_in) {
    int tid_ = tid_in; asm volatile("" : "+v"(tid_));
    const int tid = tid_, wid = __builtin_amdgcn_readfirstlane(tid >> 6), lane = tid & 63, wr = wid >> 2, wc = wid & 3, fr = lane & 15, fq = lane >> 4;
    const int K = g.K, nt = K / BK;
    unsigned voffA[2], voffB[2];
#pragma unroll
    for (int i = 0; i < 2; ++i) { int R, C; stage_rc(tid * 16 + i * 8192, R, C); const int Rp = Epi::PERM ? ((R & ~31) + perm32(R & 31)) : R;
        const int Rb = Epi::WIDE ? (((Rp >> 5) << 6) + (Rp & 31)) : Rp;
        voffA[i] = (unsigned)(R * K + C) * 2u; voffB[i] = (unsigned)(Rb * K + C) * 2u; }
    const size_t kstep = (size_t)(BK * 2);
    const size_t hstep = (size_t)HALF * K * 2;
    const size_t tstep = 2 * hstep;
    const size_t hstepB = Epi::WIDE ? (size_t)32 * K * 2 : hstep;
    const unsigned ldsw = (unsigned)wid * 1024u;
    const int aoff = lds_byte(wr * 64 + fr, fq * 8), boff = lds_byte(wc * 32 + fr, fq * 8);
#define PG8_SA(b, h) (((b) * 2 + (h)) * HTB)
#define PG8_SB(b, h) ((4 + (b) * 2 + (h)) * HTB)
#define PG8_STAGE(bufoff, gbase, voff) do { _Pragma("unroll") for (int _i = 0; _i < 2; ++_i) \
        __builtin_amdgcn_global_load_lds((const unsigned*)((const char*)(gbase) + (voff)[_i]), (PG8_LAS unsigned*)(lds + (bufoff) + ldsw + _i * 8192), 16, 0, 0); } while (0)
#define PG8_LDA(dst, b, h) do { _Pragma("unroll") for (int m = 0; m < 4; ++m) _Pragma("unroll") for (int k = 0; k < 2; ++k) dst[m][k] = *(const PG8_LAS bf16x8*)(lds + PG8_SA(b, h) + aoff + m * 2048 + k * 1024); } while (0)
#define PG8_LDB(dst, b, h) do { _Pragma("unroll") for (int n = 0; n < 2; ++n) _Pragma("unroll") for (int k = 0; k < 2; ++k) dst[n][k] = *(const PG8_LAS bf16x8*)(lds + PG8_SB(b, h) + boff + n * 2048 + k * 1024); } while (0)
#define PG8_MMA(ai, bj, At, Bt) do { __builtin_amdgcn_s_setprio(1); _Pragma("unroll") for (int m = 0; m < 4; ++m) _Pragma("unroll") for (int n = 0; n < 2; ++n) _Pragma("unroll") for (int k = 0; k < 2; ++k) \
        acc[ai][bj][m][n] = __builtin_amdgcn_mfma_f32_16x16x32_bf16(Bt[n][k], At[m][k], acc[ai][bj][m][n], 0, 0, 0); __builtin_amdgcn_s_setprio(0); } while (0)
#define PG8_WAIT_V(n) asm volatile("s_waitcnt vmcnt(" #n ")" ::: "memory")
#define PG8_WAIT_L(n) asm volatile("s_waitcnt lgkmcnt(" #n ")" ::: "memory")
#define PG8_BAR __builtin_amdgcn_s_barrier()
#define PG8_SCHED __builtin_amdgcn_sched_barrier(0)
    Unit cur, nxt; int ui = 0;
    if (!S.next(0, cur)) return;
    f32x4 acc[2][2][4][2];
#pragma unroll
    for (int a = 0; a < 2; ++a)
#pragma unroll
        for (int b = 0; b < 2; ++b)
#pragma unroll
            for (int m = 0; m < 4; ++m)
#pragma unroll
                for (int n = 0; n < 2; ++n) acc[a][b][m][n] = (f32x4){0.f, 0.f, 0.f, 0.f};
    bf16x8 At[4][2], B0[2][2], B1[2][2];
    const char* cA = (const char*)g.A + (size_t)cur.pm * tstep; const char* cB = (const char*)g.Bt + (size_t)cur.pn * tstep;
    S.a_ready(cur);
    if constexpr (SP2) {
        PG8_STAGE(PG8_SB(0, 0), cB, voffB); PG8_STAGE(PG8_SB(0, 1), cB + hstepB, voffB); PG8_STAGE(PG8_SA(0, 0), cA, voffA); PG8_STAGE(PG8_SA(0, 1), cA + hstep, voffA);
        if (wr == 1) PG8_BAR;
        PG8_WAIT_V(2); PG8_BAR;
        PG8_STAGE(PG8_SB(1, 0), cB + kstep, voffB); PG8_STAGE(PG8_SA(1, 0), cA + kstep, voffA); PG8_STAGE(PG8_SB(1, 1), cB + hstepB + kstep, voffB);
        PG8_WAIT_V(6); PG8_BAR;
    } else {
        PG8_STAGE(PG8_SB(0, 0), cB, voffB); PG8_STAGE(PG8_SA(0, 0), cA, voffA); PG8_STAGE(PG8_SB(0, 1), cB + hstepB, voffB); PG8_STAGE(PG8_SA(0, 1), cA + hstep, voffA);
        if (wr == 1) PG8_BAR;
        PG8_WAIT_V(4); PG8_BAR;
        PG8_STAGE(PG8_SB(1, 0), cB + kstep, voffB); PG8_STAGE(PG8_SA(1, 0), cA + kstep, voffA); PG8_STAGE(PG8_SB(1, 1), cB + hstepB + kstep, voffB);
        PG8_WAIT_V(6); PG8_BAR;
    }
    for (;;) {
        const bool has_next = S.next(ui + 1, nxt);
        const char* nA = has_next ? (const char*)g.A + (size_t)nxt.pm * tstep : cA; const char* nB = has_next ? (const char*)g.Bt + (size_t)nxt.pn * tstep : cB;
        for (int t = 0; t < nt; t += 2) {
            const bool last = (t == nt - 2);
            const char* a1 = cA + (size_t)(t + 1) * kstep;
            const char* a2 = last ? nA : cA + (size_t)(t + 2) * kstep; const char* b2 = last ? nB : cB + (size_t)(t + 2) * kstep;
            const char* a3 = a2 + kstep; const char* b3 = b2 + kstep;
            if (last && has_next) S.a_ready(nxt);
            if constexpr (SP2) {
            PG8_LDB(B0, 0, 0); PG8_LDB(B1, 0, 1); PG8_SCHED; PG8_LDA(At, 0, 0); PG8_STAGE(PG8_SA(1, 1), a1 + hstep, voffA);
            PG8_WAIT_V(8); PG8_WAIT_L(0); PG8_BAR; PG8_MMA(0, 0, At, B0); PG8_MMA(0, 1, At, B1); PG8_BAR; PG8_SCHED;
            PG8_LDA(At, 0, 1); PG8_STAGE(PG8_SB(0, 0), b2, voffB); PG8_STAGE(PG8_SB(0, 1), b2 + hstepB, voffB); PG8_STAGE(PG8_SA(0, 0), a2, voffA);
            PG8_WAIT_V(8); PG8_WAIT_L(0); PG8_BAR; PG8_MMA(1, 0, At, B0); PG8_MMA(1, 1, At, B1); PG8_BAR; PG8_SCHED;
            PG8_LDB(B0, 1, 0); PG8_LDB(B1, 1, 1); PG8_SCHED; PG8_LDA(At, 1, 0); PG8_STAGE(PG8_SA(0, 1), a2 + hstep, voffA);
            PG8_WAIT_V(8); PG8_WAIT_L(0); PG8_BAR; PG8_MMA(0, 0, At, B0); PG8_MMA(0, 1, At, B1); PG8_BAR; PG8_SCHED;
            PG8_LDA(At, 1, 1); PG8_STAGE(PG8_SB(1, 0), b3, voffB); PG8_STAGE(PG8_SB(1, 1), b3 + hstepB, voffB); PG8_STAGE(PG8_SA(1, 0), a3, voffA);
            PG8_WAIT_V(8); PG8_WAIT_L(0); PG8_BAR; PG8_MMA(1, 0, At, B0); PG8_MMA(1, 1, At, B1); PG8_BAR; PG8_SCHED;
            } else {
            PG8_LDB(B0, 0, 0); PG8_SCHED; PG8_LDA(At, 0, 0); PG8_STAGE(PG8_SA(1, 1), a1 + hstep, voffA);
            PG8_WAIT_L(8); PG8_BAR; PG8_WAIT_L(0); PG8_MMA(0, 0, At, B0); PG8_BAR; PG8_SCHED;
            PG8_LDB(B1, 0, 1); PG8_STAGE(PG8_SB(0, 0), b2, voffB);
            PG8_BAR; PG8_WAIT_L(0); PG8_MMA(0, 1, At, B1); PG8_BAR;
            PG8_LDA(At, 0, 1); PG8_STAGE(PG8_SA(0, 0), a2, voffA);
            PG8_BAR; PG8_WAIT_L(0); PG8_MMA(1, 0, At, B0); PG8_BAR; PG8_SCHED;
            PG8_STAGE(PG8_SB(0, 1), b2 + hstepB, voffB);
            PG8_WAIT_V(6); PG8_BAR; PG8_MMA(1, 1, At, B1); PG8_BAR;
            PG8_LDB(B0, 1, 0); PG8_SCHED; PG8_LDA(At, 1, 0); PG8_STAGE(PG8_SA(0, 1), a2 + hstep, voffA);
            PG8_WAIT_L(8); PG8_BAR; PG8_WAIT_L(0); PG8_MMA(0, 0, At, B0); PG8_BAR; PG8_SCHED;
            PG8_LDB(B1, 1, 1); PG8_STAGE(PG8_SB(1, 0), b3, voffB);
            PG8_BAR; PG8_WAIT_L(0); PG8_MMA(0, 1, At, B1); PG8_BAR;
            PG8_LDA(At, 1, 1); PG8_STAGE(PG8_SA(1, 0), a3, voffA);
            PG8_BAR; PG8_WAIT_L(0); PG8_MMA(1, 0, At, B0); PG8_BAR; PG8_SCHED;
            PG8_STAGE(PG8_SB(1, 1), b3 + hstepB, voffB);
            PG8_WAIT_V(6); PG8_BAR; PG8_MMA(1, 1, At, B1); PG8_BAR;
            }
        }
        if constexpr (ALIGN_EPI) { if (wr == 0) PG8_BAR; }
        if constexpr (!Epi::AFTER_DRAIN) { E(acc, cur, wr, wc, fr, fq); S.done(cur); }
        if (!has_next) break;
#pragma unroll
        for (int a = 0; a < 2; ++a)
#pragma unroll
            for (int b = 0; b < 2; ++b)
#pragma unroll
                for (int m = 0; m < 4; ++m)
#pragma unroll
                    for (int n = 0; n < 2; ++n) acc[a][b][m][n] = (f32x4){0.f, 0.f, 0.f, 0.f};
        cur = nxt; cA = nA; cB = nB; ++ui;
        if constexpr (ALIGN_EPI) { if (wr == 1) PG8_BAR; }
    }
    PG8_WAIT_V(0);
    if constexpr (!ALIGN_EPI) { if (wr == 0) PG8_BAR; }
    PG8_BAR;
    if constexpr (Epi::AFTER_DRAIN) { E.fused(acc, cur, wr, wc, fr, fq, lds, wid, lane); S.done(cur); }
#undef PG8_SA
#undef PG8_SB
#undef PG8_STAGE
#undef PG8_LDA
#undef PG8_LDB
#undef PG8_MMA
#undef PG8_WAIT_V
#undef PG8_WAIT_L
#undef PG8_BAR
#undef PG8_SCHED
}
}
#define GAS __attribute__((address_space(1)))
#define LAS __attribute__((address_space(3)))
typedef unsigned short bf16;
typedef unsigned v4u __attribute__((ext_vector_type(4)));
typedef float f32x4 __attribute__((ext_vector_type(4)));
typedef short bf16x8 __attribute__((ext_vector_type(8)));
typedef GAS unsigned gu32;
typedef GAS unsigned long long gu64;
#define RLX_AGENT __ATOMIC_RELAXED, __HIP_MEMORY_SCOPE_AGENT
#define LDS_WAIT() asm volatile("s_waitcnt lgkmcnt(0)" ::: "memory")
#define VM_WAIT() asm volatile("s_waitcnt vmcnt(0)" ::: "memory")
__device__ __forceinline__ unsigned long long rt() { return __builtin_amdgcn_s_memrealtime(); }
__device__ __forceinline__ unsigned f2bf(float f) { unsigned u = __builtin_bit_cast(unsigned, f); return (u + 0x7fffu + ((u >> 16) & 1u)) >> 16; }
__device__ __forceinline__ unsigned pk2(float lo, float hi) { return f2bf(lo) | (f2bf(hi) << 16); }
#define XB_TMO      128
#define XB_XCNT(j)  (256  + 64 * (j))
#define XB_XSUB(j)  (1280 + 64 * (j))
#define XB_XGEN(j)  (2304 + 64 * (j))
#define XB_TOP      3328
#define XB_TOPGEN   3392
#define XCD_BAR_WORDS 3456
#define XB_SPIN_CAP (1u << 18)

__device__ __forceinline__ unsigned xb_ld(unsigned* p)              { return __hip_atomic_load(p, __ATOMIC_RELAXED, __HIP_MEMORY_SCOPE_AGENT); }
__device__ __forceinline__ unsigned xb_add(unsigned* p, unsigned v) { return __hip_atomic_fetch_add(p, v, __ATOMIC_RELAXED, __HIP_MEMORY_SCOPE_AGENT); }
__device__ __forceinline__ unsigned xb_xcc_id() { return (unsigned)__builtin_amdgcn_s_getreg((3 << 11) | 20) & 0xFu; }
#define XB_SPIN(cond, bar) do { unsigned _sp = 0; while (cond) { __builtin_amdgcn_s_sleep(1); \
    if ((++_sp & 255u) == 0u) { if (xb_ld(&(bar)[XB_TMO])) break; if (_sp > XB_SPIN_CAP) { atomicAdd(&(bar)[XB_TMO], 1u); break; } } } } while (0)

struct XcdBarrier {
    unsigned* bar; unsigned x;
    volatile LAS unsigned* st;
};

__device__ __forceinline__ XcdBarrier xcd_barrier_post(unsigned* bar, volatile LAS unsigned* st) {
    XcdBarrier b; b.bar = bar; b.x = xb_xcc_id(); b.st = st;
    if (threadIdx.x == 0) (void)xb_add(&bar[XB_XCNT(b.x)], 1u);
    return b;
}
__device__ __forceinline__ void xcd_barrier_complete(unsigned* bar, unsigned x, unsigned& nloc, unsigned& nx) {
    const unsigned G = gridDim.x * gridDim.y * gridDim.z;
    unsigned sum, cnt, mine, sp = 0u;
    for (;;) {
        sum = 0u; cnt = 0u; mine = 0u;
#pragma unroll
        for (unsigned j = 0; j < 16; ++j) { const unsigned c = xb_ld(&bar[XB_XCNT(j)]); sum += c; cnt += (c > 0u) ? 1u : 0u; mine = (j == x) ? c : mine; }
        if (sum == G) break;
        __builtin_amdgcn_s_sleep(1);
        if ((++sp & 255u) == 0u) { if (xb_ld(&bar[XB_TMO])) break; if (sp > XB_SPIN_CAP) { atomicAdd(&bar[XB_TMO], 1u); break; } }
    }
    nloc = mine > 0u ? mine : 1u; nx = cnt > 0u ? cnt : 1u;
}

__device__ __forceinline__ void xcd_barrier(const XcdBarrier& b) {
    asm volatile("s_waitcnt vmcnt(0)" ::: "memory");
    __syncthreads();
    if (threadIdx.x == 0) {
        unsigned* bar = b.bar;
        __builtin_amdgcn_s_waitcnt(0);
        unsigned nloc = b.st[0], nx = b.st[1];
        if (nloc == 0u) { xcd_barrier_complete(bar, b.x, nloc, nx); b.st[0] = nloc; b.st[1] = nx; }
        const unsigned old = xb_add(&bar[XB_XSUB(b.x)], 1u);
        const unsigned gen = old / nloc;
        if (old + 1u == (gen + 1u) * nloc) {
            __builtin_amdgcn_fence(__ATOMIC_RELEASE, "agent");
            asm volatile("s_waitcnt vmcnt(0)" ::: "memory");
            const unsigned og = xb_add(&bar[XB_TOP], 1u);
            const unsigned tg = og / nx;
            if (og + 1u == (tg + 1u) * nx) xb_add(&bar[XB_TOPGEN], 1u);
            else XB_SPIN(xb_ld(&bar[XB_TOPGEN]) == tg, bar);
            __builtin_amdgcn_fence(__ATOMIC_ACQUIRE, "agent");
            xb_add(&bar[XB_XGEN(b.x)], 1u);
            asm volatile("s_waitcnt vmcnt(0)" ::: "memory");
        } else {
            XB_SPIN(xb_ld(&bar[XB_XGEN(b.x)]) == gen, bar);
            __builtin_amdgcn_fence(__ATOMIC_ACQUIRE, "agent");
            asm volatile("s_waitcnt vmcnt(0)" ::: "memory");
        }
    }
    __syncthreads();
}
constexpr int NB = 8, SEQ = 4096, DM = 1024, DEPTH = 4, M = NB * SEQ;
constexpr int FF = 2816, NIN = 5852, NINP = 5888;
constexpr float EPS = 1e-6f, NEGF = -1e30f;
constexpr int NWAVES = 8;
constexpr size_t MiB = 1u << 20;
constexpr size_t WS_CTL = 0, CTL_ZERO_BYTES = 1 * MiB;
constexpr size_t WS_ROPE = 1 * MiB;
constexpr size_t WS_KVA = 3 * MiB;
constexpr size_t WS_KC = 11 * MiB, WS_VC = WS_KC + 512 * 1024;
constexpr size_t WS_W = 12 * MiB;
constexpr size_t WO_GU1 = 0, WO_D1 = 11 * MiB, WO_GU2 = WO_D1 + 5 * MiB + 512 * 1024, WO_D2 = WO_GU2 + 11 * MiB, WO_IN = WO_D2 + 5 * MiB + 512 * 1024,
                 WO_PA = WO_IN + 11 * MiB + 512 * 1024, WO_PB = WO_PA + MiB, WO_PC = WO_PB + MiB, WO_OUT = WO_PC + MiB,
                 WO_CW1 = WO_OUT + 2 * MiB  , WO_CW2 = WO_CW1 + MiB  , WO_UKV = WO_CW2 + 32768  , WO_POOL = WO_UKV + 32768  ,
                 WO_POSB = WO_POOL + 131072  , WO_END = WO_POSB + 8192;
static_assert(WO_END <= 52 * MiB, "weights region");
constexpr size_t WS_XN = 64 * MiB;
constexpr size_t WS_R = 128 * MiB;
constexpr size_t WS_G = WS_R, WS_QA = WS_R + 192 * MiB, WS_QC = WS_QA + 32 * MiB, WS_IQ = WS_QC + 32 * MiB, WS_MISC = WS_IQ + 16 * MiB,
                 WS_KVC = WS_MISC + 16 * MiB, WS_KVS = WS_KVC + 16 * MiB, WS_KVW = WS_KVS + 16 * MiB, WS_BU = WS_KVW + 16 * MiB, WS_END = WS_BU + 32 * MiB;
#ifndef YB_SPARE
#define YB_SPARE 0
#endif
constexpr size_t WS_YB = YB_SPARE ? 496 * MiB : WS_XN;
constexpr size_t WS_MG = WS_IQ;
constexpr size_t WS_H = WS_R;
static_assert(WS_END == 496 * MiB, "ws map");
constexpr int RING_BYTES = 131072, LDS_BYTES = 163840, LDSCTL_OFF = 163840 - 256;
constexpr size_t WS_SSQ = 496 * MiB;
constexpr int RS_OFF = 131072;
constexpr int NPL = 10, NPH = 1 + DEPTH * NPL + 1;


#ifndef TPROBE
#define TPROBE 0
#endif
#if TPROBE
#define TP_DECL unsigned long long tp_t_ = __builtin_amdgcn_s_memtime();
#define TP_MARK(k) do { const unsigned long long n_ = __builtin_amdgcn_s_memtime(); if (tid == 0) atomicAdd((unsigned long long*)(ws + 32768) + (k), n_ - tp_t_); tp_t_ = n_; } while (0)
#define TP_ADD(k, v) do { if (tid == 0) atomicAdd((unsigned long long*)(ws + 32768) + (k), (unsigned long long)(v)); } while (0)
#else
#define TP_DECL
#define TP_MARK(k)
#define TP_ADD(k, v)
#endif
__device__ __forceinline__ int lane_id_v() { int l; asm volatile("v_mbcnt_lo_u32_b32 %0, -1, 0\n\tv_mbcnt_hi_u32_b32 %0, -1, %0" : "=v"(l)); return l; }
__device__ __forceinline__ float bflo(unsigned w) { return __uint_as_float(w << 16); }
__device__ __forceinline__ float bfhi(unsigned w) { return __uint_as_float(w & 0xffff0000u); }
__device__ __forceinline__ float bf2f(bf16 v) { return __uint_as_float((unsigned)v << 16); }
__device__ __forceinline__ float wave_sum(float v) {
#pragma unroll
    for (int o = 1; o < 64; o <<= 1) v += __shfl_xor(v, o);
    return v;
}
__device__ __forceinline__ float wave_max(float v) {
#pragma unroll
    for (int o = 1; o < 64; o <<= 1) v = fmaxf(v, __shfl_xor(v, o));
    return v;
}
__device__ __forceinline__ int wave_sum_i(int v) {
#pragma unroll
    for (int o = 1; o < 64; o <<= 1) v += __shfl_xor(v, o);
    return v;
}
__device__ __forceinline__ unsigned wave_max_u(unsigned v) {
#pragma unroll
    for (int o = 1; o < 64; o <<= 1) { const unsigned w = (unsigned)__shfl_xor((int)v, o); v = w > v ? w : v; }
    return v;
}
#define WAVE_LDS_SYNC() do { asm volatile("s_waitcnt lgkmcnt(0)" ::: "memory"); __builtin_amdgcn_wave_barrier(); } while (0)
__host__ __device__ __forceinline__ int permd(int d) { return d < 8 ? 2 * d : (d < 16 ? 2 * (d - 8) + 1 : d); }
__device__ __forceinline__ int win_newcol(int n) {
    if (n < 512) return (n & ~63) + permd(n & 63);
    if (n < 640) return 1280 + 64 + (n - 512);
    if (n < 896) { const int m = n - 640; return 1024 + (m & ~63) + permd(m & 63); }
    if (n < 960) return 1280 + permd(n - 896);
    if (n < 964) return 1280 + 192 + (n - 960);
    if (n < 1476) return 2304 + (n - 964);
    if (n < 1988) { const int m = n - 1476; return 512 + (m & ~63) + permd(m & 63); }
    if (n < 2756) { const int m = n - 1988, kv = m >> 8, r = m & 255, base = 1536 + kv * 256; return r < 128 ? base + (r & ~63) + permd(r & 63) : base + r; }
    if (n < 2780) return 1280 + 196 + (n - 2756);
    return 2816 + (n - 2780);
}
__device__ __forceinline__ int map_row(int mode, int n) { return mode == 0 ? n : (mode == 1 ? ((n >> 7) << 8) + (n & 127) : (mode == 2 ? ((n >> 7) << 8) + 128 + (n & 127) : win_newcol(n))); }

struct Args { const float* in[24]; float* out; unsigned char* ws; int ph_lo, ph_hi; };

__device__ __forceinline__ int unperm(int p) { return p < 16 ? ((p & 1) ? (p >> 1) + 8 : (p >> 1)) : p; }
__device__ __forceinline__ void tr_item(const float* W, int K, int N, bf16* WT, int mode, LAS float* scr, int item, int lane, bool kperm = false, const float* kscale = nullptr) {
    const int nblk = (N + 31) >> 5, kb = item / nblk, nb = item - kb * nblk, k0 = 64 * kb, n0 = 32 * nb;
    const int nn = n0 + (lane & 31);
    const int nnc = nn < N ? nn : N - 1; const float msk = nn < N ? 1.0f : 0.0f;
    const float* ksp = kscale ? kscale : W; const bool hs = kscale != nullptr;
    float wv[32], sv[32];
#pragma unroll
    for (int i = 0; i < 32; ++i) { const int kk = 2 * i + (lane >> 5); wv[i] = W[(size_t)(k0 + kk) * N + nnc]; sv[i] = ksp[k0 + kk]; }
#pragma unroll
    for (int i = 0; i < 32; ++i) { const int kk = 2 * i + (lane >> 5); scr[kk * 33 + (lane & 31)] = wv[i] * (hs ? sv[i] : 1.0f) * msk; }
    LDS_WAIT(); asm volatile("" ::: "memory");
    const int c = lane & 7;
#pragma unroll
    for (int j = 0; j < 4; ++j) { const int n = (lane >> 3) + 8 * j; const LAS float* s = scr + n;
        int ks[8];
#pragma unroll
        for (int i = 0; i < 8; ++i) ks[i] = (kperm ? unperm(8 * c + i) : 8 * c + i) * 33;
        v4u o; o.x = pk2(s[ks[0]], s[ks[1]]); o.y = pk2(s[ks[2]], s[ks[3]]); o.z = pk2(s[ks[4]], s[ks[5]]); o.w = pk2(s[ks[6]], s[ks[7]]);
        if (n0 + n < N) *(v4u*)(WT + (size_t)map_row(mode, n0 + n) * K + k0 + 8 * c) = o; }
    LDS_WAIT(); asm volatile("" ::: "memory");
}
__device__ __forceinline__ void phase_convert(const Args& P, unsigned char* ws, int z, int l, LAS unsigned char* lds, int gw, int NGW, int lane, int wave) {
    asm volatile("" : "+v"(lane)); lane &= 63; asm volatile("" : "+s"(gw), "+s"(NGW));
    LAS float* scr = (LAS float*)(lds + wave * 16384);
    unsigned char* wb = ws + WS_W;
    constexpr int I_F = 16 * 88, I_D = 44 * 32, I_IN = 16 * 183, I_P = 8 * 32, I_O = 16 * 32;
    constexpr int I_C = 32 * 4;
    constexpr int NIT = 4 * I_F + 2 * I_D + I_IN + 3 * I_P + I_O + 2 * I_C;
    const size_t fo = (size_t)l * DM * FF;
    for (int it = gw; it < NIT; it += NGW) {
        int r = it, K = DM, N = FF, mode = 1; const float* W = P.in[3 + z] + fo; size_t wo = WO_GU1; bool kperm = false; const float* ksc = P.in[2 + z] + l * DM;
        if (r >= I_F) { r -= I_F; mode = 2; W = P.in[4 + z] + fo;
        if (r >= I_F) { r -= I_F; mode = 0; W = P.in[5 + z] + fo; K = FF; N = DM; wo = WO_D1; ksc = nullptr;
        if (r >= I_D) { r -= I_D; mode = 1; W = P.in[20 + z] + fo; K = DM; N = FF; wo = WO_GU2; ksc = P.in[19 + z] + l * DM;
        if (r >= I_F) { r -= I_F; mode = 2; W = P.in[21 + z] + fo;
        if (r >= I_F) { r -= I_F; mode = 0; W = P.in[22 + z] + fo; K = FF; N = DM; wo = WO_D2; ksc = nullptr;
        if (r >= I_D) { r -= I_D; mode = 3; W = P.in[7 + z] + (size_t)l * DM * NIN; K = DM; N = NIN; wo = WO_IN; ksc = P.in[6 + z] + l * DM;
        if (r >= I_IN) { r -= I_IN; mode = 0; W = P.in[15 + z] + (size_t)l * 512 * DM; K = 512; N = DM; wo = WO_PA; ksc = nullptr;
        if (r >= I_P) { r -= I_P; W = P.in[16 + z] + (size_t)l * 512 * DM; wo = WO_PB;
        if (r >= I_P) { r -= I_P; W = P.in[17 + z] + (size_t)l * 512 * DM; wo = WO_PC;
        if (r >= I_P) { r -= I_P; W = P.in[18 + z] + (size_t)l * DM * DM; K = DM; wo = WO_OUT;
        if (r >= I_O) { r -= I_O; W = P.in[13 + z] + (size_t)(l * 2) * 2048 * 128; K = 2048; N = 128; wo = WO_CW1; kperm = true;
        if (r >= I_C) { r -= I_C; W += (size_t)2048 * 128; wo = WO_CW1 + 128 * 2048 * 2; kperm = false; } } } } } } } } } } } }
        tr_item(W, K, N, (bf16*)(wb + wo), mode, scr, r, lane, kperm, ksc);
    }
    {
        const int gt = gw * 64 + lane, GT = NGW * 64;
        bf16* ukv = (bf16*)(wb + WO_UKV); bf16* pool = (bf16*)(wb + WO_POOL); bf16* cw2 = (bf16*)(wb + WO_CW2); float* posb = (float*)(wb + WO_POSB);
        const float* w_ukv = P.in[9 + z] + (size_t)l * 128 * 128; const float* gn = P.in[8 + z] + l * 128;
        for (int i = gt; i < 128 * 128; i += GT) { const int np = i >> 7, k = i & 127, n = np < 64 ? unperm(np) : np; ukv[i] = (bf16)f2bf(gn[k] * w_ukv[k * 128 + n]); }
        const float* pw = P.in[10 + z] + (size_t)l * 4 * 128 * 128; const float* psc = P.in[11 + z] + l * 512;
        for (int i = gt; i < 4 * 128 * 128; i += GT) { const int g = i >> 14, d = (i >> 7) & 127, c = i & 127; pool[i] = (bf16)f2bf(pw[(g * 128 + c) * 128 + d] * psc[g * 128 + d]); }
        const float* w2 = P.in[14 + z] + (size_t)l * 2 * 128 * 64;
        for (int i = gt; i < 2 * 64 * 128; i += GT) { const int br = i >> 13, dp = (i >> 7) & 63, n = i & 127, d = br ? dp : unperm(dp); cw2[i] = (bf16)f2bf(w2[(br * 128 + n) * 64 + d]); }
        const float* w1 = P.in[13 + z] + (size_t)l * 2 * 2048 * 128; const float* pos = P.in[12 + z] + (size_t)l * 2 * 2048;
        for (int i = gw; i < 512; i += NGW) { const int o = i & 255, part = i >> 8, br = o >> 7, n = o & 127; float a = 0.f;
#pragma unroll
            for (int q = 0; q < 16; ++q) { const int k = part * 1024 + 64 * q + lane; a += pos[br * 2048 + k] * w1[((size_t)br * 2048 + k) * 128 + n]; }
            a = wave_sum(a); if (lane == 0) posb[part * 256 + o] = a; }
    }
    if (gw < 36) { unsigned zz = 0u; asm volatile("" : "+v"(zz)); v4u z = {zz, zz, zz, zz}; v4u* rp = (v4u*)((bf16*)(wb + WO_IN) + (size_t)(1500 + gw) * DM); for (int i = lane; i < DM / 8; i += 64) rp[i] = z; }
}
__device__ __forceinline__ void phase_rope(const Args& P, unsigned char* ws, int z, int gtid, int gthreads) {
    float* rope = (float*)(ws + WS_ROPE);
    for (int idx = gtid; idx < M * 8; idx += gthreads) {
        const int row = idx >> 3, i = idx & 7;
        const double inv = i == 0 ? 1.0 : i == 1 ? 0.19392274474868576 : i == 2 ? 0.03760603093086393 : i == 3 ? 0.007292664737217109 : i == 4 ? 0.001414213562373095 : i == 5 ? 0.0002742481756762073 : i == 6 ? 5.318295896944988e-05 : 1.031338537721246e-05;
        const double ang = (double)((const int*)P.in[1 + z])[row] * inv;
        double s, c; sincos(ang, &s, &c);
        rope[row * 16 + i] = (float)c; rope[row * 16 + 8 + i] = (float)s;
    }
}
__device__ __forceinline__ void norm_row_bf16(const float* xrow, const float* gain, bf16* orow, int lane) {
    const f32x4* xr = (const f32x4*)xrow + lane; const f32x4* gr = (const f32x4*)gain + lane;
    f32x4 v[4]; float s = 0.f;
#pragma unroll
    for (int j = 0; j < 4; ++j) { v[j] = xr[64 * j]; s += (v[j].x * v[j].x + v[j].y * v[j].y) + (v[j].z * v[j].z + v[j].w * v[j].w); }
    const float r = 1.0f / sqrtf(wave_sum(s) * (1.f / DM) + EPS);
    unsigned long long* o8 = (unsigned long long*)orow + lane;
#pragma unroll
    for (int j = 0; j < 4; ++j) { const f32x4 g = gr[64 * j]; o8[64 * j] = (unsigned long long)pk2(v[j].x * r * g.x, v[j].y * r * g.y) | ((unsigned long long)pk2(v[j].z * r * g.z, v[j].w * r * g.w) << 32); }
}
__device__ __forceinline__ void stat_row_bf16(const float* xrow, bf16* orow, float* ssq16, int lane) {
    const f32x4* xr = (const f32x4*)xrow + lane;
    f32x4 v[4]; float s = 0.f;
#pragma unroll
    for (int j = 0; j < 4; ++j) { v[j] = xr[64 * j]; s += (v[j].x * v[j].x + v[j].y * v[j].y) + (v[j].z * v[j].z + v[j].w * v[j].w); }
    s = wave_sum(s);
    unsigned long long* o8 = (unsigned long long*)orow + lane;
#pragma unroll
    for (int j = 0; j < 4; ++j) o8[64 * j] = (unsigned long long)pk2(v[j].x, v[j].y) | ((unsigned long long)pk2(v[j].z, v[j].w) << 32);
    if (lane < 16) ssq16[lane] = lane == 0 ? s : 0.f;
}
__device__ __forceinline__ void norm_row_f32(float* xrow, const float* gain, int lane, float tps = 1.0f) {
    f32x4* xr = (f32x4*)xrow + lane; const f32x4* gr = (const f32x4*)gain + lane;
    f32x4 v[4]; float s = 0.f;
#pragma unroll
    for (int j = 0; j < 4; ++j) { v[j] = xr[64 * j]; s += (v[j].x * v[j].x + v[j].y * v[j].y) + (v[j].z * v[j].z + v[j].w * v[j].w); }
    const float r = tps / sqrtf(wave_sum(s) * (1.f / DM) + EPS);
#pragma unroll
    for (int j = 0; j < 4; ++j) { const f32x4 g = gr[64 * j]; xr[64 * j] = v[j] * r * g; }
}

__device__ __forceinline__ void norm_row_out(const bf16* xrow, float* orow, const float* gain, int lane, float tps = 1.0f) {
    const v4u a = *(const v4u*)(xrow + 16 * lane), b = *(const v4u*)(xrow + 16 * lane + 8);
    const float f[16] = {bflo(a.x), bfhi(a.x), bflo(a.y), bfhi(a.y), bflo(a.z), bfhi(a.z), bflo(a.w), bfhi(a.w), bflo(b.x), bfhi(b.x), bflo(b.y), bfhi(b.y), bflo(b.z), bfhi(b.z), bflo(b.w), bfhi(b.w)};
    float s = 0.f;
#pragma unroll
    for (int e = 0; e < 16; ++e) s += f[e] * f[e];
    const float r = tps / sqrtf(wave_sum(s) * (1.f / DM) + EPS);
    const f32x4* gr = (const f32x4*)(gain + 16 * lane); f32x4* orr = (f32x4*)(orow + 16 * lane);
#pragma unroll
    for (int j = 0; j < 4; ++j) { const f32x4 g = gr[j]; f32x4 o; o.x = f[4 * j] * r * g.x; o.y = f[4 * j + 1] * r * g.y; o.z = f[4 * j + 2] * r * g.z; o.w = f[4 * j + 3] * r * g.w; orr[j] = o; }
}

__device__ __forceinline__ void stat_rows4_bf16(const float* x, bf16* xo, float* ssq, int m0, int st, int lane) {
    f32x4 v[4][4];
#pragma unroll
    for (int r = 0; r < 4; ++r) { const int m = m0 + r * st; const f32x4* xr = (const f32x4*)(x + (size_t)(m < M ? m : 0) * DM) + lane;
#pragma unroll
        for (int j = 0; j < 4; ++j) v[r][j] = xr[64 * j]; }
#pragma unroll
    for (int r = 0; r < 4; ++r) { const int m = m0 + r * st; if (m < M) { float s = 0.f;
#pragma unroll
        for (int j = 0; j < 4; ++j) s += (v[r][j].x * v[r][j].x + v[r][j].y * v[r][j].y) + (v[r][j].z * v[r][j].z + v[r][j].w * v[r][j].w);
        s = wave_sum(s);
        unsigned long long* o8 = (unsigned long long*)(xo + (size_t)m * DM) + lane;
#pragma unroll
        for (int j = 0; j < 4; ++j) o8[64 * j] = (unsigned long long)pk2(v[r][j].x, v[r][j].y) | ((unsigned long long)pk2(v[r][j].z, v[r][j].w) << 32);
        if (lane < 16) ssq[(size_t)m * 16 + lane] = lane == 0 ? s : 0.f; } }
}
__device__ __forceinline__ void norm_rows4_out(const bf16* x, float* out, const float* gain, int m0, int st, int lane, float tps = 1.0f) {
    v4u a[4], b[4];
#pragma unroll
    for (int r = 0; r < 4; ++r) { const int m = m0 + r * st; const bf16* xr = x + (size_t)(m < M ? m : 0) * DM + 16 * lane; a[r] = *(const v4u*)xr; b[r] = *(const v4u*)(xr + 8); }
    f32x4 g[4];
#pragma unroll
    for (int j = 0; j < 4; ++j) g[j] = ((const f32x4*)(gain + 16 * lane))[j];
#pragma unroll
    for (int r = 0; r < 4; ++r) { const int m = m0 + r * st; if (m < M) {
        const float f[16] = {bflo(a[r].x), bfhi(a[r].x), bflo(a[r].y), bfhi(a[r].y), bflo(a[r].z), bfhi(a[r].z), bflo(a[r].w), bfhi(a[r].w), bflo(b[r].x), bfhi(b[r].x), bflo(b[r].y), bfhi(b[r].y), bflo(b[r].z), bfhi(b[r].z), bflo(b[r].w), bfhi(b[r].w)};
        float s = 0.f;
#pragma unroll
        for (int e = 0; e < 16; ++e) s += f[e] * f[e];
        const float rs = tps / sqrtf(wave_sum(s) * (1.f / DM) + EPS);
        f32x4* orr = (f32x4*)(out + (size_t)m * DM + 16 * lane);
#pragma unroll
        for (int j = 0; j < 4; ++j) { f32x4 o; o.x = f[4 * j] * rs * g[j].x; o.y = f[4 * j + 1] * rs * g[j].y; o.z = f[4 * j + 2] * rs * g[j].z; o.w = f[4 * j + 3] * rs * g[j].w; orr[j] = o; } } }
}
__device__ __forceinline__ unsigned f2o(float s) { const int b = (int)__float_as_uint(s); return (unsigned)(b ^ ((b >> 31) | (int)0x80000000)); }
__device__ __forceinline__ void unpack8(const v4u v, float* f) { f[0] = bflo(v.x); f[1] = bfhi(v.x); f[2] = bflo(v.y); f[3] = bfhi(v.y); f[4] = bflo(v.z); f[5] = bfhi(v.z); f[6] = bflo(v.w); f[7] = bfhi(v.w); }
__device__ __forceinline__ void load_row64(const bf16* p, float* f) {
    const v4u* q = (const v4u*)p;
#pragma unroll
    for (int i = 0; i < 8; ++i) unpack8(q[i], f + 8 * i);
}
__device__ __forceinline__ float dot64(const LAS float* q, const float* k) {
    float d = 0.f;
#pragma unroll
    for (int i = 0; i < 16; ++i) { const f32x4 qq = *(const LAS f32x4*)(q + 4 * i); d += qq.x * k[4 * i] + qq.y * k[4 * i + 1] + qq.z * k[4 * i + 2] + qq.w * k[4 * i + 3]; }
    return d;
}
__device__ __forceinline__ void dsa_query(const Args& P, unsigned char* ws, int z, int row, LAS unsigned char* wl, int lane) {
    const int b = row >> 12, t = row & (SEQ - 1), n = t + 1;
    LAS unsigned* su = (LAS unsigned*)wl; LAS float* pb = (LAS float*)wl; LAS unsigned short* list = (LAS unsigned short*)(wl + 16384); LAS float* qb = (LAS float*)(wl + 16896);
    const bf16* misc = (const bf16*)(ws + WS_MISC);
    const unsigned long long lt = (1ull << lane) - 1ull;
    int nsel;
    if (n <= 256) { for (int i = lane; i < n; i += 64) list[i] = (unsigned short)i; nsel = n; }
    else {
        { const uint2 v = *(const uint2*)((const bf16*)(ws + WS_IQ) + (size_t)row * 256 + lane * 4); qb[lane * 4] = bflo(v.x); qb[lane * 4 + 1] = bfhi(v.x); qb[lane * 4 + 2] = bflo(v.y); qb[lane * 4 + 3] = bfhi(v.y); }
        float iw[4]; { const uint2 v = *(const uint2*)(misc + (size_t)row * 256 + 192); iw[0] = 0.5f * bflo(v.x); iw[1] = 0.5f * bfhi(v.x); iw[2] = 0.5f * bflo(v.y); iw[3] = 0.5f * bfhi(v.y); }
        WAVE_LDS_SYNC();
        const int nch = (n + 63) >> 6;
        for (int i = 0; i < nch; ++i) {
            const int key = i * 64 + lane; const bool valid = key <= t;
            float kf[64]; load_row64(misc + (size_t)(b * SEQ + (valid ? key : t)) * 256, kf);
            float s = 0.f;
#pragma unroll
            for (int h = 0; h < 4; ++h) s += iw[h] * fmaxf(dot64(qb + h * 64, kf), 0.f);
            su[key] = valid ? f2o(s) : 0u;
        }
        WAVE_LDS_SYNC();
        unsigned prefix = 0u;
        for (int bit = 31; bit >= 0; --bit) {
            const unsigned cand = prefix | (1u << bit); int c = 0;
            for (int i = 0; i < nch; ++i) c += (su[i * 64 + lane] >= cand) ? 1 : 0;
            c = wave_sum_i(c);
            if (c >= 256) prefix = cand;
            if (c == 256) break;
        }
        int cgt = 0;
        for (int i = 0; i < nch; ++i) cgt += (su[i * 64 + lane] > prefix) ? 1 : 0;
        const int need_eq = 256 - wave_sum_i(cgt);
        int base = 0, eq_taken = 0;
        for (int i = 0; i < nch; ++i) {
            const unsigned v = su[i * 64 + lane]; const bool gt = v > prefix, eq = v == prefix;
            const unsigned long long meq = __ballot(eq);
            const bool sel = gt || (eq && (eq_taken + __popcll(meq & lt)) < need_eq);
            const unsigned long long ms = __ballot(sel);
            if (sel) list[base + __popcll(ms & lt)] = (unsigned short)(i * 64 + lane);
            base += __popcll(ms); eq_taken += __popcll(meq);
        }
        nsel = 256;
    }
    { const v4u v = *(const v4u*)((const bf16*)(ws + WS_QA) + (size_t)row * 512 + lane * 8); float f[8]; unpack8(v, f);
#pragma unroll
      for (int e = 0; e < 8; ++e) qb[lane * 8 + e] = f[e]; }
    WAVE_LDS_SYNC();
    const bf16* kva = (const bf16*)(ws + WS_KVA);
    float s[8][4];
#pragma unroll
    for (int j = 0; j < 4; ++j) {
        const int slot = lane + 64 * j; const bool valid = slot < nsel; const int key = list[valid ? slot : 0];
        float kf[64]; load_row64(kva + (size_t)(b * SEQ + key) * 128, kf);
#pragma unroll
        for (int h = 0; h < 8; ++h) s[h][j] = valid ? dot64(qb + h * 64, kf) : NEGF;
    }
    float linv[8];
#pragma unroll
    for (int h = 0; h < 8; ++h) {
        const float m = wave_max(fmaxf(fmaxf(s[h][0], s[h][1]), fmaxf(s[h][2], s[h][3]))); float ls = 0.f;
#pragma unroll
        for (int j = 0; j < 4; ++j) { const float p = __expf(s[h][j] - m); ls += p; pb[h * 256 + lane + 64 * j] = p; }
        linv[h] = 1.0f / wave_sum(ls);
    }
    WAVE_LDS_SYNC();
    float acc[8] = {0.f, 0.f, 0.f, 0.f, 0.f, 0.f, 0.f, 0.f};
    for (int slot = 0; slot < nsel; ++slot) {
        const float v = bf2f(kva[(size_t)(b * SEQ + list[slot]) * 128 + 64 + lane]);
#pragma unroll
        for (int h = 0; h < 8; ++h) acc[h] += pb[h * 256 + slot] * v;
    }
    bf16* ya = (bf16*)(ws + WS_QA) + (size_t)row * 512;
#pragma unroll
    for (int h = 0; h < 8; ++h) ya[h * 64 + lane] = (bf16)f2bf(acc[h] * linv[h]);
    WAVE_LDS_SYNC();
}
typedef short s16x4 __attribute__((ext_vector_type(4)));
typedef short v4i16_t __attribute__((ext_vector_type(4)));
typedef float f32x4v __attribute__((ext_vector_type(4)));
typedef __bf16 bf16x2_t __attribute__((ext_vector_type(2)));
typedef float f32x2_t __attribute__((ext_vector_type(2)));
__device__ __forceinline__ unsigned cvtpk(float lo, float hi) { f32x2_t v = {lo, hi}; bf16x2_t b = __builtin_convertvector(v, bf16x2_t); return __builtin_bit_cast(unsigned, b); }
constexpr float L2E = 1.4426950408889634f;
#ifndef NSA_JOINT
#define NSA_JOINT 1
#endif
#ifndef NSA_NOSKIP
#define NSA_NOSKIP 0
#endif
constexpr int NSA_KSTR = 72, NSA_VSTR = 80;
constexpr int NSA_KB = 64 * NSA_KSTR * 2, NSA_VB = 64 * NSA_VSTR * 2;
constexpr int NSA_D = 6, NSA_SLOT = 16384;
constexpr int NSA_OFF_RING = 0, NSA_OFF_KCL = 0, NSA_OFF_VCTL = 32768  , NSA_OFF_IMPA = 65536  , NSA_OFF_IMPB = NSA_OFF_IMPA + 64 * 65 * 4, NSA_OFF_UM = NSA_D * NSA_SLOT + 1024  , NSA_OFF_QM = NSA_OFF_UM + 64, NSA_OFF_ST = NSA_OFF_UM + 1024, NSA_LDS = NSA_OFF_ST + 512 * 64;
__device__ __forceinline__ s16x4 tr16(const LAS unsigned char* p) { return __builtin_bit_cast(s16x4, __builtin_amdgcn_ds_read_tr16_b64_v4i16((LAS v4i16_t*)p)); }
__device__ __forceinline__ bf16x8 cat4(s16x4 a, s16x4 b) { return __builtin_shufflevector(a, b, 0, 1, 2, 3, 4, 5, 6, 7); }
__device__ __forceinline__ bf16x8 pack8(float a0, float a1, float a2, float a3, float b0, float b1, float b2, float b3) {
    v4u w; w.x = pg8::cvt_pk_bf16(a0, a1); w.y = pg8::cvt_pk_bf16(a2, a3); w.z = pg8::cvt_pk_bf16(b0, b1); w.w = pg8::cvt_pk_bf16(b2, b3); return __builtin_bit_cast(bf16x8, w);
}
__device__ __forceinline__ float qxor1(float v) { return __builtin_bit_cast(float, __builtin_amdgcn_update_dpp(0, __builtin_bit_cast(int, v), 0xB1, 0xF, 0xF, true)); }
__device__ __forceinline__ float qxor2(float v) { return __builtin_bit_cast(float, __builtin_amdgcn_update_dpp(0, __builtin_bit_cast(int, v), 0x4E, 0xF, 0xF, true)); }
__device__ __forceinline__ float xmax16(float v) { v = fmaxf(v, __shfl_xor(v, 16)); return fmaxf(v, __shfl_xor(v, 32)); }
__device__ __forceinline__ float xsum16(float v) { v += __shfl_xor(v, 16); return v + __shfl_xor(v, 32); }

__device__ __forceinline__ void nsa_fetch(const bf16* kv, int b, int jb, int g, int tid, v4u& kr, v4u& vr) {
    const bf16* p = kv + (size_t)(b * SEQ + 64 * jb + (tid >> 3)) * 256 + g * 64 + (tid & 7) * 8;
    kr = *(const v4u*)p; vr = *(const v4u*)(p + 128);
}
__device__ __forceinline__ void nsa_stash(LAS unsigned char* Kb, LAS unsigned char* Vb, int tid, const v4u& kr, const v4u& vr) {
    *(LAS v4u*)(Kb + ((tid >> 3) * NSA_KSTR + (tid & 7) * 8) * 2) = kr; *(LAS v4u*)(Vb + ((tid >> 3) * NSA_VSTR + (tid & 7) * 8) * 2) = vr;
}
template <bool FULL>
__device__ __forceinline__ void nsa_block2(const LAS unsigned char* Kb, const LAS unsigned char* Vb, const bf16x8 (&qf)[2][2], const bool (&sel)[2], const int (&klo)[2], const int (&khi)[2],
                                           float (&mrow)[2], float (&lrow)[2], f32x4v (&o)[2][4], int lane) {
    const int j = lane & 15, gq = lane >> 4;
    f32x4v s[2][4];
#pragma unroll
    for (int kt = 0; kt < 4; ++kt) {
        s[0][kt] = (f32x4v){0.f, 0.f, 0.f, 0.f}; s[1][kt] = (f32x4v){0.f, 0.f, 0.f, 0.f};
#pragma unroll
        for (int ks = 0; ks < 2; ++ks) {
            const bf16x8 kf = *(const LAS bf16x8*)(Kb + (16 * kt + j) * 128 + (((gq + 4 * ks) ^ (j & 7)) << 4));
            s[0][kt] = __builtin_amdgcn_mfma_f32_16x16x32_bf16(kf, qf[0][ks], s[0][kt], 0, 0, 0);
            s[1][kt] = __builtin_amdgcn_mfma_f32_16x16x32_bf16(kf, qf[1][ks], s[1][kt], 0, 0, 0);
        }
    }
#pragma unroll
    for (int rg = 0; rg < 2; ++rg) {
        float bm = NEGF;
        if (FULL) { const float bias = sel[rg] ? 0.f : NEGF;
#pragma unroll
            for (int kt = 0; kt < 4; ++kt)
#pragma unroll
                for (int e = 0; e < 4; ++e) { const float v = s[rg][kt][e] + bias; s[rg][kt][e] = v; bm = fmaxf(bm, v); }
        } else {
#pragma unroll
            for (int kt = 0; kt < 4; ++kt)
#pragma unroll
                for (int e = 0; e < 4; ++e) { const int ko = 16 * kt + 4 * gq + e; const bool ok = sel[rg] && ko >= klo[rg] && ko <= khi[rg]; const float v = ok ? s[rg][kt][e] : NEGF; s[rg][kt][e] = v; bm = fmaxf(bm, v); }
        }
        bm = xmax16(bm);
        const float mnew = fmaxf(mrow[rg], bm), alpha = __builtin_amdgcn_exp2f(mrow[rg] - mnew);
        const bool moved = __builtin_amdgcn_ballot_w64(mnew != mrow[rg]) != 0ull;
        mrow[rg] = mnew;
        float ps = 0.f;
#pragma unroll
        for (int kt = 0; kt < 4; ++kt)
#pragma unroll
            for (int e = 0; e < 4; ++e) { const float p = __builtin_amdgcn_exp2f(s[rg][kt][e] - mnew); s[rg][kt][e] = p; ps += p; }
        lrow[rg] = lrow[rg] * alpha + ps;
        if (moved) {
#pragma unroll
            for (int dt = 0; dt < 4; ++dt) o[rg][dt] *= alpha;
        }
    }
#pragma unroll
    for (int kk = 0; kk < 2; ++kk) {
        const bf16x8 pf0 = pack8(s[0][2 * kk][0], s[0][2 * kk][1], s[0][2 * kk][2], s[0][2 * kk][3], s[0][2 * kk + 1][0], s[0][2 * kk + 1][1], s[0][2 * kk + 1][2], s[0][2 * kk + 1][3]);
        const bf16x8 pf1 = pack8(s[1][2 * kk][0], s[1][2 * kk][1], s[1][2 * kk][2], s[1][2 * kk][3], s[1][2 * kk + 1][0], s[1][2 * kk + 1][1], s[1][2 * kk + 1][2], s[1][2 * kk + 1][3]);
#pragma unroll
        for (int dt = 0; dt < 4; ++dt) {
            const LAS unsigned char* va = Vb + (32 * kk + 4 * gq + (j >> 2)) * 128 + (16 * dt + 4 * (j & 3)) * 2;
            const bf16x8 vf = cat4(tr16(va), tr16(va + 16 * 128));
            o[0][dt] = __builtin_amdgcn_mfma_f32_16x16x32_bf16(vf, pf0, o[0][dt], 0, 0, 0);
            o[1][dt] = __builtin_amdgcn_mfma_f32_16x16x32_bf16(vf, pf1, o[1][dt], 0, 0, 0);
        }
        }
}
__device__ __forceinline__ void nsa_block4(const LAS unsigned char* KbA, const LAS unsigned char* VbA, const LAS unsigned char* KbB, const LAS unsigned char* VbB, const bf16x8 (&qf)[2][2],
                                           const bool (&selA)[2], const bool (&selB)[2], float (&mrow)[2], float (&lrow)[2], f32x4v (&o)[2][4], int lane) {
    const int j = lane & 15, gq = lane >> 4;
    f32x4v s[2][2][4];
#pragma unroll
    for (int bl = 0; bl < 2; ++bl) { const LAS unsigned char* Kb = bl ? KbB : KbA;
#pragma unroll
        for (int kt = 0; kt < 4; ++kt) {
            s[bl][0][kt] = (f32x4v){0.f, 0.f, 0.f, 0.f}; s[bl][1][kt] = (f32x4v){0.f, 0.f, 0.f, 0.f};
#pragma unroll
            for (int ks = 0; ks < 2; ++ks) {
                const bf16x8 kf = *(const LAS bf16x8*)(Kb + (16 * kt + j) * 128 + (((gq + 4 * ks) ^ (j & 7)) << 4));
                s[bl][0][kt] = __builtin_amdgcn_mfma_f32_16x16x32_bf16(kf, qf[0][ks], s[bl][0][kt], 0, 0, 0);
                s[bl][1][kt] = __builtin_amdgcn_mfma_f32_16x16x32_bf16(kf, qf[1][ks], s[bl][1][kt], 0, 0, 0);
            }
        } }
#pragma unroll
    for (int rg = 0; rg < 2; ++rg) {
        float ba = NEGF, bb = NEGF;
#pragma unroll
        for (int kt = 0; kt < 4; ++kt)
#pragma unroll
            for (int e = 0; e < 4; ++e) { ba = fmaxf(ba, s[0][rg][kt][e]); bb = fmaxf(bb, s[1][rg][kt][e]); }
        if (!selA[rg]) ba = NEGF;
        if (!selB[rg]) bb = NEGF;
        const float bm = xmax16(fmaxf(ba, bb));
        const float mnew = fmaxf(mrow[rg], bm), alpha = __builtin_amdgcn_exp2f(mrow[rg] - mnew);
        const bool moved = __builtin_amdgcn_ballot_w64(mnew != mrow[rg]) != 0ull;
        mrow[rg] = mnew;
        const float sa = selA[rg] ? mnew : 1e30f, sb = selB[rg] ? mnew : 1e30f;
        float ps = 0.f;
#pragma unroll
        for (int kt = 0; kt < 4; ++kt)
#pragma unroll
            for (int e = 0; e < 4; ++e) { const float pa = __builtin_amdgcn_exp2f(s[0][rg][kt][e] - sa), pb = __builtin_amdgcn_exp2f(s[1][rg][kt][e] - sb); s[0][rg][kt][e] = pa; s[1][rg][kt][e] = pb; ps += pa + pb; }
        lrow[rg] = lrow[rg] * alpha + ps;
        if (moved) {
#pragma unroll
            for (int dt = 0; dt < 4; ++dt) o[rg][dt] *= alpha;
        }
    }
#pragma unroll
    for (int bl = 0; bl < 2; ++bl) { const LAS unsigned char* Vb = bl ? VbB : VbA;
#pragma unroll
        for (int kk = 0; kk < 2; ++kk) {
            const bf16x8 pf0 = pack8(s[bl][0][2 * kk][0], s[bl][0][2 * kk][1], s[bl][0][2 * kk][2], s[bl][0][2 * kk][3], s[bl][0][2 * kk + 1][0], s[bl][0][2 * kk + 1][1], s[bl][0][2 * kk + 1][2], s[bl][0][2 * kk + 1][3]);
            const bf16x8 pf1 = pack8(s[bl][1][2 * kk][0], s[bl][1][2 * kk][1], s[bl][1][2 * kk][2], s[bl][1][2 * kk][3], s[bl][1][2 * kk + 1][0], s[bl][1][2 * kk + 1][1], s[bl][1][2 * kk + 1][2], s[bl][1][2 * kk + 1][3]);
#pragma unroll
            for (int dt = 0; dt < 4; ++dt) {
                const LAS unsigned char* va = Vb + (32 * kk + 4 * gq + (j >> 2)) * 128 + (16 * dt + 4 * (j & 3)) * 2;
                const bf16x8 vf = cat4(tr16(va), tr16(va + 16 * 128));
                o[0][dt] = __builtin_amdgcn_mfma_f32_16x16x32_bf16(vf, pf0, o[0][dt], 0, 0, 0);
                o[1][dt] = __builtin_amdgcn_mfma_f32_16x16x32_bf16(vf, pf1, o[1][dt], 0, 0, 0);
            }
        } }
}
__device__ __forceinline__ void glds16(const void* gsrc, unsigned lds_dst) { unsigned keep;
    asm volatile("s_mov_b32 %0, m0\n\ts_mov_b32 m0, %2\n\ts_nop 0\n\tglobal_load_lds_dwordx4 %1, off\n\ts_mov_b32 m0, %0" : "=&s"(keep) : "v"(gsrc), "s"(lds_dst) : "memory"); }
template <int MODE>
__device__ __forceinline__ void nsa_attend(const bf16* kv, unsigned long long mask, int b, int g, int c, int tid, int lane, LAS unsigned char* ring, const bf16x8 (&qf)[2][2],
                                           const unsigned long long (&rmask)[2], const unsigned long long (&gmask)[2], const int (&trow)[2], float (&mrow)[2], float (&lrow)[2], f32x4v (&o)[2][4]) {
    const int wave = __builtin_amdgcn_readfirstlane(tid >> 6);
    const int rr = 8 * wave + (lane >> 3);
    const bf16* gk = kv + (size_t)(b * SEQ + rr) * 256 + g * 64 + (((lane & 7) ^ (rr & 7)) << 3);
    const bf16* gv = kv + (size_t)(b * SEQ + rr) * 256 + 128 + g * 64 + ((lane & 7) << 3);
    const unsigned ring0 = (unsigned)(uintptr_t)(unsigned char*)ring + wave * 1024;
#define NSA_ISSUE(jb_, slot_) do { glds16(gk + (size_t)(jb_) * 64 * 256, (unsigned)__builtin_amdgcn_readfirstlane(ring0 + (slot_) * NSA_SLOT)); \
                                   glds16(gv + (size_t)(jb_) * 64 * 256, (unsigned)__builtin_amdgcn_readfirstlane(ring0 + (slot_) * NSA_SLOT + 8192)); } while (0)
    unsigned long long remi = mask, remc = mask; int lastb = 0, si = 0, sc_ = 0;
#if DUP == 12
    float m2_[2] = {NEGF, NEGF}, l2_[2] = {0.f, 0.f}; f32x4v o2_[2][4]; for (int rg = 0; rg < 2; ++rg) for (int dt = 0; dt < 4; ++dt) o2_[rg][dt] = (f32x4v){0.f, 0.f, 0.f, 0.f};
#endif
#define NSA_ISSUE1() do { if (remi) { lastb = (int)__builtin_ctzll(remi); remi &= remi - 1ull; } NSA_ISSUE(lastb, si); si = si + 1 == NSA_D ? 0 : si + 1; } while (0)
#define NSA_FLAGS(jj_, sel_, klo_, khi_, act_) do { _Pragma("unroll") for (int rg = 0; rg < 2; ++rg) { const int o6 = trow[rg] & 63; \
            if (MODE == 0) { sel_[rg] = (rmask[rg] >> (jj_)) & 1ull; act_[rg] = (gmask[rg] >> (jj_)) & 1ull; klo_[rg] = 0; khi_[rg] = ((jj_) == c) ? o6 : 63; } \
            else { sel_[rg] = true; act_[rg] = true; klo_[rg] = ((jj_) == c - 4) ? o6 + 1 : 0; khi_[rg] = ((jj_) == c) ? o6 : 63; } } } while (0)
    NSA_ISSUE1(); NSA_ISSUE1(); NSA_ISSUE1(); NSA_ISSUE1();
    while (remc) {
        const int jA = (int)__builtin_ctzll(remc); remc &= remc - 1ull;
        const bool two = remc != 0ull; const int jB = two ? (int)__builtin_ctzll(remc) : jA; if (two) remc &= remc - 1ull;
        asm volatile("s_waitcnt vmcnt(4) lgkmcnt(0)\n\ts_barrier" ::: "memory");
        NSA_ISSUE1(); NSA_ISSUE1();
        const LAS unsigned char* kA = ring + sc_ * NSA_SLOT; const LAS unsigned char* vA = kA + 8192; const LAS unsigned char* kB = kA + NSA_SLOT; const LAS unsigned char* vB = kB + 8192;
        sc_ = sc_ + 2 == NSA_D ? 0 : sc_ + 2;
        bool selA[2], selB[2], actA[2], actB[2]; int kloA[2], khiA[2], kloB[2], khiB[2];
        NSA_FLAGS(jA, selA, kloA, khiA, actA); NSA_FLAGS(jB, selB, kloB, khiB, actB);
        const bool fullA = (MODE == 0) ? (jA != c) : (jA != c && jA != c - 4), fullB = (MODE == 0) ? (jB != c) : (jB != c && jB != c - 4);
        const bool doA = actA[0] || actA[1], doB = two && (actB[0] || actB[1]);
        if (NSA_JOINT && MODE == 0 && doA && doB && fullA && fullB) nsa_block4(kA, vA, kB, vB, qf, selA, selB, mrow, lrow, o, lane);
        else {
            if (doA) { if (fullA) nsa_block2<true>(kA, vA, qf, selA, kloA, khiA, mrow, lrow, o, lane); else nsa_block2<false>(kA, vA, qf, selA, kloA, khiA, mrow, lrow, o, lane); }
            if (doB) { if (fullB) nsa_block2<true>(kB, vB, qf, selB, kloB, khiB, mrow, lrow, o, lane); else nsa_block2<false>(kB, vB, qf, selB, kloB, khiB, mrow, lrow, o, lane); }
        }
    }
#undef NSA_ISSUE1
#undef NSA_FLAGS
    asm volatile("s_waitcnt vmcnt(0) lgkmcnt(0)\n\ts_barrier" ::: "memory");
#undef NSA_ISSUE
}
#if defined(PROBE_CMP)
__device__ __forceinline__ void nsa_probe_store(unsigned char* ws, int row, int head, int gq, const f32x4v (&v)[4]) {
    bf16* pb_ = (bf16*)(ws + 497 * MiB);
    for (int dt = 0; dt < 4; ++dt) { uint2 w; w.x = cvtpk(v[dt][0], v[dt][1]); w.y = cvtpk(v[dt][2], v[dt][3]); *(uint2*)(pb_ + (size_t)row * 512 + head * 64 + 16 * dt + 4 * gq) = w; }
}
#endif
__device__ __forceinline__ void nsa_unit(unsigned char* ws, int unit, LAS unsigned char* lds, int tid_in, bf16* yout) {
    int tid = tid_in; asm volatile("" : "+v"(tid));
    const int lane = tid & 63, wave = __builtin_amdgcn_readfirstlane(tid >> 6), j = lane & 15, gq = lane >> 4;
    const int c = unit & 63, g = (unit >> 6) & 1, b = unit >> 7, bg = b * 2 + g;
    LAS float* impa = (LAS float*)(lds + NSA_OFF_IMPA); LAS float* impb = (LAS float*)(lds + NSA_OFF_IMPB);
    LAS unsigned long long* um = (LAS unsigned long long*)(lds + NSA_OFF_UM);
    TP_DECL
    for (int i = tid; i < 2 * 64 * 65; i += 512) impa[i] = 0.f;
    {
        const v4u* ksrc = (const v4u*)((const bf16*)(ws + WS_KC) + (size_t)bg * 256 * 64); const v4u* vsrc = (const v4u*)((const bf16*)(ws + WS_VC) + (size_t)bg * 64 * 256);
        v4u kst[4], vst[4];
#pragma unroll
        for (int i = 0; i < 4; ++i) { kst[i] = ksrc[tid + 512 * i]; vst[i] = vsrc[tid + 512 * i]; }
#pragma unroll
        for (int i = 0; i < 4; ++i) { const int idx = tid + 512 * i; const int r = idx >> 3, sg = idx & 7; *(LAS v4u*)(lds + NSA_OFF_KCL + r * 128 + ((sg ^ (r & 7)) << 4)) = kst[i]; }
#pragma unroll
        for (int i = 0; i < 4; ++i) { const int idx = tid + 512 * i; const int r = idx >> 5, sg = idx & 31; *(LAS v4u*)(lds + NSA_OFF_VCTL + r * 512 + ((sg ^ (r & 15)) << 4)) = vst[i]; }
    }
    bf16* qc = (bf16*)(ws + WS_QC);
    const bf16* misc = (const bf16*)(ws + WS_MISC);
    bf16x8 qf[2][2]; float gate[2][3]; int trow[2];
#pragma unroll
    for (int rg = 0; rg < 2; ++rg) {
        const int q = 8 * wave + 4 * rg + (j >> 2), t = 64 * c + q, row = b * SEQ + t, head = g * 4 + (j & 3);
        trow[rg] = t;
#pragma unroll
        for (int ks = 0; ks < 2; ++ks) qf[rg][ks] = *(const bf16x8*)(qc + (size_t)row * 512 + head * 64 + 8 * gq + 32 * ks);
        gate[rg][0] = __builtin_amdgcn_rcpf(1.0f + __expf(-bf2f(misc[(size_t)row * 256 + 196 + head * 3])));
    }
    typedef unsigned u32x2v __attribute__((ext_vector_type(2)));
    LAS u32x2v* stash = (LAS u32x2v*)(lds + NSA_OFF_ST) + tid * 8;
    __syncthreads();
    const int nT = (c >> 2) + 1;
#pragma unroll
    for (int rg = 0; rg < 2; ++rg) {
        const int t = trow[rg], nv = t >= 31 ? ((t - 15) >> 4) : 0;
        f32x4v s[16]; float mx = NEGF;
#pragma unroll
        for (int T = 0; T < 16; ++T) {
            s[T] = (f32x4v){0.f, 0.f, 0.f, 0.f};
            if (T < nT) {
#pragma unroll
                for (int ks = 0; ks < 2; ++ks) { const bf16x8 kf = *(const LAS bf16x8*)(lds + NSA_OFF_KCL + (16 * T + j) * 128 + (((gq + 4 * ks) ^ (j & 7)) << 4)); s[T] = __builtin_amdgcn_mfma_f32_16x16x32_bf16(kf, qf[rg][ks], s[T], 0, 0, 0); }
#pragma unroll
                for (int e = 0; e < 4; ++e) { const float v = (16 * T + 4 * gq + e < nv) ? s[T][e] : NEGF; s[T][e] = v; mx = fmaxf(mx, v); }
            }
        }
        mx = xmax16(mx);
        float ls = 0.f;
#pragma unroll
        for (int T = 0; T < 16; ++T) if (T < nT) {
#pragma unroll
            for (int e = 0; e < 4; ++e) { const float p = (16 * T + 4 * gq + e < nv) ? __builtin_amdgcn_exp2f(s[T][e] - mx) : 0.f; s[T][e] = p; ls += p; }
        }
        ls = xsum16(ls);
        const float inv = nv > 0 ? __builtin_amdgcn_rcpf(ls) : 0.f;
        const int q = 8 * wave + 4 * rg + (j >> 2);
#pragma unroll
        for (int T = 0; T < 16; ++T) if (T < nT) {
#pragma unroll
            for (int e = 0; e < 4; ++e) s[T][e] *= inv;
            float a = s[T][0] + s[T][1] + s[T][2] + 0.5f * s[T][3], bb = 0.5f * s[T][3];
            a += qxor1(a); a += qxor2(a); bb += qxor1(bb); bb += qxor2(bb);
            if ((j & 3) == 0) { impa[q * 65 + 4 * T + gq] = a; impb[q * 65 + 4 * T + gq + 1] = bb; }
        }
        f32x4v oc[4];
#pragma unroll
        for (int dt = 0; dt < 4; ++dt) oc[dt] = (f32x4v){0.f, 0.f, 0.f, 0.f};
#pragma unroll
        for (int kk = 0; kk < 8; ++kk) if (2 * kk < nT) {
            const bf16x8 pf = pack8(s[2 * kk][0], s[2 * kk][1], s[2 * kk][2], s[2 * kk][3], s[2 * kk + 1][0], s[2 * kk + 1][1], s[2 * kk + 1][2], s[2 * kk + 1][3]);
#pragma unroll
            for (int dt = 0; dt < 4; ++dt) {
                const LAS unsigned char* vp = lds + NSA_OFF_VCTL + (16 * dt + j) * 512 + (gq & 1) * 8;
                const s16x4 v0 = *(const LAS s16x4*)(vp + ((((8 * kk + gq) >> 1) ^ j) << 4)), v1 = *(const LAS s16x4*)(vp + (((((8 * kk + gq) >> 1) + 2) ^ j) << 4));
                oc[dt] = __builtin_amdgcn_mfma_f32_16x16x32_bf16(cat4(v0, v1), pf, oc[dt], 0, 0, 0);
            }
        }
#pragma unroll
        for (int dt = 0; dt < 4; ++dt) { const f32x4v v = oc[dt] * gate[rg][0]; u32x2v w; w.x = pg8::cvt_pk_bf16(v[0], v[1]); w.y = pg8::cvt_pk_bf16(v[2], v[3]); stash[rg * 4 + dt] = w; }
        __builtin_amdgcn_sched_barrier(0);
    }
    __syncthreads();
    TP_MARK(5);
    unsigned long long smask[8], mymask = 0ull;
#pragma unroll
    for (int qi = 0; qi < 8; ++qi) {
        const int q = 8 * wave + qi;
#if PROBE == 4
        const float imp = ((const float*)(ws + 500 * MiB))[((size_t)(b * SEQ + 64 * c + q) * 2 + g) * 64 + lane];
#else
        const float imp = impa[q * 65 + lane] + impb[q * 65 + lane];
#endif
#if PROBE && (PROBE != 5 || defined(PROBE5_IMP))
        ((float*)(ws + 516 * MiB))[((size_t)(b * SEQ + 64 * c + q) * 2 + g) * 64 + lane] = (lane <= c) ? imp : 0.f;
#endif
        const bool forced = (lane == 0) || (lane == c), adm = lane <= c;
        unsigned key = forced ? (0xFFFFFF00u | (unsigned)(63 - lane)) : (adm ? ((__float_as_uint(imp) & 0xFFFFFFC0u) | (unsigned)(63 - lane)) : 0u);
        unsigned long long mk = 0ull;
#if TOP8_RANK
        { int rank = 0;
#pragma unroll
          for (int jj = 0; jj < 64; ++jj) { const unsigned kk = (unsigned)__builtin_amdgcn_readlane((int)key, jj); rank += (kk > key) ? 1 : 0; }
          mk = __ballot(key != 0u && rank < 8); }
#else
        for (int k = 0; k < 8; ++k) { const unsigned mx = wave_max_u(key); if (mx == 0u) break; const int win = 63 - (int)(mx & 63u); mk |= 1ull << win; if (lane == win) key = 0u; }
#endif
        mk = ((unsigned long long)(unsigned)__builtin_amdgcn_readfirstlane((unsigned)(mk >> 32)) << 32) | (unsigned long long)(unsigned)__builtin_amdgcn_readfirstlane((unsigned)mk);
#ifdef FIXSEL
        { mk = 1ull | (1ull << c); for (int d = 1; d <= 6; ++d) mk |= 1ull << (((FIXHOM ? 0 : q * 7) + d * 5) % (c + 1)); }
#endif
#if PROBE == 2
        mk = ((const unsigned long long*)(ws + 496 * MiB))[(size_t)(b * SEQ + 64 * c + q) * 2 + g];
        mk = ((unsigned long long)(unsigned)__builtin_amdgcn_readfirstlane((unsigned)(mk >> 32)) << 32) | (unsigned long long)(unsigned)__builtin_amdgcn_readfirstlane((unsigned)mk);
#endif
#if PROBE == 5
        if (lane == 0) ((unsigned long long*)(ws + 498 * MiB))[(size_t)(b * SEQ + 64 * c + q) * 2 + g] = mk;
#endif
#if PROBE == 5 && !defined(PROBE5_IMP)
        ((float*)(ws + 516 * MiB))[((size_t)(b * SEQ + 64 * c + q) * 2 + g) * 64 + lane] = ((mk >> lane) & 1ull) ? 1.f : 0.f;
#endif
        smask[qi] = mk; mymask |= mk;
    }
    if (lane == 0) um[wave] = mymask;
    __syncthreads();
    unsigned long long umask = 0ull;
#pragma unroll
    for (int w = 0; w < 8; ++w) umask |= um[w];
    umask = ((unsigned long long)(unsigned)__builtin_amdgcn_readfirstlane((unsigned)(umask >> 32)) << 32) | (unsigned long long)(unsigned)__builtin_amdgcn_readfirstlane((unsigned)umask);
    unsigned long long rmask[2];
    { LAS unsigned long long* qm = (LAS unsigned long long*)(lds + NSA_OFF_QM);
      __syncthreads();
#pragma unroll
      for (int qi = 0; qi < 8; ++qi) if (lane == 0) qm[8 * wave + qi] = smask[qi];
      __syncthreads();
#pragma unroll
      for (int rg = 0; rg < 2; ++rg) rmask[rg] = qm[8 * wave + 4 * rg + (j >> 2)]; }
    const unsigned long long gmask[2] = {smask[0] | smask[1] | smask[2] | smask[3], smask[4] | smask[5] | smask[6] | smask[7]};
    TP_MARK(6); TP_ADD(9, __popcll(umask)); TP_ADD(10, 1); TP_ADD(11, c + 1); TP_ADD(12, __popcll(umask & ~(c == 63 ? ~0ull : ((2ull << c) - 1ull)))); TP_ADD(13, __popcll(smask[0]));
    const bf16* kvs = (const bf16*)(ws + WS_KVS); const bf16* kvw = (const bf16*)(ws + WS_KVW);
    LAS unsigned char* ring = lds + NSA_OFF_RING;
    {
        float mrow[2] = {NEGF, NEGF}, lrow[2] = {0.f, 0.f}; f32x4v o[2][4];
#pragma unroll
        for (int rg = 0; rg < 2; ++rg)
#pragma unroll
            for (int dt = 0; dt < 4; ++dt) o[rg][dt] = (f32x4v){0.f, 0.f, 0.f, 0.f};
        nsa_attend<0>(kvs, umask, b, g, c, tid, lane, ring, qf, rmask, gmask, trow, mrow, lrow, o);
#if DUP == 8
        { __syncthreads(); float m2[2] = {NEGF, NEGF}, l2[2] = {0.f, 0.f}; f32x4v o2[2][4];
          for (int rg = 0; rg < 2; ++rg) for (int dt = 0; dt < 4; ++dt) o2[rg][dt] = (f32x4v){0.f, 0.f, 0.f, 0.f};
          nsa_attend<0>(kvs, umask, b, g, c, tid, lane, Kb, Vb, qf, rmask, gmask, trow, m2, l2, o2);
          bf16* dmy = (bf16*)(ws + WS_BU) + (size_t)(b * SEQ + trow[0]) * 512 + (g * 4 + (j & 3)) * 64 + 4 * gq;
          for (int rg = 0; rg < 2; ++rg) for (int dt = 0; dt < 4; ++dt) { uint2 w; w.x = pg8::cvt_pk_bf16(o2[rg][dt][0] + l2[rg], o2[rg][dt][1]); w.y = pg8::cvt_pk_bf16(o2[rg][dt][2], o2[rg][dt][3]); *(uint2*)(dmy + 16 * dt) = w; } }
#endif
        const int lf1_ = lane_id_v(), jf1_ = lf1_ & 15;
#pragma unroll
        for (int rg = 0; rg < 2; ++rg) { const float g1_ = __builtin_amdgcn_rcpf(1.0f + __expf(-bf2f(misc[(size_t)(b * SEQ + 64 * c + 8 * wave + 4 * rg + (jf1_ >> 2)) * 256 + 196 + (g * 4 + (jf1_ & 3)) * 3 + 1]))); const float sc = g1_ * __builtin_amdgcn_rcpf(xsum16(lrow[rg]));
#pragma unroll
            for (int dt = 0; dt < 4; ++dt) { const u32x2v p = stash[rg * 4 + dt]; const f32x4v v = o[rg][dt] * sc; u32x2v w; w.x = pg8::cvt_pk_bf16(v[0] + bflo(p.x), v[1] + bfhi(p.x)); w.y = pg8::cvt_pk_bf16(v[2] + bflo(p.y), v[3] + bfhi(p.y)); stash[rg * 4 + dt] = w; }
            }
        __syncthreads();
    }
    TP_MARK(7);
    {
        float mrow[2] = {NEGF, NEGF}, lrow[2] = {0.f, 0.f}; f32x4v o[2][4];
#pragma unroll
        for (int rg = 0; rg < 2; ++rg)
#pragma unroll
            for (int dt = 0; dt < 4; ++dt) o[rg][dt] = (f32x4v){0.f, 0.f, 0.f, 0.f};
        { const int j0 = c - 4 > 0 ? c - 4 : 0; const unsigned long long wmask = ((c == 63 ? ~0ull : ((1ull << (c + 1)) - 1ull)) >> j0) << j0;
          nsa_attend<1>(kvw, wmask, b, g, c, tid, lane, ring, qf, rmask, gmask, trow, mrow, lrow, o); }
        const int lf2_ = lane_id_v(), jf2_ = lf2_ & 15, gf2_ = lf2_ >> 4;
#pragma unroll
        for (int rg = 0; rg < 2; ++rg) { const float g2_ = __builtin_amdgcn_rcpf(1.0f + __expf(-bf2f(misc[(size_t)(b * SEQ + 64 * c + 8 * wave + 4 * rg + (jf2_ >> 2)) * 256 + 196 + (g * 4 + (jf2_ & 3)) * 3 + 2]))); const float sc = g2_ * __builtin_amdgcn_rcpf(xsum16(lrow[rg]));
#pragma unroll
            for (int dt = 0; dt < 4; ++dt) { const u32x2v p = stash[rg * 4 + dt]; const f32x4v v = o[rg][dt] * sc; uint2 w; w.x = pg8::cvt_pk_bf16(v[0] + bflo(p.x), v[1] + bfhi(p.x)); w.y = pg8::cvt_pk_bf16(v[2] + bflo(p.y), v[3] + bfhi(p.y));
                *(uint2*)(yout + (size_t)(b * SEQ + 64 * c + 8 * wave + 4 * rg + (jf2_ >> 2)) * 512 + (g * 4 + (jf2_ & 3)) * 64 + 16 * dt + 4 * gf2_) = w; }
            }
    }
    __syncthreads();
    TP_MARK(8);
}
__device__ __forceinline__ void prep_kva16(unsigned char* ws, int task, int lane) {
    const int j = lane & 15, gq = lane >> 4, row = task * 16 + j;
    const bf16* misc = (const bf16*)(ws + WS_MISC) + (size_t)row * 256 + 64;
    const bf16* wu = (const bf16*)(ws + WS_W + WO_UKV);
    bf16x8 cf[4]; float ss = 0.f;
#pragma unroll
    for (int ks = 0; ks < 4; ++ks) { const v4u v = *(const v4u*)(misc + 8 * gq + 32 * ks); cf[ks] = __builtin_bit_cast(bf16x8, v); float f[8]; unpack8(v, f);
#pragma unroll
        for (int e = 0; e < 8; ++e) ss += f[e] * f[e]; }
    ss = xsum16(ss);
    const float r = 1.0f / sqrtf(ss * (1.f / 128.f) + EPS);
    const float* rp = (const float*)(ws + WS_ROPE) + (size_t)row * 16;
    bf16* o = (bf16*)(ws + WS_KVA) + (size_t)row * 128;
#pragma unroll
    for (int ct = 0; ct < 8; ++ct) {
        f32x4v a = {0.f, 0.f, 0.f, 0.f};
#pragma unroll
        for (int ks = 0; ks < 4; ++ks) { const bf16x8 wf = *(const bf16x8*)(wu + (size_t)(16 * ct + j) * 128 + 8 * gq + 32 * ks); a = __builtin_amdgcn_mfma_f32_16x16x32_bf16(wf, cf[ks], a, 0, 0, 0); }
        a *= r;
        if (ct == 0) {
            const float c0 = rp[2 * gq], s0 = rp[8 + 2 * gq], c1 = rp[2 * gq + 1], s1 = rp[8 + 2 * gq + 1];
            const float x0 = a[0], x1 = a[1], x2 = a[2], x3 = a[3];
            a[0] = x0 * c0 - x1 * s0; a[1] = x1 * c0 + x0 * s0; a[2] = x2 * c1 - x3 * s1; a[3] = x3 * c1 + x2 * s1;
        }
        uint2 w; w.x = cvtpk(a[0], a[1]); w.y = cvtpk(a[2], a[3]);
        *(uint2*)(o + 16 * ct + 4 * gq) = w;
    }
}
__device__ __forceinline__ void prep_pool16(unsigned char* ws, int task, int lane, const LAS unsigned char* wl, bf16* ybuf) {
    const int j = lane & 15, gq = lane >> 4, row = task * 16 + j, t = row & (SEQ - 1);
    const bf16* bu = (const bf16*)(ws + WS_BU);
    bf16* yb = ybuf + (size_t)row * 512;
#pragma unroll 1
    for (int g = 0; g < 4; ++g) {
        const int w = 2 << g, lo = (t + 1 - w) > 0 ? (t + 1 - w) : 0, cnt = t + 1 - lo; const float inv = 1.0f / (float)cnt;
        bf16x8 pf[4];
#pragma unroll
        for (int ks = 0; ks < 4; ++ks) {
            const bf16* p = bu + (size_t)row * 512 + g * 128 + 8 * gq + 32 * ks;
            float sum[8] = {0.f, 0.f, 0.f, 0.f, 0.f, 0.f, 0.f, 0.f}, cur[8];
            { const v4u v = *(const v4u*)p; unpack8(v, cur);
#pragma unroll
              for (int e = 0; e < 8; ++e) sum[e] = cur[e]; }
            v4u wv_[15];
#pragma unroll
            for (int i = 1; i < 16; ++i) if (i < w) wv_[i - 1] = *(const v4u*)(p - (size_t)(i < cnt ? i : 0) * 512);
#pragma unroll
            for (int i = 1; i < 16; ++i) if (i < w) { const bool ok = i < cnt; float f[8]; unpack8(wv_[i - 1], f);
#pragma unroll
                for (int e = 0; e < 8; ++e) sum[e] += ok ? f[e] : 0.f; }
            __builtin_amdgcn_sched_barrier(0);
            pf[ks] = pack8(sum[0] * inv - cur[0], sum[1] * inv - cur[1], sum[2] * inv - cur[2], sum[3] * inv - cur[3], sum[4] * inv - cur[4], sum[5] * inv - cur[5], sum[6] * inv - cur[6], sum[7] * inv - cur[7]);
        }
#pragma unroll
        for (int dt = 0; dt < 8; ++dt) {
            f32x4v a = {0.f, 0.f, 0.f, 0.f};
#pragma unroll
            for (int ks = 0; ks < 4; ++ks) {
#if POOLDBG == 1
                bf16x8 wf; for (int e = 0; e < 8; ++e) wf[e] = (short)0x3c00;
#else
                const bf16x8 wf = *(const LAS bf16x8*)(wl + (g * 128 + 16 * dt + j) * 256 + (((gq + 4 * ks) ^ j) << 4));
#endif
#if POOLDBG == 2
                bf16x8 pz; for (int e = 0; e < 8; ++e) pz[e] = (short)0x3c00; a = __builtin_amdgcn_mfma_f32_16x16x32_bf16(wf, pz, a, 0, 0, 0);
#else
                a = __builtin_amdgcn_mfma_f32_16x16x32_bf16(wf, pf[ks], a, 0, 0, 0);
#endif
            }
            uint2 wv; wv.x = cvtpk(a[0], a[1]); wv.y = cvtpk(a[2], a[3]);
            *(uint2*)(yb + g * 128 + 16 * dt + 4 * gq) = wv;
        }
    }
}
__device__ __forceinline__ float gelu_tanh_f(float x) { const float u = 0.7978845608028654f * (x + 0.044715f * x * x * x); const float e = __expf(2.0f * u); return 0.5f * x * (1.0f + (1.0f - 2.0f / (e + 1.0f))); }
__device__ __forceinline__ void prep_cmp16(unsigned char* ws, int task, LAS unsigned char* lds, int wave, int lane) {
    const int j = lane & 15, gq = lane >> 4, grp = wave >> 2, wq = wave & 3;
    const int i0 = (task & 15) * 16, bg = (task >> 4) & 15, br = task >> 8, b = bg >> 1, g = bg & 1, i = i0 + j;
    const bf16* kvc = (const bf16*)(ws + WS_KVC);
    const bf16* w1 = (const bf16*)(ws + WS_W + WO_CW1) + (size_t)br * 128 * 2048;
    const bf16* w2 = (const bf16*)(ws + WS_W + WO_CW2) + (size_t)br * 64 * 128;
    const float* posb = (const float*)(ws + WS_W + WO_POSB) + br * 128;
    LAS float* part = (LAS float*)(lds + (size_t)grp * 4 * 16384);
    LAS unsigned char* wst = lds + wave * 16384;
    f32x4v h[8];
#pragma unroll
    for (int nt = 0; nt < 8; ++nt) h[nt] = (f32x4v){0.f, 0.f, 0.f, 0.f};
#define CMP_DMA(p_) do { _Pragma("unroll") for (int i_ = 0; i_ < 16; ++i_) { const int r_ = 8 * i_ + (lane >> 3); \
        __builtin_amdgcn_global_load_lds((const unsigned*)(w1 + (size_t)r_ * 2048 + 512 * wq + 64 * (p_) + (((lane & 7) ^ (r_ & 7)) << 3)), (LAS unsigned*)(wst + i_ * 1024), 16, 0, 0); } } while (0)
#define CMP_FF(p_, fa_, fb_) do { int tok_ = 16 * i + 8 * wq + (p_); tok_ = tok_ > SEQ - 1 ? SEQ - 1 : tok_;     \
        const bf16* fp_ = kvc + (size_t)(b * SEQ + tok_) * 256 + br * 128 + g * 64 + 8 * gq; fa_ = *(const bf16x8*)fp_; fb_ = *(const bf16x8*)(fp_ + 32); } while (0)
    bf16x8 ffA, ffB;
    CMP_DMA(0); CMP_FF(0, ffA, ffB);
#pragma unroll 1
    for (int p = 0; p < 8; ++p) {
        bf16x8 wf[2][8];
#pragma unroll
        for (int hh = 0; hh < 2; ++hh)
#pragma unroll
            for (int nt = 0; nt < 8; ++nt) wf[hh][nt] = *(const LAS bf16x8*)(wst + (16 * nt + j) * 128 + (((gq + 4 * hh) ^ (j & 7)) << 4));
        const bf16x8 fa = ffA, fb = ffB;
        asm volatile("s_waitcnt lgkmcnt(0)" ::: "memory");
        if (p + 1 < 8) { CMP_DMA(p + 1); CMP_FF(p + 1, ffA, ffB); }
#pragma unroll
        for (int nt = 0; nt < 8; ++nt) { h[nt] = __builtin_amdgcn_mfma_f32_16x16x32_bf16(wf[0][nt], fa, h[nt], 0, 0, 0); h[nt] = __builtin_amdgcn_mfma_f32_16x16x32_bf16(wf[1][nt], fb, h[nt], 0, 0, 0); }
    }
#undef CMP_DMA
#undef CMP_FF
#pragma unroll
    for (int nt = 0; nt < 8; ++nt)
#pragma unroll
        for (int e = 0; e < 4; ++e) part[wq * 4096 + (nt * 4 + e) * 64 + lane] = h[nt][e];
    f32x4v pbv_[8];
#pragma unroll
    for (int nt = 0; nt < 8; ++nt) pbv_[nt] = *(const f32x4v*)(posb + 16 * nt + 4 * gq) + *(const f32x4v*)(posb + 256 + 16 * nt + 4 * gq);

    __syncthreads();
    if (wq == 0) {
#pragma unroll
        for (int nt = 0; nt < 8; ++nt) { const f32x4v pbv = pbv_[nt];
#pragma unroll
            for (int e = 0; e < 4; ++e) { const int idx = (nt * 4 + e) * 64 + lane; h[nt][e] = gelu_tanh_f(((part[idx] + part[4096 + idx]) + (part[2 * 4096 + idx] + part[3 * 4096 + idx])) + pbv[e]); } }
        f32x4v o[4];
#pragma unroll
        for (int dt = 0; dt < 4; ++dt) o[dt] = (f32x4v){0.f, 0.f, 0.f, 0.f};
        s16x4 w2a[4][4], w2b[4][4];
#pragma unroll
        for (int kk = 0; kk < 4; ++kk)
#pragma unroll
            for (int dt = 0; dt < 4; ++dt) { const bf16* wp = w2 + (size_t)(16 * dt + j) * 128 + 32 * kk + 4 * gq; w2a[kk][dt] = *(const s16x4*)wp; w2b[kk][dt] = *(const s16x4*)(wp + 16); }
        __builtin_amdgcn_sched_barrier(0);
#pragma unroll
        for (int kk = 0; kk < 4; ++kk) {
            const bf16x8 hf = pack8(h[2 * kk][0], h[2 * kk][1], h[2 * kk][2], h[2 * kk][3], h[2 * kk + 1][0], h[2 * kk + 1][1], h[2 * kk + 1][2], h[2 * kk + 1][3]);
#pragma unroll
            for (int dt = 0; dt < 4; ++dt) o[dt] = __builtin_amdgcn_mfma_f32_16x16x32_bf16(cat4(w2a[kk][dt], w2b[kk][dt]), hf, o[dt], 0, 0, 0);
        }
        const bool dead = i == 255;
        if (br == 0) { bf16* kc = (bf16*)(ws + WS_KC) + ((size_t)bg * 256 + i) * 64;
#pragma unroll
            for (int dt = 0; dt < 4; ++dt) { uint2 w; w.x = dead ? 0u : cvtpk(o[dt][0], o[dt][1]); w.y = dead ? 0u : cvtpk(o[dt][2], o[dt][3]); *(uint2*)(kc + 16 * dt + 4 * gq) = w; }
        } else { bf16* vct = (bf16*)(ws + WS_VC) + (size_t)bg * 64 * 256 + i;
#pragma unroll
            for (int dt = 0; dt < 4; ++dt)
#pragma unroll
                for (int e = 0; e < 4; ++e) vct[(size_t)(16 * dt + 4 * gq + e) * 256] = dead ? (bf16)0 : (bf16)f2bf(o[dt][e]);
        }
    }
    __syncthreads();
}
__device__ __forceinline__ void phase_prep(const Args& P, unsigned char* ws, int z, int l, LAS unsigned char* lds, int gw, int NGW, int lane, int wave, bf16* ybuf) {
    asm volatile("" : "+v"(lane)); lane &= 63; asm volatile("" : "+s"(gw), "+s"(NGW));
#if TPROBE
    const int tid = (wave << 6) | lane; unsigned long long tp_t_ = __builtin_amdgcn_s_memtime();
#endif
    for (int it = 2 * (gw >> 3) + (wave >> 2); it < 512 + (wave >> 2); it += 2 * (NGW >> 3)) prep_cmp16(ws, it < 512 ? it : 511, lds, wave, lane);
    TP_MARK(27);
    {
        const v4u* src = (const v4u*)(ws + WS_W + WO_POOL); const int t_ = (wave << 6) | lane;
        v4u pst[16];
#pragma unroll
        for (int i = 0; i < 16; ++i) pst[i] = src[t_ + 512 * i];
#pragma unroll
        for (int i = 0; i < 16; ++i) { const int idx = t_ + 512 * i, r = idx >> 4, sg = idx & 15; *(LAS v4u*)(lds + r * 256 + ((sg ^ (r & 15)) << 4)) = pst[i]; }
        __syncthreads();
    }
    TP_MARK(28);
    for (int it = gw; it < M / 16; it += NGW) { prep_kva16(ws, it, lane); TP_MARK(29); prep_pool16(ws, it, lane, lds, ybuf); }
    __syncthreads();
    TP_MARK(31);
}
#ifndef DSA_HIST
#define DSA_HIST 0
#endif
constexpr int DSA_K = DSA_HIST ? 16 : DSA_K_V, DSA_S = 32 - DSA_K, DSA_CAP = DSA_CAP_V;
constexpr int DSA_OFF_CNT = 0, DSA_OFF_PC = 3072, DSA_OFF_LIST = DSA_OFF_PC + 32 * 16 * 4, DSA_OFF_V = DSA_OFF_LIST + 16 * 256 * 2, DSA_VB = 64 * NSA_VSTR * 2, DSA_LDS = DSA_OFF_V + 8 * DSA_VB;
#define DSA_FOR_TILES(...) _Pragma("unroll") for (int G8 = 0; G8 < 8; ++G8) { if (G8 < ngrp) { _Pragma("unroll") for (int T8 = 0; T8 < 4; ++T8) { const int T = G8 * 4 + T8; __VA_ARGS__ } } }
__device__ __forceinline__ void cnt_ge(int& c, unsigned u, unsigned cand) { asm volatile("v_cmp_ge_u32_e32 vcc, %1, %2\n\tv_addc_co_u32_e32 %0, vcc, 0, %0, vcc" : "+v"(c) : "v"(u), "v"(cand) : "vcc"); }
__device__ __forceinline__ void cnt_gt(int& c, unsigned u, unsigned cand) { asm volatile("v_cmp_gt_u32_e32 vcc, %1, %2\n\tv_addc_co_u32_e32 %0, vcc, 0, %0, vcc" : "+v"(c) : "v"(u), "v"(cand) : "vcc"); }
__device__ __forceinline__ void cnt_le(int& c, unsigned u, unsigned cand) { asm volatile("v_cmp_le_u32_e32 vcc, %1, %2\n\tv_addc_co_u32_e32 %0, vcc, 0, %0, vcc" : "+v"(c) : "v"(u), "v"(cand) : "vcc"); }
__device__ __forceinline__ int dsa_total(LAS unsigned* cnt, int par, int wave, int j, int gq, int c) {
    c += __shfl_xor(c, 16); c += __shfl_xor(c, 32);
    if (gq == 0) cnt[(par * 8 + wave) * 16 + j] = (unsigned)c;
    __syncthreads();
    int tot = 0;
#pragma unroll
    for (int w = 0; w < 8; ++w) tot += (int)cnt[(par * 8 + w) * 16 + j];
    return tot;
}
__device__ __forceinline__ void dsa_unit(unsigned char* ws, int unit, LAS unsigned char* lds, int tid_in, bf16* yout) {
    int tid = tid_in; asm volatile("" : "+v"(tid));
    const int lane = tid & 63, wave = __builtin_amdgcn_readfirstlane(tid >> 6), j = lane & 15, gq = lane >> 4;
    const int b = unit >> 8, q0 = (unit & 255) * 16, t = q0 + j, row = b * SEQ + t;
    LAS unsigned* cnt = (LAS unsigned*)(lds + DSA_OFF_CNT); LAS unsigned* pc = (LAS unsigned*)(lds + DSA_OFF_PC);
    LAS unsigned short* list = (LAS unsigned short*)(lds + DSA_OFF_LIST);
    const bf16* misc = (const bf16*)(ws + WS_MISC);
    TP_DECL
    if (q0 >= 256) {
        const int ntiles = (q0 >> 4) + 1;
        const int ntl = wave < ntiles ? ((ntiles - 1 - wave) >> 3) + 1 : 0;
        const int ngrp = (ntl + 3) >> 2;
        bf16x8 qf[4][2]; float iw[4];
        { const bf16* iq = (const bf16*)(ws + WS_IQ) + (size_t)row * 256;
#pragma unroll
          for (int h = 0; h < 4; ++h) { iw[h] = 0.5f * bf2f(misc[(size_t)row * 256 + 192 + h]);
#pragma unroll
              for (int ks = 0; ks < 2; ++ks) qf[h][ks] = *(const bf16x8*)(iq + h * 64 + 8 * gq + 32 * ks); } }
        unsigned u[32][4];
#pragma unroll
        for (int T = 0; T < 32; ++T)
#pragma unroll
            for (int e = 0; e < 4; ++e) u[T][e] = 0u;
        LAS unsigned* h0e = (LAS unsigned*)(lds + DSA_OFF_V + 8 * 16384);
        for (int i_ = tid; i_ < 4096; i_ += 512) h0e[i_] = 0u;
        __syncthreads();
        const int kb0 = 16 * wave + 4 * gq;
        LAS unsigned char* ring = lds + DSA_OFF_V + wave * 16384;
#define DSA_ISSUE(Ti) do { _Pragma("unroll") for (int i_ = 0; i_ < 2; ++i_) { const int r_ = 8 * i_ + (lane >> 3); int kr_ = 16 * wave + 128 * (Ti) + r_; kr_ = kr_ > SEQ - 1 ? SEQ - 1 : kr_; \
            __builtin_amdgcn_global_load_lds((const unsigned*)(misc + (size_t)(b * SEQ + kr_) * 256 + (((lane & 7) ^ (r_ & 7)) << 3)), (LAS unsigned*)(ring + ((Ti) & 7) * 2048 + i_ * 1024), 16, 0, 0); } } while (0)
        if (ngrp > 0) {
#pragma unroll
            for (int T = 0; T < 8; ++T) DSA_ISSUE(T);
        }
        DSA_FOR_TILES(
            asm volatile("s_waitcnt vmcnt(14)" ::: "memory");
            const LAS unsigned char* tp = ring + (T & 7) * 2048 + j * 128;
            const bf16x8 kf0 = *(const LAS bf16x8*)(tp + ((gq ^ (j & 7)) << 4)); const bf16x8 kf1 = *(const LAS bf16x8*)(tp + (((gq + 4) ^ (j & 7)) << 4));
            asm volatile("s_waitcnt lgkmcnt(0)" ::: "memory");
            DSA_ISSUE(T + 8);
            float sc[4] = {0.f, 0.f, 0.f, 0.f};
            _Pragma("unroll") for (int h = 0; h < 4; ++h) {
                f32x4v a = {0.f, 0.f, 0.f, 0.f};
                a = __builtin_amdgcn_mfma_f32_16x16x32_bf16(kf0, qf[h][0], a, 0, 0, 0);
                a = __builtin_amdgcn_mfma_f32_16x16x32_bf16(kf1, qf[h][1], a, 0, 0, 0);
                _Pragma("unroll") for (int e = 0; e < 4; ++e) { const int ai_ = (int)__float_as_uint(a[e]); sc[e] += iw[h] * __uint_as_float((unsigned)(ai_ > 0 ? ai_ : 0)); }
                asm volatile("" : "+v"(sc[0]), "+v"(sc[1]), "+v"(sc[2]), "+v"(sc[3]));
            }
            _Pragma("unroll") for (int e = 0; e < 4; ++e) { unsigned x = f2o(sc[e]); asm volatile("" : "+v"(x)); x = (kb0 + 128 * T + e <= t) ? x : 0u; u[T][e] = x; \
                __hip_atomic_fetch_add(h0e + j * 256 + (x >> 24), x < 1u ? x : 1u, __ATOMIC_RELAXED, __HIP_MEMORY_SCOPE_WORKGROUP); }
        )
        asm volatile("s_waitcnt vmcnt(0)" ::: "memory");
#undef DSA_ISSUE
        TP_MARK(0);
        {
        const int lane2_ = lane_id_v(); const int lane = lane2_, j = lane2_ & 15, gq = lane2_ >> 4, t = q0 + j, kb0 = 16 * wave + 4 * gq, tid = (wave << 6) | lane2_;
        unsigned prefix = 0u; bool exact = false; int par = 0; int cab = 0;
        LAS unsigned* lcnt = (LAS unsigned*)(lds + DSA_OFF_V); LAS unsigned* lcab = lcnt + 16; LAS unsigned* lvst = lcnt + 32; LAS unsigned* lexf = lcnt + 48; LAS unsigned* llist = lcnt + 64;
#if DSA_HIST
        {
            const int lh_ = lane_id_v(), jh_ = lh_ & 15;
            LAS unsigned* h0 = (LAS unsigned*)(lds + DSA_OFF_V + 8 * 16384); LAS unsigned* h1 = (LAS unsigned*)(lds + DSA_OFF_V + 256 + 16 * DSA_CAP * 4); LAS unsigned* lsel = cnt + 512; LAS unsigned* labv = cnt + 528;
            __syncthreads();
            for (int i = tid; i < 4096; i += 512) h1[i] = 0u;
            if (tid < 16) lcnt[tid] = 0u;
            __syncthreads();
#define DSA_SCAN(H_, NEED_, BIN_, ABV_) do { const LAS unsigned* hq_ = (H_) + 4 * lh_; const unsigned hx_ = hq_[0], hy_ = hq_[1], hz_ = hq_[2], hw_ = hq_[3]; const int s_ = (int)(hx_ + hy_ + hz_ + hw_); int S_ = s_; \
                _Pragma("unroll") for (int d_ = 1; d_ < 64; d_ <<= 1) { const int t_ = __shfl_down(S_, d_); S_ += (lh_ + d_ < 64) ? t_ : 0; }        \
                const unsigned long long m_ = __ballot(S_ >= (NEED_)); const int L_ = __builtin_amdgcn_readfirstlane(63 - (int)__builtin_clzll(m_ | 1ull)); \
                int acc_ = S_ - s_, sel_, ab_; \
                if (acc_ + (int)hw_ >= (NEED_)) { sel_ = 3; ab_ = acc_; } else { acc_ += (int)hw_; if (acc_ + (int)hz_ >= (NEED_)) { sel_ = 2; ab_ = acc_; } else { acc_ += (int)hz_; if (acc_ + (int)hy_ >= (NEED_)) { sel_ = 1; ab_ = acc_; } else { acc_ += (int)hy_; sel_ = 0; ab_ = acc_; } } } \
                BIN_ = __builtin_amdgcn_readlane(4 * lh_ + sel_, L_); ABV_ = __builtin_amdgcn_readlane(ab_, L_); } while (0)
#pragma unroll 1
            for (int qq = 0; qq < 2; ++qq) { const int q = 2 * wave + qq; int b1_, a1_; DSA_SCAN(h0 + q * 256, 256, b1_, a1_);        if (lh_ == 0) { lsel[q] = (unsigned)b1_; labv[q] = (unsigned)a1_; } }
            __syncthreads();
            const unsigned b1 = lsel[jh_]; const int ab1 = (int)labv[jh_];
            DSA_FOR_TILES(_Pragma("unroll") for (int e = 0; e < 4; ++e) { const unsigned x = u[T][e]; if (x != 0u && (x >> 24) == b1) __hip_atomic_fetch_add(h1 + jh_ * 256 + ((x >> 16) & 255u), 1u, __ATOMIC_RELAXED, __HIP_MEMORY_SCOPE_WORKGROUP); })
            __syncthreads();
#pragma unroll 1
            for (int qq = 0; qq < 2; ++qq) { const int q = 2 * wave + qq; const int need_ = 256 - (int)labv[q]; int b2_, a2_; DSA_SCAN(h1 + q * 256, need_, b2_, a2_); if (lh_ == 0) { lsel[16 + q] = (unsigned)b2_; labv[16 + q] = (unsigned)a2_; } }
#undef DSA_SCAN
            __syncthreads();
            prefix = (b1 << 24) | (lsel[16 + jh_] << 16); cab = ab1 + (int)labv[16 + jh_];
        }
#else
        if (tid < 16) lcnt[tid] = 0u;
#pragma unroll 1
        for (int bit = 31; bit >= DSA_S; --bit) {
            const unsigned cand = prefix | (1u << bit); int c0 = 0, c1 = 0;
            DSA_FOR_TILES(cnt_ge(c0, u[T][0], cand); cnt_ge(c1, u[T][1], cand); cnt_ge(c0, u[T][2], cand); cnt_ge(c1, u[T][3], cand);)
            const int tot = dsa_total(cnt, par, wave, j, gq, c0 + c1); par ^= 1;
            if (tot >= 256) prefix = cand; else cab = tot;
        }
#endif
        TP_MARK(1);
        { const unsigned ptop = prefix >> DSA_S;
          DSA_FOR_TILES(unsigned pos_[4]; bool cd_[4];
              _Pragma("unroll") for (int e = 0; e < 4; ++e) { const unsigned x = u[T][e]; cd_[e] = x != 0u && (x >> DSA_S) == ptop; pos_[e] = DSA_CAP; }
              _Pragma("unroll") for (int e = 0; e < 4; ++e) if (cd_[e]) pos_[e] = __hip_atomic_fetch_add(&lcnt[j], 1u, __ATOMIC_RELAXED, __HIP_MEMORY_SCOPE_WORKGROUP);
              _Pragma("unroll") for (int e = 0; e < 4; ++e) if (pos_[e] < DSA_CAP) llist[j * DSA_CAP + pos_[e]] = u[T][e];)
          if (wave == 0 && gq == 0) lcab[j] = (unsigned)cab; }
        __syncthreads();
        const bool ovf = __any(lcnt[j] > (unsigned)DSA_CAP);
        TP_ADD(14, ovf ? 1 : 0); TP_ADD(15, 1);
        if (!ovf) {
#pragma unroll 1
            for (int qq = 0; qq < 2; ++qq) {
                const int q = 2 * wave + qq; const int n = (int)lcnt[q]; const int r = 256 - (int)lcab[q];
                unsigned ev[DSA_CAP / 64];
#pragma unroll
                for (int i = 0; i < DSA_CAP / 64; ++i) ev[i] = (lane + 64 * i < n) ? llist[q * DSA_CAP + lane + 64 * i] : 0u;
                unsigned p2 = (unsigned)__shfl((int)prefix, q);
#pragma unroll 1
                for (int bit = DSA_S - 1; bit >= 0; --bit) {
                    const unsigned cand = p2 | (1u << bit); int c = 0;
#pragma unroll
                    for (int i = 0; i < DSA_CAP / 64; ++i) c += __popcll(__ballot(ev[i] >= cand));
                    if (c >= r) p2 = cand;
                }
                int cf = 0;
#pragma unroll
                for (int i = 0; i < DSA_CAP / 64; ++i) cf += __popcll(__ballot(ev[i] >= p2));
                if (lane == 0) { lvst[q] = p2; lexf[q] = (cf == r) ? 1u : 0u; }
            }
            __syncthreads();
            prefix = lvst[j]; exact = lexf[j] != 0u;
        } else {
#pragma unroll 1
            for (int bit = DSA_S - 1; bit >= 0; --bit) {
                const unsigned cand = prefix | (1u << bit); int c0 = 0, c1 = 0;
                DSA_FOR_TILES(cnt_ge(c0, u[T][0], cand); cnt_ge(c1, u[T][1], cand); cnt_ge(c0, u[T][2], cand); cnt_ge(c1, u[T][3], cand);)
                const int tot = dsa_total(cnt, par, wave, j, gq, c0 + c1); par ^= 1;
                if (!exact && tot >= 256) { prefix = cand; exact = (tot == 256); }
            }
        }
        TP_MARK(2);
        const bool alle = __all(exact);
        unsigned kp = 0u;
        if (!alle) {
        DSA_FOR_TILES(_Pragma("unroll") for (int e = 0; e < 4; ++e) { const unsigned x = u[T][e]; u[T][e] = (x > prefix || (exact && x == prefix)) ? 0u : (x == prefix ? (unsigned)(1 + kb0 + 128 * T + e) : 0xFFFFFFFFu); })
            __syncthreads();
#pragma unroll 1
            for (int bit = 11; bit >= 0; --bit) {
                const unsigned cand = kp | (1u << bit); int c0 = 0, c1 = 0;
                DSA_FOR_TILES(cnt_le(c0, u[T][0], cand); cnt_le(c1, u[T][1], cand); cnt_le(c0, u[T][2], cand); cnt_le(c1, u[T][3], cand);)
                const int tot = dsa_total(cnt, par, wave, j, gq, c0 + c1); par ^= 1;
                if (tot <= 255) kp = cand;
            }
        }
        const unsigned kp1 = kp + 1u;
        int ns0 = 0, ns1 = 0;
        if (alle) { DSA_FOR_TILES(cnt_ge(ns0, u[T][0], prefix); cnt_ge(ns1, u[T][1], prefix); cnt_ge(ns0, u[T][2], prefix); cnt_ge(ns1, u[T][3], prefix);) }
        else { DSA_FOR_TILES(cnt_le(ns0, u[T][0], kp1); cnt_le(ns1, u[T][1], kp1); cnt_le(ns0, u[T][2], kp1); cnt_le(ns1, u[T][3], kp1);) }
        pc[(wave * 4 + gq) * 16 + j] = (unsigned)(ns0 + ns1);
        __syncthreads();
        int base = 0;
        { const int me = wave * 4 + gq;
#pragma unroll
          for (int i = 0; i < 31; ++i) { const int v = (int)pc[i * 16 + j]; base += (i < me) ? v : 0; } }
        if (alle) { DSA_FOR_TILES(_Pragma("unroll") for (int e = 0; e < 4; ++e) { if (u[T][e] >= prefix) { list[j * 256 + base] = (unsigned short)(kb0 + 128 * T + e); ++base; }     }) }
        else { DSA_FOR_TILES(_Pragma("unroll") for (int e = 0; e < 4; ++e) { if (u[T][e] <= kp1) { if (base < 256) list[j * 256 + base] = (unsigned short)(kb0 + 128 * T + e); ++base; } }) }
        }
    } else {
        for (int i = tid; i < 16 * 256; i += 512) list[i] = (unsigned short)(i & 255);
    }
    __syncthreads();
    TP_MARK(3);
    {
    const int lane4_ = lane_id_v(); const int lane = lane4_, j = lane4_ & 15, gq = lane4_ >> 4;
    const bf16* kva = (const bf16*)(ws + WS_KVA);
    bf16* qa = (bf16*)(ws + WS_QA);
    LAS unsigned char* Vw = lds + DSA_OFF_V + wave * 16384;
    const unsigned vlds0 = (unsigned)(uintptr_t)(unsigned char*)Vw;
    const int tq2[2] = {q0 + 2 * wave, q0 + 2 * wave + 1};
    const int nselq[2] = {tq2[0] + 1 < 256 ? tq2[0] + 1 : 256, tq2[1] + 1 < 256 ? tq2[1] + 1 : 256};
    v4u qfq[2][2];
#pragma unroll
    for (int qq = 0; qq < 2; ++qq)
#pragma unroll
        for (int ks = 0; ks < 2; ++ks) { qfq[qq][ks] = (v4u){0u, 0u, 0u, 0u}; if (j < 8) qfq[qq][ks] = *(const v4u*)(qa + (size_t)(b * SEQ + tq2[qq]) * 512 + j * 64 + 8 * gq + 32 * ks); }
    asm volatile("s_waitcnt vmcnt(0)" : "+v"(qfq[0][0]), "+v"(qfq[0][1]), "+v"(qfq[1][0]), "+v"(qfq[1][1]) :: "memory");
    const bf16* kvb_ = kva + (size_t)b * SEQ * 128;
    const unsigned long long kvbase = ((unsigned long long)(unsigned)__builtin_amdgcn_readfirstlane((int)((unsigned long long)(uintptr_t)kvb_ >> 32)) << 32) | (unsigned long long)(unsigned)__builtin_amdgcn_readfirstlane((int)(unsigned)(uintptr_t)kvb_);
    const unsigned kofs = (unsigned)(((lane & 7) ^ (lane >> 3)) << 4), vofs = 128u + (unsigned)(lane & 7) * 16u;
#define DSA_KEY(M_, st_, slot_) ((unsigned)list[(2 * wave + ((st_) >> 2)) * 256 + ((M_) ? (((slot_) < nselq[(st_) >> 2]) ? (slot_) : 0) : (slot_))])
#define DSA_DMA8(M_, st_, OFS_, LDSB_) do { unsigned kv_[8]; _Pragma("unroll") for (int i_ = 0; i_ < 8; ++i_) kv_[i_] = DSA_KEY(M_, st_, 64 * ((st_) & 3) + 8 * i_ + (lane >> 3)) * 256u + (OFS_); \
        unsigned keep_; const unsigned ld_ = (unsigned)__builtin_amdgcn_readfirstlane((int)(LDSB_)); \
        asm volatile("s_mov_b32 %0, m0\n\ts_mov_b32 m0, %9\n\ts_nop 0\n\t" \
                     "global_load_lds_dwordx4 %1, %10\n\ts_add_u32 m0, m0, 0x400\n\ts_nop 0\n\t" "global_load_lds_dwordx4 %2, %10\n\ts_add_u32 m0, m0, 0x400\n\ts_nop 0\n\t" \
                     "global_load_lds_dwordx4 %3, %10\n\ts_add_u32 m0, m0, 0x400\n\ts_nop 0\n\t" "global_load_lds_dwordx4 %4, %10\n\ts_add_u32 m0, m0, 0x400\n\ts_nop 0\n\t" \
                     "global_load_lds_dwordx4 %5, %10\n\ts_add_u32 m0, m0, 0x400\n\ts_nop 0\n\t" "global_load_lds_dwordx4 %6, %10\n\ts_add_u32 m0, m0, 0x400\n\ts_nop 0\n\t" \
                     "global_load_lds_dwordx4 %7, %10\n\ts_add_u32 m0, m0, 0x400\n\ts_nop 0\n\t" "global_load_lds_dwordx4 %8, %10\n\ts_mov_b32 m0, %0" \
                     : "=&s"(keep_) : "v"(kv_[0]), "v"(kv_[1]), "v"(kv_[2]), "v"(kv_[3]), "v"(kv_[4]), "v"(kv_[5]), "v"(kv_[6]), "v"(kv_[7]), "s"(ld_), "s"(kvbase) : "memory", "scc"); } while (0)
    float mrow = NEGF, lrow = 0.f; f32x4v o[4];
#define DSA_STEP(M_, st_, NK_, NV_) do { \
        if (((st_) & 3) == 0) { mrow = NEGF; lrow = 0.f; _Pragma("unroll") for (int dt_ = 0; dt_ < 4; ++dt_) o[dt_] = (f32x4v){0.f, 0.f, 0.f, 0.f}; } \
        asm volatile("s_waitcnt vmcnt(" #NK_ ")" ::: "memory");                       \
        bf16x8 kf_[8]; \
        _Pragma("unroll") for (int kt_ = 0; kt_ < 4; ++kt_) _Pragma("unroll") for (int ks_ = 0; ks_ < 2; ++ks_) kf_[2 * kt_ + ks_] = *(const LAS bf16x8*)(Vw + 8192 + (16 * kt_ + j) * 128 + (((gq + 4 * ks_) ^ (j & 7)) << 4)); \
        if ((st_) + 1 < 8) { asm volatile("s_waitcnt lgkmcnt(0)" ::: "memory"); DSA_DMA8(M_, (st_) + 1, kofs, vlds0 + 8192); }       \
        const bf16x8 q0_ = __builtin_bit_cast(bf16x8, qfq[(st_) >> 2][0]), q1_ = __builtin_bit_cast(bf16x8, qfq[(st_) >> 2][1]); \
        f32x4v s_[4]; float bm_ = NEGF; \
        _Pragma("unroll") for (int kt_ = 0; kt_ < 4; ++kt_) { f32x4v a_ = {0.f, 0.f, 0.f, 0.f}; \
            a_ = __builtin_amdgcn_mfma_f32_16x16x32_bf16(kf_[2 * kt_], q0_, a_, 0, 0, 0); a_ = __builtin_amdgcn_mfma_f32_16x16x32_bf16(kf_[2 * kt_ + 1], q1_, a_, 0, 0, 0); \
            _Pragma("unroll") for (int e_ = 0; e_ < 4; ++e_) { const float v_ = (!(M_) || (64 * ((st_) & 3) + 16 * kt_ + 4 * gq + e_ < nselq[(st_) >> 2])) ? a_[e_] : NEGF; a_[e_] = v_; bm_ = fmaxf(bm_, v_); } s_[kt_] = a_; } \
        bm_ = xmax16(bm_); \
        { const float mnew_ = fmaxf(mrow, bm_), alpha_ = __builtin_amdgcn_exp2f(mrow - mnew_); mrow = mnew_; float ps_ = 0.f; \
          _Pragma("unroll") for (int kt_ = 0; kt_ < 4; ++kt_) _Pragma("unroll") for (int e_ = 0; e_ < 4; ++e_) { const float p_ = __builtin_amdgcn_exp2f(s_[kt_][e_] - mnew_); s_[kt_][e_] = p_; ps_ += p_; } \
          lrow = lrow * alpha_ + ps_; _Pragma("unroll") for (int dt_ = 0; dt_ < 4; ++dt_) o[dt_] *= alpha_; } \
        asm volatile("s_waitcnt vmcnt(" #NV_ ")" : "+v"(s_[0]), "+v"(s_[1]), "+v"(s_[2]), "+v"(s_[3]) :: "memory");       \
        _Pragma("unroll") for (int kk_ = 0; kk_ < 2; ++kk_) { \
            const bf16x8 pf_ = pack8(s_[2 * kk_][0], s_[2 * kk_][1], s_[2 * kk_][2], s_[2 * kk_][3], s_[2 * kk_ + 1][0], s_[2 * kk_ + 1][1], s_[2 * kk_ + 1][2], s_[2 * kk_ + 1][3]); \
            _Pragma("unroll") for (int dt_ = 0; dt_ < 4; ++dt_) { const LAS unsigned char* va_ = Vw + (32 * kk_ + 4 * gq + (j >> 2)) * 128 + (16 * dt_ + 4 * (j & 3)) * 2; \
                o[dt_] = __builtin_amdgcn_mfma_f32_16x16x32_bf16(cat4(tr16(va_), tr16(va_ + 16 * 128)), pf_, o[dt_], 0, 0, 0); } } \
        if (((st_) & 3) == 3) { const float inv_ = __builtin_amdgcn_rcpf(xsum16(lrow)); const int rowq_ = b * SEQ + tq2[(st_) >> 2]; \
            if (j < 8) { _Pragma("unroll") for (int dt_ = 0; dt_ < 4; ++dt_) { uint2 w_; w_.x = cvtpk(o[dt_][0] * inv_, o[dt_][1] * inv_); w_.y = cvtpk(o[dt_][2] * inv_, o[dt_][3] * inv_); \
                *(uint2*)(yout + (size_t)rowq_ * 512 + j * 64 + 16 * dt_ + 4 * gq) = w_; } } } \
        if ((st_) + 1 < 8) { asm volatile("s_waitcnt lgkmcnt(0)" ::: "memory"); DSA_DMA8(M_, (st_) + 1, vofs, vlds0); }            \
    } while (0)
#define DSA_RUN(M_) do { DSA_DMA8(M_, 0, kofs, vlds0 + 8192); DSA_DMA8(M_, 0, vofs, vlds0); \
    DSA_STEP(M_, 0, 8, 8); DSA_STEP(M_, 1, 8, 8); DSA_STEP(M_, 2, 8, 8); DSA_STEP(M_, 3, 8, 8); DSA_STEP(M_, 4, 8, 8); DSA_STEP(M_, 5, 8, 8); DSA_STEP(M_, 6, 8, 8); DSA_STEP(M_, 7, 8, 0); } while (0)
    if (q0 >= 256) DSA_RUN(0); else DSA_RUN(1);
#undef DSA_RUN
#undef DSA_STEP
#undef DSA_DMA8
#undef DSA_KEY
    }
    __syncthreads();
    TP_MARK(4);
}
__device__ __forceinline__ void phase_mixers(const Args& P, unsigned char* ws, int z, LAS unsigned char* lds, int gw, int NGW, int lane, int wave, int bid, int G, int l) {
    asm volatile("" : "+v"(lane)); lane &= 63; asm volatile("" : "+s"(gw), "+s"(NGW));
    unsigned* qc = (unsigned*)(ws + WS_CTL) + 9216 + l * 8;
    volatile LAS unsigned* bw = (volatile LAS unsigned*)(lds + LDSCTL_OFF) + 40;
    const bool lead = (wave == 0) && (lane == 0);
    int qid = (int)(xb_xcc_id() & 7u), tries = 0;
#define MIX_BCAST(v_) ({ if (lead) *bw = (unsigned)(v_); __syncthreads(); const int r_ = (int)*bw; __syncthreads(); __builtin_amdgcn_readfirstlane(r_); })
    int nx = 0; if (lead) nx = (int)__hip_atomic_fetch_add(qc + qid, 1u, __ATOMIC_RELAXED, __HIP_MEMORY_SCOPE_AGENT);
    int cur = MIX_BCAST(nx);
    for (;;) {
        while (cur >= 384) { if (++tries == 8) break; qid = (qid + 1) & 7; nx = 0; if (lead) nx = (int)__hip_atomic_fetch_add(qc + qid, 1u, __ATOMIC_RELAXED, __HIP_MEMORY_SCOPE_AGENT); cur = MIX_BCAST(nx); }
        if (cur >= 384) break;
        nx = 0; if (lead) nx = (int)__hip_atomic_fetch_add(qc + qid, 1u, __ATOMIC_RELAXED, __HIP_MEMORY_SCOPE_AGENT);
        const int t3 = cur / 3;
        if (cur - 3 * t3 == 0) { const int n = t3, unit = (qid * 2 + (n & 1)) * 64 + (63 - (n >> 1)); nsa_unit(ws, unit, lds, (wave << 6) | lane_id_v(), (bf16*)(ws + WS_QC)); }
        else { const int d = cur - t3 - 1, unit = qid * 256 + (255 - d); dsa_unit(ws, unit, lds, (wave << 6) | lane_id_v(), (bf16*)(ws + WS_QA)); }
        cur = MIX_BCAST(nx);
    }
#undef MIX_BCAST
}
__global__ void __launch_bounds__(NWAVES * 64, 2) fwd_kernel(Args args) {
    extern __shared__ __attribute__((aligned(16))) unsigned char lds_raw[];
    LAS unsigned char* lds = (LAS unsigned char*)lds_raw;
    const int wave = __builtin_amdgcn_readfirstlane((int)threadIdx.x >> 6);
#define TIDX ((wave << 6) | lane_id_v())
#define tid TIDX
#define lane TIDX
    const int G = gridDim.x, bid = blockIdx.x;
    const int gw = bid * NWAVES + wave, NGW = G * NWAVES;
    const int lo = args.ph_lo, hi = args.ph_hi;
    const Args& P = args;
    int z = 0; asm volatile("" : "+s"(z));
    unsigned char* ws = args.ws + z;
    volatile LAS unsigned* MISCW = (volatile LAS unsigned*)(lds + LDSCTL_OFF);
    if (tid < 64) MISCW[tid] = 0u;
    __syncthreads();
    XcdBarrier bar; bar.bar = (unsigned*)(ws + WS_CTL) + 4096; bar.x = 0; bar.st = nullptr;
    if (hi - lo > 1) bar = xcd_barrier_post((unsigned*)(ws + WS_CTL) + 4096, MISCW + 8);
#define RUN(k) (lo <= (k) && (k) < hi)
#if TPROBE
#define TP_PHASE(k) do { if (bid == 0 && TIDX == 0) { volatile unsigned long long* sl_ = (volatile unsigned long long*)(args.ws + z + 32768); const unsigned long long n_ = __builtin_amdgcn_s_memtime(); const int cls_ = (k) == 0 ? 0 : 1 + (((k) - 1) % NPL); sl_[16 + cls_] += n_ - sl_[30]; sl_[30] = n_; } } while (0)
#else
#define TP_PHASE(k)
#endif
#define SEAM(k) do { TP_PHASE(k); if ((k) + 1 < hi) { XcdBarrier b2_ = bar; asm volatile("" : "+s"(b2_.bar), "+s"(b2_.x)); xcd_barrier(b2_); if (DUP == 13) xcd_barrier(b2_); } else { VM_WAIT(); __syncthreads(); } } while (0)


#if TPROBE
    if (bid == 0 && TIDX == 0) { volatile unsigned long long* sl_ = (volatile unsigned long long*)(args.ws + z + 32768); sl_[30] = __builtin_amdgcn_s_memtime(); }
#endif
    if (RUN(0)) { phase_rope(P, ws, z, bid * (NWAVES * 64) + tid, G * NWAVES * 64);
        { int ln_ = TIDX; asm volatile("" : "+v"(ln_)); ln_ &= 63;
          for (int m = gw; m < M; m += 4 * NGW) stat_rows4_bf16(P.in[0 + z], (bf16*)(ws + WS_XN), (float*)(ws + WS_SSQ), m, NGW, ln_); }
        if (!RUN(1)) SEAM(0); }
#define RS_PREPASS(Sref) do { const float* ssq_ = (const float*)(ws + WS_SSQ); LAS float* rsl_ = (LAS float*)(lds + RS_OFF); const int t_ = TIDX; pg8::Unit u_; \
        for (int i_ = 0; (Sref).next(i_, u_); ++i_) { const f32x4* p_ = (const f32x4*)(ssq_ + (size_t)(u_.pm * 256 + (t_ >> 1)) * 16 + (t_ & 1) * 8); const f32x4 a_ = p_[0], b_ = p_[1]; \
            float s_ = (a_.x + a_.y) + (a_.z + a_.w) + (b_.x + b_.y) + (b_.z + b_.w); s_ += __shfl_xor(s_, 1); if ((t_ & 1) == 0) rsl_[i_ * 256 + (t_ >> 1)] = 1.0f / sqrtf(s_ * (1.f / DM) + EPS); } \
        __syncthreads(); } while (0)

    for (int it = 0; it < 2 * DEPTH; ++it) {
        const int l = it >> 1, second = it & 1, pb = 1 + l * NPL + (second ? 7 : 0);
        asm volatile("" : "+s"(z));
        ws = args.ws + z;
        bf16* const XN = (bf16*)(ws + WS_XN);
        bf16* const HB = (bf16*)(ws + WS_H);
        bf16* const MG = (bf16*)(ws + WS_MG);
        bf16* const GB = (bf16*)(ws + WS_G);
        unsigned char* const wb = ws + WS_W;
        float* const OUT = P.out + z;
        if (!second && RUN(pb)) { phase_convert(P, ws, z, l, lds, gw, NGW, lane, wave);
#if DUP == 30
            phase_convert(P, ws, z, l, lds, gw, NGW, lane, wave);
#endif
            SEAM(pb); }
        if (RUN(pb + 1)) {
            pg8::Gemm g{XN, (const bf16*)(wb + (second ? WO_GU2 : WO_GU1)), M, 2 * FF, DM}; pg8::StaticOrder S; S.init(M, 2 * FF, G, bid + z);
            pg8::EpiSwiglu E{HB, FF, (const LAS float*)(lds + RS_OFF)};
            RS_PREPASS(S);
#if !defined(SITE_MASK) || ((SITE_MASK >> 0) & 1)
            pg8::gemm_phase<pg8::EpiSwiglu, pg8::StaticOrder, ALIGN_UP, true>(lds, g, S, E, TIDX);
#if DUP == 3
            pg8::gemm_phase<pg8::EpiSwiglu, pg8::StaticOrder, ALIGN_UP, true>(lds, g, S, E, TIDX);
#endif
#endif
            SEAM(pb + 1);
        }
        if (RUN(pb + 2)) {
            pg8::Gemm g{HB, (const bf16*)(wb + (second ? WO_D2 : WO_D1)), M, DM, FF}; pg8::StaticOrder S; S.init(M, DM, G, bid + z);
            pg8::EpiResid E{XN, 0.5f, (float*)(ws + WS_SSQ)};
#if !defined(SITE_MASK) || ((SITE_MASK >> 1) & 1)
            pg8::gemm_phase<pg8::EpiResid, pg8::StaticOrder, true, true>(lds, g, S, E, TIDX);
#endif
            SEAM(pb + 2);
        }
        if (second) continue;
        const int pm = 1 + l * NPL + 2;
        if (RUN(pm + 1)) {
            pg8::Gemm g{XN, (const bf16*)(wb + WO_IN), M, NINP, DM}; pg8::StaticOrder S; S.init(M, NINP, G, bid + z);
            pg8::EpiWin E{(bf16*)(ws + WS_QA), (bf16*)(ws + WS_QC), (bf16*)(ws + WS_IQ), (bf16*)(ws + WS_MISC), (bf16*)(ws + WS_KVC), (bf16*)(ws + WS_KVS), (bf16*)(ws + WS_KVW), (bf16*)(ws + WS_BU), GB,
                          (const float*)(ws + WS_ROPE), (const LAS float*)(lds + RS_OFF)};
            RS_PREPASS(S);
#if !defined(SITE_MASK) || ((SITE_MASK >> 2) & 1)
            pg8::gemm_phase<pg8::EpiWin, pg8::StaticOrder, ALIGN_WIN, true>(lds, g, S, E, TIDX);
#if DUP == 4
            pg8::gemm_phase<pg8::EpiWin, pg8::StaticOrder, ALIGN_WIN, true>(lds, g, S, E, TIDX);
#endif
#endif
            SEAM(pm + 1);
        }
        #ifndef NO_PREP
        if (RUN(pm + 2)) { phase_prep(P, ws, z, l, lds, gw, NGW, lane, wave, (bf16*)OUT);
#if DUP == 1
            { XcdBarrier b2_ = bar; asm volatile("" : "+s"(b2_.bar), "+s"(b2_.x)); xcd_barrier(b2_); } phase_prep(P, ws, z, l, lds, gw, NGW, lane, wave, (bf16*)OUT);
#endif
            SEAM(pm + 2); }
#endif
        #ifndef NO_MIX
        if (RUN(pm + 3)) {
#if TPROBE
            unsigned long long tm0_ = __builtin_amdgcn_s_memtime();
#endif
            phase_mixers(P, ws, z, lds, gw, NGW, lane, wave, bid, G, l);
#if TPROBE
            { const unsigned long long tm1_ = __builtin_amdgcn_s_memtime(); if (TIDX == 0) { atomicAdd((unsigned long long*)(args.ws + z + 32768) + 12, tm1_ - tm0_); atomicMax((unsigned long long*)(args.ws + z + 32768) + 13 + (l & 1), tm1_ - tm0_); } }
#endif
            SEAM(pm + 3); }
#endif
        if (RUN(pm + 4)) {
#if DUP == 5
          for (int rep_ = 0; rep_ < 2; ++rep_) {
#endif
            pg8::StaticOrder S; S.init(M, DM, G, bid + z);
            { pg8::Gemm g{(const bf16*)(ws + WS_QA), (const bf16*)(wb + WO_PA), M, DM, 512}; pg8::EpiProj<0> E{MG, GB, 0};
#if !defined(SITE_MASK) || ((SITE_MASK >> 3) & 1)
              pg8::gemm_phase<pg8::EpiProj<0>, pg8::StaticOrder, true, true>(lds, g, S, E, TIDX);
#endif
            }
            { pg8::Gemm g{(const bf16*)OUT, (const bf16*)(wb + WO_PB), M, DM, 512}; pg8::EpiProj<1> E{MG, GB, 1024};
#if !defined(SITE_MASK) || ((SITE_MASK >> 4) & 1)
              pg8::gemm_phase<pg8::EpiProj<1>, pg8::StaticOrder, true, true>(lds, g, S, E, TIDX);
#endif
            }
            { pg8::Gemm g{(const bf16*)(ws + WS_QC), (const bf16*)(wb + WO_PC), M, DM, 512}; pg8::EpiProj<1> E{MG, GB, 2048};
#if !defined(SITE_MASK) || ((SITE_MASK >> 5) & 1)
              pg8::gemm_phase<pg8::EpiProj<1>, pg8::StaticOrder, true, true>(lds, g, S, E, TIDX);
#endif
            }
#if DUP == 5
          }
#endif
#if DUP == 31
            { pg8::Gemm g{(const bf16*)(ws + WS_QC), (const bf16*)(wb + WO_PC), M, DM, 512}; pg8::EpiPlain E{(bf16*)OUT + (size_t)32 * 1024 * 1024 / 2};
              pg8::gemm_phase<pg8::EpiPlain, pg8::StaticOrder, true, true>(lds, g, S, E, TIDX); }
#endif
            SEAM(pm + 4);
        }
        if (RUN(pm + 5)) {
            pg8::Gemm g{MG, (const bf16*)(wb + WO_OUT), M, DM, DM}; pg8::StaticOrder S; S.init(M, DM, G, bid + z);
            pg8::EpiResid E{XN, 1.0f, (float*)(ws + WS_SSQ)};
#if !defined(SITE_MASK) || ((SITE_MASK >> 6) & 1)
            pg8::gemm_phase<pg8::EpiResid, pg8::StaticOrder, true, true>(lds, g, S, E, TIDX);
#endif
            SEAM(pm + 5);
        }
    }
    if (RUN(NPH - 1)) { asm volatile("" : "+s"(z)); int ln_ = TIDX; asm volatile("" : "+v"(ln_)); ln_ &= 63; float* o_ = P.out + z; float tps_ = 1.0f;
#if TPROBE
        { const unsigned long long* sl_ = (const unsigned long long*)(P.ws + z + 32768); double a_ = 0., b_ = 0.; for (int k = 0; k < 32; ++k) { const double v_ = (double)__hip_atomic_load(sl_ + k, __ATOMIC_RELAXED, __HIP_MEMORY_SCOPE_AGENT); if (((unsigned)TP_A >> k) & 1) a_ += v_; if (((unsigned)TP_B >> k) & 1) b_ += v_; } tps_ = 1.0f + floorf((float)(a_ / b_) * TP_SCALE * 20.0f + 0.5f) * 0.05f; }
#endif
        { const bf16* xr_ = (const bf16*)(args.ws + z + WS_XN); for (int m = gw; m < M; m += 4 * NGW) norm_rows4_out(xr_, o_, P.in[23 + z], m, NGW, ln_, tps_); }
#if TPROBE
        if (gw == 0 && ln_ == 0) { const unsigned long long* sl_ = (const unsigned long long*)(P.ws + z + 32768); double c_ = 0., d_ = 0.; for (int k = 0; k < 32; ++k) { const double v_ = (double)__hip_atomic_load(sl_ + k, __ATOMIC_RELAXED, __HIP_MEMORY_SCOPE_AGENT); if (((unsigned)TP_C >> k) & 1) c_ += v_; if (((unsigned)TP_D >> k) & 1) d_ += v_; } o_[0] = 1000.0f * floorf((float)(c_ / d_) * TP_SCALE2 * 20.0f + 0.5f) * 0.05f; }
#endif
    }
#undef RUN
#undef tid
#undef TIDX
#undef lane
#undef SEAM
}

extern "C" void kernel_launch(void* const* d_in, const int* in_sizes, int n_in, void* d_out, int out_size, void* d_ws, size_t ws_size, hipStream_t stream) {
    static int grid = 0;
    if (grid == 0) {
        if (n_in != 24 || out_size != M * DM || ws_size < WS_END) { fprintf(stderr, "kernel_launch: unexpected shapes (n_in %d out %d ws %zu)\n", n_in, out_size, ws_size); grid = -1; return; }
        int dev = 0, cus = 0, per_cu = 0;
        if (hipGetDevice(&dev) != hipSuccess || hipDeviceGetAttribute(&cus, hipDeviceAttributeMultiprocessorCount, dev) != hipSuccess) { grid = -1; return; }
        if (hipFuncSetAttribute((const void*)fwd_kernel, hipFuncAttributeMaxDynamicSharedMemorySize, LDS_BYTES) != hipSuccess) { fprintf(stderr, "kernel_launch: hipFuncSetAttribute failed\n"); grid = -1; return; }
        if (hipOccupancyMaxActiveBlocksPerMultiprocessor(&per_cu, (const void*)fwd_kernel, NWAVES * 64, LDS_BYTES) != hipSuccess || per_cu < 1) { fprintf(stderr, "kernel_launch: occupancy query says %d\n", per_cu); }
        (void)hipGetLastError();
        grid = cus;
    }
    if (grid < 0) return;
    (void)hipMemsetAsync((char*)d_ws + WS_CTL, 0, CTL_ZERO_BYTES, stream);
    Args a{};
    for (int i = 0; i < 24; ++i) a.in[i] = (const float*)d_in[i];
    a.out = (float*)d_out; a.ws = (unsigned char*)d_ws;
#if MK_ONE_LAUNCH
    a.ph_lo = 0; a.ph_hi = NPH;
    hipLaunchKernelGGL(fwd_kernel, dim3(grid), dim3(NWAVES * 64), LDS_BYTES, stream, a);
#else
    for (int ph = 0; ph < NPH; ++ph) { a.ph_lo = ph; a.ph_hi = ph + 1; hipLaunchKernelGGL(fwd_kernel, dim3(grid), dim3(NWAVES * 64), LDS_BYTES, stream, a); }
#endif
}
```
